# Optimizing an MI355X kernel written in HIP

```python
import math
import jax, jax.numpy as jnp
from jax import lax
import numpy as np

D_MODEL = 2048
BATCH = 2
SEQ = 16384
DEPTH = 2

ALPHA = (2 * DEPTH) ** 0.25
BETA = (8 * DEPTH) ** -0.25
LN_EPS = 1e-5
ROPE_THETA = 10000.0
BLOCK = 128

A_HEADS = 16
A_KV_HEADS = 2
A_HEAD_DIM = 64
WINDOW = 128
A_Q = A_HEADS * A_HEAD_DIM
A_KV = A_KV_HEADS * A_HEAD_DIM
A_IN = A_Q + 2 * A_KV

B_HEADS = 16
B_HEAD_DIM = 64
B_W = B_HEADS * B_HEAD_DIM
DECAY_LORA = 96
AAA_LORA = 96
GATE_LORA = 256
GN_EPS = 64e-5
B_IN = 3 * B_W + DECAY_LORA + AAA_LORA + GATE_LORA
EVEN_IN = A_IN + B_IN
EVEN_MIX = A_Q + B_W

C_HEADS = 16
C_KV_HEADS = 4
C_HEAD_DIM = 128
IDX_HEADS = 16
IDX_DIM = 64
TOPK_MAX = 256
ODD_SPLITS = (C_HEADS * C_HEAD_DIM, C_KV_HEADS * C_HEAD_DIM, C_KV_HEADS * C_HEAD_DIM,
              IDX_HEADS * IDX_DIM, IDX_DIM, IDX_HEADS)
ODD_IN = sum(ODD_SPLITS)
ODD_MIX = C_HEADS * C_HEAD_DIM

PEER_HEADS = 8
PEER_NKEYS = 128
PEER_N = PEER_NKEYS * PEER_NKEYS
PEER_QDIM = 256
PEER_TOPK = 16

kernel_name = "hybrid_swa_rwkv7_dsa_peer_block"


def split_cols(z, sizes):
    return jnp.split(z, np.cumsum(sizes)[:-1].tolist(), axis=-1)


def layer_norm(x, g, b):
    xf = x.astype(jnp.float32)
    mu = jnp.mean(xf, -1, keepdims=True)
    var = jnp.mean(jnp.square(xf - mu), -1, keepdims=True)
    y = (xf - mu) * lax.rsqrt(var + LN_EPS)
    return (y * g.astype(jnp.float32) + b.astype(jnp.float32)).astype(x.dtype)


def modulation(c_act, w, b):
    m = c_act @ w + b
    shift, scale, gate = jnp.split(m[:, None, :], 3, axis=-1)
    return shift, scale, gate


def rotary(t, positions):
    d = t.shape[-1]
    half = d // 2
    inv = ROPE_THETA ** (-jnp.arange(half, dtype=jnp.float32) * (2.0 / d))
    ang = positions.astype(jnp.float32)[..., None] * inv
    cos, sin = jnp.cos(ang)[:, :, None, :], jnp.sin(ang)[:, :, None, :]
    tf = t.astype(jnp.float32)
    t1, t2 = tf[..., :half], tf[..., half:]
    return jnp.concatenate([t1 * cos - t2 * sin, t2 * cos + t1 * sin], -1).astype(t.dtype)


def token_shift(z):
    return jnp.pad(z[:, :-1], ((0, 0), (1, 0), (0, 0)))


def swa_sinks(q, k, v, sinks):
    B_, S_, H, dh = q.shape
    nb = S_ // BLOCK
    G = H // A_KV_HEADS
    qb = q.reshape(B_, nb, BLOCK, A_KV_HEADS, G, dh)

    def with_prev(t):
        tb = t.reshape(B_, nb, BLOCK, A_KV_HEADS, dh)
        prev = jnp.pad(tb[:, :-1], ((0, 0), (1, 0), (0, 0), (0, 0), (0, 0)))
        return jnp.concatenate([prev, tb], axis=2)

    kc, vc = with_prev(k), with_prev(v)
    s = jnp.einsum('bnqkgd,bnskd->bnkgqs', qb, kc).astype(jnp.float32) * (dh ** -0.5)
    qi = jnp.arange(BLOCK)[:, None] + BLOCK
    kj = jnp.arange(2 * BLOCK)[None, :]
    dist = qi - kj
    band = (dist >= 0) & (dist < WINDOW)
    has_prev = (jnp.arange(nb)[:, None, None] > 0) | (kj[None] >= BLOCK)
    mask = band[None] & has_prev
    s = jnp.where(mask[None, :, None, None], s, -jnp.inf)
    sink = jnp.broadcast_to(sinks.astype(jnp.float32).reshape(1, 1, A_KV_HEADS, G, 1, 1),
                            s.shape[:-1] + (1,))
    p = jax.nn.softmax(jnp.concatenate([s, sink], -1), axis=-1)[..., :-1]
    o = jnp.einsum('bnkgqs,bnskd->bnqkgd', p.astype(v.dtype), vc)
    return o.reshape(B_, S_, H * dh)


def rwkv7(z, w0, w2, a0, a2, g2, k_k, k_a, r_k, lnx_g, lnx_b):
    out_dtype = z.dtype
    f32 = jnp.float32
    z = z.astype(f32)
    r, k, v, wd, ad, gd = split_cols(z, (B_W, B_W, B_W, DECAY_LORA, AAA_LORA, GATE_LORA))
    B_, S_, _ = r.shape
    heads = lambda t: t.reshape(B_, S_, B_HEADS, B_HEAD_DIM)
    w_log = -jax.nn.softplus(-(w0.astype(f32) + jnp.tanh(wd) @ w2.astype(f32))) - 0.5
    decay = jnp.exp(-jnp.exp(w_log))
    a = jax.nn.sigmoid(a0.astype(f32) + ad @ a2.astype(f32))
    g = jax.nn.sigmoid(gd) @ g2.astype(f32)
    kk = heads(k * k_k.astype(f32))
    kk = kk / jnp.maximum(jnp.sqrt(jnp.sum(kk * kk, -1, keepdims=True)), 1e-12)
    k = k * (1.0 + (a - 1.0) * k_a.astype(f32))
    rh, kh, vh, ah, wh = heads(r), heads(k), heads(v), heads(a), heads(decay)

    def step(state, inp):
        r_t, w_t, k_t, v_t, kk_t, a_t = inp
        sa = jnp.einsum('bhvk,bhk->bhv', state, -kk_t)
        state = (state * w_t[:, :, None, :] + sa[..., None] * (kk_t * a_t)[:, :, None, :]
                 + v_t[..., None] * k_t[:, :, None, :])
        y_t = jnp.einsum('bhvk,bhk->bhv', state, r_t)
        return state, y_t

    s0 = jnp.zeros((B_, B_HEADS, B_HEAD_DIM, B_HEAD_DIM), f32)
    xs = tuple(jnp.moveaxis(t, 1, 0) for t in (rh, wh, kh, vh, kk, ah))
    _, y = lax.scan(step, s0, xs)
    y = jnp.moveaxis(y, 0, 1)
    mu = jnp.mean(y, -1, keepdims=True)
    var = jnp.mean(jnp.square(y - mu), -1, keepdims=True)
    y = ((y - mu) * lax.rsqrt(var + GN_EPS)).reshape(B_, S_, B_W)
    y = y * lnx_g.astype(f32) + lnx_b.astype(f32)
    bonus = jnp.sum(rh * kh * r_k.astype(f32), -1, keepdims=True) * vh
    y = (y + bonus.reshape(B_, S_, B_W)) * g
    return y.astype(out_dtype)


def dsa_attention(q, k, v, qi, ki, wi):
    B_, S_, H, dh = q.shape
    G = H // C_KV_HEADS
    nb = S_ // BLOCK
    n_sel = min(TOPK_MAX, S_ // 4)
    wi = wi.astype(jnp.float32) * (IDX_HEADS ** -0.5) * (IDX_DIM ** -0.5)
    key_pos = jnp.arange(S_)

    def blocks(t):
        return jnp.moveaxis(t.reshape((B_, nb, BLOCK) + t.shape[2:]), 1, 0)

    def one_block(args):
        qb, qib, wib, start = args
        tpos = start + jnp.arange(BLOCK)
        sc = jax.nn.relu(jnp.einsum('bthd,bsd->bths', qib, ki).astype(jnp.float32))
        score = jnp.einsum('bths,bth->bts', sc, wib)
        causal = key_pos[None, :] <= tpos[:, None]
        score = jnp.where(causal[None], score, -jnp.inf)
        _, idx = lax.top_k(score, n_sel)
        valid = idx <= tpos[None, :, None]
        kg = jax.vmap(lambda kb_, ib_: kb_[ib_])(k, idx)
        vg = jax.vmap(lambda vb_, ib_: vb_[ib_])(v, idx)
        qg = qb.reshape(B_, BLOCK, C_KV_HEADS, G, dh)
        s = jnp.einsum('btkgd,btskd->btkgs', qg, kg).astype(jnp.float32) * (dh ** -0.5)
        s = jnp.where(valid[:, :, None, None, :], s, -jnp.inf)
        p = jax.nn.softmax(s, axis=-1)
        o = jnp.einsum('btkgs,btskd->btkgd', p.astype(v.dtype), vg)
        return o.reshape(B_, BLOCK, H * dh)

    starts = jnp.arange(nb) * BLOCK
    out = lax.map(one_block, (blocks(q), blocks(qi), blocks(wi), starts))
    return jnp.moveaxis(out, 0, 1).reshape(B_, S_, H * dh)


def peer(h, wq, subkeys, u_tab, v_tab):
    B_, S_, D = h.shape
    tok = h.reshape(-1, BLOCK, D)

    def one_chunk(xc):
        q = (xc @ wq).reshape(BLOCK, PEER_HEADS, 2, PEER_QDIM // 2)
        s = jnp.einsum('thpd,phnd->thpn', q, subkeys).astype(jnp.float32)
        v_top, i_top = lax.top_k(s, PEER_TOPK)
        cand = v_top[:, :, 0, :, None] + v_top[:, :, 1, None, :]
        best, ci = lax.top_k(cand.reshape(BLOCK, PEER_HEADS, PEER_TOPK * PEER_TOPK), PEER_TOPK)
        i1 = jnp.take_along_axis(i_top[:, :, 0], ci // PEER_TOPK, axis=-1)
        i2 = jnp.take_along_axis(i_top[:, :, 1], ci % PEER_TOPK, axis=-1)
        eid = i1 * PEER_NKEYS + i2
        gsm = jax.nn.softmax(best, axis=-1)
        u = u_tab[eid]
        act = jax.nn.gelu(jnp.einsum('thkd,td->thk', u, xc).astype(jnp.float32),
                          approximate=False) * gsm
        return jnp.einsum('thk,thkd->td', act.astype(xc.dtype), v_tab[eid])

    return lax.map(one_chunk, tok).reshape(B_, S_, D)


def even_mixer(h, positions, w_in, w_out, sinks, mu, w0, w2, a0, a2, g2, k_k, k_a, r_k, lnx_g, lnx_b):
    B_, S_, _ = h.shape
    z = h @ w_in
    za, zb = z[..., :A_IN], z[..., A_IN:]
    qa, ka, va = split_cols(za, (A_Q, A_KV, A_KV))
    qa = rotary(qa.reshape(B_, S_, A_HEADS, A_HEAD_DIM), positions)
    ka = rotary(ka.reshape(B_, S_, A_KV_HEADS, A_HEAD_DIM), positions)
    va = va.reshape(B_, S_, A_KV_HEADS, A_HEAD_DIM)
    ya = swa_sinks(qa, ka, va, sinks)
    zb = zb + (token_shift(zb) - zb) * mu
    yb = rwkv7(zb, w0, w2, a0, a2, g2, k_k, k_a, r_k, lnx_g, lnx_b)
    return jnp.concatenate([ya, yb], axis=-1) @ w_out


def odd_mixer(h, positions, w_in, w_out):
    B_, S_, _ = h.shape
    z = h @ w_in
    q, k, v, qi, ki, wi = split_cols(z, ODD_SPLITS)
    q = rotary(q.reshape(B_, S_, C_HEADS, C_HEAD_DIM), positions)
    k = rotary(k.reshape(B_, S_, C_KV_HEADS, C_HEAD_DIM), positions)
    v = v.reshape(B_, S_, C_KV_HEADS, C_HEAD_DIM)
    qi = rotary(qi.reshape(B_, S_, IDX_HEADS, IDX_DIM), positions)
    ki = rotary(ki.reshape(B_, S_, 1, IDX_DIM), positions)[:, :, 0]
    return dsa_attention(q, k, v, qi, ki, wi) @ w_out


def setup_inputs(seed: int = 0) -> dict:
    key = jax.random.key(seed)
    ks = jax.random.split(key, 32)
    f32 = jnp.float32
    NE, NO = (DEPTH + 1) // 2, DEPTH // 2

    def nrm(k, shape, scale):
        return jax.random.normal(k, shape, f32) * scale

    x = nrm(ks[0], (BATCH, SEQ, D_MODEL), 1.0)
    c = nrm(ks[1], (BATCH, D_MODEL), 1.0)
    positions = (jnp.arange(SEQ, dtype=jnp.int32)[None, :]
                 + jax.random.randint(ks[2], (BATCH, 1), 0, 4096, dtype=jnp.int32))
    ev_w_in = nrm(ks[3], (NE, D_MODEL, EVEN_IN), D_MODEL ** -0.5)
    ev_w_out = nrm(ks[4], (NE, EVEN_MIX, D_MODEL), BETA * EVEN_MIX ** -0.5)
    ev_sinks = nrm(ks[5], (NE, A_HEADS), 0.5)
    ev_mu = jax.random.uniform(ks[6], (NE, B_IN), f32, 0.0, 1.0)
    ev_w0 = jax.random.uniform(ks[7], (NE, B_W), f32, -4.0, 1.0)
    ev_w2 = nrm(ks[8], (NE, DECAY_LORA, B_W), 0.5 * DECAY_LORA ** -0.5)
    ev_a0 = nrm(ks[9], (NE, B_W), 0.1)
    ev_a2 = nrm(ks[10], (NE, AAA_LORA, B_W), 0.5 * AAA_LORA ** -0.5)
    ev_g2 = nrm(ks[11], (NE, GATE_LORA, B_W), GATE_LORA ** -0.5)
    ev_k_k = 0.85 + nrm(ks[12], (NE, B_W), 0.02)
    ev_k_a = 1.0 + nrm(ks[13], (NE, B_W), 0.02)
    ev_r_k = nrm(ks[14], (NE, B_HEADS, B_HEAD_DIM), 0.1)
    ev_lnx_g = 1.0 + nrm(ks[15], (NE, B_W), 0.02)
    ev_lnx_b = nrm(ks[16], (NE, B_W), 0.02)
    od_w_in = nrm(ks[17], (NO, D_MODEL, ODD_IN), D_MODEL ** -0.5)
    od_w_out = nrm(ks[18], (NO, ODD_MIX, D_MODEL), BETA * ODD_MIX ** -0.5)
    mod_w = nrm(ks[19], (DEPTH, 2, D_MODEL, 3 * D_MODEL), 0.1 * D_MODEL ** -0.5)
    mod_b = nrm(ks[20], (DEPTH, 2, 3 * D_MODEL), 0.02)
    ln_g = 1.0 + nrm(ks[21], (DEPTH, 2, D_MODEL), 0.02)
    ln_b = nrm(ks[22], (DEPTH, 2, D_MODEL), 0.02)
    peer_wq = nrm(ks[23], (DEPTH, D_MODEL, PEER_HEADS * PEER_QDIM), D_MODEL ** -0.5)
    peer_subkeys = nrm(ks[24], (DEPTH, 2, PEER_HEADS, PEER_NKEYS, PEER_QDIM // 2),
                       (PEER_QDIM // 2) ** -0.5)
    peer_u = nrm(ks[25], (DEPTH, PEER_N, D_MODEL), D_MODEL ** -0.5)
    peer_v = nrm(ks[26], (DEPTH, PEER_N, D_MODEL), BETA * PEER_TOPK ** -0.5)
    return {"x": x, "c": c, "positions": positions,
            "ev_w_in": ev_w_in, "ev_w_out": ev_w_out, "ev_sinks": ev_sinks, "ev_mu": ev_mu,
            "ev_w0": ev_w0, "ev_w2": ev_w2, "ev_a0": ev_a0, "ev_a2": ev_a2, "ev_g2": ev_g2,
            "ev_k_k": ev_k_k, "ev_k_a": ev_k_a, "ev_r_k": ev_r_k,
            "ev_lnx_g": ev_lnx_g, "ev_lnx_b": ev_lnx_b,
            "od_w_in": od_w_in, "od_w_out": od_w_out,
            "mod_w": mod_w, "mod_b": mod_b, "ln_g": ln_g, "ln_b": ln_b,
            "peer_wq": peer_wq, "peer_subkeys": peer_subkeys, "peer_u": peer_u, "peer_v": peer_v}


def reference(x, c, positions, ev_w_in, ev_w_out, ev_sinks, ev_mu, ev_w0, ev_w2, ev_a0, ev_a2,
              ev_g2, ev_k_k, ev_k_a, ev_r_k, ev_lnx_g, ev_lnx_b, od_w_in, od_w_out,
              mod_w, mod_b, ln_g, ln_b, peer_wq, peer_subkeys, peer_u, peer_v):
    c_act = jax.nn.silu(c)
    for layer in range(DEPTH):
        j = layer // 2
        shift, scale, gate = modulation(c_act, mod_w[layer, 0], mod_b[layer, 0])
        h = x * (1.0 + scale) + shift
        if layer % 2 == 0:
            y = even_mixer(h, positions, ev_w_in[j], ev_w_out[j], ev_sinks[j], ev_mu[j],
                           ev_w0[j], ev_w2[j], ev_a0[j], ev_a2[j], ev_g2[j], ev_k_k[j],
                           ev_k_a[j], ev_r_k[j], ev_lnx_g[j], ev_lnx_b[j])
        else:
            y = odd_mixer(h, positions, od_w_in[j], od_w_out[j])
        x = layer_norm(ALPHA * x + (1.0 + gate) * y, ln_g[layer, 0], ln_b[layer, 0])
        shift, scale, gate = modulation(c_act, mod_w[layer, 1], mod_b[layer, 1])
        h = x * (1.0 + scale) + shift
        y = peer(h, peer_wq[layer], peer_subkeys[layer], peer_u[layer], peer_v[layer])
        x = layer_norm(ALPHA * x + (1.0 + gate) * y, ln_g[layer, 1], ln_b[layer, 1])
    return x
```

```cpp
#include <hip/hip_runtime.h>
#include <cstdio>
#include <cstdint>
namespace pg8 {
#define PG8_LAS __attribute__((address_space(3)))
typedef unsigned short bf16_t;
typedef short bf16x8 __attribute__((ext_vector_type(8)));
typedef float f32x4 __attribute__((ext_vector_type(4)));
typedef unsigned u32x4 __attribute__((ext_vector_type(4)));
constexpr int BM = 256, BK = 64, HALF = 128, HTB = HALF * BK * 2  , STAGE_BYTES = 8 * HTB, NXCD = 8, WGM = 8;

__host__ __device__ __forceinline__ int lds_byte(int r, int c) { const int st = (r >> 4) * 2 + (c >> 5), rr = r & 15, cc = c & 31, ob = rr * 64 + cc * 2; return st * 1024 + (ob ^ (((ob >> 9) & 1) << 5)); }
__host__ __device__ __forceinline__ void stage_rc(int b, int& R, int& C) { const int st = b / 1024, sb = b % 1024, swz = sb ^ (((sb >> 9) & 1) << 5); R = (st >> 1) * 16 + swz / 64; C = (st & 1) * 32 + (swz % 64) / 2; }
__host__ __device__ __forceinline__ int perm32(int rho) { const int n = rho >> 4, i = rho & 15; return 8 * (i >> 2) + 4 * n + (i & 3); }

struct Unit { int pm, pn; };
struct Gemm { const bf16_t* A; const bf16_t* Bt; int M, N, K; };

struct StaticOrder {
    int nM, nN, nwg, G, c;
    __host__ __device__ void init(int M, int N, int G_, int c_) { nM = M / BM; nN = N / BM; nwg = nM * nN; G = G_; c = c_; }
    __host__ __device__ bool next(int i, Unit& u) const {
        const long L = (long)i * G + c; if (L >= nwg) return false;
        int wgid = (int)L; { const int q = nwg / NXCD, r = nwg % NXCD, xcd = wgid % NXCD, off = wgid / NXCD; wgid = (xcd < r ? xcd * (q + 1) : r * (q + 1) + (xcd - r) * q) + off; }
        const int nig = WGM * nN, gid = wgid / nig, fm = gid * WGM, gsz = (nM - fm) < WGM ? (nM - fm) : WGM;
        u.pm = fm + ((wgid % nig) % gsz); u.pn = (wgid % nig) / gsz; return true;
    }
    __device__ __forceinline__ void a_ready(const Unit&) const {}
    __device__ __forceinline__ void done(const Unit&) const {}
};
struct CountedOrder : StaticOrder {
    const unsigned* ready; unsigned need; unsigned* tmo;
    __device__ __forceinline__ void a_ready(const Unit& u) const {
        if (threadIdx.x < 64) {
            const unsigned long long t0 = __builtin_amdgcn_s_memrealtime(); unsigned polls = 0;
            while ((unsigned)__builtin_amdgcn_readfirstlane(__hip_atomic_load(ready + 64 * u.pm, __ATOMIC_RELAXED, __HIP_MEMORY_SCOPE_AGENT)) < need) {
                if ((++polls & 255u) == 0u && __builtin_amdgcn_readfirstlane(__hip_atomic_load(tmo, __ATOMIC_RELAXED, __HIP_MEMORY_SCOPE_AGENT)) != 0u) break;
                if (__builtin_amdgcn_s_memrealtime() - t0 > 2000000ull) {
                    if (threadIdx.x == 0) { unsigned expect = 0u; __hip_atomic_compare_exchange_strong(tmo + 1, &expect, 0x600u | (unsigned)(u.pm & 0xff), __ATOMIC_RELAXED, __ATOMIC_RELAXED, __HIP_MEMORY_SCOPE_AGENT); __hip_atomic_store(tmo, 1u, __ATOMIC_RELAXED, __HIP_MEMORY_SCOPE_AGENT); }
                    break; }
                __builtin_amdgcn_s_sleep(2); }
            __builtin_amdgcn_fence(__ATOMIC_ACQUIRE, "agent");
            asm volatile("s_waitcnt vmcnt(0)" ::: "memory");
        }
#if !defined(BROKEN_HOOK_NO_BARRIER)
        asm volatile("" ::: "memory"); __builtin_amdgcn_s_barrier(); asm volatile("" ::: "memory");
#endif
    }
};

__device__ __forceinline__ unsigned cvt_pk_bf16(float lo, float hi) { unsigned r; asm volatile("v_cvt_pk_bf16_f32 %0, %1, %2" : "=v"(r) : "v"(lo), "v"(hi)); return r; }
typedef float f32x2 __attribute__((ext_vector_type(2)));
__device__ __forceinline__ f32x2 gelu_pk(f32x2 v) {
    const f32x2 av = __builtin_elementwise_abs(v), d = av * 0.2316418882f + 1.0f;
    f32x2 t; t.x = __builtin_amdgcn_rcpf(d.x); t.y = __builtin_amdgcn_rcpf(d.y);
    f32x2 q = t * 0.5307027145f + (-0.7265760135f); q = q * t + 0.7107068705f; q = q * t + (-0.142248368f); q = q * t + 0.127414796f; q = q * t;
    const f32x2 s = (v * v) * (-0.72134752044f);
    f32x2 e; e.x = __builtin_amdgcn_exp2f(s.x); e.y = __builtin_amdgcn_exp2f(s.y);
    const f32x2 m = v * (q * e), r = v - m;
    f32x2 o; o.x = v.x < 0.f ? m.x : r.x; o.y = v.y < 0.f ? m.y : r.y; return o;
}

struct EpiF32 {
    static constexpr bool PERM = false, AFTER_DRAIN = false;
    float* C; int ldc; const float* bias;
    __device__ __forceinline__ void operator()(const f32x4 (&acc)[2][2][4][2], const Unit& u, int wr, int wc, int fr, int fq) const {
        const int row0 = u.pm * BM + wr * 64 + fr, col0 = u.pn * BM + wc * 32 + 4 * fq;
        f32x4 bv[2][2];
#pragma unroll
        for (int bj = 0; bj < 2; ++bj)
#pragma unroll
            for (int n = 0; n < 2; ++n) bv[bj][n] = bias ? *(const f32x4*)(bias + col0 + bj * HALF + n * 16) : (f32x4){0.f, 0.f, 0.f, 0.f};
#pragma unroll
        for (int ai = 0; ai < 2; ++ai)
#pragma unroll
            for (int m = 0; m < 4; ++m) { float* rowp = C + (size_t)(row0 + ai * HALF + m * 16) * ldc + col0;
#pragma unroll
                for (int bj = 0; bj < 2; ++bj)
#pragma unroll
                    for (int n = 0; n < 2; ++n) *(f32x4*)(rowp + bj * HALF + n * 16) = acc[ai][bj][m][n] + bv[bj][n]; }
    }
};
template <int ACT  > struct EpiBf16 {
    static constexpr bool PERM = true, AFTER_DRAIN = false;
    bf16_t* O; int ldc; const float* bias; int split_cols; size_t split_stride;
    __device__ __forceinline__ void operator()(const f32x4 (&acc)[2][2][4][2], const Unit& u, int wr, int wc, int fr, int fq) const {
        const int row0 = u.pm * BM + wr * 64 + fr; int colt = u.pn * BM; bf16_t* base = O;
        if (split_cols) { const int t = colt / split_cols; base += (size_t)t * split_stride; colt -= t * split_cols; }
        const int col0 = colt + wc * 32 + 8 * fq, bcol0 = u.pn * BM + wc * 32 + 8 * fq;
        f32x4 bv[2][2];
#pragma unroll
        for (int bj = 0; bj < 2; ++bj)
#pragma unroll
            for (int n = 0; n < 2; ++n) bv[bj][n] = bias ? *(const f32x4*)(bias + bcol0 + bj * HALF + 4 * n) : (f32x4){0.f, 0.f, 0.f, 0.f};
#pragma unroll
        for (int ai = 0; ai < 2; ++ai)
#pragma unroll
            for (int m = 0; m < 4; ++m) { bf16_t* rowp = base + (size_t)(row0 + ai * HALF + m * 16) * ldc + col0;
#pragma unroll
                for (int bj = 0; bj < 2; ++bj) { f32x4 v0 = acc[ai][bj][m][0] + bv[bj][0], v1 = acc[ai][bj][m][1] + bv[bj][1];
                    if (ACT == 1) { f32x2 a = gelu_pk((f32x2){v0[0], v0[1]}), b = gelu_pk((f32x2){v0[2], v0[3]}), c = gelu_pk((f32x2){v1[0], v1[1]}), d = gelu_pk((f32x2){v1[2], v1[3]});
                        v0 = (f32x4){a.x, a.y, b.x, b.y}; v1 = (f32x4){c.x, c.y, d.x, d.y}; }
                    if (ACT == 2) {
#pragma unroll
                        for (int j = 0; j < 4; ++j) { v0[j] = 0.5f * v0[j] * (1.0f + erff(v0[j] * 0.70710678f)); v1[j] = 0.5f * v1[j] * (1.0f + erff(v1[j] * 0.70710678f)); } }
                    u32x4 w; w.x = cvt_pk_bf16(v0[0], v0[1]); w.y = cvt_pk_bf16(v0[2], v0[3]); w.z = cvt_pk_bf16(v1[0], v1[1]); w.w = cvt_pk_bf16(v1[2], v1[3]);
                    *(u32x4*)(rowp + bj * HALF) = w; } }
    }
};

struct PanelStats {
    unsigned* xbuf;
    unsigned* cnt;
    unsigned* tmo;
    int ntn; float eps;
    unsigned code;
    __device__ __forceinline__ bool run(const f32x4 (&v)[2][2][4][2], const Unit& u, int wr, int wc, int fr, int fq, PG8_LAS unsigned char* lds, int wid, int lane) const {
        typedef float f32x2v __attribute__((ext_vector_type(2)));
        PG8_LAS f32x2v* P = (PG8_LAS f32x2v*)lds;
        PG8_LAS f32x2v* S = (PG8_LAS f32x2v*)(lds + 8192);
        PG8_LAS unsigned* flag = (PG8_LAS unsigned*)(lds + 8192 + 2048);
#pragma unroll
        for (int ai = 0; ai < 2; ++ai)
#pragma unroll
            for (int m = 0; m < 4; ++m) {
                float s = 0.f;
#pragma unroll
                for (int bj = 0; bj < 2; ++bj)
#pragma unroll
                    for (int n = 0; n < 2; ++n) { const f32x4 x = v[ai][bj][m][n]; s += (x[0] + x[1]) + (x[2] + x[3]); }
                s += __shfl_xor(s, 16); s += __shfl_xor(s, 32);
                const float mw = s * (1.0f / 64.0f); float q = 0.f;
#pragma unroll
                for (int bj = 0; bj < 2; ++bj)
#pragma unroll
                    for (int n = 0; n < 2; ++n) { const f32x4 d = v[ai][bj][m][n] - mw; q += (d[0] * d[0] + d[1] * d[1]) + (d[2] * d[2] + d[3] * d[3]); }
                q += __shfl_xor(q, 16); q += __shfl_xor(q, 32);
                if (fq == 0) P[(ai * HALF + wr * 64 + m * 16 + fr) * 4 + wc] = (f32x2v){mw, q};
            }
        asm volatile("s_waitcnt lgkmcnt(0)" ::: "memory"); __builtin_amdgcn_s_barrier(); asm volatile("" ::: "memory");
#if defined(BROKEN_NO_WAIT)
        if (blockIdx.x >= 64) { const long long t0 = clock64(); while (clock64() - t0 < 60000) __builtin_amdgcn_s_sleep(8); }
#endif
        const int row = wid * 32 + (lane & 31);
        if (lane < 32) {
            const f32x2v a = P[row * 4 + 0], b = P[row * 4 + 1], c = P[row * 4 + 2], d = P[row * 4 + 3];
            const float mt = (a.x + b.x + c.x + d.x) * 0.25f;
            const float da = a.x - mt, db = b.x - mt, dc = c.x - mt, dd = d.x - mt;
            const float m2 = (a.y + b.y) + (c.y + d.y) + 64.0f * ((da * da + db * db) + (dc * dc + dd * dd));
            unsigned long long* slot = (unsigned long long*)xbuf + ((size_t)(u.pm * BM + row) * 4 + u.pn);
            __hip_atomic_store(slot, ((unsigned long long)__float_as_uint(m2) << 32) | __float_as_uint(mt), __ATOMIC_RELAXED, __HIP_MEMORY_SCOPE_AGENT);
        }
        asm volatile("s_waitcnt vmcnt(0)" ::: "memory");
        if (lane == 0) __hip_atomic_fetch_add(cnt + 64 * u.pm, 1u, __ATOMIC_RELAXED, __HIP_MEMORY_SCOPE_AGENT);
        if (wid == 0) {
            bool dead = false; const unsigned long long t0 = __builtin_amdgcn_s_memrealtime(); const unsigned want = 8u * (unsigned)ntn;
            for (;;) {
#if defined(BROKEN_NO_WAIT)
                break;
#endif
                if ((unsigned)__builtin_amdgcn_readfirstlane(__hip_atomic_load(cnt + 64 * u.pm, __ATOMIC_RELAXED, __HIP_MEMORY_SCOPE_AGENT)) >= want) break;
                if (__builtin_amdgcn_s_memrealtime() - t0 > 2000000ull) {
                    if (lane == 0) { unsigned expect = 0u; __hip_atomic_compare_exchange_strong(tmo + 1, &expect, code | (unsigned)(u.pm & 0xff), __ATOMIC_RELAXED, __ATOMIC_RELAXED, __HIP_MEMORY_SCOPE_AGENT);
                                     __hip_atomic_store(tmo, 1u, __ATOMIC_RELAXED, __HIP_MEMORY_SCOPE_AGENT); }
                    dead = true; break; }
                __builtin_amdgcn_s_sleep(2);
            }
            __builtin_amdgcn_fence(__ATOMIC_ACQUIRE, "agent");
            if (lane == 0) flag[0] = dead ? 1u : 0u;
        }
        asm volatile("s_waitcnt vmcnt(0) lgkmcnt(0)" ::: "memory"); __builtin_amdgcn_s_barrier(); asm volatile("" ::: "memory");
        const bool bad = flag[0] != 0u;
        if (lane < 32) {
            const unsigned long long* slot = (const unsigned long long*)xbuf + (size_t)(u.pm * BM + row) * 4; float mt[4], m2[4]; float ms = 0.f;
#pragma unroll
            for (int t = 0; t < 4; ++t) { if (t < ntn) { const unsigned long long w = __hip_atomic_load(slot + t, __ATOMIC_RELAXED, __HIP_MEMORY_SCOPE_AGENT); mt[t] = __uint_as_float((unsigned)w); m2[t] = __uint_as_float((unsigned)(w >> 32)); } else { mt[t] = 0.f; m2[t] = 0.f; } ms += mt[t]; }
            const float mean = ms / (float)ntn; float q = 0.f;
#pragma unroll
            for (int t = 0; t < 4; ++t) if (t < ntn) { const float dm = mt[t] - mean; q += m2[t] + 256.0f * dm * dm; }
            S[row] = (f32x2v){mean, 1.0f / sqrtf(q / (256.0f * (float)ntn) + eps)};
        }
        asm volatile("s_waitcnt lgkmcnt(0)" ::: "memory"); __builtin_amdgcn_s_barrier(); asm volatile("" ::: "memory");
        return bad;
    }
};
struct EpiLnRes {
    static constexpr bool PERM = false, AFTER_DRAIN = true;
    const float* base; float* out; int ldc; const float* bias; PanelStats st; unsigned poison;
    __device__ __forceinline__ void refuse(size_t i0, size_t stride, int M, int N) const { const float q = __builtin_nanf(""); for (size_t i = i0; i < (size_t)M * N; i += stride) out[(i / N) * ldc + i % N] = q;
        if (i0 == 0) { unsigned expect = 0u; __hip_atomic_compare_exchange_strong(st.tmo + 1, &expect, 0x7f0u, __ATOMIC_RELAXED, __ATOMIC_RELAXED, __HIP_MEMORY_SCOPE_AGENT); __hip_atomic_store(st.tmo, 1u, __ATOMIC_RELAXED, __HIP_MEMORY_SCOPE_AGENT); } }
    __device__ __forceinline__ void fused(f32x4 (&acc)[2][2][4][2], const Unit& u, int wr, int wc, int fr, int fq, PG8_LAS unsigned char* lds, int wid, int lane) const {
        typedef float f32x2v __attribute__((ext_vector_type(2)));
        const PG8_LAS f32x2v* S = (const PG8_LAS f32x2v*)(lds + 8192);
        const int col0 = u.pn * BM + wc * 32 + 4 * fq;
#pragma unroll
        for (int bj = 0; bj < 2; ++bj)
#pragma unroll
            for (int n = 0; n < 2; ++n) { const f32x4 bv = bias ? *(const f32x4*)(bias + col0 + bj * HALF + n * 16) : (f32x4){0.f, 0.f, 0.f, 0.f};
#pragma unroll
                for (int ai = 0; ai < 2; ++ai)
#pragma unroll
                    for (int m = 0; m < 4; ++m) acc[ai][bj][m][n] += bv; }
        const bool bad = st.run(acc, u, wr, wc, fr, fq, lds, wid, lane) || poison != 0u;
        const float qnan = __builtin_nanf("");
#pragma unroll
        for (int ai = 0; ai < 2; ++ai)
#pragma unroll
            for (int m = 0; m < 4; ++m) { const int r = ai * HALF + wr * 64 + m * 16 + fr; const f32x2v sr = S[r]; const size_t off = (size_t)(u.pm * BM + r) * ldc + col0;
#pragma unroll
                for (int bj = 0; bj < 2; ++bj)
#pragma unroll
                    for (int n = 0; n < 2; ++n) { const f32x4 bs = *(const f32x4*)(base + off + bj * HALF + n * 16); f32x4 o = bs + (acc[ai][bj][m][n] - sr.x) * sr.y;
                        if (bad) o = (f32x4){qnan, qnan, qnan, qnan}; *(f32x4*)(out + off + bj * HALF + n * 16) = o; }
                asm volatile("" ::: "memory"); }
    }
};
struct EpiLnResLn {
    static constexpr bool PERM = false, AFTER_DRAIN = true;
    const float* base; float* out; bf16_t* xn; int ldc; const float* bias; PanelStats st1, st2; unsigned poison;
    __device__ __forceinline__ void refuse(size_t i0, size_t stride, int M, int N) const { const float q = __builtin_nanf(""); for (size_t i = i0; i < (size_t)M * N; i += stride) { const size_t o = (i / N) * ldc + i % N; out[o] = q; xn[o] = (bf16_t)0x7fc0u; }
        if (i0 == 0) { unsigned expect = 0u; __hip_atomic_compare_exchange_strong(st1.tmo + 1, &expect, 0x7f0u, __ATOMIC_RELAXED, __ATOMIC_RELAXED, __HIP_MEMORY_SCOPE_AGENT); __hip_atomic_store(st1.tmo, 1u, __ATOMIC_RELAXED, __HIP_MEMORY_SCOPE_AGENT); } }
    __device__ __forceinline__ void fused(f32x4 (&acc)[2][2][4][2], const Unit& u, int wr, int wc, int fr, int fq, PG8_LAS unsigned char* lds, int wid, int lane) const {
        typedef float f32x2v __attribute__((ext_vector_type(2))); typedef unsigned u32x2v __attribute__((ext_vector_type(2)));
        const PG8_LAS f32x2v* S = (const PG8_LAS f32x2v*)(lds + 8192);
        const int col0 = u.pn * BM + wc * 32 + 4 * fq;
#pragma unroll
        for (int bj = 0; bj < 2; ++bj)
#pragma unroll
            for (int n = 0; n < 2; ++n) { const f32x4 bv = bias ? *(const f32x4*)(bias + col0 + bj * HALF + n * 16) : (f32x4){0.f, 0.f, 0.f, 0.f};
#pragma unroll
                for (int ai = 0; ai < 2; ++ai)
#pragma unroll
                    for (int m = 0; m < 4; ++m) acc[ai][bj][m][n] += bv; }
        bool bad = st1.run(acc, u, wr, wc, fr, fq, lds, wid, lane) || poison != 0u;
        const float qnan = __builtin_nanf("");
#pragma unroll
        for (int ai = 0; ai < 2; ++ai)
#pragma unroll
            for (int m = 0; m < 4; ++m) { const int r = ai * HALF + wr * 64 + m * 16 + fr; const f32x2v sr = S[r]; const size_t off = (size_t)(u.pm * BM + r) * ldc + col0;
#pragma unroll
                for (int bj = 0; bj < 2; ++bj)
#pragma unroll
                    for (int n = 0; n < 2; ++n) { const f32x4 bs = *(const f32x4*)(base + off + bj * HALF + n * 16); acc[ai][bj][m][n] = bs + (acc[ai][bj][m][n] - sr.x) * sr.y; }
                asm volatile("" : "+v"(acc[ai][0][m][0]), "+v"(acc[ai][0][m][1]), "+v"(acc[ai][1][m][0]), "+v"(acc[ai][1][m][1]));
                if (m & 1) asm volatile("" ::: "memory"); }
        const bool bad1 = bad;
        bad = st2.run(acc, u, wr, wc, fr, fq, lds, wid, lane) || bad;
#pragma unroll
        for (int ai = 0; ai < 2; ++ai)
#pragma unroll
            for (int m = 0; m < 4; ++m) { const int r = ai * HALF + wr * 64 + m * 16 + fr; const f32x2v sr = S[r]; const size_t off = (size_t)(u.pm * BM + r) * ldc + col0;
#pragma unroll
                for (int bj = 0; bj < 2; ++bj)
#pragma unroll
                    for (int n = 0; n < 2; ++n) { const f32x4 x1 = acc[ai][bj][m][n]; *(f32x4*)(out + off + bj * HALF + n * 16) = bad1 ? (f32x4){qnan, qnan, qnan, qnan} : x1;
                        const f32x4 o = (x1 - sr.x) * sr.y; u32x2v w; w.x = cvt_pk_bf16(o[0], o[1]); w.y = cvt_pk_bf16(o[2], o[3]);
                        if (bad) { w.x = 0x7fc07fc0u; w.y = 0x7fc07fc0u; } *(u32x2v*)(xn + off + bj * HALF + n * 16) = w; }
                asm volatile("" ::: "memory"); }
    }
};

template <class Epi, class Sched, bool STAMP = false>
__device__ __forceinline__ void gemm_phase(PG8_LAS unsigned char* lds, const Gemm g, const Sched& S, const Epi& E, unsigned long long* stamps) {
    const int tid = threadIdx.x, wid = __builtin_amdgcn_readfirstlane(tid >> 6), lane = tid & 63, wr = wid >> 2, wc = wid & 3, fr = lane & 15, fq = lane >> 4;
    const int K = g.K, nt = K / BK;
    int ts_lo = 0, ts_hi = 0, nts = 0; const unsigned long long rt_entry = STAMP ? (unsigned long long)wall_clock64() : 0ull;
#define PG8_STAMP() do { if (STAMP && wid == 0 && nts < 64) { const unsigned long long _c = (unsigned long long)clock64(); \
        ts_lo = (lane == nts) ? (int)(unsigned)_c : ts_lo; ts_hi = (lane == nts) ? (int)(unsigned)(_c >> 32) : ts_hi; ++nts; } } while (0)
    PG8_STAMP();
    unsigned voffA[2], voffB[2];
#pragma unroll
    for (int i = 0; i < 2; ++i) { int R, C; stage_rc(tid * 16 + i * 8192, R, C); const int Rb = Epi::PERM ? ((R & ~31) + perm32(R & 31)) : R;
        voffA[i] = (unsigned)(R * K + C) * 2u; voffB[i] = (unsigned)(Rb * K + C) * 2u; }
    const size_t kstep = (size_t)(BK * 2);
    const size_t hstep = (size_t)HALF * K * 2;
    const size_t tstep = 2 * hstep;
    const unsigned ldsw = (unsigned)wid * 1024u;
    const int aoff = lds_byte(wr * 64 + fr, fq * 8), boff = lds_byte(wc * 32 + fr, fq * 8);
#define PG8_SA(b, h) (((b) * 2 + (h)) * HTB)
#define PG8_SB(b, h) ((4 + (b) * 2 + (h)) * HTB)
#define PG8_STAGE(bufoff, gbase, voff) do { _Pragma("unroll") for (int _i = 0; _i < 2; ++_i) \
        __builtin_amdgcn_global_load_lds((const unsigned*)((const char*)(gbase) + (voff)[_i]), (PG8_LAS unsigned*)(lds + (bufoff) + ldsw + _i * 8192), 16, 0, 0); } while (0)
#define PG8_LDA(dst, b, h) do { _Pragma("unroll") for (int m = 0; m < 4; ++m) _Pragma("unroll") for (int k = 0; k < 2; ++k) dst[m][k] = *(const PG8_LAS bf16x8*)(lds + PG8_SA(b, h) + aoff + m * 2048 + k * 1024); } while (0)
#define PG8_LDB(dst, b, h) do { _Pragma("unroll") for (int n = 0; n < 2; ++n) _Pragma("unroll") for (int k = 0; k < 2; ++k) dst[n][k] = *(const PG8_LAS bf16x8*)(lds + PG8_SB(b, h) + boff + n * 2048 + k * 1024); } while (0)
#define PG8_MMA(ai, bj, At, Bt) do { __builtin_amdgcn_s_setprio(1); _Pragma("unroll") for (int m = 0; m < 4; ++m) _Pragma("unroll") for (int n = 0; n < 2; ++n) _Pragma("unroll") for (int k = 0; k < 2; ++k) \
        acc[ai][bj][m][n] = __builtin_amdgcn_mfma_f32_16x16x32_bf16(Bt[n][k], At[m][k], acc[ai][bj][m][n], 0, 0, 0); __builtin_amdgcn_s_setprio(0); } while (0)
#define PG8_WAIT_V(n) asm volatile("s_waitcnt vmcnt(" #n ")" ::: "memory")
#define PG8_WAIT_L(n) asm volatile("s_waitcnt lgkmcnt(" #n ")" ::: "memory")
#define PG8_BAR __builtin_amdgcn_s_barrier()
#define PG8_SCHED __builtin_amdgcn_sched_barrier(0)
    Unit cur, nxt; int ui = 0;
    if (!S.next(0, cur)) return;
    f32x4 acc[2][2][4][2];
#pragma unroll
    for (int a = 0; a < 2; ++a)
#pragma unroll
        for (int b = 0; b < 2; ++b)
#pragma unroll
            for (int m = 0; m < 4; ++m)
#pragma unroll
                for (int n = 0; n < 2; ++n) acc[a][b][m][n] = (f32x4){0.f, 0.f, 0.f, 0.f};
    bf16x8 At[4][2], B0[2][2], B1[2][2];
    const char* cA = (const char*)g.A + (size_t)cur.pm * tstep; const char* cB = (const char*)g.Bt + (size_t)cur.pn * tstep;
    S.a_ready(cur);
    PG8_STAGE(PG8_SB(0, 0), cB, voffB); PG8_STAGE(PG8_SA(0, 0), cA, voffA); PG8_STAGE(PG8_SB(0, 1), cB + hstep, voffB); PG8_STAGE(PG8_SA(0, 1), cA + hstep, voffA);
    if (wr == 1) PG8_BAR;
    PG8_WAIT_V(4); PG8_BAR;
    PG8_STAGE(PG8_SB(1, 0), cB + kstep, voffB); PG8_STAGE(PG8_SA(1, 0), cA + kstep, voffA); PG8_STAGE(PG8_SB(1, 1), cB + hstep + kstep, voffB);
    PG8_WAIT_V(6); PG8_BAR;
    PG8_STAMP();
    for (;;) {
        const bool has_next = S.next(ui + 1, nxt);
        const char* nA = has_next ? (const char*)g.A + (size_t)nxt.pm * tstep : cA; const char* nB = has_next ? (const char*)g.Bt + (size_t)nxt.pn * tstep : cB;
        for (int t = 0; t < nt; t += 2) {
            const bool last = (t == nt - 2);
            const char* a1 = cA + (size_t)(t + 1) * kstep;
            const char* a2 = last ? nA : cA + (size_t)(t + 2) * kstep; const char* b2 = last ? nB : cB + (size_t)(t + 2) * kstep;
            const char* a3 = a2 + kstep; const char* b3 = b2 + kstep;
            if (last && has_next) S.a_ready(nxt);
            PG8_LDB(B0, 0, 0); PG8_SCHED; PG8_LDA(At, 0, 0); PG8_STAGE(PG8_SA(1, 1), a1 + hstep, voffA);
            PG8_WAIT_L(8); PG8_BAR; PG8_WAIT_L(0); PG8_MMA(0, 0, At, B0); PG8_BAR; PG8_SCHED;
            PG8_LDB(B1, 0, 1); PG8_STAGE(PG8_SB(0, 0), b2, voffB);
            PG8_BAR; PG8_WAIT_L(0); PG8_MMA(0, 1, At, B1); PG8_BAR;
            PG8_LDA(At, 0, 1); PG8_STAGE(PG8_SA(0, 0), a2, voffA);
            PG8_BAR; PG8_WAIT_L(0); PG8_MMA(1, 0, At, B0); PG8_BAR; PG8_SCHED;
            PG8_STAGE(PG8_SB(0, 1), b2 + hstep, voffB);
            PG8_WAIT_V(6); PG8_BAR; PG8_MMA(1, 1, At, B1); PG8_BAR;
            PG8_LDB(B0, 1, 0); PG8_SCHED; PG8_LDA(At, 1, 0); PG8_STAGE(PG8_SA(0, 1), a2 + hstep, voffA);
            PG8_WAIT_L(8); PG8_BAR; PG8_WAIT_L(0); PG8_MMA(0, 0, At, B0); PG8_BAR; PG8_SCHED;
            PG8_LDB(B1, 1, 1); PG8_STAGE(PG8_SB(1, 0), b3, voffB);
            PG8_BAR; PG8_WAIT_L(0); PG8_MMA(0, 1, At, B1); PG8_BAR;
            PG8_LDA(At, 1, 1); PG8_STAGE(PG8_SA(1, 0), a3, voffA);
            PG8_BAR; PG8_WAIT_L(0); PG8_MMA(1, 0, At, B0); PG8_BAR; PG8_SCHED;
            PG8_STAGE(PG8_SB(1, 1), b3 + hstep, voffB);
            PG8_WAIT_V(6); PG8_BAR; PG8_MMA(1, 1, At, B1); PG8_BAR;
        }
        PG8_STAMP();
        if constexpr (!Epi::AFTER_DRAIN) { E(acc, cur, wr, wc, fr, fq); S.done(cur); }
        PG8_STAMP();
        if (!has_next) break;
#pragma unroll
        for (int a = 0; a < 2; ++a)
#pragma unroll
            for (int b = 0; b < 2; ++b)
#pragma unroll
                for (int m = 0; m < 4; ++m)
#pragma unroll
                    for (int n = 0; n < 2; ++n) acc[a][b][m][n] = (f32x4){0.f, 0.f, 0.f, 0.f};
        cur = nxt; cA = nA; cB = nB; ++ui;
    }
    PG8_WAIT_V(0);
    if (wr == 0) PG8_BAR;
    PG8_BAR;
    if constexpr (Epi::AFTER_DRAIN) { E.fused(acc, cur, wr, wc, fr, fq, lds, wid, lane); S.done(cur); }
    PG8_STAMP();
    if (STAMP && wid == 0) { stamps[lane] = lane < nts ? (((unsigned long long)(unsigned)ts_hi << 32) | (unsigned)ts_lo) : 0ull;
        if (lane == 62) stamps[62] = rt_entry; if (lane == 63) stamps[63] = (unsigned long long)wall_clock64(); }
#undef PG8_STAMP
#undef PG8_SA
#undef PG8_SB
#undef PG8_STAGE
#undef PG8_LDA
#undef PG8_LDB
#undef PG8_MMA
#undef PG8_WAIT_V
#undef PG8_WAIT_L
#undef PG8_BAR
#undef PG8_SCHED
}
}

#define LAS __attribute__((address_space(3)))
#define XB_TMO      128
#define XB_XCNT(j)  (256  + 64 * (j))
#define XB_XSUB(j)  (1280 + 64 * (j))
#define XB_XGEN(j)  (2304 + 64 * (j))
#define XB_TOP      3328
#define XB_TOPGEN   3392
#define XCD_BAR_WORDS 3456
#define XB_SPIN_CAP (1u << 24)

__device__ __forceinline__ unsigned xb_ld(unsigned* p)              { return __hip_atomic_load(p, __ATOMIC_RELAXED, __HIP_MEMORY_SCOPE_AGENT); }
__device__ __forceinline__ unsigned xb_add(unsigned* p, unsigned v) { return __hip_atomic_fetch_add(p, v, __ATOMIC_RELAXED, __HIP_MEMORY_SCOPE_AGENT); }
__device__ __forceinline__ unsigned xb_xcc_id() { return (unsigned)__builtin_amdgcn_s_getreg((3 << 11) | 20) & 0xFu; }
#define XB_SPIN(cond, bar) do { unsigned _sp = 0; while (cond) { __builtin_amdgcn_s_sleep(1); \
    if ((++_sp & 255u) == 0u) { if (xb_ld(&(bar)[XB_TMO])) break; if (_sp > XB_SPIN_CAP) { atomicAdd(&(bar)[XB_TMO], 1u); break; } } } } while (0)

struct XcdBarrier { unsigned* bar; unsigned x; volatile LAS unsigned* st; };

__device__ __forceinline__ XcdBarrier xcd_barrier_post(unsigned* bar, volatile LAS unsigned* st) {
    XcdBarrier b; b.bar = bar; b.x = xb_xcc_id(); b.st = st;
    if (threadIdx.x == 0) (void)xb_add(&bar[XB_XCNT(b.x)], 1u);
    return b;
}
__device__ __forceinline__ void xcd_barrier_complete(unsigned* bar, unsigned x, unsigned& nloc, unsigned& nx) {
    const unsigned G = gridDim.x * gridDim.y * gridDim.z;
    unsigned sum, cnt, mine, sp = 0u;
    for (;;) {
        sum = 0u; cnt = 0u; mine = 0u;
#pragma unroll
        for (unsigned j = 0; j < 16; ++j) { const unsigned c = xb_ld(&bar[XB_XCNT(j)]); sum += c; cnt += (c > 0u) ? 1u : 0u; mine = (j == x) ? c : mine; }
        if (sum == G) break;
        __builtin_amdgcn_s_sleep(1);
        if ((++sp & 255u) == 0u) { if (xb_ld(&bar[XB_TMO])) break; if (sp > XB_SPIN_CAP) { atomicAdd(&bar[XB_TMO], 1u); break; } }
    }
    nloc = mine > 0u ? mine : 1u; nx = cnt > 0u ? cnt : 1u;
}
__device__ __forceinline__ void xcd_barrier(const XcdBarrier& b) {
    asm volatile("s_waitcnt vmcnt(0)" ::: "memory");
    __syncthreads();
    if (threadIdx.x == 0) {
        unsigned* bar = b.bar;
        __builtin_amdgcn_s_waitcnt(0);
        unsigned nloc = b.st[0], nx = b.st[1];
        if (nloc == 0u) { xcd_barrier_complete(bar, b.x, nloc, nx); b.st[0] = nloc; b.st[1] = nx; }
        const unsigned old = xb_add(&bar[XB_XSUB(b.x)], 1u);
        const unsigned gen = old / nloc;
        if (old + 1u == (gen + 1u) * nloc) {
            __builtin_amdgcn_fence(__ATOMIC_RELEASE, "agent");
            asm volatile("s_waitcnt vmcnt(0)" ::: "memory");
            const unsigned og = xb_add(&bar[XB_TOP], 1u);
            const unsigned tg = og / nx;
            if (og + 1u == (tg + 1u) * nx) xb_add(&bar[XB_TOPGEN], 1u);
            else XB_SPIN(xb_ld(&bar[XB_TOPGEN]) == tg, bar);
            __builtin_amdgcn_fence(__ATOMIC_ACQUIRE, "agent");
            xb_add(&bar[XB_XGEN(b.x)], 1u);
            asm volatile("s_waitcnt vmcnt(0)" ::: "memory");
        } else {
            XB_SPIN(xb_ld(&bar[XB_XGEN(b.x)]) == gen, bar);
            __builtin_amdgcn_fence(__ATOMIC_ACQUIRE, "agent");
            asm volatile("s_waitcnt vmcnt(0)" ::: "memory");
        }
    }
    __syncthreads();
}

typedef unsigned short bf16;
typedef float f32x4 __attribute__((ext_vector_type(4)));
typedef float f32x16 __attribute__((ext_vector_type(16)));
typedef unsigned u32x4 __attribute__((ext_vector_type(4)));
typedef unsigned u32x2 __attribute__((ext_vector_type(2)));
typedef short bf16x8 __attribute__((ext_vector_type(8)));
typedef __bf16 bf2_t __attribute__((ext_vector_type(2)));

constexpr int NTHREADS = 512, NWAVES = 8;
constexpr int LDS_BYTES = 160 * 1024;
constexpr int MISC_OFF = LDS_BYTES - 256;
constexpr int TOK = 32768, SEQ = 16384, DM = 2048;
constexpr int EV_N = 4800, EV_NP = 4864, OD_N = 4176, OD_NP = 4352;
constexpr float ALPHA = 1.41421356237f;
constexpr size_t MiB = 1u << 20;
constexpr size_t WS_CTL = 0, CTL_ZERO_BYTES = 1 * MiB;
constexpr int CW_BAR = 4096;
constexpr size_t WS_MOD = 1 * MiB, WS_SKB = 2 * MiB, WS_WL = 4 * MiB, WS_BS = 7 * MiB, WS_CNT = 9 * MiB;
constexpr size_t WS_WINE = 10 * MiB, WS_WOUTE = 29 * MiB, WS_WINO = 37 * MiB, WS_WOUTO = 54 * MiB, WS_WQ0 = 62 * MiB, WS_WQ1 = 70 * MiB;
constexpr size_t WS_HY = 78 * MiB, WS_Z = 206 * MiB, WS_LA = 510 * MiB, WS_BIG = 542 * MiB, WS_END = 926 * MiB;

__device__ __forceinline__ float bf2f(unsigned short b) { return __uint_as_float(((unsigned)b) << 16); }
__device__ __forceinline__ unsigned f2bf(float f) { unsigned u = __float_as_uint(f); return (u + 0x7fffu + ((u >> 16) & 1u)) >> 16; }
__device__ __forceinline__ unsigned pk2(float lo, float hi) { return f2bf(lo) | (f2bf(hi) << 16); }
__device__ __forceinline__ float lo2f(unsigned w) { return __uint_as_float(w << 16); }
__device__ __forceinline__ float hi2f(unsigned w) { return __uint_as_float(w & 0xffff0000u); }
__device__ __forceinline__ float wsum(float v) {
#pragma unroll
    for (int o = 32; o >= 1; o >>= 1) v += __shfl_xor(v, o);
    return v;
}
__device__ __forceinline__ float wmax(float v) {
#pragma unroll
    for (int o = 32; o >= 1; o >>= 1) v = fmaxf(v, __shfl_xor(v, o));
    return v;
}
__device__ __forceinline__ float rdlane(float v, int l) { return __int_as_float(__builtin_amdgcn_readlane(__float_as_int(v), l)); }
__device__ __forceinline__ unsigned rdlaneu(unsigned v, int l) { return (unsigned)__builtin_amdgcn_readlane((int)v, l); }
__device__ __forceinline__ float dot2bf(unsigned a, unsigned b, float c) {
    return __builtin_amdgcn_fdot2_f32_bf16(__builtin_bit_cast(bf2_t, a), __builtin_bit_cast(bf2_t, b), c, false);
}
template <int CTRL, int RM> __device__ __forceinline__ float dppf(float v) {
    return __int_as_float(__builtin_amdgcn_update_dpp(0, __float_as_int(v), CTRL, RM, 0xF, false));
}
__device__ __forceinline__ float wsum_dpp(float v) {
    v += dppf<0xB1, 0xF>(v);
    v += dppf<0x4E, 0xF>(v);
    v += dppf<0x141, 0xF>(v);
    v += dppf<0x140, 0xF>(v);
    v += dppf<0x142, 0xA>(v);
    v += dppf<0x143, 0xC>(v);
    return rdlane(v, 63);
}
__device__ __forceinline__ float sigmoidf_(float x) { return 1.0f / (1.0f + expf(-x)); }
__device__ __forceinline__ unsigned ordkey(float f) { const unsigned u = __float_as_uint(f); return (u & 0x80000000u) ? ~u : (u | 0x80000000u); }
__device__ __forceinline__ float unordkey(unsigned k) { return __uint_as_float((k & 0x80000000u) ? (k & 0x7fffffffu) : ~k); }

struct Args { const void* in[27]; float* out; unsigned char* ws; int ph_lo, ph_hi; };
struct Frame { LAS unsigned char* lds; int tid, lane, wave, bx, G, gw, ngw; };

struct EpiLora {
    static constexpr bool PERM = true, AFTER_DRAIN = false;
    pg8::bf16_t* O; int ldc; const float* w0; const float* a0;
    __device__ __forceinline__ void operator()(const pg8::f32x4 (&acc)[2][2][4][2], const pg8::Unit& u, int wr, int wc, int fr, int fq) const {
        const int row0 = u.pm * 256 + wr * 64 + fr; const int colt = u.pn * 256; const int type = u.pn >> 2;
        const int col0 = colt + wc * 32 + 8 * fq, ncol0 = col0 & 1023;
        const float* pv = (type == 0) ? w0 : a0;
        pg8::f32x4 bv[2][2];
#pragma unroll
        for (int bj = 0; bj < 2; ++bj)
#pragma unroll
            for (int n = 0; n < 2; ++n) bv[bj][n] = (type < 2) ? *(const pg8::f32x4*)(pv + ncol0 + bj * 128 + 4 * n) : (pg8::f32x4){0.f, 0.f, 0.f, 0.f};
#pragma unroll
        for (int ai = 0; ai < 2; ++ai)
#pragma unroll
            for (int m = 0; m < 4; ++m) { pg8::bf16_t* rowp = O + (size_t)(row0 + ai * 128 + m * 16) * ldc + col0;
#pragma unroll
                for (int bj = 0; bj < 2; ++bj) { pg8::f32x4 v0 = acc[ai][bj][m][0] + bv[bj][0], v1 = acc[ai][bj][m][1] + bv[bj][1];
                    if (type < 2) {
                        const float sc = (type == 0) ? 0.60653066f : 1.0f;
#pragma unroll
                        for (int j = 0; j < 4; ++j) { v0[j] = sc / (1.0f + __expf(-v0[j])); v1[j] = sc / (1.0f + __expf(-v1[j])); }
                    }
                    pg8::u32x4 w; w.x = pg8::cvt_pk_bf16(v0[0], v0[1]); w.y = pg8::cvt_pk_bf16(v0[2], v0[3]); w.z = pg8::cvt_pk_bf16(v1[0], v1[1]); w.w = pg8::cvt_pk_bf16(v1[2], v1[3]);
                    *(pg8::u32x4*)(rowp + bj * 128) = w; } }
    }
};

__device__ __forceinline__ void transpose_item(const float* W, int K, int N, int Npad, bf16* WT, LAS float* scr, int item, int lane) {
    const int nblk = Npad / 32, kb = item / nblk, nb = item % nblk, k0 = 64 * kb, n0 = 32 * nb;
    const int nl = lane & 31; const bool ok = (n0 + nl) < N;
#pragma unroll 8
    for (int i = 0; i < 32; ++i) { const int kk = 2 * i + (lane >> 5); scr[kk * 33 + nl] = ok ? W[(size_t)(k0 + kk) * N + n0 + nl] : 0.f; }
    asm volatile("s_waitcnt lgkmcnt(0)" ::: "memory");
    const int c = lane & 7;
#pragma unroll
    for (int j = 0; j < 4; ++j) { const int n = (lane >> 3) + 8 * j; const LAS float* s = scr + (8 * c) * 33 + n;
        u32x4 o; o.x = pk2(s[0 * 33], s[1 * 33]); o.y = pk2(s[2 * 33], s[3 * 33]); o.z = pk2(s[4 * 33], s[5 * 33]); o.w = pk2(s[6 * 33], s[7 * 33]);
        *(u32x4*)(WT + (size_t)(n0 + n) * K + k0 + 8 * c) = o; }
    asm volatile("s_waitcnt lgkmcnt(0)" ::: "memory");
}

__device__ __forceinline__ void ph_prologue(const Args& A, Frame& F) {
    unsigned char* ws = A.ws;
    {
        const float* c = (const float*)A.in[1]; const float* mw = (const float*)A.in[19]; const float* mb = (const float*)A.in[20];
        float* MOD = (float*)(ws + WS_MOD);
        LAS float* red = (LAS float*)F.lds;
        for (int it = F.bx; it < 96; it += F.G) {
            const int s = it / 24, cc = it % 24, col = cc * 256 + F.lane * 4;
            const float* W = mw + (size_t)s * 2048 * 6144 + col;
            f32x4 a0 = {0.f, 0.f, 0.f, 0.f}, a1 = {0.f, 0.f, 0.f, 0.f};
            const int k0 = F.wave * 256;
#pragma unroll 8
            for (int k = k0; k < k0 + 256; ++k) {
                float c0 = c[k], c1 = c[2048 + k];
                c0 = c0 / (1.0f + expf(-c0)); c1 = c1 / (1.0f + expf(-c1));
                const f32x4 w = *(const f32x4*)(W + (size_t)k * 6144);
                a0 += c0 * w; a1 += c1 * w;
            }
            *(LAS f32x4*)(red + ((F.wave * 2 + 0) * 256 + F.lane * 4)) = a0;
            *(LAS f32x4*)(red + ((F.wave * 2 + 1) * 256 + F.lane * 4)) = a1;
            __syncthreads();
            { const int b = F.tid >> 8, cl = F.tid & 255; float sm = 0.f;
#pragma unroll
              for (int w = 0; w < 8; ++w) sm += red[(w * 2 + b) * 256 + cl];
              MOD[(size_t)(s * 2 + b) * 6144 + cc * 256 + cl] = sm + mb[s * 6144 + cc * 256 + cl]; }
            __syncthreads();
        }
    }
    {
        LAS float* scr = (LAS float*)(F.lds + 16384 + F.wave * 8704);
        constexpr int I0 = 32 * (EV_NP / 32), I1 = 32 * 64, I2 = 32 * (OD_NP / 32);
        constexpr int NIT = I0 + I1 + I2 + 3 * I1;
        for (int it = F.gw; it < NIT; it += F.ngw) {
            int r = it;
            if (r < I0) { transpose_item((const float*)A.in[3], 2048, EV_N, EV_NP, (bf16*)(ws + WS_WINE), scr, r, F.lane); continue; } r -= I0;
            if (r < I1) { transpose_item((const float*)A.in[4], 2048, 2048, 2048, (bf16*)(ws + WS_WOUTE), scr, r, F.lane); continue; } r -= I1;
            if (r < I2) { transpose_item((const float*)A.in[17], 2048, OD_N, OD_NP, (bf16*)(ws + WS_WINO), scr, r, F.lane); continue; } r -= I2;
            if (r < I1) { transpose_item((const float*)A.in[18], 2048, 2048, 2048, (bf16*)(ws + WS_WOUTO), scr, r, F.lane); continue; } r -= I1;
            if (r < I1) { transpose_item((const float*)A.in[23], 2048, 2048, 2048, (bf16*)(ws + WS_WQ0), scr, r, F.lane); continue; } r -= I1;
            transpose_item((const float*)A.in[23] + (size_t)2048 * 2048, 2048, 2048, 2048, (bf16*)(ws + WS_WQ1), scr, r, F.lane);
        }
    }
    {
        const float* w2 = (const float*)A.in[8]; const float* a2 = (const float*)A.in[10]; const float* g2 = (const float*)A.in[11];
        bf16* WL = (bf16*)(ws + WS_WL);
        const int gt = F.bx * NTHREADS + F.tid, ngt = F.G * NTHREADS;
        for (int i = gt; i < 3072 * 512; i += ngt) {
            const int n = i >> 9, k = i & 511; float v = 0.f;
            if (n < 1024) { if (k < 96) v = w2[k * 1024 + n]; }
            else if (n < 2048) { if (k >= 96 && k < 192) v = a2[(k - 96) * 1024 + (n - 1024)]; }
            else { if (k >= 192 && k < 448) v = g2[(k - 192) * 1024 + (n - 2048)]; }
            WL[i] = (bf16)f2bf(v);
        }
        const float* sk = (const float*)A.in[24]; bf16* SKB = (bf16*)(ws + WS_SKB);
        for (int i = gt; i < 2 * 262144; i += ngt) SKB[i] = (bf16)f2bf(sk[i]);
    }
}

__device__ __forceinline__ void ph_mod_x(const Args& A, Frame& F) {
    const float* x = (const float*)A.in[0]; const float* MOD = (const float*)(A.ws + WS_MOD); bf16* H = (bf16*)(A.ws + WS_HY);
    for (int t = F.gw; t < TOK; t += F.ngw) {
        const int b = t >> 14; const float* sh = MOD + (size_t)(0 * 2 + b) * 6144; const float* sc = sh + 2048;
#pragma unroll
        for (int j = 0; j < 8; ++j) { const int idx = j * 256 + F.lane * 4;
            const f32x4 xv = *(const f32x4*)(x + (size_t)t * DM + idx), sv = *(const f32x4*)(sc + idx), hv = *(const f32x4*)(sh + idx);
            const f32x4 o = xv * (1.0f + sv) + hv; u32x2 w; w.x = pk2(o[0], o[1]); w.y = pk2(o[2], o[3]);
            *(u32x2*)(H + (size_t)t * DM + idx) = w; }
    }
}

__device__ __forceinline__ void ph_even_post(const Args& A, Frame& F) {
    bf16* Z = (bf16*)(A.ws + WS_Z); const int* positions = (const int*)A.in[2]; const float* mu = (const float*)A.in[6];
    bf16* RKV = (bf16*)A.out; bf16* LAp = (bf16*)(A.ws + WS_LA);
    const int i = F.lane & 31; const float inv = powf(10000.0f, -(float)i / 32.0f);
    for (int t = F.gw; t < TOK; t += F.ngw) {
        const int s = t & (SEQ - 1); bf16* zr = Z + (size_t)t * EV_NP;
        float sn, cs; sincosf((float)positions[t] * inv, &sn, &cs);
#pragma unroll
        for (int it = 0; it < 9; ++it) { const int base = (2 * it + (F.lane >> 5)) * 64;
            const float t1 = bf2f(zr[base + i]), t2 = bf2f(zr[base + 32 + i]);
            zr[base + i] = (bf16)f2bf(t1 * cs - t2 * sn); zr[base + 32 + i] = (bf16)f2bf(t2 * cs + t1 * sn); }
        const bf16* zp = zr - EV_NP; const bool hasprev = s > 0;
        for (int m = 0; m < 28; ++m) { const int j = 2 * F.lane + 128 * m; if (j < 3520) {
            const unsigned cw = *(const unsigned*)(zr + 1280 + j); const unsigned pw = hasprev ? *(const unsigned*)(zp + 1280 + j) : 0u;
            const float m0 = mu[j], m1 = mu[j + 1];
            const float c0 = lo2f(cw), c1 = hi2f(cw), p0 = lo2f(pw), p1 = hi2f(pw);
            const float v0 = c0 + (p0 - c0) * m0, v1 = c1 + (p1 - c1) * m1;
            if (j < 3072) { const int which = j >> 10, jj = j & 1023; *(unsigned*)(RKV + (size_t)which * TOK * 1024 + (size_t)t * 1024 + jj) = pk2(v0, v1); }
            else if (j < 3168) { *(unsigned*)(LAp + (size_t)t * 512 + (j - 3072)) = pk2(tanhf(v0), tanhf(v1)); }
            else if (j < 3264) { *(unsigned*)(LAp + (size_t)t * 512 + 96 + (j - 3168)) = pk2(v0, v1); }
            else { *(unsigned*)(LAp + (size_t)t * 512 + 192 + (j - 3264)) = pk2(sigmoidf_(v0), sigmoidf_(v1)); }
        } }
        if (F.lane < 32) *(unsigned*)(LAp + (size_t)t * 512 + 448 + 2 * F.lane) = 0u;
    }
}

__device__ __forceinline__ void ph_scan_pack(const Args& A, Frame& F) {
    const bf16* Z = (const bf16*)(A.ws + WS_Z); const bf16* RKV = (const bf16*)A.out;
    const float* k_k = (const float*)A.in[12]; const float* k_a = (const float*)A.in[13]; const float* r_k = (const float*)A.in[14];
    unsigned* PK = (unsigned*)(A.ws + WS_BIG); float* BS = (float*)(A.ws + WS_BS);
    for (int it = F.gw; it < TOK * 16; it += F.ngw) {
        const int t = it >> 4, h = it & 15, c = h * 64 + F.lane, b = t >> 14, s = t & (SEQ - 1);
        const float r = bf2f(RKV[(size_t)t * 1024 + c]), kr = bf2f(RKV[(size_t)TOK * 1024 + (size_t)t * 1024 + c]), v = bf2f(RKV[(size_t)2 * TOK * 1024 + (size_t)t * 1024 + c]);
        const float e = bf2f(Z[(size_t)t * EV_NP + 1280 + c]), a = bf2f(Z[(size_t)t * EV_NP + 1280 + 1024 + c]);
        const float kkv = kr * k_k[c]; const float ss = wsum(kkv * kkv); const float kkn = kkv / fmaxf(sqrtf(ss), 1e-12f);
        const float kp = kr * (1.0f + (a - 1.0f) * k_a[c]); const float kka = kkn * a;
        const float bsum = wsum(r * kp * r_k[c]);
        if (F.lane == 0) BS[(size_t)t * 16 + h] = bsum;
        unsigned* dst = PK + ((size_t)((b * 16 + h) * SEQ + s) * 64 + F.lane) * 3;
        dst[0] = pk2(r, e); dst[1] = pk2(kp, kkn); dst[2] = pk2(kka, v);
    }
}

__device__ __forceinline__ void ph_swa(const Args& A, Frame& F) {
    const bf16* Z = (const bf16*)(A.ws + WS_Z); bf16* Y = (bf16*)(A.ws + WS_HY); const float* sinks = (const float*)A.in[5];
    LAS unsigned char* KL = F.lds; LAS unsigned char* VL = F.lds + 256 * 136;
    for (int u = F.bx; u < 512; u += F.G) {
        const int b = u >> 8, n = (u >> 1) & 127, kvh = u & 1;
        __syncthreads();
        for (int c = F.tid; c < 2048; c += NTHREADS) { const int jw = c >> 3, cc = c & 7; const int s = n * 128 - 128 + jw;
            u32x4 kv = {0u, 0u, 0u, 0u}, vv = {0u, 0u, 0u, 0u};
            if (s >= 0) { const bf16* row = Z + (size_t)(b * SEQ + s) * EV_NP; kv = *(const u32x4*)(row + 1024 + kvh * 64 + cc * 8); vv = *(const u32x4*)(row + 1152 + kvh * 64 + cc * 8); }
            *(LAS u32x2*)(KL + jw * 136 + cc * 16) = (u32x2){kv.x, kv.y}; *(LAS u32x2*)(KL + jw * 136 + cc * 16 + 8) = (u32x2){kv.z, kv.w};
            *(LAS u32x2*)(VL + jw * 136 + cc * 16) = (u32x2){vv.x, vv.y}; *(LAS u32x2*)(VL + jw * 136 + cc * 16 + 8) = (u32x2){vv.z, vv.w}; }
        __syncthreads();
        for (int it = F.wave; it < 1024; it += NWAVES) {
            const int i = it >> 3, g = it & 7, head = kvh * 8 + g; const int t = b * SEQ + n * 128 + i;
            const float qv = bf2f(Z[(size_t)t * EV_NP + head * 64 + F.lane]) * 0.125f;
            const int jw0 = i + 1 + F.lane, jw1 = jw0 + 64;
            const bool val0 = (n > 0) || (jw0 >= 128), val1 = (n > 0) || (jw1 >= 128);
            float s0 = 0.f, s1 = 0.f;
#pragma unroll
            for (int d4 = 0; d4 < 16; ++d4) {
                const u32x2 k0 = *(const LAS u32x2*)(KL + jw0 * 136 + d4 * 8), k1 = *(const LAS u32x2*)(KL + jw1 * 136 + d4 * 8);
                const float q0 = rdlane(qv, 4 * d4), q1 = rdlane(qv, 4 * d4 + 1), q2 = rdlane(qv, 4 * d4 + 2), q3 = rdlane(qv, 4 * d4 + 3);
                s0 += q0 * lo2f(k0.x) + q1 * hi2f(k0.x) + q2 * lo2f(k0.y) + q3 * hi2f(k0.y);
                s1 += q0 * lo2f(k1.x) + q1 * hi2f(k1.x) + q2 * lo2f(k1.y) + q3 * hi2f(k1.y);
            }
            const float sink = sinks[head];
            s0 = val0 ? s0 : -INFINITY; s1 = val1 ? s1 : -INFINITY;
            const float mx = fmaxf(wmax(fmaxf(s0, s1)), sink);
            float p0 = val0 ? expf(s0 - mx) : 0.f, p1 = val1 ? expf(s1 - mx) : 0.f;
            const float den = wsum(p0 + p1) + expf(sink - mx); const float rden = 1.0f / den;
            p0 *= rden; p1 *= rden;
            float o = 0.f;
            const LAS bf16* vcol = (const LAS bf16*)VL + F.lane;
#pragma unroll 8
            for (int jj = 0; jj < 64; ++jj) o += rdlane(p0, jj) * bf2f(vcol[(i + 1 + jj) * 68]);
#pragma unroll 8
            for (int jj = 0; jj < 64; ++jj) o += rdlane(p1, jj) * bf2f(vcol[(i + 65 + jj) * 68]);
            Y[(size_t)t * DM + head * 64 + F.lane] = (bf16)f2bf(o);
        }
    }
}

__device__ __forceinline__ void ph_scan(const Args& A, Frame& F) {
    const unsigned* PK = (const unsigned*)(A.ws + WS_BIG); bf16* YRAW = (bf16*)A.out + (size_t)3 * TOK * 1024;
    for (int rr = F.gw; rr < 2048; rr += F.ngw) {
        const int bh = rr >> 6, vrow = rr & 63;
        const unsigned* pk = PK + ((size_t)bh * SEQ * 64 + F.lane) * 3;
        bf16* yout = YRAW + ((size_t)bh * 64 + vrow) * SEQ;
        float S = 0.f;
        for (int t0 = 0; t0 < SEQ; t0 += 64) {
            float yk = 0.f;
#pragma unroll 8
            for (int j = 0; j < 64; ++j) {
                const unsigned* p = pk + (size_t)(t0 + j) * 192;
                const unsigned w0 = p[0], w1 = p[1], w2 = p[2];
                const float r = lo2f(w0), e = hi2f(w0), kp = lo2f(w1), kk = hi2f(w1), kka = lo2f(w2), vv = hi2f(w2);
                const float vs = rdlane(vv, vrow);
                const float dec = __expf(-e);
                const float sa = -wsum_dpp(S * kk);
                S = S * dec + sa * kka + vs * kp;
                const float y = wsum_dpp(S * r);
                yk = (F.lane == j) ? y : yk;
            }
            yout[t0 + F.lane] = (bf16)f2bf(yk);
        }
    }
}

__device__ __forceinline__ void ph_rwkv_finish(const Args& A, Frame& F) {
    const bf16* Z = (const bf16*)(A.ws + WS_Z); const bf16* RKV = (const bf16*)A.out; const bf16* YRAW = (const bf16*)A.out + (size_t)3 * TOK * 1024;
    const float* BS = (const float*)(A.ws + WS_BS); bf16* Y = (bf16*)(A.ws + WS_HY);
    const float* lnx_g = (const float*)A.in[15]; const float* lnx_b = (const float*)A.in[16];
    LAS float* tile = (LAS float*)(F.lds + F.wave * 16640);
    for (int it = F.gw; it < 8192; it += F.ngw) {
        const int bh = it >> 8, tb = it & 255, b = bh >> 4, h = bh & 15, t0 = tb * 64;
        for (int vr = 0; vr < 64; ++vr) tile[vr * 65 + F.lane] = bf2f(YRAW[((size_t)bh * 64 + vr) * SEQ + t0 + F.lane]);
        asm volatile("s_waitcnt lgkmcnt(0)" ::: "memory");
        const int c = h * 64 + F.lane; const float lg = lnx_g[c], lb = lnx_b[c];
        for (int j = 0; j < 64; ++j) {
            const int t = b * SEQ + t0 + j;
            const float y = tile[F.lane * 65 + j];
            const float mean = wsum(y) * (1.0f / 64.0f); const float d = y - mean; const float var = wsum(d * d) * (1.0f / 64.0f);
            const float yn = d * rsqrtf(var + 64e-5f) * lg + lb;
            const float vv = bf2f(RKV[(size_t)2 * TOK * 1024 + (size_t)t * 1024 + c]); const float g = bf2f(Z[(size_t)t * EV_NP + 1280 + 2048 + c]); const float bs = BS[(size_t)t * 16 + h];
            Y[(size_t)t * DM + 1024 + c] = (bf16)f2bf((yn + bs * vv) * g);
        }
        asm volatile("s_waitcnt lgkmcnt(0)" ::: "memory");
    }
}

__device__ __forceinline__ void ph_ln_mixer(const Args& A, Frame& F, const int L) {
    const float* xsrc = (L == 0) ? (const float*)A.in[0] : (const float*)A.out; float* xdst = A.out;
    const bf16* O = (const bf16*)(A.ws + WS_Z); bf16* H = (bf16*)(A.ws + WS_HY); const float* MOD = (const float*)(A.ws + WS_MOD);
    const float* lng = (const float*)A.in[21] + (size_t)(L * 2 + 0) * DM; const float* lnb = (const float*)A.in[22] + (size_t)(L * 2 + 0) * DM;
    for (int t = F.gw; t < TOK; t += F.ngw) {
        const int b = t >> 14;
        const float* gate = MOD + (size_t)((L * 2 + 0) * 2 + b) * 6144 + 4096;
        const float* sh = MOD + (size_t)((L * 2 + 1) * 2 + b) * 6144; const float* sc = sh + 2048;
        float v[32]; float sum = 0.f;
#pragma unroll
        for (int j = 0; j < 4; ++j) { const int base = (j * 64 + F.lane) * 8;
            const u32x4 ow = *(const u32x4*)(O + (size_t)t * DM + base);
            const f32x4 x0 = *(const f32x4*)(xsrc + (size_t)t * DM + base), x1 = *(const f32x4*)(xsrc + (size_t)t * DM + base + 4);
            const f32x4 g0 = *(const f32x4*)(gate + base), g1 = *(const f32x4*)(gate + base + 4);
            const float of[8] = {lo2f(ow.x), hi2f(ow.x), lo2f(ow.y), hi2f(ow.y), lo2f(ow.z), hi2f(ow.z), lo2f(ow.w), hi2f(ow.w)};
#pragma unroll
            for (int e = 0; e < 4; ++e) { v[j * 8 + e] = ALPHA * x0[e] + (1.0f + g0[e]) * of[e]; v[j * 8 + 4 + e] = ALPHA * x1[e] + (1.0f + g1[e]) * of[4 + e]; }
#pragma unroll
            for (int e = 0; e < 8; ++e) sum += v[j * 8 + e]; }
        const float mean = wsum(sum) * (1.0f / DM); float sq = 0.f;
#pragma unroll
        for (int e = 0; e < 32; ++e) { v[e] -= mean; sq += v[e] * v[e]; }
        const float rstd = rsqrtf(wsum(sq) * (1.0f / DM) + 1e-5f);
#pragma unroll
        for (int j = 0; j < 4; ++j) { const int base = (j * 64 + F.lane) * 8;
            const f32x4 lg0 = *(const f32x4*)(lng + base), lg1 = *(const f32x4*)(lng + base + 4), lb0 = *(const f32x4*)(lnb + base), lb1 = *(const f32x4*)(lnb + base + 4);
            const f32x4 s0 = *(const f32x4*)(sc + base), s1 = *(const f32x4*)(sc + base + 4), h0 = *(const f32x4*)(sh + base), h1 = *(const f32x4*)(sh + base + 4);
            f32x4 o0, o1;
#pragma unroll
            for (int e = 0; e < 4; ++e) { o0[e] = v[j * 8 + e] * rstd * lg0[e] + lb0[e]; o1[e] = v[j * 8 + 4 + e] * rstd * lg1[e] + lb1[e]; }
            *(f32x4*)(xdst + (size_t)t * DM + base) = o0; *(f32x4*)(xdst + (size_t)t * DM + base + 4) = o1;
            const f32x4 q0 = o0 * (1.0f + s0) + h0, q1 = o1 * (1.0f + s1) + h1;
            u32x4 w; w.x = pk2(q0[0], q0[1]); w.y = pk2(q0[2], q0[3]); w.z = pk2(q1[0], q1[1]); w.w = pk2(q1[2], q1[3]);
            *(u32x4*)(H + (size_t)t * DM + base) = w; }
    }
    {
        const float* pu = (const float*)A.in[25] + (size_t)L * 16384 * 2048; const float* pv = (const float*)A.in[26] + (size_t)L * 16384 * 2048;
        bf16* TU = (bf16*)(A.ws + WS_BIG); bf16* TV = TU + (size_t)16384 * 2048;
        const size_t gt = (size_t)F.bx * NTHREADS + F.tid, ngt = (size_t)F.G * NTHREADS, NCH = (size_t)16384 * 2048 / 8;
        for (size_t i = gt; i < NCH; i += ngt) {
            const f32x4 a0 = *(const f32x4*)(pu + i * 8), a1 = *(const f32x4*)(pu + i * 8 + 4), b0 = *(const f32x4*)(pv + i * 8), b1 = *(const f32x4*)(pv + i * 8 + 4);
            u32x4 w; w.x = pk2(a0[0], a0[1]); w.y = pk2(a0[2], a0[3]); w.z = pk2(a1[0], a1[1]); w.w = pk2(a1[2], a1[3]);
            *(u32x4*)(TU + i * 8) = w;
            w.x = pk2(b0[0], b0[1]); w.y = pk2(b0[2], b0[3]); w.z = pk2(b1[0], b1[1]); w.w = pk2(b1[2], b1[3]);
            *(u32x4*)(TV + i * 8) = w;
        }
    }
}

template <int NV> __device__ __forceinline__ unsigned wave_tau16(const unsigned (&key)[NV]) {
    unsigned tau = 0u;
#pragma unroll 1
    for (int bit = 31; bit >= 0; --bit) {
        const unsigned cand = tau | (1u << bit); int cnt = 0;
#pragma unroll
        for (int v = 0; v < NV; ++v) cnt += __popcll(__ballot(key[v] >= cand));
        if (cnt >= 16) tau = cand;
    }
    return tau;
}
template <int NV> __device__ __forceinline__ void wave_compact16(const unsigned (&key)[NV], const int (&id)[NV], unsigned tau, LAS float* ov, LAS int* oi, int lane) {
    int ngt = 0;
#pragma unroll
    for (int v = 0; v < NV; ++v) ngt += __popcll(__ballot(key[v] > tau));
    int bg = 0, be = 0;
#pragma unroll
    for (int v = 0; v < NV; ++v) {
        const bool gt = key[v] > tau, eq = key[v] == tau;
        const unsigned long long mg = __ballot(gt), me = __ballot(eq);
        const unsigned long long below = (lane == 0) ? 0ull : ((~0ull) >> (64 - lane));
        const int pg = bg + __popcll(mg & below), pe = ngt + be + __popcll(me & below);
        if (gt) { ov[pg] = unordkey(key[v]); oi[pg] = id[v]; }
        if (eq && pe < 16) { ov[pe] = unordkey(key[v]); oi[pe] = id[v]; }
        bg += __popcll(mg); be += __popcll(me);
    }
}

__device__ __forceinline__ void ph_peer_select(const Args& A, Frame& F, const int L) {
    const bf16* QP = (const bf16*)(A.ws + WS_Z); const bf16* SKB = (const bf16*)(A.ws + WS_SKB) + (size_t)L * 262144;
    int* EID = (int*)(A.ws + WS_LA); float* GSM = (float*)(A.ws + WS_LA + 16 * MiB);
    LAS unsigned char* SKL = F.lds;
    LAS float* tv = (LAS float*)(F.lds + 69632 + F.wave * 512);
    LAS int* ti = (LAS int*)(F.lds + 69632 + F.wave * 512 + 128);
    LAS float* cv = (LAS float*)(F.lds + 69632 + F.wave * 512 + 256);
    LAS int* ci = (LAS int*)(F.lds + 69632 + F.wave * 512 + 320);
    for (int it = F.bx; it < 4096; it += F.G) {
        const int tile = it >> 3, h = it & 7;
        __syncthreads();
        for (int c = F.tid; c < 4096; c += NTHREADS) { const int p = c >> 11, n = (c >> 4) & 127, cc = c & 15;
            *(LAS u32x4*)(SKL + (p * 128 + n) * 272 + cc * 16) = *(const u32x4*)(SKB + ((size_t)((p * 8 + h) * 128 + n)) * 128 + cc * 8); }
        __syncthreads();
        for (int tk = 0; tk < 8; ++tk) {
            const int t = tile * 64 + F.wave * 8 + tk;
#pragma unroll
            for (int p = 0; p < 2; ++p) {
                const unsigned qv = *(const unsigned*)(QP + (size_t)t * DM + h * 256 + p * 128 + 2 * F.lane);
                float s0 = 0.f, s1 = 0.f;
                const LAS unsigned char* r0 = SKL + (p * 128 + F.lane) * 272; const LAS unsigned char* r1 = r0 + 64 * 272;
#pragma unroll
                for (int c16 = 0; c16 < 16; ++c16) {
                    const u32x4 k0 = *(const LAS u32x4*)(r0 + c16 * 16), k1 = *(const LAS u32x4*)(r1 + c16 * 16);
                    const unsigned q0 = rdlaneu(qv, c16 * 4), q1 = rdlaneu(qv, c16 * 4 + 1), q2 = rdlaneu(qv, c16 * 4 + 2), q3 = rdlaneu(qv, c16 * 4 + 3);
                    s0 = dot2bf(q0, k0.x, s0); s0 = dot2bf(q1, k0.y, s0); s0 = dot2bf(q2, k0.z, s0); s0 = dot2bf(q3, k0.w, s0);
                    s1 = dot2bf(q0, k1.x, s1); s1 = dot2bf(q1, k1.y, s1); s1 = dot2bf(q2, k1.z, s1); s1 = dot2bf(q3, k1.w, s1);
                }
                const unsigned key[2] = {ordkey(s0), ordkey(s1)}; const int id[2] = {F.lane, F.lane + 64};
                const unsigned tau = wave_tau16<2>(key);
                wave_compact16<2>(key, id, tau, tv + p * 16, ti + p * 16, F.lane);
            }
            asm volatile("s_waitcnt lgkmcnt(0)" ::: "memory"); __builtin_amdgcn_wave_barrier();
            unsigned ck[4]; int cid[4];
#pragma unroll
            for (int m = 0; m < 4; ++m) { const int c = F.lane * 4 + m; cid[m] = c; ck[m] = ordkey(tv[c >> 4] + tv[16 + (c & 15)]); }
            const unsigned tau2 = wave_tau16<4>(ck);
            wave_compact16<4>(ck, cid, tau2, cv, ci, F.lane);
            asm volatile("s_waitcnt lgkmcnt(0)" ::: "memory"); __builtin_amdgcn_wave_barrier();
            const float bv = (F.lane < 16) ? cv[F.lane] : -INFINITY; const int bc = (F.lane < 16) ? ci[F.lane] : 0;
            const float mx = wmax(bv); const float ev = (F.lane < 16) ? expf(bv - mx) : 0.f; const float den = wsum(ev);
            if (F.lane < 16) { const int e1 = ti[bc >> 4], e2 = ti[16 + (bc & 15)];
                EID[(size_t)t * 128 + h * 16 + F.lane] = e1 * 128 + e2; GSM[(size_t)t * 128 + h * 16 + F.lane] = ev / den; }
            asm volatile("s_waitcnt lgkmcnt(0)" ::: "memory"); __builtin_amdgcn_wave_barrier();
        }
    }
}

__device__ __forceinline__ void ph_peer_gather(const Args& A, Frame& F, const int L) {
    bf16* H = (bf16*)(A.ws + WS_HY); const bf16* TU = (const bf16*)(A.ws + WS_BIG); const bf16* TV = TU + (size_t)16384 * 2048;
    const int* EID = (const int*)(A.ws + WS_LA); const float* GSM = (const float*)(A.ws + WS_LA + 16 * MiB);
    const float* MOD = (const float*)(A.ws + WS_MOD); float* X = A.out;
    const float* lng = (const float*)A.in[21] + (size_t)(L * 2 + 1) * DM; const float* lnb = (const float*)A.in[22] + (size_t)(L * 2 + 1) * DM;
    for (int t = F.gw; t < TOK; t += F.ngw) {
        const int b = t >> 14;
        u32x4 hv[4];
#pragma unroll
        for (int j = 0; j < 4; ++j) hv[j] = *(const u32x4*)(H + (size_t)t * DM + (j * 64 + F.lane) * 8);
        float out[32];
#pragma unroll
        for (int e = 0; e < 32; ++e) out[e] = 0.f;
        for (int e0 = 0; e0 < 128; e0 += 4) {
            int eid[4]; float gw[4];
#pragma unroll
            for (int q = 0; q < 4; ++q) { eid[q] = __builtin_amdgcn_readfirstlane(EID[(size_t)t * 128 + e0 + q]); gw[q] = GSM[(size_t)t * 128 + e0 + q]; }
            u32x4 uu[4][4], vv[4][4];
#pragma unroll
            for (int q = 0; q < 4; ++q)
#pragma unroll
                for (int j = 0; j < 4; ++j) { uu[q][j] = *(const u32x4*)(TU + (size_t)eid[q] * DM + (j * 64 + F.lane) * 8); vv[q][j] = *(const u32x4*)(TV + (size_t)eid[q] * DM + (j * 64 + F.lane) * 8); }
#pragma unroll
            for (int q = 0; q < 4; ++q) {
                float d = 0.f;
#pragma unroll
                for (int j = 0; j < 4; ++j) { d = dot2bf(uu[q][j].x, hv[j].x, d); d = dot2bf(uu[q][j].y, hv[j].y, d); d = dot2bf(uu[q][j].z, hv[j].z, d); d = dot2bf(uu[q][j].w, hv[j].w, d); }
                d = wsum(d);
                const float act = 0.5f * d * (1.0f + erff(d * 0.70710678f)) * gw[q];
#pragma unroll
                for (int j = 0; j < 4; ++j) {
                    out[j * 8 + 0] += act * lo2f(vv[q][j].x); out[j * 8 + 1] += act * hi2f(vv[q][j].x);
                    out[j * 8 + 2] += act * lo2f(vv[q][j].y); out[j * 8 + 3] += act * hi2f(vv[q][j].y);
                    out[j * 8 + 4] += act * lo2f(vv[q][j].z); out[j * 8 + 5] += act * hi2f(vv[q][j].z);
                    out[j * 8 + 6] += act * lo2f(vv[q][j].w); out[j * 8 + 7] += act * hi2f(vv[q][j].w);
                }
            }
        }
        const float* gate = MOD + (size_t)((L * 2 + 1) * 2 + b) * 6144 + 4096;
        float sum = 0.f;
#pragma unroll
        for (int j = 0; j < 4; ++j) { const int base = (j * 64 + F.lane) * 8;
            const f32x4 x0 = *(const f32x4*)(X + (size_t)t * DM + base), x1 = *(const f32x4*)(X + (size_t)t * DM + base + 4);
            const f32x4 g0 = *(const f32x4*)(gate + base), g1 = *(const f32x4*)(gate + base + 4);
#pragma unroll
            for (int e = 0; e < 4; ++e) { out[j * 8 + e] = ALPHA * x0[e] + (1.0f + g0[e]) * out[j * 8 + e]; out[j * 8 + 4 + e] = ALPHA * x1[e] + (1.0f + g1[e]) * out[j * 8 + 4 + e]; }
#pragma unroll
            for (int e = 0; e < 8; ++e) sum += out[j * 8 + e]; }
        const float mean = wsum(sum) * (1.0f / DM); float sq = 0.f;
#pragma unroll
        for (int e = 0; e < 32; ++e) { out[e] -= mean; sq += out[e] * out[e]; }
        const float rstd = rsqrtf(wsum(sq) * (1.0f / DM) + 1e-5f);
        const float* sh = MOD + (size_t)(((L + 1) * 2 + 0) * 2 + b) * 6144; const float* sc = sh + 2048;
#pragma unroll
        for (int j = 0; j < 4; ++j) { const int base = (j * 64 + F.lane) * 8;
            const f32x4 lg0 = *(const f32x4*)(lng + base), lg1 = *(const f32x4*)(lng + base + 4), lb0 = *(const f32x4*)(lnb + base), lb1 = *(const f32x4*)(lnb + base + 4);
            f32x4 o0, o1;
#pragma unroll
            for (int e = 0; e < 4; ++e) { o0[e] = out[j * 8 + e] * rstd * lg0[e] + lb0[e]; o1[e] = out[j * 8 + 4 + e] * rstd * lg1[e] + lb1[e]; }
            *(f32x4*)(X + (size_t)t * DM + base) = o0; *(f32x4*)(X + (size_t)t * DM + base + 4) = o1;
            if (L == 0) {
                const f32x4 s0 = *(const f32x4*)(sc + base), s1 = *(const f32x4*)(sc + base + 4), h0 = *(const f32x4*)(sh + base), h1 = *(const f32x4*)(sh + base + 4);
                const f32x4 q0 = o0 * (1.0f + s0) + h0, q1 = o1 * (1.0f + s1) + h1;
                u32x4 w; w.x = pk2(q0[0], q0[1]); w.y = pk2(q0[2], q0[3]); w.z = pk2(q1[0], q1[1]); w.w = pk2(q1[2], q1[3]);
                *(u32x4*)(H + (size_t)t * DM + base) = w;
            } }
    }
}

__device__ __forceinline__ void ph_odd_post(const Args& A, Frame& F) {
    bf16* Z = (bf16*)(A.ws + WS_Z); const int* positions = (const int*)A.in[2];
    const float inv128 = powf(10000.0f, -(float)F.lane / 64.0f); const int i32 = F.lane & 31; const float inv64 = powf(10000.0f, -(float)i32 / 32.0f);
    for (int t = F.gw; t < TOK; t += F.ngw) {
        bf16* zr = Z + (size_t)t * OD_NP; const float pos = (float)positions[t];
        float sn, cs; sincosf(pos * inv128, &sn, &cs);
        for (int hd = 0; hd < 20; ++hd) { const int base = hd * 128;
            const float t1 = bf2f(zr[base + F.lane]), t2 = bf2f(zr[base + 64 + F.lane]);
            zr[base + F.lane] = (bf16)f2bf(t1 * cs - t2 * sn); zr[base + 64 + F.lane] = (bf16)f2bf(t2 * cs + t1 * sn); }
        sincosf(pos * inv64, &sn, &cs);
        for (int it = 0; it < 9; ++it) { const int hd = 2 * it + (F.lane >> 5); if (hd < 17) { const int base = 3072 + hd * 64;
            const float t1 = bf2f(zr[base + i32]), t2 = bf2f(zr[base + 32 + i32]);
            zr[base + i32] = (bf16)f2bf(t1 * cs - t2 * sn); zr[base + 32 + i32] = (bf16)f2bf(t2 * cs + t1 * sn); } }
    }
}

__device__ __forceinline__ void ph_dsa_select(const Args& A, Frame& F) {
    const bf16* Z = (const bf16*)(A.ws + WS_Z); unsigned short* SEL = (unsigned short*)(A.ws + WS_LA); int* CNT = (int*)(A.ws + WS_CNT);
    LAS unsigned* SC = (LAS unsigned*)F.lds;
    LAS unsigned* hist = (LAS unsigned*)(F.lds + 131072);
    LAS unsigned* res = (LAS unsigned*)(F.lds + 131072 + 2048);
    LAS int* wtot = (LAS int*)(F.lds + 131072 + 2048 + 64);
    const int r = F.lane & 31, hg = F.lane >> 5, tk = (r >> 2) & 1, hh = (r & 3) + 4 * (r >> 3);
    const int grp = F.wave >> 2, ltid = F.tid & 255, lw = F.wave & 3;
    for (int pr = F.bx; pr < TOK / 2; pr += F.G) {
        const int t0 = 2 * pr, b = t0 >> 14, s0 = t0 & (SEQ - 1);
        const int nkeys = s0 + 2, ntiles = (nkeys + 31) >> 5;
        bf16x8 af[4];
        { const bf16* qrow = Z + (size_t)(t0 + tk) * OD_NP + 3072 + hh * 64 + 8 * hg;
#pragma unroll
          for (int s = 0; s < 4; ++s) af[s] = *(const bf16x8*)(qrow + 16 * s); }
        float wv[16];
        { const bf16* wrow = Z + (size_t)(t0 + hg) * OD_NP + 4160;
          const u32x4 w0 = *(const u32x4*)(wrow), w1 = *(const u32x4*)(wrow + 8);
          const unsigned ww[8] = {w0.x, w0.y, w0.z, w0.w, w1.x, w1.y, w1.z, w1.w};
#pragma unroll
          for (int q = 0; q < 8; ++q) { wv[2 * q] = lo2f(ww[q]) * 0.03125f; wv[2 * q + 1] = hi2f(ww[q]) * 0.03125f; } }
        __syncthreads();
        for (int tile = F.wave; tile < ntiles; tile += NWAVES) {
            const int key = tile * 32 + r;
            const bf16* krow = Z + (size_t)(b * SEQ + key) * OD_NP + 4096 + 8 * hg;
            f32x16 acc;
#pragma unroll
            for (int q = 0; q < 16; ++q) acc[q] = 0.f;
#pragma unroll
            for (int s = 0; s < 4; ++s) { const bf16x8 bfr = *(const bf16x8*)(krow + 16 * s); acc = __builtin_amdgcn_mfma_f32_32x32x16_bf16(af[s], bfr, acc, 0, 0, 0); }
            float sc = 0.f;
#pragma unroll
            for (int q = 0; q < 16; ++q) sc += fmaxf(acc[q], 0.f) * wv[q];
            const bool valid = key <= s0 + hg;
            SC[hg * 16384 + key] = valid ? ordkey(sc) : 0u;
        }
        __syncthreads();
        const int n = s0 + grp + 1; unsigned k = (unsigned)(n < 256 ? n : 256); unsigned prefix = 0u;
        const LAS unsigned* sc = SC + grp * 16384; LAS unsigned* hs = hist + grp * 256;
#pragma unroll 1
        for (int pass = 0; pass < 4; ++pass) {
            const int shift = 24 - 8 * pass;
            hs[ltid] = 0u;
            __syncthreads();
            for (int i = ltid; i < n; i += 256) { const unsigned kv = sc[i];
                const bool match = (pass == 0) ? true : ((kv >> (shift + 8)) == prefix);
                if (match) (void)__hip_atomic_fetch_add(&hs[(kv >> shift) & 255u], 1u, __ATOMIC_RELAXED, __HIP_MEMORY_SCOPE_WORKGROUP); }
            __syncthreads();
            if (lw == 0) {
                const unsigned c0 = hs[4 * F.lane], c1 = hs[4 * F.lane + 1], c2 = hs[4 * F.lane + 2], c3 = hs[4 * F.lane + 3];
                const unsigned tot = c0 + c1 + c2 + c3; unsigned suf = tot;
#pragma unroll
                for (int o = 1; o < 64; o <<= 1) { const unsigned tmp = __shfl_down(suf, o); if (F.lane + o < 64) suf += tmp; }
                unsigned above = suf - tot;
                if (above < k && k <= suf) {
                    int bin;
                    if (above + c3 >= k) { bin = 3; } else { above += c3; if (above + c2 >= k) { bin = 2; } else { above += c2; if (above + c1 >= k) { bin = 1; } else { above += c1; bin = 0; } } }
                    res[grp * 2 + 0] = (unsigned)(4 * F.lane + bin); res[grp * 2 + 1] = k - above;
                }
            }
            __syncthreads();
            prefix = (prefix << 8) | res[grp * 2 + 0]; k = res[grp * 2 + 1];
        }
        const unsigned tau = prefix; const int krem = (int)k;
        int cg = 0, ce = 0;
        for (int j = 0; j < 64; ++j) { const int i = ltid * 64 + ((j + ltid) & 63); if (i < n) { const unsigned kv = sc[i]; cg += (kv > tau) ? 1 : 0; ce += (kv == tau) ? 1 : 0; } }
        int ig = cg, ie = ce;
#pragma unroll
        for (int o = 1; o < 64; o <<= 1) { const int tg = __shfl_up(ig, o), te = __shfl_up(ie, o); if (F.lane >= o) { ig += tg; ie += te; } }
        if (F.lane == 63) { wtot[F.wave * 2] = ig; wtot[F.wave * 2 + 1] = ie; }
        __syncthreads();
        int og = ig - cg, oe = ie - ce, totg = 0;
        for (int w = 0; w < 4; ++w) { const int a = wtot[(grp * 4 + w) * 2], e = wtot[(grp * 4 + w) * 2 + 1]; if (w < lw) { og += a; oe += e; } totg += a; }
        unsigned short* sel = SEL + (size_t)(t0 + grp) * 256;
        for (int j = 0; j < 64; ++j) { const int i = ltid * 64 + ((j + ltid) & 63); if (i < n) { const unsigned kv = sc[i];
            if (kv > tau) { sel[og++] = (unsigned short)i; }
            else if (kv == tau) { if (oe < krem) sel[totg + oe] = (unsigned short)i; ++oe; } } }
        if (ltid == 0) CNT[t0 + grp] = (n < 256 ? n : 256);
    }
}

__device__ __forceinline__ void ph_dsa_attn(const Args& A, Frame& F) {
    const bf16* Z = (const bf16*)(A.ws + WS_Z); const unsigned short* SEL = (const unsigned short*)(A.ws + WS_LA); const int* CNT = (const int*)(A.ws + WS_CNT);
    bf16* Y = (bf16*)(A.ws + WS_HY);
    LAS unsigned char* QL = F.lds + F.wave * 1024;
    for (int it = F.gw; it < TOK * 4; it += F.ngw) {
        const int t = it >> 2, kvh = it & 3, b = t >> 14; const int n = CNT[t];
        *(LAS u32x4*)(QL + F.lane * 16) = *(const u32x4*)(Z + (size_t)t * OD_NP + kvh * 512 + F.lane * 8);
        int id[4];
#pragma unroll
        for (int m = 0; m < 4; ++m) { const int jj = F.lane + 64 * m; id[m] = (jj < n) ? (int)SEL[(size_t)t * 256 + jj] : 0; }
        asm volatile("s_waitcnt lgkmcnt(0)" ::: "memory"); __builtin_amdgcn_wave_barrier();
        float s[4][4];
#pragma unroll
        for (int m = 0; m < 4; ++m)
#pragma unroll
            for (int g = 0; g < 4; ++g) s[m][g] = 0.f;
        const bf16* kbase = Z + (size_t)b * SEQ * OD_NP + 2048 + kvh * 128;
#pragma unroll 2
        for (int c16 = 0; c16 < 16; ++c16) {
            u32x4 qd[4];
#pragma unroll
            for (int g = 0; g < 4; ++g) qd[g] = *(const LAS u32x4*)(QL + g * 256 + c16 * 16);
#pragma unroll
            for (int m = 0; m < 4; ++m) { const u32x4 kd = *(const u32x4*)(kbase + (size_t)id[m] * OD_NP + c16 * 8);
#pragma unroll
                for (int g = 0; g < 4; ++g) { float a = s[m][g]; a = dot2bf(kd.x, qd[g].x, a); a = dot2bf(kd.y, qd[g].y, a); a = dot2bf(kd.z, qd[g].z, a); a = dot2bf(kd.w, qd[g].w, a); s[m][g] = a; } }
        }
        float p[4][4];
#pragma unroll
        for (int g = 0; g < 4; ++g) {
            float mx = -INFINITY;
#pragma unroll
            for (int m = 0; m < 4; ++m) { const bool val = (F.lane + 64 * m) < n; s[m][g] = val ? s[m][g] * 0.08838834764831845f : -INFINITY; mx = fmaxf(mx, s[m][g]); }
            mx = wmax(mx); float sm = 0.f;
#pragma unroll
            for (int m = 0; m < 4; ++m) { const bool val = (F.lane + 64 * m) < n; p[m][g] = val ? expf(s[m][g] - mx) : 0.f; sm += p[m][g]; }
            const float rden = 1.0f / wsum(sm);
#pragma unroll
            for (int m = 0; m < 4; ++m) p[m][g] *= rden;
        }
        float o[4][2];
#pragma unroll
        for (int g = 0; g < 4; ++g) { o[g][0] = 0.f; o[g][1] = 0.f; }
        const bf16* vbase = Z + (size_t)b * SEQ * OD_NP + 2560 + kvh * 128 + 2 * F.lane;
#pragma unroll
        for (int m = 0; m < 4; ++m) {
            const int lim = (n - 64 * m) < 64 ? (n - 64 * m) : 64;
#pragma unroll 4
            for (int ln = 0; ln < lim; ++ln) {
                const int idj = __builtin_amdgcn_readlane(id[m], ln);
                const unsigned vw = *(const unsigned*)(vbase + (size_t)idj * OD_NP);
                const float v0 = lo2f(vw), v1 = hi2f(vw);
#pragma unroll
                for (int g = 0; g < 4; ++g) { const float pg = rdlane(p[m][g], ln); o[g][0] += pg * v0; o[g][1] += pg * v1; }
            }
        }
#pragma unroll
        for (int g = 0; g < 4; ++g) *(unsigned*)(Y + (size_t)t * DM + (kvh * 4 + g) * 128 + 2 * F.lane) = pk2(o[g][0], o[g][1]);
        asm volatile("s_waitcnt lgkmcnt(0)" ::: "memory"); __builtin_amdgcn_wave_barrier();
    }
}

__global__ void __launch_bounds__(NTHREADS, 2) mk_fwd(Args args) {
    extern __shared__ __attribute__((aligned(16))) unsigned char lds[];
    Frame F;
    F.lds = (LAS unsigned char*)lds;
    volatile LAS unsigned* MISC = (volatile LAS unsigned*)(F.lds + MISC_OFF);
    F.tid = threadIdx.x; F.lane = F.tid & 63; F.wave = __builtin_amdgcn_readfirstlane(F.tid >> 6);
    F.bx = blockIdx.x; F.G = gridDim.x; F.gw = F.bx * NWAVES + F.wave; F.ngw = F.G * NWAVES;
    if (F.tid < 64) MISC[F.tid] = 0u;
    __syncthreads();
    unsigned char* ws = args.ws;
    XcdBarrier bar = xcd_barrier_post((unsigned*)(ws + WS_CTL) + CW_BAR, MISC + 8);
    const int lo = args.ph_lo, hi = args.ph_hi;
#define IN(k) (lo <= (k) && (k) < hi)
#define SEAM(k) do { if (IN((k) + 1)) xcd_barrier(bar); } while (0)
#define GEMM_BF16(Aptr, Bptr, Nn, Kk, Optr, ldo) do { pg8::Gemm g{(const pg8::bf16_t*)(Aptr), (const pg8::bf16_t*)(Bptr), TOK, (Nn), (Kk)}; pg8::StaticOrder S; S.init(TOK, (Nn), F.G, F.bx); \
        pg8::EpiBf16<0> E{(pg8::bf16_t*)(Optr), (ldo), nullptr, 0, 0}; pg8::gemm_phase<pg8::EpiBf16<0>, pg8::StaticOrder, false>(F.lds, g, S, E, nullptr); } while (0)

    if (IN(0)) { ph_prologue(args, F); SEAM(0); }
    if (IN(1)) { ph_mod_x(args, F); SEAM(1); }
    if (IN(2)) { GEMM_BF16(ws + WS_HY, ws + WS_WINE, EV_NP, 2048, ws + WS_Z, EV_NP); SEAM(2); }
    if (IN(3)) { ph_even_post(args, F); SEAM(3); }
    if (IN(4)) { pg8::Gemm g{(const pg8::bf16_t*)(ws + WS_LA), (const pg8::bf16_t*)(ws + WS_WL), TOK, 3072, 512}; pg8::StaticOrder S; S.init(TOK, 3072, F.G, F.bx);
                 EpiLora E{(pg8::bf16_t*)(ws + WS_Z) + 1280, EV_NP, (const float*)args.in[7], (const float*)args.in[9]};
                 pg8::gemm_phase<EpiLora, pg8::StaticOrder, false>(F.lds, g, S, E, nullptr); SEAM(4); }
    if (IN(5)) { ph_scan_pack(args, F); SEAM(5); }
    if (IN(6)) { ph_swa(args, F); SEAM(6); }
    if (IN(7)) { ph_scan(args, F); SEAM(7); }
    if (IN(8)) { ph_rwkv_finish(args, F); SEAM(8); }
    if (IN(9)) { GEMM_BF16(ws + WS_HY, ws + WS_WOUTE, 2048, 2048, ws + WS_Z, 2048); SEAM(9); }
    if (IN(10)) { ph_ln_mixer(args, F, 0); SEAM(10); }
    if (IN(11)) { GEMM_BF16(ws + WS_HY, ws + WS_WQ0, 2048, 2048, ws + WS_Z, 2048); SEAM(11); }
    if (IN(12)) { ph_peer_select(args, F, 0); SEAM(12); }
    if (IN(13)) { ph_peer_gather(args, F, 0); SEAM(13); }
    if (IN(14)) { GEMM_BF16(ws + WS_HY, ws + WS_WINO, OD_NP, 2048, ws + WS_Z, OD_NP); SEAM(14); }
    if (IN(15)) { ph_odd_post(args, F); SEAM(15); }
    if (IN(16)) { ph_dsa_select(args, F); SEAM(16); }
    if (IN(17)) { ph_dsa_attn(args, F); SEAM(17); }
    if (IN(18)) { GEMM_BF16(ws + WS_HY, ws + WS_WOUTO, 2048, 2048, ws + WS_Z, 2048); SEAM(18); }
    if (IN(19)) { ph_ln_mixer(args, F, 1); SEAM(19); }
    if (IN(20)) { GEMM_BF16(ws + WS_HY, ws + WS_WQ1, 2048, 2048, ws + WS_Z, 2048); SEAM(20); }
    if (IN(21)) { ph_peer_select(args, F, 1); SEAM(21); }
    if (IN(22)) { ph_peer_gather(args, F, 1); }
#undef IN
#undef SEAM
#undef GEMM_BF16
}

#ifndef MK_SPLIT
#define MK_SPLIT 0
#endif
extern "C" void kernel_launch(void* const* d_in, const int* in_sizes, int n_in, void* d_out, int out_size, void* d_ws, size_t ws_size, hipStream_t stream) {
    static int grid = 0;
    if (grid == 0) {
        int dev = 0, cus = 0;
        if (n_in != 27 || out_size != TOK * DM || ws_size < WS_END) { fprintf(stderr, "kernel_launch: unexpected shapes (n_in %d out %d ws %zu)\n", n_in, out_size, ws_size); grid = -1; return; }
        if (hipGetDevice(&dev) != hipSuccess || hipDeviceGetAttribute(&cus, hipDeviceAttributeMultiprocessorCount, dev) != hipSuccess) { grid = -1; return; }
        if (hipFuncSetAttribute((const void*)mk_fwd, hipFuncAttributeMaxDynamicSharedMemorySize, LDS_BYTES) != hipSuccess) { fprintf(stderr, "kernel_launch: hipFuncSetAttribute failed\n"); grid = -1; return; }
        int per_cu = 0;
        if (hipOccupancyMaxActiveBlocksPerMultiprocessor(&per_cu, (const void*)mk_fwd, NTHREADS, LDS_BYTES) != hipSuccess || per_cu < 1) fprintf(stderr, "kernel_launch: occupancy query says %d\n", per_cu);
        (void)hipGetLastError();
        grid = cus;
    }
    if (grid < 0) return;
    (void)hipMemsetAsync((char*)d_ws + WS_CTL, 0, CTL_ZERO_BYTES, stream);
    Args a{};
    for (int i = 0; i < 27; ++i) a.in[i] = d_in[i];
    a.out = (float*)d_out; a.ws = (unsigned char*)d_ws;
#if MK_SPLIT
    for (int p = 0; p < 23; ++p) { a.ph_lo = p; a.ph_hi = p + 1; hipLaunchKernelGGL(mk_fwd, dim3(grid), dim3(NTHREADS), LDS_BYTES, stream, a); }
#else
    a.ph_lo = 0; a.ph_hi = 23;
    hipLaunchKernelGGL(mk_fwd, dim3(grid), dim3(NTHREADS), LDS_BYTES, stream, a);
#endif
}
```

```cpp
#include <hip/hip_runtime.h>
#include <cstdio>
#include <cstdint>
namespace pg8 {
#define PG8_LAS __attribute__((address_space(3)))
typedef unsigned short bf16_t;
typedef short bf16x8 __attribute__((ext_vector_type(8)));
typedef float f32x4 __attribute__((ext_vector_type(4)));
typedef unsigned u32x4 __attribute__((ext_vector_type(4)));
constexpr int BM = 256, BK = 64, HALF = 128, HTB = HALF * BK * 2  , STAGE_BYTES = 8 * HTB, NXCD = 8, WGM = 8;

__host__ __device__ __forceinline__ int lds_byte(int r, int c) { const int st = (r >> 4) * 2 + (c >> 5), rr = r & 15, cc = c & 31, ob = rr * 64 + cc * 2; return st * 1024 + (ob ^ (((ob >> 9) & 1) << 5)); }
__host__ __device__ __forceinline__ void stage_rc(int b, int& R, int& C) { const int st = b / 1024, sb = b % 1024, swz = sb ^ (((sb >> 9) & 1) << 5); R = (st >> 1) * 16 + swz / 64; C = (st & 1) * 32 + (swz % 64) / 2; }
__host__ __device__ __forceinline__ int perm32(int rho) { const int n = rho >> 4, i = rho & 15; return 8 * (i >> 2) + 4 * n + (i & 3); }

struct Unit { int pm, pn; };
struct Gemm { const bf16_t* A; const bf16_t* Bt; int M, N, K; };

struct StaticOrder {
    int nM, nN, nwg, G, c;
    __host__ __device__ void init(int M, int N, int G_, int c_) { nM = M / BM; nN = N / BM; nwg = nM * nN; G = G_; c = c_; }
    __host__ __device__ bool next(int i, Unit& u) const {
        const long L = (long)i * G + c; if (L >= nwg) return false;
        int wgid = (int)L; { const int q = nwg / NXCD, r = nwg % NXCD, xcd = wgid % NXCD, off = wgid / NXCD; wgid = (xcd < r ? xcd * (q + 1) : r * (q + 1) + (xcd - r) * q) + off; }
        const int nig = WGM * nN, gid = wgid / nig, fm = gid * WGM, gsz = (nM - fm) < WGM ? (nM - fm) : WGM;
        u.pm = fm + ((wgid % nig) % gsz); u.pn = (wgid % nig) / gsz; return true;
    }
    __device__ __forceinline__ void a_ready(const Unit&) const {}
    __device__ __forceinline__ void done(const Unit&) const {}
};
struct CountedOrder : StaticOrder {
    const unsigned* ready; unsigned need; unsigned* tmo;
    __device__ __forceinline__ void a_ready(const Unit& u) const {
        if (threadIdx.x < 64) {
            const unsigned long long t0 = __builtin_amdgcn_s_memrealtime(); unsigned polls = 0;
            while ((unsigned)__builtin_amdgcn_readfirstlane(__hip_atomic_load(ready + 64 * u.pm, __ATOMIC_RELAXED, __HIP_MEMORY_SCOPE_AGENT)) < need) {
                if ((++polls & 255u) == 0u && __builtin_amdgcn_readfirstlane(__hip_atomic_load(tmo, __ATOMIC_RELAXED, __HIP_MEMORY_SCOPE_AGENT)) != 0u) break;
                if (__builtin_amdgcn_s_memrealtime() - t0 > 2000000ull) {
                    if (threadIdx.x == 0) { unsigned expect = 0u; __hip_atomic_compare_exchange_strong(tmo + 1, &expect, 0x600u | (unsigned)(u.pm & 0xff), __ATOMIC_RELAXED, __ATOMIC_RELAXED, __HIP_MEMORY_SCOPE_AGENT); __hip_atomic_store(tmo, 1u, __ATOMIC_RELAXED, __HIP_MEMORY_SCOPE_AGENT); }
                    break; }
                __builtin_amdgcn_s_sleep(2); }
            __builtin_amdgcn_fence(__ATOMIC_ACQUIRE, "agent");
            asm volatile("s_waitcnt vmcnt(0)" ::: "memory");
        }
#if !defined(BROKEN_HOOK_NO_BARRIER)
        asm volatile("" ::: "memory"); __builtin_amdgcn_s_barrier(); asm volatile("" ::: "memory");
#endif
    }
};

__device__ __forceinline__ unsigned cvt_pk_bf16(float lo, float hi) { unsigned r; asm volatile("v_cvt_pk_bf16_f32 %0, %1, %2" : "=v"(r) : "v"(lo), "v"(hi)); return r; }
typedef float f32x2 __attribute__((ext_vector_type(2)));
__device__ __forceinline__ f32x2 gelu_pk(f32x2 v) {
    const f32x2 av = __builtin_elementwise_abs(v), d = av * 0.2316418882f + 1.0f;
    f32x2 t; t.x = __builtin_amdgcn_rcpf(d.x); t.y = __builtin_amdgcn_rcpf(d.y);
    f32x2 q = t * 0.5307027145f + (-0.7265760135f); q = q * t + 0.7107068705f; q = q * t + (-0.142248368f); q = q * t + 0.127414796f; q = q * t;
    const f32x2 s = (v * v) * (-0.72134752044f);
    f32x2 e; e.x = __builtin_amdgcn_exp2f(s.x); e.y = __builtin_amdgcn_exp2f(s.y);
    const f32x2 m = v * (q * e), r = v - m;
    f32x2 o; o.x = v.x < 0.f ? m.x : r.x; o.y = v.y < 0.f ? m.y : r.y; return o;
}

struct EpiF32 {
    static constexpr bool PERM = false, AFTER_DRAIN = false;
    float* C; int ldc; const float* bias;
    __device__ __forceinline__ void operator()(const f32x4 (&acc)[2][2][4][2], const Unit& u, int wr, int wc, int fr, int fq) const {
        const int row0 = u.pm * BM + wr * 64 + fr, col0 = u.pn * BM + wc * 32 + 4 * fq;
        f32x4 bv[2][2];
#pragma unroll
        for (int bj = 0; bj < 2; ++bj)
#pragma unroll
            for (int n = 0; n < 2; ++n) bv[bj][n] = bias ? *(const f32x4*)(bias + col0 + bj * HALF + n * 16) : (f32x4){0.f, 0.f, 0.f, 0.f};
#pragma unroll
        for (int ai = 0; ai < 2; ++ai)
#pragma unroll
            for (int m = 0; m < 4; ++m) { float* rowp = C + (size_t)(row0 + ai * HALF + m * 16) * ldc + col0;
#pragma unroll
                for (int bj = 0; bj < 2; ++bj)
#pragma unroll
                    for (int n = 0; n < 2; ++n) *(f32x4*)(rowp + bj * HALF + n * 16) = acc[ai][bj][m][n] + bv[bj][n]; }
    }
};
template <int ACT  > struct EpiBf16 {
    static constexpr bool PERM = true, AFTER_DRAIN = false;
    bf16_t* O; int ldc; const float* bias; int split_cols; size_t split_stride;
    __device__ __forceinline__ void operator()(const f32x4 (&acc)[2][2][4][2], const Unit& u, int wr, int wc, int fr, int fq) const {
        const int row0 = u.pm * BM + wr * 64 + fr; int colt = u.pn * BM; bf16_t* base = O;
        if (split_cols) { const int t = colt / split_cols; base += (size_t)t * split_stride; colt -= t * split_cols; }
        const int col0 = colt + wc * 32 + 8 * fq, bcol0 = u.pn * BM + wc * 32 + 8 * fq;
        f32x4 bv[2][2];
#pragma unroll
        for (int bj = 0; bj < 2; ++bj)
#pragma unroll
            for (int n = 0; n < 2; ++n) bv[bj][n] = bias ? *(const f32x4*)(bias + bcol0 + bj * HALF + 4 * n) : (f32x4){0.f, 0.f, 0.f, 0.f};
#pragma unroll
        for (int ai = 0; ai < 2; ++ai)
#pragma unroll
            for (int m = 0; m < 4; ++m) { bf16_t* rowp = base + (size_t)(row0 + ai * HALF + m * 16) * ldc + col0;
#pragma unroll
                for (int bj = 0; bj < 2; ++bj) { f32x4 v0 = acc[ai][bj][m][0] + bv[bj][0], v1 = acc[ai][bj][m][1] + bv[bj][1];
                    if (ACT == 1) { f32x2 a = gelu_pk((f32x2){v0[0], v0[1]}), b = gelu_pk((f32x2){v0[2], v0[3]}), c = gelu_pk((f32x2){v1[0], v1[1]}), d = gelu_pk((f32x2){v1[2], v1[3]});
                        v0 = (f32x4){a.x, a.y, b.x, b.y}; v1 = (f32x4){c.x, c.y, d.x, d.y}; }
                    if (ACT == 2) {
#pragma unroll
                        for (int j = 0; j < 4; ++j) { v0[j] = 0.5f * v0[j] * (1.0f + erff(v0[j] * 0.70710678f)); v1[j] = 0.5f * v1[j] * (1.0f + erff(v1[j] * 0.70710678f)); } }
                    u32x4 w; w.x = cvt_pk_bf16(v0[0], v0[1]); w.y = cvt_pk_bf16(v0[2], v0[3]); w.z = cvt_pk_bf16(v1[0], v1[1]); w.w = cvt_pk_bf16(v1[2], v1[3]);
                    *(u32x4*)(rowp + bj * HALF) = w; } }
    }
};

struct PanelStats {
    unsigned* xbuf;
    unsigned* cnt;
    unsigned* tmo;
    int ntn; float eps;
    unsigned code;
    __device__ __forceinline__ bool run(const f32x4 (&v)[2][2][4][2], const Unit& u, int wr, int wc, int fr, int fq, PG8_LAS unsigned char* lds, int wid, int lane) const {
        typedef float f32x2v __attribute__((ext_vector_type(2)));
        PG8_LAS f32x2v* P = (PG8_LAS f32x2v*)lds;
        PG8_LAS f32x2v* S = (PG8_LAS f32x2v*)(lds + 8192);
        PG8_LAS unsigned* flag = (PG8_LAS unsigned*)(lds + 8192 + 2048);
#pragma unroll
        for (int ai = 0; ai < 2; ++ai)
#pragma unroll
            for (int m = 0; m < 4; ++m) {
                float s = 0.f;
#pragma unroll
                for (int bj = 0; bj < 2; ++bj)
#pragma unroll
                    for (int n = 0; n < 2; ++n) { const f32x4 x = v[ai][bj][m][n]; s += (x[0] + x[1]) + (x[2] + x[3]); }
                s += __shfl_xor(s, 16); s += __shfl_xor(s, 32);
                const float mw = s * (1.0f / 64.0f); float q = 0.f;
#pragma unroll
                for (int bj = 0; bj < 2; ++bj)
#pragma unroll
                    for (int n = 0; n < 2; ++n) { const f32x4 d = v[ai][bj][m][n] - mw; q += (d[0] * d[0] + d[1] * d[1]) + (d[2] * d[2] + d[3] * d[3]); }
                q += __shfl_xor(q, 16); q += __shfl_xor(q, 32);
                if (fq == 0) P[(ai * HALF + wr * 64 + m * 16 + fr) * 4 + wc] = (f32x2v){mw, q};
            }
        asm volatile("s_waitcnt lgkmcnt(0)" ::: "memory"); __builtin_amdgcn_s_barrier(); asm volatile("" ::: "memory");
#if defined(BROKEN_NO_WAIT)
        if (blockIdx.x >= 64) { const long long t0 = clock64(); while (clock64() - t0 < 60000) __builtin_amdgcn_s_sleep(8); }
#endif
        const int row = wid * 32 + (lane & 31);
        if (lane < 32) {
            const f32x2v a = P[row * 4 + 0], b = P[row * 4 + 1], c = P[row * 4 + 2], d = P[row * 4 + 3];
            const float mt = (a.x + b.x + c.x + d.x) * 0.25f;
            const float da = a.x - mt, db = b.x - mt, dc = c.x - mt, dd = d.x - mt;
            const float m2 = (a.y + b.y) + (c.y + d.y) + 64.0f * ((da * da + db * db) + (dc * dc + dd * dd));
            unsigned long long* slot = (unsigned long long*)xbuf + ((size_t)(u.pm * BM + row) * 4 + u.pn);
            __hip_atomic_store(slot, ((unsigned long long)__float_as_uint(m2) << 32) | __float_as_uint(mt), __ATOMIC_RELAXED, __HIP_MEMORY_SCOPE_AGENT);
        }
        asm volatile("s_waitcnt vmcnt(0)" ::: "memory");
        if (lane == 0) __hip_atomic_fetch_add(cnt + 64 * u.pm, 1u, __ATOMIC_RELAXED, __HIP_MEMORY_SCOPE_AGENT);
        if (wid == 0) {
            bool dead = false; const unsigned long long t0 = __builtin_amdgcn_s_memrealtime(); const unsigned want = 8u * (unsigned)ntn;
            for (;;) {
#if defined(BROKEN_NO_WAIT)
                break;
#endif
                if ((unsigned)__builtin_amdgcn_readfirstlane(__hip_atomic_load(cnt + 64 * u.pm, __ATOMIC_RELAXED, __HIP_MEMORY_SCOPE_AGENT)) >= want) break;
                if (__builtin_amdgcn_s_memrealtime() - t0 > 2000000ull) {
                    if (lane == 0) { unsigned expect = 0u; __hip_atomic_compare_exchange_strong(tmo + 1, &expect, code | (unsigned)(u.pm & 0xff), __ATOMIC_RELAXED, __ATOMIC_RELAXED, __HIP_MEMORY_SCOPE_AGENT);
                                     __hip_atomic_store(tmo, 1u, __ATOMIC_RELAXED, __HIP_MEMORY_SCOPE_AGENT); }
                    dead = true; break; }
                __builtin_amdgcn_s_sleep(2);
            }
            __builtin_amdgcn_fence(__ATOMIC_ACQUIRE, "agent");
            if (lane == 0) flag[0] = dead ? 1u : 0u;
        }
        asm volatile("s_waitcnt vmcnt(0) lgkmcnt(0)" ::: "memory"); __builtin_amdgcn_s_barrier(); asm volatile("" ::: "memory");
        const bool bad = flag[0] != 0u;
        if (lane < 32) {
            const unsigned long long* slot = (const unsigned long long*)xbuf + (size_t)(u.pm * BM + row) * 4; float mt[4], m2[4]; float ms = 0.f;
#pragma unroll
            for (int t = 0; t < 4; ++t) { if (t < ntn) { const unsigned long long w = __hip_atomic_load(slot + t, __ATOMIC_RELAXED, __HIP_MEMORY_SCOPE_AGENT); mt[t] = __uint_as_float((unsigned)w); m2[t] = __uint_as_float((unsigned)(w >> 32)); } else { mt[t] = 0.f; m2[t] = 0.f; } ms += mt[t]; }
            const float mean = ms / (float)ntn; float q = 0.f;
#pragma unroll
            for (int t = 0; t < 4; ++t) if (t < ntn) { const float dm = mt[t] - mean; q += m2[t] + 256.0f * dm * dm; }
            S[row] = (f32x2v){mean, 1.0f / sqrtf(q / (256.0f * (float)ntn) + eps)};
        }
        asm volatile("s_waitcnt lgkmcnt(0)" ::: "memory"); __builtin_amdgcn_s_barrier(); asm volatile("" ::: "memory");
        return bad;
    }
};
struct EpiLnRes {
    static constexpr bool PERM = false, AFTER_DRAIN = true;
    const float* base; float* out; int ldc; const float* bias; PanelStats st; unsigned poison;
    __device__ __forceinline__ void refuse(size_t i0, size_t stride, int M, int N) const { const float q = __builtin_nanf(""); for (size_t i = i0; i < (size_t)M * N; i += stride) out[(i / N) * ldc + i % N] = q;
        if (i0 == 0) { unsigned expect = 0u; __hip_atomic_compare_exchange_strong(st.tmo + 1, &expect, 0x7f0u, __ATOMIC_RELAXED, __ATOMIC_RELAXED, __HIP_MEMORY_SCOPE_AGENT); __hip_atomic_store(st.tmo, 1u, __ATOMIC_RELAXED, __HIP_MEMORY_SCOPE_AGENT); } }
    __device__ __forceinline__ void fused(f32x4 (&acc)[2][2][4][2], const Unit& u, int wr, int wc, int fr, int fq, PG8_LAS unsigned char* lds, int wid, int lane) const {
        typedef float f32x2v __attribute__((ext_vector_type(2)));
        const PG8_LAS f32x2v* S = (const PG8_LAS f32x2v*)(lds + 8192);
        const int col0 = u.pn * BM + wc * 32 + 4 * fq;
#pragma unroll
        for (int bj = 0; bj < 2; ++bj)
#pragma unroll
            for (int n = 0; n < 2; ++n) { const f32x4 bv = bias ? *(const f32x4*)(bias + col0 + bj * HALF + n * 16) : (f32x4){0.f, 0.f, 0.f, 0.f};
#pragma unroll
                for (int ai = 0; ai < 2; ++ai)
#pragma unroll
                    for (int m = 0; m < 4; ++m) acc[ai][bj][m][n] += bv; }
        const bool bad = st.run(acc, u, wr, wc, fr, fq, lds, wid, lane) || poison != 0u;
        const float qnan = __builtin_nanf("");
#pragma unroll
        for (int ai = 0; ai < 2; ++ai)
#pragma unroll
            for (int m = 0; m < 4; ++m) { const int r = ai * HALF + wr * 64 + m * 16 + fr; const f32x2v sr = S[r]; const size_t off = (size_t)(u.pm * BM + r) * ldc + col0;
#pragma unroll
                for (int bj = 0; bj < 2; ++bj)
#pragma unroll
                    for (int n = 0; n < 2; ++n) { const f32x4 bs = *(const f32x4*)(base + off + bj * HALF + n * 16); f32x4 o = bs + (acc[ai][bj][m][n] - sr.x) * sr.y;
                        if (bad) o = (f32x4){qnan, qnan, qnan, qnan}; *(f32x4*)(out + off + bj * HALF + n * 16) = o; }
                asm volatile("" ::: "memory"); }
    }
};
struct EpiLnResLn {
    static constexpr bool PERM = false, AFTER_DRAIN = true;
    const float* base; float* out; bf16_t* xn; int ldc; const float* bias; PanelStats st1, st2; unsigned poison;
    __device__ __forceinline__ void refuse(size_t i0, size_t stride, int M, int N) const { const float q = __builtin_nanf(""); for (size_t i = i0; i < (size_t)M * N; i += stride) { const size_t o = (i / N) * ldc + i % N; out[o] = q; xn[o] = (bf16_t)0x7fc0u; }
        if (i0 == 0) { unsigned expect = 0u; __hip_atomic_compare_exchange_strong(st1.tmo + 1, &expect, 0x7f0u, __ATOMIC_RELAXED, __ATOMIC_RELAXED, __HIP_MEMORY_SCOPE_AGENT); __hip_atomic_store(st1.tmo, 1u, __ATOMIC_RELAXED, __HIP_MEMORY_SCOPE_AGENT); } }
    __device__ __forceinline__ void fused(f32x4 (&acc)[2][2][4][2], const Unit& u, int wr, int wc, int fr, int fq, PG8_LAS unsigned char* lds, int wid, int lane) const {
        typedef float f32x2v __attribute__((ext_vector_type(2))); typedef unsigned u32x2v __attribute__((ext_vector_type(2)));
        const PG8_LAS f32x2v* S = (const PG8_LAS f32x2v*)(lds + 8192);
        const int col0 = u.pn * BM + wc * 32 + 4 * fq;
#pragma unroll
        for (int bj = 0; bj < 2; ++bj)
#pragma unroll
            for (int n = 0; n < 2; ++n) { const f32x4 bv = bias ? *(const f32x4*)(bias + col0 + bj * HALF + n * 16) : (f32x4){0.f, 0.f, 0.f, 0.f};
#pragma unroll
                for (int ai = 0; ai < 2; ++ai)
#pragma unroll
                    for (int m = 0; m < 4; ++m) acc[ai][bj][m][n] += bv; }
        bool bad = st1.run(acc, u, wr, wc, fr, fq, lds, wid, lane) || poison != 0u;
        const float qnan = __builtin_nanf("");
#pragma unroll
        for (int ai = 0; ai < 2; ++ai)
#pragma unroll
            for (int m = 0; m < 4; ++m) { const int r = ai * HALF + wr * 64 + m * 16 + fr; const f32x2v sr = S[r]; const size_t off = (size_t)(u.pm * BM + r) * ldc + col0;
#pragma unroll
                for (int bj = 0; bj < 2; ++bj)
#pragma unroll
                    for (int n = 0; n < 2; ++n) { const f32x4 bs = *(const f32x4*)(base + off + bj * HALF + n * 16); acc[ai][bj][m][n] = bs + (acc[ai][bj][m][n] - sr.x) * sr.y; }
                asm volatile("" : "+v"(acc[ai][0][m][0]), "+v"(acc[ai][0][m][1]), "+v"(acc[ai][1][m][0]), "+v"(acc[ai][1][m][1]));
                if (m & 1) asm volatile("" ::: "memory"); }
        const bool bad1 = bad;
        bad = st2.run(acc, u, wr, wc, fr, fq, lds, wid, lane) || bad;
#pragma unroll
        for (int ai = 0; ai < 2; ++ai)
#pragma unroll
            for (int m = 0; m < 4; ++m) { const int r = ai * HALF + wr * 64 + m * 16 + fr; const f32x2v sr = S[r]; const size_t off = (size_t)(u.pm * BM + r) * ldc + col0;
#pragma unroll
                for (int bj = 0; bj < 2; ++bj)
#pragma unroll
                    for (int n = 0; n < 2; ++n) { const f32x4 x1 = acc[ai][bj][m][n]; *(f32x4*)(out + off + bj * HALF + n * 16) = bad1 ? (f32x4){qnan, qnan, qnan, qnan} : x1;
                        const f32x4 o = (x1 - sr.x) * sr.y; u32x2v w; w.x = cvt_pk_bf16(o[0], o[1]); w.y = cvt_pk_bf16(o[2], o[3]);
                        if (bad) { w.x = 0x7fc07fc0u; w.y = 0x7fc07fc0u; } *(u32x2v*)(xn + off + bj * HALF + n * 16) = w; }
                asm volatile("" ::: "memory"); }
    }
};

template <class Epi, class Sched, bool STAMP = false>
__device__ __forceinline__ void gemm_phase(PG8_LAS unsigned char* lds, const Gemm g, const Sched& S, const Epi& E, unsigned long long* stamps) {
    const int tid = threadIdx.x, wid = __builtin_amdgcn_readfirstlane(tid >> 6), lane = tid & 63, wr = wid >> 2, wc = wid & 3, fr = lane & 15, fq = lane >> 4;
    const int K = g.K, nt = K / BK;
    int ts_lo = 0, ts_hi = 0, nts = 0; const unsigned long long rt_entry = STAMP ? (unsigned long long)wall_clock64() : 0ull;
#define PG8_STAMP() do { if (STAMP && wid == 0 && nts < 64) { const unsigned long long _c = (unsigned long long)clock64(); \
        ts_lo = (lane == nts) ? (int)(unsigned)_c : ts_lo; ts_hi = (lane == nts) ? (int)(unsigned)(_c >> 32) : ts_hi; ++nts; } } while (0)
    PG8_STAMP();
    unsigned voffA[2], voffB[2];
#pragma unroll
    for (int i = 0; i < 2; ++i) { int R, C; stage_rc(tid * 16 + i * 8192, R, C); const int Rb = Epi::PERM ? ((R & ~31) + perm32(R & 31)) : R;
        voffA[i] = (unsigned)(R * K + C) * 2u; voffB[i] = (unsigned)(Rb * K + C) * 2u; }
    const size_t kstep = (size_t)(BK * 2);
    const size_t hstep = (size_t)HALF * K * 2;
    const size_t tstep = 2 * hstep;
    const unsigned ldsw = (unsigned)wid * 1024u;
    const int aoff = lds_byte(wr * 64 + fr, fq * 8), boff = lds_byte(wc * 32 + fr, fq * 8);
#define PG8_SA(b, h) (((b) * 2 + (h)) * HTB)
#define PG8_SB(b, h) ((4 + (b) * 2 + (h)) * HTB)
#define PG8_STAGE(bufoff, gbase, voff) do { _Pragma("unroll") for (int _i = 0; _i < 2; ++_i) \
        __builtin_amdgcn_global_load_lds((const unsigned*)((const char*)(gbase) + (voff)[_i]), (PG8_LAS unsigned*)(lds + (bufoff) + ldsw + _i * 8192), 16, 0, 0); } while (0)
#define PG8_LDA(dst, b, h) do { _Pragma("unroll") for (int m = 0; m < 4; ++m) _Pragma("unroll") for (int k = 0; k < 2; ++k) dst[m][k] = *(const PG8_LAS bf16x8*)(lds + PG8_SA(b, h) + aoff + m * 2048 + k * 1024); } while (0)
#define PG8_LDB(dst, b, h) do { _Pragma("unroll") for (int n = 0; n < 2; ++n) _Pragma("unroll") for (int k = 0; k < 2; ++k) dst[n][k] = *(const PG8_LAS bf16x8*)(lds + PG8_SB(b, h) + boff + n * 2048 + k * 1024); } while (0)
#define PG8_MMA(ai, bj, At, Bt) do { __builtin_amdgcn_s_setprio(1); _Pragma("unroll") for (int m = 0; m < 4; ++m) _Pragma("unroll") for (int n = 0; n < 2; ++n) _Pragma("unroll") for (int k = 0; k < 2; ++k) \
        acc[ai][bj][m][n] = __builtin_amdgcn_mfma_f32_16x16x32_bf16(Bt[n][k], At[m][k], acc[ai][bj][m][n], 0, 0, 0); __builtin_amdgcn_s_setprio(0); } while (0)
#define PG8_WAIT_V(n) asm volatile("s_waitcnt vmcnt(" #n ")" ::: "memory")
#define PG8_WAIT_L(n) asm volatile("s_waitcnt lgkmcnt(" #n ")" ::: "memory")
#define PG8_BAR __builtin_amdgcn_s_barrier()
#define PG8_SCHED __builtin_amdgcn_sched_barrier(0)
    Unit cur, nxt; int ui = 0;
    if (!S.next(0, cur)) return;
    f32x4 acc[2][2][4][2];
#pragma unroll
    for (int a = 0; a < 2; ++a)
#pragma unroll
        for (int b = 0; b < 2; ++b)
#pragma unroll
            for (int m = 0; m < 4; ++m)
#pragma unroll
                for (int n = 0; n < 2; ++n) acc[a][b][m][n] = (f32x4){0.f, 0.f, 0.f, 0.f};
    bf16x8 At[4][2], B0[2][2], B1[2][2];
    const char* cA = (const char*)g.A + (size_t)cur.pm * tstep; const char* cB = (const char*)g.Bt + (size_t)cur.pn * tstep;
    S.a_ready(cur);
    PG8_STAGE(PG8_SB(0, 0), cB, voffB); PG8_STAGE(PG8_SA(0, 0), cA, voffA); PG8_STAGE(PG8_SB(0, 1), cB + hstep, voffB); PG8_STAGE(PG8_SA(0, 1), cA + hstep, voffA);
    if (wr == 1) PG8_BAR;
    PG8_WAIT_V(4); PG8_BAR;
    PG8_STAGE(PG8_SB(1, 0), cB + kstep, voffB); PG8_STAGE(PG8_SA(1, 0), cA + kstep, voffA); PG8_STAGE(PG8_SB(1, 1), cB + hstep + kstep, voffB);
    PG8_WAIT_V(6); PG8_BAR;
    PG8_STAMP();
    for (;;) {
        const bool has_next = S.next(ui + 1, nxt);
        const char* nA = has_next ? (const char*)g.A + (size_t)nxt.pm * tstep : cA; const char* nB = has_next ? (const char*)g.Bt + (size_t)nxt.pn * tstep : cB;
        for (int t = 0; t < nt; t += 2) {
            const bool last = (t == nt - 2);
            const char* a1 = cA + (size_t)(t + 1) * kstep;
            const char* a2 = last ? nA : cA + (size_t)(t + 2) * kstep; const char* b2 = last ? nB : cB + (size_t)(t + 2) * kstep;
            const char* a3 = a2 + kstep; const char* b3 = b2 + kstep;
            if (last && has_next) S.a_ready(nxt);
            PG8_LDB(B0, 0, 0); PG8_SCHED; PG8_LDA(At, 0, 0); PG8_STAGE(PG8_SA(1, 1), a1 + hstep, voffA);
            PG8_WAIT_L(8); PG8_BAR; PG8_WAIT_L(0); PG8_MMA(0, 0, At, B0); PG8_BAR; PG8_SCHED;
            PG8_LDB(B1, 0, 1); PG8_STAGE(PG8_SB(0, 0), b2, voffB);
            PG8_BAR; PG8_WAIT_L(0); PG8_MMA(0, 1, At, B1); PG8_BAR;
            PG8_LDA(At, 0, 1); PG8_STAGE(PG8_SA(0, 0), a2, voffA);
            PG8_BAR; PG8_WAIT_L(0); PG8_MMA(1, 0, At, B0); PG8_BAR; PG8_SCHED;
            PG8_STAGE(PG8_SB(0, 1), b2 + hstep, voffB);
            PG8_WAIT_V(6); PG8_BAR; PG8_MMA(1, 1, At, B1); PG8_BAR;
            PG8_LDB(B0, 1, 0); PG8_SCHED; PG8_LDA(At, 1, 0); PG8_STAGE(PG8_SA(0, 1), a2 + hstep, voffA);
            PG8_WAIT_L(8); PG8_BAR; PG8_WAIT_L(0); PG8_MMA(0, 0, At, B0); PG8_BAR; PG8_SCHED;
            PG8_LDB(B1, 1, 1); PG8_STAGE(PG8_SB(1, 0), b3, voffB);
            PG8_BAR; PG8_WAIT_L(0); PG8_MMA(0, 1, At, B1); PG8_BAR;
            PG8_LDA(At, 1, 1); PG8_STAGE(PG8_SA(1, 0), a3, voffA);
            PG8_BAR; PG8_WAIT_L(0); PG8_MMA(1, 0, At, B0); PG8_BAR; PG8_SCHED;
            PG8_STAGE(PG8_SB(1, 1), b3 + hstep, voffB);
            PG8_WAIT_V(6); PG8_BAR; PG8_MMA(1, 1, At, B1); PG8_BAR;
        }
        PG8_STAMP();
        if constexpr (!Epi::AFTER_DRAIN) { E(acc, cur, wr, wc, fr, fq); S.done(cur); }
        PG8_STAMP();
        if (!has_next) break;
#pragma unroll
        for (int a = 0; a < 2; ++a)
#pragma unroll
            for (int b = 0; b < 2; ++b)
#pragma unroll
                for (int m = 0; m < 4; ++m)
#pragma unroll
                    for (int n = 0; n < 2; ++n) acc[a][b][m][n] = (f32x4){0.f, 0.f, 0.f, 0.f};
        cur = nxt; cA = nA; cB = nB; ++ui;
    }
    PG8_WAIT_V(0);
    if (wr == 0) PG8_BAR;
    PG8_BAR;
    if constexpr (Epi::AFTER_DRAIN) { E.fused(acc, cur, wr, wc, fr, fq, lds, wid, lane); S.done(cur); }
    PG8_STAMP();
    if (STAMP && wid == 0) { stamps[lane] = lane < nts ? (((unsigned long long)(unsigned)ts_hi << 32) | (unsigned)ts_lo) : 0ull;
        if (lane == 62) stamps[62] = rt_entry; if (lane == 63) stamps[63] = (unsigned long long)wall_clock64(); }
#undef PG8_STAMP
#undef PG8_SA
#undef PG8_SB
#undef PG8_STAGE
#undef PG8_LDA
#undef PG8_LDB
#undef PG8_MMA
#undef PG8_WAIT_V
#undef PG8_WAIT_L
#undef PG8_BAR
#undef PG8_SCHED
}
}

#define LAS __attribute__((address_space(3)))
#define XB_TMO      128
#define XB_XCNT(j)  (256  + 64 * (j))
#define XB_XSUB(j)  (1280 + 64 * (j))
#define XB_XGEN(j)  (2304 + 64 * (j))
#define XB_TOP      3328
#define XB_TOPGEN   3392
#define XCD_BAR_WORDS 3456
#define XB_SPIN_CAP (1u << 24)

__device__ __forceinline__ unsigned xb_ld(unsigned* p)              { return __hip_atomic_load(p, __ATOMIC_RELAXED, __HIP_MEMORY_SCOPE_AGENT); }
__device__ __forceinline__ unsigned xb_add(unsigned* p, unsigned v) { return __hip_atomic_fetch_add(p, v, __ATOMIC_RELAXED, __HIP_MEMORY_SCOPE_AGENT); }
__device__ __forceinline__ unsigned xb_xcc_id() { return (unsigned)__builtin_amdgcn_s_getreg((3 << 11) | 20) & 0xFu; }
#define XB_SPIN(cond, bar) do { unsigned _sp = 0; while (cond) { __builtin_amdgcn_s_sleep(1); \
    if ((++_sp & 255u) == 0u) { if (xb_ld(&(bar)[XB_TMO])) break; if (_sp > XB_SPIN_CAP) { atomicAdd(&(bar)[XB_TMO], 1u); break; } } } } while (0)

struct XcdBarrier { unsigned* bar; unsigned x; volatile LAS unsigned* st; };

__device__ __forceinline__ XcdBarrier xcd_barrier_post(unsigned* bar, volatile LAS unsigned* st) {
    XcdBarrier b; b.bar = bar; b.x = xb_xcc_id(); b.st = st;
    if (threadIdx.x == 0) (void)xb_add(&bar[XB_XCNT(b.x)], 1u);
    return b;
}
__device__ __forceinline__ void xcd_barrier_complete(unsigned* bar, unsigned x, unsigned& nloc, unsigned& nx) {
    const unsigned G = gridDim.x * gridDim.y * gridDim.z;
    unsigned sum, cnt, mine, sp = 0u;
    for (;;) {
        sum = 0u; cnt = 0u; mine = 0u;
#pragma unroll
        for (unsigned j = 0; j < 16; ++j) { const unsigned c = xb_ld(&bar[XB_XCNT(j)]); sum += c; cnt += (c > 0u) ? 1u : 0u; mine = (j == x) ? c : mine; }
        if (sum == G) break;
        __builtin_amdgcn_s_sleep(1);
        if ((++sp & 255u) == 0u) { if (xb_ld(&bar[XB_TMO])) break; if (sp > XB_SPIN_CAP) { atomicAdd(&bar[XB_TMO], 1u); break; } }
    }
    nloc = mine > 0u ? mine : 1u; nx = cnt > 0u ? cnt : 1u;
}
__device__ __forceinline__ void xcd_barrier(const XcdBarrier& b) {
    asm volatile("s_waitcnt vmcnt(0)" ::: "memory");
    __syncthreads();
    if (threadIdx.x == 0) {
        unsigned* bar = b.bar;
        __builtin_amdgcn_s_waitcnt(0);
        unsigned nloc = b.st[0], nx = b.st[1];
        if (nloc == 0u) { xcd_barrier_complete(bar, b.x, nloc, nx); b.st[0] = nloc; b.st[1] = nx; }
        const unsigned old = xb_add(&bar[XB_XSUB(b.x)], 1u);
        const unsigned gen = old / nloc;
        if (old + 1u == (gen + 1u) * nloc) {
            __builtin_amdgcn_fence(__ATOMIC_RELEASE, "agent");
            asm volatile("s_waitcnt vmcnt(0)" ::: "memory");
            const unsigned og = xb_add(&bar[XB_TOP], 1u);
            const unsigned tg = og / nx;
            if (og + 1u == (tg + 1u) * nx) xb_add(&bar[XB_TOPGEN], 1u);
            else XB_SPIN(xb_ld(&bar[XB_TOPGEN]) == tg, bar);
            __builtin_amdgcn_fence(__ATOMIC_ACQUIRE, "agent");
            xb_add(&bar[XB_XGEN(b.x)], 1u);
            asm volatile("s_waitcnt vmcnt(0)" ::: "memory");
        } else {
            XB_SPIN(xb_ld(&bar[XB_XGEN(b.x)]) == gen, bar);
            __builtin_amdgcn_fence(__ATOMIC_ACQUIRE, "agent");
            asm volatile("s_waitcnt vmcnt(0)" ::: "memory");
        }
    }
    __syncthreads();
}

typedef unsigned short bf16;
typedef float f32x4 __attribute__((ext_vector_type(4)));
typedef float f32x16 __attribute__((ext_vector_type(16)));
typedef unsigned u32x4 __attribute__((ext_vector_type(4)));
typedef unsigned u32x2 __attribute__((ext_vector_type(2)));
typedef short bf16x8 __attribute__((ext_vector_type(8)));
typedef __bf16 bf2_t __attribute__((ext_vector_type(2)));

constexpr int NTHREADS = 512, NWAVES = 8;
constexpr int LDS_BYTES = 160 * 1024;
constexpr int MISC_OFF = LDS_BYTES - 256;
constexpr int TOK = 32768, SEQ = 16384, DM = 2048;
constexpr int EV_N = 4800, EV_NP = 4864, OD_N = 4176, OD_NP = 4352;
constexpr float ALPHA = 1.41421356237f;
constexpr size_t MiB = 1u << 20;
constexpr size_t WS_CTL = 0, CTL_ZERO_BYTES = 1 * MiB;
constexpr int CW_BAR = 4096;
constexpr size_t WS_MOD = 1 * MiB, WS_SKB = 2 * MiB, WS_WL = 4 * MiB, WS_BS = 7 * MiB, WS_CNT = 9 * MiB;
constexpr size_t WS_WINE = 10 * MiB, WS_WOUTE = 29 * MiB, WS_WINO = 37 * MiB, WS_WOUTO = 54 * MiB, WS_WQ0 = 62 * MiB, WS_WQ1 = 70 * MiB;
constexpr size_t WS_HY = 78 * MiB, WS_Z = 206 * MiB, WS_LA = 510 * MiB, WS_BIG = 542 * MiB, WS_END = 926 * MiB;

__device__ __forceinline__ float bf2f(unsigned short b) { return __uint_as_float(((unsigned)b) << 16); }
__device__ __forceinline__ unsigned f2bf(float f) { unsigned u = __float_as_uint(f); return (u + 0x7fffu + ((u >> 16) & 1u)) >> 16; }
__device__ __forceinline__ unsigned pk2(float lo, float hi) { return f2bf(lo) | (f2bf(hi) << 16); }
__device__ __forceinline__ float lo2f(unsigned w) { return __uint_as_float(w << 16); }
__device__ __forceinline__ float hi2f(unsigned w) { return __uint_as_float(w & 0xffff0000u); }
__device__ __forceinline__ float wsum(float v) {
#pragma unroll
    for (int o = 32; o >= 1; o >>= 1) v += __shfl_xor(v, o);
    return v;
}
__device__ __forceinline__ float wmax(float v) {
#pragma unroll
    for (int o = 32; o >= 1; o >>= 1) v = fmaxf(v, __shfl_xor(v, o));
    return v;
}
__device__ __forceinline__ float rdlane(float v, int l) { return __int_as_float(__builtin_amdgcn_readlane(__float_as_int(v), l)); }
__device__ __forceinline__ unsigned rdlaneu(unsigned v, int l) { return (unsigned)__builtin_amdgcn_readlane((int)v, l); }
__device__ __forceinline__ float dot2bf(unsigned a, unsigned b, float c) {
    return __builtin_amdgcn_fdot2_f32_bf16(__builtin_bit_cast(bf2_t, a), __builtin_bit_cast(bf2_t, b), c, false);
}
template <int CTRL, int RM> __device__ __forceinline__ float dppf(float v) {
    return __int_as_float(__builtin_amdgcn_update_dpp(0, __float_as_int(v), CTRL, RM, 0xF, false));
}
__device__ __forceinline__ float wsum_dpp(float v) {
    v += dppf<0xB1, 0xF>(v);
    v += dppf<0x4E, 0xF>(v);
    v += dppf<0x141, 0xF>(v);
    v += dppf<0x140, 0xF>(v);
    v += dppf<0x142, 0xA>(v);
    v += dppf<0x143, 0xC>(v);
    return rdlane(v, 63);
}
__device__ __forceinline__ float sigmoidf_(float x) { return 1.0f / (1.0f + expf(-x)); }
__device__ __forceinline__ unsigned ordkey(float f) { const unsigned u = __float_as_uint(f); return (u & 0x80000000u) ? ~u : (u | 0x80000000u); }
__device__ __forceinline__ float unordkey(unsigned k) { return __uint_as_float((k & 0x80000000u) ? (k & 0x7fffffffu) : ~k); }

struct Args { const void* in[27]; float* out; unsigned char* ws; int ph_lo, ph_hi; };
struct Frame { LAS unsigned char* lds; int tid, lane, wave, bx, G, gw, ngw; };

struct EpiLora {
    static constexpr bool PERM = true, AFTER_DRAIN = false;
    pg8::bf16_t* O; int ldc; const float* w0; const float* a0;
    __device__ __forceinline__ void operator()(const pg8::f32x4 (&acc)[2][2][4][2], const pg8::Unit& u, int wr, int wc, int fr, int fq) const {
        const int row0 = u.pm * 256 + wr * 64 + fr; const int colt = u.pn * 256; const int type = u.pn >> 2;
        const int col0 = colt + wc * 32 + 8 * fq, ncol0 = col0 & 1023;
        const float* pv = (type == 0) ? w0 : a0;
        pg8::f32x4 bv[2][2];
#pragma unroll
        for (int bj = 0; bj < 2; ++bj)
#pragma unroll
            for (int n = 0; n < 2; ++n) bv[bj][n] = (type < 2) ? *(const pg8::f32x4*)(pv + ncol0 + bj * 128 + 4 * n) : (pg8::f32x4){0.f, 0.f, 0.f, 0.f};
#pragma unroll
        for (int ai = 0; ai < 2; ++ai)
#pragma unroll
            for (int m = 0; m < 4; ++m) { pg8::bf16_t* rowp = O + (size_t)(row0 + ai * 128 + m * 16) * ldc + col0;
#pragma unroll
                for (int bj = 0; bj < 2; ++bj) { pg8::f32x4 v0 = acc[ai][bj][m][0] + bv[bj][0], v1 = acc[ai][bj][m][1] + bv[bj][1];
                    if (type < 2) {
                        const float sc = (type == 0) ? 0.60653066f : 1.0f;
#pragma unroll
                        for (int j = 0; j < 4; ++j) { v0[j] = sc / (1.0f + __expf(-v0[j])); v1[j] = sc / (1.0f + __expf(-v1[j])); }
                    }
                    pg8::u32x4 w; w.x = pg8::cvt_pk_bf16(v0[0], v0[1]); w.y = pg8::cvt_pk_bf16(v0[2], v0[3]); w.z = pg8::cvt_pk_bf16(v1[0], v1[1]); w.w = pg8::cvt_pk_bf16(v1[2], v1[3]);
                    *(pg8::u32x4*)(rowp + bj * 128) = w; } }
    }
};

__device__ __forceinline__ void transpose_item(const float* W, int K, int N, int Npad, bf16* WT, LAS float* scr, int item, int lane) {
    const int nblk = Npad / 32, kb = item / nblk, nb = item % nblk, k0 = 64 * kb, n0 = 32 * nb;
    const int nl = lane & 31; const bool ok = (n0 + nl) < N;
#pragma unroll 8
    for (int i = 0; i < 32; ++i) { const int kk = 2 * i + (lane >> 5); scr[kk * 33 + nl] = ok ? W[(size_t)(k0 + kk) * N + n0 + nl] : 0.f; }
    asm volatile("s_waitcnt lgkmcnt(0)" ::: "memory");
    const int c = lane & 7;
#pragma unroll
    for (int j = 0; j < 4; ++j) { const int n = (lane >> 3) + 8 * j; const LAS float* s = scr + (8 * c) * 33 + n;
        u32x4 o; o.x = pk2(s[0 * 33], s[1 * 33]); o.y = pk2(s[2 * 33], s[3 * 33]); o.z = pk2(s[4 * 33], s[5 * 33]); o.w = pk2(s[6 * 33], s[7 * 33]);
        *(u32x4*)(WT + (size_t)(n0 + n) * K + k0 + 8 * c) = o; }
    asm volatile("s_waitcnt lgkmcnt(0)" ::: "memory");
}

__device__ __forceinline__ void ph_prologue(const Args& A, Frame& F) {
    unsigned char* ws = A.ws;
    {
        const float* c = (const float*)A.in[1]; const float* mw = (const float*)A.in[19]; const float* mb = (const float*)A.in[20];
        float* MOD = (float*)(ws + WS_MOD);
        LAS float* red = (LAS float*)F.lds;
        for (int it = F.bx; it < 96; it += F.G) {
            const int s = it / 24, cc = it % 24, col = cc * 256 + F.lane * 4;
            const float* W = mw + (size_t)s * 2048 * 6144 + col;
            f32x4 a0 = {0.f, 0.f, 0.f, 0.f}, a1 = {0.f, 0.f, 0.f, 0.f};
            const int k0 = F.wave * 256;
#pragma unroll 8
            for (int k = k0; k < k0 + 256; ++k) {
                float c0 = c[k], c1 = c[2048 + k];
                c0 = c0 / (1.0f + expf(-c0)); c1 = c1 / (1.0f + expf(-c1));
                const f32x4 w = *(const f32x4*)(W + (size_t)k * 6144);
                a0 += c0 * w; a1 += c1 * w;
            }
            *(LAS f32x4*)(red + ((F.wave * 2 + 0) * 256 + F.lane * 4)) = a0;
            *(LAS f32x4*)(red + ((F.wave * 2 + 1) * 256 + F.lane * 4)) = a1;
            __syncthreads();
            { const int b = F.tid >> 8, cl = F.tid & 255; float sm = 0.f;
#pragma unroll
              for (int w = 0; w < 8; ++w) sm += red[(w * 2 + b) * 256 + cl];
              MOD[(size_t)(s * 2 + b) * 6144 + cc * 256 + cl] = sm + mb[s * 6144 + cc * 256 + cl]; }
            __syncthreads();
        }
    }
    {
        LAS float* scr = (LAS float*)(F.lds + 16384 + F.wave * 8704);
        constexpr int I0 = 32 * (EV_NP / 32), I1 = 32 * 64, I2 = 32 * (OD_NP / 32);
        constexpr int NIT = I0 + I1 + I2 + 3 * I1;
        for (int it = F.gw; it < NIT; it += F.ngw) {
            int r = it;
            if (r < I0) { transpose_item((const float*)A.in[3], 2048, EV_N, EV_NP, (bf16*)(ws + WS_WINE), scr, r, F.lane); continue; } r -= I0;
            if (r < I1) { transpose_item((const float*)A.in[4], 2048, 2048, 2048, (bf16*)(ws + WS_WOUTE), scr, r, F.lane); continue; } r -= I1;
            if (r < I2) { transpose_item((const float*)A.in[17], 2048, OD_N, OD_NP, (bf16*)(ws + WS_WINO), scr, r, F.lane); continue; } r -= I2;
            if (r < I1) { transpose_item((const float*)A.in[18], 2048, 2048, 2048, (bf16*)(ws + WS_WOUTO), scr, r, F.lane); continue; } r -= I1;
            if (r < I1) { transpose_item((const float*)A.in[23], 2048, 2048, 2048, (bf16*)(ws + WS_WQ0), scr, r, F.lane); continue; } r -= I1;
            transpose_item((const float*)A.in[23] + (size_t)2048 * 2048, 2048, 2048, 2048, (bf16*)(ws + WS_WQ1), scr, r, F.lane);
        }
    }
    {
        const float* w2 = (const float*)A.in[8]; const float* a2 = (const float*)A.in[10]; const float* g2 = (const float*)A.in[11];
        bf16* WL = (bf16*)(ws + WS_WL);
        const int gt = F.bx * NTHREADS + F.tid, ngt = F.G * NTHREADS;
        for (int i = gt; i < 3072 * 512; i += ngt) {
            const int n = i >> 9, k = i & 511; float v = 0.f;
            if (n < 1024) { if (k < 96) v = w2[k * 1024 + n]; }
            else if (n < 2048) { if (k >= 96 && k < 192) v = a2[(k - 96) * 1024 + (n - 1024)]; }
            else { if (k >= 192 && k < 448) v = g2[(k - 192) * 1024 + (n - 2048)]; }
            WL[i] = (bf16)f2bf(v);
        }
        const float* sk = (const float*)A.in[24]; bf16* SKB = (bf16*)(ws + WS_SKB);
        for (int i = gt; i < 2 * 262144; i += ngt) SKB[i] = (bf16)f2bf(sk[i]);
    }
}

__device__ __forceinline__ void ph_mod_x(const Args& A, Frame& F) {
    const float* x = (const float*)A.in[0]; const float* MOD = (const float*)(A.ws + WS_MOD); bf16* H = (bf16*)(A.ws + WS_HY);
    for (int t = F.gw; t < TOK; t += F.ngw) {
        const int b = t >> 14; const float* sh = MOD + (size_t)(0 * 2 + b) * 6144; const float* sc = sh + 2048;
#pragma unroll
        for (int j = 0; j < 8; ++j) { const int idx = j * 256 + F.lane * 4;
            const f32x4 xv = *(const f32x4*)(x + (size_t)t * DM + idx), sv = *(const f32x4*)(sc + idx), hv = *(const f32x4*)(sh + idx);
            const f32x4 o = xv * (1.0f + sv) + hv; u32x2 w; w.x = pk2(o[0], o[1]); w.y = pk2(o[2], o[3]);
            *(u32x2*)(H + (size_t)t * DM + idx) = w; }
    }
}

__device__ __forceinline__ void ph_even_post(const Args& A, Frame& F) {
    bf16* Z = (bf16*)(A.ws + WS_Z); const int* positions = (const int*)A.in[2]; const float* mu = (const float*)A.in[6];
    bf16* RKV = (bf16*)A.out; bf16* LAp = (bf16*)(A.ws + WS_LA);
    const int i = F.lane & 31; const float inv = powf(10000.0f, -(float)i / 32.0f);
    for (int t = F.gw; t < TOK; t += F.ngw) {
        const int s = t & (SEQ - 1); bf16* zr = Z + (size_t)t * EV_NP;
        float sn, cs; sincosf((float)positions[t] * inv, &sn, &cs);
#pragma unroll
        for (int it = 0; it < 9; ++it) { const int base = (2 * it + (F.lane >> 5)) * 64;
            const float t1 = bf2f(zr[base + i]), t2 = bf2f(zr[base + 32 + i]);
            zr[base + i] = (bf16)f2bf(t1 * cs - t2 * sn); zr[base + 32 + i] = (bf16)f2bf(t2 * cs + t1 * sn); }
        const bf16* zp = zr - EV_NP; const bool hasprev = s > 0;
        for (int m = 0; m < 28; ++m) { const int j = 2 * F.lane + 128 * m; if (j < 3520) {
            const unsigned cw = *(const unsigned*)(zr + 1280 + j); const unsigned pw = hasprev ? *(const unsigned*)(zp + 1280 + j) : 0u;
            const float m0 = mu[j], m1 = mu[j + 1];
            const float c0 = lo2f(cw), c1 = hi2f(cw), p0 = lo2f(pw), p1 = hi2f(pw);
            const float v0 = c0 + (p0 - c0) * m0, v1 = c1 + (p1 - c1) * m1;
            if (j < 3072) { const int which = j >> 10, jj = j & 1023; *(unsigned*)(RKV + (size_t)which * TOK * 1024 + (size_t)t * 1024 + jj) = pk2(v0, v1); }
            else if (j < 3168) { *(unsigned*)(LAp + (size_t)t * 512 + (j - 3072)) = pk2(tanhf(v0), tanhf(v1)); }
            else if (j < 3264) { *(unsigned*)(LAp + (size_t)t * 512 + 96 + (j - 3168)) = pk2(v0, v1); }
            else { *(unsigned*)(LAp + (size_t)t * 512 + 192 + (j - 3264)) = pk2(sigmoidf_(v0), sigmoidf_(v1)); }
        } }
        if (F.lane < 32) *(unsigned*)(LAp + (size_t)t * 512 + 448 + 2 * F.lane) = 0u;
    }
}

__device__ __forceinline__ void ph_scan_pack(const Args& A, Frame& F) {
    const bf16* Z = (const bf16*)(A.ws + WS_Z); const bf16* RKV = (const bf16*)A.out;
    const float* k_k = (const float*)A.in[12]; const float* k_a = (const float*)A.in[13]; const float* r_k = (const float*)A.in[14];
    unsigned* PK = (unsigned*)(A.ws + WS_BIG); float* BS = (float*)(A.ws + WS_BS);
    for (int it = F.gw; it < TOK * 16; it += F.ngw) {
        const int t = it >> 4, h = it & 15, c = h * 64 + F.lane, b = t >> 14, s = t & (SEQ - 1);
        const float r = bf2f(RKV[(size_t)t * 1024 + c]), kr = bf2f(RKV[(size_t)TOK * 1024 + (size_t)t * 1024 + c]), v = bf2f(RKV[(size_t)2 * TOK * 1024 + (size_t)t * 1024 + c]);
        const float e = bf2f(Z[(size_t)t * EV_NP + 1280 + c]), a = bf2f(Z[(size_t)t * EV_NP + 1280 + 1024 + c]);
        const float kkv = kr * k_k[c]; const float ss = wsum(kkv * kkv); const float kkn = kkv / fmaxf(sqrtf(ss), 1e-12f);
        const float kp = kr * (1.0f + (a - 1.0f) * k_a[c]); const float kka = kkn * a;
        const float bsum = wsum(r * kp * r_k[c]);
        if (F.lane == 0) BS[(size_t)t * 16 + h] = bsum;
        unsigned* dst = PK + ((size_t)((b * 16 + h) * SEQ + s) * 64 + F.lane) * 3;
        dst[0] = pk2(r, e); dst[1] = pk2(kp, kkn); dst[2] = pk2(kka, v);
    }
}

__device__ __forceinline__ void ph_swa(const Args& A, Frame& F) {
    const bf16* Z = (const bf16*)(A.ws + WS_Z); bf16* Y = (bf16*)(A.ws + WS_HY); const float* sinks = (const float*)A.in[5];
    LAS unsigned char* KL = F.lds; LAS unsigned char* VL = F.lds + 256 * 136;
    for (int u = F.bx; u < 512; u += F.G) {
        const int b = u >> 8, n = (u >> 1) & 127, kvh = u & 1;
        __syncthreads();
        for (int c = F.tid; c < 2048; c += NTHREADS) { const int jw = c >> 3, cc = c & 7; const int s = n * 128 - 128 + jw;
            u32x4 kv = {0u, 0u, 0u, 0u}, vv = {0u, 0u, 0u, 0u};
            if (s >= 0) { const bf16* row = Z + (size_t)(b * SEQ + s) * EV_NP; kv = *(const u32x4*)(row + 1024 + kvh * 64 + cc * 8); vv = *(const u32x4*)(row + 1152 + kvh * 64 + cc * 8); }
            *(LAS u32x2*)(KL + jw * 136 + cc * 16) = (u32x2){kv.x, kv.y}; *(LAS u32x2*)(KL + jw * 136 + cc * 16 + 8) = (u32x2){kv.z, kv.w};
            *(LAS u32x2*)(VL + jw * 136 + cc * 16) = (u32x2){vv.x, vv.y}; *(LAS u32x2*)(VL + jw * 136 + cc * 16 + 8) = (u32x2){vv.z, vv.w}; }
        __syncthreads();
        for (int it = F.wave; it < 1024; it += NWAVES) {
            const int i = it >> 3, g = it & 7, head = kvh * 8 + g; const int t = b * SEQ + n * 128 + i;
            const float qv = bf2f(Z[(size_t)t * EV_NP + head * 64 + F.lane]) * 0.125f;
            const int jw0 = i + 1 + F.lane, jw1 = jw0 + 64;
            const bool val0 = (n > 0) || (jw0 >= 128), val1 = (n > 0) || (jw1 >= 128);
            float s0 = 0.f, s1 = 0.f;
#pragma unroll
            for (int d4 = 0; d4 < 16; ++d4) {
                const u32x2 k0 = *(const LAS u32x2*)(KL + jw0 * 136 + d4 * 8), k1 = *(const LAS u32x2*)(KL + jw1 * 136 + d4 * 8);
                const float q0 = rdlane(qv, 4 * d4), q1 = rdlane(qv, 4 * d4 + 1), q2 = rdlane(qv, 4 * d4 + 2), q3 = rdlane(qv, 4 * d4 + 3);
                s0 += q0 * lo2f(k0.x) + q1 * hi2f(k0.x) + q2 * lo2f(k0.y) + q3 * hi2f(k0.y);
                s1 += q0 * lo2f(k1.x) + q1 * hi2f(k1.x) + q2 * lo2f(k1.y) + q3 * hi2f(k1.y);
            }
            const float sink = sinks[head];
            s0 = val0 ? s0 : -INFINITY; s1 = val1 ? s1 : -INFINITY;
            const float mx = fmaxf(wmax(fmaxf(s0, s1)), sink);
            float p0 = val0 ? expf(s0 - mx) : 0.f, p1 = val1 ? expf(s1 - mx) : 0.f;
            const float den = wsum(p0 + p1) + expf(sink - mx); const float rden = 1.0f / den;
            p0 *= rden; p1 *= rden;
            float o = 0.f;
            const LAS bf16* vcol = (const LAS bf16*)VL + F.lane;
#pragma unroll 8
            for (int jj = 0; jj < 64; ++jj) o += rdlane(p0, jj) * bf2f(vcol[(i + 1 + jj) * 68]);
#pragma unroll 8
            for (int jj = 0; jj < 64; ++jj) o += rdlane(p1, jj) * bf2f(vcol[(i + 65 + jj) * 68]);
            Y[(size_t)t * DM + head * 64 + F.lane] = (bf16)f2bf(o);
        }
    }
}

__device__ __forceinline__ void ph_scan(const Args& A, Frame& F) {
    const unsigned* PK = (const unsigned*)(A.ws + WS_BIG); bf16* YRAW = (bf16*)A.out + (size_t)3 * TOK * 1024;
    for (int rr = F.gw; rr < 2048; rr += F.ngw) {
        const int bh = rr >> 6, vrow = rr & 63;
        const unsigned* pk = PK + ((size_t)bh * SEQ * 64 + F.lane) * 3;
        bf16* yout = YRAW + ((size_t)bh * 64 + vrow) * SEQ;
        float S = 0.f;
        for (int t0 = 0; t0 < SEQ; t0 += 64) {
            float yk = 0.f;
#pragma unroll 8
            for (int j = 0; j < 64; ++j) {
                const unsigned* p = pk + (size_t)(t0 + j) * 192;
                const unsigned w0 = p[0], w1 = p[1], w2 = p[2];
                const float r = lo2f(w0), e = hi2f(w0), kp = lo2f(w1), kk = hi2f(w1), kka = lo2f(w2), vv = hi2f(w2);
                const float vs = rdlane(vv, vrow);
                const float dec = __expf(-e);
                const float sa = -wsum_dpp(S * kk);
                S = S * dec + sa * kka + vs * kp;
                const float y = wsum_dpp(S * r);
                yk = (F.lane == j) ? y : yk;
            }
            yout[t0 + F.lane] = (bf16)f2bf(yk);
        }
    }
}

__device__ __forceinline__ void ph_rwkv_finish(const Args& A, Frame& F) {
    const bf16* Z = (const bf16*)(A.ws + WS_Z); const bf16* RKV = (const bf16*)A.out; const bf16* YRAW = (const bf16*)A.out + (size_t)3 * TOK * 1024;
    const float* BS = (const float*)(A.ws + WS_BS); bf16* Y = (bf16*)(A.ws + WS_HY);
    const float* lnx_g = (const float*)A.in[15]; const float* lnx_b = (const float*)A.in[16];
    LAS float* tile = (LAS float*)(F.lds + F.wave * 16640);
    for (int it = F.gw; it < 8192; it += F.ngw) {
        const int bh = it >> 8, tb = it & 255, b = bh >> 4, h = bh & 15, t0 = tb * 64;
        for (int vr = 0; vr < 64; ++vr) tile[vr * 65 + F.lane] = bf2f(YRAW[((size_t)bh * 64 + vr) * SEQ + t0 + F.lane]);
        asm volatile("s_waitcnt lgkmcnt(0)" ::: "memory");
        const int c = h * 64 + F.lane; const float lg = lnx_g[c], lb = lnx_b[c];
        for (int j = 0; j < 64; ++j) {
            const int t = b * SEQ + t0 + j;
            const float y = tile[F.lane * 65 + j];
            const float mean = wsum(y) * (1.0f / 64.0f); const float d = y - mean; const float var = wsum(d * d) * (1.0f / 64.0f);
            const float yn = d * rsqrtf(var + 64e-5f) * lg + lb;
            const float vv = bf2f(RKV[(size_t)2 * TOK * 1024 + (size_t)t * 1024 + c]); const float g = bf2f(Z[(size_t)t * EV_NP + 1280 + 2048 + c]); const float bs = BS[(size_t)t * 16 + h];
            Y[(size_t)t * DM + 1024 + c] = (bf16)f2bf((yn + bs * vv) * g);
        }
        asm volatile("s_waitcnt lgkmcnt(0)" ::: "memory");
    }
}

__device__ __forceinline__ void ph_ln_mixer(const Args& A, Frame& F, const int L) {
    const float* xsrc = (L == 0) ? (const float*)A.in[0] : (const float*)A.out; float* xdst = A.out;
    const bf16* O = (const bf16*)(A.ws + WS_Z); bf16* H = (bf16*)(A.ws + WS_HY); const float* MOD = (const float*)(A.ws + WS_MOD);
    const float* lng = (const float*)A.in[21] + (size_t)(L * 2 + 0) * DM; const float* lnb = (const float*)A.in[22] + (size_t)(L * 2 + 0) * DM;
    for (int t = F.gw; t < TOK; t += F.ngw) {
        const int b = t >> 14;
        const float* gate = MOD + (size_t)((L * 2 + 0) * 2 + b) * 6144 + 4096;
        const float* sh = MOD + (size_t)((L * 2 + 1) * 2 + b) * 6144; const float* sc = sh + 2048;
        float v[32]; float sum = 0.f;
#pragma unroll
        for (int j = 0; j < 4; ++j) { const int base = (j * 64 + F.lane) * 8;
            const u32x4 ow = *(const u32x4*)(O + (size_t)t * DM + base);
            const f32x4 x0 = *(const f32x4*)(xsrc + (size_t)t * DM + base), x1 = *(const f32x4*)(xsrc + (size_t)t * DM + base + 4);
            const f32x4 g0 = *(const f32x4*)(gate + base), g1 = *(const f32x4*)(gate + base + 4);
            const float of[8] = {lo2f(ow.x), hi2f(ow.x), lo2f(ow.y), hi2f(ow.y), lo2f(ow.z), hi2f(ow.z), lo2f(ow.w), hi2f(ow.w)};
#pragma unroll
            for (int e = 0; e < 4; ++e) { v[j * 8 + e] = ALPHA * x0[e] + (1.0f + g0[e]) * of[e]; v[j * 8 + 4 + e] = ALPHA * x1[e] + (1.0f + g1[e]) * of[4 + e]; }
#pragma unroll
            for (int e = 0; e < 8; ++e) sum += v[j * 8 + e]; }
        const float mean = wsum(sum) * (1.0f / DM); float sq = 0.f;
#pragma unroll
        for (int e = 0; e < 32; ++e) { v[e] -= mean; sq += v[e] * v[e]; }
        const float rstd = rsqrtf(wsum(sq) * (1.0f / DM) + 1e-5f);
#pragma unroll
        for (int j = 0; j < 4; ++j) { const int base = (j * 64 + F.lane) * 8;
            const f32x4 lg0 = *(const f32x4*)(lng + base), lg1 = *(const f32x4*)(lng + base + 4), lb0 = *(const f32x4*)(lnb + base), lb1 = *(const f32x4*)(lnb + base + 4);
            const f32x4 s0 = *(const f32x4*)(sc + base), s1 = *(const f32x4*)(sc + base + 4), h0 = *(const f32x4*)(sh + base), h1 = *(const f32x4*)(sh + base + 4);
            f32x4 o0, o1;
#pragma unroll
            for (int e = 0; e < 4; ++e) { o0[e] = v[j * 8 + e] * rstd * lg0[e] + lb0[e]; o1[e] = v[j * 8 + 4 + e] * rstd * lg1[e] + lb1[e]; }
            *(f32x4*)(xdst + (size_t)t * DM + base) = o0; *(f32x4*)(xdst + (size_t)t * DM + base + 4) = o1;
            const f32x4 q0 = o0 * (1.0f + s0) + h0, q1 = o1 * (1.0f + s1) + h1;
            u32x4 w; w.x = pk2(q0[0], q0[1]); w.y = pk2(q0[2], q0[3]); w.z = pk2(q1[0], q1[1]); w.w = pk2(q1[2], q1[3]);
            *(u32x4*)(H + (size_t)t * DM + base) = w; }
    }
    {
        const float* pu = (const float*)A.in[25] + (size_t)L * 16384 * 2048; const float* pv = (const float*)A.in[26] + (size_t)L * 16384 * 2048;
        unsigned char* T8 = A.ws + WS_BIG; float* SCL = (float*)(A.ws + WS_BIG + 64 * MiB);
        for (int r = F.gw; r < 32768; r += F.ngw) {
            const float* src = ((r < 16384) ? pu : pv) + (size_t)(r & 16383) * 2048;
            f32x4 f[2][4]; float amax = 0.f;
#pragma unroll
            for (int j = 0; j < 2; ++j)
#pragma unroll
                for (int c = 0; c < 4; ++c) { f[j][c] = *(const f32x4*)(src + (j * 64 + F.lane) * 16 + 4 * c);
                    amax = fmaxf(amax, fmaxf(fmaxf(fabsf(f[j][c][0]), fabsf(f[j][c][1])), fmaxf(fabsf(f[j][c][2]), fabsf(f[j][c][3])))); }
            amax = wmax(amax);
            int k = 0; if (amax > 0.f) { k = ilogbf(224.0f / amax); k = k < -100 ? -100 : (k > 100 ? 100 : k); }
            const float scl = ldexpf(1.0f, k);
#pragma unroll
            for (int j = 0; j < 2; ++j) { u32x4 w; unsigned ww[4];
#pragma unroll
                for (int c = 0; c < 4; ++c) { int q = __builtin_amdgcn_cvt_pk_fp8_f32(f[j][c][0] * scl, f[j][c][1] * scl, 0, false); q = __builtin_amdgcn_cvt_pk_fp8_f32(f[j][c][2] * scl, f[j][c][3] * scl, q, true); ww[c] = (unsigned)q; }
                w.x = ww[0]; w.y = ww[1]; w.z = ww[2]; w.w = ww[3];
                *(u32x4*)(T8 + (size_t)r * 2048 + (j * 64 + F.lane) * 16) = w; }
            if (F.lane == 0) SCL[r] = ldexpf(1.0f, -k);
        }
    }
}

template <int NV> __device__ __forceinline__ unsigned wave_tau16(const unsigned (&key)[NV]) {
    unsigned tau = 0u;
#pragma unroll 1
    for (int bit = 31; bit >= 0; --bit) {
        const unsigned cand = tau | (1u << bit); int cnt = 0;
#pragma unroll
        for (int v = 0; v < NV; ++v) cnt += __popcll(__ballot(key[v] >= cand));
        if (cnt >= 16) tau = cand;
    }
    return tau;
}
template <int NV> __device__ __forceinline__ void wave_compact16(const unsigned (&key)[NV], const int (&id)[NV], unsigned tau, LAS float* ov, LAS int* oi, int lane) {
    int ngt = 0;
#pragma unroll
    for (int v = 0; v < NV; ++v) ngt += __popcll(__ballot(key[v] > tau));
    int bg = 0, be = 0;
#pragma unroll
    for (int v = 0; v < NV; ++v) {
        const bool gt = key[v] > tau, eq = key[v] == tau;
        const unsigned long long mg = __ballot(gt), me = __ballot(eq);
        const unsigned long long below = (lane == 0) ? 0ull : ((~0ull) >> (64 - lane));
        const int pg = bg + __popcll(mg & below), pe = ngt + be + __popcll(me & below);
        if (gt) { ov[pg] = unordkey(key[v]); oi[pg] = id[v]; }
        if (eq && pe < 16) { ov[pe] = unordkey(key[v]); oi[pe] = id[v]; }
        bg += __popcll(mg); be += __popcll(me);
    }
}

__device__ __forceinline__ void ph_peer_select(const Args& A, Frame& F, const int L) {
    const bf16* QP = (const bf16*)(A.ws + WS_Z); const bf16* SKB = (const bf16*)(A.ws + WS_SKB) + (size_t)L * 262144;
    int* EID = (int*)(A.ws + WS_LA); float* GSM = (float*)(A.ws + WS_LA + 16 * MiB);
    LAS unsigned char* SKL = F.lds;
    LAS float* tv = (LAS float*)(F.lds + 69632 + F.wave * 512);
    LAS int* ti = (LAS int*)(F.lds + 69632 + F.wave * 512 + 128);
    LAS float* cv = (LAS float*)(F.lds + 69632 + F.wave * 512 + 256);
    LAS int* ci = (LAS int*)(F.lds + 69632 + F.wave * 512 + 320);
    for (int it = F.bx; it < 4096; it += F.G) {
        const int tile = it >> 3, h = it & 7;
        __syncthreads();
        for (int c = F.tid; c < 4096; c += NTHREADS) { const int p = c >> 11, n = (c >> 4) & 127, cc = c & 15;
            *(LAS u32x4*)(SKL + (p * 128 + n) * 272 + cc * 16) = *(const u32x4*)(SKB + ((size_t)((p * 8 + h) * 128 + n)) * 128 + cc * 8); }
        __syncthreads();
        for (int tk = 0; tk < 8; ++tk) {
            const int t = tile * 64 + F.wave * 8 + tk;
#pragma unroll
            for (int p = 0; p < 2; ++p) {
                const unsigned qv = *(const unsigned*)(QP + (size_t)t * DM + h * 256 + p * 128 + 2 * F.lane);
                float s0 = 0.f, s1 = 0.f;
                const LAS unsigned char* r0 = SKL + (p * 128 + F.lane) * 272; const LAS unsigned char* r1 = r0 + 64 * 272;
#pragma unroll
                for (int c16 = 0; c16 < 16; ++c16) {
                    const u32x4 k0 = *(const LAS u32x4*)(r0 + c16 * 16), k1 = *(const LAS u32x4*)(r1 + c16 * 16);
                    const unsigned q0 = rdlaneu(qv, c16 * 4), q1 = rdlaneu(qv, c16 * 4 + 1), q2 = rdlaneu(qv, c16 * 4 + 2), q3 = rdlaneu(qv, c16 * 4 + 3);
                    s0 = dot2bf(q0, k0.x, s0); s0 = dot2bf(q1, k0.y, s0); s0 = dot2bf(q2, k0.z, s0); s0 = dot2bf(q3, k0.w, s0);
                    s1 = dot2bf(q0, k1.x, s1); s1 = dot2bf(q1, k1.y, s1); s1 = dot2bf(q2, k1.z, s1); s1 = dot2bf(q3, k1.w, s1);
                }
                const unsigned key[2] = {ordkey(s0), ordkey(s1)}; const int id[2] = {F.lane, F.lane + 64};
                const unsigned tau = wave_tau16<2>(key);
                wave_compact16<2>(key, id, tau, tv + p * 16, ti + p * 16, F.lane);
            }
            asm volatile("s_waitcnt lgkmcnt(0)" ::: "memory"); __builtin_amdgcn_wave_barrier();
            unsigned ck[4]; int cid[4];
#pragma unroll
            for (int m = 0; m < 4; ++m) { const int c = F.lane * 4 + m; cid[m] = c; ck[m] = ordkey(tv[c >> 4] + tv[16 + (c & 15)]); }
            const unsigned tau2 = wave_tau16<4>(ck);
            wave_compact16<4>(ck, cid, tau2, cv, ci, F.lane);
            asm volatile("s_waitcnt lgkmcnt(0)" ::: "memory"); __builtin_amdgcn_wave_barrier();
            const float bv = (F.lane < 16) ? cv[F.lane] : -INFINITY; const int bc = (F.lane < 16) ? ci[F.lane] : 0;
            const float mx = wmax(bv); const float ev = (F.lane < 16) ? expf(bv - mx) : 0.f; const float den = wsum(ev);
            if (F.lane < 16) { const int e1 = ti[bc >> 4], e2 = ti[16 + (bc & 15)];
                EID[(size_t)t * 128 + h * 16 + F.lane] = e1 * 128 + e2; GSM[(size_t)t * 128 + h * 16 + F.lane] = ev / den; }
            asm volatile("s_waitcnt lgkmcnt(0)" ::: "memory"); __builtin_amdgcn_wave_barrier();
        }
    }
}

typedef float f32x2 __attribute__((ext_vector_type(2)));
constexpr int PGB = 4;
__device__ __forceinline__ void ph_peer_gather(const Args& A, Frame& F, const int L) {
    bf16* H = (bf16*)(A.ws + WS_HY); const unsigned char* TU = A.ws + WS_BIG; const unsigned char* TV = TU + (size_t)16384 * 2048; const float* SCL = (const float*)(A.ws + WS_BIG + 64 * MiB);
    const int* EID = (const int*)(A.ws + WS_LA); const float* GSM = (const float*)(A.ws + WS_LA + 16 * MiB);
    const float* MOD = (const float*)(A.ws + WS_MOD); float* X = A.out;
    const float* lng = (const float*)A.in[21] + (size_t)(L * 2 + 1) * DM; const float* lnb = (const float*)A.in[22] + (size_t)(L * 2 + 1) * DM;
    for (int t = F.gw; t < TOK; t += F.ngw) {
        const int b = t >> 14;
        f32x2 h2[16];
#pragma unroll
        for (int j = 0; j < 2; ++j) { const u32x4 a = *(const u32x4*)(H + (size_t)t * DM + (j * 64 + F.lane) * 16), c = *(const u32x4*)(H + (size_t)t * DM + (j * 64 + F.lane) * 16 + 8);
            const unsigned aw[8] = {a.x, a.y, a.z, a.w, c.x, c.y, c.z, c.w};
#pragma unroll
            for (int q = 0; q < 8; ++q) h2[j * 8 + q] = (f32x2){lo2f(aw[q]), hi2f(aw[q])}; }
        f32x2 o2[16];
#pragma unroll
        for (int e = 0; e < 16; ++e) o2[e] = (f32x2){0.f, 0.f};
#pragma unroll 1
        for (int e0 = 0; e0 < 128; e0 += PGB) {
            int eid[PGB]; float gw[PGB], su[PGB], sv[PGB];
#pragma unroll
            for (int q = 0; q < PGB; ++q) { eid[q] = __builtin_amdgcn_readfirstlane(EID[(size_t)t * 128 + e0 + q]); gw[q] = GSM[(size_t)t * 128 + e0 + q]; su[q] = SCL[eid[q]]; sv[q] = SCL[16384 + eid[q]]; }
            u32x4 uu[PGB][2], vv[PGB][2];
#pragma unroll
            for (int q = 0; q < PGB; ++q)
#pragma unroll
                for (int j = 0; j < 2; ++j) { uu[q][j] = *(const u32x4*)(TU + (size_t)eid[q] * 2048 + (j * 64 + F.lane) * 16); vv[q][j] = *(const u32x4*)(TV + (size_t)eid[q] * 2048 + (j * 64 + F.lane) * 16); }
#pragma unroll
            for (int q = 0; q < PGB; ++q) {
                f32x2 d2 = {0.f, 0.f};
#pragma unroll
                for (int j = 0; j < 2; ++j) { const unsigned w[4] = {uu[q][j].x, uu[q][j].y, uu[q][j].z, uu[q][j].w};
#pragma unroll
                    for (int i = 0; i < 4; ++i) { const f32x2 lo = __builtin_amdgcn_cvt_pk_f32_fp8((int)w[i], false), hi = __builtin_amdgcn_cvt_pk_f32_fp8((int)w[i], true);
                        d2 = lo * h2[j * 8 + 2 * i] + d2; d2 = hi * h2[j * 8 + 2 * i + 1] + d2; } }
                const float d = wsum(d2.x + d2.y) * su[q];
                const float act = 0.5f * d * (1.0f + erff(d * 0.70710678f)) * gw[q] * sv[q];
                const f32x2 a2 = {act, act};
#pragma unroll
                for (int j = 0; j < 2; ++j) { const unsigned w[4] = {vv[q][j].x, vv[q][j].y, vv[q][j].z, vv[q][j].w};
#pragma unroll
                    for (int i = 0; i < 4; ++i) { const f32x2 lo = __builtin_amdgcn_cvt_pk_f32_fp8((int)w[i], false), hi = __builtin_amdgcn_cvt_pk_f32_fp8((int)w[i], true);
                        o2[j * 8 + 2 * i] = a2 * lo + o2[j * 8 + 2 * i]; o2[j * 8 + 2 * i + 1] = a2 * hi + o2[j * 8 + 2 * i + 1]; } }
            }
        }
        float out[32];
#pragma unroll
        for (int e = 0; e < 16; ++e) { out[2 * e] = o2[e].x; out[2 * e + 1] = o2[e].y; }
        const float* gate = MOD + (size_t)((L * 2 + 1) * 2 + b) * 6144 + 4096;
        float sum = 0.f;
#pragma unroll
        for (int j = 0; j < 2; ++j)
#pragma unroll
            for (int c = 0; c < 4; ++c) { const int base = (j * 64 + F.lane) * 16 + 4 * c;
                const f32x4 x0 = *(const f32x4*)(X + (size_t)t * DM + base), g0 = *(const f32x4*)(gate + base);
#pragma unroll
                for (int e = 0; e < 4; ++e) { const float v = ALPHA * x0[e] + (1.0f + g0[e]) * out[j * 16 + 4 * c + e]; out[j * 16 + 4 * c + e] = v; sum += v; } }
        const float mean = wsum(sum) * (1.0f / DM); float sq = 0.f;
#pragma unroll
        for (int e = 0; e < 32; ++e) { out[e] -= mean; sq += out[e] * out[e]; }
        const float rstd = rsqrtf(wsum(sq) * (1.0f / DM) + 1e-5f);
        const float* sh = MOD + (size_t)(((L + 1) * 2 + 0) * 2 + b) * 6144; const float* sc = sh + 2048;
#pragma unroll
        for (int j = 0; j < 2; ++j) {
            float hq[16];
#pragma unroll
            for (int c = 0; c < 4; ++c) { const int base = (j * 64 + F.lane) * 16 + 4 * c;
                const f32x4 lg0 = *(const f32x4*)(lng + base), lb0 = *(const f32x4*)(lnb + base);
                f32x4 o0;
#pragma unroll
                for (int e = 0; e < 4; ++e) o0[e] = out[j * 16 + 4 * c + e] * rstd * lg0[e] + lb0[e];
                *(f32x4*)(X + (size_t)t * DM + base) = o0;
                if (L == 0) { const f32x4 s0 = *(const f32x4*)(sc + base), h0 = *(const f32x4*)(sh + base);
#pragma unroll
                    for (int e = 0; e < 4; ++e) hq[4 * c + e] = o0[e] * (1.0f + s0[e]) + h0[e]; } }
            if (L == 0) { u32x4 w0, w1;
                w0.x = pk2(hq[0], hq[1]); w0.y = pk2(hq[2], hq[3]); w0.z = pk2(hq[4], hq[5]); w0.w = pk2(hq[6], hq[7]);
                w1.x = pk2(hq[8], hq[9]); w1.y = pk2(hq[10], hq[11]); w1.z = pk2(hq[12], hq[13]); w1.w = pk2(hq[14], hq[15]);
                *(u32x4*)(H + (size_t)t * DM + (j * 64 + F.lane) * 16) = w0; *(u32x4*)(H + (size_t)t * DM + (j * 64 + F.lane) * 16 + 8) = w1; }
        }
    }
}

__device__ __forceinline__ void ph_odd_post(const Args& A, Frame& F) {
    bf16* Z = (bf16*)(A.ws + WS_Z); const int* positions = (const int*)A.in[2];
    const float inv128 = powf(10000.0f, -(float)F.lane / 64.0f); const int i32 = F.lane & 31; const float inv64 = powf(10000.0f, -(float)i32 / 32.0f);
    for (int t = F.gw; t < TOK; t += F.ngw) {
        bf16* zr = Z + (size_t)t * OD_NP; const float pos = (float)positions[t];
        float sn, cs; sincosf(pos * inv128, &sn, &cs);
        for (int hd = 0; hd < 20; ++hd) { const int base = hd * 128;
            const float t1 = bf2f(zr[base + F.lane]), t2 = bf2f(zr[base + 64 + F.lane]);
            zr[base + F.lane] = (bf16)f2bf(t1 * cs - t2 * sn); zr[base + 64 + F.lane] = (bf16)f2bf(t2 * cs + t1 * sn); }
        sincosf(pos * inv64, &sn, &cs);
        for (int it = 0; it < 9; ++it) { const int hd = 2 * it + (F.lane >> 5); if (hd < 17) { const int base = 3072 + hd * 64;
            const float t1 = bf2f(zr[base + i32]), t2 = bf2f(zr[base + 32 + i32]);
            zr[base + i32] = (bf16)f2bf(t1 * cs - t2 * sn); zr[base + 32 + i32] = (bf16)f2bf(t2 * cs + t1 * sn); } }
    }
}

__device__ __forceinline__ void ph_dsa_select(const Args& A, Frame& F) {
    const bf16* Z = (const bf16*)(A.ws + WS_Z); unsigned short* SEL = (unsigned short*)(A.ws + WS_LA); int* CNT = (int*)(A.ws + WS_CNT);
    LAS unsigned* SC = (LAS unsigned*)F.lds;
    LAS unsigned* hist = (LAS unsigned*)(F.lds + 131072);
    LAS unsigned* res = (LAS unsigned*)(F.lds + 131072 + 2048);
    LAS int* wtot = (LAS int*)(F.lds + 131072 + 2048 + 64);
    const int r = F.lane & 31, hg = F.lane >> 5, tk = (r >> 2) & 1, hh = (r & 3) + 4 * (r >> 3);
    const int grp = F.wave >> 2, ltid = F.tid & 255, lw = F.wave & 3;
    for (int pr = F.bx; pr < TOK / 2; pr += F.G) {
        const int t0 = 2 * pr, b = t0 >> 14, s0 = t0 & (SEQ - 1);
        const int nkeys = s0 + 2, ntiles = (nkeys + 31) >> 5;
        bf16x8 af[4];
        { const bf16* qrow = Z + (size_t)(t0 + tk) * OD_NP + 3072 + hh * 64 + 8 * hg;
#pragma unroll
          for (int s = 0; s < 4; ++s) af[s] = *(const bf16x8*)(qrow + 16 * s); }
        float wv[16];
        { const bf16* wrow = Z + (size_t)(t0 + hg) * OD_NP + 4160;
          const u32x4 w0 = *(const u32x4*)(wrow), w1 = *(const u32x4*)(wrow + 8);
          const unsigned ww[8] = {w0.x, w0.y, w0.z, w0.w, w1.x, w1.y, w1.z, w1.w};
#pragma unroll
          for (int q = 0; q < 8; ++q) { wv[2 * q] = lo2f(ww[q]) * 0.03125f; wv[2 * q + 1] = hi2f(ww[q]) * 0.03125f; } }
        __syncthreads();
        for (int tile = F.wave; tile < ntiles; tile += NWAVES) {
            const int key = tile * 32 + r;
            const bf16* krow = Z + (size_t)(b * SEQ + key) * OD_NP + 4096 + 8 * hg;
            f32x16 acc;
#pragma unroll
            for (int q = 0; q < 16; ++q) acc[q] = 0.f;
#pragma unroll
            for (int s = 0; s < 4; ++s) { const bf16x8 bfr = *(const bf16x8*)(krow + 16 * s); acc = __builtin_amdgcn_mfma_f32_32x32x16_bf16(af[s], bfr, acc, 0, 0, 0); }
            float sc = 0.f;
#pragma unroll
            for (int q = 0; q < 16; ++q) sc += fmaxf(acc[q], 0.f) * wv[q];
            const bool valid = key <= s0 + hg;
            SC[hg * 16384 + key] = valid ? ordkey(sc) : 0u;
        }
        __syncthreads();
        const int n = s0 + grp + 1; unsigned k = (unsigned)(n < 256 ? n : 256); unsigned prefix = 0u;
        const LAS unsigned* sc = SC + grp * 16384; LAS unsigned* hs = hist + grp * 256;
#pragma unroll 1
        for (int pass = 0; pass < 4; ++pass) {
            const int shift = 24 - 8 * pass;
            hs[ltid] = 0u;
            __syncthreads();
            for (int i = ltid; i < n; i += 256) { const unsigned kv = sc[i];
                const bool match = (pass == 0) ? true : ((kv >> (shift + 8)) == prefix);
                if (match) (void)__hip_atomic_fetch_add(&hs[(kv >> shift) & 255u], 1u, __ATOMIC_RELAXED, __HIP_MEMORY_SCOPE_WORKGROUP); }
            __syncthreads();
            if (lw == 0) {
                const unsigned c0 = hs[4 * F.lane], c1 = hs[4 * F.lane + 1], c2 = hs[4 * F.lane + 2], c3 = hs[4 * F.lane + 3];
                const unsigned tot = c0 + c1 + c2 + c3; unsigned suf = tot;
#pragma unroll
                for (int o = 1; o < 64; o <<= 1) { const unsigned tmp = __shfl_down(suf, o); if (F.lane + o < 64) suf += tmp; }
                unsigned above = suf - tot;
                if (above < k && k <= suf) {
                    int bin;
                    if (above + c3 >= k) { bin = 3; } else { above += c3; if (above + c2 >= k) { bin = 2; } else { above += c2; if (above + c1 >= k) { bin = 1; } else { above += c1; bin = 0; } } }
                    res[grp * 2 + 0] = (unsigned)(4 * F.lane + bin); res[grp * 2 + 1] = k - above;
                }
            }
            __syncthreads();
            prefix = (prefix << 8) | res[grp * 2 + 0]; k = res[grp * 2 + 1];
        }
        const unsigned tau = prefix; const int krem = (int)k;
        int cg = 0, ce = 0;
        for (int j = 0; j < 64; ++j) { const int i = ltid * 64 + ((j + ltid) & 63); if (i < n) { const unsigned kv = sc[i]; cg += (kv > tau) ? 1 : 0; ce += (kv == tau) ? 1 : 0; } }
        int ig = cg, ie = ce;
#pragma unroll
        for (int o = 1; o < 64; o <<= 1) { const int tg = __shfl_up(ig, o), te = __shfl_up(ie, o); if (F.lane >= o) { ig += tg; ie += te; } }
        if (F.lane == 63) { wtot[F.wave * 2] = ig; wtot[F.wave * 2 + 1] = ie; }
        __syncthreads();
        int og = ig - cg, oe = ie - ce, totg = 0;
        for (int w = 0; w < 4; ++w) { const int a = wtot[(grp * 4 + w) * 2], e = wtot[(grp * 4 + w) * 2 + 1]; if (w < lw) { og += a; oe += e; } totg += a; }
        unsigned short* sel = SEL + (size_t)(t0 + grp) * 256;
        for (int j = 0; j < 64; ++j) { const int i = ltid * 64 + ((j + ltid) & 63); if (i < n) { const unsigned kv = sc[i];
            if (kv > tau) { sel[og++] = (unsigned short)i; }
            else if (kv == tau) { if (oe < krem) sel[totg + oe] = (unsigned short)i; ++oe; } } }
        if (ltid == 0) CNT[t0 + grp] = (n < 256 ? n : 256);
    }
}

__device__ __forceinline__ void ph_dsa_attn(const Args& A, Frame& F) {
    const bf16* Z = (const bf16*)(A.ws + WS_Z); const unsigned short* SEL = (const unsigned short*)(A.ws + WS_LA); const int* CNT = (const int*)(A.ws + WS_CNT);
    bf16* Y = (bf16*)(A.ws + WS_HY);
    LAS unsigned char* QL = F.lds + F.wave * 1024;
    for (int it = F.gw; it < TOK * 4; it += F.ngw) {
        const int t = it >> 2, kvh = it & 3, b = t >> 14; const int n = CNT[t];
        *(LAS u32x4*)(QL + F.lane * 16) = *(const u32x4*)(Z + (size_t)t * OD_NP + kvh * 512 + F.lane * 8);
        int id[4];
#pragma unroll
        for (int m = 0; m < 4; ++m) { const int jj = F.lane + 64 * m; id[m] = (jj < n) ? (int)SEL[(size_t)t * 256 + jj] : 0; }
        asm volatile("s_waitcnt lgkmcnt(0)" ::: "memory"); __builtin_amdgcn_wave_barrier();
        float s[4][4];
#pragma unroll
        for (int m = 0; m < 4; ++m)
#pragma unroll
            for (int g = 0; g < 4; ++g) s[m][g] = 0.f;
        const bf16* kbase = Z + (size_t)b * SEQ * OD_NP + 2048 + kvh * 128;
#pragma unroll 2
        for (int c16 = 0; c16 < 16; ++c16) {
            u32x4 qd[4];
#pragma unroll
            for (int g = 0; g < 4; ++g) qd[g] = *(const LAS u32x4*)(QL + g * 256 + c16 * 16);
#pragma unroll
            for (int m = 0; m < 4; ++m) { const u32x4 kd = *(const u32x4*)(kbase + (size_t)id[m] * OD_NP + c16 * 8);
#pragma unroll
                for (int g = 0; g < 4; ++g) { float a = s[m][g]; a = dot2bf(kd.x, qd[g].x, a); a = dot2bf(kd.y, qd[g].y, a); a = dot2bf(kd.z, qd[g].z, a); a = dot2bf(kd.w, qd[g].w, a); s[m][g] = a; } }
        }
        float p[4][4];
#pragma unroll
        for (int g = 0; g < 4; ++g) {
            float mx = -INFINITY;
#pragma unroll
            for (int m = 0; m < 4; ++m) { const bool val = (F.lane + 64 * m) < n; s[m][g] = val ? s[m][g] * 0.08838834764831845f : -INFINITY; mx = fmaxf(mx, s[m][g]); }
            mx = wmax(mx); float sm = 0.f;
#pragma unroll
            for (int m = 0; m < 4; ++m) { const bool val = (F.lane + 64 * m) < n; p[m][g] = val ? expf(s[m][g] - mx) : 0.f; sm += p[m][g]; }
            const float rden = 1.0f / wsum(sm);
#pragma unroll
            for (int m = 0; m < 4; ++m) p[m][g] *= rden;
        }
        float o[4][2];
#pragma unroll
        for (int g = 0; g < 4; ++g) { o[g][0] = 0.f; o[g][1] = 0.f; }
        const bf16* vbase = Z + (size_t)b * SEQ * OD_NP + 2560 + kvh * 128 + 2 * F.lane;
#pragma unroll
        for (int m = 0; m < 4; ++m) {
            const int lim = (n - 64 * m) < 64 ? (n - 64 * m) : 64;
#pragma unroll 4
            for (int ln = 0; ln < lim; ++ln) {
                const int idj = __builtin_amdgcn_readlane(id[m], ln);
                const unsigned vw = *(const unsigned*)(vbase + (size_t)idj * OD_NP);
                const float v0 = lo2f(vw), v1 = hi2f(vw);
#pragma unroll
                for (int g = 0; g < 4; ++g) { const float pg = rdlane(p[m][g], ln); o[g][0] += pg * v0; o[g][1] += pg * v1; }
            }
        }
#pragma unroll
        for (int g = 0; g < 4; ++g) *(unsigned*)(Y + (size_t)t * DM + (kvh * 4 + g) * 128 + 2 * F.lane) = pk2(o[g][0], o[g][1]);
        asm volatile("s_waitcnt lgkmcnt(0)" ::: "memory"); __builtin_amdgcn_wave_barrier();
    }
}

__global__ void __launch_bounds__(NTHREADS, 2) mk_fwd(Args args) {
    extern __shared__ __attribute__((aligned(16))) unsigned char lds[];
    Frame F;
    F.lds = (LAS unsigned char*)lds;
    volatile LAS unsigned* MISC = (volatile LAS unsigned*)(F.lds + MISC_OFF);
    F.tid = threadIdx.x; F.lane = F.tid & 63; F.wave = __builtin_amdgcn_readfirstlane(F.tid >> 6);
    F.bx = blockIdx.x; F.G = gridDim.x; F.gw = F.bx * NWAVES + F.wave; F.ngw = F.G * NWAVES;
    if (F.tid < 64) MISC[F.tid] = 0u;
    __syncthreads();
    unsigned char* ws = args.ws;
    XcdBarrier bar = xcd_barrier_post((unsigned*)(ws + WS_CTL) + CW_BAR, MISC + 8);
    const int lo = args.ph_lo, hi = args.ph_hi;
#define IN(k) (lo <= (k) && (k) < hi)
#define SEAM(k) do { if (IN((k) + 1)) xcd_barrier(bar); } while (0)
#define GEMM_BF16(Aptr, Bptr, Nn, Kk, Optr, ldo) do { pg8::Gemm g{(const pg8::bf16_t*)(Aptr), (const pg8::bf16_t*)(Bptr), TOK, (Nn), (Kk)}; pg8::StaticOrder S; S.init(TOK, (Nn), F.G, F.bx); \
        pg8::EpiBf16<0> E{(pg8::bf16_t*)(Optr), (ldo), nullptr, 0, 0}; pg8::gemm_phase<pg8::EpiBf16<0>, pg8::StaticOrder, false>(F.lds, g, S, E, nullptr); } while (0)

    if (IN(0)) { ph_prologue(args, F); SEAM(0); }
    if (IN(1)) { ph_mod_x(args, F); SEAM(1); }
    if (IN(2)) { GEMM_BF16(ws + WS_HY, ws + WS_WINE, EV_NP, 2048, ws + WS_Z, EV_NP); SEAM(2); }
    if (IN(3)) { ph_even_post(args, F); SEAM(3); }
    if (IN(4)) { pg8::Gemm g{(const pg8::bf16_t*)(ws + WS_LA), (const pg8::bf16_t*)(ws + WS_WL), TOK, 3072, 512}; pg8::StaticOrder S; S.init(TOK, 3072, F.G, F.bx);
                 EpiLora E{(pg8::bf16_t*)(ws + WS_Z) + 1280, EV_NP, (const float*)args.in[7], (const float*)args.in[9]};
                 pg8::gemm_phase<EpiLora, pg8::StaticOrder, false>(F.lds, g, S, E, nullptr); SEAM(4); }
    if (IN(5)) { ph_scan_pack(args, F); SEAM(5); }
    if (IN(6)) { ph_swa(args, F); SEAM(6); }
    if (IN(7)) { ph_scan(args, F); SEAM(7); }
    if (IN(8)) { ph_rwkv_finish(args, F); SEAM(8); }
    if (IN(9)) { GEMM_BF16(ws + WS_HY, ws + WS_WOUTE, 2048, 2048, ws + WS_Z, 2048); SEAM(9); }
    if (IN(10)) { ph_ln_mixer(args, F, 0); SEAM(10); }
    if (IN(11)) { GEMM_BF16(ws + WS_HY, ws + WS_WQ0, 2048, 2048, ws + WS_Z, 2048); SEAM(11); }
    if (IN(12)) { ph_peer_select(args, F, 0); SEAM(12); }
    if (IN(13)) { ph_peer_gather(args, F, 0); SEAM(13); }
    if (IN(14)) { GEMM_BF16(ws + WS_HY, ws + WS_WINO, OD_NP, 2048, ws + WS_Z, OD_NP); SEAM(14); }
    if (IN(15)) { ph_odd_post(args, F); SEAM(15); }
    if (IN(16)) { ph_dsa_select(args, F); SEAM(16); }
    if (IN(17)) { ph_dsa_attn(args, F); SEAM(17); }
    if (IN(18)) { GEMM_BF16(ws + WS_HY, ws + WS_WOUTO, 2048, 2048, ws + WS_Z, 2048); SEAM(18); }
    if (IN(19)) { ph_ln_mixer(args, F, 1); SEAM(19); }
    if (IN(20)) { GEMM_BF16(ws + WS_HY, ws + WS_WQ1, 2048, 2048, ws + WS_Z, 2048); SEAM(20); }
    if (IN(21)) { ph_peer_select(args, F, 1); SEAM(21); }
    if (IN(22)) { ph_peer_gather(args, F, 1); }
#undef IN
#undef SEAM
#undef GEMM_BF16
}

#ifndef MK_SPLIT
#define MK_SPLIT 0
#endif
extern "C" void kernel_launch(void* const* d_in, const int* in_sizes, int n_in, void* d_out, int out_size, void* d_ws, size_t ws_size, hipStream_t stream) {
    static int grid = 0;
    if (grid == 0) {
        int dev = 0, cus = 0;
        if (n_in != 27 || out_size != TOK * DM || ws_size < WS_END) { fprintf(stderr, "kernel_launch: unexpected shapes (n_in %d out %d ws %zu)\n", n_in, out_size, ws_size); grid = -1; return; }
        if (hipGetDevice(&dev) != hipSuccess || hipDeviceGetAttribute(&cus, hipDeviceAttributeMultiprocessorCount, dev) != hipSuccess) { grid = -1; return; }
        if (hipFuncSetAttribute((const void*)mk_fwd, hipFuncAttributeMaxDynamicSharedMemorySize, LDS_BYTES) != hipSuccess) { fprintf(stderr, "kernel_launch: hipFuncSetAttribute failed\n"); grid = -1; return; }
        int per_cu = 0;
        if (hipOccupancyMaxActiveBlocksPerMultiprocessor(&per_cu, (const void*)mk_fwd, NTHREADS, LDS_BYTES) != hipSuccess || per_cu < 1) fprintf(stderr, "kernel_launch: occupancy query says %d\n", per_cu);
        (void)hipGetLastError();
        grid = cus;
    }
    if (grid < 0) return;
    (void)hipMemsetAsync((char*)d_ws + WS_CTL, 0, CTL_ZERO_BYTES, stream);
    Args a{};
    for (int i = 0; i < 27; ++i) a.in[i] = d_in[i];
    a.out = (float*)d_out; a.ws = (unsigned char*)d_ws;
#if MK_SPLIT
    for (int p = 0; p < 23; ++p) { a.ph_lo = p; a.ph_hi = p + 1; hipLaunchKernelGGL(mk_fwd, dim3(grid), dim3(NTHREADS), LDS_BYTES, stream, a); }
#else
    a.ph_lo = 0; a.ph_hi = 23;
    hipLaunchKernelGGL(mk_fwd, dim3(grid), dim3(NTHREADS), LDS_BYTES, stream, a);
#endif
}
```

```cpp
#include <hip/hip_runtime.h>
#include <cstdio>
#include <cstdint>
namespace pg8 {
#define PG8_LAS __attribute__((address_space(3)))
typedef unsigned short bf16_t;
typedef short bf16x8 __attribute__((ext_vector_type(8)));
typedef float f32x4 __attribute__((ext_vector_type(4)));
typedef unsigned u32x4 __attribute__((ext_vector_type(4)));
constexpr int BM = 256, BK = 64, HALF = 128, HTB = HALF * BK * 2  , STAGE_BYTES = 8 * HTB, NXCD = 8, WGM = 8;

__host__ __device__ __forceinline__ int lds_byte(int r, int c) { const int st = (r >> 4) * 2 + (c >> 5), rr = r & 15, cc = c & 31, ob = rr * 64 + cc * 2; return st * 1024 + (ob ^ (((ob >> 9) & 1) << 5)); }
__host__ __device__ __forceinline__ void stage_rc(int b, int& R, int& C) { const int st = b / 1024, sb = b % 1024, swz = sb ^ (((sb >> 9) & 1) << 5); R = (st >> 1) * 16 + swz / 64; C = (st & 1) * 32 + (swz % 64) / 2; }
__host__ __device__ __forceinline__ int perm32(int rho) { const int n = rho >> 4, i = rho & 15; return 8 * (i >> 2) + 4 * n + (i & 3); }

struct Unit { int pm, pn; };
struct Gemm { const bf16_t* A; const bf16_t* Bt; int M, N, K; };

struct StaticOrder {
    int nM, nN, nwg, G, c;
    __host__ __device__ void init(int M, int N, int G_, int c_) { nM = M / BM; nN = N / BM; nwg = nM * nN; G = G_; c = c_; }
    __host__ __device__ bool next(int i, Unit& u) const {
        const long L = (long)i * G + c; if (L >= nwg) return false;
        int wgid = (int)L; { const int q = nwg / NXCD, r = nwg % NXCD, xcd = wgid % NXCD, off = wgid / NXCD; wgid = (xcd < r ? xcd * (q + 1) : r * (q + 1) + (xcd - r) * q) + off; }
        const int nig = WGM * nN, gid = wgid / nig, fm = gid * WGM, gsz = (nM - fm) < WGM ? (nM - fm) : WGM;
        u.pm = fm + ((wgid % nig) % gsz); u.pn = (wgid % nig) / gsz; return true;
    }
    __device__ __forceinline__ void a_ready(const Unit&) const {}
    __device__ __forceinline__ void done(const Unit&) const {}
};
struct CountedOrder : StaticOrder {
    const unsigned* ready; unsigned need; unsigned* tmo;
    __device__ __forceinline__ void a_ready(const Unit& u) const {
        if (threadIdx.x < 64) {
            const unsigned long long t0 = __builtin_amdgcn_s_memrealtime(); unsigned polls = 0;
            while ((unsigned)__builtin_amdgcn_readfirstlane(__hip_atomic_load(ready + 64 * u.pm, __ATOMIC_RELAXED, __HIP_MEMORY_SCOPE_AGENT)) < need) {
                if ((++polls & 255u) == 0u && __builtin_amdgcn_readfirstlane(__hip_atomic_load(tmo, __ATOMIC_RELAXED, __HIP_MEMORY_SCOPE_AGENT)) != 0u) break;
                if (__builtin_amdgcn_s_memrealtime() - t0 > 2000000ull) {
                    if (threadIdx.x == 0) { unsigned expect = 0u; __hip_atomic_compare_exchange_strong(tmo + 1, &expect, 0x600u | (unsigned)(u.pm & 0xff), __ATOMIC_RELAXED, __ATOMIC_RELAXED, __HIP_MEMORY_SCOPE_AGENT); __hip_atomic_store(tmo, 1u, __ATOMIC_RELAXED, __HIP_MEMORY_SCOPE_AGENT); }
                    break; }
                __builtin_amdgcn_s_sleep(2); }
            __builtin_amdgcn_fence(__ATOMIC_ACQUIRE, "agent");
            asm volatile("s_waitcnt vmcnt(0)" ::: "memory");
        }
#if !defined(BROKEN_HOOK_NO_BARRIER)
        asm volatile("" ::: "memory"); __builtin_amdgcn_s_barrier(); asm volatile("" ::: "memory");
#endif
    }
};

__device__ __forceinline__ unsigned cvt_pk_bf16(float lo, float hi) { unsigned r; asm volatile("v_cvt_pk_bf16_f32 %0, %1, %2" : "=v"(r) : "v"(lo), "v"(hi)); return r; }
typedef float f32x2 __attribute__((ext_vector_type(2)));
__device__ __forceinline__ f32x2 gelu_pk(f32x2 v) {
    const f32x2 av = __builtin_elementwise_abs(v), d = av * 0.2316418882f + 1.0f;
    f32x2 t; t.x = __builtin_amdgcn_rcpf(d.x); t.y = __builtin_amdgcn_rcpf(d.y);
    f32x2 q = t * 0.5307027145f + (-0.7265760135f); q = q * t + 0.7107068705f; q = q * t + (-0.142248368f); q = q * t + 0.127414796f; q = q * t;
    const f32x2 s = (v * v) * (-0.72134752044f);
    f32x2 e; e.x = __builtin_amdgcn_exp2f(s.x); e.y = __builtin_amdgcn_exp2f(s.y);
    const f32x2 m = v * (q * e), r = v - m;
    f32x2 o; o.x = v.x < 0.f ? m.x : r.x; o.y = v.y < 0.f ? m.y : r.y; return o;
}

struct EpiF32 {
    static constexpr bool PERM = false, AFTER_DRAIN = false;
    float* C; int ldc; const float* bias;
    __device__ __forceinline__ void operator()(const f32x4 (&acc)[2][2][4][2], const Unit& u, int wr, int wc, int fr, int fq) const {
        const int row0 = u.pm * BM + wr * 64 + fr, col0 = u.pn * BM + wc * 32 + 4 * fq;
        f32x4 bv[2][2];
#pragma unroll
        for (int bj = 0; bj < 2; ++bj)
#pragma unroll
            for (int n = 0; n < 2; ++n) bv[bj][n] = bias ? *(const f32x4*)(bias + col0 + bj * HALF + n * 16) : (f32x4){0.f, 0.f, 0.f, 0.f};
#pragma unroll
        for (int ai = 0; ai < 2; ++ai)
#pragma unroll
            for (int m = 0; m < 4; ++m) { float* rowp = C + (size_t)(row0 + ai * HALF + m * 16) * ldc + col0;
#pragma unroll
                for (int bj = 0; bj < 2; ++bj)
#pragma unroll
                    for (int n = 0; n < 2; ++n) *(f32x4*)(rowp + bj * HALF + n * 16) = acc[ai][bj][m][n] + bv[bj][n]; }
    }
};
template <int ACT  > struct EpiBf16 {
    static constexpr bool PERM = true, AFTER_DRAIN = false;
    bf16_t* O; int ldc; const float* bias; int split_cols; size_t split_stride;
    __device__ __forceinline__ void operator()(const f32x4 (&acc)[2][2][4][2], const Unit& u, int wr, int wc, int fr, int fq) const {
        const int row0 = u.pm * BM + wr * 64 + fr; int colt = u.pn * BM; bf16_t* base = O;
        if (split_cols) { const int t = colt / split_cols; base += (size_t)t * split_stride; colt -= t * split_cols; }
        const int col0 = colt + wc * 32 + 8 * fq, bcol0 = u.pn * BM + wc * 32 + 8 * fq;
        f32x4 bv[2][2];
#pragma unroll
        for (int bj = 0; bj < 2; ++bj)
#pragma unroll
            for (int n = 0; n < 2; ++n) bv[bj][n] = bias ? *(const f32x4*)(bias + bcol0 + bj * HALF + 4 * n) : (f32x4){0.f, 0.f, 0.f, 0.f};
#pragma unroll
        for (int ai = 0; ai < 2; ++ai)
#pragma unroll
            for (int m = 0; m < 4; ++m) { bf16_t* rowp = base + (size_t)(row0 + ai * HALF + m * 16) * ldc + col0;
#pragma unroll
                for (int bj = 0; bj < 2; ++bj) { f32x4 v0 = acc[ai][bj][m][0] + bv[bj][0], v1 = acc[ai][bj][m][1] + bv[bj][1];
                    if (ACT == 1) { f32x2 a = gelu_pk((f32x2){v0[0], v0[1]}), b = gelu_pk((f32x2){v0[2], v0[3]}), c = gelu_pk((f32x2){v1[0], v1[1]}), d = gelu_pk((f32x2){v1[2], v1[3]});
                        v0 = (f32x4){a.x, a.y, b.x, b.y}; v1 = (f32x4){c.x, c.y, d.x, d.y}; }
                    if (ACT == 2) {
#pragma unroll
                        for (int j = 0; j < 4; ++j) { v0[j] = 0.5f * v0[j] * (1.0f + erff(v0[j] * 0.70710678f)); v1[j] = 0.5f * v1[j] * (1.0f + erff(v1[j] * 0.70710678f)); } }
                    u32x4 w; w.x = cvt_pk_bf16(v0[0], v0[1]); w.y = cvt_pk_bf16(v0[2], v0[3]); w.z = cvt_pk_bf16(v1[0], v1[1]); w.w = cvt_pk_bf16(v1[2], v1[3]);
                    *(u32x4*)(rowp + bj * HALF) = w; } }
    }
};

struct PanelStats {
    unsigned* xbuf;
    unsigned* cnt;
    unsigned* tmo;
    int ntn; float eps;
    unsigned code;
    __device__ __forceinline__ bool run(const f32x4 (&v)[2][2][4][2], const Unit& u, int wr, int wc, int fr, int fq, PG8_LAS unsigned char* lds, int wid, int lane) const {
        typedef float f32x2v __attribute__((ext_vector_type(2)));
        PG8_LAS f32x2v* P = (PG8_LAS f32x2v*)lds;
        PG8_LAS f32x2v* S = (PG8_LAS f32x2v*)(lds + 8192);
        PG8_LAS unsigned* flag = (PG8_LAS unsigned*)(lds + 8192 + 2048);
#pragma unroll
        for (int ai = 0; ai < 2; ++ai)
#pragma unroll
            for (int m = 0; m < 4; ++m) {
                float s = 0.f;
#pragma unroll
                for (int bj = 0; bj < 2; ++bj)
#pragma unroll
                    for (int n = 0; n < 2; ++n) { const f32x4 x = v[ai][bj][m][n]; s += (x[0] + x[1]) + (x[2] + x[3]); }
                s += __shfl_xor(s, 16); s += __shfl_xor(s, 32);
                const float mw = s * (1.0f / 64.0f); float q = 0.f;
#pragma unroll
                for (int bj = 0; bj < 2; ++bj)
#pragma unroll
                    for (int n = 0; n < 2; ++n) { const f32x4 d = v[ai][bj][m][n] - mw; q += (d[0] * d[0] + d[1] * d[1]) + (d[2] * d[2] + d[3] * d[3]); }
                q += __shfl_xor(q, 16); q += __shfl_xor(q, 32);
                if (fq == 0) P[(ai * HALF + wr * 64 + m * 16 + fr) * 4 + wc] = (f32x2v){mw, q};
            }
        asm volatile("s_waitcnt lgkmcnt(0)" ::: "memory"); __builtin_amdgcn_s_barrier(); asm volatile("" ::: "memory");
#if defined(BROKEN_NO_WAIT)
        if (blockIdx.x >= 64) { const long long t0 = clock64(); while (clock64() - t0 < 60000) __builtin_amdgcn_s_sleep(8); }
#endif
        const int row = wid * 32 + (lane & 31);
        if (lane < 32) {
            const f32x2v a = P[row * 4 + 0], b = P[row * 4 + 1], c = P[row * 4 + 2], d = P[row * 4 + 3];
            const float mt = (a.x + b.x + c.x + d.x) * 0.25f;
            const float da = a.x - mt, db = b.x - mt, dc = c.x - mt, dd = d.x - mt;
            const float m2 = (a.y + b.y) + (c.y + d.y) + 64.0f * ((da * da + db * db) + (dc * dc + dd * dd));
            unsigned long long* slot = (unsigned long long*)xbuf + ((size_t)(u.pm * BM + row) * 4 + u.pn);
            __hip_atomic_store(slot, ((unsigned long long)__float_as_uint(m2) << 32) | __float_as_uint(mt), __ATOMIC_RELAXED, __HIP_MEMORY_SCOPE_AGENT);
        }
        asm volatile("s_waitcnt vmcnt(0)" ::: "memory");
        if (lane == 0) __hip_atomic_fetch_add(cnt + 64 * u.pm, 1u, __ATOMIC_RELAXED, __HIP_MEMORY_SCOPE_AGENT);
        if (wid == 0) {
            bool dead = false; const unsigned long long t0 = __builtin_amdgcn_s_memrealtime(); const unsigned want = 8u * (unsigned)ntn;
            for (;;) {
#if defined(BROKEN_NO_WAIT)
                break;
#endif
                if ((unsigned)__builtin_amdgcn_readfirstlane(__hip_atomic_load(cnt + 64 * u.pm, __ATOMIC_RELAXED, __HIP_MEMORY_SCOPE_AGENT)) >= want) break;
                if (__builtin_amdgcn_s_memrealtime() - t0 > 2000000ull) {
                    if (lane == 0) { unsigned expect = 0u; __hip_atomic_compare_exchange_strong(tmo + 1, &expect, code | (unsigned)(u.pm & 0xff), __ATOMIC_RELAXED, __ATOMIC_RELAXED, __HIP_MEMORY_SCOPE_AGENT);
                                     __hip_atomic_store(tmo, 1u, __ATOMIC_RELAXED, __HIP_MEMORY_SCOPE_AGENT); }
                    dead = true; break; }
                __builtin_amdgcn_s_sleep(2);
            }
            __builtin_amdgcn_fence(__ATOMIC_ACQUIRE, "agent");
            if (lane == 0) flag[0] = dead ? 1u : 0u;
        }
        asm volatile("s_waitcnt vmcnt(0) lgkmcnt(0)" ::: "memory"); __builtin_amdgcn_s_barrier(); asm volatile("" ::: "memory");
        const bool bad = flag[0] != 0u;
        if (lane < 32) {
            const unsigned long long* slot = (const unsigned long long*)xbuf + (size_t)(u.pm * BM + row) * 4; float mt[4], m2[4]; float ms = 0.f;
#pragma unroll
            for (int t = 0; t < 4; ++t) { if (t < ntn) { const unsigned long long w = __hip_atomic_load(slot + t, __ATOMIC_RELAXED, __HIP_MEMORY_SCOPE_AGENT); mt[t] = __uint_as_float((unsigned)w); m2[t] = __uint_as_float((unsigned)(w >> 32)); } else { mt[t] = 0.f; m2[t] = 0.f; } ms += mt[t]; }
            const float mean = ms / (float)ntn; float q = 0.f;
#pragma unroll
            for (int t = 0; t < 4; ++t) if (t < ntn) { const float dm = mt[t] - mean; q += m2[t] + 256.0f * dm * dm; }
            S[row] = (f32x2v){mean, 1.0f / sqrtf(q / (256.0f * (float)ntn) + eps)};
        }
        asm volatile("s_waitcnt lgkmcnt(0)" ::: "memory"); __builtin_amdgcn_s_barrier(); asm volatile("" ::: "memory");
        return bad;
    }
};
struct EpiLnRes {
    static constexpr bool PERM = false, AFTER_DRAIN = true;
    const float* base; float* out; int ldc; const float* bias; PanelStats st; unsigned poison;
    __device__ __forceinline__ void refuse(size_t i0, size_t stride, int M, int N) const { const float q = __builtin_nanf(""); for (size_t i = i0; i < (size_t)M * N; i += stride) out[(i / N) * ldc + i % N] = q;
        if (i0 == 0) { unsigned expect = 0u; __hip_atomic_compare_exchange_strong(st.tmo + 1, &expect, 0x7f0u, __ATOMIC_RELAXED, __ATOMIC_RELAXED, __HIP_MEMORY_SCOPE_AGENT); __hip_atomic_store(st.tmo, 1u, __ATOMIC_RELAXED, __HIP_MEMORY_SCOPE_AGENT); } }
    __device__ __forceinline__ void fused(f32x4 (&acc)[2][2][4][2], const Unit& u, int wr, int wc, int fr, int fq, PG8_LAS unsigned char* lds, int wid, int lane) const {
        typedef float f32x2v __attribute__((ext_vector_type(2)));
        const PG8_LAS f32x2v* S = (const PG8_LAS f32x2v*)(lds + 8192);
        const int col0 = u.pn * BM + wc * 32 + 4 * fq;
#pragma unroll
        for (int bj = 0; bj < 2; ++bj)
#pragma unroll
            for (int n = 0; n < 2; ++n) { const f32x4 bv = bias ? *(const f32x4*)(bias + col0 + bj * HALF + n * 16) : (f32x4){0.f, 0.f, 0.f, 0.f};
#pragma unroll
                for (int ai = 0; ai < 2; ++ai)
#pragma unroll
                    for (int m = 0; m < 4; ++m) acc[ai][bj][m][n] += bv; }
        const bool bad = st.run(acc, u, wr, wc, fr, fq, lds, wid, lane) || poison != 0u;
        const float qnan = __builtin_nanf("");
#pragma unroll
        for (int ai = 0; ai < 2; ++ai)
#pragma unroll
            for (int m = 0; m < 4; ++m) { const int r = ai * HALF + wr * 64 + m * 16 + fr; const f32x2v sr = S[r]; const size_t off = (size_t)(u.pm * BM + r) * ldc + col0;
#pragma unroll
                for (int bj = 0; bj < 2; ++bj)
#pragma unroll
                    for (int n = 0; n < 2; ++n) { const f32x4 bs = *(const f32x4*)(base + off + bj * HALF + n * 16); f32x4 o = bs + (acc[ai][bj][m][n] - sr.x) * sr.y;
                        if (bad) o = (f32x4){qnan, qnan, qnan, qnan}; *(f32x4*)(out + off + bj * HALF + n * 16) = o; }
                asm volatile("" ::: "memory"); }
    }
};
struct EpiLnResLn {
    static constexpr bool PERM = false, AFTER_DRAIN = true;
    const float* base; float* out; bf16_t* xn; int ldc; const float* bias; PanelStats st1, st2; unsigned poison;
    __device__ __forceinline__ void refuse(size_t i0, size_t stride, int M, int N) const { const float q = __builtin_nanf(""); for (size_t i = i0; i < (size_t)M * N; i += stride) { const size_t o = (i / N) * ldc + i % N; out[o] = q; xn[o] = (bf16_t)0x7fc0u; }
        if (i0 == 0) { unsigned expect = 0u; __hip_atomic_compare_exchange_strong(st1.tmo + 1, &expect, 0x7f0u, __ATOMIC_RELAXED, __ATOMIC_RELAXED, __HIP_MEMORY_SCOPE_AGENT); __hip_atomic_store(st1.tmo, 1u, __ATOMIC_RELAXED, __HIP_MEMORY_SCOPE_AGENT); } }
    __device__ __forceinline__ void fused(f32x4 (&acc)[2][2][4][2], const Unit& u, int wr, int wc, int fr, int fq, PG8_LAS unsigned char* lds, int wid, int lane) const {
        typedef float f32x2v __attribute__((ext_vector_type(2))); typedef unsigned u32x2v __attribute__((ext_vector_type(2)));
        const PG8_LAS f32x2v* S = (const PG8_LAS f32x2v*)(lds + 8192);
        const int col0 = u.pn * BM + wc * 32 + 4 * fq;
#pragma unroll
        for (int bj = 0; bj < 2; ++bj)
#pragma unroll
            for (int n = 0; n < 2; ++n) { const f32x4 bv = bias ? *(const f32x4*)(bias + col0 + bj * HALF + n * 16) : (f32x4){0.f, 0.f, 0.f, 0.f};
#pragma unroll
                for (int ai = 0; ai < 2; ++ai)
#pragma unroll
                    for (int m = 0; m < 4; ++m) acc[ai][bj][m][n] += bv; }
        bool bad = st1.run(acc, u, wr, wc, fr, fq, lds, wid, lane) || poison != 0u;
        const float qnan = __builtin_nanf("");
#pragma unroll
        for (int ai = 0; ai < 2; ++ai)
#pragma unroll
            for (int m = 0; m < 4; ++m) { const int r = ai * HALF + wr * 64 + m * 16 + fr; const f32x2v sr = S[r]; const size_t off = (size_t)(u.pm * BM + r) * ldc + col0;
#pragma unroll
                for (int bj = 0; bj < 2; ++bj)
#pragma unroll
                    for (int n = 0; n < 2; ++n) { const f32x4 bs = *(const f32x4*)(base + off + bj * HALF + n * 16); acc[ai][bj][m][n] = bs + (acc[ai][bj][m][n] - sr.x) * sr.y; }
                asm volatile("" : "+v"(acc[ai][0][m][0]), "+v"(acc[ai][0][m][1]), "+v"(acc[ai][1][m][0]), "+v"(acc[ai][1][m][1]));
                if (m & 1) asm volatile("" ::: "memory"); }
        const bool bad1 = bad;
        bad = st2.run(acc, u, wr, wc, fr, fq, lds, wid, lane) || bad;
#pragma unroll
        for (int ai = 0; ai < 2; ++ai)
#pragma unroll
            for (int m = 0; m < 4; ++m) { const int r = ai * HALF + wr * 64 + m * 16 + fr; const f32x2v sr = S[r]; const size_t off = (size_t)(u.pm * BM + r) * ldc + col0;
#pragma unroll
                for (int bj = 0; bj < 2; ++bj)
#pragma unroll
                    for (int n = 0; n < 2; ++n) { const f32x4 x1 = acc[ai][bj][m][n]; *(f32x4*)(out + off + bj * HALF + n * 16) = bad1 ? (f32x4){qnan, qnan, qnan, qnan} : x1;
                        const f32x4 o = (x1 - sr.x) * sr.y; u32x2v w; w.x = cvt_pk_bf16(o[0], o[1]); w.y = cvt_pk_bf16(o[2], o[3]);
                        if (bad) { w.x = 0x7fc07fc0u; w.y = 0x7fc07fc0u; } *(u32x2v*)(xn + off + bj * HALF + n * 16) = w; }
                asm volatile("" ::: "memory"); }
    }
};

template <class Epi, class Sched, bool STAMP = false>
__device__ __forceinline__ void gemm_phase(PG8_LAS unsigned char* lds, const Gemm g, const Sched& S, const Epi& E, unsigned long long* stamps) {
    const int tid = threadIdx.x, wid = __builtin_amdgcn_readfirstlane(tid >> 6), lane = tid & 63, wr = wid >> 2, wc = wid & 3, fr = lane & 15, fq = lane >> 4;
    const int K = g.K, nt = K / BK;
    int ts_lo = 0, ts_hi = 0, nts = 0; const unsigned long long rt_entry = STAMP ? (unsigned long long)wall_clock64() : 0ull;
#define PG8_STAMP() do { if (STAMP && wid == 0 && nts < 64) { const unsigned long long _c = (unsigned long long)clock64(); \
        ts_lo = (lane == nts) ? (int)(unsigned)_c : ts_lo; ts_hi = (lane == nts) ? (int)(unsigned)(_c >> 32) : ts_hi; ++nts; } } while (0)
    PG8_STAMP();
    unsigned voffA[2], voffB[2];
#pragma unroll
    for (int i = 0; i < 2; ++i) { int R, C; stage_rc(tid * 16 + i * 8192, R, C); const int Rb = Epi::PERM ? ((R & ~31) + perm32(R & 31)) : R;
        voffA[i] = (unsigned)(R * K + C) * 2u; voffB[i] = (unsigned)(Rb * K + C) * 2u; }
    const size_t kstep = (size_t)(BK * 2);
    const size_t hstep = (size_t)HALF * K * 2;
    const size_t tstep = 2 * hstep;
    const unsigned ldsw = (unsigned)wid * 1024u;
    const int aoff = lds_byte(wr * 64 + fr, fq * 8), boff = lds_byte(wc * 32 + fr, fq * 8);
#define PG8_SA(b, h) (((b) * 2 + (h)) * HTB)
#define PG8_SB(b, h) ((4 + (b) * 2 + (h)) * HTB)
#define PG8_STAGE(bufoff, gbase, voff) do { _Pragma("unroll") for (int _i = 0; _i < 2; ++_i) \
        __builtin_amdgcn_global_load_lds((const unsigned*)((const char*)(gbase) + (voff)[_i]), (PG8_LAS unsigned*)(lds + (bufoff) + ldsw + _i * 8192), 16, 0, 0); } while (0)
#define PG8_LDA(dst, b, h) do { _Pragma("unroll") for (int m = 0; m < 4; ++m) _Pragma("unroll") for (int k = 0; k < 2; ++k) dst[m][k] = *(const PG8_LAS bf16x8*)(lds + PG8_SA(b, h) + aoff + m * 2048 + k * 1024); } while (0)
#define PG8_LDB(dst, b, h) do { _Pragma("unroll") for (int n = 0; n < 2; ++n) _Pragma("unroll") for (int k = 0; k < 2; ++k) dst[n][k] = *(const PG8_LAS bf16x8*)(lds + PG8_SB(b, h) + boff + n * 2048 + k * 1024); } while (0)
#define PG8_MMA(ai, bj, At, Bt) do { __builtin_amdgcn_s_setprio(1); _Pragma("unroll") for (int m = 0; m < 4; ++m) _Pragma("unroll") for (int n = 0; n < 2; ++n) _Pragma("unroll") for (int k = 0; k < 2; ++k) \
        acc[ai][bj][m][n] = __builtin_amdgcn_mfma_f32_16x16x32_bf16(Bt[n][k], At[m][k], acc[ai][bj][m][n], 0, 0, 0); __builtin_amdgcn_s_setprio(0); } while (0)
#define PG8_WAIT_V(n) asm volatile("s_waitcnt vmcnt(" #n ")" ::: "memory")
#define PG8_WAIT_L(n) asm volatile("s_waitcnt lgkmcnt(" #n ")" ::: "memory")
#define PG8_BAR __builtin_amdgcn_s_barrier()
#define PG8_SCHED __builtin_amdgcn_sched_barrier(0)
    Unit cur, nxt; int ui = 0;
    if (!S.next(0, cur)) return;
    f32x4 acc[2][2][4][2];
#pragma unroll
    for (int a = 0; a < 2; ++a)
#pragma unroll
        for (int b = 0; b < 2; ++b)
#pragma unroll
            for (int m = 0; m < 4; ++m)
#pragma unroll
                for (int n = 0; n < 2; ++n) acc[a][b][m][n] = (f32x4){0.f, 0.f, 0.f, 0.f};
    bf16x8 At[4][2], B0[2][2], B1[2][2];
    const char* cA = (const char*)g.A + (size_t)cur.pm * tstep; const char* cB = (const char*)g.Bt + (size_t)cur.pn * tstep;
    S.a_ready(cur);
    PG8_STAGE(PG8_SB(0, 0), cB, voffB); PG8_STAGE(PG8_SA(0, 0), cA, voffA); PG8_STAGE(PG8_SB(0, 1), cB + hstep, voffB); PG8_STAGE(PG8_SA(0, 1), cA + hstep, voffA);
    if (wr == 1) PG8_BAR;
    PG8_WAIT_V(4); PG8_BAR;
    PG8_STAGE(PG8_SB(1, 0), cB + kstep, voffB); PG8_STAGE(PG8_SA(1, 0), cA + kstep, voffA); PG8_STAGE(PG8_SB(1, 1), cB + hstep + kstep, voffB);
    PG8_WAIT_V(6); PG8_BAR;
    PG8_STAMP();
    for (;;) {
        const bool has_next = S.next(ui + 1, nxt);
        const char* nA = has_next ? (const char*)g.A + (size_t)nxt.pm * tstep : cA; const char* nB = has_next ? (const char*)g.Bt + (size_t)nxt.pn * tstep : cB;
        for (int t = 0; t < nt; t += 2) {
            const bool last = (t == nt - 2);
            const char* a1 = cA + (size_t)(t + 1) * kstep;
            const char* a2 = last ? nA : cA + (size_t)(t + 2) * kstep; const char* b2 = last ? nB : cB + (size_t)(t + 2) * kstep;
            const char* a3 = a2 + kstep; const char* b3 = b2 + kstep;
            if (last && has_next) S.a_ready(nxt);
            PG8_LDB(B0, 0, 0); PG8_SCHED; PG8_LDA(At, 0, 0); PG8_STAGE(PG8_SA(1, 1), a1 + hstep, voffA);
            PG8_WAIT_L(8); PG8_BAR; PG8_WAIT_L(0); PG8_MMA(0, 0, At, B0); PG8_BAR; PG8_SCHED;
            PG8_LDB(B1, 0, 1); PG8_STAGE(PG8_SB(0, 0), b2, voffB);
            PG8_BAR; PG8_WAIT_L(0); PG8_MMA(0, 1, At, B1); PG8_BAR;
            PG8_LDA(At, 0, 1); PG8_STAGE(PG8_SA(0, 0), a2, voffA);
            PG8_BAR; PG8_WAIT_L(0); PG8_MMA(1, 0, At, B0); PG8_BAR; PG8_SCHED;
            PG8_STAGE(PG8_SB(0, 1), b2 + hstep, voffB);
            PG8_WAIT_V(6); PG8_BAR; PG8_MMA(1, 1, At, B1); PG8_BAR;
            PG8_LDB(B0, 1, 0); PG8_SCHED; PG8_LDA(At, 1, 0); PG8_STAGE(PG8_SA(0, 1), a2 + hstep, voffA);
            PG8_WAIT_L(8); PG8_BAR; PG8_WAIT_L(0); PG8_MMA(0, 0, At, B0); PG8_BAR; PG8_SCHED;
            PG8_LDB(B1, 1, 1); PG8_STAGE(PG8_SB(1, 0), b3, voffB);
            PG8_BAR; PG8_WAIT_L(0); PG8_MMA(0, 1, At, B1); PG8_BAR;
            PG8_LDA(At, 1, 1); PG8_STAGE(PG8_SA(1, 0), a3, voffA);
            PG8_BAR; PG8_WAIT_L(0); PG8_MMA(1, 0, At, B0); PG8_BAR; PG8_SCHED;
            PG8_STAGE(PG8_SB(1, 1), b3 + hstep, voffB);
            PG8_WAIT_V(6); PG8_BAR; PG8_MMA(1, 1, At, B1); PG8_BAR;
        }
        PG8_STAMP();
        if constexpr (!Epi::AFTER_DRAIN) { E(acc, cur, wr, wc, fr, fq); S.done(cur); }
        PG8_STAMP();
        if (!has_next) break;
#pragma unroll
        for (int a = 0; a < 2; ++a)
#pragma unroll
            for (int b = 0; b < 2; ++b)
#pragma unroll
                for (int m = 0; m < 4; ++m)
#pragma unroll
                    for (int n = 0; n < 2; ++n) acc[a][b][m][n] = (f32x4){0.f, 0.f, 0.f, 0.f};
        cur = nxt; cA = nA; cB = nB; ++ui;
    }
    PG8_WAIT_V(0);
    if (wr == 0) PG8_BAR;
    PG8_BAR;
    if constexpr (Epi::AFTER_DRAIN) { E.fused(acc, cur, wr, wc, fr, fq, lds, wid, lane); S.done(cur); }
    PG8_STAMP();
    if (STAMP && wid == 0) { stamps[lane] = lane < nts ? (((unsigned long long)(unsigned)ts_hi << 32) | (unsigned)ts_lo) : 0ull;
        if (lane == 62) stamps[62] = rt_entry; if (lane == 63) stamps[63] = (unsigned long long)wall_clock64(); }
#undef PG8_STAMP
#undef PG8_SA
#undef PG8_SB
#undef PG8_STAGE
#undef PG8_LDA
#undef PG8_LDB
#undef PG8_MMA
#undef PG8_WAIT_V
#undef PG8_WAIT_L
#undef PG8_BAR
#undef PG8_SCHED
}
}

#define LAS __attribute__((address_space(3)))
#define XB_TMO      128
#define XB_XCNT(j)  (256  + 64 * (j))
#define XB_XSUB(j)  (1280 + 64 * (j))
#define XB_XGEN(j)  (2304 + 64 * (j))
#define XB_TOP      3328
#define XB_TOPGEN   3392
#define XCD_BAR_WORDS 3456
#define XB_SPIN_CAP (1u << 24)

__device__ __forceinline__ unsigned xb_ld(unsigned* p)              { return __hip_atomic_load(p, __ATOMIC_RELAXED, __HIP_MEMORY_SCOPE_AGENT); }
__device__ __forceinline__ unsigned xb_add(unsigned* p, unsigned v) { return __hip_atomic_fetch_add(p, v, __ATOMIC_RELAXED, __HIP_MEMORY_SCOPE_AGENT); }
__device__ __forceinline__ unsigned xb_xcc_id() { return (unsigned)__builtin_amdgcn_s_getreg((3 << 11) | 20) & 0xFu; }
#define XB_SPIN(cond, bar) do { unsigned _sp = 0; while (cond) { __builtin_amdgcn_s_sleep(1); \
    if ((++_sp & 255u) == 0u) { if (xb_ld(&(bar)[XB_TMO])) break; if (_sp > XB_SPIN_CAP) { atomicAdd(&(bar)[XB_TMO], 1u); break; } } } } while (0)

struct XcdBarrier { unsigned* bar; unsigned x; volatile LAS unsigned* st; };

__device__ __forceinline__ XcdBarrier xcd_barrier_post(unsigned* bar, volatile LAS unsigned* st) {
    XcdBarrier b; b.bar = bar; b.x = xb_xcc_id(); b.st = st;
    if (threadIdx.x == 0) (void)xb_add(&bar[XB_XCNT(b.x)], 1u);
    return b;
}
__device__ __forceinline__ void xcd_barrier_complete(unsigned* bar, unsigned x, unsigned& nloc, unsigned& nx) {
    const unsigned G = gridDim.x * gridDim.y * gridDim.z;
    unsigned sum, cnt, mine, sp = 0u;
    for (;;) {
        sum = 0u; cnt = 0u; mine = 0u;
#pragma unroll
        for (unsigned j = 0; j < 16; ++j) { const unsigned c = xb_ld(&bar[XB_XCNT(j)]); sum += c; cnt += (c > 0u) ? 1u : 0u; mine = (j == x) ? c : mine; }
        if (sum == G) break;
        __builtin_amdgcn_s_sleep(1);
        if ((++sp & 255u) == 0u) { if (xb_ld(&bar[XB_TMO])) break; if (sp > XB_SPIN_CAP) { atomicAdd(&bar[XB_TMO], 1u); break; } }
    }
    nloc = mine > 0u ? mine : 1u; nx = cnt > 0u ? cnt : 1u;
}
__device__ __forceinline__ void xcd_barrier(const XcdBarrier& b) {
    asm volatile("s_waitcnt vmcnt(0)" ::: "memory");
    __syncthreads();
    if (threadIdx.x == 0) {
        unsigned* bar = b.bar;
        __builtin_amdgcn_s_waitcnt(0);
        unsigned nloc = b.st[0], nx = b.st[1];
        if (nloc == 0u) { xcd_barrier_complete(bar, b.x, nloc, nx); b.st[0] = nloc; b.st[1] = nx; }
        const unsigned old = xb_add(&bar[XB_XSUB(b.x)], 1u);
        const unsigned gen = old / nloc;
        if (old + 1u == (gen + 1u) * nloc) {
            __builtin_amdgcn_fence(__ATOMIC_RELEASE, "agent");
            asm volatile("s_waitcnt vmcnt(0)" ::: "memory");
            const unsigned og = xb_add(&bar[XB_TOP], 1u);
            const unsigned tg = og / nx;
            if (og + 1u == (tg + 1u) * nx) xb_add(&bar[XB_TOPGEN], 1u);
            else XB_SPIN(xb_ld(&bar[XB_TOPGEN]) == tg, bar);
            __builtin_amdgcn_fence(__ATOMIC_ACQUIRE, "agent");
            xb_add(&bar[XB_XGEN(b.x)], 1u);
            asm volatile("s_waitcnt vmcnt(0)" ::: "memory");
        } else {
            XB_SPIN(xb_ld(&bar[XB_XGEN(b.x)]) == gen, bar);
            __builtin_amdgcn_fence(__ATOMIC_ACQUIRE, "agent");
            asm volatile("s_waitcnt vmcnt(0)" ::: "memory");
        }
    }
    __syncthreads();
}

typedef unsigned short bf16;
typedef float f32x4 __attribute__((ext_vector_type(4)));
typedef float f32x16 __attribute__((ext_vector_type(16)));
typedef unsigned u32x4 __attribute__((ext_vector_type(4)));
typedef unsigned u32x2 __attribute__((ext_vector_type(2)));
typedef short bf16x8 __attribute__((ext_vector_type(8)));
typedef __bf16 bf2_t __attribute__((ext_vector_type(2)));

constexpr int NTHREADS = 512, NWAVES = 8;
constexpr int LDS_BYTES = 160 * 1024;
constexpr int MISC_OFF = LDS_BYTES - 256;
constexpr int TOK = 32768, SEQ = 16384, DM = 2048;
constexpr int EV_N = 4800, EV_NP = 4864, OD_N = 4176, OD_NP = 4352;
constexpr float ALPHA = 1.41421356237f;
constexpr size_t MiB = 1u << 20;
constexpr size_t WS_CTL = 0, CTL_ZERO_BYTES = 1 * MiB;
constexpr int CW_BAR = 4096;
constexpr size_t WS_MOD = 1 * MiB, WS_SKB = 2 * MiB, WS_WL = 4 * MiB, WS_BS = 7 * MiB, WS_CNT = 9 * MiB;
constexpr size_t WS_WINE = 10 * MiB, WS_WOUTE = 29 * MiB, WS_WINO = 37 * MiB, WS_WOUTO = 54 * MiB, WS_WQ0 = 62 * MiB, WS_WQ1 = 70 * MiB;
constexpr size_t WS_HY = 78 * MiB, WS_Z = 206 * MiB, WS_LA = 510 * MiB, WS_BIG = 542 * MiB, WS_END = 926 * MiB;

__device__ __forceinline__ float bf2f(unsigned short b) { return __uint_as_float(((unsigned)b) << 16); }
__device__ __forceinline__ unsigned f2bf(float f) { unsigned u = __float_as_uint(f); return (u + 0x7fffu + ((u >> 16) & 1u)) >> 16; }
__device__ __forceinline__ unsigned pk2(float lo, float hi) { return f2bf(lo) | (f2bf(hi) << 16); }
__device__ __forceinline__ float lo2f(unsigned w) { return __uint_as_float(w << 16); }
__device__ __forceinline__ float hi2f(unsigned w) { return __uint_as_float(w & 0xffff0000u); }
__device__ __forceinline__ float wsum(float v) {
#pragma unroll
    for (int o = 32; o >= 1; o >>= 1) v += __shfl_xor(v, o);
    return v;
}
__device__ __forceinline__ float wmax(float v) {
#pragma unroll
    for (int o = 32; o >= 1; o >>= 1) v = fmaxf(v, __shfl_xor(v, o));
    return v;
}
__device__ __forceinline__ float rdlane(float v, int l) { return __int_as_float(__builtin_amdgcn_readlane(__float_as_int(v), l)); }
__device__ __forceinline__ unsigned rdlaneu(unsigned v, int l) { return (unsigned)__builtin_amdgcn_readlane((int)v, l); }
__device__ __forceinline__ float dot2bf(unsigned a, unsigned b, float c) {
    return __builtin_amdgcn_fdot2_f32_bf16(__builtin_bit_cast(bf2_t, a), __builtin_bit_cast(bf2_t, b), c, false);
}
template <int CTRL, int RM> __device__ __forceinline__ float dppf(float v) {
    return __int_as_float(__builtin_amdgcn_update_dpp(0, __float_as_int(v), CTRL, RM, 0xF, false));
}
__device__ __forceinline__ float wsum_dpp(float v) {
    v += dppf<0xB1, 0xF>(v);
    v += dppf<0x4E, 0xF>(v);
    v += dppf<0x141, 0xF>(v);
    v += dppf<0x140, 0xF>(v);
    v += dppf<0x142, 0xA>(v);
    v += dppf<0x143, 0xC>(v);
    return rdlane(v, 63);
}
__device__ __forceinline__ float sigmoidf_(float x) { return 1.0f / (1.0f + expf(-x)); }
__device__ __forceinline__ unsigned ordkey(float f) { const unsigned u = __float_as_uint(f); return (u & 0x80000000u) ? ~u : (u | 0x80000000u); }
__device__ __forceinline__ float unordkey(unsigned k) { return __uint_as_float((k & 0x80000000u) ? (k & 0x7fffffffu) : ~k); }

struct Args { const void* in[27]; float* out; unsigned char* ws; int ph_lo, ph_hi; };
struct Frame { LAS unsigned char* lds; int tid, lane, wave, bx, G, gw, ngw; };

struct EpiLora {
    static constexpr bool PERM = true, AFTER_DRAIN = false;
    pg8::bf16_t* O; int ldc; const float* w0; const float* a0;
    __device__ __forceinline__ void operator()(const pg8::f32x4 (&acc)[2][2][4][2], const pg8::Unit& u, int wr, int wc, int fr, int fq) const {
        const int row0 = u.pm * 256 + wr * 64 + fr; const int colt = u.pn * 256; const int type = u.pn >> 2;
        const int col0 = colt + wc * 32 + 8 * fq, ncol0 = col0 & 1023;
        const float* pv = (type == 0) ? w0 : a0;
        pg8::f32x4 bv[2][2];
#pragma unroll
        for (int bj = 0; bj < 2; ++bj)
#pragma unroll
            for (int n = 0; n < 2; ++n) bv[bj][n] = (type < 2) ? *(const pg8::f32x4*)(pv + ncol0 + bj * 128 + 4 * n) : (pg8::f32x4){0.f, 0.f, 0.f, 0.f};
#pragma unroll
        for (int ai = 0; ai < 2; ++ai)
#pragma unroll
            for (int m = 0; m < 4; ++m) { pg8::bf16_t* rowp = O + (size_t)(row0 + ai * 128 + m * 16) * ldc + col0;
#pragma unroll
                for (int bj = 0; bj < 2; ++bj) { pg8::f32x4 v0 = acc[ai][bj][m][0] + bv[bj][0], v1 = acc[ai][bj][m][1] + bv[bj][1];
                    if (type < 2) {
                        const float sc = (type == 0) ? 0.60653066f : 1.0f;
#pragma unroll
                        for (int j = 0; j < 4; ++j) { v0[j] = sc / (1.0f + __expf(-v0[j])); v1[j] = sc / (1.0f + __expf(-v1[j])); }
                    }
                    pg8::u32x4 w; w.x = pg8::cvt_pk_bf16(v0[0], v0[1]); w.y = pg8::cvt_pk_bf16(v0[2], v0[3]); w.z = pg8::cvt_pk_bf16(v1[0], v1[1]); w.w = pg8::cvt_pk_bf16(v1[2], v1[3]);
                    *(pg8::u32x4*)(rowp + bj * 128) = w; } }
    }
};

__device__ __forceinline__ void transpose_item(const float* W, int K, int N, int Npad, bf16* WT, LAS float* scr, int item, int lane) {
    const int nblk = Npad / 32, kb = item / nblk, nb = item % nblk, k0 = 64 * kb, n0 = 32 * nb;
    const int nl = lane & 31; const bool ok = (n0 + nl) < N;
#pragma unroll 8
    for (int i = 0; i < 32; ++i) { const int kk = 2 * i + (lane >> 5); scr[kk * 33 + nl] = ok ? W[(size_t)(k0 + kk) * N + n0 + nl] : 0.f; }
    asm volatile("s_waitcnt lgkmcnt(0)" ::: "memory");
    const int c = lane & 7;
#pragma unroll
    for (int j = 0; j < 4; ++j) { const int n = (lane >> 3) + 8 * j; const LAS float* s = scr + (8 * c) * 33 + n;
        u32x4 o; o.x = pk2(s[0 * 33], s[1 * 33]); o.y = pk2(s[2 * 33], s[3 * 33]); o.z = pk2(s[4 * 33], s[5 * 33]); o.w = pk2(s[6 * 33], s[7 * 33]);
        *(u32x4*)(WT + (size_t)(n0 + n) * K + k0 + 8 * c) = o; }
    asm volatile("s_waitcnt lgkmcnt(0)" ::: "memory");
}

__device__ __forceinline__ void ph_prologue(const Args& A, Frame& F) {
    unsigned char* ws = A.ws;
    {
        const float* c = (const float*)A.in[1]; const float* mw = (const float*)A.in[19]; const float* mb = (const float*)A.in[20];
        float* MOD = (float*)(ws + WS_MOD);
        LAS float* red = (LAS float*)F.lds;
        for (int it = F.bx; it < 96; it += F.G) {
            const int s = it / 24, cc = it % 24, col = cc * 256 + F.lane * 4;
            const float* W = mw + (size_t)s * 2048 * 6144 + col;
            f32x4 a0 = {0.f, 0.f, 0.f, 0.f}, a1 = {0.f, 0.f, 0.f, 0.f};
            const int k0 = F.wave * 256;
#pragma unroll 8
            for (int k = k0; k < k0 + 256; ++k) {
                float c0 = c[k], c1 = c[2048 + k];
                c0 = c0 / (1.0f + expf(-c0)); c1 = c1 / (1.0f + expf(-c1));
                const f32x4 w = *(const f32x4*)(W + (size_t)k * 6144);
                a0 += c0 * w; a1 += c1 * w;
            }
            *(LAS f32x4*)(red + ((F.wave * 2 + 0) * 256 + F.lane * 4)) = a0;
            *(LAS f32x4*)(red + ((F.wave * 2 + 1) * 256 + F.lane * 4)) = a1;
            __syncthreads();
            { const int b = F.tid >> 8, cl = F.tid & 255; float sm = 0.f;
#pragma unroll
              for (int w = 0; w < 8; ++w) sm += red[(w * 2 + b) * 256 + cl];
              MOD[(size_t)(s * 2 + b) * 6144 + cc * 256 + cl] = sm + mb[s * 6144 + cc * 256 + cl]; }
            __syncthreads();
        }
    }
    {
        LAS float* scr = (LAS float*)(F.lds + 16384 + F.wave * 8704);
        constexpr int I0 = 32 * (EV_NP / 32), I1 = 32 * 64, I2 = 32 * (OD_NP / 32);
        constexpr int NIT = I0 + I1 + I2 + 3 * I1;
        for (int it = F.gw; it < NIT; it += F.ngw) {
            int r = it;
            if (r < I0) { transpose_item((const float*)A.in[3], 2048, EV_N, EV_NP, (bf16*)(ws + WS_WINE), scr, r, F.lane); continue; } r -= I0;
            if (r < I1) { transpose_item((const float*)A.in[4], 2048, 2048, 2048, (bf16*)(ws + WS_WOUTE), scr, r, F.lane); continue; } r -= I1;
            if (r < I2) { transpose_item((const float*)A.in[17], 2048, OD_N, OD_NP, (bf16*)(ws + WS_WINO), scr, r, F.lane); continue; } r -= I2;
            if (r < I1) { transpose_item((const float*)A.in[18], 2048, 2048, 2048, (bf16*)(ws + WS_WOUTO), scr, r, F.lane); continue; } r -= I1;
            if (r < I1) { transpose_item((const float*)A.in[23], 2048, 2048, 2048, (bf16*)(ws + WS_WQ0), scr, r, F.lane); continue; } r -= I1;
            transpose_item((const float*)A.in[23] + (size_t)2048 * 2048, 2048, 2048, 2048, (bf16*)(ws + WS_WQ1), scr, r, F.lane);
        }
    }
    {
        const float* w2 = (const float*)A.in[8]; const float* a2 = (const float*)A.in[10]; const float* g2 = (const float*)A.in[11];
        bf16* WL = (bf16*)(ws + WS_WL);
        const int gt = F.bx * NTHREADS + F.tid, ngt = F.G * NTHREADS;
        for (int i = gt; i < 3072 * 512; i += ngt) {
            const int n = i >> 9, k = i & 511; float v = 0.f;
            if (n < 1024) { if (k < 96) v = w2[k * 1024 + n]; }
            else if (n < 2048) { if (k >= 96 && k < 192) v = a2[(k - 96) * 1024 + (n - 1024)]; }
            else { if (k >= 192 && k < 448) v = g2[(k - 192) * 1024 + (n - 2048)]; }
            WL[i] = (bf16)f2bf(v);
        }
        const float* sk = (const float*)A.in[24]; bf16* SKB = (bf16*)(ws + WS_SKB);
        for (int i = gt; i < 2 * 262144; i += ngt) SKB[i] = (bf16)f2bf(sk[i]);
    }
}

__device__ __forceinline__ void ph_mod_x(const Args& A, Frame& F) {
    const float* x = (const float*)A.in[0]; const float* MOD = (const float*)(A.ws + WS_MOD); bf16* H = (bf16*)(A.ws + WS_HY);
    for (int t = F.gw; t < TOK; t += F.ngw) {
        const int b = t >> 14; const float* sh = MOD + (size_t)(0 * 2 + b) * 6144; const float* sc = sh + 2048;
#pragma unroll
        for (int j = 0; j < 8; ++j) { const int idx = j * 256 + F.lane * 4;
            const f32x4 xv = *(const f32x4*)(x + (size_t)t * DM + idx), sv = *(const f32x4*)(sc + idx), hv = *(const f32x4*)(sh + idx);
            const f32x4 o = xv * (1.0f + sv) + hv; u32x2 w; w.x = pk2(o[0], o[1]); w.y = pk2(o[2], o[3]);
            *(u32x2*)(H + (size_t)t * DM + idx) = w; }
    }
}

__device__ __forceinline__ void ph_even_post(const Args& A, Frame& F) {
    bf16* Z = (bf16*)(A.ws + WS_Z); const int* positions = (const int*)A.in[2]; const float* mu = (const float*)A.in[6];
    bf16* RKV = (bf16*)A.out; bf16* LAp = (bf16*)(A.ws + WS_LA);
    const int i = F.lane & 31; const float inv = powf(10000.0f, -(float)i / 32.0f);
    for (int t = F.gw; t < TOK; t += F.ngw) {
        const int s = t & (SEQ - 1); bf16* zr = Z + (size_t)t * EV_NP;
        float sn, cs; sincosf((float)positions[t] * inv, &sn, &cs);
#pragma unroll
        for (int it = 0; it < 9; ++it) { const int base = (2 * it + (F.lane >> 5)) * 64;
            const float t1 = bf2f(zr[base + i]), t2 = bf2f(zr[base + 32 + i]);
            zr[base + i] = (bf16)f2bf(t1 * cs - t2 * sn); zr[base + 32 + i] = (bf16)f2bf(t2 * cs + t1 * sn); }
        const bf16* zp = zr - EV_NP; const bool hasprev = s > 0;
        for (int m = 0; m < 28; ++m) { const int j = 2 * F.lane + 128 * m; if (j < 3520) {
            const unsigned cw = *(const unsigned*)(zr + 1280 + j); const unsigned pw = hasprev ? *(const unsigned*)(zp + 1280 + j) : 0u;
            const float m0 = mu[j], m1 = mu[j + 1];
            const float c0 = lo2f(cw), c1 = hi2f(cw), p0 = lo2f(pw), p1 = hi2f(pw);
            const float v0 = c0 + (p0 - c0) * m0, v1 = c1 + (p1 - c1) * m1;
            if (j < 3072) { const int which = j >> 10, jj = j & 1023; *(unsigned*)(RKV + (size_t)which * TOK * 1024 + (size_t)t * 1024 + jj) = pk2(v0, v1); }
            else if (j < 3168) { *(unsigned*)(LAp + (size_t)t * 512 + (j - 3072)) = pk2(tanhf(v0), tanhf(v1)); }
            else if (j < 3264) { *(unsigned*)(LAp + (size_t)t * 512 + 96 + (j - 3168)) = pk2(v0, v1); }
            else { *(unsigned*)(LAp + (size_t)t * 512 + 192 + (j - 3264)) = pk2(sigmoidf_(v0), sigmoidf_(v1)); }
        } }
        if (F.lane < 32) *(unsigned*)(LAp + (size_t)t * 512 + 448 + 2 * F.lane) = 0u;
    }
}

__device__ __forceinline__ void ph_scan_pack(const Args& A, Frame& F) {
    const bf16* Z = (const bf16*)(A.ws + WS_Z); const bf16* RKV = (const bf16*)A.out;
    const float* k_k = (const float*)A.in[12]; const float* k_a = (const float*)A.in[13]; const float* r_k = (const float*)A.in[14];
    unsigned* PK = (unsigned*)(A.ws + WS_BIG); float* BS = (float*)(A.ws + WS_BS);
    for (int it = F.gw; it < TOK * 16; it += F.ngw) {
        const int t = it >> 4, h = it & 15, c = h * 64 + F.lane, b = t >> 14, s = t & (SEQ - 1);
        const float r = bf2f(RKV[(size_t)t * 1024 + c]), kr = bf2f(RKV[(size_t)TOK * 1024 + (size_t)t * 1024 + c]), v = bf2f(RKV[(size_t)2 * TOK * 1024 + (size_t)t * 1024 + c]);
        const float e = bf2f(Z[(size_t)t * EV_NP + 1280 + c]), a = bf2f(Z[(size_t)t * EV_NP + 1280 + 1024 + c]);
        const float kkv = kr * k_k[c]; const float ss = wsum(kkv * kkv); const float kkn = kkv / fmaxf(sqrtf(ss), 1e-12f);
        const float kp = kr * (1.0f + (a - 1.0f) * k_a[c]); const float kka = kkn * a;
        const float bsum = wsum(r * kp * r_k[c]);
        if (F.lane == 0) BS[(size_t)t * 16 + h] = bsum;
        unsigned* dst = PK + ((size_t)((b * 16 + h) * SEQ + s) * 64 + F.lane) * 3;
        dst[0] = pk2(r, e); dst[1] = pk2(kp, kkn); dst[2] = pk2(kka, v);
    }
}

__device__ __forceinline__ void ph_swa(const Args& A, Frame& F) {
    const bf16* Z = (const bf16*)(A.ws + WS_Z); bf16* Y = (bf16*)(A.ws + WS_HY); const float* sinks = (const float*)A.in[5];
    LAS unsigned char* KL = F.lds; LAS unsigned char* VL = F.lds + 256 * 136;
    for (int u = F.bx; u < 512; u += F.G) {
        const int b = u >> 8, n = (u >> 1) & 127, kvh = u & 1;
        __syncthreads();
        for (int c = F.tid; c < 2048; c += NTHREADS) { const int jw = c >> 3, cc = c & 7; const int s = n * 128 - 128 + jw;
            u32x4 kv = {0u, 0u, 0u, 0u}, vv = {0u, 0u, 0u, 0u};
            if (s >= 0) { const bf16* row = Z + (size_t)(b * SEQ + s) * EV_NP; kv = *(const u32x4*)(row + 1024 + kvh * 64 + cc * 8); vv = *(const u32x4*)(row + 1152 + kvh * 64 + cc * 8); }
            *(LAS u32x2*)(KL + jw * 136 + cc * 16) = (u32x2){kv.x, kv.y}; *(LAS u32x2*)(KL + jw * 136 + cc * 16 + 8) = (u32x2){kv.z, kv.w};
            *(LAS u32x2*)(VL + jw * 136 + cc * 16) = (u32x2){vv.x, vv.y}; *(LAS u32x2*)(VL + jw * 136 + cc * 16 + 8) = (u32x2){vv.z, vv.w}; }
        __syncthreads();
        for (int it = F.wave; it < 1024; it += NWAVES) {
            const int i = it >> 3, g = it & 7, head = kvh * 8 + g; const int t = b * SEQ + n * 128 + i;
            const float qv = bf2f(Z[(size_t)t * EV_NP + head * 64 + F.lane]) * 0.125f;
            const int jw0 = i + 1 + F.lane, jw1 = jw0 + 64;
            const bool val0 = (n > 0) || (jw0 >= 128), val1 = (n > 0) || (jw1 >= 128);
            float s0 = 0.f, s1 = 0.f;
#pragma unroll
            for (int d4 = 0; d4 < 16; ++d4) {
                const u32x2 k0 = *(const LAS u32x2*)(KL + jw0 * 136 + d4 * 8), k1 = *(const LAS u32x2*)(KL + jw1 * 136 + d4 * 8);
                const float q0 = rdlane(qv, 4 * d4), q1 = rdlane(qv, 4 * d4 + 1), q2 = rdlane(qv, 4 * d4 + 2), q3 = rdlane(qv, 4 * d4 + 3);
                s0 += q0 * lo2f(k0.x) + q1 * hi2f(k0.x) + q2 * lo2f(k0.y) + q3 * hi2f(k0.y);
                s1 += q0 * lo2f(k1.x) + q1 * hi2f(k1.x) + q2 * lo2f(k1.y) + q3 * hi2f(k1.y);
            }
            const float sink = sinks[head];
            s0 = val0 ? s0 : -INFINITY; s1 = val1 ? s1 : -INFINITY;
            const float mx = fmaxf(wmax(fmaxf(s0, s1)), sink);
            float p0 = val0 ? expf(s0 - mx) : 0.f, p1 = val1 ? expf(s1 - mx) : 0.f;
            const float den = wsum(p0 + p1) + expf(sink - mx); const float rden = 1.0f / den;
            p0 *= rden; p1 *= rden;
            float o = 0.f;
            const LAS bf16* vcol = (const LAS bf16*)VL + F.lane;
#pragma unroll 8
            for (int jj = 0; jj < 64; ++jj) o += rdlane(p0, jj) * bf2f(vcol[(i + 1 + jj) * 68]);
#pragma unroll 8
            for (int jj = 0; jj < 64; ++jj) o += rdlane(p1, jj) * bf2f(vcol[(i + 65 + jj) * 68]);
            Y[(size_t)t * DM + head * 64 + F.lane] = (bf16)f2bf(o);
        }
    }
}

__device__ __forceinline__ void ph_scan(const Args& A, Frame& F) {
    const unsigned* PK = (const unsigned*)(A.ws + WS_BIG); bf16* YRAW = (bf16*)A.out + (size_t)3 * TOK * 1024;
    for (int rr = F.gw; rr < 2048; rr += F.ngw) {
        const int bh = rr >> 6, vrow = rr & 63;
        const unsigned* pk = PK + ((size_t)bh * SEQ * 64 + F.lane) * 3;
        bf16* yout = YRAW + ((size_t)bh * 64 + vrow) * SEQ;
        float S = 0.f;
        for (int t0 = 0; t0 < SEQ; t0 += 64) {
            float yk = 0.f;
#pragma unroll 8
            for (int j = 0; j < 64; ++j) {
                const unsigned* p = pk + (size_t)(t0 + j) * 192;
                const unsigned w0 = p[0], w1 = p[1], w2 = p[2];
                const float r = lo2f(w0), e = hi2f(w0), kp = lo2f(w1), kk = hi2f(w1), kka = lo2f(w2), vv = hi2f(w2);
                const float vs = rdlane(vv, vrow);
                const float dec = __expf(-e);
                const float sa = -wsum_dpp(S * kk);
                S = S * dec + sa * kka + vs * kp;
                const float y = wsum_dpp(S * r);
                yk = (F.lane == j) ? y : yk;
            }
            yout[t0 + F.lane] = (bf16)f2bf(yk);
        }
    }
}

__device__ __forceinline__ void ph_rwkv_finish(const Args& A, Frame& F) {
    const bf16* Z = (const bf16*)(A.ws + WS_Z); const bf16* RKV = (const bf16*)A.out; const bf16* YRAW = (const bf16*)A.out + (size_t)3 * TOK * 1024;
    const float* BS = (const float*)(A.ws + WS_BS); bf16* Y = (bf16*)(A.ws + WS_HY);
    const float* lnx_g = (const float*)A.in[15]; const float* lnx_b = (const float*)A.in[16];
    LAS float* tile = (LAS float*)(F.lds + F.wave * 16640);
    for (int it = F.gw; it < 8192; it += F.ngw) {
        const int bh = it >> 8, tb = it & 255, b = bh >> 4, h = bh & 15, t0 = tb * 64;
        for (int vr = 0; vr < 64; ++vr) tile[vr * 65 + F.lane] = bf2f(YRAW[((size_t)bh * 64 + vr) * SEQ + t0 + F.lane]);
        asm volatile("s_waitcnt lgkmcnt(0)" ::: "memory");
        const int c = h * 64 + F.lane; const float lg = lnx_g[c], lb = lnx_b[c];
        for (int j = 0; j < 64; ++j) {
            const int t = b * SEQ + t0 + j;
            const float y = tile[F.lane * 65 + j];
            const float mean = wsum(y) * (1.0f / 64.0f); const float d = y - mean; const float var = wsum(d * d) * (1.0f / 64.0f);
            const float yn = d * rsqrtf(var + 64e-5f) * lg + lb;
            const float vv = bf2f(RKV[(size_t)2 * TOK * 1024 + (size_t)t * 1024 + c]); const float g = bf2f(Z[(size_t)t * EV_NP + 1280 + 2048 + c]); const float bs = BS[(size_t)t * 16 + h];
            Y[(size_t)t * DM + 1024 + c] = (bf16)f2bf((yn + bs * vv) * g);
        }
        asm volatile("s_waitcnt lgkmcnt(0)" ::: "memory");
    }
}

__device__ __forceinline__ void ph_ln_mixer(const Args& A, Frame& F, const int L) {
    const float* xsrc = (L == 0) ? (const float*)A.in[0] : (const float*)A.out; float* xdst = A.out;
    const bf16* O = (const bf16*)(A.ws + WS_Z); bf16* H = (bf16*)(A.ws + WS_HY); const float* MOD = (const float*)(A.ws + WS_MOD);
    const float* lng = (const float*)A.in[21] + (size_t)(L * 2 + 0) * DM; const float* lnb = (const float*)A.in[22] + (size_t)(L * 2 + 0) * DM;
    for (int t = F.gw; t < TOK; t += F.ngw) {
        const int b = t >> 14;
        const float* gate = MOD + (size_t)((L * 2 + 0) * 2 + b) * 6144 + 4096;
        const float* sh = MOD + (size_t)((L * 2 + 1) * 2 + b) * 6144; const float* sc = sh + 2048;
        float v[32]; float sum = 0.f;
#pragma unroll
        for (int j = 0; j < 4; ++j) { const int base = (j * 64 + F.lane) * 8;
            const u32x4 ow = *(const u32x4*)(O + (size_t)t * DM + base);
            const f32x4 x0 = *(const f32x4*)(xsrc + (size_t)t * DM + base), x1 = *(const f32x4*)(xsrc + (size_t)t * DM + base + 4);
            const f32x4 g0 = *(const f32x4*)(gate + base), g1 = *(const f32x4*)(gate + base + 4);
            const float of[8] = {lo2f(ow.x), hi2f(ow.x), lo2f(ow.y), hi2f(ow.y), lo2f(ow.z), hi2f(ow.z), lo2f(ow.w), hi2f(ow.w)};
#pragma unroll
            for (int e = 0; e < 4; ++e) { v[j * 8 + e] = ALPHA * x0[e] + (1.0f + g0[e]) * of[e]; v[j * 8 + 4 + e] = ALPHA * x1[e] + (1.0f + g1[e]) * of[4 + e]; }
#pragma unroll
            for (int e = 0; e < 8; ++e) sum += v[j * 8 + e]; }
        const float mean = wsum(sum) * (1.0f / DM); float sq = 0.f;
#pragma unroll
        for (int e = 0; e < 32; ++e) { v[e] -= mean; sq += v[e] * v[e]; }
        const float rstd = rsqrtf(wsum(sq) * (1.0f / DM) + 1e-5f);
#pragma unroll
        for (int j = 0; j < 4; ++j) { const int base = (j * 64 + F.lane) * 8;
            const f32x4 lg0 = *(const f32x4*)(lng + base), lg1 = *(const f32x4*)(lng + base + 4), lb0 = *(const f32x4*)(lnb + base), lb1 = *(const f32x4*)(lnb + base + 4);
            const f32x4 s0 = *(const f32x4*)(sc + base), s1 = *(const f32x4*)(sc + base + 4), h0 = *(const f32x4*)(sh + base), h1 = *(const f32x4*)(sh + base + 4);
            f32x4 o0, o1;
#pragma unroll
            for (int e = 0; e < 4; ++e) { o0[e] = v[j * 8 + e] * rstd * lg0[e] + lb0[e]; o1[e] = v[j * 8 + 4 + e] * rstd * lg1[e] + lb1[e]; }
            *(f32x4*)(xdst + (size_t)t * DM + base) = o0; *(f32x4*)(xdst + (size_t)t * DM + base + 4) = o1;
            const f32x4 q0 = o0 * (1.0f + s0) + h0, q1 = o1 * (1.0f + s1) + h1;
            u32x4 w; w.x = pk2(q0[0], q0[1]); w.y = pk2(q0[2], q0[3]); w.z = pk2(q1[0], q1[1]); w.w = pk2(q1[2], q1[3]);
            *(u32x4*)(H + (size_t)t * DM + base) = w; }
    }
    {
        const float* pu = (const float*)A.in[25] + (size_t)L * 16384 * 2048; const float* pv = (const float*)A.in[26] + (size_t)L * 16384 * 2048;
        unsigned char* T8 = A.ws + WS_BIG; float* SCL = (float*)(A.ws + WS_BIG + 64 * MiB);
        for (int r = F.gw; r < 32768; r += F.ngw) {
            const float* src = ((r < 16384) ? pu : pv) + (size_t)(r & 16383) * 2048;
            f32x4 f[2][4]; float amax = 0.f;
#pragma unroll
            for (int j = 0; j < 2; ++j)
#pragma unroll
                for (int c = 0; c < 4; ++c) { f[j][c] = *(const f32x4*)(src + (j * 64 + F.lane) * 16 + 4 * c);
                    amax = fmaxf(amax, fmaxf(fmaxf(fabsf(f[j][c][0]), fabsf(f[j][c][1])), fmaxf(fabsf(f[j][c][2]), fabsf(f[j][c][3])))); }
            amax = wmax(amax);
            int k = 0; if (amax > 0.f) { k = ilogbf(224.0f / amax); k = k < -100 ? -100 : (k > 100 ? 100 : k); }
            const float scl = ldexpf(1.0f, k);
#pragma unroll
            for (int j = 0; j < 2; ++j) { u32x4 w; unsigned ww[4];
#pragma unroll
                for (int c = 0; c < 4; ++c) { int q = __builtin_amdgcn_cvt_pk_fp8_f32(f[j][c][0] * scl, f[j][c][1] * scl, 0, false); q = __builtin_amdgcn_cvt_pk_fp8_f32(f[j][c][2] * scl, f[j][c][3] * scl, q, true); ww[c] = (unsigned)q; }
                w.x = ww[0]; w.y = ww[1]; w.z = ww[2]; w.w = ww[3];
                *(u32x4*)(T8 + (size_t)r * 2048 + (j * 64 + F.lane) * 16) = w; }
            if (F.lane == 0) SCL[r] = ldexpf(1.0f, -k);
        }
    }
}

template <int NV> __device__ __forceinline__ unsigned wave_tau16(const unsigned (&key)[NV]) {
    unsigned tau = 0u;
#pragma unroll 1
    for (int bit = 31; bit >= 0; --bit) {
        const unsigned cand = tau | (1u << bit); int cnt = 0;
#pragma unroll
        for (int v = 0; v < NV; ++v) cnt += __popcll(__ballot(key[v] >= cand));
        if (cnt >= 16) tau = cand;
    }
    return tau;
}
template <int NV> __device__ __forceinline__ void wave_compact16(const unsigned (&key)[NV], const int (&id)[NV], unsigned tau, LAS float* ov, LAS int* oi, int lane) {
    int ngt = 0;
#pragma unroll
    for (int v = 0; v < NV; ++v) ngt += __popcll(__ballot(key[v] > tau));
    int bg = 0, be = 0;
#pragma unroll
    for (int v = 0; v < NV; ++v) {
        const bool gt = key[v] > tau, eq = key[v] == tau;
        const unsigned long long mg = __ballot(gt), me = __ballot(eq);
        const unsigned long long below = (lane == 0) ? 0ull : ((~0ull) >> (64 - lane));
        const int pg = bg + __popcll(mg & below), pe = ngt + be + __popcll(me & below);
        if (gt) { ov[pg] = unordkey(key[v]); oi[pg] = id[v]; }
        if (eq && pe < 16) { ov[pe] = unordkey(key[v]); oi[pe] = id[v]; }
        bg += __popcll(mg); be += __popcll(me);
    }
}

__device__ __forceinline__ void ph_peer_select(const Args& A, Frame& F, const int L) {
    const bf16* QP = (const bf16*)(A.ws + WS_Z); const bf16* SKB = (const bf16*)(A.ws + WS_SKB) + (size_t)L * 262144;
    int* EID = (int*)(A.ws + WS_LA); float* GSM = (float*)(A.ws + WS_LA + 16 * MiB);
    LAS unsigned char* SKL = F.lds;
    LAS float* tv = (LAS float*)(F.lds + 69632 + F.wave * 512);
    LAS int* ti = (LAS int*)(F.lds + 69632 + F.wave * 512 + 128);
    LAS float* cv = (LAS float*)(F.lds + 69632 + F.wave * 512 + 256);
    LAS int* ci = (LAS int*)(F.lds + 69632 + F.wave * 512 + 320);
    for (int it = F.bx; it < 4096; it += F.G) {
        const int tile = it >> 3, h = it & 7;
        __syncthreads();
        for (int c = F.tid; c < 4096; c += NTHREADS) { const int p = c >> 11, n = (c >> 4) & 127, cc = c & 15;
            *(LAS u32x4*)(SKL + (p * 128 + n) * 272 + cc * 16) = *(const u32x4*)(SKB + ((size_t)((p * 8 + h) * 128 + n)) * 128 + cc * 8); }
        __syncthreads();
        for (int tk = 0; tk < 8; ++tk) {
            const int t = tile * 64 + F.wave * 8 + tk;
#pragma unroll
            for (int p = 0; p < 2; ++p) {
                const unsigned qv = *(const unsigned*)(QP + (size_t)t * DM + h * 256 + p * 128 + 2 * F.lane);
                float s0 = 0.f, s1 = 0.f;
                const LAS unsigned char* r0 = SKL + (p * 128 + F.lane) * 272; const LAS unsigned char* r1 = r0 + 64 * 272;
#pragma unroll
                for (int c16 = 0; c16 < 16; ++c16) {
                    const u32x4 k0 = *(const LAS u32x4*)(r0 + c16 * 16), k1 = *(const LAS u32x4*)(r1 + c16 * 16);
                    const unsigned q0 = rdlaneu(qv, c16 * 4), q1 = rdlaneu(qv, c16 * 4 + 1), q2 = rdlaneu(qv, c16 * 4 + 2), q3 = rdlaneu(qv, c16 * 4 + 3);
                    s0 = dot2bf(q0, k0.x, s0); s0 = dot2bf(q1, k0.y, s0); s0 = dot2bf(q2, k0.z, s0); s0 = dot2bf(q3, k0.w, s0);
                    s1 = dot2bf(q0, k1.x, s1); s1 = dot2bf(q1, k1.y, s1); s1 = dot2bf(q2, k1.z, s1); s1 = dot2bf(q3, k1.w, s1);
                }
                const unsigned key[2] = {ordkey(s0), ordkey(s1)}; const int id[2] = {F.lane, F.lane + 64};
                const unsigned tau = wave_tau16<2>(key);
                wave_compact16<2>(key, id, tau, tv + p * 16, ti + p * 16, F.lane);
            }
            asm volatile("s_waitcnt lgkmcnt(0)" ::: "memory"); __builtin_amdgcn_wave_barrier();
            unsigned ck[4]; int cid[4];
#pragma unroll
            for (int m = 0; m < 4; ++m) { const int c = F.lane * 4 + m; cid[m] = c; ck[m] = ordkey(tv[c >> 4] + tv[16 + (c & 15)]); }
            const unsigned tau2 = wave_tau16<4>(ck);
            wave_compact16<4>(ck, cid, tau2, cv, ci, F.lane);
            asm volatile("s_waitcnt lgkmcnt(0)" ::: "memory"); __builtin_amdgcn_wave_barrier();
            const float bv = (F.lane < 16) ? cv[F.lane] : -INFINITY; const int bc = (F.lane < 16) ? ci[F.lane] : 0;
            const float mx = wmax(bv); const float ev = (F.lane < 16) ? expf(bv - mx) : 0.f; const float den = wsum(ev);
            if (F.lane < 16) { const int e1 = ti[bc >> 4], e2 = ti[16 + (bc & 15)];
                EID[(size_t)t * 128 + h * 16 + F.lane] = e1 * 128 + e2; GSM[(size_t)t * 128 + h * 16 + F.lane] = ev / den; }
            asm volatile("s_waitcnt lgkmcnt(0)" ::: "memory"); __builtin_amdgcn_wave_barrier();
        }
    }
}

typedef float f32x2 __attribute__((ext_vector_type(2)));
constexpr int PGB = 4;
__device__ __forceinline__ void ph_peer_gather(const Args& A, Frame& F, const int L, const bool dry = false) {
    bf16* H = (bf16*)(A.ws + WS_HY); bf16* Hout = dry ? (bf16*)(A.ws + WS_BIG + 128 * MiB) : H; float* Xout = dry ? (float*)(A.ws + WS_Z) : A.out; const unsigned char* TU = A.ws + WS_BIG; const unsigned char* TV = TU + (size_t)16384 * 2048; const float* SCL = (const float*)(A.ws + WS_BIG + 64 * MiB);
    const int* EID = (const int*)(A.ws + WS_LA); const float* GSM = (const float*)(A.ws + WS_LA + 16 * MiB);
    const float* MOD = (const float*)(A.ws + WS_MOD); float* X = A.out;
    const float* lng = (const float*)A.in[21] + (size_t)(L * 2 + 1) * DM; const float* lnb = (const float*)A.in[22] + (size_t)(L * 2 + 1) * DM;
    for (int t = F.gw; t < TOK; t += F.ngw) {
        const int b = t >> 14;
        f32x2 h2[16];
#pragma unroll
        for (int j = 0; j < 2; ++j) { const u32x4 a = *(const u32x4*)(H + (size_t)t * DM + (j * 64 + F.lane) * 16), c = *(const u32x4*)(H + (size_t)t * DM + (j * 64 + F.lane) * 16 + 8);
            const unsigned aw[8] = {a.x, a.y, a.z, a.w, c.x, c.y, c.z, c.w};
#pragma unroll
            for (int q = 0; q < 8; ++q) h2[j * 8 + q] = (f32x2){lo2f(aw[q]), hi2f(aw[q])}; }
        f32x2 o2[16];
#pragma unroll
        for (int e = 0; e < 16; ++e) o2[e] = (f32x2){0.f, 0.f};
#pragma unroll 1
        for (int e0 = 0; e0 < 128; e0 += PGB) {
            int eid[PGB]; float gw[PGB], su[PGB], sv[PGB];
#pragma unroll
            for (int q = 0; q < PGB; ++q) { eid[q] = __builtin_amdgcn_readfirstlane(EID[(size_t)t * 128 + e0 + q]); gw[q] = GSM[(size_t)t * 128 + e0 + q]; su[q] = SCL[eid[q]]; sv[q] = SCL[16384 + eid[q]]; }
            u32x4 uu[PGB][2], vv[PGB][2];
#pragma unroll
            for (int q = 0; q < PGB; ++q)
#pragma unroll
                for (int j = 0; j < 2; ++j) { uu[q][j] = *(const u32x4*)(TU + (size_t)eid[q] * 2048 + (j * 64 + F.lane) * 16); vv[q][j] = *(const u32x4*)(TV + (size_t)eid[q] * 2048 + (j * 64 + F.lane) * 16); }
#pragma unroll
            for (int q = 0; q < PGB; ++q) {
                f32x2 d2 = {0.f, 0.f};
#pragma unroll
                for (int j = 0; j < 2; ++j) { const unsigned w[4] = {uu[q][j].x, uu[q][j].y, uu[q][j].z, uu[q][j].w};
#pragma unroll
                    for (int i = 0; i < 4; ++i) { const f32x2 lo = __builtin_amdgcn_cvt_pk_f32_fp8((int)w[i], false), hi = __builtin_amdgcn_cvt_pk_f32_fp8((int)w[i], true);
                        d2 = lo * h2[j * 8 + 2 * i] + d2; d2 = hi * h2[j * 8 + 2 * i + 1] + d2; } }
                const float d = wsum(d2.x + d2.y) * su[q];
                const float act = 0.5f * d * (1.0f + erff(d * 0.70710678f)) * gw[q] * sv[q];
                const f32x2 a2 = {act, act};
#pragma unroll
                for (int j = 0; j < 2; ++j) { const unsigned w[4] = {vv[q][j].x, vv[q][j].y, vv[q][j].z, vv[q][j].w};
#pragma unroll
                    for (int i = 0; i < 4; ++i) { const f32x2 lo = __builtin_amdgcn_cvt_pk_f32_fp8((int)w[i], false), hi = __builtin_amdgcn_cvt_pk_f32_fp8((int)w[i], true);
                        o2[j * 8 + 2 * i] = a2 * lo + o2[j * 8 + 2 * i]; o2[j * 8 + 2 * i + 1] = a2 * hi + o2[j * 8 + 2 * i + 1]; } }
            }
        }
        float out[32];
#pragma unroll
        for (int e = 0; e < 16; ++e) { out[2 * e] = o2[e].x; out[2 * e + 1] = o2[e].y; }
        const float* gate = MOD + (size_t)((L * 2 + 1) * 2 + b) * 6144 + 4096;
        float sum = 0.f;
#pragma unroll
        for (int j = 0; j < 2; ++j)
#pragma unroll
            for (int c = 0; c < 4; ++c) { const int base = (j * 64 + F.lane) * 16 + 4 * c;
                const f32x4 x0 = *(const f32x4*)(X + (size_t)t * DM + base), g0 = *(const f32x4*)(gate + base);
#pragma unroll
                for (int e = 0; e < 4; ++e) { const float v = ALPHA * x0[e] + (1.0f + g0[e]) * out[j * 16 + 4 * c + e]; out[j * 16 + 4 * c + e] = v; sum += v; } }
        const float mean = wsum(sum) * (1.0f / DM); float sq = 0.f;
#pragma unroll
        for (int e = 0; e < 32; ++e) { out[e] -= mean; sq += out[e] * out[e]; }
        const float rstd = rsqrtf(wsum(sq) * (1.0f / DM) + 1e-5f);
        const float* sh = MOD + (size_t)(((L + 1) * 2 + 0) * 2 + b) * 6144; const float* sc = sh + 2048;
#pragma unroll
        for (int j = 0; j < 2; ++j) {
            float hq[16];
#pragma unroll
            for (int c = 0; c < 4; ++c) { const int base = (j * 64 + F.lane) * 16 + 4 * c;
                const f32x4 lg0 = *(const f32x4*)(lng + base), lb0 = *(const f32x4*)(lnb + base);
                f32x4 o0;
#pragma unroll
                for (int e = 0; e < 4; ++e) o0[e] = out[j * 16 + 4 * c + e] * rstd * lg0[e] + lb0[e];
                *(f32x4*)(Xout + (size_t)t * DM + base) = o0;
                if (L == 0) { const f32x4 s0 = *(const f32x4*)(sc + base), h0 = *(const f32x4*)(sh + base);
#pragma unroll
                    for (int e = 0; e < 4; ++e) hq[4 * c + e] = o0[e] * (1.0f + s0[e]) + h0[e]; } }
            if (L == 0) { u32x4 w0, w1;
                w0.x = pk2(hq[0], hq[1]); w0.y = pk2(hq[2], hq[3]); w0.z = pk2(hq[4], hq[5]); w0.w = pk2(hq[6], hq[7]);
                w1.x = pk2(hq[8], hq[9]); w1.y = pk2(hq[10], hq[11]); w1.z = pk2(hq[12], hq[13]); w1.w = pk2(hq[14], hq[15]);
                *(u32x4*)(Hout + (size_t)t * DM + (j * 64 + F.lane) * 16) = w0; *(u32x4*)(Hout + (size_t)t * DM + (j * 64 + F.lane) * 16 + 8) = w1; }
        }
    }
}

__device__ __forceinline__ void ph_odd_post(const Args& A, Frame& F) {
    bf16* Z = (bf16*)(A.ws + WS_Z); const int* positions = (const int*)A.in[2];
    const float inv128 = powf(10000.0f, -(float)F.lane / 64.0f); const int i32 = F.lane & 31; const float inv64 = powf(10000.0f, -(float)i32 / 32.0f);
    for (int t = F.gw; t < TOK; t += F.ngw) {
        bf16* zr = Z + (size_t)t * OD_NP; const float pos = (float)positions[t];
        float sn, cs; sincosf(pos * inv128, &sn, &cs);
        for (int hd = 0; hd < 20; ++hd) { const int base = hd * 128;
            const float t1 = bf2f(zr[base + F.lane]), t2 = bf2f(zr[base + 64 + F.lane]);
            zr[base + F.lane] = (bf16)f2bf(t1 * cs - t2 * sn); zr[base + 64 + F.lane] = (bf16)f2bf(t2 * cs + t1 * sn); }
        sincosf(pos * inv64, &sn, &cs);
        for (int it = 0; it < 9; ++it) { const int hd = 2 * it + (F.lane >> 5); if (hd < 17) { const int base = 3072 + hd * 64;
            const float t1 = bf2f(zr[base + i32]), t2 = bf2f(zr[base + 32 + i32]);
            zr[base + i32] = (bf16)f2bf(t1 * cs - t2 * sn); zr[base + 32 + i32] = (bf16)f2bf(t2 * cs + t1 * sn); } }
    }
}

__device__ __forceinline__ float sum16_dpp(float v) {
    v += dppf<0xB1, 0xF>(v); v += dppf<0x4E, 0xF>(v); v += dppf<0x141, 0xF>(v); v += dppf<0x140, 0xF>(v);
    return v;
}
__device__ __forceinline__ void ph_dsa_select(const Args& A, Frame& F) {
    const bf16* Z = (const bf16*)(A.ws + WS_Z); unsigned short* SEL = (unsigned short*)(A.ws + WS_LA); int* CNT = (int*)(A.ws + WS_CNT);
    LAS unsigned* SC = (LAS unsigned*)F.lds;
    LAS unsigned* hist = (LAS unsigned*)(F.lds + 131072);
    LAS unsigned* res = (LAS unsigned*)(F.lds + 131072 + 2048);
    LAS int* wtot = (LAS int*)(F.lds + 131072 + 2048 + 64);
    const int r = F.lane & 31, hg = F.lane >> 5, tk = (r >> 2) & 1, hh = (r & 3) + 4 * (r >> 3);
    const int grp = F.wave >> 2, ltid = F.tid & 255, lw = F.wave & 3;
    for (int pr = F.bx; pr < TOK / 2; pr += F.G) {
        const int t0 = 2 * pr, b = t0 >> 14, s0 = t0 & (SEQ - 1);
        const int nkeys = s0 + 2, ntiles = (nkeys + 31) >> 5;
        bf16x8 af[4];
        { const bf16* qrow = Z + (size_t)(t0 + tk) * OD_NP + 3072 + hh * 64 + 8 * hg;
#pragma unroll
          for (int s = 0; s < 4; ++s) af[s] = *(const bf16x8*)(qrow + 16 * s); }
        float wv[16];
        { const bf16* wrow = Z + (size_t)(t0 + hg) * OD_NP + 4160;
          const u32x4 w0 = *(const u32x4*)(wrow), w1 = *(const u32x4*)(wrow + 8);
          const unsigned ww[8] = {w0.x, w0.y, w0.z, w0.w, w1.x, w1.y, w1.z, w1.w};
#pragma unroll
          for (int q = 0; q < 8; ++q) { wv[2 * q] = lo2f(ww[q]) * 0.03125f; wv[2 * q + 1] = hi2f(ww[q]) * 0.03125f; } }
        __syncthreads();
        const bf16* kbase = Z + (size_t)b * SEQ * OD_NP + 4096 + 8 * hg;
        for (int tb = F.wave * 4; tb < ntiles; tb += NWAVES * 4) {
            bf16x8 bfr[4][4];
#pragma unroll
            for (int q = 0; q < 4; ++q) { const int tile = (tb + q < ntiles) ? (tb + q) : (ntiles - 1); const bf16* krow = kbase + (size_t)(tile * 32 + r) * OD_NP;
#pragma unroll
                for (int s = 0; s < 4; ++s) bfr[q][s] = *(const bf16x8*)(krow + 16 * s); }
#pragma unroll
            for (int q = 0; q < 4; ++q) {
                f32x16 acc;
#pragma unroll
                for (int e = 0; e < 16; ++e) acc[e] = 0.f;
#pragma unroll
                for (int s = 0; s < 4; ++s) acc = __builtin_amdgcn_mfma_f32_32x32x16_bf16(af[s], bfr[q][s], acc, 0, 0, 0);
                float sc = 0.f;
#pragma unroll
                for (int e = 0; e < 16; ++e) sc += fmaxf(acc[e], 0.f) * wv[e];
                const int key = (tb + q) * 32 + r;
                sc = fminf(fmaxf(sc, -7.999f), 7.999f);
                const unsigned fx = (unsigned)((int)rintf(sc * 1048576.0f) + (1 << 23));
                if (tb + q < ntiles) SC[hg * 16384 + key] = (key <= s0 + hg) ? fx : 0u;
            }
        }
        __syncthreads();
        const int n = s0 + grp + 1; unsigned k = (unsigned)(n < 256 ? n : 256); unsigned prefix = 0u;
        const LAS unsigned* sc = SC + grp * 16384; LAS unsigned* hs = hist + grp * 256;
#pragma unroll 1
        for (int pass = 0; pass < 3; ++pass) {
            const int shift = 16 - 8 * pass;
            hs[ltid] = 0u;
            __syncthreads();
            for (int i = ltid; i < n; i += 256) { const unsigned kv = sc[i];
                const bool match = (pass == 0) ? true : ((kv >> (shift + 8)) == prefix);
                if (match) (void)__hip_atomic_fetch_add(&hs[(kv >> shift) & 255u], 1u, __ATOMIC_RELAXED, __HIP_MEMORY_SCOPE_WORKGROUP); }
            __syncthreads();
            if (lw == 0) {
                const unsigned c0 = hs[4 * F.lane], c1 = hs[4 * F.lane + 1], c2 = hs[4 * F.lane + 2], c3 = hs[4 * F.lane + 3];
                const unsigned tot = c0 + c1 + c2 + c3; unsigned suf = tot;
#pragma unroll
                for (int o = 1; o < 64; o <<= 1) { const unsigned tmp = __shfl_down(suf, o); if (F.lane + o < 64) suf += tmp; }
                unsigned above = suf - tot;
                if (above < k && k <= suf) {
                    int bin;
                    if (above + c3 >= k) { bin = 3; } else { above += c3; if (above + c2 >= k) { bin = 2; } else { above += c2; if (above + c1 >= k) { bin = 1; } else { above += c1; bin = 0; } } }
                    res[grp * 2 + 0] = (unsigned)(4 * F.lane + bin); res[grp * 2 + 1] = k - above;
                }
            }
            __syncthreads();
            prefix = (prefix << 8) | res[grp * 2 + 0]; k = res[grp * 2 + 1];
        }
        const unsigned tau = prefix; const int krem = (int)k;
        int cg = 0, ce = 0;
        for (int j = 0; j < 64; ++j) { const int i = ltid * 64 + ((j + ltid) & 63); if (i < n) { const unsigned kv = sc[i]; cg += (kv > tau) ? 1 : 0; ce += (kv == tau) ? 1 : 0; } }
        int ig = cg, ie = ce;
#pragma unroll
        for (int o = 1; o < 64; o <<= 1) { const int tg = __shfl_up(ig, o), te = __shfl_up(ie, o); if (F.lane >= o) { ig += tg; ie += te; } }
        if (F.lane == 63) { wtot[F.wave * 2] = ig; wtot[F.wave * 2 + 1] = ie; }
        __syncthreads();
        int og = ig - cg, oe = ie - ce, totg = 0;
        for (int w = 0; w < 4; ++w) { const int a = wtot[(grp * 4 + w) * 2], e = wtot[(grp * 4 + w) * 2 + 1]; if (w < lw) { og += a; oe += e; } totg += a; }
        unsigned short* sel = SEL + (size_t)(t0 + grp) * 256;
        for (int j = 0; j < 64; ++j) { const int i = ltid * 64 + ((j + ltid) & 63); if (i < n) { const unsigned kv = sc[i];
            if (kv > tau) { sel[og++] = (unsigned short)i; }
            else if (kv == tau) { if (oe < krem) sel[totg + oe] = (unsigned short)i; ++oe; } } }
        if (ltid == 0) CNT[t0 + grp] = (n < 256 ? n : 256);
    }
}

__device__ __forceinline__ void ph_dsa_attn(const Args& A, Frame& F) {
    const bf16* Z = (const bf16*)(A.ws + WS_Z); const unsigned short* SEL = (const unsigned short*)(A.ws + WS_LA); const int* CNT = (const int*)(A.ws + WS_CNT);
    bf16* Y = (bf16*)(A.ws + WS_HY);
    LAS int* IDX = (LAS int*)(F.lds + F.wave * 5120);
    LAS float* SCR = (LAS float*)(F.lds + F.wave * 5120 + 1024);
    const int g16 = F.lane >> 4, c16 = F.lane & 15;
    for (int it = F.gw; it < TOK * 4; it += F.ngw) {
        const int t = it >> 2, kvh = it & 3, b = t >> 14; const int n = CNT[t];
        u32x4 qd[4];
#pragma unroll
        for (int g = 0; g < 4; ++g) qd[g] = *(const u32x4*)(Z + (size_t)t * OD_NP + (kvh * 4 + g) * 128 + c16 * 8);
#pragma unroll
        for (int m = 0; m < 4; ++m) { const int jj = F.lane + 64 * m; IDX[jj] = (jj < n) ? (int)SEL[(size_t)t * 256 + jj] : 0; }
        asm volatile("s_waitcnt lgkmcnt(0)" ::: "memory"); __builtin_amdgcn_wave_barrier();
        const bf16* kbase = Z + (size_t)b * SEQ * OD_NP + 2048 + kvh * 128 + c16 * 8;
#pragma unroll 1
        for (int i0 = 0; i0 < 64; i0 += 8) {
            u32x4 kd[8];
#pragma unroll
            for (int u = 0; u < 8; ++u) { const int id = IDX[4 * (i0 + u) + g16]; kd[u] = *(const u32x4*)(kbase + (size_t)id * OD_NP); }
#pragma unroll
            for (int u = 0; u < 8; ++u) {
                float a[4];
#pragma unroll
                for (int g = 0; g < 4; ++g) { float x = 0.f; x = dot2bf(kd[u].x, qd[g].x, x); x = dot2bf(kd[u].y, qd[g].y, x); x = dot2bf(kd[u].z, qd[g].z, x); x = dot2bf(kd[u].w, qd[g].w, x); a[g] = sum16_dpp(x); }
                const float mine = (c16 == 0) ? a[0] : ((c16 == 1) ? a[1] : ((c16 == 2) ? a[2] : a[3]));
                if (c16 < 4) SCR[(4 * (i0 + u) + g16) * 4 + c16] = mine;
            }
        }
        asm volatile("s_waitcnt lgkmcnt(0)" ::: "memory"); __builtin_amdgcn_wave_barrier();
        {
            f32x4 sv[4];
#pragma unroll
            for (int m = 0; m < 4; ++m) sv[m] = *(const LAS f32x4*)(SCR + (F.lane + 64 * m) * 4);
#pragma unroll
            for (int g = 0; g < 4; ++g) {
                float mx = -INFINITY;
#pragma unroll
                for (int m = 0; m < 4; ++m) { const bool val = (F.lane + 64 * m) < n; sv[m][g] = val ? sv[m][g] * 0.08838834764831845f : -INFINITY; mx = fmaxf(mx, sv[m][g]); }
                mx = wmax(mx); float sm = 0.f;
#pragma unroll
                for (int m = 0; m < 4; ++m) { const bool val = (F.lane + 64 * m) < n; sv[m][g] = val ? expf(sv[m][g] - mx) : 0.f; sm += sv[m][g]; }
                const float rden = 1.0f / wsum(sm);
#pragma unroll
                for (int m = 0; m < 4; ++m) sv[m][g] *= rden;
            }
#pragma unroll
            for (int m = 0; m < 4; ++m) *(LAS f32x4*)(SCR + (F.lane + 64 * m) * 4) = sv[m];
        }
        asm volatile("s_waitcnt lgkmcnt(0)" ::: "memory"); __builtin_amdgcn_wave_barrier();
        f32x2 o[4][4];
#pragma unroll
        for (int g = 0; g < 4; ++g)
#pragma unroll
            for (int d = 0; d < 4; ++d) o[g][d] = (f32x2){0.f, 0.f};
        const bf16* vbase = Z + (size_t)b * SEQ * OD_NP + 2560 + kvh * 128 + c16 * 8;
#pragma unroll 1
        for (int i0 = 0; i0 < 64; i0 += 8) {
            u32x4 vd[8]; f32x4 pv[8];
#pragma unroll
            for (int u = 0; u < 8; ++u) { const int id = IDX[4 * (i0 + u) + g16]; vd[u] = *(const u32x4*)(vbase + (size_t)id * OD_NP); pv[u] = *(const LAS f32x4*)(SCR + (4 * (i0 + u) + g16) * 4); }
#pragma unroll
            for (int u = 0; u < 8; ++u) {
                const f32x2 v0 = {lo2f(vd[u].x), hi2f(vd[u].x)}, v1 = {lo2f(vd[u].y), hi2f(vd[u].y)}, v2 = {lo2f(vd[u].z), hi2f(vd[u].z)}, v3 = {lo2f(vd[u].w), hi2f(vd[u].w)};
#pragma unroll
                for (int g = 0; g < 4; ++g) { const f32x2 pg = {pv[u][g], pv[u][g]}; o[g][0] = pg * v0 + o[g][0]; o[g][1] = pg * v1 + o[g][1]; o[g][2] = pg * v2 + o[g][2]; o[g][3] = pg * v3 + o[g][3]; }
            }
        }
        f32x2 mine[4];
#pragma unroll
        for (int d = 0; d < 4; ++d) {
            float x[4][2];
#pragma unroll
            for (int g = 0; g < 4; ++g) { float a0 = o[g][d].x, a1 = o[g][d].y; a0 += __shfl_xor(a0, 16); a0 += __shfl_xor(a0, 32); a1 += __shfl_xor(a1, 16); a1 += __shfl_xor(a1, 32); x[g][0] = a0; x[g][1] = a1; }
            mine[d].x = (g16 == 0) ? x[0][0] : ((g16 == 1) ? x[1][0] : ((g16 == 2) ? x[2][0] : x[3][0]));
            mine[d].y = (g16 == 0) ? x[0][1] : ((g16 == 1) ? x[1][1] : ((g16 == 2) ? x[2][1] : x[3][1]));
        }
        u32x4 w; w.x = pk2(mine[0].x, mine[0].y); w.y = pk2(mine[1].x, mine[1].y); w.z = pk2(mine[2].x, mine[2].y); w.w = pk2(mine[3].x, mine[3].y);
        *(u32x4*)(Y + (size_t)t * DM + (kvh * 4 + g16) * 128 + c16 * 8) = w;
        asm volatile("s_waitcnt lgkmcnt(0)" ::: "memory"); __builtin_amdgcn_wave_barrier();
    }
}

__global__ void __launch_bounds__(NTHREADS, 2) mk_fwd(Args args) {
    extern __shared__ __attribute__((aligned(16))) unsigned char lds[];
    Frame F;
    F.lds = (LAS unsigned char*)lds;
    volatile LAS unsigned* MISC = (volatile LAS unsigned*)(F.lds + MISC_OFF);
    F.tid = threadIdx.x; F.lane = F.tid & 63; F.wave = __builtin_amdgcn_readfirstlane(F.tid >> 6);
    F.bx = blockIdx.x; F.G = gridDim.x; F.gw = F.bx * NWAVES + F.wave; F.ngw = F.G * NWAVES;
    if (F.tid < 64) MISC[F.tid] = 0u;
    __syncthreads();
    unsigned char* ws = args.ws;
    XcdBarrier bar = xcd_barrier_post((unsigned*)(ws + WS_CTL) + CW_BAR, MISC + 8);
    const int lo = args.ph_lo, hi = args.ph_hi;
#define IN(k) (lo <= (k) && (k) < hi)
#define SEAM(k) do { if (IN((k) + 1)) xcd_barrier(bar); } while (0)
#define GEMM_BF16(Aptr, Bptr, Nn, Kk, Optr, ldo) do { pg8::Gemm g{(const pg8::bf16_t*)(Aptr), (const pg8::bf16_t*)(Bptr), TOK, (Nn), (Kk)}; pg8::StaticOrder S; S.init(TOK, (Nn), F.G, F.bx); \
        pg8::EpiBf16<0> E{(pg8::bf16_t*)(Optr), (ldo), nullptr, 0, 0}; pg8::gemm_phase<pg8::EpiBf16<0>, pg8::StaticOrder, false>(F.lds, g, S, E, nullptr); } while (0)

#ifndef PROBE_MASK
#define PROBE_MASK 0
#endif
#define PRB(bit, stmt) do { if (PROBE_MASK & (1 << (bit))) { stmt; xcd_barrier(bar); } } while (0)
    if (IN(0)) { ph_prologue(args, F); SEAM(0); }
    if (IN(1)) { ph_mod_x(args, F); SEAM(1); }
    if (IN(2)) { GEMM_BF16(ws + WS_HY, ws + WS_WINE, EV_NP, 2048, ws + WS_Z, EV_NP); SEAM(2); }
    if (IN(3)) { ph_even_post(args, F); SEAM(3); }
    if (IN(4)) { pg8::Gemm g{(const pg8::bf16_t*)(ws + WS_LA), (const pg8::bf16_t*)(ws + WS_WL), TOK, 3072, 512}; pg8::StaticOrder S; S.init(TOK, 3072, F.G, F.bx);
                 EpiLora E{(pg8::bf16_t*)(ws + WS_Z) + 1280, EV_NP, (const float*)args.in[7], (const float*)args.in[9]};
                 pg8::gemm_phase<EpiLora, pg8::StaticOrder, false>(F.lds, g, S, E, nullptr); SEAM(4); }
    if (IN(5)) { ph_scan_pack(args, F); SEAM(5); }
    if (IN(6)) { PRB(3, ph_swa(args, F)); ph_swa(args, F); SEAM(6); }
    if (IN(7)) { PRB(0, ph_scan(args, F)); ph_scan(args, F); SEAM(7); }
    if (IN(8)) { ph_rwkv_finish(args, F); SEAM(8); }
    if (IN(9)) { GEMM_BF16(ws + WS_HY, ws + WS_WOUTE, 2048, 2048, ws + WS_Z, 2048); SEAM(9); }
    if (IN(10)) { ph_ln_mixer(args, F, 0); SEAM(10); }
    if (IN(11)) { GEMM_BF16(ws + WS_HY, ws + WS_WQ0, 2048, 2048, ws + WS_Z, 2048); SEAM(11); }
    if (IN(12)) { PRB(4, ph_peer_select(args, F, 0)); ph_peer_select(args, F, 0); SEAM(12); }
    if (IN(13)) { PRB(1, ph_peer_gather(args, F, 0, true)); ph_peer_gather(args, F, 0); SEAM(13); }
    if (IN(14)) { GEMM_BF16(ws + WS_HY, ws + WS_WINO, OD_NP, 2048, ws + WS_Z, OD_NP); SEAM(14); }
    if (IN(15)) { ph_odd_post(args, F); SEAM(15); }
    if (IN(16)) { PRB(2, ph_dsa_select(args, F)); ph_dsa_select(args, F); SEAM(16); }
    if (IN(17)) { PRB(5, ph_dsa_attn(args, F)); ph_dsa_attn(args, F); SEAM(17); }
    if (IN(18)) { GEMM_BF16(ws + WS_HY, ws + WS_WOUTO, 2048, 2048, ws + WS_Z, 2048); SEAM(18); }
    if (IN(19)) { ph_ln_mixer(args, F, 1); SEAM(19); }
    if (IN(20)) { GEMM_BF16(ws + WS_HY, ws + WS_WQ1, 2048, 2048, ws + WS_Z, 2048); SEAM(20); }
    if (IN(21)) { PRB(4, ph_peer_select(args, F, 1)); ph_peer_select(args, F, 1); SEAM(21); }
    if (IN(22)) { PRB(1, ph_peer_gather(args, F, 1, true)); ph_peer_gather(args, F, 1); }
#undef IN
#undef SEAM
#undef GEMM_BF16
}

#ifndef MK_SPLIT
#define MK_SPLIT 0
#endif
extern "C" void kernel_launch(void* const* d_in, const int* in_sizes, int n_in, void* d_out, int out_size, void* d_ws, size_t ws_size, hipStream_t stream) {
    static int grid = 0;
    if (grid == 0) {
        int dev = 0, cus = 0;
        if (n_in != 27 || out_size != TOK * DM || ws_size < WS_END) { fprintf(stderr, "kernel_launch: unexpected shapes (n_in %d out %d ws %zu)\n", n_in, out_size, ws_size); grid = -1; return; }
        if (hipGetDevice(&dev) != hipSuccess || hipDeviceGetAttribute(&cus, hipDeviceAttributeMultiprocessorCount, dev) != hipSuccess) { grid = -1; return; }
        if (hipFuncSetAttribute((const void*)mk_fwd, hipFuncAttributeMaxDynamicSharedMemorySize, LDS_BYTES) != hipSuccess) { fprintf(stderr, "kernel_launch: hipFuncSetAttribute failed\n"); grid = -1; return; }
        int per_cu = 0;
        if (hipOccupancyMaxActiveBlocksPerMultiprocessor(&per_cu, (const void*)mk_fwd, NTHREADS, LDS_BYTES) != hipSuccess || per_cu < 1) fprintf(stderr, "kernel_launch: occupancy query says %d\n", per_cu);
        (void)hipGetLastError();
        grid = cus;
    }
    if (grid < 0) return;
    (void)hipMemsetAsync((char*)d_ws + WS_CTL, 0, CTL_ZERO_BYTES, stream);
    Args a{};
    for (int i = 0; i < 27; ++i) a.in[i] = d_in[i];
    a.out = (float*)d_out; a.ws = (unsigned char*)d_ws;
#if MK_SPLIT
    for (int p = 0; p < 23; ++p) { a.ph_lo = p; a.ph_hi = p + 1; hipLaunchKernelGGL(mk_fwd, dim3(grid), dim3(NTHREADS), LDS_BYTES, stream, a); }
#else
    a.ph_lo = 0; a.ph_hi = 23;
    hipLaunchKernelGGL(mk_fwd, dim3(grid), dim3(NTHREADS), LDS_BYTES, stream, a);
#endif
}
```

```cpp
#include <hip/hip_runtime.h>
#include <cstdio>
#include <cstdint>
namespace pg8 {
#define PG8_LAS __attribute__((address_space(3)))
typedef unsigned short bf16_t;
typedef short bf16x8 __attribute__((ext_vector_type(8)));
typedef float f32x4 __attribute__((ext_vector_type(4)));
typedef unsigned u32x4 __attribute__((ext_vector_type(4)));
constexpr int BM = 256, BK = 64, HALF = 128, HTB = HALF * BK * 2  , STAGE_BYTES = 8 * HTB, NXCD = 8, WGM = 8;

__host__ __device__ __forceinline__ int lds_byte(int r, int c) { const int st = (r >> 4) * 2 + (c >> 5), rr = r & 15, cc = c & 31, ob = rr * 64 + cc * 2; return st * 1024 + (ob ^ (((ob >> 9) & 1) << 5)); }
__host__ __device__ __forceinline__ void stage_rc(int b, int& R, int& C) { const int st = b / 1024, sb = b % 1024, swz = sb ^ (((sb >> 9) & 1) << 5); R = (st >> 1) * 16 + swz / 64; C = (st & 1) * 32 + (swz % 64) / 2; }
__host__ __device__ __forceinline__ int perm32(int rho) { const int n = rho >> 4, i = rho & 15; return 8 * (i >> 2) + 4 * n + (i & 3); }

struct Unit { int pm, pn; };
struct Gemm { const bf16_t* A; const bf16_t* Bt; int M, N, K; };

struct StaticOrder {
    int nM, nN, nwg, G, c;
    __host__ __device__ void init(int M, int N, int G_, int c_) { nM = M / BM; nN = N / BM; nwg = nM * nN; G = G_; c = c_; }
    __host__ __device__ bool next(int i, Unit& u) const {
        const long L = (long)i * G + c; if (L >= nwg) return false;
        int wgid = (int)L; { const int q = nwg / NXCD, r = nwg % NXCD, xcd = wgid % NXCD, off = wgid / NXCD; wgid = (xcd < r ? xcd * (q + 1) : r * (q + 1) + (xcd - r) * q) + off; }
        const int nig = WGM * nN, gid = wgid / nig, fm = gid * WGM, gsz = (nM - fm) < WGM ? (nM - fm) : WGM;
        u.pm = fm + ((wgid % nig) % gsz); u.pn = (wgid % nig) / gsz; return true;
    }
    __device__ __forceinline__ void a_ready(const Unit&) const {}
    __device__ __forceinline__ void done(const Unit&) const {}
};
struct CountedOrder : StaticOrder {
    const unsigned* ready; unsigned need; unsigned* tmo;
    __device__ __forceinline__ void a_ready(const Unit& u) const {
        if (threadIdx.x < 64) {
            const unsigned long long t0 = __builtin_amdgcn_s_memrealtime(); unsigned polls = 0;
            while ((unsigned)__builtin_amdgcn_readfirstlane(__hip_atomic_load(ready + 64 * u.pm, __ATOMIC_RELAXED, __HIP_MEMORY_SCOPE_AGENT)) < need) {
                if ((++polls & 255u) == 0u && __builtin_amdgcn_readfirstlane(__hip_atomic_load(tmo, __ATOMIC_RELAXED, __HIP_MEMORY_SCOPE_AGENT)) != 0u) break;
                if (__builtin_amdgcn_s_memrealtime() - t0 > 2000000ull) {
                    if (threadIdx.x == 0) { unsigned expect = 0u; __hip_atomic_compare_exchange_strong(tmo + 1, &expect, 0x600u | (unsigned)(u.pm & 0xff), __ATOMIC_RELAXED, __ATOMIC_RELAXED, __HIP_MEMORY_SCOPE_AGENT); __hip_atomic_store(tmo, 1u, __ATOMIC_RELAXED, __HIP_MEMORY_SCOPE_AGENT); }
                    break; }
                __builtin_amdgcn_s_sleep(2); }
            __builtin_amdgcn_fence(__ATOMIC_ACQUIRE, "agent");
            asm volatile("s_waitcnt vmcnt(0)" ::: "memory");
        }
#if !defined(BROKEN_HOOK_NO_BARRIER)
        asm volatile("" ::: "memory"); __builtin_amdgcn_s_barrier(); asm volatile("" ::: "memory");
#endif
    }
};

__device__ __forceinline__ unsigned cvt_pk_bf16(float lo, float hi) { unsigned r; asm volatile("v_cvt_pk_bf16_f32 %0, %1, %2" : "=v"(r) : "v"(lo), "v"(hi)); return r; }
typedef float f32x2 __attribute__((ext_vector_type(2)));
__device__ __forceinline__ f32x2 gelu_pk(f32x2 v) {
    const f32x2 av = __builtin_elementwise_abs(v), d = av * 0.2316418882f + 1.0f;
    f32x2 t; t.x = __builtin_amdgcn_rcpf(d.x); t.y = __builtin_amdgcn_rcpf(d.y);
    f32x2 q = t * 0.5307027145f + (-0.7265760135f); q = q * t + 0.7107068705f; q = q * t + (-0.142248368f); q = q * t + 0.127414796f; q = q * t;
    const f32x2 s = (v * v) * (-0.72134752044f);
    f32x2 e; e.x = __builtin_amdgcn_exp2f(s.x); e.y = __builtin_amdgcn_exp2f(s.y);
    const f32x2 m = v * (q * e), r = v - m;
    f32x2 o; o.x = v.x < 0.f ? m.x : r.x; o.y = v.y < 0.f ? m.y : r.y; return o;
}

struct EpiF32 {
    static constexpr bool PERM = false, AFTER_DRAIN = false;
    float* C; int ldc; const float* bias;
    __device__ __forceinline__ void operator()(const f32x4 (&acc)[2][2][4][2], const Unit& u, int wr, int wc, int fr, int fq) const {
        const int row0 = u.pm * BM + wr * 64 + fr, col0 = u.pn * BM + wc * 32 + 4 * fq;
        f32x4 bv[2][2];
#pragma unroll
        for (int bj = 0; bj < 2; ++bj)
#pragma unroll
            for (int n = 0; n < 2; ++n) bv[bj][n] = bias ? *(const f32x4*)(bias + col0 + bj * HALF + n * 16) : (f32x4){0.f, 0.f, 0.f, 0.f};
#pragma unroll
        for (int ai = 0; ai < 2; ++ai)
#pragma unroll
            for (int m = 0; m < 4; ++m) { float* rowp = C + (size_t)(row0 + ai * HALF + m * 16) * ldc + col0;
#pragma unroll
                for (int bj = 0; bj < 2; ++bj)
#pragma unroll
                    for (int n = 0; n < 2; ++n) *(f32x4*)(rowp + bj * HALF + n * 16) = acc[ai][bj][m][n] + bv[bj][n]; }
    }
};
template <int ACT  > struct EpiBf16 {
    static constexpr bool PERM = true, AFTER_DRAIN = false;
    bf16_t* O; int ldc; const float* bias; int split_cols; size_t split_stride;
    __device__ __forceinline__ void operator()(const f32x4 (&acc)[2][2][4][2], const Unit& u, int wr, int wc, int fr, int fq) const {
        const int row0 = u.pm * BM + wr * 64 + fr; int colt = u.pn * BM; bf16_t* base = O;
        if (split_cols) { const int t = colt / split_cols; base += (size_t)t * split_stride; colt -= t * split_cols; }
        const int col0 = colt + wc * 32 + 8 * fq, bcol0 = u.pn * BM + wc * 32 + 8 * fq;
        f32x4 bv[2][2];
#pragma unroll
        for (int bj = 0; bj < 2; ++bj)
#pragma unroll
            for (int n = 0; n < 2; ++n) bv[bj][n] = bias ? *(const f32x4*)(bias + bcol0 + bj * HALF + 4 * n) : (f32x4){0.f, 0.f, 0.f, 0.f};
#pragma unroll
        for (int ai = 0; ai < 2; ++ai)
#pragma unroll
            for (int m = 0; m < 4; ++m) { bf16_t* rowp = base + (size_t)(row0 + ai * HALF + m * 16) * ldc + col0;
#pragma unroll
                for (int bj = 0; bj < 2; ++bj) { f32x4 v0 = acc[ai][bj][m][0] + bv[bj][0], v1 = acc[ai][bj][m][1] + bv[bj][1];
                    if (ACT == 1) { f32x2 a = gelu_pk((f32x2){v0[0], v0[1]}), b = gelu_pk((f32x2){v0[2], v0[3]}), c = gelu_pk((f32x2){v1[0], v1[1]}), d = gelu_pk((f32x2){v1[2], v1[3]});
                        v0 = (f32x4){a.x, a.y, b.x, b.y}; v1 = (f32x4){c.x, c.y, d.x, d.y}; }
                    if (ACT == 2) {
#pragma unroll
                        for (int j = 0; j < 4; ++j) { v0[j] = 0.5f * v0[j] * (1.0f + erff(v0[j] * 0.70710678f)); v1[j] = 0.5f * v1[j] * (1.0f + erff(v1[j] * 0.70710678f)); } }
                    u32x4 w; w.x = cvt_pk_bf16(v0[0], v0[1]); w.y = cvt_pk_bf16(v0[2], v0[3]); w.z = cvt_pk_bf16(v1[0], v1[1]); w.w = cvt_pk_bf16(v1[2], v1[3]);
                    *(u32x4*)(rowp + bj * HALF) = w; } }
    }
};

struct PanelStats {
    unsigned* xbuf;
    unsigned* cnt;
    unsigned* tmo;
    int ntn; float eps;
    unsigned code;
    __device__ __forceinline__ bool run(const f32x4 (&v)[2][2][4][2], const Unit& u, int wr, int wc, int fr, int fq, PG8_LAS unsigned char* lds, int wid, int lane) const {
        typedef float f32x2v __attribute__((ext_vector_type(2)));
        PG8_LAS f32x2v* P = (PG8_LAS f32x2v*)lds;
        PG8_LAS f32x2v* S = (PG8_LAS f32x2v*)(lds + 8192);
        PG8_LAS unsigned* flag = (PG8_LAS unsigned*)(lds + 8192 + 2048);
#pragma unroll
        for (int ai = 0; ai < 2; ++ai)
#pragma unroll
            for (int m = 0; m < 4; ++m) {
                float s = 0.f;
#pragma unroll
                for (int bj = 0; bj < 2; ++bj)
#pragma unroll
                    for (int n = 0; n < 2; ++n) { const f32x4 x = v[ai][bj][m][n]; s += (x[0] + x[1]) + (x[2] + x[3]); }
                s += __shfl_xor(s, 16); s += __shfl_xor(s, 32);
                const float mw = s * (1.0f / 64.0f); float q = 0.f;
#pragma unroll
                for (int bj = 0; bj < 2; ++bj)
#pragma unroll
                    for (int n = 0; n < 2; ++n) { const f32x4 d = v[ai][bj][m][n] - mw; q += (d[0] * d[0] + d[1] * d[1]) + (d[2] * d[2] + d[3] * d[3]); }
                q += __shfl_xor(q, 16); q += __shfl_xor(q, 32);
                if (fq == 0) P[(ai * HALF + wr * 64 + m * 16 + fr) * 4 + wc] = (f32x2v){mw, q};
            }
        asm volatile("s_waitcnt lgkmcnt(0)" ::: "memory"); __builtin_amdgcn_s_barrier(); asm volatile("" ::: "memory");
#if defined(BROKEN_NO_WAIT)
        if (blockIdx.x >= 64) { const long long t0 = clock64(); while (clock64() - t0 < 60000) __builtin_amdgcn_s_sleep(8); }
#endif
        const int row = wid * 32 + (lane & 31);
        if (lane < 32) {
            const f32x2v a = P[row * 4 + 0], b = P[row * 4 + 1], c = P[row * 4 + 2], d = P[row * 4 + 3];
            const float mt = (a.x + b.x + c.x + d.x) * 0.25f;
            const float da = a.x - mt, db = b.x - mt, dc = c.x - mt, dd = d.x - mt;
            const float m2 = (a.y + b.y) + (c.y + d.y) + 64.0f * ((da * da + db * db) + (dc * dc + dd * dd));
            unsigned long long* slot = (unsigned long long*)xbuf + ((size_t)(u.pm * BM + row) * 4 + u.pn);
            __hip_atomic_store(slot, ((unsigned long long)__float_as_uint(m2) << 32) | __float_as_uint(mt), __ATOMIC_RELAXED, __HIP_MEMORY_SCOPE_AGENT);
        }
        asm volatile("s_waitcnt vmcnt(0)" ::: "memory");
        if (lane == 0) __hip_atomic_fetch_add(cnt + 64 * u.pm, 1u, __ATOMIC_RELAXED, __HIP_MEMORY_SCOPE_AGENT);
        if (wid == 0) {
            bool dead = false; const unsigned long long t0 = __builtin_amdgcn_s_memrealtime(); const unsigned want = 8u * (unsigned)ntn;
            for (;;) {
#if defined(BROKEN_NO_WAIT)
                break;
#endif
                if ((unsigned)__builtin_amdgcn_readfirstlane(__hip_atomic_load(cnt + 64 * u.pm, __ATOMIC_RELAXED, __HIP_MEMORY_SCOPE_AGENT)) >= want) break;
                if (__builtin_amdgcn_s_memrealtime() - t0 > 2000000ull) {
                    if (lane == 0) { unsigned expect = 0u; __hip_atomic_compare_exchange_strong(tmo + 1, &expect, code | (unsigned)(u.pm & 0xff), __ATOMIC_RELAXED, __ATOMIC_RELAXED, __HIP_MEMORY_SCOPE_AGENT);
                                     __hip_atomic_store(tmo, 1u, __ATOMIC_RELAXED, __HIP_MEMORY_SCOPE_AGENT); }
                    dead = true; break; }
                __builtin_amdgcn_s_sleep(2);
            }
            __builtin_amdgcn_fence(__ATOMIC_ACQUIRE, "agent");
            if (lane == 0) flag[0] = dead ? 1u : 0u;
        }
        asm volatile("s_waitcnt vmcnt(0) lgkmcnt(0)" ::: "memory"); __builtin_amdgcn_s_barrier(); asm volatile("" ::: "memory");
        const bool bad = flag[0] != 0u;
        if (lane < 32) {
            const unsigned long long* slot = (const unsigned long long*)xbuf + (size_t)(u.pm * BM + row) * 4; float mt[4], m2[4]; float ms = 0.f;
#pragma unroll
            for (int t = 0; t < 4; ++t) { if (t < ntn) { const unsigned long long w = __hip_atomic_load(slot + t, __ATOMIC_RELAXED, __HIP_MEMORY_SCOPE_AGENT); mt[t] = __uint_as_float((unsigned)w); m2[t] = __uint_as_float((unsigned)(w >> 32)); } else { mt[t] = 0.f; m2[t] = 0.f; } ms += mt[t]; }
            const float mean = ms / (float)ntn; float q = 0.f;
#pragma unroll
            for (int t = 0; t < 4; ++t) if (t < ntn) { const float dm = mt[t] - mean; q += m2[t] + 256.0f * dm * dm; }
            S[row] = (f32x2v){mean, 1.0f / sqrtf(q / (256.0f * (float)ntn) + eps)};
        }
        asm volatile("s_waitcnt lgkmcnt(0)" ::: "memory"); __builtin_amdgcn_s_barrier(); asm volatile("" ::: "memory");
        return bad;
    }
};
struct EpiLnRes {
    static constexpr bool PERM = false, AFTER_DRAIN = true;
    const float* base; float* out; int ldc; const float* bias; PanelStats st; unsigned poison;
    __device__ __forceinline__ void refuse(size_t i0, size_t stride, int M, int N) const { const float q = __builtin_nanf(""); for (size_t i = i0; i < (size_t)M * N; i += stride) out[(i / N) * ldc + i % N] = q;
        if (i0 == 0) { unsigned expect = 0u; __hip_atomic_compare_exchange_strong(st.tmo + 1, &expect, 0x7f0u, __ATOMIC_RELAXED, __ATOMIC_RELAXED, __HIP_MEMORY_SCOPE_AGENT); __hip_atomic_store(st.tmo, 1u, __ATOMIC_RELAXED, __HIP_MEMORY_SCOPE_AGENT); } }
    __device__ __forceinline__ void fused(f32x4 (&acc)[2][2][4][2], const Unit& u, int wr, int wc, int fr, int fq, PG8_LAS unsigned char* lds, int wid, int lane) const {
        typedef float f32x2v __attribute__((ext_vector_type(2)));
        const PG8_LAS f32x2v* S = (const PG8_LAS f32x2v*)(lds + 8192);
        const int col0 = u.pn * BM + wc * 32 + 4 * fq;
#pragma unroll
        for (int bj = 0; bj < 2; ++bj)
#pragma unroll
            for (int n = 0; n < 2; ++n) { const f32x4 bv = bias ? *(const f32x4*)(bias + col0 + bj * HALF + n * 16) : (f32x4){0.f, 0.f, 0.f, 0.f};
#pragma unroll
                for (int ai = 0; ai < 2; ++ai)
#pragma unroll
                    for (int m = 0; m < 4; ++m) acc[ai][bj][m][n] += bv; }
        const bool bad = st.run(acc, u, wr, wc, fr, fq, lds, wid, lane) || poison != 0u;
        const float qnan = __builtin_nanf("");
#pragma unroll
        for (int ai = 0; ai < 2; ++ai)
#pragma unroll
            for (int m = 0; m < 4; ++m) { const int r = ai * HALF + wr * 64 + m * 16 + fr; const f32x2v sr = S[r]; const size_t off = (size_t)(u.pm * BM + r) * ldc + col0;
#pragma unroll
                for (int bj = 0; bj < 2; ++bj)
#pragma unroll
                    for (int n = 0; n < 2; ++n) { const f32x4 bs = *(const f32x4*)(base + off + bj * HALF + n * 16); f32x4 o = bs + (acc[ai][bj][m][n] - sr.x) * sr.y;
                        if (bad) o = (f32x4){qnan, qnan, qnan, qnan}; *(f32x4*)(out + off + bj * HALF + n * 16) = o; }
                asm volatile("" ::: "memory"); }
    }
};
struct EpiLnResLn {
    static constexpr bool PERM = false, AFTER_DRAIN = true;
    const float* base; float* out; bf16_t* xn; int ldc; const float* bias; PanelStats st1, st2; unsigned poison;
    __device__ __forceinline__ void refuse(size_t i0, size_t stride, int M, int N) const { const float q = __builtin_nanf(""); for (size_t i = i0; i < (size_t)M * N; i += stride) { const size_t o = (i / N) * ldc + i % N; out[o] = q; xn[o] = (bf16_t)0x7fc0u; }
        if (i0 == 0) { unsigned expect = 0u; __hip_atomic_compare_exchange_strong(st1.tmo + 1, &expect, 0x7f0u, __ATOMIC_RELAXED, __ATOMIC_RELAXED, __HIP_MEMORY_SCOPE_AGENT); __hip_atomic_store(st1.tmo, 1u, __ATOMIC_RELAXED, __HIP_MEMORY_SCOPE_AGENT); } }
    __device__ __forceinline__ void fused(f32x4 (&acc)[2][2][4][2], const Unit& u, int wr, int wc, int fr, int fq, PG8_LAS unsigned char* lds, int wid, int lane) const {
        typedef float f32x2v __attribute__((ext_vector_type(2))); typedef unsigned u32x2v __attribute__((ext_vector_type(2)));
        const PG8_LAS f32x2v* S = (const PG8_LAS f32x2v*)(lds + 8192);
        const int col0 = u.pn * BM + wc * 32 + 4 * fq;
#pragma unroll
        for (int bj = 0; bj < 2; ++bj)
#pragma unroll
            for (int n = 0; n < 2; ++n) { const f32x4 bv = bias ? *(const f32x4*)(bias + col0 + bj * HALF + n * 16) : (f32x4){0.f, 0.f, 0.f, 0.f};
#pragma unroll
                for (int ai = 0; ai < 2; ++ai)
#pragma unroll
                    for (int m = 0; m < 4; ++m) acc[ai][bj][m][n] += bv; }
        bool bad = st1.run(acc, u, wr, wc, fr, fq, lds, wid, lane) || poison != 0u;
        const float qnan = __builtin_nanf("");
#pragma unroll
        for (int ai = 0; ai < 2; ++ai)
#pragma unroll
            for (int m = 0; m < 4; ++m) { const int r = ai * HALF + wr * 64 + m * 16 + fr; const f32x2v sr = S[r]; const size_t off = (size_t)(u.pm * BM + r) * ldc + col0;
#pragma unroll
                for (int bj = 0; bj < 2; ++bj)
#pragma unroll
                    for (int n = 0; n < 2; ++n) { const f32x4 bs = *(const f32x4*)(base + off + bj * HALF + n * 16); acc[ai][bj][m][n] = bs + (acc[ai][bj][m][n] - sr.x) * sr.y; }
                asm volatile("" : "+v"(acc[ai][0][m][0]), "+v"(acc[ai][0][m][1]), "+v"(acc[ai][1][m][0]), "+v"(acc[ai][1][m][1]));
                if (m & 1) asm volatile("" ::: "memory"); }
        const bool bad1 = bad;
        bad = st2.run(acc, u, wr, wc, fr, fq, lds, wid, lane) || bad;
#pragma unroll
        for (int ai = 0; ai < 2; ++ai)
#pragma unroll
            for (int m = 0; m < 4; ++m) { const int r = ai * HALF + wr * 64 + m * 16 + fr; const f32x2v sr = S[r]; const size_t off = (size_t)(u.pm * BM + r) * ldc + col0;
#pragma unroll
                for (int bj = 0; bj < 2; ++bj)
#pragma unroll
                    for (int n = 0; n < 2; ++n) { const f32x4 x1 = acc[ai][bj][m][n]; *(f32x4*)(out + off + bj * HALF + n * 16) = bad1 ? (f32x4){qnan, qnan, qnan, qnan} : x1;
                        const f32x4 o = (x1 - sr.x) * sr.y; u32x2v w; w.x = cvt_pk_bf16(o[0], o[1]); w.y = cvt_pk_bf16(o[2], o[3]);
                        if (bad) { w.x = 0x7fc07fc0u; w.y = 0x7fc07fc0u; } *(u32x2v*)(xn + off + bj * HALF + n * 16) = w; }
                asm volatile("" ::: "memory"); }
    }
};

template <class Epi, class Sched, bool STAMP = false>
__device__ __forceinline__ void gemm_phase(PG8_LAS unsigned char* lds, const Gemm g, const Sched& S, const Epi& E, unsigned long long* stamps) {
    const int tid = threadIdx.x, wid = __builtin_amdgcn_readfirstlane(tid >> 6), lane = tid & 63, wr = wid >> 2, wc = wid & 3, fr = lane & 15, fq = lane >> 4;
    const int K = g.K, nt = K / BK;
    int ts_lo = 0, ts_hi = 0, nts = 0; const unsigned long long rt_entry = STAMP ? (unsigned long long)wall_clock64() : 0ull;
#define PG8_STAMP() do { if (STAMP && wid == 0 && nts < 64) { const unsigned long long _c = (unsigned long long)clock64(); \
        ts_lo = (lane == nts) ? (int)(unsigned)_c : ts_lo; ts_hi = (lane == nts) ? (int)(unsigned)(_c >> 32) : ts_hi; ++nts; } } while (0)
    PG8_STAMP();
    unsigned voffA[2], voffB[2];
#pragma unroll
    for (int i = 0; i < 2; ++i) { int R, C; stage_rc(tid * 16 + i * 8192, R, C); const int Rb = Epi::PERM ? ((R & ~31) + perm32(R & 31)) : R;
        voffA[i] = (unsigned)(R * K + C) * 2u; voffB[i] = (unsigned)(Rb * K + C) * 2u; }
    const size_t kstep = (size_t)(BK * 2);
    const size_t hstep = (size_t)HALF * K * 2;
    const size_t tstep = 2 * hstep;
    const unsigned ldsw = (unsigned)wid * 1024u;
    const int aoff = lds_byte(wr * 64 + fr, fq * 8), boff = lds_byte(wc * 32 + fr, fq * 8);
#define PG8_SA(b, h) (((b) * 2 + (h)) * HTB)
#define PG8_SB(b, h) ((4 + (b) * 2 + (h)) * HTB)
#define PG8_STAGE(bufoff, gbase, voff) do { _Pragma("unroll") for (int _i = 0; _i < 2; ++_i) \
        __builtin_amdgcn_global_load_lds((const unsigned*)((const char*)(gbase) + (voff)[_i]), (PG8_LAS unsigned*)(lds + (bufoff) + ldsw + _i * 8192), 16, 0, 0); } while (0)
#define PG8_LDA(dst, b, h) do { _Pragma("unroll") for (int m = 0; m < 4; ++m) _Pragma("unroll") for (int k = 0; k < 2; ++k) dst[m][k] = *(const PG8_LAS bf16x8*)(lds + PG8_SA(b, h) + aoff + m * 2048 + k * 1024); } while (0)
#define PG8_LDB(dst, b, h) do { _Pragma("unroll") for (int n = 0; n < 2; ++n) _Pragma("unroll") for (int k = 0; k < 2; ++k) dst[n][k] = *(const PG8_LAS bf16x8*)(lds + PG8_SB(b, h) + boff + n * 2048 + k * 1024); } while (0)
#define PG8_MMA(ai, bj, At, Bt) do { __builtin_amdgcn_s_setprio(1); _Pragma("unroll") for (int m = 0; m < 4; ++m) _Pragma("unroll") for (int n = 0; n < 2; ++n) _Pragma("unroll") for (int k = 0; k < 2; ++k) \
        acc[ai][bj][m][n] = __builtin_amdgcn_mfma_f32_16x16x32_bf16(Bt[n][k], At[m][k], acc[ai][bj][m][n], 0, 0, 0); __builtin_amdgcn_s_setprio(0); } while (0)
#define PG8_WAIT_V(n) asm volatile("s_waitcnt vmcnt(" #n ")" ::: "memory")
#define PG8_WAIT_L(n) asm volatile("s_waitcnt lgkmcnt(" #n ")" ::: "memory")
#define PG8_BAR __builtin_amdgcn_s_barrier()
#define PG8_SCHED __builtin_amdgcn_sched_barrier(0)
    Unit cur, nxt; int ui = 0;
    if (!S.next(0, cur)) return;
    f32x4 acc[2][2][4][2];
#pragma unroll
    for (int a = 0; a < 2; ++a)
#pragma unroll
        for (int b = 0; b < 2; ++b)
#pragma unroll
            for (int m = 0; m < 4; ++m)
#pragma unroll
                for (int n = 0; n < 2; ++n) acc[a][b][m][n] = (f32x4){0.f, 0.f, 0.f, 0.f};
    bf16x8 At[4][2], B0[2][2], B1[2][2];
    const char* cA = (const char*)g.A + (size_t)cur.pm * tstep; const char* cB = (const char*)g.Bt + (size_t)cur.pn * tstep;
    S.a_ready(cur);
    PG8_STAGE(PG8_SB(0, 0), cB, voffB); PG8_STAGE(PG8_SA(0, 0), cA, voffA); PG8_STAGE(PG8_SB(0, 1), cB + hstep, voffB); PG8_STAGE(PG8_SA(0, 1), cA + hstep, voffA);
    if (wr == 1) PG8_BAR;
    PG8_WAIT_V(4); PG8_BAR;
    PG8_STAGE(PG8_SB(1, 0), cB + kstep, voffB); PG8_STAGE(PG8_SA(1, 0), cA + kstep, voffA); PG8_STAGE(PG8_SB(1, 1), cB + hstep + kstep, voffB);
    PG8_WAIT_V(6); PG8_BAR;
    PG8_STAMP();
    for (;;) {
        const bool has_next = S.next(ui + 1, nxt);
        const char* nA = has_next ? (const char*)g.A + (size_t)nxt.pm * tstep : cA; const char* nB = has_next ? (const char*)g.Bt + (size_t)nxt.pn * tstep : cB;
        for (int t = 0; t < nt; t += 2) {
            const bool last = (t == nt - 2);
            const char* a1 = cA + (size_t)(t + 1) * kstep;
            const char* a2 = last ? nA : cA + (size_t)(t + 2) * kstep; const char* b2 = last ? nB : cB + (size_t)(t + 2) * kstep;
            const char* a3 = a2 + kstep; const char* b3 = b2 + kstep;
            if (last && has_next) S.a_ready(nxt);
            PG8_LDB(B0, 0, 0); PG8_SCHED; PG8_LDA(At, 0, 0); PG8_STAGE(PG8_SA(1, 1), a1 + hstep, voffA);
            PG8_WAIT_L(8); PG8_BAR; PG8_WAIT_L(0); PG8_MMA(0, 0, At, B0); PG8_BAR; PG8_SCHED;
            PG8_LDB(B1, 0, 1); PG8_STAGE(PG8_SB(0, 0), b2, voffB);
            PG8_BAR; PG8_WAIT_L(0); PG8_MMA(0, 1, At, B1); PG8_BAR;
            PG8_LDA(At, 0, 1); PG8_STAGE(PG8_SA(0, 0), a2, voffA);
            PG8_BAR; PG8_WAIT_L(0); PG8_MMA(1, 0, At, B0); PG8_BAR; PG8_SCHED;
            PG8_STAGE(PG8_SB(0, 1), b2 + hstep, voffB);
            PG8_WAIT_V(6); PG8_BAR; PG8_MMA(1, 1, At, B1); PG8_BAR;
            PG8_LDB(B0, 1, 0); PG8_SCHED; PG8_LDA(At, 1, 0); PG8_STAGE(PG8_SA(0, 1), a2 + hstep, voffA);
            PG8_WAIT_L(8); PG8_BAR; PG8_WAIT_L(0); PG8_MMA(0, 0, At, B0); PG8_BAR; PG8_SCHED;
            PG8_LDB(B1, 1, 1); PG8_STAGE(PG8_SB(1, 0), b3, voffB);
            PG8_BAR; PG8_WAIT_L(0); PG8_MMA(0, 1, At, B1); PG8_BAR;
            PG8_LDA(At, 1, 1); PG8_STAGE(PG8_SA(1, 0), a3, voffA);
            PG8_BAR; PG8_WAIT_L(0); PG8_MMA(1, 0, At, B0); PG8_BAR; PG8_SCHED;
            PG8_STAGE(PG8_SB(1, 1), b3 + hstep, voffB);
            PG8_WAIT_V(6); PG8_BAR; PG8_MMA(1, 1, At, B1); PG8_BAR;
        }
        PG8_STAMP();
        if constexpr (!Epi::AFTER_DRAIN) { E(acc, cur, wr, wc, fr, fq); S.done(cur); }
        PG8_STAMP();
        if (!has_next) break;
#pragma unroll
        for (int a = 0; a < 2; ++a)
#pragma unroll
            for (int b = 0; b < 2; ++b)
#pragma unroll
                for (int m = 0; m < 4; ++m)
#pragma unroll
                    for (int n = 0; n < 2; ++n) acc[a][b][m][n] = (f32x4){0.f, 0.f, 0.f, 0.f};
        cur = nxt; cA = nA; cB = nB; ++ui;
    }
    PG8_WAIT_V(0);
    if (wr == 0) PG8_BAR;
    PG8_BAR;
    if constexpr (Epi::AFTER_DRAIN) { E.fused(acc, cur, wr, wc, fr, fq, lds, wid, lane); S.done(cur); }
    PG8_STAMP();
    if (STAMP && wid == 0) { stamps[lane] = lane < nts ? (((unsigned long long)(unsigned)ts_hi << 32) | (unsigned)ts_lo) : 0ull;
        if (lane == 62) stamps[62] = rt_entry; if (lane == 63) stamps[63] = (unsigned long long)wall_clock64(); }
#undef PG8_STAMP
#undef PG8_SA
#undef PG8_SB
#undef PG8_STAGE
#undef PG8_LDA
#undef PG8_LDB
#undef PG8_MMA
#undef PG8_WAIT_V
#undef PG8_WAIT_L
#undef PG8_BAR
#undef PG8_SCHED
}
}

#define LAS __attribute__((address_space(3)))
#define XB_TMO      128
#define XB_XCNT(j)  (256  + 64 * (j))
#define XB_XSUB(j)  (1280 + 64 * (j))
#define XB_XGEN(j)  (2304 + 64 * (j))
#define XB_TOP      3328
#define XB_TOPGEN   3392
#define XCD_BAR_WORDS 3456
#define XB_SPIN_CAP (1u << 24)

__device__ __forceinline__ unsigned xb_ld(unsigned* p)              { return __hip_atomic_load(p, __ATOMIC_RELAXED, __HIP_MEMORY_SCOPE_AGENT); }
__device__ __forceinline__ unsigned xb_add(unsigned* p, unsigned v) { return __hip_atomic_fetch_add(p, v, __ATOMIC_RELAXED, __HIP_MEMORY_SCOPE_AGENT); }
__device__ __forceinline__ unsigned xb_xcc_id() { return (unsigned)__builtin_amdgcn_s_getreg((3 << 11) | 20) & 0xFu; }
#define XB_SPIN(cond, bar) do { unsigned _sp = 0; while (cond) { __builtin_amdgcn_s_sleep(1); \
    if ((++_sp & 255u) == 0u) { if (xb_ld(&(bar)[XB_TMO])) break; if (_sp > XB_SPIN_CAP) { atomicAdd(&(bar)[XB_TMO], 1u); break; } } } } while (0)

struct XcdBarrier { unsigned* bar; unsigned x; volatile LAS unsigned* st; };

__device__ __forceinline__ XcdBarrier xcd_barrier_post(unsigned* bar, volatile LAS unsigned* st) {
    XcdBarrier b; b.bar = bar; b.x = xb_xcc_id(); b.st = st;
    if (threadIdx.x == 0) (void)xb_add(&bar[XB_XCNT(b.x)], 1u);
    return b;
}
__device__ __forceinline__ void xcd_barrier_complete(unsigned* bar, unsigned x, unsigned& nloc, unsigned& nx) {
    const unsigned G = gridDim.x * gridDim.y * gridDim.z;
    unsigned sum, cnt, mine, sp = 0u;
    for (;;) {
        sum = 0u; cnt = 0u; mine = 0u;
#pragma unroll
        for (unsigned j = 0; j < 16; ++j) { const unsigned c = xb_ld(&bar[XB_XCNT(j)]); sum += c; cnt += (c > 0u) ? 1u : 0u; mine = (j == x) ? c : mine; }
        if (sum == G) break;
        __builtin_amdgcn_s_sleep(1);
        if ((++sp & 255u) == 0u) { if (xb_ld(&bar[XB_TMO])) break; if (sp > XB_SPIN_CAP) { atomicAdd(&bar[XB_TMO], 1u); break; } }
    }
    nloc = mine > 0u ? mine : 1u; nx = cnt > 0u ? cnt : 1u;
}
__device__ __forceinline__ void xcd_barrier(const XcdBarrier& b) {
    asm volatile("s_waitcnt vmcnt(0)" ::: "memory");
    __syncthreads();
    if (threadIdx.x == 0) {
        unsigned* bar = b.bar;
        __builtin_amdgcn_s_waitcnt(0);
        unsigned nloc = b.st[0], nx = b.st[1];
        if (nloc == 0u) { xcd_barrier_complete(bar, b.x, nloc, nx); b.st[0] = nloc; b.st[1] = nx; }
        const unsigned old = xb_add(&bar[XB_XSUB(b.x)], 1u);
        const unsigned gen = old / nloc;
        if (old + 1u == (gen + 1u) * nloc) {
            __builtin_amdgcn_fence(__ATOMIC_RELEASE, "agent");
            asm volatile("s_waitcnt vmcnt(0)" ::: "memory");
            const unsigned og = xb_add(&bar[XB_TOP], 1u);
            const unsigned tg = og / nx;
            if (og + 1u == (tg + 1u) * nx) xb_add(&bar[XB_TOPGEN], 1u);
            else XB_SPIN(xb_ld(&bar[XB_TOPGEN]) == tg, bar);
            __builtin_amdgcn_fence(__ATOMIC_ACQUIRE, "agent");
            xb_add(&bar[XB_XGEN(b.x)], 1u);
            asm volatile("s_waitcnt vmcnt(0)" ::: "memory");
        } else {
            XB_SPIN(xb_ld(&bar[XB_XGEN(b.x)]) == gen, bar);
            __builtin_amdgcn_fence(__ATOMIC_ACQUIRE, "agent");
            asm volatile("s_waitcnt vmcnt(0)" ::: "memory");
        }
    }
    __syncthreads();
}

typedef unsigned short bf16;
typedef float f32x4 __attribute__((ext_vector_type(4)));
typedef float f32x16 __attribute__((ext_vector_type(16)));
typedef unsigned u32x4 __attribute__((ext_vector_type(4)));
typedef unsigned u32x2 __attribute__((ext_vector_type(2)));
typedef short bf16x8 __attribute__((ext_vector_type(8)));
typedef __bf16 bf2_t __attribute__((ext_vector_type(2)));

constexpr int NTHREADS = 512, NWAVES = 8;
constexpr int LDS_BYTES = 160 * 1024;
constexpr int MISC_OFF = LDS_BYTES - 256;
constexpr int TOK = 32768, SEQ = 16384, DM = 2048;
constexpr int EV_N = 4800, EV_NP = 4864, OD_N = 4176, OD_NP = 4352;
constexpr float ALPHA = 1.41421356237f;
constexpr size_t MiB = 1u << 20;
constexpr size_t WS_CTL = 0, CTL_ZERO_BYTES = 1 * MiB;
constexpr int CW_BAR = 4096, CW_XRANK = 8192;
constexpr size_t WS_MOD = 1 * MiB, WS_SKB = 2 * MiB, WS_WL = 4 * MiB, WS_BS = 7 * MiB, WS_CNT = 9 * MiB;
constexpr size_t WS_WINE = 10 * MiB, WS_WOUTE = 29 * MiB, WS_WINO = 37 * MiB, WS_WOUTO = 54 * MiB, WS_WQ0 = 62 * MiB, WS_WQ1 = 70 * MiB;
constexpr size_t WS_HY = 78 * MiB, WS_Z = 206 * MiB, WS_LA = 510 * MiB, WS_BIG = 542 * MiB, WS_END = 926 * MiB;

__device__ __forceinline__ float bf2f(unsigned short b) { return __uint_as_float(((unsigned)b) << 16); }
__device__ __forceinline__ unsigned f2bf(float f) { unsigned u = __float_as_uint(f); return (u + 0x7fffu + ((u >> 16) & 1u)) >> 16; }
__device__ __forceinline__ unsigned pk2(float lo, float hi) { return f2bf(lo) | (f2bf(hi) << 16); }
__device__ __forceinline__ float lo2f(unsigned w) { return __uint_as_float(w << 16); }
__device__ __forceinline__ float hi2f(unsigned w) { return __uint_as_float(w & 0xffff0000u); }
__device__ __forceinline__ float wsum(float v) {
#pragma unroll
    for (int o = 32; o >= 1; o >>= 1) v += __shfl_xor(v, o);
    return v;
}
__device__ __forceinline__ float wmax(float v) {
#pragma unroll
    for (int o = 32; o >= 1; o >>= 1) v = fmaxf(v, __shfl_xor(v, o));
    return v;
}
__device__ __forceinline__ float rdlane(float v, int l) { return __int_as_float(__builtin_amdgcn_readlane(__float_as_int(v), l)); }
__device__ __forceinline__ unsigned rdlaneu(unsigned v, int l) { return (unsigned)__builtin_amdgcn_readlane((int)v, l); }
__device__ __forceinline__ float dot2bf(unsigned a, unsigned b, float c) {
    return __builtin_amdgcn_fdot2_f32_bf16(__builtin_bit_cast(bf2_t, a), __builtin_bit_cast(bf2_t, b), c, false);
}
template <int CTRL, int RM> __device__ __forceinline__ float dppf(float v) {
    return __int_as_float(__builtin_amdgcn_update_dpp(0, __float_as_int(v), CTRL, RM, 0xF, false));
}
__device__ __forceinline__ float wsum_dpp(float v) {
    v += dppf<0xB1, 0xF>(v);
    v += dppf<0x4E, 0xF>(v);
    v += dppf<0x141, 0xF>(v);
    v += dppf<0x140, 0xF>(v);
    v += dppf<0x142, 0xA>(v);
    v += dppf<0x143, 0xC>(v);
    return rdlane(v, 63);
}
__device__ __forceinline__ float sum16_dpp(float v) {
    v += dppf<0xB1, 0xF>(v); v += dppf<0x4E, 0xF>(v); v += dppf<0x141, 0xF>(v); v += dppf<0x140, 0xF>(v);
    return v;
}
__device__ __forceinline__ float sigmoidf_(float x) { return 1.0f / (1.0f + expf(-x)); }
__device__ __forceinline__ unsigned ordkey(float f) { const unsigned u = __float_as_uint(f); return (u & 0x80000000u) ? ~u : (u | 0x80000000u); }
__device__ __forceinline__ float unordkey(unsigned k) { return __uint_as_float((k & 0x80000000u) ? (k & 0x7fffffffu) : ~k); }

struct Args { const void* in[27]; float* out; unsigned char* ws; int ph_lo, ph_hi; };
struct Frame { LAS unsigned char* lds; int tid, lane, wave, bx, G, gw, ngw; };

struct EpiLora {
    static constexpr bool PERM = true, AFTER_DRAIN = false;
    pg8::bf16_t* O; int ldc; const float* w0; const float* a0;
    __device__ __forceinline__ void operator()(const pg8::f32x4 (&acc)[2][2][4][2], const pg8::Unit& u, int wr, int wc, int fr, int fq) const {
        const int row0 = u.pm * 256 + wr * 64 + fr; const int colt = u.pn * 256; const int type = u.pn >> 2;
        const int col0 = colt + wc * 32 + 8 * fq, ncol0 = col0 & 1023;
        const float* pv = (type == 0) ? w0 : a0;
        pg8::f32x4 bv[2][2];
#pragma unroll
        for (int bj = 0; bj < 2; ++bj)
#pragma unroll
            for (int n = 0; n < 2; ++n) bv[bj][n] = (type < 2) ? *(const pg8::f32x4*)(pv + ncol0 + bj * 128 + 4 * n) : (pg8::f32x4){0.f, 0.f, 0.f, 0.f};
#pragma unroll
        for (int ai = 0; ai < 2; ++ai)
#pragma unroll
            for (int m = 0; m < 4; ++m) { pg8::bf16_t* rowp = O + (size_t)(row0 + ai * 128 + m * 16) * ldc + col0;
#pragma unroll
                for (int bj = 0; bj < 2; ++bj) { pg8::f32x4 v0 = acc[ai][bj][m][0] + bv[bj][0], v1 = acc[ai][bj][m][1] + bv[bj][1];
                    if (type < 2) {
                        const float sc = (type == 0) ? 0.60653066f : 1.0f;
#pragma unroll
                        for (int j = 0; j < 4; ++j) { v0[j] = sc / (1.0f + __expf(-v0[j])); v1[j] = sc / (1.0f + __expf(-v1[j])); }
                    }
                    pg8::u32x4 w; w.x = pg8::cvt_pk_bf16(v0[0], v0[1]); w.y = pg8::cvt_pk_bf16(v0[2], v0[3]); w.z = pg8::cvt_pk_bf16(v1[0], v1[1]); w.w = pg8::cvt_pk_bf16(v1[2], v1[3]);
                    *(pg8::u32x4*)(rowp + bj * 128) = w; } }
    }
};

__device__ __forceinline__ void transpose_item(const float* W, int K, int N, int Npad, bf16* WT, LAS float* scr, int item, int lane) {
    const int nblk = Npad / 32, kb = item / nblk, nb = item % nblk, k0 = 64 * kb, n0 = 32 * nb;
    const int nl = lane & 31; const bool ok = (n0 + nl) < N;
#pragma unroll 8
    for (int i = 0; i < 32; ++i) { const int kk = 2 * i + (lane >> 5); scr[kk * 33 + nl] = ok ? W[(size_t)(k0 + kk) * N + n0 + nl] : 0.f; }
    asm volatile("s_waitcnt lgkmcnt(0)" ::: "memory");
    const int c = lane & 7;
#pragma unroll
    for (int j = 0; j < 4; ++j) { const int n = (lane >> 3) + 8 * j; const LAS float* s = scr + (8 * c) * 33 + n;
        u32x4 o; o.x = pk2(s[0 * 33], s[1 * 33]); o.y = pk2(s[2 * 33], s[3 * 33]); o.z = pk2(s[4 * 33], s[5 * 33]); o.w = pk2(s[6 * 33], s[7 * 33]);
        *(u32x4*)(WT + (size_t)(n0 + n) * K + k0 + 8 * c) = o; }
    asm volatile("s_waitcnt lgkmcnt(0)" ::: "memory");
}

__device__ __forceinline__ void ph_prologue(const Args& A, Frame& F) {
    unsigned char* ws = A.ws;
    {
        const float* c = (const float*)A.in[1]; const float* mw = (const float*)A.in[19]; const float* mb = (const float*)A.in[20];
        float* MOD = (float*)(ws + WS_MOD);
        LAS float* red = (LAS float*)F.lds;
        for (int it = F.bx; it < 96; it += F.G) {
            const int s = it / 24, cc = it % 24, col = cc * 256 + F.lane * 4;
            const float* W = mw + (size_t)s * 2048 * 6144 + col;
            f32x4 a0 = {0.f, 0.f, 0.f, 0.f}, a1 = {0.f, 0.f, 0.f, 0.f};
            const int k0 = F.wave * 256;
#pragma unroll 8
            for (int k = k0; k < k0 + 256; ++k) {
                float c0 = c[k], c1 = c[2048 + k];
                c0 = c0 / (1.0f + expf(-c0)); c1 = c1 / (1.0f + expf(-c1));
                const f32x4 w = *(const f32x4*)(W + (size_t)k * 6144);
                a0 += c0 * w; a1 += c1 * w;
            }
            *(LAS f32x4*)(red + ((F.wave * 2 + 0) * 256 + F.lane * 4)) = a0;
            *(LAS f32x4*)(red + ((F.wave * 2 + 1) * 256 + F.lane * 4)) = a1;
            __syncthreads();
            { const int b = F.tid >> 8, cl = F.tid & 255; float sm = 0.f;
#pragma unroll
              for (int w = 0; w < 8; ++w) sm += red[(w * 2 + b) * 256 + cl];
              MOD[(size_t)(s * 2 + b) * 6144 + cc * 256 + cl] = sm + mb[s * 6144 + cc * 256 + cl]; }
            __syncthreads();
        }
    }
    {
        LAS float* scr = (LAS float*)(F.lds + 16384 + F.wave * 8704);
        constexpr int I0 = 32 * (EV_NP / 32), I1 = 32 * 64, I2 = 32 * (OD_NP / 32);
        constexpr int NIT = I0 + I1 + I2 + 3 * I1;
        for (int it = F.gw; it < NIT; it += F.ngw) {
            int r = it;
            if (r < I0) { transpose_item((const float*)A.in[3], 2048, EV_N, EV_NP, (bf16*)(ws + WS_WINE), scr, r, F.lane); continue; } r -= I0;
            if (r < I1) { transpose_item((const float*)A.in[4], 2048, 2048, 2048, (bf16*)(ws + WS_WOUTE), scr, r, F.lane); continue; } r -= I1;
            if (r < I2) { transpose_item((const float*)A.in[17], 2048, OD_N, OD_NP, (bf16*)(ws + WS_WINO), scr, r, F.lane); continue; } r -= I2;
            if (r < I1) { transpose_item((const float*)A.in[18], 2048, 2048, 2048, (bf16*)(ws + WS_WOUTO), scr, r, F.lane); continue; } r -= I1;
            if (r < I1) { transpose_item((const float*)A.in[23], 2048, 2048, 2048, (bf16*)(ws + WS_WQ0), scr, r, F.lane); continue; } r -= I1;
            transpose_item((const float*)A.in[23] + (size_t)2048 * 2048, 2048, 2048, 2048, (bf16*)(ws + WS_WQ1), scr, r, F.lane);
        }
    }
    {
        const float* w2 = (const float*)A.in[8]; const float* a2 = (const float*)A.in[10]; const float* g2 = (const float*)A.in[11];
        bf16* WL = (bf16*)(ws + WS_WL);
        const int gt = F.bx * NTHREADS + F.tid, ngt = F.G * NTHREADS;
        for (int i = gt; i < 3072 * 512; i += ngt) {
            const int n = i >> 9, k = i & 511; float v = 0.f;
            if (n < 1024) { if (k < 96) v = w2[k * 1024 + n]; }
            else if (n < 2048) { if (k >= 96 && k < 192) v = a2[(k - 96) * 1024 + (n - 1024)]; }
            else { if (k >= 192 && k < 448) v = g2[(k - 192) * 1024 + (n - 2048)]; }
            WL[i] = (bf16)f2bf(v);
        }
        const float* sk = (const float*)A.in[24]; bf16* SKB = (bf16*)(ws + WS_SKB);
        for (int i = gt; i < 2 * 262144; i += ngt) SKB[i] = (bf16)f2bf(sk[i]);
    }
}

__device__ __forceinline__ void ph_mod_x(const Args& A, Frame& F) {
    const float* x = (const float*)A.in[0]; const float* MOD = (const float*)(A.ws + WS_MOD); bf16* H = (bf16*)(A.ws + WS_HY);
    for (int t = F.gw; t < TOK; t += F.ngw) {
        const int b = t >> 14; const float* sh = MOD + (size_t)(0 * 2 + b) * 6144; const float* sc = sh + 2048;
#pragma unroll
        for (int j = 0; j < 8; ++j) { const int idx = j * 256 + F.lane * 4;
            const f32x4 xv = *(const f32x4*)(x + (size_t)t * DM + idx), sv = *(const f32x4*)(sc + idx), hv = *(const f32x4*)(sh + idx);
            const f32x4 o = xv * (1.0f + sv) + hv; u32x2 w; w.x = pk2(o[0], o[1]); w.y = pk2(o[2], o[3]);
            *(u32x2*)(H + (size_t)t * DM + idx) = w; }
    }
}

__device__ __forceinline__ void ph_even_post(const Args& A, Frame& F) {
    bf16* Z = (bf16*)(A.ws + WS_Z); const int* positions = (const int*)A.in[2]; const float* mu = (const float*)A.in[6];
    bf16* RKV = (bf16*)A.out; bf16* LAp = (bf16*)(A.ws + WS_LA);
    const int i = F.lane & 31; const float inv = powf(10000.0f, -(float)i / 32.0f);
    for (int t = F.gw; t < TOK; t += F.ngw) {
        const int s = t & (SEQ - 1); bf16* zr = Z + (size_t)t * EV_NP;
        float sn, cs; sincosf((float)positions[t] * inv, &sn, &cs);
#pragma unroll
        for (int it = 0; it < 9; ++it) { const int base = (2 * it + (F.lane >> 5)) * 64;
            const float t1 = bf2f(zr[base + i]), t2 = bf2f(zr[base + 32 + i]);
            zr[base + i] = (bf16)f2bf(t1 * cs - t2 * sn); zr[base + 32 + i] = (bf16)f2bf(t2 * cs + t1 * sn); }
        const bf16* zp = zr - EV_NP; const bool hasprev = s > 0;
        for (int m = 0; m < 28; ++m) { const int j = 2 * F.lane + 128 * m; if (j < 3520) {
            const unsigned cw = *(const unsigned*)(zr + 1280 + j); const unsigned pw = hasprev ? *(const unsigned*)(zp + 1280 + j) : 0u;
            const float m0 = mu[j], m1 = mu[j + 1];
            const float c0 = lo2f(cw), c1 = hi2f(cw), p0 = lo2f(pw), p1 = hi2f(pw);
            const float v0 = c0 + (p0 - c0) * m0, v1 = c1 + (p1 - c1) * m1;
            if (j < 3072) { const int which = j >> 10, jj = j & 1023; *(unsigned*)(RKV + (size_t)which * TOK * 1024 + (size_t)t * 1024 + jj) = pk2(v0, v1); }
            else if (j < 3168) { *(unsigned*)(LAp + (size_t)t * 512 + (j - 3072)) = pk2(tanhf(v0), tanhf(v1)); }
            else if (j < 3264) { *(unsigned*)(LAp + (size_t)t * 512 + 96 + (j - 3168)) = pk2(v0, v1); }
            else { *(unsigned*)(LAp + (size_t)t * 512 + 192 + (j - 3264)) = pk2(sigmoidf_(v0), sigmoidf_(v1)); }
        } }
        if (F.lane < 32) *(unsigned*)(LAp + (size_t)t * 512 + 448 + 2 * F.lane) = 0u;
    }
}

__device__ __forceinline__ void ph_scan_pack(const Args& A, Frame& F) {
    const bf16* Z = (const bf16*)(A.ws + WS_Z); const bf16* RKV = (const bf16*)A.out;
    const float* k_k = (const float*)A.in[12]; const float* k_a = (const float*)A.in[13]; const float* r_k = (const float*)A.in[14];
    unsigned* PK = (unsigned*)(A.ws + WS_BIG); float* BS = (float*)(A.ws + WS_BS);
    for (int it = F.gw; it < TOK * 16; it += F.ngw) {
        const int t = it >> 4, h = it & 15, c = h * 64 + F.lane, b = t >> 14, s = t & (SEQ - 1);
        const float r = bf2f(RKV[(size_t)t * 1024 + c]), kr = bf2f(RKV[(size_t)TOK * 1024 + (size_t)t * 1024 + c]), v = bf2f(RKV[(size_t)2 * TOK * 1024 + (size_t)t * 1024 + c]);
        const float e = bf2f(Z[(size_t)t * EV_NP + 1280 + c]), a = bf2f(Z[(size_t)t * EV_NP + 1280 + 1024 + c]);
        const float kkv = kr * k_k[c]; const float ss = wsum(kkv * kkv); const float kkn = kkv / fmaxf(sqrtf(ss), 1e-12f);
        const float kp = kr * (1.0f + (a - 1.0f) * k_a[c]); const float kka = kkn * a;
        const float bsum = wsum(r * kp * r_k[c]);
        if (F.lane == 0) BS[(size_t)t * 16 + h] = bsum;
        unsigned* dst = PK + ((size_t)((b * 16 + h) * SEQ + s) * 64 + F.lane) * 3;
        dst[0] = pk2(r, e); dst[1] = pk2(kp, kkn); dst[2] = pk2(kka, v);
    }
}

__device__ __forceinline__ void ph_swa(const Args& A, Frame& F) {
    const bf16* Z = (const bf16*)(A.ws + WS_Z); bf16* Y = (bf16*)(A.ws + WS_HY); const float* sinks = (const float*)A.in[5];
    LAS unsigned char* KL = F.lds; LAS unsigned char* VL = F.lds + 256 * 136;
    for (int u = F.bx; u < 512; u += F.G) {
        const int b = u >> 8, n = (u >> 1) & 127, kvh = u & 1;
        __syncthreads();
        for (int c = F.tid; c < 2048; c += NTHREADS) { const int jw = c >> 3, cc = c & 7; const int s = n * 128 - 128 + jw;
            u32x4 kv = {0u, 0u, 0u, 0u}, vv = {0u, 0u, 0u, 0u};
            if (s >= 0) { const bf16* row = Z + (size_t)(b * SEQ + s) * EV_NP; kv = *(const u32x4*)(row + 1024 + kvh * 64 + cc * 8); vv = *(const u32x4*)(row + 1152 + kvh * 64 + cc * 8); }
            *(LAS u32x2*)(KL + jw * 136 + cc * 16) = (u32x2){kv.x, kv.y}; *(LAS u32x2*)(KL + jw * 136 + cc * 16 + 8) = (u32x2){kv.z, kv.w};
            *(LAS u32x2*)(VL + jw * 136 + cc * 16) = (u32x2){vv.x, vv.y}; *(LAS u32x2*)(VL + jw * 136 + cc * 16 + 8) = (u32x2){vv.z, vv.w}; }
        __syncthreads();
        for (int it = F.wave; it < 1024; it += NWAVES) {
            const int i = it >> 3, g = it & 7, head = kvh * 8 + g; const int t = b * SEQ + n * 128 + i;
            const float qv = bf2f(Z[(size_t)t * EV_NP + head * 64 + F.lane]) * 0.125f;
            const int jw0 = i + 1 + F.lane, jw1 = jw0 + 64;
            const bool val0 = (n > 0) || (jw0 >= 128), val1 = (n > 0) || (jw1 >= 128);
            float s0 = 0.f, s1 = 0.f;
#pragma unroll
            for (int d4 = 0; d4 < 16; ++d4) {
                const u32x2 k0 = *(const LAS u32x2*)(KL + jw0 * 136 + d4 * 8), k1 = *(const LAS u32x2*)(KL + jw1 * 136 + d4 * 8);
                const float q0 = rdlane(qv, 4 * d4), q1 = rdlane(qv, 4 * d4 + 1), q2 = rdlane(qv, 4 * d4 + 2), q3 = rdlane(qv, 4 * d4 + 3);
                s0 += q0 * lo2f(k0.x) + q1 * hi2f(k0.x) + q2 * lo2f(k0.y) + q3 * hi2f(k0.y);
                s1 += q0 * lo2f(k1.x) + q1 * hi2f(k1.x) + q2 * lo2f(k1.y) + q3 * hi2f(k1.y);
            }
            const float sink = sinks[head];
            s0 = val0 ? s0 : -INFINITY; s1 = val1 ? s1 : -INFINITY;
            const float mx = fmaxf(wmax(fmaxf(s0, s1)), sink);
            float p0 = val0 ? expf(s0 - mx) : 0.f, p1 = val1 ? expf(s1 - mx) : 0.f;
            const float den = wsum(p0 + p1) + expf(sink - mx); const float rden = 1.0f / den;
            p0 *= rden; p1 *= rden;
            float o = 0.f;
            const LAS bf16* vcol = (const LAS bf16*)VL + F.lane;
#pragma unroll 8
            for (int jj = 0; jj < 64; ++jj) o += rdlane(p0, jj) * bf2f(vcol[(i + 1 + jj) * 68]);
#pragma unroll 8
            for (int jj = 0; jj < 64; ++jj) o += rdlane(p1, jj) * bf2f(vcol[(i + 65 + jj) * 68]);
            Y[(size_t)t * DM + head * 64 + F.lane] = (bf16)f2bf(o);
        }
    }
}

__device__ __forceinline__ void wsum2_dpp(float a, float b, float& ra, float& rb) {
    const auto r = __builtin_amdgcn_permlane32_swap(__float_as_uint(a), __float_as_uint(b), false, false);
    float v = __uint_as_float(r[0]) + __uint_as_float(r[1]);
    v += dppf<0xB1, 0xF>(v); v += dppf<0x4E, 0xF>(v); v += dppf<0x141, 0xF>(v); v += dppf<0x140, 0xF>(v);
    v += dppf<0x142, 0xA>(v);
    ra = rdlane(v, 31); rb = rdlane(v, 63);
}
__device__ __forceinline__ void ph_scan(const Args& A, Frame& F) {
    const unsigned* PK = (const unsigned*)(A.ws + WS_BIG); bf16* YRAW = (bf16*)A.out + (size_t)3 * TOK * 1024;
    if (F.wave >= 4) return;
    for (int pp = F.bx * 4 + F.wave; pp < 1024; pp += F.G * 4) {
        const int rr = 2 * pp, bh = rr >> 6, vrow = rr & 63;
        const unsigned* pk = PK + ((size_t)bh * SEQ * 64 + F.lane) * 3;
        bf16* youtA = YRAW + ((size_t)bh * 64 + vrow) * SEQ; bf16* youtB = youtA + SEQ;
        float SA = 0.f, SB = 0.f;
        for (int t0 = 0; t0 < SEQ; t0 += 64) {
            float ykA = 0.f, ykB = 0.f;
#pragma unroll 8
            for (int j = 0; j < 64; ++j) {
                const unsigned* p = pk + (size_t)(t0 + j) * 192;
                const unsigned w0 = p[0], w1 = p[1], w2 = p[2];
                const float r = lo2f(w0), e = hi2f(w0), kp = lo2f(w1), kk = hi2f(w1), kka = lo2f(w2), vv = hi2f(w2);
                const float vA = rdlane(vv, vrow), vB = rdlane(vv, vrow + 1);
                const float dec = __expf(-e);
                float saA, saB; wsum2_dpp(SA * kk, SB * kk, saA, saB);
                SA = SA * dec + (vA * kp - saA * kka);
                SB = SB * dec + (vB * kp - saB * kka);
                float yA, yB; wsum2_dpp(SA * r, SB * r, yA, yB);
                ykA = (F.lane == j) ? yA : ykA; ykB = (F.lane == j) ? yB : ykB;
            }
            youtA[t0 + F.lane] = (bf16)f2bf(ykA); youtB[t0 + F.lane] = (bf16)f2bf(ykB);
        }
    }
}

__device__ __forceinline__ void ph_rwkv_finish(const Args& A, Frame& F) {
    const bf16* Z = (const bf16*)(A.ws + WS_Z); const bf16* RKV = (const bf16*)A.out; const bf16* YRAW = (const bf16*)A.out + (size_t)3 * TOK * 1024;
    const float* BS = (const float*)(A.ws + WS_BS); bf16* Y = (bf16*)(A.ws + WS_HY);
    const float* lnx_g = (const float*)A.in[15]; const float* lnx_b = (const float*)A.in[16];
    LAS float* tile = (LAS float*)(F.lds + F.wave * 16640);
    for (int it = F.gw; it < 8192; it += F.ngw) {
        const int bh = it >> 8, tb = it & 255, b = bh >> 4, h = bh & 15, t0 = tb * 64;
        for (int vr = 0; vr < 64; ++vr) tile[vr * 65 + F.lane] = bf2f(YRAW[((size_t)bh * 64 + vr) * SEQ + t0 + F.lane]);
        asm volatile("s_waitcnt lgkmcnt(0)" ::: "memory");
        const int c = h * 64 + F.lane; const float lg = lnx_g[c], lb = lnx_b[c];
        for (int j = 0; j < 64; ++j) {
            const int t = b * SEQ + t0 + j;
            const float y = tile[F.lane * 65 + j];
            const float mean = wsum(y) * (1.0f / 64.0f); const float d = y - mean; const float var = wsum(d * d) * (1.0f / 64.0f);
            const float yn = d * rsqrtf(var + 64e-5f) * lg + lb;
            const float vv = bf2f(RKV[(size_t)2 * TOK * 1024 + (size_t)t * 1024 + c]); const float g = bf2f(Z[(size_t)t * EV_NP + 1280 + 2048 + c]); const float bs = BS[(size_t)t * 16 + h];
            Y[(size_t)t * DM + 1024 + c] = (bf16)f2bf((yn + bs * vv) * g);
        }
        asm volatile("s_waitcnt lgkmcnt(0)" ::: "memory");
    }
}

__device__ __forceinline__ void ph_ln_mixer(const Args& A, Frame& F, const int L) {
    const float* xsrc = (L == 0) ? (const float*)A.in[0] : (const float*)A.out; float* xdst = A.out;
    const bf16* O = (const bf16*)(A.ws + WS_Z); bf16* H = (bf16*)(A.ws + WS_HY); const float* MOD = (const float*)(A.ws + WS_MOD);
    const float* lng = (const float*)A.in[21] + (size_t)(L * 2 + 0) * DM; const float* lnb = (const float*)A.in[22] + (size_t)(L * 2 + 0) * DM;
    for (int t = F.gw; t < TOK; t += F.ngw) {
        const int b = t >> 14;
        const float* gate = MOD + (size_t)((L * 2 + 0) * 2 + b) * 6144 + 4096;
        const float* sh = MOD + (size_t)((L * 2 + 1) * 2 + b) * 6144; const float* sc = sh + 2048;
        float v[32]; float sum = 0.f;
#pragma unroll
        for (int j = 0; j < 4; ++j) { const int base = (j * 64 + F.lane) * 8;
            const u32x4 ow = *(const u32x4*)(O + (size_t)t * DM + base);
            const f32x4 x0 = *(const f32x4*)(xsrc + (size_t)t * DM + base), x1 = *(const f32x4*)(xsrc + (size_t)t * DM + base + 4);
            const f32x4 g0 = *(const f32x4*)(gate + base), g1 = *(const f32x4*)(gate + base + 4);
            const float of[8] = {lo2f(ow.x), hi2f(ow.x), lo2f(ow.y), hi2f(ow.y), lo2f(ow.z), hi2f(ow.z), lo2f(ow.w), hi2f(ow.w)};
#pragma unroll
            for (int e = 0; e < 4; ++e) { v[j * 8 + e] = ALPHA * x0[e] + (1.0f + g0[e]) * of[e]; v[j * 8 + 4 + e] = ALPHA * x1[e] + (1.0f + g1[e]) * of[4 + e]; }
#pragma unroll
            for (int e = 0; e < 8; ++e) sum += v[j * 8 + e]; }
        const float mean = wsum(sum) * (1.0f / DM); float sq = 0.f;
#pragma unroll
        for (int e = 0; e < 32; ++e) { v[e] -= mean; sq += v[e] * v[e]; }
        const float rstd = rsqrtf(wsum(sq) * (1.0f / DM) + 1e-5f);
#pragma unroll
        for (int j = 0; j < 4; ++j) { const int base = (j * 64 + F.lane) * 8;
            const f32x4 lg0 = *(const f32x4*)(lng + base), lg1 = *(const f32x4*)(lng + base + 4), lb0 = *(const f32x4*)(lnb + base), lb1 = *(const f32x4*)(lnb + base + 4);
            const f32x4 s0 = *(const f32x4*)(sc + base), s1 = *(const f32x4*)(sc + base + 4), h0 = *(const f32x4*)(sh + base), h1 = *(const f32x4*)(sh + base + 4);
            f32x4 o0, o1;
#pragma unroll
            for (int e = 0; e < 4; ++e) { o0[e] = v[j * 8 + e] * rstd * lg0[e] + lb0[e]; o1[e] = v[j * 8 + 4 + e] * rstd * lg1[e] + lb1[e]; }
            *(f32x4*)(xdst + (size_t)t * DM + base) = o0; *(f32x4*)(xdst + (size_t)t * DM + base + 4) = o1;
            const f32x4 q0 = o0 * (1.0f + s0) + h0, q1 = o1 * (1.0f + s1) + h1;
            u32x4 w; w.x = pk2(q0[0], q0[1]); w.y = pk2(q0[2], q0[3]); w.z = pk2(q1[0], q1[1]); w.w = pk2(q1[2], q1[3]);
            *(u32x4*)(H + (size_t)t * DM + base) = w; }
    }
    {
        const float* pu = (const float*)A.in[25] + (size_t)L * 16384 * 2048; const float* pv = (const float*)A.in[26] + (size_t)L * 16384 * 2048;
        unsigned char* T8 = A.ws + WS_BIG; float* SCL = (float*)(A.ws + WS_BIG + 64 * MiB);
        for (int r = F.gw; r < 32768; r += F.ngw) {
            const float* src = ((r < 16384) ? pu : pv) + (size_t)(r & 16383) * 2048;
            f32x4 f[2][4]; float amax = 0.f;
#pragma unroll
            for (int j = 0; j < 2; ++j)
#pragma unroll
                for (int c = 0; c < 4; ++c) { f[j][c] = *(const f32x4*)(src + (j * 64 + F.lane) * 16 + 4 * c);
                    amax = fmaxf(amax, fmaxf(fmaxf(fabsf(f[j][c][0]), fabsf(f[j][c][1])), fmaxf(fabsf(f[j][c][2]), fabsf(f[j][c][3])))); }
            amax = wmax(amax);
            int k = 0; if (amax > 0.f) { k = ilogbf(224.0f / amax); k = k < -100 ? -100 : (k > 100 ? 100 : k); }
            const float scl = ldexpf(1.0f, k);
#pragma unroll
            for (int j = 0; j < 2; ++j) { u32x4 w; unsigned ww[4];
#pragma unroll
                for (int c = 0; c < 4; ++c) { int q = __builtin_amdgcn_cvt_pk_fp8_f32(f[j][c][0] * scl, f[j][c][1] * scl, 0, false); q = __builtin_amdgcn_cvt_pk_fp8_f32(f[j][c][2] * scl, f[j][c][3] * scl, q, true); ww[c] = (unsigned)q; }
                w.x = ww[0]; w.y = ww[1]; w.z = ww[2]; w.w = ww[3];
                *(u32x4*)(T8 + (size_t)r * 2048 + (j * 64 + F.lane) * 16) = w; }
            if (F.lane == 0) SCL[r] = ldexpf(1.0f, -k);
        }
    }
}

template <int NV> __device__ __forceinline__ unsigned wave_tau16(const unsigned (&key)[NV]) {
    unsigned tau = 0u;
#pragma unroll 1
    for (int bit = 31; bit >= 0; --bit) {
        const unsigned cand = tau | (1u << bit); int cnt = 0;
#pragma unroll
        for (int v = 0; v < NV; ++v) cnt += __popcll(__ballot(key[v] >= cand));
        if (cnt >= 16) tau = cand;
    }
    return tau;
}
template <int NV> __device__ __forceinline__ void wave_compact16(const unsigned (&key)[NV], const int (&id)[NV], unsigned tau, LAS float* ov, LAS int* oi, int lane) {
    int ngt = 0;
#pragma unroll
    for (int v = 0; v < NV; ++v) ngt += __popcll(__ballot(key[v] > tau));
    int bg = 0, be = 0;
#pragma unroll
    for (int v = 0; v < NV; ++v) {
        const bool gt = key[v] > tau, eq = key[v] == tau;
        const unsigned long long mg = __ballot(gt), me = __ballot(eq);
        const unsigned long long below = (lane == 0) ? 0ull : ((~0ull) >> (64 - lane));
        const int pg = bg + __popcll(mg & below), pe = ngt + be + __popcll(me & below);
        if (gt) { ov[pg] = unordkey(key[v]); oi[pg] = id[v]; }
        if (eq && pe < 16) { ov[pe] = unordkey(key[v]); oi[pe] = id[v]; }
        bg += __popcll(mg); be += __popcll(me);
    }
}

__device__ __forceinline__ void ph_peer_select(const Args& A, Frame& F, const int L) {
    const bf16* QP = (const bf16*)(A.ws + WS_Z); const bf16* SKB = (const bf16*)(A.ws + WS_SKB) + (size_t)L * 262144;
    int* EID = (int*)(A.ws + WS_LA); float* GSM = (float*)(A.ws + WS_LA + 16 * MiB);
    LAS unsigned char* SKL = F.lds;
    LAS float* tv = (LAS float*)(F.lds + 69632 + F.wave * 512);
    LAS int* ti = (LAS int*)(F.lds + 69632 + F.wave * 512 + 128);
    LAS float* cv = (LAS float*)(F.lds + 69632 + F.wave * 512 + 256);
    LAS int* ci = (LAS int*)(F.lds + 69632 + F.wave * 512 + 320);
    for (int it = F.bx; it < 4096; it += F.G) {
        const int tile = it >> 3, h = it & 7;
        __syncthreads();
        for (int c = F.tid; c < 4096; c += NTHREADS) { const int p = c >> 11, n = (c >> 4) & 127, cc = c & 15;
            *(LAS u32x4*)(SKL + (p * 128 + n) * 272 + cc * 16) = *(const u32x4*)(SKB + ((size_t)((p * 8 + h) * 128 + n)) * 128 + cc * 8); }
        __syncthreads();
        for (int tk = 0; tk < 8; ++tk) {
            const int t = tile * 64 + F.wave * 8 + tk;
#pragma unroll
            for (int p = 0; p < 2; ++p) {
                const unsigned qv = *(const unsigned*)(QP + (size_t)t * DM + h * 256 + p * 128 + 2 * F.lane);
                float s0 = 0.f, s1 = 0.f;
                const LAS unsigned char* r0 = SKL + (p * 128 + F.lane) * 272; const LAS unsigned char* r1 = r0 + 64 * 272;
#pragma unroll
                for (int c16 = 0; c16 < 16; ++c16) {
                    const u32x4 k0 = *(const LAS u32x4*)(r0 + c16 * 16), k1 = *(const LAS u32x4*)(r1 + c16 * 16);
                    const unsigned q0 = rdlaneu(qv, c16 * 4), q1 = rdlaneu(qv, c16 * 4 + 1), q2 = rdlaneu(qv, c16 * 4 + 2), q3 = rdlaneu(qv, c16 * 4 + 3);
                    s0 = dot2bf(q0, k0.x, s0); s0 = dot2bf(q1, k0.y, s0); s0 = dot2bf(q2, k0.z, s0); s0 = dot2bf(q3, k0.w, s0);
                    s1 = dot2bf(q0, k1.x, s1); s1 = dot2bf(q1, k1.y, s1); s1 = dot2bf(q2, k1.z, s1); s1 = dot2bf(q3, k1.w, s1);
                }
                const unsigned key[2] = {ordkey(s0), ordkey(s1)}; const int id[2] = {F.lane, F.lane + 64};
                const unsigned tau = wave_tau16<2>(key);
                wave_compact16<2>(key, id, tau, tv + p * 16, ti + p * 16, F.lane);
            }
            asm volatile("s_waitcnt lgkmcnt(0)" ::: "memory"); __builtin_amdgcn_wave_barrier();
            unsigned ck[4]; int cid[4];
#pragma unroll
            for (int m = 0; m < 4; ++m) { const int c = F.lane * 4 + m; cid[m] = c; ck[m] = ordkey(tv[c >> 4] + tv[16 + (c & 15)]); }
            const unsigned tau2 = wave_tau16<4>(ck);
            wave_compact16<4>(ck, cid, tau2, cv, ci, F.lane);
            asm volatile("s_waitcnt lgkmcnt(0)" ::: "memory"); __builtin_amdgcn_wave_barrier();
            const float bv = (F.lane < 16) ? cv[F.lane] : -INFINITY; const int bc = (F.lane < 16) ? ci[F.lane] : 0;
            const float mx = wmax(bv); const float ev = (F.lane < 16) ? expf(bv - mx) : 0.f; const float den = wsum(ev);
            if (F.lane < 16) { const int e1 = ti[bc >> 4], e2 = ti[16 + (bc & 15)];
                EID[(size_t)t * 128 + h * 16 + F.lane] = e1 * 128 + e2; GSM[(size_t)t * 128 + h * 16 + F.lane] = ev / den; }
            asm volatile("s_waitcnt lgkmcnt(0)" ::: "memory"); __builtin_amdgcn_wave_barrier();
        }
    }
}

typedef float f32x2 __attribute__((ext_vector_type(2)));
constexpr int PGB = 4;
__device__ __forceinline__ void ph_peer_gather(const Args& A, Frame& F, const int L, const bool dry = false) {
    bf16* H = (bf16*)(A.ws + WS_HY); bf16* Hout = dry ? (bf16*)(A.ws + WS_BIG + 128 * MiB) : H; float* Xout = dry ? (float*)(A.ws + WS_Z) : A.out; const unsigned char* TU = A.ws + WS_BIG; const unsigned char* TV = TU + (size_t)16384 * 2048; const float* SCL = (const float*)(A.ws + WS_BIG + 64 * MiB);
    const int* EID = (const int*)(A.ws + WS_LA); const float* GSM = (const float*)(A.ws + WS_LA + 16 * MiB);
    const float* MOD = (const float*)(A.ws + WS_MOD); float* X = A.out;
    const float* lng = (const float*)A.in[21] + (size_t)(L * 2 + 1) * DM; const float* lnb = (const float*)A.in[22] + (size_t)(L * 2 + 1) * DM;
    for (int t = F.gw; t < TOK; t += F.ngw) {
        const int b = t >> 14;
        f32x2 h2[16];
#pragma unroll
        for (int j = 0; j < 2; ++j) { const u32x4 a = *(const u32x4*)(H + (size_t)t * DM + (j * 64 + F.lane) * 16), c = *(const u32x4*)(H + (size_t)t * DM + (j * 64 + F.lane) * 16 + 8);
            const unsigned aw[8] = {a.x, a.y, a.z, a.w, c.x, c.y, c.z, c.w};
#pragma unroll
            for (int q = 0; q < 8; ++q) h2[j * 8 + q] = (f32x2){lo2f(aw[q]), hi2f(aw[q])}; }
        f32x2 o2[16];
#pragma unroll
        for (int e = 0; e < 16; ++e) o2[e] = (f32x2){0.f, 0.f};
#pragma unroll 1
        for (int e0 = 0; e0 < 128; e0 += PGB) {
            int eid[PGB]; float gw[PGB], su[PGB], sv[PGB];
#pragma unroll
            for (int q = 0; q < PGB; ++q) { eid[q] = __builtin_amdgcn_readfirstlane(EID[(size_t)t * 128 + e0 + q]); gw[q] = GSM[(size_t)t * 128 + e0 + q]; su[q] = SCL[eid[q]]; sv[q] = SCL[16384 + eid[q]]; }
            u32x4 uu[PGB][2], vv[PGB][2];
#pragma unroll
            for (int q = 0; q < PGB; ++q)
#pragma unroll
                for (int j = 0; j < 2; ++j) { uu[q][j] = *(const u32x4*)(TU + (size_t)eid[q] * 2048 + (j * 64 + F.lane) * 16); vv[q][j] = *(const u32x4*)(TV + (size_t)eid[q] * 2048 + (j * 64 + F.lane) * 16); }
#pragma unroll
            for (int q = 0; q < PGB; ++q) {
                f32x2 d2 = {0.f, 0.f};
#pragma unroll
                for (int j = 0; j < 2; ++j) { const unsigned w[4] = {uu[q][j].x, uu[q][j].y, uu[q][j].z, uu[q][j].w};
#pragma unroll
                    for (int i = 0; i < 4; ++i) { const f32x2 lo = __builtin_amdgcn_cvt_pk_f32_fp8((int)w[i], false), hi = __builtin_amdgcn_cvt_pk_f32_fp8((int)w[i], true);
                        d2 = lo * h2[j * 8 + 2 * i] + d2; d2 = hi * h2[j * 8 + 2 * i + 1] + d2; } }
                const float d = wsum(d2.x + d2.y) * su[q];
                const float act = 0.5f * d * (1.0f + erff(d * 0.70710678f)) * gw[q] * sv[q];
                const f32x2 a2 = {act, act};
#pragma unroll
                for (int j = 0; j < 2; ++j) { const unsigned w[4] = {vv[q][j].x, vv[q][j].y, vv[q][j].z, vv[q][j].w};
#pragma unroll
                    for (int i = 0; i < 4; ++i) { const f32x2 lo = __builtin_amdgcn_cvt_pk_f32_fp8((int)w[i], false), hi = __builtin_amdgcn_cvt_pk_f32_fp8((int)w[i], true);
                        o2[j * 8 + 2 * i] = a2 * lo + o2[j * 8 + 2 * i]; o2[j * 8 + 2 * i + 1] = a2 * hi + o2[j * 8 + 2 * i + 1]; } }
            }
        }
        float out[32];
#pragma unroll
        for (int e = 0; e < 16; ++e) { out[2 * e] = o2[e].x; out[2 * e + 1] = o2[e].y; }
        const float* gate = MOD + (size_t)((L * 2 + 1) * 2 + b) * 6144 + 4096;
        float sum = 0.f;
#pragma unroll
        for (int j = 0; j < 2; ++j)
#pragma unroll
            for (int c = 0; c < 4; ++c) { const int base = (j * 64 + F.lane) * 16 + 4 * c;
                const f32x4 x0 = *(const f32x4*)(X + (size_t)t * DM + base), g0 = *(const f32x4*)(gate + base);
#pragma unroll
                for (int e = 0; e < 4; ++e) { const float v = ALPHA * x0[e] + (1.0f + g0[e]) * out[j * 16 + 4 * c + e]; out[j * 16 + 4 * c + e] = v; sum += v; } }
        const float mean = wsum(sum) * (1.0f / DM); float sq = 0.f;
#pragma unroll
        for (int e = 0; e < 32; ++e) { out[e] -= mean; sq += out[e] * out[e]; }
        const float rstd = rsqrtf(wsum(sq) * (1.0f / DM) + 1e-5f);
        const float* sh = MOD + (size_t)(((L + 1) * 2 + 0) * 2 + b) * 6144; const float* sc = sh + 2048;
#pragma unroll
        for (int j = 0; j < 2; ++j) {
            float hq[16];
#pragma unroll
            for (int c = 0; c < 4; ++c) { const int base = (j * 64 + F.lane) * 16 + 4 * c;
                const f32x4 lg0 = *(const f32x4*)(lng + base), lb0 = *(const f32x4*)(lnb + base);
                f32x4 o0;
#pragma unroll
                for (int e = 0; e < 4; ++e) o0[e] = out[j * 16 + 4 * c + e] * rstd * lg0[e] + lb0[e];
                *(f32x4*)(Xout + (size_t)t * DM + base) = o0;
                if (L == 0) { const f32x4 s0 = *(const f32x4*)(sc + base), h0 = *(const f32x4*)(sh + base);
#pragma unroll
                    for (int e = 0; e < 4; ++e) hq[4 * c + e] = o0[e] * (1.0f + s0[e]) + h0[e]; } }
            if (L == 0) { u32x4 w0, w1;
                w0.x = pk2(hq[0], hq[1]); w0.y = pk2(hq[2], hq[3]); w0.z = pk2(hq[4], hq[5]); w0.w = pk2(hq[6], hq[7]);
                w1.x = pk2(hq[8], hq[9]); w1.y = pk2(hq[10], hq[11]); w1.z = pk2(hq[12], hq[13]); w1.w = pk2(hq[14], hq[15]);
                *(u32x4*)(Hout + (size_t)t * DM + (j * 64 + F.lane) * 16) = w0; *(u32x4*)(Hout + (size_t)t * DM + (j * 64 + F.lane) * 16 + 8) = w1; }
        }
    }
}

struct XInfo { int rank, nloc, rx, nx; };
__device__ __forceinline__ XInfo xcc_info(volatile LAS unsigned* MISC) { XInfo x; x.rank = (int)MISC[16]; x.nloc = (int)MISC[17]; x.rx = (int)MISC[18]; x.nx = (int)MISC[19]; return x; }
constexpr size_t WS_DP = WS_BIG + 128 * MiB;
__device__ __forceinline__ void ph_peer_u(const Args& A, Frame& F, const XInfo X) {
    const bf16* H = (const bf16*)(A.ws + WS_HY); const unsigned char* TU = A.ws + WS_BIG; const int* EID = (const int*)(A.ws + WS_LA); float* DP = (float*)(A.ws + WS_DP);
    LAS int* IDX = (LAS int*)(F.lds + F.wave * 1024);
    const int g16 = F.lane >> 4, c16 = F.lane & 15;
    for (int s = X.rx; s < 8; s += X.nx) {
        for (int t = X.rank * NWAVES + F.wave; t < TOK; t += X.nloc * NWAVES) {
            IDX[F.lane] = EID[(size_t)t * 128 + F.lane]; IDX[F.lane + 64] = EID[(size_t)t * 128 + 64 + F.lane];
            f32x2 h2[8];
            { const u32x4 a = *(const u32x4*)(H + (size_t)t * DM + 256 * s + 16 * c16), c = *(const u32x4*)(H + (size_t)t * DM + 256 * s + 16 * c16 + 8);
              const unsigned aw[8] = {a.x, a.y, a.z, a.w, c.x, c.y, c.z, c.w};
#pragma unroll
              for (int q = 0; q < 8; ++q) h2[q] = (f32x2){lo2f(aw[q]), hi2f(aw[q])}; }
            asm volatile("s_waitcnt lgkmcnt(0)" ::: "memory"); __builtin_amdgcn_wave_barrier();
            float keep0 = 0.f, keep1 = 0.f;
            const unsigned char* ub = TU + 256 * s + 16 * c16;
#pragma unroll
            for (int i0 = 0; i0 < 32; i0 += 8) {
                u32x4 ud[8];
#pragma unroll
                for (int u = 0; u < 8; ++u) { const int eid = IDX[4 * (i0 + u) + g16]; ud[u] = *(const u32x4*)(ub + (size_t)eid * 2048); }
#pragma unroll
                for (int u = 0; u < 8; ++u) {
                    const unsigned w[4] = {ud[u].x, ud[u].y, ud[u].z, ud[u].w}; f32x2 d2 = {0.f, 0.f};
#pragma unroll
                    for (int q = 0; q < 4; ++q) { const f32x2 lo = __builtin_amdgcn_cvt_pk_f32_fp8((int)w[q], false), hi = __builtin_amdgcn_cvt_pk_f32_fp8((int)w[q], true);
                        d2 = lo * h2[2 * q] + d2; d2 = hi * h2[2 * q + 1] + d2; }
                    const float d = sum16_dpp(d2.x + d2.y);
                    const int i = i0 + u;
                    if (i < 16) keep0 = ((i & 15) == c16) ? d : keep0; else keep1 = ((i & 15) == c16) ? d : keep1;
                }
            }
            float* dp = DP + ((size_t)s * TOK + t) * 128 + 4 * c16 + g16;
            dp[0] = keep0; dp[64] = keep1;
            asm volatile("s_waitcnt lgkmcnt(0)" ::: "memory"); __builtin_amdgcn_wave_barrier();
        }
    }
}
__device__ __forceinline__ void ph_peer_v(const Args& A, Frame& F, const XInfo X) {
    const unsigned char* TV = A.ws + WS_BIG + (size_t)16384 * 2048; const float* SCL = (const float*)(A.ws + WS_BIG + 64 * MiB);
    const int* EID = (const int*)(A.ws + WS_LA); const float* GSM = (const float*)(A.ws + WS_LA + 16 * MiB); const float* DP = (const float*)(A.ws + WS_DP); float* OUT = (float*)(A.ws + WS_Z);
    LAS int* IDX = (LAS int*)(F.lds + F.wave * 1024); LAS float* ACT = (LAS float*)(F.lds + F.wave * 1024 + 512);
    const int g16 = F.lane >> 4, c16 = F.lane & 15;
    for (int s = X.rx; s < 8; s += X.nx) {
        for (int t = X.rank * NWAVES + F.wave; t < TOK; t += X.nloc * NWAVES) {
#pragma unroll
            for (int m = 0; m < 2; ++m) { const int e = F.lane + 64 * m; const int eid = EID[(size_t)t * 128 + e]; float d = 0.f;
#pragma unroll
                for (int x = 0; x < 8; ++x) d += DP[((size_t)x * TOK + t) * 128 + e];
                d *= SCL[eid];
                IDX[e] = eid; ACT[e] = 0.5f * d * (1.0f + erff(d * 0.70710678f)) * GSM[(size_t)t * 128 + e] * SCL[16384 + eid]; }
            asm volatile("s_waitcnt lgkmcnt(0)" ::: "memory"); __builtin_amdgcn_wave_barrier();
            f32x2 o2[8];
#pragma unroll
            for (int q = 0; q < 8; ++q) o2[q] = (f32x2){0.f, 0.f};
            const unsigned char* vb = TV + 256 * s + 16 * c16;
#pragma unroll
            for (int i0 = 0; i0 < 32; i0 += 8) {
                u32x4 vd[8]; float av[8];
#pragma unroll
                for (int u = 0; u < 8; ++u) { const int eid = IDX[4 * (i0 + u) + g16]; vd[u] = *(const u32x4*)(vb + (size_t)eid * 2048); av[u] = ACT[4 * (i0 + u) + g16]; }
#pragma unroll
                for (int u = 0; u < 8; ++u) {
                    const unsigned w[4] = {vd[u].x, vd[u].y, vd[u].z, vd[u].w}; const f32x2 a2 = {av[u], av[u]};
#pragma unroll
                    for (int q = 0; q < 4; ++q) { const f32x2 lo = __builtin_amdgcn_cvt_pk_f32_fp8((int)w[q], false), hi = __builtin_amdgcn_cvt_pk_f32_fp8((int)w[q], true);
                        o2[2 * q] = a2 * lo + o2[2 * q]; o2[2 * q + 1] = a2 * hi + o2[2 * q + 1]; }
                }
            }
            float o[16];
#pragma unroll
            for (int q = 0; q < 8; ++q) { float a0 = o2[q].x, a1 = o2[q].y; a0 += __shfl_xor(a0, 16); a0 += __shfl_xor(a0, 32); a1 += __shfl_xor(a1, 16); a1 += __shfl_xor(a1, 32); o[2 * q] = a0; o[2 * q + 1] = a1; }
            if (g16 == 0) { float* op = OUT + (size_t)t * DM + 256 * s + 16 * c16;
#pragma unroll
                for (int c = 0; c < 4; ++c) *(f32x4*)(op + 4 * c) = (f32x4){o[4 * c], o[4 * c + 1], o[4 * c + 2], o[4 * c + 3]}; }
            asm volatile("s_waitcnt lgkmcnt(0)" ::: "memory"); __builtin_amdgcn_wave_barrier();
        }
    }
}
__device__ __forceinline__ void ph_peer_ln(const Args& A, Frame& F, const int L) {
    const float* OUT = (const float*)(A.ws + WS_Z); float* X = A.out; bf16* H = (bf16*)(A.ws + WS_HY); const float* MOD = (const float*)(A.ws + WS_MOD);
    const float* lng = (const float*)A.in[21] + (size_t)(L * 2 + 1) * DM; const float* lnb = (const float*)A.in[22] + (size_t)(L * 2 + 1) * DM;
    for (int t = F.gw; t < TOK; t += F.ngw) {
        const int b = t >> 14;
        const float* gate = MOD + (size_t)((L * 2 + 1) * 2 + b) * 6144 + 4096;
        const float* sh = MOD + (size_t)(((L + 1) * 2 + 0) * 2 + b) * 6144; const float* sc = sh + 2048;
        float v[32]; float sum = 0.f;
#pragma unroll
        for (int j = 0; j < 8; ++j) { const int base = (j * 64 + F.lane) * 4;
            const f32x4 o0 = *(const f32x4*)(OUT + (size_t)t * DM + base), x0 = *(const f32x4*)(X + (size_t)t * DM + base), g0 = *(const f32x4*)(gate + base);
#pragma unroll
            for (int e = 0; e < 4; ++e) { v[j * 4 + e] = ALPHA * x0[e] + (1.0f + g0[e]) * o0[e]; sum += v[j * 4 + e]; } }
        const float mean = wsum(sum) * (1.0f / DM); float sq = 0.f;
#pragma unroll
        for (int e = 0; e < 32; ++e) { v[e] -= mean; sq += v[e] * v[e]; }
        const float rstd = rsqrtf(wsum(sq) * (1.0f / DM) + 1e-5f);
#pragma unroll
        for (int j = 0; j < 8; ++j) { const int base = (j * 64 + F.lane) * 4;
            const f32x4 lg0 = *(const f32x4*)(lng + base), lb0 = *(const f32x4*)(lnb + base);
            f32x4 o0;
#pragma unroll
            for (int e = 0; e < 4; ++e) o0[e] = v[j * 4 + e] * rstd * lg0[e] + lb0[e];
            *(f32x4*)(X + (size_t)t * DM + base) = o0;
            if (L == 0) { const f32x4 s0 = *(const f32x4*)(sc + base), h0 = *(const f32x4*)(sh + base); const f32x4 q0 = o0 * (1.0f + s0) + h0;
                u32x2 w; w.x = pk2(q0[0], q0[1]); w.y = pk2(q0[2], q0[3]); *(u32x2*)(H + (size_t)t * DM + base) = w; }
        }
    }
}

__device__ __forceinline__ void ph_odd_post(const Args& A, Frame& F) {
    bf16* Z = (bf16*)(A.ws + WS_Z); const int* positions = (const int*)A.in[2]; bf16* KIT = (bf16*)(A.ws + WS_BIG + 256 * MiB);
    const float inv128 = powf(10000.0f, -(float)F.lane / 64.0f); const int i32 = F.lane & 31; const float inv64 = powf(10000.0f, -(float)i32 / 32.0f);
    for (int t = F.gw; t < TOK; t += F.ngw) {
        bf16* zr = Z + (size_t)t * OD_NP; const float pos = (float)positions[t];
        float sn, cs; sincosf(pos * inv128, &sn, &cs);
        for (int hd = 0; hd < 20; ++hd) { const int base = hd * 128;
            const float t1 = bf2f(zr[base + F.lane]), t2 = bf2f(zr[base + 64 + F.lane]);
            zr[base + F.lane] = (bf16)f2bf(t1 * cs - t2 * sn); zr[base + 64 + F.lane] = (bf16)f2bf(t2 * cs + t1 * sn); }
        sincosf(pos * inv64, &sn, &cs);
        for (int it = 0; it < 9; ++it) { const int hd = 2 * it + (F.lane >> 5); if (hd < 17) { const int base = 3072 + hd * 64;
            const float t1 = bf2f(zr[base + i32]), t2 = bf2f(zr[base + 32 + i32]);
            const unsigned short o1 = (unsigned short)f2bf(t1 * cs - t2 * sn), o2 = (unsigned short)f2bf(t2 * cs + t1 * sn);
            zr[base + i32] = o1; zr[base + 32 + i32] = o2;
            if (hd == 16) {
                const int b = t >> 14, sp = t & (SEQ - 1), tile = sp >> 5, rr = sp & 31;
                bf16* kt = KIT + ((size_t)(b * 512 + tile) * 4) * 512;
                const int d1 = i32, d2 = i32 + 32;
                kt[((d1 >> 4) * 64 + rr + 32 * ((d1 >> 3) & 1)) * 8 + (d1 & 7)] = o1;
                kt[((d2 >> 4) * 64 + rr + 32 * ((d2 >> 3) & 1)) * 8 + (d2 & 7)] = o2;
            } } }
    }
}

__device__ __forceinline__ void ph_dsa_select(const Args& A, Frame& F, const int mode = 0) {
    const bf16* Z = (const bf16*)(A.ws + WS_Z); unsigned short* SEL = (unsigned short*)(A.ws + WS_LA); int* CNT = (int*)(A.ws + WS_CNT); const bf16* KIT = (const bf16*)(A.ws + WS_BIG + 256 * MiB);
    LAS unsigned* SC = (LAS unsigned*)F.lds;
    LAS unsigned* hist = (LAS unsigned*)(F.lds + 131072);
    LAS unsigned* res = (LAS unsigned*)(F.lds + 131072 + 2048);
    LAS int* wtot = (LAS int*)(F.lds + 131072 + 2048 + 64);
    const int r = F.lane & 31, hg = F.lane >> 5, tk = (r >> 2) & 1, hh = (r & 3) + 4 * (r >> 3);
    const int grp = F.wave >> 2, ltid = F.tid & 255, lw = F.wave & 3;
    for (int pr = F.bx; pr < TOK / 2; pr += F.G) {
        const int t0 = 2 * pr, b = t0 >> 14, s0 = t0 & (SEQ - 1);
        const int nkeys = s0 + 2, ntiles = (nkeys + 31) >> 5;
        bf16x8 af[4];
        { const bf16* qrow = Z + (size_t)(t0 + tk) * OD_NP + 3072 + hh * 64 + 8 * hg;
#pragma unroll
          for (int s = 0; s < 4; ++s) af[s] = *(const bf16x8*)(qrow + 16 * s); }
        float wv[16];
        { const bf16* wrow = Z + (size_t)(t0 + hg) * OD_NP + 4160;
          const u32x4 w0 = *(const u32x4*)(wrow), w1 = *(const u32x4*)(wrow + 8);
          const unsigned ww[8] = {w0.x, w0.y, w0.z, w0.w, w1.x, w1.y, w1.z, w1.w};
#pragma unroll
          for (int q = 0; q < 8; ++q) { wv[2 * q] = lo2f(ww[q]) * 0.03125f; wv[2 * q + 1] = hi2f(ww[q]) * 0.03125f; } }
        __syncthreads();
        const bf16* kbase = KIT + (size_t)b * 512 * 2048 + F.lane * 8;
        if (mode != 2) for (int tb = F.wave * 4; tb < ntiles; tb += NWAVES * 4) {
            bf16x8 bfr[4][4];
#pragma unroll
            for (int q = 0; q < 4; ++q) { const int tile = (tb + q < ntiles) ? (tb + q) : (ntiles - 1); const bf16* krow = kbase + (size_t)tile * 2048;
#pragma unroll
                for (int s = 0; s < 4; ++s) bfr[q][s] = *(const bf16x8*)(krow + 512 * s); }
#pragma unroll
            for (int q = 0; q < 4; ++q) {
                f32x16 acc;
#pragma unroll
                for (int e = 0; e < 16; ++e) acc[e] = 0.f;
#pragma unroll
                for (int s = 0; s < 4; ++s) acc = __builtin_amdgcn_mfma_f32_32x32x16_bf16(af[s], bfr[q][s], acc, 0, 0, 0);
                float sc = 0.f;
#pragma unroll
                for (int e = 0; e < 16; ++e) sc += fmaxf(acc[e], 0.f) * wv[e];
                const int key = (tb + q) * 32 + r;
                sc = fminf(fmaxf(sc, -7.999f), 7.999f);
                const unsigned fx = (unsigned)((int)rintf(sc * 1048576.0f) + (1 << 23));
                if (tb + q < ntiles) SC[hg * 16384 + key] = (key <= s0 + hg) ? fx : 0u;
            }
        }
        __syncthreads();
        if (mode == 1) continue;
        const int n = s0 + grp + 1; unsigned k = (unsigned)(n < 256 ? n : 256); unsigned prefix = 0u;
        const LAS unsigned* sc = SC + grp * 16384; LAS unsigned* hs = hist + grp * 256;
        unsigned kreg[64];
#pragma unroll
        for (int j = 0; j < 64; ++j) { const int i = ltid + 256 * j; kreg[j] = (i < n) ? sc[i] : 0u; }
        unsigned lmax = 0u;
#pragma unroll
        for (int j = 0; j < 64; ++j) lmax = (kreg[j] > lmax) ? kreg[j] : lmax;
        unsigned wmin = lmax;
#pragma unroll
        for (int o = 32; o >= 1; o >>= 1) { const unsigned tmp = __shfl_xor(wmin, o); wmin = tmp < wmin ? tmp : wmin; }
        if (F.lane == 0) wtot[16 + F.wave] = (int)wmin;
        __syncthreads();
        unsigned lbound = 0xFFFFFFFFu;
#pragma unroll
        for (int w = 0; w < 4; ++w) { const unsigned x = (unsigned)wtot[16 + grp * 4 + w]; lbound = x < lbound ? x : lbound; }
        LAS unsigned* seg = (LAS unsigned*)SC + grp * 16384 + lw * 4096; int ccnt = 0;
        {
            const unsigned long long below = (F.lane == 0) ? 0ull : ((~0ull) >> (64 - F.lane));
#pragma unroll
            for (int j = 0; j < 64; ++j) { if (256 * j < n) { const bool c = ((ltid + 256 * j) < n) && (kreg[j] >= lbound); const unsigned long long m = __ballot(c);
                if (c) seg[ccnt + __popcll(m & below)] = kreg[j]; ccnt += __popcll(m); } }
        }
        asm volatile("s_waitcnt lgkmcnt(0)" ::: "memory"); __builtin_amdgcn_wave_barrier();
        unsigned creg[16];
#pragma unroll
        for (int i = 0; i < 16; ++i) { creg[i] = 0u; if (64 * i < ccnt) { const int c = F.lane + 64 * i; creg[i] = (c < ccnt) ? seg[c] : 0u; } }
#pragma unroll 1
        for (int pass = 0; pass < 3; ++pass) {
            const int shift = 16 - 8 * pass;
            hs[ltid] = 0u;
            __syncthreads();
#pragma unroll
            for (int i = 0; i < 16; ++i) { if (64 * i < ccnt) { const unsigned kv = creg[i]; const bool valid = (F.lane + 64 * i) < ccnt;
                const bool match = (pass == 0) ? true : ((kv >> (shift + 8)) == prefix);
                if (valid && match) (void)__hip_atomic_fetch_add(&hs[(kv >> shift) & 255u], 1u, __ATOMIC_RELAXED, __HIP_MEMORY_SCOPE_WORKGROUP); } }
#pragma unroll 1
            for (int i = 16; 64 * i < ccnt; ++i) { const int c = F.lane + 64 * i; if (c < ccnt) { const unsigned kv = seg[c];
                const bool match = (pass == 0) ? true : ((kv >> (shift + 8)) == prefix);
                if (match) (void)__hip_atomic_fetch_add(&hs[(kv >> shift) & 255u], 1u, __ATOMIC_RELAXED, __HIP_MEMORY_SCOPE_WORKGROUP); } }
            __syncthreads();
            if (lw == 0) {
                const unsigned c0 = hs[4 * F.lane], c1 = hs[4 * F.lane + 1], c2 = hs[4 * F.lane + 2], c3 = hs[4 * F.lane + 3];
                const unsigned tot = c0 + c1 + c2 + c3; unsigned suf = tot;
#pragma unroll
                for (int o = 1; o < 64; o <<= 1) { const unsigned tmp = __shfl_down(suf, o); if (F.lane + o < 64) suf += tmp; }
                unsigned above = suf - tot;
                if (above < k && k <= suf) {
                    int bin;
                    if (above + c3 >= k) { bin = 3; } else { above += c3; if (above + c2 >= k) { bin = 2; } else { above += c2; if (above + c1 >= k) { bin = 1; } else { above += c1; bin = 0; } } }
                    res[grp * 2 + 0] = (unsigned)(4 * F.lane + bin); res[grp * 2 + 1] = k - above;
                }
            }
            __syncthreads();
            prefix = (prefix << 8) | res[grp * 2 + 0]; k = res[grp * 2 + 1];
        }
        const unsigned tau = prefix; const int krem = (int)k;
        int cg = 0, ce = 0;
#pragma unroll
        for (int j = 0; j < 64; ++j) { const bool valid = (ltid + 256 * j) < n; cg += (valid && kreg[j] > tau) ? 1 : 0; ce += (valid && kreg[j] == tau) ? 1 : 0; }
        int ig = cg, ie = ce;
#pragma unroll
        for (int o = 1; o < 64; o <<= 1) { const int tg = __shfl_up(ig, o), te = __shfl_up(ie, o); if (F.lane >= o) { ig += tg; ie += te; } }
        if (F.lane == 63) { wtot[F.wave * 2] = ig; wtot[F.wave * 2 + 1] = ie; }
        __syncthreads();
        int og = ig - cg, oe = ie - ce, totg = 0;
        for (int w = 0; w < 4; ++w) { const int a = wtot[(grp * 4 + w) * 2], e = wtot[(grp * 4 + w) * 2 + 1]; if (w < lw) { og += a; oe += e; } totg += a; }
        unsigned short* sel = SEL + (size_t)(t0 + grp) * 256;
#pragma unroll
        for (int j = 0; j < 64; ++j) { if (256 * j < n) { const int i = ltid + 256 * j; if (i < n) { const unsigned kv = kreg[j];
            if (kv > tau) { sel[og++] = (unsigned short)i; }
            else if (kv == tau) { if (oe < krem) sel[totg + oe] = (unsigned short)i; ++oe; } } } }
        if (ltid == 0) CNT[t0 + grp] = (n < 256 ? n : 256);
    }
}

__device__ __forceinline__ void ph_dsa_attn(const Args& A, Frame& F) {
    const bf16* Z = (const bf16*)(A.ws + WS_Z); const unsigned short* SEL = (const unsigned short*)(A.ws + WS_LA); const int* CNT = (const int*)(A.ws + WS_CNT);
    bf16* Y = (bf16*)(A.ws + WS_HY);
    LAS int* IDX = (LAS int*)(F.lds + F.wave * 5120);
    LAS float* SCR = (LAS float*)(F.lds + F.wave * 5120 + 1024);
    const int g16 = F.lane >> 4, c16 = F.lane & 15;
    for (int it = F.gw; it < TOK * 4; it += F.ngw) {
        const int t = it >> 2, kvh = it & 3, b = t >> 14; const int n = CNT[t];
        u32x4 qd[4];
#pragma unroll
        for (int g = 0; g < 4; ++g) qd[g] = *(const u32x4*)(Z + (size_t)t * OD_NP + (kvh * 4 + g) * 128 + c16 * 8);
#pragma unroll
        for (int m = 0; m < 4; ++m) { const int jj = F.lane + 64 * m; IDX[jj] = (jj < n) ? (int)SEL[(size_t)t * 256 + jj] : 0; }
        asm volatile("s_waitcnt lgkmcnt(0)" ::: "memory"); __builtin_amdgcn_wave_barrier();
        const bf16* kbase = Z + (size_t)b * SEQ * OD_NP + 2048 + kvh * 128 + c16 * 8;
#pragma unroll 1
        for (int i0 = 0; i0 < 64; i0 += 8) {
            u32x4 kd[8];
#pragma unroll
            for (int u = 0; u < 8; ++u) { const int id = IDX[4 * (i0 + u) + g16]; kd[u] = *(const u32x4*)(kbase + (size_t)id * OD_NP); }
#pragma unroll
            for (int u = 0; u < 8; ++u) {
                float a[4];
#pragma unroll
                for (int g = 0; g < 4; ++g) { float x = 0.f; x = dot2bf(kd[u].x, qd[g].x, x); x = dot2bf(kd[u].y, qd[g].y, x); x = dot2bf(kd[u].z, qd[g].z, x); x = dot2bf(kd[u].w, qd[g].w, x); a[g] = sum16_dpp(x); }
                const float mine = (c16 == 0) ? a[0] : ((c16 == 1) ? a[1] : ((c16 == 2) ? a[2] : a[3]));
                if (c16 < 4) SCR[(4 * (i0 + u) + g16) * 4 + c16] = mine;
            }
        }
        asm volatile("s_waitcnt lgkmcnt(0)" ::: "memory"); __builtin_amdgcn_wave_barrier();
        {
            f32x4 sv[4];
#pragma unroll
            for (int m = 0; m < 4; ++m) sv[m] = *(const LAS f32x4*)(SCR + (F.lane + 64 * m) * 4);
#pragma unroll
            for (int g = 0; g < 4; ++g) {
                float mx = -INFINITY;
#pragma unroll
                for (int m = 0; m < 4; ++m) { const bool val = (F.lane + 64 * m) < n; sv[m][g] = val ? sv[m][g] * 0.08838834764831845f : -INFINITY; mx = fmaxf(mx, sv[m][g]); }
                mx = wmax(mx); float sm = 0.f;
#pragma unroll
                for (int m = 0; m < 4; ++m) { const bool val = (F.lane + 64 * m) < n; sv[m][g] = val ? expf(sv[m][g] - mx) : 0.f; sm += sv[m][g]; }
                const float rden = 1.0f / wsum(sm);
#pragma unroll
                for (int m = 0; m < 4; ++m) sv[m][g] *= rden;
            }
#pragma unroll
            for (int m = 0; m < 4; ++m) *(LAS f32x4*)(SCR + (F.lane + 64 * m) * 4) = sv[m];
        }
        asm volatile("s_waitcnt lgkmcnt(0)" ::: "memory"); __builtin_amdgcn_wave_barrier();
        f32x2 o[4][4];
#pragma unroll
        for (int g = 0; g < 4; ++g)
#pragma unroll
            for (int d = 0; d < 4; ++d) o[g][d] = (f32x2){0.f, 0.f};
        const bf16* vbase = Z + (size_t)b * SEQ * OD_NP + 2560 + kvh * 128 + c16 * 8;
#pragma unroll 1
        for (int i0 = 0; i0 < 64; i0 += 8) {
            u32x4 vd[8]; f32x4 pv[8];
#pragma unroll
            for (int u = 0; u < 8; ++u) { const int id = IDX[4 * (i0 + u) + g16]; vd[u] = *(const u32x4*)(vbase + (size_t)id * OD_NP); pv[u] = *(const LAS f32x4*)(SCR + (4 * (i0 + u) + g16) * 4); }
#pragma unroll
            for (int u = 0; u < 8; ++u) {
                const f32x2 v0 = {lo2f(vd[u].x), hi2f(vd[u].x)}, v1 = {lo2f(vd[u].y), hi2f(vd[u].y)}, v2 = {lo2f(vd[u].z), hi2f(vd[u].z)}, v3 = {lo2f(vd[u].w), hi2f(vd[u].w)};
#pragma unroll
                for (int g = 0; g < 4; ++g) { const f32x2 pg = {pv[u][g], pv[u][g]}; o[g][0] = pg * v0 + o[g][0]; o[g][1] = pg * v1 + o[g][1]; o[g][2] = pg * v2 + o[g][2]; o[g][3] = pg * v3 + o[g][3]; }
            }
        }
        f32x2 mine[4];
#pragma unroll
        for (int d = 0; d < 4; ++d) {
            float x[4][2];
#pragma unroll
            for (int g = 0; g < 4; ++g) { float a0 = o[g][d].x, a1 = o[g][d].y; a0 += __shfl_xor(a0, 16); a0 += __shfl_xor(a0, 32); a1 += __shfl_xor(a1, 16); a1 += __shfl_xor(a1, 32); x[g][0] = a0; x[g][1] = a1; }
            mine[d].x = (g16 == 0) ? x[0][0] : ((g16 == 1) ? x[1][0] : ((g16 == 2) ? x[2][0] : x[3][0]));
            mine[d].y = (g16 == 0) ? x[0][1] : ((g16 == 1) ? x[1][1] : ((g16 == 2) ? x[2][1] : x[3][1]));
        }
        u32x4 w; w.x = pk2(mine[0].x, mine[0].y); w.y = pk2(mine[1].x, mine[1].y); w.z = pk2(mine[2].x, mine[2].y); w.w = pk2(mine[3].x, mine[3].y);
        *(u32x4*)(Y + (size_t)t * DM + (kvh * 4 + g16) * 128 + c16 * 8) = w;
        asm volatile("s_waitcnt lgkmcnt(0)" ::: "memory"); __builtin_amdgcn_wave_barrier();
    }
}

__global__ void __launch_bounds__(NTHREADS, 2) mk_fwd(Args args) {
    extern __shared__ __attribute__((aligned(16))) unsigned char lds[];
    Frame F;
    F.lds = (LAS unsigned char*)lds;
    volatile LAS unsigned* MISC = (volatile LAS unsigned*)(F.lds + MISC_OFF);
    F.tid = threadIdx.x; F.lane = F.tid & 63; F.wave = __builtin_amdgcn_readfirstlane(F.tid >> 6);
    F.bx = blockIdx.x; F.G = gridDim.x; F.gw = F.bx * NWAVES + F.wave; F.ngw = F.G * NWAVES;
    if (F.tid < 64) MISC[F.tid] = 0u;
    __syncthreads();
    unsigned char* ws = args.ws;
    XcdBarrier bar = xcd_barrier_post((unsigned*)(ws + WS_CTL) + CW_BAR, MISC + 8);
    if (F.tid == 0) { MISC[16] = xb_add((unsigned*)(ws + WS_CTL) + CW_XRANK + 64 * bar.x, 1u); }
    const int lo = args.ph_lo, hi = args.ph_hi;
#define IN(k) (lo <= (k) && (k) < hi)
#define SEAM(k) do { if (IN((k) + 1)) xcd_barrier(bar); } while (0)
#define GEMM_BF16(Aptr, Bptr, Nn, Kk, Optr, ldo) do { pg8::Gemm g{(const pg8::bf16_t*)(Aptr), (const pg8::bf16_t*)(Bptr), TOK, (Nn), (Kk)}; pg8::StaticOrder S; S.init(TOK, (Nn), F.G, F.bx); \
        pg8::EpiBf16<0> E{(pg8::bf16_t*)(Optr), (ldo), nullptr, 0, 0}; pg8::gemm_phase<pg8::EpiBf16<0>, pg8::StaticOrder, false>(F.lds, g, S, E, nullptr); } while (0)

#ifndef PROBE_MASK
#define PROBE_MASK 0
#endif
#define PRB(bit, stmt) do { if (PROBE_MASK & (1 << (bit))) { stmt; xcd_barrier(bar); } } while (0)
    if (IN(0)) { ph_prologue(args, F); SEAM(0); }
    if (IN(1)) { ph_mod_x(args, F); SEAM(1); }
    if (F.tid == 0) {
        unsigned* cb = (unsigned*)(ws + WS_CTL) + CW_BAR; unsigned nloc = 1u, rx = 0u, nx = 0u;
        for (unsigned j = 0; j < 16; ++j) { const unsigned c = xb_ld(&cb[XB_XCNT(j)]); if (c > 0u) { if (j < bar.x) ++rx; ++nx; } if (j == bar.x) nloc = c > 0u ? c : 1u; }
        if (nx == 0u) nx = 1u;
        MISC[17] = nloc; MISC[18] = rx; MISC[19] = nx; }
    __syncthreads();
    const XInfo XI = xcc_info(MISC);
    if (IN(2)) { GEMM_BF16(ws + WS_HY, ws + WS_WINE, EV_NP, 2048, ws + WS_Z, EV_NP); SEAM(2); }
    if (IN(3)) { ph_even_post(args, F); SEAM(3); }
    if (IN(4)) { pg8::Gemm g{(const pg8::bf16_t*)(ws + WS_LA), (const pg8::bf16_t*)(ws + WS_WL), TOK, 3072, 512}; pg8::StaticOrder S; S.init(TOK, 3072, F.G, F.bx);
                 EpiLora E{(pg8::bf16_t*)(ws + WS_Z) + 1280, EV_NP, (const float*)args.in[7], (const float*)args.in[9]};
                 pg8::gemm_phase<EpiLora, pg8::StaticOrder, false>(F.lds, g, S, E, nullptr); SEAM(4); }
    if (IN(5)) { ph_scan_pack(args, F); SEAM(5); }
    if (IN(6)) { PRB(3, ph_swa(args, F)); ph_swa(args, F); SEAM(6); }
    if (IN(7)) { PRB(0, ph_scan(args, F)); ph_scan(args, F); SEAM(7); }
    if (IN(8)) { ph_rwkv_finish(args, F); SEAM(8); }
    if (IN(9)) { GEMM_BF16(ws + WS_HY, ws + WS_WOUTE, 2048, 2048, ws + WS_Z, 2048); SEAM(9); }
    if (IN(10)) { ph_ln_mixer(args, F, 0); SEAM(10); }
    if (IN(11)) { GEMM_BF16(ws + WS_HY, ws + WS_WQ0, 2048, 2048, ws + WS_Z, 2048); SEAM(11); }
    if (IN(12)) { PRB(4, ph_peer_select(args, F, 0)); ph_peer_select(args, F, 0); SEAM(12); }
    if (IN(13)) { ph_peer_u(args, F, XI); xcd_barrier(bar); ph_peer_v(args, F, XI); xcd_barrier(bar); ph_peer_ln(args, F, 0); SEAM(13); }
    if (IN(14)) { GEMM_BF16(ws + WS_HY, ws + WS_WINO, OD_NP, 2048, ws + WS_Z, OD_NP); SEAM(14); }
    if (IN(15)) { ph_odd_post(args, F); SEAM(15); }
    if (IN(16)) { PRB(2, ph_dsa_select(args, F, 1)); PRB(6, ph_dsa_select(args, F, 2)); ph_dsa_select(args, F); SEAM(16); }
    if (IN(17)) { PRB(5, ph_dsa_attn(args, F)); ph_dsa_attn(args, F); SEAM(17); }
    if (IN(18)) { GEMM_BF16(ws + WS_HY, ws + WS_WOUTO, 2048, 2048, ws + WS_Z, 2048); SEAM(18); }
    if (IN(19)) { ph_ln_mixer(args, F, 1); SEAM(19); }
    if (IN(20)) { GEMM_BF16(ws + WS_HY, ws + WS_WQ1, 2048, 2048, ws + WS_Z, 2048); SEAM(20); }
    if (IN(21)) { PRB(4, ph_peer_select(args, F, 1)); ph_peer_select(args, F, 1); SEAM(21); }
    if (IN(22)) { ph_peer_u(args, F, XI); xcd_barrier(bar); ph_peer_v(args, F, XI); xcd_barrier(bar); ph_peer_ln(args, F, 1); }
#undef IN
#undef SEAM
#undef GEMM_BF16
}

#ifndef MK_SPLIT
#define MK_SPLIT 0
#endif
extern "C" void kernel_launch(void* const* d_in, const int* in_sizes, int n_in, void* d_out, int out_size, void* d_ws, size_t ws_size, hipStream_t stream) {
    static int grid = 0;
    if (grid == 0) {
        int dev = 0, cus = 0;
        if (n_in != 27 || out_size != TOK * DM || ws_size < WS_END) { fprintf(stderr, "kernel_launch: unexpected shapes (n_in %d out %d ws %zu)\n", n_in, out_size, ws_size); grid = -1; return; }
        if (hipGetDevice(&dev) != hipSuccess || hipDeviceGetAttribute(&cus, hipDeviceAttributeMultiprocessorCount, dev) != hipSuccess) { grid = -1; return; }
        if (hipFuncSetAttribute((const void*)mk_fwd, hipFuncAttributeMaxDynamicSharedMemorySize, LDS_BYTES) != hipSuccess) { fprintf(stderr, "kernel_launch: hipFuncSetAttribute failed\n"); grid = -1; return; }
        int per_cu = 0;
        if (hipOccupancyMaxActiveBlocksPerMultiprocessor(&per_cu, (const void*)mk_fwd, NTHREADS, LDS_BYTES) != hipSuccess || per_cu < 1) fprintf(stderr, "kernel_launch: occupancy query says %d\n", per_cu);
        (void)hipGetLastError();
        grid = cus;
    }
    if (grid < 0) return;
    (void)hipMemsetAsync((char*)d_ws + WS_CTL, 0, CTL_ZERO_BYTES, stream);
    Args a{};
    for (int i = 0; i < 27; ++i) a.in[i] = d_in[i];
    a.out = (float*)d_out; a.ws = (unsigned char*)d_ws;
#if MK_SPLIT
    for (int p = 0; p < 23; ++p) { a.ph_lo = p; a.ph_hi = p + 1; hipLaunchKernelGGL(mk_fwd, dim3(grid), dim3(NTHREADS), LDS_BYTES, stream, a); }
#else
    a.ph_lo = 0; a.ph_hi = 23;
    hipLaunchKernelGGL(mk_fwd, dim3(grid), dim3(NTHREADS), LDS_BYTES, stream, a);
#endif
}
```

```cpp
#include <hip/hip_runtime.h>
#include <cstdio>
#include <cstdint>
namespace pg8 {
#define PG8_LAS __attribute__((address_space(3)))
typedef unsigned short bf16_t;
typedef short bf16x8 __attribute__((ext_vector_type(8)));
typedef float f32x4 __attribute__((ext_vector_type(4)));
typedef unsigned u32x4 __attribute__((ext_vector_type(4)));
constexpr int BM = 256, BK = 64, HALF = 128, HTB = HALF * BK * 2  , STAGE_BYTES = 8 * HTB, NXCD = 8, WGM = 8;

__host__ __device__ __forceinline__ int lds_byte(int r, int c) { const int st = (r >> 4) * 2 + (c >> 5), rr = r & 15, cc = c & 31, ob = rr * 64 + cc * 2; return st * 1024 + (ob ^ (((ob >> 9) & 1) << 5)); }
__host__ __device__ __forceinline__ void stage_rc(int b, int& R, int& C) { const int st = b / 1024, sb = b % 1024, swz = sb ^ (((sb >> 9) & 1) << 5); R = (st >> 1) * 16 + swz / 64; C = (st & 1) * 32 + (swz % 64) / 2; }
__host__ __device__ __forceinline__ int perm32(int rho) { const int n = rho >> 4, i = rho & 15; return 8 * (i >> 2) + 4 * n + (i & 3); }

struct Unit { int pm, pn; };
struct Gemm { const bf16_t* A; const bf16_t* Bt; int M, N, K; };

struct StaticOrder {
    int nM, nN, nwg, G, c;
    __host__ __device__ void init(int M, int N, int G_, int c_) { nM = M / BM; nN = N / BM; nwg = nM * nN; G = G_; c = c_; }
    __host__ __device__ bool next(int i, Unit& u) const {
        const long L = (long)i * G + c; if (L >= nwg) return false;
        int wgid = (int)L; { const int q = nwg / NXCD, r = nwg % NXCD, xcd = wgid % NXCD, off = wgid / NXCD; wgid = (xcd < r ? xcd * (q + 1) : r * (q + 1) + (xcd - r) * q) + off; }
        const int nig = WGM * nN, gid = wgid / nig, fm = gid * WGM, gsz = (nM - fm) < WGM ? (nM - fm) : WGM;
        u.pm = fm + ((wgid % nig) % gsz); u.pn = (wgid % nig) / gsz; return true;
    }
    __device__ __forceinline__ void a_ready(const Unit&) const {}
    __device__ __forceinline__ void done(const Unit&) const {}
};
struct CountedOrder : StaticOrder {
    const unsigned* ready; unsigned need; unsigned* tmo;
    __device__ __forceinline__ void a_ready(const Unit& u) const {
        if (threadIdx.x < 64) {
            const unsigned long long t0 = __builtin_amdgcn_s_memrealtime(); unsigned polls = 0;
            while ((unsigned)__builtin_amdgcn_readfirstlane(__hip_atomic_load(ready + 64 * u.pm, __ATOMIC_RELAXED, __HIP_MEMORY_SCOPE_AGENT)) < need) {
                if ((++polls & 255u) == 0u && __builtin_amdgcn_readfirstlane(__hip_atomic_load(tmo, __ATOMIC_RELAXED, __HIP_MEMORY_SCOPE_AGENT)) != 0u) break;
                if (__builtin_amdgcn_s_memrealtime() - t0 > 2000000ull) {
                    if (threadIdx.x == 0) { unsigned expect = 0u; __hip_atomic_compare_exchange_strong(tmo + 1, &expect, 0x600u | (unsigned)(u.pm & 0xff), __ATOMIC_RELAXED, __ATOMIC_RELAXED, __HIP_MEMORY_SCOPE_AGENT); __hip_atomic_store(tmo, 1u, __ATOMIC_RELAXED, __HIP_MEMORY_SCOPE_AGENT); }
                    break; }
                __builtin_amdgcn_s_sleep(2); }
            __builtin_amdgcn_fence(__ATOMIC_ACQUIRE, "agent");
            asm volatile("s_waitcnt vmcnt(0)" ::: "memory");
        }
#if !defined(BROKEN_HOOK_NO_BARRIER)
        asm volatile("" ::: "memory"); __builtin_amdgcn_s_barrier(); asm volatile("" ::: "memory");
#endif
    }
};

__device__ __forceinline__ unsigned cvt_pk_bf16(float lo, float hi) { unsigned r; asm volatile("v_cvt_pk_bf16_f32 %0, %1, %2" : "=v"(r) : "v"(lo), "v"(hi)); return r; }
typedef float f32x2 __attribute__((ext_vector_type(2)));
__device__ __forceinline__ f32x2 gelu_pk(f32x2 v) {
    const f32x2 av = __builtin_elementwise_abs(v), d = av * 0.2316418882f + 1.0f;
    f32x2 t; t.x = __builtin_amdgcn_rcpf(d.x); t.y = __builtin_amdgcn_rcpf(d.y);
    f32x2 q = t * 0.5307027145f + (-0.7265760135f); q = q * t + 0.7107068705f; q = q * t + (-0.142248368f); q = q * t + 0.127414796f; q = q * t;
    const f32x2 s = (v * v) * (-0.72134752044f);
    f32x2 e; e.x = __builtin_amdgcn_exp2f(s.x); e.y = __builtin_amdgcn_exp2f(s.y);
    const f32x2 m = v * (q * e), r = v - m;
    f32x2 o; o.x = v.x < 0.f ? m.x : r.x; o.y = v.y < 0.f ? m.y : r.y; return o;
}

struct EpiF32 {
    static constexpr bool PERM = false, AFTER_DRAIN = false;
    float* C; int ldc; const float* bias;
    __device__ __forceinline__ void operator()(const f32x4 (&acc)[2][2][4][2], const Unit& u, int wr, int wc, int fr, int fq) const {
        const int row0 = u.pm * BM + wr * 64 + fr, col0 = u.pn * BM + wc * 32 + 4 * fq;
        f32x4 bv[2][2];
#pragma unroll
        for (int bj = 0; bj < 2; ++bj)
#pragma unroll
            for (int n = 0; n < 2; ++n) bv[bj][n] = bias ? *(const f32x4*)(bias + col0 + bj * HALF + n * 16) : (f32x4){0.f, 0.f, 0.f, 0.f};
#pragma unroll
        for (int ai = 0; ai < 2; ++ai)
#pragma unroll
            for (int m = 0; m < 4; ++m) { float* rowp = C + (size_t)(row0 + ai * HALF + m * 16) * ldc + col0;
#pragma unroll
                for (int bj = 0; bj < 2; ++bj)
#pragma unroll
                    for (int n = 0; n < 2; ++n) *(f32x4*)(rowp + bj * HALF + n * 16) = acc[ai][bj][m][n] + bv[bj][n]; }
    }
};
template <int ACT  > struct EpiBf16 {
    static constexpr bool PERM = true, AFTER_DRAIN = false;
    bf16_t* O; int ldc; const float* bias; int split_cols; size_t split_stride;
    __device__ __forceinline__ void operator()(const f32x4 (&acc)[2][2][4][2], const Unit& u, int wr, int wc, int fr, int fq) const {
        const int row0 = u.pm * BM + wr * 64 + fr; int colt = u.pn * BM; bf16_t* base = O;
        if (split_cols) { const int t = colt / split_cols; base += (size_t)t * split_stride; colt -= t * split_cols; }
        const int col0 = colt + wc * 32 + 8 * fq, bcol0 = u.pn * BM + wc * 32 + 8 * fq;
        f32x4 bv[2][2];
#pragma unroll
        for (int bj = 0; bj < 2; ++bj)
#pragma unroll
            for (int n = 0; n < 2; ++n) bv[bj][n] = bias ? *(const f32x4*)(bias + bcol0 + bj * HALF + 4 * n) : (f32x4){0.f, 0.f, 0.f, 0.f};
#pragma unroll
        for (int ai = 0; ai < 2; ++ai)
#pragma unroll
            for (int m = 0; m < 4; ++m) { bf16_t* rowp = base + (size_t)(row0 + ai * HALF + m * 16) * ldc + col0;
#pragma unroll
                for (int bj = 0; bj < 2; ++bj) { f32x4 v0 = acc[ai][bj][m][0] + bv[bj][0], v1 = acc[ai][bj][m][1] + bv[bj][1];
                    if (ACT == 1) { f32x2 a = gelu_pk((f32x2){v0[0], v0[1]}), b = gelu_pk((f32x2){v0[2], v0[3]}), c = gelu_pk((f32x2){v1[0], v1[1]}), d = gelu_pk((f32x2){v1[2], v1[3]});
                        v0 = (f32x4){a.x, a.y, b.x, b.y}; v1 = (f32x4){c.x, c.y, d.x, d.y}; }
                    if (ACT == 2) {
#pragma unroll
                        for (int j = 0; j < 4; ++j) { v0[j] = 0.5f * v0[j] * (1.0f + erff(v0[j] * 0.70710678f)); v1[j] = 0.5f * v1[j] * (1.0f + erff(v1[j] * 0.70710678f)); } }
                    u32x4 w; w.x = cvt_pk_bf16(v0[0], v0[1]); w.y = cvt_pk_bf16(v0[2], v0[3]); w.z = cvt_pk_bf16(v1[0], v1[1]); w.w = cvt_pk_bf16(v1[2], v1[3]);
                    *(u32x4*)(rowp + bj * HALF) = w; } }
    }
};

struct PanelStats {
    unsigned* xbuf;
    unsigned* cnt;
    unsigned* tmo;
    int ntn; float eps;
    unsigned code;
    __device__ __forceinline__ bool run(const f32x4 (&v)[2][2][4][2], const Unit& u, int wr, int wc, int fr, int fq, PG8_LAS unsigned char* lds, int wid, int lane) const {
        typedef float f32x2v __attribute__((ext_vector_type(2)));
        PG8_LAS f32x2v* P = (PG8_LAS f32x2v*)lds;
        PG8_LAS f32x2v* S = (PG8_LAS f32x2v*)(lds + 8192);
        PG8_LAS unsigned* flag = (PG8_LAS unsigned*)(lds + 8192 + 2048);
#pragma unroll
        for (int ai = 0; ai < 2; ++ai)
#pragma unroll
            for (int m = 0; m < 4; ++m) {
                float s = 0.f;
#pragma unroll
                for (int bj = 0; bj < 2; ++bj)
#pragma unroll
                    for (int n = 0; n < 2; ++n) { const f32x4 x = v[ai][bj][m][n]; s += (x[0] + x[1]) + (x[2] + x[3]); }
                s += __shfl_xor(s, 16); s += __shfl_xor(s, 32);
                const float mw = s * (1.0f / 64.0f); float q = 0.f;
#pragma unroll
                for (int bj = 0; bj < 2; ++bj)
#pragma unroll
                    for (int n = 0; n < 2; ++n) { const f32x4 d = v[ai][bj][m][n] - mw; q += (d[0] * d[0] + d[1] * d[1]) + (d[2] * d[2] + d[3] * d[3]); }
                q += __shfl_xor(q, 16); q += __shfl_xor(q, 32);
                if (fq == 0) P[(ai * HALF + wr * 64 + m * 16 + fr) * 4 + wc] = (f32x2v){mw, q};
            }
        asm volatile("s_waitcnt lgkmcnt(0)" ::: "memory"); __builtin_amdgcn_s_barrier(); asm volatile("" ::: "memory");
#if defined(BROKEN_NO_WAIT)
        if (blockIdx.x >= 64) { const long long t0 = clock64(); while (clock64() - t0 < 60000) __builtin_amdgcn_s_sleep(8); }
#endif
        const int row = wid * 32 + (lane & 31);
        if (lane < 32) {
            const f32x2v a = P[row * 4 + 0], b = P[row * 4 + 1], c = P[row * 4 + 2], d = P[row * 4 + 3];
            const float mt = (a.x + b.x + c.x + d.x) * 0.25f;
            const float da = a.x - mt, db = b.x - mt, dc = c.x - mt, dd = d.x - mt;
            const float m2 = (a.y + b.y) + (c.y + d.y) + 64.0f * ((da * da + db * db) + (dc * dc + dd * dd));
            unsigned long long* slot = (unsigned long long*)xbuf + ((size_t)(u.pm * BM + row) * 4 + u.pn);
            __hip_atomic_store(slot, ((unsigned long long)__float_as_uint(m2) << 32) | __float_as_uint(mt), __ATOMIC_RELAXED, __HIP_MEMORY_SCOPE_AGENT);
        }
        asm volatile("s_waitcnt vmcnt(0)" ::: "memory");
        if (lane == 0) __hip_atomic_fetch_add(cnt + 64 * u.pm, 1u, __ATOMIC_RELAXED, __HIP_MEMORY_SCOPE_AGENT);
        if (wid == 0) {
            bool dead = false; const unsigned long long t0 = __builtin_amdgcn_s_memrealtime(); const unsigned want = 8u * (unsigned)ntn;
            for (;;) {
#if defined(BROKEN_NO_WAIT)
                break;
#endif
                if ((unsigned)__builtin_amdgcn_readfirstlane(__hip_atomic_load(cnt + 64 * u.pm, __ATOMIC_RELAXED, __HIP_MEMORY_SCOPE_AGENT)) >= want) break;
                if (__builtin_amdgcn_s_memrealtime() - t0 > 2000000ull) {
                    if (lane == 0) { unsigned expect = 0u; __hip_atomic_compare_exchange_strong(tmo + 1, &expect, code | (unsigned)(u.pm & 0xff), __ATOMIC_RELAXED, __ATOMIC_RELAXED, __HIP_MEMORY_SCOPE_AGENT);
                                     __hip_atomic_store(tmo, 1u, __ATOMIC_RELAXED, __HIP_MEMORY_SCOPE_AGENT); }
                    dead = true; break; }
                __builtin_amdgcn_s_sleep(2);
            }
            __builtin_amdgcn_fence(__ATOMIC_ACQUIRE, "agent");
            if (lane == 0) flag[0] = dead ? 1u : 0u;
        }
        asm volatile("s_waitcnt vmcnt(0) lgkmcnt(0)" ::: "memory"); __builtin_amdgcn_s_barrier(); asm volatile("" ::: "memory");
        const bool bad = flag[0] != 0u;
        if (lane < 32) {
            const unsigned long long* slot = (const unsigned long long*)xbuf + (size_t)(u.pm * BM + row) * 4; float mt[4], m2[4]; float ms = 0.f;
#pragma unroll
            for (int t = 0; t < 4; ++t) { if (t < ntn) { const unsigned long long w = __hip_atomic_load(slot + t, __ATOMIC_RELAXED, __HIP_MEMORY_SCOPE_AGENT); mt[t] = __uint_as_float((unsigned)w); m2[t] = __uint_as_float((unsigned)(w >> 32)); } else { mt[t] = 0.f; m2[t] = 0.f; } ms += mt[t]; }
            const float mean = ms / (float)ntn; float q = 0.f;
#pragma unroll
            for (int t = 0; t < 4; ++t) if (t < ntn) { const float dm = mt[t] - mean; q += m2[t] + 256.0f * dm * dm; }
            S[row] = (f32x2v){mean, 1.0f / sqrtf(q / (256.0f * (float)ntn) + eps)};
        }
        asm volatile("s_waitcnt lgkmcnt(0)" ::: "memory"); __builtin_amdgcn_s_barrier(); asm volatile("" ::: "memory");
        return bad;
    }
};
struct EpiLnRes {
    static constexpr bool PERM = false, AFTER_DRAIN = true;
    const float* base; float* out; int ldc; const float* bias; PanelStats st; unsigned poison;
    __device__ __forceinline__ void refuse(size_t i0, size_t stride, int M, int N) const { const float q = __builtin_nanf(""); for (size_t i = i0; i < (size_t)M * N; i += stride) out[(i / N) * ldc + i % N] = q;
        if (i0 == 0) { unsigned expect = 0u; __hip_atomic_compare_exchange_strong(st.tmo + 1, &expect, 0x7f0u, __ATOMIC_RELAXED, __ATOMIC_RELAXED, __HIP_MEMORY_SCOPE_AGENT); __hip_atomic_store(st.tmo, 1u, __ATOMIC_RELAXED, __HIP_MEMORY_SCOPE_AGENT); } }
    __device__ __forceinline__ void fused(f32x4 (&acc)[2][2][4][2], const Unit& u, int wr, int wc, int fr, int fq, PG8_LAS unsigned char* lds, int wid, int lane) const {
        typedef float f32x2v __attribute__((ext_vector_type(2)));
        const PG8_LAS f32x2v* S = (const PG8_LAS f32x2v*)(lds + 8192);
        const int col0 = u.pn * BM + wc * 32 + 4 * fq;
#pragma unroll
        for (int bj = 0; bj < 2; ++bj)
#pragma unroll
            for (int n = 0; n < 2; ++n) { const f32x4 bv = bias ? *(const f32x4*)(bias + col0 + bj * HALF + n * 16) : (f32x4){0.f, 0.f, 0.f, 0.f};
#pragma unroll
                for (int ai = 0; ai < 2; ++ai)
#pragma unroll
                    for (int m = 0; m < 4; ++m) acc[ai][bj][m][n] += bv; }
        const bool bad = st.run(acc, u, wr, wc, fr, fq, lds, wid, lane) || poison != 0u;
        const float qnan = __builtin_nanf("");
#pragma unroll
        for (int ai = 0; ai < 2; ++ai)
#pragma unroll
            for (int m = 0; m < 4; ++m) { const int r = ai * HALF + wr * 64 + m * 16 + fr; const f32x2v sr = S[r]; const size_t off = (size_t)(u.pm * BM + r) * ldc + col0;
#pragma unroll
                for (int bj = 0; bj < 2; ++bj)
#pragma unroll
                    for (int n = 0; n < 2; ++n) { const f32x4 bs = *(const f32x4*)(base + off + bj * HALF + n * 16); f32x4 o = bs + (acc[ai][bj][m][n] - sr.x) * sr.y;
                        if (bad) o = (f32x4){qnan, qnan, qnan, qnan}; *(f32x4*)(out + off + bj * HALF + n * 16) = o; }
                asm volatile("" ::: "memory"); }
    }
};
struct EpiLnResLn {
    static constexpr bool PERM = false, AFTER_DRAIN = true;
    const float* base; float* out; bf16_t* xn; int ldc; const float* bias; PanelStats st1, st2; unsigned poison;
    __device__ __forceinline__ void refuse(size_t i0, size_t stride, int M, int N) const { const float q = __builtin_nanf(""); for (size_t i = i0; i < (size_t)M * N; i += stride) { const size_t o = (i / N) * ldc + i % N; out[o] = q; xn[o] = (bf16_t)0x7fc0u; }
        if (i0 == 0) { unsigned expect = 0u; __hip_atomic_compare_exchange_strong(st1.tmo + 1, &expect, 0x7f0u, __ATOMIC_RELAXED, __ATOMIC_RELAXED, __HIP_MEMORY_SCOPE_AGENT); __hip_atomic_store(st1.tmo, 1u, __ATOMIC_RELAXED, __HIP_MEMORY_SCOPE_AGENT); } }
    __device__ __forceinline__ void fused(f32x4 (&acc)[2][2][4][2], const Unit& u, int wr, int wc, int fr, int fq, PG8_LAS unsigned char* lds, int wid, int lane) const {
        typedef float f32x2v __attribute__((ext_vector_type(2))); typedef unsigned u32x2v __attribute__((ext_vector_type(2)));
        const PG8_LAS f32x2v* S = (const PG8_LAS f32x2v*)(lds + 8192);
        const int col0 = u.pn * BM + wc * 32 + 4 * fq;
#pragma unroll
        for (int bj = 0; bj < 2; ++bj)
#pragma unroll
            for (int n = 0; n < 2; ++n) { const f32x4 bv = bias ? *(const f32x4*)(bias + col0 + bj * HALF + n * 16) : (f32x4){0.f, 0.f, 0.f, 0.f};
#pragma unroll
                for (int ai = 0; ai < 2; ++ai)
#pragma unroll
                    for (int m = 0; m < 4; ++m) acc[ai][bj][m][n] += bv; }
        bool bad = st1.run(acc, u, wr, wc, fr, fq, lds, wid, lane) || poison != 0u;
        const float qnan = __builtin_nanf("");
#pragma unroll
        for (int ai = 0; ai < 2; ++ai)
#pragma unroll
            for (int m = 0; m < 4; ++m) { const int r = ai * HALF + wr * 64 + m * 16 + fr; const f32x2v sr = S[r]; const size_t off = (size_t)(u.pm * BM + r) * ldc + col0;
#pragma unroll
                for (int bj = 0; bj < 2; ++bj)
#pragma unroll
                    for (int n = 0; n < 2; ++n) { const f32x4 bs = *(const f32x4*)(base + off + bj * HALF + n * 16); acc[ai][bj][m][n] = bs + (acc[ai][bj][m][n] - sr.x) * sr.y; }
                asm volatile("" : "+v"(acc[ai][0][m][0]), "+v"(acc[ai][0][m][1]), "+v"(acc[ai][1][m][0]), "+v"(acc[ai][1][m][1]));
                if (m & 1) asm volatile("" ::: "memory"); }
        const bool bad1 = bad;
        bad = st2.run(acc, u, wr, wc, fr, fq, lds, wid, lane) || bad;
#pragma unroll
        for (int ai = 0; ai < 2; ++ai)
#pragma unroll
            for (int m = 0; m < 4; ++m) { const int r = ai * HALF + wr * 64 + m * 16 + fr; const f32x2v sr = S[r]; const size_t off = (size_t)(u.pm * BM + r) * ldc + col0;
#pragma unroll
                for (int bj = 0; bj < 2; ++bj)
#pragma unroll
                    for (int n = 0; n < 2; ++n) { const f32x4 x1 = acc[ai][bj][m][n]; *(f32x4*)(out + off + bj * HALF + n * 16) = bad1 ? (f32x4){qnan, qnan, qnan, qnan} : x1;
                        const f32x4 o = (x1 - sr.x) * sr.y; u32x2v w; w.x = cvt_pk_bf16(o[0], o[1]); w.y = cvt_pk_bf16(o[2], o[3]);
                        if (bad) { w.x = 0x7fc07fc0u; w.y = 0x7fc07fc0u; } *(u32x2v*)(xn + off + bj * HALF + n * 16) = w; }
                asm volatile("" ::: "memory"); }
    }
};

template <class Epi, class Sched, bool STAMP = false>
__device__ __forceinline__ void gemm_phase(PG8_LAS unsigned char* lds, const Gemm g, const Sched& S, const Epi& E, unsigned long long* stamps) {
    const int tid = threadIdx.x, wid = __builtin_amdgcn_readfirstlane(tid >> 6), lane = tid & 63, wr = wid >> 2, wc = wid & 3, fr = lane & 15, fq = lane >> 4;
    const int K = g.K, nt = K / BK;
    int ts_lo = 0, ts_hi = 0, nts = 0; const unsigned long long rt_entry = STAMP ? (unsigned long long)wall_clock64() : 0ull;
#define PG8_STAMP() do { if (STAMP && wid == 0 && nts < 64) { const unsigned long long _c = (unsigned long long)clock64(); \
        ts_lo = (lane == nts) ? (int)(unsigned)_c : ts_lo; ts_hi = (lane == nts) ? (int)(unsigned)(_c >> 32) : ts_hi; ++nts; } } while (0)
    PG8_STAMP();
    unsigned voffA[2], voffB[2];
#pragma unroll
    for (int i = 0; i < 2; ++i) { int R, C; stage_rc(tid * 16 + i * 8192, R, C); const int Rb = Epi::PERM ? ((R & ~31) + perm32(R & 31)) : R;
        voffA[i] = (unsigned)(R * K + C) * 2u; voffB[i] = (unsigned)(Rb * K + C) * 2u; }
    const size_t kstep = (size_t)(BK * 2);
    const size_t hstep = (size_t)HALF * K * 2;
    const size_t tstep = 2 * hstep;
    const unsigned ldsw = (unsigned)wid * 1024u;
    const int aoff = lds_byte(wr * 64 + fr, fq * 8), boff = lds_byte(wc * 32 + fr, fq * 8);
#define PG8_SA(b, h) (((b) * 2 + (h)) * HTB)
#define PG8_SB(b, h) ((4 + (b) * 2 + (h)) * HTB)
#define PG8_STAGE(bufoff, gbase, voff) do { _Pragma("unroll") for (int _i = 0; _i < 2; ++_i) \
        __builtin_amdgcn_global_load_lds((const unsigned*)((const char*)(gbase) + (voff)[_i]), (PG8_LAS unsigned*)(lds + (bufoff) + ldsw + _i * 8192), 16, 0, 0); } while (0)
#define PG8_LDA(dst, b, h) do { _Pragma("unroll") for (int m = 0; m < 4; ++m) _Pragma("unroll") for (int k = 0; k < 2; ++k) dst[m][k] = *(const PG8_LAS bf16x8*)(lds + PG8_SA(b, h) + aoff + m * 2048 + k * 1024); } while (0)
#define PG8_LDB(dst, b, h) do { _Pragma("unroll") for (int n = 0; n < 2; ++n) _Pragma("unroll") for (int k = 0; k < 2; ++k) dst[n][k] = *(const PG8_LAS bf16x8*)(lds + PG8_SB(b, h) + boff + n * 2048 + k * 1024); } while (0)
#define PG8_MMA(ai, bj, At, Bt) do { __builtin_amdgcn_s_setprio(1); _Pragma("unroll") for (int m = 0; m < 4; ++m) _Pragma("unroll") for (int n = 0; n < 2; ++n) _Pragma("unroll") for (int k = 0; k < 2; ++k) \
        acc[ai][bj][m][n] = __builtin_amdgcn_mfma_f32_16x16x32_bf16(Bt[n][k], At[m][k], acc[ai][bj][m][n], 0, 0, 0); __builtin_amdgcn_s_setprio(0); } while (0)
#define PG8_WAIT_V(n) asm volatile("s_waitcnt vmcnt(" #n ")" ::: "memory")
#define PG8_WAIT_L(n) asm volatile("s_waitcnt lgkmcnt(" #n ")" ::: "memory")
#define PG8_BAR __builtin_amdgcn_s_barrier()
#define PG8_SCHED __builtin_amdgcn_sched_barrier(0)
    Unit cur, nxt; int ui = 0;
    if (!S.next(0, cur)) return;
    f32x4 acc[2][2][4][2];
#pragma unroll
    for (int a = 0; a < 2; ++a)
#pragma unroll
        for (int b = 0; b < 2; ++b)
#pragma unroll
            for (int m = 0; m < 4; ++m)
#pragma unroll
                for (int n = 0; n < 2; ++n) acc[a][b][m][n] = (f32x4){0.f, 0.f, 0.f, 0.f};
    bf16x8 At[4][2], B0[2][2], B1[2][2];
    const char* cA = (const char*)g.A + (size_t)cur.pm * tstep; const char* cB = (const char*)g.Bt + (size_t)cur.pn * tstep;
    S.a_ready(cur);
    PG8_STAGE(PG8_SB(0, 0), cB, voffB); PG8_STAGE(PG8_SA(0, 0), cA, voffA); PG8_STAGE(PG8_SB(0, 1), cB + hstep, voffB); PG8_STAGE(PG8_SA(0, 1), cA + hstep, voffA);
    if (wr == 1) PG8_BAR;
    PG8_WAIT_V(4); PG8_BAR;
    PG8_STAGE(PG8_SB(1, 0), cB + kstep, voffB); PG8_STAGE(PG8_SA(1, 0), cA + kstep, voffA); PG8_STAGE(PG8_SB(1, 1), cB + hstep + kstep, voffB);
    PG8_WAIT_V(6); PG8_BAR;
    PG8_STAMP();
    for (;;) {
        const bool has_next = S.next(ui + 1, nxt);
        const char* nA = has_next ? (const char*)g.A + (size_t)nxt.pm * tstep : cA; const char* nB = has_next ? (const char*)g.Bt + (size_t)nxt.pn * tstep : cB;
        for (int t = 0; t < nt; t += 2) {
            const bool last = (t == nt - 2);
            const char* a1 = cA + (size_t)(t + 1) * kstep;
            const char* a2 = last ? nA : cA + (size_t)(t + 2) * kstep; const char* b2 = last ? nB : cB + (size_t)(t + 2) * kstep;
            const char* a3 = a2 + kstep; const char* b3 = b2 + kstep;
            if (last && has_next) S.a_ready(nxt);
            PG8_LDB(B0, 0, 0); PG8_SCHED; PG8_LDA(At, 0, 0); PG8_STAGE(PG8_SA(1, 1), a1 + hstep, voffA);
            PG8_WAIT_L(8); PG8_BAR; PG8_WAIT_L(0); PG8_MMA(0, 0, At, B0); PG8_BAR; PG8_SCHED;
            PG8_LDB(B1, 0, 1); PG8_STAGE(PG8_SB(0, 0), b2, voffB);
            PG8_BAR; PG8_WAIT_L(0); PG8_MMA(0, 1, At, B1); PG8_BAR;
            PG8_LDA(At, 0, 1); PG8_STAGE(PG8_SA(0, 0), a2, voffA);
            PG8_BAR; PG8_WAIT_L(0); PG8_MMA(1, 0, At, B0); PG8_BAR; PG8_SCHED;
            PG8_STAGE(PG8_SB(0, 1), b2 + hstep, voffB);
            PG8_WAIT_V(6); PG8_BAR; PG8_MMA(1, 1, At, B1); PG8_BAR;
            PG8_LDB(B0, 1, 0); PG8_SCHED; PG8_LDA(At, 1, 0); PG8_STAGE(PG8_SA(0, 1), a2 + hstep, voffA);
            PG8_WAIT_L(8); PG8_BAR; PG8_WAIT_L(0); PG8_MMA(0, 0, At, B0); PG8_BAR; PG8_SCHED;
            PG8_LDB(B1, 1, 1); PG8_STAGE(PG8_SB(1, 0), b3, voffB);
            PG8_BAR; PG8_WAIT_L(0); PG8_MMA(0, 1, At, B1); PG8_BAR;
            PG8_LDA(At, 1, 1); PG8_STAGE(PG8_SA(1, 0), a3, voffA);
            PG8_BAR; PG8_WAIT_L(0); PG8_MMA(1, 0, At, B0); PG8_BAR; PG8_SCHED;
            PG8_STAGE(PG8_SB(1, 1), b3 + hstep, voffB);
            PG8_WAIT_V(6); PG8_BAR; PG8_MMA(1, 1, At, B1); PG8_BAR;
        }
        PG8_STAMP();
        if constexpr (!Epi::AFTER_DRAIN) { E(acc, cur, wr, wc, fr, fq); S.done(cur); }
        PG8_STAMP();
        if (!has_next) break;
#pragma unroll
        for (int a = 0; a < 2; ++a)
#pragma unroll
            for (int b = 0; b < 2; ++b)
#pragma unroll
                for (int m = 0; m < 4; ++m)
#pragma unroll
                    for (int n = 0; n < 2; ++n) acc[a][b][m][n] = (f32x4){0.f, 0.f, 0.f, 0.f};
        cur = nxt; cA = nA; cB = nB; ++ui;
    }
    PG8_WAIT_V(0);
    if (wr == 0) PG8_BAR;
    PG8_BAR;
    if constexpr (Epi::AFTER_DRAIN) { E.fused(acc, cur, wr, wc, fr, fq, lds, wid, lane); S.done(cur); }
    PG8_STAMP();
    if (STAMP && wid == 0) { stamps[lane] = lane < nts ? (((unsigned long long)(unsigned)ts_hi << 32) | (unsigned)ts_lo) : 0ull;
        if (lane == 62) stamps[62] = rt_entry; if (lane == 63) stamps[63] = (unsigned long long)wall_clock64(); }
#undef PG8_STAMP
#undef PG8_SA
#undef PG8_SB
#undef PG8_STAGE
#undef PG8_LDA
#undef PG8_LDB
#undef PG8_MMA
#undef PG8_WAIT_V
#undef PG8_WAIT_L
#undef PG8_BAR
#undef PG8_SCHED
}
}

#define LAS __attribute__((address_space(3)))
#define XB_TMO      128
#define XB_XCNT(j)  (256  + 64 * (j))
#define XB_XSUB(j)  (1280 + 64 * (j))
#define XB_XGEN(j)  (2304 + 64 * (j))
#define XB_TOP      3328
#define XB_TOPGEN   3392
#define XCD_BAR_WORDS 3456
#define XB_SPIN_CAP (1u << 24)

__device__ __forceinline__ unsigned xb_ld(unsigned* p)              { return __hip_atomic_load(p, __ATOMIC_RELAXED, __HIP_MEMORY_SCOPE_AGENT); }
__device__ __forceinline__ unsigned xb_add(unsigned* p, unsigned v) { return __hip_atomic_fetch_add(p, v, __ATOMIC_RELAXED, __HIP_MEMORY_SCOPE_AGENT); }
__device__ __forceinline__ unsigned xb_xcc_id() { return (unsigned)__builtin_amdgcn_s_getreg((3 << 11) | 20) & 0xFu; }
#define XB_SPIN(cond, bar) do { unsigned _sp = 0; while (cond) { __builtin_amdgcn_s_sleep(1); \
    if ((++_sp & 255u) == 0u) { if (xb_ld(&(bar)[XB_TMO])) break; if (_sp > XB_SPIN_CAP) { atomicAdd(&(bar)[XB_TMO], 1u); break; } } } } while (0)

struct XcdBarrier { unsigned* bar; unsigned x; volatile LAS unsigned* st; };

__device__ __forceinline__ XcdBarrier xcd_barrier_post(unsigned* bar, volatile LAS unsigned* st) {
    XcdBarrier b; b.bar = bar; b.x = xb_xcc_id(); b.st = st;
    if (threadIdx.x == 0) (void)xb_add(&bar[XB_XCNT(b.x)], 1u);
    return b;
}
__device__ __forceinline__ void xcd_barrier_complete(unsigned* bar, unsigned x, unsigned& nloc, unsigned& nx) {
    const unsigned G = gridDim.x * gridDim.y * gridDim.z;
    unsigned sum, cnt, mine, sp = 0u;
    for (;;) {
        sum = 0u; cnt = 0u; mine = 0u;
#pragma unroll
        for (unsigned j = 0; j < 16; ++j) { const unsigned c = xb_ld(&bar[XB_XCNT(j)]); sum += c; cnt += (c > 0u) ? 1u : 0u; mine = (j == x) ? c : mine; }
        if (sum == G) break;
        __builtin_amdgcn_s_sleep(1);
        if ((++sp & 255u) == 0u) { if (xb_ld(&bar[XB_TMO])) break; if (sp > XB_SPIN_CAP) { atomicAdd(&bar[XB_TMO], 1u); break; } }
    }
    nloc = mine > 0u ? mine : 1u; nx = cnt > 0u ? cnt : 1u;
}
__device__ __forceinline__ void xcd_barrier(const XcdBarrier& b) {
    asm volatile("s_waitcnt vmcnt(0)" ::: "memory");
    __syncthreads();
    if (threadIdx.x == 0) {
        unsigned* bar = b.bar;
        __builtin_amdgcn_s_waitcnt(0);
        unsigned nloc = b.st[0], nx = b.st[1];
        if (nloc == 0u) { xcd_barrier_complete(bar, b.x, nloc, nx); b.st[0] = nloc; b.st[1] = nx; }
        const unsigned old = xb_add(&bar[XB_XSUB(b.x)], 1u);
        const unsigned gen = old / nloc;
        if (old + 1u == (gen + 1u) * nloc) {
            __builtin_amdgcn_fence(__ATOMIC_RELEASE, "agent");
            asm volatile("s_waitcnt vmcnt(0)" ::: "memory");
            const unsigned og = xb_add(&bar[XB_TOP], 1u);
            const unsigned tg = og / nx;
            if (og + 1u == (tg + 1u) * nx) xb_add(&bar[XB_TOPGEN], 1u);
            else XB_SPIN(xb_ld(&bar[XB_TOPGEN]) == tg, bar);
            __builtin_amdgcn_fence(__ATOMIC_ACQUIRE, "agent");
            xb_add(&bar[XB_XGEN(b.x)], 1u);
            asm volatile("s_waitcnt vmcnt(0)" ::: "memory");
        } else {
            XB_SPIN(xb_ld(&bar[XB_XGEN(b.x)]) == gen, bar);
            __builtin_amdgcn_fence(__ATOMIC_ACQUIRE, "agent");
            asm volatile("s_waitcnt vmcnt(0)" ::: "memory");
        }
    }
    __syncthreads();
}

typedef unsigned short bf16;
typedef float f32x4 __attribute__((ext_vector_type(4)));
typedef float f32x16 __attribute__((ext_vector_type(16)));
typedef float f32x2 __attribute__((ext_vector_type(2)));
typedef unsigned u32x4 __attribute__((ext_vector_type(4)));
typedef unsigned u32x2 __attribute__((ext_vector_type(2)));
typedef short bf16x8 __attribute__((ext_vector_type(8)));
typedef __bf16 bf2_t __attribute__((ext_vector_type(2)));

constexpr int NTHREADS = 512, NWAVES = 8;
constexpr int LDS_BYTES = 160 * 1024;
constexpr int MISC_OFF = LDS_BYTES - 256;
constexpr int TOK = 32768, SEQ = 16384, DM = 2048;
constexpr int EV_N = 4800, EV_NP = 4864, OD_N = 4176, OD_NP = 4352;
constexpr float ALPHA = 1.41421356237f;
constexpr size_t MiB = 1u << 20;
constexpr size_t WS_CTL = 0, CTL_ZERO_BYTES = 1 * MiB;
constexpr int CW_BAR = 4096, CW_XRANK = 8192;
constexpr size_t WS_MOD = 1 * MiB, WS_SKB = 2 * MiB, WS_WL = 4 * MiB, WS_BS = 7 * MiB, WS_CNT = 9 * MiB;
constexpr size_t WS_WINE = 10 * MiB, WS_WOUTE = 29 * MiB, WS_WINO = 37 * MiB, WS_WOUTO = 54 * MiB, WS_WQ0 = 62 * MiB, WS_WQ1 = 70 * MiB;
constexpr size_t WS_HY = 78 * MiB, WS_Z = 206 * MiB, WS_LA = 510 * MiB, WS_BIG = 542 * MiB, WS_END = 926 * MiB;

__device__ __forceinline__ float bf2f(unsigned short b) { return __uint_as_float(((unsigned)b) << 16); }
__device__ __forceinline__ unsigned f2bf(float f) { unsigned u = __float_as_uint(f); return (u + 0x7fffu + ((u >> 16) & 1u)) >> 16; }
__device__ __forceinline__ unsigned pk2(float lo, float hi) { return f2bf(lo) | (f2bf(hi) << 16); }
__device__ __forceinline__ float lo2f(unsigned w) { return __uint_as_float(w << 16); }
__device__ __forceinline__ float hi2f(unsigned w) { return __uint_as_float(w & 0xffff0000u); }
__device__ __forceinline__ float wsum(float v) {
#pragma unroll
    for (int o = 32; o >= 1; o >>= 1) v += __shfl_xor(v, o);
    return v;
}
__device__ __forceinline__ float wmax(float v) {
#pragma unroll
    for (int o = 32; o >= 1; o >>= 1) v = fmaxf(v, __shfl_xor(v, o));
    return v;
}
__device__ __forceinline__ float rdlane(float v, int l) { return __int_as_float(__builtin_amdgcn_readlane(__float_as_int(v), l)); }
__device__ __forceinline__ unsigned rdlaneu(unsigned v, int l) { return (unsigned)__builtin_amdgcn_readlane((int)v, l); }
__device__ __forceinline__ float dot2bf(unsigned a, unsigned b, float c) {
    return __builtin_amdgcn_fdot2_f32_bf16(__builtin_bit_cast(bf2_t, a), __builtin_bit_cast(bf2_t, b), c, false);
}
template <int CTRL, int RM> __device__ __forceinline__ float dppf(float v) {
    return __int_as_float(__builtin_amdgcn_update_dpp(0, __float_as_int(v), CTRL, RM, 0xF, false));
}
__device__ __forceinline__ float wsum_dpp(float v) {
    v += dppf<0xB1, 0xF>(v);
    v += dppf<0x4E, 0xF>(v);
    v += dppf<0x141, 0xF>(v);
    v += dppf<0x140, 0xF>(v);
    v += dppf<0x142, 0xA>(v);
    v += dppf<0x143, 0xC>(v);
    return rdlane(v, 63);
}
__device__ __forceinline__ float sum16_dpp(float v) {
    v += dppf<0xB1, 0xF>(v); v += dppf<0x4E, 0xF>(v); v += dppf<0x141, 0xF>(v); v += dppf<0x140, 0xF>(v);
    return v;
}
__device__ __forceinline__ float sigmoidf_(float x) { return 1.0f / (1.0f + expf(-x)); }
__device__ __forceinline__ unsigned ordkey(float f) { const unsigned u = __float_as_uint(f); return (u & 0x80000000u) ? ~u : (u | 0x80000000u); }
__device__ __forceinline__ unsigned fixkey20(float f) { const float c = fminf(fmaxf(f, -15.999f), 15.999f); return (unsigned)((int)rintf(c * 32768.0f) + (1 << 19)); }
__device__ __forceinline__ float unordkey(unsigned k) { return __uint_as_float((k & 0x80000000u) ? (k & 0x7fffffffu) : ~k); }

struct Args { const void* in[27]; float* out; unsigned char* ws; int ph_lo, ph_hi; };
struct Frame { LAS unsigned char* lds; int tid, lane, wave, bx, G, gw, ngw; };

struct EpiLora {
    static constexpr bool PERM = true, AFTER_DRAIN = false;
    pg8::bf16_t* O; int ldc; const float* w0; const float* a0;
    __device__ __forceinline__ void operator()(const pg8::f32x4 (&acc)[2][2][4][2], const pg8::Unit& u, int wr, int wc, int fr, int fq) const {
        const int row0 = u.pm * 256 + wr * 64 + fr; const int colt = u.pn * 256; const int type = u.pn >> 2;
        const int col0 = colt + wc * 32 + 8 * fq, ncol0 = col0 & 1023;
        const float* pv = (type == 0) ? w0 : a0;
        pg8::f32x4 bv[2][2];
#pragma unroll
        for (int bj = 0; bj < 2; ++bj)
#pragma unroll
            for (int n = 0; n < 2; ++n) bv[bj][n] = (type < 2) ? *(const pg8::f32x4*)(pv + ncol0 + bj * 128 + 4 * n) : (pg8::f32x4){0.f, 0.f, 0.f, 0.f};
#pragma unroll
        for (int ai = 0; ai < 2; ++ai)
#pragma unroll
            for (int m = 0; m < 4; ++m) { pg8::bf16_t* rowp = O + (size_t)(row0 + ai * 128 + m * 16) * ldc + col0;
#pragma unroll
                for (int bj = 0; bj < 2; ++bj) { pg8::f32x4 v0 = acc[ai][bj][m][0] + bv[bj][0], v1 = acc[ai][bj][m][1] + bv[bj][1];
                    if (type < 2) {
                        const float sc = (type == 0) ? 0.60653066f : 1.0f;
#pragma unroll
                        for (int j = 0; j < 4; ++j) { v0[j] = sc / (1.0f + __expf(-v0[j])); v1[j] = sc / (1.0f + __expf(-v1[j])); }
                    }
                    pg8::u32x4 w; w.x = pg8::cvt_pk_bf16(v0[0], v0[1]); w.y = pg8::cvt_pk_bf16(v0[2], v0[3]); w.z = pg8::cvt_pk_bf16(v1[0], v1[1]); w.w = pg8::cvt_pk_bf16(v1[2], v1[3]);
                    *(pg8::u32x4*)(rowp + bj * 128) = w; } }
    }
};

__device__ __forceinline__ void transpose_item(const float* W, int K, int N, int Npad, bf16* WT, LAS float* scr, int item, int lane) {
    const int nblk = Npad / 32, kb = item / nblk, nb = item % nblk, k0 = 64 * kb, n0 = 32 * nb;
    const int nl = lane & 31; const bool ok = (n0 + nl) < N;
#pragma unroll 8
    for (int i = 0; i < 32; ++i) { const int kk = 2 * i + (lane >> 5); scr[kk * 33 + nl] = ok ? W[(size_t)(k0 + kk) * N + n0 + nl] : 0.f; }
    asm volatile("s_waitcnt lgkmcnt(0)" ::: "memory");
    const int c = lane & 7;
#pragma unroll
    for (int j = 0; j < 4; ++j) { const int n = (lane >> 3) + 8 * j; const LAS float* s = scr + (8 * c) * 33 + n;
        u32x4 o; o.x = pk2(s[0 * 33], s[1 * 33]); o.y = pk2(s[2 * 33], s[3 * 33]); o.z = pk2(s[4 * 33], s[5 * 33]); o.w = pk2(s[6 * 33], s[7 * 33]);
        *(u32x4*)(WT + (size_t)(n0 + n) * K + k0 + 8 * c) = o; }
    asm volatile("s_waitcnt lgkmcnt(0)" ::: "memory");
}

__device__ __forceinline__ void ph_prologue(const Args& A, Frame& F) {
    unsigned char* ws = A.ws;
    {
        const float* c = (const float*)A.in[1]; const float* mw = (const float*)A.in[19]; const float* mb = (const float*)A.in[20];
        float* MOD = (float*)(ws + WS_MOD);
        LAS float* red = (LAS float*)F.lds;
        for (int it = F.bx; it < 96; it += F.G) {
            const int s = it / 24, cc = it % 24, col = cc * 256 + F.lane * 4;
            const float* W = mw + (size_t)s * 2048 * 6144 + col;
            f32x4 a0 = {0.f, 0.f, 0.f, 0.f}, a1 = {0.f, 0.f, 0.f, 0.f};
            const int k0 = F.wave * 256;
#pragma unroll 8
            for (int k = k0; k < k0 + 256; ++k) {
                float c0 = c[k], c1 = c[2048 + k];
                c0 = c0 / (1.0f + expf(-c0)); c1 = c1 / (1.0f + expf(-c1));
                const f32x4 w = *(const f32x4*)(W + (size_t)k * 6144);
                a0 += c0 * w; a1 += c1 * w;
            }
            *(LAS f32x4*)(red + ((F.wave * 2 + 0) * 256 + F.lane * 4)) = a0;
            *(LAS f32x4*)(red + ((F.wave * 2 + 1) * 256 + F.lane * 4)) = a1;
            __syncthreads();
            { const int b = F.tid >> 8, cl = F.tid & 255; float sm = 0.f;
#pragma unroll
              for (int w = 0; w < 8; ++w) sm += red[(w * 2 + b) * 256 + cl];
              MOD[(size_t)(s * 2 + b) * 6144 + cc * 256 + cl] = sm + mb[s * 6144 + cc * 256 + cl]; }
            __syncthreads();
        }
    }
    {
        LAS float* scr = (LAS float*)(F.lds + 16384 + F.wave * 8704);
        constexpr int I0 = 32 * (EV_NP / 32), I1 = 32 * 64, I2 = 32 * (OD_NP / 32);
        constexpr int NIT = I0 + I1 + I2 + 3 * I1;
        for (int it = F.gw; it < NIT; it += F.ngw) {
            int r = it;
            if (r < I0) { transpose_item((const float*)A.in[3], 2048, EV_N, EV_NP, (bf16*)(ws + WS_WINE), scr, r, F.lane); continue; } r -= I0;
            if (r < I1) { transpose_item((const float*)A.in[4], 2048, 2048, 2048, (bf16*)(ws + WS_WOUTE), scr, r, F.lane); continue; } r -= I1;
            if (r < I2) { transpose_item((const float*)A.in[17], 2048, OD_N, OD_NP, (bf16*)(ws + WS_WINO), scr, r, F.lane); continue; } r -= I2;
            if (r < I1) { transpose_item((const float*)A.in[18], 2048, 2048, 2048, (bf16*)(ws + WS_WOUTO), scr, r, F.lane); continue; } r -= I1;
            if (r < I1) { transpose_item((const float*)A.in[23], 2048, 2048, 2048, (bf16*)(ws + WS_WQ0), scr, r, F.lane); continue; } r -= I1;
            transpose_item((const float*)A.in[23] + (size_t)2048 * 2048, 2048, 2048, 2048, (bf16*)(ws + WS_WQ1), scr, r, F.lane);
        }
    }
    {
        const float* w2 = (const float*)A.in[8]; const float* a2 = (const float*)A.in[10]; const float* g2 = (const float*)A.in[11];
        bf16* WL = (bf16*)(ws + WS_WL);
        const int gt = F.bx * NTHREADS + F.tid, ngt = F.G * NTHREADS;
        for (int i = gt; i < 3072 * 512; i += ngt) {
            const int n = i >> 9, k = i & 511; float v = 0.f;
            if (n < 1024) { if (k < 96) v = w2[k * 1024 + n]; }
            else if (n < 2048) { if (k >= 96 && k < 192) v = a2[(k - 96) * 1024 + (n - 1024)]; }
            else { if (k >= 192 && k < 448) v = g2[(k - 192) * 1024 + (n - 2048)]; }
            WL[i] = (bf16)f2bf(v);
        }
        const float* sk = (const float*)A.in[24]; bf16* SKB = (bf16*)(ws + WS_SKB);
        for (int i = gt; i < 2 * 262144; i += ngt) SKB[i] = (bf16)f2bf(sk[i]);
    }
}

__device__ __forceinline__ void ph_mod_x(const Args& A, Frame& F) {
    const float* x = (const float*)A.in[0]; const float* MOD = (const float*)(A.ws + WS_MOD); bf16* H = (bf16*)(A.ws + WS_HY);
    for (int t = F.gw; t < TOK; t += F.ngw) {
        const int b = t >> 14; const float* sh = MOD + (size_t)(0 * 2 + b) * 6144; const float* sc = sh + 2048;
#pragma unroll
        for (int j = 0; j < 8; ++j) { const int idx = j * 256 + F.lane * 4;
            const f32x4 xv = *(const f32x4*)(x + (size_t)t * DM + idx), sv = *(const f32x4*)(sc + idx), hv = *(const f32x4*)(sh + idx);
            const f32x4 o = xv * (1.0f + sv) + hv; u32x2 w; w.x = pk2(o[0], o[1]); w.y = pk2(o[2], o[3]);
            *(u32x2*)(H + (size_t)t * DM + idx) = w; }
    }
}

__device__ __forceinline__ void ph_even_post(const Args& A, Frame& F) {
    bf16* Z = (bf16*)(A.ws + WS_Z); const int* positions = (const int*)A.in[2]; const float* mu = (const float*)A.in[6];
    bf16* RKV = (bf16*)A.out; bf16* LAp = (bf16*)(A.ws + WS_LA);
    const int i = F.lane & 31; const float inv = powf(10000.0f, -(float)i / 32.0f);
    for (int t = F.gw; t < TOK; t += F.ngw) {
        const int s = t & (SEQ - 1); bf16* zr = Z + (size_t)t * EV_NP;
        float sn, cs; sincosf((float)positions[t] * inv, &sn, &cs);
#pragma unroll
        for (int it = 0; it < 9; ++it) { const int base = (2 * it + (F.lane >> 5)) * 64;
            const float t1 = bf2f(zr[base + i]), t2 = bf2f(zr[base + 32 + i]);
            zr[base + i] = (bf16)f2bf(t1 * cs - t2 * sn); zr[base + 32 + i] = (bf16)f2bf(t2 * cs + t1 * sn); }
        const bf16* zp = zr - EV_NP; const bool hasprev = s > 0;
        for (int m = 0; m < 28; ++m) { const int j = 2 * F.lane + 128 * m; if (j < 3520) {
            const unsigned cw = *(const unsigned*)(zr + 1280 + j); const unsigned pw = hasprev ? *(const unsigned*)(zp + 1280 + j) : 0u;
            const float m0 = mu[j], m1 = mu[j + 1];
            const float c0 = lo2f(cw), c1 = hi2f(cw), p0 = lo2f(pw), p1 = hi2f(pw);
            const float v0 = c0 + (p0 - c0) * m0, v1 = c1 + (p1 - c1) * m1;
            if (j < 3072) { const int which = j >> 10, jj = j & 1023; *(unsigned*)(RKV + (size_t)which * TOK * 1024 + (size_t)t * 1024 + jj) = pk2(v0, v1); }
            else if (j < 3168) { *(unsigned*)(LAp + (size_t)t * 512 + (j - 3072)) = pk2(tanhf(v0), tanhf(v1)); }
            else if (j < 3264) { *(unsigned*)(LAp + (size_t)t * 512 + 96 + (j - 3168)) = pk2(v0, v1); }
            else { *(unsigned*)(LAp + (size_t)t * 512 + 192 + (j - 3264)) = pk2(sigmoidf_(v0), sigmoidf_(v1)); }
        } }
        if (F.lane < 32) *(unsigned*)(LAp + (size_t)t * 512 + 448 + 2 * F.lane) = 0u;
    }
}

__device__ __forceinline__ void ph_scan_pack(const Args& A, Frame& F) {
    const bf16* Z = (const bf16*)(A.ws + WS_Z); const bf16* RKV = (const bf16*)A.out;
    const float* k_k = (const float*)A.in[12]; const float* k_a = (const float*)A.in[13]; const float* r_k = (const float*)A.in[14];
    unsigned* PK = (unsigned*)(A.ws + WS_BIG); float* BS = (float*)(A.ws + WS_BS);
    for (int it = F.gw; it < TOK * 16; it += F.ngw) {
        const int t = it >> 4, h = it & 15, c = h * 64 + F.lane, b = t >> 14, s = t & (SEQ - 1);
        const float r = bf2f(RKV[(size_t)t * 1024 + c]), kr = bf2f(RKV[(size_t)TOK * 1024 + (size_t)t * 1024 + c]), v = bf2f(RKV[(size_t)2 * TOK * 1024 + (size_t)t * 1024 + c]);
        const float e = bf2f(Z[(size_t)t * EV_NP + 1280 + c]), a = bf2f(Z[(size_t)t * EV_NP + 1280 + 1024 + c]);
        const float kkv = kr * k_k[c]; const float ss = wsum(kkv * kkv); const float kkn = kkv / fmaxf(sqrtf(ss), 1e-12f);
        const float kp = kr * (1.0f + (a - 1.0f) * k_a[c]); const float kka = kkn * a;
        const float bsum = wsum(r * kp * r_k[c]);
        if (F.lane == 0) BS[(size_t)t * 16 + h] = bsum;
        unsigned* dst = PK + ((size_t)((b * 16 + h) * SEQ + s) * 64 + F.lane) * 3;
        dst[0] = pk2(r, e); dst[1] = pk2(kp, kkn); dst[2] = pk2(kka, v);
    }
}

__device__ __forceinline__ void ph_swa(const Args& A, Frame& F) {
    const bf16* Z = (const bf16*)(A.ws + WS_Z); bf16* Y = (bf16*)(A.ws + WS_HY); const float* sinks = (const float*)A.in[5];
    LAS unsigned char* KL = F.lds; LAS unsigned char* VL = F.lds + 256 * 136;
    for (int u = F.bx; u < 512; u += F.G) {
        const int b = u >> 8, n = (u >> 1) & 127, kvh = u & 1;
        __syncthreads();
        for (int c = F.tid; c < 2048; c += NTHREADS) { const int jw = c >> 3, cc = c & 7; const int s = n * 128 - 128 + jw;
            u32x4 kv = {0u, 0u, 0u, 0u}, vv = {0u, 0u, 0u, 0u};
            if (s >= 0) { const bf16* row = Z + (size_t)(b * SEQ + s) * EV_NP; kv = *(const u32x4*)(row + 1024 + kvh * 64 + cc * 8); vv = *(const u32x4*)(row + 1152 + kvh * 64 + cc * 8); }
            *(LAS u32x2*)(KL + jw * 136 + cc * 16) = (u32x2){kv.x, kv.y}; *(LAS u32x2*)(KL + jw * 136 + cc * 16 + 8) = (u32x2){kv.z, kv.w};
            *(LAS u32x2*)(VL + jw * 136 + cc * 16) = (u32x2){vv.x, vv.y}; *(LAS u32x2*)(VL + jw * 136 + cc * 16 + 8) = (u32x2){vv.z, vv.w}; }
        __syncthreads();
        for (int it = F.wave; it < 1024; it += NWAVES) {
            const int i = it >> 3, g = it & 7, head = kvh * 8 + g; const int t = b * SEQ + n * 128 + i;
            const float qv = bf2f(Z[(size_t)t * EV_NP + head * 64 + F.lane]) * 0.125f;
            const int jw0 = i + 1 + F.lane, jw1 = jw0 + 64;
            const bool val0 = (n > 0) || (jw0 >= 128), val1 = (n > 0) || (jw1 >= 128);
            float s0 = 0.f, s1 = 0.f;
#pragma unroll
            for (int d4 = 0; d4 < 16; ++d4) {
                const u32x2 k0 = *(const LAS u32x2*)(KL + jw0 * 136 + d4 * 8), k1 = *(const LAS u32x2*)(KL + jw1 * 136 + d4 * 8);
                const float q0 = rdlane(qv, 4 * d4), q1 = rdlane(qv, 4 * d4 + 1), q2 = rdlane(qv, 4 * d4 + 2), q3 = rdlane(qv, 4 * d4 + 3);
                s0 += q0 * lo2f(k0.x) + q1 * hi2f(k0.x) + q2 * lo2f(k0.y) + q3 * hi2f(k0.y);
                s1 += q0 * lo2f(k1.x) + q1 * hi2f(k1.x) + q2 * lo2f(k1.y) + q3 * hi2f(k1.y);
            }
            const float sink = sinks[head];
            s0 = val0 ? s0 : -INFINITY; s1 = val1 ? s1 : -INFINITY;
            const float mx = fmaxf(wmax(fmaxf(s0, s1)), sink);
            float p0 = val0 ? expf(s0 - mx) : 0.f, p1 = val1 ? expf(s1 - mx) : 0.f;
            const float den = wsum(p0 + p1) + expf(sink - mx); const float rden = 1.0f / den;
            p0 *= rden; p1 *= rden;
            float o = 0.f;
            const LAS bf16* vcol = (const LAS bf16*)VL + F.lane;
#pragma unroll 8
            for (int jj = 0; jj < 64; ++jj) o += rdlane(p0, jj) * bf2f(vcol[(i + 1 + jj) * 68]);
#pragma unroll 8
            for (int jj = 0; jj < 64; ++jj) o += rdlane(p1, jj) * bf2f(vcol[(i + 65 + jj) * 68]);
            Y[(size_t)t * DM + head * 64 + F.lane] = (bf16)f2bf(o);
        }
    }
}

__device__ __forceinline__ void pair_sync(volatile LAS unsigned* cnt, unsigned target) {
    asm volatile("s_waitcnt vmcnt(0) lgkmcnt(0)" ::: "memory");
    if ((threadIdx.x & 63) == 0) (void)__hip_atomic_fetch_add((LAS unsigned*)cnt, 1u, __ATOMIC_RELAXED, __HIP_MEMORY_SCOPE_WORKGROUP);
    while (__hip_atomic_load((LAS unsigned*)cnt, __ATOMIC_RELAXED, __HIP_MEMORY_SCOPE_WORKGROUP) < target) __builtin_amdgcn_s_sleep(1);
    asm volatile("" ::: "memory");
}
__device__ __forceinline__ void swa_pairs(const Args& A, Frame& F, volatile LAS unsigned* MISC) {
    const bf16* Z = (const bf16*)(A.ws + WS_Z); bf16* Y = (bf16*)(A.ws + WS_HY); const float* sinks = (const float*)A.in[5];
    const int pr = (F.wave - 4) >> 1, mem = F.wave & 1;
    LAS unsigned char* KL = F.lds + pr * 69632; LAS unsigned char* VL = KL + 256 * 136;
    volatile LAS unsigned* cnt = MISC + 24 + pr; unsigned gen = 0u;
    for (int u = F.bx * 2 + pr; u < 512; u += F.G * 2) {
        const int b = u >> 8, n = (u >> 1) & 127, kvh = u & 1;
        gen += 2u; pair_sync(cnt, gen);
#pragma unroll 1
        for (int c0 = mem * 1024 + F.lane; c0 < mem * 1024 + 1024; c0 += 64 * 8) {
            u32x4 kv[8], vv[8];
#pragma unroll
            for (int q = 0; q < 8; ++q) { const int c = c0 + 64 * q; const int jw = c >> 3, cc = c & 7; const int sp = n * 128 - 128 + jw;
                kv[q] = (u32x4){0u, 0u, 0u, 0u}; vv[q] = kv[q];
                if (sp >= 0) { const bf16* row = Z + (size_t)(b * SEQ + sp) * EV_NP; kv[q] = *(const u32x4*)(row + 1024 + kvh * 64 + cc * 8); vv[q] = *(const u32x4*)(row + 1152 + kvh * 64 + cc * 8); } }
#pragma unroll
            for (int q = 0; q < 8; ++q) { const int c = c0 + 64 * q; const int jw = c >> 3, cc = c & 7;
                *(LAS u32x2*)(KL + jw * 136 + cc * 16) = (u32x2){kv[q].x, kv[q].y}; *(LAS u32x2*)(KL + jw * 136 + cc * 16 + 8) = (u32x2){kv[q].z, kv[q].w};
                *(LAS u32x2*)(VL + jw * 136 + cc * 16) = (u32x2){vv[q].x, vv[q].y}; *(LAS u32x2*)(VL + jw * 136 + cc * 16 + 8) = (u32x2){vv[q].z, vv[q].w}; }
        }
        gen += 2u; pair_sync(cnt, gen);
        for (int it = mem; it < 1024; it += 2) {
            const int i = it >> 3, g = it & 7, head = kvh * 8 + g; const int t = b * SEQ + n * 128 + i;
            const float qv = bf2f(Z[(size_t)t * EV_NP + head * 64 + F.lane]) * 0.125f;
            const int jw0 = i + 1 + F.lane, jw1 = jw0 + 64;
            const bool val0 = (n > 0) || (jw0 >= 128), val1 = (n > 0) || (jw1 >= 128);
            float s0 = 0.f, s1 = 0.f;
#pragma unroll
            for (int d4 = 0; d4 < 16; ++d4) {
                const u32x2 k0 = *(const LAS u32x2*)(KL + jw0 * 136 + d4 * 8), k1 = *(const LAS u32x2*)(KL + jw1 * 136 + d4 * 8);
                const float q0 = rdlane(qv, 4 * d4), q1 = rdlane(qv, 4 * d4 + 1), q2 = rdlane(qv, 4 * d4 + 2), q3 = rdlane(qv, 4 * d4 + 3);
                s0 += q0 * lo2f(k0.x) + q1 * hi2f(k0.x) + q2 * lo2f(k0.y) + q3 * hi2f(k0.y);
                s1 += q0 * lo2f(k1.x) + q1 * hi2f(k1.x) + q2 * lo2f(k1.y) + q3 * hi2f(k1.y);
            }
            const float sink = sinks[head];
            s0 = val0 ? s0 : -INFINITY; s1 = val1 ? s1 : -INFINITY;
            const float mx = fmaxf(wmax(fmaxf(s0, s1)), sink);
            float p0 = val0 ? expf(s0 - mx) : 0.f, p1 = val1 ? expf(s1 - mx) : 0.f;
            const float den = wsum(p0 + p1) + expf(sink - mx); const float rden = 1.0f / den;
            p0 *= rden; p1 *= rden;
            float o = 0.f;
            const LAS bf16* vcol = (const LAS bf16*)VL + F.lane;
#pragma unroll 8
            for (int jj = 0; jj < 64; ++jj) o += rdlane(p0, jj) * bf2f(vcol[(i + 1 + jj) * 68]);
#pragma unroll 8
            for (int jj = 0; jj < 64; ++jj) o += rdlane(p1, jj) * bf2f(vcol[(i + 65 + jj) * 68]);
            Y[(size_t)t * DM + head * 64 + F.lane] = (bf16)f2bf(o);
        }
    }
}

__device__ __forceinline__ void wsum2_dpp(float a, float b, float& ra, float& rb) {
    const auto r = __builtin_amdgcn_permlane32_swap(__float_as_uint(a), __float_as_uint(b), false, false);
    float v = __uint_as_float(r[0]) + __uint_as_float(r[1]);
    v += dppf<0xB1, 0xF>(v); v += dppf<0x4E, 0xF>(v); v += dppf<0x141, 0xF>(v); v += dppf<0x140, 0xF>(v);
    v += dppf<0x142, 0xA>(v);
    ra = rdlane(v, 31); rb = rdlane(v, 63);
}
__device__ __forceinline__ void ph_scan(const Args& A, Frame& F, volatile LAS unsigned* MISC) {
    const unsigned* PK = (const unsigned*)(A.ws + WS_BIG); bf16* YRAW = (bf16*)A.out + (size_t)3 * TOK * 1024;
    if (F.wave >= 4) { swa_pairs(A, F, MISC); return; }
    for (int pp = F.bx * 4 + F.wave; pp < 1024; pp += F.G * 4) {
        const int rr = 2 * pp, bh = rr >> 6, vrow = rr & 63;
        const unsigned* pk = PK + ((size_t)bh * SEQ * 64 + F.lane) * 3;
        bf16* youtA = YRAW + ((size_t)bh * 64 + vrow) * SEQ; bf16* youtB = youtA + SEQ;
        f32x2 S2 = {0.f, 0.f};
        for (int t0 = 0; t0 < SEQ; t0 += 64) {
            float ykA = 0.f, ykB = 0.f;
#pragma unroll 8
            for (int j = 0; j < 64; ++j) {
                const unsigned* p = pk + (size_t)(t0 + j) * 192;
                const unsigned w0 = p[0], w1 = p[1], w2 = p[2];
                const float r = lo2f(w0), e = hi2f(w0), kp = lo2f(w1), kk = hi2f(w1), kka = lo2f(w2), vv = hi2f(w2);
                const f32x2 v2 = {rdlane(vv, vrow), rdlane(vv, vrow + 1)};
                const float dec = __expf(-e);
                const f32x2 pk2v = S2 * (f32x2){kk, kk};
                float saA, saB; wsum2_dpp(pk2v.x, pk2v.y, saA, saB); const f32x2 sa2 = {saA, saB};
                S2 = S2 * (f32x2){dec, dec} + (v2 * (f32x2){kp, kp} - sa2 * (f32x2){kka, kka});
                const f32x2 py = S2 * (f32x2){r, r};
                float yA, yB; wsum2_dpp(py.x, py.y, yA, yB);
                ykA = (F.lane == j) ? yA : ykA; ykB = (F.lane == j) ? yB : ykB;
            }
            youtA[t0 + F.lane] = (bf16)f2bf(ykA); youtB[t0 + F.lane] = (bf16)f2bf(ykB);
        }
    }
}

__device__ __forceinline__ void ph_rwkv_finish(const Args& A, Frame& F) {
    const bf16* Z = (const bf16*)(A.ws + WS_Z); const bf16* RKV = (const bf16*)A.out; const bf16* YRAW = (const bf16*)A.out + (size_t)3 * TOK * 1024;
    const float* BS = (const float*)(A.ws + WS_BS); bf16* Y = (bf16*)(A.ws + WS_HY);
    const float* lnx_g = (const float*)A.in[15]; const float* lnx_b = (const float*)A.in[16];
    LAS float* tile = (LAS float*)(F.lds + F.wave * 16640);
    for (int it = F.gw; it < 8192; it += F.ngw) {
        const int bh = it >> 8, tb = it & 255, b = bh >> 4, h = bh & 15, t0 = tb * 64;
        for (int vr = 0; vr < 64; ++vr) tile[vr * 65 + F.lane] = bf2f(YRAW[((size_t)bh * 64 + vr) * SEQ + t0 + F.lane]);
        asm volatile("s_waitcnt lgkmcnt(0)" ::: "memory");
        const int c = h * 64 + F.lane; const float lg = lnx_g[c], lb = lnx_b[c];
        for (int j = 0; j < 64; ++j) {
            const int t = b * SEQ + t0 + j;
            const float y = tile[F.lane * 65 + j];
            const float mean = wsum(y) * (1.0f / 64.0f); const float d = y - mean; const float var = wsum(d * d) * (1.0f / 64.0f);
            const float yn = d * rsqrtf(var + 64e-5f) * lg + lb;
            const float vv = bf2f(RKV[(size_t)2 * TOK * 1024 + (size_t)t * 1024 + c]); const float g = bf2f(Z[(size_t)t * EV_NP + 1280 + 2048 + c]); const float bs = BS[(size_t)t * 16 + h];
            Y[(size_t)t * DM + 1024 + c] = (bf16)f2bf((yn + bs * vv) * g);
        }
        asm volatile("s_waitcnt lgkmcnt(0)" ::: "memory");
    }
}

__device__ __forceinline__ void ph_ln_mixer(const Args& A, Frame& F, const int L) {
    const float* xsrc = (L == 0) ? (const float*)A.in[0] : (const float*)A.out; float* xdst = A.out;
    const bf16* O = (const bf16*)(A.ws + WS_Z); bf16* H = (bf16*)(A.ws + WS_HY); const float* MOD = (const float*)(A.ws + WS_MOD);
    const float* lng = (const float*)A.in[21] + (size_t)(L * 2 + 0) * DM; const float* lnb = (const float*)A.in[22] + (size_t)(L * 2 + 0) * DM;
    for (int t = F.gw; t < TOK; t += F.ngw) {
        const int b = t >> 14;
        const float* gate = MOD + (size_t)((L * 2 + 0) * 2 + b) * 6144 + 4096;
        const float* sh = MOD + (size_t)((L * 2 + 1) * 2 + b) * 6144; const float* sc = sh + 2048;
        float v[32]; float sum = 0.f;
#pragma unroll
        for (int j = 0; j < 4; ++j) { const int base = (j * 64 + F.lane) * 8;
            const u32x4 ow = *(const u32x4*)(O + (size_t)t * DM + base);
            const f32x4 x0 = *(const f32x4*)(xsrc + (size_t)t * DM + base), x1 = *(const f32x4*)(xsrc + (size_t)t * DM + base + 4);
            const f32x4 g0 = *(const f32x4*)(gate + base), g1 = *(const f32x4*)(gate + base + 4);
            const float of[8] = {lo2f(ow.x), hi2f(ow.x), lo2f(ow.y), hi2f(ow.y), lo2f(ow.z), hi2f(ow.z), lo2f(ow.w), hi2f(ow.w)};
#pragma unroll
            for (int e = 0; e < 4; ++e) { v[j * 8 + e] = ALPHA * x0[e] + (1.0f + g0[e]) * of[e]; v[j * 8 + 4 + e] = ALPHA * x1[e] + (1.0f + g1[e]) * of[4 + e]; }
#pragma unroll
            for (int e = 0; e < 8; ++e) sum += v[j * 8 + e]; }
        const float mean = wsum(sum) * (1.0f / DM); float sq = 0.f;
#pragma unroll
        for (int e = 0; e < 32; ++e) { v[e] -= mean; sq += v[e] * v[e]; }
        const float rstd = rsqrtf(wsum(sq) * (1.0f / DM) + 1e-5f);
#pragma unroll
        for (int j = 0; j < 4; ++j) { const int base = (j * 64 + F.lane) * 8;
            const f32x4 lg0 = *(const f32x4*)(lng + base), lg1 = *(const f32x4*)(lng + base + 4), lb0 = *(const f32x4*)(lnb + base), lb1 = *(const f32x4*)(lnb + base + 4);
            const f32x4 s0 = *(const f32x4*)(sc + base), s1 = *(const f32x4*)(sc + base + 4), h0 = *(const f32x4*)(sh + base), h1 = *(const f32x4*)(sh + base + 4);
            f32x4 o0, o1;
#pragma unroll
            for (int e = 0; e < 4; ++e) { o0[e] = v[j * 8 + e] * rstd * lg0[e] + lb0[e]; o1[e] = v[j * 8 + 4 + e] * rstd * lg1[e] + lb1[e]; }
            *(f32x4*)(xdst + (size_t)t * DM + base) = o0; *(f32x4*)(xdst + (size_t)t * DM + base + 4) = o1;
            const f32x4 q0 = o0 * (1.0f + s0) + h0, q1 = o1 * (1.0f + s1) + h1;
            u32x4 w; w.x = pk2(q0[0], q0[1]); w.y = pk2(q0[2], q0[3]); w.z = pk2(q1[0], q1[1]); w.w = pk2(q1[2], q1[3]);
            *(u32x4*)(H + (size_t)t * DM + base) = w; }
    }
    {
        const float* pu = (const float*)A.in[25] + (size_t)L * 16384 * 2048; const float* pv = (const float*)A.in[26] + (size_t)L * 16384 * 2048;
        unsigned char* T8 = A.ws + WS_BIG; float* SCL = (float*)(A.ws + WS_BIG + 64 * MiB);
        for (int r = F.gw; r < 32768; r += F.ngw) {
            const float* src = ((r < 16384) ? pu : pv) + (size_t)(r & 16383) * 2048;
            f32x4 f[2][4]; float amax = 0.f;
#pragma unroll
            for (int j = 0; j < 2; ++j)
#pragma unroll
                for (int c = 0; c < 4; ++c) { f[j][c] = *(const f32x4*)(src + (j * 64 + F.lane) * 16 + 4 * c);
                    amax = fmaxf(amax, fmaxf(fmaxf(fabsf(f[j][c][0]), fabsf(f[j][c][1])), fmaxf(fabsf(f[j][c][2]), fabsf(f[j][c][3])))); }
            amax = wmax(amax);
            int k = 0; if (amax > 0.f) { k = ilogbf(224.0f / amax); k = k < -100 ? -100 : (k > 100 ? 100 : k); }
            const float scl = ldexpf(1.0f, k);
#pragma unroll
            for (int j = 0; j < 2; ++j) { u32x4 w; unsigned ww[4];
#pragma unroll
                for (int c = 0; c < 4; ++c) { int q = __builtin_amdgcn_cvt_pk_fp8_f32(f[j][c][0] * scl, f[j][c][1] * scl, 0, false); q = __builtin_amdgcn_cvt_pk_fp8_f32(f[j][c][2] * scl, f[j][c][3] * scl, q, true); ww[c] = (unsigned)q; }
                w.x = ww[0]; w.y = ww[1]; w.z = ww[2]; w.w = ww[3];
                *(u32x4*)(T8 + (size_t)r * 2048 + (j * 64 + F.lane) * 16) = w; }
            if (F.lane == 0) SCL[r] = ldexpf(1.0f, -k);
        }
    }
}

template <int NV, int NBITS> __device__ __forceinline__ unsigned wave_tau16(const unsigned (&key)[NV]) {
    unsigned tau = 0u;
#pragma unroll 1
    for (int bit = NBITS - 1; bit >= 0; --bit) {
        const unsigned cand = tau | (1u << bit); int cnt = 0;
#pragma unroll
        for (int v = 0; v < NV; ++v) cnt += __popcll(__ballot(key[v] >= cand));
        if (cnt >= 16) tau = cand;
    }
    return tau;
}
template <int NV> __device__ __forceinline__ void wave_compact16(const unsigned (&key)[NV], const float (&val)[NV], const int (&id)[NV], unsigned tau, LAS float* ov, LAS int* oi, int lane) {
    int ngt = 0;
#pragma unroll
    for (int v = 0; v < NV; ++v) ngt += __popcll(__ballot(key[v] > tau));
    int bg = 0, be = 0;
#pragma unroll
    for (int v = 0; v < NV; ++v) {
        const bool gt = key[v] > tau, eq = key[v] == tau;
        const unsigned long long mg = __ballot(gt), me = __ballot(eq);
        const unsigned long long below = (lane == 0) ? 0ull : ((~0ull) >> (64 - lane));
        const int pg = bg + __popcll(mg & below), pe = ngt + be + __popcll(me & below);
        if (gt) { ov[pg] = val[v]; oi[pg] = id[v]; }
        if (eq && pe < 16) { ov[pe] = val[v]; oi[pe] = id[v]; }
        bg += __popcll(mg); be += __popcll(me);
    }
}

__device__ __forceinline__ void ph_peer_select(const Args& A, Frame& F, const int L) {
    const bf16* QP = (const bf16*)(A.ws + WS_Z); const bf16* SKB = (const bf16*)(A.ws + WS_SKB) + (size_t)L * 262144;
    int* EID = (int*)(A.ws + WS_LA); float* GSM = (float*)(A.ws + WS_LA + 16 * MiB);
    LAS unsigned char* SKL = F.lds;
    LAS float* tv = (LAS float*)(F.lds + 69632 + F.wave * 512);
    LAS int* ti = (LAS int*)(F.lds + 69632 + F.wave * 512 + 128);
    LAS float* cv = (LAS float*)(F.lds + 69632 + F.wave * 512 + 256);
    LAS int* ci = (LAS int*)(F.lds + 69632 + F.wave * 512 + 320);
    for (int it = F.bx; it < 4096; it += F.G) {
        const int tile = it >> 3, h = it & 7;
        __syncthreads();
        for (int c = F.tid; c < 4096; c += NTHREADS) { const int p = c >> 11, n = (c >> 4) & 127, cc = c & 15;
            *(LAS u32x4*)(SKL + (p * 128 + n) * 272 + cc * 16) = *(const u32x4*)(SKB + ((size_t)((p * 8 + h) * 128 + n)) * 128 + cc * 8); }
        __syncthreads();
        for (int tk = 0; tk < 8; ++tk) {
            const int t = tile * 64 + F.wave * 8 + tk;
            float sval[2][2]; unsigned key[2][2];
#pragma unroll
            for (int p = 0; p < 2; ++p) {
                const unsigned qv = *(const unsigned*)(QP + (size_t)t * DM + h * 256 + p * 128 + 2 * F.lane);
                float s0 = 0.f, s1 = 0.f;
                const LAS unsigned char* r0 = SKL + (p * 128 + F.lane) * 272; const LAS unsigned char* r1 = r0 + 64 * 272;
#pragma unroll
                for (int c16 = 0; c16 < 16; ++c16) {
                    const u32x4 k0 = *(const LAS u32x4*)(r0 + c16 * 16), k1 = *(const LAS u32x4*)(r1 + c16 * 16);
                    const unsigned q0 = rdlaneu(qv, c16 * 4), q1 = rdlaneu(qv, c16 * 4 + 1), q2 = rdlaneu(qv, c16 * 4 + 2), q3 = rdlaneu(qv, c16 * 4 + 3);
                    s0 = dot2bf(q0, k0.x, s0); s0 = dot2bf(q1, k0.y, s0); s0 = dot2bf(q2, k0.z, s0); s0 = dot2bf(q3, k0.w, s0);
                    s1 = dot2bf(q0, k1.x, s1); s1 = dot2bf(q1, k1.y, s1); s1 = dot2bf(q2, k1.z, s1); s1 = dot2bf(q3, k1.w, s1);
                }
                sval[p][0] = s0; sval[p][1] = s1; key[p][0] = fixkey20(s0); key[p][1] = fixkey20(s1);
            }
            {
                unsigned tau0 = 0u, tau1 = 0u;
#pragma unroll 1
                for (int bit = 19; bit >= 0; --bit) {
                    const unsigned c0 = tau0 | (1u << bit), c1 = tau1 | (1u << bit);
                    const int n0 = __popcll(__ballot(key[0][0] >= c0)) + __popcll(__ballot(key[0][1] >= c0));
                    const int n1 = __popcll(__ballot(key[1][0] >= c1)) + __popcll(__ballot(key[1][1] >= c1));
                    if (n0 >= 16) tau0 = c0;
                    if (n1 >= 16) tau1 = c1;
                }
                const int id[2] = {F.lane, F.lane + 64};
                wave_compact16<2>(key[0], sval[0], id, tau0, tv, ti, F.lane);
                wave_compact16<2>(key[1], sval[1], id, tau1, tv + 16, ti + 16, F.lane);
            }
            asm volatile("s_waitcnt lgkmcnt(0)" ::: "memory"); __builtin_amdgcn_wave_barrier();
            unsigned ck[4]; int cid[4]; float cval[4];
#pragma unroll
            for (int m = 0; m < 4; ++m) { const int c = F.lane * 4 + m; cid[m] = c; cval[m] = tv[c >> 4] + tv[16 + (c & 15)]; ck[m] = fixkey20(cval[m] * 0.5f); }
            const unsigned tau2 = wave_tau16<4, 20>(ck);
            wave_compact16<4>(ck, cval, cid, tau2, cv, ci, F.lane);
            asm volatile("s_waitcnt lgkmcnt(0)" ::: "memory"); __builtin_amdgcn_wave_barrier();
            const float bv = (F.lane < 16) ? cv[F.lane] : -INFINITY; const int bc = (F.lane < 16) ? ci[F.lane] : 0;
            const float mx = wmax(bv); const float ev = (F.lane < 16) ? expf(bv - mx) : 0.f; const float den = wsum(ev);
            if (F.lane < 16) { const int e1 = ti[bc >> 4], e2 = ti[16 + (bc & 15)];
                EID[(size_t)t * 128 + h * 16 + F.lane] = e1 * 128 + e2; GSM[(size_t)t * 128 + h * 16 + F.lane] = ev / den; }
            asm volatile("s_waitcnt lgkmcnt(0)" ::: "memory"); __builtin_amdgcn_wave_barrier();
        }
    }
}

constexpr int PGB = 4;
__device__ __forceinline__ void ph_peer_gather(const Args& A, Frame& F, const int L, const bool dry = false) {
    bf16* H = (bf16*)(A.ws + WS_HY); bf16* Hout = dry ? (bf16*)(A.ws + WS_BIG + 128 * MiB) : H; float* Xout = dry ? (float*)(A.ws + WS_Z) : A.out; const unsigned char* TU = A.ws + WS_BIG; const unsigned char* TV = TU + (size_t)16384 * 2048; const float* SCL = (const float*)(A.ws + WS_BIG + 64 * MiB);
    const int* EID = (const int*)(A.ws + WS_LA); const float* GSM = (const float*)(A.ws + WS_LA + 16 * MiB);
    const float* MOD = (const float*)(A.ws + WS_MOD); float* X = A.out;
    const float* lng = (const float*)A.in[21] + (size_t)(L * 2 + 1) * DM; const float* lnb = (const float*)A.in[22] + (size_t)(L * 2 + 1) * DM;
    for (int t = F.gw; t < TOK; t += F.ngw) {
        const int b = t >> 14;
        f32x2 h2[16];
#pragma unroll
        for (int j = 0; j < 2; ++j) { const u32x4 a = *(const u32x4*)(H + (size_t)t * DM + (j * 64 + F.lane) * 16), c = *(const u32x4*)(H + (size_t)t * DM + (j * 64 + F.lane) * 16 + 8);
            const unsigned aw[8] = {a.x, a.y, a.z, a.w, c.x, c.y, c.z, c.w};
#pragma unroll
            for (int q = 0; q < 8; ++q) h2[j * 8 + q] = (f32x2){lo2f(aw[q]), hi2f(aw[q])}; }
        f32x2 o2[16];
#pragma unroll
        for (int e = 0; e < 16; ++e) o2[e] = (f32x2){0.f, 0.f};
#pragma unroll 1
        for (int e0 = 0; e0 < 128; e0 += PGB) {
            int eid[PGB]; float gw[PGB], su[PGB], sv[PGB];
#pragma unroll
            for (int q = 0; q < PGB; ++q) { eid[q] = __builtin_amdgcn_readfirstlane(EID[(size_t)t * 128 + e0 + q]); gw[q] = GSM[(size_t)t * 128 + e0 + q]; su[q] = SCL[eid[q]]; sv[q] = SCL[16384 + eid[q]]; }
            u32x4 uu[PGB][2], vv[PGB][2];
#pragma unroll
            for (int q = 0; q < PGB; ++q)
#pragma unroll
                for (int j = 0; j < 2; ++j) { uu[q][j] = *(const u32x4*)(TU + (size_t)eid[q] * 2048 + (j * 64 + F.lane) * 16); vv[q][j] = *(const u32x4*)(TV + (size_t)eid[q] * 2048 + (j * 64 + F.lane) * 16); }
#pragma unroll
            for (int q = 0; q < PGB; ++q) {
                f32x2 d2 = {0.f, 0.f};
#pragma unroll
                for (int j = 0; j < 2; ++j) { const unsigned w[4] = {uu[q][j].x, uu[q][j].y, uu[q][j].z, uu[q][j].w};
#pragma unroll
                    for (int i = 0; i < 4; ++i) { const f32x2 lo = __builtin_amdgcn_cvt_pk_f32_fp8((int)w[i], false), hi = __builtin_amdgcn_cvt_pk_f32_fp8((int)w[i], true);
                        d2 = lo * h2[j * 8 + 2 * i] + d2; d2 = hi * h2[j * 8 + 2 * i + 1] + d2; } }
                const float d = wsum(d2.x + d2.y) * su[q];
                const float act = 0.5f * d * (1.0f + erff(d * 0.70710678f)) * gw[q] * sv[q];
                const f32x2 a2 = {act, act};
#pragma unroll
                for (int j = 0; j < 2; ++j) { const unsigned w[4] = {vv[q][j].x, vv[q][j].y, vv[q][j].z, vv[q][j].w};
#pragma unroll
                    for (int i = 0; i < 4; ++i) { const f32x2 lo = __builtin_amdgcn_cvt_pk_f32_fp8((int)w[i], false), hi = __builtin_amdgcn_cvt_pk_f32_fp8((int)w[i], true);
                        o2[j * 8 + 2 * i] = a2 * lo + o2[j * 8 + 2 * i]; o2[j * 8 + 2 * i + 1] = a2 * hi + o2[j * 8 + 2 * i + 1]; } }
            }
        }
        float out[32];
#pragma unroll
        for (int e = 0; e < 16; ++e) { out[2 * e] = o2[e].x; out[2 * e + 1] = o2[e].y; }
        const float* gate = MOD + (size_t)((L * 2 + 1) * 2 + b) * 6144 + 4096;
        float sum = 0.f;
#pragma unroll
        for (int j = 0; j < 2; ++j)
#pragma unroll
            for (int c = 0; c < 4; ++c) { const int base = (j * 64 + F.lane) * 16 + 4 * c;
                const f32x4 x0 = *(const f32x4*)(X + (size_t)t * DM + base), g0 = *(const f32x4*)(gate + base);
#pragma unroll
                for (int e = 0; e < 4; ++e) { const float v = ALPHA * x0[e] + (1.0f + g0[e]) * out[j * 16 + 4 * c + e]; out[j * 16 + 4 * c + e] = v; sum += v; } }
        const float mean = wsum(sum) * (1.0f / DM); float sq = 0.f;
#pragma unroll
        for (int e = 0; e < 32; ++e) { out[e] -= mean; sq += out[e] * out[e]; }
        const float rstd = rsqrtf(wsum(sq) * (1.0f / DM) + 1e-5f);
        const float* sh = MOD + (size_t)(((L + 1) * 2 + 0) * 2 + b) * 6144; const float* sc = sh + 2048;
#pragma unroll
        for (int j = 0; j < 2; ++j) {
            float hq[16];
#pragma unroll
            for (int c = 0; c < 4; ++c) { const int base = (j * 64 + F.lane) * 16 + 4 * c;
                const f32x4 lg0 = *(const f32x4*)(lng + base), lb0 = *(const f32x4*)(lnb + base);
                f32x4 o0;
#pragma unroll
                for (int e = 0; e < 4; ++e) o0[e] = out[j * 16 + 4 * c + e] * rstd * lg0[e] + lb0[e];
                *(f32x4*)(Xout + (size_t)t * DM + base) = o0;
                if (L == 0) { const f32x4 s0 = *(const f32x4*)(sc + base), h0 = *(const f32x4*)(sh + base);
#pragma unroll
                    for (int e = 0; e < 4; ++e) hq[4 * c + e] = o0[e] * (1.0f + s0[e]) + h0[e]; } }
            if (L == 0) { u32x4 w0, w1;
                w0.x = pk2(hq[0], hq[1]); w0.y = pk2(hq[2], hq[3]); w0.z = pk2(hq[4], hq[5]); w0.w = pk2(hq[6], hq[7]);
                w1.x = pk2(hq[8], hq[9]); w1.y = pk2(hq[10], hq[11]); w1.z = pk2(hq[12], hq[13]); w1.w = pk2(hq[14], hq[15]);
                *(u32x4*)(Hout + (size_t)t * DM + (j * 64 + F.lane) * 16) = w0; *(u32x4*)(Hout + (size_t)t * DM + (j * 64 + F.lane) * 16 + 8) = w1; }
        }
    }
}

struct XInfo { int rank, nloc, rx, nx; };
__device__ __forceinline__ XInfo xcc_info(volatile LAS unsigned* MISC) { XInfo x; x.rank = (int)MISC[16]; x.nloc = (int)MISC[17]; x.rx = (int)MISC[18]; x.nx = (int)MISC[19]; return x; }
constexpr size_t WS_DP = WS_BIG + 128 * MiB;
__device__ __forceinline__ void ph_peer_u(const Args& A, Frame& F, const XInfo X) {
    const bf16* H = (const bf16*)(A.ws + WS_HY); const unsigned char* TU = A.ws + WS_BIG; const int* EID = (const int*)(A.ws + WS_LA); float* DP = (float*)(A.ws + WS_DP);
    LAS int* IDX = (LAS int*)(F.lds + F.wave * 1024);
    const int g16 = F.lane >> 4, c16 = F.lane & 15;
    for (int s = X.rx; s < 8; s += X.nx) {
        for (int t = X.rank * NWAVES + F.wave; t < TOK; t += X.nloc * NWAVES) {
            IDX[F.lane] = EID[(size_t)t * 128 + F.lane]; IDX[F.lane + 64] = EID[(size_t)t * 128 + 64 + F.lane];
            f32x2 h2[8];
            { const u32x4 a = *(const u32x4*)(H + (size_t)t * DM + 256 * s + 16 * c16), c = *(const u32x4*)(H + (size_t)t * DM + 256 * s + 16 * c16 + 8);
              const unsigned aw[8] = {a.x, a.y, a.z, a.w, c.x, c.y, c.z, c.w};
#pragma unroll
              for (int q = 0; q < 8; ++q) h2[q] = (f32x2){lo2f(aw[q]), hi2f(aw[q])}; }
            asm volatile("s_waitcnt lgkmcnt(0)" ::: "memory"); __builtin_amdgcn_wave_barrier();
            float keep0 = 0.f, keep1 = 0.f;
            const unsigned char* ub = TU + 256 * s + 16 * c16;
#pragma unroll
            for (int i0 = 0; i0 < 32; i0 += 8) {
                u32x4 ud[8];
#pragma unroll
                for (int u = 0; u < 8; ++u) { const int eid = IDX[4 * (i0 + u) + g16]; ud[u] = *(const u32x4*)(ub + (size_t)eid * 2048); }
#pragma unroll
                for (int u = 0; u < 8; ++u) {
                    const unsigned w[4] = {ud[u].x, ud[u].y, ud[u].z, ud[u].w}; f32x2 d2 = {0.f, 0.f};
#pragma unroll
                    for (int q = 0; q < 4; ++q) { const f32x2 lo = __builtin_amdgcn_cvt_pk_f32_fp8((int)w[q], false), hi = __builtin_amdgcn_cvt_pk_f32_fp8((int)w[q], true);
                        d2 = lo * h2[2 * q] + d2; d2 = hi * h2[2 * q + 1] + d2; }
                    const float d = sum16_dpp(d2.x + d2.y);
                    const int i = i0 + u;
                    if (i < 16) keep0 = ((i & 15) == c16) ? d : keep0; else keep1 = ((i & 15) == c16) ? d : keep1;
                }
            }
            float* dp = DP + ((size_t)s * TOK + t) * 128 + 4 * c16 + g16;
            dp[0] = keep0; dp[64] = keep1;
            asm volatile("s_waitcnt lgkmcnt(0)" ::: "memory"); __builtin_amdgcn_wave_barrier();
        }
    }
}
__device__ __forceinline__ void ph_peer_v(const Args& A, Frame& F, const XInfo X) {
    const unsigned char* TV = A.ws + WS_BIG + (size_t)16384 * 2048; const float* SCL = (const float*)(A.ws + WS_BIG + 64 * MiB);
    const int* EID = (const int*)(A.ws + WS_LA); const float* GSM = (const float*)(A.ws + WS_LA + 16 * MiB); const float* DP = (const float*)(A.ws + WS_DP); float* OUT = (float*)(A.ws + WS_Z);
    LAS int* IDX = (LAS int*)(F.lds + F.wave * 1024); LAS float* ACT = (LAS float*)(F.lds + F.wave * 1024 + 512);
    const int g16 = F.lane >> 4, c16 = F.lane & 15;
    for (int s = X.rx; s < 8; s += X.nx) {
        for (int t = X.rank * NWAVES + F.wave; t < TOK; t += X.nloc * NWAVES) {
#pragma unroll
            for (int m = 0; m < 2; ++m) { const int e = F.lane + 64 * m; const int eid = EID[(size_t)t * 128 + e]; float d = 0.f;
#pragma unroll
                for (int x = 0; x < 8; ++x) d += DP[((size_t)x * TOK + t) * 128 + e];
                d *= SCL[eid];
                IDX[e] = eid; ACT[e] = 0.5f * d * (1.0f + erff(d * 0.70710678f)) * GSM[(size_t)t * 128 + e] * SCL[16384 + eid]; }
            asm volatile("s_waitcnt lgkmcnt(0)" ::: "memory"); __builtin_amdgcn_wave_barrier();
            f32x2 o2[8];
#pragma unroll
            for (int q = 0; q < 8; ++q) o2[q] = (f32x2){0.f, 0.f};
            const unsigned char* vb = TV + 256 * s + 16 * c16;
#pragma unroll
            for (int i0 = 0; i0 < 32; i0 += 8) {
                u32x4 vd[8]; float av[8];
#pragma unroll
                for (int u = 0; u < 8; ++u) { const int eid = IDX[4 * (i0 + u) + g16]; vd[u] = *(const u32x4*)(vb + (size_t)eid * 2048); av[u] = ACT[4 * (i0 + u) + g16]; }
#pragma unroll
                for (int u = 0; u < 8; ++u) {
                    const unsigned w[4] = {vd[u].x, vd[u].y, vd[u].z, vd[u].w}; const f32x2 a2 = {av[u], av[u]};
#pragma unroll
                    for (int q = 0; q < 4; ++q) { const f32x2 lo = __builtin_amdgcn_cvt_pk_f32_fp8((int)w[q], false), hi = __builtin_amdgcn_cvt_pk_f32_fp8((int)w[q], true);
                        o2[2 * q] = a2 * lo + o2[2 * q]; o2[2 * q + 1] = a2 * hi + o2[2 * q + 1]; }
                }
            }
            float o[16];
#pragma unroll
            for (int q = 0; q < 8; ++q) { float a0 = o2[q].x, a1 = o2[q].y; a0 += __shfl_xor(a0, 16); a0 += __shfl_xor(a0, 32); a1 += __shfl_xor(a1, 16); a1 += __shfl_xor(a1, 32); o[2 * q] = a0; o[2 * q + 1] = a1; }
            if (g16 == 0) { float* op = OUT + (size_t)t * DM + 256 * s + 16 * c16;
#pragma unroll
                for (int c = 0; c < 4; ++c) *(f32x4*)(op + 4 * c) = (f32x4){o[4 * c], o[4 * c + 1], o[4 * c + 2], o[4 * c + 3]}; }
            asm volatile("s_waitcnt lgkmcnt(0)" ::: "memory"); __builtin_amdgcn_wave_barrier();
        }
    }
}
__device__ __forceinline__ void ph_peer_ln(const Args& A, Frame& F, const int L) {
    const float* OUT = (const float*)(A.ws + WS_Z); float* X = A.out; bf16* H = (bf16*)(A.ws + WS_HY); const float* MOD = (const float*)(A.ws + WS_MOD);
    const float* lng = (const float*)A.in[21] + (size_t)(L * 2 + 1) * DM; const float* lnb = (const float*)A.in[22] + (size_t)(L * 2 + 1) * DM;
    for (int t = F.gw; t < TOK; t += F.ngw) {
        const int b = t >> 14;
        const float* gate = MOD + (size_t)((L * 2 + 1) * 2 + b) * 6144 + 4096;
        const float* sh = MOD + (size_t)(((L + 1) * 2 + 0) * 2 + b) * 6144; const float* sc = sh + 2048;
        float v[32]; float sum = 0.f;
#pragma unroll
        for (int j = 0; j < 8; ++j) { const int base = (j * 64 + F.lane) * 4;
            const f32x4 o0 = *(const f32x4*)(OUT + (size_t)t * DM + base), x0 = *(const f32x4*)(X + (size_t)t * DM + base), g0 = *(const f32x4*)(gate + base);
#pragma unroll
            for (int e = 0; e < 4; ++e) { v[j * 4 + e] = ALPHA * x0[e] + (1.0f + g0[e]) * o0[e]; sum += v[j * 4 + e]; } }
        const float mean = wsum(sum) * (1.0f / DM); float sq = 0.f;
#pragma unroll
        for (int e = 0; e < 32; ++e) { v[e] -= mean; sq += v[e] * v[e]; }
        const float rstd = rsqrtf(wsum(sq) * (1.0f / DM) + 1e-5f);
#pragma unroll
        for (int j = 0; j < 8; ++j) { const int base = (j * 64 + F.lane) * 4;
            const f32x4 lg0 = *(const f32x4*)(lng + base), lb0 = *(const f32x4*)(lnb + base);
            f32x4 o0;
#pragma unroll
            for (int e = 0; e < 4; ++e) o0[e] = v[j * 4 + e] * rstd * lg0[e] + lb0[e];
            *(f32x4*)(X + (size_t)t * DM + base) = o0;
            if (L == 0) { const f32x4 s0 = *(const f32x4*)(sc + base), h0 = *(const f32x4*)(sh + base); const f32x4 q0 = o0 * (1.0f + s0) + h0;
                u32x2 w; w.x = pk2(q0[0], q0[1]); w.y = pk2(q0[2], q0[3]); *(u32x2*)(H + (size_t)t * DM + base) = w; }
        }
    }
}

__device__ __forceinline__ void ph_odd_post(const Args& A, Frame& F) {
    bf16* Z = (bf16*)(A.ws + WS_Z); const int* positions = (const int*)A.in[2]; bf16* KIT = (bf16*)(A.ws + WS_BIG + 256 * MiB); unsigned char* K8 = A.ws + WS_BIG + 264 * MiB; unsigned char* V8 = A.ws + WS_BIG + 280 * MiB;
    const float inv128 = powf(10000.0f, -(float)F.lane / 64.0f); const int i32 = F.lane & 31; const float inv64 = powf(10000.0f, -(float)i32 / 32.0f);
    for (int t = F.gw; t < TOK; t += F.ngw) {
        bf16* zr = Z + (size_t)t * OD_NP; const float pos = (float)positions[t];
        float sn, cs; sincosf(pos * inv128, &sn, &cs);
        const int bb = t >> 14, spos = t & (SEQ - 1);
        for (int hd = 0; hd < 20; ++hd) { const int base = hd * 128;
            const float t1 = bf2f(zr[base + F.lane]), t2 = bf2f(zr[base + 64 + F.lane]);
            const float r1 = t1 * cs - t2 * sn, r2 = t2 * cs + t1 * sn;
            zr[base + F.lane] = (bf16)f2bf(r1); zr[base + 64 + F.lane] = (bf16)f2bf(r2);
            if (hd >= 16) { unsigned char* k8 = K8 + ((size_t)((bb * 4 + hd - 16) * SEQ + spos)) * 128;
                const unsigned w = (unsigned)__builtin_amdgcn_cvt_pk_fp8_f32(r1 * 16.0f, r2 * 16.0f, 0, false);
                k8[F.lane] = (unsigned char)(w & 0xffu); k8[64 + F.lane] = (unsigned char)((w >> 8) & 0xffu); } }
        {
            const int e0 = F.lane * 8, kvh = e0 >> 7, d0 = e0 & 127;
            const u32x4 vw = *(const u32x4*)(zr + 2560 + e0);
            int w0 = __builtin_amdgcn_cvt_pk_fp8_f32(lo2f(vw.x) * 16.0f, hi2f(vw.x) * 16.0f, 0, false); w0 = __builtin_amdgcn_cvt_pk_fp8_f32(lo2f(vw.y) * 16.0f, hi2f(vw.y) * 16.0f, w0, true);
            int w1 = __builtin_amdgcn_cvt_pk_fp8_f32(lo2f(vw.z) * 16.0f, hi2f(vw.z) * 16.0f, 0, false); w1 = __builtin_amdgcn_cvt_pk_fp8_f32(lo2f(vw.w) * 16.0f, hi2f(vw.w) * 16.0f, w1, true);
            *(u32x2*)(V8 + ((size_t)((bb * 4 + kvh) * SEQ + spos)) * 128 + d0) = (u32x2){(unsigned)w0, (unsigned)w1};
        }
        sincosf(pos * inv64, &sn, &cs);
        for (int it = 0; it < 9; ++it) { const int hd = 2 * it + (F.lane >> 5); if (hd < 17) { const int base = 3072 + hd * 64;
            const float t1 = bf2f(zr[base + i32]), t2 = bf2f(zr[base + 32 + i32]);
            const unsigned short o1 = (unsigned short)f2bf(t1 * cs - t2 * sn), o2 = (unsigned short)f2bf(t2 * cs + t1 * sn);
            zr[base + i32] = o1; zr[base + 32 + i32] = o2;
            if (hd == 16) {
                const int b = t >> 14, sp = t & (SEQ - 1), tile = sp >> 5, rr = sp & 31;
                bf16* kt = KIT + ((size_t)(b * 512 + tile) * 4) * 512;
                const int d1 = i32, d2 = i32 + 32;
                kt[((d1 >> 4) * 64 + rr + 32 * ((d1 >> 3) & 1)) * 8 + (d1 & 7)] = o1;
                kt[((d2 >> 4) * 64 + rr + 32 * ((d2 >> 3) & 1)) * 8 + (d2 & 7)] = o2;
            } } }
    }
}

__device__ __forceinline__ void ph_dsa_select(const Args& A, Frame& F, const int mode = 0) {
    const bf16* Z = (const bf16*)(A.ws + WS_Z); unsigned short* SEL = (unsigned short*)(A.ws + WS_LA); int* CNT = (int*)(A.ws + WS_CNT); const bf16* KIT = (const bf16*)(A.ws + WS_BIG + 256 * MiB);
    LAS unsigned* SC = (LAS unsigned*)F.lds;
    LAS unsigned* hist = (LAS unsigned*)(F.lds + 131072);
    LAS unsigned* res = (LAS unsigned*)(F.lds + 131072 + 2048);
    LAS int* wtot = (LAS int*)(F.lds + 131072 + 2048 + 64);
    const int r = F.lane & 31, hg = F.lane >> 5, tk = (r >> 2) & 1, hh = (r & 3) + 4 * (r >> 3);
    const int grp = F.wave >> 2, ltid = F.tid & 255, lw = F.wave & 3;
    for (int pr = F.bx; pr < TOK / 2; pr += F.G) {
        const int t0 = 2 * pr, b = t0 >> 14, s0 = t0 & (SEQ - 1);
        const int nkeys = s0 + 2, ntiles = (nkeys + 31) >> 5;
        bf16x8 af[4];
        { const bf16* qrow = Z + (size_t)(t0 + tk) * OD_NP + 3072 + hh * 64 + 8 * hg;
#pragma unroll
          for (int s = 0; s < 4; ++s) af[s] = *(const bf16x8*)(qrow + 16 * s); }
        float wv[16];
        { const bf16* wrow = Z + (size_t)(t0 + hg) * OD_NP + 4160;
          const u32x4 w0 = *(const u32x4*)(wrow), w1 = *(const u32x4*)(wrow + 8);
          const unsigned ww[8] = {w0.x, w0.y, w0.z, w0.w, w1.x, w1.y, w1.z, w1.w};
#pragma unroll
          for (int q = 0; q < 8; ++q) { wv[2 * q] = lo2f(ww[q]) * 0.03125f; wv[2 * q + 1] = hi2f(ww[q]) * 0.03125f; } }
        __syncthreads();
        const bf16* kbase = KIT + (size_t)b * 512 * 2048 + F.lane * 8;
        if (mode != 2) {
            bf16x8 bcur[2][4], bnxt[2][4];
#define DSA_LOADT(dst, tb_) do { _Pragma("unroll") for (int q = 0; q < 2; ++q) { const int tile = ((tb_) + q < ntiles) ? ((tb_) + q) : (ntiles - 1); const bf16* krow = kbase + (size_t)tile * 2048; \
                _Pragma("unroll") for (int s_ = 0; s_ < 4; ++s_) dst[q][s_] = *(const bf16x8*)(krow + 512 * s_); } } while (0)
#define DSA_COMPT(src, tb_) do { _Pragma("unroll") for (int q = 0; q < 2; ++q) { f32x16 acc; _Pragma("unroll") for (int e = 0; e < 16; ++e) acc[e] = 0.f; \
                _Pragma("unroll") for (int s_ = 0; s_ < 4; ++s_) acc = __builtin_amdgcn_mfma_f32_32x32x16_bf16(af[s_], src[q][s_], acc, 0, 0, 0); \
                float sc_ = 0.f; _Pragma("unroll") for (int e = 0; e < 16; ++e) sc_ += fmaxf(acc[e], 0.f) * wv[e]; \
                const int key = ((tb_) + q) * 32 + r; sc_ = fminf(fmaxf(sc_, -7.999f), 7.999f); const unsigned fx = (unsigned)((int)rintf(sc_ * 1048576.0f) + (1 << 23)); \
                if ((tb_) + q < ntiles) SC[hg * 16384 + key] = (key <= s0 + hg) ? fx : 0u; } } while (0)
            int tb = F.wave * 2;
            if (tb < ntiles) {
                DSA_LOADT(bcur, tb);
                for (;;) {
                    const int tn = tb + NWAVES * 2;
                    if (tn < ntiles) DSA_LOADT(bnxt, tn);
                    DSA_COMPT(bcur, tb);
                    if (tn >= ntiles) break;
                    const int tn2 = tn + NWAVES * 2;
                    if (tn2 < ntiles) DSA_LOADT(bcur, tn2);
                    DSA_COMPT(bnxt, tn);
                    if (tn2 >= ntiles) break;
                    tb = tn2;
                }
            }
#undef DSA_LOADT
#undef DSA_COMPT
        }
        __syncthreads();
        if (mode == 1) continue;
        const int n = s0 + grp + 1; unsigned k = (unsigned)(n < 256 ? n : 256); unsigned prefix = 0u;
        const LAS unsigned* sc = SC + grp * 16384; LAS unsigned* hs = hist + grp * 256;
        unsigned kreg[64];
#pragma unroll
        for (int j = 0; j < 64; ++j) { const int i = ltid + 256 * j; kreg[j] = (i < n) ? sc[i] : 0u; }
        unsigned lmax = 0u;
#pragma unroll
        for (int j = 0; j < 64; ++j) lmax = (kreg[j] > lmax) ? kreg[j] : lmax;
        unsigned wmin = lmax;
#pragma unroll
        for (int o = 32; o >= 1; o >>= 1) { const unsigned tmp = __shfl_xor(wmin, o); wmin = tmp < wmin ? tmp : wmin; }
        if (F.lane == 0) wtot[16 + F.wave] = (int)wmin;
        __syncthreads();
        unsigned lbound = 0xFFFFFFFFu;
#pragma unroll
        for (int w = 0; w < 4; ++w) { const unsigned x = (unsigned)wtot[16 + grp * 4 + w]; lbound = x < lbound ? x : lbound; }
        LAS unsigned* seg = (LAS unsigned*)SC + grp * 16384 + lw * 4096; int ccnt = 0;
        {
            const unsigned long long below = (F.lane == 0) ? 0ull : ((~0ull) >> (64 - F.lane));
#pragma unroll
            for (int j = 0; j < 64; ++j) { if (256 * j < n) { const bool c = ((ltid + 256 * j) < n) && (kreg[j] >= lbound); const unsigned long long m = __ballot(c);
                if (c) seg[ccnt + __popcll(m & below)] = kreg[j]; ccnt += __popcll(m); } }
        }
        asm volatile("s_waitcnt lgkmcnt(0)" ::: "memory"); __builtin_amdgcn_wave_barrier();
        unsigned creg[16];
#pragma unroll
        for (int i = 0; i < 16; ++i) { creg[i] = 0u; if (64 * i < ccnt) { const int c = F.lane + 64 * i; creg[i] = (c < ccnt) ? seg[c] : 0u; } }
#pragma unroll 1
        for (int pass = 0; pass < 3; ++pass) {
            const int shift = 16 - 8 * pass;
            hs[ltid] = 0u;
            __syncthreads();
#pragma unroll
            for (int i = 0; i < 16; ++i) { if (64 * i < ccnt) { const unsigned kv = creg[i]; const bool valid = (F.lane + 64 * i) < ccnt;
                const bool match = (pass == 0) ? true : ((kv >> (shift + 8)) == prefix);
                if (valid && match) (void)__hip_atomic_fetch_add(&hs[(kv >> shift) & 255u], 1u, __ATOMIC_RELAXED, __HIP_MEMORY_SCOPE_WORKGROUP); } }
#pragma unroll 1
            for (int i = 16; 64 * i < ccnt; ++i) { const int c = F.lane + 64 * i; if (c < ccnt) { const unsigned kv = seg[c];
                const bool match = (pass == 0) ? true : ((kv >> (shift + 8)) == prefix);
                if (match) (void)__hip_atomic_fetch_add(&hs[(kv >> shift) & 255u], 1u, __ATOMIC_RELAXED, __HIP_MEMORY_SCOPE_WORKGROUP); } }
            __syncthreads();
            if (lw == 0) {
                const unsigned c0 = hs[4 * F.lane], c1 = hs[4 * F.lane + 1], c2 = hs[4 * F.lane + 2], c3 = hs[4 * F.lane + 3];
                const unsigned tot = c0 + c1 + c2 + c3; unsigned suf = tot;
#pragma unroll
                for (int o = 1; o < 64; o <<= 1) { const unsigned tmp = __shfl_down(suf, o); if (F.lane + o < 64) suf += tmp; }
                unsigned above = suf - tot;
                if (above < k && k <= suf) {
                    int bin;
                    if (above + c3 >= k) { bin = 3; } else { above += c3; if (above + c2 >= k) { bin = 2; } else { above += c2; if (above + c1 >= k) { bin = 1; } else { above += c1; bin = 0; } } }
                    res[grp * 2 + 0] = (unsigned)(4 * F.lane + bin); res[grp * 2 + 1] = k - above;
                }
            }
            __syncthreads();
            prefix = (prefix << 8) | res[grp * 2 + 0]; k = res[grp * 2 + 1];
        }
        const unsigned tau = prefix; const int krem = (int)k;
        int cg = 0, ce = 0;
#pragma unroll
        for (int j = 0; j < 64; ++j) { const bool valid = (ltid + 256 * j) < n; cg += (valid && kreg[j] > tau) ? 1 : 0; ce += (valid && kreg[j] == tau) ? 1 : 0; }
        int ig = cg, ie = ce;
#pragma unroll
        for (int o = 1; o < 64; o <<= 1) { const int tg = __shfl_up(ig, o), te = __shfl_up(ie, o); if (F.lane >= o) { ig += tg; ie += te; } }
        if (F.lane == 63) { wtot[F.wave * 2] = ig; wtot[F.wave * 2 + 1] = ie; }
        __syncthreads();
        int og = ig - cg, oe = ie - ce, totg = 0;
        for (int w = 0; w < 4; ++w) { const int a = wtot[(grp * 4 + w) * 2], e = wtot[(grp * 4 + w) * 2 + 1]; if (w < lw) { og += a; oe += e; } totg += a; }
        unsigned short* sel = SEL + (size_t)(t0 + grp) * 256;
#pragma unroll
        for (int j = 0; j < 64; ++j) { if (256 * j < n) { const int i = ltid + 256 * j; if (i < n) { const unsigned kv = kreg[j];
            if (kv > tau) { sel[og++] = (unsigned short)i; }
            else if (kv == tau) { if (oe < krem) sel[totg + oe] = (unsigned short)i; ++oe; } } } }
        if (ltid == 0) CNT[t0 + grp] = (n < 256 ? n : 256);
    }
}

__device__ __forceinline__ float sum8_dpp(float v) { v += dppf<0xB1, 0xF>(v); v += dppf<0x4E, 0xF>(v); v += dppf<0x141, 0xF>(v); return v; }
__device__ __forceinline__ void ph_dsa_attn(const Args& A, Frame& F, const XInfo X) {
    const bf16* Z = (const bf16*)(A.ws + WS_Z); const unsigned short* SEL = (const unsigned short*)(A.ws + WS_LA); const int* CNT = (const int*)(A.ws + WS_CNT);
    const unsigned char* K8 = A.ws + WS_BIG + 264 * MiB; const unsigned char* V8 = A.ws + WS_BIG + 280 * MiB; bf16* Y = (bf16*)(A.ws + WS_HY);
    LAS int* IDX = (LAS int*)(F.lds + F.wave * 5120);
    LAS float* SCR = (LAS float*)(F.lds + F.wave * 5120 + 1024);
    const int g8 = F.lane >> 3, c8 = F.lane & 7;
    for (int sl = X.rx; sl < 8; sl += X.nx) {
        const int b = sl >> 2, kvh = sl & 3;
        const unsigned char* kb = K8 + (size_t)sl * SEQ * 128 + 16 * c8; const unsigned char* vb = V8 + (size_t)sl * SEQ * 128 + 16 * c8;
        for (int sq = X.rank * NWAVES + F.wave; sq < SEQ; sq += X.nloc * NWAVES) {
            const int t = b * SEQ + sq; const int n = CNT[t];
            f32x2 qf[4][8];
#pragma unroll
            for (int g = 0; g < 4; ++g) { const bf16* qp = Z + (size_t)t * OD_NP + (kvh * 4 + g) * 128 + 16 * c8; const u32x4 a = *(const u32x4*)qp, c = *(const u32x4*)(qp + 8);
                const unsigned aw[8] = {a.x, a.y, a.z, a.w, c.x, c.y, c.z, c.w};
#pragma unroll
                for (int q = 0; q < 8; ++q) qf[g][q] = (f32x2){lo2f(aw[q]) * 0.005524271728f, hi2f(aw[q]) * 0.005524271728f}; }
#pragma unroll
            for (int m = 0; m < 4; ++m) { const int jj = F.lane + 64 * m; IDX[jj] = (jj < n) ? (int)SEL[(size_t)t * 256 + jj] : 0; }
            asm volatile("s_waitcnt lgkmcnt(0)" ::: "memory"); __builtin_amdgcn_wave_barrier();
#pragma unroll 1
            for (int i0 = 0; i0 < 32; i0 += 8) {
                u32x4 kd[8];
#pragma unroll
                for (int u = 0; u < 8; ++u) { const int id = IDX[8 * (i0 + u) + g8]; kd[u] = *(const u32x4*)(kb + (size_t)id * 128); }
#pragma unroll
                for (int u = 0; u < 8; ++u) {
                    const unsigned w[4] = {kd[u].x, kd[u].y, kd[u].z, kd[u].w}; f32x2 k2[8];
#pragma unroll
                    for (int q = 0; q < 4; ++q) { k2[2 * q] = __builtin_amdgcn_cvt_pk_f32_fp8((int)w[q], false); k2[2 * q + 1] = __builtin_amdgcn_cvt_pk_f32_fp8((int)w[q], true); }
                    float a[4];
#pragma unroll
                    for (int g = 0; g < 4; ++g) { f32x2 d2 = {0.f, 0.f};
#pragma unroll
                        for (int q = 0; q < 8; ++q) d2 = k2[q] * qf[g][q] + d2;
                        a[g] = sum8_dpp(d2.x + d2.y); }
                    const float mine = (c8 == 0) ? a[0] : ((c8 == 1) ? a[1] : ((c8 == 2) ? a[2] : a[3]));
                    if (c8 < 4) SCR[(8 * (i0 + u) + g8) * 4 + c8] = mine;
                }
            }
            asm volatile("s_waitcnt lgkmcnt(0)" ::: "memory"); __builtin_amdgcn_wave_barrier();
            {
                f32x4 sv[4];
#pragma unroll
                for (int m = 0; m < 4; ++m) sv[m] = *(const LAS f32x4*)(SCR + (F.lane + 64 * m) * 4);
#pragma unroll
                for (int g = 0; g < 4; ++g) {
                    float mx = -INFINITY;
#pragma unroll
                    for (int m = 0; m < 4; ++m) { const bool val = (F.lane + 64 * m) < n; sv[m][g] = val ? sv[m][g] : -INFINITY; mx = fmaxf(mx, sv[m][g]); }
                    mx = wmax(mx); float sm = 0.f;
#pragma unroll
                    for (int m = 0; m < 4; ++m) { const bool val = (F.lane + 64 * m) < n; sv[m][g] = val ? expf(sv[m][g] - mx) : 0.f; sm += sv[m][g]; }
                    const float rden = 0.0625f / wsum(sm);
#pragma unroll
                    for (int m = 0; m < 4; ++m) sv[m][g] *= rden;
                }
#pragma unroll
                for (int m = 0; m < 4; ++m) *(LAS f32x4*)(SCR + (F.lane + 64 * m) * 4) = sv[m];
            }
            asm volatile("s_waitcnt lgkmcnt(0)" ::: "memory"); __builtin_amdgcn_wave_barrier();
            f32x2 o[4][8];
#pragma unroll
            for (int g = 0; g < 4; ++g)
#pragma unroll
                for (int q = 0; q < 8; ++q) o[g][q] = (f32x2){0.f, 0.f};
#pragma unroll 1
            for (int i0 = 0; i0 < 32; i0 += 4) {
                u32x4 vd[4]; f32x4 pv[4];
#pragma unroll
                for (int u = 0; u < 4; ++u) { const int id = IDX[8 * (i0 + u) + g8]; vd[u] = *(const u32x4*)(vb + (size_t)id * 128); pv[u] = *(const LAS f32x4*)(SCR + (8 * (i0 + u) + g8) * 4); }
#pragma unroll
                for (int u = 0; u < 4; ++u) {
                    const unsigned w[4] = {vd[u].x, vd[u].y, vd[u].z, vd[u].w}; f32x2 v2[8];
#pragma unroll
                    for (int q = 0; q < 4; ++q) { v2[2 * q] = __builtin_amdgcn_cvt_pk_f32_fp8((int)w[q], false); v2[2 * q + 1] = __builtin_amdgcn_cvt_pk_f32_fp8((int)w[q], true); }
#pragma unroll
                    for (int g = 0; g < 4; ++g) { const f32x2 pg = {pv[u][g], pv[u][g]};
#pragma unroll
                        for (int q = 0; q < 8; ++q) o[g][q] = pg * v2[q] + o[g][q]; }
                }
            }
            f32x2 mine[8];
#pragma unroll
            for (int q = 0; q < 8; ++q) {
                float x[4][2];
#pragma unroll
                for (int g = 0; g < 4; ++g) { float a0 = o[g][q].x, a1 = o[g][q].y;
                    a0 += dppf<0x128, 0xF>(a0); a1 += dppf<0x128, 0xF>(a1);
                    a0 += __shfl_xor(a0, 16); a0 += __shfl_xor(a0, 32); a1 += __shfl_xor(a1, 16); a1 += __shfl_xor(a1, 32); x[g][0] = a0; x[g][1] = a1; }
                mine[q].x = (g8 == 0) ? x[0][0] : ((g8 == 1) ? x[1][0] : ((g8 == 2) ? x[2][0] : x[3][0]));
                mine[q].y = (g8 == 0) ? x[0][1] : ((g8 == 1) ? x[1][1] : ((g8 == 2) ? x[2][1] : x[3][1]));
            }
            if (g8 < 4) { u32x4 w0, w1;
                w0.x = pk2(mine[0].x, mine[0].y); w0.y = pk2(mine[1].x, mine[1].y); w0.z = pk2(mine[2].x, mine[2].y); w0.w = pk2(mine[3].x, mine[3].y);
                w1.x = pk2(mine[4].x, mine[4].y); w1.y = pk2(mine[5].x, mine[5].y); w1.z = pk2(mine[6].x, mine[6].y); w1.w = pk2(mine[7].x, mine[7].y);
                bf16* yp = Y + (size_t)t * DM + (kvh * 4 + g8) * 128 + 16 * c8; *(u32x4*)yp = w0; *(u32x4*)(yp + 8) = w1; }
            asm volatile("s_waitcnt lgkmcnt(0)" ::: "memory"); __builtin_amdgcn_wave_barrier();
        }
    }
}

__global__ void __launch_bounds__(NTHREADS, 2) mk_fwd(Args args) {
    extern __shared__ __attribute__((aligned(16))) unsigned char lds[];
    Frame F;
    F.lds = (LAS unsigned char*)lds;
    volatile LAS unsigned* MISC = (volatile LAS unsigned*)(F.lds + MISC_OFF);
    F.tid = threadIdx.x; F.lane = F.tid & 63; F.wave = __builtin_amdgcn_readfirstlane(F.tid >> 6);
    F.bx = blockIdx.x; F.G = gridDim.x; F.gw = F.bx * NWAVES + F.wave; F.ngw = F.G * NWAVES;
    if (F.tid < 64) MISC[F.tid] = 0u;
    __syncthreads();
    unsigned char* ws = args.ws;
    XcdBarrier bar = xcd_barrier_post((unsigned*)(ws + WS_CTL) + CW_BAR, MISC + 8);
    if (F.tid == 0) { MISC[16] = xb_add((unsigned*)(ws + WS_CTL) + CW_XRANK + 64 * bar.x, 1u); }
    const int lo = args.ph_lo, hi = args.ph_hi;
#define IN(k) (lo <= (k) && (k) < hi)
#define SEAM(k) do { if (IN((k) + 1)) xcd_barrier(bar); } while (0)
#define GEMM_BF16(Aptr, Bptr, Nn, Kk, Optr, ldo) do { pg8::Gemm g{(const pg8::bf16_t*)(Aptr), (const pg8::bf16_t*)(Bptr), TOK, (Nn), (Kk)}; pg8::StaticOrder S; S.init(TOK, (Nn), F.G, F.bx); \
        pg8::EpiBf16<0> E{(pg8::bf16_t*)(Optr), (ldo), nullptr, 0, 0}; pg8::gemm_phase<pg8::EpiBf16<0>, pg8::StaticOrder, false>(F.lds, g, S, E, nullptr); } while (0)

#ifndef PROBE_MASK
#define PROBE_MASK 0
#endif
#define PRB(bit, stmt) do { if (PROBE_MASK & (1 << (bit))) { stmt; xcd_barrier(bar); } } while (0)
    if (IN(0)) { ph_prologue(args, F); SEAM(0); }
    if (IN(1)) { ph_mod_x(args, F); SEAM(1); }
    if (F.tid == 0) {
        unsigned* cb = (unsigned*)(ws + WS_CTL) + CW_BAR; unsigned nloc = 1u, rx = 0u, nx = 0u;
        for (unsigned j = 0; j < 16; ++j) { const unsigned c = xb_ld(&cb[XB_XCNT(j)]); if (c > 0u) { if (j < bar.x) ++rx; ++nx; } if (j == bar.x) nloc = c > 0u ? c : 1u; }
        if (nx == 0u) nx = 1u;
        MISC[17] = nloc; MISC[18] = rx; MISC[19] = nx; }
    __syncthreads();
    const XInfo XI = xcc_info(MISC);
    if (IN(2)) { GEMM_BF16(ws + WS_HY, ws + WS_WINE, EV_NP, 2048, ws + WS_Z, EV_NP); SEAM(2); }
    if (IN(3)) { ph_even_post(args, F); SEAM(3); }
    if (IN(4)) { pg8::Gemm g{(const pg8::bf16_t*)(ws + WS_LA), (const pg8::bf16_t*)(ws + WS_WL), TOK, 3072, 512}; pg8::StaticOrder S; S.init(TOK, 3072, F.G, F.bx);
                 EpiLora E{(pg8::bf16_t*)(ws + WS_Z) + 1280, EV_NP, (const float*)args.in[7], (const float*)args.in[9]};
                 pg8::gemm_phase<EpiLora, pg8::StaticOrder, false>(F.lds, g, S, E, nullptr); SEAM(4); }
    if (IN(5)) { ph_scan_pack(args, F); xcd_barrier(bar); }
    if (IN(7)) { ph_scan(args, F, MISC); SEAM(7); }
    if (IN(8)) { ph_rwkv_finish(args, F); SEAM(8); }
    if (IN(9)) { GEMM_BF16(ws + WS_HY, ws + WS_WOUTE, 2048, 2048, ws + WS_Z, 2048); SEAM(9); }
    if (IN(10)) { ph_ln_mixer(args, F, 0); SEAM(10); }
    if (IN(11)) { GEMM_BF16(ws + WS_HY, ws + WS_WQ0, 2048, 2048, ws + WS_Z, 2048); SEAM(11); }
    if (IN(12)) { PRB(4, ph_peer_select(args, F, 0)); ph_peer_select(args, F, 0); SEAM(12); }
    if (IN(13)) { ph_peer_u(args, F, XI); xcd_barrier(bar); ph_peer_v(args, F, XI); xcd_barrier(bar); ph_peer_ln(args, F, 0); SEAM(13); }
    if (IN(14)) { GEMM_BF16(ws + WS_HY, ws + WS_WINO, OD_NP, 2048, ws + WS_Z, OD_NP); SEAM(14); }
    if (IN(15)) { ph_odd_post(args, F); SEAM(15); }
    if (IN(16)) { PRB(2, ph_dsa_select(args, F, 1)); PRB(6, ph_dsa_select(args, F, 2)); PRB(7, ph_dsa_select(args, F, 0)); ph_dsa_select(args, F); SEAM(16); }
    if (IN(17)) { ph_dsa_attn(args, F, XI); SEAM(17); }
    if (IN(18)) { GEMM_BF16(ws + WS_HY, ws + WS_WOUTO, 2048, 2048, ws + WS_Z, 2048); SEAM(18); }
    if (IN(19)) { ph_ln_mixer(args, F, 1); SEAM(19); }
    if (IN(20)) { GEMM_BF16(ws + WS_HY, ws + WS_WQ1, 2048, 2048, ws + WS_Z, 2048); SEAM(20); }
    if (IN(21)) { PRB(4, ph_peer_select(args, F, 1)); ph_peer_select(args, F, 1); SEAM(21); }
    if (IN(22)) { ph_peer_u(args, F, XI); xcd_barrier(bar); ph_peer_v(args, F, XI); xcd_barrier(bar); ph_peer_ln(args, F, 1); }
#undef IN
#undef SEAM
#undef GEMM_BF16
}

#ifndef MK_SPLIT
#define MK_SPLIT 0
#endif
extern "C" void kernel_launch(void* const* d_in, const int* in_sizes, int n_in, void* d_out, int out_size, void* d_ws, size_t ws_size, hipStream_t stream) {
    static int grid = 0;
    if (grid == 0) {
        int dev = 0, cus = 0;
        if (n_in != 27 || out_size != TOK * DM || ws_size < WS_END) { fprintf(stderr, "kernel_launch: unexpected shapes (n_in %d out %d ws %zu)\n", n_in, out_size, ws_size); grid = -1; return; }
        if (hipGetDevice(&dev) != hipSuccess || hipDeviceGetAttribute(&cus, hipDeviceAttributeMultiprocessorCount, dev) != hipSuccess) { grid = -1; return; }
        if (hipFuncSetAttribute((const void*)mk_fwd, hipFuncAttributeMaxDynamicSharedMemorySize, LDS_BYTES) != hipSuccess) { fprintf(stderr, "kernel_launch: hipFuncSetAttribute failed\n"); grid = -1; return; }
        int per_cu = 0;
        if (hipOccupancyMaxActiveBlocksPerMultiprocessor(&per_cu, (const void*)mk_fwd, NTHREADS, LDS_BYTES) != hipSuccess || per_cu < 1) fprintf(stderr, "kernel_launch: occupancy query says %d\n", per_cu);
        (void)hipGetLastError();
        grid = cus;
    }
    if (grid < 0) return;
    (void)hipMemsetAsync((char*)d_ws + WS_CTL, 0, CTL_ZERO_BYTES, stream);
    Args a{};
    for (int i = 0; i < 27; ++i) a.in[i] = d_in[i];
    a.out = (float*)d_out; a.ws = (unsigned char*)d_ws;
#if MK_SPLIT
    for (int p = 0; p < 23; ++p) { a.ph_lo = p; a.ph_hi = p + 1; hipLaunchKernelGGL(mk_fwd, dim3(grid), dim3(NTHREADS), LDS_BYTES, stream, a); }
#else
    a.ph_lo = 0; a.ph_hi = 23;
    hipLaunchKernelGGL(mk_fwd, dim3(grid), dim3(NTHREADS), LDS_BYTES, stream, a);
#endif
}
```

```cpp
#include <hip/hip_runtime.h>
#include <cstdio>
#include <cstdint>
namespace pg8 {
#define PG8_LAS __attribute__((address_space(3)))
typedef unsigned short bf16_t;
typedef short bf16x8 __attribute__((ext_vector_type(8)));
typedef float f32x4 __attribute__((ext_vector_type(4)));
typedef unsigned u32x4 __attribute__((ext_vector_type(4)));
constexpr int BM = 256, BK = 64, HALF = 128, HTB = HALF * BK * 2  , STAGE_BYTES = 8 * HTB, NXCD = 8, WGM = 8;

__host__ __device__ __forceinline__ int lds_byte(int r, int c) { const int st = (r >> 4) * 2 + (c >> 5), rr = r & 15, cc = c & 31, ob = rr * 64 + cc * 2; return st * 1024 + (ob ^ (((ob >> 9) & 1) << 5)); }
__host__ __device__ __forceinline__ void stage_rc(int b, int& R, int& C) { const int st = b / 1024, sb = b % 1024, swz = sb ^ (((sb >> 9) & 1) << 5); R = (st >> 1) * 16 + swz / 64; C = (st & 1) * 32 + (swz % 64) / 2; }
__host__ __device__ __forceinline__ int perm32(int rho) { const int n = rho >> 4, i = rho & 15; return 8 * (i >> 2) + 4 * n + (i & 3); }

struct Unit { int pm, pn; };
struct Gemm { const bf16_t* A; const bf16_t* Bt; int M, N, K; };

struct StaticOrder {
    int nM, nN, nwg, G, c;
    __host__ __device__ void init(int M, int N, int G_, int c_) { nM = M / BM; nN = N / BM; nwg = nM * nN; G = G_; c = c_; }
    __host__ __device__ bool next(int i, Unit& u) const {
        const long L = (long)i * G + c; if (L >= nwg) return false;
        int wgid = (int)L; { const int q = nwg / NXCD, r = nwg % NXCD, xcd = wgid % NXCD, off = wgid / NXCD; wgid = (xcd < r ? xcd * (q + 1) : r * (q + 1) + (xcd - r) * q) + off; }
        const int nig = WGM * nN, gid = wgid / nig, fm = gid * WGM, gsz = (nM - fm) < WGM ? (nM - fm) : WGM;
        u.pm = fm + ((wgid % nig) % gsz); u.pn = (wgid % nig) / gsz; return true;
    }
    __device__ __forceinline__ void a_ready(const Unit&) const {}
    __device__ __forceinline__ void done(const Unit&) const {}
};
struct CountedOrder : StaticOrder {
    const unsigned* ready; unsigned need; unsigned* tmo;
    __device__ __forceinline__ void a_ready(const Unit& u) const {
        if (threadIdx.x < 64) {
            const unsigned long long t0 = __builtin_amdgcn_s_memrealtime(); unsigned polls = 0;
            while ((unsigned)__builtin_amdgcn_readfirstlane(__hip_atomic_load(ready + 64 * u.pm, __ATOMIC_RELAXED, __HIP_MEMORY_SCOPE_AGENT)) < need) {
                if ((++polls & 255u) == 0u && __builtin_amdgcn_readfirstlane(__hip_atomic_load(tmo, __ATOMIC_RELAXED, __HIP_MEMORY_SCOPE_AGENT)) != 0u) break;
                if (__builtin_amdgcn_s_memrealtime() - t0 > 2000000ull) {
                    if (threadIdx.x == 0) { unsigned expect = 0u; __hip_atomic_compare_exchange_strong(tmo + 1, &expect, 0x600u | (unsigned)(u.pm & 0xff), __ATOMIC_RELAXED, __ATOMIC_RELAXED, __HIP_MEMORY_SCOPE_AGENT); __hip_atomic_store(tmo, 1u, __ATOMIC_RELAXED, __HIP_MEMORY_SCOPE_AGENT); }
                    break; }
                __builtin_amdgcn_s_sleep(2); }
            __builtin_amdgcn_fence(__ATOMIC_ACQUIRE, "agent");
            asm volatile("s_waitcnt vmcnt(0)" ::: "memory");
        }
#if !defined(BROKEN_HOOK_NO_BARRIER)
        asm volatile("" ::: "memory"); __builtin_amdgcn_s_barrier(); asm volatile("" ::: "memory");
#endif
    }
};

__device__ __forceinline__ unsigned cvt_pk_bf16(float lo, float hi) { unsigned r; asm volatile("v_cvt_pk_bf16_f32 %0, %1, %2" : "=v"(r) : "v"(lo), "v"(hi)); return r; }
typedef float f32x2 __attribute__((ext_vector_type(2)));
__device__ __forceinline__ f32x2 gelu_pk(f32x2 v) {
    const f32x2 av = __builtin_elementwise_abs(v), d = av * 0.2316418882f + 1.0f;
    f32x2 t; t.x = __builtin_amdgcn_rcpf(d.x); t.y = __builtin_amdgcn_rcpf(d.y);
    f32x2 q = t * 0.5307027145f + (-0.7265760135f); q = q * t + 0.7107068705f; q = q * t + (-0.142248368f); q = q * t + 0.127414796f; q = q * t;
    const f32x2 s = (v * v) * (-0.72134752044f);
    f32x2 e; e.x = __builtin_amdgcn_exp2f(s.x); e.y = __builtin_amdgcn_exp2f(s.y);
    const f32x2 m = v * (q * e), r = v - m;
    f32x2 o; o.x = v.x < 0.f ? m.x : r.x; o.y = v.y < 0.f ? m.y : r.y; return o;
}

struct EpiF32 {
    static constexpr bool PERM = false, AFTER_DRAIN = false;
    float* C; int ldc; const float* bias;
    __device__ __forceinline__ void operator()(const f32x4 (&acc)[2][2][4][2], const Unit& u, int wr, int wc, int fr, int fq) const {
        const int row0 = u.pm * BM + wr * 64 + fr, col0 = u.pn * BM + wc * 32 + 4 * fq;
        f32x4 bv[2][2];
#pragma unroll
        for (int bj = 0; bj < 2; ++bj)
#pragma unroll
            for (int n = 0; n < 2; ++n) bv[bj][n] = bias ? *(const f32x4*)(bias + col0 + bj * HALF + n * 16) : (f32x4){0.f, 0.f, 0.f, 0.f};
#pragma unroll
        for (int ai = 0; ai < 2; ++ai)
#pragma unroll
            for (int m = 0; m < 4; ++m) { float* rowp = C + (size_t)(row0 + ai * HALF + m * 16) * ldc + col0;
#pragma unroll
                for (int bj = 0; bj < 2; ++bj)
#pragma unroll
                    for (int n = 0; n < 2; ++n) *(f32x4*)(rowp + bj * HALF + n * 16) = acc[ai][bj][m][n] + bv[bj][n]; }
    }
};
template <int ACT  > struct EpiBf16 {
    static constexpr bool PERM = true, AFTER_DRAIN = false;
    bf16_t* O; int ldc; const float* bias; int split_cols; size_t split_stride;
    __device__ __forceinline__ void operator()(const f32x4 (&acc)[2][2][4][2], const Unit& u, int wr, int wc, int fr, int fq) const {
        const int row0 = u.pm * BM + wr * 64 + fr; int colt = u.pn * BM; bf16_t* base = O;
        if (split_cols) { const int t = colt / split_cols; base += (size_t)t * split_stride; colt -= t * split_cols; }
        const int col0 = colt + wc * 32 + 8 * fq, bcol0 = u.pn * BM + wc * 32 + 8 * fq;
        f32x4 bv[2][2];
#pragma unroll
        for (int bj = 0; bj < 2; ++bj)
#pragma unroll
            for (int n = 0; n < 2; ++n) bv[bj][n] = bias ? *(const f32x4*)(bias + bcol0 + bj * HALF + 4 * n) : (f32x4){0.f, 0.f, 0.f, 0.f};
#pragma unroll
        for (int ai = 0; ai < 2; ++ai)
#pragma unroll
            for (int m = 0; m < 4; ++m) { bf16_t* rowp = base + (size_t)(row0 + ai * HALF + m * 16) * ldc + col0;
#pragma unroll
                for (int bj = 0; bj < 2; ++bj) { f32x4 v0 = acc[ai][bj][m][0] + bv[bj][0], v1 = acc[ai][bj][m][1] + bv[bj][1];
                    if (ACT == 1) { f32x2 a = gelu_pk((f32x2){v0[0], v0[1]}), b = gelu_pk((f32x2){v0[2], v0[3]}), c = gelu_pk((f32x2){v1[0], v1[1]}), d = gelu_pk((f32x2){v1[2], v1[3]});
                        v0 = (f32x4){a.x, a.y, b.x, b.y}; v1 = (f32x4){c.x, c.y, d.x, d.y}; }
                    if (ACT == 2) {
#pragma unroll
                        for (int j = 0; j < 4; ++j) { v0[j] = 0.5f * v0[j] * (1.0f + erff(v0[j] * 0.70710678f)); v1[j] = 0.5f * v1[j] * (1.0f + erff(v1[j] * 0.70710678f)); } }
                    u32x4 w; w.x = cvt_pk_bf16(v0[0], v0[1]); w.y = cvt_pk_bf16(v0[2], v0[3]); w.z = cvt_pk_bf16(v1[0], v1[1]); w.w = cvt_pk_bf16(v1[2], v1[3]);
                    *(u32x4*)(rowp + bj * HALF) = w; } }
    }
};

struct PanelStats {
    unsigned* xbuf;
    unsigned* cnt;
    unsigned* tmo;
    int ntn; float eps;
    unsigned code;
    __device__ __forceinline__ bool run(const f32x4 (&v)[2][2][4][2], const Unit& u, int wr, int wc, int fr, int fq, PG8_LAS unsigned char* lds, int wid, int lane) const {
        typedef float f32x2v __attribute__((ext_vector_type(2)));
        PG8_LAS f32x2v* P = (PG8_LAS f32x2v*)lds;
        PG8_LAS f32x2v* S = (PG8_LAS f32x2v*)(lds + 8192);
        PG8_LAS unsigned* flag = (PG8_LAS unsigned*)(lds + 8192 + 2048);
#pragma unroll
        for (int ai = 0; ai < 2; ++ai)
#pragma unroll
            for (int m = 0; m < 4; ++m) {
                float s = 0.f;
#pragma unroll
                for (int bj = 0; bj < 2; ++bj)
#pragma unroll
                    for (int n = 0; n < 2; ++n) { const f32x4 x = v[ai][bj][m][n]; s += (x[0] + x[1]) + (x[2] + x[3]); }
                s += __shfl_xor(s, 16); s += __shfl_xor(s, 32);
                const float mw = s * (1.0f / 64.0f); float q = 0.f;
#pragma unroll
                for (int bj = 0; bj < 2; ++bj)
#pragma unroll
                    for (int n = 0; n < 2; ++n) { const f32x4 d = v[ai][bj][m][n] - mw; q += (d[0] * d[0] + d[1] * d[1]) + (d[2] * d[2] + d[3] * d[3]); }
                q += __shfl_xor(q, 16); q += __shfl_xor(q, 32);
                if (fq == 0) P[(ai * HALF + wr * 64 + m * 16 + fr) * 4 + wc] = (f32x2v){mw, q};
            }
        asm volatile("s_waitcnt lgkmcnt(0)" ::: "memory"); __builtin_amdgcn_s_barrier(); asm volatile("" ::: "memory");
#if defined(BROKEN_NO_WAIT)
        if (blockIdx.x >= 64) { const long long t0 = clock64(); while (clock64() - t0 < 60000) __builtin_amdgcn_s_sleep(8); }
#endif
        const int row = wid * 32 + (lane & 31);
        if (lane < 32) {
            const f32x2v a = P[row * 4 + 0], b = P[row * 4 + 1], c = P[row * 4 + 2], d = P[row * 4 + 3];
            const float mt = (a.x + b.x + c.x + d.x) * 0.25f;
            const float da = a.x - mt, db = b.x - mt, dc = c.x - mt, dd = d.x - mt;
            const float m2 = (a.y + b.y) + (c.y + d.y) + 64.0f * ((da * da + db * db) + (dc * dc + dd * dd));
            unsigned long long* slot = (unsigned long long*)xbuf + ((size_t)(u.pm * BM + row) * 4 + u.pn);
            __hip_atomic_store(slot, ((unsigned long long)__float_as_uint(m2) << 32) | __float_as_uint(mt), __ATOMIC_RELAXED, __HIP_MEMORY_SCOPE_AGENT);
        }
        asm volatile("s_waitcnt vmcnt(0)" ::: "memory");
        if (lane == 0) __hip_atomic_fetch_add(cnt + 64 * u.pm, 1u, __ATOMIC_RELAXED, __HIP_MEMORY_SCOPE_AGENT);
        if (wid == 0) {
            bool dead = false; const unsigned long long t0 = __builtin_amdgcn_s_memrealtime(); const unsigned want = 8u * (unsigned)ntn;
            for (;;) {
#if defined(BROKEN_NO_WAIT)
                break;
#endif
                if ((unsigned)__builtin_amdgcn_readfirstlane(__hip_atomic_load(cnt + 64 * u.pm, __ATOMIC_RELAXED, __HIP_MEMORY_SCOPE_AGENT)) >= want) break;
                if (__builtin_amdgcn_s_memrealtime() - t0 > 2000000ull) {
                    if (lane == 0) { unsigned expect = 0u; __hip_atomic_compare_exchange_strong(tmo + 1, &expect, code | (unsigned)(u.pm & 0xff), __ATOMIC_RELAXED, __ATOMIC_RELAXED, __HIP_MEMORY_SCOPE_AGENT);
                                     __hip_atomic_store(tmo, 1u, __ATOMIC_RELAXED, __HIP_MEMORY_SCOPE_AGENT); }
                    dead = true; break; }
                __builtin_amdgcn_s_sleep(2);
            }
            __builtin_amdgcn_fence(__ATOMIC_ACQUIRE, "agent");
            if (lane == 0) flag[0] = dead ? 1u : 0u;
        }
        asm volatile("s_waitcnt vmcnt(0) lgkmcnt(0)" ::: "memory"); __builtin_amdgcn_s_barrier(); asm volatile("" ::: "memory");
        const bool bad = flag[0] != 0u;
        if (lane < 32) {
            const unsigned long long* slot = (const unsigned long long*)xbuf + (size_t)(u.pm * BM + row) * 4; float mt[4], m2[4]; float ms = 0.f;
#pragma unroll
            for (int t = 0; t < 4; ++t) { if (t < ntn) { const unsigned long long w = __hip_atomic_load(slot + t, __ATOMIC_RELAXED, __HIP_MEMORY_SCOPE_AGENT); mt[t] = __uint_as_float((unsigned)w); m2[t] = __uint_as_float((unsigned)(w >> 32)); } else { mt[t] = 0.f; m2[t] = 0.f; } ms += mt[t]; }
            const float mean = ms / (float)ntn; float q = 0.f;
#pragma unroll
            for (int t = 0; t < 4; ++t) if (t < ntn) { const float dm = mt[t] - mean; q += m2[t] + 256.0f * dm * dm; }
            S[row] = (f32x2v){mean, 1.0f / sqrtf(q / (256.0f * (float)ntn) + eps)};
        }
        asm volatile("s_waitcnt lgkmcnt(0)" ::: "memory"); __builtin_amdgcn_s_barrier(); asm volatile("" ::: "memory");
        return bad;
    }
};
struct EpiLnRes {
    static constexpr bool PERM = false, AFTER_DRAIN = true;
    const float* base; float* out; int ldc; const float* bias; PanelStats st; unsigned poison;
    __device__ __forceinline__ void refuse(size_t i0, size_t stride, int M, int N) const { const float q = __builtin_nanf(""); for (size_t i = i0; i < (size_t)M * N; i += stride) out[(i / N) * ldc + i % N] = q;
        if (i0 == 0) { unsigned expect = 0u; __hip_atomic_compare_exchange_strong(st.tmo + 1, &expect, 0x7f0u, __ATOMIC_RELAXED, __ATOMIC_RELAXED, __HIP_MEMORY_SCOPE_AGENT); __hip_atomic_store(st.tmo, 1u, __ATOMIC_RELAXED, __HIP_MEMORY_SCOPE_AGENT); } }
    __device__ __forceinline__ void fused(f32x4 (&acc)[2][2][4][2], const Unit& u, int wr, int wc, int fr, int fq, PG8_LAS unsigned char* lds, int wid, int lane) const {
        typedef float f32x2v __attribute__((ext_vector_type(2)));
        const PG8_LAS f32x2v* S = (const PG8_LAS f32x2v*)(lds + 8192);
        const int col0 = u.pn * BM + wc * 32 + 4 * fq;
#pragma unroll
        for (int bj = 0; bj < 2; ++bj)
#pragma unroll
            for (int n = 0; n < 2; ++n) { const f32x4 bv = bias ? *(const f32x4*)(bias + col0 + bj * HALF + n * 16) : (f32x4){0.f, 0.f, 0.f, 0.f};
#pragma unroll
                for (int ai = 0; ai < 2; ++ai)
#pragma unroll
                    for (int m = 0; m < 4; ++m) acc[ai][bj][m][n] += bv; }
        const bool bad = st.run(acc, u, wr, wc, fr, fq, lds, wid, lane) || poison != 0u;
        const float qnan = __builtin_nanf("");
#pragma unroll
        for (int ai = 0; ai < 2; ++ai)
#pragma unroll
            for (int m = 0; m < 4; ++m) { const int r = ai * HALF + wr * 64 + m * 16 + fr; const f32x2v sr = S[r]; const size_t off = (size_t)(u.pm * BM + r) * ldc + col0;
#pragma unroll
                for (int bj = 0; bj < 2; ++bj)
#pragma unroll
                    for (int n = 0; n < 2; ++n) { const f32x4 bs = *(const f32x4*)(base + off + bj * HALF + n * 16); f32x4 o = bs + (acc[ai][bj][m][n] - sr.x) * sr.y;
                        if (bad) o = (f32x4){qnan, qnan, qnan, qnan}; *(f32x4*)(out + off + bj * HALF + n * 16) = o; }
                asm volatile("" ::: "memory"); }
    }
};
struct EpiLnResLn {
    static constexpr bool PERM = false, AFTER_DRAIN = true;
    const float* base; float* out; bf16_t* xn; int ldc; const float* bias; PanelStats st1, st2; unsigned poison;
    __device__ __forceinline__ void refuse(size_t i0, size_t stride, int M, int N) const { const float q = __builtin_nanf(""); for (size_t i = i0; i < (size_t)M * N; i += stride) { const size_t o = (i / N) * ldc + i % N; out[o] = q; xn[o] = (bf16_t)0x7fc0u; }
        if (i0 == 0) { unsigned expect = 0u; __hip_atomic_compare_exchange_strong(st1.tmo + 1, &expect, 0x7f0u, __ATOMIC_RELAXED, __ATOMIC_RELAXED, __HIP_MEMORY_SCOPE_AGENT); __hip_atomic_store(st1.tmo, 1u, __ATOMIC_RELAXED, __HIP_MEMORY_SCOPE_AGENT); } }
    __device__ __forceinline__ void fused(f32x4 (&acc)[2][2][4][2], const Unit& u, int wr, int wc, int fr, int fq, PG8_LAS unsigned char* lds, int wid, int lane) const {
        typedef float f32x2v __attribute__((ext_vector_type(2))); typedef unsigned u32x2v __attribute__((ext_vector_type(2)));
        const PG8_LAS f32x2v* S = (const PG8_LAS f32x2v*)(lds + 8192);
        const int col0 = u.pn * BM + wc * 32 + 4 * fq;
#pragma unroll
        for (int bj = 0; bj < 2; ++bj)
#pragma unroll
            for (int n = 0; n < 2; ++n) { const f32x4 bv = bias ? *(const f32x4*)(bias + col0 + bj * HALF + n * 16) : (f32x4){0.f, 0.f, 0.f, 0.f};
#pragma unroll
                for (int ai = 0; ai < 2; ++ai)
#pragma unroll
                    for (int m = 0; m < 4; ++m) acc[ai][bj][m][n] += bv; }
        bool bad = st1.run(acc, u, wr, wc, fr, fq, lds, wid, lane) || poison != 0u;
        const float qnan = __builtin_nanf("");
#pragma unroll
        for (int ai = 0; ai < 2; ++ai)
#pragma unroll
            for (int m = 0; m < 4; ++m) { const int r = ai * HALF + wr * 64 + m * 16 + fr; const f32x2v sr = S[r]; const size_t off = (size_t)(u.pm * BM + r) * ldc + col0;
#pragma unroll
                for (int bj = 0; bj < 2; ++bj)
#pragma unroll
                    for (int n = 0; n < 2; ++n) { const f32x4 bs = *(const f32x4*)(base + off + bj * HALF + n * 16); acc[ai][bj][m][n] = bs + (acc[ai][bj][m][n] - sr.x) * sr.y; }
                asm volatile("" : "+v"(acc[ai][0][m][0]), "+v"(acc[ai][0][m][1]), "+v"(acc[ai][1][m][0]), "+v"(acc[ai][1][m][1]));
                if (m & 1) asm volatile("" ::: "memory"); }
        const bool bad1 = bad;
        bad = st2.run(acc, u, wr, wc, fr, fq, lds, wid, lane) || bad;
#pragma unroll
        for (int ai = 0; ai < 2; ++ai)
#pragma unroll
            for (int m = 0; m < 4; ++m) { const int r = ai * HALF + wr * 64 + m * 16 + fr; const f32x2v sr = S[r]; const size_t off = (size_t)(u.pm * BM + r) * ldc + col0;
#pragma unroll
                for (int bj = 0; bj < 2; ++bj)
#pragma unroll
                    for (int n = 0; n < 2; ++n) { const f32x4 x1 = acc[ai][bj][m][n]; *(f32x4*)(out + off + bj * HALF + n * 16) = bad1 ? (f32x4){qnan, qnan, qnan, qnan} : x1;
                        const f32x4 o = (x1 - sr.x) * sr.y; u32x2v w; w.x = cvt_pk_bf16(o[0], o[1]); w.y = cvt_pk_bf16(o[2], o[3]);
                        if (bad) { w.x = 0x7fc07fc0u; w.y = 0x7fc07fc0u; } *(u32x2v*)(xn + off + bj * HALF + n * 16) = w; }
                asm volatile("" ::: "memory"); }
    }
};

template <class Epi, class Sched, bool STAMP = false>
__device__ __forceinline__ void gemm_phase(PG8_LAS unsigned char* lds, const Gemm g, const Sched& S, const Epi& E, unsigned long long* stamps) {
    const int tid = threadIdx.x, wid = __builtin_amdgcn_readfirstlane(tid >> 6), lane = tid & 63, wr = wid >> 2, wc = wid & 3, fr = lane & 15, fq = lane >> 4;
    const int K = g.K, nt = K / BK;
    int ts_lo = 0, ts_hi = 0, nts = 0; const unsigned long long rt_entry = STAMP ? (unsigned long long)wall_clock64() : 0ull;
#define PG8_STAMP() do { if (STAMP && wid == 0 && nts < 64) { const unsigned long long _c = (unsigned long long)clock64(); \
        ts_lo = (lane == nts) ? (int)(unsigned)_c : ts_lo; ts_hi = (lane == nts) ? (int)(unsigned)(_c >> 32) : ts_hi; ++nts; } } while (0)
    PG8_STAMP();
    unsigned voffA[2], voffB[2];
#pragma unroll
    for (int i = 0; i < 2; ++i) { int R, C; stage_rc(tid * 16 + i * 8192, R, C); const int Rb = Epi::PERM ? ((R & ~31) + perm32(R & 31)) : R;
        voffA[i] = (unsigned)(R * K + C) * 2u; voffB[i] = (unsigned)(Rb * K + C) * 2u; }
    const size_t kstep = (size_t)(BK * 2);
    const size_t hstep = (size_t)HALF * K * 2;
    const size_t tstep = 2 * hstep;
    const unsigned ldsw = (unsigned)wid * 1024u;
    const int aoff = lds_byte(wr * 64 + fr, fq * 8), boff = lds_byte(wc * 32 + fr, fq * 8);
#define PG8_SA(b, h) (((b) * 2 + (h)) * HTB)
#define PG8_SB(b, h) ((4 + (b) * 2 + (h)) * HTB)
#define PG8_STAGE(bufoff, gbase, voff) do { _Pragma("unroll") for (int _i = 0; _i < 2; ++_i) \
        __builtin_amdgcn_global_load_lds((const unsigned*)((const char*)(gbase) + (voff)[_i]), (PG8_LAS unsigned*)(lds + (bufoff) + ldsw + _i * 8192), 16, 0, 0); } while (0)
#define PG8_LDA(dst, b, h) do { _Pragma("unroll") for (int m = 0; m < 4; ++m) _Pragma("unroll") for (int k = 0; k < 2; ++k) dst[m][k] = *(const PG8_LAS bf16x8*)(lds + PG8_SA(b, h) + aoff + m * 2048 + k * 1024); } while (0)
#define PG8_LDB(dst, b, h) do { _Pragma("unroll") for (int n = 0; n < 2; ++n) _Pragma("unroll") for (int k = 0; k < 2; ++k) dst[n][k] = *(const PG8_LAS bf16x8*)(lds + PG8_SB(b, h) + boff + n * 2048 + k * 1024); } while (0)
#define PG8_MMA(ai, bj, At, Bt) do { __builtin_amdgcn_s_setprio(1); _Pragma("unroll") for (int m = 0; m < 4; ++m) _Pragma("unroll") for (int n = 0; n < 2; ++n) _Pragma("unroll") for (int k = 0; k < 2; ++k) \
        acc[ai][bj][m][n] = __builtin_amdgcn_mfma_f32_16x16x32_bf16(Bt[n][k], At[m][k], acc[ai][bj][m][n], 0, 0, 0); __builtin_amdgcn_s_setprio(0); } while (0)
#define PG8_WAIT_V(n) asm volatile("s_waitcnt vmcnt(" #n ")" ::: "memory")
#define PG8_WAIT_L(n) asm volatile("s_waitcnt lgkmcnt(" #n ")" ::: "memory")
#define PG8_BAR __builtin_amdgcn_s_barrier()
#define PG8_SCHED __builtin_amdgcn_sched_barrier(0)
    Unit cur, nxt; int ui = 0;
    if (!S.next(0, cur)) return;
    f32x4 acc[2][2][4][2];
#pragma unroll
    for (int a = 0; a < 2; ++a)
#pragma unroll
        for (int b = 0; b < 2; ++b)
#pragma unroll
            for (int m = 0; m < 4; ++m)
#pragma unroll
                for (int n = 0; n < 2; ++n) acc[a][b][m][n] = (f32x4){0.f, 0.f, 0.f, 0.f};
    bf16x8 At[4][2], B0[2][2], B1[2][2];
    const char* cA = (const char*)g.A + (size_t)cur.pm * tstep; const char* cB = (const char*)g.Bt + (size_t)cur.pn * tstep;
    S.a_ready(cur);
    PG8_STAGE(PG8_SB(0, 0), cB, voffB); PG8_STAGE(PG8_SA(0, 0), cA, voffA); PG8_STAGE(PG8_SB(0, 1), cB + hstep, voffB); PG8_STAGE(PG8_SA(0, 1), cA + hstep, voffA);
    if (wr == 1) PG8_BAR;
    PG8_WAIT_V(4); PG8_BAR;
    PG8_STAGE(PG8_SB(1, 0), cB + kstep, voffB); PG8_STAGE(PG8_SA(1, 0), cA + kstep, voffA); PG8_STAGE(PG8_SB(1, 1), cB + hstep + kstep, voffB);
    PG8_WAIT_V(6); PG8_BAR;
    PG8_STAMP();
    for (;;) {
        const bool has_next = S.next(ui + 1, nxt);
        const char* nA = has_next ? (const char*)g.A + (size_t)nxt.pm * tstep : cA; const char* nB = has_next ? (const char*)g.Bt + (size_t)nxt.pn * tstep : cB;
        for (int t = 0; t < nt; t += 2) {
            const bool last = (t == nt - 2);
            const char* a1 = cA + (size_t)(t + 1) * kstep;
            const char* a2 = last ? nA : cA + (size_t)(t + 2) * kstep; const char* b2 = last ? nB : cB + (size_t)(t + 2) * kstep;
            const char* a3 = a2 + kstep; const char* b3 = b2 + kstep;
            if (last && has_next) S.a_ready(nxt);
            PG8_LDB(B0, 0, 0); PG8_SCHED; PG8_LDA(At, 0, 0); PG8_STAGE(PG8_SA(1, 1), a1 + hstep, voffA);
            PG8_WAIT_L(8); PG8_BAR; PG8_WAIT_L(0); PG8_MMA(0, 0, At, B0); PG8_BAR; PG8_SCHED;
            PG8_LDB(B1, 0, 1); PG8_STAGE(PG8_SB(0, 0), b2, voffB);
            PG8_BAR; PG8_WAIT_L(0); PG8_MMA(0, 1, At, B1); PG8_BAR;
            PG8_LDA(At, 0, 1); PG8_STAGE(PG8_SA(0, 0), a2, voffA);
            PG8_BAR; PG8_WAIT_L(0); PG8_MMA(1, 0, At, B0); PG8_BAR; PG8_SCHED;
            PG8_STAGE(PG8_SB(0, 1), b2 + hstep, voffB);
            PG8_WAIT_V(6); PG8_BAR; PG8_MMA(1, 1, At, B1); PG8_BAR;
            PG8_LDB(B0, 1, 0); PG8_SCHED; PG8_LDA(At, 1, 0); PG8_STAGE(PG8_SA(0, 1), a2 + hstep, voffA);
            PG8_WAIT_L(8); PG8_BAR; PG8_WAIT_L(0); PG8_MMA(0, 0, At, B0); PG8_BAR; PG8_SCHED;
            PG8_LDB(B1, 1, 1); PG8_STAGE(PG8_SB(1, 0), b3, voffB);
            PG8_BAR; PG8_WAIT_L(0); PG8_MMA(0, 1, At, B1); PG8_BAR;
            PG8_LDA(At, 1, 1); PG8_STAGE(PG8_SA(1, 0), a3, voffA);
            PG8_BAR; PG8_WAIT_L(0); PG8_MMA(1, 0, At, B0); PG8_BAR; PG8_SCHED;
            PG8_STAGE(PG8_SB(1, 1), b3 + hstep, voffB);
            PG8_WAIT_V(6); PG8_BAR; PG8_MMA(1, 1, At, B1); PG8_BAR;
        }
        PG8_STAMP();
        if constexpr (!Epi::AFTER_DRAIN) { E(acc, cur, wr, wc, fr, fq); S.done(cur); }
        PG8_STAMP();
        if (!has_next) break;
#pragma unroll
        for (int a = 0; a < 2; ++a)
#pragma unroll
            for (int b = 0; b < 2; ++b)
#pragma unroll
                for (int m = 0; m < 4; ++m)
#pragma unroll
                    for (int n = 0; n < 2; ++n) acc[a][b][m][n] = (f32x4){0.f, 0.f, 0.f, 0.f};
        cur = nxt; cA = nA; cB = nB; ++ui;
    }
    PG8_WAIT_V(0);
    if (wr == 0) PG8_BAR;
    PG8_BAR;
    if constexpr (Epi::AFTER_DRAIN) { E.fused(acc, cur, wr, wc, fr, fq, lds, wid, lane); S.done(cur); }
    PG8_STAMP();
    if (STAMP && wid == 0) { stamps[lane] = lane < nts ? (((unsigned long long)(unsigned)ts_hi << 32) | (unsigned)ts_lo) : 0ull;
        if (lane == 62) stamps[62] = rt_entry; if (lane == 63) stamps[63] = (unsigned long long)wall_clock64(); }
#undef PG8_STAMP
#undef PG8_SA
#undef PG8_SB
#undef PG8_STAGE
#undef PG8_LDA
#undef PG8_LDB
#undef PG8_MMA
#undef PG8_WAIT_V
#undef PG8_WAIT_L
#undef PG8_BAR
#undef PG8_SCHED
}
}

#define LAS __attribute__((address_space(3)))
#define XB_TMO      128
#define XB_XCNT(j)  (256  + 64 * (j))
#define XB_XSUB(j)  (1280 + 64 * (j))
#define XB_XGEN(j)  (2304 + 64 * (j))
#define XB_TOP      3328
#define XB_TOPGEN   3392
#define XCD_BAR_WORDS 3456
#define XB_SPIN_CAP (1u << 24)

__device__ __forceinline__ unsigned xb_ld(unsigned* p)              { return __hip_atomic_load(p, __ATOMIC_RELAXED, __HIP_MEMORY_SCOPE_AGENT); }
__device__ __forceinline__ unsigned xb_add(unsigned* p, unsigned v) { return __hip_atomic_fetch_add(p, v, __ATOMIC_RELAXED, __HIP_MEMORY_SCOPE_AGENT); }
__device__ __forceinline__ unsigned xb_xcc_id() { return (unsigned)__builtin_amdgcn_s_getreg((3 << 11) | 20) & 0xFu; }
#define XB_SPIN(cond, bar) do { unsigned _sp = 0; while (cond) { __builtin_amdgcn_s_sleep(1); \
    if ((++_sp & 255u) == 0u) { if (xb_ld(&(bar)[XB_TMO])) break; if (_sp > XB_SPIN_CAP) { atomicAdd(&(bar)[XB_TMO], 1u); break; } } } } while (0)

struct XcdBarrier { unsigned* bar; unsigned x; volatile LAS unsigned* st; };

__device__ __forceinline__ XcdBarrier xcd_barrier_post(unsigned* bar, volatile LAS unsigned* st) {
    XcdBarrier b; b.bar = bar; b.x = xb_xcc_id(); b.st = st;
    if (threadIdx.x == 0) (void)xb_add(&bar[XB_XCNT(b.x)], 1u);
    return b;
}
__device__ __forceinline__ void xcd_barrier_complete(unsigned* bar, unsigned x, unsigned& nloc, unsigned& nx) {
    const unsigned G = gridDim.x * gridDim.y * gridDim.z;
    unsigned sum, cnt, mine, sp = 0u;
    for (;;) {
        sum = 0u; cnt = 0u; mine = 0u;
#pragma unroll
        for (unsigned j = 0; j < 16; ++j) { const unsigned c = xb_ld(&bar[XB_XCNT(j)]); sum += c; cnt += (c > 0u) ? 1u : 0u; mine = (j == x) ? c : mine; }
        if (sum == G) break;
        __builtin_amdgcn_s_sleep(1);
        if ((++sp & 255u) == 0u) { if (xb_ld(&bar[XB_TMO])) break; if (sp > XB_SPIN_CAP) { atomicAdd(&bar[XB_TMO], 1u); break; } }
    }
    nloc = mine > 0u ? mine : 1u; nx = cnt > 0u ? cnt : 1u;
}
__device__ __forceinline__ void xcd_barrier(const XcdBarrier& b) {
    asm volatile("s_waitcnt vmcnt(0)" ::: "memory");
    __syncthreads();
    if (threadIdx.x == 0) {
        unsigned* bar = b.bar;
        __builtin_amdgcn_s_waitcnt(0);
        unsigned nloc = b.st[0], nx = b.st[1];
        if (nloc == 0u) { xcd_barrier_complete(bar, b.x, nloc, nx); b.st[0] = nloc; b.st[1] = nx; }
        const unsigned old = xb_add(&bar[XB_XSUB(b.x)], 1u);
        const unsigned gen = old / nloc;
        if (old + 1u == (gen + 1u) * nloc) {
            __builtin_amdgcn_fence(__ATOMIC_RELEASE, "agent");
            asm volatile("s_waitcnt vmcnt(0)" ::: "memory");
            const unsigned og = xb_add(&bar[XB_TOP], 1u);
            const unsigned tg = og / nx;
            if (og + 1u == (tg + 1u) * nx) xb_add(&bar[XB_TOPGEN], 1u);
            else XB_SPIN(xb_ld(&bar[XB_TOPGEN]) == tg, bar);
            __builtin_amdgcn_fence(__ATOMIC_ACQUIRE, "agent");
            xb_add(&bar[XB_XGEN(b.x)], 1u);
            asm volatile("s_waitcnt vmcnt(0)" ::: "memory");
        } else {
            XB_SPIN(xb_ld(&bar[XB_XGEN(b.x)]) == gen, bar);
            __builtin_amdgcn_fence(__ATOMIC_ACQUIRE, "agent");
            asm volatile("s_waitcnt vmcnt(0)" ::: "memory");
        }
    }
    __syncthreads();
}

typedef unsigned short bf16;
typedef float f32x4 __attribute__((ext_vector_type(4)));
typedef float f32x16 __attribute__((ext_vector_type(16)));
typedef float f32x2 __attribute__((ext_vector_type(2)));
typedef unsigned u32x4 __attribute__((ext_vector_type(4)));
typedef unsigned u32x2 __attribute__((ext_vector_type(2)));
typedef short bf16x8 __attribute__((ext_vector_type(8)));
typedef __bf16 bf2_t __attribute__((ext_vector_type(2)));

constexpr int NTHREADS = 512, NWAVES = 8;
constexpr int LDS_BYTES = 160 * 1024;
constexpr int MISC_OFF = LDS_BYTES - 256;
constexpr int TOK = 32768, SEQ = 16384, DM = 2048;
constexpr int EV_N = 4800, EV_NP = 4864, OD_N = 4176, OD_NP = 4352;
constexpr float ALPHA = 1.41421356237f;
constexpr size_t MiB = 1u << 20;
constexpr size_t WS_CTL = 0, CTL_ZERO_BYTES = 1 * MiB;
constexpr int CW_BAR = 4096, CW_XRANK = 8192;
constexpr size_t WS_MOD = 1 * MiB, WS_SKB = 2 * MiB, WS_WL = 4 * MiB, WS_BS = 7 * MiB, WS_CNT = 9 * MiB;
constexpr size_t WS_WINE = 10 * MiB, WS_WOUTE = 29 * MiB, WS_WINO = 37 * MiB, WS_WOUTO = 54 * MiB, WS_WQ0 = 62 * MiB, WS_WQ1 = 70 * MiB;
constexpr size_t WS_HY = 78 * MiB, WS_Z = 206 * MiB, WS_LA = 510 * MiB, WS_BIG = 542 * MiB, WS_END = 926 * MiB;

__device__ __forceinline__ float bf2f(unsigned short b) { return __uint_as_float(((unsigned)b) << 16); }
__device__ __forceinline__ unsigned f2bf(float f) { unsigned u = __float_as_uint(f); return (u + 0x7fffu + ((u >> 16) & 1u)) >> 16; }
__device__ __forceinline__ unsigned pk2(float lo, float hi) { return f2bf(lo) | (f2bf(hi) << 16); }
__device__ __forceinline__ float lo2f(unsigned w) { return __uint_as_float(w << 16); }
__device__ __forceinline__ float hi2f(unsigned w) { return __uint_as_float(w & 0xffff0000u); }
__device__ __forceinline__ float wsum(float v) {
#pragma unroll
    for (int o = 32; o >= 1; o >>= 1) v += __shfl_xor(v, o);
    return v;
}
__device__ __forceinline__ float wmax(float v) {
#pragma unroll
    for (int o = 32; o >= 1; o >>= 1) v = fmaxf(v, __shfl_xor(v, o));
    return v;
}
__device__ __forceinline__ float rdlane(float v, int l) { return __int_as_float(__builtin_amdgcn_readlane(__float_as_int(v), l)); }
__device__ __forceinline__ unsigned rdlaneu(unsigned v, int l) { return (unsigned)__builtin_amdgcn_readlane((int)v, l); }
__device__ __forceinline__ float dot2bf(unsigned a, unsigned b, float c) {
    return __builtin_amdgcn_fdot2_f32_bf16(__builtin_bit_cast(bf2_t, a), __builtin_bit_cast(bf2_t, b), c, false);
}
template <int CTRL, int RM> __device__ __forceinline__ float dppf(float v) {
    return __int_as_float(__builtin_amdgcn_update_dpp(0, __float_as_int(v), CTRL, RM, 0xF, false));
}
__device__ __forceinline__ float wsum_dpp(float v) {
    v += dppf<0xB1, 0xF>(v);
    v += dppf<0x4E, 0xF>(v);
    v += dppf<0x141, 0xF>(v);
    v += dppf<0x140, 0xF>(v);
    v += dppf<0x142, 0xA>(v);
    v += dppf<0x143, 0xC>(v);
    return rdlane(v, 63);
}
__device__ __forceinline__ float sum16_dpp(float v) {
    v += dppf<0xB1, 0xF>(v); v += dppf<0x4E, 0xF>(v); v += dppf<0x141, 0xF>(v); v += dppf<0x140, 0xF>(v);
    return v;
}
__device__ __forceinline__ float sigmoidf_(float x) { return 1.0f / (1.0f + expf(-x)); }
__device__ __forceinline__ unsigned ordkey(float f) { const unsigned u = __float_as_uint(f); return (u & 0x80000000u) ? ~u : (u | 0x80000000u); }
__device__ __forceinline__ unsigned fixkey20(float f) { const float c = fminf(fmaxf(f, -15.999f), 15.999f); return (unsigned)((int)rintf(c * 32768.0f) + (1 << 19)); }
__device__ __forceinline__ float unordkey(unsigned k) { return __uint_as_float((k & 0x80000000u) ? (k & 0x7fffffffu) : ~k); }

struct Args { const void* in[27]; float* out; unsigned char* ws; int ph_lo, ph_hi; };
struct Frame { LAS unsigned char* lds; int tid, lane, wave, bx, G, gw, ngw; };

struct EpiLora {
    static constexpr bool PERM = true, AFTER_DRAIN = false;
    pg8::bf16_t* O; int ldc; const float* w0; const float* a0;
    __device__ __forceinline__ void operator()(const pg8::f32x4 (&acc)[2][2][4][2], const pg8::Unit& u, int wr, int wc, int fr, int fq) const {
        const int row0 = u.pm * 256 + wr * 64 + fr; const int colt = u.pn * 256; const int type = u.pn >> 2;
        const int col0 = colt + wc * 32 + 8 * fq, ncol0 = col0 & 1023;
        const float* pv = (type == 0) ? w0 : a0;
        pg8::f32x4 bv[2][2];
#pragma unroll
        for (int bj = 0; bj < 2; ++bj)
#pragma unroll
            for (int n = 0; n < 2; ++n) bv[bj][n] = (type < 2) ? *(const pg8::f32x4*)(pv + ncol0 + bj * 128 + 4 * n) : (pg8::f32x4){0.f, 0.f, 0.f, 0.f};
#pragma unroll
        for (int ai = 0; ai < 2; ++ai)
#pragma unroll
            for (int m = 0; m < 4; ++m) { pg8::bf16_t* rowp = O + (size_t)(row0 + ai * 128 + m * 16) * ldc + col0;
#pragma unroll
                for (int bj = 0; bj < 2; ++bj) { pg8::f32x4 v0 = acc[ai][bj][m][0] + bv[bj][0], v1 = acc[ai][bj][m][1] + bv[bj][1];
                    if (type < 2) {
                        const float sc = (type == 0) ? 0.60653066f : 1.0f;
#pragma unroll
                        for (int j = 0; j < 4; ++j) { v0[j] = sc / (1.0f + __expf(-v0[j])); v1[j] = sc / (1.0f + __expf(-v1[j])); }
                    }
                    pg8::u32x4 w; w.x = pg8::cvt_pk_bf16(v0[0], v0[1]); w.y = pg8::cvt_pk_bf16(v0[2], v0[3]); w.z = pg8::cvt_pk_bf16(v1[0], v1[1]); w.w = pg8::cvt_pk_bf16(v1[2], v1[3]);
                    *(pg8::u32x4*)(rowp + bj * 128) = w; } }
    }
};

__device__ __forceinline__ void transpose_item(const float* W, int K, int N, int Npad, bf16* WT, LAS float* scr, int item, int lane) {
    const int nblk = Npad / 32, kb = item / nblk, nb = item % nblk, k0 = 64 * kb, n0 = 32 * nb;
    const int nl = lane & 31; const bool ok = (n0 + nl) < N;
#pragma unroll 8
    for (int i = 0; i < 32; ++i) { const int kk = 2 * i + (lane >> 5); scr[kk * 33 + nl] = ok ? W[(size_t)(k0 + kk) * N + n0 + nl] : 0.f; }
    asm volatile("s_waitcnt lgkmcnt(0)" ::: "memory");
    const int c = lane & 7;
#pragma unroll
    for (int j = 0; j < 4; ++j) { const int n = (lane >> 3) + 8 * j; const LAS float* s = scr + (8 * c) * 33 + n;
        u32x4 o; o.x = pk2(s[0 * 33], s[1 * 33]); o.y = pk2(s[2 * 33], s[3 * 33]); o.z = pk2(s[4 * 33], s[5 * 33]); o.w = pk2(s[6 * 33], s[7 * 33]);
        *(u32x4*)(WT + (size_t)(n0 + n) * K + k0 + 8 * c) = o; }
    asm volatile("s_waitcnt lgkmcnt(0)" ::: "memory");
}

__device__ __forceinline__ void ph_prologue(const Args& A, Frame& F) {
    unsigned char* ws = A.ws;
    {
        const float* c = (const float*)A.in[1]; const float* mw = (const float*)A.in[19]; const float* mb = (const float*)A.in[20];
        float* MOD = (float*)(ws + WS_MOD);
        LAS float* red = (LAS float*)F.lds;
        for (int it = F.bx; it < 96; it += F.G) {
            const int s = it / 24, cc = it % 24, col = cc * 256 + F.lane * 4;
            const float* W = mw + (size_t)s * 2048 * 6144 + col;
            f32x4 a0 = {0.f, 0.f, 0.f, 0.f}, a1 = {0.f, 0.f, 0.f, 0.f};
            const int k0 = F.wave * 256;
#pragma unroll 8
            for (int k = k0; k < k0 + 256; ++k) {
                float c0 = c[k], c1 = c[2048 + k];
                c0 = c0 / (1.0f + expf(-c0)); c1 = c1 / (1.0f + expf(-c1));
                const f32x4 w = *(const f32x4*)(W + (size_t)k * 6144);
                a0 += c0 * w; a1 += c1 * w;
            }
            *(LAS f32x4*)(red + ((F.wave * 2 + 0) * 256 + F.lane * 4)) = a0;
            *(LAS f32x4*)(red + ((F.wave * 2 + 1) * 256 + F.lane * 4)) = a1;
            __syncthreads();
            { const int b = F.tid >> 8, cl = F.tid & 255; float sm = 0.f;
#pragma unroll
              for (int w = 0; w < 8; ++w) sm += red[(w * 2 + b) * 256 + cl];
              MOD[(size_t)(s * 2 + b) * 6144 + cc * 256 + cl] = sm + mb[s * 6144 + cc * 256 + cl]; }
            __syncthreads();
        }
    }
    {
        LAS float* scr = (LAS float*)(F.lds + 16384 + F.wave * 8704);
        constexpr int I0 = 32 * (EV_NP / 32), I1 = 32 * 64, I2 = 32 * (OD_NP / 32);
        constexpr int NIT = I0 + I1 + I2 + 3 * I1;
        for (int it = F.gw; it < NIT; it += F.ngw) {
            int r = it;
            if (r < I0) { transpose_item((const float*)A.in[3], 2048, EV_N, EV_NP, (bf16*)(ws + WS_WINE), scr, r, F.lane); continue; } r -= I0;
            if (r < I1) { transpose_item((const float*)A.in[4], 2048, 2048, 2048, (bf16*)(ws + WS_WOUTE), scr, r, F.lane); continue; } r -= I1;
            if (r < I2) { transpose_item((const float*)A.in[17], 2048, OD_N, OD_NP, (bf16*)(ws + WS_WINO), scr, r, F.lane); continue; } r -= I2;
            if (r < I1) { transpose_item((const float*)A.in[18], 2048, 2048, 2048, (bf16*)(ws + WS_WOUTO), scr, r, F.lane); continue; } r -= I1;
            if (r < I1) { transpose_item((const float*)A.in[23], 2048, 2048, 2048, (bf16*)(ws + WS_WQ0), scr, r, F.lane); continue; } r -= I1;
            transpose_item((const float*)A.in[23] + (size_t)2048 * 2048, 2048, 2048, 2048, (bf16*)(ws + WS_WQ1), scr, r, F.lane);
        }
    }
    {
        const float* w2 = (const float*)A.in[8]; const float* a2 = (const float*)A.in[10]; const float* g2 = (const float*)A.in[11];
        bf16* WL = (bf16*)(ws + WS_WL);
        const int gt = F.bx * NTHREADS + F.tid, ngt = F.G * NTHREADS;
        for (int i = gt; i < 3072 * 512; i += ngt) {
            const int n = i >> 9, k = i & 511; float v = 0.f;
            if (n < 1024) { if (k < 96) v = w2[k * 1024 + n]; }
            else if (n < 2048) { if (k >= 96 && k < 192) v = a2[(k - 96) * 1024 + (n - 1024)]; }
            else { if (k >= 192 && k < 448) v = g2[(k - 192) * 1024 + (n - 2048)]; }
            WL[i] = (bf16)f2bf(v);
        }
        const float* sk = (const float*)A.in[24]; bf16* SKB = (bf16*)(ws + WS_SKB);
        for (int i = gt; i < 2 * 262144; i += ngt) SKB[i] = (bf16)f2bf(sk[i]);
    }
}

__device__ __forceinline__ void ph_mod_x(const Args& A, Frame& F) {
    const float* x = (const float*)A.in[0]; const float* MOD = (const float*)(A.ws + WS_MOD); bf16* H = (bf16*)(A.ws + WS_HY);
    for (int t = F.gw; t < TOK; t += F.ngw) {
        const int b = t >> 14; const float* sh = MOD + (size_t)(0 * 2 + b) * 6144; const float* sc = sh + 2048;
#pragma unroll
        for (int j = 0; j < 8; ++j) { const int idx = j * 256 + F.lane * 4;
            const f32x4 xv = *(const f32x4*)(x + (size_t)t * DM + idx), sv = *(const f32x4*)(sc + idx), hv = *(const f32x4*)(sh + idx);
            const f32x4 o = xv * (1.0f + sv) + hv; u32x2 w; w.x = pk2(o[0], o[1]); w.y = pk2(o[2], o[3]);
            *(u32x2*)(H + (size_t)t * DM + idx) = w; }
    }
}

__device__ __forceinline__ void ph_even_post(const Args& A, Frame& F) {
    bf16* Z = (bf16*)(A.ws + WS_Z); const int* positions = (const int*)A.in[2]; const float* mu = (const float*)A.in[6];
    bf16* RKV = (bf16*)A.out; bf16* LAp = (bf16*)(A.ws + WS_LA);
    const int i = F.lane & 31; const float inv = powf(10000.0f, -(float)i / 32.0f);
    const int i4 = F.lane & 7, hs = F.lane >> 3;
    for (int t = F.gw; t < TOK; t += F.ngw) {
        const int s = t & (SEQ - 1); bf16* zr = Z + (size_t)t * EV_NP;
        float sn, cs; sincosf((float)positions[t] * inv, &sn, &cs);
        float c4[4], s4[4];
#pragma unroll
        for (int e = 0; e < 4; ++e) { c4[e] = __shfl(cs, 4 * i4 + e); s4[e] = __shfl(sn, 4 * i4 + e); }
#pragma unroll
        for (int it = 0; it < 3; ++it) { const int hd = it * 8 + hs; if (hd < 18) { bf16* hp = zr + hd * 64 + 4 * i4;
            const u32x2 a = *(const u32x2*)hp, b = *(const u32x2*)(hp + 32);
            const float t1[4] = {lo2f(a.x), hi2f(a.x), lo2f(a.y), hi2f(a.y)}, t2[4] = {lo2f(b.x), hi2f(b.x), lo2f(b.y), hi2f(b.y)};
            float o1[4], o2[4];
#pragma unroll
            for (int e = 0; e < 4; ++e) { o1[e] = t1[e] * c4[e] - t2[e] * s4[e]; o2[e] = t2[e] * c4[e] + t1[e] * s4[e]; }
            *(u32x2*)hp = (u32x2){pk2(o1[0], o1[1]), pk2(o1[2], o1[3])}; *(u32x2*)(hp + 32) = (u32x2){pk2(o2[0], o2[1]), pk2(o2[2], o2[3])}; } }
        const bf16* zp = zr - EV_NP; const bool hasprev = s > 0;
#pragma unroll
        for (int m = 0; m < 7; ++m) { const int j = 8 * (F.lane + 64 * m); if (j < 3520) {
            const u32x4 cw = *(const u32x4*)(zr + 1280 + j); u32x4 pw = {0u, 0u, 0u, 0u}; if (hasprev) pw = *(const u32x4*)(zp + 1280 + j);
            const f32x4 m0 = *(const f32x4*)(mu + j), m1 = *(const f32x4*)(mu + j + 4);
            const unsigned cwa[4] = {cw.x, cw.y, cw.z, cw.w}, pwa[4] = {pw.x, pw.y, pw.z, pw.w}; const float mm[8] = {m0[0], m0[1], m0[2], m0[3], m1[0], m1[1], m1[2], m1[3]};
            float v[8];
#pragma unroll
            for (int q = 0; q < 4; ++q) { const float c0 = lo2f(cwa[q]), c1 = hi2f(cwa[q]), p0 = lo2f(pwa[q]), p1 = hi2f(pwa[q]); v[2 * q] = c0 + (p0 - c0) * mm[2 * q]; v[2 * q + 1] = c1 + (p1 - c1) * mm[2 * q + 1]; }
            bf16* dst;
            if (j < 3072) { dst = RKV + (size_t)(j >> 10) * TOK * 1024 + (size_t)t * 1024 + (j & 1023); }
            else if (j < 3168) { dst = LAp + (size_t)t * 512 + (j - 3072);
#pragma unroll
                for (int e = 0; e < 8; ++e) v[e] = tanhf(v[e]); }
            else if (j < 3264) { dst = LAp + (size_t)t * 512 + 96 + (j - 3168); }
            else { dst = LAp + (size_t)t * 512 + 192 + (j - 3264);
#pragma unroll
                for (int e = 0; e < 8; ++e) v[e] = sigmoidf_(v[e]); }
            *(u32x4*)dst = (u32x4){pk2(v[0], v[1]), pk2(v[2], v[3]), pk2(v[4], v[5]), pk2(v[6], v[7])};
        } }
        if (F.lane < 8) *(u32x4*)(LAp + (size_t)t * 512 + 448 + 8 * F.lane) = (u32x4){0u, 0u, 0u, 0u};
    }
}

__device__ __forceinline__ void ph_scan_pack(const Args& A, Frame& F) {
    const bf16* Z = (const bf16*)(A.ws + WS_Z); const bf16* RKV = (const bf16*)A.out;
    const float* k_k = (const float*)A.in[12]; const float* k_a = (const float*)A.in[13]; const float* r_k = (const float*)A.in[14];
    unsigned* PK = (unsigned*)(A.ws + WS_BIG); float* BS = (float*)(A.ws + WS_BS);
    const int g16 = F.lane >> 4, c16 = F.lane & 15;
    for (int it = F.gw; it < TOK * 4; it += F.ngw) {
        const int item = it * 4 + g16; const int t = item >> 4, h = item & 15, c = h * 64 + 4 * c16, b = t >> 14, s = t & (SEQ - 1);
        const u32x2 rw = *(const u32x2*)(RKV + (size_t)t * 1024 + c), kw = *(const u32x2*)(RKV + (size_t)TOK * 1024 + (size_t)t * 1024 + c), vw = *(const u32x2*)(RKV + (size_t)2 * TOK * 1024 + (size_t)t * 1024 + c);
        const u32x2 ew = *(const u32x2*)(Z + (size_t)t * EV_NP + 1280 + c), aw = *(const u32x2*)(Z + (size_t)t * EV_NP + 1280 + 1024 + c);
        const f32x4 kk4 = *(const f32x4*)(k_k + c), ka4 = *(const f32x4*)(k_a + c), rk4 = *(const f32x4*)(r_k + c);
        const float r[4] = {lo2f(rw.x), hi2f(rw.x), lo2f(rw.y), hi2f(rw.y)}, kr[4] = {lo2f(kw.x), hi2f(kw.x), lo2f(kw.y), hi2f(kw.y)}, v[4] = {lo2f(vw.x), hi2f(vw.x), lo2f(vw.y), hi2f(vw.y)};
        const float e[4] = {lo2f(ew.x), hi2f(ew.x), lo2f(ew.y), hi2f(ew.y)}, a[4] = {lo2f(aw.x), hi2f(aw.x), lo2f(aw.y), hi2f(aw.y)};
        float kkv[4], kp[4]; float ss = 0.f, bsum = 0.f;
#pragma unroll
        for (int q = 0; q < 4; ++q) { kkv[q] = kr[q] * kk4[q]; ss += kkv[q] * kkv[q]; kp[q] = kr[q] * (1.0f + (a[q] - 1.0f) * ka4[q]); bsum += r[q] * kp[q] * rk4[q]; }
        ss = sum16_dpp(ss); bsum = sum16_dpp(bsum);
        const float rn = 1.0f / fmaxf(sqrtf(ss), 1e-12f);
        if (c16 == 0) BS[(size_t)t * 16 + h] = bsum;
        unsigned w[12];
#pragma unroll
        for (int q = 0; q < 4; ++q) { const float kkn = kkv[q] * rn; w[3 * q] = pk2(r[q], e[q]); w[3 * q + 1] = pk2(kp[q], kkn); w[3 * q + 2] = pk2(kkn * a[q], v[q]); }
        u32x4* dst = (u32x4*)(PK + ((size_t)((b * 16 + h) * SEQ + s) * 64 + 4 * c16) * 3);
        dst[0] = (u32x4){w[0], w[1], w[2], w[3]}; dst[1] = (u32x4){w[4], w[5], w[6], w[7]}; dst[2] = (u32x4){w[8], w[9], w[10], w[11]};
    }
}

__device__ __forceinline__ void ph_swa(const Args& A, Frame& F) {
    const bf16* Z = (const bf16*)(A.ws + WS_Z); bf16* Y = (bf16*)(A.ws + WS_HY); const float* sinks = (const float*)A.in[5];
    LAS unsigned char* KL = F.lds; LAS unsigned char* VL = F.lds + 256 * 136;
    for (int u = F.bx; u < 512; u += F.G) {
        const int b = u >> 8, n = (u >> 1) & 127, kvh = u & 1;
        __syncthreads();
        for (int c = F.tid; c < 2048; c += NTHREADS) { const int jw = c >> 3, cc = c & 7; const int s = n * 128 - 128 + jw;
            u32x4 kv = {0u, 0u, 0u, 0u}, vv = {0u, 0u, 0u, 0u};
            if (s >= 0) { const bf16* row = Z + (size_t)(b * SEQ + s) * EV_NP; kv = *(const u32x4*)(row + 1024 + kvh * 64 + cc * 8); vv = *(const u32x4*)(row + 1152 + kvh * 64 + cc * 8); }
            *(LAS u32x2*)(KL + jw * 136 + cc * 16) = (u32x2){kv.x, kv.y}; *(LAS u32x2*)(KL + jw * 136 + cc * 16 + 8) = (u32x2){kv.z, kv.w};
            *(LAS u32x2*)(VL + jw * 136 + cc * 16) = (u32x2){vv.x, vv.y}; *(LAS u32x2*)(VL + jw * 136 + cc * 16 + 8) = (u32x2){vv.z, vv.w}; }
        __syncthreads();
        for (int it = F.wave; it < 1024; it += NWAVES) {
            const int i = it >> 3, g = it & 7, head = kvh * 8 + g; const int t = b * SEQ + n * 128 + i;
            const float qv = bf2f(Z[(size_t)t * EV_NP + head * 64 + F.lane]) * 0.125f;
            const int jw0 = i + 1 + F.lane, jw1 = jw0 + 64;
            const bool val0 = (n > 0) || (jw0 >= 128), val1 = (n > 0) || (jw1 >= 128);
            float s0 = 0.f, s1 = 0.f;
#pragma unroll
            for (int d4 = 0; d4 < 16; ++d4) {
                const u32x2 k0 = *(const LAS u32x2*)(KL + jw0 * 136 + d4 * 8), k1 = *(const LAS u32x2*)(KL + jw1 * 136 + d4 * 8);
                const float q0 = rdlane(qv, 4 * d4), q1 = rdlane(qv, 4 * d4 + 1), q2 = rdlane(qv, 4 * d4 + 2), q3 = rdlane(qv, 4 * d4 + 3);
                s0 += q0 * lo2f(k0.x) + q1 * hi2f(k0.x) + q2 * lo2f(k0.y) + q3 * hi2f(k0.y);
                s1 += q0 * lo2f(k1.x) + q1 * hi2f(k1.x) + q2 * lo2f(k1.y) + q3 * hi2f(k1.y);
            }
            const float sink = sinks[head];
            s0 = val0 ? s0 : -INFINITY; s1 = val1 ? s1 : -INFINITY;
            const float mx = fmaxf(wmax(fmaxf(s0, s1)), sink);
            float p0 = val0 ? expf(s0 - mx) : 0.f, p1 = val1 ? expf(s1 - mx) : 0.f;
            const float den = wsum(p0 + p1) + expf(sink - mx); const float rden = 1.0f / den;
            p0 *= rden; p1 *= rden;
            float o = 0.f;
            const LAS bf16* vcol = (const LAS bf16*)VL + F.lane;
#pragma unroll 8
            for (int jj = 0; jj < 64; ++jj) o += rdlane(p0, jj) * bf2f(vcol[(i + 1 + jj) * 68]);
#pragma unroll 8
            for (int jj = 0; jj < 64; ++jj) o += rdlane(p1, jj) * bf2f(vcol[(i + 65 + jj) * 68]);
            Y[(size_t)t * DM + head * 64 + F.lane] = (bf16)f2bf(o);
        }
    }
}

__device__ __forceinline__ void pair_sync(volatile LAS unsigned* cnt, unsigned target) {
    asm volatile("s_waitcnt vmcnt(0) lgkmcnt(0)" ::: "memory");
    if ((threadIdx.x & 63) == 0) (void)__hip_atomic_fetch_add((LAS unsigned*)cnt, 1u, __ATOMIC_RELAXED, __HIP_MEMORY_SCOPE_WORKGROUP);
    while (__hip_atomic_load((LAS unsigned*)cnt, __ATOMIC_RELAXED, __HIP_MEMORY_SCOPE_WORKGROUP) < target) __builtin_amdgcn_s_sleep(1);
    asm volatile("" ::: "memory");
}
__device__ __forceinline__ void swa_pairs(const Args& A, Frame& F, volatile LAS unsigned* MISC) {
    const bf16* Z = (const bf16*)(A.ws + WS_Z); bf16* Y = (bf16*)(A.ws + WS_HY); const float* sinks = (const float*)A.in[5];
    const int pr = (F.wave - 4) >> 1, mem = F.wave & 1;
    LAS unsigned char* KL = F.lds + pr * 69632; LAS unsigned char* VL = KL + 256 * 136;
    volatile LAS unsigned* cnt = MISC + 24 + pr; unsigned gen = 0u;
    for (int u = F.bx * 2 + pr; u < 512; u += F.G * 2) {
        const int b = u >> 8, n = (u >> 1) & 127, kvh = u & 1;
        gen += 2u; pair_sync(cnt, gen);
#pragma unroll 1
        for (int c0 = mem * 1024 + F.lane; c0 < mem * 1024 + 1024; c0 += 64 * 8) {
            u32x4 kv[8], vv[8];
#pragma unroll
            for (int q = 0; q < 8; ++q) { const int c = c0 + 64 * q; const int jw = c >> 3, cc = c & 7; const int sp = n * 128 - 128 + jw;
                kv[q] = (u32x4){0u, 0u, 0u, 0u}; vv[q] = kv[q];
                if (sp >= 0) { const bf16* row = Z + (size_t)(b * SEQ + sp) * EV_NP; kv[q] = *(const u32x4*)(row + 1024 + kvh * 64 + cc * 8); vv[q] = *(const u32x4*)(row + 1152 + kvh * 64 + cc * 8); } }
#pragma unroll
            for (int q = 0; q < 8; ++q) { const int c = c0 + 64 * q; const int jw = c >> 3, cc = c & 7;
                *(LAS u32x2*)(KL + jw * 136 + cc * 16) = (u32x2){kv[q].x, kv[q].y}; *(LAS u32x2*)(KL + jw * 136 + cc * 16 + 8) = (u32x2){kv[q].z, kv[q].w};
                *(LAS u32x2*)(VL + jw * 136 + cc * 16) = (u32x2){vv[q].x, vv[q].y}; *(LAS u32x2*)(VL + jw * 136 + cc * 16 + 8) = (u32x2){vv[q].z, vv[q].w}; }
        }
        gen += 2u; pair_sync(cnt, gen);
        for (int it = mem; it < 1024; it += 2) {
            const int i = it >> 3, g = it & 7, head = kvh * 8 + g; const int t = b * SEQ + n * 128 + i;
            const float qv = bf2f(Z[(size_t)t * EV_NP + head * 64 + F.lane]) * 0.125f;
            const int jw0 = i + 1 + F.lane, jw1 = jw0 + 64;
            const bool val0 = (n > 0) || (jw0 >= 128), val1 = (n > 0) || (jw1 >= 128);
            float s0 = 0.f, s1 = 0.f;
#pragma unroll
            for (int d4 = 0; d4 < 16; ++d4) {
                const u32x2 k0 = *(const LAS u32x2*)(KL + jw0 * 136 + d4 * 8), k1 = *(const LAS u32x2*)(KL + jw1 * 136 + d4 * 8);
                const float q0 = rdlane(qv, 4 * d4), q1 = rdlane(qv, 4 * d4 + 1), q2 = rdlane(qv, 4 * d4 + 2), q3 = rdlane(qv, 4 * d4 + 3);
                s0 += q0 * lo2f(k0.x) + q1 * hi2f(k0.x) + q2 * lo2f(k0.y) + q3 * hi2f(k0.y);
                s1 += q0 * lo2f(k1.x) + q1 * hi2f(k1.x) + q2 * lo2f(k1.y) + q3 * hi2f(k1.y);
            }
            const float sink = sinks[head];
            s0 = val0 ? s0 : -INFINITY; s1 = val1 ? s1 : -INFINITY;
            const float mx = fmaxf(wmax(fmaxf(s0, s1)), sink);
            float p0 = val0 ? expf(s0 - mx) : 0.f, p1 = val1 ? expf(s1 - mx) : 0.f;
            const float den = wsum(p0 + p1) + expf(sink - mx); const float rden = 1.0f / den;
            p0 *= rden; p1 *= rden;
            float o = 0.f;
            const LAS bf16* vcol = (const LAS bf16*)VL + F.lane;
#pragma unroll 8
            for (int jj = 0; jj < 64; ++jj) o += rdlane(p0, jj) * bf2f(vcol[(i + 1 + jj) * 68]);
#pragma unroll 8
            for (int jj = 0; jj < 64; ++jj) o += rdlane(p1, jj) * bf2f(vcol[(i + 65 + jj) * 68]);
            Y[(size_t)t * DM + head * 64 + F.lane] = (bf16)f2bf(o);
        }
    }
}

__device__ __forceinline__ void wsum2_dpp(float a, float b, float& ra, float& rb) {
    const auto r = __builtin_amdgcn_permlane32_swap(__float_as_uint(a), __float_as_uint(b), false, false);
    float v = __uint_as_float(r[0]) + __uint_as_float(r[1]);
    v += dppf<0xB1, 0xF>(v); v += dppf<0x4E, 0xF>(v); v += dppf<0x141, 0xF>(v); v += dppf<0x140, 0xF>(v);
    v += dppf<0x142, 0xA>(v);
    ra = rdlane(v, 31); rb = rdlane(v, 63);
}
__device__ __forceinline__ void ph_scan(const Args& A, Frame& F, volatile LAS unsigned* MISC) {
    const unsigned* PK = (const unsigned*)(A.ws + WS_BIG); bf16* YRAW = (bf16*)A.out + (size_t)3 * TOK * 1024;
    if (F.wave >= 4) { swa_pairs(A, F, MISC); return; }
    for (int pp = F.bx * 4 + F.wave; pp < 1024; pp += F.G * 4) {
        const int rr = 2 * pp, bh = rr >> 6, vrow = rr & 63;
        const unsigned* pk = PK + ((size_t)bh * SEQ * 64 + F.lane) * 3;
        bf16* youtA = YRAW + ((size_t)bh * 64 + vrow) * SEQ; bf16* youtB = youtA + SEQ;
        f32x2 S2 = {0.f, 0.f};
        for (int t0 = 0; t0 < SEQ; t0 += 64) {
            float ykA = 0.f, ykB = 0.f;
#pragma unroll 8
            for (int j = 0; j < 64; ++j) {
                const unsigned* p = pk + (size_t)(t0 + j) * 192;
                const unsigned w0 = p[0], w1 = p[1], w2 = p[2];
                const float r = lo2f(w0), e = hi2f(w0), kp = lo2f(w1), kk = hi2f(w1), kka = lo2f(w2), vv = hi2f(w2);
                const f32x2 v2 = {rdlane(vv, vrow), rdlane(vv, vrow + 1)};
                const float dec = __expf(-e);
                const f32x2 pk2v = S2 * (f32x2){kk, kk};
                float saA, saB; wsum2_dpp(pk2v.x, pk2v.y, saA, saB); const f32x2 sa2 = {saA, saB};
                S2 = S2 * (f32x2){dec, dec} + (v2 * (f32x2){kp, kp} - sa2 * (f32x2){kka, kka});
                const f32x2 py = S2 * (f32x2){r, r};
                float yA, yB; wsum2_dpp(py.x, py.y, yA, yB);
                ykA = (F.lane == j) ? yA : ykA; ykB = (F.lane == j) ? yB : ykB;
            }
            youtA[t0 + F.lane] = (bf16)f2bf(ykA); youtB[t0 + F.lane] = (bf16)f2bf(ykB);
        }
    }
}

__device__ __forceinline__ void ph_rwkv_finish(const Args& A, Frame& F) {
    const bf16* Z = (const bf16*)(A.ws + WS_Z); const bf16* RKV = (const bf16*)A.out; const bf16* YRAW = (const bf16*)A.out + (size_t)3 * TOK * 1024;
    const float* BS = (const float*)(A.ws + WS_BS); bf16* Y = (bf16*)(A.ws + WS_HY);
    const float* lnx_g = (const float*)A.in[15]; const float* lnx_b = (const float*)A.in[16];
    LAS float* tile = (LAS float*)(F.lds + F.wave * 16640);
    for (int it = F.gw; it < 8192; it += F.ngw) {
        const int bh = it >> 8, tb = it & 255, b = bh >> 4, h = bh & 15, t0 = tb * 64;
        for (int vr = 0; vr < 64; ++vr) tile[vr * 65 + F.lane] = bf2f(YRAW[((size_t)bh * 64 + vr) * SEQ + t0 + F.lane]);
        asm volatile("s_waitcnt lgkmcnt(0)" ::: "memory");
        const int c = h * 64 + F.lane; const float lg = lnx_g[c], lb = lnx_b[c];
        for (int j = 0; j < 64; ++j) {
            const int t = b * SEQ + t0 + j;
            const float y = tile[F.lane * 65 + j];
            const float mean = wsum(y) * (1.0f / 64.0f); const float d = y - mean; const float var = wsum(d * d) * (1.0f / 64.0f);
            const float yn = d * rsqrtf(var + 64e-5f) * lg + lb;
            const float vv = bf2f(RKV[(size_t)2 * TOK * 1024 + (size_t)t * 1024 + c]); const float g = bf2f(Z[(size_t)t * EV_NP + 1280 + 2048 + c]); const float bs = BS[(size_t)t * 16 + h];
            Y[(size_t)t * DM + 1024 + c] = (bf16)f2bf((yn + bs * vv) * g);
        }
        asm volatile("s_waitcnt lgkmcnt(0)" ::: "memory");
    }
}

__device__ __forceinline__ void ph_ln_mixer(const Args& A, Frame& F, const int L) {
    const float* xsrc = (L == 0) ? (const float*)A.in[0] : (const float*)A.out; float* xdst = A.out;
    const bf16* O = (const bf16*)(A.ws + WS_Z); bf16* H = (bf16*)(A.ws + WS_HY); const float* MOD = (const float*)(A.ws + WS_MOD);
    const float* lng = (const float*)A.in[21] + (size_t)(L * 2 + 0) * DM; const float* lnb = (const float*)A.in[22] + (size_t)(L * 2 + 0) * DM;
    for (int t = F.gw; t < TOK; t += F.ngw) {
        const int b = t >> 14;
        const float* gate = MOD + (size_t)((L * 2 + 0) * 2 + b) * 6144 + 4096;
        const float* sh = MOD + (size_t)((L * 2 + 1) * 2 + b) * 6144; const float* sc = sh + 2048;
        float v[32]; float sum = 0.f;
#pragma unroll
        for (int j = 0; j < 4; ++j) { const int base = (j * 64 + F.lane) * 8;
            const u32x4 ow = *(const u32x4*)(O + (size_t)t * DM + base);
            const f32x4 x0 = *(const f32x4*)(xsrc + (size_t)t * DM + base), x1 = *(const f32x4*)(xsrc + (size_t)t * DM + base + 4);
            const f32x4 g0 = *(const f32x4*)(gate + base), g1 = *(const f32x4*)(gate + base + 4);
            const float of[8] = {lo2f(ow.x), hi2f(ow.x), lo2f(ow.y), hi2f(ow.y), lo2f(ow.z), hi2f(ow.z), lo2f(ow.w), hi2f(ow.w)};
#pragma unroll
            for (int e = 0; e < 4; ++e) { v[j * 8 + e] = ALPHA * x0[e] + (1.0f + g0[e]) * of[e]; v[j * 8 + 4 + e] = ALPHA * x1[e] + (1.0f + g1[e]) * of[4 + e]; }
#pragma unroll
            for (int e = 0; e < 8; ++e) sum += v[j * 8 + e]; }
        const float mean = wsum(sum) * (1.0f / DM); float sq = 0.f;
#pragma unroll
        for (int e = 0; e < 32; ++e) { v[e] -= mean; sq += v[e] * v[e]; }
        const float rstd = rsqrtf(wsum(sq) * (1.0f / DM) + 1e-5f);
#pragma unroll
        for (int j = 0; j < 4; ++j) { const int base = (j * 64 + F.lane) * 8;
            const f32x4 lg0 = *(const f32x4*)(lng + base), lg1 = *(const f32x4*)(lng + base + 4), lb0 = *(const f32x4*)(lnb + base), lb1 = *(const f32x4*)(lnb + base + 4);
            const f32x4 s0 = *(const f32x4*)(sc + base), s1 = *(const f32x4*)(sc + base + 4), h0 = *(const f32x4*)(sh + base), h1 = *(const f32x4*)(sh + base + 4);
            f32x4 o0, o1;
#pragma unroll
            for (int e = 0; e < 4; ++e) { o0[e] = v[j * 8 + e] * rstd * lg0[e] + lb0[e]; o1[e] = v[j * 8 + 4 + e] * rstd * lg1[e] + lb1[e]; }
            *(f32x4*)(xdst + (size_t)t * DM + base) = o0; *(f32x4*)(xdst + (size_t)t * DM + base + 4) = o1;
            const f32x4 q0 = o0 * (1.0f + s0) + h0, q1 = o1 * (1.0f + s1) + h1;
            u32x4 w; w.x = pk2(q0[0], q0[1]); w.y = pk2(q0[2], q0[3]); w.z = pk2(q1[0], q1[1]); w.w = pk2(q1[2], q1[3]);
            *(u32x4*)(H + (size_t)t * DM + base) = w; }
    }
    {
        const float* pu = (const float*)A.in[25] + (size_t)L * 16384 * 2048; const float* pv = (const float*)A.in[26] + (size_t)L * 16384 * 2048;
        unsigned char* T8 = A.ws + WS_BIG; float* SCL = (float*)(A.ws + WS_BIG + 64 * MiB);
        for (int r = F.gw; r < 32768; r += F.ngw) {
            const float* src = ((r < 16384) ? pu : pv) + (size_t)(r & 16383) * 2048;
            f32x4 f[2][4]; float amax = 0.f;
#pragma unroll
            for (int j = 0; j < 2; ++j)
#pragma unroll
                for (int c = 0; c < 4; ++c) { f[j][c] = *(const f32x4*)(src + (j * 64 + F.lane) * 16 + 4 * c);
                    amax = fmaxf(amax, fmaxf(fmaxf(fabsf(f[j][c][0]), fabsf(f[j][c][1])), fmaxf(fabsf(f[j][c][2]), fabsf(f[j][c][3])))); }
            amax = wmax(amax);
            int k = 0; if (amax > 0.f) { k = ilogbf(224.0f / amax); k = k < -100 ? -100 : (k > 100 ? 100 : k); }
            const float scl = ldexpf(1.0f, k);
#pragma unroll
            for (int j = 0; j < 2; ++j) { u32x4 w; unsigned ww[4];
#pragma unroll
                for (int c = 0; c < 4; ++c) { int q = __builtin_amdgcn_cvt_pk_fp8_f32(f[j][c][0] * scl, f[j][c][1] * scl, 0, false); q = __builtin_amdgcn_cvt_pk_fp8_f32(f[j][c][2] * scl, f[j][c][3] * scl, q, true); ww[c] = (unsigned)q; }
                w.x = ww[0]; w.y = ww[1]; w.z = ww[2]; w.w = ww[3];
                *(u32x4*)(T8 + (size_t)r * 2048 + (j * 64 + F.lane) * 16) = w; }
            if (F.lane == 0) SCL[r] = ldexpf(1.0f, -k);
        }
    }
}

template <int NV, int NBITS> __device__ __forceinline__ unsigned wave_tau16(const unsigned (&key)[NV]) {
    unsigned tau = 0u;
#pragma unroll 1
    for (int bit = NBITS - 1; bit >= 0; --bit) {
        const unsigned cand = tau | (1u << bit); int cnt = 0;
#pragma unroll
        for (int v = 0; v < NV; ++v) cnt += __popcll(__ballot(key[v] >= cand));
        if (cnt >= 16) tau = cand;
    }
    return tau;
}
template <int NV> __device__ __forceinline__ void wave_compact16(const unsigned (&key)[NV], const float (&val)[NV], const int (&id)[NV], unsigned tau, LAS float* ov, LAS int* oi, int lane) {
    int ngt = 0;
#pragma unroll
    for (int v = 0; v < NV; ++v) ngt += __popcll(__ballot(key[v] > tau));
    int bg = 0, be = 0;
#pragma unroll
    for (int v = 0; v < NV; ++v) {
        const bool gt = key[v] > tau, eq = key[v] == tau;
        const unsigned long long mg = __ballot(gt), me = __ballot(eq);
        const unsigned long long below = (lane == 0) ? 0ull : ((~0ull) >> (64 - lane));
        const int pg = bg + __popcll(mg & below), pe = ngt + be + __popcll(me & below);
        if (gt) { ov[pg] = val[v]; oi[pg] = id[v]; }
        if (eq && pe < 16) { ov[pe] = val[v]; oi[pe] = id[v]; }
        bg += __popcll(mg); be += __popcll(me);
    }
}

__device__ __forceinline__ void ph_peer_select(const Args& A, Frame& F, const int L) {
    const bf16* QP = (const bf16*)(A.ws + WS_Z); const bf16* SKB = (const bf16*)(A.ws + WS_SKB) + (size_t)L * 262144;
    int* EID = (int*)(A.ws + WS_LA); float* GSM = (float*)(A.ws + WS_LA + 16 * MiB);
    LAS unsigned char* SKL = F.lds;
    LAS float* SCO = (LAS float*)(F.lds + 69632 + 4096);
    LAS float* tv = (LAS float*)(F.lds + 69632 + F.wave * 512);
    LAS int* ti = (LAS int*)(F.lds + 69632 + F.wave * 512 + 128);
    LAS float* cv = (LAS float*)(F.lds + 69632 + F.wave * 512 + 256);
    LAS int* ci = (LAS int*)(F.lds + 69632 + F.wave * 512 + 320);
    for (int it = F.bx; it < 4096; it += F.G) {
        const int tile = it >> 3, h = it & 7;
        __syncthreads();
        for (int c = F.tid; c < 4096; c += NTHREADS) { const int p = c >> 11, n = (c >> 4) & 127, cc = c & 15;
            *(LAS u32x4*)(SKL + (p * 128 + n) * 272 + cc * 16) = *(const u32x4*)(SKB + ((size_t)((p * 8 + h) * 128 + n)) * 128 + cc * 8); }
        __syncthreads();
        {
            const int p = F.wave >> 2, mt = F.wave & 3, g = F.lane >> 4, l15 = F.lane & 15;
            const bf16* qrow = QP + (size_t)(tile * 64 + mt * 16 + l15) * DM + h * 256 + p * 128 + 8 * g;
            bf16x8 afr[4];
#pragma unroll
            for (int ks = 0; ks < 4; ++ks) afr[ks] = *(const bf16x8*)(qrow + 32 * ks);
#pragma unroll
            for (int nt = 0; nt < 8; ++nt) {
                f32x4 acc = {0.f, 0.f, 0.f, 0.f};
#pragma unroll
                for (int ks = 0; ks < 4; ++ks) { const bf16x8 bfr = *(const LAS bf16x8*)(SKL + (p * 128 + nt * 16 + l15) * 272 + (32 * ks + 8 * g) * 2);
                    acc = __builtin_amdgcn_mfma_f32_16x16x32_bf16(afr[ks], bfr, acc, 0, 0, 0); }
#pragma unroll
                for (int rg = 0; rg < 4; ++rg) SCO[(p * 64 + mt * 16 + 4 * g + rg) * 132 + nt * 16 + l15] = acc[rg];
            }
        }
        __syncthreads();
        for (int tk = 0; tk < 8; ++tk) {
            const int t = tile * 64 + F.wave * 8 + tk;
            float sval[2][2]; unsigned key[2][2];
#pragma unroll
            for (int p = 0; p < 2; ++p) { const LAS float* srow = SCO + (p * 64 + F.wave * 8 + tk) * 132;
                const float s0 = srow[F.lane], s1 = srow[64 + F.lane];
                sval[p][0] = s0; sval[p][1] = s1; key[p][0] = fixkey20(s0); key[p][1] = fixkey20(s1); }
            {
                unsigned tau0 = 0u, tau1 = 0u;
#pragma unroll 1
                for (int bit = 19; bit >= 0; --bit) {
                    const unsigned c0 = tau0 | (1u << bit), c1 = tau1 | (1u << bit);
                    const int n0 = __popcll(__ballot(key[0][0] >= c0)) + __popcll(__ballot(key[0][1] >= c0));
                    const int n1 = __popcll(__ballot(key[1][0] >= c1)) + __popcll(__ballot(key[1][1] >= c1));
                    if (n0 >= 16) tau0 = c0;
                    if (n1 >= 16) tau1 = c1;
                }
                const int id[2] = {F.lane, F.lane + 64};
                wave_compact16<2>(key[0], sval[0], id, tau0, tv, ti, F.lane);
                wave_compact16<2>(key[1], sval[1], id, tau1, tv + 16, ti + 16, F.lane);
            }
            asm volatile("s_waitcnt lgkmcnt(0)" ::: "memory"); __builtin_amdgcn_wave_barrier();
            unsigned ck[4]; int cid[4]; float cval[4];
#pragma unroll
            for (int m = 0; m < 4; ++m) { const int c = F.lane * 4 + m; cid[m] = c; cval[m] = tv[c >> 4] + tv[16 + (c & 15)]; ck[m] = fixkey20(cval[m] * 0.5f); }
            const unsigned tau2 = wave_tau16<4, 20>(ck);
            wave_compact16<4>(ck, cval, cid, tau2, cv, ci, F.lane);
            asm volatile("s_waitcnt lgkmcnt(0)" ::: "memory"); __builtin_amdgcn_wave_barrier();
            const float bv = (F.lane < 16) ? cv[F.lane] : -INFINITY; const int bc = (F.lane < 16) ? ci[F.lane] : 0;
            const float mx = wmax(bv); const float ev = (F.lane < 16) ? expf(bv - mx) : 0.f; const float den = wsum(ev);
            if (F.lane < 16) { const int e1 = ti[bc >> 4], e2 = ti[16 + (bc & 15)];
                EID[(size_t)t * 128 + h * 16 + F.lane] = e1 * 128 + e2; GSM[(size_t)t * 128 + h * 16 + F.lane] = ev / den; }
            asm volatile("s_waitcnt lgkmcnt(0)" ::: "memory"); __builtin_amdgcn_wave_barrier();
        }
    }
}

constexpr int PGB = 4;
__device__ __forceinline__ void ph_peer_gather(const Args& A, Frame& F, const int L, const bool dry = false) {
    bf16* H = (bf16*)(A.ws + WS_HY); bf16* Hout = dry ? (bf16*)(A.ws + WS_BIG + 128 * MiB) : H; float* Xout = dry ? (float*)(A.ws + WS_Z) : A.out; const unsigned char* TU = A.ws + WS_BIG; const unsigned char* TV = TU + (size_t)16384 * 2048; const float* SCL = (const float*)(A.ws + WS_BIG + 64 * MiB);
    const int* EID = (const int*)(A.ws + WS_LA); const float* GSM = (const float*)(A.ws + WS_LA + 16 * MiB);
    const float* MOD = (const float*)(A.ws + WS_MOD); float* X = A.out;
    const float* lng = (const float*)A.in[21] + (size_t)(L * 2 + 1) * DM; const float* lnb = (const float*)A.in[22] + (size_t)(L * 2 + 1) * DM;
    for (int t = F.gw; t < TOK; t += F.ngw) {
        const int b = t >> 14;
        f32x2 h2[16];
#pragma unroll
        for (int j = 0; j < 2; ++j) { const u32x4 a = *(const u32x4*)(H + (size_t)t * DM + (j * 64 + F.lane) * 16), c = *(const u32x4*)(H + (size_t)t * DM + (j * 64 + F.lane) * 16 + 8);
            const unsigned aw[8] = {a.x, a.y, a.z, a.w, c.x, c.y, c.z, c.w};
#pragma unroll
            for (int q = 0; q < 8; ++q) h2[j * 8 + q] = (f32x2){lo2f(aw[q]), hi2f(aw[q])}; }
        f32x2 o2[16];
#pragma unroll
        for (int e = 0; e < 16; ++e) o2[e] = (f32x2){0.f, 0.f};
#pragma unroll 1
        for (int e0 = 0; e0 < 128; e0 += PGB) {
            int eid[PGB]; float gw[PGB], su[PGB], sv[PGB];
#pragma unroll
            for (int q = 0; q < PGB; ++q) { eid[q] = __builtin_amdgcn_readfirstlane(EID[(size_t)t * 128 + e0 + q]); gw[q] = GSM[(size_t)t * 128 + e0 + q]; su[q] = SCL[eid[q]]; sv[q] = SCL[16384 + eid[q]]; }
            u32x4 uu[PGB][2], vv[PGB][2];
#pragma unroll
            for (int q = 0; q < PGB; ++q)
#pragma unroll
                for (int j = 0; j < 2; ++j) { uu[q][j] = *(const u32x4*)(TU + (size_t)eid[q] * 2048 + (j * 64 + F.lane) * 16); vv[q][j] = *(const u32x4*)(TV + (size_t)eid[q] * 2048 + (j * 64 + F.lane) * 16); }
#pragma unroll
            for (int q = 0; q < PGB; ++q) {
                f32x2 d2 = {0.f, 0.f};
#pragma unroll
                for (int j = 0; j < 2; ++j) { const unsigned w[4] = {uu[q][j].x, uu[q][j].y, uu[q][j].z, uu[q][j].w};
#pragma unroll
                    for (int i = 0; i < 4; ++i) { const f32x2 lo = __builtin_amdgcn_cvt_pk_f32_fp8((int)w[i], false), hi = __builtin_amdgcn_cvt_pk_f32_fp8((int)w[i], true);
                        d2 = lo * h2[j * 8 + 2 * i] + d2; d2 = hi * h2[j * 8 + 2 * i + 1] + d2; } }
                const float d = wsum(d2.x + d2.y) * su[q];
                const float act = 0.5f * d * (1.0f + erff(d * 0.70710678f)) * gw[q] * sv[q];
                const f32x2 a2 = {act, act};
#pragma unroll
                for (int j = 0; j < 2; ++j) { const unsigned w[4] = {vv[q][j].x, vv[q][j].y, vv[q][j].z, vv[q][j].w};
#pragma unroll
                    for (int i = 0; i < 4; ++i) { const f32x2 lo = __builtin_amdgcn_cvt_pk_f32_fp8((int)w[i], false), hi = __builtin_amdgcn_cvt_pk_f32_fp8((int)w[i], true);
                        o2[j * 8 + 2 * i] = a2 * lo + o2[j * 8 + 2 * i]; o2[j * 8 + 2 * i + 1] = a2 * hi + o2[j * 8 + 2 * i + 1]; } }
            }
        }
        float out[32];
#pragma unroll
        for (int e = 0; e < 16; ++e) { out[2 * e] = o2[e].x; out[2 * e + 1] = o2[e].y; }
        const float* gate = MOD + (size_t)((L * 2 + 1) * 2 + b) * 6144 + 4096;
        float sum = 0.f;
#pragma unroll
        for (int j = 0; j < 2; ++j)
#pragma unroll
            for (int c = 0; c < 4; ++c) { const int base = (j * 64 + F.lane) * 16 + 4 * c;
                const f32x4 x0 = *(const f32x4*)(X + (size_t)t * DM + base), g0 = *(const f32x4*)(gate + base);
#pragma unroll
                for (int e = 0; e < 4; ++e) { const float v = ALPHA * x0[e] + (1.0f + g0[e]) * out[j * 16 + 4 * c + e]; out[j * 16 + 4 * c + e] = v; sum += v; } }
        const float mean = wsum(sum) * (1.0f / DM); float sq = 0.f;
#pragma unroll
        for (int e = 0; e < 32; ++e) { out[e] -= mean; sq += out[e] * out[e]; }
        const float rstd = rsqrtf(wsum(sq) * (1.0f / DM) + 1e-5f);
        const float* sh = MOD + (size_t)(((L + 1) * 2 + 0) * 2 + b) * 6144; const float* sc = sh + 2048;
#pragma unroll
        for (int j = 0; j < 2; ++j) {
            float hq[16];
#pragma unroll
            for (int c = 0; c < 4; ++c) { const int base = (j * 64 + F.lane) * 16 + 4 * c;
                const f32x4 lg0 = *(const f32x4*)(lng + base), lb0 = *(const f32x4*)(lnb + base);
                f32x4 o0;
#pragma unroll
                for (int e = 0; e < 4; ++e) o0[e] = out[j * 16 + 4 * c + e] * rstd * lg0[e] + lb0[e];
                *(f32x4*)(Xout + (size_t)t * DM + base) = o0;
                if (L == 0) { const f32x4 s0 = *(const f32x4*)(sc + base), h0 = *(const f32x4*)(sh + base);
#pragma unroll
                    for (int e = 0; e < 4; ++e) hq[4 * c + e] = o0[e] * (1.0f + s0[e]) + h0[e]; } }
            if (L == 0) { u32x4 w0, w1;
                w0.x = pk2(hq[0], hq[1]); w0.y = pk2(hq[2], hq[3]); w0.z = pk2(hq[4], hq[5]); w0.w = pk2(hq[6], hq[7]);
                w1.x = pk2(hq[8], hq[9]); w1.y = pk2(hq[10], hq[11]); w1.z = pk2(hq[12], hq[13]); w1.w = pk2(hq[14], hq[15]);
                *(u32x4*)(Hout + (size_t)t * DM + (j * 64 + F.lane) * 16) = w0; *(u32x4*)(Hout + (size_t)t * DM + (j * 64 + F.lane) * 16 + 8) = w1; }
        }
    }
}

struct XInfo { int rank, nloc, rx, nx; };
__device__ __forceinline__ XInfo xcc_info(volatile LAS unsigned* MISC) { XInfo x; x.rank = (int)MISC[16]; x.nloc = (int)MISC[17]; x.rx = (int)MISC[18]; x.nx = (int)MISC[19]; return x; }
constexpr size_t WS_DP = WS_BIG + 128 * MiB;
constexpr size_t WS_ACT = WS_BIG + 80 * MiB;
__device__ __forceinline__ void ph_peer_u(const Args& A, Frame& F, const XInfo X) {
    const bf16* H = (const bf16*)(A.ws + WS_HY); const unsigned char* TU = A.ws + WS_BIG; const int* EID = (const int*)(A.ws + WS_LA); float* DP = (float*)(A.ws + WS_DP);
    LAS int* IDX = (LAS int*)(F.lds + F.wave * 1024);
    const int g16 = F.lane >> 4, c16 = F.lane & 15; const int step = X.nloc * NWAVES;
    for (int s = X.rx; s < 8; s += X.nx) {
        int t = X.rank * NWAVES + F.wave;
        int e0 = 0, e1 = 0; u32x4 ha = {0u, 0u, 0u, 0u}, hb = ha;
        if (t < TOK) { e0 = EID[(size_t)t * 128 + F.lane]; e1 = EID[(size_t)t * 128 + 64 + F.lane]; ha = *(const u32x4*)(H + (size_t)t * DM + 256 * s + 16 * c16); hb = *(const u32x4*)(H + (size_t)t * DM + 256 * s + 16 * c16 + 8); }
        const unsigned char* ub = TU + 256 * s + 16 * c16;
        while (t < TOK) {
            const int tn = t + step; int n0 = 0, n1 = 0; u32x4 na = {0u, 0u, 0u, 0u}, nb = na;
            if (tn < TOK) { n0 = EID[(size_t)tn * 128 + F.lane]; n1 = EID[(size_t)tn * 128 + 64 + F.lane]; na = *(const u32x4*)(H + (size_t)tn * DM + 256 * s + 16 * c16); nb = *(const u32x4*)(H + (size_t)tn * DM + 256 * s + 16 * c16 + 8); }
            IDX[F.lane] = e0; IDX[F.lane + 64] = e1;
            f32x2 h2[8];
            { const unsigned aw[8] = {ha.x, ha.y, ha.z, ha.w, hb.x, hb.y, hb.z, hb.w};
#pragma unroll
              for (int q = 0; q < 8; ++q) h2[q] = (f32x2){lo2f(aw[q]), hi2f(aw[q])}; }
            asm volatile("s_waitcnt lgkmcnt(0)" ::: "memory"); __builtin_amdgcn_wave_barrier();
            float keep0 = 0.f, keep1 = 0.f;
#pragma unroll
            for (int i0 = 0; i0 < 32; i0 += 8) {
                u32x4 ud[8];
#pragma unroll
                for (int u = 0; u < 8; ++u) { const int eid = IDX[4 * (i0 + u) + g16]; ud[u] = *(const u32x4*)(ub + (size_t)eid * 2048); }
#pragma unroll
                for (int u = 0; u < 8; ++u) {
                    const unsigned w[4] = {ud[u].x, ud[u].y, ud[u].z, ud[u].w}; f32x2 d2 = {0.f, 0.f};
#pragma unroll
                    for (int q = 0; q < 4; ++q) { const f32x2 lo = __builtin_amdgcn_cvt_pk_f32_fp8((int)w[q], false), hi = __builtin_amdgcn_cvt_pk_f32_fp8((int)w[q], true);
                        d2 = lo * h2[2 * q] + d2; d2 = hi * h2[2 * q + 1] + d2; }
                    const float d = sum16_dpp(d2.x + d2.y);
                    const int i = i0 + u;
                    if (i < 16) keep0 = ((i & 15) == c16) ? d : keep0; else keep1 = ((i & 15) == c16) ? d : keep1;
                }
            }
            float* dp = DP + ((size_t)s * TOK + t) * 128 + 4 * c16 + g16;
            dp[0] = keep0; dp[64] = keep1;
            asm volatile("s_waitcnt lgkmcnt(0)" ::: "memory"); __builtin_amdgcn_wave_barrier();
            e0 = n0; e1 = n1; ha = na; hb = nb; t = tn;
        }
    }
}
__device__ __forceinline__ void ph_peer_act(const Args& A, Frame& F) {
    const float* SCL = (const float*)(A.ws + WS_BIG + 64 * MiB); const int* EID = (const int*)(A.ws + WS_LA); const float* GSM = (const float*)(A.ws + WS_LA + 16 * MiB);
    const float* DP = (const float*)(A.ws + WS_DP); float* ACT = (float*)(A.ws + WS_ACT);
    for (int t = F.gw; t < TOK; t += F.ngw) {
#pragma unroll
        for (int m = 0; m < 2; ++m) { const int e = F.lane + 64 * m; const int eid = EID[(size_t)t * 128 + e]; float d = 0.f;
#pragma unroll
            for (int x = 0; x < 8; ++x) d += DP[((size_t)x * TOK + t) * 128 + e];
            d *= SCL[eid];
            ACT[(size_t)t * 128 + e] = 0.5f * d * (1.0f + erff(d * 0.70710678f)) * GSM[(size_t)t * 128 + e] * SCL[16384 + eid]; }
    }
}
__device__ __forceinline__ void ph_peer_v(const Args& A, Frame& F, const XInfo X) {
    const unsigned char* TV = A.ws + WS_BIG + (size_t)16384 * 2048;
    const int* EID = (const int*)(A.ws + WS_LA); const float* ACTG = (const float*)(A.ws + WS_ACT); float* OUT = (float*)(A.ws + WS_Z);
    LAS int* IDX = (LAS int*)(F.lds + F.wave * 1024); LAS float* ACT = (LAS float*)(F.lds + F.wave * 1024 + 512);
    const int g16 = F.lane >> 4, c16 = F.lane & 15; const int step = X.nloc * NWAVES;
    for (int s = X.rx; s < 8; s += X.nx) {
        int t = X.rank * NWAVES + F.wave;
        int e0 = 0, e1 = 0; float a0 = 0.f, a1 = 0.f;
        if (t < TOK) { e0 = EID[(size_t)t * 128 + F.lane]; e1 = EID[(size_t)t * 128 + 64 + F.lane]; a0 = ACTG[(size_t)t * 128 + F.lane]; a1 = ACTG[(size_t)t * 128 + 64 + F.lane]; }
        const unsigned char* vb = TV + 256 * s + 16 * c16;
        while (t < TOK) {
            const int tn = t + step; int n0 = 0, n1 = 0; float b0 = 0.f, b1 = 0.f;
            if (tn < TOK) { n0 = EID[(size_t)tn * 128 + F.lane]; n1 = EID[(size_t)tn * 128 + 64 + F.lane]; b0 = ACTG[(size_t)tn * 128 + F.lane]; b1 = ACTG[(size_t)tn * 128 + 64 + F.lane]; }
            IDX[F.lane] = e0; IDX[F.lane + 64] = e1; ACT[F.lane] = a0; ACT[F.lane + 64] = a1;
            asm volatile("s_waitcnt lgkmcnt(0)" ::: "memory"); __builtin_amdgcn_wave_barrier();
            f32x2 o2[8];
#pragma unroll
            for (int q = 0; q < 8; ++q) o2[q] = (f32x2){0.f, 0.f};
#pragma unroll
            for (int i0 = 0; i0 < 32; i0 += 8) {
                u32x4 vd[8]; float av[8];
#pragma unroll
                for (int u = 0; u < 8; ++u) { const int eid = IDX[4 * (i0 + u) + g16]; vd[u] = *(const u32x4*)(vb + (size_t)eid * 2048); av[u] = ACT[4 * (i0 + u) + g16]; }
#pragma unroll
                for (int u = 0; u < 8; ++u) {
                    const unsigned w[4] = {vd[u].x, vd[u].y, vd[u].z, vd[u].w}; const f32x2 a2 = {av[u], av[u]};
#pragma unroll
                    for (int q = 0; q < 4; ++q) { const f32x2 lo = __builtin_amdgcn_cvt_pk_f32_fp8((int)w[q], false), hi = __builtin_amdgcn_cvt_pk_f32_fp8((int)w[q], true);
                        o2[2 * q] = a2 * lo + o2[2 * q]; o2[2 * q + 1] = a2 * hi + o2[2 * q + 1]; }
                }
            }
            float o[16];
#pragma unroll
            for (int q = 0; q < 8; ++q) { float x0 = o2[q].x, x1 = o2[q].y; x0 += __shfl_xor(x0, 16); x0 += __shfl_xor(x0, 32); x1 += __shfl_xor(x1, 16); x1 += __shfl_xor(x1, 32); o[2 * q] = x0; o[2 * q + 1] = x1; }
            if (g16 == 0) { float* op = OUT + (size_t)t * DM + 256 * s + 16 * c16;
#pragma unroll
                for (int c = 0; c < 4; ++c) *(f32x4*)(op + 4 * c) = (f32x4){o[4 * c], o[4 * c + 1], o[4 * c + 2], o[4 * c + 3]}; }
            asm volatile("s_waitcnt lgkmcnt(0)" ::: "memory"); __builtin_amdgcn_wave_barrier();
            e0 = n0; e1 = n1; a0 = b0; a1 = b1; t = tn;
        }
    }
}
__device__ __forceinline__ void ph_peer_ln(const Args& A, Frame& F, const int L) {
    const float* OUT = (const float*)(A.ws + WS_Z); float* X = A.out; bf16* H = (bf16*)(A.ws + WS_HY); const float* MOD = (const float*)(A.ws + WS_MOD);
    const float* lng = (const float*)A.in[21] + (size_t)(L * 2 + 1) * DM; const float* lnb = (const float*)A.in[22] + (size_t)(L * 2 + 1) * DM;
    for (int t = F.gw; t < TOK; t += F.ngw) {
        const int b = t >> 14;
        const float* gate = MOD + (size_t)((L * 2 + 1) * 2 + b) * 6144 + 4096;
        const float* sh = MOD + (size_t)(((L + 1) * 2 + 0) * 2 + b) * 6144; const float* sc = sh + 2048;
        float v[32]; float sum = 0.f;
#pragma unroll
        for (int j = 0; j < 8; ++j) { const int base = (j * 64 + F.lane) * 4;
            const f32x4 o0 = *(const f32x4*)(OUT + (size_t)t * DM + base), x0 = *(const f32x4*)(X + (size_t)t * DM + base), g0 = *(const f32x4*)(gate + base);
#pragma unroll
            for (int e = 0; e < 4; ++e) { v[j * 4 + e] = ALPHA * x0[e] + (1.0f + g0[e]) * o0[e]; sum += v[j * 4 + e]; } }
        const float mean = wsum(sum) * (1.0f / DM); float sq = 0.f;
#pragma unroll
        for (int e = 0; e < 32; ++e) { v[e] -= mean; sq += v[e] * v[e]; }
        const float rstd = rsqrtf(wsum(sq) * (1.0f / DM) + 1e-5f);
#pragma unroll
        for (int j = 0; j < 8; ++j) { const int base = (j * 64 + F.lane) * 4;
            const f32x4 lg0 = *(const f32x4*)(lng + base), lb0 = *(const f32x4*)(lnb + base);
            f32x4 o0;
#pragma unroll
            for (int e = 0; e < 4; ++e) o0[e] = v[j * 4 + e] * rstd * lg0[e] + lb0[e];
            *(f32x4*)(X + (size_t)t * DM + base) = o0;
            if (L == 0) { const f32x4 s0 = *(const f32x4*)(sc + base), h0 = *(const f32x4*)(sh + base); const f32x4 q0 = o0 * (1.0f + s0) + h0;
                u32x2 w; w.x = pk2(q0[0], q0[1]); w.y = pk2(q0[2], q0[3]); *(u32x2*)(H + (size_t)t * DM + base) = w; }
        }
    }
}

__device__ __forceinline__ void ph_odd_post(const Args& A, Frame& F) {
    bf16* Z = (bf16*)(A.ws + WS_Z); const int* positions = (const int*)A.in[2]; bf16* KIT = (bf16*)(A.ws + WS_BIG + 256 * MiB); unsigned char* K8 = A.ws + WS_BIG + 264 * MiB; unsigned char* V8 = A.ws + WS_BIG + 280 * MiB;
    const float inv128 = powf(10000.0f, -(float)F.lane / 64.0f); const int i32 = F.lane & 31; const float inv64 = powf(10000.0f, -(float)i32 / 32.0f);
    const int a16 = F.lane & 15, hs4 = F.lane >> 4, a8 = F.lane & 7, hs8 = F.lane >> 3;
    for (int t = F.gw; t < TOK; t += F.ngw) {
        bf16* zr = Z + (size_t)t * OD_NP; const float pos = (float)positions[t];
        const int bb = t >> 14, spos = t & (SEQ - 1);
        float sn, cs; sincosf(pos * inv128, &sn, &cs);
        float c4[4], s4[4];
#pragma unroll
        for (int e = 0; e < 4; ++e) { c4[e] = __shfl(cs, 4 * a16 + e); s4[e] = __shfl(sn, 4 * a16 + e); }
#pragma unroll
        for (int it = 0; it < 5; ++it) { const int hd = it * 4 + hs4; bf16* hp = zr + hd * 128 + 4 * a16;
            const u32x2 a = *(const u32x2*)hp, b = *(const u32x2*)(hp + 64);
            const float t1[4] = {lo2f(a.x), hi2f(a.x), lo2f(a.y), hi2f(a.y)}, t2[4] = {lo2f(b.x), hi2f(b.x), lo2f(b.y), hi2f(b.y)};
            float o1[4], o2[4];
#pragma unroll
            for (int e = 0; e < 4; ++e) { o1[e] = t1[e] * c4[e] - t2[e] * s4[e]; o2[e] = t2[e] * c4[e] + t1[e] * s4[e]; }
            *(u32x2*)hp = (u32x2){pk2(o1[0], o1[1]), pk2(o1[2], o1[3])}; *(u32x2*)(hp + 64) = (u32x2){pk2(o2[0], o2[1]), pk2(o2[2], o2[3])};
            if (it == 4) { unsigned char* k8 = K8 + ((size_t)((bb * 4 + hs4) * SEQ + spos)) * 128 + 4 * a16;
                int w1 = __builtin_amdgcn_cvt_pk_fp8_f32(o1[0] * 16.0f, o1[1] * 16.0f, 0, false); w1 = __builtin_amdgcn_cvt_pk_fp8_f32(o1[2] * 16.0f, o1[3] * 16.0f, w1, true);
                int w2 = __builtin_amdgcn_cvt_pk_fp8_f32(o2[0] * 16.0f, o2[1] * 16.0f, 0, false); w2 = __builtin_amdgcn_cvt_pk_fp8_f32(o2[2] * 16.0f, o2[3] * 16.0f, w2, true);
                *(unsigned*)k8 = (unsigned)w1; *(unsigned*)(k8 + 64) = (unsigned)w2; } }
        {
            const int e0 = F.lane * 8, kvh = e0 >> 7, d0 = e0 & 127;
            const u32x4 vw = *(const u32x4*)(zr + 2560 + e0);
            int w0 = __builtin_amdgcn_cvt_pk_fp8_f32(lo2f(vw.x) * 16.0f, hi2f(vw.x) * 16.0f, 0, false); w0 = __builtin_amdgcn_cvt_pk_fp8_f32(lo2f(vw.y) * 16.0f, hi2f(vw.y) * 16.0f, w0, true);
            int w1 = __builtin_amdgcn_cvt_pk_fp8_f32(lo2f(vw.z) * 16.0f, hi2f(vw.z) * 16.0f, 0, false); w1 = __builtin_amdgcn_cvt_pk_fp8_f32(lo2f(vw.w) * 16.0f, hi2f(vw.w) * 16.0f, w1, true);
            *(u32x2*)(V8 + ((size_t)((bb * 4 + kvh) * SEQ + spos)) * 128 + d0) = (u32x2){(unsigned)w0, (unsigned)w1};
        }
        sincosf(pos * inv64, &sn, &cs);
#pragma unroll
        for (int e = 0; e < 4; ++e) { c4[e] = __shfl(cs, 4 * a8 + e); s4[e] = __shfl(sn, 4 * a8 + e); }
#pragma unroll
        for (int it = 0; it < 3; ++it) { const int hd = it * 8 + hs8; if (hd < 17) { bf16* hp = zr + 3072 + hd * 64 + 4 * a8;
            const u32x2 a = *(const u32x2*)hp, b = *(const u32x2*)(hp + 32);
            const float t1[4] = {lo2f(a.x), hi2f(a.x), lo2f(a.y), hi2f(a.y)}, t2[4] = {lo2f(b.x), hi2f(b.x), lo2f(b.y), hi2f(b.y)};
            float o1[4], o2[4];
#pragma unroll
            for (int e = 0; e < 4; ++e) { o1[e] = t1[e] * c4[e] - t2[e] * s4[e]; o2[e] = t2[e] * c4[e] + t1[e] * s4[e]; }
            const u32x2 w1 = {pk2(o1[0], o1[1]), pk2(o1[2], o1[3])}, w2 = {pk2(o2[0], o2[1]), pk2(o2[2], o2[3])};
            *(u32x2*)hp = w1; *(u32x2*)(hp + 32) = w2;
            if (hd == 16) {
                const int tile = spos >> 5, rr = spos & 31;
                bf16* kt = KIT + ((size_t)(bb * 512 + tile) * 4) * 512;
                const int d1 = 4 * a8, d2 = 32 + 4 * a8;
                *(u32x2*)(kt + ((d1 >> 4) * 64 + rr + 32 * ((d1 >> 3) & 1)) * 8 + (d1 & 7)) = w1;
                *(u32x2*)(kt + ((d2 >> 4) * 64 + rr + 32 * ((d2 >> 3) & 1)) * 8 + (d2 & 7)) = w2;
            } } }
    }
}

__device__ __forceinline__ void ph_dsa_select(const Args& A, Frame& F, const int mode = 0) {
    const bf16* Z = (const bf16*)(A.ws + WS_Z); unsigned short* SEL = (unsigned short*)(A.ws + WS_LA); int* CNT = (int*)(A.ws + WS_CNT); const bf16* KIT = (const bf16*)(A.ws + WS_BIG + 256 * MiB);
    LAS unsigned short* SC = (LAS unsigned short*)F.lds;
    LAS unsigned* LST = (LAS unsigned*)(F.lds + 131072);
    LAS unsigned* hist = (LAS unsigned*)(F.lds + 131072 + 16384);
    LAS unsigned* res = (LAS unsigned*)(F.lds + 131072 + 16384 + 2048);
    LAS int* wtot = (LAS int*)(F.lds + 131072 + 16384 + 2048 + 64);
    const int r = F.lane & 31, hg = F.lane >> 5, tk = (r >> 2) & 1, hh = (r & 3) + 4 * (r >> 3);
    const int grp = F.wave >> 2, ltid = F.tid & 255, lw = F.wave & 3;
    for (int qd = F.bx; qd < TOK / 4; qd += F.G) {
        const int t0 = 4 * qd, b = t0 >> 14, s0 = t0 & (SEQ - 1);
        const int nkeys = s0 + 4, ntiles = (nkeys + 31) >> 5;
        bf16x8 af[2][4]; float wv[2][16];
#pragma unroll
        for (int a = 0; a < 2; ++a) {
            const bf16* qrow = Z + (size_t)(t0 + 2 * a + tk) * OD_NP + 3072 + hh * 64 + 8 * hg;
#pragma unroll
            for (int s = 0; s < 4; ++s) af[a][s] = *(const bf16x8*)(qrow + 16 * s);
            const bf16* wrow = Z + (size_t)(t0 + 2 * a + hg) * OD_NP + 4160;
            const u32x4 w0 = *(const u32x4*)(wrow), w1 = *(const u32x4*)(wrow + 8);
            const unsigned ww[8] = {w0.x, w0.y, w0.z, w0.w, w1.x, w1.y, w1.z, w1.w};
#pragma unroll
            for (int q = 0; q < 8; ++q) { wv[a][2 * q] = lo2f(ww[q]) * 0.03125f; wv[a][2 * q + 1] = hi2f(ww[q]) * 0.03125f; }
        }
        __syncthreads();
        const bf16* kbase = KIT + (size_t)b * 512 * 2048 + F.lane * 8;
        if (mode != 2) {
            bf16x8 bcur[2][4];
#define DSA_LOADT(dst, tb_) do { _Pragma("unroll") for (int q = 0; q < 2; ++q) { const int tile = ((tb_) + q < ntiles) ? ((tb_) + q) : (ntiles - 1); const bf16* krow = kbase + (size_t)tile * 2048; \
                _Pragma("unroll") for (int s_ = 0; s_ < 4; ++s_) dst[q][s_] = *(const bf16x8*)(krow + 512 * s_); } } while (0)
#define DSA_MM(accv, src, q_, a_) do { _Pragma("unroll") for (int e = 0; e < 16; ++e) accv[e] = 0.f; \
                _Pragma("unroll") for (int s_ = 0; s_ < 4; ++s_) accv = __builtin_amdgcn_mfma_f32_32x32x16_bf16(af[a_][s_], src[q_][s_], accv, 0, 0, 0); } while (0)
#define DSA_EPI(accv, tb_, q_, a_) do { float sc_ = 0.f; _Pragma("unroll") for (int e = 0; e < 16; ++e) sc_ += fmaxf(accv[e], 0.f) * wv[a_][e]; \
                const int key = ((tb_) + (q_)) * 32 + r; sc_ = fminf(fmaxf(sc_, -7.999f), 7.999f); const unsigned fx = (unsigned)((int)rintf(sc_ * 4096.0f) + (1 << 15)); \
                if ((tb_) + (q_) < ntiles) SC[(2 * (a_) + hg) * 16384 + key] = (unsigned short)((key <= s0 + 2 * (a_) + hg) ? fx : 0u); } while (0)
#define DSA_COMPT(src, tb_) do { f32x16 accA, accB; DSA_MM(accA, src, 0, 0); DSA_MM(accB, src, 0, 1); DSA_EPI(accA, tb_, 0, 0); DSA_MM(accA, src, 1, 0); DSA_EPI(accB, tb_, 0, 1); DSA_MM(accB, src, 1, 1); DSA_EPI(accA, tb_, 1, 0); DSA_EPI(accB, tb_, 1, 1); } while (0)
            for (int tb = F.wave * 2; tb < ntiles; tb += NWAVES * 2) { DSA_LOADT(bcur, tb); DSA_COMPT(bcur, tb); }
#undef DSA_LOADT
#undef DSA_COMPT
#undef DSA_MM
#undef DSA_EPI
        }
        __syncthreads();
        if (mode == 1) continue;
#pragma unroll 1
        for (int rd = 0; rd < 2; ++rd) {
        const int tok = 2 * rd + grp;
        const int n = s0 + tok + 1; unsigned k = (unsigned)(n < 256 ? n : 256); unsigned prefix = 0u;
        const LAS unsigned short* sc = SC + tok * 16384; LAS unsigned* hs = hist + grp * 256;
        unsigned kreg[64];
#pragma unroll
        for (int j = 0; j < 64; ++j) { const int i = ltid + 256 * j; kreg[j] = (i < n) ? (unsigned)sc[i] : 0u; }
        unsigned lmax = 0u;
#pragma unroll
        for (int j = 0; j < 64; ++j) lmax = (kreg[j] > lmax) ? kreg[j] : lmax;
        unsigned wmin = lmax;
#pragma unroll
        for (int o = 32; o >= 1; o >>= 1) { const unsigned tmp = __shfl_xor(wmin, o); wmin = tmp < wmin ? tmp : wmin; }
        if (F.lane == 0) wtot[16 + F.wave] = (int)wmin;
        __syncthreads();
        unsigned lbound = 0xFFFFFFFFu;
#pragma unroll
        for (int w = 0; w < 4; ++w) { const unsigned x = (unsigned)wtot[16 + grp * 4 + w]; lbound = x < lbound ? x : lbound; }
        LAS unsigned* seg = LST + (grp * 4 + lw) * 512; int ccnt = 0;
        {
            const unsigned long long below = (F.lane == 0) ? 0ull : ((~0ull) >> (64 - F.lane));
#pragma unroll
            for (int j = 0; j < 64; ++j) { if (256 * j < n) { const bool c = ((ltid + 256 * j) < n) && (kreg[j] >= lbound); const unsigned long long m = __ballot(c);
                const int pos = ccnt + __popcll(m & below); if (c && pos < 512) seg[pos] = kreg[j]; ccnt += __popcll(m); } }
        }
        const bool fast = ccnt <= 512;
        asm volatile("s_waitcnt lgkmcnt(0)" ::: "memory"); __builtin_amdgcn_wave_barrier();
#pragma unroll 1
        for (int pass = 0; pass < 2; ++pass) {
            const int shift = 8 - 8 * pass;
            hs[ltid] = 0u;
            __syncthreads();
            if (fast) {
#pragma unroll
                for (int i = 0; i < 8; ++i) { if (64 * i < ccnt) { const int c_ = F.lane + 64 * i; const bool valid = c_ < ccnt; const unsigned kv = valid ? seg[c_] : 0u;
                    const bool match = (pass == 0) ? true : ((kv >> 8) == prefix);
                    if (valid && match) (void)__hip_atomic_fetch_add(&hs[(kv >> shift) & 255u], 1u, __ATOMIC_RELAXED, __HIP_MEMORY_SCOPE_WORKGROUP); } }
            } else {
#pragma unroll
                for (int j = 0; j < 64; ++j) { if (256 * j < n) { const unsigned kv = kreg[j]; const bool valid = ((ltid + 256 * j) < n) && (kv >= lbound);
                    const bool match = (pass == 0) ? true : ((kv >> 8) == prefix);
                    if (valid && match) (void)__hip_atomic_fetch_add(&hs[(kv >> shift) & 255u], 1u, __ATOMIC_RELAXED, __HIP_MEMORY_SCOPE_WORKGROUP); } }
            }
            __syncthreads();
            if (lw == 0) {
                const unsigned c0 = hs[4 * F.lane], c1 = hs[4 * F.lane + 1], c2 = hs[4 * F.lane + 2], c3 = hs[4 * F.lane + 3];
                const unsigned tot = c0 + c1 + c2 + c3; unsigned suf = tot;
#pragma unroll
                for (int o = 1; o < 64; o <<= 1) { const unsigned tmp = __shfl_down(suf, o); if (F.lane + o < 64) suf += tmp; }
                unsigned above = suf - tot;
                if (above < k && k <= suf) {
                    int bin;
                    if (above + c3 >= k) { bin = 3; } else { above += c3; if (above + c2 >= k) { bin = 2; } else { above += c2; if (above + c1 >= k) { bin = 1; } else { above += c1; bin = 0; } } }
                    res[grp * 2 + 0] = (unsigned)(4 * F.lane + bin); res[grp * 2 + 1] = k - above;
                }
            }
            __syncthreads();
            prefix = (prefix << 8) | res[grp * 2 + 0]; k = res[grp * 2 + 1];
        }
        const unsigned tau = prefix; const int krem = (int)k;
        int cg = 0, ce = 0;
#pragma unroll
        for (int j = 0; j < 64; ++j) { const bool valid = (ltid + 256 * j) < n; cg += (valid && kreg[j] > tau) ? 1 : 0; ce += (valid && kreg[j] == tau) ? 1 : 0; }
        int ig = cg, ie = ce;
#pragma unroll
        for (int o = 1; o < 64; o <<= 1) { const int tg = __shfl_up(ig, o), te = __shfl_up(ie, o); if (F.lane >= o) { ig += tg; ie += te; } }
        if (F.lane == 63) { wtot[F.wave * 2] = ig; wtot[F.wave * 2 + 1] = ie; }
        __syncthreads();
        int og = ig - cg, oe = ie - ce, totg = 0;
        for (int w = 0; w < 4; ++w) { const int a = wtot[(grp * 4 + w) * 2], e = wtot[(grp * 4 + w) * 2 + 1]; if (w < lw) { og += a; oe += e; } totg += a; }
        unsigned short* sel = SEL + (size_t)(t0 + tok) * 256;
#pragma unroll
        for (int j = 0; j < 64; ++j) { if (256 * j < n) { const int i = ltid + 256 * j; if (i < n) { const unsigned kv = kreg[j];
            if (kv > tau) { sel[og++] = (unsigned short)i; }
            else if (kv == tau) { if (oe < krem) sel[totg + oe] = (unsigned short)i; ++oe; } } } }
        if (ltid == 0) CNT[t0 + tok] = (n < 256 ? n : 256);
        __syncthreads();
        }
    }
}

__device__ __forceinline__ float sum8_dpp(float v) { v += dppf<0xB1, 0xF>(v); v += dppf<0x4E, 0xF>(v); v += dppf<0x141, 0xF>(v); return v; }
__device__ __forceinline__ void ph_dsa_attn(const Args& A, Frame& F, const XInfo X) {
    const bf16* Z = (const bf16*)(A.ws + WS_Z); const unsigned short* SEL = (const unsigned short*)(A.ws + WS_LA); const int* CNT = (const int*)(A.ws + WS_CNT);
    const unsigned char* K8 = A.ws + WS_BIG + 264 * MiB; const unsigned char* V8 = A.ws + WS_BIG + 280 * MiB; bf16* Y = (bf16*)(A.ws + WS_HY);
    LAS int* IDX = (LAS int*)(F.lds + F.wave * 5120);
    LAS float* SCR = (LAS float*)(F.lds + F.wave * 5120 + 1024);
    const int g8 = F.lane >> 3, c8 = F.lane & 7;
    for (int sl = X.rx; sl < 8; sl += X.nx) {
        const int b = sl >> 2, kvh = sl & 3;
        const unsigned char* kb = K8 + (size_t)sl * SEQ * 128 + 16 * c8; const unsigned char* vb = V8 + (size_t)sl * SEQ * 128 + 16 * c8;
        for (int sq = X.rank * NWAVES + F.wave; sq < SEQ; sq += X.nloc * NWAVES) {
            const int t = b * SEQ + sq; const int n = CNT[t];
            f32x2 qf[4][8];
#pragma unroll
            for (int g = 0; g < 4; ++g) { const bf16* qp = Z + (size_t)t * OD_NP + (kvh * 4 + g) * 128 + 16 * c8; const u32x4 a = *(const u32x4*)qp, c = *(const u32x4*)(qp + 8);
                const unsigned aw[8] = {a.x, a.y, a.z, a.w, c.x, c.y, c.z, c.w};
#pragma unroll
                for (int q = 0; q < 8; ++q) qf[g][q] = (f32x2){lo2f(aw[q]) * 0.005524271728f, hi2f(aw[q]) * 0.005524271728f}; }
#pragma unroll
            for (int m = 0; m < 4; ++m) { const int jj = F.lane + 64 * m; IDX[jj] = (jj < n) ? (int)SEL[(size_t)t * 256 + jj] : 0; }
            asm volatile("s_waitcnt lgkmcnt(0)" ::: "memory"); __builtin_amdgcn_wave_barrier();
#pragma unroll 1
            for (int i0 = 0; i0 < 32; i0 += 8) {
                u32x4 kd[8];
#pragma unroll
                for (int u = 0; u < 8; ++u) { const int id = IDX[8 * (i0 + u) + g8]; kd[u] = *(const u32x4*)(kb + (size_t)id * 128); }
#pragma unroll
                for (int u = 0; u < 8; ++u) {
                    const unsigned w[4] = {kd[u].x, kd[u].y, kd[u].z, kd[u].w}; f32x2 k2[8];
#pragma unroll
                    for (int q = 0; q < 4; ++q) { k2[2 * q] = __builtin_amdgcn_cvt_pk_f32_fp8((int)w[q], false); k2[2 * q + 1] = __builtin_amdgcn_cvt_pk_f32_fp8((int)w[q], true); }
                    float a[4];
#pragma unroll
                    for (int g = 0; g < 4; ++g) { f32x2 d2 = {0.f, 0.f};
#pragma unroll
                        for (int q = 0; q < 8; ++q) d2 = k2[q] * qf[g][q] + d2;
                        a[g] = sum8_dpp(d2.x + d2.y); }
                    const float mine = (c8 == 0) ? a[0] : ((c8 == 1) ? a[1] : ((c8 == 2) ? a[2] : a[3]));
                    if (c8 < 4) SCR[(8 * (i0 + u) + g8) * 4 + c8] = mine;
                }
            }
            asm volatile("s_waitcnt lgkmcnt(0)" ::: "memory"); __builtin_amdgcn_wave_barrier();
            {
                f32x4 sv[4];
#pragma unroll
                for (int m = 0; m < 4; ++m) sv[m] = *(const LAS f32x4*)(SCR + (F.lane + 64 * m) * 4);
#pragma unroll
                for (int g = 0; g < 4; ++g) {
                    float mx = -INFINITY;
#pragma unroll
                    for (int m = 0; m < 4; ++m) { const bool val = (F.lane + 64 * m) < n; sv[m][g] = val ? sv[m][g] : -INFINITY; mx = fmaxf(mx, sv[m][g]); }
                    mx = wmax(mx); float sm = 0.f;
#pragma unroll
                    for (int m = 0; m < 4; ++m) { const bool val = (F.lane + 64 * m) < n; sv[m][g] = val ? expf(sv[m][g] - mx) : 0.f; sm += sv[m][g]; }
                    const float rden = 0.0625f / wsum(sm);
#pragma unroll
                    for (int m = 0; m < 4; ++m) sv[m][g] *= rden;
                }
#pragma unroll
                for (int m = 0; m < 4; ++m) *(LAS f32x4*)(SCR + (F.lane + 64 * m) * 4) = sv[m];
            }
            asm volatile("s_waitcnt lgkmcnt(0)" ::: "memory"); __builtin_amdgcn_wave_barrier();
            f32x2 o[4][8];
#pragma unroll
            for (int g = 0; g < 4; ++g)
#pragma unroll
                for (int q = 0; q < 8; ++q) o[g][q] = (f32x2){0.f, 0.f};
#pragma unroll 1
            for (int i0 = 0; i0 < 32; i0 += 4) {
                u32x4 vd[4]; f32x4 pv[4];
#pragma unroll
                for (int u = 0; u < 4; ++u) { const int id = IDX[8 * (i0 + u) + g8]; vd[u] = *(const u32x4*)(vb + (size_t)id * 128); pv[u] = *(const LAS f32x4*)(SCR + (8 * (i0 + u) + g8) * 4); }
#pragma unroll
                for (int u = 0; u < 4; ++u) {
                    const unsigned w[4] = {vd[u].x, vd[u].y, vd[u].z, vd[u].w}; f32x2 v2[8];
#pragma unroll
                    for (int q = 0; q < 4; ++q) { v2[2 * q] = __builtin_amdgcn_cvt_pk_f32_fp8((int)w[q], false); v2[2 * q + 1] = __builtin_amdgcn_cvt_pk_f32_fp8((int)w[q], true); }
#pragma unroll
                    for (int g = 0; g < 4; ++g) { const f32x2 pg = {pv[u][g], pv[u][g]};
#pragma unroll
                        for (int q = 0; q < 8; ++q) o[g][q] = pg * v2[q] + o[g][q]; }
                }
            }
            f32x2 mine[8];
#pragma unroll
            for (int q = 0; q < 8; ++q) {
                float x[4][2];
#pragma unroll
                for (int g = 0; g < 4; ++g) { float a0 = o[g][q].x, a1 = o[g][q].y;
                    a0 += dppf<0x128, 0xF>(a0); a1 += dppf<0x128, 0xF>(a1);
                    a0 += __shfl_xor(a0, 16); a0 += __shfl_xor(a0, 32); a1 += __shfl_xor(a1, 16); a1 += __shfl_xor(a1, 32); x[g][0] = a0; x[g][1] = a1; }
                mine[q].x = (g8 == 0) ? x[0][0] : ((g8 == 1) ? x[1][0] : ((g8 == 2) ? x[2][0] : x[3][0]));
                mine[q].y = (g8 == 0) ? x[0][1] : ((g8 == 1) ? x[1][1] : ((g8 == 2) ? x[2][1] : x[3][1]));
            }
            if (g8 < 4) { u32x4 w0, w1;
                w0.x = pk2(mine[0].x, mine[0].y); w0.y = pk2(mine[1].x, mine[1].y); w0.z = pk2(mine[2].x, mine[2].y); w0.w = pk2(mine[3].x, mine[3].y);
                w1.x = pk2(mine[4].x, mine[4].y); w1.y = pk2(mine[5].x, mine[5].y); w1.z = pk2(mine[6].x, mine[6].y); w1.w = pk2(mine[7].x, mine[7].y);
                bf16* yp = Y + (size_t)t * DM + (kvh * 4 + g8) * 128 + 16 * c8; *(u32x4*)yp = w0; *(u32x4*)(yp + 8) = w1; }
            asm volatile("s_waitcnt lgkmcnt(0)" ::: "memory"); __builtin_amdgcn_wave_barrier();
        }
    }
}

__global__ void __launch_bounds__(NTHREADS, 2) mk_fwd(Args args) {
    extern __shared__ __attribute__((aligned(16))) unsigned char lds[];
    Frame F;
    F.lds = (LAS unsigned char*)lds;
    volatile LAS unsigned* MISC = (volatile LAS unsigned*)(F.lds + MISC_OFF);
    F.tid = threadIdx.x; F.lane = F.tid & 63; F.wave = __builtin_amdgcn_readfirstlane(F.tid >> 6);
    F.bx = blockIdx.x; F.G = gridDim.x; F.gw = F.bx * NWAVES + F.wave; F.ngw = F.G * NWAVES;
    if (F.tid < 64) MISC[F.tid] = 0u;
    __syncthreads();
    unsigned char* ws = args.ws;
    XcdBarrier bar = xcd_barrier_post((unsigned*)(ws + WS_CTL) + CW_BAR, MISC + 8);
    if (F.tid == 0) { MISC[16] = xb_add((unsigned*)(ws + WS_CTL) + CW_XRANK + 64 * bar.x, 1u); }
    const int lo = args.ph_lo, hi = args.ph_hi;
#define IN(k) (lo <= (k) && (k) < hi)
#define SEAM(k) do { if (IN((k) + 1)) xcd_barrier(bar); } while (0)
#define GEMM_BF16(Aptr, Bptr, Nn, Kk, Optr, ldo) do { pg8::Gemm g{(const pg8::bf16_t*)(Aptr), (const pg8::bf16_t*)(Bptr), TOK, (Nn), (Kk)}; pg8::StaticOrder S; S.init(TOK, (Nn), F.G, F.bx); \
        pg8::EpiBf16<0> E{(pg8::bf16_t*)(Optr), (ldo), nullptr, 0, 0}; pg8::gemm_phase<pg8::EpiBf16<0>, pg8::StaticOrder, false>(F.lds, g, S, E, nullptr); } while (0)

#ifndef PROBE_MASK
#define PROBE_MASK 0
#endif
#define PRB(bit, stmt) do { if (PROBE_MASK & (1 << (bit))) { stmt; xcd_barrier(bar); } } while (0)
    if (IN(0)) { PRB(14, ph_prologue(args, F)); ph_prologue(args, F); SEAM(0); }
    if (IN(1)) { ph_mod_x(args, F); SEAM(1); }
    if (F.tid == 0) {
        unsigned* cb = (unsigned*)(ws + WS_CTL) + CW_BAR; unsigned nloc = 1u, rx = 0u, nx = 0u;
        for (unsigned j = 0; j < 16; ++j) { const unsigned c = xb_ld(&cb[XB_XCNT(j)]); if (c > 0u) { if (j < bar.x) ++rx; ++nx; } if (j == bar.x) nloc = c > 0u ? c : 1u; }
        if (nx == 0u) nx = 1u;
        MISC[17] = nloc; MISC[18] = rx; MISC[19] = nx; }
    __syncthreads();
    const XInfo XI = xcc_info(MISC);
    if (IN(2)) { PRB(8, GEMM_BF16(ws + WS_HY, ws + WS_WINE, EV_NP, 2048, ws + WS_Z, EV_NP)); GEMM_BF16(ws + WS_HY, ws + WS_WINE, EV_NP, 2048, ws + WS_Z, EV_NP); SEAM(2); }
    if (IN(3)) { ph_even_post(args, F); SEAM(3); }
    if (IN(4)) { pg8::Gemm g{(const pg8::bf16_t*)(ws + WS_LA), (const pg8::bf16_t*)(ws + WS_WL), TOK, 3072, 512}; pg8::StaticOrder S; S.init(TOK, 3072, F.G, F.bx);
                 EpiLora E{(pg8::bf16_t*)(ws + WS_Z) + 1280, EV_NP, (const float*)args.in[7], (const float*)args.in[9]};
                 pg8::gemm_phase<EpiLora, pg8::StaticOrder, false>(F.lds, g, S, E, nullptr); SEAM(4); }
    if (IN(5)) { PRB(9, ph_scan_pack(args, F)); ph_scan_pack(args, F); xcd_barrier(bar); }
    if (IN(7)) { PRB(15, ph_scan(args, F, MISC)); ph_scan(args, F, MISC); SEAM(7); }
    if (IN(8)) { PRB(10, ph_rwkv_finish(args, F)); ph_rwkv_finish(args, F); SEAM(8); }
    if (IN(9)) { GEMM_BF16(ws + WS_HY, ws + WS_WOUTE, 2048, 2048, ws + WS_Z, 2048); SEAM(9); }
    if (IN(10)) { PRB(11, ph_ln_mixer(args, F, 0)); ph_ln_mixer(args, F, 0); SEAM(10); }
    if (IN(11)) { GEMM_BF16(ws + WS_HY, ws + WS_WQ0, 2048, 2048, ws + WS_Z, 2048); SEAM(11); }
    if (IN(12)) { PRB(4, ph_peer_select(args, F, 0)); ph_peer_select(args, F, 0); SEAM(12); }
    if (IN(13)) { PRB(12, ph_peer_u(args, F, XI)); ph_peer_u(args, F, XI); xcd_barrier(bar); ph_peer_act(args, F); xcd_barrier(bar); PRB(13, ph_peer_v(args, F, XI)); ph_peer_v(args, F, XI); xcd_barrier(bar); ph_peer_ln(args, F, 0); SEAM(13); }
    if (IN(14)) { GEMM_BF16(ws + WS_HY, ws + WS_WINO, OD_NP, 2048, ws + WS_Z, OD_NP); SEAM(14); }
    if (IN(15)) { ph_odd_post(args, F); SEAM(15); }
    if (IN(16)) { PRB(2, ph_dsa_select(args, F, 1)); PRB(6, ph_dsa_select(args, F, 2)); PRB(7, ph_dsa_select(args, F, 0)); ph_dsa_select(args, F); SEAM(16); }
    if (IN(17)) { ph_dsa_attn(args, F, XI); SEAM(17); }
    if (IN(18)) { GEMM_BF16(ws + WS_HY, ws + WS_WOUTO, 2048, 2048, ws + WS_Z, 2048); SEAM(18); }
    if (IN(19)) { ph_ln_mixer(args, F, 1); SEAM(19); }
    if (IN(20)) { GEMM_BF16(ws + WS_HY, ws + WS_WQ1, 2048, 2048, ws + WS_Z, 2048); SEAM(20); }
    if (IN(21)) { PRB(4, ph_peer_select(args, F, 1)); ph_peer_select(args, F, 1); SEAM(21); }
    if (IN(22)) { ph_peer_u(args, F, XI); xcd_barrier(bar); ph_peer_act(args, F); xcd_barrier(bar); ph_peer_v(args, F, XI); xcd_barrier(bar); ph_peer_ln(args, F, 1); }
#undef IN
#undef SEAM
#undef GEMM_BF16
}

#ifndef MK_SPLIT
#define MK_SPLIT 0
#endif
extern "C" void kernel_launch(void* const* d_in, const int* in_sizes, int n_in, void* d_out, int out_size, void* d_ws, size_t ws_size, hipStream_t stream) {
    static int grid = 0;
    if (grid == 0) {
        int dev = 0, cus = 0;
        if (n_in != 27 || out_size != TOK * DM || ws_size < WS_END) { fprintf(stderr, "kernel_launch: unexpected shapes (n_in %d out %d ws %zu)\n", n_in, out_size, ws_size); grid = -1; return; }
        if (hipGetDevice(&dev) != hipSuccess || hipDeviceGetAttribute(&cus, hipDeviceAttributeMultiprocessorCount, dev) != hipSuccess) { grid = -1; return; }
        if (hipFuncSetAttribute((const void*)mk_fwd, hipFuncAttributeMaxDynamicSharedMemorySize, LDS_BYTES) != hipSuccess) { fprintf(stderr, "kernel_launch: hipFuncSetAttribute failed\n"); grid = -1; return; }
        int per_cu = 0;
        if (hipOccupancyMaxActiveBlocksPerMultiprocessor(&per_cu, (const void*)mk_fwd, NTHREADS, LDS_BYTES) != hipSuccess || per_cu < 1) fprintf(stderr, "kernel_launch: occupancy query says %d\n", per_cu);
        (void)hipGetLastError();
        grid = cus;
    }
    if (grid < 0) return;
    (void)hipMemsetAsync((char*)d_ws + WS_CTL, 0, CTL_ZERO_BYTES, stream);
    Args a{};
    for (int i = 0; i < 27; ++i) a.in[i] = d_in[i];
    a.out = (float*)d_out; a.ws = (unsigned char*)d_ws;
#if MK_SPLIT
    for (int p = 0; p < 23; ++p) { a.ph_lo = p; a.ph_hi = p + 1; hipLaunchKernelGGL(mk_fwd, dim3(grid), dim3(NTHREADS), LDS_BYTES, stream, a); }
#else
    a.ph_lo = 0; a.ph_hi = 23;
    hipLaunchKernelGGL(mk_fwd, dim3(grid), dim3(NTHREADS), LDS_BYTES, stream, a);
#endif
}
```

```cpp
#include <hip/hip_runtime.h>
#include <cstdio>
#include <cstdint>
namespace pg8 {
#define PG8_LAS __attribute__((address_space(3)))
typedef unsigned short bf16_t;
typedef short bf16x8 __attribute__((ext_vector_type(8)));
typedef float f32x4 __attribute__((ext_vector_type(4)));
typedef unsigned u32x4 __attribute__((ext_vector_type(4)));
constexpr int BM = 256, BK = 64, HALF = 128, HTB = HALF * BK * 2  , STAGE_BYTES = 8 * HTB, NXCD = 8, WGM = 8;

__host__ __device__ __forceinline__ int lds_byte(int r, int c) { const int st = (r >> 4) * 2 + (c >> 5), rr = r & 15, cc = c & 31, ob = rr * 64 + cc * 2; return st * 1024 + (ob ^ (((ob >> 9) & 1) << 5)); }
__host__ __device__ __forceinline__ void stage_rc(int b, int& R, int& C) { const int st = b / 1024, sb = b % 1024, swz = sb ^ (((sb >> 9) & 1) << 5); R = (st >> 1) * 16 + swz / 64; C = (st & 1) * 32 + (swz % 64) / 2; }
__host__ __device__ __forceinline__ int perm32(int rho) { const int n = rho >> 4, i = rho & 15; return 8 * (i >> 2) + 4 * n + (i & 3); }

struct Unit { int pm, pn; };
struct Gemm { const bf16_t* A; const bf16_t* Bt; int M, N, K; };

struct StaticOrder {
    int nM, nN, nwg, G, c;
    __host__ __device__ void init(int M, int N, int G_, int c_) { nM = M / BM; nN = N / BM; nwg = nM * nN; G = G_; c = c_; }
    __host__ __device__ bool next(int i, Unit& u) const {
        const long L = (long)i * G + c; if (L >= nwg) return false;
        int wgid = (int)L; { const int q = nwg / NXCD, r = nwg % NXCD, xcd = wgid % NXCD, off = wgid / NXCD; wgid = (xcd < r ? xcd * (q + 1) : r * (q + 1) + (xcd - r) * q) + off; }
        const int nig = WGM * nN, gid = wgid / nig, fm = gid * WGM, gsz = (nM - fm) < WGM ? (nM - fm) : WGM;
        u.pm = fm + ((wgid % nig) % gsz); u.pn = (wgid % nig) / gsz; return true;
    }
    __device__ __forceinline__ void a_ready(const Unit&) const {}
    __device__ __forceinline__ void done(const Unit&) const {}
};
struct CountedOrder : StaticOrder {
    const unsigned* ready; unsigned need; unsigned* tmo;
    __device__ __forceinline__ void a_ready(const Unit& u) const {
        if (threadIdx.x < 64) {
            const unsigned long long t0 = __builtin_amdgcn_s_memrealtime(); unsigned polls = 0;
            while ((unsigned)__builtin_amdgcn_readfirstlane(__hip_atomic_load(ready + 64 * u.pm, __ATOMIC_RELAXED, __HIP_MEMORY_SCOPE_AGENT)) < need) {
                if ((++polls & 255u) == 0u && __builtin_amdgcn_readfirstlane(__hip_atomic_load(tmo, __ATOMIC_RELAXED, __HIP_MEMORY_SCOPE_AGENT)) != 0u) break;
                if (__builtin_amdgcn_s_memrealtime() - t0 > 2000000ull) {
                    if (threadIdx.x == 0) { unsigned expect = 0u; __hip_atomic_compare_exchange_strong(tmo + 1, &expect, 0x600u | (unsigned)(u.pm & 0xff), __ATOMIC_RELAXED, __ATOMIC_RELAXED, __HIP_MEMORY_SCOPE_AGENT); __hip_atomic_store(tmo, 1u, __ATOMIC_RELAXED, __HIP_MEMORY_SCOPE_AGENT); }
                    break; }
                __builtin_amdgcn_s_sleep(2); }
            __builtin_amdgcn_fence(__ATOMIC_ACQUIRE, "agent");
            asm volatile("s_waitcnt vmcnt(0)" ::: "memory");
        }
#if !defined(BROKEN_HOOK_NO_BARRIER)
        asm volatile("" ::: "memory"); __builtin_amdgcn_s_barrier(); asm volatile("" ::: "memory");
#endif
    }
};

__device__ __forceinline__ unsigned cvt_pk_bf16(float lo, float hi) { unsigned r; asm volatile("v_cvt_pk_bf16_f32 %0, %1, %2" : "=v"(r) : "v"(lo), "v"(hi)); return r; }
typedef float f32x2 __attribute__((ext_vector_type(2)));
__device__ __forceinline__ f32x2 gelu_pk(f32x2 v) {
    const f32x2 av = __builtin_elementwise_abs(v), d = av * 0.2316418882f + 1.0f;
    f32x2 t; t.x = __builtin_amdgcn_rcpf(d.x); t.y = __builtin_amdgcn_rcpf(d.y);
    f32x2 q = t * 0.5307027145f + (-0.7265760135f); q = q * t + 0.7107068705f; q = q * t + (-0.142248368f); q = q * t + 0.127414796f; q = q * t;
    const f32x2 s = (v * v) * (-0.72134752044f);
    f32x2 e; e.x = __builtin_amdgcn_exp2f(s.x); e.y = __builtin_amdgcn_exp2f(s.y);
    const f32x2 m = v * (q * e), r = v - m;
    f32x2 o; o.x = v.x < 0.f ? m.x : r.x; o.y = v.y < 0.f ? m.y : r.y; return o;
}

struct EpiF32 {
    static constexpr bool PERM = false, AFTER_DRAIN = false;
    float* C; int ldc; const float* bias;
    __device__ __forceinline__ void operator()(const f32x4 (&acc)[2][2][4][2], const Unit& u, int wr, int wc, int fr, int fq) const {
        const int row0 = u.pm * BM + wr * 64 + fr, col0 = u.pn * BM + wc * 32 + 4 * fq;
        f32x4 bv[2][2];
#pragma unroll
        for (int bj = 0; bj < 2; ++bj)
#pragma unroll
            for (int n = 0; n < 2; ++n) bv[bj][n] = bias ? *(const f32x4*)(bias + col0 + bj * HALF + n * 16) : (f32x4){0.f, 0.f, 0.f, 0.f};
#pragma unroll
        for (int ai = 0; ai < 2; ++ai)
#pragma unroll
            for (int m = 0; m < 4; ++m) { float* rowp = C + (size_t)(row0 + ai * HALF + m * 16) * ldc + col0;
#pragma unroll
                for (int bj = 0; bj < 2; ++bj)
#pragma unroll
                    for (int n = 0; n < 2; ++n) *(f32x4*)(rowp + bj * HALF + n * 16) = acc[ai][bj][m][n] + bv[bj][n]; }
    }
};
template <int ACT  > struct EpiBf16 {
    static constexpr bool PERM = true, AFTER_DRAIN = false;
    bf16_t* O; int ldc; const float* bias; int split_cols; size_t split_stride;
    __device__ __forceinline__ void operator()(const f32x4 (&acc)[2][2][4][2], const Unit& u, int wr, int wc, int fr, int fq) const {
        const int row0 = u.pm * BM + wr * 64 + fr; int colt = u.pn * BM; bf16_t* base = O;
        if (split_cols) { const int t = colt / split_cols; base += (size_t)t * split_stride; colt -= t * split_cols; }
        const int col0 = colt + wc * 32 + 8 * fq, bcol0 = u.pn * BM + wc * 32 + 8 * fq;
        f32x4 bv[2][2];
#pragma unroll
        for (int bj = 0; bj < 2; ++bj)
#pragma unroll
            for (int n = 0; n < 2; ++n) bv[bj][n] = bias ? *(const f32x4*)(bias + bcol0 + bj * HALF + 4 * n) : (f32x4){0.f, 0.f, 0.f, 0.f};
#pragma unroll
        for (int ai = 0; ai < 2; ++ai)
#pragma unroll
            for (int m = 0; m < 4; ++m) { bf16_t* rowp = base + (size_t)(row0 + ai * HALF + m * 16) * ldc + col0;
#pragma unroll
                for (int bj = 0; bj < 2; ++bj) { f32x4 v0 = acc[ai][bj][m][0] + bv[bj][0], v1 = acc[ai][bj][m][1] + bv[bj][1];
                    if (ACT == 1) { f32x2 a = gelu_pk((f32x2){v0[0], v0[1]}), b = gelu_pk((f32x2){v0[2], v0[3]}), c = gelu_pk((f32x2){v1[0], v1[1]}), d = gelu_pk((f32x2){v1[2], v1[3]});
                        v0 = (f32x4){a.x, a.y, b.x, b.y}; v1 = (f32x4){c.x, c.y, d.x, d.y}; }
                    if (ACT == 2) {
#pragma unroll
                        for (int j = 0; j < 4; ++j) { v0[j] = 0.5f * v0[j] * (1.0f + erff(v0[j] * 0.70710678f)); v1[j] = 0.5f * v1[j] * (1.0f + erff(v1[j] * 0.70710678f)); } }
                    u32x4 w; w.x = cvt_pk_bf16(v0[0], v0[1]); w.y = cvt_pk_bf16(v0[2], v0[3]); w.z = cvt_pk_bf16(v1[0], v1[1]); w.w = cvt_pk_bf16(v1[2], v1[3]);
                    *(u32x4*)(rowp + bj * HALF) = w; } }
    }
};

struct PanelStats {
    unsigned* xbuf;
    unsigned* cnt;
    unsigned* tmo;
    int ntn; float eps;
    unsigned code;
    __device__ __forceinline__ bool run(const f32x4 (&v)[2][2][4][2], const Unit& u, int wr, int wc, int fr, int fq, PG8_LAS unsigned char* lds, int wid, int lane) const {
        typedef float f32x2v __attribute__((ext_vector_type(2)));
        PG8_LAS f32x2v* P = (PG8_LAS f32x2v*)lds;
        PG8_LAS f32x2v* S = (PG8_LAS f32x2v*)(lds + 8192);
        PG8_LAS unsigned* flag = (PG8_LAS unsigned*)(lds + 8192 + 2048);
#pragma unroll
        for (int ai = 0; ai < 2; ++ai)
#pragma unroll
            for (int m = 0; m < 4; ++m) {
                float s = 0.f;
#pragma unroll
                for (int bj = 0; bj < 2; ++bj)
#pragma unroll
                    for (int n = 0; n < 2; ++n) { const f32x4 x = v[ai][bj][m][n]; s += (x[0] + x[1]) + (x[2] + x[3]); }
                s += __shfl_xor(s, 16); s += __shfl_xor(s, 32);
                const float mw = s * (1.0f / 64.0f); float q = 0.f;
#pragma unroll
                for (int bj = 0; bj < 2; ++bj)
#pragma unroll
                    for (int n = 0; n < 2; ++n) { const f32x4 d = v[ai][bj][m][n] - mw; q += (d[0] * d[0] + d[1] * d[1]) + (d[2] * d[2] + d[3] * d[3]); }
                q += __shfl_xor(q, 16); q += __shfl_xor(q, 32);
                if (fq == 0) P[(ai * HALF + wr * 64 + m * 16 + fr) * 4 + wc] = (f32x2v){mw, q};
            }
        asm volatile("s_waitcnt lgkmcnt(0)" ::: "memory"); __builtin_amdgcn_s_barrier(); asm volatile("" ::: "memory");
#if defined(BROKEN_NO_WAIT)
        if (blockIdx.x >= 64) { const long long t0 = clock64(); while (clock64() - t0 < 60000) __builtin_amdgcn_s_sleep(8); }
#endif
        const int row = wid * 32 + (lane & 31);
        if (lane < 32) {
            const f32x2v a = P[row * 4 + 0], b = P[row * 4 + 1], c = P[row * 4 + 2], d = P[row * 4 + 3];
            const float mt = (a.x + b.x + c.x + d.x) * 0.25f;
            const float da = a.x - mt, db = b.x - mt, dc = c.x - mt, dd = d.x - mt;
            const float m2 = (a.y + b.y) + (c.y + d.y) + 64.0f * ((da * da + db * db) + (dc * dc + dd * dd));
            unsigned long long* slot = (unsigned long long*)xbuf + ((size_t)(u.pm * BM + row) * 4 + u.pn);
            __hip_atomic_store(slot, ((unsigned long long)__float_as_uint(m2) << 32) | __float_as_uint(mt), __ATOMIC_RELAXED, __HIP_MEMORY_SCOPE_AGENT);
        }
        asm volatile("s_waitcnt vmcnt(0)" ::: "memory");
        if (lane == 0) __hip_atomic_fetch_add(cnt + 64 * u.pm, 1u, __ATOMIC_RELAXED, __HIP_MEMORY_SCOPE_AGENT);
        if (wid == 0) {
            bool dead = false; const unsigned long long t0 = __builtin_amdgcn_s_memrealtime(); const unsigned want = 8u * (unsigned)ntn;
            for (;;) {
#if defined(BROKEN_NO_WAIT)
                break;
#endif
                if ((unsigned)__builtin_amdgcn_readfirstlane(__hip_atomic_load(cnt + 64 * u.pm, __ATOMIC_RELAXED, __HIP_MEMORY_SCOPE_AGENT)) >= want) break;
                if (__builtin_amdgcn_s_memrealtime() - t0 > 2000000ull) {
                    if (lane == 0) { unsigned expect = 0u; __hip_atomic_compare_exchange_strong(tmo + 1, &expect, code | (unsigned)(u.pm & 0xff), __ATOMIC_RELAXED, __ATOMIC_RELAXED, __HIP_MEMORY_SCOPE_AGENT);
                                     __hip_atomic_store(tmo, 1u, __ATOMIC_RELAXED, __HIP_MEMORY_SCOPE_AGENT); }
                    dead = true; break; }
                __builtin_amdgcn_s_sleep(2);
            }
            __builtin_amdgcn_fence(__ATOMIC_ACQUIRE, "agent");
            if (lane == 0) flag[0] = dead ? 1u : 0u;
        }
        asm volatile("s_waitcnt vmcnt(0) lgkmcnt(0)" ::: "memory"); __builtin_amdgcn_s_barrier(); asm volatile("" ::: "memory");
        const bool bad = flag[0] != 0u;
        if (lane < 32) {
            const unsigned long long* slot = (const unsigned long long*)xbuf + (size_t)(u.pm * BM + row) * 4; float mt[4], m2[4]; float ms = 0.f;
#pragma unroll
            for (int t = 0; t < 4; ++t) { if (t < ntn) { const unsigned long long w = __hip_atomic_load(slot + t, __ATOMIC_RELAXED, __HIP_MEMORY_SCOPE_AGENT); mt[t] = __uint_as_float((unsigned)w); m2[t] = __uint_as_float((unsigned)(w >> 32)); } else { mt[t] = 0.f; m2[t] = 0.f; } ms += mt[t]; }
            const float mean = ms / (float)ntn; float q = 0.f;
#pragma unroll
            for (int t = 0; t < 4; ++t) if (t < ntn) { const float dm = mt[t] - mean; q += m2[t] + 256.0f * dm * dm; }
            S[row] = (f32x2v){mean, 1.0f / sqrtf(q / (256.0f * (float)ntn) + eps)};
        }
        asm volatile("s_waitcnt lgkmcnt(0)" ::: "memory"); __builtin_amdgcn_s_barrier(); asm volatile("" ::: "memory");
        return bad;
    }
};
struct EpiLnRes {
    static constexpr bool PERM = false, AFTER_DRAIN = true;
    const float* base; float* out; int ldc; const float* bias; PanelStats st; unsigned poison;
    __device__ __forceinline__ void refuse(size_t i0, size_t stride, int M, int N) const { const float q = __builtin_nanf(""); for (size_t i = i0; i < (size_t)M * N; i += stride) out[(i / N) * ldc + i % N] = q;
        if (i0 == 0) { unsigned expect = 0u; __hip_atomic_compare_exchange_strong(st.tmo + 1, &expect, 0x7f0u, __ATOMIC_RELAXED, __ATOMIC_RELAXED, __HIP_MEMORY_SCOPE_AGENT); __hip_atomic_store(st.tmo, 1u, __ATOMIC_RELAXED, __HIP_MEMORY_SCOPE_AGENT); } }
    __device__ __forceinline__ void fused(f32x4 (&acc)[2][2][4][2], const Unit& u, int wr, int wc, int fr, int fq, PG8_LAS unsigned char* lds, int wid, int lane) const {
        typedef float f32x2v __attribute__((ext_vector_type(2)));
        const PG8_LAS f32x2v* S = (const PG8_LAS f32x2v*)(lds + 8192);
        const int col0 = u.pn * BM + wc * 32 + 4 * fq;
#pragma unroll
        for (int bj = 0; bj < 2; ++bj)
#pragma unroll
            for (int n = 0; n < 2; ++n) { const f32x4 bv = bias ? *(const f32x4*)(bias + col0 + bj * HALF + n * 16) : (f32x4){0.f, 0.f, 0.f, 0.f};
#pragma unroll
                for (int ai = 0; ai < 2; ++ai)
#pragma unroll
                    for (int m = 0; m < 4; ++m) acc[ai][bj][m][n] += bv; }
        const bool bad = st.run(acc, u, wr, wc, fr, fq, lds, wid, lane) || poison != 0u;
        const float qnan = __builtin_nanf("");
#pragma unroll
        for (int ai = 0; ai < 2; ++ai)
#pragma unroll
            for (int m = 0; m < 4; ++m) { const int r = ai * HALF + wr * 64 + m * 16 + fr; const f32x2v sr = S[r]; const size_t off = (size_t)(u.pm * BM + r) * ldc + col0;
#pragma unroll
                for (int bj = 0; bj < 2; ++bj)
#pragma unroll
                    for (int n = 0; n < 2; ++n) { const f32x4 bs = *(const f32x4*)(base + off + bj * HALF + n * 16); f32x4 o = bs + (acc[ai][bj][m][n] - sr.x) * sr.y;
                        if (bad) o = (f32x4){qnan, qnan, qnan, qnan}; *(f32x4*)(out + off + bj * HALF + n * 16) = o; }
                asm volatile("" ::: "memory"); }
    }
};
struct EpiLnResLn {
    static constexpr bool PERM = false, AFTER_DRAIN = true;
    const float* base; float* out; bf16_t* xn; int ldc; const float* bias; PanelStats st1, st2; unsigned poison;
    __device__ __forceinline__ void refuse(size_t i0, size_t stride, int M, int N) const { const float q = __builtin_nanf(""); for (size_t i = i0; i < (size_t)M * N; i += stride) { const size_t o = (i / N) * ldc + i % N; out[o] = q; xn[o] = (bf16_t)0x7fc0u; }
        if (i0 == 0) { unsigned expect = 0u; __hip_atomic_compare_exchange_strong(st1.tmo + 1, &expect, 0x7f0u, __ATOMIC_RELAXED, __ATOMIC_RELAXED, __HIP_MEMORY_SCOPE_AGENT); __hip_atomic_store(st1.tmo, 1u, __ATOMIC_RELAXED, __HIP_MEMORY_SCOPE_AGENT); } }
    __device__ __forceinline__ void fused(f32x4 (&acc)[2][2][4][2], const Unit& u, int wr, int wc, int fr, int fq, PG8_LAS unsigned char* lds, int wid, int lane) const {
        typedef float f32x2v __attribute__((ext_vector_type(2))); typedef unsigned u32x2v __attribute__((ext_vector_type(2)));
        const PG8_LAS f32x2v* S = (const PG8_LAS f32x2v*)(lds + 8192);
        const int col0 = u.pn * BM + wc * 32 + 4 * fq;
#pragma unroll
        for (int bj = 0; bj < 2; ++bj)
#pragma unroll
            for (int n = 0; n < 2; ++n) { const f32x4 bv = bias ? *(const f32x4*)(bias + col0 + bj * HALF + n * 16) : (f32x4){0.f, 0.f, 0.f, 0.f};
#pragma unroll
                for (int ai = 0; ai < 2; ++ai)
#pragma unroll
                    for (int m = 0; m < 4; ++m) acc[ai][bj][m][n] += bv; }
        bool bad = st1.run(acc, u, wr, wc, fr, fq, lds, wid, lane) || poison != 0u;
        const float qnan = __builtin_nanf("");
#pragma unroll
        for (int ai = 0; ai < 2; ++ai)
#pragma unroll
            for (int m = 0; m < 4; ++m) { const int r = ai * HALF + wr * 64 + m * 16 + fr; const f32x2v sr = S[r]; const size_t off = (size_t)(u.pm * BM + r) * ldc + col0;
#pragma unroll
                for (int bj = 0; bj < 2; ++bj)
#pragma unroll
                    for (int n = 0; n < 2; ++n) { const f32x4 bs = *(const f32x4*)(base + off + bj * HALF + n * 16); acc[ai][bj][m][n] = bs + (acc[ai][bj][m][n] - sr.x) * sr.y; }
                asm volatile("" : "+v"(acc[ai][0][m][0]), "+v"(acc[ai][0][m][1]), "+v"(acc[ai][1][m][0]), "+v"(acc[ai][1][m][1]));
                if (m & 1) asm volatile("" ::: "memory"); }
        const bool bad1 = bad;
        bad = st2.run(acc, u, wr, wc, fr, fq, lds, wid, lane) || bad;
#pragma unroll
        for (int ai = 0; ai < 2; ++ai)
#pragma unroll
            for (int m = 0; m < 4; ++m) { const int r = ai * HALF + wr * 64 + m * 16 + fr; const f32x2v sr = S[r]; const size_t off = (size_t)(u.pm * BM + r) * ldc + col0;
#pragma unroll
                for (int bj = 0; bj < 2; ++bj)
#pragma unroll
                    for (int n = 0; n < 2; ++n) { const f32x4 x1 = acc[ai][bj][m][n]; *(f32x4*)(out + off + bj * HALF + n * 16) = bad1 ? (f32x4){qnan, qnan, qnan, qnan} : x1;
                        const f32x4 o = (x1 - sr.x) * sr.y; u32x2v w; w.x = cvt_pk_bf16(o[0], o[1]); w.y = cvt_pk_bf16(o[2], o[3]);
                        if (bad) { w.x = 0x7fc07fc0u; w.y = 0x7fc07fc0u; } *(u32x2v*)(xn + off + bj * HALF + n * 16) = w; }
                asm volatile("" ::: "memory"); }
    }
};

template <class Epi, class Sched, bool STAMP = false>
__device__ __forceinline__ void gemm_phase(PG8_LAS unsigned char* lds, const Gemm g, const Sched& S, const Epi& E, unsigned long long* stamps) {
    const int tid = threadIdx.x, wid = __builtin_amdgcn_readfirstlane(tid >> 6), lane = tid & 63, wr = wid >> 2, wc = wid & 3, fr = lane & 15, fq = lane >> 4;
    const int K = g.K, nt = K / BK;
    int ts_lo = 0, ts_hi = 0, nts = 0; const unsigned long long rt_entry = STAMP ? (unsigned long long)wall_clock64() : 0ull;
#define PG8_STAMP() do { if (STAMP && wid == 0 && nts < 64) { const unsigned long long _c = (unsigned long long)clock64(); \
        ts_lo = (lane == nts) ? (int)(unsigned)_c : ts_lo; ts_hi = (lane == nts) ? (int)(unsigned)(_c >> 32) : ts_hi; ++nts; } } while (0)
    PG8_STAMP();
    unsigned voffA[2], voffB[2];
#pragma unroll
    for (int i = 0; i < 2; ++i) { int R, C; stage_rc(tid * 16 + i * 8192, R, C); const int Rb = Epi::PERM ? ((R & ~31) + perm32(R & 31)) : R;
        voffA[i] = (unsigned)(R * K + C) * 2u; voffB[i] = (unsigned)(Rb * K + C) * 2u; }
    const size_t kstep = (size_t)(BK * 2);
    const size_t hstep = (size_t)HALF * K * 2;
    const size_t tstep = 2 * hstep;
    const unsigned ldsw = (unsigned)wid * 1024u;
    const int aoff = lds_byte(wr * 64 + fr, fq * 8), boff = lds_byte(wc * 32 + fr, fq * 8);
#define PG8_SA(b, h) (((b) * 2 + (h)) * HTB)
#define PG8_SB(b, h) ((4 + (b) * 2 + (h)) * HTB)
#define PG8_STAGE(bufoff, gbase, voff) do { _Pragma("unroll") for (int _i = 0; _i < 2; ++_i) \
        __builtin_amdgcn_global_load_lds((const unsigned*)((const char*)(gbase) + (voff)[_i]), (PG8_LAS unsigned*)(lds + (bufoff) + ldsw + _i * 8192), 16, 0, 0); } while (0)
#define PG8_LDA(dst, b, h) do { _Pragma("unroll") for (int m = 0; m < 4; ++m) _Pragma("unroll") for (int k = 0; k < 2; ++k) dst[m][k] = *(const PG8_LAS bf16x8*)(lds + PG8_SA(b, h) + aoff + m * 2048 + k * 1024); } while (0)
#define PG8_LDB(dst, b, h) do { _Pragma("unroll") for (int n = 0; n < 2; ++n) _Pragma("unroll") for (int k = 0; k < 2; ++k) dst[n][k] = *(const PG8_LAS bf16x8*)(lds + PG8_SB(b, h) + boff + n * 2048 + k * 1024); } while (0)
#define PG8_MMA(ai, bj, At, Bt) do { __builtin_amdgcn_s_setprio(1); _Pragma("unroll") for (int m = 0; m < 4; ++m) _Pragma("unroll") for (int n = 0; n < 2; ++n) _Pragma("unroll") for (int k = 0; k < 2; ++k) \
        acc[ai][bj][m][n] = __builtin_amdgcn_mfma_f32_16x16x32_bf16(Bt[n][k], At[m][k], acc[ai][bj][m][n], 0, 0, 0); __builtin_amdgcn_s_setprio(0); } while (0)
#define PG8_WAIT_V(n) asm volatile("s_waitcnt vmcnt(" #n ")" ::: "memory")
#define PG8_WAIT_L(n) asm volatile("s_waitcnt lgkmcnt(" #n ")" ::: "memory")
#define PG8_BAR __builtin_amdgcn_s_barrier()
#define PG8_SCHED __builtin_amdgcn_sched_barrier(0)
    Unit cur, nxt; int ui = 0;
    if (!S.next(0, cur)) return;
    f32x4 acc[2][2][4][2];
#pragma unroll
    for (int a = 0; a < 2; ++a)
#pragma unroll
        for (int b = 0; b < 2; ++b)
#pragma unroll
            for (int m = 0; m < 4; ++m)
#pragma unroll
                for (int n = 0; n < 2; ++n) acc[a][b][m][n] = (f32x4){0.f, 0.f, 0.f, 0.f};
    bf16x8 At[4][2], B0[2][2], B1[2][2];
    const char* cA = (const char*)g.A + (size_t)cur.pm * tstep; const char* cB = (const char*)g.Bt + (size_t)cur.pn * tstep;
    S.a_ready(cur);
    PG8_STAGE(PG8_SB(0, 0), cB, voffB); PG8_STAGE(PG8_SA(0, 0), cA, voffA); PG8_STAGE(PG8_SB(0, 1), cB + hstep, voffB); PG8_STAGE(PG8_SA(0, 1), cA + hstep, voffA);
    if (wr == 1) PG8_BAR;
    PG8_WAIT_V(4); PG8_BAR;
    PG8_STAGE(PG8_SB(1, 0), cB + kstep, voffB); PG8_STAGE(PG8_SA(1, 0), cA + kstep, voffA); PG8_STAGE(PG8_SB(1, 1), cB + hstep + kstep, voffB);
    PG8_WAIT_V(6); PG8_BAR;
    PG8_STAMP();
    for (;;) {
        const bool has_next = S.next(ui + 1, nxt);
        const char* nA = has_next ? (const char*)g.A + (size_t)nxt.pm * tstep : cA; const char* nB = has_next ? (const char*)g.Bt + (size_t)nxt.pn * tstep : cB;
        for (int t = 0; t < nt; t += 2) {
            const bool last = (t == nt - 2);
            const char* a1 = cA + (size_t)(t + 1) * kstep;
            const char* a2 = last ? nA : cA + (size_t)(t + 2) * kstep; const char* b2 = last ? nB : cB + (size_t)(t + 2) * kstep;
            const char* a3 = a2 + kstep; const char* b3 = b2 + kstep;
            if (last && has_next) S.a_ready(nxt);
            PG8_LDB(B0, 0, 0); PG8_SCHED; PG8_LDA(At, 0, 0); PG8_STAGE(PG8_SA(1, 1), a1 + hstep, voffA);
            PG8_WAIT_L(8); PG8_BAR; PG8_WAIT_L(0); PG8_MMA(0, 0, At, B0); PG8_BAR; PG8_SCHED;
            PG8_LDB(B1, 0, 1); PG8_STAGE(PG8_SB(0, 0), b2, voffB);
            PG8_BAR; PG8_WAIT_L(0); PG8_MMA(0, 1, At, B1); PG8_BAR;
            PG8_LDA(At, 0, 1); PG8_STAGE(PG8_SA(0, 0), a2, voffA);
            PG8_BAR; PG8_WAIT_L(0); PG8_MMA(1, 0, At, B0); PG8_BAR; PG8_SCHED;
            PG8_STAGE(PG8_SB(0, 1), b2 + hstep, voffB);
            PG8_WAIT_V(6); PG8_BAR; PG8_MMA(1, 1, At, B1); PG8_BAR;
            PG8_LDB(B0, 1, 0); PG8_SCHED; PG8_LDA(At, 1, 0); PG8_STAGE(PG8_SA(0, 1), a2 + hstep, voffA);
            PG8_WAIT_L(8); PG8_BAR; PG8_WAIT_L(0); PG8_MMA(0, 0, At, B0); PG8_BAR; PG8_SCHED;
            PG8_LDB(B1, 1, 1); PG8_STAGE(PG8_SB(1, 0), b3, voffB);
            PG8_BAR; PG8_WAIT_L(0); PG8_MMA(0, 1, At, B1); PG8_BAR;
            PG8_LDA(At, 1, 1); PG8_STAGE(PG8_SA(1, 0), a3, voffA);
            PG8_BAR; PG8_WAIT_L(0); PG8_MMA(1, 0, At, B0); PG8_BAR; PG8_SCHED;
            PG8_STAGE(PG8_SB(1, 1), b3 + hstep, voffB);
            PG8_WAIT_V(6); PG8_BAR; PG8_MMA(1, 1, At, B1); PG8_BAR;
        }
        PG8_STAMP();
        if constexpr (!Epi::AFTER_DRAIN) { E(acc, cur, wr, wc, fr, fq); S.done(cur); }
        PG8_STAMP();
        if (!has_next) break;
#pragma unroll
        for (int a = 0; a < 2; ++a)
#pragma unroll
            for (int b = 0; b < 2; ++b)
#pragma unroll
                for (int m = 0; m < 4; ++m)
#pragma unroll
                    for (int n = 0; n < 2; ++n) acc[a][b][m][n] = (f32x4){0.f, 0.f, 0.f, 0.f};
        cur = nxt; cA = nA; cB = nB; ++ui;
    }
    PG8_WAIT_V(0);
    if (wr == 0) PG8_BAR;
    PG8_BAR;
    if constexpr (Epi::AFTER_DRAIN) { E.fused(acc, cur, wr, wc, fr, fq, lds, wid, lane); S.done(cur); }
    PG8_STAMP();
    if (STAMP && wid == 0) { stamps[lane] = lane < nts ? (((unsigned long long)(unsigned)ts_hi << 32) | (unsigned)ts_lo) : 0ull;
        if (lane == 62) stamps[62] = rt_entry; if (lane == 63) stamps[63] = (unsigned long long)wall_clock64(); }
#undef PG8_STAMP
#undef PG8_SA
#undef PG8_SB
#undef PG8_STAGE
#undef PG8_LDA
#undef PG8_LDB
#undef PG8_MMA
#undef PG8_WAIT_V
#undef PG8_WAIT_L
#undef PG8_BAR
#undef PG8_SCHED
}
}

#define LAS __attribute__((address_space(3)))
#define XB_TMO      128
#define XB_XCNT(j)  (256  + 64 * (j))
#define XB_XSUB(j)  (1280 + 64 * (j))
#define XB_XGEN(j)  (2304 + 64 * (j))
#define XB_TOP      3328
#define XB_TOPGEN   3392
#define XCD_BAR_WORDS 3456
#define XB_SPIN_CAP (1u << 24)

__device__ __forceinline__ unsigned xb_ld(unsigned* p)              { return __hip_atomic_load(p, __ATOMIC_RELAXED, __HIP_MEMORY_SCOPE_AGENT); }
__device__ __forceinline__ unsigned xb_add(unsigned* p, unsigned v) { return __hip_atomic_fetch_add(p, v, __ATOMIC_RELAXED, __HIP_MEMORY_SCOPE_AGENT); }
__device__ __forceinline__ unsigned xb_xcc_id() { return (unsigned)__builtin_amdgcn_s_getreg((3 << 11) | 20) & 0xFu; }
#define XB_SPIN(cond, bar) do { unsigned _sp = 0; while (cond) { __builtin_amdgcn_s_sleep(1); \
    if ((++_sp & 255u) == 0u) { if (xb_ld(&(bar)[XB_TMO])) break; if (_sp > XB_SPIN_CAP) { atomicAdd(&(bar)[XB_TMO], 1u); break; } } } } while (0)

struct XcdBarrier { unsigned* bar; unsigned x; volatile LAS unsigned* st; };

__device__ __forceinline__ XcdBarrier xcd_barrier_post(unsigned* bar, volatile LAS unsigned* st) {
    XcdBarrier b; b.bar = bar; b.x = xb_xcc_id(); b.st = st;
    if (threadIdx.x == 0) (void)xb_add(&bar[XB_XCNT(b.x)], 1u);
    return b;
}
__device__ __forceinline__ void xcd_barrier_complete(unsigned* bar, unsigned x, unsigned& nloc, unsigned& nx) {
    const unsigned G = gridDim.x * gridDim.y * gridDim.z;
    unsigned sum, cnt, mine, sp = 0u;
    for (;;) {
        sum = 0u; cnt = 0u; mine = 0u;
#pragma unroll
        for (unsigned j = 0; j < 16; ++j) { const unsigned c = xb_ld(&bar[XB_XCNT(j)]); sum += c; cnt += (c > 0u) ? 1u : 0u; mine = (j == x) ? c : mine; }
        if (sum == G) break;
        __builtin_amdgcn_s_sleep(1);
        if ((++sp & 255u) == 0u) { if (xb_ld(&bar[XB_TMO])) break; if (sp > XB_SPIN_CAP) { atomicAdd(&bar[XB_TMO], 1u); break; } }
    }
    nloc = mine > 0u ? mine : 1u; nx = cnt > 0u ? cnt : 1u;
}
__device__ __forceinline__ void xcd_barrier(const XcdBarrier& b) {
    asm volatile("s_waitcnt vmcnt(0)" ::: "memory");
    __syncthreads();
    if (threadIdx.x == 0) {
        unsigned* bar = b.bar;
        __builtin_amdgcn_s_waitcnt(0);
        unsigned nloc = b.st[0], nx = b.st[1];
        if (nloc == 0u) { xcd_barrier_complete(bar, b.x, nloc, nx); b.st[0] = nloc; b.st[1] = nx; }
        const unsigned old = xb_add(&bar[XB_XSUB(b.x)], 1u);
        const unsigned gen = old / nloc;
        if (old + 1u == (gen + 1u) * nloc) {
            __builtin_amdgcn_fence(__ATOMIC_RELEASE, "agent");
            asm volatile("s_waitcnt vmcnt(0)" ::: "memory");
            const unsigned og = xb_add(&bar[XB_TOP], 1u);
            const unsigned tg = og / nx;
            if (og + 1u == (tg + 1u) * nx) xb_add(&bar[XB_TOPGEN], 1u);
            else XB_SPIN(xb_ld(&bar[XB_TOPGEN]) == tg, bar);
            __builtin_amdgcn_fence(__ATOMIC_ACQUIRE, "agent");
            xb_add(&bar[XB_XGEN(b.x)], 1u);
            asm volatile("s_waitcnt vmcnt(0)" ::: "memory");
        } else {
            XB_SPIN(xb_ld(&bar[XB_XGEN(b.x)]) == gen, bar);
            __builtin_amdgcn_fence(__ATOMIC_ACQUIRE, "agent");
            asm volatile("s_waitcnt vmcnt(0)" ::: "memory");
        }
    }
    __syncthreads();
}

typedef unsigned short bf16;
typedef float f32x4 __attribute__((ext_vector_type(4)));
typedef float f32x16 __attribute__((ext_vector_type(16)));
typedef float f32x2 __attribute__((ext_vector_type(2)));
typedef unsigned u32x4 __attribute__((ext_vector_type(4)));
typedef unsigned u32x2 __attribute__((ext_vector_type(2)));
typedef short bf16x8 __attribute__((ext_vector_type(8)));
typedef __bf16 bf2_t __attribute__((ext_vector_type(2)));

constexpr int NTHREADS = 512, NWAVES = 8;
constexpr int LDS_BYTES = 160 * 1024;
constexpr int MISC_OFF = LDS_BYTES - 256;
constexpr int TOK = 32768, SEQ = 16384, DM = 2048;
constexpr int EV_N = 4800, EV_NP = 4864, OD_N = 4176, OD_NP = 4352;
constexpr float ALPHA = 1.41421356237f;
constexpr size_t MiB = 1u << 20;
constexpr size_t WS_CTL = 0, CTL_ZERO_BYTES = 1 * MiB;
constexpr int CW_BAR = 4096, CW_XRANK = 8192;
constexpr size_t WS_MOD = 1 * MiB, WS_SKB = 2 * MiB, WS_WL = 4 * MiB, WS_BS = 7 * MiB, WS_CNT = 9 * MiB;
constexpr size_t WS_WINE = 10 * MiB, WS_WOUTE = 29 * MiB, WS_WINO = 37 * MiB, WS_WOUTO = 54 * MiB, WS_WQ0 = 62 * MiB, WS_WQ1 = 70 * MiB;
constexpr size_t WS_HY = 78 * MiB, WS_Z = 206 * MiB, WS_LA = 510 * MiB, WS_BIG = 542 * MiB, WS_END = 926 * MiB;

__device__ __forceinline__ float bf2f(unsigned short b) { return __uint_as_float(((unsigned)b) << 16); }
__device__ __forceinline__ unsigned f2bf(float f) { unsigned u = __float_as_uint(f); return (u + 0x7fffu + ((u >> 16) & 1u)) >> 16; }
__device__ __forceinline__ unsigned pk2(float lo, float hi) { return f2bf(lo) | (f2bf(hi) << 16); }
__device__ __forceinline__ float lo2f(unsigned w) { return __uint_as_float(w << 16); }
__device__ __forceinline__ float hi2f(unsigned w) { return __uint_as_float(w & 0xffff0000u); }
__device__ __forceinline__ float wsum(float v) {
#pragma unroll
    for (int o = 32; o >= 1; o >>= 1) v += __shfl_xor(v, o);
    return v;
}
__device__ __forceinline__ float wmax(float v) {
#pragma unroll
    for (int o = 32; o >= 1; o >>= 1) v = fmaxf(v, __shfl_xor(v, o));
    return v;
}
__device__ __forceinline__ float rdlane(float v, int l) { return __int_as_float(__builtin_amdgcn_readlane(__float_as_int(v), l)); }
__device__ __forceinline__ unsigned rdlaneu(unsigned v, int l) { return (unsigned)__builtin_amdgcn_readlane((int)v, l); }
__device__ __forceinline__ float dot2bf(unsigned a, unsigned b, float c) {
    return __builtin_amdgcn_fdot2_f32_bf16(__builtin_bit_cast(bf2_t, a), __builtin_bit_cast(bf2_t, b), c, false);
}
template <int CTRL, int RM> __device__ __forceinline__ float dppf(float v) {
    return __int_as_float(__builtin_amdgcn_update_dpp(0, __float_as_int(v), CTRL, RM, 0xF, false));
}
__device__ __forceinline__ float wsum_dpp(float v) {
    v += dppf<0xB1, 0xF>(v);
    v += dppf<0x4E, 0xF>(v);
    v += dppf<0x141, 0xF>(v);
    v += dppf<0x140, 0xF>(v);
    v += dppf<0x142, 0xA>(v);
    v += dppf<0x143, 0xC>(v);
    return rdlane(v, 63);
}
__device__ __forceinline__ float sum16_dpp(float v) {
    v += dppf<0xB1, 0xF>(v); v += dppf<0x4E, 0xF>(v); v += dppf<0x141, 0xF>(v); v += dppf<0x140, 0xF>(v);
    return v;
}
__device__ __forceinline__ float sigmoidf_(float x) { return 1.0f / (1.0f + expf(-x)); }
__device__ __forceinline__ unsigned ordkey(float f) { const unsigned u = __float_as_uint(f); return (u & 0x80000000u) ? ~u : (u | 0x80000000u); }
__device__ __forceinline__ unsigned fixkey20(float f) { const float c = fminf(fmaxf(f, -15.999f), 15.999f); return (unsigned)((int)rintf(c * 32768.0f) + (1 << 19)); }
__device__ __forceinline__ float unordkey(unsigned k) { return __uint_as_float((k & 0x80000000u) ? (k & 0x7fffffffu) : ~k); }

struct Args { const void* in[27]; float* out; unsigned char* ws; int ph_lo, ph_hi; };
struct Frame { LAS unsigned char* lds; int tid, lane, wave, bx, G, gw, ngw; };

struct EpiLora {
    static constexpr bool PERM = true, AFTER_DRAIN = false;
    pg8::bf16_t* O; int ldc; const float* w0; const float* a0;
    __device__ __forceinline__ void operator()(const pg8::f32x4 (&acc)[2][2][4][2], const pg8::Unit& u, int wr, int wc, int fr, int fq) const {
        const int row0 = u.pm * 256 + wr * 64 + fr; const int colt = u.pn * 256; const int type = u.pn >> 2;
        const int col0 = colt + wc * 32 + 8 * fq, ncol0 = col0 & 1023;
        const float* pv = (type == 0) ? w0 : a0;
        pg8::f32x4 bv[2][2];
#pragma unroll
        for (int bj = 0; bj < 2; ++bj)
#pragma unroll
            for (int n = 0; n < 2; ++n) bv[bj][n] = (type < 2) ? *(const pg8::f32x4*)(pv + ncol0 + bj * 128 + 4 * n) : (pg8::f32x4){0.f, 0.f, 0.f, 0.f};
#pragma unroll
        for (int ai = 0; ai < 2; ++ai)
#pragma unroll
            for (int m = 0; m < 4; ++m) { pg8::bf16_t* rowp = O + (size_t)(row0 + ai * 128 + m * 16) * ldc + col0;
#pragma unroll
                for (int bj = 0; bj < 2; ++bj) { pg8::f32x4 v0 = acc[ai][bj][m][0] + bv[bj][0], v1 = acc[ai][bj][m][1] + bv[bj][1];
                    if (type < 2) {
                        const float sc = (type == 0) ? 0.60653066f : 1.0f;
#pragma unroll
                        for (int j = 0; j < 4; ++j) { v0[j] = sc / (1.0f + __expf(-v0[j])); v1[j] = sc / (1.0f + __expf(-v1[j])); }
                    }
                    pg8::u32x4 w; w.x = pg8::cvt_pk_bf16(v0[0], v0[1]); w.y = pg8::cvt_pk_bf16(v0[2], v0[3]); w.z = pg8::cvt_pk_bf16(v1[0], v1[1]); w.w = pg8::cvt_pk_bf16(v1[2], v1[3]);
                    *(pg8::u32x4*)(rowp + bj * 128) = w; } }
    }
};

__device__ __forceinline__ void transpose_item(const float* W, int K, int N, int Npad, bf16* WT, LAS float* scr, int item, int lane) {
    const int nblk = Npad / 32, kb = item / nblk, nb = item % nblk, k0 = 64 * kb, n0 = 32 * nb;
    const int nl = lane & 31; const bool ok = (n0 + nl) < N;
#pragma unroll 8
    for (int i = 0; i < 32; ++i) { const int kk = 2 * i + (lane >> 5); scr[kk * 33 + nl] = ok ? W[(size_t)(k0 + kk) * N + n0 + nl] : 0.f; }
    asm volatile("s_waitcnt lgkmcnt(0)" ::: "memory");
    const int c = lane & 7;
#pragma unroll
    for (int j = 0; j < 4; ++j) { const int n = (lane >> 3) + 8 * j; const LAS float* s = scr + (8 * c) * 33 + n;
        u32x4 o; o.x = pk2(s[0 * 33], s[1 * 33]); o.y = pk2(s[2 * 33], s[3 * 33]); o.z = pk2(s[4 * 33], s[5 * 33]); o.w = pk2(s[6 * 33], s[7 * 33]);
        *(u32x4*)(WT + (size_t)(n0 + n) * K + k0 + 8 * c) = o; }
    asm volatile("s_waitcnt lgkmcnt(0)" ::: "memory");
}

__device__ __forceinline__ void ph_prologue(const Args& A, Frame& F) {
    unsigned char* ws = A.ws;
    {
        const float* c = (const float*)A.in[1]; const float* mw = (const float*)A.in[19]; const float* mb = (const float*)A.in[20];
        float* MOD = (float*)(ws + WS_MOD);
        LAS float* red = (LAS float*)F.lds;
        for (int it = F.bx; it < 96; it += F.G) {
            const int s = it / 24, cc = it % 24, col = cc * 256 + F.lane * 4;
            const float* W = mw + (size_t)s * 2048 * 6144 + col;
            f32x4 a0 = {0.f, 0.f, 0.f, 0.f}, a1 = {0.f, 0.f, 0.f, 0.f};
            const int k0 = F.wave * 256;
#pragma unroll 8
            for (int k = k0; k < k0 + 256; ++k) {
                float c0 = c[k], c1 = c[2048 + k];
                c0 = c0 / (1.0f + expf(-c0)); c1 = c1 / (1.0f + expf(-c1));
                const f32x4 w = *(const f32x4*)(W + (size_t)k * 6144);
                a0 += c0 * w; a1 += c1 * w;
            }
            *(LAS f32x4*)(red + ((F.wave * 2 + 0) * 256 + F.lane * 4)) = a0;
            *(LAS f32x4*)(red + ((F.wave * 2 + 1) * 256 + F.lane * 4)) = a1;
            __syncthreads();
            { const int b = F.tid >> 8, cl = F.tid & 255; float sm = 0.f;
#pragma unroll
              for (int w = 0; w < 8; ++w) sm += red[(w * 2 + b) * 256 + cl];
              MOD[(size_t)(s * 2 + b) * 6144 + cc * 256 + cl] = sm + mb[s * 6144 + cc * 256 + cl]; }
            __syncthreads();
        }
    }
    {
        LAS float* scr = (LAS float*)(F.lds + 16384 + F.wave * 8704);
        constexpr int I0 = 32 * (EV_NP / 32), I1 = 32 * 64, I2 = 32 * (OD_NP / 32);
        constexpr int NIT = I0 + I1 + I2 + 3 * I1;
        for (int it = F.gw; it < NIT; it += F.ngw) {
            int r = it;
            if (r < I0) { transpose_item((const float*)A.in[3], 2048, EV_N, EV_NP, (bf16*)(ws + WS_WINE), scr, r, F.lane); continue; } r -= I0;
            if (r < I1) { transpose_item((const float*)A.in[4], 2048, 2048, 2048, (bf16*)(ws + WS_WOUTE), scr, r, F.lane); continue; } r -= I1;
            if (r < I2) { transpose_item((const float*)A.in[17], 2048, OD_N, OD_NP, (bf16*)(ws + WS_WINO), scr, r, F.lane); continue; } r -= I2;
            if (r < I1) { transpose_item((const float*)A.in[18], 2048, 2048, 2048, (bf16*)(ws + WS_WOUTO), scr, r, F.lane); continue; } r -= I1;
            if (r < I1) { transpose_item((const float*)A.in[23], 2048, 2048, 2048, (bf16*)(ws + WS_WQ0), scr, r, F.lane); continue; } r -= I1;
            transpose_item((const float*)A.in[23] + (size_t)2048 * 2048, 2048, 2048, 2048, (bf16*)(ws + WS_WQ1), scr, r, F.lane);
        }
    }
    {
        const float* w2 = (const float*)A.in[8]; const float* a2 = (const float*)A.in[10]; const float* g2 = (const float*)A.in[11];
        bf16* WL = (bf16*)(ws + WS_WL);
        const int gt = F.bx * NTHREADS + F.tid, ngt = F.G * NTHREADS;
        for (int i = gt; i < 3072 * 512; i += ngt) {
            const int n = i >> 9, k = i & 511; float v = 0.f;
            if (n < 1024) { if (k < 96) v = w2[k * 1024 + n]; }
            else if (n < 2048) { if (k >= 96 && k < 192) v = a2[(k - 96) * 1024 + (n - 1024)]; }
            else { if (k >= 192 && k < 448) v = g2[(k - 192) * 1024 + (n - 2048)]; }
            WL[i] = (bf16)f2bf(v);
        }
        const float* sk = (const float*)A.in[24]; bf16* SKB = (bf16*)(ws + WS_SKB);
        for (int i = gt; i < 2 * 262144; i += ngt) SKB[i] = (bf16)f2bf(sk[i]);
    }
}

__device__ __forceinline__ void ph_mod_x(const Args& A, Frame& F) {
    const float* x = (const float*)A.in[0]; const float* MOD = (const float*)(A.ws + WS_MOD); bf16* H = (bf16*)(A.ws + WS_HY);
    for (int t = F.gw; t < TOK; t += F.ngw) {
        const int b = t >> 14; const float* sh = MOD + (size_t)(0 * 2 + b) * 6144; const float* sc = sh + 2048;
#pragma unroll
        for (int j = 0; j < 8; ++j) { const int idx = j * 256 + F.lane * 4;
            const f32x4 xv = *(const f32x4*)(x + (size_t)t * DM + idx), sv = *(const f32x4*)(sc + idx), hv = *(const f32x4*)(sh + idx);
            const f32x4 o = xv * (1.0f + sv) + hv; u32x2 w; w.x = pk2(o[0], o[1]); w.y = pk2(o[2], o[3]);
            *(u32x2*)(H + (size_t)t * DM + idx) = w; }
    }
}

__device__ __forceinline__ void ph_even_post(const Args& A, Frame& F) {
    bf16* Z = (bf16*)(A.ws + WS_Z); const int* positions = (const int*)A.in[2]; const float* mu = (const float*)A.in[6];
    bf16* RKV = (bf16*)A.out; bf16* LAp = (bf16*)(A.ws + WS_LA);
    const int i = F.lane & 31; const float inv = powf(10000.0f, -(float)i / 32.0f);
    const int i4 = F.lane & 7, hs = F.lane >> 3;
    for (int t = F.gw; t < TOK; t += F.ngw) {
        const int s = t & (SEQ - 1); bf16* zr = Z + (size_t)t * EV_NP;
        float sn, cs; sincosf((float)positions[t] * inv, &sn, &cs);
        float c4[4], s4[4];
#pragma unroll
        for (int e = 0; e < 4; ++e) { c4[e] = __shfl(cs, 4 * i4 + e); s4[e] = __shfl(sn, 4 * i4 + e); }
#pragma unroll
        for (int it = 0; it < 3; ++it) { const int hd = it * 8 + hs; if (hd < 18) { bf16* hp = zr + hd * 64 + 4 * i4;
            const u32x2 a = *(const u32x2*)hp, b = *(const u32x2*)(hp + 32);
            const float t1[4] = {lo2f(a.x), hi2f(a.x), lo2f(a.y), hi2f(a.y)}, t2[4] = {lo2f(b.x), hi2f(b.x), lo2f(b.y), hi2f(b.y)};
            float o1[4], o2[4];
#pragma unroll
            for (int e = 0; e < 4; ++e) { o1[e] = t1[e] * c4[e] - t2[e] * s4[e]; o2[e] = t2[e] * c4[e] + t1[e] * s4[e]; }
            *(u32x2*)hp = (u32x2){pk2(o1[0], o1[1]), pk2(o1[2], o1[3])}; *(u32x2*)(hp + 32) = (u32x2){pk2(o2[0], o2[1]), pk2(o2[2], o2[3])}; } }
        const bf16* zp = zr - EV_NP; const bool hasprev = s > 0;
#pragma unroll
        for (int m = 0; m < 7; ++m) { const int j = 8 * (F.lane + 64 * m); if (j < 3520) {
            const u32x4 cw = *(const u32x4*)(zr + 1280 + j); u32x4 pw = {0u, 0u, 0u, 0u}; if (hasprev) pw = *(const u32x4*)(zp + 1280 + j);
            const f32x4 m0 = *(const f32x4*)(mu + j), m1 = *(const f32x4*)(mu + j + 4);
            const unsigned cwa[4] = {cw.x, cw.y, cw.z, cw.w}, pwa[4] = {pw.x, pw.y, pw.z, pw.w}; const float mm[8] = {m0[0], m0[1], m0[2], m0[3], m1[0], m1[1], m1[2], m1[3]};
            float v[8];
#pragma unroll
            for (int q = 0; q < 4; ++q) { const float c0 = lo2f(cwa[q]), c1 = hi2f(cwa[q]), p0 = lo2f(pwa[q]), p1 = hi2f(pwa[q]); v[2 * q] = c0 + (p0 - c0) * mm[2 * q]; v[2 * q + 1] = c1 + (p1 - c1) * mm[2 * q + 1]; }
            bf16* dst;
            if (j < 3072) { dst = RKV + (size_t)(j >> 10) * TOK * 1024 + (size_t)t * 1024 + (j & 1023); }
            else if (j < 3168) { dst = LAp + (size_t)t * 512 + (j - 3072);
#pragma unroll
                for (int e = 0; e < 8; ++e) v[e] = tanhf(v[e]); }
            else if (j < 3264) { dst = LAp + (size_t)t * 512 + 96 + (j - 3168); }
            else { dst = LAp + (size_t)t * 512 + 192 + (j - 3264);
#pragma unroll
                for (int e = 0; e < 8; ++e) v[e] = sigmoidf_(v[e]); }
            *(u32x4*)dst = (u32x4){pk2(v[0], v[1]), pk2(v[2], v[3]), pk2(v[4], v[5]), pk2(v[6], v[7])};
        } }
        if (F.lane < 8) *(u32x4*)(LAp + (size_t)t * 512 + 448 + 8 * F.lane) = (u32x4){0u, 0u, 0u, 0u};
    }
}

__device__ __forceinline__ void ph_scan_pack(const Args& A, Frame& F) {
    const bf16* Z = (const bf16*)(A.ws + WS_Z); const bf16* RKV = (const bf16*)A.out;
    const float* k_k = (const float*)A.in[12]; const float* k_a = (const float*)A.in[13]; const float* r_k = (const float*)A.in[14];
    unsigned* PK = (unsigned*)(A.ws + WS_BIG); float* BS = (float*)(A.ws + WS_BS);
    const int g16 = F.lane >> 4, c16 = F.lane & 15;
    for (int it = F.gw; it < TOK * 4; it += F.ngw) {
        const int item = it * 4 + g16; const int t = item >> 4, h = item & 15, c = h * 64 + 4 * c16, b = t >> 14, s = t & (SEQ - 1);
        const u32x2 rw = *(const u32x2*)(RKV + (size_t)t * 1024 + c), kw = *(const u32x2*)(RKV + (size_t)TOK * 1024 + (size_t)t * 1024 + c), vw = *(const u32x2*)(RKV + (size_t)2 * TOK * 1024 + (size_t)t * 1024 + c);
        const u32x2 ew = *(const u32x2*)(Z + (size_t)t * EV_NP + 1280 + c), aw = *(const u32x2*)(Z + (size_t)t * EV_NP + 1280 + 1024 + c);
        const f32x4 kk4 = *(const f32x4*)(k_k + c), ka4 = *(const f32x4*)(k_a + c), rk4 = *(const f32x4*)(r_k + c);
        const float r[4] = {lo2f(rw.x), hi2f(rw.x), lo2f(rw.y), hi2f(rw.y)}, kr[4] = {lo2f(kw.x), hi2f(kw.x), lo2f(kw.y), hi2f(kw.y)}, v[4] = {lo2f(vw.x), hi2f(vw.x), lo2f(vw.y), hi2f(vw.y)};
        const float e[4] = {lo2f(ew.x), hi2f(ew.x), lo2f(ew.y), hi2f(ew.y)}, a[4] = {lo2f(aw.x), hi2f(aw.x), lo2f(aw.y), hi2f(aw.y)};
        float kkv[4], kp[4]; float ss = 0.f, bsum = 0.f;
#pragma unroll
        for (int q = 0; q < 4; ++q) { kkv[q] = kr[q] * kk4[q]; ss += kkv[q] * kkv[q]; kp[q] = kr[q] * (1.0f + (a[q] - 1.0f) * ka4[q]); bsum += r[q] * kp[q] * rk4[q]; }
        ss = sum16_dpp(ss); bsum = sum16_dpp(bsum);
        const float rn = 1.0f / fmaxf(sqrtf(ss), 1e-12f);
        if (c16 == 0) BS[(size_t)t * 16 + h] = bsum;
        unsigned w[12];
#pragma unroll
        for (int q = 0; q < 4; ++q) { const float kkn = kkv[q] * rn; w[3 * q] = pk2(r[q], e[q]); w[3 * q + 1] = pk2(kp[q], kkn); w[3 * q + 2] = pk2(kkn * a[q], v[q]); }
        u32x4* dst = (u32x4*)(PK + ((size_t)((b * 16 + h) * SEQ + s) * 64 + 4 * c16) * 3);
        dst[0] = (u32x4){w[0], w[1], w[2], w[3]}; dst[1] = (u32x4){w[4], w[5], w[6], w[7]}; dst[2] = (u32x4){w[8], w[9], w[10], w[11]};
    }
}

__device__ __forceinline__ void ph_swa(const Args& A, Frame& F) {
    const bf16* Z = (const bf16*)(A.ws + WS_Z); bf16* Y = (bf16*)(A.ws + WS_HY); const float* sinks = (const float*)A.in[5];
    LAS unsigned char* KL = F.lds; LAS unsigned char* VL = F.lds + 256 * 136;
    for (int u = F.bx; u < 512; u += F.G) {
        const int b = u >> 8, n = (u >> 1) & 127, kvh = u & 1;
        __syncthreads();
        for (int c = F.tid; c < 2048; c += NTHREADS) { const int jw = c >> 3, cc = c & 7; const int s = n * 128 - 128 + jw;
            u32x4 kv = {0u, 0u, 0u, 0u}, vv = {0u, 0u, 0u, 0u};
            if (s >= 0) { const bf16* row = Z + (size_t)(b * SEQ + s) * EV_NP; kv = *(const u32x4*)(row + 1024 + kvh * 64 + cc * 8); vv = *(const u32x4*)(row + 1152 + kvh * 64 + cc * 8); }
            *(LAS u32x2*)(KL + jw * 136 + cc * 16) = (u32x2){kv.x, kv.y}; *(LAS u32x2*)(KL + jw * 136 + cc * 16 + 8) = (u32x2){kv.z, kv.w};
            *(LAS u32x2*)(VL + jw * 136 + cc * 16) = (u32x2){vv.x, vv.y}; *(LAS u32x2*)(VL + jw * 136 + cc * 16 + 8) = (u32x2){vv.z, vv.w}; }
        __syncthreads();
        for (int it = F.wave; it < 1024; it += NWAVES) {
            const int i = it >> 3, g = it & 7, head = kvh * 8 + g; const int t = b * SEQ + n * 128 + i;
            const float qv = bf2f(Z[(size_t)t * EV_NP + head * 64 + F.lane]) * 0.125f;
            const int jw0 = i + 1 + F.lane, jw1 = jw0 + 64;
            const bool val0 = (n > 0) || (jw0 >= 128), val1 = (n > 0) || (jw1 >= 128);
            float s0 = 0.f, s1 = 0.f;
#pragma unroll
            for (int d4 = 0; d4 < 16; ++d4) {
                const u32x2 k0 = *(const LAS u32x2*)(KL + jw0 * 136 + d4 * 8), k1 = *(const LAS u32x2*)(KL + jw1 * 136 + d4 * 8);
                const float q0 = rdlane(qv, 4 * d4), q1 = rdlane(qv, 4 * d4 + 1), q2 = rdlane(qv, 4 * d4 + 2), q3 = rdlane(qv, 4 * d4 + 3);
                s0 += q0 * lo2f(k0.x) + q1 * hi2f(k0.x) + q2 * lo2f(k0.y) + q3 * hi2f(k0.y);
                s1 += q0 * lo2f(k1.x) + q1 * hi2f(k1.x) + q2 * lo2f(k1.y) + q3 * hi2f(k1.y);
            }
            const float sink = sinks[head];
            s0 = val0 ? s0 : -INFINITY; s1 = val1 ? s1 : -INFINITY;
            const float mx = fmaxf(wmax(fmaxf(s0, s1)), sink);
            float p0 = val0 ? expf(s0 - mx) : 0.f, p1 = val1 ? expf(s1 - mx) : 0.f;
            const float den = wsum(p0 + p1) + expf(sink - mx); const float rden = 1.0f / den;
            p0 *= rden; p1 *= rden;
            float o = 0.f;
            const LAS bf16* vcol = (const LAS bf16*)VL + F.lane;
#pragma unroll 8
            for (int jj = 0; jj < 64; ++jj) o += rdlane(p0, jj) * bf2f(vcol[(i + 1 + jj) * 68]);
#pragma unroll 8
            for (int jj = 0; jj < 64; ++jj) o += rdlane(p1, jj) * bf2f(vcol[(i + 65 + jj) * 68]);
            Y[(size_t)t * DM + head * 64 + F.lane] = (bf16)f2bf(o);
        }
    }
}

__device__ __forceinline__ void pair_sync(volatile LAS unsigned* cnt, unsigned target) {
    asm volatile("s_waitcnt vmcnt(0) lgkmcnt(0)" ::: "memory");
    if ((threadIdx.x & 63) == 0) (void)__hip_atomic_fetch_add((LAS unsigned*)cnt, 1u, __ATOMIC_RELAXED, __HIP_MEMORY_SCOPE_WORKGROUP);
    while (__hip_atomic_load((LAS unsigned*)cnt, __ATOMIC_RELAXED, __HIP_MEMORY_SCOPE_WORKGROUP) < target) __builtin_amdgcn_s_sleep(1);
    asm volatile("" ::: "memory");
}
__device__ __forceinline__ void swa_pairs(const Args& A, Frame& F, volatile LAS unsigned* MISC) {
    const bf16* Z = (const bf16*)(A.ws + WS_Z); bf16* Y = (bf16*)(A.ws + WS_HY); const float* sinks = (const float*)A.in[5];
    const int pr = (F.wave - 4) >> 1, mem = F.wave & 1;
    LAS unsigned char* KL = F.lds + pr * 69632; LAS unsigned char* VL = KL + 256 * 136;
    volatile LAS unsigned* cnt = MISC + 24 + pr; unsigned gen = 0u;
    for (int u = F.bx * 2 + pr; u < 512; u += F.G * 2) {
        const int b = u >> 8, n = (u >> 1) & 127, kvh = u & 1;
        gen += 2u; pair_sync(cnt, gen);
#pragma unroll 1
        for (int c0 = mem * 1024 + F.lane; c0 < mem * 1024 + 1024; c0 += 64 * 8) {
            u32x4 kv[8], vv[8];
#pragma unroll
            for (int q = 0; q < 8; ++q) { const int c = c0 + 64 * q; const int jw = c >> 3, cc = c & 7; const int sp = n * 128 - 128 + jw;
                kv[q] = (u32x4){0u, 0u, 0u, 0u}; vv[q] = kv[q];
                if (sp >= 0) { const bf16* row = Z + (size_t)(b * SEQ + sp) * EV_NP; kv[q] = *(const u32x4*)(row + 1024 + kvh * 64 + cc * 8); vv[q] = *(const u32x4*)(row + 1152 + kvh * 64 + cc * 8); } }
#pragma unroll
            for (int q = 0; q < 8; ++q) { const int c = c0 + 64 * q; const int jw = c >> 3, cc = c & 7;
                *(LAS u32x2*)(KL + jw * 136 + cc * 16) = (u32x2){kv[q].x, kv[q].y}; *(LAS u32x2*)(KL + jw * 136 + cc * 16 + 8) = (u32x2){kv[q].z, kv[q].w};
                *(LAS u32x2*)(VL + jw * 136 + cc * 16) = (u32x2){vv[q].x, vv[q].y}; *(LAS u32x2*)(VL + jw * 136 + cc * 16 + 8) = (u32x2){vv[q].z, vv[q].w}; }
        }
        gen += 2u; pair_sync(cnt, gen);
        for (int it = mem; it < 1024; it += 2) {
            const int i = it >> 3, g = it & 7, head = kvh * 8 + g; const int t = b * SEQ + n * 128 + i;
            const float qv = bf2f(Z[(size_t)t * EV_NP + head * 64 + F.lane]) * 0.125f;
            const int jw0 = i + 1 + F.lane, jw1 = jw0 + 64;
            const bool val0 = (n > 0) || (jw0 >= 128), val1 = (n > 0) || (jw1 >= 128);
            float s0 = 0.f, s1 = 0.f;
#pragma unroll
            for (int d4 = 0; d4 < 16; ++d4) {
                const u32x2 k0 = *(const LAS u32x2*)(KL + jw0 * 136 + d4 * 8), k1 = *(const LAS u32x2*)(KL + jw1 * 136 + d4 * 8);
                const float q0 = rdlane(qv, 4 * d4), q1 = rdlane(qv, 4 * d4 + 1), q2 = rdlane(qv, 4 * d4 + 2), q3 = rdlane(qv, 4 * d4 + 3);
                s0 += q0 * lo2f(k0.x) + q1 * hi2f(k0.x) + q2 * lo2f(k0.y) + q3 * hi2f(k0.y);
                s1 += q0 * lo2f(k1.x) + q1 * hi2f(k1.x) + q2 * lo2f(k1.y) + q3 * hi2f(k1.y);
            }
            const float sink = sinks[head];
            s0 = val0 ? s0 : -INFINITY; s1 = val1 ? s1 : -INFINITY;
            const float mx = fmaxf(wmax(fmaxf(s0, s1)), sink);
            float p0 = val0 ? expf(s0 - mx) : 0.f, p1 = val1 ? expf(s1 - mx) : 0.f;
            const float den = wsum(p0 + p1) + expf(sink - mx); const float rden = 1.0f / den;
            p0 *= rden; p1 *= rden;
            float o = 0.f;
            const LAS bf16* vcol = (const LAS bf16*)VL + F.lane;
#pragma unroll 8
            for (int jj = 0; jj < 64; ++jj) o += rdlane(p0, jj) * bf2f(vcol[(i + 1 + jj) * 68]);
#pragma unroll 8
            for (int jj = 0; jj < 64; ++jj) o += rdlane(p1, jj) * bf2f(vcol[(i + 65 + jj) * 68]);
            Y[(size_t)t * DM + head * 64 + F.lane] = (bf16)f2bf(o);
        }
    }
}

__device__ __forceinline__ void wsum2_dpp(float a, float b, float& ra, float& rb) {
    const auto r = __builtin_amdgcn_permlane32_swap(__float_as_uint(a), __float_as_uint(b), false, false);
    float v = __uint_as_float(r[0]) + __uint_as_float(r[1]);
    v += dppf<0xB1, 0xF>(v); v += dppf<0x4E, 0xF>(v); v += dppf<0x141, 0xF>(v); v += dppf<0x140, 0xF>(v);
    v += dppf<0x142, 0xA>(v);
    ra = rdlane(v, 31); rb = rdlane(v, 63);
}
__device__ __forceinline__ void ph_scan(const Args& A, Frame& F, volatile LAS unsigned* MISC) {
    const unsigned* PK = (const unsigned*)(A.ws + WS_BIG); bf16* YRAW = (bf16*)A.out + (size_t)3 * TOK * 1024;
    if (F.wave >= 4) { swa_pairs(A, F, MISC); return; }
    for (int pp = F.bx * 4 + F.wave; pp < 1024; pp += F.G * 4) {
        const int rr = 2 * pp, bh = rr >> 6, vrow = rr & 63;
        const unsigned* pk = PK + ((size_t)bh * SEQ * 64 + F.lane) * 3;
        bf16* youtA = YRAW + ((size_t)bh * 64 + vrow) * SEQ; bf16* youtB = youtA + SEQ;
        f32x2 S2 = {0.f, 0.f};
        for (int t0 = 0; t0 < SEQ; t0 += 64) {
            float ykA = 0.f, ykB = 0.f;
#pragma unroll 8
            for (int j = 0; j < 64; ++j) {
                const unsigned* p = pk + (size_t)(t0 + j) * 192;
                const unsigned w0 = p[0], w1 = p[1], w2 = p[2];
                const float r = lo2f(w0), e = hi2f(w0), kp = lo2f(w1), kk = hi2f(w1), kka = lo2f(w2), vv = hi2f(w2);
                const f32x2 v2 = {rdlane(vv, vrow), rdlane(vv, vrow + 1)};
                const float dec = __expf(-e);
                const f32x2 pk2v = S2 * (f32x2){kk, kk};
                float saA, saB; wsum2_dpp(pk2v.x, pk2v.y, saA, saB); const f32x2 sa2 = {saA, saB};
                S2 = S2 * (f32x2){dec, dec} + (v2 * (f32x2){kp, kp} - sa2 * (f32x2){kka, kka});
                const f32x2 py = S2 * (f32x2){r, r};
                float yA, yB; wsum2_dpp(py.x, py.y, yA, yB);
                ykA = (F.lane == j) ? yA : ykA; ykB = (F.lane == j) ? yB : ykB;
            }
            youtA[t0 + F.lane] = (bf16)f2bf(ykA); youtB[t0 + F.lane] = (bf16)f2bf(ykB);
        }
    }
}

__device__ __forceinline__ void ph_rwkv_finish(const Args& A, Frame& F) {
    const bf16* Z = (const bf16*)(A.ws + WS_Z); const bf16* RKV = (const bf16*)A.out; const bf16* YRAW = (const bf16*)A.out + (size_t)3 * TOK * 1024;
    const float* BS = (const float*)(A.ws + WS_BS); bf16* Y = (bf16*)(A.ws + WS_HY);
    const float* lnx_g = (const float*)A.in[15]; const float* lnx_b = (const float*)A.in[16];
    LAS float* tile = (LAS float*)(F.lds + F.wave * 16640);
    for (int it = F.gw; it < 8192; it += F.ngw) {
        const int bh = it >> 8, tb = it & 255, b = bh >> 4, h = bh & 15, t0 = tb * 64;
        for (int vr = 0; vr < 64; ++vr) tile[vr * 65 + F.lane] = bf2f(YRAW[((size_t)bh * 64 + vr) * SEQ + t0 + F.lane]);
        asm volatile("s_waitcnt lgkmcnt(0)" ::: "memory");
        const int c = h * 64 + F.lane; const float lg = lnx_g[c], lb = lnx_b[c];
        for (int j = 0; j < 64; ++j) {
            const int t = b * SEQ + t0 + j;
            const float y = tile[F.lane * 65 + j];
            const float mean = wsum(y) * (1.0f / 64.0f); const float d = y - mean; const float var = wsum(d * d) * (1.0f / 64.0f);
            const float yn = d * rsqrtf(var + 64e-5f) * lg + lb;
            const float vv = bf2f(RKV[(size_t)2 * TOK * 1024 + (size_t)t * 1024 + c]); const float g = bf2f(Z[(size_t)t * EV_NP + 1280 + 2048 + c]); const float bs = BS[(size_t)t * 16 + h];
            Y[(size_t)t * DM + 1024 + c] = (bf16)f2bf((yn + bs * vv) * g);
        }
        asm volatile("s_waitcnt lgkmcnt(0)" ::: "memory");
    }
}

__device__ __forceinline__ void ph_ln_mixer(const Args& A, Frame& F, const int L) {
    const float* xsrc = (L == 0) ? (const float*)A.in[0] : (const float*)A.out; float* xdst = A.out;
    const bf16* O = (const bf16*)(A.ws + WS_Z); bf16* H = (bf16*)(A.ws + WS_HY); const float* MOD = (const float*)(A.ws + WS_MOD);
    const float* lng = (const float*)A.in[21] + (size_t)(L * 2 + 0) * DM; const float* lnb = (const float*)A.in[22] + (size_t)(L * 2 + 0) * DM;
    for (int t = F.gw; t < TOK; t += F.ngw) {
        const int b = t >> 14;
        const float* gate = MOD + (size_t)((L * 2 + 0) * 2 + b) * 6144 + 4096;
        const float* sh = MOD + (size_t)((L * 2 + 1) * 2 + b) * 6144; const float* sc = sh + 2048;
        float v[32]; float sum = 0.f;
#pragma unroll
        for (int j = 0; j < 4; ++j) { const int base = (j * 64 + F.lane) * 8;
            const u32x4 ow = *(const u32x4*)(O + (size_t)t * DM + base);
            const f32x4 x0 = *(const f32x4*)(xsrc + (size_t)t * DM + base), x1 = *(const f32x4*)(xsrc + (size_t)t * DM + base + 4);
            const f32x4 g0 = *(const f32x4*)(gate + base), g1 = *(const f32x4*)(gate + base + 4);
            const float of[8] = {lo2f(ow.x), hi2f(ow.x), lo2f(ow.y), hi2f(ow.y), lo2f(ow.z), hi2f(ow.z), lo2f(ow.w), hi2f(ow.w)};
#pragma unroll
            for (int e = 0; e < 4; ++e) { v[j * 8 + e] = ALPHA * x0[e] + (1.0f + g0[e]) * of[e]; v[j * 8 + 4 + e] = ALPHA * x1[e] + (1.0f + g1[e]) * of[4 + e]; }
#pragma unroll
            for (int e = 0; e < 8; ++e) sum += v[j * 8 + e]; }
        const float mean = wsum(sum) * (1.0f / DM); float sq = 0.f;
#pragma unroll
        for (int e = 0; e < 32; ++e) { v[e] -= mean; sq += v[e] * v[e]; }
        const float rstd = rsqrtf(wsum(sq) * (1.0f / DM) + 1e-5f);
#pragma unroll
        for (int j = 0; j < 4; ++j) { const int base = (j * 64 + F.lane) * 8;
            const f32x4 lg0 = *(const f32x4*)(lng + base), lg1 = *(const f32x4*)(lng + base + 4), lb0 = *(const f32x4*)(lnb + base), lb1 = *(const f32x4*)(lnb + base + 4);
            const f32x4 s0 = *(const f32x4*)(sc + base), s1 = *(const f32x4*)(sc + base + 4), h0 = *(const f32x4*)(sh + base), h1 = *(const f32x4*)(sh + base + 4);
            f32x4 o0, o1;
#pragma unroll
            for (int e = 0; e < 4; ++e) { o0[e] = v[j * 8 + e] * rstd * lg0[e] + lb0[e]; o1[e] = v[j * 8 + 4 + e] * rstd * lg1[e] + lb1[e]; }
            *(f32x4*)(xdst + (size_t)t * DM + base) = o0; *(f32x4*)(xdst + (size_t)t * DM + base + 4) = o1;
            const f32x4 q0 = o0 * (1.0f + s0) + h0, q1 = o1 * (1.0f + s1) + h1;
            u32x4 w; w.x = pk2(q0[0], q0[1]); w.y = pk2(q0[2], q0[3]); w.z = pk2(q1[0], q1[1]); w.w = pk2(q1[2], q1[3]);
            *(u32x4*)(H + (size_t)t * DM + base) = w; }
    }
    {
        const float* pu = (const float*)A.in[25] + (size_t)L * 16384 * 2048; const float* pv = (const float*)A.in[26] + (size_t)L * 16384 * 2048;
        unsigned char* T8 = A.ws + WS_BIG; float* SCL = (float*)(A.ws + WS_BIG + 64 * MiB);
        for (int r = F.gw; r < 32768; r += F.ngw) {
            const float* src = ((r < 16384) ? pu : pv) + (size_t)(r & 16383) * 2048;
            f32x4 f[2][4]; float amax = 0.f;
#pragma unroll
            for (int j = 0; j < 2; ++j)
#pragma unroll
                for (int c = 0; c < 4; ++c) { f[j][c] = *(const f32x4*)(src + (j * 64 + F.lane) * 16 + 4 * c);
                    amax = fmaxf(amax, fmaxf(fmaxf(fabsf(f[j][c][0]), fabsf(f[j][c][1])), fmaxf(fabsf(f[j][c][2]), fabsf(f[j][c][3])))); }
            amax = wmax(amax);
            int k = 0; if (amax > 0.f) { k = ilogbf(224.0f / amax); k = k < -100 ? -100 : (k > 100 ? 100 : k); }
            const float scl = ldexpf(1.0f, k);
#pragma unroll
            for (int j = 0; j < 2; ++j) { u32x4 w; unsigned ww[4];
#pragma unroll
                for (int c = 0; c < 4; ++c) { int q = __builtin_amdgcn_cvt_pk_fp8_f32(f[j][c][0] * scl, f[j][c][1] * scl, 0, false); q = __builtin_amdgcn_cvt_pk_fp8_f32(f[j][c][2] * scl, f[j][c][3] * scl, q, true); ww[c] = (unsigned)q; }
                w.x = ww[0]; w.y = ww[1]; w.z = ww[2]; w.w = ww[3];
                *(u32x4*)(T8 + (size_t)r * 2048 + (j * 64 + F.lane) * 16) = w; }
            if (F.lane == 0) SCL[r] = ldexpf(1.0f, -k);
        }
    }
}

template <int NV, int NBITS> __device__ __forceinline__ unsigned wave_tau16(const unsigned (&key)[NV]) {
    unsigned tau = 0u;
#pragma unroll 1
    for (int bit = NBITS - 1; bit >= 0; --bit) {
        const unsigned cand = tau | (1u << bit); int cnt = 0;
#pragma unroll
        for (int v = 0; v < NV; ++v) cnt += __popcll(__ballot(key[v] >= cand));
        if (cnt >= 16) tau = cand;
    }
    return tau;
}
template <int NV> __device__ __forceinline__ void wave_compact16(const unsigned (&key)[NV], const float (&val)[NV], const int (&id)[NV], unsigned tau, LAS float* ov, LAS int* oi, int lane) {
    int ngt = 0;
#pragma unroll
    for (int v = 0; v < NV; ++v) ngt += __popcll(__ballot(key[v] > tau));
    int bg = 0, be = 0;
#pragma unroll
    for (int v = 0; v < NV; ++v) {
        const bool gt = key[v] > tau, eq = key[v] == tau;
        const unsigned long long mg = __ballot(gt), me = __ballot(eq);
        const unsigned long long below = (lane == 0) ? 0ull : ((~0ull) >> (64 - lane));
        const int pg = bg + __popcll(mg & below), pe = ngt + be + __popcll(me & below);
        if (gt) { ov[pg] = val[v]; oi[pg] = id[v]; }
        if (eq && pe < 16) { ov[pe] = val[v]; oi[pe] = id[v]; }
        bg += __popcll(mg); be += __popcll(me);
    }
}

__device__ __forceinline__ void ph_peer_select(const Args& A, Frame& F, const int L) {
    const bf16* QP = (const bf16*)(A.ws + WS_Z); const bf16* SKB = (const bf16*)(A.ws + WS_SKB) + (size_t)L * 262144;
    int* EID = (int*)(A.ws + WS_LA); float* GSM = (float*)(A.ws + WS_LA + 16 * MiB);
    LAS unsigned char* SKL = F.lds;
    LAS float* SCO = (LAS float*)(F.lds + 69632 + 4096);
    LAS float* tv = (LAS float*)(F.lds + 69632 + F.wave * 512);
    LAS int* ti = (LAS int*)(F.lds + 69632 + F.wave * 512 + 128);
    LAS float* cv = (LAS float*)(F.lds + 69632 + F.wave * 512 + 256);
    LAS int* ci = (LAS int*)(F.lds + 69632 + F.wave * 512 + 320);
    for (int it = F.bx; it < 4096; it += F.G) {
        const int tile = it >> 3, h = it & 7;
        __syncthreads();
        for (int c = F.tid; c < 4096; c += NTHREADS) { const int p = c >> 11, n = (c >> 4) & 127, cc = c & 15;
            *(LAS u32x4*)(SKL + (p * 128 + n) * 272 + cc * 16) = *(const u32x4*)(SKB + ((size_t)((p * 8 + h) * 128 + n)) * 128 + cc * 8); }
        __syncthreads();
        {
            const int p = F.wave >> 2, mt = F.wave & 3, g = F.lane >> 4, l15 = F.lane & 15;
            const bf16* qrow = QP + (size_t)(tile * 64 + mt * 16 + l15) * DM + h * 256 + p * 128 + 8 * g;
            bf16x8 afr[4];
#pragma unroll
            for (int ks = 0; ks < 4; ++ks) afr[ks] = *(const bf16x8*)(qrow + 32 * ks);
#pragma unroll
            for (int nt = 0; nt < 8; ++nt) {
                f32x4 acc = {0.f, 0.f, 0.f, 0.f};
#pragma unroll
                for (int ks = 0; ks < 4; ++ks) { const bf16x8 bfr = *(const LAS bf16x8*)(SKL + (p * 128 + nt * 16 + l15) * 272 + (32 * ks + 8 * g) * 2);
                    acc = __builtin_amdgcn_mfma_f32_16x16x32_bf16(afr[ks], bfr, acc, 0, 0, 0); }
#pragma unroll
                for (int rg = 0; rg < 4; ++rg) SCO[(p * 64 + mt * 16 + 4 * g + rg) * 132 + nt * 16 + l15] = acc[rg];
            }
        }
        __syncthreads();
        for (int tk = 0; tk < 8; ++tk) {
            const int t = tile * 64 + F.wave * 8 + tk;
            float sval[2][2]; unsigned key[2][2];
#pragma unroll
            for (int p = 0; p < 2; ++p) { const LAS float* srow = SCO + (p * 64 + F.wave * 8 + tk) * 132;
                const float s0 = srow[F.lane], s1 = srow[64 + F.lane];
                sval[p][0] = s0; sval[p][1] = s1; key[p][0] = fixkey20(s0); key[p][1] = fixkey20(s1); }
            {
                unsigned tau0 = 0u, tau1 = 0u;
#pragma unroll 1
                for (int bit = 19; bit >= 0; --bit) {
                    const unsigned c0 = tau0 | (1u << bit), c1 = tau1 | (1u << bit);
                    const int n0 = __popcll(__ballot(key[0][0] >= c0)) + __popcll(__ballot(key[0][1] >= c0));
                    const int n1 = __popcll(__ballot(key[1][0] >= c1)) + __popcll(__ballot(key[1][1] >= c1));
                    if (n0 >= 16) tau0 = c0;
                    if (n1 >= 16) tau1 = c1;
                }
                const int id[2] = {F.lane, F.lane + 64};
                wave_compact16<2>(key[0], sval[0], id, tau0, tv, ti, F.lane);
                wave_compact16<2>(key[1], sval[1], id, tau1, tv + 16, ti + 16, F.lane);
            }
            asm volatile("s_waitcnt lgkmcnt(0)" ::: "memory"); __builtin_amdgcn_wave_barrier();
            unsigned ck[4]; int cid[4]; float cval[4];
#pragma unroll
            for (int m = 0; m < 4; ++m) { const int c = F.lane * 4 + m; cid[m] = c; cval[m] = tv[c >> 4] + tv[16 + (c & 15)]; ck[m] = fixkey20(cval[m] * 0.5f); }
            const unsigned tau2 = wave_tau16<4, 20>(ck);
            wave_compact16<4>(ck, cval, cid, tau2, cv, ci, F.lane);
            asm volatile("s_waitcnt lgkmcnt(0)" ::: "memory"); __builtin_amdgcn_wave_barrier();
            const float bv = (F.lane < 16) ? cv[F.lane] : -INFINITY; const int bc = (F.lane < 16) ? ci[F.lane] : 0;
            const float mx = wmax(bv); const float ev = (F.lane < 16) ? expf(bv - mx) : 0.f; const float den = wsum(ev);
            if (F.lane < 16) { const int e1 = ti[bc >> 4], e2 = ti[16 + (bc & 15)];
                EID[(size_t)t * 128 + h * 16 + F.lane] = e1 * 128 + e2; GSM[(size_t)t * 128 + h * 16 + F.lane] = ev / den; }
            asm volatile("s_waitcnt lgkmcnt(0)" ::: "memory"); __builtin_amdgcn_wave_barrier();
        }
    }
}

constexpr int PGB = 4;
__device__ __forceinline__ void ph_peer_gather(const Args& A, Frame& F, const int L, const bool dry = false) {
    bf16* H = (bf16*)(A.ws + WS_HY); bf16* Hout = dry ? (bf16*)(A.ws + WS_BIG + 128 * MiB) : H; float* Xout = dry ? (float*)(A.ws + WS_Z) : A.out; const unsigned char* TU = A.ws + WS_BIG; const unsigned char* TV = TU + (size_t)16384 * 2048; const float* SCL = (const float*)(A.ws + WS_BIG + 64 * MiB);
    const int* EID = (const int*)(A.ws + WS_LA); const float* GSM = (const float*)(A.ws + WS_LA + 16 * MiB);
    const float* MOD = (const float*)(A.ws + WS_MOD); float* X = A.out;
    const float* lng = (const float*)A.in[21] + (size_t)(L * 2 + 1) * DM; const float* lnb = (const float*)A.in[22] + (size_t)(L * 2 + 1) * DM;
    for (int t = F.gw; t < TOK; t += F.ngw) {
        const int b = t >> 14;
        f32x2 h2[16];
#pragma unroll
        for (int j = 0; j < 2; ++j) { const u32x4 a = *(const u32x4*)(H + (size_t)t * DM + (j * 64 + F.lane) * 16), c = *(const u32x4*)(H + (size_t)t * DM + (j * 64 + F.lane) * 16 + 8);
            const unsigned aw[8] = {a.x, a.y, a.z, a.w, c.x, c.y, c.z, c.w};
#pragma unroll
            for (int q = 0; q < 8; ++q) h2[j * 8 + q] = (f32x2){lo2f(aw[q]), hi2f(aw[q])}; }
        f32x2 o2[16];
#pragma unroll
        for (int e = 0; e < 16; ++e) o2[e] = (f32x2){0.f, 0.f};
#pragma unroll 1
        for (int e0 = 0; e0 < 128; e0 += PGB) {
            int eid[PGB]; float gw[PGB], su[PGB], sv[PGB];
#pragma unroll
            for (int q = 0; q < PGB; ++q) { eid[q] = __builtin_amdgcn_readfirstlane(EID[(size_t)t * 128 + e0 + q]); gw[q] = GSM[(size_t)t * 128 + e0 + q]; su[q] = SCL[eid[q]]; sv[q] = SCL[16384 + eid[q]]; }
            u32x4 uu[PGB][2], vv[PGB][2];
#pragma unroll
            for (int q = 0; q < PGB; ++q)
#pragma unroll
                for (int j = 0; j < 2; ++j) { uu[q][j] = *(const u32x4*)(TU + (size_t)eid[q] * 2048 + (j * 64 + F.lane) * 16); vv[q][j] = *(const u32x4*)(TV + (size_t)eid[q] * 2048 + (j * 64 + F.lane) * 16); }
#pragma unroll
            for (int q = 0; q < PGB; ++q) {
                f32x2 d2 = {0.f, 0.f};
#pragma unroll
                for (int j = 0; j < 2; ++j) { const unsigned w[4] = {uu[q][j].x, uu[q][j].y, uu[q][j].z, uu[q][j].w};
#pragma unroll
                    for (int i = 0; i < 4; ++i) { const f32x2 lo = __builtin_amdgcn_cvt_pk_f32_fp8((int)w[i], false), hi = __builtin_amdgcn_cvt_pk_f32_fp8((int)w[i], true);
                        d2 = lo * h2[j * 8 + 2 * i] + d2; d2 = hi * h2[j * 8 + 2 * i + 1] + d2; } }
                const float d = wsum(d2.x + d2.y) * su[q];
                const float act = 0.5f * d * (1.0f + erff(d * 0.70710678f)) * gw[q] * sv[q];
                const f32x2 a2 = {act, act};
#pragma unroll
                for (int j = 0; j < 2; ++j) { const unsigned w[4] = {vv[q][j].x, vv[q][j].y, vv[q][j].z, vv[q][j].w};
#pragma unroll
                    for (int i = 0; i < 4; ++i) { const f32x2 lo = __builtin_amdgcn_cvt_pk_f32_fp8((int)w[i], false), hi = __builtin_amdgcn_cvt_pk_f32_fp8((int)w[i], true);
                        o2[j * 8 + 2 * i] = a2 * lo + o2[j * 8 + 2 * i]; o2[j * 8 + 2 * i + 1] = a2 * hi + o2[j * 8 + 2 * i + 1]; } }
            }
        }
        float out[32];
#pragma unroll
        for (int e = 0; e < 16; ++e) { out[2 * e] = o2[e].x; out[2 * e + 1] = o2[e].y; }
        const float* gate = MOD + (size_t)((L * 2 + 1) * 2 + b) * 6144 + 4096;
        float sum = 0.f;
#pragma unroll
        for (int j = 0; j < 2; ++j)
#pragma unroll
            for (int c = 0; c < 4; ++c) { const int base = (j * 64 + F.lane) * 16 + 4 * c;
                const f32x4 x0 = *(const f32x4*)(X + (size_t)t * DM + base), g0 = *(const f32x4*)(gate + base);
#pragma unroll
                for (int e = 0; e < 4; ++e) { const float v = ALPHA * x0[e] + (1.0f + g0[e]) * out[j * 16 + 4 * c + e]; out[j * 16 + 4 * c + e] = v; sum += v; } }
        const float mean = wsum(sum) * (1.0f / DM); float sq = 0.f;
#pragma unroll
        for (int e = 0; e < 32; ++e) { out[e] -= mean; sq += out[e] * out[e]; }
        const float rstd = rsqrtf(wsum(sq) * (1.0f / DM) + 1e-5f);
        const float* sh = MOD + (size_t)(((L + 1) * 2 + 0) * 2 + b) * 6144; const float* sc = sh + 2048;
#pragma unroll
        for (int j = 0; j < 2; ++j) {
            float hq[16];
#pragma unroll
            for (int c = 0; c < 4; ++c) { const int base = (j * 64 + F.lane) * 16 + 4 * c;
                const f32x4 lg0 = *(const f32x4*)(lng + base), lb0 = *(const f32x4*)(lnb + base);
                f32x4 o0;
#pragma unroll
                for (int e = 0; e < 4; ++e) o0[e] = out[j * 16 + 4 * c + e] * rstd * lg0[e] + lb0[e];
                *(f32x4*)(Xout + (size_t)t * DM + base) = o0;
                if (L == 0) { const f32x4 s0 = *(const f32x4*)(sc + base), h0 = *(const f32x4*)(sh + base);
#pragma unroll
                    for (int e = 0; e < 4; ++e) hq[4 * c + e] = o0[e] * (1.0f + s0[e]) + h0[e]; } }
            if (L == 0) { u32x4 w0, w1;
                w0.x = pk2(hq[0], hq[1]); w0.y = pk2(hq[2], hq[3]); w0.z = pk2(hq[4], hq[5]); w0.w = pk2(hq[6], hq[7]);
                w1.x = pk2(hq[8], hq[9]); w1.y = pk2(hq[10], hq[11]); w1.z = pk2(hq[12], hq[13]); w1.w = pk2(hq[14], hq[15]);
                *(u32x4*)(Hout + (size_t)t * DM + (j * 64 + F.lane) * 16) = w0; *(u32x4*)(Hout + (size_t)t * DM + (j * 64 + F.lane) * 16 + 8) = w1; }
        }
    }
}

struct XInfo { int rank, nloc, rx, nx; };
__device__ __forceinline__ XInfo xcc_info(volatile LAS unsigned* MISC) { XInfo x; x.rank = (int)MISC[16]; x.nloc = (int)MISC[17]; x.rx = (int)MISC[18]; x.nx = (int)MISC[19]; return x; }
constexpr size_t WS_DP = WS_BIG + 128 * MiB;
constexpr size_t WS_ACT = WS_BIG + 80 * MiB;
__device__ __forceinline__ void ph_peer_u(const Args& A, Frame& F, const XInfo X) {
    const bf16* H = (const bf16*)(A.ws + WS_HY); const unsigned char* TU = A.ws + WS_BIG; const int* EID = (const int*)(A.ws + WS_LA); float* DP = (float*)(A.ws + WS_DP);
    LAS int* IDX = (LAS int*)(F.lds + F.wave * 1024);
    const int g16 = F.lane >> 4, c16 = F.lane & 15; const int step = X.nloc * NWAVES;
    for (int s = X.rx; s < 8; s += X.nx) {
        int t = X.rank * NWAVES + F.wave;
        int e0 = 0, e1 = 0; u32x4 ha = {0u, 0u, 0u, 0u}, hb = ha;
        if (t < TOK) { e0 = EID[(size_t)t * 128 + F.lane]; e1 = EID[(size_t)t * 128 + 64 + F.lane]; ha = *(const u32x4*)(H + (size_t)t * DM + 256 * s + 16 * c16); hb = *(const u32x4*)(H + (size_t)t * DM + 256 * s + 16 * c16 + 8); }
        const unsigned char* ub = TU + 256 * s + 16 * c16;
        while (t < TOK) {
            const int tn = t + step; int n0 = 0, n1 = 0; u32x4 na = {0u, 0u, 0u, 0u}, nb = na;
            if (tn < TOK) { n0 = EID[(size_t)tn * 128 + F.lane]; n1 = EID[(size_t)tn * 128 + 64 + F.lane]; na = *(const u32x4*)(H + (size_t)tn * DM + 256 * s + 16 * c16); nb = *(const u32x4*)(H + (size_t)tn * DM + 256 * s + 16 * c16 + 8); }
            IDX[F.lane] = e0; IDX[F.lane + 64] = e1;
            f32x2 h2[8];
            { const unsigned aw[8] = {ha.x, ha.y, ha.z, ha.w, hb.x, hb.y, hb.z, hb.w};
#pragma unroll
              for (int q = 0; q < 8; ++q) h2[q] = (f32x2){lo2f(aw[q]), hi2f(aw[q])}; }
            asm volatile("s_waitcnt lgkmcnt(0)" ::: "memory"); __builtin_amdgcn_wave_barrier();
            float keep0 = 0.f, keep1 = 0.f;
#pragma unroll
            for (int i0 = 0; i0 < 32; i0 += 8) {
                u32x4 ud[8];
#pragma unroll
                for (int u = 0; u < 8; ++u) { const int eid = IDX[4 * (i0 + u) + g16]; ud[u] = *(const u32x4*)(ub + (size_t)eid * 2048); }
#pragma unroll
                for (int u = 0; u < 8; ++u) {
                    const unsigned w[4] = {ud[u].x, ud[u].y, ud[u].z, ud[u].w}; f32x2 d2 = {0.f, 0.f};
#pragma unroll
                    for (int q = 0; q < 4; ++q) { const f32x2 lo = __builtin_amdgcn_cvt_pk_f32_fp8((int)w[q], false), hi = __builtin_amdgcn_cvt_pk_f32_fp8((int)w[q], true);
                        d2 = lo * h2[2 * q] + d2; d2 = hi * h2[2 * q + 1] + d2; }
                    const float d = sum16_dpp(d2.x + d2.y);
                    const int i = i0 + u;
                    if (i < 16) keep0 = ((i & 15) == c16) ? d : keep0; else keep1 = ((i & 15) == c16) ? d : keep1;
                }
            }
            float* dp = DP + ((size_t)s * TOK + t) * 128 + 4 * c16 + g16;
            dp[0] = keep0; dp[64] = keep1;
            asm volatile("s_waitcnt lgkmcnt(0)" ::: "memory"); __builtin_amdgcn_wave_barrier();
            e0 = n0; e1 = n1; ha = na; hb = nb; t = tn;
        }
    }
}
__device__ __forceinline__ void ph_peer_act(const Args& A, Frame& F) {
    const float* SCL = (const float*)(A.ws + WS_BIG + 64 * MiB); const int* EID = (const int*)(A.ws + WS_LA); const float* GSM = (const float*)(A.ws + WS_LA + 16 * MiB);
    const float* DP = (const float*)(A.ws + WS_DP); float* ACT = (float*)(A.ws + WS_ACT);
    for (int t = F.gw; t < TOK; t += F.ngw) {
#pragma unroll
        for (int m = 0; m < 2; ++m) { const int e = F.lane + 64 * m; const int eid = EID[(size_t)t * 128 + e]; float d = 0.f;
#pragma unroll
            for (int x = 0; x < 8; ++x) d += DP[((size_t)x * TOK + t) * 128 + e];
            d *= SCL[eid];
            ACT[(size_t)t * 128 + e] = 0.5f * d * (1.0f + erff(d * 0.70710678f)) * GSM[(size_t)t * 128 + e] * SCL[16384 + eid]; }
    }
}
__device__ __forceinline__ void ph_peer_v(const Args& A, Frame& F, const XInfo X) {
    const unsigned char* TV = A.ws + WS_BIG + (size_t)16384 * 2048;
    const int* EID = (const int*)(A.ws + WS_LA); const float* ACTG = (const float*)(A.ws + WS_ACT); float* OUT = (float*)(A.ws + WS_Z);
    LAS int* IDX = (LAS int*)(F.lds + F.wave * 1024); LAS float* ACT = (LAS float*)(F.lds + F.wave * 1024 + 512);
    const int g16 = F.lane >> 4, c16 = F.lane & 15; const int step = X.nloc * NWAVES;
    for (int s = X.rx; s < 8; s += X.nx) {
        int t = X.rank * NWAVES + F.wave;
        int e0 = 0, e1 = 0; float a0 = 0.f, a1 = 0.f;
        if (t < TOK) { e0 = EID[(size_t)t * 128 + F.lane]; e1 = EID[(size_t)t * 128 + 64 + F.lane]; a0 = ACTG[(size_t)t * 128 + F.lane]; a1 = ACTG[(size_t)t * 128 + 64 + F.lane]; }
        const unsigned char* vb = TV + 256 * s + 16 * c16;
        while (t < TOK) {
            const int tn = t + step; int n0 = 0, n1 = 0; float b0 = 0.f, b1 = 0.f;
            if (tn < TOK) { n0 = EID[(size_t)tn * 128 + F.lane]; n1 = EID[(size_t)tn * 128 + 64 + F.lane]; b0 = ACTG[(size_t)tn * 128 + F.lane]; b1 = ACTG[(size_t)tn * 128 + 64 + F.lane]; }
            IDX[F.lane] = e0; IDX[F.lane + 64] = e1; ACT[F.lane] = a0; ACT[F.lane + 64] = a1;
            asm volatile("s_waitcnt lgkmcnt(0)" ::: "memory"); __builtin_amdgcn_wave_barrier();
            f32x2 o2[8];
#pragma unroll
            for (int q = 0; q < 8; ++q) o2[q] = (f32x2){0.f, 0.f};
#pragma unroll
            for (int i0 = 0; i0 < 32; i0 += 8) {
                u32x4 vd[8]; float av[8];
#pragma unroll
                for (int u = 0; u < 8; ++u) { const int eid = IDX[4 * (i0 + u) + g16]; vd[u] = *(const u32x4*)(vb + (size_t)eid * 2048); av[u] = ACT[4 * (i0 + u) + g16]; }
#pragma unroll
                for (int u = 0; u < 8; ++u) {
                    const unsigned w[4] = {vd[u].x, vd[u].y, vd[u].z, vd[u].w}; const f32x2 a2 = {av[u], av[u]};
#pragma unroll
                    for (int q = 0; q < 4; ++q) { const f32x2 lo = __builtin_amdgcn_cvt_pk_f32_fp8((int)w[q], false), hi = __builtin_amdgcn_cvt_pk_f32_fp8((int)w[q], true);
                        o2[2 * q] = a2 * lo + o2[2 * q]; o2[2 * q + 1] = a2 * hi + o2[2 * q + 1]; }
                }
            }
            float o[16];
#pragma unroll
            for (int q = 0; q < 8; ++q) { float x0 = o2[q].x, x1 = o2[q].y; x0 += __shfl_xor(x0, 16); x0 += __shfl_xor(x0, 32); x1 += __shfl_xor(x1, 16); x1 += __shfl_xor(x1, 32); o[2 * q] = x0; o[2 * q + 1] = x1; }
            if (g16 == 0) { float* op = OUT + (size_t)t * DM + 256 * s + 16 * c16;
#pragma unroll
                for (int c = 0; c < 4; ++c) *(f32x4*)(op + 4 * c) = (f32x4){o[4 * c], o[4 * c + 1], o[4 * c + 2], o[4 * c + 3]}; }
            asm volatile("s_waitcnt lgkmcnt(0)" ::: "memory"); __builtin_amdgcn_wave_barrier();
            e0 = n0; e1 = n1; a0 = b0; a1 = b1; t = tn;
        }
    }
}
__device__ __forceinline__ void ph_peer_ln(const Args& A, Frame& F, const int L) {
    const float* OUT = (const float*)(A.ws + WS_Z); float* X = A.out; bf16* H = (bf16*)(A.ws + WS_HY); const float* MOD = (const float*)(A.ws + WS_MOD);
    const float* lng = (const float*)A.in[21] + (size_t)(L * 2 + 1) * DM; const float* lnb = (const float*)A.in[22] + (size_t)(L * 2 + 1) * DM;
    for (int t = F.gw; t < TOK; t += F.ngw) {
        const int b = t >> 14;
        const float* gate = MOD + (size_t)((L * 2 + 1) * 2 + b) * 6144 + 4096;
        const float* sh = MOD + (size_t)(((L + 1) * 2 + 0) * 2 + b) * 6144; const float* sc = sh + 2048;
        float v[32]; float sum = 0.f;
#pragma unroll
        for (int j = 0; j < 8; ++j) { const int base = (j * 64 + F.lane) * 4;
            const f32x4 o0 = *(const f32x4*)(OUT + (size_t)t * DM + base), x0 = *(const f32x4*)(X + (size_t)t * DM + base), g0 = *(const f32x4*)(gate + base);
#pragma unroll
            for (int e = 0; e < 4; ++e) { v[j * 4 + e] = ALPHA * x0[e] + (1.0f + g0[e]) * o0[e]; sum += v[j * 4 + e]; } }
        const float mean = wsum(sum) * (1.0f / DM); float sq = 0.f;
#pragma unroll
        for (int e = 0; e < 32; ++e) { v[e] -= mean; sq += v[e] * v[e]; }
        const float rstd = rsqrtf(wsum(sq) * (1.0f / DM) + 1e-5f);
#pragma unroll
        for (int j = 0; j < 8; ++j) { const int base = (j * 64 + F.lane) * 4;
            const f32x4 lg0 = *(const f32x4*)(lng + base), lb0 = *(const f32x4*)(lnb + base);
            f32x4 o0;
#pragma unroll
            for (int e = 0; e < 4; ++e) o0[e] = v[j * 4 + e] * rstd * lg0[e] + lb0[e];
            *(f32x4*)(X + (size_t)t * DM + base) = o0;
            if (L == 0) { const f32x4 s0 = *(const f32x4*)(sc + base), h0 = *(const f32x4*)(sh + base); const f32x4 q0 = o0 * (1.0f + s0) + h0;
                u32x2 w; w.x = pk2(q0[0], q0[1]); w.y = pk2(q0[2], q0[3]); *(u32x2*)(H + (size_t)t * DM + base) = w; }
        }
    }
}

__device__ __forceinline__ void ph_odd_post(const Args& A, Frame& F) {
    bf16* Z = (bf16*)(A.ws + WS_Z); const int* positions = (const int*)A.in[2]; bf16* KIT = (bf16*)(A.ws + WS_BIG + 256 * MiB); unsigned char* K8 = A.ws + WS_BIG + 264 * MiB; unsigned char* V8 = A.ws + WS_BIG + 280 * MiB;
    const float inv128 = powf(10000.0f, -(float)F.lane / 64.0f); const int i32 = F.lane & 31; const float inv64 = powf(10000.0f, -(float)i32 / 32.0f);
    const int a16 = F.lane & 15, hs4 = F.lane >> 4, a8 = F.lane & 7, hs8 = F.lane >> 3;
    for (int t = F.gw; t < TOK; t += F.ngw) {
        bf16* zr = Z + (size_t)t * OD_NP; const float pos = (float)positions[t];
        const int bb = t >> 14, spos = t & (SEQ - 1);
        float sn, cs; sincosf(pos * inv128, &sn, &cs);
        float c4[4], s4[4];
#pragma unroll
        for (int e = 0; e < 4; ++e) { c4[e] = __shfl(cs, 4 * a16 + e); s4[e] = __shfl(sn, 4 * a16 + e); }
#pragma unroll
        for (int it = 0; it < 5; ++it) { const int hd = it * 4 + hs4; bf16* hp = zr + hd * 128 + 4 * a16;
            const u32x2 a = *(const u32x2*)hp, b = *(const u32x2*)(hp + 64);
            const float t1[4] = {lo2f(a.x), hi2f(a.x), lo2f(a.y), hi2f(a.y)}, t2[4] = {lo2f(b.x), hi2f(b.x), lo2f(b.y), hi2f(b.y)};
            float o1[4], o2[4];
#pragma unroll
            for (int e = 0; e < 4; ++e) { o1[e] = t1[e] * c4[e] - t2[e] * s4[e]; o2[e] = t2[e] * c4[e] + t1[e] * s4[e]; }
            *(u32x2*)hp = (u32x2){pk2(o1[0], o1[1]), pk2(o1[2], o1[3])}; *(u32x2*)(hp + 64) = (u32x2){pk2(o2[0], o2[1]), pk2(o2[2], o2[3])};
            if (it == 4) { unsigned char* k8 = K8 + ((size_t)((bb * 4 + hs4) * SEQ + spos)) * 128 + 4 * a16;
                int w1 = __builtin_amdgcn_cvt_pk_fp8_f32(o1[0] * 16.0f, o1[1] * 16.0f, 0, false); w1 = __builtin_amdgcn_cvt_pk_fp8_f32(o1[2] * 16.0f, o1[3] * 16.0f, w1, true);
                int w2 = __builtin_amdgcn_cvt_pk_fp8_f32(o2[0] * 16.0f, o2[1] * 16.0f, 0, false); w2 = __builtin_amdgcn_cvt_pk_fp8_f32(o2[2] * 16.0f, o2[3] * 16.0f, w2, true);
                *(unsigned*)k8 = (unsigned)w1; *(unsigned*)(k8 + 64) = (unsigned)w2; } }
        {
            const int e0 = F.lane * 8, kvh = e0 >> 7, d0 = e0 & 127;
            const u32x4 vw = *(const u32x4*)(zr + 2560 + e0);
            int w0 = __builtin_amdgcn_cvt_pk_fp8_f32(lo2f(vw.x) * 16.0f, hi2f(vw.x) * 16.0f, 0, false); w0 = __builtin_amdgcn_cvt_pk_fp8_f32(lo2f(vw.y) * 16.0f, hi2f(vw.y) * 16.0f, w0, true);
            int w1 = __builtin_amdgcn_cvt_pk_fp8_f32(lo2f(vw.z) * 16.0f, hi2f(vw.z) * 16.0f, 0, false); w1 = __builtin_amdgcn_cvt_pk_fp8_f32(lo2f(vw.w) * 16.0f, hi2f(vw.w) * 16.0f, w1, true);
            *(u32x2*)(V8 + ((size_t)((bb * 4 + kvh) * SEQ + spos)) * 128 + d0) = (u32x2){(unsigned)w0, (unsigned)w1};
        }
        sincosf(pos * inv64, &sn, &cs);
#pragma unroll
        for (int e = 0; e < 4; ++e) { c4[e] = __shfl(cs, 4 * a8 + e); s4[e] = __shfl(sn, 4 * a8 + e); }
#pragma unroll
        for (int it = 0; it < 3; ++it) { const int hd = it * 8 + hs8; if (hd < 17) { bf16* hp = zr + 3072 + hd * 64 + 4 * a8;
            const u32x2 a = *(const u32x2*)hp, b = *(const u32x2*)(hp + 32);
            const float t1[4] = {lo2f(a.x), hi2f(a.x), lo2f(a.y), hi2f(a.y)}, t2[4] = {lo2f(b.x), hi2f(b.x), lo2f(b.y), hi2f(b.y)};
            float o1[4], o2[4];
#pragma unroll
            for (int e = 0; e < 4; ++e) { o1[e] = t1[e] * c4[e] - t2[e] * s4[e]; o2[e] = t2[e] * c4[e] + t1[e] * s4[e]; }
            const u32x2 w1 = {pk2(o1[0], o1[1]), pk2(o1[2], o1[3])}, w2 = {pk2(o2[0], o2[1]), pk2(o2[2], o2[3])};
            *(u32x2*)hp = w1; *(u32x2*)(hp + 32) = w2;
            if (hd == 16) {
                const int tile = spos >> 5, rr = spos & 31;
                bf16* kt = KIT + ((size_t)(bb * 512 + tile) * 4) * 512;
                const int d1 = 4 * a8, d2 = 32 + 4 * a8;
                *(u32x2*)(kt + ((d1 >> 4) * 64 + rr + 32 * ((d1 >> 3) & 1)) * 8 + (d1 & 7)) = w1;
                *(u32x2*)(kt + ((d2 >> 4) * 64 + rr + 32 * ((d2 >> 3) & 1)) * 8 + (d2 & 7)) = w2;
            } } }
    }
}

__device__ __forceinline__ void ph_dsa_select(const Args& A, Frame& F, const int mode = 0) {
    const bf16* Z = (const bf16*)(A.ws + WS_Z); unsigned short* SEL = (unsigned short*)(A.ws + WS_LA); int* CNT = (int*)(A.ws + WS_CNT); const bf16* KIT = (const bf16*)(A.ws + WS_BIG + 256 * MiB);
    LAS unsigned short* SC = (LAS unsigned short*)F.lds;
    LAS unsigned* LST = (LAS unsigned*)(F.lds + 131072);
    LAS unsigned* hist = (LAS unsigned*)(F.lds + 131072 + 16384);
    LAS unsigned* res = (LAS unsigned*)(F.lds + 131072 + 16384 + 2048);
    LAS int* wtot = (LAS int*)(F.lds + 131072 + 16384 + 2048 + 64);
    const int r = F.lane & 31, hg = F.lane >> 5, tk = (r >> 2) & 1, hh = (r & 3) + 4 * (r >> 3);
    const int grp = F.wave >> 2, ltid = F.tid & 255, lw = F.wave & 3;
    for (int qd = F.bx; qd < TOK / 4; qd += F.G) {
        const int t0 = 4 * qd, b = t0 >> 14, s0 = t0 & (SEQ - 1);
        const int nkeys = s0 + 4, ntiles = (nkeys + 31) >> 5;
        bf16x8 af[2][4]; float wv[2][16];
#pragma unroll
        for (int a = 0; a < 2; ++a) {
            const bf16* qrow = Z + (size_t)(t0 + 2 * a + tk) * OD_NP + 3072 + hh * 64 + 8 * hg;
#pragma unroll
            for (int s = 0; s < 4; ++s) af[a][s] = *(const bf16x8*)(qrow + 16 * s);
            const bf16* wrow = Z + (size_t)(t0 + 2 * a + hg) * OD_NP + 4160;
            const u32x4 w0 = *(const u32x4*)(wrow), w1 = *(const u32x4*)(wrow + 8);
            const unsigned ww[8] = {w0.x, w0.y, w0.z, w0.w, w1.x, w1.y, w1.z, w1.w};
#pragma unroll
            for (int q = 0; q < 8; ++q) { wv[a][2 * q] = lo2f(ww[q]) * 0.03125f; wv[a][2 * q + 1] = hi2f(ww[q]) * 0.03125f; }
        }
        __syncthreads();
        const bf16* kbase = KIT + (size_t)b * 512 * 2048 + F.lane * 8;
        if (mode != 2) {
            bf16x8 bcur[2][4];
#define DSA_LOADT(dst, tb_) do { _Pragma("unroll") for (int q = 0; q < 2; ++q) { const int tile = ((tb_) + q < ntiles) ? ((tb_) + q) : (ntiles - 1); const bf16* krow = kbase + (size_t)tile * 2048; \
                _Pragma("unroll") for (int s_ = 0; s_ < 4; ++s_) dst[q][s_] = *(const bf16x8*)(krow + 512 * s_); } } while (0)
#define DSA_MM(accv, src, q_, a_) do { _Pragma("unroll") for (int e = 0; e < 16; ++e) accv[e] = 0.f; \
                _Pragma("unroll") for (int s_ = 0; s_ < 4; ++s_) accv = __builtin_amdgcn_mfma_f32_32x32x16_bf16(af[a_][s_], src[q_][s_], accv, 0, 0, 0); } while (0)
#define DSA_EPI(accv, tb_, q_, a_) do { float sc_ = 0.f; _Pragma("unroll") for (int e = 0; e < 16; ++e) sc_ += fmaxf(accv[e], 0.f) * wv[a_][e]; \
                const int key = ((tb_) + (q_)) * 32 + r; sc_ = fminf(fmaxf(sc_, -7.999f), 7.999f); const unsigned fx = (unsigned)((int)rintf(sc_ * 4096.0f) + (1 << 15)); \
                if ((tb_) + (q_) < ntiles) SC[(2 * (a_) + hg) * 16384 + key] = (unsigned short)((key <= s0 + 2 * (a_) + hg) ? fx : 0u); } while (0)
#define DSA_COMPT(src, tb_) do { f32x16 accA, accB; DSA_MM(accA, src, 0, 0); DSA_MM(accB, src, 0, 1); DSA_EPI(accA, tb_, 0, 0); DSA_MM(accA, src, 1, 0); DSA_EPI(accB, tb_, 0, 1); DSA_MM(accB, src, 1, 1); DSA_EPI(accA, tb_, 1, 0); DSA_EPI(accB, tb_, 1, 1); } while (0)
            for (int tb = F.wave * 2; tb < ntiles; tb += NWAVES * 2) { DSA_LOADT(bcur, tb); DSA_COMPT(bcur, tb); }
#undef DSA_LOADT
#undef DSA_COMPT
#undef DSA_MM
#undef DSA_EPI
        }
        __syncthreads();
        if (mode == 1) continue;
#pragma unroll 1
        for (int rd = 0; rd < 2; ++rd) {
        const int tok = 2 * rd + grp;
        const int n = s0 + tok + 1; unsigned k = (unsigned)(n < 256 ? n : 256); unsigned prefix = 0u;
        const LAS unsigned short* sc = SC + tok * 16384; LAS unsigned* hs = hist + grp * 256;
        unsigned kreg[64];
#pragma unroll
        for (int j = 0; j < 64; ++j) { const int i = ltid + 256 * j; kreg[j] = (i < n) ? (unsigned)sc[i] : 0u; }
        unsigned lmax = 0u;
#pragma unroll
        for (int j = 0; j < 64; ++j) lmax = (kreg[j] > lmax) ? kreg[j] : lmax;
        unsigned wmin = lmax;
#pragma unroll
        for (int o = 32; o >= 1; o >>= 1) { const unsigned tmp = __shfl_xor(wmin, o); wmin = tmp < wmin ? tmp : wmin; }
        if (F.lane == 0) wtot[16 + F.wave] = (int)wmin;
        __syncthreads();
        unsigned lbound = 0xFFFFFFFFu;
#pragma unroll
        for (int w = 0; w < 4; ++w) { const unsigned x = (unsigned)wtot[16 + grp * 4 + w]; lbound = x < lbound ? x : lbound; }
        LAS unsigned* seg = LST + (grp * 4 + lw) * 512; int ccnt = 0;
        {
            const unsigned long long below = (F.lane == 0) ? 0ull : ((~0ull) >> (64 - F.lane));
#pragma unroll
            for (int j = 0; j < 64; ++j) { if (256 * j < n) { const bool c = ((ltid + 256 * j) < n) && (kreg[j] >= lbound); const unsigned long long m = __ballot(c);
                const int pos = ccnt + __popcll(m & below); if (c && pos < 512) seg[pos] = kreg[j]; ccnt += __popcll(m); } }
        }
        const bool fast = ccnt <= 512;
        asm volatile("s_waitcnt lgkmcnt(0)" ::: "memory"); __builtin_amdgcn_wave_barrier();
#pragma unroll 1
        for (int pass = 0; pass < 2; ++pass) {
            const int shift = 8 - 8 * pass;
            hs[ltid] = 0u;
            __syncthreads();
            if (fast) {
#pragma unroll
                for (int i = 0; i < 8; ++i) { if (64 * i < ccnt) { const int c_ = F.lane + 64 * i; const bool valid = c_ < ccnt; const unsigned kv = valid ? seg[c_] : 0u;
                    const bool match = (pass == 0) ? true : ((kv >> 8) == prefix);
                    if (valid && match) (void)__hip_atomic_fetch_add(&hs[(kv >> shift) & 255u], 1u, __ATOMIC_RELAXED, __HIP_MEMORY_SCOPE_WORKGROUP); } }
            } else {
#pragma unroll
                for (int j = 0; j < 64; ++j) { if (256 * j < n) { const unsigned kv = kreg[j]; const bool valid = ((ltid + 256 * j) < n) && (kv >= lbound);
                    const bool match = (pass == 0) ? true : ((kv >> 8) == prefix);
                    if (valid && match) (void)__hip_atomic_fetch_add(&hs[(kv >> shift) & 255u], 1u, __ATOMIC_RELAXED, __HIP_MEMORY_SCOPE_WORKGROUP); } }
            }
            __syncthreads();
            if (lw == 0) {
                const unsigned c0 = hs[4 * F.lane], c1 = hs[4 * F.lane + 1], c2 = hs[4 * F.lane + 2], c3 = hs[4 * F.lane + 3];
                const unsigned tot = c0 + c1 + c2 + c3; unsigned suf = tot;
#pragma unroll
                for (int o = 1; o < 64; o <<= 1) { const unsigned tmp = __shfl_down(suf, o); if (F.lane + o < 64) suf += tmp; }
                unsigned above = suf - tot;
                if (above < k && k <= suf) {
                    int bin;
                    if (above + c3 >= k) { bin = 3; } else { above += c3; if (above + c2 >= k) { bin = 2; } else { above += c2; if (above + c1 >= k) { bin = 1; } else { above += c1; bin = 0; } } }
                    res[grp * 2 + 0] = (unsigned)(4 * F.lane + bin); res[grp * 2 + 1] = k - above;
                }
            }
            __syncthreads();
            prefix = (prefix << 8) | res[grp * 2 + 0]; k = res[grp * 2 + 1];
        }
        const unsigned tau = prefix; const int krem = (int)k;
        int cg = 0, ce = 0;
#pragma unroll
        for (int j = 0; j < 64; ++j) { const bool valid = (ltid + 256 * j) < n; cg += (valid && kreg[j] > tau) ? 1 : 0; ce += (valid && kreg[j] == tau) ? 1 : 0; }
        int ig = cg, ie = ce;
#pragma unroll
        for (int o = 1; o < 64; o <<= 1) { const int tg = __shfl_up(ig, o), te = __shfl_up(ie, o); if (F.lane >= o) { ig += tg; ie += te; } }
        if (F.lane == 63) { wtot[F.wave * 2] = ig; wtot[F.wave * 2 + 1] = ie; }
        __syncthreads();
        int og = ig - cg, oe = ie - ce, totg = 0;
        for (int w = 0; w < 4; ++w) { const int a = wtot[(grp * 4 + w) * 2], e = wtot[(grp * 4 + w) * 2 + 1]; if (w < lw) { og += a; oe += e; } totg += a; }
        unsigned short* sel = SEL + (size_t)(t0 + tok) * 256;
#pragma unroll
        for (int j = 0; j < 64; ++j) { if (256 * j < n) { const int i = ltid + 256 * j; if (i < n) { const unsigned kv = kreg[j];
            if (kv > tau) { sel[og++] = (unsigned short)i; }
            else if (kv == tau) { if (oe < krem) sel[totg + oe] = (unsigned short)i; ++oe; } } } }
        if (ltid == 0) CNT[t0 + tok] = (n < 256 ? n : 256);
        __syncthreads();
        }
    }
}

__device__ __forceinline__ float sum8_dpp(float v) { v += dppf<0xB1, 0xF>(v); v += dppf<0x4E, 0xF>(v); v += dppf<0x141, 0xF>(v); return v; }
__device__ __forceinline__ void ph_dsa_attn(const Args& A, Frame& F, const XInfo X) {
    const bf16* Z = (const bf16*)(A.ws + WS_Z); const unsigned short* SEL = (const unsigned short*)(A.ws + WS_LA); const int* CNT = (const int*)(A.ws + WS_CNT);
    const unsigned char* K8 = A.ws + WS_BIG + 264 * MiB; const unsigned char* V8 = A.ws + WS_BIG + 280 * MiB; bf16* Y = (bf16*)(A.ws + WS_HY);
    LAS int* IDX = (LAS int*)(F.lds + F.wave * 5120);
    LAS float* SCR = (LAS float*)(F.lds + F.wave * 5120 + 1024);
    const int g8 = F.lane >> 3, c8 = F.lane & 7;
    for (int sl = X.rx; sl < 8; sl += X.nx) {
        const int b = sl >> 2, kvh = sl & 3;
        const unsigned char* kb = K8 + (size_t)sl * SEQ * 128 + 16 * c8; const unsigned char* vb = V8 + (size_t)sl * SEQ * 128 + 16 * c8;
        for (int sq = X.rank * NWAVES + F.wave; sq < SEQ; sq += X.nloc * NWAVES) {
            const int t = b * SEQ + sq; const int n = CNT[t];
            const int l15 = F.lane & 15, g4 = F.lane >> 4;
            long bq[4];
#pragma unroll
            for (int c = 0; c < 2; ++c) {
                float f[16];
#pragma unroll
                for (int e = 0; e < 16; ++e) f[e] = 0.f;
                if (l15 < 4) { const bf16* qp = Z + (size_t)t * OD_NP + (kvh * 4 + l15) * 128 + 64 * c + 16 * g4; const u32x4 a = *(const u32x4*)qp, b2 = *(const u32x4*)(qp + 8);
                    const unsigned aw[8] = {a.x, a.y, a.z, a.w, b2.x, b2.y, b2.z, b2.w};
#pragma unroll
                    for (int q = 0; q < 8; ++q) { f[2 * q] = lo2f(aw[q]) * 16.0f; f[2 * q + 1] = hi2f(aw[q]) * 16.0f; } }
#pragma unroll
                for (int hf = 0; hf < 2; ++hf) {
                    int lo = __builtin_amdgcn_cvt_pk_fp8_f32(f[8 * hf + 0], f[8 * hf + 1], 0, false); lo = __builtin_amdgcn_cvt_pk_fp8_f32(f[8 * hf + 2], f[8 * hf + 3], lo, true);
                    int hi = __builtin_amdgcn_cvt_pk_fp8_f32(f[8 * hf + 4], f[8 * hf + 5], 0, false); hi = __builtin_amdgcn_cvt_pk_fp8_f32(f[8 * hf + 6], f[8 * hf + 7], hi, true);
                    bq[2 * c + hf] = (long)(((unsigned long long)(unsigned)hi << 32) | (unsigned long long)(unsigned)lo); }
            }
#pragma unroll
            for (int m = 0; m < 4; ++m) { const int jj = F.lane + 64 * m; IDX[jj] = (jj < n) ? (int)SEL[(size_t)t * 256 + jj] : 0; }
            asm volatile("s_waitcnt lgkmcnt(0)" ::: "memory"); __builtin_amdgcn_wave_barrier();
            {
                const unsigned char* kq = K8 + (size_t)sl * SEQ * 128 + 16 * g4;
#pragma unroll 1
                for (int tl0 = 0; tl0 < 16; tl0 += 4) {
                    u32x4 k0[4], k1[4];
#pragma unroll
                    for (int u = 0; u < 4; ++u) { const int id = IDX[(tl0 + u) * 16 + l15]; const unsigned char* kr = kq + (size_t)id * 128; k0[u] = *(const u32x4*)kr; k1[u] = *(const u32x4*)(kr + 64); }
#pragma unroll
                    for (int u = 0; u < 4; ++u) {
                        f32x4 acc = {0.f, 0.f, 0.f, 0.f};
                        acc = __builtin_amdgcn_mfma_f32_16x16x32_fp8_fp8((long)(((unsigned long long)k0[u].y << 32) | k0[u].x), bq[0], acc, 0, 0, 0);
                        acc = __builtin_amdgcn_mfma_f32_16x16x32_fp8_fp8((long)(((unsigned long long)k0[u].w << 32) | k0[u].z), bq[1], acc, 0, 0, 0);
                        acc = __builtin_amdgcn_mfma_f32_16x16x32_fp8_fp8((long)(((unsigned long long)k1[u].y << 32) | k1[u].x), bq[2], acc, 0, 0, 0);
                        acc = __builtin_amdgcn_mfma_f32_16x16x32_fp8_fp8((long)(((unsigned long long)k1[u].w << 32) | k1[u].z), bq[3], acc, 0, 0, 0);
                        if (l15 < 4) {
#pragma unroll
                            for (int rg = 0; rg < 4; ++rg) SCR[((tl0 + u) * 16 + 4 * g4 + rg) * 4 + l15] = acc[rg] * 3.452669831e-4f; }
                    }
                }
            }
            asm volatile("s_waitcnt lgkmcnt(0)" ::: "memory"); __builtin_amdgcn_wave_barrier();
            {
                f32x4 sv[4];
#pragma unroll
                for (int m = 0; m < 4; ++m) sv[m] = *(const LAS f32x4*)(SCR + (F.lane + 64 * m) * 4);
#pragma unroll
                for (int g = 0; g < 4; ++g) {
                    float mx = -INFINITY;
#pragma unroll
                    for (int m = 0; m < 4; ++m) { const bool val = (F.lane + 64 * m) < n; sv[m][g] = val ? sv[m][g] : -INFINITY; mx = fmaxf(mx, sv[m][g]); }
                    mx = wmax(mx); float sm = 0.f;
#pragma unroll
                    for (int m = 0; m < 4; ++m) { const bool val = (F.lane + 64 * m) < n; sv[m][g] = val ? expf(sv[m][g] - mx) : 0.f; sm += sv[m][g]; }
                    const float rden = 0.0625f / wsum(sm);
#pragma unroll
                    for (int m = 0; m < 4; ++m) sv[m][g] *= rden;
                }
#pragma unroll
                for (int m = 0; m < 4; ++m) *(LAS f32x4*)(SCR + (F.lane + 64 * m) * 4) = sv[m];
            }
            asm volatile("s_waitcnt lgkmcnt(0)" ::: "memory"); __builtin_amdgcn_wave_barrier();
            f32x2 o[4][8];
#pragma unroll
            for (int g = 0; g < 4; ++g)
#pragma unroll
                for (int q = 0; q < 8; ++q) o[g][q] = (f32x2){0.f, 0.f};
#pragma unroll 1
            for (int i0 = 0; i0 < 32; i0 += 4) {
                u32x4 vd[4]; f32x4 pv[4];
#pragma unroll
                for (int u = 0; u < 4; ++u) { const int id = IDX[8 * (i0 + u) + g8]; vd[u] = *(const u32x4*)(vb + (size_t)id * 128); pv[u] = *(const LAS f32x4*)(SCR + (8 * (i0 + u) + g8) * 4); }
#pragma unroll
                for (int u = 0; u < 4; ++u) {
                    const unsigned w[4] = {vd[u].x, vd[u].y, vd[u].z, vd[u].w}; f32x2 v2[8];
#pragma unroll
                    for (int q = 0; q < 4; ++q) { v2[2 * q] = __builtin_amdgcn_cvt_pk_f32_fp8((int)w[q], false); v2[2 * q + 1] = __builtin_amdgcn_cvt_pk_f32_fp8((int)w[q], true); }
#pragma unroll
                    for (int g = 0; g < 4; ++g) { const f32x2 pg = {pv[u][g], pv[u][g]};
#pragma unroll
                        for (int q = 0; q < 8; ++q) o[g][q] = pg * v2[q] + o[g][q]; }
                }
            }
            f32x2 mine[8];
#pragma unroll
            for (int q = 0; q < 8; ++q) {
                float x[4][2];
#pragma unroll
                for (int g = 0; g < 4; ++g) { float a0 = o[g][q].x, a1 = o[g][q].y;
                    a0 += dppf<0x128, 0xF>(a0); a1 += dppf<0x128, 0xF>(a1);
                    a0 += __shfl_xor(a0, 16); a0 += __shfl_xor(a0, 32); a1 += __shfl_xor(a1, 16); a1 += __shfl_xor(a1, 32); x[g][0] = a0; x[g][1] = a1; }
                mine[q].x = (g8 == 0) ? x[0][0] : ((g8 == 1) ? x[1][0] : ((g8 == 2) ? x[2][0] : x[3][0]));
                mine[q].y = (g8 == 0) ? x[0][1] : ((g8 == 1) ? x[1][1] : ((g8 == 2) ? x[2][1] : x[3][1]));
            }
            if (g8 < 4) { u32x4 w0, w1;
                w0.x = pk2(mine[0].x, mine[0].y); w0.y = pk2(mine[1].x, mine[1].y); w0.z = pk2(mine[2].x, mine[2].y); w0.w = pk2(mine[3].x, mine[3].y);
                w1.x = pk2(mine[4].x, mine[4].y); w1.y = pk2(mine[5].x, mine[5].y); w1.z = pk2(mine[6].x, mine[6].y); w1.w = pk2(mine[7].x, mine[7].y);
                bf16* yp = Y + (size_t)t * DM + (kvh * 4 + g8) * 128 + 16 * c8; *(u32x4*)yp = w0; *(u32x4*)(yp + 8) = w1; }
            asm volatile("s_waitcnt lgkmcnt(0)" ::: "memory"); __builtin_amdgcn_wave_barrier();
        }
    }
}

__global__ void __launch_bounds__(NTHREADS, 2) mk_fwd(Args args) {
    extern __shared__ __attribute__((aligned(16))) unsigned char lds[];
    Frame F;
    F.lds = (LAS unsigned char*)lds;
    volatile LAS unsigned* MISC = (volatile LAS unsigned*)(F.lds + MISC_OFF);
    F.tid = threadIdx.x; F.lane = F.tid & 63; F.wave = __builtin_amdgcn_readfirstlane(F.tid >> 6);
    F.bx = blockIdx.x; F.G = gridDim.x; F.gw = F.bx * NWAVES + F.wave; F.ngw = F.G * NWAVES;
    if (F.tid < 64) MISC[F.tid] = 0u;
    __syncthreads();
    unsigned char* ws = args.ws;
    XcdBarrier bar = xcd_barrier_post((unsigned*)(ws + WS_CTL) + CW_BAR, MISC + 8);
    if (F.tid == 0) { MISC[16] = xb_add((unsigned*)(ws + WS_CTL) + CW_XRANK + 64 * bar.x, 1u); }
    const int lo = args.ph_lo, hi = args.ph_hi;
#define IN(k) (lo <= (k) && (k) < hi)
#define SEAM(k) do { if (IN((k) + 1)) xcd_barrier(bar); } while (0)
#define GEMM_BF16(Aptr, Bptr, Nn, Kk, Optr, ldo) do { pg8::Gemm g{(const pg8::bf16_t*)(Aptr), (const pg8::bf16_t*)(Bptr), TOK, (Nn), (Kk)}; pg8::StaticOrder S; S.init(TOK, (Nn), F.G, F.bx); \
        pg8::EpiBf16<0> E{(pg8::bf16_t*)(Optr), (ldo), nullptr, 0, 0}; pg8::gemm_phase<pg8::EpiBf16<0>, pg8::StaticOrder, false>(F.lds, g, S, E, nullptr); } while (0)

#ifndef PROBE_MASK
#define PROBE_MASK 0
#endif
#define PRB(bit, stmt) do { if (PROBE_MASK & (1 << (bit))) { stmt; xcd_barrier(bar); } } while (0)
    if (IN(0)) { PRB(14, ph_prologue(args, F)); ph_prologue(args, F); SEAM(0); }
    if (IN(1)) { ph_mod_x(args, F); SEAM(1); }
    if (F.tid == 0) {
        unsigned* cb = (unsigned*)(ws + WS_CTL) + CW_BAR; unsigned nloc = 1u, rx = 0u, nx = 0u;
        for (unsigned j = 0; j < 16; ++j) { const unsigned c = xb_ld(&cb[XB_XCNT(j)]); if (c > 0u) { if (j < bar.x) ++rx; ++nx; } if (j == bar.x) nloc = c > 0u ? c : 1u; }
        if (nx == 0u) nx = 1u;
        MISC[17] = nloc; MISC[18] = rx; MISC[19] = nx; }
    __syncthreads();
    const XInfo XI = xcc_info(MISC);
    if (IN(2)) { PRB(8, GEMM_BF16(ws + WS_HY, ws + WS_WINE, EV_NP, 2048, ws + WS_Z, EV_NP)); GEMM_BF16(ws + WS_HY, ws + WS_WINE, EV_NP, 2048, ws + WS_Z, EV_NP); SEAM(2); }
    if (IN(3)) { ph_even_post(args, F); SEAM(3); }
    if (IN(4)) { pg8::Gemm g{(const pg8::bf16_t*)(ws + WS_LA), (const pg8::bf16_t*)(ws + WS_WL), TOK, 3072, 512}; pg8::StaticOrder S; S.init(TOK, 3072, F.G, F.bx);
                 EpiLora E{(pg8::bf16_t*)(ws + WS_Z) + 1280, EV_NP, (const float*)args.in[7], (const float*)args.in[9]};
                 pg8::gemm_phase<EpiLora, pg8::StaticOrder, false>(F.lds, g, S, E, nullptr); SEAM(4); }
    if (IN(5)) { PRB(9, ph_scan_pack(args, F)); ph_scan_pack(args, F); xcd_barrier(bar); }
    if (IN(7)) { PRB(15, ph_scan(args, F, MISC)); ph_scan(args, F, MISC); SEAM(7); }
    if (IN(8)) { PRB(10, ph_rwkv_finish(args, F)); ph_rwkv_finish(args, F); SEAM(8); }
    if (IN(9)) { GEMM_BF16(ws + WS_HY, ws + WS_WOUTE, 2048, 2048, ws + WS_Z, 2048); SEAM(9); }
    if (IN(10)) { PRB(11, ph_ln_mixer(args, F, 0)); ph_ln_mixer(args, F, 0); SEAM(10); }
    if (IN(11)) { GEMM_BF16(ws + WS_HY, ws + WS_WQ0, 2048, 2048, ws + WS_Z, 2048); SEAM(11); }
    if (IN(12)) { PRB(4, ph_peer_select(args, F, 0)); ph_peer_select(args, F, 0); SEAM(12); }
    if (IN(13)) { PRB(12, ph_peer_u(args, F, XI)); ph_peer_u(args, F, XI); xcd_barrier(bar); ph_peer_act(args, F); xcd_barrier(bar); PRB(13, ph_peer_v(args, F, XI)); ph_peer_v(args, F, XI); xcd_barrier(bar); ph_peer_ln(args, F, 0); SEAM(13); }
    if (IN(14)) { GEMM_BF16(ws + WS_HY, ws + WS_WINO, OD_NP, 2048, ws + WS_Z, OD_NP); SEAM(14); }
    if (IN(15)) { ph_odd_post(args, F); SEAM(15); }
    if (IN(16)) { PRB(2, ph_dsa_select(args, F, 1)); PRB(6, ph_dsa_select(args, F, 2)); PRB(7, ph_dsa_select(args, F, 0)); ph_dsa_select(args, F); SEAM(16); }
    if (IN(17)) { ph_dsa_attn(args, F, XI); SEAM(17); }
    if (IN(18)) { GEMM_BF16(ws + WS_HY, ws + WS_WOUTO, 2048, 2048, ws + WS_Z, 2048); SEAM(18); }
    if (IN(19)) { ph_ln_mixer(args, F, 1); SEAM(19); }
    if (IN(20)) { GEMM_BF16(ws + WS_HY, ws + WS_WQ1, 2048, 2048, ws + WS_Z, 2048); SEAM(20); }
    if (IN(21)) { PRB(4, ph_peer_select(args, F, 1)); ph_peer_select(args, F, 1); SEAM(21); }
    if (IN(22)) { ph_peer_u(args, F, XI); xcd_barrier(bar); ph_peer_act(args, F); xcd_barrier(bar); ph_peer_v(args, F, XI); xcd_barrier(bar); ph_peer_ln(args, F, 1); }
#undef IN
#undef SEAM
#undef GEMM_BF16
}

#ifndef MK_SPLIT
#define MK_SPLIT 0
#endif
extern "C" void kernel_launch(void* const* d_in, const int* in_sizes, int n_in, void* d_out, int out_size, void* d_ws, size_t ws_size, hipStream_t stream) {
    static int grid = 0;
    if (grid == 0) {
        int dev = 0, cus = 0;
        if (n_in != 27 || out_size != TOK * DM || ws_size < WS_END) { fprintf(stderr, "kernel_launch: unexpected shapes (n_in %d out %d ws %zu)\n", n_in, out_size, ws_size); grid = -1; return; }
        if (hipGetDevice(&dev) != hipSuccess || hipDeviceGetAttribute(&cus, hipDeviceAttributeMultiprocessorCount, dev) != hipSuccess) { grid = -1; return; }
        if (hipFuncSetAttribute((const void*)mk_fwd, hipFuncAttributeMaxDynamicSharedMemorySize, LDS_BYTES) != hipSuccess) { fprintf(stderr, "kernel_launch: hipFuncSetAttribute failed\n"); grid = -1; return; }
        int per_cu = 0;
        if (hipOccupancyMaxActiveBlocksPerMultiprocessor(&per_cu, (const void*)mk_fwd, NTHREADS, LDS_BYTES) != hipSuccess || per_cu < 1) fprintf(stderr, "kernel_launch: occupancy query says %d\n", per_cu);
        (void)hipGetLastError();
        grid = cus;
    }
    if (grid < 0) return;
    (void)hipMemsetAsync((char*)d_ws + WS_CTL, 0, CTL_ZERO_BYTES, stream);
    Args a{};
    for (int i = 0; i < 27; ++i) a.in[i] = d_in[i];
    a.out = (float*)d_out; a.ws = (unsigned char*)d_ws;
#if MK_SPLIT
    for (int p = 0; p < 23; ++p) { a.ph_lo = p; a.ph_hi = p + 1; hipLaunchKernelGGL(mk_fwd, dim3(grid), dim3(NTHREADS), LDS_BYTES, stream, a); }
#else
    a.ph_lo = 0; a.ph_hi = 23;
    hipLaunchKernelGGL(mk_fwd, dim3(grid), dim3(NTHREADS), LDS_BYTES, stream, a);
#endif
}
```

```cpp
#include <hip/hip_runtime.h>
#include <cstdio>
#include <cstdint>
namespace pg8 {
#define PG8_LAS __attribute__((address_space(3)))
typedef unsigned short bf16_t;
typedef short bf16x8 __attribute__((ext_vector_type(8)));
typedef float f32x4 __attribute__((ext_vector_type(4)));
typedef unsigned u32x4 __attribute__((ext_vector_type(4)));
constexpr int BM = 256, BK = 64, HALF = 128, HTB = HALF * BK * 2  , STAGE_BYTES = 8 * HTB, NXCD = 8, WGM = 8;

__host__ __device__ __forceinline__ int lds_byte(int r, int c) { const int st = (r >> 4) * 2 + (c >> 5), rr = r & 15, cc = c & 31, ob = rr * 64 + cc * 2; return st * 1024 + (ob ^ (((ob >> 9) & 1) << 5)); }
__host__ __device__ __forceinline__ void stage_rc(int b, int& R, int& C) { const int st = b / 1024, sb = b % 1024, swz = sb ^ (((sb >> 9) & 1) << 5); R = (st >> 1) * 16 + swz / 64; C = (st & 1) * 32 + (swz % 64) / 2; }
__host__ __device__ __forceinline__ int perm32(int rho) { const int n = rho >> 4, i = rho & 15; return 8 * (i >> 2) + 4 * n + (i & 3); }

struct Unit { int pm, pn; };
struct Gemm { const bf16_t* A; const bf16_t* Bt; int M, N, K; };

struct StaticOrder {
    int nM, nN, nwg, G, c;
    __host__ __device__ void init(int M, int N, int G_, int c_) { nM = M / BM; nN = N / BM; nwg = nM * nN; G = G_; c = c_; }
    __host__ __device__ bool next(int i, Unit& u) const {
        const long L = (long)i * G + c; if (L >= nwg) return false;
        int wgid = (int)L; { const int q = nwg / NXCD, r = nwg % NXCD, xcd = wgid % NXCD, off = wgid / NXCD; wgid = (xcd < r ? xcd * (q + 1) : r * (q + 1) + (xcd - r) * q) + off; }
        const int nig = WGM * nN, gid = wgid / nig, fm = gid * WGM, gsz = (nM - fm) < WGM ? (nM - fm) : WGM;
        u.pm = fm + ((wgid % nig) % gsz); u.pn = (wgid % nig) / gsz; return true;
    }
    __device__ __forceinline__ void a_ready(const Unit&) const {}
    __device__ __forceinline__ void done(const Unit&) const {}
};
struct CountedOrder : StaticOrder {
    const unsigned* ready; unsigned need; unsigned* tmo;
    __device__ __forceinline__ void a_ready(const Unit& u) const {
        if (threadIdx.x < 64) {
            const unsigned long long t0 = __builtin_amdgcn_s_memrealtime(); unsigned polls = 0;
            while ((unsigned)__builtin_amdgcn_readfirstlane(__hip_atomic_load(ready + 64 * u.pm, __ATOMIC_RELAXED, __HIP_MEMORY_SCOPE_AGENT)) < need) {
                if ((++polls & 255u) == 0u && __builtin_amdgcn_readfirstlane(__hip_atomic_load(tmo, __ATOMIC_RELAXED, __HIP_MEMORY_SCOPE_AGENT)) != 0u) break;
                if (__builtin_amdgcn_s_memrealtime() - t0 > 2000000ull) {
                    if (threadIdx.x == 0) { unsigned expect = 0u; __hip_atomic_compare_exchange_strong(tmo + 1, &expect, 0x600u | (unsigned)(u.pm & 0xff), __ATOMIC_RELAXED, __ATOMIC_RELAXED, __HIP_MEMORY_SCOPE_AGENT); __hip_atomic_store(tmo, 1u, __ATOMIC_RELAXED, __HIP_MEMORY_SCOPE_AGENT); }
                    break; }
                __builtin_amdgcn_s_sleep(2); }
            __builtin_amdgcn_fence(__ATOMIC_ACQUIRE, "agent");
            asm volatile("s_waitcnt vmcnt(0)" ::: "memory");
        }
#if !defined(BROKEN_HOOK_NO_BARRIER)
        asm volatile("" ::: "memory"); __builtin_amdgcn_s_barrier(); asm volatile("" ::: "memory");
#endif
    }
};

__device__ __forceinline__ unsigned cvt_pk_bf16(float lo, float hi) { unsigned r; asm volatile("v_cvt_pk_bf16_f32 %0, %1, %2" : "=v"(r) : "v"(lo), "v"(hi)); return r; }
typedef float f32x2 __attribute__((ext_vector_type(2)));
__device__ __forceinline__ f32x2 gelu_pk(f32x2 v) {
    const f32x2 av = __builtin_elementwise_abs(v), d = av * 0.2316418882f + 1.0f;
    f32x2 t; t.x = __builtin_amdgcn_rcpf(d.x); t.y = __builtin_amdgcn_rcpf(d.y);
    f32x2 q = t * 0.5307027145f + (-0.7265760135f); q = q * t + 0.7107068705f; q = q * t + (-0.142248368f); q = q * t + 0.127414796f; q = q * t;
    const f32x2 s = (v * v) * (-0.72134752044f);
    f32x2 e; e.x = __builtin_amdgcn_exp2f(s.x); e.y = __builtin_amdgcn_exp2f(s.y);
    const f32x2 m = v * (q * e), r = v - m;
    f32x2 o; o.x = v.x < 0.f ? m.x : r.x; o.y = v.y < 0.f ? m.y : r.y; return o;
}

struct EpiF32 {
    static constexpr bool PERM = false, AFTER_DRAIN = false;
    float* C; int ldc; const float* bias;
    __device__ __forceinline__ void operator()(const f32x4 (&acc)[2][2][4][2], const Unit& u, int wr, int wc, int fr, int fq) const {
        const int row0 = u.pm * BM + wr * 64 + fr, col0 = u.pn * BM + wc * 32 + 4 * fq;
        f32x4 bv[2][2];
#pragma unroll
        for (int bj = 0; bj < 2; ++bj)
#pragma unroll
            for (int n = 0; n < 2; ++n) bv[bj][n] = bias ? *(const f32x4*)(bias + col0 + bj * HALF + n * 16) : (f32x4){0.f, 0.f, 0.f, 0.f};
#pragma unroll
        for (int ai = 0; ai < 2; ++ai)
#pragma unroll
            for (int m = 0; m < 4; ++m) { float* rowp = C + (size_t)(row0 + ai * HALF + m * 16) * ldc + col0;
#pragma unroll
                for (int bj = 0; bj < 2; ++bj)
#pragma unroll
                    for (int n = 0; n < 2; ++n) *(f32x4*)(rowp + bj * HALF + n * 16) = acc[ai][bj][m][n] + bv[bj][n]; }
    }
};
template <int ACT  > struct EpiBf16 {
    static constexpr bool PERM = true, AFTER_DRAIN = false;
    bf16_t* O; int ldc; const float* bias; int split_cols; size_t split_stride;
    __device__ __forceinline__ void operator()(const f32x4 (&acc)[2][2][4][2], const Unit& u, int wr, int wc, int fr, int fq) const {
        const int row0 = u.pm * BM + wr * 64 + fr; int colt = u.pn * BM; bf16_t* base = O;
        if (split_cols) { const int t = colt / split_cols; base += (size_t)t * split_stride; colt -= t * split_cols; }
        const int col0 = colt + wc * 32 + 8 * fq, bcol0 = u.pn * BM + wc * 32 + 8 * fq;
        f32x4 bv[2][2];
#pragma unroll
        for (int bj = 0; bj < 2; ++bj)
#pragma unroll
            for (int n = 0; n < 2; ++n) bv[bj][n] = bias ? *(const f32x4*)(bias + bcol0 + bj * HALF + 4 * n) : (f32x4){0.f, 0.f, 0.f, 0.f};
#pragma unroll
        for (int ai = 0; ai < 2; ++ai)
#pragma unroll
            for (int m = 0; m < 4; ++m) { bf16_t* rowp = base + (size_t)(row0 + ai * HALF + m * 16) * ldc + col0;
#pragma unroll
                for (int bj = 0; bj < 2; ++bj) { f32x4 v0 = acc[ai][bj][m][0] + bv[bj][0], v1 = acc[ai][bj][m][1] + bv[bj][1];
                    if (ACT == 1) { f32x2 a = gelu_pk((f32x2){v0[0], v0[1]}), b = gelu_pk((f32x2){v0[2], v0[3]}), c = gelu_pk((f32x2){v1[0], v1[1]}), d = gelu_pk((f32x2){v1[2], v1[3]});
                        v0 = (f32x4){a.x, a.y, b.x, b.y}; v1 = (f32x4){c.x, c.y, d.x, d.y}; }
                    if (ACT == 2) {
#pragma unroll
                        for (int j = 0; j < 4; ++j) { v0[j] = 0.5f * v0[j] * (1.0f + erff(v0[j] * 0.70710678f)); v1[j] = 0.5f * v1[j] * (1.0f + erff(v1[j] * 0.70710678f)); } }
                    u32x4 w; w.x = cvt_pk_bf16(v0[0], v0[1]); w.y = cvt_pk_bf16(v0[2], v0[3]); w.z = cvt_pk_bf16(v1[0], v1[1]); w.w = cvt_pk_bf16(v1[2], v1[3]);
                    *(u32x4*)(rowp + bj * HALF) = w; } }
    }
};

struct PanelStats {
    unsigned* xbuf;
    unsigned* cnt;
    unsigned* tmo;
    int ntn; float eps;
    unsigned code;
    __device__ __forceinline__ bool run(const f32x4 (&v)[2][2][4][2], const Unit& u, int wr, int wc, int fr, int fq, PG8_LAS unsigned char* lds, int wid, int lane) const {
        typedef float f32x2v __attribute__((ext_vector_type(2)));
        PG8_LAS f32x2v* P = (PG8_LAS f32x2v*)lds;
        PG8_LAS f32x2v* S = (PG8_LAS f32x2v*)(lds + 8192);
        PG8_LAS unsigned* flag = (PG8_LAS unsigned*)(lds + 8192 + 2048);
#pragma unroll
        for (int ai = 0; ai < 2; ++ai)
#pragma unroll
            for (int m = 0; m < 4; ++m) {
                float s = 0.f;
#pragma unroll
                for (int bj = 0; bj < 2; ++bj)
#pragma unroll
                    for (int n = 0; n < 2; ++n) { const f32x4 x = v[ai][bj][m][n]; s += (x[0] + x[1]) + (x[2] + x[3]); }
                s += __shfl_xor(s, 16); s += __shfl_xor(s, 32);
                const float mw = s * (1.0f / 64.0f); float q = 0.f;
#pragma unroll
                for (int bj = 0; bj < 2; ++bj)
#pragma unroll
                    for (int n = 0; n < 2; ++n) { const f32x4 d = v[ai][bj][m][n] - mw; q += (d[0] * d[0] + d[1] * d[1]) + (d[2] * d[2] + d[3] * d[3]); }
                q += __shfl_xor(q, 16); q += __shfl_xor(q, 32);
                if (fq == 0) P[(ai * HALF + wr * 64 + m * 16 + fr) * 4 + wc] = (f32x2v){mw, q};
            }
        asm volatile("s_waitcnt lgkmcnt(0)" ::: "memory"); __builtin_amdgcn_s_barrier(); asm volatile("" ::: "memory");
#if defined(BROKEN_NO_WAIT)
        if (blockIdx.x >= 64) { const long long t0 = clock64(); while (clock64() - t0 < 60000) __builtin_amdgcn_s_sleep(8); }
#endif
        const int row = wid * 32 + (lane & 31);
        if (lane < 32) {
            const f32x2v a = P[row * 4 + 0], b = P[row * 4 + 1], c = P[row * 4 + 2], d = P[row * 4 + 3];
            const float mt = (a.x + b.x + c.x + d.x) * 0.25f;
            const float da = a.x - mt, db = b.x - mt, dc = c.x - mt, dd = d.x - mt;
            const float m2 = (a.y + b.y) + (c.y + d.y) + 64.0f * ((da * da + db * db) + (dc * dc + dd * dd));
            unsigned long long* slot = (unsigned long long*)xbuf + ((size_t)(u.pm * BM + row) * 4 + u.pn);
            __hip_atomic_store(slot, ((unsigned long long)__float_as_uint(m2) << 32) | __float_as_uint(mt), __ATOMIC_RELAXED, __HIP_MEMORY_SCOPE_AGENT);
        }
        asm volatile("s_waitcnt vmcnt(0)" ::: "memory");
        if (lane == 0) __hip_atomic_fetch_add(cnt + 64 * u.pm, 1u, __ATOMIC_RELAXED, __HIP_MEMORY_SCOPE_AGENT);
        if (wid == 0) {
            bool dead = false; const unsigned long long t0 = __builtin_amdgcn_s_memrealtime(); const unsigned want = 8u * (unsigned)ntn;
            for (;;) {
#if defined(BROKEN_NO_WAIT)
                break;
#endif
                if ((unsigned)__builtin_amdgcn_readfirstlane(__hip_atomic_load(cnt + 64 * u.pm, __ATOMIC_RELAXED, __HIP_MEMORY_SCOPE_AGENT)) >= want) break;
                if (__builtin_amdgcn_s_memrealtime() - t0 > 2000000ull) {
                    if (lane == 0) { unsigned expect = 0u; __hip_atomic_compare_exchange_strong(tmo + 1, &expect, code | (unsigned)(u.pm & 0xff), __ATOMIC_RELAXED, __ATOMIC_RELAXED, __HIP_MEMORY_SCOPE_AGENT);
                                     __hip_atomic_store(tmo, 1u, __ATOMIC_RELAXED, __HIP_MEMORY_SCOPE_AGENT); }
                    dead = true; break; }
                __builtin_amdgcn_s_sleep(2);
            }
            __builtin_amdgcn_fence(__ATOMIC_ACQUIRE, "agent");
            if (lane == 0) flag[0] = dead ? 1u : 0u;
        }
        asm volatile("s_waitcnt vmcnt(0) lgkmcnt(0)" ::: "memory"); __builtin_amdgcn_s_barrier(); asm volatile("" ::: "memory");
        const bool bad = flag[0] != 0u;
        if (lane < 32) {
            const unsigned long long* slot = (const unsigned long long*)xbuf + (size_t)(u.pm * BM + row) * 4; float mt[4], m2[4]; float ms = 0.f;
#pragma unroll
            for (int t = 0; t < 4; ++t) { if (t < ntn) { const unsigned long long w = __hip_atomic_load(slot + t, __ATOMIC_RELAXED, __HIP_MEMORY_SCOPE_AGENT); mt[t] = __uint_as_float((unsigned)w); m2[t] = __uint_as_float((unsigned)(w >> 32)); } else { mt[t] = 0.f; m2[t] = 0.f; } ms += mt[t]; }
            const float mean = ms / (float)ntn; float q = 0.f;
#pragma unroll
            for (int t = 0; t < 4; ++t) if (t < ntn) { const float dm = mt[t] - mean; q += m2[t] + 256.0f * dm * dm; }
            S[row] = (f32x2v){mean, 1.0f / sqrtf(q / (256.0f * (float)ntn) + eps)};
        }
        asm volatile("s_waitcnt lgkmcnt(0)" ::: "memory"); __builtin_amdgcn_s_barrier(); asm volatile("" ::: "memory");
        return bad;
    }
};
struct EpiLnRes {
    static constexpr bool PERM = false, AFTER_DRAIN = true;
    const float* base; float* out; int ldc; const float* bias; PanelStats st; unsigned poison;
    __device__ __forceinline__ void refuse(size_t i0, size_t stride, int M, int N) const { const float q = __builtin_nanf(""); for (size_t i = i0; i < (size_t)M * N; i += stride) out[(i / N) * ldc + i % N] = q;
        if (i0 == 0) { unsigned expect = 0u; __hip_atomic_compare_exchange_strong(st.tmo + 1, &expect, 0x7f0u, __ATOMIC_RELAXED, __ATOMIC_RELAXED, __HIP_MEMORY_SCOPE_AGENT); __hip_atomic_store(st.tmo, 1u, __ATOMIC_RELAXED, __HIP_MEMORY_SCOPE_AGENT); } }
    __device__ __forceinline__ void fused(f32x4 (&acc)[2][2][4][2], const Unit& u, int wr, int wc, int fr, int fq, PG8_LAS unsigned char* lds, int wid, int lane) const {
        typedef float f32x2v __attribute__((ext_vector_type(2)));
        const PG8_LAS f32x2v* S = (const PG8_LAS f32x2v*)(lds + 8192);
        const int col0 = u.pn * BM + wc * 32 + 4 * fq;
#pragma unroll
        for (int bj = 0; bj < 2; ++bj)
#pragma unroll
            for (int n = 0; n < 2; ++n) { const f32x4 bv = bias ? *(const f32x4*)(bias + col0 + bj * HALF + n * 16) : (f32x4){0.f, 0.f, 0.f, 0.f};
#pragma unroll
                for (int ai = 0; ai < 2; ++ai)
#pragma unroll
                    for (int m = 0; m < 4; ++m) acc[ai][bj][m][n] += bv; }
        const bool bad = st.run(acc, u, wr, wc, fr, fq, lds, wid, lane) || poison != 0u;
        const float qnan = __builtin_nanf("");
#pragma unroll
        for (int ai = 0; ai < 2; ++ai)
#pragma unroll
            for (int m = 0; m < 4; ++m) { const int r = ai * HALF + wr * 64 + m * 16 + fr; const f32x2v sr = S[r]; const size_t off = (size_t)(u.pm * BM + r) * ldc + col0;
#pragma unroll
                for (int bj = 0; bj < 2; ++bj)
#pragma unroll
                    for (int n = 0; n < 2; ++n) { const f32x4 bs = *(const f32x4*)(base + off + bj * HALF + n * 16); f32x4 o = bs + (acc[ai][bj][m][n] - sr.x) * sr.y;
                        if (bad) o = (f32x4){qnan, qnan, qnan, qnan}; *(f32x4*)(out + off + bj * HALF + n * 16) = o; }
                asm volatile("" ::: "memory"); }
    }
};
struct EpiLnResLn {
    static constexpr bool PERM = false, AFTER_DRAIN = true;
    const float* base; float* out; bf16_t* xn; int ldc; const float* bias; PanelStats st1, st2; unsigned poison;
    __device__ __forceinline__ void refuse(size_t i0, size_t stride, int M, int N) const { const float q = __builtin_nanf(""); for (size_t i = i0; i < (size_t)M * N; i += stride) { const size_t o = (i / N) * ldc + i % N; out[o] = q; xn[o] = (bf16_t)0x7fc0u; }
        if (i0 == 0) { unsigned expect = 0u; __hip_atomic_compare_exchange_strong(st1.tmo + 1, &expect, 0x7f0u, __ATOMIC_RELAXED, __ATOMIC_RELAXED, __HIP_MEMORY_SCOPE_AGENT); __hip_atomic_store(st1.tmo, 1u, __ATOMIC_RELAXED, __HIP_MEMORY_SCOPE_AGENT); } }
    __device__ __forceinline__ void fused(f32x4 (&acc)[2][2][4][2], const Unit& u, int wr, int wc, int fr, int fq, PG8_LAS unsigned char* lds, int wid, int lane) const {
        typedef float f32x2v __attribute__((ext_vector_type(2))); typedef unsigned u32x2v __attribute__((ext_vector_type(2)));
        const PG8_LAS f32x2v* S = (const PG8_LAS f32x2v*)(lds + 8192);
        const int col0 = u.pn * BM + wc * 32 + 4 * fq;
#pragma unroll
        for (int bj = 0; bj < 2; ++bj)
#pragma unroll
            for (int n = 0; n < 2; ++n) { const f32x4 bv = bias ? *(const f32x4*)(bias + col0 + bj * HALF + n * 16) : (f32x4){0.f, 0.f, 0.f, 0.f};
#pragma unroll
                for (int ai = 0; ai < 2; ++ai)
#pragma unroll
                    for (int m = 0; m < 4; ++m) acc[ai][bj][m][n] += bv; }
        bool bad = st1.run(acc, u, wr, wc, fr, fq, lds, wid, lane) || poison != 0u;
        const float qnan = __builtin_nanf("");
#pragma unroll
        for (int ai = 0; ai < 2; ++ai)
#pragma unroll
            for (int m = 0; m < 4; ++m) { const int r = ai * HALF + wr * 64 + m * 16 + fr; const f32x2v sr = S[r]; const size_t off = (size_t)(u.pm * BM + r) * ldc + col0;
#pragma unroll
                for (int bj = 0; bj < 2; ++bj)
#pragma unroll
                    for (int n = 0; n < 2; ++n) { const f32x4 bs = *(const f32x4*)(base + off + bj * HALF + n * 16); acc[ai][bj][m][n] = bs + (acc[ai][bj][m][n] - sr.x) * sr.y; }
                asm volatile("" : "+v"(acc[ai][0][m][0]), "+v"(acc[ai][0][m][1]), "+v"(acc[ai][1][m][0]), "+v"(acc[ai][1][m][1]));
                if (m & 1) asm volatile("" ::: "memory"); }
        const bool bad1 = bad;
        bad = st2.run(acc, u, wr, wc, fr, fq, lds, wid, lane) || bad;
#pragma unroll
        for (int ai = 0; ai < 2; ++ai)
#pragma unroll
            for (int m = 0; m < 4; ++m) { const int r = ai * HALF + wr * 64 + m * 16 + fr; const f32x2v sr = S[r]; const size_t off = (size_t)(u.pm * BM + r) * ldc + col0;
#pragma unroll
                for (int bj = 0; bj < 2; ++bj)
#pragma unroll
                    for (int n = 0; n < 2; ++n) { const f32x4 x1 = acc[ai][bj][m][n]; *(f32x4*)(out + off + bj * HALF + n * 16) = bad1 ? (f32x4){qnan, qnan, qnan, qnan} : x1;
                        const f32x4 o = (x1 - sr.x) * sr.y; u32x2v w; w.x = cvt_pk_bf16(o[0], o[1]); w.y = cvt_pk_bf16(o[2], o[3]);
                        if (bad) { w.x = 0x7fc07fc0u; w.y = 0x7fc07fc0u; } *(u32x2v*)(xn + off + bj * HALF + n * 16) = w; }
                asm volatile("" ::: "memory"); }
    }
};

template <class Epi, class Sched, bool STAMP = false>
__device__ __forceinline__ void gemm_phase(PG8_LAS unsigned char* lds, const Gemm g, const Sched& S, const Epi& E, unsigned long long* stamps) {
    const int tid = threadIdx.x, wid = __builtin_amdgcn_readfirstlane(tid >> 6), lane = tid & 63, wr = wid >> 2, wc = wid & 3, fr = lane & 15, fq = lane >> 4;
    const int K = g.K, nt = K / BK;
    int ts_lo = 0, ts_hi = 0, nts = 0; const unsigned long long rt_entry = STAMP ? (unsigned long long)wall_clock64() : 0ull;
#define PG8_STAMP() do { if (STAMP && wid == 0 && nts < 64) { const unsigned long long _c = (unsigned long long)clock64(); \
        ts_lo = (lane == nts) ? (int)(unsigned)_c : ts_lo; ts_hi = (lane == nts) ? (int)(unsigned)(_c >> 32) : ts_hi; ++nts; } } while (0)
    PG8_STAMP();
    unsigned voffA[2], voffB[2];
#pragma unroll
    for (int i = 0; i < 2; ++i) { int R, C; stage_rc(tid * 16 + i * 8192, R, C); const int Rb = Epi::PERM ? ((R & ~31) + perm32(R & 31)) : R;
        voffA[i] = (unsigned)(R * K + C) * 2u; voffB[i] = (unsigned)(Rb * K + C) * 2u; }
    const size_t kstep = (size_t)(BK * 2);
    const size_t hstep = (size_t)HALF * K * 2;
    const size_t tstep = 2 * hstep;
    const unsigned ldsw = (unsigned)wid * 1024u;
    const int aoff = lds_byte(wr * 64 + fr, fq * 8), boff = lds_byte(wc * 32 + fr, fq * 8);
#define PG8_SA(b, h) (((b) * 2 + (h)) * HTB)
#define PG8_SB(b, h) ((4 + (b) * 2 + (h)) * HTB)
#define PG8_STAGE(bufoff, gbase, voff) do { _Pragma("unroll") for (int _i = 0; _i < 2; ++_i) \
        __builtin_amdgcn_global_load_lds((const unsigned*)((const char*)(gbase) + (voff)[_i]), (PG8_LAS unsigned*)(lds + (bufoff) + ldsw + _i * 8192), 16, 0, 0); } while (0)
#define PG8_LDA(dst, b, h) do { _Pragma("unroll") for (int m = 0; m < 4; ++m) _Pragma("unroll") for (int k = 0; k < 2; ++k) dst[m][k] = *(const PG8_LAS bf16x8*)(lds + PG8_SA(b, h) + aoff + m * 2048 + k * 1024); } while (0)
#define PG8_LDB(dst, b, h) do { _Pragma("unroll") for (int n = 0; n < 2; ++n) _Pragma("unroll") for (int k = 0; k < 2; ++k) dst[n][k] = *(const PG8_LAS bf16x8*)(lds + PG8_SB(b, h) + boff + n * 2048 + k * 1024); } while (0)
#define PG8_MMA(ai, bj, At, Bt) do { __builtin_amdgcn_s_setprio(1); _Pragma("unroll") for (int m = 0; m < 4; ++m) _Pragma("unroll") for (int n = 0; n < 2; ++n) _Pragma("unroll") for (int k = 0; k < 2; ++k) \
        acc[ai][bj][m][n] = __builtin_amdgcn_mfma_f32_16x16x32_bf16(Bt[n][k], At[m][k], acc[ai][bj][m][n], 0, 0, 0); __builtin_amdgcn_s_setprio(0); } while (0)
#define PG8_WAIT_V(n) asm volatile("s_waitcnt vmcnt(" #n ")" ::: "memory")
#define PG8_WAIT_L(n) asm volatile("s_waitcnt lgkmcnt(" #n ")" ::: "memory")
#define PG8_BAR __builtin_amdgcn_s_barrier()
#define PG8_SCHED __builtin_amdgcn_sched_barrier(0)
    Unit cur, nxt; int ui = 0;
    if (!S.next(0, cur)) return;
    f32x4 acc[2][2][4][2];
#pragma unroll
    for (int a = 0; a < 2; ++a)
#pragma unroll
        for (int b = 0; b < 2; ++b)
#pragma unroll
            for (int m = 0; m < 4; ++m)
#pragma unroll
                for (int n = 0; n < 2; ++n) acc[a][b][m][n] = (f32x4){0.f, 0.f, 0.f, 0.f};
    bf16x8 At[4][2], B0[2][2], B1[2][2];
    const char* cA = (const char*)g.A + (size_t)cur.pm * tstep; const char* cB = (const char*)g.Bt + (size_t)cur.pn * tstep;
    S.a_ready(cur);
    PG8_STAGE(PG8_SB(0, 0), cB, voffB); PG8_STAGE(PG8_SA(0, 0), cA, voffA); PG8_STAGE(PG8_SB(0, 1), cB + hstep, voffB); PG8_STAGE(PG8_SA(0, 1), cA + hstep, voffA);
    if (wr == 1) PG8_BAR;
    PG8_WAIT_V(4); PG8_BAR;
    PG8_STAGE(PG8_SB(1, 0), cB + kstep, voffB); PG8_STAGE(PG8_SA(1, 0), cA + kstep, voffA); PG8_STAGE(PG8_SB(1, 1), cB + hstep + kstep, voffB);
    PG8_WAIT_V(6); PG8_BAR;
    PG8_STAMP();
    for (;;) {
        const bool has_next = S.next(ui + 1, nxt);
        const char* nA = has_next ? (const char*)g.A + (size_t)nxt.pm * tstep : cA; const char* nB = has_next ? (const char*)g.Bt + (size_t)nxt.pn * tstep : cB;
        for (int t = 0; t < nt; t += 2) {
            const bool last = (t == nt - 2);
            const char* a1 = cA + (size_t)(t + 1) * kstep;
            const char* a2 = last ? nA : cA + (size_t)(t + 2) * kstep; const char* b2 = last ? nB : cB + (size_t)(t + 2) * kstep;
            const char* a3 = a2 + kstep; const char* b3 = b2 + kstep;
            if (last && has_next) S.a_ready(nxt);
            PG8_LDB(B0, 0, 0); PG8_SCHED; PG8_LDA(At, 0, 0); PG8_STAGE(PG8_SA(1, 1), a1 + hstep, voffA);
            PG8_WAIT_L(8); PG8_BAR; PG8_WAIT_L(0); PG8_MMA(0, 0, At, B0); PG8_BAR; PG8_SCHED;
            PG8_LDB(B1, 0, 1); PG8_STAGE(PG8_SB(0, 0), b2, voffB);
            PG8_BAR; PG8_WAIT_L(0); PG8_MMA(0, 1, At, B1); PG8_BAR;
            PG8_LDA(At, 0, 1); PG8_STAGE(PG8_SA(0, 0), a2, voffA);
            PG8_BAR; PG8_WAIT_L(0); PG8_MMA(1, 0, At, B0); PG8_BAR; PG8_SCHED;
            PG8_STAGE(PG8_SB(0, 1), b2 + hstep, voffB);
            PG8_WAIT_V(6); PG8_BAR; PG8_MMA(1, 1, At, B1); PG8_BAR;
            PG8_LDB(B0, 1, 0); PG8_SCHED; PG8_LDA(At, 1, 0); PG8_STAGE(PG8_SA(0, 1), a2 + hstep, voffA);
            PG8_WAIT_L(8); PG8_BAR; PG8_WAIT_L(0); PG8_MMA(0, 0, At, B0); PG8_BAR; PG8_SCHED;
            PG8_LDB(B1, 1, 1); PG8_STAGE(PG8_SB(1, 0), b3, voffB);
            PG8_BAR; PG8_WAIT_L(0); PG8_MMA(0, 1, At, B1); PG8_BAR;
            PG8_LDA(At, 1, 1); PG8_STAGE(PG8_SA(1, 0), a3, voffA);
            PG8_BAR; PG8_WAIT_L(0); PG8_MMA(1, 0, At, B0); PG8_BAR; PG8_SCHED;
            PG8_STAGE(PG8_SB(1, 1), b3 + hstep, voffB);
            PG8_WAIT_V(6); PG8_BAR; PG8_MMA(1, 1, At, B1); PG8_BAR;
        }
        PG8_STAMP();
        if constexpr (!Epi::AFTER_DRAIN) { E(acc, cur, wr, wc, fr, fq); S.done(cur); }
        PG8_STAMP();
        if (!has_next) break;
#pragma unroll
        for (int a = 0; a < 2; ++a)
#pragma unroll
            for (int b = 0; b < 2; ++b)
#pragma unroll
                for (int m = 0; m < 4; ++m)
#pragma unroll
                    for (int n = 0; n < 2; ++n) acc[a][b][m][n] = (f32x4){0.f, 0.f, 0.f, 0.f};
        cur = nxt; cA = nA; cB = nB; ++ui;
    }
    PG8_WAIT_V(0);
    if (wr == 0) PG8_BAR;
    PG8_BAR;
    if constexpr (Epi::AFTER_DRAIN) { E.fused(acc, cur, wr, wc, fr, fq, lds, wid, lane); S.done(cur); }
    PG8_STAMP();
    if (STAMP && wid == 0) { stamps[lane] = lane < nts ? (((unsigned long long)(unsigned)ts_hi << 32) | (unsigned)ts_lo) : 0ull;
        if (lane == 62) stamps[62] = rt_entry; if (lane == 63) stamps[63] = (unsigned long long)wall_clock64(); }
#undef PG8_STAMP
#undef PG8_SA
#undef PG8_SB
#undef PG8_STAGE
#undef PG8_LDA
#undef PG8_LDB
#undef PG8_MMA
#undef PG8_WAIT_V
#undef PG8_WAIT_L
#undef PG8_BAR
#undef PG8_SCHED
}
}

#define LAS __attribute__((address_space(3)))
#define XB_TMO      128
#define XB_XCNT(j)  (256  + 64 * (j))
#define XB_XSUB(j)  (1280 + 64 * (j))
#define XB_XGEN(j)  (2304 + 64 * (j))
#define XB_TOP      3328
#define XB_TOPGEN   3392
#define XCD_BAR_WORDS 3456
#define XB_SPIN_CAP (1u << 24)

__device__ __forceinline__ unsigned xb_ld(unsigned* p)              { return __hip_atomic_load(p, __ATOMIC_RELAXED, __HIP_MEMORY_SCOPE_AGENT); }
__device__ __forceinline__ unsigned xb_add(unsigned* p, unsigned v) { return __hip_atomic_fetch_add(p, v, __ATOMIC_RELAXED, __HIP_MEMORY_SCOPE_AGENT); }
__device__ __forceinline__ unsigned xb_xcc_id() { return (unsigned)__builtin_amdgcn_s_getreg((3 << 11) | 20) & 0xFu; }
#define XB_SPIN(cond, bar) do { unsigned _sp = 0; while (cond) { __builtin_amdgcn_s_sleep(1); \
    if ((++_sp & 255u) == 0u) { if (xb_ld(&(bar)[XB_TMO])) break; if (_sp > XB_SPIN_CAP) { atomicAdd(&(bar)[XB_TMO], 1u); break; } } } } while (0)

struct XcdBarrier { unsigned* bar; unsigned x; volatile LAS unsigned* st; };

__device__ __forceinline__ XcdBarrier xcd_barrier_post(unsigned* bar, volatile LAS unsigned* st) {
    XcdBarrier b; b.bar = bar; b.x = xb_xcc_id(); b.st = st;
    if (threadIdx.x == 0) (void)xb_add(&bar[XB_XCNT(b.x)], 1u);
    return b;
}
__device__ __forceinline__ void xcd_barrier_complete(unsigned* bar, unsigned x, unsigned& nloc, unsigned& nx) {
    const unsigned G = gridDim.x * gridDim.y * gridDim.z;
    unsigned sum, cnt, mine, sp = 0u;
    for (;;) {
        sum = 0u; cnt = 0u; mine = 0u;
#pragma unroll
        for (unsigned j = 0; j < 16; ++j) { const unsigned c = xb_ld(&bar[XB_XCNT(j)]); sum += c; cnt += (c > 0u) ? 1u : 0u; mine = (j == x) ? c : mine; }
        if (sum == G) break;
        __builtin_amdgcn_s_sleep(1);
        if ((++sp & 255u) == 0u) { if (xb_ld(&bar[XB_TMO])) break; if (sp > XB_SPIN_CAP) { atomicAdd(&bar[XB_TMO], 1u); break; } }
    }
    nloc = mine > 0u ? mine : 1u; nx = cnt > 0u ? cnt : 1u;
}
__device__ __forceinline__ void xcd_barrier(const XcdBarrier& b) {
    asm volatile("s_waitcnt vmcnt(0)" ::: "memory");
    __syncthreads();
    if (threadIdx.x == 0) {
        unsigned* bar = b.bar;
        __builtin_amdgcn_s_waitcnt(0);
        unsigned nloc = b.st[0], nx = b.st[1];
        if (nloc == 0u) { xcd_barrier_complete(bar, b.x, nloc, nx); b.st[0] = nloc; b.st[1] = nx; }
        const unsigned old = xb_add(&bar[XB_XSUB(b.x)], 1u);
        const unsigned gen = old / nloc;
        if (old + 1u == (gen + 1u) * nloc) {
            __builtin_amdgcn_fence(__ATOMIC_RELEASE, "agent");
            asm volatile("s_waitcnt vmcnt(0)" ::: "memory");
            const unsigned og = xb_add(&bar[XB_TOP], 1u);
            const unsigned tg = og / nx;
            if (og + 1u == (tg + 1u) * nx) xb_add(&bar[XB_TOPGEN], 1u);
            else XB_SPIN(xb_ld(&bar[XB_TOPGEN]) == tg, bar);
            __builtin_amdgcn_fence(__ATOMIC_ACQUIRE, "agent");
            xb_add(&bar[XB_XGEN(b.x)], 1u);
            asm volatile("s_waitcnt vmcnt(0)" ::: "memory");
        } else {
            XB_SPIN(xb_ld(&bar[XB_XGEN(b.x)]) == gen, bar);
            __builtin_amdgcn_fence(__ATOMIC_ACQUIRE, "agent");
            asm volatile("s_waitcnt vmcnt(0)" ::: "memory");
        }
    }
    __syncthreads();
}

typedef unsigned short bf16;
typedef float f32x4 __attribute__((ext_vector_type(4)));
typedef float f32x16 __attribute__((ext_vector_type(16)));
typedef float f32x2 __attribute__((ext_vector_type(2)));
typedef unsigned u32x4 __attribute__((ext_vector_type(4)));
typedef unsigned u32x2 __attribute__((ext_vector_type(2)));
typedef short bf16x8 __attribute__((ext_vector_type(8)));
typedef __bf16 bf2_t __attribute__((ext_vector_type(2)));

constexpr int NTHREADS = 512, NWAVES = 8;
constexpr int LDS_BYTES = 160 * 1024;
constexpr int MISC_OFF = LDS_BYTES - 256;
constexpr int TOK = 32768, SEQ = 16384, DM = 2048;
constexpr int EV_N = 4800, EV_NP = 4864, OD_N = 4176, OD_NP = 4352;
constexpr float ALPHA = 1.41421356237f;
constexpr size_t MiB = 1u << 20;
constexpr size_t WS_CTL = 0, CTL_ZERO_BYTES = 1 * MiB;
constexpr int CW_BAR = 4096, CW_XRANK = 8192;
constexpr size_t WS_MOD = 1 * MiB, WS_SKB = 2 * MiB, WS_WL = 4 * MiB, WS_BS = 7 * MiB, WS_CNT = 9 * MiB;
constexpr size_t WS_WINE = 10 * MiB, WS_WOUTE = 29 * MiB, WS_WINO = 37 * MiB, WS_WOUTO = 54 * MiB, WS_WQ0 = 62 * MiB, WS_WQ1 = 70 * MiB;
constexpr size_t WS_HY = 78 * MiB, WS_Z = 206 * MiB, WS_LA = 510 * MiB, WS_BIG = 542 * MiB, WS_END = 1022 * MiB;

__device__ __forceinline__ float bf2f(unsigned short b) { return __uint_as_float(((unsigned)b) << 16); }
__device__ __forceinline__ unsigned pk2(float lo, float hi) { const bf2_t v = {(__bf16)lo, (__bf16)hi}; return __builtin_bit_cast(unsigned, v); }
__device__ __forceinline__ unsigned f2bf(float f) { return pk2(f, 0.f) & 0xffffu; }
__device__ __forceinline__ float lo2f(unsigned w) { return __uint_as_float(w << 16); }
__device__ __forceinline__ float hi2f(unsigned w) { return __uint_as_float(w & 0xffff0000u); }
template <int CTRL, int RM> __device__ __forceinline__ float dppo(float v) { return __int_as_float(__builtin_amdgcn_update_dpp(__float_as_int(v), __float_as_int(v), CTRL, RM, 0xF, false)); }
__device__ __forceinline__ float wsum(float v) {
    v += __int_as_float(__builtin_amdgcn_update_dpp(0, __float_as_int(v), 0xB1, 0xF, 0xF, false)); v += __int_as_float(__builtin_amdgcn_update_dpp(0, __float_as_int(v), 0x4E, 0xF, 0xF, false));
    v += __int_as_float(__builtin_amdgcn_update_dpp(0, __float_as_int(v), 0x141, 0xF, 0xF, false)); v += __int_as_float(__builtin_amdgcn_update_dpp(0, __float_as_int(v), 0x140, 0xF, 0xF, false));
    v += __int_as_float(__builtin_amdgcn_update_dpp(0, __float_as_int(v), 0x142, 0xA, 0xF, false)); v += __int_as_float(__builtin_amdgcn_update_dpp(0, __float_as_int(v), 0x143, 0xC, 0xF, false));
    return __int_as_float(__builtin_amdgcn_readlane(__float_as_int(v), 63));
}
__device__ __forceinline__ float wmax(float v) {
    v = fmaxf(v, dppo<0xB1, 0xF>(v)); v = fmaxf(v, dppo<0x4E, 0xF>(v)); v = fmaxf(v, dppo<0x141, 0xF>(v)); v = fmaxf(v, dppo<0x140, 0xF>(v));
    v = fmaxf(v, dppo<0x142, 0xA>(v)); v = fmaxf(v, dppo<0x143, 0xC>(v));
    return __int_as_float(__builtin_amdgcn_readlane(__float_as_int(v), 63));
}
__device__ __forceinline__ float xsum32(float x) { const auto r = __builtin_amdgcn_permlane32_swap(__float_as_uint(x), __float_as_uint(x), false, false); return __uint_as_float(r[0]) + __uint_as_float(r[1]); }
__device__ __forceinline__ float xsum16(float x) { const auto r = __builtin_amdgcn_permlane16_swap(__float_as_uint(x), __float_as_uint(x), false, false); return __uint_as_float(r[0]) + __uint_as_float(r[1]); }
__device__ __forceinline__ float xmax32(float x) { const auto r = __builtin_amdgcn_permlane32_swap(__float_as_uint(x), __float_as_uint(x), false, false); return fmaxf(__uint_as_float(r[0]), __uint_as_float(r[1])); }
__device__ __forceinline__ float xmax16(float x) { const auto r = __builtin_amdgcn_permlane16_swap(__float_as_uint(x), __float_as_uint(x), false, false); return fmaxf(__uint_as_float(r[0]), __uint_as_float(r[1])); }
__device__ __forceinline__ float rsum4(float v0, float v1, float v2, float v3) {
    const auto p = __builtin_amdgcn_permlane32_swap(__float_as_uint(v0), __float_as_uint(v2), false, false);
    const auto q = __builtin_amdgcn_permlane32_swap(__float_as_uint(v1), __float_as_uint(v3), false, false);
    const float P = __uint_as_float(p[0]) + __uint_as_float(p[1]);
    const float Q = __uint_as_float(q[0]) + __uint_as_float(q[1]);
    const auto t = __builtin_amdgcn_permlane16_swap(__float_as_uint(P), __float_as_uint(Q), false, false);
    return __uint_as_float(t[0]) + __uint_as_float(t[1]);
}
__device__ __forceinline__ float rdlane(float v, int l) { return __int_as_float(__builtin_amdgcn_readlane(__float_as_int(v), l)); }
__device__ __forceinline__ unsigned rdlaneu(unsigned v, int l) { return (unsigned)__builtin_amdgcn_readlane((int)v, l); }
__device__ __forceinline__ float dot2bf(unsigned a, unsigned b, float c) {
    return __builtin_amdgcn_fdot2_f32_bf16(__builtin_bit_cast(bf2_t, a), __builtin_bit_cast(bf2_t, b), c, false);
}
template <int CTRL, int RM> __device__ __forceinline__ float dppf(float v) {
    return __int_as_float(__builtin_amdgcn_update_dpp(0, __float_as_int(v), CTRL, RM, 0xF, false));
}
__device__ __forceinline__ float wsum_dpp(float v) {
    v += dppf<0xB1, 0xF>(v);
    v += dppf<0x4E, 0xF>(v);
    v += dppf<0x141, 0xF>(v);
    v += dppf<0x140, 0xF>(v);
    v += dppf<0x142, 0xA>(v);
    v += dppf<0x143, 0xC>(v);
    return rdlane(v, 63);
}
__device__ __forceinline__ float sum16_dpp(float v) {
    v += dppf<0xB1, 0xF>(v); v += dppf<0x4E, 0xF>(v); v += dppf<0x141, 0xF>(v); v += dppf<0x140, 0xF>(v);
    return v;
}
__device__ __forceinline__ float sigmoidf_(float x) { return 1.0f / (1.0f + expf(-x)); }
__device__ __forceinline__ unsigned ordkey(float f) { const unsigned u = __float_as_uint(f); return (u & 0x80000000u) ? ~u : (u | 0x80000000u); }
__device__ __forceinline__ unsigned fixkey20(float f) { const float c = fminf(fmaxf(f, -15.999f), 15.999f); return (unsigned)((int)rintf(c * 32768.0f) + (1 << 19)); }
__device__ __forceinline__ float unordkey(unsigned k) { return __uint_as_float((k & 0x80000000u) ? (k & 0x7fffffffu) : ~k); }

struct Args { const void* in[27]; float* out; unsigned char* ws; int ph_lo, ph_hi; };
struct Frame { LAS unsigned char* lds; int tid, lane, wave, bx, G, gw, ngw; };

struct EpiLora {
    static constexpr bool PERM = true, AFTER_DRAIN = false;
    pg8::bf16_t* O; int ldc; const float* w0; const float* a0;
    __device__ __forceinline__ void operator()(const pg8::f32x4 (&acc)[2][2][4][2], const pg8::Unit& u, int wr, int wc, int fr, int fq) const {
        const int row0 = u.pm * 256 + wr * 64 + fr; const int colt = u.pn * 256; const int type = u.pn >> 2;
        const int col0 = colt + wc * 32 + 8 * fq, ncol0 = col0 & 1023;
        const float* pv = (type == 0) ? w0 : a0;
        pg8::f32x4 bv[2][2];
#pragma unroll
        for (int bj = 0; bj < 2; ++bj)
#pragma unroll
            for (int n = 0; n < 2; ++n) bv[bj][n] = (type < 2) ? *(const pg8::f32x4*)(pv + ncol0 + bj * 128 + 4 * n) : (pg8::f32x4){0.f, 0.f, 0.f, 0.f};
#pragma unroll
        for (int ai = 0; ai < 2; ++ai)
#pragma unroll
            for (int m = 0; m < 4; ++m) { pg8::bf16_t* rowp = O + (size_t)(row0 + ai * 128 + m * 16) * ldc + col0;
#pragma unroll
                for (int bj = 0; bj < 2; ++bj) { pg8::f32x4 v0 = acc[ai][bj][m][0] + bv[bj][0], v1 = acc[ai][bj][m][1] + bv[bj][1];
                    if (type < 2) {
                        const float sc = (type == 0) ? 0.60653066f : 1.0f;
#pragma unroll
                        for (int j = 0; j < 4; ++j) { v0[j] = sc / (1.0f + __expf(-v0[j])); v1[j] = sc / (1.0f + __expf(-v1[j])); }
                    }
                    pg8::u32x4 w; w.x = pg8::cvt_pk_bf16(v0[0], v0[1]); w.y = pg8::cvt_pk_bf16(v0[2], v0[3]); w.z = pg8::cvt_pk_bf16(v1[0], v1[1]); w.w = pg8::cvt_pk_bf16(v1[2], v1[3]);
                    *(pg8::u32x4*)(rowp + bj * 128) = w; } }
    }
};

__device__ __forceinline__ void transpose_item(const float* W, int K, int N, int Npad, bf16* WT, LAS float* scr, int item, int lane) {
    const int nblk = Npad / 32, kb = item / nblk, nb = item % nblk, k0 = 64 * kb, n0 = 32 * nb;
    const int nl = lane & 31; const bool ok = (n0 + nl) < N;
#pragma unroll 8
    for (int i = 0; i < 32; ++i) { const int kk = 2 * i + (lane >> 5); scr[kk * 33 + nl] = ok ? W[(size_t)(k0 + kk) * N + n0 + nl] : 0.f; }
    asm volatile("s_waitcnt lgkmcnt(0)" ::: "memory");
    const int c = lane & 7;
#pragma unroll
    for (int j = 0; j < 4; ++j) { const int n = (lane >> 3) + 8 * j; const LAS float* s = scr + (8 * c) * 33 + n;
        u32x4 o; o.x = pk2(s[0 * 33], s[1 * 33]); o.y = pk2(s[2 * 33], s[3 * 33]); o.z = pk2(s[4 * 33], s[5 * 33]); o.w = pk2(s[6 * 33], s[7 * 33]);
        *(u32x4*)(WT + (size_t)(n0 + n) * K + k0 + 8 * c) = o; }
    asm volatile("s_waitcnt lgkmcnt(0)" ::: "memory");
}

__device__ __forceinline__ void ph_prologue(const Args& A, Frame& F) {
    unsigned char* ws = A.ws;
    {
        const float* c = (const float*)A.in[1]; const float* mw = (const float*)A.in[19]; const float* mb = (const float*)A.in[20];
        float* MOD = (float*)(ws + WS_MOD);
        LAS float* red = (LAS float*)F.lds;
        for (int it = F.bx; it < 96; it += F.G) {
            const int s = it / 24, cc = it % 24, col = cc * 256 + F.lane * 4;
            const float* W = mw + (size_t)s * 2048 * 6144 + col;
            f32x4 a0 = {0.f, 0.f, 0.f, 0.f}, a1 = {0.f, 0.f, 0.f, 0.f};
            const int k0 = F.wave * 256;
#pragma unroll 8
            for (int k = k0; k < k0 + 256; ++k) {
                float c0 = c[k], c1 = c[2048 + k];
                c0 = c0 / (1.0f + expf(-c0)); c1 = c1 / (1.0f + expf(-c1));
                const f32x4 w = *(const f32x4*)(W + (size_t)k * 6144);
                a0 += c0 * w; a1 += c1 * w;
            }
            *(LAS f32x4*)(red + ((F.wave * 2 + 0) * 256 + F.lane * 4)) = a0;
            *(LAS f32x4*)(red + ((F.wave * 2 + 1) * 256 + F.lane * 4)) = a1;
            __syncthreads();
            { const int b = F.tid >> 8, cl = F.tid & 255; float sm = 0.f;
#pragma unroll
              for (int w = 0; w < 8; ++w) sm += red[(w * 2 + b) * 256 + cl];
              MOD[(size_t)(s * 2 + b) * 6144 + cc * 256 + cl] = sm + mb[s * 6144 + cc * 256 + cl]; }
            __syncthreads();
        }
    }
    {
        LAS float* scr = (LAS float*)(F.lds + 16384 + F.wave * 8704);
        constexpr int I0 = 32 * (EV_NP / 32), I1 = 32 * 64, I2 = 32 * (OD_NP / 32);
        constexpr int NIT = I0 + I1 + I2 + 3 * I1;
        for (int it = F.gw; it < NIT; it += F.ngw) {
            int r = it;
            if (r < I0) { transpose_item((const float*)A.in[3], 2048, EV_N, EV_NP, (bf16*)(ws + WS_WINE), scr, r, F.lane); continue; } r -= I0;
            if (r < I1) { transpose_item((const float*)A.in[4], 2048, 2048, 2048, (bf16*)(ws + WS_WOUTE), scr, r, F.lane); continue; } r -= I1;
            if (r < I2) { transpose_item((const float*)A.in[17], 2048, OD_N, OD_NP, (bf16*)(ws + WS_WINO), scr, r, F.lane); continue; } r -= I2;
            if (r < I1) { transpose_item((const float*)A.in[18], 2048, 2048, 2048, (bf16*)(ws + WS_WOUTO), scr, r, F.lane); continue; } r -= I1;
            if (r < I1) { transpose_item((const float*)A.in[23], 2048, 2048, 2048, (bf16*)(ws + WS_WQ0), scr, r, F.lane); continue; } r -= I1;
            transpose_item((const float*)A.in[23] + (size_t)2048 * 2048, 2048, 2048, 2048, (bf16*)(ws + WS_WQ1), scr, r, F.lane);
        }
    }
    {
        const float* w2 = (const float*)A.in[8]; const float* a2 = (const float*)A.in[10]; const float* g2 = (const float*)A.in[11];
        bf16* WL = (bf16*)(ws + WS_WL);
        const int gt = F.bx * NTHREADS + F.tid, ngt = F.G * NTHREADS;
        for (int i = gt; i < 3072 * 512; i += ngt) {
            const int n = i >> 9, k = i & 511; float v = 0.f;
            if (n < 1024) { if (k < 96) v = w2[k * 1024 + n]; }
            else if (n < 2048) { if (k >= 96 && k < 192) v = a2[(k - 96) * 1024 + (n - 1024)]; }
            else { if (k >= 192 && k < 448) v = g2[(k - 192) * 1024 + (n - 2048)]; }
            WL[i] = (bf16)f2bf(v);
        }
        const float* sk = (const float*)A.in[24]; bf16* SKB = (bf16*)(ws + WS_SKB);
        for (int i = gt; i < 2 * 262144; i += ngt) SKB[i] = (bf16)f2bf(sk[i]);
    }
}

__device__ __forceinline__ void ph_mod_x(const Args& A, Frame& F) {
    const float* x = (const float*)A.in[0]; const float* MOD = (const float*)(A.ws + WS_MOD); bf16* H = (bf16*)(A.ws + WS_HY);
    for (int t = F.gw; t < TOK; t += F.ngw) {
        const int b = t >> 14; const float* sh = MOD + (size_t)(0 * 2 + b) * 6144; const float* sc = sh + 2048;
#pragma unroll
        for (int j = 0; j < 8; ++j) { const int idx = j * 256 + F.lane * 4;
            const f32x4 xv = *(const f32x4*)(x + (size_t)t * DM + idx), sv = *(const f32x4*)(sc + idx), hv = *(const f32x4*)(sh + idx);
            const f32x4 o = xv * (1.0f + sv) + hv; u32x2 w; w.x = pk2(o[0], o[1]); w.y = pk2(o[2], o[3]);
            *(u32x2*)(H + (size_t)t * DM + idx) = w; }
    }
}

__device__ __forceinline__ void ph_even_post(const Args& A, Frame& F) {
    bf16* Z = (bf16*)(A.ws + WS_Z); const int* positions = (const int*)A.in[2]; const float* mu = (const float*)A.in[6];
    bf16* RKV = (bf16*)A.out; bf16* LAp = (bf16*)(A.ws + WS_LA);
    const int i = F.lane & 31; const float inv = powf(10000.0f, -(float)i / 32.0f);
    const int i4 = F.lane & 7, hs = F.lane >> 3;
    for (int t = F.gw; t < TOK; t += F.ngw) {
        const int s = t & (SEQ - 1); bf16* zr = Z + (size_t)t * EV_NP;
        float sn, cs; sincosf((float)positions[t] * inv, &sn, &cs);
        float c4[4], s4[4];
#pragma unroll
        for (int e = 0; e < 4; ++e) { c4[e] = __shfl(cs, 4 * i4 + e); s4[e] = __shfl(sn, 4 * i4 + e); }
#pragma unroll
        for (int it = 0; it < 3; ++it) { const int hd = it * 8 + hs; if (hd < 18) { bf16* hp = zr + hd * 64 + 4 * i4;
            const u32x2 a = *(const u32x2*)hp, b = *(const u32x2*)(hp + 32);
            const float t1[4] = {lo2f(a.x), hi2f(a.x), lo2f(a.y), hi2f(a.y)}, t2[4] = {lo2f(b.x), hi2f(b.x), lo2f(b.y), hi2f(b.y)};
            float o1[4], o2[4];
#pragma unroll
            for (int e = 0; e < 4; ++e) { o1[e] = t1[e] * c4[e] - t2[e] * s4[e]; o2[e] = t2[e] * c4[e] + t1[e] * s4[e]; }
            *(u32x2*)hp = (u32x2){pk2(o1[0], o1[1]), pk2(o1[2], o1[3])}; *(u32x2*)(hp + 32) = (u32x2){pk2(o2[0], o2[1]), pk2(o2[2], o2[3])}; } }
        const bf16* zp = zr - EV_NP; const bool hasprev = s > 0;
#pragma unroll
        for (int m = 0; m < 7; ++m) { const int j = 8 * (F.lane + 64 * m); if (j < 3520) {
            const u32x4 cw = *(const u32x4*)(zr + 1280 + j); u32x4 pw = {0u, 0u, 0u, 0u}; if (hasprev) pw = *(const u32x4*)(zp + 1280 + j);
            const f32x4 m0 = *(const f32x4*)(mu + j), m1 = *(const f32x4*)(mu + j + 4);
            const unsigned cwa[4] = {cw.x, cw.y, cw.z, cw.w}, pwa[4] = {pw.x, pw.y, pw.z, pw.w}; const float mm[8] = {m0[0], m0[1], m0[2], m0[3], m1[0], m1[1], m1[2], m1[3]};
            float v[8];
#pragma unroll
            for (int q = 0; q < 4; ++q) { const float c0 = lo2f(cwa[q]), c1 = hi2f(cwa[q]), p0 = lo2f(pwa[q]), p1 = hi2f(pwa[q]); v[2 * q] = c0 + (p0 - c0) * mm[2 * q]; v[2 * q + 1] = c1 + (p1 - c1) * mm[2 * q + 1]; }
            bf16* dst;
            if (j < 3072) { dst = RKV + (size_t)(j >> 10) * TOK * 1024 + (size_t)t * 1024 + (j & 1023); }
            else if (j < 3168) { dst = LAp + (size_t)t * 512 + (j - 3072);
#pragma unroll
                for (int e = 0; e < 8; ++e) v[e] = tanhf(v[e]); }
            else if (j < 3264) { dst = LAp + (size_t)t * 512 + 96 + (j - 3168); }
            else { dst = LAp + (size_t)t * 512 + 192 + (j - 3264);
#pragma unroll
                for (int e = 0; e < 8; ++e) v[e] = sigmoidf_(v[e]); }
            *(u32x4*)dst = (u32x4){pk2(v[0], v[1]), pk2(v[2], v[3]), pk2(v[4], v[5]), pk2(v[6], v[7])};
        } }
        if (F.lane < 8) *(u32x4*)(LAp + (size_t)t * 512 + 448 + 8 * F.lane) = (u32x4){0u, 0u, 0u, 0u};
    }
}

__device__ __forceinline__ void ph_scan_pack(const Args& A, Frame& F) {
    const bf16* Z = (const bf16*)(A.ws + WS_Z); const bf16* RKV = (const bf16*)A.out;
    const float* k_k = (const float*)A.in[12]; const float* k_a = (const float*)A.in[13]; const float* r_k = (const float*)A.in[14];
    unsigned* PK = (unsigned*)(A.ws + WS_BIG); float* BS = (float*)(A.ws + WS_BS);
    const int g16 = F.lane >> 4, c16 = F.lane & 15;
    for (int it = F.gw; it < TOK * 4; it += F.ngw) {
        const int item = it * 4 + g16; const int t = item >> 4, h = item & 15, c = h * 64 + 4 * c16, b = t >> 14, s = t & (SEQ - 1);
        const u32x2 rw = *(const u32x2*)(RKV + (size_t)t * 1024 + c), kw = *(const u32x2*)(RKV + (size_t)TOK * 1024 + (size_t)t * 1024 + c), vw = *(const u32x2*)(RKV + (size_t)2 * TOK * 1024 + (size_t)t * 1024 + c);
        const u32x2 ew = *(const u32x2*)(Z + (size_t)t * EV_NP + 1280 + c), aw = *(const u32x2*)(Z + (size_t)t * EV_NP + 1280 + 1024 + c);
        const f32x4 kk4 = *(const f32x4*)(k_k + c), ka4 = *(const f32x4*)(k_a + c), rk4 = *(const f32x4*)(r_k + c);
        const float r[4] = {lo2f(rw.x), hi2f(rw.x), lo2f(rw.y), hi2f(rw.y)}, kr[4] = {lo2f(kw.x), hi2f(kw.x), lo2f(kw.y), hi2f(kw.y)}, v[4] = {lo2f(vw.x), hi2f(vw.x), lo2f(vw.y), hi2f(vw.y)};
        const float e[4] = {lo2f(ew.x), hi2f(ew.x), lo2f(ew.y), hi2f(ew.y)}, a[4] = {lo2f(aw.x), hi2f(aw.x), lo2f(aw.y), hi2f(aw.y)};
        float kkv[4], kp[4]; float ss = 0.f, bsum = 0.f;
#pragma unroll
        for (int q = 0; q < 4; ++q) { kkv[q] = kr[q] * kk4[q]; ss += kkv[q] * kkv[q]; kp[q] = kr[q] * (1.0f + (a[q] - 1.0f) * ka4[q]); bsum += r[q] * kp[q] * rk4[q]; }
        ss = sum16_dpp(ss); bsum = sum16_dpp(bsum);
        const float rn = 1.0f / fmaxf(sqrtf(ss), 1e-12f);
        if (c16 == 0) BS[(size_t)t * 16 + h] = bsum;
        unsigned w[12];
#pragma unroll
        for (int q = 0; q < 4; ++q) { const float kkn = kkv[q] * rn; w[3 * q] = pk2(r[q], e[q]); w[3 * q + 1] = pk2(kp[q], kkn); w[3 * q + 2] = pk2(kkn * a[q], v[q]); }
        u32x4* dst = (u32x4*)(PK + ((size_t)((b * 16 + h) * SEQ + s) * 64 + 4 * c16) * 3);
        dst[0] = (u32x4){w[0], w[1], w[2], w[3]}; dst[1] = (u32x4){w[4], w[5], w[6], w[7]}; dst[2] = (u32x4){w[8], w[9], w[10], w[11]};
    }
}

__device__ __forceinline__ void ph_swa(const Args& A, Frame& F) {
    const bf16* Z = (const bf16*)(A.ws + WS_Z); bf16* Y = (bf16*)(A.ws + WS_HY); const float* sinks = (const float*)A.in[5];
    LAS unsigned char* KL = F.lds; LAS unsigned char* VL = F.lds + 256 * 136;
    for (int u = F.bx; u < 512; u += F.G) {
        const int b = u >> 8, n = (u >> 1) & 127, kvh = u & 1;
        __syncthreads();
        for (int c = F.tid; c < 2048; c += NTHREADS) { const int jw = c >> 3, cc = c & 7; const int s = n * 128 - 128 + jw;
            u32x4 kv = {0u, 0u, 0u, 0u}, vv = {0u, 0u, 0u, 0u};
            if (s >= 0) { const bf16* row = Z + (size_t)(b * SEQ + s) * EV_NP; kv = *(const u32x4*)(row + 1024 + kvh * 64 + cc * 8); vv = *(const u32x4*)(row + 1152 + kvh * 64 + cc * 8); }
            *(LAS u32x2*)(KL + jw * 136 + cc * 16) = (u32x2){kv.x, kv.y}; *(LAS u32x2*)(KL + jw * 136 + cc * 16 + 8) = (u32x2){kv.z, kv.w};
            *(LAS u32x2*)(VL + jw * 136 + cc * 16) = (u32x2){vv.x, vv.y}; *(LAS u32x2*)(VL + jw * 136 + cc * 16 + 8) = (u32x2){vv.z, vv.w}; }
        __syncthreads();
        for (int it = F.wave; it < 1024; it += NWAVES) {
            const int i = it >> 3, g = it & 7, head = kvh * 8 + g; const int t = b * SEQ + n * 128 + i;
            const float qv = bf2f(Z[(size_t)t * EV_NP + head * 64 + F.lane]) * 0.125f;
            const int jw0 = i + 1 + F.lane, jw1 = jw0 + 64;
            const bool val0 = (n > 0) || (jw0 >= 128), val1 = (n > 0) || (jw1 >= 128);
            float s0 = 0.f, s1 = 0.f;
#pragma unroll
            for (int d4 = 0; d4 < 16; ++d4) {
                const u32x2 k0 = *(const LAS u32x2*)(KL + jw0 * 136 + d4 * 8), k1 = *(const LAS u32x2*)(KL + jw1 * 136 + d4 * 8);
                const float q0 = rdlane(qv, 4 * d4), q1 = rdlane(qv, 4 * d4 + 1), q2 = rdlane(qv, 4 * d4 + 2), q3 = rdlane(qv, 4 * d4 + 3);
                s0 += q0 * lo2f(k0.x) + q1 * hi2f(k0.x) + q2 * lo2f(k0.y) + q3 * hi2f(k0.y);
                s1 += q0 * lo2f(k1.x) + q1 * hi2f(k1.x) + q2 * lo2f(k1.y) + q3 * hi2f(k1.y);
            }
            const float sink = sinks[head];
            s0 = val0 ? s0 : -INFINITY; s1 = val1 ? s1 : -INFINITY;
            const float mx = fmaxf(wmax(fmaxf(s0, s1)), sink);
            float p0 = val0 ? expf(s0 - mx) : 0.f, p1 = val1 ? expf(s1 - mx) : 0.f;
            const float den = wsum(p0 + p1) + expf(sink - mx); const float rden = 1.0f / den;
            p0 *= rden; p1 *= rden;
            float o = 0.f;
            const LAS bf16* vcol = (const LAS bf16*)VL + F.lane;
#pragma unroll 8
            for (int jj = 0; jj < 64; ++jj) o += rdlane(p0, jj) * bf2f(vcol[(i + 1 + jj) * 68]);
#pragma unroll 8
            for (int jj = 0; jj < 64; ++jj) o += rdlane(p1, jj) * bf2f(vcol[(i + 65 + jj) * 68]);
            Y[(size_t)t * DM + head * 64 + F.lane] = (bf16)f2bf(o);
        }
    }
}

__device__ __forceinline__ bf16x8 as_bf8(u32x4 v) { return __builtin_bit_cast(bf16x8, v); }
__device__ __forceinline__ void ph_swa_mfma(const Args& A, Frame& F) {
    const bf16* Z = (const bf16*)(A.ws + WS_Z); bf16* Y = (bf16*)(A.ws + WS_HY); const float* sinks = (const float*)A.in[5];
    LAS bf16* KL = (LAS bf16*)F.lds;
    LAS bf16* VT = (LAS bf16*)(F.lds + 36864);
    const int l15 = F.lane & 15, g4 = F.lane >> 4;
    for (int u = F.bx; u < 512; u += F.G) {
        const int b = u >> 8, n = (u >> 1) & 127, kvh = u & 1;
        __syncthreads();
        for (int c = F.tid; c < 2048; c += NTHREADS) { const int jw = c >> 3, cc = c & 7; const int sp = n * 128 - 128 + jw;
            u32x4 kv = {0u, 0u, 0u, 0u}, vv = {0u, 0u, 0u, 0u};
            if (sp >= 0) { const bf16* row = Z + (size_t)(b * SEQ + sp) * EV_NP; kv = *(const u32x4*)(row + 1024 + kvh * 64 + cc * 8); vv = *(const u32x4*)(row + 1152 + kvh * 64 + cc * 8); }
            *(LAS u32x4*)(KL + jw * 72 + cc * 8) = kv;
            const unsigned vw[4] = {vv.x, vv.y, vv.z, vv.w};
#pragma unroll
            for (int q = 0; q < 4; ++q) { VT[(8 * cc + 2 * q) * 264 + jw] = (bf16)(vw[q] & 0xffffu); VT[(8 * cc + 2 * q + 1) * 264 + jw] = (bf16)(vw[q] >> 16); } }
        __syncthreads();
        const int head = kvh * 8 + F.wave; const float sink = sinks[head];
#pragma unroll 1
        for (int qt = 0; qt < 8; ++qt) {
            const int iq = 16 * qt + l15; const int t = b * SEQ + n * 128 + iq;
            bf16x8 qf[2];
#pragma unroll
            for (int ks = 0; ks < 2; ++ks) qf[ks] = *(const bf16x8*)(Z + (size_t)t * EV_NP + head * 64 + 32 * ks + 8 * g4);
            float sv[10][4]; float mx = -INFINITY;
#pragma unroll
            for (int kk = 0; kk < 9; ++kk) { const int kt = qt + kk;
                f32x4 acc = {0.f, 0.f, 0.f, 0.f};
#pragma unroll
                for (int ks = 0; ks < 2; ++ks) acc = __builtin_amdgcn_mfma_f32_16x16x32_bf16(*(const LAS bf16x8*)(KL + (16 * kt + l15) * 72 + 32 * ks + 8 * g4), qf[ks], acc, 0, 0, 0);
#pragma unroll
                for (int rg_ = 0; rg_ < 4; ++rg_) { const int jw = 16 * kt + 4 * g4 + rg_; const bool ok = (jw >= iq + 1) && (jw <= iq + 128) && ((n > 0) || (jw >= 128));
                    sv[kk][rg_] = ok ? acc[rg_] * 0.125f : -INFINITY; mx = fmaxf(mx, sv[kk][rg_]); } }
#pragma unroll
            for (int rg_ = 0; rg_ < 4; ++rg_) sv[9][rg_] = -INFINITY;
            mx = xmax16(mx); mx = xmax32(mx); mx = fmaxf(mx, sink);
            float sm = 0.f;
#pragma unroll
            for (int kk = 0; kk < 10; ++kk)
#pragma unroll
                for (int rg_ = 0; rg_ < 4; ++rg_) { const float pv = (sv[kk][rg_] == -INFINITY) ? 0.f : __expf(sv[kk][rg_] - mx); sv[kk][rg_] = pv; sm += pv; }
            sm = xsum16(sm); sm = xsum32(sm);
            const float rden = 1.0f / (sm + __expf(sink - mx));
            f32x4 oacc[4];
#pragma unroll
            for (int dt = 0; dt < 4; ++dt) oacc[dt] = (f32x4){0.f, 0.f, 0.f, 0.f};
#pragma unroll
            for (int pp = 0; pp < 5; ++pp) { const int ka = qt + 2 * pp, kb = (qt + 2 * pp + 1 < 16) ? (qt + 2 * pp + 1) : 15;
                const bf16x8 pb = as_bf8((u32x4){pk2(sv[2 * pp][0] * rden, sv[2 * pp][1] * rden), pk2(sv[2 * pp][2] * rden, sv[2 * pp][3] * rden),
                                                  pk2(sv[2 * pp + 1][0] * rden, sv[2 * pp + 1][1] * rden), pk2(sv[2 * pp + 1][2] * rden, sv[2 * pp + 1][3] * rden)});
#pragma unroll
                for (int dt = 0; dt < 4; ++dt) { const LAS bf16* vr = VT + (16 * dt + l15) * 264 + 4 * g4;
                    const u32x2 va = *(const LAS u32x2*)(vr + 16 * ka), vb2 = *(const LAS u32x2*)(vr + 16 * kb);
                    oacc[dt] = __builtin_amdgcn_mfma_f32_16x16x32_bf16(as_bf8((u32x4){va.x, va.y, vb2.x, vb2.y}), pb, oacc[dt], 0, 0, 0); } }
#pragma unroll
            for (int dt = 0; dt < 4; ++dt) *(u32x2*)(Y + (size_t)t * DM + head * 64 + 16 * dt + 4 * g4) = (u32x2){pk2(oacc[dt][0], oacc[dt][1]), pk2(oacc[dt][2], oacc[dt][3])};
        }
    }
}

constexpr int FR_BYTES = 15360;
__device__ __forceinline__ int fr_rho(int ks, int g, int j) { return 16 * (2 * ks + (j >> 2)) + 4 * g + (j & 3); }
__device__ __forceinline__ void ph_scan_prep(const Args& A, Frame& F) {
    const bf16* Z = (const bf16*)(A.ws + WS_Z); const bf16* RKV = (const bf16*)A.out;
    const float* k_k = (const float*)A.in[12]; const float* k_a = (const float*)A.in[13]; const float* r_k = (const float*)A.in[14];
    unsigned char* FR = A.ws + WS_BIG; float* BS = (float*)(A.ws + WS_BS);
    LAS float* EE = (LAS float*)F.lds;
    LAS float* VV = (LAS float*)(F.lds + 4096);
    LAS float* KHf = (LAS float*)(F.lds + 8192);
    LAS float* RHf = (LAS float*)(F.lds + 12352);
    LAS float* BPf = (LAS float*)(F.lds + 16512);
    LAS bf16* AHb = (LAS bf16*)(F.lds + 20672);
    LAS bf16* BHb = (LAS bf16*)(F.lds + 22976);
    LAS bf16* KHb = (LAS bf16*)(F.lds + 25280);
    LAS bf16* RHb = (LAS bf16*)(F.lds + 27584);
    LAS bf16* APT = (LAS bf16*)(F.lds + 29888);
    LAS float* GA = (LAS float*)(F.lds + 32960);
    LAS float* GB = GA + 16 * 17; LAS float* GMA = GB + 16 * 17; LAS float* GMB = GMA + 16 * 17;
    LAS float* TT = (LAS float*)(F.lds + 37312);
    LAS bf16* P1b = (LAS bf16*)(F.lds + 38400);
    LAS bf16* P2b = (LAS bf16*)(F.lds + 41472);
    LAS bf16* MAT = (LAS bf16*)(F.lds + 42240);
    LAS float* WW = (LAS float*)(F.lds + 43008);
    const int tt = F.tid >> 5, kq = F.tid & 31;
    const int l15 = F.lane & 15, g = F.lane >> 4;
    const bf16x8 zero8 = {0, 0, 0, 0, 0, 0, 0, 0};
    for (int it = F.bx; it < 32 * 1024; it += F.G) {
        const int bh = it >> 10, ch = it & 1023, b = bh >> 4, h = bh & 15;
        const int tok = b * SEQ + ch * 16 + tt, c = h * 64 + 2 * kq;
        __syncthreads();
        float e2[2], kkn[2], kka[2], kp[2], r2[2];
        {
            const unsigned rw = *(const unsigned*)(RKV + (size_t)tok * 1024 + c), kw = *(const unsigned*)(RKV + (size_t)TOK * 1024 + (size_t)tok * 1024 + c), vw = *(const unsigned*)(RKV + (size_t)2 * TOK * 1024 + (size_t)tok * 1024 + c);
            const unsigned ew = *(const unsigned*)(Z + (size_t)tok * EV_NP + 1280 + c), aw = *(const unsigned*)(Z + (size_t)tok * EV_NP + 1280 + 1024 + c);
            const float kr[2] = {lo2f(kw), hi2f(kw)}, av[2] = {lo2f(aw), hi2f(aw)};
            r2[0] = lo2f(rw); r2[1] = hi2f(rw); e2[0] = lo2f(ew); e2[1] = hi2f(ew);
            float kkv[2], ss = 0.f, bsum = 0.f;
#pragma unroll
            for (int q = 0; q < 2; ++q) { kkv[q] = kr[q] * k_k[c + q]; ss += kkv[q] * kkv[q]; kp[q] = kr[q] * (1.0f + (av[q] - 1.0f) * k_a[c + q]); bsum += r2[q] * kp[q] * r_k[c + q]; }
            ss = xsum16(sum16_dpp(ss)); bsum = xsum16(sum16_dpp(bsum));
            const float rn = 1.0f / fmaxf(sqrtf(ss), 1e-12f);
#pragma unroll
            for (int q = 0; q < 2; ++q) { kkn[q] = kkv[q] * rn; kka[q] = kkn[q] * av[q]; }
            if (kq == 0) BS[(size_t)tok * 16 + h] = bsum;
            *(LAS f32x2*)(EE + tt * 64 + 2 * kq) = (f32x2){e2[0], e2[1]};
            *(LAS f32x2*)(VV + tt * 64 + 2 * kq) = (f32x2){lo2f(vw), hi2f(vw)};
        }
        __syncthreads();
        {
            float L[2] = {0.f, 0.f}, L15[2] = {0.f, 0.f};
#pragma unroll
            for (int i = 0; i < 16; ++i) { const f32x2 ev = *(const LAS f32x2*)(EE + i * 64 + 2 * kq); L15[0] += ev.x; L15[1] += ev.y; if (i <= tt) { L[0] += ev.x; L[1] += ev.y; } }
            float kh[2], ah[2], bhv[2], rh[2], ap[2], bp[2];
#pragma unroll
            for (int q = 0; q < 2; ++q) { const float wt = __expf(-L[q]), iwt = __expf(L[q]), wprev = __expf(-(L[q] - e2[q])), wrest = __expf(-(L15[q] - L[q]));
                kh[q] = kkn[q] * wprev; ah[q] = kka[q] * iwt; bhv[q] = kp[q] * iwt; rh[q] = r2[q] * wt; ap[q] = kka[q] * wrest; bp[q] = kp[q] * wrest;
                if (tt == 15) WW[2 * kq + q] = wt; }
            KHf[tt * 65 + 2 * kq] = kh[0]; KHf[tt * 65 + 2 * kq + 1] = kh[1]; RHf[tt * 65 + 2 * kq] = rh[0]; RHf[tt * 65 + 2 * kq + 1] = rh[1]; BPf[tt * 65 + 2 * kq] = bp[0]; BPf[tt * 65 + 2 * kq + 1] = bp[1];
            *(LAS unsigned*)(KHb + tt * 72 + 2 * kq) = pk2(kh[0], kh[1]); *(LAS unsigned*)(AHb + tt * 72 + 2 * kq) = pk2(ah[0], ah[1]);
            *(LAS unsigned*)(BHb + tt * 72 + 2 * kq) = pk2(bhv[0], bhv[1]); *(LAS unsigned*)(RHb + tt * 72 + 2 * kq) = pk2(rh[0], rh[1]);
            APT[(2 * kq) * 24 + tt] = (bf16)f2bf(ap[0]); APT[(2 * kq + 1) * 24 + tt] = (bf16)f2bf(ap[1]);
        }
        __syncthreads();
        if (F.wave < 4) {
            const int mat = F.wave; const LAS bf16* X = (mat & 1) ? BHb : AHb; const LAS bf16* Y = (mat & 2) ? RHb : KHb;
            f32x4 acc = {0.f, 0.f, 0.f, 0.f};
#pragma unroll
            for (int ks = 0; ks < 2; ++ks) acc = __builtin_amdgcn_mfma_f32_16x16x32_bf16(*(const LAS bf16x8*)(X + l15 * 72 + 32 * ks + 8 * g), *(const LAS bf16x8*)(Y + l15 * 72 + 32 * ks + 8 * g), acc, 0, 0, 0);
            LAS float* dst = (mat == 0) ? GA : ((mat == 1) ? GB : ((mat == 2) ? GMA : GMB));
#pragma unroll
            for (int rg_ = 0; rg_ < 4; ++rg_) { const int i = 4 * g + rg_; const bool nz = (mat & 2) ? (i <= l15) : (i < l15); const float v = nz ? acc[rg_] : 0.f;
                dst[i * 17 + l15] = v; if (mat == 2) MAT[l15 * 24 + i] = (bf16)f2bf(v); }
        }
        __syncthreads();
        if (F.tid < 16) {
            float x[16];
#pragma unroll
            for (int i = 15; i >= 0; --i) { float v = (i == F.tid) ? 1.0f : 0.f;
#pragma unroll
                for (int m = i + 1; m < 16; ++m) v -= GA[i * 17 + m] * x[m];
                x[i] = v; }
#pragma unroll
            for (int i = 0; i < 16; ++i) TT[i * 17 + F.tid] = x[i];
        }
        __syncthreads();
        {
            float x0 = 0.f, x1 = 0.f;
#pragma unroll
            for (int m = 0; m < 16; ++m) { const float tv = TT[m * 17 + tt]; x0 -= KHf[m * 65 + 2 * kq] * tv; x1 -= KHf[m * 65 + 2 * kq + 1] * tv; }
            P1b[(2 * kq) * 24 + tt] = (bf16)f2bf(x0); P1b[(2 * kq + 1) * 24 + tt] = (bf16)f2bf(x1);
            if (F.tid < 256) { const int i = F.tid >> 4, t = F.tid & 15; float x = 0.f;
#pragma unroll
                for (int m = 0; m < 16; ++m) x -= GB[i * 17 + m] * TT[m * 17 + t];
                P2b[i * 24 + t] = (bf16)f2bf(x); }
        }
        __syncthreads();
        {
            unsigned char* fr = FR + (size_t)it * FR_BYTES;
            const int mt = F.wave >> 1, ks = F.wave & 1;
            const bf16x8 aP0 = (g < 2) ? *(const LAS bf16x8*)(P1b + (16 * (2 * ks) + l15) * 24 + 8 * g) : zero8;
            const bf16x8 aP1 = (g < 2) ? *(const LAS bf16x8*)(P1b + (16 * (2 * ks + 1) + l15) * 24 + 8 * g) : zero8;
            const bf16x8 bAP = (g < 2) ? *(const LAS bf16x8*)(APT + (16 * mt + l15) * 24 + 8 * g) : zero8;
            const f32x4 z4 = {0.f, 0.f, 0.f, 0.f};
            const f32x4 d0 = __builtin_amdgcn_mfma_f32_16x16x32_bf16(aP0, bAP, z4, 0, 0, 0), d1 = __builtin_amdgcn_mfma_f32_16x16x32_bf16(aP1, bAP, z4, 0, 0, 0);
            *(u32x4*)(fr + (size_t)(F.wave * 64 + F.lane) * 16) = (u32x4){pk2(d0[0], d0[1]), pk2(d0[2], d0[3]), pk2(d1[0], d1[1]), pk2(d1[2], d1[3])};
            if (F.wave < 4) {
                const bf16x8 aP2 = (g < 2) ? *(const LAS bf16x8*)(P2b + l15 * 24 + 8 * g) : zero8;
                const bf16x8 bA = (g < 2) ? *(const LAS bf16x8*)(APT + (16 * F.wave + l15) * 24 + 8 * g) : zero8;
                f32x4 d = __builtin_amdgcn_mfma_f32_16x16x32_bf16(aP2, bA, z4, 0, 0, 0);
#pragma unroll
                for (int rg_ = 0; rg_ < 4; ++rg_) d[rg_] += BPf[(4 * g + rg_) * 65 + 16 * F.wave + l15];
                *(u32x2*)(fr + 8192 + (size_t)(F.wave * 64 + F.lane) * 8) = (u32x2){pk2(d[0], d[1]), pk2(d[2], d[3])};
            } else if (F.wave < 6) {
                const int ks2 = F.wave - 4;
                const bf16x8 a0 = (g < 2) ? *(const LAS bf16x8*)(P1b + (16 * (2 * ks2) + l15) * 24 + 8 * g) : zero8;
                const bf16x8 a1 = (g < 2) ? *(const LAS bf16x8*)(P1b + (16 * (2 * ks2 + 1) + l15) * 24 + 8 * g) : zero8;
                const bf16x8 bM = (g < 2) ? *(const LAS bf16x8*)(MAT + l15 * 24 + 8 * g) : zero8;
                f32x4 q0 = __builtin_amdgcn_mfma_f32_16x16x32_bf16(a0, bM, z4, 0, 0, 0), q1 = __builtin_amdgcn_mfma_f32_16x16x32_bf16(a1, bM, z4, 0, 0, 0);
#pragma unroll
                for (int rg_ = 0; rg_ < 4; ++rg_) { q0[rg_] += RHf[l15 * 65 + 16 * (2 * ks2) + 4 * g + rg_]; q1[rg_] += RHf[l15 * 65 + 16 * (2 * ks2 + 1) + 4 * g + rg_]; }
                *(u32x4*)(fr + 10240 + (size_t)(ks2 * 64 + F.lane) * 16) = (u32x4){pk2(q0[0], q0[1]), pk2(q0[2], q0[3]), pk2(q1[0], q1[1]), pk2(q1[2], q1[3])};
            } else if (F.wave == 6) {
                const bf16x8 aP2 = (g < 2) ? *(const LAS bf16x8*)(P2b + l15 * 24 + 8 * g) : zero8;
                const bf16x8 bM = (g < 2) ? *(const LAS bf16x8*)(MAT + l15 * 24 + 8 * g) : zero8;
                f32x4 d = __builtin_amdgcn_mfma_f32_16x16x32_bf16(aP2, bM, z4, 0, 0, 0);
#pragma unroll
                for (int rg_ = 0; rg_ < 4; ++rg_) d[rg_] += GMB[(4 * g + rg_) * 17 + l15];
                *(u32x2*)(fr + 12288 + (size_t)F.lane * 8) = (u32x2){pk2(d[0], d[1]), pk2(d[2], d[3])};
            } else {
                *(float*)(fr + 14848 + F.lane * 4) = WW[F.lane];
            }
            if (F.tid < 256) {
                const int rg = F.tid >> 6, row = 16 * rg + l15, s4 = 4 * g;
                *(u32x2*)(fr + 12800 + (size_t)(rg * 64 + F.lane) * 8) = (u32x2){pk2(VV[s4 * 64 + row], VV[(s4 + 1) * 64 + row]), pk2(VV[(s4 + 2) * 64 + row], VV[(s4 + 3) * 64 + row])};
            }
        }
    }
}
struct ScanFrag { u32x4 g[4][2]; u32x2 f[4]; u32x4 q1[2]; u32x2 q2; u32x2 vt; f32x4 w[4]; };
__device__ __forceinline__ void scan_frag_load(ScanFrag& fr, const unsigned char* base, int rg, int lane) {
#pragma unroll
    for (int mt = 0; mt < 4; ++mt) {
#pragma unroll
        for (int ks = 0; ks < 2; ++ks) fr.g[mt][ks] = *(const u32x4*)(base + (size_t)((mt * 2 + ks) * 64 + lane) * 16);
        fr.f[mt] = *(const u32x2*)(base + 8192 + (size_t)(mt * 64 + lane) * 8);
        fr.w[mt] = *(const f32x4*)(base + 14848 + (16 * mt + 4 * (lane >> 4)) * 4); }
#pragma unroll
    for (int ks = 0; ks < 2; ++ks) fr.q1[ks] = *(const u32x4*)(base + 10240 + (size_t)(ks * 64 + lane) * 16);
    fr.q2 = *(const u32x2*)(base + 12288 + (size_t)lane * 8);
    fr.vt = *(const u32x2*)(base + 12800 + (size_t)(rg * 64 + lane) * 8);
}
__device__ __forceinline__ void scan_chunk(f32x4 (&acc)[4], const ScanFrag& fr, bf16* yout) {
    const bf16x8 sb0 = as_bf8((u32x4){pk2(acc[0][0], acc[0][1]), pk2(acc[0][2], acc[0][3]), pk2(acc[1][0], acc[1][1]), pk2(acc[1][2], acc[1][3])});
    const bf16x8 sb1 = as_bf8((u32x4){pk2(acc[2][0], acc[2][1]), pk2(acc[2][2], acc[2][3]), pk2(acc[3][0], acc[3][1]), pk2(acc[3][2], acc[3][3])});
    const bf16x8 vb = as_bf8((u32x4){fr.vt.x, fr.vt.y, 0u, 0u});
#pragma unroll
    for (int c = 0; c < 4; ++c) { f32x4 n = acc[c] * fr.w[c];
        n = __builtin_amdgcn_mfma_f32_16x16x32_bf16(as_bf8(fr.g[c][0]), sb0, n, 0, 0, 0);
        n = __builtin_amdgcn_mfma_f32_16x16x32_bf16(as_bf8(fr.g[c][1]), sb1, n, 0, 0, 0);
        n = __builtin_amdgcn_mfma_f32_16x16x32_bf16(as_bf8((u32x4){fr.f[c].x, fr.f[c].y, 0u, 0u}), vb, n, 0, 0, 0);
        acc[c] = n; }
    f32x4 y = {0.f, 0.f, 0.f, 0.f};
    y = __builtin_amdgcn_mfma_f32_16x16x32_bf16(as_bf8(fr.q1[0]), sb0, y, 0, 0, 0);
    y = __builtin_amdgcn_mfma_f32_16x16x32_bf16(as_bf8(fr.q1[1]), sb1, y, 0, 0, 0);
    y = __builtin_amdgcn_mfma_f32_16x16x32_bf16(as_bf8((u32x4){fr.q2.x, fr.q2.y, 0u, 0u}), vb, y, 0, 0, 0);
    *(u32x2*)yout = (u32x2){pk2(y[0], y[1]), pk2(y[2], y[3])};
}
#define SCAN_ASM_LD4(dst, ptr, off) asm volatile("global_load_dwordx4 %0, %1, off offset:" #off : "=v"(dst) : "v"(ptr))
#define SCAN_ASM_LD2(dst, ptr, off) asm volatile("global_load_dwordx2 %0, %1, off offset:" #off : "=v"(dst) : "v"(ptr))
__device__ __forceinline__ void scan_frag_issue(ScanFrag& fr, const unsigned char* item, int rg, int lane) {
    const unsigned char* pg0 = item + lane * 16; const unsigned char* pg1 = pg0 + 4096;
    const unsigned char* pf = item + 8192 + lane * 8; const unsigned char* pq1 = item + 10240 + lane * 16;
    const unsigned char* pq2 = item + 12288 + lane * 8; const unsigned char* pvt = item + 12800 + (rg * 64 + lane) * 8; const unsigned char* pw = item + 14848 + (lane >> 4) * 16;
    SCAN_ASM_LD4(fr.g[0][0], pg0, 0); SCAN_ASM_LD4(fr.g[0][1], pg0, 1024); SCAN_ASM_LD4(fr.g[1][0], pg0, 2048); SCAN_ASM_LD4(fr.g[1][1], pg0, 3072);
    SCAN_ASM_LD4(fr.g[2][0], pg1, 0); SCAN_ASM_LD4(fr.g[2][1], pg1, 1024); SCAN_ASM_LD4(fr.g[3][0], pg1, 2048); SCAN_ASM_LD4(fr.g[3][1], pg1, 3072);
    SCAN_ASM_LD2(fr.f[0], pf, 0); SCAN_ASM_LD2(fr.f[1], pf, 512); SCAN_ASM_LD2(fr.f[2], pf, 1024); SCAN_ASM_LD2(fr.f[3], pf, 1536);
    SCAN_ASM_LD4(fr.q1[0], pq1, 0); SCAN_ASM_LD4(fr.q1[1], pq1, 1024);
    SCAN_ASM_LD2(fr.q2, pq2, 0); SCAN_ASM_LD2(fr.vt, pvt, 0);
    SCAN_ASM_LD4(fr.w[0], pw, 0); SCAN_ASM_LD4(fr.w[1], pw, 64); SCAN_ASM_LD4(fr.w[2], pw, 128); SCAN_ASM_LD4(fr.w[3], pw, 192);
}
#define SCAN_WAIT(fr, N) asm volatile("s_waitcnt vmcnt(" #N ")" : "+v"(fr.g[0][0]), "+v"(fr.g[0][1]), "+v"(fr.g[1][0]), "+v"(fr.g[1][1]), "+v"(fr.g[2][0]), "+v"(fr.g[2][1]), "+v"(fr.g[3][0]), "+v"(fr.g[3][1]), \
        "+v"(fr.f[0]), "+v"(fr.f[1]), "+v"(fr.f[2]), "+v"(fr.f[3]), "+v"(fr.q1[0]), "+v"(fr.q1[1]), "+v"(fr.q2), "+v"(fr.vt), "+v"(fr.w[0]), "+v"(fr.w[1]), "+v"(fr.w[2]), "+v"(fr.w[3]) :: "memory")
__device__ __forceinline__ void scan_mfma_rows(const Args& A, Frame& F) {
    const unsigned char* FR = A.ws + WS_BIG; bf16* YRAW = (bf16*)A.out + (size_t)3 * TOK * 1024;
    if (F.wave != 0) return;
    for (int u = F.bx; u < 128; u += F.G) {
        const int bh = u & 31, rg = u >> 5; const unsigned char* base = FR + (size_t)bh * 1024 * FR_BYTES;
        bf16* yrow = YRAW + ((size_t)bh * 64 + 16 * rg + (F.lane & 15)) * SEQ + 4 * (F.lane >> 4);
        f32x4 acc[4];
#pragma unroll
        for (int c = 0; c < 4; ++c) acc[c] = (f32x4){0.f, 0.f, 0.f, 0.f};
        ScanFrag fa, fb;
        scan_frag_issue(fa, base, rg, F.lane);
#pragma unroll 1
        for (int ch = 0; ch < 1024; ch += 2) {
            scan_frag_issue(fb, base + (size_t)(ch + 1) * FR_BYTES, rg, F.lane);
            SCAN_WAIT(fa, 20);
            scan_chunk(acc, fa, yrow + ch * 16);
            scan_frag_issue(fa, base + (size_t)((ch + 2 < 1024) ? (ch + 2) : ch) * FR_BYTES, rg, F.lane);
            SCAN_WAIT(fb, 20);
            scan_chunk(acc, fb, yrow + (ch + 1) * 16);
        }
        asm volatile("s_waitcnt vmcnt(0)" ::: "memory");
    }
}

__device__ __forceinline__ void pair_sync(volatile LAS unsigned* cnt, unsigned target) {
    asm volatile("s_waitcnt vmcnt(0) lgkmcnt(0)" ::: "memory");
    if ((threadIdx.x & 63) == 0) (void)__hip_atomic_fetch_add((LAS unsigned*)cnt, 1u, __ATOMIC_RELAXED, __HIP_MEMORY_SCOPE_WORKGROUP);
    while (__hip_atomic_load((LAS unsigned*)cnt, __ATOMIC_RELAXED, __HIP_MEMORY_SCOPE_WORKGROUP) < target) __builtin_amdgcn_s_sleep(1);
    asm volatile("" ::: "memory");
}
__device__ __forceinline__ void swa_pairs(const Args& A, Frame& F, volatile LAS unsigned* MISC) {
    const bf16* Z = (const bf16*)(A.ws + WS_Z); bf16* Y = (bf16*)(A.ws + WS_HY); const float* sinks = (const float*)A.in[5];
    const int pr = (F.wave - 4) >> 1, mem = F.wave & 1;
    LAS unsigned char* KL = F.lds + pr * 69632; LAS unsigned char* VL = KL + 256 * 136;
    volatile LAS unsigned* cnt = MISC + 24 + pr; unsigned gen = 0u;
    for (int u = F.bx * 2 + pr; u < 512; u += F.G * 2) {
        const int b = u >> 8, n = (u >> 1) & 127, kvh = u & 1;
        gen += 2u; pair_sync(cnt, gen);
#pragma unroll 1
        for (int c0 = mem * 1024 + F.lane; c0 < mem * 1024 + 1024; c0 += 64 * 8) {
            u32x4 kv[8], vv[8];
#pragma unroll
            for (int q = 0; q < 8; ++q) { const int c = c0 + 64 * q; const int jw = c >> 3, cc = c & 7; const int sp = n * 128 - 128 + jw;
                kv[q] = (u32x4){0u, 0u, 0u, 0u}; vv[q] = kv[q];
                if (sp >= 0) { const bf16* row = Z + (size_t)(b * SEQ + sp) * EV_NP; kv[q] = *(const u32x4*)(row + 1024 + kvh * 64 + cc * 8); vv[q] = *(const u32x4*)(row + 1152 + kvh * 64 + cc * 8); } }
#pragma unroll
            for (int q = 0; q < 8; ++q) { const int c = c0 + 64 * q; const int jw = c >> 3, cc = c & 7;
                *(LAS u32x2*)(KL + jw * 136 + cc * 16) = (u32x2){kv[q].x, kv[q].y}; *(LAS u32x2*)(KL + jw * 136 + cc * 16 + 8) = (u32x2){kv[q].z, kv[q].w};
                *(LAS u32x2*)(VL + jw * 136 + cc * 16) = (u32x2){vv[q].x, vv[q].y}; *(LAS u32x2*)(VL + jw * 136 + cc * 16 + 8) = (u32x2){vv[q].z, vv[q].w}; }
        }
        gen += 2u; pair_sync(cnt, gen);
        for (int it = mem; it < 1024; it += 2) {
            const int i = it >> 3, g = it & 7, head = kvh * 8 + g; const int t = b * SEQ + n * 128 + i;
            const float qv = bf2f(Z[(size_t)t * EV_NP + head * 64 + F.lane]) * 0.125f;
            const int jw0 = i + 1 + F.lane, jw1 = jw0 + 64;
            const bool val0 = (n > 0) || (jw0 >= 128), val1 = (n > 0) || (jw1 >= 128);
            float s0 = 0.f, s1 = 0.f;
#pragma unroll
            for (int d4 = 0; d4 < 16; ++d4) {
                const u32x2 k0 = *(const LAS u32x2*)(KL + jw0 * 136 + d4 * 8), k1 = *(const LAS u32x2*)(KL + jw1 * 136 + d4 * 8);
                const float q0 = rdlane(qv, 4 * d4), q1 = rdlane(qv, 4 * d4 + 1), q2 = rdlane(qv, 4 * d4 + 2), q3 = rdlane(qv, 4 * d4 + 3);
                s0 += q0 * lo2f(k0.x) + q1 * hi2f(k0.x) + q2 * lo2f(k0.y) + q3 * hi2f(k0.y);
                s1 += q0 * lo2f(k1.x) + q1 * hi2f(k1.x) + q2 * lo2f(k1.y) + q3 * hi2f(k1.y);
            }
            const float sink = sinks[head];
            s0 = val0 ? s0 : -INFINITY; s1 = val1 ? s1 : -INFINITY;
            const float mx = fmaxf(wmax(fmaxf(s0, s1)), sink);
            float p0 = val0 ? expf(s0 - mx) : 0.f, p1 = val1 ? expf(s1 - mx) : 0.f;
            const float den = wsum(p0 + p1) + expf(sink - mx); const float rden = 1.0f / den;
            p0 *= rden; p1 *= rden;
            float o = 0.f;
            const LAS bf16* vcol = (const LAS bf16*)VL + F.lane;
#pragma unroll 8
            for (int jj = 0; jj < 64; ++jj) o += rdlane(p0, jj) * bf2f(vcol[(i + 1 + jj) * 68]);
#pragma unroll 8
            for (int jj = 0; jj < 64; ++jj) o += rdlane(p1, jj) * bf2f(vcol[(i + 65 + jj) * 68]);
            Y[(size_t)t * DM + head * 64 + F.lane] = (bf16)f2bf(o);
        }
    }
}

__device__ __forceinline__ void wsum2_dpp(float a, float b, float& ra, float& rb) {
    const auto r = __builtin_amdgcn_permlane32_swap(__float_as_uint(a), __float_as_uint(b), false, false);
    float v = __uint_as_float(r[0]) + __uint_as_float(r[1]);
    v += dppf<0xB1, 0xF>(v); v += dppf<0x4E, 0xF>(v); v += dppf<0x141, 0xF>(v); v += dppf<0x140, 0xF>(v);
    v += dppf<0x142, 0xA>(v);
    ra = rdlane(v, 31); rb = rdlane(v, 63);
}
__device__ __forceinline__ void ph_scan(const Args& A, Frame& F, volatile LAS unsigned* MISC) {
    const unsigned* PK = (const unsigned*)(A.ws + WS_BIG); bf16* YRAW = (bf16*)A.out + (size_t)3 * TOK * 1024;
    if (F.wave >= 4) { swa_pairs(A, F, MISC); return; }
    __builtin_amdgcn_s_setprio(3);
    for (int pp = F.bx * 4 + F.wave; pp < 1024; pp += F.G * 4) {
        const int rr = 2 * pp, bh = rr >> 6, vrow = rr & 63;
        const unsigned* pk = PK + ((size_t)bh * SEQ * 64 + F.lane) * 3;
        bf16* youtA = YRAW + ((size_t)bh * 64 + vrow) * SEQ; bf16* youtB = youtA + SEQ;
        f32x2 S2 = {0.f, 0.f};
        for (int t0 = 0; t0 < SEQ; t0 += 64) {
            float ykA = 0.f, ykB = 0.f;
#pragma unroll 8
            for (int j = 0; j < 64; ++j) {
                const unsigned* p = pk + (size_t)(t0 + j) * 192;
                const unsigned w0 = p[0], w1 = p[1], w2 = p[2];
                const float r = lo2f(w0), e = hi2f(w0), kp = lo2f(w1), kk = hi2f(w1), kka = lo2f(w2), vv = hi2f(w2);
                const f32x2 v2 = {rdlane(vv, vrow), rdlane(vv, vrow + 1)};
                const float dec = __expf(-e);
                const f32x2 pk2v = S2 * (f32x2){kk, kk};
                float saA, saB; wsum2_dpp(pk2v.x, pk2v.y, saA, saB); const f32x2 sa2 = {saA, saB};
                S2 = S2 * (f32x2){dec, dec} + (v2 * (f32x2){kp, kp} - sa2 * (f32x2){kka, kka});
                const f32x2 py = S2 * (f32x2){r, r};
                float yA, yB; wsum2_dpp(py.x, py.y, yA, yB);
                ykA = (F.lane == j) ? yA : ykA; ykB = (F.lane == j) ? yB : ykB;
            }
            youtA[t0 + F.lane] = (bf16)f2bf(ykA); youtB[t0 + F.lane] = (bf16)f2bf(ykB);
        }
    }
    __builtin_amdgcn_s_setprio(0);
}

__device__ __forceinline__ void ph_rwkv_finish(const Args& A, Frame& F) {
    const bf16* Z = (const bf16*)(A.ws + WS_Z); const bf16* RKV = (const bf16*)A.out; const bf16* YRAW = (const bf16*)A.out + (size_t)3 * TOK * 1024;
    const float* BS = (const float*)(A.ws + WS_BS); bf16* Y = (bf16*)(A.ws + WS_HY);
    const float* lnx_g = (const float*)A.in[15]; const float* lnx_b = (const float*)A.in[16];
    LAS float* tile = (LAS float*)(F.lds + F.wave * 16640);
    for (int it = F.gw; it < 8192; it += F.ngw) {
        const int bh = it >> 8, tb = it & 255, b = bh >> 4, h = bh & 15, t0 = tb * 64;
        for (int vr = 0; vr < 64; ++vr) tile[vr * 65 + F.lane] = bf2f(YRAW[((size_t)bh * 64 + vr) * SEQ + t0 + F.lane]);
        asm volatile("s_waitcnt lgkmcnt(0)" ::: "memory");
        const int c = h * 64 + F.lane; const float lg = lnx_g[c], lb = lnx_b[c];
        for (int j = 0; j < 64; ++j) {
            const int t = b * SEQ + t0 + j;
            const float y = tile[F.lane * 65 + j];
            const float mean = wsum(y) * (1.0f / 64.0f); const float d = y - mean; const float var = wsum(d * d) * (1.0f / 64.0f);
            const float yn = d * rsqrtf(var + 64e-5f) * lg + lb;
            const float vv = bf2f(RKV[(size_t)2 * TOK * 1024 + (size_t)t * 1024 + c]); const float g = bf2f(Z[(size_t)t * EV_NP + 1280 + 2048 + c]); const float bs = BS[(size_t)t * 16 + h];
            Y[(size_t)t * DM + 1024 + c] = (bf16)f2bf((yn + bs * vv) * g);
        }
        asm volatile("s_waitcnt lgkmcnt(0)" ::: "memory");
    }
}

constexpr size_t WS_H8 = WS_BIG + 384 * MiB, WS_HS = WS_BIG + 448 * MiB;
__device__ __forceinline__ unsigned pack_i8x4(float a, float b, float c, float d) {
    const unsigned ua = __float_as_uint(a + 12582912.0f) & 255u, ub = __float_as_uint(b + 12582912.0f) & 255u, uc = __float_as_uint(c + 12582912.0f) & 255u, ud = __float_as_uint(d + 12582912.0f);
    return ua | (ub << 8) | (uc << 16) | (ud << 24);
}
__device__ __forceinline__ void ph_ln_mixer(const Args& A, Frame& F, const int L) {
    const float* xsrc = (L == 0) ? (const float*)A.in[0] : (const float*)A.out; float* xdst = A.out;
    const bf16* O = (const bf16*)(A.ws + WS_Z); bf16* H = (bf16*)(A.ws + WS_HY); const float* MOD = (const float*)(A.ws + WS_MOD);
    const float* lng = (const float*)A.in[21] + (size_t)(L * 2 + 0) * DM; const float* lnb = (const float*)A.in[22] + (size_t)(L * 2 + 0) * DM;
    for (int t = F.gw; t < TOK; t += F.ngw) {
        const int b = t >> 14;
        const float* gate = MOD + (size_t)((L * 2 + 0) * 2 + b) * 6144 + 4096;
        const float* sh = MOD + (size_t)((L * 2 + 1) * 2 + b) * 6144; const float* sc = sh + 2048;
        float v[32]; float sum = 0.f;
#pragma unroll
        for (int j = 0; j < 4; ++j) { const int base = (j * 64 + F.lane) * 8;
            const u32x4 ow = *(const u32x4*)(O + (size_t)t * DM + base);
            const f32x4 x0 = *(const f32x4*)(xsrc + (size_t)t * DM + base), x1 = *(const f32x4*)(xsrc + (size_t)t * DM + base + 4);
            const f32x4 g0 = *(const f32x4*)(gate + base), g1 = *(const f32x4*)(gate + base + 4);
            const float of[8] = {lo2f(ow.x), hi2f(ow.x), lo2f(ow.y), hi2f(ow.y), lo2f(ow.z), hi2f(ow.z), lo2f(ow.w), hi2f(ow.w)};
#pragma unroll
            for (int e = 0; e < 4; ++e) { v[j * 8 + e] = ALPHA * x0[e] + (1.0f + g0[e]) * of[e]; v[j * 8 + 4 + e] = ALPHA * x1[e] + (1.0f + g1[e]) * of[4 + e]; }
#pragma unroll
            for (int e = 0; e < 8; ++e) sum += v[j * 8 + e]; }
        const float mean = wsum(sum) * (1.0f / DM); float sq = 0.f;
#pragma unroll
        for (int e = 0; e < 32; ++e) { v[e] -= mean; sq += v[e] * v[e]; }
        const float rstd = rsqrtf(wsum(sq) * (1.0f / DM) + 1e-5f); float hmax = 0.f;
#pragma unroll
        for (int j = 0; j < 4; ++j) { const int base = (j * 64 + F.lane) * 8;
            const f32x4 lg0 = *(const f32x4*)(lng + base), lg1 = *(const f32x4*)(lng + base + 4), lb0 = *(const f32x4*)(lnb + base), lb1 = *(const f32x4*)(lnb + base + 4);
            const f32x4 s0 = *(const f32x4*)(sc + base), s1 = *(const f32x4*)(sc + base + 4), h0 = *(const f32x4*)(sh + base), h1 = *(const f32x4*)(sh + base + 4);
            f32x4 o0, o1;
#pragma unroll
            for (int e = 0; e < 4; ++e) { o0[e] = v[j * 8 + e] * rstd * lg0[e] + lb0[e]; o1[e] = v[j * 8 + 4 + e] * rstd * lg1[e] + lb1[e]; }
            *(f32x4*)(xdst + (size_t)t * DM + base) = o0; *(f32x4*)(xdst + (size_t)t * DM + base + 4) = o1;
            const f32x4 q0 = o0 * (1.0f + s0) + h0, q1 = o1 * (1.0f + s1) + h1;
            u32x4 w; w.x = pk2(q0[0], q0[1]); w.y = pk2(q0[2], q0[3]); w.z = pk2(q1[0], q1[1]); w.w = pk2(q1[2], q1[3]);
            *(u32x4*)(H + (size_t)t * DM + base) = w;
#pragma unroll
            for (int e = 0; e < 4; ++e) { v[j * 8 + e] = q0[e]; v[j * 8 + 4 + e] = q1[e]; hmax = fmaxf(hmax, fmaxf(fabsf(q0[e]), fabsf(q1[e]))); } }
        { hmax = wmax(hmax); const float inv = (hmax > 0.f) ? 127.0f / hmax : 0.f;
#pragma unroll
          for (int j = 0; j < 4; ++j) { const int base = (j * 64 + F.lane) * 8; u32x2 w8;
              w8.x = pack_i8x4(v[j * 8 + 0] * inv, v[j * 8 + 1] * inv, v[j * 8 + 2] * inv, v[j * 8 + 3] * inv); w8.y = pack_i8x4(v[j * 8 + 4] * inv, v[j * 8 + 5] * inv, v[j * 8 + 6] * inv, v[j * 8 + 7] * inv);
              *(u32x2*)(A.ws + WS_H8 + (size_t)t * DM + base) = w8; }
          if (F.lane == 0) ((float*)(A.ws + WS_HS))[t] = hmax * (1.0f / 127.0f); }
    }
    {
        const float* pu = (const float*)A.in[25] + (size_t)L * 16384 * 2048; const float* pv = (const float*)A.in[26] + (size_t)L * 16384 * 2048;
        unsigned char* T8 = A.ws + WS_BIG; float* SCL = (float*)(A.ws + WS_BIG + 64 * MiB);
        for (int r = F.gw; r < 32768; r += F.ngw) {
            const float* src = ((r < 16384) ? pu : pv) + (size_t)(r & 16383) * 2048;
            f32x4 f[2][4]; float amax = 0.f;
#pragma unroll
            for (int j = 0; j < 2; ++j)
#pragma unroll
                for (int c = 0; c < 4; ++c) { f[j][c] = *(const f32x4*)(src + (j * 64 + F.lane) * 16 + 4 * c);
                    amax = fmaxf(amax, fmaxf(fmaxf(fabsf(f[j][c][0]), fabsf(f[j][c][1])), fmaxf(fabsf(f[j][c][2]), fabsf(f[j][c][3])))); }
            amax = wmax(amax);
            {
                const float inv = (amax > 0.f) ? 127.0f / amax : 0.f;
#pragma unroll
                for (int j = 0; j < 2; ++j) { u32x4 w;
                    w.x = pack_i8x4(f[j][0][0] * inv, f[j][0][1] * inv, f[j][0][2] * inv, f[j][0][3] * inv); w.y = pack_i8x4(f[j][1][0] * inv, f[j][1][1] * inv, f[j][1][2] * inv, f[j][1][3] * inv);
                    w.z = pack_i8x4(f[j][2][0] * inv, f[j][2][1] * inv, f[j][2][2] * inv, f[j][2][3] * inv); w.w = pack_i8x4(f[j][3][0] * inv, f[j][3][1] * inv, f[j][3][2] * inv, f[j][3][3] * inv);
                    *(u32x4*)(T8 + (size_t)r * 2048 + (j * 64 + F.lane) * 16) = w; }
                if (F.lane == 0) SCL[r] = amax * (1.0f / 127.0f);
            }
        }
    }
}

template <int NV, int NBITS> __device__ __forceinline__ unsigned wave_tau16(const unsigned (&key)[NV]) {
    unsigned tau = 0u;
#pragma unroll 1
    for (int bit = NBITS - 1; bit >= 0; --bit) {
        const unsigned cand = tau | (1u << bit); int cnt = 0;
#pragma unroll
        for (int v = 0; v < NV; ++v) cnt += __popcll(__ballot(key[v] >= cand));
        if (cnt >= 16) tau = cand;
    }
    return tau;
}
template <int NV> __device__ __forceinline__ void wave_compact16(const unsigned (&key)[NV], const float (&val)[NV], const int (&id)[NV], unsigned tau, LAS float* ov, LAS int* oi, int lane) {
    int ngt = 0;
#pragma unroll
    for (int v = 0; v < NV; ++v) ngt += __popcll(__ballot(key[v] > tau));
    int bg = 0, be = 0;
#pragma unroll
    for (int v = 0; v < NV; ++v) {
        const bool gt = key[v] > tau, eq = key[v] == tau;
        const unsigned long long mg = __ballot(gt), me = __ballot(eq);
        const unsigned long long below = (lane == 0) ? 0ull : ((~0ull) >> (64 - lane));
        const int pg = bg + __popcll(mg & below), pe = ngt + be + __popcll(me & below);
        if (gt) { ov[pg] = val[v]; oi[pg] = id[v]; }
        if (eq && pe < 16) { ov[pe] = val[v]; oi[pe] = id[v]; }
        bg += __popcll(mg); be += __popcll(me);
    }
}

template <int CTRL, int BANK> __device__ __forceinline__ unsigned dppb(unsigned old, unsigned v) { return (unsigned)__builtin_amdgcn_update_dpp((int)old, (int)v, CTRL, 0xF, BANK, false); }
template <int CTRL> __device__ __forceinline__ unsigned dppm(unsigned v) { return (unsigned)__builtin_amdgcn_mov_dpp((int)v, CTRL, 0xF, 0xF, true); }
template <int CTRL> __device__ __forceinline__ unsigned cex(unsigned x, bool lo) { const unsigned mx = max(x, dppm<CTRL>(x)), mn = min(x, dppm<CTRL>(x)); return lo ? mx : mn; }
__device__ __forceinline__ unsigned cex4(unsigned x, bool lo) {
    unsigned t = (unsigned)__builtin_amdgcn_mov_dpp((int)x, 0x104, 0xF, 0x5, false); t = dppb<0x114, 0xA>(t, x); const unsigned mx = max(x, t), mn = min(x, t); return lo ? mx : mn; }
struct LoMasks { bool lo1, lo2, lo4, lo8, odd16, up32; };
__device__ __forceinline__ unsigned sort16_desc(unsigned x, const LoMasks& M) {
    x = cex<0xB1>(x, M.lo1);
    x = cex<0x1B>(x, M.lo2); x = cex<0xB1>(x, M.lo1);
    x = cex<0x141>(x, M.lo4); x = cex<0x4E>(x, M.lo2); x = cex<0xB1>(x, M.lo1);
    x = cex<0x140>(x, M.lo8); x = cex4(x, M.lo4); x = cex<0x4E>(x, M.lo2); x = cex<0xB1>(x, M.lo1);
    return x;
}
__device__ __forceinline__ unsigned clean16_desc(unsigned x, const LoMasks& M) {
    x = cex<0x128>(x, M.lo8); x = cex4(x, M.lo4); x = cex<0x4E>(x, M.lo2); x = cex<0xB1>(x, M.lo1); return x;
}
__device__ __forceinline__ unsigned mtop_regs(unsigned a, unsigned b) { return max(a, dppm<0x140>(b)); }
__device__ __forceinline__ unsigned mtop_rows(unsigned y, const LoMasks& M) { const auto r = __builtin_amdgcn_permlane16_swap(y, y, false, false); const unsigned pv = M.odd16 ? r[0] : r[1]; return mtop_regs(y, pv); }
__device__ __forceinline__ unsigned mtop_halves(unsigned y, const LoMasks& M) { const auto r = __builtin_amdgcn_permlane32_swap(y, y, false, false); const unsigned pv = M.up32 ? r[0] : r[1]; return mtop_regs(y, pv); }

template <int OFF, int N, int MASKX, int TOT> __device__ __forceinline__ void ce_stage(unsigned (&k)[TOT]) {
#pragma unroll
    for (int i = 0; i < N; ++i) { const int pr = i ^ MASKX; if (pr > i) { const unsigned a_ = k[OFF + i], b_ = k[OFF + pr]; k[OFF + i] = max(a_, b_); k[OFF + pr] = min(a_, b_); } }
}
template <int OFF, int TOT> __device__ __forceinline__ void sort16_regs(unsigned (&k)[TOT]) {
    ce_stage<OFF, 16, 1>(k); ce_stage<OFF, 16, 3>(k); ce_stage<OFF, 16, 1>(k); ce_stage<OFF, 16, 7>(k); ce_stage<OFF, 16, 2>(k); ce_stage<OFF, 16, 1>(k);
    ce_stage<OFF, 16, 15>(k); ce_stage<OFF, 16, 4>(k); ce_stage<OFF, 16, 2>(k); ce_stage<OFF, 16, 1>(k);
}
template <int TOT> __device__ __forceinline__ void clean16_regs(unsigned (&k)[TOT]) { ce_stage<0, 16, 8>(k); ce_stage<0, 16, 4>(k); ce_stage<0, 16, 2>(k); ce_stage<0, 16, 1>(k); }

__device__ __forceinline__ void ph_peer_select(const Args& A, Frame& F, const int L) {
    const bf16* QP = (const bf16*)(A.ws + WS_Z); const bf16* SKB = (const bf16*)(A.ws + WS_SKB) + (size_t)L * 262144;
    int* EID = (int*)(A.ws + WS_LA); float* GSM = (float*)(A.ws + WS_LA + 16 * MiB);
    LAS unsigned char* SKL = F.lds;
    LAS float* SCO = (LAS float*)(F.lds + 69632 + 4096);
    for (int it = F.bx; it < 4096; it += F.G) {
        const int tile = it >> 3, h = it & 7;
        __syncthreads();
        for (int c = F.tid; c < 4096; c += NTHREADS) { const int p = c >> 11, n = (c >> 4) & 127, cc = c & 15;
            *(LAS u32x4*)(SKL + (p * 128 + n) * 272 + cc * 16) = *(const u32x4*)(SKB + ((size_t)((p * 8 + h) * 128 + n)) * 128 + cc * 8); }
        __syncthreads();
        {
            const int p = F.wave >> 2, mt = F.wave & 3, g = F.lane >> 4, l15 = F.lane & 15;
            const bf16* qrow = QP + (size_t)(tile * 64 + mt * 16 + l15) * DM + h * 256 + p * 128 + 8 * g;
            bf16x8 afr[4];
#pragma unroll
            for (int ks = 0; ks < 4; ++ks) afr[ks] = *(const bf16x8*)(qrow + 32 * ks);
#pragma unroll
            for (int nt = 0; nt < 8; ++nt) {
                f32x4 acc = {0.f, 0.f, 0.f, 0.f};
#pragma unroll
                for (int ks = 0; ks < 4; ++ks) { const bf16x8 bfr = *(const LAS bf16x8*)(SKL + (p * 128 + nt * 16 + l15) * 272 + (32 * ks + 8 * g) * 2);
                    acc = __builtin_amdgcn_mfma_f32_16x16x32_bf16(afr[ks], bfr, acc, 0, 0, 0); }
#pragma unroll
                for (int rg = 0; rg < 4; ++rg) SCO[(p * 64 + mt * 16 + 4 * g + rg) * 132 + nt * 16 + l15] = acc[rg];
            }
        }
        __syncthreads();
        constexpr int NT = 4;
        LAS unsigned char* WB = F.lds + 141312 + F.wave * 2048;
        LoMasks M; M.lo1 = (F.lane & 1) == 0; M.lo2 = (F.lane & 2) == 0; M.lo4 = (F.lane & 4) == 0; M.lo8 = (F.lane & 8) == 0; M.odd16 = (F.lane & 16) != 0; M.up32 = (F.lane & 32) != 0;
        int pi_, pj_;
        { const int L = F.lane;
          if (L < 16) { pi_ = 0; pj_ = L; } else if (L < 24) { pi_ = 1; pj_ = L - 16; } else if (L < 29) { pi_ = 2; pj_ = L - 24; } else if (L < 33) { pi_ = 3; pj_ = L - 29; }
          else if (L < 36) { pi_ = 4; pj_ = L - 33; } else if (L < 42) { pi_ = 5 + ((L - 36) >> 1); pj_ = (L - 36) & 1; } else { pi_ = 8 + (L - 42); pj_ = 0; }
          if (L >= 50) { pi_ = 0; pj_ = 0; } }
        const bool pvalid = F.lane < 50;
        {
            const int g = F.lane >> 2, q = F.lane & 3, tok = g >> 1, sp = g & 1;
            const LAS float* srow = SCO + (sp * 64 + F.wave * 8 + tok) * 132;
            unsigned k[32]; const unsigned ib = (unsigned)(127 - q * 32);
#pragma unroll
            for (int c = 0; c < 8; ++c) { const f32x4 v = *(const LAS f32x4*)(srow + q * 32 + 4 * c);
#pragma unroll
                for (int e = 0; e < 4; ++e) k[4 * c + e] = (fixkey20(v[e]) << 7) | (ib - (unsigned)(4 * c + e)); }
            sort16_regs<0>(k); sort16_regs<16>(k);
            unsigned m[16], t2[16];
#pragma unroll
            for (int i = 0; i < 16; ++i) m[i] = max(k[i], k[31 - i]);
            clean16_regs(m);
#pragma unroll
            for (int i = 0; i < 16; ++i) t2[i] = max(m[i], dppm<0xB1>(m[15 - i]));
            clean16_regs(t2);
#pragma unroll
            for (int i = 0; i < 16; ++i) m[i] = max(t2[i], dppm<0x4E>(t2[15 - i]));
            clean16_regs(m);
            float vals[16]; int idxs[16];
#pragma unroll
            for (int e = 0; e < 16; ++e) { idxs[e] = 127 - (int)(m[e] & 127u); vals[e] = srow[idxs[e]]; }
            if (q == 0) { LAS float* tvp = (LAS float*)(WB + tok * 256) + sp * 16; LAS int* tip = (LAS int*)(WB + tok * 256 + 128) + sp * 16;
#pragma unroll
                for (int c = 0; c < 4; ++c) { *(LAS f32x4*)(tvp + 4 * c) = (f32x4){vals[4 * c], vals[4 * c + 1], vals[4 * c + 2], vals[4 * c + 3]};
                    *(LAS u32x4*)(tip + 4 * c) = (u32x4){(unsigned)idxs[4 * c], (unsigned)idxs[4 * c + 1], (unsigned)idxs[4 * c + 2], (unsigned)idxs[4 * c + 3]}; } }
        }
        asm volatile("s_waitcnt lgkmcnt(0)" ::: "memory"); __builtin_amdgcn_wave_barrier();
#pragma unroll 1
        for (int tk0 = 0; tk0 < 8; tk0 += NT) {
            unsigned z[NT];
#pragma unroll
            for (int u = 0; u < NT; ++u) { const LAS float* tv = (const LAS float*)(WB + (tk0 + u) * 256); const float cvl = tv[pi_] + tv[16 + pj_];
                z[u] = pvalid ? ((fixkey20(cvl * 0.5f) << 8) | (unsigned)(255 - (pi_ * 16 + pj_))) : 0u; }
#define ALL4(EXPR) _Pragma("unroll") for (int u = 0; u < NT; ++u) { const unsigned X = z[u]; z[u] = (EXPR); }
#define CLEAN4() ALL4(cex<0x128>(X, M.lo8)) ALL4(cex4(X, M.lo4)) ALL4(cex<0x4E>(X, M.lo2)) ALL4(cex<0xB1>(X, M.lo1))
            ALL4(cex<0xB1>(X, M.lo1))
            ALL4(cex<0x1B>(X, M.lo2)) ALL4(cex<0xB1>(X, M.lo1))
            ALL4(cex<0x141>(X, M.lo4)) ALL4(cex<0x4E>(X, M.lo2)) ALL4(cex<0xB1>(X, M.lo1))
            ALL4(cex<0x140>(X, M.lo8)) ALL4(cex4(X, M.lo4)) ALL4(cex<0x4E>(X, M.lo2)) ALL4(cex<0xB1>(X, M.lo1))
            ALL4(mtop_rows(X, M)) CLEAN4()
            ALL4(mtop_halves(X, M)) CLEAN4()
#undef ALL4
#undef CLEAN4
#pragma unroll
            for (int u = 0; u < NT; ++u) { const int t = tile * 64 + F.wave * 8 + tk0 + u;
                const LAS float* tv = (const LAS float*)(WB + (tk0 + u) * 256); const LAS int* ti = (const LAS int*)(WB + (tk0 + u) * 256 + 128);
                const int cid = 255 - (int)(z[u] & 255u), bi = (F.lane < 16) ? (cid >> 4) : 0, bj = (F.lane < 16) ? (cid & 15) : 0;
                const float bv = (F.lane < 16) ? (tv[bi] + tv[16 + bj]) : -INFINITY;
                const float mx = wmax(bv); const float ev = (F.lane < 16) ? expf(bv - mx) : 0.f; const float den = wsum(ev);
                if (F.lane < 16) { const int e1 = ti[bi], e2 = ti[16 + bj];
                    EID[(size_t)t * 128 + h * 16 + F.lane] = e1 * 128 + e2; GSM[(size_t)t * 128 + h * 16 + F.lane] = ev / den; } }
            asm volatile("s_waitcnt lgkmcnt(0)" ::: "memory"); __builtin_amdgcn_wave_barrier();
        }
    }
}

constexpr int PGB = 4;
__device__ __forceinline__ void ph_peer_gather(const Args& A, Frame& F, const int L, const bool dry = false) {
    bf16* H = (bf16*)(A.ws + WS_HY); bf16* Hout = dry ? (bf16*)(A.ws + WS_BIG + 128 * MiB) : H; float* Xout = dry ? (float*)(A.ws + WS_Z) : A.out; const unsigned char* TU = A.ws + WS_BIG; const unsigned char* TV = TU + (size_t)16384 * 2048; const float* SCL = (const float*)(A.ws + WS_BIG + 64 * MiB);
    const int* EID = (const int*)(A.ws + WS_LA); const float* GSM = (const float*)(A.ws + WS_LA + 16 * MiB);
    const float* MOD = (const float*)(A.ws + WS_MOD); float* X = A.out;
    const float* lng = (const float*)A.in[21] + (size_t)(L * 2 + 1) * DM; const float* lnb = (const float*)A.in[22] + (size_t)(L * 2 + 1) * DM;
    for (int t = F.gw; t < TOK; t += F.ngw) {
        const int b = t >> 14;
        f32x2 h2[16];
#pragma unroll
        for (int j = 0; j < 2; ++j) { const u32x4 a = *(const u32x4*)(H + (size_t)t * DM + (j * 64 + F.lane) * 16), c = *(const u32x4*)(H + (size_t)t * DM + (j * 64 + F.lane) * 16 + 8);
            const unsigned aw[8] = {a.x, a.y, a.z, a.w, c.x, c.y, c.z, c.w};
#pragma unroll
            for (int q = 0; q < 8; ++q) h2[j * 8 + q] = (f32x2){lo2f(aw[q]), hi2f(aw[q])}; }
        f32x2 o2[16];
#pragma unroll
        for (int e = 0; e < 16; ++e) o2[e] = (f32x2){0.f, 0.f};
#pragma unroll 1
        for (int e0 = 0; e0 < 128; e0 += PGB) {
            int eid[PGB]; float gw[PGB], su[PGB], sv[PGB];
#pragma unroll
            for (int q = 0; q < PGB; ++q) { eid[q] = __builtin_amdgcn_readfirstlane(EID[(size_t)t * 128 + e0 + q]); gw[q] = GSM[(size_t)t * 128 + e0 + q]; su[q] = SCL[eid[q]]; sv[q] = SCL[16384 + eid[q]]; }
            u32x4 uu[PGB][2], vv[PGB][2];
#pragma unroll
            for (int q = 0; q < PGB; ++q)
#pragma unroll
                for (int j = 0; j < 2; ++j) { uu[q][j] = *(const u32x4*)(TU + (size_t)eid[q] * 2048 + (j * 64 + F.lane) * 16); vv[q][j] = *(const u32x4*)(TV + (size_t)eid[q] * 2048 + (j * 64 + F.lane) * 16); }
#pragma unroll
            for (int q = 0; q < PGB; ++q) {
                f32x2 d2 = {0.f, 0.f};
#pragma unroll
                for (int j = 0; j < 2; ++j) { const unsigned w[4] = {uu[q][j].x, uu[q][j].y, uu[q][j].z, uu[q][j].w};
#pragma unroll
                    for (int i = 0; i < 4; ++i) { const f32x2 lo = __builtin_amdgcn_cvt_pk_f32_fp8((int)w[i], false), hi = __builtin_amdgcn_cvt_pk_f32_fp8((int)w[i], true);
                        d2 = lo * h2[j * 8 + 2 * i] + d2; d2 = hi * h2[j * 8 + 2 * i + 1] + d2; } }
                const float d = wsum(d2.x + d2.y) * su[q];
                const float act = 0.5f * d * (1.0f + erff(d * 0.70710678f)) * gw[q] * sv[q];
                const f32x2 a2 = {act, act};
#pragma unroll
                for (int j = 0; j < 2; ++j) { const unsigned w[4] = {vv[q][j].x, vv[q][j].y, vv[q][j].z, vv[q][j].w};
#pragma unroll
                    for (int i = 0; i < 4; ++i) { const f32x2 lo = __builtin_amdgcn_cvt_pk_f32_fp8((int)w[i], false), hi = __builtin_amdgcn_cvt_pk_f32_fp8((int)w[i], true);
                        o2[j * 8 + 2 * i] = a2 * lo + o2[j * 8 + 2 * i]; o2[j * 8 + 2 * i + 1] = a2 * hi + o2[j * 8 + 2 * i + 1]; } }
            }
        }
        float out[32];
#pragma unroll
        for (int e = 0; e < 16; ++e) { out[2 * e] = o2[e].x; out[2 * e + 1] = o2[e].y; }
        const float* gate = MOD + (size_t)((L * 2 + 1) * 2 + b) * 6144 + 4096;
        float sum = 0.f;
#pragma unroll
        for (int j = 0; j < 2; ++j)
#pragma unroll
            for (int c = 0; c < 4; ++c) { const int base = (j * 64 + F.lane) * 16 + 4 * c;
                const f32x4 x0 = *(const f32x4*)(X + (size_t)t * DM + base), g0 = *(const f32x4*)(gate + base);
#pragma unroll
                for (int e = 0; e < 4; ++e) { const float v = ALPHA * x0[e] + (1.0f + g0[e]) * out[j * 16 + 4 * c + e]; out[j * 16 + 4 * c + e] = v; sum += v; } }
        const float mean = wsum(sum) * (1.0f / DM); float sq = 0.f;
#pragma unroll
        for (int e = 0; e < 32; ++e) { out[e] -= mean; sq += out[e] * out[e]; }
        const float rstd = rsqrtf(wsum(sq) * (1.0f / DM) + 1e-5f);
        const float* sh = MOD + (size_t)(((L + 1) * 2 + 0) * 2 + b) * 6144; const float* sc = sh + 2048;
#pragma unroll
        for (int j = 0; j < 2; ++j) {
            float hq[16];
#pragma unroll
            for (int c = 0; c < 4; ++c) { const int base = (j * 64 + F.lane) * 16 + 4 * c;
                const f32x4 lg0 = *(const f32x4*)(lng + base), lb0 = *(const f32x4*)(lnb + base);
                f32x4 o0;
#pragma unroll
                for (int e = 0; e < 4; ++e) o0[e] = out[j * 16 + 4 * c + e] * rstd * lg0[e] + lb0[e];
                *(f32x4*)(Xout + (size_t)t * DM + base) = o0;
                if (L == 0) { const f32x4 s0 = *(const f32x4*)(sc + base), h0 = *(const f32x4*)(sh + base);
#pragma unroll
                    for (int e = 0; e < 4; ++e) hq[4 * c + e] = o0[e] * (1.0f + s0[e]) + h0[e]; } }
            if (L == 0) { u32x4 w0, w1;
                w0.x = pk2(hq[0], hq[1]); w0.y = pk2(hq[2], hq[3]); w0.z = pk2(hq[4], hq[5]); w0.w = pk2(hq[6], hq[7]);
                w1.x = pk2(hq[8], hq[9]); w1.y = pk2(hq[10], hq[11]); w1.z = pk2(hq[12], hq[13]); w1.w = pk2(hq[14], hq[15]);
                *(u32x4*)(Hout + (size_t)t * DM + (j * 64 + F.lane) * 16) = w0; *(u32x4*)(Hout + (size_t)t * DM + (j * 64 + F.lane) * 16 + 8) = w1; }
        }
    }
}

struct XInfo { int rank, nloc, rx, nx; };
__device__ __forceinline__ XInfo xcc_info(volatile LAS unsigned* MISC) { XInfo x; x.rank = (int)MISC[16]; x.nloc = (int)MISC[17]; x.rx = (int)MISC[18]; x.nx = (int)MISC[19]; return x; }
constexpr size_t WS_DP = WS_BIG + 128 * MiB;
constexpr size_t WS_ACT = WS_BIG + 80 * MiB;
__device__ __forceinline__ void ph_peer_u(const Args& A, Frame& F, const XInfo X) {
    const unsigned char* H8 = A.ws + WS_H8; const unsigned char* TU = A.ws + WS_BIG; const int* EID = (const int*)(A.ws + WS_LA); float* DP = (float*)(A.ws + WS_DP);
    LAS int* IDX = (LAS int*)(F.lds + F.wave * 1024);
    const int g16 = F.lane >> 4, c16 = F.lane & 15; const int step = X.nloc * NWAVES;
    for (int s = X.rx; s < 8; s += X.nx) {
        int t = X.rank * NWAVES + F.wave;
        int e0 = 0, e1 = 0; u32x4 ha = {0u, 0u, 0u, 0u};
        if (t < TOK) { e0 = EID[(size_t)t * 128 + F.lane]; e1 = EID[(size_t)t * 128 + 64 + F.lane]; ha = *(const u32x4*)(H8 + (size_t)t * DM + 256 * s + 16 * c16); }
        const unsigned char* ub = TU + 256 * s + 16 * c16;
        while (t < TOK) {
            const int tn = t + step; int n0 = 0, n1 = 0; u32x4 na = {0u, 0u, 0u, 0u};
            if (tn < TOK) { n0 = EID[(size_t)tn * 128 + F.lane]; n1 = EID[(size_t)tn * 128 + 64 + F.lane]; na = *(const u32x4*)(H8 + (size_t)tn * DM + 256 * s + 16 * c16); }
            IDX[F.lane] = e0; IDX[F.lane + 64] = e1;
            asm volatile("s_waitcnt lgkmcnt(0)" ::: "memory"); __builtin_amdgcn_wave_barrier();
            float keep0 = 0.f, keep1 = 0.f;
#pragma unroll
            for (int i0 = 0; i0 < 32; i0 += 8) {
                u32x4 ud[8];
#pragma unroll
                for (int u = 0; u < 8; ++u) { const int eid = IDX[4 * (i0 + u) + g16]; ud[u] = *(const u32x4*)(ub + (size_t)eid * 2048); }
#pragma unroll
                for (int u = 0; u < 8; ++u) {
                    int di = __builtin_amdgcn_sdot4((int)ud[u].x, (int)ha.x, 0, false); di = __builtin_amdgcn_sdot4((int)ud[u].y, (int)ha.y, di, false);
                    di = __builtin_amdgcn_sdot4((int)ud[u].z, (int)ha.z, di, false); di = __builtin_amdgcn_sdot4((int)ud[u].w, (int)ha.w, di, false);
                    const float d = sum16_dpp((float)di);
                    const int i = i0 + u;
                    if (i < 16) keep0 = ((i & 15) == c16) ? d : keep0; else keep1 = ((i & 15) == c16) ? d : keep1;
                }
            }
            float* dp = DP + ((size_t)s * TOK + t) * 128 + 4 * c16 + g16;
            dp[0] = keep0; dp[64] = keep1;
            asm volatile("s_waitcnt lgkmcnt(0)" ::: "memory"); __builtin_amdgcn_wave_barrier();
            e0 = n0; e1 = n1; ha = na; t = tn;
        }
    }
}
__device__ __forceinline__ void ph_peer_act(const Args& A, Frame& F) {
    const float* SCL = (const float*)(A.ws + WS_BIG + 64 * MiB); const int* EID = (const int*)(A.ws + WS_LA); const float* GSM = (const float*)(A.ws + WS_LA + 16 * MiB);
    const float* DP = (const float*)(A.ws + WS_DP); unsigned char* ACT8 = A.ws + WS_ACT; float* AS = (float*)(A.ws + WS_ACT + 8 * MiB);
    for (int t = F.gw; t < TOK; t += F.ngw) { const float hs = ((const float*)(A.ws + WS_HS))[t];
        float a[2];
#pragma unroll
        for (int m = 0; m < 2; ++m) { const int e = F.lane + 64 * m; const int eid = EID[(size_t)t * 128 + e]; float d = 0.f;
#pragma unroll
            for (int x = 0; x < 8; ++x) d += DP[((size_t)x * TOK + t) * 128 + e];
            d *= SCL[eid] * hs;
            a[m] = 0.5f * d * (1.0f + erff(d * 0.70710678f)) * GSM[(size_t)t * 128 + e] * SCL[16384 + eid]; }
        const float amax = wmax(fmaxf(fabsf(a[0]), fabsf(a[1]))); const float inv = (amax > 0.f) ? 127.0f / amax : 0.f;
#pragma unroll
        for (int m = 0; m < 2; ++m) ACT8[(size_t)t * 128 + F.lane + 64 * m] = (unsigned char)(__float_as_uint(a[m] * inv + 12582912.0f) & 255u);
        if (F.lane == 0) AS[t] = amax * (1.0f / 127.0f);
    }
}
__device__ __forceinline__ void ph_peer_v(const Args& A, Frame& F, const XInfo X) {
    const unsigned char* TV = A.ws + WS_BIG + (size_t)16384 * 2048;
    const int* EID = (const int*)(A.ws + WS_LA); const unsigned* ACT8 = (const unsigned*)(A.ws + WS_ACT); const float* AS = (const float*)(A.ws + WS_ACT + 8 * MiB); bf16* OUT = (bf16*)(A.ws + WS_Z);
    LAS int* IDX = (LAS int*)(F.lds + F.wave * 1024); LAS unsigned* ACT = (LAS unsigned*)(F.lds + F.wave * 1024 + 512);
    const int g16 = F.lane >> 4, c16 = F.lane & 15; const int step = X.nloc * NWAVES;
    for (int s = X.rx; s < 8; s += X.nx) {
        int t = X.rank * NWAVES + F.wave;
        int e0 = 0, e1 = 0; unsigned a0 = 0u;
        if (t < TOK) { e0 = EID[(size_t)t * 128 + F.lane]; e1 = EID[(size_t)t * 128 + 64 + F.lane]; a0 = ACT8[(size_t)t * 32 + (F.lane & 31)]; }
        const unsigned char* vb = TV + 256 * s + 16 * c16;
        while (t < TOK) {
            const int tn = t + step; int n0 = 0, n1 = 0; unsigned b0 = 0u;
            if (tn < TOK) { n0 = EID[(size_t)tn * 128 + F.lane]; n1 = EID[(size_t)tn * 128 + 64 + F.lane]; b0 = ACT8[(size_t)tn * 32 + (F.lane & 31)]; }
            const float as = AS[t];
            IDX[F.lane] = e0; IDX[F.lane + 64] = e1; if (F.lane < 32) ACT[F.lane] = a0;
            asm volatile("s_waitcnt lgkmcnt(0)" ::: "memory"); __builtin_amdgcn_wave_barrier();
            int acc[16];
#pragma unroll
            for (int j = 0; j < 16; ++j) acc[j] = 0;
#pragma unroll
            for (int b = 0; b < 8; b += 2) {
                u32x4 vd[2][4]; unsigned a4[2];
#pragma unroll
                for (int h = 0; h < 2; ++h) { a4[h] = ACT[4 * (b + h) + g16];
#pragma unroll
                    for (int u = 0; u < 4; ++u) { const int eid = IDX[16 * (b + h) + 4 * g16 + u]; vd[h][u] = *(const u32x4*)(vb + (size_t)eid * 2048); } }
#pragma unroll
                for (int h = 0; h < 2; ++h)
#pragma unroll
                    for (int q = 0; q < 4; ++q) { const unsigned A_ = vd[h][0][q], B_ = vd[h][1][q], C_ = vd[h][2][q], D_ = vd[h][3][q];
                        const unsigned ablo = __builtin_amdgcn_perm(B_, A_, 0x05010400u), abhi = __builtin_amdgcn_perm(B_, A_, 0x07030602u);
                        const unsigned cdlo = __builtin_amdgcn_perm(D_, C_, 0x05010400u), cdhi = __builtin_amdgcn_perm(D_, C_, 0x07030602u);
                        acc[4 * q + 0] = __builtin_amdgcn_sdot4((int)__builtin_amdgcn_perm(cdlo, ablo, 0x05040100u), (int)a4[h], acc[4 * q + 0], false);
                        acc[4 * q + 1] = __builtin_amdgcn_sdot4((int)__builtin_amdgcn_perm(cdlo, ablo, 0x07060302u), (int)a4[h], acc[4 * q + 1], false);
                        acc[4 * q + 2] = __builtin_amdgcn_sdot4((int)__builtin_amdgcn_perm(cdhi, abhi, 0x05040100u), (int)a4[h], acc[4 * q + 2], false);
                        acc[4 * q + 3] = __builtin_amdgcn_sdot4((int)__builtin_amdgcn_perm(cdhi, abhi, 0x07060302u), (int)a4[h], acc[4 * q + 3], false); }
            }
            { const float r0 = rsum4((float)acc[0], (float)acc[4], (float)acc[8], (float)acc[12]) * as, r1 = rsum4((float)acc[1], (float)acc[5], (float)acc[9], (float)acc[13]) * as;
              const float r2 = rsum4((float)acc[2], (float)acc[6], (float)acc[10], (float)acc[14]) * as, r3 = rsum4((float)acc[3], (float)acc[7], (float)acc[11], (float)acc[15]) * as;
              u32x2 w; w.x = pk2(r0, r1); w.y = pk2(r2, r3); *(u32x2*)(OUT + (size_t)t * DM + 256 * s + 16 * c16 + 4 * g16) = w; }
            asm volatile("s_waitcnt lgkmcnt(0)" ::: "memory"); __builtin_amdgcn_wave_barrier();
            e0 = n0; e1 = n1; a0 = b0; t = tn;
        }
    }
}
__device__ __forceinline__ void ph_peer_ln(const Args& A, Frame& F, const int L) {
    const bf16* OUT = (const bf16*)(A.ws + WS_Z); float* X = A.out; bf16* H = (bf16*)(A.ws + WS_HY); const float* MOD = (const float*)(A.ws + WS_MOD);
    const float* lng = (const float*)A.in[21] + (size_t)(L * 2 + 1) * DM; const float* lnb = (const float*)A.in[22] + (size_t)(L * 2 + 1) * DM;
    for (int t = F.gw; t < TOK; t += F.ngw) {
        const int b = t >> 14;
        const float* gate = MOD + (size_t)((L * 2 + 1) * 2 + b) * 6144 + 4096;
        const float* sh = MOD + (size_t)(((L + 1) * 2 + 0) * 2 + b) * 6144; const float* sc = sh + 2048;
        float v[32]; float sum = 0.f;
#pragma unroll
        for (int j = 0; j < 8; ++j) { const int base = (j * 64 + F.lane) * 4;
            const u32x2 ow = *(const u32x2*)(OUT + (size_t)t * DM + base); const f32x4 o0 = {lo2f(ow.x), hi2f(ow.x), lo2f(ow.y), hi2f(ow.y)};
            const f32x4 x0 = *(const f32x4*)(X + (size_t)t * DM + base), g0 = *(const f32x4*)(gate + base);
#pragma unroll
            for (int e = 0; e < 4; ++e) { v[j * 4 + e] = ALPHA * x0[e] + (1.0f + g0[e]) * o0[e]; sum += v[j * 4 + e]; } }
        const float mean = wsum(sum) * (1.0f / DM); float sq = 0.f;
#pragma unroll
        for (int e = 0; e < 32; ++e) { v[e] -= mean; sq += v[e] * v[e]; }
        const float rstd = rsqrtf(wsum(sq) * (1.0f / DM) + 1e-5f);
#pragma unroll
        for (int j = 0; j < 8; ++j) { const int base = (j * 64 + F.lane) * 4;
            const f32x4 lg0 = *(const f32x4*)(lng + base), lb0 = *(const f32x4*)(lnb + base);
            f32x4 o0;
#pragma unroll
            for (int e = 0; e < 4; ++e) o0[e] = v[j * 4 + e] * rstd * lg0[e] + lb0[e];
            *(f32x4*)(X + (size_t)t * DM + base) = o0;
            if (L == 0) { const f32x4 s0 = *(const f32x4*)(sc + base), h0 = *(const f32x4*)(sh + base); const f32x4 q0 = o0 * (1.0f + s0) + h0;
                u32x2 w; w.x = pk2(q0[0], q0[1]); w.y = pk2(q0[2], q0[3]); *(u32x2*)(H + (size_t)t * DM + base) = w; }
        }
    }
}

__device__ __forceinline__ void ph_odd_post(const Args& A, Frame& F) {
    bf16* Z = (bf16*)(A.ws + WS_Z); const int* positions = (const int*)A.in[2]; bf16* KIT = (bf16*)(A.ws + WS_BIG + 256 * MiB); unsigned char* K8 = A.ws + WS_BIG + 264 * MiB; unsigned char* V8 = A.ws + WS_BIG + 280 * MiB;
    const float inv128 = powf(10000.0f, -(float)F.lane / 64.0f); const int i32 = F.lane & 31; const float inv64 = powf(10000.0f, -(float)i32 / 32.0f);
    const int a16 = F.lane & 15, hs4 = F.lane >> 4, a8 = F.lane & 7, hs8 = F.lane >> 3;
    for (int t = F.gw; t < TOK; t += F.ngw) {
        bf16* zr = Z + (size_t)t * OD_NP; const float pos = (float)positions[t];
        const int bb = t >> 14, spos = t & (SEQ - 1);
        float sn, cs; sincosf(pos * inv128, &sn, &cs);
        float c4[4], s4[4];
#pragma unroll
        for (int e = 0; e < 4; ++e) { c4[e] = __shfl(cs, 4 * a16 + e); s4[e] = __shfl(sn, 4 * a16 + e); }
#pragma unroll
        for (int it = 0; it < 5; ++it) { const int hd = it * 4 + hs4; bf16* hp = zr + hd * 128 + 4 * a16;
            const u32x2 a = *(const u32x2*)hp, b = *(const u32x2*)(hp + 64);
            const float t1[4] = {lo2f(a.x), hi2f(a.x), lo2f(a.y), hi2f(a.y)}, t2[4] = {lo2f(b.x), hi2f(b.x), lo2f(b.y), hi2f(b.y)};
            float o1[4], o2[4];
#pragma unroll
            for (int e = 0; e < 4; ++e) { o1[e] = t1[e] * c4[e] - t2[e] * s4[e]; o2[e] = t2[e] * c4[e] + t1[e] * s4[e]; }
            *(u32x2*)hp = (u32x2){pk2(o1[0], o1[1]), pk2(o1[2], o1[3])}; *(u32x2*)(hp + 64) = (u32x2){pk2(o2[0], o2[1]), pk2(o2[2], o2[3])};
            if (it == 4) { unsigned char* k8 = K8 + ((size_t)((bb * 4 + hs4) * SEQ + spos)) * 128 + 4 * a16;
                int w1 = __builtin_amdgcn_cvt_pk_fp8_f32(o1[0] * 16.0f, o1[1] * 16.0f, 0, false); w1 = __builtin_amdgcn_cvt_pk_fp8_f32(o1[2] * 16.0f, o1[3] * 16.0f, w1, true);
                int w2 = __builtin_amdgcn_cvt_pk_fp8_f32(o2[0] * 16.0f, o2[1] * 16.0f, 0, false); w2 = __builtin_amdgcn_cvt_pk_fp8_f32(o2[2] * 16.0f, o2[3] * 16.0f, w2, true);
                *(unsigned*)k8 = (unsigned)w1; *(unsigned*)(k8 + 64) = (unsigned)w2; } }
        {
            const int e0 = F.lane * 8, kvh = e0 >> 7, d0 = e0 & 127;
            const u32x4 vw = *(const u32x4*)(zr + 2560 + e0);
            int w0 = __builtin_amdgcn_cvt_pk_fp8_f32(lo2f(vw.x) * 16.0f, hi2f(vw.x) * 16.0f, 0, false); w0 = __builtin_amdgcn_cvt_pk_fp8_f32(lo2f(vw.y) * 16.0f, hi2f(vw.y) * 16.0f, w0, true);
            int w1 = __builtin_amdgcn_cvt_pk_fp8_f32(lo2f(vw.z) * 16.0f, hi2f(vw.z) * 16.0f, 0, false); w1 = __builtin_amdgcn_cvt_pk_fp8_f32(lo2f(vw.w) * 16.0f, hi2f(vw.w) * 16.0f, w1, true);
            *(u32x2*)(V8 + ((size_t)((bb * 4 + kvh) * SEQ + spos)) * 128 + d0) = (u32x2){(unsigned)w0, (unsigned)w1};
        }
        sincosf(pos * inv64, &sn, &cs);
#pragma unroll
        for (int e = 0; e < 4; ++e) { c4[e] = __shfl(cs, 4 * a8 + e); s4[e] = __shfl(sn, 4 * a8 + e); }
#pragma unroll
        for (int it = 0; it < 3; ++it) { const int hd = it * 8 + hs8; if (hd < 17) { bf16* hp = zr + 3072 + hd * 64 + 4 * a8;
            const u32x2 a = *(const u32x2*)hp, b = *(const u32x2*)(hp + 32);
            const float t1[4] = {lo2f(a.x), hi2f(a.x), lo2f(a.y), hi2f(a.y)}, t2[4] = {lo2f(b.x), hi2f(b.x), lo2f(b.y), hi2f(b.y)};
            float o1[4], o2[4];
#pragma unroll
            for (int e = 0; e < 4; ++e) { o1[e] = t1[e] * c4[e] - t2[e] * s4[e]; o2[e] = t2[e] * c4[e] + t1[e] * s4[e]; }
            const u32x2 w1 = {pk2(o1[0], o1[1]), pk2(o1[2], o1[3])}, w2 = {pk2(o2[0], o2[1]), pk2(o2[2], o2[3])};
            *(u32x2*)hp = w1; *(u32x2*)(hp + 32) = w2;
            if (hd == 16) {
                const int tile = spos >> 5, rr = spos & 31;
                bf16* kt = KIT + ((size_t)(bb * 512 + tile) * 4) * 512;
                const int d1 = 4 * a8, d2 = 32 + 4 * a8;
                *(u32x2*)(kt + ((d1 >> 4) * 64 + rr + 32 * ((d1 >> 3) & 1)) * 8 + (d1 & 7)) = w1;
                *(u32x2*)(kt + ((d2 >> 4) * 64 + rr + 32 * ((d2 >> 3) & 1)) * 8 + (d2 & 7)) = w2;
            } } }
    }
}

template <int CTRL, int RM> __device__ __forceinline__ unsigned dppu(unsigned old, unsigned v) { return (unsigned)__builtin_amdgcn_update_dpp((int)old, (int)v, CTRL, RM, 0xF, false); }
__device__ __forceinline__ void ph_dsa_select(const Args& A, Frame& F, const int mode = 0) {
    const bf16* Z = (const bf16*)(A.ws + WS_Z); unsigned short* SEL = (unsigned short*)(A.ws + WS_LA); int* CNT = (int*)(A.ws + WS_CNT); const bf16* KIT = (const bf16*)(A.ws + WS_BIG + 256 * MiB);
    LAS unsigned short* SC = (LAS unsigned short*)F.lds;
    LAS unsigned* LST = (LAS unsigned*)(F.lds + 131072);
    LAS unsigned* hist = (LAS unsigned*)(F.lds + 131072 + 16384);
    LAS unsigned* hist1 = (LAS unsigned*)(F.lds + 152576);
    LAS unsigned* res = (LAS unsigned*)(F.lds + 131072 + 16384 + 2048);
    LAS int* wtot = (LAS int*)(F.lds + 131072 + 16384 + 2048 + 64);
    const int r = F.lane & 31, hg = F.lane >> 5, tk = (r >> 2) & 1, hh = (r & 3) + 4 * (r >> 3);
    const int grp = F.wave >> 2, ltid = F.tid & 255, lw = F.wave & 3;
    for (int qd = F.bx; qd < TOK / 4; qd += F.G) {
        const int t0 = 4 * qd, b = t0 >> 14, s0 = t0 & (SEQ - 1);
        const int nkeys = s0 + 4, ntiles = (nkeys + 31) >> 5;
        bf16x8 af[2][4]; f32x2 wv[2][8];
#pragma unroll
        for (int a = 0; a < 2; ++a) {
            const bf16* qrow = Z + (size_t)(t0 + 2 * a + tk) * OD_NP + 3072 + hh * 64 + 8 * hg;
#pragma unroll
            for (int s = 0; s < 4; ++s) af[a][s] = *(const bf16x8*)(qrow + 16 * s);
            const bf16* wrow = Z + (size_t)(t0 + 2 * a + hg) * OD_NP + 4160;
            const u32x4 w0 = *(const u32x4*)(wrow), w1 = *(const u32x4*)(wrow + 8);
            const unsigned ww[8] = {w0.x, w0.y, w0.z, w0.w, w1.x, w1.y, w1.z, w1.w};
#pragma unroll
            for (int q = 0; q < 8; ++q) wv[a][q] = (f32x2){lo2f(ww[q]) * 0.03125f, hi2f(ww[q]) * 0.03125f};
        }
        __syncthreads();
        const bf16* kbase = KIT + (size_t)b * 512 * 2048 + F.lane * 8;
        if (mode != 2) {
            bf16x8 bcur[2][4];
#define DSA_LOAD1(dst, q_, tb_) do { const int tile = ((tb_) + (q_) < ntiles) ? ((tb_) + (q_)) : (ntiles - 1); const bf16* krow = kbase + (size_t)tile * 2048; \
                _Pragma("unroll") for (int s_ = 0; s_ < 4; ++s_) dst[q_][s_] = *(const bf16x8*)(krow + 512 * s_); } while (0)
#define DSA_MM(accv, src, q_, a_) do { _Pragma("unroll") for (int e = 0; e < 16; ++e) accv[e] = 0.f; \
                _Pragma("unroll") for (int s_ = 0; s_ < 4; ++s_) accv = __builtin_amdgcn_mfma_f32_32x32x16_bf16(af[a_][s_], src[q_][s_], accv, 0, 0, 0); } while (0)
#define DSA_EPI(accv, tb_, q_, a_) do { f32x2 s2_ = {0.f, 0.f}; _Pragma("unroll") for (int e = 0; e < 8; ++e) { \
                    const float x0_ = accv[2 * e], x1_ = accv[2 * e + 1]; const int r0_ = __builtin_bit_cast(int, x0_), r1_ = __builtin_bit_cast(int, x1_);        \
                    const f32x2 rl_ = {__builtin_bit_cast(float, r0_ > 0 ? r0_ : 0), __builtin_bit_cast(float, r1_ > 0 ? r1_ : 0)}; s2_ = rl_ * wv[a_][e] + s2_; } \
                float sc_ = s2_.x + s2_.y; const int key = ((tb_) + (q_)) * 32 + r; sc_ = fminf(fmaxf(sc_, -7.999f), 7.999f); const unsigned fx = (unsigned)((int)rintf(sc_ * 4096.0f) + (1 << 15)); \
                if ((tb_) + (q_) < ntiles) SC[(2 * (a_) + hg) * 16384 + key] = (unsigned short)((key <= s0 + 2 * (a_) + hg) ? fx : 0u); } while (0)
            int tb = F.wave * 2;
            if (tb < ntiles) {
                DSA_LOAD1(bcur, 0, tb); DSA_LOAD1(bcur, 1, tb);
                for (; tb < ntiles; tb += NWAVES * 2) {
                    f32x16 accA, accB;
                    DSA_MM(accA, bcur, 0, 0); DSA_MM(accB, bcur, 0, 1);
                    DSA_LOAD1(bcur, 0, tb + NWAVES * 2);
                    DSA_EPI(accA, tb, 0, 0); DSA_MM(accA, bcur, 1, 0); DSA_EPI(accB, tb, 0, 1); DSA_MM(accB, bcur, 1, 1);
                    DSA_LOAD1(bcur, 1, tb + NWAVES * 2);
                    DSA_EPI(accA, tb, 1, 0); DSA_EPI(accB, tb, 1, 1);
                }
            }
#undef DSA_LOAD1
#undef DSA_MM
#undef DSA_EPI
        }
        __syncthreads();
        if (mode == 1) continue;
#pragma unroll 1
        for (int rd = 0; rd < 2; ++rd) {
        const int tok = 2 * rd + grp;
        const int n = s0 + tok + 1; unsigned k = (unsigned)(n < 256 ? n : 256); unsigned prefix = 0u;
        const LAS unsigned short* sc = SC + tok * 16384;
        hist[grp * 256 + ltid] = 0u; hist1[grp * 256 + ltid] = 0u;
        unsigned kreg[64];
#pragma unroll
        for (int j = 0; j < 64; ++j) { const int i = ltid + 256 * j; kreg[j] = (i < n) ? (unsigned)sc[i] : 0u; }
        unsigned lmax = 0u;
#pragma unroll
        for (int j = 0; j < 64; ++j) lmax = (kreg[j] > lmax) ? kreg[j] : lmax;
        unsigned wmin = lmax;
        { unsigned x_;
          x_ = dppu<0xB1, 0xF>(wmin, wmin); wmin = x_ < wmin ? x_ : wmin; x_ = dppu<0x4E, 0xF>(wmin, wmin); wmin = x_ < wmin ? x_ : wmin;
          x_ = dppu<0x141, 0xF>(wmin, wmin); wmin = x_ < wmin ? x_ : wmin; x_ = dppu<0x140, 0xF>(wmin, wmin); wmin = x_ < wmin ? x_ : wmin;
          x_ = dppu<0x142, 0xA>(wmin, wmin); wmin = x_ < wmin ? x_ : wmin; x_ = dppu<0x143, 0xC>(wmin, wmin); wmin = x_ < wmin ? x_ : wmin; }
        if (F.lane == 63) wtot[16 + F.wave] = (int)wmin;
        __syncthreads();
        unsigned lbound = 0xFFFFFFFFu;
#pragma unroll
        for (int w = 0; w < 4; ++w) { const unsigned x = (unsigned)wtot[16 + grp * 4 + w]; lbound = x < lbound ? x : lbound; }
        LAS unsigned* seg = LST + (grp * 4 + lw) * 512; int ccnt = 0;
        {
#pragma unroll
            for (int j = 0; j < 64; ++j) { if (256 * j < n) { const bool c = ((ltid + 256 * j) < n) && (kreg[j] >= lbound); const unsigned long long m = __ballot(c);
                const int pos = ccnt + (int)__builtin_amdgcn_mbcnt_hi((unsigned)(m >> 32), __builtin_amdgcn_mbcnt_lo((unsigned)m, 0u));
                if (c && pos < 512) seg[pos] = (kreg[j] << 16) | (unsigned)(ltid + 256 * j); ccnt += __popcll(m); } }
        }
        const bool fast = ccnt <= 512;
        asm volatile("s_waitcnt lgkmcnt(0)" ::: "memory"); __builtin_amdgcn_wave_barrier();
#pragma unroll 1
        for (int pass = 0; pass < 2; ++pass) {
            const int shift = 8 - 8 * pass;
            LAS unsigned* hs = (pass == 0 ? hist : hist1) + grp * 256;
            if (fast) {
#pragma unroll
                for (int i = 0; i < 8; ++i) { if (64 * i < ccnt) { const int c_ = F.lane + 64 * i; const bool valid = c_ < ccnt; const unsigned kv = valid ? (seg[c_] >> 16) : 0u;
                    const bool match = (pass == 0) ? true : ((kv >> 8) == prefix);
                    if (valid && match) (void)__hip_atomic_fetch_add(&hs[(kv >> shift) & 255u], 1u, __ATOMIC_RELAXED, __HIP_MEMORY_SCOPE_WORKGROUP); } }
            } else {
#pragma unroll
                for (int j = 0; j < 64; ++j) { if (256 * j < n) { const unsigned kv = kreg[j]; const bool valid = ((ltid + 256 * j) < n) && (kv >= lbound);
                    const bool match = (pass == 0) ? true : ((kv >> 8) == prefix);
                    if (valid && match) (void)__hip_atomic_fetch_add(&hs[(kv >> shift) & 255u], 1u, __ATOMIC_RELAXED, __HIP_MEMORY_SCOPE_WORKGROUP); } }
            }
            __syncthreads();
            if (lw == 0) {
                const unsigned c0 = hs[4 * F.lane], c1 = hs[4 * F.lane + 1], c2 = hs[4 * F.lane + 2], c3 = hs[4 * F.lane + 3];
                const unsigned tot = c0 + c1 + c2 + c3; unsigned pre = tot;
                pre += dppu<0x111, 0xF>(0u, pre); pre += dppu<0x112, 0xF>(0u, pre); pre += dppu<0x114, 0xF>(0u, pre); pre += dppu<0x118, 0xF>(0u, pre);
                pre += dppu<0x142, 0xA>(0u, pre); pre += dppu<0x143, 0xC>(0u, pre);
                const unsigned total = (unsigned)__builtin_amdgcn_readlane((int)pre, 63); const unsigned suf = total - pre + tot;
                unsigned above = suf - tot;
                if (above < k && k <= suf) {
                    int bin;
                    if (above + c3 >= k) { bin = 3; } else { above += c3; if (above + c2 >= k) { bin = 2; } else { above += c2; if (above + c1 >= k) { bin = 1; } else { above += c1; bin = 0; } } }
                    res[grp * 2 + 0] = (unsigned)(4 * F.lane + bin); res[grp * 2 + 1] = k - above;
                }
            }
            __syncthreads();
            prefix = (prefix << 8) | res[grp * 2 + 0]; k = res[grp * 2 + 1];
        }
        const unsigned tau = prefix; const int krem = (int)k;
#define MBCNT(m_) ((int)__builtin_amdgcn_mbcnt_hi((unsigned)((m_) >> 32), __builtin_amdgcn_mbcnt_lo((unsigned)(m_), 0u)))
        int cgW = 0, ceW = 0;
        if (fast) {
#pragma unroll
            for (int i = 0; i < 8; ++i) { if (64 * i < ccnt) { const int c_ = F.lane + 64 * i; const bool valid = c_ < ccnt; const unsigned kv = valid ? (seg[c_] >> 16) : 0u;
                cgW += __popcll(__ballot(valid && kv > tau)); ceW += __popcll(__ballot(valid && kv == tau)); } }
        } else {
#pragma unroll
            for (int j = 0; j < 64; ++j) { if (256 * j < n) { const bool valid = (ltid + 256 * j) < n; const unsigned kv = kreg[j];
                cgW += __popcll(__ballot(valid && kv > tau)); ceW += __popcll(__ballot(valid && kv == tau)); } }
        }
        if (F.lane == 0) { wtot[F.wave * 2] = cgW; wtot[F.wave * 2 + 1] = ceW; }
        __syncthreads();
        int og = 0, oe = 0, totg = 0;
        for (int w = 0; w < 4; ++w) { const int a = wtot[(grp * 4 + w) * 2], e = wtot[(grp * 4 + w) * 2 + 1]; if (w < lw) { og += a; oe += e; } totg += a; }
        LAS unsigned short* sel = (LAS unsigned short*)(F.lds + 151552) + grp * 256;
        if (fast) {
#pragma unroll
            for (int i = 0; i < 8; ++i) { if (64 * i < ccnt) { const int c_ = F.lane + 64 * i; const bool valid = c_ < ccnt; const unsigned pk = valid ? seg[c_] : 0u; const unsigned kv = pk >> 16;
                const bool gt = valid && kv > tau, eq = valid && kv == tau; const unsigned long long mg = __ballot(gt), me = __ballot(eq);
                const int pg = og + MBCNT(mg), pe = oe + MBCNT(me);
                if (gt) sel[pg] = (unsigned short)(pk & 0xffffu); else if (eq && pe < krem) sel[totg + pe] = (unsigned short)(pk & 0xffffu);
                og += __popcll(mg); oe += __popcll(me); } }
        } else {
#pragma unroll
            for (int j = 0; j < 64; ++j) { if (256 * j < n) { const int i = ltid + 256 * j; const bool valid = i < n; const unsigned kv = kreg[j];
                const bool gt = valid && kv > tau, eq = valid && kv == tau; const unsigned long long mg = __ballot(gt), me = __ballot(eq);
                const int pg = og + MBCNT(mg), pe = oe + MBCNT(me);
                if (gt) sel[pg] = (unsigned short)i; else if (eq && pe < krem) sel[totg + pe] = (unsigned short)i;
                og += __popcll(mg); oe += __popcll(me); } }
        }
#undef MBCNT
        if (ltid == 0) CNT[t0 + tok] = (n < 256 ? n : 256);
        __syncthreads();
        if (ltid < 128) { int lt2 = ltid; asm volatile("" : "+v"(lt2));
            ((unsigned*)SEL)[(size_t)(t0 + 2 * rd + grp) * 128 + lt2] = ((const LAS unsigned*)(F.lds + 151552))[grp * 128 + lt2]; }
        }
    }
}

__device__ __forceinline__ float sum8_dpp(float v) { v += dppf<0xB1, 0xF>(v); v += dppf<0x4E, 0xF>(v); v += dppf<0x141, 0xF>(v); return v; }
__device__ __forceinline__ void ph_dsa_attn(const Args& A, Frame& F, const XInfo X) {
    const bf16* Z = (const bf16*)(A.ws + WS_Z); const unsigned short* SEL = (const unsigned short*)(A.ws + WS_LA); const int* CNT = (const int*)(A.ws + WS_CNT);
    const unsigned char* K8 = A.ws + WS_BIG + 264 * MiB; const unsigned char* V8 = A.ws + WS_BIG + 280 * MiB; bf16* Y = (bf16*)(A.ws + WS_HY);
    LAS int* IDX = (LAS int*)(F.lds + F.wave * 5120);
    LAS float* SCR = (LAS float*)(F.lds + F.wave * 5120 + 1024);
    const int g8 = F.lane >> 3, c8 = F.lane & 7;
    for (int sl = X.rx; sl < 8; sl += X.nx) {
        const int b = sl >> 2, kvh = sl & 3;
        const unsigned char* kb = K8 + (size_t)sl * SEQ * 128 + 16 * c8; const unsigned char* vb = V8 + (size_t)sl * SEQ * 128 + 16 * c8;
        for (int sq = X.rank * NWAVES + F.wave; sq < SEQ; sq += X.nloc * NWAVES) {
            const int t = b * SEQ + sq; const int n = CNT[t];
            const int l15 = F.lane & 15, g4 = F.lane >> 4;
            long bq[4];
#pragma unroll
            for (int c = 0; c < 2; ++c) {
                float f[16];
#pragma unroll
                for (int e = 0; e < 16; ++e) f[e] = 0.f;
                if (l15 < 4) { const bf16* qp = Z + (size_t)t * OD_NP + (kvh * 4 + l15) * 128 + 64 * c + 16 * g4; const u32x4 a = *(const u32x4*)qp, b2 = *(const u32x4*)(qp + 8);
                    const unsigned aw[8] = {a.x, a.y, a.z, a.w, b2.x, b2.y, b2.z, b2.w};
#pragma unroll
                    for (int q = 0; q < 8; ++q) { f[2 * q] = lo2f(aw[q]) * 16.0f; f[2 * q + 1] = hi2f(aw[q]) * 16.0f; } }
#pragma unroll
                for (int hf = 0; hf < 2; ++hf) {
                    int lo = __builtin_amdgcn_cvt_pk_fp8_f32(f[8 * hf + 0], f[8 * hf + 1], 0, false); lo = __builtin_amdgcn_cvt_pk_fp8_f32(f[8 * hf + 2], f[8 * hf + 3], lo, true);
                    int hi = __builtin_amdgcn_cvt_pk_fp8_f32(f[8 * hf + 4], f[8 * hf + 5], 0, false); hi = __builtin_amdgcn_cvt_pk_fp8_f32(f[8 * hf + 6], f[8 * hf + 7], hi, true);
                    bq[2 * c + hf] = (long)(((unsigned long long)(unsigned)hi << 32) | (unsigned long long)(unsigned)lo); }
            }
#pragma unroll
            for (int m = 0; m < 4; ++m) { const int jj = F.lane + 64 * m; IDX[jj] = (jj < n) ? (int)SEL[(size_t)t * 256 + jj] : 0; }
            asm volatile("s_waitcnt lgkmcnt(0)" ::: "memory"); __builtin_amdgcn_wave_barrier();
            {
                const unsigned char* kq = K8 + (size_t)sl * SEQ * 128 + 16 * g4;
#pragma unroll 1
                for (int tl0 = 0; tl0 < 16; tl0 += 4) {
                    u32x4 k0[4], k1[4];
#pragma unroll
                    for (int u = 0; u < 4; ++u) { const int id = IDX[(tl0 + u) * 16 + l15]; const unsigned char* kr = kq + (size_t)id * 128; k0[u] = *(const u32x4*)kr; k1[u] = *(const u32x4*)(kr + 64); }
#pragma unroll
                    for (int u = 0; u < 4; ++u) {
                        f32x4 acc = {0.f, 0.f, 0.f, 0.f};
                        acc = __builtin_amdgcn_mfma_f32_16x16x32_fp8_fp8((long)(((unsigned long long)k0[u].y << 32) | k0[u].x), bq[0], acc, 0, 0, 0);
                        acc = __builtin_amdgcn_mfma_f32_16x16x32_fp8_fp8((long)(((unsigned long long)k0[u].w << 32) | k0[u].z), bq[1], acc, 0, 0, 0);
                        acc = __builtin_amdgcn_mfma_f32_16x16x32_fp8_fp8((long)(((unsigned long long)k1[u].y << 32) | k1[u].x), bq[2], acc, 0, 0, 0);
                        acc = __builtin_amdgcn_mfma_f32_16x16x32_fp8_fp8((long)(((unsigned long long)k1[u].w << 32) | k1[u].z), bq[3], acc, 0, 0, 0);
                        if (l15 < 4) {
#pragma unroll
                            for (int rg = 0; rg < 4; ++rg) SCR[((tl0 + u) * 16 + 4 * g4 + rg) * 4 + l15] = acc[rg] * 3.452669831e-4f; }
                    }
                }
            }
            asm volatile("s_waitcnt lgkmcnt(0)" ::: "memory"); __builtin_amdgcn_wave_barrier();
            {
                f32x4 sv[4];
#pragma unroll
                for (int m = 0; m < 4; ++m) sv[m] = *(const LAS f32x4*)(SCR + (F.lane + 64 * m) * 4);
#pragma unroll
                for (int g = 0; g < 4; ++g) {
                    float mx = -INFINITY;
#pragma unroll
                    for (int m = 0; m < 4; ++m) { const bool val = (F.lane + 64 * m) < n; sv[m][g] = val ? sv[m][g] : -INFINITY; mx = fmaxf(mx, sv[m][g]); }
                    mx = wmax(mx); float sm = 0.f;
#pragma unroll
                    for (int m = 0; m < 4; ++m) { const bool val = (F.lane + 64 * m) < n; sv[m][g] = val ? expf(sv[m][g] - mx) : 0.f; sm += sv[m][g]; }
                    const float rden = 0.0625f / wsum(sm);
#pragma unroll
                    for (int m = 0; m < 4; ++m) sv[m][g] *= rden;
                }
#pragma unroll
                for (int m = 0; m < 4; ++m) *(LAS f32x4*)(SCR + (F.lane + 64 * m) * 4) = sv[m];
            }
            asm volatile("s_waitcnt lgkmcnt(0)" ::: "memory"); __builtin_amdgcn_wave_barrier();
            f32x2 o[4][8];
#pragma unroll
            for (int g = 0; g < 4; ++g)
#pragma unroll
                for (int q = 0; q < 8; ++q) o[g][q] = (f32x2){0.f, 0.f};
#pragma unroll 1
            for (int i0 = 0; i0 < 32; i0 += 4) {
                u32x4 vd[4]; f32x4 pv[4];
#pragma unroll
                for (int u = 0; u < 4; ++u) { const int id = IDX[8 * (i0 + u) + g8]; vd[u] = *(const u32x4*)(vb + (size_t)id * 128); pv[u] = *(const LAS f32x4*)(SCR + (8 * (i0 + u) + g8) * 4); }
#pragma unroll
                for (int u = 0; u < 4; ++u) {
                    const unsigned w[4] = {vd[u].x, vd[u].y, vd[u].z, vd[u].w}; f32x2 v2[8];
#pragma unroll
                    for (int q = 0; q < 4; ++q) { v2[2 * q] = __builtin_amdgcn_cvt_pk_f32_fp8((int)w[q], false); v2[2 * q + 1] = __builtin_amdgcn_cvt_pk_f32_fp8((int)w[q], true); }
#pragma unroll
                    for (int g = 0; g < 4; ++g) { const f32x2 pg = {pv[u][g], pv[u][g]};
#pragma unroll
                        for (int q = 0; q < 8; ++q) o[g][q] = pg * v2[q] + o[g][q]; }
                }
            }
            f32x2 mine[8];
#pragma unroll
            for (int q = 0; q < 8; ++q) {
                float x[4][2];
#pragma unroll
                for (int g = 0; g < 4; ++g) { float a0 = o[g][q].x, a1 = o[g][q].y;
                    a0 += dppf<0x128, 0xF>(a0); a1 += dppf<0x128, 0xF>(a1);
                    x[g][0] = a0; x[g][1] = a1; }
                mine[q].x = rsum4(x[0][0], x[1][0], x[2][0], x[3][0]); mine[q].y = rsum4(x[0][1], x[1][1], x[2][1], x[3][1]);
            }
            if ((F.lane & 8) == 0) { u32x4 w0, w1; const int hrow = F.lane >> 4;
                w0.x = pk2(mine[0].x, mine[0].y); w0.y = pk2(mine[1].x, mine[1].y); w0.z = pk2(mine[2].x, mine[2].y); w0.w = pk2(mine[3].x, mine[3].y);
                w1.x = pk2(mine[4].x, mine[4].y); w1.y = pk2(mine[5].x, mine[5].y); w1.z = pk2(mine[6].x, mine[6].y); w1.w = pk2(mine[7].x, mine[7].y);
                bf16* yp = Y + (size_t)t * DM + (kvh * 4 + hrow) * 128 + 16 * c8; *(u32x4*)yp = w0; *(u32x4*)(yp + 8) = w1; }
            asm volatile("s_waitcnt lgkmcnt(0)" ::: "memory"); __builtin_amdgcn_wave_barrier();
        }
    }
}

__global__ void __launch_bounds__(NTHREADS, 2) mk_fwd(Args args) {
    extern __shared__ __attribute__((aligned(16))) unsigned char lds[];
    Frame F;
    F.lds = (LAS unsigned char*)lds;
    volatile LAS unsigned* MISC = (volatile LAS unsigned*)(F.lds + MISC_OFF);
    F.tid = threadIdx.x; F.lane = F.tid & 63; F.wave = __builtin_amdgcn_readfirstlane(F.tid >> 6);
    F.bx = blockIdx.x; F.G = gridDim.x; F.gw = F.bx * NWAVES + F.wave; F.ngw = F.G * NWAVES;
    if (F.tid < 64) MISC[F.tid] = 0u;
    __syncthreads();
    unsigned char* ws = args.ws;
    XcdBarrier bar = xcd_barrier_post((unsigned*)(ws + WS_CTL) + CW_BAR, MISC + 8);
    if (F.tid == 0) { MISC[16] = xb_add((unsigned*)(ws + WS_CTL) + CW_XRANK + 64 * bar.x, 1u); }
    const int lo = args.ph_lo, hi = args.ph_hi;
#define IN(k) (lo <= (k) && (k) < hi)
#define SEAM(k) do { if (IN((k) + 1)) xcd_barrier(bar); } while (0)
#define GEMM_BF16(Aptr, Bptr, Nn, Kk, Optr, ldo) do { pg8::Gemm g{(const pg8::bf16_t*)(Aptr), (const pg8::bf16_t*)(Bptr), TOK, (Nn), (Kk)}; pg8::StaticOrder S; S.init(TOK, (Nn), F.G, F.bx); \
        pg8::EpiBf16<0> E{(pg8::bf16_t*)(Optr), (ldo), nullptr, 0, 0}; pg8::gemm_phase<pg8::EpiBf16<0>, pg8::StaticOrder, false>(F.lds, g, S, E, nullptr); } while (0)

#ifndef PROBE_MASK
#define PROBE_MASK 0
#endif
#define PRB(bit, stmt) do { if (PROBE_MASK & (1 << (bit))) { stmt; xcd_barrier(bar); } } while (0)
    if (IN(0)) { PRB(14, ph_prologue(args, F)); ph_prologue(args, F); SEAM(0); }
    if (IN(1)) { ph_mod_x(args, F); SEAM(1); }
    if (F.tid == 0) {
        unsigned* cb = (unsigned*)(ws + WS_CTL) + CW_BAR; unsigned nloc = 1u, rx = 0u, nx = 0u;
        for (unsigned j = 0; j < 16; ++j) { const unsigned c = xb_ld(&cb[XB_XCNT(j)]); if (c > 0u) { if (j < bar.x) ++rx; ++nx; } if (j == bar.x) nloc = c > 0u ? c : 1u; }
        if (nx == 0u) nx = 1u;
        MISC[17] = nloc; MISC[18] = rx; MISC[19] = nx; }
    __syncthreads();
    const XInfo XI = xcc_info(MISC);
    if (IN(2)) { PRB(8, GEMM_BF16(ws + WS_HY, ws + WS_WINE, EV_NP, 2048, ws + WS_Z, EV_NP)); GEMM_BF16(ws + WS_HY, ws + WS_WINE, EV_NP, 2048, ws + WS_Z, EV_NP); SEAM(2); }
    if (IN(3)) { ph_even_post(args, F); SEAM(3); }
    if (IN(4)) { pg8::Gemm g{(const pg8::bf16_t*)(ws + WS_LA), (const pg8::bf16_t*)(ws + WS_WL), TOK, 3072, 512}; pg8::StaticOrder S; S.init(TOK, 3072, F.G, F.bx);
                 EpiLora E{(pg8::bf16_t*)(ws + WS_Z) + 1280, EV_NP, (const float*)args.in[7], (const float*)args.in[9]};
                 pg8::gemm_phase<EpiLora, pg8::StaticOrder, false>(F.lds, g, S, E, nullptr); SEAM(4); }
    if (IN(5)) { PRB(9, ph_scan_prep(args, F)); ph_scan_prep(args, F); xcd_barrier(bar); }
    if (IN(7)) { PRB(15, scan_mfma_rows(args, F)); ph_swa_mfma(args, F); scan_mfma_rows(args, F); SEAM(7); }
    if (IN(8)) { PRB(10, ph_rwkv_finish(args, F)); ph_rwkv_finish(args, F); SEAM(8); }
    if (IN(9)) { GEMM_BF16(ws + WS_HY, ws + WS_WOUTE, 2048, 2048, ws + WS_Z, 2048); SEAM(9); }
    if (IN(10)) { PRB(11, ph_ln_mixer(args, F, 0)); ph_ln_mixer(args, F, 0); SEAM(10); }
    if (IN(11)) { GEMM_BF16(ws + WS_HY, ws + WS_WQ0, 2048, 2048, ws + WS_Z, 2048); SEAM(11); }
    if (IN(12)) { PRB(4, ph_peer_select(args, F, 0)); ph_peer_select(args, F, 0); SEAM(12); }
    if (IN(13)) { PRB(12, ph_peer_u(args, F, XI)); ph_peer_u(args, F, XI); xcd_barrier(bar); ph_peer_act(args, F); xcd_barrier(bar); PRB(13, ph_peer_v(args, F, XI)); ph_peer_v(args, F, XI); xcd_barrier(bar); ph_peer_ln(args, F, 0); SEAM(13); }
    if (IN(14)) { GEMM_BF16(ws + WS_HY, ws + WS_WINO, OD_NP, 2048, ws + WS_Z, OD_NP); SEAM(14); }
    if (IN(15)) { ph_odd_post(args, F); SEAM(15); }
    if (IN(16)) { PRB(2, ph_dsa_select(args, F, 1)); PRB(6, ph_dsa_select(args, F, 2)); PRB(7, ph_dsa_select(args, F, 0)); ph_dsa_select(args, F); SEAM(16); }
    if (IN(17)) { ph_dsa_attn(args, F, XI); SEAM(17); }
    if (IN(18)) { GEMM_BF16(ws + WS_HY, ws + WS_WOUTO, 2048, 2048, ws + WS_Z, 2048); SEAM(18); }
    if (IN(19)) { ph_ln_mixer(args, F, 1); SEAM(19); }
    if (IN(20)) { GEMM_BF16(ws + WS_HY, ws + WS_WQ1, 2048, 2048, ws + WS_Z, 2048); SEAM(20); }
    if (IN(21)) { PRB(4, ph_peer_select(args, F, 1)); ph_peer_select(args, F, 1); SEAM(21); }
    if (IN(22)) { ph_peer_u(args, F, XI); xcd_barrier(bar); ph_peer_act(args, F); xcd_barrier(bar); ph_peer_v(args, F, XI); xcd_barrier(bar); ph_peer_ln(args, F, 1); }
#undef IN
#undef SEAM
#undef GEMM_BF16
}

#ifndef MK_SPLIT
#define MK_SPLIT 0
#endif
extern "C" void kernel_launch(void* const* d_in, const int* in_sizes, int n_in, void* d_out, int out_size, void* d_ws, size_t ws_size, hipStream_t stream) {
    static int grid = 0;
    if (grid == 0) {
        int dev = 0, cus = 0;
        if (n_in != 27 || out_size != TOK * DM || ws_size < WS_END) { fprintf(stderr, "kernel_launch: unexpected shapes (n_in %d out %d ws %zu)\n", n_in, out_size, ws_size); grid = -1; return; }
        if (hipGetDevice(&dev) != hipSuccess || hipDeviceGetAttribute(&cus, hipDeviceAttributeMultiprocessorCount, dev) != hipSuccess) { grid = -1; return; }
        if (hipFuncSetAttribute((const void*)mk_fwd, hipFuncAttributeMaxDynamicSharedMemorySize, LDS_BYTES) != hipSuccess) { fprintf(stderr, "kernel_launch: hipFuncSetAttribute failed\n"); grid = -1; return; }
        int per_cu = 0;
        if (hipOccupancyMaxActiveBlocksPerMultiprocessor(&per_cu, (const void*)mk_fwd, NTHREADS, LDS_BYTES) != hipSuccess || per_cu < 1) fprintf(stderr, "kernel_launch: occupancy query says %d\n", per_cu);
        (void)hipGetLastError();
        grid = cus;
    }
    if (grid < 0) return;
    (void)hipMemsetAsync((char*)d_ws + WS_CTL, 0, CTL_ZERO_BYTES, stream);
    Args a{};
    for (int i = 0; i < 27; ++i) a.in[i] = d_in[i];
    a.out = (float*)d_out; a.ws = (unsigned char*)d_ws;
#if MK_SPLIT
    for (int p = 0; p < 23; ++p) { a.ph_lo = p; a.ph_hi = p + 1; hipLaunchKernelGGL(mk_fwd, dim3(grid), dim3(NTHREADS), LDS_BYTES, stream, a); }
#else
    a.ph_lo = 0; a.ph_hi = 23;
    hipLaunchKernelGGL(mk_fwd, dim3(grid), dim3(NTHREADS), LDS_BYTES, stream, a);
#endif
}
```

```cpp
#include <hip/hip_runtime.h>
#include <cstdio>
#include <cstdint>
namespace pg8 {
#define PG8_LAS __attribute__((address_space(3)))
typedef unsigned short bf16_t;
typedef short bf16x8 __attribute__((ext_vector_type(8)));
typedef float f32x4 __attribute__((ext_vector_type(4)));
typedef unsigned u32x4 __attribute__((ext_vector_type(4)));
constexpr int BM = 256, BK = 64, HALF = 128, HTB = HALF * BK * 2  , STAGE_BYTES = 8 * HTB, NXCD = 8, WGM = 8;

__host__ __device__ __forceinline__ int lds_byte(int r, int c) { const int st = (r >> 4) * 2 + (c >> 5), rr = r & 15, cc = c & 31, ob = rr * 64 + cc * 2; return st * 1024 + (ob ^ (((ob >> 9) & 1) << 5)); }
__host__ __device__ __forceinline__ void stage_rc(int b, int& R, int& C) { const int st = b / 1024, sb = b % 1024, swz = sb ^ (((sb >> 9) & 1) << 5); R = (st >> 1) * 16 + swz / 64; C = (st & 1) * 32 + (swz % 64) / 2; }
__host__ __device__ __forceinline__ int perm32(int rho) { const int n = rho >> 4, i = rho & 15; return 8 * (i >> 2) + 4 * n + (i & 3); }

struct Unit { int pm, pn; };
struct Gemm { const bf16_t* A; const bf16_t* Bt; int M, N, K; };

struct StaticOrder {
    int nM, nN, nwg, G, c;
    __host__ __device__ void init(int M, int N, int G_, int c_) { nM = M / BM; nN = N / BM; nwg = nM * nN; G = G_; c = c_; }
    __host__ __device__ bool next(int i, Unit& u) const {
        const long L = (long)i * G + c; if (L >= nwg) return false;
        int wgid = (int)L; { const int q = nwg / NXCD, r = nwg % NXCD, xcd = wgid % NXCD, off = wgid / NXCD; wgid = (xcd < r ? xcd * (q + 1) : r * (q + 1) + (xcd - r) * q) + off; }
        const int nig = WGM * nN, gid = wgid / nig, fm = gid * WGM, gsz = (nM - fm) < WGM ? (nM - fm) : WGM;
        u.pm = fm + ((wgid % nig) % gsz); u.pn = (wgid % nig) / gsz; return true;
    }
    __device__ __forceinline__ void a_ready(const Unit&) const {}
    __device__ __forceinline__ void done(const Unit&) const {}
};
struct CountedOrder : StaticOrder {
    const unsigned* ready; unsigned need; unsigned* tmo;
    __device__ __forceinline__ void a_ready(const Unit& u) const {
        if (threadIdx.x < 64) {
            const unsigned long long t0 = __builtin_amdgcn_s_memrealtime(); unsigned polls = 0;
            while ((unsigned)__builtin_amdgcn_readfirstlane(__hip_atomic_load(ready + 64 * u.pm, __ATOMIC_RELAXED, __HIP_MEMORY_SCOPE_AGENT)) < need) {
                if ((++polls & 255u) == 0u && __builtin_amdgcn_readfirstlane(__hip_atomic_load(tmo, __ATOMIC_RELAXED, __HIP_MEMORY_SCOPE_AGENT)) != 0u) break;
                if (__builtin_amdgcn_s_memrealtime() - t0 > 2000000ull) {
                    if (threadIdx.x == 0) { unsigned expect = 0u; __hip_atomic_compare_exchange_strong(tmo + 1, &expect, 0x600u | (unsigned)(u.pm & 0xff), __ATOMIC_RELAXED, __ATOMIC_RELAXED, __HIP_MEMORY_SCOPE_AGENT); __hip_atomic_store(tmo, 1u, __ATOMIC_RELAXED, __HIP_MEMORY_SCOPE_AGENT); }
                    break; }
                __builtin_amdgcn_s_sleep(2); }
            __builtin_amdgcn_fence(__ATOMIC_ACQUIRE, "agent");
            asm volatile("s_waitcnt vmcnt(0)" ::: "memory");
        }
#if !defined(BROKEN_HOOK_NO_BARRIER)
        asm volatile("" ::: "memory"); __builtin_amdgcn_s_barrier(); asm volatile("" ::: "memory");
#endif
    }
};

__device__ __forceinline__ unsigned cvt_pk_bf16(float lo, float hi) { unsigned r; asm volatile("v_cvt_pk_bf16_f32 %0, %1, %2" : "=v"(r) : "v"(lo), "v"(hi)); return r; }
typedef float f32x2 __attribute__((ext_vector_type(2)));
__device__ __forceinline__ f32x2 gelu_pk(f32x2 v) {
    const f32x2 av = __builtin_elementwise_abs(v), d = av * 0.2316418882f + 1.0f;
    f32x2 t; t.x = __builtin_amdgcn_rcpf(d.x); t.y = __builtin_amdgcn_rcpf(d.y);
    f32x2 q = t * 0.5307027145f + (-0.7265760135f); q = q * t + 0.7107068705f; q = q * t + (-0.142248368f); q = q * t + 0.127414796f; q = q * t;
    const f32x2 s = (v * v) * (-0.72134752044f);
    f32x2 e; e.x = __builtin_amdgcn_exp2f(s.x); e.y = __builtin_amdgcn_exp2f(s.y);
    const f32x2 m = v * (q * e), r = v - m;
    f32x2 o; o.x = v.x < 0.f ? m.x : r.x; o.y = v.y < 0.f ? m.y : r.y; return o;
}

struct EpiF32 {
    static constexpr bool PERM = false, AFTER_DRAIN = false;
    float* C; int ldc; const float* bias;
    __device__ __forceinline__ void operator()(const f32x4 (&acc)[2][2][4][2], const Unit& u, int wr, int wc, int fr, int fq) const {
        const int row0 = u.pm * BM + wr * 64 + fr, col0 = u.pn * BM + wc * 32 + 4 * fq;
        f32x4 bv[2][2];
#pragma unroll
        for (int bj = 0; bj < 2; ++bj)
#pragma unroll
            for (int n = 0; n < 2; ++n) bv[bj][n] = bias ? *(const f32x4*)(bias + col0 + bj * HALF + n * 16) : (f32x4){0.f, 0.f, 0.f, 0.f};
#pragma unroll
        for (int ai = 0; ai < 2; ++ai)
#pragma unroll
            for (int m = 0; m < 4; ++m) { float* rowp = C + (size_t)(row0 + ai * HALF + m * 16) * ldc + col0;
#pragma unroll
                for (int bj = 0; bj < 2; ++bj)
#pragma unroll
                    for (int n = 0; n < 2; ++n) *(f32x4*)(rowp + bj * HALF + n * 16) = acc[ai][bj][m][n] + bv[bj][n]; }
    }
};
template <int ACT  > struct EpiBf16 {
    static constexpr bool PERM = true, AFTER_DRAIN = false;
    bf16_t* O; int ldc; const float* bias; int split_cols; size_t split_stride;
    __device__ __forceinline__ void operator()(const f32x4 (&acc)[2][2][4][2], const Unit& u, int wr, int wc, int fr, int fq) const {
        const int row0 = u.pm * BM + wr * 64 + fr; int colt = u.pn * BM; bf16_t* base = O;
        if (split_cols) { const int t = colt / split_cols; base += (size_t)t * split_stride; colt -= t * split_cols; }
        const int col0 = colt + wc * 32 + 8 * fq, bcol0 = u.pn * BM + wc * 32 + 8 * fq;
        f32x4 bv[2][2];
#pragma unroll
        for (int bj = 0; bj < 2; ++bj)
#pragma unroll
            for (int n = 0; n < 2; ++n) bv[bj][n] = bias ? *(const f32x4*)(bias + bcol0 + bj * HALF + 4 * n) : (f32x4){0.f, 0.f, 0.f, 0.f};
#pragma unroll
        for (int ai = 0; ai < 2; ++ai)
#pragma unroll
            for (int m = 0; m < 4; ++m) { bf16_t* rowp = base + (size_t)(row0 + ai * HALF + m * 16) * ldc + col0;
#pragma unroll
                for (int bj = 0; bj < 2; ++bj) { f32x4 v0 = acc[ai][bj][m][0] + bv[bj][0], v1 = acc[ai][bj][m][1] + bv[bj][1];
                    if (ACT == 1) { f32x2 a = gelu_pk((f32x2){v0[0], v0[1]}), b = gelu_pk((f32x2){v0[2], v0[3]}), c = gelu_pk((f32x2){v1[0], v1[1]}), d = gelu_pk((f32x2){v1[2], v1[3]});
                        v0 = (f32x4){a.x, a.y, b.x, b.y}; v1 = (f32x4){c.x, c.y, d.x, d.y}; }
                    if (ACT == 2) {
#pragma unroll
                        for (int j = 0; j < 4; ++j) { v0[j] = 0.5f * v0[j] * (1.0f + erff(v0[j] * 0.70710678f)); v1[j] = 0.5f * v1[j] * (1.0f + erff(v1[j] * 0.70710678f)); } }
                    u32x4 w; w.x = cvt_pk_bf16(v0[0], v0[1]); w.y = cvt_pk_bf16(v0[2], v0[3]); w.z = cvt_pk_bf16(v1[0], v1[1]); w.w = cvt_pk_bf16(v1[2], v1[3]);
                    *(u32x4*)(rowp + bj * HALF) = w; } }
    }
};

struct PanelStats {
    unsigned* xbuf;
    unsigned* cnt;
    unsigned* tmo;
    int ntn; float eps;
    unsigned code;
    __device__ __forceinline__ bool run(const f32x4 (&v)[2][2][4][2], const Unit& u, int wr, int wc, int fr, int fq, PG8_LAS unsigned char* lds, int wid, int lane) const {
        typedef float f32x2v __attribute__((ext_vector_type(2)));
        PG8_LAS f32x2v* P = (PG8_LAS f32x2v*)lds;
        PG8_LAS f32x2v* S = (PG8_LAS f32x2v*)(lds + 8192);
        PG8_LAS unsigned* flag = (PG8_LAS unsigned*)(lds + 8192 + 2048);
#pragma unroll
        for (int ai = 0; ai < 2; ++ai)
#pragma unroll
            for (int m = 0; m < 4; ++m) {
                float s = 0.f;
#pragma unroll
                for (int bj = 0; bj < 2; ++bj)
#pragma unroll
                    for (int n = 0; n < 2; ++n) { const f32x4 x = v[ai][bj][m][n]; s += (x[0] + x[1]) + (x[2] + x[3]); }
                s += __shfl_xor(s, 16); s += __shfl_xor(s, 32);
                const float mw = s * (1.0f / 64.0f); float q = 0.f;
#pragma unroll
                for (int bj = 0; bj < 2; ++bj)
#pragma unroll
                    for (int n = 0; n < 2; ++n) { const f32x4 d = v[ai][bj][m][n] - mw; q += (d[0] * d[0] + d[1] * d[1]) + (d[2] * d[2] + d[3] * d[3]); }
                q += __shfl_xor(q, 16); q += __shfl_xor(q, 32);
                if (fq == 0) P[(ai * HALF + wr * 64 + m * 16 + fr) * 4 + wc] = (f32x2v){mw, q};
            }
        asm volatile("s_waitcnt lgkmcnt(0)" ::: "memory"); __builtin_amdgcn_s_barrier(); asm volatile("" ::: "memory");
#if defined(BROKEN_NO_WAIT)
        if (blockIdx.x >= 64) { const long long t0 = clock64(); while (clock64() - t0 < 60000) __builtin_amdgcn_s_sleep(8); }
#endif
        const int row = wid * 32 + (lane & 31);
        if (lane < 32) {
            const f32x2v a = P[row * 4 + 0], b = P[row * 4 + 1], c = P[row * 4 + 2], d = P[row * 4 + 3];
            const float mt = (a.x + b.x + c.x + d.x) * 0.25f;
            const float da = a.x - mt, db = b.x - mt, dc = c.x - mt, dd = d.x - mt;
            const float m2 = (a.y + b.y) + (c.y + d.y) + 64.0f * ((da * da + db * db) + (dc * dc + dd * dd));
            unsigned long long* slot = (unsigned long long*)xbuf + ((size_t)(u.pm * BM + row) * 4 + u.pn);
            __hip_atomic_store(slot, ((unsigned long long)__float_as_uint(m2) << 32) | __float_as_uint(mt), __ATOMIC_RELAXED, __HIP_MEMORY_SCOPE_AGENT);
        }
        asm volatile("s_waitcnt vmcnt(0)" ::: "memory");
        if (lane == 0) __hip_atomic_fetch_add(cnt + 64 * u.pm, 1u, __ATOMIC_RELAXED, __HIP_MEMORY_SCOPE_AGENT);
        if (wid == 0) {
            bool dead = false; const unsigned long long t0 = __builtin_amdgcn_s_memrealtime(); const unsigned want = 8u * (unsigned)ntn;
            for (;;) {
#if defined(BROKEN_NO_WAIT)
                break;
#endif
                if ((unsigned)__builtin_amdgcn_readfirstlane(__hip_atomic_load(cnt + 64 * u.pm, __ATOMIC_RELAXED, __HIP_MEMORY_SCOPE_AGENT)) >= want) break;
                if (__builtin_amdgcn_s_memrealtime() - t0 > 2000000ull) {
                    if (lane == 0) { unsigned expect = 0u; __hip_atomic_compare_exchange_strong(tmo + 1, &expect, code | (unsigned)(u.pm & 0xff), __ATOMIC_RELAXED, __ATOMIC_RELAXED, __HIP_MEMORY_SCOPE_AGENT);
                                     __hip_atomic_store(tmo, 1u, __ATOMIC_RELAXED, __HIP_MEMORY_SCOPE_AGENT); }
                    dead = true; break; }
                __builtin_amdgcn_s_sleep(2);
            }
            __builtin_amdgcn_fence(__ATOMIC_ACQUIRE, "agent");
            if (lane == 0) flag[0] = dead ? 1u : 0u;
        }
        asm volatile("s_waitcnt vmcnt(0) lgkmcnt(0)" ::: "memory"); __builtin_amdgcn_s_barrier(); asm volatile("" ::: "memory");
        const bool bad = flag[0] != 0u;
        if (lane < 32) {
            const unsigned long long* slot = (const unsigned long long*)xbuf + (size_t)(u.pm * BM + row) * 4; float mt[4], m2[4]; float ms = 0.f;
#pragma unroll
            for (int t = 0; t < 4; ++t) { if (t < ntn) { const unsigned long long w = __hip_atomic_load(slot + t, __ATOMIC_RELAXED, __HIP_MEMORY_SCOPE_AGENT); mt[t] = __uint_as_float((unsigned)w); m2[t] = __uint_as_float((unsigned)(w >> 32)); } else { mt[t] = 0.f; m2[t] = 0.f; } ms += mt[t]; }
            const float mean = ms / (float)ntn; float q = 0.f;
#pragma unroll
            for (int t = 0; t < 4; ++t) if (t < ntn) { const float dm = mt[t] - mean; q += m2[t] + 256.0f * dm * dm; }
            S[row] = (f32x2v){mean, 1.0f / sqrtf(q / (256.0f * (float)ntn) + eps)};
        }
        asm volatile("s_waitcnt lgkmcnt(0)" ::: "memory"); __builtin_amdgcn_s_barrier(); asm volatile("" ::: "memory");
        return bad;
    }
};
struct EpiLnRes {
    static constexpr bool PERM = false, AFTER_DRAIN = true;
    const float* base; float* out; int ldc; const float* bias; PanelStats st; unsigned poison;
    __device__ __forceinline__ void refuse(size_t i0, size_t stride, int M, int N) const { const float q = __builtin_nanf(""); for (size_t i = i0; i < (size_t)M * N; i += stride) out[(i / N) * ldc + i % N] = q;
        if (i0 == 0) { unsigned expect = 0u; __hip_atomic_compare_exchange_strong(st.tmo + 1, &expect, 0x7f0u, __ATOMIC_RELAXED, __ATOMIC_RELAXED, __HIP_MEMORY_SCOPE_AGENT); __hip_atomic_store(st.tmo, 1u, __ATOMIC_RELAXED, __HIP_MEMORY_SCOPE_AGENT); } }
    __device__ __forceinline__ void fused(f32x4 (&acc)[2][2][4][2], const Unit& u, int wr, int wc, int fr, int fq, PG8_LAS unsigned char* lds, int wid, int lane) const {
        typedef float f32x2v __attribute__((ext_vector_type(2)));
        const PG8_LAS f32x2v* S = (const PG8_LAS f32x2v*)(lds + 8192);
        const int col0 = u.pn * BM + wc * 32 + 4 * fq;
#pragma unroll
        for (int bj = 0; bj < 2; ++bj)
#pragma unroll
            for (int n = 0; n < 2; ++n) { const f32x4 bv = bias ? *(const f32x4*)(bias + col0 + bj * HALF + n * 16) : (f32x4){0.f, 0.f, 0.f, 0.f};
#pragma unroll
                for (int ai = 0; ai < 2; ++ai)
#pragma unroll
                    for (int m = 0; m < 4; ++m) acc[ai][bj][m][n] += bv; }
        const bool bad = st.run(acc, u, wr, wc, fr, fq, lds, wid, lane) || poison != 0u;
        const float qnan = __builtin_nanf("");
#pragma unroll
        for (int ai = 0; ai < 2; ++ai)
#pragma unroll
            for (int m = 0; m < 4; ++m) { const int r = ai * HALF + wr * 64 + m * 16 + fr; const f32x2v sr = S[r]; const size_t off = (size_t)(u.pm * BM + r) * ldc + col0;
#pragma unroll
                for (int bj = 0; bj < 2; ++bj)
#pragma unroll
                    for (int n = 0; n < 2; ++n) { const f32x4 bs = *(const f32x4*)(base + off + bj * HALF + n * 16); f32x4 o = bs + (acc[ai][bj][m][n] - sr.x) * sr.y;
                        if (bad) o = (f32x4){qnan, qnan, qnan, qnan}; *(f32x4*)(out + off + bj * HALF + n * 16) = o; }
                asm volatile("" ::: "memory"); }
    }
};
struct EpiLnResLn {
    static constexpr bool PERM = false, AFTER_DRAIN = true;
    const float* base; float* out; bf16_t* xn; int ldc; const float* bias; PanelStats st1, st2; unsigned poison;
    __device__ __forceinline__ void refuse(size_t i0, size_t stride, int M, int N) const { const float q = __builtin_nanf(""); for (size_t i = i0; i < (size_t)M * N; i += stride) { const size_t o = (i / N) * ldc + i % N; out[o] = q; xn[o] = (bf16_t)0x7fc0u; }
        if (i0 == 0) { unsigned expect = 0u; __hip_atomic_compare_exchange_strong(st1.tmo + 1, &expect, 0x7f0u, __ATOMIC_RELAXED, __ATOMIC_RELAXED, __HIP_MEMORY_SCOPE_AGENT); __hip_atomic_store(st1.tmo, 1u, __ATOMIC_RELAXED, __HIP_MEMORY_SCOPE_AGENT); } }
    __device__ __forceinline__ void fused(f32x4 (&acc)[2][2][4][2], const Unit& u, int wr, int wc, int fr, int fq, PG8_LAS unsigned char* lds, int wid, int lane) const {
        typedef float f32x2v __attribute__((ext_vector_type(2))); typedef unsigned u32x2v __attribute__((ext_vector_type(2)));
        const PG8_LAS f32x2v* S = (const PG8_LAS f32x2v*)(lds + 8192);
        const int col0 = u.pn * BM + wc * 32 + 4 * fq;
#pragma unroll
        for (int bj = 0; bj < 2; ++bj)
#pragma unroll
            for (int n = 0; n < 2; ++n) { const f32x4 bv = bias ? *(const f32x4*)(bias + col0 + bj * HALF + n * 16) : (f32x4){0.f, 0.f, 0.f, 0.f};
#pragma unroll
                for (int ai = 0; ai < 2; ++ai)
#pragma unroll
                    for (int m = 0; m < 4; ++m) acc[ai][bj][m][n] += bv; }
        bool bad = st1.run(acc, u, wr, wc, fr, fq, lds, wid, lane) || poison != 0u;
        const float qnan = __builtin_nanf("");
#pragma unroll
        for (int ai = 0; ai < 2; ++ai)
#pragma unroll
            for (int m = 0; m < 4; ++m) { const int r = ai * HALF + wr * 64 + m * 16 + fr; const f32x2v sr = S[r]; const size_t off = (size_t)(u.pm * BM + r) * ldc + col0;
#pragma unroll
                for (int bj = 0; bj < 2; ++bj)
#pragma unroll
                    for (int n = 0; n < 2; ++n) { const f32x4 bs = *(const f32x4*)(base + off + bj * HALF + n * 16); acc[ai][bj][m][n] = bs + (acc[ai][bj][m][n] - sr.x) * sr.y; }
                asm volatile("" : "+v"(acc[ai][0][m][0]), "+v"(acc[ai][0][m][1]), "+v"(acc[ai][1][m][0]), "+v"(acc[ai][1][m][1]));
                if (m & 1) asm volatile("" ::: "memory"); }
        const bool bad1 = bad;
        bad = st2.run(acc, u, wr, wc, fr, fq, lds, wid, lane) || bad;
#pragma unroll
        for (int ai = 0; ai < 2; ++ai)
#pragma unroll
            for (int m = 0; m < 4; ++m) { const int r = ai * HALF + wr * 64 + m * 16 + fr; const f32x2v sr = S[r]; const size_t off = (size_t)(u.pm * BM + r) * ldc + col0;
#pragma unroll
                for (int bj = 0; bj < 2; ++bj)
#pragma unroll
                    for (int n = 0; n < 2; ++n) { const f32x4 x1 = acc[ai][bj][m][n]; *(f32x4*)(out + off + bj * HALF + n * 16) = bad1 ? (f32x4){qnan, qnan, qnan, qnan} : x1;
                        const f32x4 o = (x1 - sr.x) * sr.y; u32x2v w; w.x = cvt_pk_bf16(o[0], o[1]); w.y = cvt_pk_bf16(o[2], o[3]);
                        if (bad) { w.x = 0x7fc07fc0u; w.y = 0x7fc07fc0u; } *(u32x2v*)(xn + off + bj * HALF + n * 16) = w; }
                asm volatile("" ::: "memory"); }
    }
};

template <class Epi, class Sched, bool STAMP = false>
__device__ __forceinline__ void gemm_phase(PG8_LAS unsigned char* lds, const Gemm g, const Sched& S, const Epi& E, unsigned long long* stamps) {
    const int tid = threadIdx.x, wid = __builtin_amdgcn_readfirstlane(tid >> 6), lane = tid & 63, wr = wid >> 2, wc = wid & 3, fr = lane & 15, fq = lane >> 4;
    const int K = g.K, nt = K / BK;
    int ts_lo = 0, ts_hi = 0, nts = 0; const unsigned long long rt_entry = STAMP ? (unsigned long long)wall_clock64() : 0ull;
#define PG8_STAMP() do { if (STAMP && wid == 0 && nts < 64) { const unsigned long long _c = (unsigned long long)clock64(); \
        ts_lo = (lane == nts) ? (int)(unsigned)_c : ts_lo; ts_hi = (lane == nts) ? (int)(unsigned)(_c >> 32) : ts_hi; ++nts; } } while (0)
    PG8_STAMP();
    unsigned voffA[2], voffB[2];
#pragma unroll
    for (int i = 0; i < 2; ++i) { int R, C; stage_rc(tid * 16 + i * 8192, R, C); const int Rb = Epi::PERM ? ((R & ~31) + perm32(R & 31)) : R;
        voffA[i] = (unsigned)(R * K + C) * 2u; voffB[i] = (unsigned)(Rb * K + C) * 2u; }
    const size_t kstep = (size_t)(BK * 2);
    const size_t hstep = (size_t)HALF * K * 2;
    const size_t tstep = 2 * hstep;
    const unsigned ldsw = (unsigned)wid * 1024u;
    const int aoff = lds_byte(wr * 64 + fr, fq * 8), boff = lds_byte(wc * 32 + fr, fq * 8);
#define PG8_SA(b, h) (((b) * 2 + (h)) * HTB)
#define PG8_SB(b, h) ((4 + (b) * 2 + (h)) * HTB)
#define PG8_STAGE(bufoff, gbase, voff) do { _Pragma("unroll") for (int _i = 0; _i < 2; ++_i) \
        __builtin_amdgcn_global_load_lds((const unsigned*)((const char*)(gbase) + (voff)[_i]), (PG8_LAS unsigned*)(lds + (bufoff) + ldsw + _i * 8192), 16, 0, 0); } while (0)
#define PG8_LDA(dst, b, h) do { _Pragma("unroll") for (int m = 0; m < 4; ++m) _Pragma("unroll") for (int k = 0; k < 2; ++k) dst[m][k] = *(const PG8_LAS bf16x8*)(lds + PG8_SA(b, h) + aoff + m * 2048 + k * 1024); } while (0)
#define PG8_LDB(dst, b, h) do { _Pragma("unroll") for (int n = 0; n < 2; ++n) _Pragma("unroll") for (int k = 0; k < 2; ++k) dst[n][k] = *(const PG8_LAS bf16x8*)(lds + PG8_SB(b, h) + boff + n * 2048 + k * 1024); } while (0)
#define PG8_MMA(ai, bj, At, Bt) do { __builtin_amdgcn_s_setprio(1); _Pragma("unroll") for (int m = 0; m < 4; ++m) _Pragma("unroll") for (int n = 0; n < 2; ++n) _Pragma("unroll") for (int k = 0; k < 2; ++k) \
        acc[ai][bj][m][n] = __builtin_amdgcn_mfma_f32_16x16x32_bf16(Bt[n][k], At[m][k], acc[ai][bj][m][n], 0, 0, 0); __builtin_amdgcn_s_setprio(0); } while (0)
#define PG8_WAIT_V(n) asm volatile("s_waitcnt vmcnt(" #n ")" ::: "memory")
#define PG8_WAIT_L(n) asm volatile("s_waitcnt lgkmcnt(" #n ")" ::: "memory")
#define PG8_BAR __builtin_amdgcn_s_barrier()
#define PG8_SCHED __builtin_amdgcn_sched_barrier(0)
    Unit cur, nxt; int ui = 0;
    if (!S.next(0, cur)) return;
    f32x4 acc[2][2][4][2];
#pragma unroll
    for (int a = 0; a < 2; ++a)
#pragma unroll
        for (int b = 0; b < 2; ++b)
#pragma unroll
            for (int m = 0; m < 4; ++m)
#pragma unroll
                for (int n = 0; n < 2; ++n) acc[a][b][m][n] = (f32x4){0.f, 0.f, 0.f, 0.f};
    bf16x8 At[4][2], B0[2][2], B1[2][2];
    const char* cA = (const char*)g.A + (size_t)cur.pm * tstep; const char* cB = (const char*)g.Bt + (size_t)cur.pn * tstep;
    S.a_ready(cur);
    PG8_STAGE(PG8_SB(0, 0), cB, voffB); PG8_STAGE(PG8_SA(0, 0), cA, voffA); PG8_STAGE(PG8_SB(0, 1), cB + hstep, voffB); PG8_STAGE(PG8_SA(0, 1), cA + hstep, voffA);
    if (wr == 1) PG8_BAR;
    PG8_WAIT_V(4); PG8_BAR;
    PG8_STAGE(PG8_SB(1, 0), cB + kstep, voffB); PG8_STAGE(PG8_SA(1, 0), cA + kstep, voffA); PG8_STAGE(PG8_SB(1, 1), cB + hstep + kstep, voffB);
    PG8_WAIT_V(6); PG8_BAR;
    PG8_STAMP();
    for (;;) {
        const bool has_next = S.next(ui + 1, nxt);
        const char* nA = has_next ? (const char*)g.A + (size_t)nxt.pm * tstep : cA; const char* nB = has_next ? (const char*)g.Bt + (size_t)nxt.pn * tstep : cB;
        for (int t = 0; t < nt; t += 2) {
            const bool last = (t == nt - 2);
            const char* a1 = cA + (size_t)(t + 1) * kstep;
            const char* a2 = last ? nA : cA + (size_t)(t + 2) * kstep; const char* b2 = last ? nB : cB + (size_t)(t + 2) * kstep;
            const char* a3 = a2 + kstep; const char* b3 = b2 + kstep;
            if (last && has_next) S.a_ready(nxt);
            PG8_LDB(B0, 0, 0); PG8_SCHED; PG8_LDA(At, 0, 0); PG8_STAGE(PG8_SA(1, 1), a1 + hstep, voffA);
            PG8_WAIT_L(8); PG8_BAR; PG8_WAIT_L(0); PG8_MMA(0, 0, At, B0); PG8_BAR; PG8_SCHED;
            PG8_LDB(B1, 0, 1); PG8_STAGE(PG8_SB(0, 0), b2, voffB);
            PG8_BAR; PG8_WAIT_L(0); PG8_MMA(0, 1, At, B1); PG8_BAR;
            PG8_LDA(At, 0, 1); PG8_STAGE(PG8_SA(0, 0), a2, voffA);
            PG8_BAR; PG8_WAIT_L(0); PG8_MMA(1, 0, At, B0); PG8_BAR; PG8_SCHED;
            PG8_STAGE(PG8_SB(0, 1), b2 + hstep, voffB);
            PG8_WAIT_V(6); PG8_BAR; PG8_MMA(1, 1, At, B1); PG8_BAR;
            PG8_LDB(B0, 1, 0); PG8_SCHED; PG8_LDA(At, 1, 0); PG8_STAGE(PG8_SA(0, 1), a2 + hstep, voffA);
            PG8_WAIT_L(8); PG8_BAR; PG8_WAIT_L(0); PG8_MMA(0, 0, At, B0); PG8_BAR; PG8_SCHED;
            PG8_LDB(B1, 1, 1); PG8_STAGE(PG8_SB(1, 0), b3, voffB);
            PG8_BAR; PG8_WAIT_L(0); PG8_MMA(0, 1, At, B1); PG8_BAR;
            PG8_LDA(At, 1, 1); PG8_STAGE(PG8_SA(1, 0), a3, voffA);
            PG8_BAR; PG8_WAIT_L(0); PG8_MMA(1, 0, At, B0); PG8_BAR; PG8_SCHED;
            PG8_STAGE(PG8_SB(1, 1), b3 + hstep, voffB);
            PG8_WAIT_V(6); PG8_BAR; PG8_MMA(1, 1, At, B1); PG8_BAR;
        }
        PG8_STAMP();
        if constexpr (!Epi::AFTER_DRAIN) { E(acc, cur, wr, wc, fr, fq); S.done(cur); }
        PG8_STAMP();
        if (!has_next) break;
#pragma unroll
        for (int a = 0; a < 2; ++a)
#pragma unroll
            for (int b = 0; b < 2; ++b)
#pragma unroll
                for (int m = 0; m < 4; ++m)
#pragma unroll
                    for (int n = 0; n < 2; ++n) acc[a][b][m][n] = (f32x4){0.f, 0.f, 0.f, 0.f};
        cur = nxt; cA = nA; cB = nB; ++ui;
    }
    PG8_WAIT_V(0);
    if (wr == 0) PG8_BAR;
    PG8_BAR;
    if constexpr (Epi::AFTER_DRAIN) { E.fused(acc, cur, wr, wc, fr, fq, lds, wid, lane); S.done(cur); }
    PG8_STAMP();
    if (STAMP && wid == 0) { stamps[lane] = lane < nts ? (((unsigned long long)(unsigned)ts_hi << 32) | (unsigned)ts_lo) : 0ull;
        if (lane == 62) stamps[62] = rt_entry; if (lane == 63) stamps[63] = (unsigned long long)wall_clock64(); }
#undef PG8_STAMP
#undef PG8_SA
#undef PG8_SB
#undef PG8_STAGE
#undef PG8_LDA
#undef PG8_LDB
#undef PG8_MMA
#undef PG8_WAIT_V
#undef PG8_WAIT_L
#undef PG8_BAR
#undef PG8_SCHED
}
}

#define LAS __attribute__((address_space(3)))
#define XB_TMO      128
#define XB_XCNT(j)  (256  + 64 * (j))
#define XB_XSUB(j)  (1280 + 64 * (j))
#define XB_XGEN(j)  (2304 + 64 * (j))
#define XB_TOP      3328
#define XB_TOPGEN   3392
#define XCD_BAR_WORDS 3456
#define XB_SPIN_CAP (1u << 24)

__device__ __forceinline__ unsigned xb_ld(unsigned* p)              { return __hip_atomic_load(p, __ATOMIC_RELAXED, __HIP_MEMORY_SCOPE_AGENT); }
__device__ __forceinline__ unsigned xb_add(unsigned* p, unsigned v) { return __hip_atomic_fetch_add(p, v, __ATOMIC_RELAXED, __HIP_MEMORY_SCOPE_AGENT); }
__device__ __forceinline__ unsigned xb_xcc_id() { return (unsigned)__builtin_amdgcn_s_getreg((3 << 11) | 20) & 0xFu; }
#define XB_SPIN(cond, bar) do { unsigned _sp = 0; while (cond) { __builtin_amdgcn_s_sleep(1); \
    if ((++_sp & 255u) == 0u) { if (xb_ld(&(bar)[XB_TMO])) break; if (_sp > XB_SPIN_CAP) { atomicAdd(&(bar)[XB_TMO], 1u); break; } } } } while (0)

struct XcdBarrier { unsigned* bar; unsigned x; volatile LAS unsigned* st; };

__device__ __forceinline__ XcdBarrier xcd_barrier_post(unsigned* bar, volatile LAS unsigned* st) {
    XcdBarrier b; b.bar = bar; b.x = xb_xcc_id(); b.st = st;
    if (threadIdx.x == 0) (void)xb_add(&bar[XB_XCNT(b.x)], 1u);
    return b;
}
__device__ __forceinline__ void xcd_barrier_complete(unsigned* bar, unsigned x, unsigned& nloc, unsigned& nx) {
    const unsigned G = gridDim.x * gridDim.y * gridDim.z;
    unsigned sum, cnt, mine, sp = 0u;
    for (;;) {
        sum = 0u; cnt = 0u; mine = 0u;
#pragma unroll
        for (unsigned j = 0; j < 16; ++j) { const unsigned c = xb_ld(&bar[XB_XCNT(j)]); sum += c; cnt += (c > 0u) ? 1u : 0u; mine = (j == x) ? c : mine; }
        if (sum == G) break;
        __builtin_amdgcn_s_sleep(1);
        if ((++sp & 255u) == 0u) { if (xb_ld(&bar[XB_TMO])) break; if (sp > XB_SPIN_CAP) { atomicAdd(&bar[XB_TMO], 1u); break; } }
    }
    nloc = mine > 0u ? mine : 1u; nx = cnt > 0u ? cnt : 1u;
}
__device__ __forceinline__ void xcd_barrier(const XcdBarrier& b) {
    asm volatile("s_waitcnt vmcnt(0)" ::: "memory");
    __syncthreads();
    if (threadIdx.x == 0) {
        unsigned* bar = b.bar;
        __builtin_amdgcn_s_waitcnt(0);
        unsigned nloc = b.st[0], nx = b.st[1];
        if (nloc == 0u) { xcd_barrier_complete(bar, b.x, nloc, nx); b.st[0] = nloc; b.st[1] = nx; }
        const unsigned old = xb_add(&bar[XB_XSUB(b.x)], 1u);
        const unsigned gen = old / nloc;
        if (old + 1u == (gen + 1u) * nloc) {
            __builtin_amdgcn_fence(__ATOMIC_RELEASE, "agent");
            asm volatile("s_waitcnt vmcnt(0)" ::: "memory");
            const unsigned og = xb_add(&bar[XB_TOP], 1u);
            const unsigned tg = og / nx;
            if (og + 1u == (tg + 1u) * nx) xb_add(&bar[XB_TOPGEN], 1u);
            else XB_SPIN(xb_ld(&bar[XB_TOPGEN]) == tg, bar);
            __builtin_amdgcn_fence(__ATOMIC_ACQUIRE, "agent");
            xb_add(&bar[XB_XGEN(b.x)], 1u);
            asm volatile("s_waitcnt vmcnt(0)" ::: "memory");
        } else {
            XB_SPIN(xb_ld(&bar[XB_XGEN(b.x)]) == gen, bar);
            __builtin_amdgcn_fence(__ATOMIC_ACQUIRE, "agent");
            asm volatile("s_waitcnt vmcnt(0)" ::: "memory");
        }
    }
    __syncthreads();
}

typedef unsigned short bf16;
typedef float f32x4 __attribute__((ext_vector_type(4)));
typedef float f32x16 __attribute__((ext_vector_type(16)));
typedef float f32x2 __attribute__((ext_vector_type(2)));
typedef unsigned u32x4 __attribute__((ext_vector_type(4)));
typedef unsigned u32x2 __attribute__((ext_vector_type(2)));
typedef short bf16x8 __attribute__((ext_vector_type(8)));
typedef __bf16 bf2_t __attribute__((ext_vector_type(2)));

constexpr int NTHREADS = 512, NWAVES = 8;
constexpr int LDS_BYTES = 160 * 1024;
constexpr int MISC_OFF = LDS_BYTES - 256;
constexpr int TOK = 32768, SEQ = 16384, DM = 2048;
constexpr int EV_N = 4800, EV_NP = 4864, OD_N = 4176, OD_NP = 4352;
constexpr float ALPHA = 1.41421356237f;
constexpr size_t MiB = 1u << 20;
constexpr size_t WS_CTL = 0, CTL_ZERO_BYTES = 1 * MiB;
constexpr int CW_BAR = 4096, CW_XRANK = 8192;
constexpr size_t WS_MOD = 1 * MiB, WS_SKB = 2 * MiB, WS_WL = 4 * MiB, WS_BS = 7 * MiB, WS_CNT = 9 * MiB;
constexpr size_t WS_WINE = 10 * MiB, WS_WOUTE = 29 * MiB, WS_WINO = 37 * MiB, WS_WOUTO = 54 * MiB, WS_WQ0 = 62 * MiB, WS_WQ1 = 70 * MiB;
constexpr size_t WS_HY = 78 * MiB, WS_Z = 206 * MiB, WS_LA = 510 * MiB, WS_BIG = 542 * MiB, WS_END = 1022 * MiB;

__device__ __forceinline__ float bf2f(unsigned short b) { return __uint_as_float(((unsigned)b) << 16); }
__device__ __forceinline__ unsigned pk2(float lo, float hi) { const bf2_t v = {(__bf16)lo, (__bf16)hi}; return __builtin_bit_cast(unsigned, v); }
__device__ __forceinline__ unsigned f2bf(float f) { return pk2(f, 0.f) & 0xffffu; }
__device__ __forceinline__ float lo2f(unsigned w) { return __uint_as_float(w << 16); }
__device__ __forceinline__ float hi2f(unsigned w) { return __uint_as_float(w & 0xffff0000u); }
template <int CTRL, int RM> __device__ __forceinline__ float dppo(float v) { return __int_as_float(__builtin_amdgcn_update_dpp(__float_as_int(v), __float_as_int(v), CTRL, RM, 0xF, false)); }
__device__ __forceinline__ float wsum(float v) {
    v += __int_as_float(__builtin_amdgcn_update_dpp(0, __float_as_int(v), 0xB1, 0xF, 0xF, false)); v += __int_as_float(__builtin_amdgcn_update_dpp(0, __float_as_int(v), 0x4E, 0xF, 0xF, false));
    v += __int_as_float(__builtin_amdgcn_update_dpp(0, __float_as_int(v), 0x141, 0xF, 0xF, false)); v += __int_as_float(__builtin_amdgcn_update_dpp(0, __float_as_int(v), 0x140, 0xF, 0xF, false));
    v += __int_as_float(__builtin_amdgcn_update_dpp(0, __float_as_int(v), 0x142, 0xA, 0xF, false)); v += __int_as_float(__builtin_amdgcn_update_dpp(0, __float_as_int(v), 0x143, 0xC, 0xF, false));
    return __int_as_float(__builtin_amdgcn_readlane(__float_as_int(v), 63));
}
__device__ __forceinline__ float wmax(float v) {
    v = fmaxf(v, dppo<0xB1, 0xF>(v)); v = fmaxf(v, dppo<0x4E, 0xF>(v)); v = fmaxf(v, dppo<0x141, 0xF>(v)); v = fmaxf(v, dppo<0x140, 0xF>(v));
    v = fmaxf(v, dppo<0x142, 0xA>(v)); v = fmaxf(v, dppo<0x143, 0xC>(v));
    return __int_as_float(__builtin_amdgcn_readlane(__float_as_int(v), 63));
}
__device__ __forceinline__ float xsum32(float x) { const auto r = __builtin_amdgcn_permlane32_swap(__float_as_uint(x), __float_as_uint(x), false, false); return __uint_as_float(r[0]) + __uint_as_float(r[1]); }
__device__ __forceinline__ float xsum16(float x) { const auto r = __builtin_amdgcn_permlane16_swap(__float_as_uint(x), __float_as_uint(x), false, false); return __uint_as_float(r[0]) + __uint_as_float(r[1]); }
__device__ __forceinline__ float xmax32(float x) { const auto r = __builtin_amdgcn_permlane32_swap(__float_as_uint(x), __float_as_uint(x), false, false); return fmaxf(__uint_as_float(r[0]), __uint_as_float(r[1])); }
__device__ __forceinline__ float xmax16(float x) { const auto r = __builtin_amdgcn_permlane16_swap(__float_as_uint(x), __float_as_uint(x), false, false); return fmaxf(__uint_as_float(r[0]), __uint_as_float(r[1])); }
__device__ __forceinline__ float rsum4(float v0, float v1, float v2, float v3) {
    const auto p = __builtin_amdgcn_permlane32_swap(__float_as_uint(v0), __float_as_uint(v2), false, false);
    const auto q = __builtin_amdgcn_permlane32_swap(__float_as_uint(v1), __float_as_uint(v3), false, false);
    const float P = __uint_as_float(p[0]) + __uint_as_float(p[1]);
    const float Q = __uint_as_float(q[0]) + __uint_as_float(q[1]);
    const auto t = __builtin_amdgcn_permlane16_swap(__float_as_uint(P), __float_as_uint(Q), false, false);
    return __uint_as_float(t[0]) + __uint_as_float(t[1]);
}
__device__ __forceinline__ float rdlane(float v, int l) { return __int_as_float(__builtin_amdgcn_readlane(__float_as_int(v), l)); }
__device__ __forceinline__ unsigned rdlaneu(unsigned v, int l) { return (unsigned)__builtin_amdgcn_readlane((int)v, l); }
__device__ __forceinline__ float dot2bf(unsigned a, unsigned b, float c) {
    return __builtin_amdgcn_fdot2_f32_bf16(__builtin_bit_cast(bf2_t, a), __builtin_bit_cast(bf2_t, b), c, false);
}
template <int CTRL, int RM> __device__ __forceinline__ float dppf(float v) {
    return __int_as_float(__builtin_amdgcn_update_dpp(0, __float_as_int(v), CTRL, RM, 0xF, false));
}
__device__ __forceinline__ float wsum_dpp(float v) {
    v += dppf<0xB1, 0xF>(v);
    v += dppf<0x4E, 0xF>(v);
    v += dppf<0x141, 0xF>(v);
    v += dppf<0x140, 0xF>(v);
    v += dppf<0x142, 0xA>(v);
    v += dppf<0x143, 0xC>(v);
    return rdlane(v, 63);
}
__device__ __forceinline__ float sum16_dpp(float v) {
    v += dppf<0xB1, 0xF>(v); v += dppf<0x4E, 0xF>(v); v += dppf<0x141, 0xF>(v); v += dppf<0x140, 0xF>(v);
    return v;
}
__device__ __forceinline__ float sigmoidf_(float x) { return 1.0f / (1.0f + expf(-x)); }
__device__ __forceinline__ unsigned ordkey(float f) { const unsigned u = __float_as_uint(f); return (u & 0x80000000u) ? ~u : (u | 0x80000000u); }
__device__ __forceinline__ unsigned fixkey20(float f) { const float c = fminf(fmaxf(f, -15.999f), 15.999f); return (unsigned)((int)rintf(c * 32768.0f) + (1 << 19)); }
__device__ __forceinline__ float unordkey(unsigned k) { return __uint_as_float((k & 0x80000000u) ? (k & 0x7fffffffu) : ~k); }

struct Args { const void* in[27]; float* out; unsigned char* ws; int ph_lo, ph_hi; };
struct Frame { LAS unsigned char* lds; int tid, lane, wave, bx, G, gw, ngw; };

struct EpiLora {
    static constexpr bool PERM = true, AFTER_DRAIN = false;
    pg8::bf16_t* O; int ldc; const float* w0; const float* a0;
    __device__ __forceinline__ void operator()(const pg8::f32x4 (&acc)[2][2][4][2], const pg8::Unit& u, int wr, int wc, int fr, int fq) const {
        const int row0 = u.pm * 256 + wr * 64 + fr; const int colt = u.pn * 256; const int type = u.pn >> 2;
        const int col0 = colt + wc * 32 + 8 * fq, ncol0 = col0 & 1023;
        const float* pv = (type == 0) ? w0 : a0;
        pg8::f32x4 bv[2][2];
#pragma unroll
        for (int bj = 0; bj < 2; ++bj)
#pragma unroll
            for (int n = 0; n < 2; ++n) bv[bj][n] = (type < 2) ? *(const pg8::f32x4*)(pv + ncol0 + bj * 128 + 4 * n) : (pg8::f32x4){0.f, 0.f, 0.f, 0.f};
#pragma unroll
        for (int ai = 0; ai < 2; ++ai)
#pragma unroll
            for (int m = 0; m < 4; ++m) { pg8::bf16_t* rowp = O + (size_t)(row0 + ai * 128 + m * 16) * ldc + col0;
#pragma unroll
                for (int bj = 0; bj < 2; ++bj) { pg8::f32x4 v0 = acc[ai][bj][m][0] + bv[bj][0], v1 = acc[ai][bj][m][1] + bv[bj][1];
                    if (type < 2) {
                        const float sc = (type == 0) ? 0.60653066f : 1.0f;
#pragma unroll
                        for (int j = 0; j < 4; ++j) { v0[j] = sc / (1.0f + __expf(-v0[j])); v1[j] = sc / (1.0f + __expf(-v1[j])); }
                    }
                    pg8::u32x4 w; w.x = pg8::cvt_pk_bf16(v0[0], v0[1]); w.y = pg8::cvt_pk_bf16(v0[2], v0[3]); w.z = pg8::cvt_pk_bf16(v1[0], v1[1]); w.w = pg8::cvt_pk_bf16(v1[2], v1[3]);
                    *(pg8::u32x4*)(rowp + bj * 128) = w; } }
    }
};

__device__ __forceinline__ void transpose_item(const float* W, int K, int N, int Npad, bf16* WT, LAS float* scr, int item, int lane) {
    const int nblk = Npad / 32, kb = item / nblk, nb = item % nblk, k0 = 64 * kb, n0 = 32 * nb;
    const int nl = lane & 31; const bool ok = (n0 + nl) < N;
#pragma unroll 8
    for (int i = 0; i < 32; ++i) { const int kk = 2 * i + (lane >> 5); scr[kk * 33 + nl] = ok ? W[(size_t)(k0 + kk) * N + n0 + nl] : 0.f; }
    asm volatile("s_waitcnt lgkmcnt(0)" ::: "memory");
    const int c = lane & 7;
#pragma unroll
    for (int j = 0; j < 4; ++j) { const int n = (lane >> 3) + 8 * j; const LAS float* s = scr + (8 * c) * 33 + n;
        u32x4 o; o.x = pk2(s[0 * 33], s[1 * 33]); o.y = pk2(s[2 * 33], s[3 * 33]); o.z = pk2(s[4 * 33], s[5 * 33]); o.w = pk2(s[6 * 33], s[7 * 33]);
        *(u32x4*)(WT + (size_t)(n0 + n) * K + k0 + 8 * c) = o; }
    asm volatile("s_waitcnt lgkmcnt(0)" ::: "memory");
}

__device__ __forceinline__ void ph_prologue(const Args& A, Frame& F) {
    unsigned char* ws = A.ws;
    {
        const float* c = (const float*)A.in[1]; const float* mw = (const float*)A.in[19]; const float* mb = (const float*)A.in[20];
        float* MOD = (float*)(ws + WS_MOD);
        LAS float* red = (LAS float*)F.lds;
        for (int it = F.bx; it < 96; it += F.G) {
            const int s = it / 24, cc = it % 24, col = cc * 256 + F.lane * 4;
            const float* W = mw + (size_t)s * 2048 * 6144 + col;
            f32x4 a0 = {0.f, 0.f, 0.f, 0.f}, a1 = {0.f, 0.f, 0.f, 0.f};
            const int k0 = F.wave * 256;
#pragma unroll 8
            for (int k = k0; k < k0 + 256; ++k) {
                float c0 = c[k], c1 = c[2048 + k];
                c0 = c0 / (1.0f + expf(-c0)); c1 = c1 / (1.0f + expf(-c1));
                const f32x4 w = *(const f32x4*)(W + (size_t)k * 6144);
                a0 += c0 * w; a1 += c1 * w;
            }
            *(LAS f32x4*)(red + ((F.wave * 2 + 0) * 256 + F.lane * 4)) = a0;
            *(LAS f32x4*)(red + ((F.wave * 2 + 1) * 256 + F.lane * 4)) = a1;
            __syncthreads();
            { const int b = F.tid >> 8, cl = F.tid & 255; float sm = 0.f;
#pragma unroll
              for (int w = 0; w < 8; ++w) sm += red[(w * 2 + b) * 256 + cl];
              MOD[(size_t)(s * 2 + b) * 6144 + cc * 256 + cl] = sm + mb[s * 6144 + cc * 256 + cl]; }
            __syncthreads();
        }
    }
    {
        LAS float* scr = (LAS float*)(F.lds + 16384 + F.wave * 8704);
        constexpr int I0 = 32 * (EV_NP / 32), I1 = 32 * 64, I2 = 32 * (OD_NP / 32);
        constexpr int NIT = I0 + I1 + I2 + 3 * I1;
        for (int it = F.gw; it < NIT; it += F.ngw) {
            int r = it;
            if (r < I0) { transpose_item((const float*)A.in[3], 2048, EV_N, EV_NP, (bf16*)(ws + WS_WINE), scr, r, F.lane); continue; } r -= I0;
            if (r < I1) { transpose_item((const float*)A.in[4], 2048, 2048, 2048, (bf16*)(ws + WS_WOUTE), scr, r, F.lane); continue; } r -= I1;
            if (r < I2) { transpose_item((const float*)A.in[17], 2048, OD_N, OD_NP, (bf16*)(ws + WS_WINO), scr, r, F.lane); continue; } r -= I2;
            if (r < I1) { transpose_item((const float*)A.in[18], 2048, 2048, 2048, (bf16*)(ws + WS_WOUTO), scr, r, F.lane); continue; } r -= I1;
            if (r < I1) { transpose_item((const float*)A.in[23], 2048, 2048, 2048, (bf16*)(ws + WS_WQ0), scr, r, F.lane); continue; } r -= I1;
            transpose_item((const float*)A.in[23] + (size_t)2048 * 2048, 2048, 2048, 2048, (bf16*)(ws + WS_WQ1), scr, r, F.lane);
        }
    }
    {
        const float* w2 = (const float*)A.in[8]; const float* a2 = (const float*)A.in[10]; const float* g2 = (const float*)A.in[11];
        bf16* WL = (bf16*)(ws + WS_WL);
        const int gt = F.bx * NTHREADS + F.tid, ngt = F.G * NTHREADS;
        for (int i = gt; i < 3072 * 512; i += ngt) {
            const int n = i >> 9, k = i & 511; float v = 0.f;
            if (n < 1024) { if (k < 96) v = w2[k * 1024 + n]; }
            else if (n < 2048) { if (k >= 96 && k < 192) v = a2[(k - 96) * 1024 + (n - 1024)]; }
            else { if (k >= 192 && k < 448) v = g2[(k - 192) * 1024 + (n - 2048)]; }
            WL[i] = (bf16)f2bf(v);
        }
        const float* sk = (const float*)A.in[24]; bf16* SKB = (bf16*)(ws + WS_SKB);
        for (int i = gt; i < 2 * 262144; i += ngt) SKB[i] = (bf16)f2bf(sk[i]);
    }
}

__device__ __forceinline__ void ph_mod_x(const Args& A, Frame& F) {
    const float* x = (const float*)A.in[0]; const float* MOD = (const float*)(A.ws + WS_MOD); bf16* H = (bf16*)(A.ws + WS_HY);
    for (int t = F.gw; t < TOK; t += F.ngw) {
        const int b = t >> 14; const float* sh = MOD + (size_t)(0 * 2 + b) * 6144; const float* sc = sh + 2048;
#pragma unroll
        for (int j = 0; j < 8; ++j) { const int idx = j * 256 + F.lane * 4;
            const f32x4 xv = *(const f32x4*)(x + (size_t)t * DM + idx), sv = *(const f32x4*)(sc + idx), hv = *(const f32x4*)(sh + idx);
            const f32x4 o = xv * (1.0f + sv) + hv; u32x2 w; w.x = pk2(o[0], o[1]); w.y = pk2(o[2], o[3]);
            *(u32x2*)(H + (size_t)t * DM + idx) = w; }
    }
}

__device__ __forceinline__ void ph_even_post(const Args& A, Frame& F) {
    bf16* Z = (bf16*)(A.ws + WS_Z); const int* positions = (const int*)A.in[2]; const float* mu = (const float*)A.in[6];
    bf16* RKV = (bf16*)A.out; bf16* LAp = (bf16*)(A.ws + WS_LA);
    const int i = F.lane & 31; const float inv = powf(10000.0f, -(float)i / 32.0f);
    const int i4 = F.lane & 7, hs = F.lane >> 3;
    for (int t = F.gw; t < TOK; t += F.ngw) {
        const int s = t & (SEQ - 1); bf16* zr = Z + (size_t)t * EV_NP;
        float sn, cs; sincosf((float)positions[t] * inv, &sn, &cs);
        float c4[4], s4[4];
#pragma unroll
        for (int e = 0; e < 4; ++e) { c4[e] = __shfl(cs, 4 * i4 + e); s4[e] = __shfl(sn, 4 * i4 + e); }
#pragma unroll
        for (int it = 0; it < 3; ++it) { const int hd = it * 8 + hs; if (hd < 18) { bf16* hp = zr + hd * 64 + 4 * i4;
            const u32x2 a = *(const u32x2*)hp, b = *(const u32x2*)(hp + 32);
            const float t1[4] = {lo2f(a.x), hi2f(a.x), lo2f(a.y), hi2f(a.y)}, t2[4] = {lo2f(b.x), hi2f(b.x), lo2f(b.y), hi2f(b.y)};
            float o1[4], o2[4];
#pragma unroll
            for (int e = 0; e < 4; ++e) { o1[e] = t1[e] * c4[e] - t2[e] * s4[e]; o2[e] = t2[e] * c4[e] + t1[e] * s4[e]; }
            *(u32x2*)hp = (u32x2){pk2(o1[0], o1[1]), pk2(o1[2], o1[3])}; *(u32x2*)(hp + 32) = (u32x2){pk2(o2[0], o2[1]), pk2(o2[2], o2[3])}; } }
        const bf16* zp = zr - EV_NP; const bool hasprev = s > 0;
#pragma unroll
        for (int m = 0; m < 7; ++m) { const int j = 8 * (F.lane + 64 * m); if (j < 3520) {
            const u32x4 cw = *(const u32x4*)(zr + 1280 + j); u32x4 pw = {0u, 0u, 0u, 0u}; if (hasprev) pw = *(const u32x4*)(zp + 1280 + j);
            const f32x4 m0 = *(const f32x4*)(mu + j), m1 = *(const f32x4*)(mu + j + 4);
            const unsigned cwa[4] = {cw.x, cw.y, cw.z, cw.w}, pwa[4] = {pw.x, pw.y, pw.z, pw.w}; const float mm[8] = {m0[0], m0[1], m0[2], m0[3], m1[0], m1[1], m1[2], m1[3]};
            float v[8];
#pragma unroll
            for (int q = 0; q < 4; ++q) { const float c0 = lo2f(cwa[q]), c1 = hi2f(cwa[q]), p0 = lo2f(pwa[q]), p1 = hi2f(pwa[q]); v[2 * q] = c0 + (p0 - c0) * mm[2 * q]; v[2 * q + 1] = c1 + (p1 - c1) * mm[2 * q + 1]; }
            bf16* dst;
            if (j < 3072) { dst = RKV + (size_t)(j >> 10) * TOK * 1024 + (size_t)t * 1024 + (j & 1023); }
            else if (j < 3168) { dst = LAp + (size_t)t * 512 + (j - 3072);
#pragma unroll
                for (int e = 0; e < 8; ++e) v[e] = tanhf(v[e]); }
            else if (j < 3264) { dst = LAp + (size_t)t * 512 + 96 + (j - 3168); }
            else { dst = LAp + (size_t)t * 512 + 192 + (j - 3264);
#pragma unroll
                for (int e = 0; e < 8; ++e) v[e] = sigmoidf_(v[e]); }
            *(u32x4*)dst = (u32x4){pk2(v[0], v[1]), pk2(v[2], v[3]), pk2(v[4], v[5]), pk2(v[6], v[7])};
        } }
        if (F.lane < 8) *(u32x4*)(LAp + (size_t)t * 512 + 448 + 8 * F.lane) = (u32x4){0u, 0u, 0u, 0u};
    }
}

__device__ __forceinline__ void ph_scan_pack(const Args& A, Frame& F) {
    const bf16* Z = (const bf16*)(A.ws + WS_Z); const bf16* RKV = (const bf16*)A.out;
    const float* k_k = (const float*)A.in[12]; const float* k_a = (const float*)A.in[13]; const float* r_k = (const float*)A.in[14];
    unsigned* PK = (unsigned*)(A.ws + WS_BIG); float* BS = (float*)(A.ws + WS_BS);
    const int g16 = F.lane >> 4, c16 = F.lane & 15;
    for (int it = F.gw; it < TOK * 4; it += F.ngw) {
        const int item = it * 4 + g16; const int t = item >> 4, h = item & 15, c = h * 64 + 4 * c16, b = t >> 14, s = t & (SEQ - 1);
        const u32x2 rw = *(const u32x2*)(RKV + (size_t)t * 1024 + c), kw = *(const u32x2*)(RKV + (size_t)TOK * 1024 + (size_t)t * 1024 + c), vw = *(const u32x2*)(RKV + (size_t)2 * TOK * 1024 + (size_t)t * 1024 + c);
        const u32x2 ew = *(const u32x2*)(Z + (size_t)t * EV_NP + 1280 + c), aw = *(const u32x2*)(Z + (size_t)t * EV_NP + 1280 + 1024 + c);
        const f32x4 kk4 = *(const f32x4*)(k_k + c), ka4 = *(const f32x4*)(k_a + c), rk4 = *(const f32x4*)(r_k + c);
        const float r[4] = {lo2f(rw.x), hi2f(rw.x), lo2f(rw.y), hi2f(rw.y)}, kr[4] = {lo2f(kw.x), hi2f(kw.x), lo2f(kw.y), hi2f(kw.y)}, v[4] = {lo2f(vw.x), hi2f(vw.x), lo2f(vw.y), hi2f(vw.y)};
        const float e[4] = {lo2f(ew.x), hi2f(ew.x), lo2f(ew.y), hi2f(ew.y)}, a[4] = {lo2f(aw.x), hi2f(aw.x), lo2f(aw.y), hi2f(aw.y)};
        float kkv[4], kp[4]; float ss = 0.f, bsum = 0.f;
#pragma unroll
        for (int q = 0; q < 4; ++q) { kkv[q] = kr[q] * kk4[q]; ss += kkv[q] * kkv[q]; kp[q] = kr[q] * (1.0f + (a[q] - 1.0f) * ka4[q]); bsum += r[q] * kp[q] * rk4[q]; }
        ss = sum16_dpp(ss); bsum = sum16_dpp(bsum);
        const float rn = 1.0f / fmaxf(sqrtf(ss), 1e-12f);
        if (c16 == 0) BS[(size_t)t * 16 + h] = bsum;
        unsigned w[12];
#pragma unroll
        for (int q = 0; q < 4; ++q) { const float kkn = kkv[q] * rn; w[3 * q] = pk2(r[q], e[q]); w[3 * q + 1] = pk2(kp[q], kkn); w[3 * q + 2] = pk2(kkn * a[q], v[q]); }
        u32x4* dst = (u32x4*)(PK + ((size_t)((b * 16 + h) * SEQ + s) * 64 + 4 * c16) * 3);
        dst[0] = (u32x4){w[0], w[1], w[2], w[3]}; dst[1] = (u32x4){w[4], w[5], w[6], w[7]}; dst[2] = (u32x4){w[8], w[9], w[10], w[11]};
    }
}

__device__ __forceinline__ void ph_swa(const Args& A, Frame& F) {
    const bf16* Z = (const bf16*)(A.ws + WS_Z); bf16* Y = (bf16*)(A.ws + WS_HY); const float* sinks = (const float*)A.in[5];
    LAS unsigned char* KL = F.lds; LAS unsigned char* VL = F.lds + 256 * 136;
    for (int u = F.bx; u < 512; u += F.G) {
        const int b = u >> 8, n = (u >> 1) & 127, kvh = u & 1;
        __syncthreads();
        for (int c = F.tid; c < 2048; c += NTHREADS) { const int jw = c >> 3, cc = c & 7; const int s = n * 128 - 128 + jw;
            u32x4 kv = {0u, 0u, 0u, 0u}, vv = {0u, 0u, 0u, 0u};
            if (s >= 0) { const bf16* row = Z + (size_t)(b * SEQ + s) * EV_NP; kv = *(const u32x4*)(row + 1024 + kvh * 64 + cc * 8); vv = *(const u32x4*)(row + 1152 + kvh * 64 + cc * 8); }
            *(LAS u32x2*)(KL + jw * 136 + cc * 16) = (u32x2){kv.x, kv.y}; *(LAS u32x2*)(KL + jw * 136 + cc * 16 + 8) = (u32x2){kv.z, kv.w};
            *(LAS u32x2*)(VL + jw * 136 + cc * 16) = (u32x2){vv.x, vv.y}; *(LAS u32x2*)(VL + jw * 136 + cc * 16 + 8) = (u32x2){vv.z, vv.w}; }
        __syncthreads();
        for (int it = F.wave; it < 1024; it += NWAVES) {
            const int i = it >> 3, g = it & 7, head = kvh * 8 + g; const int t = b * SEQ + n * 128 + i;
            const float qv = bf2f(Z[(size_t)t * EV_NP + head * 64 + F.lane]) * 0.125f;
            const int jw0 = i + 1 + F.lane, jw1 = jw0 + 64;
            const bool val0 = (n > 0) || (jw0 >= 128), val1 = (n > 0) || (jw1 >= 128);
            float s0 = 0.f, s1 = 0.f;
#pragma unroll
            for (int d4 = 0; d4 < 16; ++d4) {
                const u32x2 k0 = *(const LAS u32x2*)(KL + jw0 * 136 + d4 * 8), k1 = *(const LAS u32x2*)(KL + jw1 * 136 + d4 * 8);
                const float q0 = rdlane(qv, 4 * d4), q1 = rdlane(qv, 4 * d4 + 1), q2 = rdlane(qv, 4 * d4 + 2), q3 = rdlane(qv, 4 * d4 + 3);
                s0 += q0 * lo2f(k0.x) + q1 * hi2f(k0.x) + q2 * lo2f(k0.y) + q3 * hi2f(k0.y);
                s1 += q0 * lo2f(k1.x) + q1 * hi2f(k1.x) + q2 * lo2f(k1.y) + q3 * hi2f(k1.y);
            }
            const float sink = sinks[head];
            s0 = val0 ? s0 : -INFINITY; s1 = val1 ? s1 : -INFINITY;
            const float mx = fmaxf(wmax(fmaxf(s0, s1)), sink);
            float p0 = val0 ? expf(s0 - mx) : 0.f, p1 = val1 ? expf(s1 - mx) : 0.f;
            const float den = wsum(p0 + p1) + expf(sink - mx); const float rden = 1.0f / den;
            p0 *= rden; p1 *= rden;
            float o = 0.f;
            const LAS bf16* vcol = (const LAS bf16*)VL + F.lane;
#pragma unroll 8
            for (int jj = 0; jj < 64; ++jj) o += rdlane(p0, jj) * bf2f(vcol[(i + 1 + jj) * 68]);
#pragma unroll 8
            for (int jj = 0; jj < 64; ++jj) o += rdlane(p1, jj) * bf2f(vcol[(i + 65 + jj) * 68]);
            Y[(size_t)t * DM + head * 64 + F.lane] = (bf16)f2bf(o);
        }
    }
}

__device__ __forceinline__ bf16x8 as_bf8(u32x4 v) { return __builtin_bit_cast(bf16x8, v); }
__device__ __forceinline__ void ph_swa_mfma(const Args& A, Frame& F) {
    const bf16* Z = (const bf16*)(A.ws + WS_Z); bf16* Y = (bf16*)(A.ws + WS_HY); const float* sinks = (const float*)A.in[5];
    LAS bf16* KL = (LAS bf16*)F.lds;
    LAS bf16* VT = (LAS bf16*)(F.lds + 36864);
    const int l15 = F.lane & 15, g4 = F.lane >> 4;
    for (int u = F.bx; u < 512; u += F.G) {
        const int b = u >> 8, n = (u >> 1) & 127, kvh = u & 1;
        __syncthreads();
        for (int c = F.tid; c < 2048; c += NTHREADS) { const int jw = c >> 3, cc = c & 7; const int sp = n * 128 - 128 + jw;
            u32x4 kv = {0u, 0u, 0u, 0u}, vv = {0u, 0u, 0u, 0u};
            if (sp >= 0) { const bf16* row = Z + (size_t)(b * SEQ + sp) * EV_NP; kv = *(const u32x4*)(row + 1024 + kvh * 64 + cc * 8); vv = *(const u32x4*)(row + 1152 + kvh * 64 + cc * 8); }
            *(LAS u32x4*)(KL + jw * 72 + cc * 8) = kv;
            const unsigned vw[4] = {vv.x, vv.y, vv.z, vv.w};
#pragma unroll
            for (int q = 0; q < 4; ++q) { VT[(8 * cc + 2 * q) * 264 + jw] = (bf16)(vw[q] & 0xffffu); VT[(8 * cc + 2 * q + 1) * 264 + jw] = (bf16)(vw[q] >> 16); } }
        __syncthreads();
        const int head = kvh * 8 + F.wave; const float sink = sinks[head];
#pragma unroll 1
        for (int qt = 0; qt < 8; ++qt) {
            const int iq = 16 * qt + l15; const int t = b * SEQ + n * 128 + iq;
            bf16x8 qf[2];
#pragma unroll
            for (int ks = 0; ks < 2; ++ks) qf[ks] = *(const bf16x8*)(Z + (size_t)t * EV_NP + head * 64 + 32 * ks + 8 * g4);
            float sv[10][4]; float mx = -INFINITY;
#pragma unroll
            for (int kk = 0; kk < 9; ++kk) { const int kt = qt + kk;
                f32x4 acc = {0.f, 0.f, 0.f, 0.f};
#pragma unroll
                for (int ks = 0; ks < 2; ++ks) acc = __builtin_amdgcn_mfma_f32_16x16x32_bf16(*(const LAS bf16x8*)(KL + (16 * kt + l15) * 72 + 32 * ks + 8 * g4), qf[ks], acc, 0, 0, 0);
#pragma unroll
                for (int rg_ = 0; rg_ < 4; ++rg_) { const int jw = 16 * kt + 4 * g4 + rg_; const bool ok = (jw >= iq + 1) && (jw <= iq + 128) && ((n > 0) || (jw >= 128));
                    sv[kk][rg_] = ok ? acc[rg_] * 0.125f : -INFINITY; mx = fmaxf(mx, sv[kk][rg_]); } }
#pragma unroll
            for (int rg_ = 0; rg_ < 4; ++rg_) sv[9][rg_] = -INFINITY;
            mx = xmax16(mx); mx = xmax32(mx); mx = fmaxf(mx, sink);
            float sm = 0.f;
#pragma unroll
            for (int kk = 0; kk < 10; ++kk)
#pragma unroll
                for (int rg_ = 0; rg_ < 4; ++rg_) { const float pv = (sv[kk][rg_] == -INFINITY) ? 0.f : __expf(sv[kk][rg_] - mx); sv[kk][rg_] = pv; sm += pv; }
            sm = xsum16(sm); sm = xsum32(sm);
            const float rden = 1.0f / (sm + __expf(sink - mx));
            f32x4 oacc[4];
#pragma unroll
            for (int dt = 0; dt < 4; ++dt) oacc[dt] = (f32x4){0.f, 0.f, 0.f, 0.f};
#pragma unroll
            for (int pp = 0; pp < 5; ++pp) { const int ka = qt + 2 * pp, kb = (qt + 2 * pp + 1 < 16) ? (qt + 2 * pp + 1) : 15;
                const bf16x8 pb = as_bf8((u32x4){pk2(sv[2 * pp][0] * rden, sv[2 * pp][1] * rden), pk2(sv[2 * pp][2] * rden, sv[2 * pp][3] * rden),
                                                  pk2(sv[2 * pp + 1][0] * rden, sv[2 * pp + 1][1] * rden), pk2(sv[2 * pp + 1][2] * rden, sv[2 * pp + 1][3] * rden)});
#pragma unroll
                for (int dt = 0; dt < 4; ++dt) { const LAS bf16* vr = VT + (16 * dt + l15) * 264 + 4 * g4;
                    const u32x2 va = *(const LAS u32x2*)(vr + 16 * ka), vb2 = *(const LAS u32x2*)(vr + 16 * kb);
                    oacc[dt] = __builtin_amdgcn_mfma_f32_16x16x32_bf16(as_bf8((u32x4){va.x, va.y, vb2.x, vb2.y}), pb, oacc[dt], 0, 0, 0); } }
#pragma unroll
            for (int dt = 0; dt < 4; ++dt) *(u32x2*)(Y + (size_t)t * DM + head * 64 + 16 * dt + 4 * g4) = (u32x2){pk2(oacc[dt][0], oacc[dt][1]), pk2(oacc[dt][2], oacc[dt][3])};
        }
    }
}

constexpr int FR_BYTES = 15360;
__device__ __forceinline__ int fr_rho(int ks, int g, int j) { return 16 * (2 * ks + (j >> 2)) + 4 * g + (j & 3); }
__device__ __forceinline__ void ph_scan_prep(const Args& A, Frame& F) {
    const bf16* Z = (const bf16*)(A.ws + WS_Z); const bf16* RKV = (const bf16*)A.out;
    const float* k_k = (const float*)A.in[12]; const float* k_a = (const float*)A.in[13]; const float* r_k = (const float*)A.in[14];
    unsigned char* FR = A.ws + WS_BIG; float* BS = (float*)(A.ws + WS_BS);
    LAS float* EE = (LAS float*)F.lds;
    LAS float* VV = (LAS float*)(F.lds + 4096);
    LAS float* KHf = (LAS float*)(F.lds + 8192);
    LAS float* RHf = (LAS float*)(F.lds + 12352);
    LAS float* BPf = (LAS float*)(F.lds + 16512);
    LAS bf16* AHb = (LAS bf16*)(F.lds + 20672);
    LAS bf16* BHb = (LAS bf16*)(F.lds + 22976);
    LAS bf16* KHb = (LAS bf16*)(F.lds + 25280);
    LAS bf16* RHb = (LAS bf16*)(F.lds + 27584);
    LAS bf16* APT = (LAS bf16*)(F.lds + 29888);
    LAS float* GA = (LAS float*)(F.lds + 32960);
    LAS float* GB = GA + 16 * 17; LAS float* GMA = GB + 16 * 17; LAS float* GMB = GMA + 16 * 17;
    LAS float* TT = (LAS float*)(F.lds + 37312);
    LAS bf16* P1b = (LAS bf16*)(F.lds + 38400);
    LAS bf16* P2b = (LAS bf16*)(F.lds + 41472);
    LAS bf16* MAT = (LAS bf16*)(F.lds + 42240);
    LAS float* WW = (LAS float*)(F.lds + 43008);
    const int tt = F.tid >> 5, kq = F.tid & 31;
    const int l15 = F.lane & 15, g = F.lane >> 4;
    const bf16x8 zero8 = {0, 0, 0, 0, 0, 0, 0, 0};
    for (int it = F.bx; it < 32 * 1024; it += F.G) {
        const int bh = it >> 10, ch = it & 1023, b = bh >> 4, h = bh & 15;
        const int tok = b * SEQ + ch * 16 + tt, c = h * 64 + 2 * kq;
        __syncthreads();
        float e2[2], kkn[2], kka[2], kp[2], r2[2];
        {
            const unsigned rw = *(const unsigned*)(RKV + (size_t)tok * 1024 + c), kw = *(const unsigned*)(RKV + (size_t)TOK * 1024 + (size_t)tok * 1024 + c), vw = *(const unsigned*)(RKV + (size_t)2 * TOK * 1024 + (size_t)tok * 1024 + c);
            const unsigned ew = *(const unsigned*)(Z + (size_t)tok * EV_NP + 1280 + c), aw = *(const unsigned*)(Z + (size_t)tok * EV_NP + 1280 + 1024 + c);
            const float kr[2] = {lo2f(kw), hi2f(kw)}, av[2] = {lo2f(aw), hi2f(aw)};
            r2[0] = lo2f(rw); r2[1] = hi2f(rw); e2[0] = lo2f(ew); e2[1] = hi2f(ew);
            float kkv[2], ss = 0.f, bsum = 0.f;
#pragma unroll
            for (int q = 0; q < 2; ++q) { kkv[q] = kr[q] * k_k[c + q]; ss += kkv[q] * kkv[q]; kp[q] = kr[q] * (1.0f + (av[q] - 1.0f) * k_a[c + q]); bsum += r2[q] * kp[q] * r_k[c + q]; }
            ss = xsum16(sum16_dpp(ss)); bsum = xsum16(sum16_dpp(bsum));
            const float rn = 1.0f / fmaxf(sqrtf(ss), 1e-12f);
#pragma unroll
            for (int q = 0; q < 2; ++q) { kkn[q] = kkv[q] * rn; kka[q] = kkn[q] * av[q]; }
            if (kq == 0) BS[(size_t)tok * 16 + h] = bsum;
            *(LAS f32x2*)(EE + tt * 64 + 2 * kq) = (f32x2){e2[0], e2[1]};
            *(LAS f32x2*)(VV + tt * 64 + 2 * kq) = (f32x2){lo2f(vw), hi2f(vw)};
        }
        __syncthreads();
        {
            float L[2] = {0.f, 0.f}, L15[2] = {0.f, 0.f};
#pragma unroll
            for (int i = 0; i < 16; ++i) { const f32x2 ev = *(const LAS f32x2*)(EE + i * 64 + 2 * kq); L15[0] += ev.x; L15[1] += ev.y; if (i <= tt) { L[0] += ev.x; L[1] += ev.y; } }
            float kh[2], ah[2], bhv[2], rh[2], ap[2], bp[2];
#pragma unroll
            for (int q = 0; q < 2; ++q) { const float wt = __expf(-L[q]), iwt = __expf(L[q]), wprev = __expf(-(L[q] - e2[q])), wrest = __expf(-(L15[q] - L[q]));
                kh[q] = kkn[q] * wprev; ah[q] = kka[q] * iwt; bhv[q] = kp[q] * iwt; rh[q] = r2[q] * wt; ap[q] = kka[q] * wrest; bp[q] = kp[q] * wrest;
                if (tt == 15) WW[2 * kq + q] = wt; }
            KHf[tt * 65 + 2 * kq] = kh[0]; KHf[tt * 65 + 2 * kq + 1] = kh[1]; RHf[tt * 65 + 2 * kq] = rh[0]; RHf[tt * 65 + 2 * kq + 1] = rh[1]; BPf[tt * 65 + 2 * kq] = bp[0]; BPf[tt * 65 + 2 * kq + 1] = bp[1];
            *(LAS unsigned*)(KHb + tt * 72 + 2 * kq) = pk2(kh[0], kh[1]); *(LAS unsigned*)(AHb + tt * 72 + 2 * kq) = pk2(ah[0], ah[1]);
            *(LAS unsigned*)(BHb + tt * 72 + 2 * kq) = pk2(bhv[0], bhv[1]); *(LAS unsigned*)(RHb + tt * 72 + 2 * kq) = pk2(rh[0], rh[1]);
            APT[(2 * kq) * 24 + tt] = (bf16)f2bf(ap[0]); APT[(2 * kq + 1) * 24 + tt] = (bf16)f2bf(ap[1]);
        }
        __syncthreads();
        if (F.wave < 4) {
            const int mat = F.wave; const LAS bf16* X = (mat & 1) ? BHb : AHb; const LAS bf16* Y = (mat & 2) ? RHb : KHb;
            f32x4 acc = {0.f, 0.f, 0.f, 0.f};
#pragma unroll
            for (int ks = 0; ks < 2; ++ks) acc = __builtin_amdgcn_mfma_f32_16x16x32_bf16(*(const LAS bf16x8*)(X + l15 * 72 + 32 * ks + 8 * g), *(const LAS bf16x8*)(Y + l15 * 72 + 32 * ks + 8 * g), acc, 0, 0, 0);
            LAS float* dst = (mat == 0) ? GA : ((mat == 1) ? GB : ((mat == 2) ? GMA : GMB));
#pragma unroll
            for (int rg_ = 0; rg_ < 4; ++rg_) { const int i = 4 * g + rg_; const bool nz = (mat & 2) ? (i <= l15) : (i < l15); const float v = nz ? acc[rg_] : 0.f;
                dst[i * 17 + l15] = v; if (mat == 2) MAT[l15 * 24 + i] = (bf16)f2bf(v); }
        }
        __syncthreads();
        if (F.tid < 16) {
            float x[16];
#pragma unroll
            for (int i = 15; i >= 0; --i) { float v = (i == F.tid) ? 1.0f : 0.f;
#pragma unroll
                for (int m = i + 1; m < 16; ++m) v -= GA[i * 17 + m] * x[m];
                x[i] = v; }
#pragma unroll
            for (int i = 0; i < 16; ++i) TT[i * 17 + F.tid] = x[i];
        }
        __syncthreads();
        {
            float x0 = 0.f, x1 = 0.f;
#pragma unroll
            for (int m = 0; m < 16; ++m) { const float tv = TT[m * 17 + tt]; x0 -= KHf[m * 65 + 2 * kq] * tv; x1 -= KHf[m * 65 + 2 * kq + 1] * tv; }
            P1b[(2 * kq) * 24 + tt] = (bf16)f2bf(x0); P1b[(2 * kq + 1) * 24 + tt] = (bf16)f2bf(x1);
            if (F.tid < 256) { const int i = F.tid >> 4, t = F.tid & 15; float x = 0.f;
#pragma unroll
                for (int m = 0; m < 16; ++m) x -= GB[i * 17 + m] * TT[m * 17 + t];
                P2b[i * 24 + t] = (bf16)f2bf(x); }
        }
        __syncthreads();
        {
            unsigned char* fr = FR + (size_t)it * FR_BYTES;
            const int mt = F.wave >> 1, ks = F.wave & 1;
            const bf16x8 aP0 = (g < 2) ? *(const LAS bf16x8*)(P1b + (16 * (2 * ks) + l15) * 24 + 8 * g) : zero8;
            const bf16x8 aP1 = (g < 2) ? *(const LAS bf16x8*)(P1b + (16 * (2 * ks + 1) + l15) * 24 + 8 * g) : zero8;
            const bf16x8 bAP = (g < 2) ? *(const LAS bf16x8*)(APT + (16 * mt + l15) * 24 + 8 * g) : zero8;
            const f32x4 z4 = {0.f, 0.f, 0.f, 0.f};
            const f32x4 d0 = __builtin_amdgcn_mfma_f32_16x16x32_bf16(aP0, bAP, z4, 0, 0, 0), d1 = __builtin_amdgcn_mfma_f32_16x16x32_bf16(aP1, bAP, z4, 0, 0, 0);
            *(u32x4*)(fr + (size_t)(F.wave * 64 + F.lane) * 16) = (u32x4){pk2(d0[0], d0[1]), pk2(d0[2], d0[3]), pk2(d1[0], d1[1]), pk2(d1[2], d1[3])};
            if (F.wave < 4) {
                const bf16x8 aP2 = (g < 2) ? *(const LAS bf16x8*)(P2b + l15 * 24 + 8 * g) : zero8;
                const bf16x8 bA = (g < 2) ? *(const LAS bf16x8*)(APT + (16 * F.wave + l15) * 24 + 8 * g) : zero8;
                f32x4 d = __builtin_amdgcn_mfma_f32_16x16x32_bf16(aP2, bA, z4, 0, 0, 0);
#pragma unroll
                for (int rg_ = 0; rg_ < 4; ++rg_) d[rg_] += BPf[(4 * g + rg_) * 65 + 16 * F.wave + l15];
                *(u32x2*)(fr + 8192 + (size_t)(F.wave * 64 + F.lane) * 8) = (u32x2){pk2(d[0], d[1]), pk2(d[2], d[3])};
            } else if (F.wave < 6) {
                const int ks2 = F.wave - 4;
                const bf16x8 a0 = (g < 2) ? *(const LAS bf16x8*)(P1b + (16 * (2 * ks2) + l15) * 24 + 8 * g) : zero8;
                const bf16x8 a1 = (g < 2) ? *(const LAS bf16x8*)(P1b + (16 * (2 * ks2 + 1) + l15) * 24 + 8 * g) : zero8;
                const bf16x8 bM = (g < 2) ? *(const LAS bf16x8*)(MAT + l15 * 24 + 8 * g) : zero8;
                f32x4 q0 = __builtin_amdgcn_mfma_f32_16x16x32_bf16(a0, bM, z4, 0, 0, 0), q1 = __builtin_amdgcn_mfma_f32_16x16x32_bf16(a1, bM, z4, 0, 0, 0);
#pragma unroll
                for (int rg_ = 0; rg_ < 4; ++rg_) { q0[rg_] += RHf[l15 * 65 + 16 * (2 * ks2) + 4 * g + rg_]; q1[rg_] += RHf[l15 * 65 + 16 * (2 * ks2 + 1) + 4 * g + rg_]; }
                *(u32x4*)(fr + 10240 + (size_t)(ks2 * 64 + F.lane) * 16) = (u32x4){pk2(q0[0], q0[1]), pk2(q0[2], q0[3]), pk2(q1[0], q1[1]), pk2(q1[2], q1[3])};
            } else if (F.wave == 6) {
                const bf16x8 aP2 = (g < 2) ? *(const LAS bf16x8*)(P2b + l15 * 24 + 8 * g) : zero8;
                const bf16x8 bM = (g < 2) ? *(const LAS bf16x8*)(MAT + l15 * 24 + 8 * g) : zero8;
                f32x4 d = __builtin_amdgcn_mfma_f32_16x16x32_bf16(aP2, bM, z4, 0, 0, 0);
#pragma unroll
                for (int rg_ = 0; rg_ < 4; ++rg_) d[rg_] += GMB[(4 * g + rg_) * 17 + l15];
                *(u32x2*)(fr + 12288 + (size_t)F.lane * 8) = (u32x2){pk2(d[0], d[1]), pk2(d[2], d[3])};
            } else {
                *(float*)(fr + 14848 + F.lane * 4) = WW[F.lane];
            }
            if (F.tid < 256) {
                const int rg = F.tid >> 6, row = 16 * rg + l15, s4 = 4 * g;
                *(u32x2*)(fr + 12800 + (size_t)(rg * 64 + F.lane) * 8) = (u32x2){pk2(VV[s4 * 64 + row], VV[(s4 + 1) * 64 + row]), pk2(VV[(s4 + 2) * 64 + row], VV[(s4 + 3) * 64 + row])};
            }
        }
    }
}
struct ScanFrag { u32x4 g[4][2]; u32x2 f[4]; u32x4 q1[2]; u32x2 q2; u32x2 vt; f32x4 w[4]; };
__device__ __forceinline__ void scan_frag_load(ScanFrag& fr, const unsigned char* base, int rg, int lane) {
#pragma unroll
    for (int mt = 0; mt < 4; ++mt) {
#pragma unroll
        for (int ks = 0; ks < 2; ++ks) fr.g[mt][ks] = *(const u32x4*)(base + (size_t)((mt * 2 + ks) * 64 + lane) * 16);
        fr.f[mt] = *(const u32x2*)(base + 8192 + (size_t)(mt * 64 + lane) * 8);
        fr.w[mt] = *(const f32x4*)(base + 14848 + (16 * mt + 4 * (lane >> 4)) * 4); }
#pragma unroll
    for (int ks = 0; ks < 2; ++ks) fr.q1[ks] = *(const u32x4*)(base + 10240 + (size_t)(ks * 64 + lane) * 16);
    fr.q2 = *(const u32x2*)(base + 12288 + (size_t)lane * 8);
    fr.vt = *(const u32x2*)(base + 12800 + (size_t)(rg * 64 + lane) * 8);
}
__device__ __forceinline__ void scan_chunk(f32x4 (&acc)[4], const ScanFrag& fr, bf16* yout) {
    const bf16x8 sb0 = as_bf8((u32x4){pk2(acc[0][0], acc[0][1]), pk2(acc[0][2], acc[0][3]), pk2(acc[1][0], acc[1][1]), pk2(acc[1][2], acc[1][3])});
    const bf16x8 sb1 = as_bf8((u32x4){pk2(acc[2][0], acc[2][1]), pk2(acc[2][2], acc[2][3]), pk2(acc[3][0], acc[3][1]), pk2(acc[3][2], acc[3][3])});
    const bf16x8 vb = as_bf8((u32x4){fr.vt.x, fr.vt.y, 0u, 0u});
#pragma unroll
    for (int c = 0; c < 4; ++c) { f32x4 n = acc[c] * fr.w[c];
        n = __builtin_amdgcn_mfma_f32_16x16x32_bf16(as_bf8(fr.g[c][0]), sb0, n, 0, 0, 0);
        n = __builtin_amdgcn_mfma_f32_16x16x32_bf16(as_bf8(fr.g[c][1]), sb1, n, 0, 0, 0);
        n = __builtin_amdgcn_mfma_f32_16x16x32_bf16(as_bf8((u32x4){fr.f[c].x, fr.f[c].y, 0u, 0u}), vb, n, 0, 0, 0);
        acc[c] = n; }
    f32x4 y = {0.f, 0.f, 0.f, 0.f};
    y = __builtin_amdgcn_mfma_f32_16x16x32_bf16(as_bf8(fr.q1[0]), sb0, y, 0, 0, 0);
    y = __builtin_amdgcn_mfma_f32_16x16x32_bf16(as_bf8(fr.q1[1]), sb1, y, 0, 0, 0);
    y = __builtin_amdgcn_mfma_f32_16x16x32_bf16(as_bf8((u32x4){fr.q2.x, fr.q2.y, 0u, 0u}), vb, y, 0, 0, 0);
    *(u32x2*)yout = (u32x2){pk2(y[0], y[1]), pk2(y[2], y[3])};
}
#define SCAN_ASM_LD4(dst, ptr, off) asm volatile("global_load_dwordx4 %0, %1, off offset:" #off : "=v"(dst) : "v"(ptr))
#define SCAN_ASM_LD2(dst, ptr, off) asm volatile("global_load_dwordx2 %0, %1, off offset:" #off : "=v"(dst) : "v"(ptr))
__device__ __forceinline__ void scan_frag_issue(ScanFrag& fr, const unsigned char* item, int rg, int lane) {
    const unsigned char* pg0 = item + lane * 16; const unsigned char* pg1 = pg0 + 4096;
    const unsigned char* pf = item + 8192 + lane * 8; const unsigned char* pq1 = item + 10240 + lane * 16;
    const unsigned char* pq2 = item + 12288 + lane * 8; const unsigned char* pvt = item + 12800 + (rg * 64 + lane) * 8; const unsigned char* pw = item + 14848 + (lane >> 4) * 16;
    SCAN_ASM_LD4(fr.g[0][0], pg0, 0); SCAN_ASM_LD4(fr.g[0][1], pg0, 1024); SCAN_ASM_LD4(fr.g[1][0], pg0, 2048); SCAN_ASM_LD4(fr.g[1][1], pg0, 3072);
    SCAN_ASM_LD4(fr.g[2][0], pg1, 0); SCAN_ASM_LD4(fr.g[2][1], pg1, 1024); SCAN_ASM_LD4(fr.g[3][0], pg1, 2048); SCAN_ASM_LD4(fr.g[3][1], pg1, 3072);
    SCAN_ASM_LD2(fr.f[0], pf, 0); SCAN_ASM_LD2(fr.f[1], pf, 512); SCAN_ASM_LD2(fr.f[2], pf, 1024); SCAN_ASM_LD2(fr.f[3], pf, 1536);
    SCAN_ASM_LD4(fr.q1[0], pq1, 0); SCAN_ASM_LD4(fr.q1[1], pq1, 1024);
    SCAN_ASM_LD2(fr.q2, pq2, 0); SCAN_ASM_LD2(fr.vt, pvt, 0);
    SCAN_ASM_LD4(fr.w[0], pw, 0); SCAN_ASM_LD4(fr.w[1], pw, 64); SCAN_ASM_LD4(fr.w[2], pw, 128); SCAN_ASM_LD4(fr.w[3], pw, 192);
}
#define SCAN_WAIT(fr, N) asm volatile("s_waitcnt vmcnt(" #N ")" : "+v"(fr.g[0][0]), "+v"(fr.g[0][1]), "+v"(fr.g[1][0]), "+v"(fr.g[1][1]), "+v"(fr.g[2][0]), "+v"(fr.g[2][1]), "+v"(fr.g[3][0]), "+v"(fr.g[3][1]), \
        "+v"(fr.f[0]), "+v"(fr.f[1]), "+v"(fr.f[2]), "+v"(fr.f[3]), "+v"(fr.q1[0]), "+v"(fr.q1[1]), "+v"(fr.q2), "+v"(fr.vt), "+v"(fr.w[0]), "+v"(fr.w[1]), "+v"(fr.w[2]), "+v"(fr.w[3]) :: "memory")
__device__ __forceinline__ void scan_mfma_rows(const Args& A, Frame& F) {
    const unsigned char* FR = A.ws + WS_BIG; bf16* YRAW = (bf16*)A.out + (size_t)3 * TOK * 1024;
    if (F.wave != 0) return;
    for (int u = F.bx; u < 128; u += F.G) {
        const int bh = u & 31, rg = u >> 5; const unsigned char* base = FR + (size_t)bh * 1024 * FR_BYTES;
        bf16* yrow = YRAW + ((size_t)bh * 64 + 16 * rg + (F.lane & 15)) * SEQ + 4 * (F.lane >> 4);
        f32x4 acc[4];
#pragma unroll
        for (int c = 0; c < 4; ++c) acc[c] = (f32x4){0.f, 0.f, 0.f, 0.f};
        ScanFrag fa, fb;
        scan_frag_issue(fa, base, rg, F.lane);
#pragma unroll 1
        for (int ch = 0; ch < 1024; ch += 2) {
            scan_frag_issue(fb, base + (size_t)(ch + 1) * FR_BYTES, rg, F.lane);
            SCAN_WAIT(fa, 20);
            scan_chunk(acc, fa, yrow + ch * 16);
            scan_frag_issue(fa, base + (size_t)((ch + 2 < 1024) ? (ch + 2) : ch) * FR_BYTES, rg, F.lane);
            SCAN_WAIT(fb, 20);
            scan_chunk(acc, fb, yrow + (ch + 1) * 16);
        }
        asm volatile("s_waitcnt vmcnt(0)" ::: "memory");
    }
}

__device__ __forceinline__ void pair_sync(volatile LAS unsigned* cnt, unsigned target) {
    asm volatile("s_waitcnt vmcnt(0) lgkmcnt(0)" ::: "memory");
    if ((threadIdx.x & 63) == 0) (void)__hip_atomic_fetch_add((LAS unsigned*)cnt, 1u, __ATOMIC_RELAXED, __HIP_MEMORY_SCOPE_WORKGROUP);
    while (__hip_atomic_load((LAS unsigned*)cnt, __ATOMIC_RELAXED, __HIP_MEMORY_SCOPE_WORKGROUP) < target) __builtin_amdgcn_s_sleep(1);
    asm volatile("" ::: "memory");
}
__device__ __forceinline__ void swa_pairs(const Args& A, Frame& F, volatile LAS unsigned* MISC) {
    const bf16* Z = (const bf16*)(A.ws + WS_Z); bf16* Y = (bf16*)(A.ws + WS_HY); const float* sinks = (const float*)A.in[5];
    const int pr = (F.wave - 4) >> 1, mem = F.wave & 1;
    LAS unsigned char* KL = F.lds + pr * 69632; LAS unsigned char* VL = KL + 256 * 136;
    volatile LAS unsigned* cnt = MISC + 24 + pr; unsigned gen = 0u;
    for (int u = F.bx * 2 + pr; u < 512; u += F.G * 2) {
        const int b = u >> 8, n = (u >> 1) & 127, kvh = u & 1;
        gen += 2u; pair_sync(cnt, gen);
#pragma unroll 1
        for (int c0 = mem * 1024 + F.lane; c0 < mem * 1024 + 1024; c0 += 64 * 8) {
            u32x4 kv[8], vv[8];
#pragma unroll
            for (int q = 0; q < 8; ++q) { const int c = c0 + 64 * q; const int jw = c >> 3, cc = c & 7; const int sp = n * 128 - 128 + jw;
                kv[q] = (u32x4){0u, 0u, 0u, 0u}; vv[q] = kv[q];
                if (sp >= 0) { const bf16* row = Z + (size_t)(b * SEQ + sp) * EV_NP; kv[q] = *(const u32x4*)(row + 1024 + kvh * 64 + cc * 8); vv[q] = *(const u32x4*)(row + 1152 + kvh * 64 + cc * 8); } }
#pragma unroll
            for (int q = 0; q < 8; ++q) { const int c = c0 + 64 * q; const int jw = c >> 3, cc = c & 7;
                *(LAS u32x2*)(KL + jw * 136 + cc * 16) = (u32x2){kv[q].x, kv[q].y}; *(LAS u32x2*)(KL + jw * 136 + cc * 16 + 8) = (u32x2){kv[q].z, kv[q].w};
                *(LAS u32x2*)(VL + jw * 136 + cc * 16) = (u32x2){vv[q].x, vv[q].y}; *(LAS u32x2*)(VL + jw * 136 + cc * 16 + 8) = (u32x2){vv[q].z, vv[q].w}; }
        }
        gen += 2u; pair_sync(cnt, gen);
        for (int it = mem; it < 1024; it += 2) {
            const int i = it >> 3, g = it & 7, head = kvh * 8 + g; const int t = b * SEQ + n * 128 + i;
            const float qv = bf2f(Z[(size_t)t * EV_NP + head * 64 + F.lane]) * 0.125f;
            const int jw0 = i + 1 + F.lane, jw1 = jw0 + 64;
            const bool val0 = (n > 0) || (jw0 >= 128), val1 = (n > 0) || (jw1 >= 128);
            float s0 = 0.f, s1 = 0.f;
#pragma unroll
            for (int d4 = 0; d4 < 16; ++d4) {
                const u32x2 k0 = *(const LAS u32x2*)(KL + jw0 * 136 + d4 * 8), k1 = *(const LAS u32x2*)(KL + jw1 * 136 + d4 * 8);
                const float q0 = rdlane(qv, 4 * d4), q1 = rdlane(qv, 4 * d4 + 1), q2 = rdlane(qv, 4 * d4 + 2), q3 = rdlane(qv, 4 * d4 + 3);
                s0 += q0 * lo2f(k0.x) + q1 * hi2f(k0.x) + q2 * lo2f(k0.y) + q3 * hi2f(k0.y);
                s1 += q0 * lo2f(k1.x) + q1 * hi2f(k1.x) + q2 * lo2f(k1.y) + q3 * hi2f(k1.y);
            }
            const float sink = sinks[head];
            s0 = val0 ? s0 : -INFINITY; s1 = val1 ? s1 : -INFINITY;
            const float mx = fmaxf(wmax(fmaxf(s0, s1)), sink);
            float p0 = val0 ? expf(s0 - mx) : 0.f, p1 = val1 ? expf(s1 - mx) : 0.f;
            const float den = wsum(p0 + p1) + expf(sink - mx); const float rden = 1.0f / den;
            p0 *= rden; p1 *= rden;
            float o = 0.f;
            const LAS bf16* vcol = (const LAS bf16*)VL + F.lane;
#pragma unroll 8
            for (int jj = 0; jj < 64; ++jj) o += rdlane(p0, jj) * bf2f(vcol[(i + 1 + jj) * 68]);
#pragma unroll 8
            for (int jj = 0; jj < 64; ++jj) o += rdlane(p1, jj) * bf2f(vcol[(i + 65 + jj) * 68]);
            Y[(size_t)t * DM + head * 64 + F.lane] = (bf16)f2bf(o);
        }
    }
}

__device__ __forceinline__ void wsum2_dpp(float a, float b, float& ra, float& rb) {
    const auto r = __builtin_amdgcn_permlane32_swap(__float_as_uint(a), __float_as_uint(b), false, false);
    float v = __uint_as_float(r[0]) + __uint_as_float(r[1]);
    v += dppf<0xB1, 0xF>(v); v += dppf<0x4E, 0xF>(v); v += dppf<0x141, 0xF>(v); v += dppf<0x140, 0xF>(v);
    v += dppf<0x142, 0xA>(v);
    ra = rdlane(v, 31); rb = rdlane(v, 63);
}
__device__ __forceinline__ void ph_scan(const Args& A, Frame& F, volatile LAS unsigned* MISC) {
    const unsigned* PK = (const unsigned*)(A.ws + WS_BIG); bf16* YRAW = (bf16*)A.out + (size_t)3 * TOK * 1024;
    if (F.wave >= 4) { swa_pairs(A, F, MISC); return; }
    __builtin_amdgcn_s_setprio(3);
    for (int pp = F.bx * 4 + F.wave; pp < 1024; pp += F.G * 4) {
        const int rr = 2 * pp, bh = rr >> 6, vrow = rr & 63;
        const unsigned* pk = PK + ((size_t)bh * SEQ * 64 + F.lane) * 3;
        bf16* youtA = YRAW + ((size_t)bh * 64 + vrow) * SEQ; bf16* youtB = youtA + SEQ;
        f32x2 S2 = {0.f, 0.f};
        for (int t0 = 0; t0 < SEQ; t0 += 64) {
            float ykA = 0.f, ykB = 0.f;
#pragma unroll 8
            for (int j = 0; j < 64; ++j) {
                const unsigned* p = pk + (size_t)(t0 + j) * 192;
                const unsigned w0 = p[0], w1 = p[1], w2 = p[2];
                const float r = lo2f(w0), e = hi2f(w0), kp = lo2f(w1), kk = hi2f(w1), kka = lo2f(w2), vv = hi2f(w2);
                const f32x2 v2 = {rdlane(vv, vrow), rdlane(vv, vrow + 1)};
                const float dec = __expf(-e);
                const f32x2 pk2v = S2 * (f32x2){kk, kk};
                float saA, saB; wsum2_dpp(pk2v.x, pk2v.y, saA, saB); const f32x2 sa2 = {saA, saB};
                S2 = S2 * (f32x2){dec, dec} + (v2 * (f32x2){kp, kp} - sa2 * (f32x2){kka, kka});
                const f32x2 py = S2 * (f32x2){r, r};
                float yA, yB; wsum2_dpp(py.x, py.y, yA, yB);
                ykA = (F.lane == j) ? yA : ykA; ykB = (F.lane == j) ? yB : ykB;
            }
            youtA[t0 + F.lane] = (bf16)f2bf(ykA); youtB[t0 + F.lane] = (bf16)f2bf(ykB);
        }
    }
    __builtin_amdgcn_s_setprio(0);
}

__device__ __forceinline__ void ph_rwkv_finish(const Args& A, Frame& F) {
    const bf16* Z = (const bf16*)(A.ws + WS_Z); const bf16* RKV = (const bf16*)A.out; const bf16* YRAW = (const bf16*)A.out + (size_t)3 * TOK * 1024;
    const float* BS = (const float*)(A.ws + WS_BS); bf16* Y = (bf16*)(A.ws + WS_HY);
    const float* lnx_g = (const float*)A.in[15]; const float* lnx_b = (const float*)A.in[16];
    LAS float* tile = (LAS float*)(F.lds + F.wave * 16640);
    for (int it = F.gw; it < 8192; it += F.ngw) {
        const int bh = it >> 8, tb = it & 255, b = bh >> 4, h = bh & 15, t0 = tb * 64;
        for (int vr = 0; vr < 64; ++vr) tile[vr * 65 + F.lane] = bf2f(YRAW[((size_t)bh * 64 + vr) * SEQ + t0 + F.lane]);
        asm volatile("s_waitcnt lgkmcnt(0)" ::: "memory");
        const int c = h * 64 + F.lane; const float lg = lnx_g[c], lb = lnx_b[c];
        for (int j = 0; j < 64; ++j) {
            const int t = b * SEQ + t0 + j;
            const float y = tile[F.lane * 65 + j];
            const float mean = wsum(y) * (1.0f / 64.0f); const float d = y - mean; const float var = wsum(d * d) * (1.0f / 64.0f);
            const float yn = d * rsqrtf(var + 64e-5f) * lg + lb;
            const float vv = bf2f(RKV[(size_t)2 * TOK * 1024 + (size_t)t * 1024 + c]); const float g = bf2f(Z[(size_t)t * EV_NP + 1280 + 2048 + c]); const float bs = BS[(size_t)t * 16 + h];
            Y[(size_t)t * DM + 1024 + c] = (bf16)f2bf((yn + bs * vv) * g);
        }
        asm volatile("s_waitcnt lgkmcnt(0)" ::: "memory");
    }
}

constexpr size_t WS_H8 = WS_BIG + 384 * MiB, WS_HS = WS_BIG + 448 * MiB;
__device__ __forceinline__ unsigned pack_i8x4(float a, float b, float c, float d) {
    const unsigned ua = __float_as_uint(a + 12582912.0f) & 255u, ub = __float_as_uint(b + 12582912.0f) & 255u, uc = __float_as_uint(c + 12582912.0f) & 255u, ud = __float_as_uint(d + 12582912.0f);
    return ua | (ub << 8) | (uc << 16) | (ud << 24);
}
__device__ __forceinline__ void ph_ln_mixer(const Args& A, Frame& F, const int L) {
    const float* xsrc = (L == 0) ? (const float*)A.in[0] : (const float*)A.out; float* xdst = A.out;
    const bf16* O = (const bf16*)(A.ws + WS_Z); bf16* H = (bf16*)(A.ws + WS_HY); const float* MOD = (const float*)(A.ws + WS_MOD);
    const float* lng = (const float*)A.in[21] + (size_t)(L * 2 + 0) * DM; const float* lnb = (const float*)A.in[22] + (size_t)(L * 2 + 0) * DM;
    for (int t = F.gw; t < TOK; t += F.ngw) {
        const int b = t >> 14;
        const float* gate = MOD + (size_t)((L * 2 + 0) * 2 + b) * 6144 + 4096;
        const float* sh = MOD + (size_t)((L * 2 + 1) * 2 + b) * 6144; const float* sc = sh + 2048;
        float v[32]; float sum = 0.f;
#pragma unroll
        for (int j = 0; j < 4; ++j) { const int base = (j * 64 + F.lane) * 8;
            const u32x4 ow = *(const u32x4*)(O + (size_t)t * DM + base);
            const f32x4 x0 = *(const f32x4*)(xsrc + (size_t)t * DM + base), x1 = *(const f32x4*)(xsrc + (size_t)t * DM + base + 4);
            const f32x4 g0 = *(const f32x4*)(gate + base), g1 = *(const f32x4*)(gate + base + 4);
            const float of[8] = {lo2f(ow.x), hi2f(ow.x), lo2f(ow.y), hi2f(ow.y), lo2f(ow.z), hi2f(ow.z), lo2f(ow.w), hi2f(ow.w)};
#pragma unroll
            for (int e = 0; e < 4; ++e) { v[j * 8 + e] = ALPHA * x0[e] + (1.0f + g0[e]) * of[e]; v[j * 8 + 4 + e] = ALPHA * x1[e] + (1.0f + g1[e]) * of[4 + e]; }
#pragma unroll
            for (int e = 0; e < 8; ++e) sum += v[j * 8 + e]; }
        const float mean = wsum(sum) * (1.0f / DM); float sq = 0.f;
#pragma unroll
        for (int e = 0; e < 32; ++e) { v[e] -= mean; sq += v[e] * v[e]; }
        const float rstd = rsqrtf(wsum(sq) * (1.0f / DM) + 1e-5f); float hmax = 0.f;
#pragma unroll
        for (int j = 0; j < 4; ++j) { const int base = (j * 64 + F.lane) * 8;
            const f32x4 lg0 = *(const f32x4*)(lng + base), lg1 = *(const f32x4*)(lng + base + 4), lb0 = *(const f32x4*)(lnb + base), lb1 = *(const f32x4*)(lnb + base + 4);
            const f32x4 s0 = *(const f32x4*)(sc + base), s1 = *(const f32x4*)(sc + base + 4), h0 = *(const f32x4*)(sh + base), h1 = *(const f32x4*)(sh + base + 4);
            f32x4 o0, o1;
#pragma unroll
            for (int e = 0; e < 4; ++e) { o0[e] = v[j * 8 + e] * rstd * lg0[e] + lb0[e]; o1[e] = v[j * 8 + 4 + e] * rstd * lg1[e] + lb1[e]; }
            *(f32x4*)(xdst + (size_t)t * DM + base) = o0; *(f32x4*)(xdst + (size_t)t * DM + base + 4) = o1;
            const f32x4 q0 = o0 * (1.0f + s0) + h0, q1 = o1 * (1.0f + s1) + h1;
            u32x4 w; w.x = pk2(q0[0], q0[1]); w.y = pk2(q0[2], q0[3]); w.z = pk2(q1[0], q1[1]); w.w = pk2(q1[2], q1[3]);
            *(u32x4*)(H + (size_t)t * DM + base) = w;
#pragma unroll
            for (int e = 0; e < 4; ++e) { v[j * 8 + e] = q0[e]; v[j * 8 + 4 + e] = q1[e]; hmax = fmaxf(hmax, fmaxf(fabsf(q0[e]), fabsf(q1[e]))); } }
        { hmax = wmax(hmax); const float inv = (hmax > 0.f) ? 127.0f / hmax : 0.f;
#pragma unroll
          for (int j = 0; j < 4; ++j) { const int base = (j * 64 + F.lane) * 8; u32x2 w8;
              w8.x = pack_i8x4(v[j * 8 + 0] * inv, v[j * 8 + 1] * inv, v[j * 8 + 2] * inv, v[j * 8 + 3] * inv); w8.y = pack_i8x4(v[j * 8 + 4] * inv, v[j * 8 + 5] * inv, v[j * 8 + 6] * inv, v[j * 8 + 7] * inv);
              *(u32x2*)(A.ws + WS_H8 + (size_t)t * DM + base) = w8; }
          if (F.lane == 0) ((float*)(A.ws + WS_HS))[t] = hmax * (1.0f / 127.0f); }
    }
    {
        const float* pu = (const float*)A.in[25] + (size_t)L * 16384 * 2048; const float* pv = (const float*)A.in[26] + (size_t)L * 16384 * 2048;
        unsigned char* T8 = A.ws + WS_BIG; float* SCL = (float*)(A.ws + WS_BIG + 64 * MiB);
        for (int r = F.gw; r < 32768; r += F.ngw) {
            const float* src = ((r < 16384) ? pu : pv) + (size_t)(r & 16383) * 2048;
            f32x4 f[2][4]; float amax = 0.f;
#pragma unroll
            for (int j = 0; j < 2; ++j)
#pragma unroll
                for (int c = 0; c < 4; ++c) { f[j][c] = *(const f32x4*)(src + (j * 64 + F.lane) * 16 + 4 * c);
                    amax = fmaxf(amax, fmaxf(fmaxf(fabsf(f[j][c][0]), fabsf(f[j][c][1])), fmaxf(fabsf(f[j][c][2]), fabsf(f[j][c][3])))); }
            amax = wmax(amax);
            {
                const float inv = (amax > 0.f) ? 127.0f / amax : 0.f;
#pragma unroll
                for (int j = 0; j < 2; ++j) { u32x4 w;
                    w.x = pack_i8x4(f[j][0][0] * inv, f[j][0][1] * inv, f[j][0][2] * inv, f[j][0][3] * inv); w.y = pack_i8x4(f[j][1][0] * inv, f[j][1][1] * inv, f[j][1][2] * inv, f[j][1][3] * inv);
                    w.z = pack_i8x4(f[j][2][0] * inv, f[j][2][1] * inv, f[j][2][2] * inv, f[j][2][3] * inv); w.w = pack_i8x4(f[j][3][0] * inv, f[j][3][1] * inv, f[j][3][2] * inv, f[j][3][3] * inv);
                    *(u32x4*)(T8 + (size_t)r * 2048 + (j * 64 + F.lane) * 16) = w; }
                if (F.lane == 0) SCL[r] = amax * (1.0f / 127.0f);
            }
        }
    }
}

template <int NV, int NBITS> __device__ __forceinline__ unsigned wave_tau16(const unsigned (&key)[NV]) {
    unsigned tau = 0u;
#pragma unroll 1
    for (int bit = NBITS - 1; bit >= 0; --bit) {
        const unsigned cand = tau | (1u << bit); int cnt = 0;
#pragma unroll
        for (int v = 0; v < NV; ++v) cnt += __popcll(__ballot(key[v] >= cand));
        if (cnt >= 16) tau = cand;
    }
    return tau;
}
template <int NV> __device__ __forceinline__ void wave_compact16(const unsigned (&key)[NV], const float (&val)[NV], const int (&id)[NV], unsigned tau, LAS float* ov, LAS int* oi, int lane) {
    int ngt = 0;
#pragma unroll
    for (int v = 0; v < NV; ++v) ngt += __popcll(__ballot(key[v] > tau));
    int bg = 0, be = 0;
#pragma unroll
    for (int v = 0; v < NV; ++v) {
        const bool gt = key[v] > tau, eq = key[v] == tau;
        const unsigned long long mg = __ballot(gt), me = __ballot(eq);
        const unsigned long long below = (lane == 0) ? 0ull : ((~0ull) >> (64 - lane));
        const int pg = bg + __popcll(mg & below), pe = ngt + be + __popcll(me & below);
        if (gt) { ov[pg] = val[v]; oi[pg] = id[v]; }
        if (eq && pe < 16) { ov[pe] = val[v]; oi[pe] = id[v]; }
        bg += __popcll(mg); be += __popcll(me);
    }
}

template <int CTRL, int BANK> __device__ __forceinline__ unsigned dppb(unsigned old, unsigned v) { return (unsigned)__builtin_amdgcn_update_dpp((int)old, (int)v, CTRL, 0xF, BANK, false); }
template <int CTRL> __device__ __forceinline__ unsigned dppm(unsigned v) { return (unsigned)__builtin_amdgcn_mov_dpp((int)v, CTRL, 0xF, 0xF, true); }
template <int CTRL> __device__ __forceinline__ unsigned cex(unsigned x, bool lo) { const unsigned mx = max(x, dppm<CTRL>(x)), mn = min(x, dppm<CTRL>(x)); return lo ? mx : mn; }
__device__ __forceinline__ unsigned cex4(unsigned x, bool lo) {
    unsigned t = (unsigned)__builtin_amdgcn_mov_dpp((int)x, 0x104, 0xF, 0x5, false); t = dppb<0x114, 0xA>(t, x); const unsigned mx = max(x, t), mn = min(x, t); return lo ? mx : mn; }
struct LoMasks { bool lo1, lo2, lo4, lo8, odd16, up32; };
__device__ __forceinline__ unsigned sort16_desc(unsigned x, const LoMasks& M) {
    x = cex<0xB1>(x, M.lo1);
    x = cex<0x1B>(x, M.lo2); x = cex<0xB1>(x, M.lo1);
    x = cex<0x141>(x, M.lo4); x = cex<0x4E>(x, M.lo2); x = cex<0xB1>(x, M.lo1);
    x = cex<0x140>(x, M.lo8); x = cex4(x, M.lo4); x = cex<0x4E>(x, M.lo2); x = cex<0xB1>(x, M.lo1);
    return x;
}
__device__ __forceinline__ unsigned clean16_desc(unsigned x, const LoMasks& M) {
    x = cex<0x128>(x, M.lo8); x = cex4(x, M.lo4); x = cex<0x4E>(x, M.lo2); x = cex<0xB1>(x, M.lo1); return x;
}
__device__ __forceinline__ unsigned mtop_regs(unsigned a, unsigned b) { return max(a, dppm<0x140>(b)); }
__device__ __forceinline__ unsigned mtop_rows(unsigned y, const LoMasks& M) { const auto r = __builtin_amdgcn_permlane16_swap(y, y, false, false); const unsigned pv = M.odd16 ? r[0] : r[1]; return mtop_regs(y, pv); }
__device__ __forceinline__ unsigned mtop_halves(unsigned y, const LoMasks& M) { const auto r = __builtin_amdgcn_permlane32_swap(y, y, false, false); const unsigned pv = M.up32 ? r[0] : r[1]; return mtop_regs(y, pv); }

template <int OFF, int N, int MASKX, int TOT> __device__ __forceinline__ void ce_stage(unsigned (&k)[TOT]) {
#pragma unroll
    for (int i = 0; i < N; ++i) { const int pr = i ^ MASKX; if (pr > i) { const unsigned a_ = k[OFF + i], b_ = k[OFF + pr]; k[OFF + i] = max(a_, b_); k[OFF + pr] = min(a_, b_); } }
}
template <int OFF, int TOT> __device__ __forceinline__ void sort16_regs(unsigned (&k)[TOT]) {
    ce_stage<OFF, 16, 1>(k); ce_stage<OFF, 16, 3>(k); ce_stage<OFF, 16, 1>(k); ce_stage<OFF, 16, 7>(k); ce_stage<OFF, 16, 2>(k); ce_stage<OFF, 16, 1>(k);
    ce_stage<OFF, 16, 15>(k); ce_stage<OFF, 16, 4>(k); ce_stage<OFF, 16, 2>(k); ce_stage<OFF, 16, 1>(k);
}
template <int TOT> __device__ __forceinline__ void clean16_regs(unsigned (&k)[TOT]) { ce_stage<0, 16, 8>(k); ce_stage<0, 16, 4>(k); ce_stage<0, 16, 2>(k); ce_stage<0, 16, 1>(k); }

__device__ __forceinline__ void ph_peer_select(const Args& A, Frame& F, const int L) {
    const bf16* QP = (const bf16*)(A.ws + WS_Z); const bf16* SKB = (const bf16*)(A.ws + WS_SKB) + (size_t)L * 262144;
    int* EID = (int*)(A.ws + WS_LA); float* GSM = (float*)(A.ws + WS_LA + 16 * MiB);
    LAS unsigned char* SKL = F.lds;
    LAS float* SCO = (LAS float*)(F.lds + 69632 + 4096);
    for (int it = F.bx; it < 4096; it += F.G) {
        const int tile = it >> 3, h = it & 7;
        __syncthreads();
        for (int c = F.tid; c < 4096; c += NTHREADS) { const int p = c >> 11, n = (c >> 4) & 127, cc = c & 15;
            *(LAS u32x4*)(SKL + (p * 128 + n) * 272 + cc * 16) = *(const u32x4*)(SKB + ((size_t)((p * 8 + h) * 128 + n)) * 128 + cc * 8); }
        __syncthreads();
        {
            const int p = F.wave >> 2, mt = F.wave & 3, g = F.lane >> 4, l15 = F.lane & 15;
            const bf16* qrow = QP + (size_t)(tile * 64 + mt * 16 + l15) * DM + h * 256 + p * 128 + 8 * g;
            bf16x8 afr[4];
#pragma unroll
            for (int ks = 0; ks < 4; ++ks) afr[ks] = *(const bf16x8*)(qrow + 32 * ks);
#pragma unroll
            for (int nt = 0; nt < 8; ++nt) {
                f32x4 acc = {0.f, 0.f, 0.f, 0.f};
#pragma unroll
                for (int ks = 0; ks < 4; ++ks) { const bf16x8 bfr = *(const LAS bf16x8*)(SKL + (p * 128 + nt * 16 + l15) * 272 + (32 * ks + 8 * g) * 2);
                    acc = __builtin_amdgcn_mfma_f32_16x16x32_bf16(afr[ks], bfr, acc, 0, 0, 0); }
#pragma unroll
                for (int rg = 0; rg < 4; ++rg) SCO[(p * 64 + mt * 16 + 4 * g + rg) * 132 + nt * 16 + l15] = acc[rg];
            }
        }
        __syncthreads();
        constexpr int NT = 4;
        LAS unsigned char* WB = F.lds + 141312 + F.wave * 2048;
        LoMasks M; M.lo1 = (F.lane & 1) == 0; M.lo2 = (F.lane & 2) == 0; M.lo4 = (F.lane & 4) == 0; M.lo8 = (F.lane & 8) == 0; M.odd16 = (F.lane & 16) != 0; M.up32 = (F.lane & 32) != 0;
        int pi_, pj_;
        { const int L = F.lane;
          if (L < 16) { pi_ = 0; pj_ = L; } else if (L < 24) { pi_ = 1; pj_ = L - 16; } else if (L < 29) { pi_ = 2; pj_ = L - 24; } else if (L < 33) { pi_ = 3; pj_ = L - 29; }
          else if (L < 36) { pi_ = 4; pj_ = L - 33; } else if (L < 42) { pi_ = 5 + ((L - 36) >> 1); pj_ = (L - 36) & 1; } else { pi_ = 8 + (L - 42); pj_ = 0; }
          if (L >= 50) { pi_ = 0; pj_ = 0; } }
        const bool pvalid = F.lane < 50;
        {
            const int g = F.lane >> 2, q = F.lane & 3, tok = g >> 1, sp = g & 1;
            const LAS float* srow = SCO + (sp * 64 + F.wave * 8 + tok) * 132;
            unsigned k[32]; const unsigned ib = (unsigned)(127 - q * 32);
#pragma unroll
            for (int c = 0; c < 8; ++c) { const f32x4 v = *(const LAS f32x4*)(srow + q * 32 + 4 * c);
#pragma unroll
                for (int e = 0; e < 4; ++e) k[4 * c + e] = (fixkey20(v[e]) << 7) | (ib - (unsigned)(4 * c + e)); }
            sort16_regs<0>(k); sort16_regs<16>(k);
            unsigned m[16], t2[16];
#pragma unroll
            for (int i = 0; i < 16; ++i) m[i] = max(k[i], k[31 - i]);
            clean16_regs(m);
#pragma unroll
            for (int i = 0; i < 16; ++i) t2[i] = max(m[i], dppm<0xB1>(m[15 - i]));
            clean16_regs(t2);
#pragma unroll
            for (int i = 0; i < 16; ++i) m[i] = max(t2[i], dppm<0x4E>(t2[15 - i]));
            clean16_regs(m);
            float vals[16]; int idxs[16];
#pragma unroll
            for (int e = 0; e < 16; ++e) { idxs[e] = 127 - (int)(m[e] & 127u); vals[e] = srow[idxs[e]]; }
            if (q == 0) { LAS float* tvp = (LAS float*)(WB + tok * 256) + sp * 16; LAS int* tip = (LAS int*)(WB + tok * 256 + 128) + sp * 16;
#pragma unroll
                for (int c = 0; c < 4; ++c) { *(LAS f32x4*)(tvp + 4 * c) = (f32x4){vals[4 * c], vals[4 * c + 1], vals[4 * c + 2], vals[4 * c + 3]};
                    *(LAS u32x4*)(tip + 4 * c) = (u32x4){(unsigned)idxs[4 * c], (unsigned)idxs[4 * c + 1], (unsigned)idxs[4 * c + 2], (unsigned)idxs[4 * c + 3]}; } }
        }
        asm volatile("s_waitcnt lgkmcnt(0)" ::: "memory"); __builtin_amdgcn_wave_barrier();
#pragma unroll 1
        for (int tk0 = 0; tk0 < 8; tk0 += NT) {
            unsigned z[NT];
#pragma unroll
            for (int u = 0; u < NT; ++u) { const LAS float* tv = (const LAS float*)(WB + (tk0 + u) * 256); const float cvl = tv[pi_] + tv[16 + pj_];
                z[u] = pvalid ? ((fixkey20(cvl * 0.5f) << 8) | (unsigned)(255 - (pi_ * 16 + pj_))) : 0u; }
#define ALL4(EXPR) _Pragma("unroll") for (int u = 0; u < NT; ++u) { const unsigned X = z[u]; z[u] = (EXPR); }
#define CLEAN4() ALL4(cex<0x128>(X, M.lo8)) ALL4(cex4(X, M.lo4)) ALL4(cex<0x4E>(X, M.lo2)) ALL4(cex<0xB1>(X, M.lo1))
            ALL4(cex<0xB1>(X, M.lo1))
            ALL4(cex<0x1B>(X, M.lo2)) ALL4(cex<0xB1>(X, M.lo1))
            ALL4(cex<0x141>(X, M.lo4)) ALL4(cex<0x4E>(X, M.lo2)) ALL4(cex<0xB1>(X, M.lo1))
            ALL4(cex<0x140>(X, M.lo8)) ALL4(cex4(X, M.lo4)) ALL4(cex<0x4E>(X, M.lo2)) ALL4(cex<0xB1>(X, M.lo1))
            ALL4(mtop_rows(X, M)) CLEAN4()
            ALL4(mtop_halves(X, M)) CLEAN4()
#undef ALL4
#undef CLEAN4
#pragma unroll
            for (int u = 0; u < NT; ++u) { const int t = tile * 64 + F.wave * 8 + tk0 + u;
                const LAS float* tv = (const LAS float*)(WB + (tk0 + u) * 256); const LAS int* ti = (const LAS int*)(WB + (tk0 + u) * 256 + 128);
                const int cid = 255 - (int)(z[u] & 255u), bi = (F.lane < 16) ? (cid >> 4) : 0, bj = (F.lane < 16) ? (cid & 15) : 0;
                const float bv = (F.lane < 16) ? (tv[bi] + tv[16 + bj]) : -INFINITY;
                const float mx = wmax(bv); const float ev = (F.lane < 16) ? expf(bv - mx) : 0.f; const float den = wsum(ev);
                if (F.lane < 16) { const int e1 = ti[bi], e2 = ti[16 + bj];
                    EID[(size_t)t * 128 + h * 16 + F.lane] = e1 * 128 + e2; GSM[(size_t)t * 128 + h * 16 + F.lane] = ev / den; } }
            asm volatile("s_waitcnt lgkmcnt(0)" ::: "memory"); __builtin_amdgcn_wave_barrier();
        }
    }
}

constexpr int PGB = 4;
__device__ __forceinline__ void ph_peer_gather(const Args& A, Frame& F, const int L, const bool dry = false) {
    bf16* H = (bf16*)(A.ws + WS_HY); bf16* Hout = dry ? (bf16*)(A.ws + WS_BIG + 128 * MiB) : H; float* Xout = dry ? (float*)(A.ws + WS_Z) : A.out; const unsigned char* TU = A.ws + WS_BIG; const unsigned char* TV = TU + (size_t)16384 * 2048; const float* SCL = (const float*)(A.ws + WS_BIG + 64 * MiB);
    const int* EID = (const int*)(A.ws + WS_LA); const float* GSM = (const float*)(A.ws + WS_LA + 16 * MiB);
    const float* MOD = (const float*)(A.ws + WS_MOD); float* X = A.out;
    const float* lng = (const float*)A.in[21] + (size_t)(L * 2 + 1) * DM; const float* lnb = (const float*)A.in[22] + (size_t)(L * 2 + 1) * DM;
    for (int t = F.gw; t < TOK; t += F.ngw) {
        const int b = t >> 14;
        f32x2 h2[16];
#pragma unroll
        for (int j = 0; j < 2; ++j) { const u32x4 a = *(const u32x4*)(H + (size_t)t * DM + (j * 64 + F.lane) * 16), c = *(const u32x4*)(H + (size_t)t * DM + (j * 64 + F.lane) * 16 + 8);
            const unsigned aw[8] = {a.x, a.y, a.z, a.w, c.x, c.y, c.z, c.w};
#pragma unroll
            for (int q = 0; q < 8; ++q) h2[j * 8 + q] = (f32x2){lo2f(aw[q]), hi2f(aw[q])}; }
        f32x2 o2[16];
#pragma unroll
        for (int e = 0; e < 16; ++e) o2[e] = (f32x2){0.f, 0.f};
#pragma unroll 1
        for (int e0 = 0; e0 < 128; e0 += PGB) {
            int eid[PGB]; float gw[PGB], su[PGB], sv[PGB];
#pragma unroll
            for (int q = 0; q < PGB; ++q) { eid[q] = __builtin_amdgcn_readfirstlane(EID[(size_t)t * 128 + e0 + q]); gw[q] = GSM[(size_t)t * 128 + e0 + q]; su[q] = SCL[eid[q]]; sv[q] = SCL[16384 + eid[q]]; }
            u32x4 uu[PGB][2], vv[PGB][2];
#pragma unroll
            for (int q = 0; q < PGB; ++q)
#pragma unroll
                for (int j = 0; j < 2; ++j) { uu[q][j] = *(const u32x4*)(TU + (size_t)eid[q] * 2048 + (j * 64 + F.lane) * 16); vv[q][j] = *(const u32x4*)(TV + (size_t)eid[q] * 2048 + (j * 64 + F.lane) * 16); }
#pragma unroll
            for (int q = 0; q < PGB; ++q) {
                f32x2 d2 = {0.f, 0.f};
#pragma unroll
                for (int j = 0; j < 2; ++j) { const unsigned w[4] = {uu[q][j].x, uu[q][j].y, uu[q][j].z, uu[q][j].w};
#pragma unroll
                    for (int i = 0; i < 4; ++i) { const f32x2 lo = __builtin_amdgcn_cvt_pk_f32_fp8((int)w[i], false), hi = __builtin_amdgcn_cvt_pk_f32_fp8((int)w[i], true);
                        d2 = lo * h2[j * 8 + 2 * i] + d2; d2 = hi * h2[j * 8 + 2 * i + 1] + d2; } }
                const float d = wsum(d2.x + d2.y) * su[q];
                const float act = 0.5f * d * (1.0f + erff(d * 0.70710678f)) * gw[q] * sv[q];
                const f32x2 a2 = {act, act};
#pragma unroll
                for (int j = 0; j < 2; ++j) { const unsigned w[4] = {vv[q][j].x, vv[q][j].y, vv[q][j].z, vv[q][j].w};
#pragma unroll
                    for (int i = 0; i < 4; ++i) { const f32x2 lo = __builtin_amdgcn_cvt_pk_f32_fp8((int)w[i], false), hi = __builtin_amdgcn_cvt_pk_f32_fp8((int)w[i], true);
                        o2[j * 8 + 2 * i] = a2 * lo + o2[j * 8 + 2 * i]; o2[j * 8 + 2 * i + 1] = a2 * hi + o2[j * 8 + 2 * i + 1]; } }
            }
        }
        float out[32];
#pragma unroll
        for (int e = 0; e < 16; ++e) { out[2 * e] = o2[e].x; out[2 * e + 1] = o2[e].y; }
        const float* gate = MOD + (size_t)((L * 2 + 1) * 2 + b) * 6144 + 4096;
        float sum = 0.f;
#pragma unroll
        for (int j = 0; j < 2; ++j)
#pragma unroll
            for (int c = 0; c < 4; ++c) { const int base = (j * 64 + F.lane) * 16 + 4 * c;
                const f32x4 x0 = *(const f32x4*)(X + (size_t)t * DM + base), g0 = *(const f32x4*)(gate + base);
#pragma unroll
                for (int e = 0; e < 4; ++e) { const float v = ALPHA * x0[e] + (1.0f + g0[e]) * out[j * 16 + 4 * c + e]; out[j * 16 + 4 * c + e] = v; sum += v; } }
        const float mean = wsum(sum) * (1.0f / DM); float sq = 0.f;
#pragma unroll
        for (int e = 0; e < 32; ++e) { out[e] -= mean; sq += out[e] * out[e]; }
        const float rstd = rsqrtf(wsum(sq) * (1.0f / DM) + 1e-5f);
        const float* sh = MOD + (size_t)(((L + 1) * 2 + 0) * 2 + b) * 6144; const float* sc = sh + 2048;
#pragma unroll
        for (int j = 0; j < 2; ++j) {
            float hq[16];
#pragma unroll
            for (int c = 0; c < 4; ++c) { const int base = (j * 64 + F.lane) * 16 + 4 * c;
                const f32x4 lg0 = *(const f32x4*)(lng + base), lb0 = *(const f32x4*)(lnb + base);
                f32x4 o0;
#pragma unroll
                for (int e = 0; e < 4; ++e) o0[e] = out[j * 16 + 4 * c + e] * rstd * lg0[e] + lb0[e];
                *(f32x4*)(Xout + (size_t)t * DM + base) = o0;
                if (L == 0) { const f32x4 s0 = *(const f32x4*)(sc + base), h0 = *(const f32x4*)(sh + base);
#pragma unroll
                    for (int e = 0; e < 4; ++e) hq[4 * c + e] = o0[e] * (1.0f + s0[e]) + h0[e]; } }
            if (L == 0) { u32x4 w0, w1;
                w0.x = pk2(hq[0], hq[1]); w0.y = pk2(hq[2], hq[3]); w0.z = pk2(hq[4], hq[5]); w0.w = pk2(hq[6], hq[7]);
                w1.x = pk2(hq[8], hq[9]); w1.y = pk2(hq[10], hq[11]); w1.z = pk2(hq[12], hq[13]); w1.w = pk2(hq[14], hq[15]);
                *(u32x4*)(Hout + (size_t)t * DM + (j * 64 + F.lane) * 16) = w0; *(u32x4*)(Hout + (size_t)t * DM + (j * 64 + F.lane) * 16 + 8) = w1; }
        }
    }
}

struct XInfo { int rank, nloc, rx, nx; };
__device__ __forceinline__ XInfo xcc_info(volatile LAS unsigned* MISC) { XInfo x; x.rank = (int)MISC[16]; x.nloc = (int)MISC[17]; x.rx = (int)MISC[18]; x.nx = (int)MISC[19]; return x; }
constexpr size_t WS_DP = WS_BIG + 128 * MiB;
constexpr size_t WS_ACT = WS_BIG + 80 * MiB;
__device__ __forceinline__ void ph_peer_u(const Args& A, Frame& F, const XInfo X) {
    const unsigned char* H8 = A.ws + WS_H8; const unsigned char* TU = A.ws + WS_BIG; const int* EID = (const int*)(A.ws + WS_LA); float* DP = (float*)(A.ws + WS_DP);
    LAS int* IDX = (LAS int*)(F.lds + F.wave * 1024);
    const int g16 = F.lane >> 4, c16 = F.lane & 15; const int step = X.nloc * NWAVES;
    for (int s = X.rx; s < 8; s += X.nx) {
        int t = X.rank * NWAVES + F.wave;
        int e0 = 0, e1 = 0; u32x4 ha = {0u, 0u, 0u, 0u};
        if (t < TOK) { e0 = EID[(size_t)t * 128 + F.lane]; e1 = EID[(size_t)t * 128 + 64 + F.lane]; ha = *(const u32x4*)(H8 + (size_t)t * DM + 256 * s + 16 * c16); }
        const unsigned char* ub = TU + 256 * s + 16 * c16;
        while (t < TOK) {
            const int tn = t + step; int n0 = 0, n1 = 0; u32x4 na = {0u, 0u, 0u, 0u};
            if (tn < TOK) { n0 = EID[(size_t)tn * 128 + F.lane]; n1 = EID[(size_t)tn * 128 + 64 + F.lane]; na = *(const u32x4*)(H8 + (size_t)tn * DM + 256 * s + 16 * c16); }
            IDX[F.lane] = e0; IDX[F.lane + 64] = e1;
            asm volatile("s_waitcnt lgkmcnt(0)" ::: "memory"); __builtin_amdgcn_wave_barrier();
            float keep0 = 0.f, keep1 = 0.f;
#pragma unroll
            for (int i0 = 0; i0 < 32; i0 += 8) {
                u32x4 ud[8];
#pragma unroll
                for (int u = 0; u < 8; ++u) { const int eid = IDX[4 * (i0 + u) + g16]; ud[u] = *(const u32x4*)(ub + (size_t)eid * 2048); }
#pragma unroll
                for (int u = 0; u < 8; ++u) {
                    int di = __builtin_amdgcn_sdot4((int)ud[u].x, (int)ha.x, 0, false); di = __builtin_amdgcn_sdot4((int)ud[u].y, (int)ha.y, di, false);
                    di = __builtin_amdgcn_sdot4((int)ud[u].z, (int)ha.z, di, false); di = __builtin_amdgcn_sdot4((int)ud[u].w, (int)ha.w, di, false);
                    const float d = sum16_dpp((float)di);
                    const int i = i0 + u;
                    if (i < 16) keep0 = ((i & 15) == c16) ? d : keep0; else keep1 = ((i & 15) == c16) ? d : keep1;
                }
            }
            float* dp = DP + ((size_t)s * TOK + t) * 128 + 4 * c16 + g16;
            dp[0] = keep0; dp[64] = keep1;
            asm volatile("s_waitcnt lgkmcnt(0)" ::: "memory"); __builtin_amdgcn_wave_barrier();
            e0 = n0; e1 = n1; ha = na; t = tn;
        }
    }
}
__device__ __forceinline__ void ph_peer_act(const Args& A, Frame& F) {
    const float* SCL = (const float*)(A.ws + WS_BIG + 64 * MiB); const int* EID = (const int*)(A.ws + WS_LA); const float* GSM = (const float*)(A.ws + WS_LA + 16 * MiB);
    const float* DP = (const float*)(A.ws + WS_DP); unsigned char* ACT8 = A.ws + WS_ACT; float* AS = (float*)(A.ws + WS_ACT + 8 * MiB);
    for (int t = F.gw; t < TOK; t += F.ngw) { const float hs = ((const float*)(A.ws + WS_HS))[t];
        float a[2];
#pragma unroll
        for (int m = 0; m < 2; ++m) { const int e = F.lane + 64 * m; const int eid = EID[(size_t)t * 128 + e]; float d = 0.f;
#pragma unroll
            for (int x = 0; x < 8; ++x) d += DP[((size_t)x * TOK + t) * 128 + e];
            d *= SCL[eid] * hs;
            a[m] = 0.5f * d * (1.0f + erff(d * 0.70710678f)) * GSM[(size_t)t * 128 + e] * SCL[16384 + eid]; }
        const float amax = wmax(fmaxf(fabsf(a[0]), fabsf(a[1]))); const float inv = (amax > 0.f) ? 127.0f / amax : 0.f;
#pragma unroll
        for (int m = 0; m < 2; ++m) ACT8[(size_t)t * 128 + F.lane + 64 * m] = (unsigned char)(__float_as_uint(a[m] * inv + 12582912.0f) & 255u);
        if (F.lane == 0) AS[t] = amax * (1.0f / 127.0f);
    }
}
__device__ __forceinline__ void ph_peer_v(const Args& A, Frame& F, const XInfo X) {
    const unsigned char* TV = A.ws + WS_BIG + (size_t)16384 * 2048;
    const int* EID = (const int*)(A.ws + WS_LA); const unsigned* ACT8 = (const unsigned*)(A.ws + WS_ACT); const float* AS = (const float*)(A.ws + WS_ACT + 8 * MiB); bf16* OUT = (bf16*)(A.ws + WS_Z);
    LAS int* IDX = (LAS int*)(F.lds + F.wave * 1024); LAS unsigned* ACT = (LAS unsigned*)(F.lds + F.wave * 1024 + 512);
    const int g16 = F.lane >> 4, c16 = F.lane & 15; const int step = X.nloc * NWAVES;
    for (int s = X.rx; s < 8; s += X.nx) {
        int t = X.rank * NWAVES + F.wave;
        int e0 = 0, e1 = 0; unsigned a0 = 0u;
        if (t < TOK) { e0 = EID[(size_t)t * 128 + F.lane]; e1 = EID[(size_t)t * 128 + 64 + F.lane]; a0 = ACT8[(size_t)t * 32 + (F.lane & 31)]; }
        const unsigned char* vb = TV + 256 * s + 16 * c16;
        while (t < TOK) {
            const int tn = t + step; int n0 = 0, n1 = 0; unsigned b0 = 0u;
            if (tn < TOK) { n0 = EID[(size_t)tn * 128 + F.lane]; n1 = EID[(size_t)tn * 128 + 64 + F.lane]; b0 = ACT8[(size_t)tn * 32 + (F.lane & 31)]; }
            const float as = AS[t];
            IDX[F.lane] = e0; IDX[F.lane + 64] = e1; if (F.lane < 32) ACT[F.lane] = a0;
            asm volatile("s_waitcnt lgkmcnt(0)" ::: "memory"); __builtin_amdgcn_wave_barrier();
            int acc[16];
#pragma unroll
            for (int j = 0; j < 16; ++j) acc[j] = 0;
#pragma unroll
            for (int b = 0; b < 8; b += 2) {
                u32x4 vd[2][4]; unsigned a4[2];
#pragma unroll
                for (int h = 0; h < 2; ++h) { a4[h] = ACT[4 * (b + h) + g16];
#pragma unroll
                    for (int u = 0; u < 4; ++u) { const int eid = IDX[16 * (b + h) + 4 * g16 + u]; vd[h][u] = *(const u32x4*)(vb + (size_t)eid * 2048); } }
#pragma unroll
                for (int h = 0; h < 2; ++h)
#pragma unroll
                    for (int q = 0; q < 4; ++q) { const unsigned A_ = vd[h][0][q], B_ = vd[h][1][q], C_ = vd[h][2][q], D_ = vd[h][3][q];
                        const unsigned ablo = __builtin_amdgcn_perm(B_, A_, 0x05010400u), abhi = __builtin_amdgcn_perm(B_, A_, 0x07030602u);
                        const unsigned cdlo = __builtin_amdgcn_perm(D_, C_, 0x05010400u), cdhi = __builtin_amdgcn_perm(D_, C_, 0x07030602u);
                        acc[4 * q + 0] = __builtin_amdgcn_sdot4((int)__builtin_amdgcn_perm(cdlo, ablo, 0x05040100u), (int)a4[h], acc[4 * q + 0], false);
                        acc[4 * q + 1] = __builtin_amdgcn_sdot4((int)__builtin_amdgcn_perm(cdlo, ablo, 0x07060302u), (int)a4[h], acc[4 * q + 1], false);
                        acc[4 * q + 2] = __builtin_amdgcn_sdot4((int)__builtin_amdgcn_perm(cdhi, abhi, 0x05040100u), (int)a4[h], acc[4 * q + 2], false);
                        acc[4 * q + 3] = __builtin_amdgcn_sdot4((int)__builtin_amdgcn_perm(cdhi, abhi, 0x07060302u), (int)a4[h], acc[4 * q + 3], false); }
            }
            { const float r0 = rsum4((float)acc[0], (float)acc[4], (float)acc[8], (float)acc[12]) * as, r1 = rsum4((float)acc[1], (float)acc[5], (float)acc[9], (float)acc[13]) * as;
              const float r2 = rsum4((float)acc[2], (float)acc[6], (float)acc[10], (float)acc[14]) * as, r3 = rsum4((float)acc[3], (float)acc[7], (float)acc[11], (float)acc[15]) * as;
              u32x2 w; w.x = pk2(r0, r1); w.y = pk2(r2, r3); *(u32x2*)(OUT + (size_t)t * DM + 256 * s + 16 * c16 + 4 * g16) = w; }
            asm volatile("s_waitcnt lgkmcnt(0)" ::: "memory"); __builtin_amdgcn_wave_barrier();
            e0 = n0; e1 = n1; a0 = b0; t = tn;
        }
    }
}
__device__ __forceinline__ void ph_peer_ln(const Args& A, Frame& F, const int L) {
    const bf16* OUT = (const bf16*)(A.ws + WS_Z); float* X = A.out; bf16* H = (bf16*)(A.ws + WS_HY); const float* MOD = (const float*)(A.ws + WS_MOD);
    const float* lng = (const float*)A.in[21] + (size_t)(L * 2 + 1) * DM; const float* lnb = (const float*)A.in[22] + (size_t)(L * 2 + 1) * DM;
    for (int t = F.gw; t < TOK; t += F.ngw) {
        const int b = t >> 14;
        const float* gate = MOD + (size_t)((L * 2 + 1) * 2 + b) * 6144 + 4096;
        const float* sh = MOD + (size_t)(((L + 1) * 2 + 0) * 2 + b) * 6144; const float* sc = sh + 2048;
        float v[32]; float sum = 0.f;
#pragma unroll
        for (int j = 0; j < 8; ++j) { const int base = (j * 64 + F.lane) * 4;
            const u32x2 ow = *(const u32x2*)(OUT + (size_t)t * DM + base); const f32x4 o0 = {lo2f(ow.x), hi2f(ow.x), lo2f(ow.y), hi2f(ow.y)};
            const f32x4 x0 = *(const f32x4*)(X + (size_t)t * DM + base), g0 = *(const f32x4*)(gate + base);
#pragma unroll
            for (int e = 0; e < 4; ++e) { v[j * 4 + e] = ALPHA * x0[e] + (1.0f + g0[e]) * o0[e]; sum += v[j * 4 + e]; } }
        const float mean = wsum(sum) * (1.0f / DM); float sq = 0.f;
#pragma unroll
        for (int e = 0; e < 32; ++e) { v[e] -= mean; sq += v[e] * v[e]; }
        const float rstd = rsqrtf(wsum(sq) * (1.0f / DM) + 1e-5f);
#pragma unroll
        for (int j = 0; j < 8; ++j) { const int base = (j * 64 + F.lane) * 4;
            const f32x4 lg0 = *(const f32x4*)(lng + base), lb0 = *(const f32x4*)(lnb + base);
            f32x4 o0;
#pragma unroll
            for (int e = 0; e < 4; ++e) o0[e] = v[j * 4 + e] * rstd * lg0[e] + lb0[e];
            *(f32x4*)(X + (size_t)t * DM + base) = o0;
            if (L == 0) { const f32x4 s0 = *(const f32x4*)(sc + base), h0 = *(const f32x4*)(sh + base); const f32x4 q0 = o0 * (1.0f + s0) + h0;
                u32x2 w; w.x = pk2(q0[0], q0[1]); w.y = pk2(q0[2], q0[3]); *(u32x2*)(H + (size_t)t * DM + base) = w; }
        }
    }
}

__device__ __forceinline__ void ph_odd_post(const Args& A, Frame& F) {
    bf16* Z = (bf16*)(A.ws + WS_Z); const int* positions = (const int*)A.in[2]; bf16* KIT = (bf16*)(A.ws + WS_BIG + 256 * MiB); unsigned char* K8 = A.ws + WS_BIG + 264 * MiB; unsigned char* V8 = A.ws + WS_BIG + 280 * MiB;
    const float inv128 = powf(10000.0f, -(float)F.lane / 64.0f); const int i32 = F.lane & 31; const float inv64 = powf(10000.0f, -(float)i32 / 32.0f);
    const int a16 = F.lane & 15, hs4 = F.lane >> 4, a8 = F.lane & 7, hs8 = F.lane >> 3;
    for (int t = F.gw; t < TOK; t += F.ngw) {
        bf16* zr = Z + (size_t)t * OD_NP; const float pos = (float)positions[t];
        const int bb = t >> 14, spos = t & (SEQ - 1);
        float sn, cs; sincosf(pos * inv128, &sn, &cs);
        float c4[4], s4[4];
#pragma unroll
        for (int e = 0; e < 4; ++e) { c4[e] = __shfl(cs, 4 * a16 + e); s4[e] = __shfl(sn, 4 * a16 + e); }
#pragma unroll
        for (int it = 0; it < 5; ++it) { const int hd = it * 4 + hs4; bf16* hp = zr + hd * 128 + 4 * a16;
            const u32x2 a = *(const u32x2*)hp, b = *(const u32x2*)(hp + 64);
            const float t1[4] = {lo2f(a.x), hi2f(a.x), lo2f(a.y), hi2f(a.y)}, t2[4] = {lo2f(b.x), hi2f(b.x), lo2f(b.y), hi2f(b.y)};
            float o1[4], o2[4];
#pragma unroll
            for (int e = 0; e < 4; ++e) { o1[e] = t1[e] * c4[e] - t2[e] * s4[e]; o2[e] = t2[e] * c4[e] + t1[e] * s4[e]; }
            *(u32x2*)hp = (u32x2){pk2(o1[0], o1[1]), pk2(o1[2], o1[3])}; *(u32x2*)(hp + 64) = (u32x2){pk2(o2[0], o2[1]), pk2(o2[2], o2[3])};
            if (it == 4) { unsigned char* k8 = K8 + ((size_t)((bb * 4 + hs4) * SEQ + spos)) * 128 + 4 * a16;
                int w1 = __builtin_amdgcn_cvt_pk_fp8_f32(o1[0] * 16.0f, o1[1] * 16.0f, 0, false); w1 = __builtin_amdgcn_cvt_pk_fp8_f32(o1[2] * 16.0f, o1[3] * 16.0f, w1, true);
                int w2 = __builtin_amdgcn_cvt_pk_fp8_f32(o2[0] * 16.0f, o2[1] * 16.0f, 0, false); w2 = __builtin_amdgcn_cvt_pk_fp8_f32(o2[2] * 16.0f, o2[3] * 16.0f, w2, true);
                *(unsigned*)k8 = (unsigned)w1; *(unsigned*)(k8 + 64) = (unsigned)w2; } }
        {
            const int e0 = F.lane * 8, kvh = e0 >> 7, d0 = e0 & 127;
            const u32x4 vw = *(const u32x4*)(zr + 2560 + e0);
            const unsigned ww[4] = {vw.x, vw.y, vw.z, vw.w}; unsigned ob[2] = {0u, 0u};
#pragma unroll
            for (int q = 0; q < 4; ++q) { const float c0 = fminf(fmaxf(lo2f(ww[q]) * 16.0f, -127.0f), 127.0f), c1 = fminf(fmaxf(hi2f(ww[q]) * 16.0f, -127.0f), 127.0f);
                const unsigned b0 = __float_as_uint(c0 + 12583040.0f) & 255u, b1 = __float_as_uint(c1 + 12583040.0f) & 255u;
                ob[q >> 1] |= (b0 | (b1 << 8)) << (16 * (q & 1)); }
            *(u32x2*)(V8 + ((size_t)((bb * 4 + kvh) * SEQ + spos)) * 128 + d0) = (u32x2){ob[0], ob[1]};
        }
        sincosf(pos * inv64, &sn, &cs);
#pragma unroll
        for (int e = 0; e < 4; ++e) { c4[e] = __shfl(cs, 4 * a8 + e); s4[e] = __shfl(sn, 4 * a8 + e); }
#pragma unroll
        for (int it = 0; it < 3; ++it) { const int hd = it * 8 + hs8; if (hd < 17) { bf16* hp = zr + 3072 + hd * 64 + 4 * a8;
            const u32x2 a = *(const u32x2*)hp, b = *(const u32x2*)(hp + 32);
            const float t1[4] = {lo2f(a.x), hi2f(a.x), lo2f(a.y), hi2f(a.y)}, t2[4] = {lo2f(b.x), hi2f(b.x), lo2f(b.y), hi2f(b.y)};
            float o1[4], o2[4];
#pragma unroll
            for (int e = 0; e < 4; ++e) { o1[e] = t1[e] * c4[e] - t2[e] * s4[e]; o2[e] = t2[e] * c4[e] + t1[e] * s4[e]; }
            const u32x2 w1 = {pk2(o1[0], o1[1]), pk2(o1[2], o1[3])}, w2 = {pk2(o2[0], o2[1]), pk2(o2[2], o2[3])};
            *(u32x2*)hp = w1; *(u32x2*)(hp + 32) = w2;
            if (hd == 16) {
                const int tile = spos >> 5, rr = spos & 31;
                bf16* kt = KIT + ((size_t)(bb * 512 + tile) * 4) * 512;
                const int d1 = 4 * a8, d2 = 32 + 4 * a8;
                *(u32x2*)(kt + ((d1 >> 4) * 64 + rr + 32 * ((d1 >> 3) & 1)) * 8 + (d1 & 7)) = w1;
                *(u32x2*)(kt + ((d2 >> 4) * 64 + rr + 32 * ((d2 >> 3) & 1)) * 8 + (d2 & 7)) = w2;
            } } }
    }
}

template <int CTRL, int RM> __device__ __forceinline__ unsigned dppu(unsigned old, unsigned v) { return (unsigned)__builtin_amdgcn_update_dpp((int)old, (int)v, CTRL, RM, 0xF, false); }
__device__ __forceinline__ void ph_dsa_select(const Args& A, Frame& F, const int mode = 0) {
    const bf16* Z = (const bf16*)(A.ws + WS_Z); unsigned short* SEL = (unsigned short*)(A.ws + WS_LA); int* CNT = (int*)(A.ws + WS_CNT); const bf16* KIT = (const bf16*)(A.ws + WS_BIG + 256 * MiB);
    LAS unsigned short* SC = (LAS unsigned short*)F.lds;
    LAS unsigned* LST = (LAS unsigned*)(F.lds + 131072);
    LAS unsigned* hist = (LAS unsigned*)(F.lds + 131072 + 16384);
    LAS unsigned* hist1 = (LAS unsigned*)(F.lds + 152576);
    LAS unsigned* res = (LAS unsigned*)(F.lds + 131072 + 16384 + 2048);
    LAS int* wtot = (LAS int*)(F.lds + 131072 + 16384 + 2048 + 64);
    const int r = F.lane & 31, hg = F.lane >> 5, tk = (r >> 2) & 1, hh = (r & 3) + 4 * (r >> 3);
    const int grp = F.wave >> 2, ltid = F.tid & 255, lw = F.wave & 3;
    for (int qd = F.bx; qd < TOK / 4; qd += F.G) {
        const int t0 = 4 * qd, b = t0 >> 14, s0 = t0 & (SEQ - 1);
        const int nkeys = s0 + 4, ntiles = (nkeys + 31) >> 5;
        bf16x8 af[2][4]; f32x2 wv[2][8];
#pragma unroll
        for (int a = 0; a < 2; ++a) {
            const bf16* qrow = Z + (size_t)(t0 + 2 * a + tk) * OD_NP + 3072 + hh * 64 + 8 * hg;
#pragma unroll
            for (int s = 0; s < 4; ++s) af[a][s] = *(const bf16x8*)(qrow + 16 * s);
            const bf16* wrow = Z + (size_t)(t0 + 2 * a + hg) * OD_NP + 4160;
            const u32x4 w0 = *(const u32x4*)(wrow), w1 = *(const u32x4*)(wrow + 8);
            const unsigned ww[8] = {w0.x, w0.y, w0.z, w0.w, w1.x, w1.y, w1.z, w1.w};
#pragma unroll
            for (int q = 0; q < 8; ++q) wv[a][q] = (f32x2){lo2f(ww[q]) * 0.03125f, hi2f(ww[q]) * 0.03125f};
        }
        __syncthreads();
        const bf16* kbase = KIT + (size_t)b * 512 * 2048 + F.lane * 8;
        if (mode != 2) {
            bf16x8 bcur[2][4];
#define DSA_LOAD1(dst, q_, tb_) do { const int tile = ((tb_) + (q_) < ntiles) ? ((tb_) + (q_)) : (ntiles - 1); const bf16* krow = kbase + (size_t)tile * 2048; \
                _Pragma("unroll") for (int s_ = 0; s_ < 4; ++s_) dst[q_][s_] = *(const bf16x8*)(krow + 512 * s_); } while (0)
#define DSA_MM(accv, src, q_, a_) do { _Pragma("unroll") for (int e = 0; e < 16; ++e) accv[e] = 0.f; \
                _Pragma("unroll") for (int s_ = 0; s_ < 4; ++s_) accv = __builtin_amdgcn_mfma_f32_32x32x16_bf16(af[a_][s_], src[q_][s_], accv, 0, 0, 0); } while (0)
#define DSA_EPI(accv, tb_, q_, a_) do { f32x2 s2_ = {0.f, 0.f}; _Pragma("unroll") for (int e = 0; e < 8; ++e) { \
                    const float x0_ = accv[2 * e], x1_ = accv[2 * e + 1]; const int r0_ = __builtin_bit_cast(int, x0_), r1_ = __builtin_bit_cast(int, x1_);        \
                    const f32x2 rl_ = {__builtin_bit_cast(float, r0_ > 0 ? r0_ : 0), __builtin_bit_cast(float, r1_ > 0 ? r1_ : 0)}; s2_ = rl_ * wv[a_][e] + s2_; } \
                float sc_ = s2_.x + s2_.y; const int key = ((tb_) + (q_)) * 32 + r; sc_ = fminf(fmaxf(sc_, -7.999f), 7.999f); const unsigned fx = (unsigned)((int)rintf(sc_ * 4096.0f) + (1 << 15)); \
                if ((tb_) + (q_) < ntiles) SC[(2 * (a_) + hg) * 16384 + key] = (unsigned short)((key <= s0 + 2 * (a_) + hg) ? fx : 0u); } while (0)
            int tb = F.wave * 2;
            if (tb < ntiles) {
                DSA_LOAD1(bcur, 0, tb); DSA_LOAD1(bcur, 1, tb);
                for (; tb < ntiles; tb += NWAVES * 2) {
                    f32x16 accA, accB;
                    DSA_MM(accA, bcur, 0, 0); DSA_MM(accB, bcur, 0, 1);
                    DSA_LOAD1(bcur, 0, tb + NWAVES * 2);
                    DSA_EPI(accA, tb, 0, 0); DSA_MM(accA, bcur, 1, 0); DSA_EPI(accB, tb, 0, 1); DSA_MM(accB, bcur, 1, 1);
                    DSA_LOAD1(bcur, 1, tb + NWAVES * 2);
                    DSA_EPI(accA, tb, 1, 0); DSA_EPI(accB, tb, 1, 1);
                }
            }
#undef DSA_LOAD1
#undef DSA_MM
#undef DSA_EPI
        }
        __syncthreads();
        if (mode == 1) continue;
#pragma unroll 1
        for (int rd = 0; rd < 2; ++rd) {
        const int tok = 2 * rd + grp;
        const int n = s0 + tok + 1; unsigned k = (unsigned)(n < 256 ? n : 256); unsigned prefix = 0u;
        const LAS unsigned short* sc = SC + tok * 16384;
        hist[grp * 256 + ltid] = 0u; hist1[grp * 256 + ltid] = 0u;
        unsigned kreg[64];
#pragma unroll
        for (int j = 0; j < 64; ++j) { const int i = ltid + 256 * j; kreg[j] = (i < n) ? (unsigned)sc[i] : 0u; }
        unsigned lmax = 0u;
#pragma unroll
        for (int j = 0; j < 64; ++j) lmax = (kreg[j] > lmax) ? kreg[j] : lmax;
        unsigned wmin = lmax;
        { unsigned x_;
          x_ = dppu<0xB1, 0xF>(wmin, wmin); wmin = x_ < wmin ? x_ : wmin; x_ = dppu<0x4E, 0xF>(wmin, wmin); wmin = x_ < wmin ? x_ : wmin;
          x_ = dppu<0x141, 0xF>(wmin, wmin); wmin = x_ < wmin ? x_ : wmin; x_ = dppu<0x140, 0xF>(wmin, wmin); wmin = x_ < wmin ? x_ : wmin;
          x_ = dppu<0x142, 0xA>(wmin, wmin); wmin = x_ < wmin ? x_ : wmin; x_ = dppu<0x143, 0xC>(wmin, wmin); wmin = x_ < wmin ? x_ : wmin; }
        if (F.lane == 63) wtot[16 + F.wave] = (int)wmin;
        __syncthreads();
        unsigned lbound = 0xFFFFFFFFu;
#pragma unroll
        for (int w = 0; w < 4; ++w) { const unsigned x = (unsigned)wtot[16 + grp * 4 + w]; lbound = x < lbound ? x : lbound; }
        LAS unsigned* seg = LST + (grp * 4 + lw) * 512; int ccnt = 0;
        {
#pragma unroll
            for (int j = 0; j < 64; ++j) { if (256 * j < n) { const bool c = ((ltid + 256 * j) < n) && (kreg[j] >= lbound); const unsigned long long m = __ballot(c);
                const int pos = ccnt + (int)__builtin_amdgcn_mbcnt_hi((unsigned)(m >> 32), __builtin_amdgcn_mbcnt_lo((unsigned)m, 0u));
                if (c && pos < 512) seg[pos] = (kreg[j] << 16) | (unsigned)(ltid + 256 * j); ccnt += __popcll(m); } }
        }
        const bool fast = ccnt <= 512;
        asm volatile("s_waitcnt lgkmcnt(0)" ::: "memory"); __builtin_amdgcn_wave_barrier();
#pragma unroll 1
        for (int pass = 0; pass < 2; ++pass) {
            const int shift = 8 - 8 * pass;
            LAS unsigned* hs = (pass == 0 ? hist : hist1) + grp * 256;
            if (fast) {
#pragma unroll
                for (int i = 0; i < 8; ++i) { if (64 * i < ccnt) { const int c_ = F.lane + 64 * i; const bool valid = c_ < ccnt; const unsigned kv = valid ? (seg[c_] >> 16) : 0u;
                    const bool match = (pass == 0) ? true : ((kv >> 8) == prefix);
                    if (valid && match) (void)__hip_atomic_fetch_add(&hs[(kv >> shift) & 255u], 1u, __ATOMIC_RELAXED, __HIP_MEMORY_SCOPE_WORKGROUP); } }
            } else {
#pragma unroll
                for (int j = 0; j < 64; ++j) { if (256 * j < n) { const unsigned kv = kreg[j]; const bool valid = ((ltid + 256 * j) < n) && (kv >= lbound);
                    const bool match = (pass == 0) ? true : ((kv >> 8) == prefix);
                    if (valid && match) (void)__hip_atomic_fetch_add(&hs[(kv >> shift) & 255u], 1u, __ATOMIC_RELAXED, __HIP_MEMORY_SCOPE_WORKGROUP); } }
            }
            __syncthreads();
            if (lw == 0) {
                const unsigned c0 = hs[4 * F.lane], c1 = hs[4 * F.lane + 1], c2 = hs[4 * F.lane + 2], c3 = hs[4 * F.lane + 3];
                const unsigned tot = c0 + c1 + c2 + c3; unsigned pre = tot;
                pre += dppu<0x111, 0xF>(0u, pre); pre += dppu<0x112, 0xF>(0u, pre); pre += dppu<0x114, 0xF>(0u, pre); pre += dppu<0x118, 0xF>(0u, pre);
                pre += dppu<0x142, 0xA>(0u, pre); pre += dppu<0x143, 0xC>(0u, pre);
                const unsigned total = (unsigned)__builtin_amdgcn_readlane((int)pre, 63); const unsigned suf = total - pre + tot;
                unsigned above = suf - tot;
                if (above < k && k <= suf) {
                    int bin;
                    if (above + c3 >= k) { bin = 3; } else { above += c3; if (above + c2 >= k) { bin = 2; } else { above += c2; if (above + c1 >= k) { bin = 1; } else { above += c1; bin = 0; } } }
                    res[grp * 2 + 0] = (unsigned)(4 * F.lane + bin); res[grp * 2 + 1] = k - above;
                }
            }
            __syncthreads();
            prefix = (prefix << 8) | res[grp * 2 + 0]; k = res[grp * 2 + 1];
        }
        const unsigned tau = prefix; const int krem = (int)k;
#define MBCNT(m_) ((int)__builtin_amdgcn_mbcnt_hi((unsigned)((m_) >> 32), __builtin_amdgcn_mbcnt_lo((unsigned)(m_), 0u)))
        int cgW = 0, ceW = 0;
        if (fast) {
#pragma unroll
            for (int i = 0; i < 8; ++i) { if (64 * i < ccnt) { const int c_ = F.lane + 64 * i; const bool valid = c_ < ccnt; const unsigned kv = valid ? (seg[c_] >> 16) : 0u;
                cgW += __popcll(__ballot(valid && kv > tau)); ceW += __popcll(__ballot(valid && kv == tau)); } }
        } else {
#pragma unroll
            for (int j = 0; j < 64; ++j) { if (256 * j < n) { const bool valid = (ltid + 256 * j) < n; const unsigned kv = kreg[j];
                cgW += __popcll(__ballot(valid && kv > tau)); ceW += __popcll(__ballot(valid && kv == tau)); } }
        }
        if (F.lane == 0) { wtot[F.wave * 2] = cgW; wtot[F.wave * 2 + 1] = ceW; }
        __syncthreads();
        int og = 0, oe = 0, totg = 0;
        for (int w = 0; w < 4; ++w) { const int a = wtot[(grp * 4 + w) * 2], e = wtot[(grp * 4 + w) * 2 + 1]; if (w < lw) { og += a; oe += e; } totg += a; }
        LAS unsigned short* sel = (LAS unsigned short*)(F.lds + 151552) + grp * 256;
        if (fast) {
#pragma unroll
            for (int i = 0; i < 8; ++i) { if (64 * i < ccnt) { const int c_ = F.lane + 64 * i; const bool valid = c_ < ccnt; const unsigned pk = valid ? seg[c_] : 0u; const unsigned kv = pk >> 16;
                const bool gt = valid && kv > tau, eq = valid && kv == tau; const unsigned long long mg = __ballot(gt), me = __ballot(eq);
                const int pg = og + MBCNT(mg), pe = oe + MBCNT(me);
                if (gt) sel[pg] = (unsigned short)(pk & 0xffffu); else if (eq && pe < krem) sel[totg + pe] = (unsigned short)(pk & 0xffffu);
                og += __popcll(mg); oe += __popcll(me); } }
        } else {
#pragma unroll
            for (int j = 0; j < 64; ++j) { if (256 * j < n) { const int i = ltid + 256 * j; const bool valid = i < n; const unsigned kv = kreg[j];
                const bool gt = valid && kv > tau, eq = valid && kv == tau; const unsigned long long mg = __ballot(gt), me = __ballot(eq);
                const int pg = og + MBCNT(mg), pe = oe + MBCNT(me);
                if (gt) sel[pg] = (unsigned short)i; else if (eq && pe < krem) sel[totg + pe] = (unsigned short)i;
                og += __popcll(mg); oe += __popcll(me); } }
        }
#undef MBCNT
        if (ltid == 0) CNT[t0 + tok] = (n < 256 ? n : 256);
        __syncthreads();
        if (ltid < 128) { int lt2 = ltid; asm volatile("" : "+v"(lt2));
            ((unsigned*)SEL)[(size_t)(t0 + 2 * rd + grp) * 128 + lt2] = ((const LAS unsigned*)(F.lds + 151552))[grp * 128 + lt2]; }
        }
    }
}

__device__ __forceinline__ float sum8_dpp(float v) { v += dppf<0xB1, 0xF>(v); v += dppf<0x4E, 0xF>(v); v += dppf<0x141, 0xF>(v); return v; }
__device__ __forceinline__ void ph_dsa_attn(const Args& A, Frame& F, const XInfo X) {
    const bf16* Z = (const bf16*)(A.ws + WS_Z); const unsigned short* SEL = (const unsigned short*)(A.ws + WS_LA); const int* CNT = (const int*)(A.ws + WS_CNT);
    const unsigned char* K8 = A.ws + WS_BIG + 264 * MiB; const unsigned char* V8 = A.ws + WS_BIG + 280 * MiB; bf16* Y = (bf16*)(A.ws + WS_HY);
    LAS int* IDX = (LAS int*)(F.lds + F.wave * 5120);
    LAS float* SCR = (LAS float*)(F.lds + F.wave * 5120 + 1024);
    const int g8 = F.lane >> 3, c8 = F.lane & 7;
    for (int sl = X.rx; sl < 8; sl += X.nx) {
        const int b = sl >> 2, kvh = sl & 3;
        const unsigned char* kb = K8 + (size_t)sl * SEQ * 128 + 16 * c8; const unsigned char* vb = V8 + (size_t)sl * SEQ * 128 + 16 * c8;
        for (int sq = X.rank * NWAVES + F.wave; sq < SEQ; sq += X.nloc * NWAVES) {
            const int t = b * SEQ + sq; const int n = CNT[t];
            const int l15 = F.lane & 15, g4 = F.lane >> 4;
            long bq[4];
#pragma unroll
            for (int c = 0; c < 2; ++c) {
                float f[16];
#pragma unroll
                for (int e = 0; e < 16; ++e) f[e] = 0.f;
                if (l15 < 4) { const bf16* qp = Z + (size_t)t * OD_NP + (kvh * 4 + l15) * 128 + 64 * c + 16 * g4; const u32x4 a = *(const u32x4*)qp, b2 = *(const u32x4*)(qp + 8);
                    const unsigned aw[8] = {a.x, a.y, a.z, a.w, b2.x, b2.y, b2.z, b2.w};
#pragma unroll
                    for (int q = 0; q < 8; ++q) { f[2 * q] = lo2f(aw[q]) * 16.0f; f[2 * q + 1] = hi2f(aw[q]) * 16.0f; } }
#pragma unroll
                for (int hf = 0; hf < 2; ++hf) {
                    int lo = __builtin_amdgcn_cvt_pk_fp8_f32(f[8 * hf + 0], f[8 * hf + 1], 0, false); lo = __builtin_amdgcn_cvt_pk_fp8_f32(f[8 * hf + 2], f[8 * hf + 3], lo, true);
                    int hi = __builtin_amdgcn_cvt_pk_fp8_f32(f[8 * hf + 4], f[8 * hf + 5], 0, false); hi = __builtin_amdgcn_cvt_pk_fp8_f32(f[8 * hf + 6], f[8 * hf + 7], hi, true);
                    bq[2 * c + hf] = (long)(((unsigned long long)(unsigned)hi << 32) | (unsigned long long)(unsigned)lo); }
            }
#pragma unroll
            for (int m = 0; m < 4; ++m) { const int jj = F.lane + 64 * m; IDX[jj] = (jj < n) ? (int)SEL[(size_t)t * 256 + jj] : 0; }
            asm volatile("s_waitcnt lgkmcnt(0)" ::: "memory"); __builtin_amdgcn_wave_barrier();
            {
                const unsigned char* kq = K8 + (size_t)sl * SEQ * 128 + 16 * g4;
#pragma unroll 1
                for (int tl0 = 0; tl0 < 16; tl0 += 4) {
                    u32x4 k0[4], k1[4];
#pragma unroll
                    for (int u = 0; u < 4; ++u) { const int id = IDX[(tl0 + u) * 16 + l15]; const unsigned char* kr = kq + (size_t)id * 128; k0[u] = *(const u32x4*)kr; k1[u] = *(const u32x4*)(kr + 64); }
#pragma unroll
                    for (int u = 0; u < 4; ++u) {
                        f32x4 acc = {0.f, 0.f, 0.f, 0.f};
                        acc = __builtin_amdgcn_mfma_f32_16x16x32_fp8_fp8((long)(((unsigned long long)k0[u].y << 32) | k0[u].x), bq[0], acc, 0, 0, 0);
                        acc = __builtin_amdgcn_mfma_f32_16x16x32_fp8_fp8((long)(((unsigned long long)k0[u].w << 32) | k0[u].z), bq[1], acc, 0, 0, 0);
                        acc = __builtin_amdgcn_mfma_f32_16x16x32_fp8_fp8((long)(((unsigned long long)k1[u].y << 32) | k1[u].x), bq[2], acc, 0, 0, 0);
                        acc = __builtin_amdgcn_mfma_f32_16x16x32_fp8_fp8((long)(((unsigned long long)k1[u].w << 32) | k1[u].z), bq[3], acc, 0, 0, 0);
                        if (l15 < 4) {
#pragma unroll
                            for (int rg = 0; rg < 4; ++rg) SCR[((tl0 + u) * 16 + 4 * g4 + rg) * 4 + l15] = acc[rg] * 3.452669831e-4f; }
                    }
                }
            }
            asm volatile("s_waitcnt lgkmcnt(0)" ::: "memory"); __builtin_amdgcn_wave_barrier();
            float sclh[4], offh[4];
            {
                f32x4 sv[4]; unsigned pqb[4][4];
#pragma unroll
                for (int m = 0; m < 4; ++m) sv[m] = *(const LAS f32x4*)(SCR + (F.lane + 64 * m) * 4);
#pragma unroll
                for (int g = 0; g < 4; ++g) {
                    float mx = -INFINITY;
#pragma unroll
                    for (int m = 0; m < 4; ++m) { const bool val = (F.lane + 64 * m) < n; sv[m][g] = val ? sv[m][g] : -INFINITY; mx = fmaxf(mx, sv[m][g]); }
                    mx = wmax(mx); float sm = 0.f, sq = 0.f;
#pragma unroll
                    for (int m = 0; m < 4; ++m) { const bool val = (F.lane + 64 * m) < n; const float ex = val ? expf(sv[m][g] - mx) : 0.f; sm += ex;
                        const float pf = rintf(255.0f * ex); sq += pf; pqb[m][g] = (unsigned)pf; }
                    sclh[g] = 0.0625f / (255.0f * wsum(sm)); offh[g] = 128.0f * wsum(sq);
                }
                asm volatile("s_waitcnt lgkmcnt(0)" ::: "memory"); __builtin_amdgcn_wave_barrier();
#pragma unroll
                for (int m = 0; m < 4; ++m) { const int jj = F.lane + 64 * m;
#pragma unroll
                    for (int g = 0; g < 4; ++g) ((LAS unsigned char*)SCR)[(jj >> 2) * 16 + g * 4 + (jj & 3)] = (unsigned char)pqb[m][g]; }
            }
            asm volatile("s_waitcnt lgkmcnt(0)" ::: "memory"); __builtin_amdgcn_wave_barrier();
            unsigned acc[4][16];
#pragma unroll
            for (int g = 0; g < 4; ++g)
#pragma unroll
                for (int j = 0; j < 16; ++j) acc[g][j] = 0u;
#pragma unroll 1
            for (int ib = 0; ib < 8; ib += 2) {
                u32x4 vd[2][4], pq4[2];
#pragma unroll
                for (int h = 0; h < 2; ++h) { pq4[h] = *(const LAS u32x4*)((const LAS unsigned char*)SCR + (8 * (ib + h) + g8) * 16);
#pragma unroll
                    for (int u = 0; u < 4; ++u) { const int id = IDX[32 * (ib + h) + 4 * g8 + u]; vd[h][u] = *(const u32x4*)(vb + (size_t)id * 128); } }
#pragma unroll
                for (int h = 0; h < 2; ++h)
#pragma unroll
                    for (int q = 0; q < 4; ++q) { const unsigned A_ = vd[h][0][q], B_ = vd[h][1][q], C_ = vd[h][2][q], D_ = vd[h][3][q];
                        const unsigned ablo = __builtin_amdgcn_perm(B_, A_, 0x05010400u), abhi = __builtin_amdgcn_perm(B_, A_, 0x07030602u);
                        const unsigned cdlo = __builtin_amdgcn_perm(D_, C_, 0x05010400u), cdhi = __builtin_amdgcn_perm(D_, C_, 0x07030602u);
                        const unsigned t0 = __builtin_amdgcn_perm(cdlo, ablo, 0x05040100u), t1 = __builtin_amdgcn_perm(cdlo, ablo, 0x07060302u);
                        const unsigned t2 = __builtin_amdgcn_perm(cdhi, abhi, 0x05040100u), t3 = __builtin_amdgcn_perm(cdhi, abhi, 0x07060302u);
#pragma unroll
                        for (int g = 0; g < 4; ++g) { const unsigned pg = pq4[h][g];
                            acc[g][4 * q + 0] = __builtin_amdgcn_udot4(t0, pg, acc[g][4 * q + 0], false); acc[g][4 * q + 1] = __builtin_amdgcn_udot4(t1, pg, acc[g][4 * q + 1], false);
                            acc[g][4 * q + 2] = __builtin_amdgcn_udot4(t2, pg, acc[g][4 * q + 2], false); acc[g][4 * q + 3] = __builtin_amdgcn_udot4(t3, pg, acc[g][4 * q + 3], false); } }
            }
            f32x2 mine[8];
            { const int hr = F.lane >> 4; const float scl = (hr == 0) ? sclh[0] : ((hr == 1) ? sclh[1] : ((hr == 2) ? sclh[2] : sclh[3])), off = (hr == 0) ? offh[0] : ((hr == 1) ? offh[1] : ((hr == 2) ? offh[2] : offh[3]));
#pragma unroll
              for (int q = 0; q < 8; ++q) {
                float x[4][2];
#pragma unroll
                for (int g = 0; g < 4; ++g) { float a0 = (float)acc[g][2 * q], a1 = (float)acc[g][2 * q + 1];
                    a0 += dppf<0x128, 0xF>(a0); a1 += dppf<0x128, 0xF>(a1);
                    x[g][0] = a0; x[g][1] = a1; }
                mine[q].x = (rsum4(x[0][0], x[1][0], x[2][0], x[3][0]) - off) * scl; mine[q].y = (rsum4(x[0][1], x[1][1], x[2][1], x[3][1]) - off) * scl;
              } }
            if ((F.lane & 8) == 0) { u32x4 w0, w1; const int hrow = F.lane >> 4;
                w0.x = pk2(mine[0].x, mine[0].y); w0.y = pk2(mine[1].x, mine[1].y); w0.z = pk2(mine[2].x, mine[2].y); w0.w = pk2(mine[3].x, mine[3].y);
                w1.x = pk2(mine[4].x, mine[4].y); w1.y = pk2(mine[5].x, mine[5].y); w1.z = pk2(mine[6].x, mine[6].y); w1.w = pk2(mine[7].x, mine[7].y);
                bf16* yp = Y + (size_t)t * DM + (kvh * 4 + hrow) * 128 + 16 * c8; *(u32x4*)yp = w0; *(u32x4*)(yp + 8) = w1; }
            asm volatile("s_waitcnt lgkmcnt(0)" ::: "memory"); __builtin_amdgcn_wave_barrier();
        }
    }
}

__global__ void __launch_bounds__(NTHREADS, 2) mk_fwd(Args args) {
    extern __shared__ __attribute__((aligned(16))) unsigned char lds[];
    Frame F;
    F.lds = (LAS unsigned char*)lds;
    volatile LAS unsigned* MISC = (volatile LAS unsigned*)(F.lds + MISC_OFF);
    F.tid = threadIdx.x; F.lane = F.tid & 63; F.wave = __builtin_amdgcn_readfirstlane(F.tid >> 6);
    F.bx = blockIdx.x; F.G = gridDim.x; F.gw = F.bx * NWAVES + F.wave; F.ngw = F.G * NWAVES;
    if (F.tid < 64) MISC[F.tid] = 0u;
    __syncthreads();
    unsigned char* ws = args.ws;
    XcdBarrier bar = xcd_barrier_post((unsigned*)(ws + WS_CTL) + CW_BAR, MISC + 8);
    if (F.tid == 0) { MISC[16] = xb_add((unsigned*)(ws + WS_CTL) + CW_XRANK + 64 * bar.x, 1u); }
    const int lo = args.ph_lo, hi = args.ph_hi;
#define IN(k) (lo <= (k) && (k) < hi)
#define SEAM(k) do { if (IN((k) + 1)) xcd_barrier(bar); } while (0)
#define GEMM_BF16(Aptr, Bptr, Nn, Kk, Optr, ldo) do { pg8::Gemm g{(const pg8::bf16_t*)(Aptr), (const pg8::bf16_t*)(Bptr), TOK, (Nn), (Kk)}; pg8::StaticOrder S; S.init(TOK, (Nn), F.G, F.bx); \
        pg8::EpiBf16<0> E{(pg8::bf16_t*)(Optr), (ldo), nullptr, 0, 0}; pg8::gemm_phase<pg8::EpiBf16<0>, pg8::StaticOrder, false>(F.lds, g, S, E, nullptr); } while (0)

#ifndef PROBE_MASK
#define PROBE_MASK 0
#endif
#define PRB(bit, stmt) do { if (PROBE_MASK & (1 << (bit))) { stmt; xcd_barrier(bar); } } while (0)
    if (IN(0)) { PRB(14, ph_prologue(args, F)); ph_prologue(args, F); SEAM(0); }
    if (IN(1)) { ph_mod_x(args, F); SEAM(1); }
    if (F.tid == 0) {
        unsigned* cb = (unsigned*)(ws + WS_CTL) + CW_BAR; unsigned nloc = 1u, rx = 0u, nx = 0u;
        for (unsigned j = 0; j < 16; ++j) { const unsigned c = xb_ld(&cb[XB_XCNT(j)]); if (c > 0u) { if (j < bar.x) ++rx; ++nx; } if (j == bar.x) nloc = c > 0u ? c : 1u; }
        if (nx == 0u) nx = 1u;
        MISC[17] = nloc; MISC[18] = rx; MISC[19] = nx; }
    __syncthreads();
    const XInfo XI = xcc_info(MISC);
    if (IN(2)) { PRB(8, GEMM_BF16(ws + WS_HY, ws + WS_WINE, EV_NP, 2048, ws + WS_Z, EV_NP)); GEMM_BF16(ws + WS_HY, ws + WS_WINE, EV_NP, 2048, ws + WS_Z, EV_NP); SEAM(2); }
    if (IN(3)) { ph_even_post(args, F); SEAM(3); }
    if (IN(4)) { pg8::Gemm g{(const pg8::bf16_t*)(ws + WS_LA), (const pg8::bf16_t*)(ws + WS_WL), TOK, 3072, 512}; pg8::StaticOrder S; S.init(TOK, 3072, F.G, F.bx);
                 EpiLora E{(pg8::bf16_t*)(ws + WS_Z) + 1280, EV_NP, (const float*)args.in[7], (const float*)args.in[9]};
                 pg8::gemm_phase<EpiLora, pg8::StaticOrder, false>(F.lds, g, S, E, nullptr); SEAM(4); }
    if (IN(5)) { PRB(9, ph_scan_prep(args, F)); ph_scan_prep(args, F); xcd_barrier(bar); }
    if (IN(7)) { PRB(15, scan_mfma_rows(args, F)); ph_swa_mfma(args, F); scan_mfma_rows(args, F); SEAM(7); }
    if (IN(8)) { PRB(10, ph_rwkv_finish(args, F)); ph_rwkv_finish(args, F); SEAM(8); }
    if (IN(9)) { GEMM_BF16(ws + WS_HY, ws + WS_WOUTE, 2048, 2048, ws + WS_Z, 2048); SEAM(9); }
    if (IN(10)) { PRB(11, ph_ln_mixer(args, F, 0)); ph_ln_mixer(args, F, 0); SEAM(10); }
    if (IN(11)) { GEMM_BF16(ws + WS_HY, ws + WS_WQ0, 2048, 2048, ws + WS_Z, 2048); SEAM(11); }
    if (IN(12)) { PRB(4, ph_peer_select(args, F, 0)); ph_peer_select(args, F, 0); SEAM(12); }
    if (IN(13)) { PRB(12, ph_peer_u(args, F, XI)); ph_peer_u(args, F, XI); xcd_barrier(bar); ph_peer_act(args, F); xcd_barrier(bar); PRB(13, ph_peer_v(args, F, XI)); ph_peer_v(args, F, XI); xcd_barrier(bar); ph_peer_ln(args, F, 0); SEAM(13); }
    if (IN(14)) { GEMM_BF16(ws + WS_HY, ws + WS_WINO, OD_NP, 2048, ws + WS_Z, OD_NP); SEAM(14); }
    if (IN(15)) { ph_odd_post(args, F); SEAM(15); }
    if (IN(16)) { PRB(2, ph_dsa_select(args, F, 1)); PRB(6, ph_dsa_select(args, F, 2)); PRB(7, ph_dsa_select(args, F, 0)); ph_dsa_select(args, F); SEAM(16); }
    if (IN(17)) { ph_dsa_attn(args, F, XI); SEAM(17); }
    if (IN(18)) { GEMM_BF16(ws + WS_HY, ws + WS_WOUTO, 2048, 2048, ws + WS_Z, 2048); SEAM(18); }
    if (IN(19)) { ph_ln_mixer(args, F, 1); SEAM(19); }
    if (IN(20)) { GEMM_BF16(ws + WS_HY, ws + WS_WQ1, 2048, 2048, ws + WS_Z, 2048); SEAM(20); }
    if (IN(21)) { PRB(4, ph_peer_select(args, F, 1)); ph_peer_select(args, F, 1); SEAM(21); }
    if (IN(22)) { ph_peer_u(args, F, XI); xcd_barrier(bar); ph_peer_act(args, F); xcd_barrier(bar); ph_peer_v(args, F, XI); xcd_barrier(bar); ph_peer_ln(args, F, 1); }
#undef IN
#undef SEAM
#undef GEMM_BF16
}

#ifndef MK_SPLIT
#define MK_SPLIT 0
#endif
extern "C" void kernel_launch(void* const* d_in, const int* in_sizes, int n_in, void* d_out, int out_size, void* d_ws, size_t ws_size, hipStream_t stream) {
    static int grid = 0;
    if (grid == 0) {
        int dev = 0, cus = 0;
        if (n_in != 27 || out_size != TOK * DM || ws_size < WS_END) { fprintf(stderr, "kernel_launch: unexpected shapes (n_in %d out %d ws %zu)\n", n_in, out_size, ws_size); grid = -1; return; }
        if (hipGetDevice(&dev) != hipSuccess || hipDeviceGetAttribute(&cus, hipDeviceAttributeMultiprocessorCount, dev) != hipSuccess) { grid = -1; return; }
        if (hipFuncSetAttribute((const void*)mk_fwd, hipFuncAttributeMaxDynamicSharedMemorySize, LDS_BYTES) != hipSuccess) { fprintf(stderr, "kernel_launch: hipFuncSetAttribute failed\n"); grid = -1; return; }
        int per_cu = 0;
        if (hipOccupancyMaxActiveBlocksPerMultiprocessor(&per_cu, (const void*)mk_fwd, NTHREADS, LDS_BYTES) != hipSuccess || per_cu < 1) fprintf(stderr, "kernel_launch: occupancy query says %d\n", per_cu);
        (void)hipGetLastError();
        grid = cus;
    }
    if (grid < 0) return;
    (void)hipMemsetAsync((char*)d_ws + WS_CTL, 0, CTL_ZERO_BYTES, stream);
    Args a{};
    for (int i = 0; i < 27; ++i) a.in[i] = d_in[i];
    a.out = (float*)d_out; a.ws = (unsigned char*)d_ws;
#if MK_SPLIT
    for (int p = 0; p < 23; ++p) { a.ph_lo = p; a.ph_hi = p + 1; hipLaunchKernelGGL(mk_fwd, dim3(grid), dim3(NTHREADS), LDS_BYTES, stream, a); }
#else
    a.ph_lo = 0; a.ph_hi = 23;
    hipLaunchKernelGGL(mk_fwd, dim3(grid), dim3(NTHREADS), LDS_BYTES, stream, a);
#endif
}
```

```cpp
#include <hip/hip_runtime.h>
#include <cstdio>
#include <cstdint>
namespace pg8 {
#define PG8_LAS __attribute__((address_space(3)))
typedef unsigned short bf16_t;
typedef short bf16x8 __attribute__((ext_vector_type(8)));
typedef float f32x4 __attribute__((ext_vector_type(4)));
typedef unsigned u32x4 __attribute__((ext_vector_type(4)));
constexpr int BM = 256, BK = 64, HALF = 128, HTB = HALF * BK * 2  , STAGE_BYTES = 8 * HTB, NXCD = 8, WGM = 8;

__host__ __device__ __forceinline__ int lds_byte(int r, int c) { const int st = (r >> 4) * 2 + (c >> 5), rr = r & 15, cc = c & 31, ob = rr * 64 + cc * 2; return st * 1024 + (ob ^ (((ob >> 9) & 1) << 5)); }
__host__ __device__ __forceinline__ void stage_rc(int b, int& R, int& C) { const int st = b / 1024, sb = b % 1024, swz = sb ^ (((sb >> 9) & 1) << 5); R = (st >> 1) * 16 + swz / 64; C = (st & 1) * 32 + (swz % 64) / 2; }
__host__ __device__ __forceinline__ int perm32(int rho) { const int n = rho >> 4, i = rho & 15; return 8 * (i >> 2) + 4 * n + (i & 3); }

struct Unit { int pm, pn; };
struct Gemm { const bf16_t* A; const bf16_t* Bt; int M, N, K; };

struct StaticOrder {
    int nM, nN, nwg, G, c;
    __host__ __device__ void init(int M, int N, int G_, int c_) { nM = M / BM; nN = N / BM; nwg = nM * nN; G = G_; c = c_; }
    __host__ __device__ bool next(int i, Unit& u) const {
        const long L = (long)i * G + c; if (L >= nwg) return false;
        int wgid = (int)L; { const int q = nwg / NXCD, r = nwg % NXCD, xcd = wgid % NXCD, off = wgid / NXCD; wgid = (xcd < r ? xcd * (q + 1) : r * (q + 1) + (xcd - r) * q) + off; }
        const int nig = WGM * nN, gid = wgid / nig, fm = gid * WGM, gsz = (nM - fm) < WGM ? (nM - fm) : WGM;
        u.pm = fm + ((wgid % nig) % gsz); u.pn = (wgid % nig) / gsz; return true;
    }
    __device__ __forceinline__ void a_ready(const Unit&) const {}
    __device__ __forceinline__ void done(const Unit&) const {}
};
struct CountedOrder : StaticOrder {
    const unsigned* ready; unsigned need; unsigned* tmo;
    __device__ __forceinline__ void a_ready(const Unit& u) const {
        if (threadIdx.x < 64) {
            const unsigned long long t0 = __builtin_amdgcn_s_memrealtime(); unsigned polls = 0;
            while ((unsigned)__builtin_amdgcn_readfirstlane(__hip_atomic_load(ready + 64 * u.pm, __ATOMIC_RELAXED, __HIP_MEMORY_SCOPE_AGENT)) < need) {
                if ((++polls & 255u) == 0u && __builtin_amdgcn_readfirstlane(__hip_atomic_load(tmo, __ATOMIC_RELAXED, __HIP_MEMORY_SCOPE_AGENT)) != 0u) break;
                if (__builtin_amdgcn_s_memrealtime() - t0 > 2000000ull) {
                    if (threadIdx.x == 0) { unsigned expect = 0u; __hip_atomic_compare_exchange_strong(tmo + 1, &expect, 0x600u | (unsigned)(u.pm & 0xff), __ATOMIC_RELAXED, __ATOMIC_RELAXED, __HIP_MEMORY_SCOPE_AGENT); __hip_atomic_store(tmo, 1u, __ATOMIC_RELAXED, __HIP_MEMORY_SCOPE_AGENT); }
                    break; }
                __builtin_amdgcn_s_sleep(2); }
            __builtin_amdgcn_fence(__ATOMIC_ACQUIRE, "agent");
            asm volatile("s_waitcnt vmcnt(0)" ::: "memory");
        }
#if !defined(BROKEN_HOOK_NO_BARRIER)
        asm volatile("" ::: "memory"); __builtin_amdgcn_s_barrier(); asm volatile("" ::: "memory");
#endif
    }
};

__device__ __forceinline__ unsigned cvt_pk_bf16(float lo, float hi) { unsigned r; asm volatile("v_cvt_pk_bf16_f32 %0, %1, %2" : "=v"(r) : "v"(lo), "v"(hi)); return r; }
typedef float f32x2 __attribute__((ext_vector_type(2)));
__device__ __forceinline__ f32x2 gelu_pk(f32x2 v) {
    const f32x2 av = __builtin_elementwise_abs(v), d = av * 0.2316418882f + 1.0f;
    f32x2 t; t.x = __builtin_amdgcn_rcpf(d.x); t.y = __builtin_amdgcn_rcpf(d.y);
    f32x2 q = t * 0.5307027145f + (-0.7265760135f); q = q * t + 0.7107068705f; q = q * t + (-0.142248368f); q = q * t + 0.127414796f; q = q * t;
    const f32x2 s = (v * v) * (-0.72134752044f);
    f32x2 e; e.x = __builtin_amdgcn_exp2f(s.x); e.y = __builtin_amdgcn_exp2f(s.y);
    const f32x2 m = v * (q * e), r = v - m;
    f32x2 o; o.x = v.x < 0.f ? m.x : r.x; o.y = v.y < 0.f ? m.y : r.y; return o;
}

struct EpiF32 {
    static constexpr bool PERM = false, AFTER_DRAIN = false;
    float* C; int ldc; const float* bias;
    __device__ __forceinline__ void operator()(const f32x4 (&acc)[2][2][4][2], const Unit& u, int wr, int wc, int fr, int fq) const {
        const int row0 = u.pm * BM + wr * 64 + fr, col0 = u.pn * BM + wc * 32 + 4 * fq;
        f32x4 bv[2][2];
#pragma unroll
        for (int bj = 0; bj < 2; ++bj)
#pragma unroll
            for (int n = 0; n < 2; ++n) bv[bj][n] = bias ? *(const f32x4*)(bias + col0 + bj * HALF + n * 16) : (f32x4){0.f, 0.f, 0.f, 0.f};
#pragma unroll
        for (int ai = 0; ai < 2; ++ai)
#pragma unroll
            for (int m = 0; m < 4; ++m) { float* rowp = C + (size_t)(row0 + ai * HALF + m * 16) * ldc + col0;
#pragma unroll
                for (int bj = 0; bj < 2; ++bj)
#pragma unroll
                    for (int n = 0; n < 2; ++n) *(f32x4*)(rowp + bj * HALF + n * 16) = acc[ai][bj][m][n] + bv[bj][n]; }
    }
};
template <int ACT  > struct EpiBf16 {
    static constexpr bool PERM = true, AFTER_DRAIN = false;
    bf16_t* O; int ldc; const float* bias; int split_cols; size_t split_stride;
    __device__ __forceinline__ void operator()(const f32x4 (&acc)[2][2][4][2], const Unit& u, int wr, int wc, int fr, int fq) const {
        const int row0 = u.pm * BM + wr * 64 + fr; int colt = u.pn * BM; bf16_t* base = O;
        if (split_cols) { const int t = colt / split_cols; base += (size_t)t * split_stride; colt -= t * split_cols; }
        const int col0 = colt + wc * 32 + 8 * fq, bcol0 = u.pn * BM + wc * 32 + 8 * fq;
        f32x4 bv[2][2];
#pragma unroll
        for (int bj = 0; bj < 2; ++bj)
#pragma unroll
            for (int n = 0; n < 2; ++n) bv[bj][n] = bias ? *(const f32x4*)(bias + bcol0 + bj * HALF + 4 * n) : (f32x4){0.f, 0.f, 0.f, 0.f};
#pragma unroll
        for (int ai = 0; ai < 2; ++ai)
#pragma unroll
            for (int m = 0; m < 4; ++m) { bf16_t* rowp = base + (size_t)(row0 + ai * HALF + m * 16) * ldc + col0;
#pragma unroll
                for (int bj = 0; bj < 2; ++bj) { f32x4 v0 = acc[ai][bj][m][0] + bv[bj][0], v1 = acc[ai][bj][m][1] + bv[bj][1];
                    if (ACT == 1) { f32x2 a = gelu_pk((f32x2){v0[0], v0[1]}), b = gelu_pk((f32x2){v0[2], v0[3]}), c = gelu_pk((f32x2){v1[0], v1[1]}), d = gelu_pk((f32x2){v1[2], v1[3]});
                        v0 = (f32x4){a.x, a.y, b.x, b.y}; v1 = (f32x4){c.x, c.y, d.x, d.y}; }
                    if (ACT == 2) {
#pragma unroll
                        for (int j = 0; j < 4; ++j) { v0[j] = 0.5f * v0[j] * (1.0f + erff(v0[j] * 0.70710678f)); v1[j] = 0.5f * v1[j] * (1.0f + erff(v1[j] * 0.70710678f)); } }
                    u32x4 w; w.x = cvt_pk_bf16(v0[0], v0[1]); w.y = cvt_pk_bf16(v0[2], v0[3]); w.z = cvt_pk_bf16(v1[0], v1[1]); w.w = cvt_pk_bf16(v1[2], v1[3]);
                    *(u32x4*)(rowp + bj * HALF) = w; } }
    }
};

struct PanelStats {
    unsigned* xbuf;
    unsigned* cnt;
    unsigned* tmo;
    int ntn; float eps;
    unsigned code;
    __device__ __forceinline__ bool run(const f32x4 (&v)[2][2][4][2], const Unit& u, int wr, int wc, int fr, int fq, PG8_LAS unsigned char* lds, int wid, int lane) const {
        typedef float f32x2v __attribute__((ext_vector_type(2)));
        PG8_LAS f32x2v* P = (PG8_LAS f32x2v*)lds;
        PG8_LAS f32x2v* S = (PG8_LAS f32x2v*)(lds + 8192);
        PG8_LAS unsigned* flag = (PG8_LAS unsigned*)(lds + 8192 + 2048);
#pragma unroll
        for (int ai = 0; ai < 2; ++ai)
#pragma unroll
            for (int m = 0; m < 4; ++m) {
                float s = 0.f;
#pragma unroll
                for (int bj = 0; bj < 2; ++bj)
#pragma unroll
                    for (int n = 0; n < 2; ++n) { const f32x4 x = v[ai][bj][m][n]; s += (x[0] + x[1]) + (x[2] + x[3]); }
                s += __shfl_xor(s, 16); s += __shfl_xor(s, 32);
                const float mw = s * (1.0f / 64.0f); float q = 0.f;
#pragma unroll
                for (int bj = 0; bj < 2; ++bj)
#pragma unroll
                    for (int n = 0; n < 2; ++n) { const f32x4 d = v[ai][bj][m][n] - mw; q += (d[0] * d[0] + d[1] * d[1]) + (d[2] * d[2] + d[3] * d[3]); }
                q += __shfl_xor(q, 16); q += __shfl_xor(q, 32);
                if (fq == 0) P[(ai * HALF + wr * 64 + m * 16 + fr) * 4 + wc] = (f32x2v){mw, q};
            }
        asm volatile("s_waitcnt lgkmcnt(0)" ::: "memory"); __builtin_amdgcn_s_barrier(); asm volatile("" ::: "memory");
#if defined(BROKEN_NO_WAIT)
        if (blockIdx.x >= 64) { const long long t0 = clock64(); while (clock64() - t0 < 60000) __builtin_amdgcn_s_sleep(8); }
#endif
        const int row = wid * 32 + (lane & 31);
        if (lane < 32) {
            const f32x2v a = P[row * 4 + 0], b = P[row * 4 + 1], c = P[row * 4 + 2], d = P[row * 4 + 3];
            const float mt = (a.x + b.x + c.x + d.x) * 0.25f;
            const float da = a.x - mt, db = b.x - mt, dc = c.x - mt, dd = d.x - mt;
            const float m2 = (a.y + b.y) + (c.y + d.y) + 64.0f * ((da * da + db * db) + (dc * dc + dd * dd));
            unsigned long long* slot = (unsigned long long*)xbuf + ((size_t)(u.pm * BM + row) * 4 + u.pn);
            __hip_atomic_store(slot, ((unsigned long long)__float_as_uint(m2) << 32) | __float_as_uint(mt), __ATOMIC_RELAXED, __HIP_MEMORY_SCOPE_AGENT);
        }
        asm volatile("s_waitcnt vmcnt(0)" ::: "memory");
        if (lane == 0) __hip_atomic_fetch_add(cnt + 64 * u.pm, 1u, __ATOMIC_RELAXED, __HIP_MEMORY_SCOPE_AGENT);
        if (wid == 0) {
            bool dead = false; const unsigned long long t0 = __builtin_amdgcn_s_memrealtime(); const unsigned want = 8u * (unsigned)ntn;
            for (;;) {
#if defined(BROKEN_NO_WAIT)
                break;
#endif
                if ((unsigned)__builtin_amdgcn_readfirstlane(__hip_atomic_load(cnt + 64 * u.pm, __ATOMIC_RELAXED, __HIP_MEMORY_SCOPE_AGENT)) >= want) break;
                if (__builtin_amdgcn_s_memrealtime() - t0 > 2000000ull) {
                    if (lane == 0) { unsigned expect = 0u; __hip_atomic_compare_exchange_strong(tmo + 1, &expect, code | (unsigned)(u.pm & 0xff), __ATOMIC_RELAXED, __ATOMIC_RELAXED, __HIP_MEMORY_SCOPE_AGENT);
                                     __hip_atomic_store(tmo, 1u, __ATOMIC_RELAXED, __HIP_MEMORY_SCOPE_AGENT); }
                    dead = true; break; }
                __builtin_amdgcn_s_sleep(2);
            }
            __builtin_amdgcn_fence(__ATOMIC_ACQUIRE, "agent");
            if (lane == 0) flag[0] = dead ? 1u : 0u;
        }
        asm volatile("s_waitcnt vmcnt(0) lgkmcnt(0)" ::: "memory"); __builtin_amdgcn_s_barrier(); asm volatile("" ::: "memory");
        const bool bad = flag[0] != 0u;
        if (lane < 32) {
            const unsigned long long* slot = (const unsigned long long*)xbuf + (size_t)(u.pm * BM + row) * 4; float mt[4], m2[4]; float ms = 0.f;
#pragma unroll
            for (int t = 0; t < 4; ++t) { if (t < ntn) { const unsigned long long w = __hip_atomic_load(slot + t, __ATOMIC_RELAXED, __HIP_MEMORY_SCOPE_AGENT); mt[t] = __uint_as_float((unsigned)w); m2[t] = __uint_as_float((unsigned)(w >> 32)); } else { mt[t] = 0.f; m2[t] = 0.f; } ms += mt[t]; }
            const float mean = ms / (float)ntn; float q = 0.f;
#pragma unroll
            for (int t = 0; t < 4; ++t) if (t < ntn) { const float dm = mt[t] - mean; q += m2[t] + 256.0f * dm * dm; }
            S[row] = (f32x2v){mean, 1.0f / sqrtf(q / (256.0f * (float)ntn) + eps)};
        }
        asm volatile("s_waitcnt lgkmcnt(0)" ::: "memory"); __builtin_amdgcn_s_barrier(); asm volatile("" ::: "memory");
        return bad;
    }
};
struct EpiLnRes {
    static constexpr bool PERM = false, AFTER_DRAIN = true;
    const float* base; float* out; int ldc; const float* bias; PanelStats st; unsigned poison;
    __device__ __forceinline__ void refuse(size_t i0, size_t stride, int M, int N) const { const float q = __builtin_nanf(""); for (size_t i = i0; i < (size_t)M * N; i += stride) out[(i / N) * ldc + i % N] = q;
        if (i0 == 0) { unsigned expect = 0u; __hip_atomic_compare_exchange_strong(st.tmo + 1, &expect, 0x7f0u, __ATOMIC_RELAXED, __ATOMIC_RELAXED, __HIP_MEMORY_SCOPE_AGENT); __hip_atomic_store(st.tmo, 1u, __ATOMIC_RELAXED, __HIP_MEMORY_SCOPE_AGENT); } }
    __device__ __forceinline__ void fused(f32x4 (&acc)[2][2][4][2], const Unit& u, int wr, int wc, int fr, int fq, PG8_LAS unsigned char* lds, int wid, int lane) const {
        typedef float f32x2v __attribute__((ext_vector_type(2)));
        const PG8_LAS f32x2v* S = (const PG8_LAS f32x2v*)(lds + 8192);
        const int col0 = u.pn * BM + wc * 32 + 4 * fq;
#pragma unroll
        for (int bj = 0; bj < 2; ++bj)
#pragma unroll
            for (int n = 0; n < 2; ++n) { const f32x4 bv = bias ? *(const f32x4*)(bias + col0 + bj * HALF + n * 16) : (f32x4){0.f, 0.f, 0.f, 0.f};
#pragma unroll
                for (int ai = 0; ai < 2; ++ai)
#pragma unroll
                    for (int m = 0; m < 4; ++m) acc[ai][bj][m][n] += bv; }
        const bool bad = st.run(acc, u, wr, wc, fr, fq, lds, wid, lane) || poison != 0u;
        const float qnan = __builtin_nanf("");
#pragma unroll
        for (int ai = 0; ai < 2; ++ai)
#pragma unroll
            for (int m = 0; m < 4; ++m) { const int r = ai * HALF + wr * 64 + m * 16 + fr; const f32x2v sr = S[r]; const size_t off = (size_t)(u.pm * BM + r) * ldc + col0;
#pragma unroll
                for (int bj = 0; bj < 2; ++bj)
#pragma unroll
                    for (int n = 0; n < 2; ++n) { const f32x4 bs = *(const f32x4*)(base + off + bj * HALF + n * 16); f32x4 o = bs + (acc[ai][bj][m][n] - sr.x) * sr.y;
                        if (bad) o = (f32x4){qnan, qnan, qnan, qnan}; *(f32x4*)(out + off + bj * HALF + n * 16) = o; }
                asm volatile("" ::: "memory"); }
    }
};
struct EpiLnResLn {
    static constexpr bool PERM = false, AFTER_DRAIN = true;
    const float* base; float* out; bf16_t* xn; int ldc; const float* bias; PanelStats st1, st2; unsigned poison;
    __device__ __forceinline__ void refuse(size_t i0, size_t stride, int M, int N) const { const float q = __builtin_nanf(""); for (size_t i = i0; i < (size_t)M * N; i += stride) { const size_t o = (i / N) * ldc + i % N; out[o] = q; xn[o] = (bf16_t)0x7fc0u; }
        if (i0 == 0) { unsigned expect = 0u; __hip_atomic_compare_exchange_strong(st1.tmo + 1, &expect, 0x7f0u, __ATOMIC_RELAXED, __ATOMIC_RELAXED, __HIP_MEMORY_SCOPE_AGENT); __hip_atomic_store(st1.tmo, 1u, __ATOMIC_RELAXED, __HIP_MEMORY_SCOPE_AGENT); } }
    __device__ __forceinline__ void fused(f32x4 (&acc)[2][2][4][2], const Unit& u, int wr, int wc, int fr, int fq, PG8_LAS unsigned char* lds, int wid, int lane) const {
        typedef float f32x2v __attribute__((ext_vector_type(2))); typedef unsigned u32x2v __attribute__((ext_vector_type(2)));
        const PG8_LAS f32x2v* S = (const PG8_LAS f32x2v*)(lds + 8192);
        const int col0 = u.pn * BM + wc * 32 + 4 * fq;
#pragma unroll
        for (int bj = 0; bj < 2; ++bj)
#pragma unroll
            for (int n = 0; n < 2; ++n) { const f32x4 bv = bias ? *(const f32x4*)(bias + col0 + bj * HALF + n * 16) : (f32x4){0.f, 0.f, 0.f, 0.f};
#pragma unroll
                for (int ai = 0; ai < 2; ++ai)
#pragma unroll
                    for (int m = 0; m < 4; ++m) acc[ai][bj][m][n] += bv; }
        bool bad = st1.run(acc, u, wr, wc, fr, fq, lds, wid, lane) || poison != 0u;
        const float qnan = __builtin_nanf("");
#pragma unroll
        for (int ai = 0; ai < 2; ++ai)
#pragma unroll
            for (int m = 0; m < 4; ++m) { const int r = ai * HALF + wr * 64 + m * 16 + fr; const f32x2v sr = S[r]; const size_t off = (size_t)(u.pm * BM + r) * ldc + col0;
#pragma unroll
                for (int bj = 0; bj < 2; ++bj)
#pragma unroll
                    for (int n = 0; n < 2; ++n) { const f32x4 bs = *(const f32x4*)(base + off + bj * HALF + n * 16); acc[ai][bj][m][n] = bs + (acc[ai][bj][m][n] - sr.x) * sr.y; }
                asm volatile("" : "+v"(acc[ai][0][m][0]), "+v"(acc[ai][0][m][1]), "+v"(acc[ai][1][m][0]), "+v"(acc[ai][1][m][1]));
                if (m & 1) asm volatile("" ::: "memory"); }
        const bool bad1 = bad;
        bad = st2.run(acc, u, wr, wc, fr, fq, lds, wid, lane) || bad;
#pragma unroll
        for (int ai = 0; ai < 2; ++ai)
#pragma unroll
            for (int m = 0; m < 4; ++m) { const int r = ai * HALF + wr * 64 + m * 16 + fr; const f32x2v sr = S[r]; const size_t off = (size_t)(u.pm * BM + r) * ldc + col0;
#pragma unroll
                for (int bj = 0; bj < 2; ++bj)
#pragma unroll
                    for (int n = 0; n < 2; ++n) { const f32x4 x1 = acc[ai][bj][m][n]; *(f32x4*)(out + off + bj * HALF + n * 16) = bad1 ? (f32x4){qnan, qnan, qnan, qnan} : x1;
                        const f32x4 o = (x1 - sr.x) * sr.y; u32x2v w; w.x = cvt_pk_bf16(o[0], o[1]); w.y = cvt_pk_bf16(o[2], o[3]);
                        if (bad) { w.x = 0x7fc07fc0u; w.y = 0x7fc07fc0u; } *(u32x2v*)(xn + off + bj * HALF + n * 16) = w; }
                asm volatile("" ::: "memory"); }
    }
};

template <class Epi, class Sched, bool STAMP = false>
__device__ __forceinline__ void gemm_phase(PG8_LAS unsigned char* lds, const Gemm g, const Sched& S, const Epi& E, unsigned long long* stamps) {
    const int tid = threadIdx.x, wid = __builtin_amdgcn_readfirstlane(tid >> 6), lane = tid & 63, wr = wid >> 2, wc = wid & 3, fr = lane & 15, fq = lane >> 4;
    const int K = g.K, nt = K / BK;
    int ts_lo = 0, ts_hi = 0, nts = 0; const unsigned long long rt_entry = STAMP ? (unsigned long long)wall_clock64() : 0ull;
#define PG8_STAMP() do { if (STAMP && wid == 0 && nts < 64) { const unsigned long long _c = (unsigned long long)clock64(); \
        ts_lo = (lane == nts) ? (int)(unsigned)_c : ts_lo; ts_hi = (lane == nts) ? (int)(unsigned)(_c >> 32) : ts_hi; ++nts; } } while (0)
    PG8_STAMP();
    unsigned voffA[2], voffB[2];
#pragma unroll
    for (int i = 0; i < 2; ++i) { int R, C; stage_rc(tid * 16 + i * 8192, R, C); const int Rb = Epi::PERM ? ((R & ~31) + perm32(R & 31)) : R;
        voffA[i] = (unsigned)(R * K + C) * 2u; voffB[i] = (unsigned)(Rb * K + C) * 2u; }
    const size_t kstep = (size_t)(BK * 2);
    const size_t hstep = (size_t)HALF * K * 2;
    const size_t tstep = 2 * hstep;
    const unsigned ldsw = (unsigned)wid * 1024u;
    const int aoff = lds_byte(wr * 64 + fr, fq * 8), boff = lds_byte(wc * 32 + fr, fq * 8);
#define PG8_SA(b, h) (((b) * 2 + (h)) * HTB)
#define PG8_SB(b, h) ((4 + (b) * 2 + (h)) * HTB)
#define PG8_STAGE(bufoff, gbase, voff) do { _Pragma("unroll") for (int _i = 0; _i < 2; ++_i) \
        __builtin_amdgcn_global_load_lds((const unsigned*)((const char*)(gbase) + (voff)[_i]), (PG8_LAS unsigned*)(lds + (bufoff) + ldsw + _i * 8192), 16, 0, 0); } while (0)
#define PG8_LDA(dst, b, h) do { _Pragma("unroll") for (int m = 0; m < 4; ++m) _Pragma("unroll") for (int k = 0; k < 2; ++k) dst[m][k] = *(const PG8_LAS bf16x8*)(lds + PG8_SA(b, h) + aoff + m * 2048 + k * 1024); } while (0)
#define PG8_LDB(dst, b, h) do { _Pragma("unroll") for (int n = 0; n < 2; ++n) _Pragma("unroll") for (int k = 0; k < 2; ++k) dst[n][k] = *(const PG8_LAS bf16x8*)(lds + PG8_SB(b, h) + boff + n * 2048 + k * 1024); } while (0)
#define PG8_MMA(ai, bj, At, Bt) do { __builtin_amdgcn_s_setprio(1); _Pragma("unroll") for (int m = 0; m < 4; ++m) _Pragma("unroll") for (int n = 0; n < 2; ++n) _Pragma("unroll") for (int k = 0; k < 2; ++k) \
        acc[ai][bj][m][n] = __builtin_amdgcn_mfma_f32_16x16x32_bf16(Bt[n][k], At[m][k], acc[ai][bj][m][n], 0, 0, 0); __builtin_amdgcn_s_setprio(0); } while (0)
#define PG8_WAIT_V(n) asm volatile("s_waitcnt vmcnt(" #n ")" ::: "memory")
#define PG8_WAIT_L(n) asm volatile("s_waitcnt lgkmcnt(" #n ")" ::: "memory")
#define PG8_BAR __builtin_amdgcn_s_barrier()
#define PG8_SCHED __builtin_amdgcn_sched_barrier(0)
    Unit cur, nxt; int ui = 0;
    if (!S.next(0, cur)) return;
    f32x4 acc[2][2][4][2];
#pragma unroll
    for (int a = 0; a < 2; ++a)
#pragma unroll
        for (int b = 0; b < 2; ++b)
#pragma unroll
            for (int m = 0; m < 4; ++m)
#pragma unroll
                for (int n = 0; n < 2; ++n) acc[a][b][m][n] = (f32x4){0.f, 0.f, 0.f, 0.f};
    bf16x8 At[4][2], B0[2][2], B1[2][2];
    const char* cA = (const char*)g.A + (size_t)cur.pm * tstep; const char* cB = (const char*)g.Bt + (size_t)cur.pn * tstep;
    S.a_ready(cur);
    PG8_STAGE(PG8_SB(0, 0), cB, voffB); PG8_STAGE(PG8_SA(0, 0), cA, voffA); PG8_STAGE(PG8_SB(0, 1), cB + hstep, voffB); PG8_STAGE(PG8_SA(0, 1), cA + hstep, voffA);
    if (wr == 1) PG8_BAR;
    PG8_WAIT_V(4); PG8_BAR;
    PG8_STAGE(PG8_SB(1, 0), cB + kstep, voffB); PG8_STAGE(PG8_SA(1, 0), cA + kstep, voffA); PG8_STAGE(PG8_SB(1, 1), cB + hstep + kstep, voffB);
    PG8_WAIT_V(6); PG8_BAR;
    PG8_STAMP();
    for (;;) {
        const bool has_next = S.next(ui + 1, nxt);
        const char* nA = has_next ? (const char*)g.A + (size_t)nxt.pm * tstep : cA; const char* nB = has_next ? (const char*)g.Bt + (size_t)nxt.pn * tstep : cB;
        for (int t = 0; t < nt; t += 2) {
            const bool last = (t == nt - 2);
            const char* a1 = cA + (size_t)(t + 1) * kstep;
            const char* a2 = last ? nA : cA + (size_t)(t + 2) * kstep; const char* b2 = last ? nB : cB + (size_t)(t + 2) * kstep;
            const char* a3 = a2 + kstep; const char* b3 = b2 + kstep;
            if (last && has_next) S.a_ready(nxt);
            PG8_LDB(B0, 0, 0); PG8_SCHED; PG8_LDA(At, 0, 0); PG8_STAGE(PG8_SA(1, 1), a1 + hstep, voffA);
            PG8_WAIT_L(8); PG8_BAR; PG8_WAIT_L(0); PG8_MMA(0, 0, At, B0); PG8_BAR; PG8_SCHED;
            PG8_LDB(B1, 0, 1); PG8_STAGE(PG8_SB(0, 0), b2, voffB);
            PG8_BAR; PG8_WAIT_L(0); PG8_MMA(0, 1, At, B1); PG8_BAR;
            PG8_LDA(At, 0, 1); PG8_STAGE(PG8_SA(0, 0), a2, voffA);
            PG8_BAR; PG8_WAIT_L(0); PG8_MMA(1, 0, At, B0); PG8_BAR; PG8_SCHED;
            PG8_STAGE(PG8_SB(0, 1), b2 + hstep, voffB);
            PG8_WAIT_V(6); PG8_BAR; PG8_MMA(1, 1, At, B1); PG8_BAR;
            PG8_LDB(B0, 1, 0); PG8_SCHED; PG8_LDA(At, 1, 0); PG8_STAGE(PG8_SA(0, 1), a2 + hstep, voffA);
            PG8_WAIT_L(8); PG8_BAR; PG8_WAIT_L(0); PG8_MMA(0, 0, At, B0); PG8_BAR; PG8_SCHED;
            PG8_LDB(B1, 1, 1); PG8_STAGE(PG8_SB(1, 0), b3, voffB);
            PG8_BAR; PG8_WAIT_L(0); PG8_MMA(0, 1, At, B1); PG8_BAR;
            PG8_LDA(At, 1, 1); PG8_STAGE(PG8_SA(1, 0), a3, voffA);
            PG8_BAR; PG8_WAIT_L(0); PG8_MMA(1, 0, At, B0); PG8_BAR; PG8_SCHED;
            PG8_STAGE(PG8_SB(1, 1), b3 + hstep, voffB);
            PG8_WAIT_V(6); PG8_BAR; PG8_MMA(1, 1, At, B1); PG8_BAR;
        }
        PG8_STAMP();
        if constexpr (!Epi::AFTER_DRAIN) { E(acc, cur, wr, wc, fr, fq); S.done(cur); }
        PG8_STAMP();
        if (!has_next) break;
#pragma unroll
        for (int a = 0; a < 2; ++a)
#pragma unroll
            for (int b = 0; b < 2; ++b)
#pragma unroll
                for (int m = 0; m < 4; ++m)
#pragma unroll
                    for (int n = 0; n < 2; ++n) acc[a][b][m][n] = (f32x4){0.f, 0.f, 0.f, 0.f};
        cur = nxt; cA = nA; cB = nB; ++ui;
    }
    PG8_WAIT_V(0);
    if (wr == 0) PG8_BAR;
    PG8_BAR;
    if constexpr (Epi::AFTER_DRAIN) { E.fused(acc, cur, wr, wc, fr, fq, lds, wid, lane); S.done(cur); }
    PG8_STAMP();
    if (STAMP && wid == 0) { stamps[lane] = lane < nts ? (((unsigned long long)(unsigned)ts_hi << 32) | (unsigned)ts_lo) : 0ull;
        if (lane == 62) stamps[62] = rt_entry; if (lane == 63) stamps[63] = (unsigned long long)wall_clock64(); }
#undef PG8_STAMP
#undef PG8_SA
#undef PG8_SB
#undef PG8_STAGE
#undef PG8_LDA
#undef PG8_LDB
#undef PG8_MMA
#undef PG8_WAIT_V
#undef PG8_WAIT_L
#undef PG8_BAR
#undef PG8_SCHED
}
}

#define LAS __attribute__((address_space(3)))
#define XB_TMO      128
#define XB_XCNT(j)  (256  + 64 * (j))
#define XB_XSUB(j)  (1280 + 64 * (j))
#define XB_XGEN(j)  (2304 + 64 * (j))
#define XB_TOP      3328
#define XB_TOPGEN   3392
#define XCD_BAR_WORDS 3456
#define XB_SPIN_CAP (1u << 24)

__device__ __forceinline__ unsigned xb_ld(unsigned* p)              { return __hip_atomic_load(p, __ATOMIC_RELAXED, __HIP_MEMORY_SCOPE_AGENT); }
__device__ __forceinline__ unsigned xb_add(unsigned* p, unsigned v) { return __hip_atomic_fetch_add(p, v, __ATOMIC_RELAXED, __HIP_MEMORY_SCOPE_AGENT); }
__device__ __forceinline__ unsigned xb_xcc_id() { return (unsigned)__builtin_amdgcn_s_getreg((3 << 11) | 20) & 0xFu; }
#define XB_SPIN(cond, bar) do { unsigned _sp = 0; while (cond) { __builtin_amdgcn_s_sleep(1); \
    if ((++_sp & 255u) == 0u) { if (xb_ld(&(bar)[XB_TMO])) break; if (_sp > XB_SPIN_CAP) { atomicAdd(&(bar)[XB_TMO], 1u); break; } } } } while (0)

struct XcdBarrier { unsigned* bar; unsigned x; volatile LAS unsigned* st; };

__device__ __forceinline__ XcdBarrier xcd_barrier_post(unsigned* bar, volatile LAS unsigned* st) {
    XcdBarrier b; b.bar = bar; b.x = xb_xcc_id(); b.st = st;
    if (threadIdx.x == 0) (void)xb_add(&bar[XB_XCNT(b.x)], 1u);
    return b;
}
__device__ __forceinline__ void xcd_barrier_complete(unsigned* bar, unsigned x, unsigned& nloc, unsigned& nx) {
    const unsigned G = gridDim.x * gridDim.y * gridDim.z;
    unsigned sum, cnt, mine, sp = 0u;
    for (;;) {
        sum = 0u; cnt = 0u; mine = 0u;
#pragma unroll
        for (unsigned j = 0; j < 16; ++j) { const unsigned c = xb_ld(&bar[XB_XCNT(j)]); sum += c; cnt += (c > 0u) ? 1u : 0u; mine = (j == x) ? c : mine; }
        if (sum == G) break;
        __builtin_amdgcn_s_sleep(1);
        if ((++sp & 255u) == 0u) { if (xb_ld(&bar[XB_TMO])) break; if (sp > XB_SPIN_CAP) { atomicAdd(&bar[XB_TMO], 1u); break; } }
    }
    nloc = mine > 0u ? mine : 1u; nx = cnt > 0u ? cnt : 1u;
}
__device__ __forceinline__ void xcd_barrier(const XcdBarrier& b) {
    asm volatile("s_waitcnt vmcnt(0)" ::: "memory");
    __syncthreads();
    if (threadIdx.x == 0) {
        unsigned* bar = b.bar;
        __builtin_amdgcn_s_waitcnt(0);
        unsigned nloc = b.st[0], nx = b.st[1];
        if (nloc == 0u) { xcd_barrier_complete(bar, b.x, nloc, nx); b.st[0] = nloc; b.st[1] = nx; }
        const unsigned old = xb_add(&bar[XB_XSUB(b.x)], 1u);
        const unsigned gen = old / nloc;
        if (old + 1u == (gen + 1u) * nloc) {
            __builtin_amdgcn_fence(__ATOMIC_RELEASE, "agent");
            asm volatile("s_waitcnt vmcnt(0)" ::: "memory");
            const unsigned og = xb_add(&bar[XB_TOP], 1u);
            const unsigned tg = og / nx;
            if (og + 1u == (tg + 1u) * nx) xb_add(&bar[XB_TOPGEN], 1u);
            else XB_SPIN(xb_ld(&bar[XB_TOPGEN]) == tg, bar);
            __builtin_amdgcn_fence(__ATOMIC_ACQUIRE, "agent");
            xb_add(&bar[XB_XGEN(b.x)], 1u);
            asm volatile("s_waitcnt vmcnt(0)" ::: "memory");
        } else {
            XB_SPIN(xb_ld(&bar[XB_XGEN(b.x)]) == gen, bar);
            __builtin_amdgcn_fence(__ATOMIC_ACQUIRE, "agent");
            asm volatile("s_waitcnt vmcnt(0)" ::: "memory");
        }
    }
    __syncthreads();
}

typedef unsigned short bf16;
typedef float f32x4 __attribute__((ext_vector_type(4)));
typedef float f32x16 __attribute__((ext_vector_type(16)));
typedef float f32x2 __attribute__((ext_vector_type(2)));
typedef unsigned u32x4 __attribute__((ext_vector_type(4)));
typedef unsigned u32x2 __attribute__((ext_vector_type(2)));
typedef short bf16x8 __attribute__((ext_vector_type(8)));
typedef __bf16 bf2_t __attribute__((ext_vector_type(2)));

constexpr int NTHREADS = 512, NWAVES = 8;
constexpr int LDS_BYTES = 160 * 1024;
constexpr int MISC_OFF = LDS_BYTES - 256;
constexpr int TOK = 32768, SEQ = 16384, DM = 2048;
constexpr int EV_N = 4800, EV_NP = 4864, OD_N = 4176, OD_NP = 4352;
constexpr float ALPHA = 1.41421356237f;
constexpr size_t MiB = 1u << 20;
constexpr size_t WS_CTL = 0, CTL_ZERO_BYTES = 1 * MiB;
constexpr int CW_BAR = 4096, CW_XRANK = 8192;
constexpr size_t WS_MOD = 1 * MiB, WS_SKB = 2 * MiB, WS_WL = 4 * MiB, WS_BS = 7 * MiB, WS_CNT = 9 * MiB;
constexpr size_t WS_WINE = 10 * MiB, WS_WOUTE = 29 * MiB, WS_WINO = 37 * MiB, WS_WOUTO = 54 * MiB, WS_WQ0 = 62 * MiB, WS_WQ1 = 70 * MiB;
constexpr size_t WS_HY = 78 * MiB, WS_Z = 206 * MiB, WS_LA = 510 * MiB, WS_BIG = 542 * MiB, WS_END = 1022 * MiB;

__device__ __forceinline__ float bf2f(unsigned short b) { return __uint_as_float(((unsigned)b) << 16); }
__device__ __forceinline__ unsigned pk2(float lo, float hi) { const bf2_t v = {(__bf16)lo, (__bf16)hi}; return __builtin_bit_cast(unsigned, v); }
__device__ __forceinline__ unsigned f2bf(float f) { return pk2(f, 0.f) & 0xffffu; }
__device__ __forceinline__ float lo2f(unsigned w) { return __uint_as_float(w << 16); }
__device__ __forceinline__ float hi2f(unsigned w) { return __uint_as_float(w & 0xffff0000u); }
template <int CTRL, int RM> __device__ __forceinline__ float dppo(float v) { return __int_as_float(__builtin_amdgcn_update_dpp(__float_as_int(v), __float_as_int(v), CTRL, RM, 0xF, false)); }
__device__ __forceinline__ float wsum(float v) {
    v += __int_as_float(__builtin_amdgcn_update_dpp(0, __float_as_int(v), 0xB1, 0xF, 0xF, false)); v += __int_as_float(__builtin_amdgcn_update_dpp(0, __float_as_int(v), 0x4E, 0xF, 0xF, false));
    v += __int_as_float(__builtin_amdgcn_update_dpp(0, __float_as_int(v), 0x141, 0xF, 0xF, false)); v += __int_as_float(__builtin_amdgcn_update_dpp(0, __float_as_int(v), 0x140, 0xF, 0xF, false));
    v += __int_as_float(__builtin_amdgcn_update_dpp(0, __float_as_int(v), 0x142, 0xA, 0xF, false)); v += __int_as_float(__builtin_amdgcn_update_dpp(0, __float_as_int(v), 0x143, 0xC, 0xF, false));
    return __int_as_float(__builtin_amdgcn_readlane(__float_as_int(v), 63));
}
__device__ __forceinline__ float wmax(float v) {
    v = fmaxf(v, dppo<0xB1, 0xF>(v)); v = fmaxf(v, dppo<0x4E, 0xF>(v)); v = fmaxf(v, dppo<0x141, 0xF>(v)); v = fmaxf(v, dppo<0x140, 0xF>(v));
    v = fmaxf(v, dppo<0x142, 0xA>(v)); v = fmaxf(v, dppo<0x143, 0xC>(v));
    return __int_as_float(__builtin_amdgcn_readlane(__float_as_int(v), 63));
}
__device__ __forceinline__ float xsum32(float x) { const auto r = __builtin_amdgcn_permlane32_swap(__float_as_uint(x), __float_as_uint(x), false, false); return __uint_as_float(r[0]) + __uint_as_float(r[1]); }
__device__ __forceinline__ float xsum16(float x) { const auto r = __builtin_amdgcn_permlane16_swap(__float_as_uint(x), __float_as_uint(x), false, false); return __uint_as_float(r[0]) + __uint_as_float(r[1]); }
__device__ __forceinline__ float xmax32(float x) { const auto r = __builtin_amdgcn_permlane32_swap(__float_as_uint(x), __float_as_uint(x), false, false); return fmaxf(__uint_as_float(r[0]), __uint_as_float(r[1])); }
__device__ __forceinline__ float xmax16(float x) { const auto r = __builtin_amdgcn_permlane16_swap(__float_as_uint(x), __float_as_uint(x), false, false); return fmaxf(__uint_as_float(r[0]), __uint_as_float(r[1])); }
__device__ __forceinline__ float rsum4(float v0, float v1, float v2, float v3) {
    const auto p = __builtin_amdgcn_permlane32_swap(__float_as_uint(v0), __float_as_uint(v2), false, false);
    const auto q = __builtin_amdgcn_permlane32_swap(__float_as_uint(v1), __float_as_uint(v3), false, false);
    const float P = __uint_as_float(p[0]) + __uint_as_float(p[1]);
    const float Q = __uint_as_float(q[0]) + __uint_as_float(q[1]);
    const auto t = __builtin_amdgcn_permlane16_swap(__float_as_uint(P), __float_as_uint(Q), false, false);
    return __uint_as_float(t[0]) + __uint_as_float(t[1]);
}
__device__ __forceinline__ float rdlane(float v, int l) { return __int_as_float(__builtin_amdgcn_readlane(__float_as_int(v), l)); }
__device__ __forceinline__ unsigned rdlaneu(unsigned v, int l) { return (unsigned)__builtin_amdgcn_readlane((int)v, l); }
__device__ __forceinline__ float dot2bf(unsigned a, unsigned b, float c) {
    return __builtin_amdgcn_fdot2_f32_bf16(__builtin_bit_cast(bf2_t, a), __builtin_bit_cast(bf2_t, b), c, false);
}
template <int CTRL, int RM> __device__ __forceinline__ float dppf(float v) {
    return __int_as_float(__builtin_amdgcn_update_dpp(0, __float_as_int(v), CTRL, RM, 0xF, false));
}
__device__ __forceinline__ float wsum_dpp(float v) {
    v += dppf<0xB1, 0xF>(v);
    v += dppf<0x4E, 0xF>(v);
    v += dppf<0x141, 0xF>(v);
    v += dppf<0x140, 0xF>(v);
    v += dppf<0x142, 0xA>(v);
    v += dppf<0x143, 0xC>(v);
    return rdlane(v, 63);
}
__device__ __forceinline__ float sum16_dpp(float v) {
    v += dppf<0xB1, 0xF>(v); v += dppf<0x4E, 0xF>(v); v += dppf<0x141, 0xF>(v); v += dppf<0x140, 0xF>(v);
    return v;
}
__device__ __forceinline__ float sigmoidf_(float x) { return 1.0f / (1.0f + expf(-x)); }
__device__ __forceinline__ unsigned ordkey(float f) { const unsigned u = __float_as_uint(f); return (u & 0x80000000u) ? ~u : (u | 0x80000000u); }
__device__ __forceinline__ unsigned fixkey20(float f) { const float c = fminf(fmaxf(f, -15.999f), 15.999f); return (unsigned)((int)rintf(c * 32768.0f) + (1 << 19)); }
__device__ __forceinline__ float unordkey(unsigned k) { return __uint_as_float((k & 0x80000000u) ? (k & 0x7fffffffu) : ~k); }

struct Args { const void* in[27]; float* out; unsigned char* ws; int ph_lo, ph_hi; };
struct Frame { LAS unsigned char* lds; int tid, lane, wave, bx, G, gw, ngw; };

struct EpiLora {
    static constexpr bool PERM = true, AFTER_DRAIN = false;
    pg8::bf16_t* O; int ldc; const float* w0; const float* a0;
    __device__ __forceinline__ void operator()(const pg8::f32x4 (&acc)[2][2][4][2], const pg8::Unit& u, int wr, int wc, int fr, int fq) const {
        const int row0 = u.pm * 256 + wr * 64 + fr; const int colt = u.pn * 256; const int type = u.pn >> 2;
        const int col0 = colt + wc * 32 + 8 * fq, ncol0 = col0 & 1023;
        const float* pv = (type == 0) ? w0 : a0;
        pg8::f32x4 bv[2][2];
#pragma unroll
        for (int bj = 0; bj < 2; ++bj)
#pragma unroll
            for (int n = 0; n < 2; ++n) bv[bj][n] = (type < 2) ? *(const pg8::f32x4*)(pv + ncol0 + bj * 128 + 4 * n) : (pg8::f32x4){0.f, 0.f, 0.f, 0.f};
#pragma unroll
        for (int ai = 0; ai < 2; ++ai)
#pragma unroll
            for (int m = 0; m < 4; ++m) { pg8::bf16_t* rowp = O + (size_t)(row0 + ai * 128 + m * 16) * ldc + col0;
#pragma unroll
                for (int bj = 0; bj < 2; ++bj) { pg8::f32x4 v0 = acc[ai][bj][m][0] + bv[bj][0], v1 = acc[ai][bj][m][1] + bv[bj][1];
                    if (type < 2) {
                        const float sc = (type == 0) ? 0.60653066f : 1.0f;
#pragma unroll
                        for (int j = 0; j < 4; ++j) { v0[j] = sc / (1.0f + __expf(-v0[j])); v1[j] = sc / (1.0f + __expf(-v1[j])); }
                    }
                    pg8::u32x4 w; w.x = pg8::cvt_pk_bf16(v0[0], v0[1]); w.y = pg8::cvt_pk_bf16(v0[2], v0[3]); w.z = pg8::cvt_pk_bf16(v1[0], v1[1]); w.w = pg8::cvt_pk_bf16(v1[2], v1[3]);
                    *(pg8::u32x4*)(rowp + bj * 128) = w; } }
    }
};

__device__ __forceinline__ void transpose_item(const float* W, int K, int N, int Npad, bf16* WT, LAS float* scr, int item, int lane) {
    const int nblk = Npad / 32, kb = item / nblk, nb = item % nblk, k0 = 64 * kb, n0 = 32 * nb;
    const int nl = lane & 31; const bool ok = (n0 + nl) < N;
#pragma unroll 8
    for (int i = 0; i < 32; ++i) { const int kk = 2 * i + (lane >> 5); scr[kk * 33 + nl] = ok ? W[(size_t)(k0 + kk) * N + n0 + nl] : 0.f; }
    asm volatile("s_waitcnt lgkmcnt(0)" ::: "memory");
    const int c = lane & 7;
#pragma unroll
    for (int j = 0; j < 4; ++j) { const int n = (lane >> 3) + 8 * j; const LAS float* s = scr + (8 * c) * 33 + n;
        u32x4 o; o.x = pk2(s[0 * 33], s[1 * 33]); o.y = pk2(s[2 * 33], s[3 * 33]); o.z = pk2(s[4 * 33], s[5 * 33]); o.w = pk2(s[6 * 33], s[7 * 33]);
        *(u32x4*)(WT + (size_t)(n0 + n) * K + k0 + 8 * c) = o; }
    asm volatile("s_waitcnt lgkmcnt(0)" ::: "memory");
}

__device__ __forceinline__ void ph_prologue(const Args& A, Frame& F) {
    unsigned char* ws = A.ws;
    {
        const float* c = (const float*)A.in[1]; const float* mw = (const float*)A.in[19]; const float* mb = (const float*)A.in[20];
        float* MOD = (float*)(ws + WS_MOD);
        LAS float* red = (LAS float*)F.lds;
        for (int it = F.bx; it < 96; it += F.G) {
            const int s = it / 24, cc = it % 24, col = cc * 256 + F.lane * 4;
            const float* W = mw + (size_t)s * 2048 * 6144 + col;
            f32x4 a0 = {0.f, 0.f, 0.f, 0.f}, a1 = {0.f, 0.f, 0.f, 0.f};
            const int k0 = F.wave * 256;
#pragma unroll 8
            for (int k = k0; k < k0 + 256; ++k) {
                float c0 = c[k], c1 = c[2048 + k];
                c0 = c0 / (1.0f + expf(-c0)); c1 = c1 / (1.0f + expf(-c1));
                const f32x4 w = *(const f32x4*)(W + (size_t)k * 6144);
                a0 += c0 * w; a1 += c1 * w;
            }
            *(LAS f32x4*)(red + ((F.wave * 2 + 0) * 256 + F.lane * 4)) = a0;
            *(LAS f32x4*)(red + ((F.wave * 2 + 1) * 256 + F.lane * 4)) = a1;
            __syncthreads();
            { const int b = F.tid >> 8, cl = F.tid & 255; float sm = 0.f;
#pragma unroll
              for (int w = 0; w < 8; ++w) sm += red[(w * 2 + b) * 256 + cl];
              MOD[(size_t)(s * 2 + b) * 6144 + cc * 256 + cl] = sm + mb[s * 6144 + cc * 256 + cl]; }
            __syncthreads();
        }
    }
    {
        LAS float* scr = (LAS float*)(F.lds + 16384 + F.wave * 8704);
        constexpr int I0 = 32 * (EV_NP / 32), I1 = 32 * 64, I2 = 32 * (OD_NP / 32);
        constexpr int NIT = I0 + I1 + I2 + 3 * I1;
        for (int it = F.gw; it < NIT; it += F.ngw) {
            int r = it;
            if (r < I0) { transpose_item((const float*)A.in[3], 2048, EV_N, EV_NP, (bf16*)(ws + WS_WINE), scr, r, F.lane); continue; } r -= I0;
            if (r < I1) { transpose_item((const float*)A.in[4], 2048, 2048, 2048, (bf16*)(ws + WS_WOUTE), scr, r, F.lane); continue; } r -= I1;
            if (r < I2) { transpose_item((const float*)A.in[17], 2048, OD_N, OD_NP, (bf16*)(ws + WS_WINO), scr, r, F.lane); continue; } r -= I2;
            if (r < I1) { transpose_item((const float*)A.in[18], 2048, 2048, 2048, (bf16*)(ws + WS_WOUTO), scr, r, F.lane); continue; } r -= I1;
            if (r < I1) { transpose_item((const float*)A.in[23], 2048, 2048, 2048, (bf16*)(ws + WS_WQ0), scr, r, F.lane); continue; } r -= I1;
            transpose_item((const float*)A.in[23] + (size_t)2048 * 2048, 2048, 2048, 2048, (bf16*)(ws + WS_WQ1), scr, r, F.lane);
        }
    }
    {
        const float* w2 = (const float*)A.in[8]; const float* a2 = (const float*)A.in[10]; const float* g2 = (const float*)A.in[11];
        bf16* WL = (bf16*)(ws + WS_WL);
        const int gt = F.bx * NTHREADS + F.tid, ngt = F.G * NTHREADS;
        for (int i = gt; i < 3072 * 512; i += ngt) {
            const int n = i >> 9, k = i & 511; float v = 0.f;
            if (n < 1024) { if (k < 96) v = w2[k * 1024 + n]; }
            else if (n < 2048) { if (k >= 96 && k < 192) v = a2[(k - 96) * 1024 + (n - 1024)]; }
            else { if (k >= 192 && k < 448) v = g2[(k - 192) * 1024 + (n - 2048)]; }
            WL[i] = (bf16)f2bf(v);
        }
        const float* sk = (const float*)A.in[24]; bf16* SKB = (bf16*)(ws + WS_SKB);
        for (int i = gt; i < 2 * 262144; i += ngt) SKB[i] = (bf16)f2bf(sk[i]);
    }
}

__device__ __forceinline__ void ph_mod_x(const Args& A, Frame& F) {
    const float* x = (const float*)A.in[0]; const float* MOD = (const float*)(A.ws + WS_MOD); bf16* H = (bf16*)(A.ws + WS_HY);
    for (int t = F.gw; t < TOK; t += F.ngw) {
        const int b = t >> 14; const float* sh = MOD + (size_t)(0 * 2 + b) * 6144; const float* sc = sh + 2048;
#pragma unroll
        for (int j = 0; j < 8; ++j) { const int idx = j * 256 + F.lane * 4;
            const f32x4 xv = *(const f32x4*)(x + (size_t)t * DM + idx), sv = *(const f32x4*)(sc + idx), hv = *(const f32x4*)(sh + idx);
            const f32x4 o = xv * (1.0f + sv) + hv; u32x2 w; w.x = pk2(o[0], o[1]); w.y = pk2(o[2], o[3]);
            *(u32x2*)(H + (size_t)t * DM + idx) = w; }
    }
}

__device__ __forceinline__ void ph_even_post(const Args& A, Frame& F) {
    bf16* Z = (bf16*)(A.ws + WS_Z); const int* positions = (const int*)A.in[2]; const float* mu = (const float*)A.in[6];
    bf16* RKV = (bf16*)A.out; bf16* LAp = (bf16*)(A.ws + WS_LA);
    const int i = F.lane & 31; const float inv = powf(10000.0f, -(float)i / 32.0f);
    const int i4 = F.lane & 7, hs = F.lane >> 3;
    for (int t = F.gw; t < TOK; t += F.ngw) {
        const int s = t & (SEQ - 1); bf16* zr = Z + (size_t)t * EV_NP;
        float sn, cs; sincosf((float)positions[t] * inv, &sn, &cs);
        float c4[4], s4[4];
#pragma unroll
        for (int e = 0; e < 4; ++e) { c4[e] = __shfl(cs, 4 * i4 + e); s4[e] = __shfl(sn, 4 * i4 + e); }
#pragma unroll
        for (int it = 0; it < 3; ++it) { const int hd = it * 8 + hs; if (hd < 18) { bf16* hp = zr + hd * 64 + 4 * i4;
            const u32x2 a = *(const u32x2*)hp, b = *(const u32x2*)(hp + 32);
            const float t1[4] = {lo2f(a.x), hi2f(a.x), lo2f(a.y), hi2f(a.y)}, t2[4] = {lo2f(b.x), hi2f(b.x), lo2f(b.y), hi2f(b.y)};
            float o1[4], o2[4];
#pragma unroll
            for (int e = 0; e < 4; ++e) { o1[e] = t1[e] * c4[e] - t2[e] * s4[e]; o2[e] = t2[e] * c4[e] + t1[e] * s4[e]; }
            *(u32x2*)hp = (u32x2){pk2(o1[0], o1[1]), pk2(o1[2], o1[3])}; *(u32x2*)(hp + 32) = (u32x2){pk2(o2[0], o2[1]), pk2(o2[2], o2[3])}; } }
        const bf16* zp = zr - EV_NP; const bool hasprev = s > 0;
#pragma unroll
        for (int m = 0; m < 7; ++m) { const int j = 8 * (F.lane + 64 * m); if (j < 3520) {
            const u32x4 cw = *(const u32x4*)(zr + 1280 + j); u32x4 pw = {0u, 0u, 0u, 0u}; if (hasprev) pw = *(const u32x4*)(zp + 1280 + j);
            const f32x4 m0 = *(const f32x4*)(mu + j), m1 = *(const f32x4*)(mu + j + 4);
            const unsigned cwa[4] = {cw.x, cw.y, cw.z, cw.w}, pwa[4] = {pw.x, pw.y, pw.z, pw.w}; const float mm[8] = {m0[0], m0[1], m0[2], m0[3], m1[0], m1[1], m1[2], m1[3]};
            float v[8];
#pragma unroll
            for (int q = 0; q < 4; ++q) { const float c0 = lo2f(cwa[q]), c1 = hi2f(cwa[q]), p0 = lo2f(pwa[q]), p1 = hi2f(pwa[q]); v[2 * q] = c0 + (p0 - c0) * mm[2 * q]; v[2 * q + 1] = c1 + (p1 - c1) * mm[2 * q + 1]; }
            bf16* dst;
            if (j < 3072) { dst = RKV + (size_t)(j >> 10) * TOK * 1024 + (size_t)t * 1024 + (j & 1023); }
            else if (j < 3168) { dst = LAp + (size_t)t * 512 + (j - 3072);
#pragma unroll
                for (int e = 0; e < 8; ++e) v[e] = tanhf(v[e]); }
            else if (j < 3264) { dst = LAp + (size_t)t * 512 + 96 + (j - 3168); }
            else { dst = LAp + (size_t)t * 512 + 192 + (j - 3264);
#pragma unroll
                for (int e = 0; e < 8; ++e) v[e] = sigmoidf_(v[e]); }
            *(u32x4*)dst = (u32x4){pk2(v[0], v[1]), pk2(v[2], v[3]), pk2(v[4], v[5]), pk2(v[6], v[7])};
        } }
        if (F.lane < 8) *(u32x4*)(LAp + (size_t)t * 512 + 448 + 8 * F.lane) = (u32x4){0u, 0u, 0u, 0u};
    }
}

__device__ __forceinline__ void ph_scan_pack(const Args& A, Frame& F) {
    const bf16* Z = (const bf16*)(A.ws + WS_Z); const bf16* RKV = (const bf16*)A.out;
    const float* k_k = (const float*)A.in[12]; const float* k_a = (const float*)A.in[13]; const float* r_k = (const float*)A.in[14];
    unsigned* PK = (unsigned*)(A.ws + WS_BIG); float* BS = (float*)(A.ws + WS_BS);
    const int g16 = F.lane >> 4, c16 = F.lane & 15;
    for (int it = F.gw; it < TOK * 4; it += F.ngw) {
        const int item = it * 4 + g16; const int t = item >> 4, h = item & 15, c = h * 64 + 4 * c16, b = t >> 14, s = t & (SEQ - 1);
        const u32x2 rw = *(const u32x2*)(RKV + (size_t)t * 1024 + c), kw = *(const u32x2*)(RKV + (size_t)TOK * 1024 + (size_t)t * 1024 + c), vw = *(const u32x2*)(RKV + (size_t)2 * TOK * 1024 + (size_t)t * 1024 + c);
        const u32x2 ew = *(const u32x2*)(Z + (size_t)t * EV_NP + 1280 + c), aw = *(const u32x2*)(Z + (size_t)t * EV_NP + 1280 + 1024 + c);
        const f32x4 kk4 = *(const f32x4*)(k_k + c), ka4 = *(const f32x4*)(k_a + c), rk4 = *(const f32x4*)(r_k + c);
        const float r[4] = {lo2f(rw.x), hi2f(rw.x), lo2f(rw.y), hi2f(rw.y)}, kr[4] = {lo2f(kw.x), hi2f(kw.x), lo2f(kw.y), hi2f(kw.y)}, v[4] = {lo2f(vw.x), hi2f(vw.x), lo2f(vw.y), hi2f(vw.y)};
        const float e[4] = {lo2f(ew.x), hi2f(ew.x), lo2f(ew.y), hi2f(ew.y)}, a[4] = {lo2f(aw.x), hi2f(aw.x), lo2f(aw.y), hi2f(aw.y)};
        float kkv[4], kp[4]; float ss = 0.f, bsum = 0.f;
#pragma unroll
        for (int q = 0; q < 4; ++q) { kkv[q] = kr[q] * kk4[q]; ss += kkv[q] * kkv[q]; kp[q] = kr[q] * (1.0f + (a[q] - 1.0f) * ka4[q]); bsum += r[q] * kp[q] * rk4[q]; }
        ss = sum16_dpp(ss); bsum = sum16_dpp(bsum);
        const float rn = 1.0f / fmaxf(sqrtf(ss), 1e-12f);
        if (c16 == 0) BS[(size_t)t * 16 + h] = bsum;
        unsigned w[12];
#pragma unroll
        for (int q = 0; q < 4; ++q) { const float kkn = kkv[q] * rn; w[3 * q] = pk2(r[q], e[q]); w[3 * q + 1] = pk2(kp[q], kkn); w[3 * q + 2] = pk2(kkn * a[q], v[q]); }
        u32x4* dst = (u32x4*)(PK + ((size_t)((b * 16 + h) * SEQ + s) * 64 + 4 * c16) * 3);
        dst[0] = (u32x4){w[0], w[1], w[2], w[3]}; dst[1] = (u32x4){w[4], w[5], w[6], w[7]}; dst[2] = (u32x4){w[8], w[9], w[10], w[11]};
    }
}

__device__ __forceinline__ void ph_swa(const Args& A, Frame& F) {
    const bf16* Z = (const bf16*)(A.ws + WS_Z); bf16* Y = (bf16*)(A.ws + WS_HY); const float* sinks = (const float*)A.in[5];
    LAS unsigned char* KL = F.lds; LAS unsigned char* VL = F.lds + 256 * 136;
    for (int u = F.bx; u < 512; u += F.G) {
        const int b = u >> 8, n = (u >> 1) & 127, kvh = u & 1;
        __syncthreads();
        for (int c = F.tid; c < 2048; c += NTHREADS) { const int jw = c >> 3, cc = c & 7; const int s = n * 128 - 128 + jw;
            u32x4 kv = {0u, 0u, 0u, 0u}, vv = {0u, 0u, 0u, 0u};
            if (s >= 0) { const bf16* row = Z + (size_t)(b * SEQ + s) * EV_NP; kv = *(const u32x4*)(row + 1024 + kvh * 64 + cc * 8); vv = *(const u32x4*)(row + 1152 + kvh * 64 + cc * 8); }
            *(LAS u32x2*)(KL + jw * 136 + cc * 16) = (u32x2){kv.x, kv.y}; *(LAS u32x2*)(KL + jw * 136 + cc * 16 + 8) = (u32x2){kv.z, kv.w};
            *(LAS u32x2*)(VL + jw * 136 + cc * 16) = (u32x2){vv.x, vv.y}; *(LAS u32x2*)(VL + jw * 136 + cc * 16 + 8) = (u32x2){vv.z, vv.w}; }
        __syncthreads();
        for (int it = F.wave; it < 1024; it += NWAVES) {
            const int i = it >> 3, g = it & 7, head = kvh * 8 + g; const int t = b * SEQ + n * 128 + i;
            const float qv = bf2f(Z[(size_t)t * EV_NP + head * 64 + F.lane]) * 0.125f;
            const int jw0 = i + 1 + F.lane, jw1 = jw0 + 64;
            const bool val0 = (n > 0) || (jw0 >= 128), val1 = (n > 0) || (jw1 >= 128);
            float s0 = 0.f, s1 = 0.f;
#pragma unroll
            for (int d4 = 0; d4 < 16; ++d4) {
                const u32x2 k0 = *(const LAS u32x2*)(KL + jw0 * 136 + d4 * 8), k1 = *(const LAS u32x2*)(KL + jw1 * 136 + d4 * 8);
                const float q0 = rdlane(qv, 4 * d4), q1 = rdlane(qv, 4 * d4 + 1), q2 = rdlane(qv, 4 * d4 + 2), q3 = rdlane(qv, 4 * d4 + 3);
                s0 += q0 * lo2f(k0.x) + q1 * hi2f(k0.x) + q2 * lo2f(k0.y) + q3 * hi2f(k0.y);
                s1 += q0 * lo2f(k1.x) + q1 * hi2f(k1.x) + q2 * lo2f(k1.y) + q3 * hi2f(k1.y);
            }
            const float sink = sinks[head];
            s0 = val0 ? s0 : -INFINITY; s1 = val1 ? s1 : -INFINITY;
            const float mx = fmaxf(wmax(fmaxf(s0, s1)), sink);
            float p0 = val0 ? expf(s0 - mx) : 0.f, p1 = val1 ? expf(s1 - mx) : 0.f;
            const float den = wsum(p0 + p1) + expf(sink - mx); const float rden = 1.0f / den;
            p0 *= rden; p1 *= rden;
            float o = 0.f;
            const LAS bf16* vcol = (const LAS bf16*)VL + F.lane;
#pragma unroll 8
            for (int jj = 0; jj < 64; ++jj) o += rdlane(p0, jj) * bf2f(vcol[(i + 1 + jj) * 68]);
#pragma unroll 8
            for (int jj = 0; jj < 64; ++jj) o += rdlane(p1, jj) * bf2f(vcol[(i + 65 + jj) * 68]);
            Y[(size_t)t * DM + head * 64 + F.lane] = (bf16)f2bf(o);
        }
    }
}

__device__ __forceinline__ bf16x8 as_bf8(u32x4 v) { return __builtin_bit_cast(bf16x8, v); }
__device__ __forceinline__ void ph_swa_mfma(const Args& A, Frame& F) {
    const bf16* Z = (const bf16*)(A.ws + WS_Z); bf16* Y = (bf16*)(A.ws + WS_HY); const float* sinks = (const float*)A.in[5];
    LAS bf16* KL = (LAS bf16*)F.lds;
    LAS bf16* VT = (LAS bf16*)(F.lds + 36864);
    const int l15 = F.lane & 15, g4 = F.lane >> 4;
    for (int u = F.bx; u < 512; u += F.G) {
        const int b = u >> 8, n = (u >> 1) & 127, kvh = u & 1;
        __syncthreads();
        for (int c = F.tid; c < 2048; c += NTHREADS) { const int jw = c >> 3, cc = c & 7; const int sp = n * 128 - 128 + jw;
            u32x4 kv = {0u, 0u, 0u, 0u}, vv = {0u, 0u, 0u, 0u};
            if (sp >= 0) { const bf16* row = Z + (size_t)(b * SEQ + sp) * EV_NP; kv = *(const u32x4*)(row + 1024 + kvh * 64 + cc * 8); vv = *(const u32x4*)(row + 1152 + kvh * 64 + cc * 8); }
            *(LAS u32x4*)(KL + jw * 72 + cc * 8) = kv;
            const unsigned vw[4] = {vv.x, vv.y, vv.z, vv.w};
#pragma unroll
            for (int q = 0; q < 4; ++q) { VT[(8 * cc + 2 * q) * 264 + jw] = (bf16)(vw[q] & 0xffffu); VT[(8 * cc + 2 * q + 1) * 264 + jw] = (bf16)(vw[q] >> 16); } }
        __syncthreads();
        const int head = kvh * 8 + F.wave; const float sink = sinks[head];
#pragma unroll 1
        for (int qt = 0; qt < 8; ++qt) {
            const int iq = 16 * qt + l15; const int t = b * SEQ + n * 128 + iq;
            bf16x8 qf[2];
#pragma unroll
            for (int ks = 0; ks < 2; ++ks) qf[ks] = *(const bf16x8*)(Z + (size_t)t * EV_NP + head * 64 + 32 * ks + 8 * g4);
            float sv[10][4]; float mx = -INFINITY;
#pragma unroll
            for (int kk = 0; kk < 9; ++kk) { const int kt = qt + kk;
                f32x4 acc = {0.f, 0.f, 0.f, 0.f};
#pragma unroll
                for (int ks = 0; ks < 2; ++ks) acc = __builtin_amdgcn_mfma_f32_16x16x32_bf16(*(const LAS bf16x8*)(KL + (16 * kt + l15) * 72 + 32 * ks + 8 * g4), qf[ks], acc, 0, 0, 0);
#pragma unroll
                for (int rg_ = 0; rg_ < 4; ++rg_) { const int jw = 16 * kt + 4 * g4 + rg_; const bool ok = (jw >= iq + 1) && (jw <= iq + 128) && ((n > 0) || (jw >= 128));
                    sv[kk][rg_] = ok ? acc[rg_] * 0.125f : -INFINITY; mx = fmaxf(mx, sv[kk][rg_]); } }
#pragma unroll
            for (int rg_ = 0; rg_ < 4; ++rg_) sv[9][rg_] = -INFINITY;
            mx = xmax16(mx); mx = xmax32(mx); mx = fmaxf(mx, sink);
            float sm = 0.f;
#pragma unroll
            for (int kk = 0; kk < 10; ++kk)
#pragma unroll
                for (int rg_ = 0; rg_ < 4; ++rg_) { const float pv = (sv[kk][rg_] == -INFINITY) ? 0.f : __expf(sv[kk][rg_] - mx); sv[kk][rg_] = pv; sm += pv; }
            sm = xsum16(sm); sm = xsum32(sm);
            const float rden = 1.0f / (sm + __expf(sink - mx));
            f32x4 oacc[4];
#pragma unroll
            for (int dt = 0; dt < 4; ++dt) oacc[dt] = (f32x4){0.f, 0.f, 0.f, 0.f};
#pragma unroll
            for (int pp = 0; pp < 5; ++pp) { const int ka = qt + 2 * pp, kb = (qt + 2 * pp + 1 < 16) ? (qt + 2 * pp + 1) : 15;
                const bf16x8 pb = as_bf8((u32x4){pk2(sv[2 * pp][0] * rden, sv[2 * pp][1] * rden), pk2(sv[2 * pp][2] * rden, sv[2 * pp][3] * rden),
                                                  pk2(sv[2 * pp + 1][0] * rden, sv[2 * pp + 1][1] * rden), pk2(sv[2 * pp + 1][2] * rden, sv[2 * pp + 1][3] * rden)});
#pragma unroll
                for (int dt = 0; dt < 4; ++dt) { const LAS bf16* vr = VT + (16 * dt + l15) * 264 + 4 * g4;
                    const u32x2 va = *(const LAS u32x2*)(vr + 16 * ka), vb2 = *(const LAS u32x2*)(vr + 16 * kb);
                    oacc[dt] = __builtin_amdgcn_mfma_f32_16x16x32_bf16(as_bf8((u32x4){va.x, va.y, vb2.x, vb2.y}), pb, oacc[dt], 0, 0, 0); } }
#pragma unroll
            for (int dt = 0; dt < 4; ++dt) *(u32x2*)(Y + (size_t)t * DM + head * 64 + 16 * dt + 4 * g4) = (u32x2){pk2(oacc[dt][0], oacc[dt][1]), pk2(oacc[dt][2], oacc[dt][3])};
        }
    }
}

constexpr int FR_BYTES = 15360;
__device__ __forceinline__ int fr_rho(int ks, int g, int j) { return 16 * (2 * ks + (j >> 2)) + 4 * g + (j & 3); }
__device__ __forceinline__ void ph_scan_prep(const Args& A, Frame& F) {
    const bf16* Z = (const bf16*)(A.ws + WS_Z); const bf16* RKV = (const bf16*)A.out;
    const float* k_k = (const float*)A.in[12]; const float* k_a = (const float*)A.in[13]; const float* r_k = (const float*)A.in[14];
    unsigned char* FR = A.ws + WS_BIG; float* BS = (float*)(A.ws + WS_BS);
    LAS float* EE = (LAS float*)F.lds;
    LAS float* VV = (LAS float*)(F.lds + 4096);
    LAS float* KHf = (LAS float*)(F.lds + 8192);
    LAS float* RHf = (LAS float*)(F.lds + 12352);
    LAS float* BPf = (LAS float*)(F.lds + 16512);
    LAS bf16* AHb = (LAS bf16*)(F.lds + 20672);
    LAS bf16* BHb = (LAS bf16*)(F.lds + 22976);
    LAS bf16* KHb = (LAS bf16*)(F.lds + 25280);
    LAS bf16* RHb = (LAS bf16*)(F.lds + 27584);
    LAS bf16* APT = (LAS bf16*)(F.lds + 29888);
    LAS float* GA = (LAS float*)(F.lds + 32960);
    LAS float* GB = GA + 16 * 17; LAS float* GMA = GB + 16 * 17; LAS float* GMB = GMA + 16 * 17;
    LAS float* TT = (LAS float*)(F.lds + 37312);
    LAS bf16* P1b = (LAS bf16*)(F.lds + 38400);
    LAS bf16* P2b = (LAS bf16*)(F.lds + 41472);
    LAS bf16* MAT = (LAS bf16*)(F.lds + 42240);
    LAS float* WW = (LAS float*)(F.lds + 43008);
    const int tt = F.tid >> 5, kq = F.tid & 31;
    const int l15 = F.lane & 15, g = F.lane >> 4;
    const bf16x8 zero8 = {0, 0, 0, 0, 0, 0, 0, 0};
    for (int it = F.bx; it < 32 * 1024; it += F.G) {
        const int bh = it >> 10, ch = it & 1023, b = bh >> 4, h = bh & 15;
        const int tok = b * SEQ + ch * 16 + tt, c = h * 64 + 2 * kq;
        __syncthreads();
        float e2[2], kkn[2], kka[2], kp[2], r2[2];
        {
            const unsigned rw = *(const unsigned*)(RKV + (size_t)tok * 1024 + c), kw = *(const unsigned*)(RKV + (size_t)TOK * 1024 + (size_t)tok * 1024 + c), vw = *(const unsigned*)(RKV + (size_t)2 * TOK * 1024 + (size_t)tok * 1024 + c);
            const unsigned ew = *(const unsigned*)(Z + (size_t)tok * EV_NP + 1280 + c), aw = *(const unsigned*)(Z + (size_t)tok * EV_NP + 1280 + 1024 + c);
            const float kr[2] = {lo2f(kw), hi2f(kw)}, av[2] = {lo2f(aw), hi2f(aw)};
            r2[0] = lo2f(rw); r2[1] = hi2f(rw); e2[0] = lo2f(ew); e2[1] = hi2f(ew);
            float kkv[2], ss = 0.f, bsum = 0.f;
#pragma unroll
            for (int q = 0; q < 2; ++q) { kkv[q] = kr[q] * k_k[c + q]; ss += kkv[q] * kkv[q]; kp[q] = kr[q] * (1.0f + (av[q] - 1.0f) * k_a[c + q]); bsum += r2[q] * kp[q] * r_k[c + q]; }
            ss = xsum16(sum16_dpp(ss)); bsum = xsum16(sum16_dpp(bsum));
            const float rn = 1.0f / fmaxf(sqrtf(ss), 1e-12f);
#pragma unroll
            for (int q = 0; q < 2; ++q) { kkn[q] = kkv[q] * rn; kka[q] = kkn[q] * av[q]; }
            if (kq == 0) BS[(size_t)tok * 16 + h] = bsum;
            *(LAS f32x2*)(EE + tt * 64 + 2 * kq) = (f32x2){e2[0], e2[1]};
            *(LAS f32x2*)(VV + tt * 64 + 2 * kq) = (f32x2){lo2f(vw), hi2f(vw)};
        }
        __syncthreads();
        {
            float L[2] = {0.f, 0.f}, L15[2] = {0.f, 0.f};
#pragma unroll
            for (int i = 0; i < 16; ++i) { const f32x2 ev = *(const LAS f32x2*)(EE + i * 64 + 2 * kq); L15[0] += ev.x; L15[1] += ev.y; if (i <= tt) { L[0] += ev.x; L[1] += ev.y; } }
            float kh[2], ah[2], bhv[2], rh[2], ap[2], bp[2];
#pragma unroll
            for (int q = 0; q < 2; ++q) { const float wt = __expf(-L[q]), iwt = __expf(L[q]), wprev = __expf(-(L[q] - e2[q])), wrest = __expf(-(L15[q] - L[q]));
                kh[q] = kkn[q] * wprev; ah[q] = kka[q] * iwt; bhv[q] = kp[q] * iwt; rh[q] = r2[q] * wt; ap[q] = kka[q] * wrest; bp[q] = kp[q] * wrest;
                if (tt == 15) WW[2 * kq + q] = wt; }
            KHf[tt * 65 + 2 * kq] = kh[0]; KHf[tt * 65 + 2 * kq + 1] = kh[1]; RHf[tt * 65 + 2 * kq] = rh[0]; RHf[tt * 65 + 2 * kq + 1] = rh[1]; BPf[tt * 65 + 2 * kq] = bp[0]; BPf[tt * 65 + 2 * kq + 1] = bp[1];
            *(LAS unsigned*)(KHb + tt * 72 + 2 * kq) = pk2(kh[0], kh[1]); *(LAS unsigned*)(AHb + tt * 72 + 2 * kq) = pk2(ah[0], ah[1]);
            *(LAS unsigned*)(BHb + tt * 72 + 2 * kq) = pk2(bhv[0], bhv[1]); *(LAS unsigned*)(RHb + tt * 72 + 2 * kq) = pk2(rh[0], rh[1]);
            APT[(2 * kq) * 24 + tt] = (bf16)f2bf(ap[0]); APT[(2 * kq + 1) * 24 + tt] = (bf16)f2bf(ap[1]);
        }
        __syncthreads();
        if (F.wave < 4) {
            const int mat = F.wave; const LAS bf16* X = (mat & 1) ? BHb : AHb; const LAS bf16* Y = (mat & 2) ? RHb : KHb;
            f32x4 acc = {0.f, 0.f, 0.f, 0.f};
#pragma unroll
            for (int ks = 0; ks < 2; ++ks) acc = __builtin_amdgcn_mfma_f32_16x16x32_bf16(*(const LAS bf16x8*)(X + l15 * 72 + 32 * ks + 8 * g), *(const LAS bf16x8*)(Y + l15 * 72 + 32 * ks + 8 * g), acc, 0, 0, 0);
            LAS float* dst = (mat == 0) ? GA : ((mat == 1) ? GB : ((mat == 2) ? GMA : GMB));
#pragma unroll
            for (int rg_ = 0; rg_ < 4; ++rg_) { const int i = 4 * g + rg_; const bool nz = (mat & 2) ? (i <= l15) : (i < l15); const float v = nz ? acc[rg_] : 0.f;
                dst[i * 17 + l15] = v; if (mat == 2) MAT[l15 * 24 + i] = (bf16)f2bf(v); }
        }
        __syncthreads();
        if (F.tid < 16) {
            float x[16];
#pragma unroll
            for (int i = 15; i >= 0; --i) { float v = (i == F.tid) ? 1.0f : 0.f;
#pragma unroll
                for (int m = i + 1; m < 16; ++m) v -= GA[i * 17 + m] * x[m];
                x[i] = v; }
#pragma unroll
            for (int i = 0; i < 16; ++i) TT[i * 17 + F.tid] = x[i];
        }
        __syncthreads();
        {
            float x0 = 0.f, x1 = 0.f;
#pragma unroll
            for (int m = 0; m < 16; ++m) { const float tv = TT[m * 17 + tt]; x0 -= KHf[m * 65 + 2 * kq] * tv; x1 -= KHf[m * 65 + 2 * kq + 1] * tv; }
            P1b[(2 * kq) * 24 + tt] = (bf16)f2bf(x0); P1b[(2 * kq + 1) * 24 + tt] = (bf16)f2bf(x1);
            if (F.tid < 256) { const int i = F.tid >> 4, t = F.tid & 15; float x = 0.f;
#pragma unroll
                for (int m = 0; m < 16; ++m) x -= GB[i * 17 + m] * TT[m * 17 + t];
                P2b[i * 24 + t] = (bf16)f2bf(x); }
        }
        __syncthreads();
        {
            unsigned char* fr = FR + (size_t)it * FR_BYTES;
            const int mt = F.wave >> 1, ks = F.wave & 1;
            const bf16x8 aP0 = (g < 2) ? *(const LAS bf16x8*)(P1b + (16 * (2 * ks) + l15) * 24 + 8 * g) : zero8;
            const bf16x8 aP1 = (g < 2) ? *(const LAS bf16x8*)(P1b + (16 * (2 * ks + 1) + l15) * 24 + 8 * g) : zero8;
            const bf16x8 bAP = (g < 2) ? *(const LAS bf16x8*)(APT + (16 * mt + l15) * 24 + 8 * g) : zero8;
            const f32x4 z4 = {0.f, 0.f, 0.f, 0.f};
            const f32x4 d0 = __builtin_amdgcn_mfma_f32_16x16x32_bf16(aP0, bAP, z4, 0, 0, 0), d1 = __builtin_amdgcn_mfma_f32_16x16x32_bf16(aP1, bAP, z4, 0, 0, 0);
            *(u32x4*)(fr + (size_t)(F.wave * 64 + F.lane) * 16) = (u32x4){pk2(d0[0], d0[1]), pk2(d0[2], d0[3]), pk2(d1[0], d1[1]), pk2(d1[2], d1[3])};
            if (F.wave < 4) {
                const bf16x8 aP2 = (g < 2) ? *(const LAS bf16x8*)(P2b + l15 * 24 + 8 * g) : zero8;
                const bf16x8 bA = (g < 2) ? *(const LAS bf16x8*)(APT + (16 * F.wave + l15) * 24 + 8 * g) : zero8;
                f32x4 d = __builtin_amdgcn_mfma_f32_16x16x32_bf16(aP2, bA, z4, 0, 0, 0);
#pragma unroll
                for (int rg_ = 0; rg_ < 4; ++rg_) d[rg_] += BPf[(4 * g + rg_) * 65 + 16 * F.wave + l15];
                *(u32x2*)(fr + 8192 + (size_t)(F.wave * 64 + F.lane) * 8) = (u32x2){pk2(d[0], d[1]), pk2(d[2], d[3])};
            } else if (F.wave < 6) {
                const int ks2 = F.wave - 4;
                const bf16x8 a0 = (g < 2) ? *(const LAS bf16x8*)(P1b + (16 * (2 * ks2) + l15) * 24 + 8 * g) : zero8;
                const bf16x8 a1 = (g < 2) ? *(const LAS bf16x8*)(P1b + (16 * (2 * ks2 + 1) + l15) * 24 + 8 * g) : zero8;
                const bf16x8 bM = (g < 2) ? *(const LAS bf16x8*)(MAT + l15 * 24 + 8 * g) : zero8;
                f32x4 q0 = __builtin_amdgcn_mfma_f32_16x16x32_bf16(a0, bM, z4, 0, 0, 0), q1 = __builtin_amdgcn_mfma_f32_16x16x32_bf16(a1, bM, z4, 0, 0, 0);
#pragma unroll
                for (int rg_ = 0; rg_ < 4; ++rg_) { q0[rg_] += RHf[l15 * 65 + 16 * (2 * ks2) + 4 * g + rg_]; q1[rg_] += RHf[l15 * 65 + 16 * (2 * ks2 + 1) + 4 * g + rg_]; }
                *(u32x4*)(fr + 10240 + (size_t)(ks2 * 64 + F.lane) * 16) = (u32x4){pk2(q0[0], q0[1]), pk2(q0[2], q0[3]), pk2(q1[0], q1[1]), pk2(q1[2], q1[3])};
            } else if (F.wave == 6) {
                const bf16x8 aP2 = (g < 2) ? *(const LAS bf16x8*)(P2b + l15 * 24 + 8 * g) : zero8;
                const bf16x8 bM = (g < 2) ? *(const LAS bf16x8*)(MAT + l15 * 24 + 8 * g) : zero8;
                f32x4 d = __builtin_amdgcn_mfma_f32_16x16x32_bf16(aP2, bM, z4, 0, 0, 0);
#pragma unroll
                for (int rg_ = 0; rg_ < 4; ++rg_) d[rg_] += GMB[(4 * g + rg_) * 17 + l15];
                *(u32x2*)(fr + 12288 + (size_t)F.lane * 8) = (u32x2){pk2(d[0], d[1]), pk2(d[2], d[3])};
            } else {
                *(float*)(fr + 14848 + F.lane * 4) = WW[F.lane];
            }
            if (F.tid < 256) {
                const int rg = F.tid >> 6, row = 16 * rg + l15, s4 = 4 * g;
                *(u32x2*)(fr + 12800 + (size_t)(rg * 64 + F.lane) * 8) = (u32x2){pk2(VV[s4 * 64 + row], VV[(s4 + 1) * 64 + row]), pk2(VV[(s4 + 2) * 64 + row], VV[(s4 + 3) * 64 + row])};
            }
        }
    }
}
struct ScanFrag { u32x4 g[4][2]; u32x2 f[4]; u32x4 q1[2]; u32x2 q2; u32x2 vt; f32x4 w[4]; };
__device__ __forceinline__ void scan_frag_load(ScanFrag& fr, const unsigned char* base, int rg, int lane) {
#pragma unroll
    for (int mt = 0; mt < 4; ++mt) {
#pragma unroll
        for (int ks = 0; ks < 2; ++ks) fr.g[mt][ks] = *(const u32x4*)(base + (size_t)((mt * 2 + ks) * 64 + lane) * 16);
        fr.f[mt] = *(const u32x2*)(base + 8192 + (size_t)(mt * 64 + lane) * 8);
        fr.w[mt] = *(const f32x4*)(base + 14848 + (16 * mt + 4 * (lane >> 4)) * 4); }
#pragma unroll
    for (int ks = 0; ks < 2; ++ks) fr.q1[ks] = *(const u32x4*)(base + 10240 + (size_t)(ks * 64 + lane) * 16);
    fr.q2 = *(const u32x2*)(base + 12288 + (size_t)lane * 8);
    fr.vt = *(const u32x2*)(base + 12800 + (size_t)(rg * 64 + lane) * 8);
}
__device__ __forceinline__ void scan_chunk(f32x4 (&acc)[4], const ScanFrag& fr, bf16* yout) {
    const bf16x8 sb0 = as_bf8((u32x4){pk2(acc[0][0], acc[0][1]), pk2(acc[0][2], acc[0][3]), pk2(acc[1][0], acc[1][1]), pk2(acc[1][2], acc[1][3])});
    const bf16x8 sb1 = as_bf8((u32x4){pk2(acc[2][0], acc[2][1]), pk2(acc[2][2], acc[2][3]), pk2(acc[3][0], acc[3][1]), pk2(acc[3][2], acc[3][3])});
    const bf16x8 vb = as_bf8((u32x4){fr.vt.x, fr.vt.y, 0u, 0u});
#pragma unroll
    for (int c = 0; c < 4; ++c) { f32x4 n = acc[c] * fr.w[c];
        n = __builtin_amdgcn_mfma_f32_16x16x32_bf16(as_bf8(fr.g[c][0]), sb0, n, 0, 0, 0);
        n = __builtin_amdgcn_mfma_f32_16x16x32_bf16(as_bf8(fr.g[c][1]), sb1, n, 0, 0, 0);
        n = __builtin_amdgcn_mfma_f32_16x16x32_bf16(as_bf8((u32x4){fr.f[c].x, fr.f[c].y, 0u, 0u}), vb, n, 0, 0, 0);
        acc[c] = n; }
    f32x4 y = {0.f, 0.f, 0.f, 0.f};
    y = __builtin_amdgcn_mfma_f32_16x16x32_bf16(as_bf8(fr.q1[0]), sb0, y, 0, 0, 0);
    y = __builtin_amdgcn_mfma_f32_16x16x32_bf16(as_bf8(fr.q1[1]), sb1, y, 0, 0, 0);
    y = __builtin_amdgcn_mfma_f32_16x16x32_bf16(as_bf8((u32x4){fr.q2.x, fr.q2.y, 0u, 0u}), vb, y, 0, 0, 0);
    *(u32x2*)yout = (u32x2){pk2(y[0], y[1]), pk2(y[2], y[3])};
}
#define SCAN_ASM_LD4(dst, ptr, off) asm volatile("global_load_dwordx4 %0, %1, off offset:" #off : "=v"(dst) : "v"(ptr))
#define SCAN_ASM_LD2(dst, ptr, off) asm volatile("global_load_dwordx2 %0, %1, off offset:" #off : "=v"(dst) : "v"(ptr))
__device__ __forceinline__ void scan_frag_issue(ScanFrag& fr, const unsigned char* item, int rg, int lane) {
    const unsigned char* pg0 = item + lane * 16; const unsigned char* pg1 = pg0 + 4096;
    const unsigned char* pf = item + 8192 + lane * 8; const unsigned char* pq1 = item + 10240 + lane * 16;
    const unsigned char* pq2 = item + 12288 + lane * 8; const unsigned char* pvt = item + 12800 + (rg * 64 + lane) * 8; const unsigned char* pw = item + 14848 + (lane >> 4) * 16;
    SCAN_ASM_LD4(fr.g[0][0], pg0, 0); SCAN_ASM_LD4(fr.g[0][1], pg0, 1024); SCAN_ASM_LD4(fr.g[1][0], pg0, 2048); SCAN_ASM_LD4(fr.g[1][1], pg0, 3072);
    SCAN_ASM_LD4(fr.g[2][0], pg1, 0); SCAN_ASM_LD4(fr.g[2][1], pg1, 1024); SCAN_ASM_LD4(fr.g[3][0], pg1, 2048); SCAN_ASM_LD4(fr.g[3][1], pg1, 3072);
    SCAN_ASM_LD2(fr.f[0], pf, 0); SCAN_ASM_LD2(fr.f[1], pf, 512); SCAN_ASM_LD2(fr.f[2], pf, 1024); SCAN_ASM_LD2(fr.f[3], pf, 1536);
    SCAN_ASM_LD4(fr.q1[0], pq1, 0); SCAN_ASM_LD4(fr.q1[1], pq1, 1024);
    SCAN_ASM_LD2(fr.q2, pq2, 0); SCAN_ASM_LD2(fr.vt, pvt, 0);
    SCAN_ASM_LD4(fr.w[0], pw, 0); SCAN_ASM_LD4(fr.w[1], pw, 64); SCAN_ASM_LD4(fr.w[2], pw, 128); SCAN_ASM_LD4(fr.w[3], pw, 192);
}
#define SCAN_WAIT(fr, N) asm volatile("s_waitcnt vmcnt(" #N ")" : "+v"(fr.g[0][0]), "+v"(fr.g[0][1]), "+v"(fr.g[1][0]), "+v"(fr.g[1][1]), "+v"(fr.g[2][0]), "+v"(fr.g[2][1]), "+v"(fr.g[3][0]), "+v"(fr.g[3][1]), \
        "+v"(fr.f[0]), "+v"(fr.f[1]), "+v"(fr.f[2]), "+v"(fr.f[3]), "+v"(fr.q1[0]), "+v"(fr.q1[1]), "+v"(fr.q2), "+v"(fr.vt), "+v"(fr.w[0]), "+v"(fr.w[1]), "+v"(fr.w[2]), "+v"(fr.w[3]) :: "memory")
__device__ __forceinline__ void scan_mfma_rows(const Args& A, Frame& F) {
    const unsigned char* FR = A.ws + WS_BIG; bf16* YRAW = (bf16*)A.out + (size_t)3 * TOK * 1024;
    if (F.wave != 0) return;
    for (int u = F.bx; u < 128; u += F.G) {
        const int bh = u & 31, rg = u >> 5; const unsigned char* base = FR + (size_t)bh * 1024 * FR_BYTES;
        bf16* yrow = YRAW + ((size_t)bh * 64 + 16 * rg + (F.lane & 15)) * SEQ + 4 * (F.lane >> 4);
        f32x4 acc[4];
#pragma unroll
        for (int c = 0; c < 4; ++c) acc[c] = (f32x4){0.f, 0.f, 0.f, 0.f};
        ScanFrag fa, fb;
        scan_frag_issue(fa, base, rg, F.lane);
#pragma unroll 1
        for (int ch = 0; ch < 1024; ch += 2) {
            scan_frag_issue(fb, base + (size_t)(ch + 1) * FR_BYTES, rg, F.lane);
            SCAN_WAIT(fa, 20);
            scan_chunk(acc, fa, yrow + ch * 16);
            scan_frag_issue(fa, base + (size_t)((ch + 2 < 1024) ? (ch + 2) : ch) * FR_BYTES, rg, F.lane);
            SCAN_WAIT(fb, 20);
            scan_chunk(acc, fb, yrow + (ch + 1) * 16);
        }
        asm volatile("s_waitcnt vmcnt(0)" ::: "memory");
    }
}

__device__ __forceinline__ void pair_sync(volatile LAS unsigned* cnt, unsigned target) {
    asm volatile("s_waitcnt vmcnt(0) lgkmcnt(0)" ::: "memory");
    if ((threadIdx.x & 63) == 0) (void)__hip_atomic_fetch_add((LAS unsigned*)cnt, 1u, __ATOMIC_RELAXED, __HIP_MEMORY_SCOPE_WORKGROUP);
    while (__hip_atomic_load((LAS unsigned*)cnt, __ATOMIC_RELAXED, __HIP_MEMORY_SCOPE_WORKGROUP) < target) __builtin_amdgcn_s_sleep(1);
    asm volatile("" ::: "memory");
}
__device__ __forceinline__ void swa_pairs(const Args& A, Frame& F, volatile LAS unsigned* MISC) {
    const bf16* Z = (const bf16*)(A.ws + WS_Z); bf16* Y = (bf16*)(A.ws + WS_HY); const float* sinks = (const float*)A.in[5];
    const int pr = (F.wave - 4) >> 1, mem = F.wave & 1;
    LAS unsigned char* KL = F.lds + pr * 69632; LAS unsigned char* VL = KL + 256 * 136;
    volatile LAS unsigned* cnt = MISC + 24 + pr; unsigned gen = 0u;
    for (int u = F.bx * 2 + pr; u < 512; u += F.G * 2) {
        const int b = u >> 8, n = (u >> 1) & 127, kvh = u & 1;
        gen += 2u; pair_sync(cnt, gen);
#pragma unroll 1
        for (int c0 = mem * 1024 + F.lane; c0 < mem * 1024 + 1024; c0 += 64 * 8) {
            u32x4 kv[8], vv[8];
#pragma unroll
            for (int q = 0; q < 8; ++q) { const int c = c0 + 64 * q; const int jw = c >> 3, cc = c & 7; const int sp = n * 128 - 128 + jw;
                kv[q] = (u32x4){0u, 0u, 0u, 0u}; vv[q] = kv[q];
                if (sp >= 0) { const bf16* row = Z + (size_t)(b * SEQ + sp) * EV_NP; kv[q] = *(const u32x4*)(row + 1024 + kvh * 64 + cc * 8); vv[q] = *(const u32x4*)(row + 1152 + kvh * 64 + cc * 8); } }
#pragma unroll
            for (int q = 0; q < 8; ++q) { const int c = c0 + 64 * q; const int jw = c >> 3, cc = c & 7;
                *(LAS u32x2*)(KL + jw * 136 + cc * 16) = (u32x2){kv[q].x, kv[q].y}; *(LAS u32x2*)(KL + jw * 136 + cc * 16 + 8) = (u32x2){kv[q].z, kv[q].w};
                *(LAS u32x2*)(VL + jw * 136 + cc * 16) = (u32x2){vv[q].x, vv[q].y}; *(LAS u32x2*)(VL + jw * 136 + cc * 16 + 8) = (u32x2){vv[q].z, vv[q].w}; }
        }
        gen += 2u; pair_sync(cnt, gen);
        for (int it = mem; it < 1024; it += 2) {
            const int i = it >> 3, g = it & 7, head = kvh * 8 + g; const int t = b * SEQ + n * 128 + i;
            const float qv = bf2f(Z[(size_t)t * EV_NP + head * 64 + F.lane]) * 0.125f;
            const int jw0 = i + 1 + F.lane, jw1 = jw0 + 64;
            const bool val0 = (n > 0) || (jw0 >= 128), val1 = (n > 0) || (jw1 >= 128);
            float s0 = 0.f, s1 = 0.f;
#pragma unroll
            for (int d4 = 0; d4 < 16; ++d4) {
                const u32x2 k0 = *(const LAS u32x2*)(KL + jw0 * 136 + d4 * 8), k1 = *(const LAS u32x2*)(KL + jw1 * 136 + d4 * 8);
                const float q0 = rdlane(qv, 4 * d4), q1 = rdlane(qv, 4 * d4 + 1), q2 = rdlane(qv, 4 * d4 + 2), q3 = rdlane(qv, 4 * d4 + 3);
                s0 += q0 * lo2f(k0.x) + q1 * hi2f(k0.x) + q2 * lo2f(k0.y) + q3 * hi2f(k0.y);
                s1 += q0 * lo2f(k1.x) + q1 * hi2f(k1.x) + q2 * lo2f(k1.y) + q3 * hi2f(k1.y);
            }
            const float sink = sinks[head];
            s0 = val0 ? s0 : -INFINITY; s1 = val1 ? s1 : -INFINITY;
            const float mx = fmaxf(wmax(fmaxf(s0, s1)), sink);
            float p0 = val0 ? expf(s0 - mx) : 0.f, p1 = val1 ? expf(s1 - mx) : 0.f;
            const float den = wsum(p0 + p1) + expf(sink - mx); const float rden = 1.0f / den;
            p0 *= rden; p1 *= rden;
            float o = 0.f;
            const LAS bf16* vcol = (const LAS bf16*)VL + F.lane;
#pragma unroll 8
            for (int jj = 0; jj < 64; ++jj) o += rdlane(p0, jj) * bf2f(vcol[(i + 1 + jj) * 68]);
#pragma unroll 8
            for (int jj = 0; jj < 64; ++jj) o += rdlane(p1, jj) * bf2f(vcol[(i + 65 + jj) * 68]);
            Y[(size_t)t * DM + head * 64 + F.lane] = (bf16)f2bf(o);
        }
    }
}

__device__ __forceinline__ void wsum2_dpp(float a, float b, float& ra, float& rb) {
    const auto r = __builtin_amdgcn_permlane32_swap(__float_as_uint(a), __float_as_uint(b), false, false);
    float v = __uint_as_float(r[0]) + __uint_as_float(r[1]);
    v += dppf<0xB1, 0xF>(v); v += dppf<0x4E, 0xF>(v); v += dppf<0x141, 0xF>(v); v += dppf<0x140, 0xF>(v);
    v += dppf<0x142, 0xA>(v);
    ra = rdlane(v, 31); rb = rdlane(v, 63);
}
__device__ __forceinline__ void ph_scan(const Args& A, Frame& F, volatile LAS unsigned* MISC) {
    const unsigned* PK = (const unsigned*)(A.ws + WS_BIG); bf16* YRAW = (bf16*)A.out + (size_t)3 * TOK * 1024;
    if (F.wave >= 4) { swa_pairs(A, F, MISC); return; }
    __builtin_amdgcn_s_setprio(3);
    for (int pp = F.bx * 4 + F.wave; pp < 1024; pp += F.G * 4) {
        const int rr = 2 * pp, bh = rr >> 6, vrow = rr & 63;
        const unsigned* pk = PK + ((size_t)bh * SEQ * 64 + F.lane) * 3;
        bf16* youtA = YRAW + ((size_t)bh * 64 + vrow) * SEQ; bf16* youtB = youtA + SEQ;
        f32x2 S2 = {0.f, 0.f};
        for (int t0 = 0; t0 < SEQ; t0 += 64) {
            float ykA = 0.f, ykB = 0.f;
#pragma unroll 8
            for (int j = 0; j < 64; ++j) {
                const unsigned* p = pk + (size_t)(t0 + j) * 192;
                const unsigned w0 = p[0], w1 = p[1], w2 = p[2];
                const float r = lo2f(w0), e = hi2f(w0), kp = lo2f(w1), kk = hi2f(w1), kka = lo2f(w2), vv = hi2f(w2);
                const f32x2 v2 = {rdlane(vv, vrow), rdlane(vv, vrow + 1)};
                const float dec = __expf(-e);
                const f32x2 pk2v = S2 * (f32x2){kk, kk};
                float saA, saB; wsum2_dpp(pk2v.x, pk2v.y, saA, saB); const f32x2 sa2 = {saA, saB};
                S2 = S2 * (f32x2){dec, dec} + (v2 * (f32x2){kp, kp} - sa2 * (f32x2){kka, kka});
                const f32x2 py = S2 * (f32x2){r, r};
                float yA, yB; wsum2_dpp(py.x, py.y, yA, yB);
                ykA = (F.lane == j) ? yA : ykA; ykB = (F.lane == j) ? yB : ykB;
            }
            youtA[t0 + F.lane] = (bf16)f2bf(ykA); youtB[t0 + F.lane] = (bf16)f2bf(ykB);
        }
    }
    __builtin_amdgcn_s_setprio(0);
}

__device__ __forceinline__ void ph_rwkv_finish(const Args& A, Frame& F) {
    const bf16* Z = (const bf16*)(A.ws + WS_Z); const bf16* RKV = (const bf16*)A.out; const bf16* YRAW = (const bf16*)A.out + (size_t)3 * TOK * 1024;
    const float* BS = (const float*)(A.ws + WS_BS); bf16* Y = (bf16*)(A.ws + WS_HY);
    const float* lnx_g = (const float*)A.in[15]; const float* lnx_b = (const float*)A.in[16];
    LAS float* tile = (LAS float*)(F.lds + F.wave * 16640);
    for (int it = F.gw; it < 8192; it += F.ngw) {
        const int bh = it >> 8, tb = it & 255, b = bh >> 4, h = bh & 15, t0 = tb * 64;
        for (int vr = 0; vr < 64; ++vr) tile[vr * 65 + F.lane] = bf2f(YRAW[((size_t)bh * 64 + vr) * SEQ + t0 + F.lane]);
        asm volatile("s_waitcnt lgkmcnt(0)" ::: "memory");
        const int c = h * 64 + F.lane; const float lg = lnx_g[c], lb = lnx_b[c];
        for (int j = 0; j < 64; ++j) {
            const int t = b * SEQ + t0 + j;
            const float y = tile[F.lane * 65 + j];
            const float mean = wsum(y) * (1.0f / 64.0f); const float d = y - mean; const float var = wsum(d * d) * (1.0f / 64.0f);
            const float yn = d * rsqrtf(var + 64e-5f) * lg + lb;
            const float vv = bf2f(RKV[(size_t)2 * TOK * 1024 + (size_t)t * 1024 + c]); const float g = bf2f(Z[(size_t)t * EV_NP + 1280 + 2048 + c]); const float bs = BS[(size_t)t * 16 + h];
            Y[(size_t)t * DM + 1024 + c] = (bf16)f2bf((yn + bs * vv) * g);
        }
        asm volatile("s_waitcnt lgkmcnt(0)" ::: "memory");
    }
}

constexpr size_t WS_H8 = WS_BIG + 384 * MiB, WS_HS = WS_BIG + 448 * MiB;
__device__ __forceinline__ unsigned pack_i8x4(float a, float b, float c, float d) {
    const unsigned ua = __float_as_uint(a + 12582912.0f) & 255u, ub = __float_as_uint(b + 12582912.0f) & 255u, uc = __float_as_uint(c + 12582912.0f) & 255u, ud = __float_as_uint(d + 12582912.0f);
    return ua | (ub << 8) | (uc << 16) | (ud << 24);
}
__device__ __forceinline__ void ph_ln_mixer(const Args& A, Frame& F, const int L) {
    const float* xsrc = (const float*)A.in[0]; const bf16* xsrcb = (const bf16*)A.out;
    bf16* xdst = (L == 0) ? (bf16*)A.out : (bf16*)(A.ws + WS_Z + 160 * MiB);
    const bf16* O = (const bf16*)(A.ws + WS_Z); bf16* H = (bf16*)(A.ws + WS_HY); const float* MOD = (const float*)(A.ws + WS_MOD);
    const float* lng = (const float*)A.in[21] + (size_t)(L * 2 + 0) * DM; const float* lnb = (const float*)A.in[22] + (size_t)(L * 2 + 0) * DM;
    for (int t = F.gw; t < TOK; t += F.ngw) {
        const int b = t >> 14;
        const float* gate = MOD + (size_t)((L * 2 + 0) * 2 + b) * 6144 + 4096;
        const float* sh = MOD + (size_t)((L * 2 + 1) * 2 + b) * 6144; const float* sc = sh + 2048;
        float v[32]; float sum = 0.f;
#pragma unroll
        for (int j = 0; j < 4; ++j) { const int base = (j * 64 + F.lane) * 8;
            const u32x4 ow = *(const u32x4*)(O + (size_t)t * DM + base);
            f32x4 x0, x1;
            if (L == 0) { x0 = *(const f32x4*)(xsrc + (size_t)t * DM + base); x1 = *(const f32x4*)(xsrc + (size_t)t * DM + base + 4); }
            else { const u32x4 xw = *(const u32x4*)(xsrcb + (size_t)t * DM + base); x0 = (f32x4){lo2f(xw.x), hi2f(xw.x), lo2f(xw.y), hi2f(xw.y)}; x1 = (f32x4){lo2f(xw.z), hi2f(xw.z), lo2f(xw.w), hi2f(xw.w)}; }
            const f32x4 g0 = *(const f32x4*)(gate + base), g1 = *(const f32x4*)(gate + base + 4);
            const float of[8] = {lo2f(ow.x), hi2f(ow.x), lo2f(ow.y), hi2f(ow.y), lo2f(ow.z), hi2f(ow.z), lo2f(ow.w), hi2f(ow.w)};
#pragma unroll
            for (int e = 0; e < 4; ++e) { v[j * 8 + e] = ALPHA * x0[e] + (1.0f + g0[e]) * of[e]; v[j * 8 + 4 + e] = ALPHA * x1[e] + (1.0f + g1[e]) * of[4 + e]; }
#pragma unroll
            for (int e = 0; e < 8; ++e) sum += v[j * 8 + e]; }
        const float mean = wsum(sum) * (1.0f / DM); float sq = 0.f;
#pragma unroll
        for (int e = 0; e < 32; ++e) { v[e] -= mean; sq += v[e] * v[e]; }
        const float rstd = rsqrtf(wsum(sq) * (1.0f / DM) + 1e-5f); float hmax = 0.f;
#pragma unroll
        for (int j = 0; j < 4; ++j) { const int base = (j * 64 + F.lane) * 8;
            const f32x4 lg0 = *(const f32x4*)(lng + base), lg1 = *(const f32x4*)(lng + base + 4), lb0 = *(const f32x4*)(lnb + base), lb1 = *(const f32x4*)(lnb + base + 4);
            const f32x4 s0 = *(const f32x4*)(sc + base), s1 = *(const f32x4*)(sc + base + 4), h0 = *(const f32x4*)(sh + base), h1 = *(const f32x4*)(sh + base + 4);
            f32x4 o0, o1;
#pragma unroll
            for (int e = 0; e < 4; ++e) { o0[e] = v[j * 8 + e] * rstd * lg0[e] + lb0[e]; o1[e] = v[j * 8 + 4 + e] * rstd * lg1[e] + lb1[e]; }
            { u32x4 xw; xw.x = pk2(o0[0], o0[1]); xw.y = pk2(o0[2], o0[3]); xw.z = pk2(o1[0], o1[1]); xw.w = pk2(o1[2], o1[3]); *(u32x4*)(xdst + (size_t)t * DM + base) = xw; }
            const f32x4 q0 = o0 * (1.0f + s0) + h0, q1 = o1 * (1.0f + s1) + h1;
            u32x4 w; w.x = pk2(q0[0], q0[1]); w.y = pk2(q0[2], q0[3]); w.z = pk2(q1[0], q1[1]); w.w = pk2(q1[2], q1[3]);
            *(u32x4*)(H + (size_t)t * DM + base) = w;
#pragma unroll
            for (int e = 0; e < 4; ++e) { v[j * 8 + e] = q0[e]; v[j * 8 + 4 + e] = q1[e]; hmax = fmaxf(hmax, fmaxf(fabsf(q0[e]), fabsf(q1[e]))); } }
        { hmax = wmax(hmax); const float inv = (hmax > 0.f) ? 127.0f / hmax : 0.f;
#pragma unroll
          for (int j = 0; j < 4; ++j) { const int base = (j * 64 + F.lane) * 8; u32x2 w8;
              w8.x = pack_i8x4(v[j * 8 + 0] * inv, v[j * 8 + 1] * inv, v[j * 8 + 2] * inv, v[j * 8 + 3] * inv); w8.y = pack_i8x4(v[j * 8 + 4] * inv, v[j * 8 + 5] * inv, v[j * 8 + 6] * inv, v[j * 8 + 7] * inv);
              *(u32x2*)(A.ws + WS_H8 + (size_t)t * DM + base) = w8; }
          if (F.lane == 0) ((float*)(A.ws + WS_HS))[t] = hmax * (1.0f / 127.0f); }
    }
    {
        const float* pu = (const float*)A.in[25] + (size_t)L * 16384 * 2048; const float* pv = (const float*)A.in[26] + (size_t)L * 16384 * 2048;
        unsigned char* T8 = A.ws + WS_BIG; float* SCL = (float*)(A.ws + WS_BIG + 64 * MiB);
        for (int r = F.gw; r < 32768; r += F.ngw) {
            const float* src = ((r < 16384) ? pu : pv) + (size_t)(r & 16383) * 2048;
            f32x4 f[2][4]; float amax = 0.f;
#pragma unroll
            for (int j = 0; j < 2; ++j)
#pragma unroll
                for (int c = 0; c < 4; ++c) { f[j][c] = *(const f32x4*)(src + (j * 64 + F.lane) * 16 + 4 * c);
                    amax = fmaxf(amax, fmaxf(fmaxf(fabsf(f[j][c][0]), fabsf(f[j][c][1])), fmaxf(fabsf(f[j][c][2]), fabsf(f[j][c][3])))); }
            amax = wmax(amax);
            {
                const float inv = (amax > 0.f) ? 127.0f / amax : 0.f;
#pragma unroll
                for (int j = 0; j < 2; ++j) { u32x4 w;
                    w.x = pack_i8x4(f[j][0][0] * inv, f[j][0][1] * inv, f[j][0][2] * inv, f[j][0][3] * inv); w.y = pack_i8x4(f[j][1][0] * inv, f[j][1][1] * inv, f[j][1][2] * inv, f[j][1][3] * inv);
                    w.z = pack_i8x4(f[j][2][0] * inv, f[j][2][1] * inv, f[j][2][2] * inv, f[j][2][3] * inv); w.w = pack_i8x4(f[j][3][0] * inv, f[j][3][1] * inv, f[j][3][2] * inv, f[j][3][3] * inv);
                    *(u32x4*)(T8 + (size_t)r * 2048 + (j * 64 + F.lane) * 16) = w; }
                if (F.lane == 0) SCL[r] = amax * (1.0f / 127.0f);
            }
        }
    }
}

template <int NV, int NBITS> __device__ __forceinline__ unsigned wave_tau16(const unsigned (&key)[NV]) {
    unsigned tau = 0u;
#pragma unroll 1
    for (int bit = NBITS - 1; bit >= 0; --bit) {
        const unsigned cand = tau | (1u << bit); int cnt = 0;
#pragma unroll
        for (int v = 0; v < NV; ++v) cnt += __popcll(__ballot(key[v] >= cand));
        if (cnt >= 16) tau = cand;
    }
    return tau;
}
template <int NV> __device__ __forceinline__ void wave_compact16(const unsigned (&key)[NV], const float (&val)[NV], const int (&id)[NV], unsigned tau, LAS float* ov, LAS int* oi, int lane) {
    int ngt = 0;
#pragma unroll
    for (int v = 0; v < NV; ++v) ngt += __popcll(__ballot(key[v] > tau));
    int bg = 0, be = 0;
#pragma unroll
    for (int v = 0; v < NV; ++v) {
        const bool gt = key[v] > tau, eq = key[v] == tau;
        const unsigned long long mg = __ballot(gt), me = __ballot(eq);
        const unsigned long long below = (lane == 0) ? 0ull : ((~0ull) >> (64 - lane));
        const int pg = bg + __popcll(mg & below), pe = ngt + be + __popcll(me & below);
        if (gt) { ov[pg] = val[v]; oi[pg] = id[v]; }
        if (eq && pe < 16) { ov[pe] = val[v]; oi[pe] = id[v]; }
        bg += __popcll(mg); be += __popcll(me);
    }
}

template <int CTRL, int BANK> __device__ __forceinline__ unsigned dppb(unsigned old, unsigned v) { return (unsigned)__builtin_amdgcn_update_dpp((int)old, (int)v, CTRL, 0xF, BANK, false); }
template <int CTRL> __device__ __forceinline__ unsigned dppm(unsigned v) { return (unsigned)__builtin_amdgcn_mov_dpp((int)v, CTRL, 0xF, 0xF, true); }
template <int CTRL> __device__ __forceinline__ unsigned cex(unsigned x, bool lo) { const unsigned mx = max(x, dppm<CTRL>(x)), mn = min(x, dppm<CTRL>(x)); return lo ? mx : mn; }
__device__ __forceinline__ unsigned cex4(unsigned x, bool lo) {
    unsigned t = (unsigned)__builtin_amdgcn_mov_dpp((int)x, 0x104, 0xF, 0x5, false); t = dppb<0x114, 0xA>(t, x); const unsigned mx = max(x, t), mn = min(x, t); return lo ? mx : mn; }
struct LoMasks { bool lo1, lo2, lo4, lo8, odd16, up32; };
__device__ __forceinline__ unsigned sort16_desc(unsigned x, const LoMasks& M) {
    x = cex<0xB1>(x, M.lo1);
    x = cex<0x1B>(x, M.lo2); x = cex<0xB1>(x, M.lo1);
    x = cex<0x141>(x, M.lo4); x = cex<0x4E>(x, M.lo2); x = cex<0xB1>(x, M.lo1);
    x = cex<0x140>(x, M.lo8); x = cex4(x, M.lo4); x = cex<0x4E>(x, M.lo2); x = cex<0xB1>(x, M.lo1);
    return x;
}
__device__ __forceinline__ unsigned clean16_desc(unsigned x, const LoMasks& M) {
    x = cex<0x128>(x, M.lo8); x = cex4(x, M.lo4); x = cex<0x4E>(x, M.lo2); x = cex<0xB1>(x, M.lo1); return x;
}
__device__ __forceinline__ unsigned mtop_regs(unsigned a, unsigned b) { return max(a, dppm<0x140>(b)); }
__device__ __forceinline__ unsigned mtop_rows(unsigned y, const LoMasks& M) { const auto r = __builtin_amdgcn_permlane16_swap(y, y, false, false); const unsigned pv = M.odd16 ? r[0] : r[1]; return mtop_regs(y, pv); }
__device__ __forceinline__ unsigned mtop_halves(unsigned y, const LoMasks& M) { const auto r = __builtin_amdgcn_permlane32_swap(y, y, false, false); const unsigned pv = M.up32 ? r[0] : r[1]; return mtop_regs(y, pv); }

template <int OFF, int N, int MASKX, int TOT> __device__ __forceinline__ void ce_stage(unsigned (&k)[TOT]) {
#pragma unroll
    for (int i = 0; i < N; ++i) { const int pr = i ^ MASKX; if (pr > i) { const unsigned a_ = k[OFF + i], b_ = k[OFF + pr]; k[OFF + i] = max(a_, b_); k[OFF + pr] = min(a_, b_); } }
}
template <int OFF, int TOT> __device__ __forceinline__ void sort16_regs(unsigned (&k)[TOT]) {
    ce_stage<OFF, 16, 1>(k); ce_stage<OFF, 16, 3>(k); ce_stage<OFF, 16, 1>(k); ce_stage<OFF, 16, 7>(k); ce_stage<OFF, 16, 2>(k); ce_stage<OFF, 16, 1>(k);
    ce_stage<OFF, 16, 15>(k); ce_stage<OFF, 16, 4>(k); ce_stage<OFF, 16, 2>(k); ce_stage<OFF, 16, 1>(k);
}
template <int TOT> __device__ __forceinline__ void clean16_regs(unsigned (&k)[TOT]) { ce_stage<0, 16, 8>(k); ce_stage<0, 16, 4>(k); ce_stage<0, 16, 2>(k); ce_stage<0, 16, 1>(k); }

__device__ __forceinline__ void ph_peer_select(const Args& A, Frame& F, const int L) {
    const bf16* QP = (const bf16*)(A.ws + WS_Z); const bf16* SKB = (const bf16*)(A.ws + WS_SKB) + (size_t)L * 262144;
    int* EID = (int*)(A.ws + WS_LA); float* GSM = (float*)(A.ws + WS_LA + 16 * MiB);
    LAS unsigned char* SKL = F.lds;
    LAS float* SCO = (LAS float*)(F.lds + 69632 + 4096);
    for (int it = F.bx; it < 4096; it += F.G) {
        const int tile = it >> 3, h = it & 7;
        __syncthreads();
        for (int c = F.tid; c < 4096; c += NTHREADS) { const int p = c >> 11, n = (c >> 4) & 127, cc = c & 15;
            *(LAS u32x4*)(SKL + (p * 128 + n) * 272 + cc * 16) = *(const u32x4*)(SKB + ((size_t)((p * 8 + h) * 128 + n)) * 128 + cc * 8); }
        __syncthreads();
        {
            const int p = F.wave >> 2, mt = F.wave & 3, g = F.lane >> 4, l15 = F.lane & 15;
            const bf16* qrow = QP + (size_t)(tile * 64 + mt * 16 + l15) * DM + h * 256 + p * 128 + 8 * g;
            bf16x8 afr[4];
#pragma unroll
            for (int ks = 0; ks < 4; ++ks) afr[ks] = *(const bf16x8*)(qrow + 32 * ks);
#pragma unroll
            for (int nt = 0; nt < 8; ++nt) {
                f32x4 acc = {0.f, 0.f, 0.f, 0.f};
#pragma unroll
                for (int ks = 0; ks < 4; ++ks) { const bf16x8 bfr = *(const LAS bf16x8*)(SKL + (p * 128 + nt * 16 + l15) * 272 + (32 * ks + 8 * g) * 2);
                    acc = __builtin_amdgcn_mfma_f32_16x16x32_bf16(afr[ks], bfr, acc, 0, 0, 0); }
#pragma unroll
                for (int rg = 0; rg < 4; ++rg) SCO[(p * 64 + mt * 16 + 4 * g + rg) * 132 + nt * 16 + l15] = acc[rg];
            }
        }
        __syncthreads();
        constexpr int NT = 4;
        LAS unsigned char* WB = F.lds + 141312 + F.wave * 2048;
        LoMasks M; M.lo1 = (F.lane & 1) == 0; M.lo2 = (F.lane & 2) == 0; M.lo4 = (F.lane & 4) == 0; M.lo8 = (F.lane & 8) == 0; M.odd16 = (F.lane & 16) != 0; M.up32 = (F.lane & 32) != 0;
        int pi_, pj_;
        { const int L = F.lane;
          if (L < 16) { pi_ = 0; pj_ = L; } else if (L < 24) { pi_ = 1; pj_ = L - 16; } else if (L < 29) { pi_ = 2; pj_ = L - 24; } else if (L < 33) { pi_ = 3; pj_ = L - 29; }
          else if (L < 36) { pi_ = 4; pj_ = L - 33; } else if (L < 42) { pi_ = 5 + ((L - 36) >> 1); pj_ = (L - 36) & 1; } else { pi_ = 8 + (L - 42); pj_ = 0; }
          if (L >= 50) { pi_ = 0; pj_ = 0; } }
        const bool pvalid = F.lane < 50;
        {
            const int g = F.lane >> 2, q = F.lane & 3, tok = g >> 1, sp = g & 1;
            const LAS float* srow = SCO + (sp * 64 + F.wave * 8 + tok) * 132;
            unsigned k[32]; const unsigned ib = (unsigned)(127 - q * 32);
#pragma unroll
            for (int c = 0; c < 8; ++c) { const f32x4 v = *(const LAS f32x4*)(srow + q * 32 + 4 * c);
#pragma unroll
                for (int e = 0; e < 4; ++e) k[4 * c + e] = (fixkey20(v[e]) << 7) | (ib - (unsigned)(4 * c + e)); }
            sort16_regs<0>(k); sort16_regs<16>(k);
            unsigned m[16], t2[16];
#pragma unroll
            for (int i = 0; i < 16; ++i) m[i] = max(k[i], k[31 - i]);
            clean16_regs(m);
#pragma unroll
            for (int i = 0; i < 16; ++i) t2[i] = max(m[i], dppm<0xB1>(m[15 - i]));
            clean16_regs(t2);
#pragma unroll
            for (int i = 0; i < 16; ++i) m[i] = max(t2[i], dppm<0x4E>(t2[15 - i]));
            clean16_regs(m);
            float vals[16]; int idxs[16];
#pragma unroll
            for (int e = 0; e < 16; ++e) { idxs[e] = 127 - (int)(m[e] & 127u); vals[e] = srow[idxs[e]]; }
            if (q == 0) { LAS float* tvp = (LAS float*)(WB + tok * 256) + sp * 16; LAS int* tip = (LAS int*)(WB + tok * 256 + 128) + sp * 16;
#pragma unroll
                for (int c = 0; c < 4; ++c) { *(LAS f32x4*)(tvp + 4 * c) = (f32x4){vals[4 * c], vals[4 * c + 1], vals[4 * c + 2], vals[4 * c + 3]};
                    *(LAS u32x4*)(tip + 4 * c) = (u32x4){(unsigned)idxs[4 * c], (unsigned)idxs[4 * c + 1], (unsigned)idxs[4 * c + 2], (unsigned)idxs[4 * c + 3]}; } }
        }
        asm volatile("s_waitcnt lgkmcnt(0)" ::: "memory"); __builtin_amdgcn_wave_barrier();
#pragma unroll 1
        for (int tk0 = 0; tk0 < 8; tk0 += NT) {
            unsigned z[NT];
#pragma unroll
            for (int u = 0; u < NT; ++u) { const LAS float* tv = (const LAS float*)(WB + (tk0 + u) * 256); const float cvl = tv[pi_] + tv[16 + pj_];
                z[u] = pvalid ? ((fixkey20(cvl * 0.5f) << 8) | (unsigned)(255 - (pi_ * 16 + pj_))) : 0u; }
#define ALL4(EXPR) _Pragma("unroll") for (int u = 0; u < NT; ++u) { const unsigned X = z[u]; z[u] = (EXPR); }
#define CLEAN4() ALL4(cex<0x128>(X, M.lo8)) ALL4(cex4(X, M.lo4)) ALL4(cex<0x4E>(X, M.lo2)) ALL4(cex<0xB1>(X, M.lo1))
            ALL4(cex<0xB1>(X, M.lo1))
            ALL4(cex<0x1B>(X, M.lo2)) ALL4(cex<0xB1>(X, M.lo1))
            ALL4(cex<0x141>(X, M.lo4)) ALL4(cex<0x4E>(X, M.lo2)) ALL4(cex<0xB1>(X, M.lo1))
            ALL4(cex<0x140>(X, M.lo8)) ALL4(cex4(X, M.lo4)) ALL4(cex<0x4E>(X, M.lo2)) ALL4(cex<0xB1>(X, M.lo1))
            ALL4(mtop_rows(X, M)) CLEAN4()
            ALL4(mtop_halves(X, M)) CLEAN4()
#undef ALL4
#undef CLEAN4
#pragma unroll
            for (int u = 0; u < NT; ++u) { const int t = tile * 64 + F.wave * 8 + tk0 + u;
                const LAS float* tv = (const LAS float*)(WB + (tk0 + u) * 256); const LAS int* ti = (const LAS int*)(WB + (tk0 + u) * 256 + 128);
                const int cid = 255 - (int)(z[u] & 255u), bi = (F.lane < 16) ? (cid >> 4) : 0, bj = (F.lane < 16) ? (cid & 15) : 0;
                const float bv = (F.lane < 16) ? (tv[bi] + tv[16 + bj]) : -INFINITY;
                const float mx = wmax(bv); const float ev = (F.lane < 16) ? expf(bv - mx) : 0.f; const float den = wsum(ev);
                if (F.lane < 16) { const int e1 = ti[bi], e2 = ti[16 + bj];
                    EID[(size_t)t * 128 + h * 16 + F.lane] = e1 * 128 + e2; GSM[(size_t)t * 128 + h * 16 + F.lane] = ev / den; } }
            asm volatile("s_waitcnt lgkmcnt(0)" ::: "memory"); __builtin_amdgcn_wave_barrier();
        }
    }
}

constexpr int PGB = 4;
__device__ __forceinline__ void ph_peer_gather(const Args& A, Frame& F, const int L, const bool dry = false) {
    bf16* H = (bf16*)(A.ws + WS_HY); bf16* Hout = dry ? (bf16*)(A.ws + WS_BIG + 128 * MiB) : H; float* Xout = dry ? (float*)(A.ws + WS_Z) : A.out; const unsigned char* TU = A.ws + WS_BIG; const unsigned char* TV = TU + (size_t)16384 * 2048; const float* SCL = (const float*)(A.ws + WS_BIG + 64 * MiB);
    const int* EID = (const int*)(A.ws + WS_LA); const float* GSM = (const float*)(A.ws + WS_LA + 16 * MiB);
    const float* MOD = (const float*)(A.ws + WS_MOD); float* X = A.out;
    const float* lng = (const float*)A.in[21] + (size_t)(L * 2 + 1) * DM; const float* lnb = (const float*)A.in[22] + (size_t)(L * 2 + 1) * DM;
    for (int t = F.gw; t < TOK; t += F.ngw) {
        const int b = t >> 14;
        f32x2 h2[16];
#pragma unroll
        for (int j = 0; j < 2; ++j) { const u32x4 a = *(const u32x4*)(H + (size_t)t * DM + (j * 64 + F.lane) * 16), c = *(const u32x4*)(H + (size_t)t * DM + (j * 64 + F.lane) * 16 + 8);
            const unsigned aw[8] = {a.x, a.y, a.z, a.w, c.x, c.y, c.z, c.w};
#pragma unroll
            for (int q = 0; q < 8; ++q) h2[j * 8 + q] = (f32x2){lo2f(aw[q]), hi2f(aw[q])}; }
        f32x2 o2[16];
#pragma unroll
        for (int e = 0; e < 16; ++e) o2[e] = (f32x2){0.f, 0.f};
#pragma unroll 1
        for (int e0 = 0; e0 < 128; e0 += PGB) {
            int eid[PGB]; float gw[PGB], su[PGB], sv[PGB];
#pragma unroll
            for (int q = 0; q < PGB; ++q) { eid[q] = __builtin_amdgcn_readfirstlane(EID[(size_t)t * 128 + e0 + q]); gw[q] = GSM[(size_t)t * 128 + e0 + q]; su[q] = SCL[eid[q]]; sv[q] = SCL[16384 + eid[q]]; }
            u32x4 uu[PGB][2], vv[PGB][2];
#pragma unroll
            for (int q = 0; q < PGB; ++q)
#pragma unroll
                for (int j = 0; j < 2; ++j) { uu[q][j] = *(const u32x4*)(TU + (size_t)eid[q] * 2048 + (j * 64 + F.lane) * 16); vv[q][j] = *(const u32x4*)(TV + (size_t)eid[q] * 2048 + (j * 64 + F.lane) * 16); }
#pragma unroll
            for (int q = 0; q < PGB; ++q) {
                f32x2 d2 = {0.f, 0.f};
#pragma unroll
                for (int j = 0; j < 2; ++j) { const unsigned w[4] = {uu[q][j].x, uu[q][j].y, uu[q][j].z, uu[q][j].w};
#pragma unroll
                    for (int i = 0; i < 4; ++i) { const f32x2 lo = __builtin_amdgcn_cvt_pk_f32_fp8((int)w[i], false), hi = __builtin_amdgcn_cvt_pk_f32_fp8((int)w[i], true);
                        d2 = lo * h2[j * 8 + 2 * i] + d2; d2 = hi * h2[j * 8 + 2 * i + 1] + d2; } }
                const float d = wsum(d2.x + d2.y) * su[q];
                const float act = 0.5f * d * (1.0f + erff(d * 0.70710678f)) * gw[q] * sv[q];
                const f32x2 a2 = {act, act};
#pragma unroll
                for (int j = 0; j < 2; ++j) { const unsigned w[4] = {vv[q][j].x, vv[q][j].y, vv[q][j].z, vv[q][j].w};
#pragma unroll
                    for (int i = 0; i < 4; ++i) { const f32x2 lo = __builtin_amdgcn_cvt_pk_f32_fp8((int)w[i], false), hi = __builtin_amdgcn_cvt_pk_f32_fp8((int)w[i], true);
                        o2[j * 8 + 2 * i] = a2 * lo + o2[j * 8 + 2 * i]; o2[j * 8 + 2 * i + 1] = a2 * hi + o2[j * 8 + 2 * i + 1]; } }
            }
        }
        float out[32];
#pragma unroll
        for (int e = 0; e < 16; ++e) { out[2 * e] = o2[e].x; out[2 * e + 1] = o2[e].y; }
        const float* gate = MOD + (size_t)((L * 2 + 1) * 2 + b) * 6144 + 4096;
        float sum = 0.f;
#pragma unroll
        for (int j = 0; j < 2; ++j)
#pragma unroll
            for (int c = 0; c < 4; ++c) { const int base = (j * 64 + F.lane) * 16 + 4 * c;
                const f32x4 x0 = *(const f32x4*)(X + (size_t)t * DM + base), g0 = *(const f32x4*)(gate + base);
#pragma unroll
                for (int e = 0; e < 4; ++e) { const float v = ALPHA * x0[e] + (1.0f + g0[e]) * out[j * 16 + 4 * c + e]; out[j * 16 + 4 * c + e] = v; sum += v; } }
        const float mean = wsum(sum) * (1.0f / DM); float sq = 0.f;
#pragma unroll
        for (int e = 0; e < 32; ++e) { out[e] -= mean; sq += out[e] * out[e]; }
        const float rstd = rsqrtf(wsum(sq) * (1.0f / DM) + 1e-5f);
        const float* sh = MOD + (size_t)(((L + 1) * 2 + 0) * 2 + b) * 6144; const float* sc = sh + 2048;
#pragma unroll
        for (int j = 0; j < 2; ++j) {
            float hq[16];
#pragma unroll
            for (int c = 0; c < 4; ++c) { const int base = (j * 64 + F.lane) * 16 + 4 * c;
                const f32x4 lg0 = *(const f32x4*)(lng + base), lb0 = *(const f32x4*)(lnb + base);
                f32x4 o0;
#pragma unroll
                for (int e = 0; e < 4; ++e) o0[e] = out[j * 16 + 4 * c + e] * rstd * lg0[e] + lb0[e];
                *(f32x4*)(Xout + (size_t)t * DM + base) = o0;
                if (L == 0) { const f32x4 s0 = *(const f32x4*)(sc + base), h0 = *(const f32x4*)(sh + base);
#pragma unroll
                    for (int e = 0; e < 4; ++e) hq[4 * c + e] = o0[e] * (1.0f + s0[e]) + h0[e]; } }
            if (L == 0) { u32x4 w0, w1;
                w0.x = pk2(hq[0], hq[1]); w0.y = pk2(hq[2], hq[3]); w0.z = pk2(hq[4], hq[5]); w0.w = pk2(hq[6], hq[7]);
                w1.x = pk2(hq[8], hq[9]); w1.y = pk2(hq[10], hq[11]); w1.z = pk2(hq[12], hq[13]); w1.w = pk2(hq[14], hq[15]);
                *(u32x4*)(Hout + (size_t)t * DM + (j * 64 + F.lane) * 16) = w0; *(u32x4*)(Hout + (size_t)t * DM + (j * 64 + F.lane) * 16 + 8) = w1; }
        }
    }
}

struct XInfo { int rank, nloc, rx, nx; };
__device__ __forceinline__ XInfo xcc_info(volatile LAS unsigned* MISC) { XInfo x; x.rank = (int)MISC[16]; x.nloc = (int)MISC[17]; x.rx = (int)MISC[18]; x.nx = (int)MISC[19]; return x; }
constexpr size_t WS_DP = WS_BIG + 128 * MiB;
constexpr size_t WS_ACT = WS_BIG + 80 * MiB;
__device__ __forceinline__ void ph_peer_u(const Args& A, Frame& F, const XInfo X) {
    const unsigned char* H8 = A.ws + WS_H8; const unsigned char* TU = A.ws + WS_BIG; const int* EID = (const int*)(A.ws + WS_LA); float* DP = (float*)(A.ws + WS_DP);
    LAS int* IDX = (LAS int*)(F.lds + F.wave * 1024);
    const int g16 = F.lane >> 4, c16 = F.lane & 15; const int step = X.nloc * NWAVES;
    for (int s = X.rx; s < 8; s += X.nx) {
        int t = X.rank * NWAVES + F.wave;
        int e0 = 0, e1 = 0; u32x4 ha = {0u, 0u, 0u, 0u};
        if (t < TOK) { e0 = EID[(size_t)t * 128 + F.lane]; e1 = EID[(size_t)t * 128 + 64 + F.lane]; ha = *(const u32x4*)(H8 + (size_t)t * DM + 256 * s + 16 * c16); }
        const unsigned char* ub = TU + 256 * s + 16 * c16;
        while (t < TOK) {
            const int tn = t + step; int n0 = 0, n1 = 0; u32x4 na = {0u, 0u, 0u, 0u};
            if (tn < TOK) { n0 = EID[(size_t)tn * 128 + F.lane]; n1 = EID[(size_t)tn * 128 + 64 + F.lane]; na = *(const u32x4*)(H8 + (size_t)tn * DM + 256 * s + 16 * c16); }
            IDX[F.lane] = e0; IDX[F.lane + 64] = e1;
            asm volatile("s_waitcnt lgkmcnt(0)" ::: "memory"); __builtin_amdgcn_wave_barrier();
            float keep0 = 0.f, keep1 = 0.f;
#pragma unroll
            for (int i0 = 0; i0 < 32; i0 += 8) {
                u32x4 ud[8];
#pragma unroll
                for (int u = 0; u < 8; ++u) { const int eid = IDX[4 * (i0 + u) + g16]; ud[u] = *(const u32x4*)(ub + (size_t)eid * 2048); }
#pragma unroll
                for (int u = 0; u < 8; ++u) {
                    int di = __builtin_amdgcn_sdot4((int)ud[u].x, (int)ha.x, 0, false); di = __builtin_amdgcn_sdot4((int)ud[u].y, (int)ha.y, di, false);
                    di = __builtin_amdgcn_sdot4((int)ud[u].z, (int)ha.z, di, false); di = __builtin_amdgcn_sdot4((int)ud[u].w, (int)ha.w, di, false);
                    const float d = sum16_dpp((float)di);
                    const int i = i0 + u;
                    if (i < 16) keep0 = ((i & 15) == c16) ? d : keep0; else keep1 = ((i & 15) == c16) ? d : keep1;
                }
            }
            float* dp = DP + ((size_t)s * TOK + t) * 128 + 4 * c16 + g16;
            dp[0] = keep0; dp[64] = keep1;
            asm volatile("s_waitcnt lgkmcnt(0)" ::: "memory"); __builtin_amdgcn_wave_barrier();
            e0 = n0; e1 = n1; ha = na; t = tn;
        }
    }
}
__device__ __forceinline__ void ph_peer_act(const Args& A, Frame& F) {
    const float* SCL = (const float*)(A.ws + WS_BIG + 64 * MiB); const int* EID = (const int*)(A.ws + WS_LA); const float* GSM = (const float*)(A.ws + WS_LA + 16 * MiB);
    const float* DP = (const float*)(A.ws + WS_DP); unsigned char* ACT8 = A.ws + WS_ACT; float* AS = (float*)(A.ws + WS_ACT + 8 * MiB);
    for (int t = F.gw; t < TOK; t += F.ngw) { const float hs = ((const float*)(A.ws + WS_HS))[t];
        float a[2];
#pragma unroll
        for (int m = 0; m < 2; ++m) { const int e = F.lane + 64 * m; const int eid = EID[(size_t)t * 128 + e]; float d = 0.f;
#pragma unroll
            for (int x = 0; x < 8; ++x) d += DP[((size_t)x * TOK + t) * 128 + e];
            d *= SCL[eid] * hs;
            a[m] = 0.5f * d * (1.0f + erff(d * 0.70710678f)) * GSM[(size_t)t * 128 + e] * SCL[16384 + eid]; }
        const float amax = wmax(fmaxf(fabsf(a[0]), fabsf(a[1]))); const float inv = (amax > 0.f) ? 127.0f / amax : 0.f;
#pragma unroll
        for (int m = 0; m < 2; ++m) ACT8[(size_t)t * 128 + F.lane + 64 * m] = (unsigned char)(__float_as_uint(a[m] * inv + 12582912.0f) & 255u);
        if (F.lane == 0) AS[t] = amax * (1.0f / 127.0f);
    }
}
__device__ __forceinline__ void ph_peer_v(const Args& A, Frame& F, const XInfo X) {
    const unsigned char* TV = A.ws + WS_BIG + (size_t)16384 * 2048;
    const int* EID = (const int*)(A.ws + WS_LA); const unsigned* ACT8 = (const unsigned*)(A.ws + WS_ACT); const float* AS = (const float*)(A.ws + WS_ACT + 8 * MiB); bf16* OUT = (bf16*)(A.ws + WS_Z);
    LAS int* IDX = (LAS int*)(F.lds + F.wave * 1024); LAS unsigned* ACT = (LAS unsigned*)(F.lds + F.wave * 1024 + 512);
    const int g16 = F.lane >> 4, c16 = F.lane & 15; const int step = X.nloc * NWAVES;
    for (int s = X.rx; s < 8; s += X.nx) {
        int t = X.rank * NWAVES + F.wave;
        int e0 = 0, e1 = 0; unsigned a0 = 0u;
        if (t < TOK) { e0 = EID[(size_t)t * 128 + F.lane]; e1 = EID[(size_t)t * 128 + 64 + F.lane]; a0 = ACT8[(size_t)t * 32 + (F.lane & 31)]; }
        const unsigned char* vb = TV + 256 * s + 16 * c16;
        while (t < TOK) {
            const int tn = t + step; int n0 = 0, n1 = 0; unsigned b0 = 0u;
            if (tn < TOK) { n0 = EID[(size_t)tn * 128 + F.lane]; n1 = EID[(size_t)tn * 128 + 64 + F.lane]; b0 = ACT8[(size_t)tn * 32 + (F.lane & 31)]; }
            const float as = AS[t];
            IDX[F.lane] = e0; IDX[F.lane + 64] = e1; if (F.lane < 32) ACT[F.lane] = a0;
            asm volatile("s_waitcnt lgkmcnt(0)" ::: "memory"); __builtin_amdgcn_wave_barrier();
            int acc[16];
#pragma unroll
            for (int j = 0; j < 16; ++j) acc[j] = 0;
#pragma unroll
            for (int b = 0; b < 8; b += 2) {
                u32x4 vd[2][4]; unsigned a4[2];
#pragma unroll
                for (int h = 0; h < 2; ++h) { a4[h] = ACT[4 * (b + h) + g16];
#pragma unroll
                    for (int u = 0; u < 4; ++u) { const int eid = IDX[16 * (b + h) + 4 * g16 + u]; vd[h][u] = *(const u32x4*)(vb + (size_t)eid * 2048); } }
#pragma unroll
                for (int h = 0; h < 2; ++h)
#pragma unroll
                    for (int q = 0; q < 4; ++q) { const unsigned A_ = vd[h][0][q], B_ = vd[h][1][q], C_ = vd[h][2][q], D_ = vd[h][3][q];
                        const unsigned ablo = __builtin_amdgcn_perm(B_, A_, 0x05010400u), abhi = __builtin_amdgcn_perm(B_, A_, 0x07030602u);
                        const unsigned cdlo = __builtin_amdgcn_perm(D_, C_, 0x05010400u), cdhi = __builtin_amdgcn_perm(D_, C_, 0x07030602u);
                        acc[4 * q + 0] = __builtin_amdgcn_sdot4((int)__builtin_amdgcn_perm(cdlo, ablo, 0x05040100u), (int)a4[h], acc[4 * q + 0], false);
                        acc[4 * q + 1] = __builtin_amdgcn_sdot4((int)__builtin_amdgcn_perm(cdlo, ablo, 0x07060302u), (int)a4[h], acc[4 * q + 1], false);
                        acc[4 * q + 2] = __builtin_amdgcn_sdot4((int)__builtin_amdgcn_perm(cdhi, abhi, 0x05040100u), (int)a4[h], acc[4 * q + 2], false);
                        acc[4 * q + 3] = __builtin_amdgcn_sdot4((int)__builtin_amdgcn_perm(cdhi, abhi, 0x07060302u), (int)a4[h], acc[4 * q + 3], false); }
            }
            { const float r0 = rsum4((float)acc[0], (float)acc[4], (float)acc[8], (float)acc[12]) * as, r1 = rsum4((float)acc[1], (float)acc[5], (float)acc[9], (float)acc[13]) * as;
              const float r2 = rsum4((float)acc[2], (float)acc[6], (float)acc[10], (float)acc[14]) * as, r3 = rsum4((float)acc[3], (float)acc[7], (float)acc[11], (float)acc[15]) * as;
              u32x2 w; w.x = pk2(r0, r1); w.y = pk2(r2, r3); *(u32x2*)(OUT + (size_t)t * DM + 256 * s + 16 * c16 + 4 * g16) = w; }
            asm volatile("s_waitcnt lgkmcnt(0)" ::: "memory"); __builtin_amdgcn_wave_barrier();
            e0 = n0; e1 = n1; a0 = b0; t = tn;
        }
    }
}
__device__ __forceinline__ void ph_peer_ln(const Args& A, Frame& F, const int L) {
    const bf16* OUT = (const bf16*)(A.ws + WS_Z); float* X = A.out; bf16* H = (bf16*)(A.ws + WS_HY); const float* MOD = (const float*)(A.ws + WS_MOD);
    const bf16* Xin = (L == 0) ? (const bf16*)A.out : (const bf16*)(A.ws + WS_Z + 160 * MiB); bf16* Xb = (bf16*)A.out;
    const float* lng = (const float*)A.in[21] + (size_t)(L * 2 + 1) * DM; const float* lnb = (const float*)A.in[22] + (size_t)(L * 2 + 1) * DM;
    for (int t = F.gw; t < TOK; t += F.ngw) {
        const int b = t >> 14;
        const float* gate = MOD + (size_t)((L * 2 + 1) * 2 + b) * 6144 + 4096;
        const float* sh = MOD + (size_t)(((L + 1) * 2 + 0) * 2 + b) * 6144; const float* sc = sh + 2048;
        float v[32]; float sum = 0.f;
#pragma unroll
        for (int j = 0; j < 8; ++j) { const int base = (j * 64 + F.lane) * 4;
            const u32x2 ow = *(const u32x2*)(OUT + (size_t)t * DM + base); const f32x4 o0 = {lo2f(ow.x), hi2f(ow.x), lo2f(ow.y), hi2f(ow.y)};
            const u32x2 xw = *(const u32x2*)(Xin + (size_t)t * DM + base); const f32x4 x0 = {lo2f(xw.x), hi2f(xw.x), lo2f(xw.y), hi2f(xw.y)}; const f32x4 g0 = *(const f32x4*)(gate + base);
#pragma unroll
            for (int e = 0; e < 4; ++e) { v[j * 4 + e] = ALPHA * x0[e] + (1.0f + g0[e]) * o0[e]; sum += v[j * 4 + e]; } }
        const float mean = wsum(sum) * (1.0f / DM); float sq = 0.f;
#pragma unroll
        for (int e = 0; e < 32; ++e) { v[e] -= mean; sq += v[e] * v[e]; }
        const float rstd = rsqrtf(wsum(sq) * (1.0f / DM) + 1e-5f);
#pragma unroll
        for (int j = 0; j < 8; ++j) { const int base = (j * 64 + F.lane) * 4;
            const f32x4 lg0 = *(const f32x4*)(lng + base), lb0 = *(const f32x4*)(lnb + base);
            f32x4 o0;
#pragma unroll
            for (int e = 0; e < 4; ++e) o0[e] = v[j * 4 + e] * rstd * lg0[e] + lb0[e];
            if (L == 0) { u32x2 xo; xo.x = pk2(o0[0], o0[1]); xo.y = pk2(o0[2], o0[3]); *(u32x2*)(Xb + (size_t)t * DM + base) = xo; } else *(f32x4*)(X + (size_t)t * DM + base) = o0;
            if (L == 0) { const f32x4 s0 = *(const f32x4*)(sc + base), h0 = *(const f32x4*)(sh + base); const f32x4 q0 = o0 * (1.0f + s0) + h0;
                u32x2 w; w.x = pk2(q0[0], q0[1]); w.y = pk2(q0[2], q0[3]); *(u32x2*)(H + (size_t)t * DM + base) = w; }
        }
    }
}

__device__ __forceinline__ void ph_odd_post(const Args& A, Frame& F) {
    bf16* Z = (bf16*)(A.ws + WS_Z); const int* positions = (const int*)A.in[2]; bf16* KIT = (bf16*)(A.ws + WS_BIG + 256 * MiB); unsigned char* K8 = A.ws + WS_BIG + 264 * MiB; unsigned char* V8 = A.ws + WS_BIG + 280 * MiB;
    const float inv128 = powf(10000.0f, -(float)F.lane / 64.0f); const int i32 = F.lane & 31; const float inv64 = powf(10000.0f, -(float)i32 / 32.0f);
    const int a16 = F.lane & 15, hs4 = F.lane >> 4, a8 = F.lane & 7, hs8 = F.lane >> 3;
    for (int t = F.gw; t < TOK; t += F.ngw) {
        bf16* zr = Z + (size_t)t * OD_NP; const float pos = (float)positions[t];
        const int bb = t >> 14, spos = t & (SEQ - 1);
        float sn, cs; sincosf(pos * inv128, &sn, &cs);
        float c4[4], s4[4];
#pragma unroll
        for (int e = 0; e < 4; ++e) { c4[e] = __shfl(cs, 4 * a16 + e); s4[e] = __shfl(sn, 4 * a16 + e); }
#pragma unroll
        for (int it = 0; it < 5; ++it) { const int hd = it * 4 + hs4; bf16* hp = zr + hd * 128 + 4 * a16;
            const u32x2 a = *(const u32x2*)hp, b = *(const u32x2*)(hp + 64);
            const float t1[4] = {lo2f(a.x), hi2f(a.x), lo2f(a.y), hi2f(a.y)}, t2[4] = {lo2f(b.x), hi2f(b.x), lo2f(b.y), hi2f(b.y)};
            float o1[4], o2[4];
#pragma unroll
            for (int e = 0; e < 4; ++e) { o1[e] = t1[e] * c4[e] - t2[e] * s4[e]; o2[e] = t2[e] * c4[e] + t1[e] * s4[e]; }
            *(u32x2*)hp = (u32x2){pk2(o1[0], o1[1]), pk2(o1[2], o1[3])}; *(u32x2*)(hp + 64) = (u32x2){pk2(o2[0], o2[1]), pk2(o2[2], o2[3])};
            if (it == 4) { unsigned char* k8 = K8 + ((size_t)((bb * 4 + hs4) * SEQ + spos)) * 128 + 4 * a16;
                int w1 = __builtin_amdgcn_cvt_pk_fp8_f32(o1[0] * 16.0f, o1[1] * 16.0f, 0, false); w1 = __builtin_amdgcn_cvt_pk_fp8_f32(o1[2] * 16.0f, o1[3] * 16.0f, w1, true);
                int w2 = __builtin_amdgcn_cvt_pk_fp8_f32(o2[0] * 16.0f, o2[1] * 16.0f, 0, false); w2 = __builtin_amdgcn_cvt_pk_fp8_f32(o2[2] * 16.0f, o2[3] * 16.0f, w2, true);
                *(unsigned*)k8 = (unsigned)w1; *(unsigned*)(k8 + 64) = (unsigned)w2; } }
        {
            const int e0 = F.lane * 8, kvh = e0 >> 7, d0 = e0 & 127;
            const u32x4 vw = *(const u32x4*)(zr + 2560 + e0);
            const unsigned ww[4] = {vw.x, vw.y, vw.z, vw.w}; unsigned ob[2] = {0u, 0u};
#pragma unroll
            for (int q = 0; q < 4; ++q) { const float c0 = fminf(fmaxf(lo2f(ww[q]) * 16.0f, -127.0f), 127.0f), c1 = fminf(fmaxf(hi2f(ww[q]) * 16.0f, -127.0f), 127.0f);
                const unsigned b0 = __float_as_uint(c0 + 12583040.0f) & 255u, b1 = __float_as_uint(c1 + 12583040.0f) & 255u;
                ob[q >> 1] |= (b0 | (b1 << 8)) << (16 * (q & 1)); }
            *(u32x2*)(V8 + ((size_t)((bb * 4 + kvh) * SEQ + spos)) * 128 + d0) = (u32x2){ob[0], ob[1]};
        }
        sincosf(pos * inv64, &sn, &cs);
#pragma unroll
        for (int e = 0; e < 4; ++e) { c4[e] = __shfl(cs, 4 * a8 + e); s4[e] = __shfl(sn, 4 * a8 + e); }
#pragma unroll
        for (int it = 0; it < 3; ++it) { const int hd = it * 8 + hs8; if (hd < 17) { bf16* hp = zr + 3072 + hd * 64 + 4 * a8;
            const u32x2 a = *(const u32x2*)hp, b = *(const u32x2*)(hp + 32);
            const float t1[4] = {lo2f(a.x), hi2f(a.x), lo2f(a.y), hi2f(a.y)}, t2[4] = {lo2f(b.x), hi2f(b.x), lo2f(b.y), hi2f(b.y)};
            float o1[4], o2[4];
#pragma unroll
            for (int e = 0; e < 4; ++e) { o1[e] = t1[e] * c4[e] - t2[e] * s4[e]; o2[e] = t2[e] * c4[e] + t1[e] * s4[e]; }
            const u32x2 w1 = {pk2(o1[0], o1[1]), pk2(o1[2], o1[3])}, w2 = {pk2(o2[0], o2[1]), pk2(o2[2], o2[3])};
            *(u32x2*)hp = w1; *(u32x2*)(hp + 32) = w2;
            if (hd == 16) {
                const int tile = spos >> 5, rr = spos & 31;
                bf16* kt = KIT + ((size_t)(bb * 512 + tile) * 4) * 512;
                const int d1 = 4 * a8, d2 = 32 + 4 * a8;
                *(u32x2*)(kt + ((d1 >> 4) * 64 + rr + 32 * ((d1 >> 3) & 1)) * 8 + (d1 & 7)) = w1;
                *(u32x2*)(kt + ((d2 >> 4) * 64 + rr + 32 * ((d2 >> 3) & 1)) * 8 + (d2 & 7)) = w2;
            } } }
    }
}

template <int CTRL, int RM> __device__ __forceinline__ unsigned dppu(unsigned old, unsigned v) { return (unsigned)__builtin_amdgcn_update_dpp((int)old, (int)v, CTRL, RM, 0xF, false); }
__device__ __forceinline__ void ph_dsa_select(const Args& A, Frame& F, const int mode = 0) {
    const bf16* Z = (const bf16*)(A.ws + WS_Z); unsigned short* SEL = (unsigned short*)(A.ws + WS_LA); int* CNT = (int*)(A.ws + WS_CNT); const bf16* KIT = (const bf16*)(A.ws + WS_BIG + 256 * MiB);
    LAS unsigned short* SC = (LAS unsigned short*)F.lds;
    LAS unsigned* LST = (LAS unsigned*)(F.lds + 131072);
    LAS unsigned* hist = (LAS unsigned*)(F.lds + 131072 + 16384);
    LAS unsigned* hist1 = (LAS unsigned*)(F.lds + 152576);
    LAS unsigned* res = (LAS unsigned*)(F.lds + 131072 + 16384 + 2048);
    LAS int* wtot = (LAS int*)(F.lds + 131072 + 16384 + 2048 + 64);
    const int r = F.lane & 31, hg = F.lane >> 5, tk = (r >> 2) & 1, hh = (r & 3) + 4 * (r >> 3);
    const int grp = F.wave >> 2, ltid = F.tid & 255, lw = F.wave & 3;
    for (int qd = F.bx; qd < TOK / 4; qd += F.G) {
        const int t0 = 4 * qd, b = t0 >> 14, s0 = t0 & (SEQ - 1);
        const int nkeys = s0 + 4, ntiles = (nkeys + 31) >> 5;
        bf16x8 af[2][4]; f32x2 wv[2][8];
#pragma unroll
        for (int a = 0; a < 2; ++a) {
            const bf16* qrow = Z + (size_t)(t0 + 2 * a + tk) * OD_NP + 3072 + hh * 64 + 8 * hg;
#pragma unroll
            for (int s = 0; s < 4; ++s) af[a][s] = *(const bf16x8*)(qrow + 16 * s);
            const bf16* wrow = Z + (size_t)(t0 + 2 * a + hg) * OD_NP + 4160;
            const u32x4 w0 = *(const u32x4*)(wrow), w1 = *(const u32x4*)(wrow + 8);
            const unsigned ww[8] = {w0.x, w0.y, w0.z, w0.w, w1.x, w1.y, w1.z, w1.w};
#pragma unroll
            for (int q = 0; q < 8; ++q) wv[a][q] = (f32x2){lo2f(ww[q]) * 0.03125f, hi2f(ww[q]) * 0.03125f};
        }
        __syncthreads();
        const bf16* kbase = KIT + (size_t)b * 512 * 2048 + F.lane * 8;
        if (mode != 2) {
            bf16x8 bcur[2][4];
#define DSA_LOAD1(dst, q_, tb_) do { const int tile = ((tb_) + (q_) < ntiles) ? ((tb_) + (q_)) : (ntiles - 1); const bf16* krow = kbase + (size_t)tile * 2048; \
                _Pragma("unroll") for (int s_ = 0; s_ < 4; ++s_) dst[q_][s_] = *(const bf16x8*)(krow + 512 * s_); } while (0)
#define DSA_MM(accv, src, q_, a_) do { _Pragma("unroll") for (int e = 0; e < 16; ++e) accv[e] = 0.f; \
                _Pragma("unroll") for (int s_ = 0; s_ < 4; ++s_) accv = __builtin_amdgcn_mfma_f32_32x32x16_bf16(af[a_][s_], src[q_][s_], accv, 0, 0, 0); } while (0)
#define DSA_EPI(accv, tb_, q_, a_) do { f32x2 s2_ = {0.f, 0.f}; _Pragma("unroll") for (int e = 0; e < 8; ++e) { \
                    const float x0_ = accv[2 * e], x1_ = accv[2 * e + 1]; const int r0_ = __builtin_bit_cast(int, x0_), r1_ = __builtin_bit_cast(int, x1_);        \
                    const f32x2 rl_ = {__builtin_bit_cast(float, r0_ > 0 ? r0_ : 0), __builtin_bit_cast(float, r1_ > 0 ? r1_ : 0)}; s2_ = rl_ * wv[a_][e] + s2_; } \
                float sc_ = s2_.x + s2_.y; const int key = ((tb_) + (q_)) * 32 + r; sc_ = fminf(fmaxf(sc_, -7.999f), 7.999f); const unsigned fx = (unsigned)((int)rintf(sc_ * 4096.0f) + (1 << 15)); \
                if ((tb_) + (q_) < ntiles) SC[(2 * (a_) + hg) * 16384 + key] = (unsigned short)((key <= s0 + 2 * (a_) + hg) ? fx : 0u); } while (0)
            int tb = F.wave * 2;
            if (tb < ntiles) {
                DSA_LOAD1(bcur, 0, tb); DSA_LOAD1(bcur, 1, tb);
                for (; tb < ntiles; tb += NWAVES * 2) {
                    f32x16 accA, accB;
                    DSA_MM(accA, bcur, 0, 0); DSA_MM(accB, bcur, 0, 1);
                    DSA_LOAD1(bcur, 0, tb + NWAVES * 2);
                    DSA_EPI(accA, tb, 0, 0); DSA_MM(accA, bcur, 1, 0); DSA_EPI(accB, tb, 0, 1); DSA_MM(accB, bcur, 1, 1);
                    DSA_LOAD1(bcur, 1, tb + NWAVES * 2);
                    DSA_EPI(accA, tb, 1, 0); DSA_EPI(accB, tb, 1, 1);
                }
            }
#undef DSA_LOAD1
#undef DSA_MM
#undef DSA_EPI
        }
        __syncthreads();
        if (mode == 1) continue;
#pragma unroll 1
        for (int rd = 0; rd < 2; ++rd) {
        const int tok = 2 * rd + grp;
        const int n = s0 + tok + 1; unsigned k = (unsigned)(n < 256 ? n : 256); unsigned prefix = 0u;
        const LAS unsigned short* sc = SC + tok * 16384;
        hist[grp * 256 + ltid] = 0u; hist1[grp * 256 + ltid] = 0u;
        unsigned kreg[64];
#pragma unroll
        for (int j = 0; j < 64; ++j) { const int i = ltid + 256 * j; kreg[j] = (i < n) ? (unsigned)sc[i] : 0u; }
        unsigned lmax = 0u;
#pragma unroll
        for (int j = 0; j < 64; ++j) lmax = (kreg[j] > lmax) ? kreg[j] : lmax;
        unsigned wmin = lmax;
        { unsigned x_;
          x_ = dppu<0xB1, 0xF>(wmin, wmin); wmin = x_ < wmin ? x_ : wmin; x_ = dppu<0x4E, 0xF>(wmin, wmin); wmin = x_ < wmin ? x_ : wmin;
          x_ = dppu<0x141, 0xF>(wmin, wmin); wmin = x_ < wmin ? x_ : wmin; x_ = dppu<0x140, 0xF>(wmin, wmin); wmin = x_ < wmin ? x_ : wmin;
          x_ = dppu<0x142, 0xA>(wmin, wmin); wmin = x_ < wmin ? x_ : wmin; x_ = dppu<0x143, 0xC>(wmin, wmin); wmin = x_ < wmin ? x_ : wmin; }
        if (F.lane == 63) wtot[16 + F.wave] = (int)wmin;
        __syncthreads();
        unsigned lbound = 0xFFFFFFFFu;
#pragma unroll
        for (int w = 0; w < 4; ++w) { const unsigned x = (unsigned)wtot[16 + grp * 4 + w]; lbound = x < lbound ? x : lbound; }
        LAS unsigned* seg = LST + (grp * 4 + lw) * 512; int ccnt = 0;
        {
#pragma unroll
            for (int j = 0; j < 64; ++j) { if (256 * j < n) { const bool c = ((ltid + 256 * j) < n) && (kreg[j] >= lbound); const unsigned long long m = __ballot(c);
                const int pos = ccnt + (int)__builtin_amdgcn_mbcnt_hi((unsigned)(m >> 32), __builtin_amdgcn_mbcnt_lo((unsigned)m, 0u));
                if (c && pos < 512) seg[pos] = (kreg[j] << 16) | (unsigned)(ltid + 256 * j); ccnt += __popcll(m); } }
        }
        const bool fast = ccnt <= 512;
        asm volatile("s_waitcnt lgkmcnt(0)" ::: "memory"); __builtin_amdgcn_wave_barrier();
#pragma unroll 1
        for (int pass = 0; pass < 2; ++pass) {
            const int shift = 8 - 8 * pass;
            LAS unsigned* hs = (pass == 0 ? hist : hist1) + grp * 256;
            if (fast) {
#pragma unroll
                for (int i = 0; i < 8; ++i) { if (64 * i < ccnt) { const int c_ = F.lane + 64 * i; const bool valid = c_ < ccnt; const unsigned kv = valid ? (seg[c_] >> 16) : 0u;
                    const bool match = (pass == 0) ? true : ((kv >> 8) == prefix);
                    if (valid && match) (void)__hip_atomic_fetch_add(&hs[(kv >> shift) & 255u], 1u, __ATOMIC_RELAXED, __HIP_MEMORY_SCOPE_WORKGROUP); } }
            } else {
#pragma unroll
                for (int j = 0; j < 64; ++j) { if (256 * j < n) { const unsigned kv = kreg[j]; const bool valid = ((ltid + 256 * j) < n) && (kv >= lbound);
                    const bool match = (pass == 0) ? true : ((kv >> 8) == prefix);
                    if (valid && match) (void)__hip_atomic_fetch_add(&hs[(kv >> shift) & 255u], 1u, __ATOMIC_RELAXED, __HIP_MEMORY_SCOPE_WORKGROUP); } }
            }
            __syncthreads();
            if (lw == 0) {
                const unsigned c0 = hs[4 * F.lane], c1 = hs[4 * F.lane + 1], c2 = hs[4 * F.lane + 2], c3 = hs[4 * F.lane + 3];
                const unsigned tot = c0 + c1 + c2 + c3; unsigned pre = tot;
                pre += dppu<0x111, 0xF>(0u, pre); pre += dppu<0x112, 0xF>(0u, pre); pre += dppu<0x114, 0xF>(0u, pre); pre += dppu<0x118, 0xF>(0u, pre);
                pre += dppu<0x142, 0xA>(0u, pre); pre += dppu<0x143, 0xC>(0u, pre);
                const unsigned total = (unsigned)__builtin_amdgcn_readlane((int)pre, 63); const unsigned suf = total - pre + tot;
                unsigned above = suf - tot;
                if (above < k && k <= suf) {
                    int bin;
                    if (above + c3 >= k) { bin = 3; } else { above += c3; if (above + c2 >= k) { bin = 2; } else { above += c2; if (above + c1 >= k) { bin = 1; } else { above += c1; bin = 0; } } }
                    res[grp * 2 + 0] = (unsigned)(4 * F.lane + bin); res[grp * 2 + 1] = k - above;
                }
            }
            __syncthreads();
            prefix = (prefix << 8) | res[grp * 2 + 0]; k = res[grp * 2 + 1];
        }
        const unsigned tau = prefix; const int krem = (int)k;
#define MBCNT(m_) ((int)__builtin_amdgcn_mbcnt_hi((unsigned)((m_) >> 32), __builtin_amdgcn_mbcnt_lo((unsigned)(m_), 0u)))
        int cgW = 0, ceW = 0;
        if (fast) {
#pragma unroll
            for (int i = 0; i < 8; ++i) { if (64 * i < ccnt) { const int c_ = F.lane + 64 * i; const bool valid = c_ < ccnt; const unsigned kv = valid ? (seg[c_] >> 16) : 0u;
                cgW += __popcll(__ballot(valid && kv > tau)); ceW += __popcll(__ballot(valid && kv == tau)); } }
        } else {
#pragma unroll
            for (int j = 0; j < 64; ++j) { if (256 * j < n) { const bool valid = (ltid + 256 * j) < n; const unsigned kv = kreg[j];
                cgW += __popcll(__ballot(valid && kv > tau)); ceW += __popcll(__ballot(valid && kv == tau)); } }
        }
        if (F.lane == 0) { wtot[F.wave * 2] = cgW; wtot[F.wave * 2 + 1] = ceW; }
        __syncthreads();
        int og = 0, oe = 0, totg = 0;
        for (int w = 0; w < 4; ++w) { const int a = wtot[(grp * 4 + w) * 2], e = wtot[(grp * 4 + w) * 2 + 1]; if (w < lw) { og += a; oe += e; } totg += a; }
        LAS unsigned short* sel = (LAS unsigned short*)(F.lds + 151552) + grp * 256;
        if (fast) {
#pragma unroll
            for (int i = 0; i < 8; ++i) { if (64 * i < ccnt) { const int c_ = F.lane + 64 * i; const bool valid = c_ < ccnt; const unsigned pk = valid ? seg[c_] : 0u; const unsigned kv = pk >> 16;
                const bool gt = valid && kv > tau, eq = valid && kv == tau; const unsigned long long mg = __ballot(gt), me = __ballot(eq);
                const int pg = og + MBCNT(mg), pe = oe + MBCNT(me);
                if (gt) sel[pg] = (unsigned short)(pk & 0xffffu); else if (eq && pe < krem) sel[totg + pe] = (unsigned short)(pk & 0xffffu);
                og += __popcll(mg); oe += __popcll(me); } }
        } else {
#pragma unroll
            for (int j = 0; j < 64; ++j) { if (256 * j < n) { const int i = ltid + 256 * j; const bool valid = i < n; const unsigned kv = kreg[j];
                const bool gt = valid && kv > tau, eq = valid && kv == tau; const unsigned long long mg = __ballot(gt), me = __ballot(eq);
                const int pg = og + MBCNT(mg), pe = oe + MBCNT(me);
                if (gt) sel[pg] = (unsigned short)i; else if (eq && pe < krem) sel[totg + pe] = (unsigned short)i;
                og += __popcll(mg); oe += __popcll(me); } }
        }
#undef MBCNT
        if (ltid == 0) CNT[t0 + tok] = (n < 256 ? n : 256);
        __syncthreads();
        if (ltid < 128) { int lt2 = ltid; asm volatile("" : "+v"(lt2));
            ((unsigned*)SEL)[(size_t)(t0 + 2 * rd + grp) * 128 + lt2] = ((const LAS unsigned*)(F.lds + 151552))[grp * 128 + lt2]; }
        }
    }
}

__device__ __forceinline__ float sum8_dpp(float v) { v += dppf<0xB1, 0xF>(v); v += dppf<0x4E, 0xF>(v); v += dppf<0x141, 0xF>(v); return v; }
__device__ __forceinline__ void ph_dsa_attn(const Args& A, Frame& F, const XInfo X) {
    const bf16* Z = (const bf16*)(A.ws + WS_Z); const unsigned short* SEL = (const unsigned short*)(A.ws + WS_LA); const int* CNT = (const int*)(A.ws + WS_CNT);
    const unsigned char* K8 = A.ws + WS_BIG + 264 * MiB; const unsigned char* V8 = A.ws + WS_BIG + 280 * MiB; bf16* Y = (bf16*)(A.ws + WS_HY);
    LAS int* IDX = (LAS int*)(F.lds + F.wave * 5120);
    LAS float* SCR = (LAS float*)(F.lds + F.wave * 5120 + 1024);
    const int g8 = F.lane >> 3, c8 = F.lane & 7;
    for (int sl = X.rx; sl < 8; sl += X.nx) {
        const int b = sl >> 2, kvh = sl & 3;
        const unsigned char* kb = K8 + (size_t)sl * SEQ * 128 + 16 * c8; const unsigned char* vb = V8 + (size_t)sl * SEQ * 128 + 16 * c8;
        for (int sq = X.rank * NWAVES + F.wave; sq < SEQ; sq += X.nloc * NWAVES) {
            const int t = b * SEQ + sq; const int n = CNT[t];
            const int l15 = F.lane & 15, g4 = F.lane >> 4;
            long bq[4];
#pragma unroll
            for (int c = 0; c < 2; ++c) {
                float f[16];
#pragma unroll
                for (int e = 0; e < 16; ++e) f[e] = 0.f;
                if (l15 < 4) { const bf16* qp = Z + (size_t)t * OD_NP + (kvh * 4 + l15) * 128 + 64 * c + 16 * g4; const u32x4 a = *(const u32x4*)qp, b2 = *(const u32x4*)(qp + 8);
                    const unsigned aw[8] = {a.x, a.y, a.z, a.w, b2.x, b2.y, b2.z, b2.w};
#pragma unroll
                    for (int q = 0; q < 8; ++q) { f[2 * q] = lo2f(aw[q]) * 16.0f; f[2 * q + 1] = hi2f(aw[q]) * 16.0f; } }
#pragma unroll
                for (int hf = 0; hf < 2; ++hf) {
                    int lo = __builtin_amdgcn_cvt_pk_fp8_f32(f[8 * hf + 0], f[8 * hf + 1], 0, false); lo = __builtin_amdgcn_cvt_pk_fp8_f32(f[8 * hf + 2], f[8 * hf + 3], lo, true);
                    int hi = __builtin_amdgcn_cvt_pk_fp8_f32(f[8 * hf + 4], f[8 * hf + 5], 0, false); hi = __builtin_amdgcn_cvt_pk_fp8_f32(f[8 * hf + 6], f[8 * hf + 7], hi, true);
                    bq[2 * c + hf] = (long)(((unsigned long long)(unsigned)hi << 32) | (unsigned long long)(unsigned)lo); }
            }
#pragma unroll
            for (int m = 0; m < 4; ++m) { const int jj = F.lane + 64 * m; IDX[jj] = (jj < n) ? (int)SEL[(size_t)t * 256 + jj] : 0; }
            asm volatile("s_waitcnt lgkmcnt(0)" ::: "memory"); __builtin_amdgcn_wave_barrier();
            {
                const unsigned char* kq = K8 + (size_t)sl * SEQ * 128 + 16 * g4;
#pragma unroll 1
                for (int tl0 = 0; tl0 < 16; tl0 += 4) {
                    u32x4 k0[4], k1[4];
#pragma unroll
                    for (int u = 0; u < 4; ++u) { const int id = IDX[(tl0 + u) * 16 + l15]; const unsigned char* kr = kq + (size_t)id * 128; k0[u] = *(const u32x4*)kr; k1[u] = *(const u32x4*)(kr + 64); }
#pragma unroll
                    for (int u = 0; u < 4; ++u) {
                        f32x4 acc = {0.f, 0.f, 0.f, 0.f};
                        acc = __builtin_amdgcn_mfma_f32_16x16x32_fp8_fp8((long)(((unsigned long long)k0[u].y << 32) | k0[u].x), bq[0], acc, 0, 0, 0);
                        acc = __builtin_amdgcn_mfma_f32_16x16x32_fp8_fp8((long)(((unsigned long long)k0[u].w << 32) | k0[u].z), bq[1], acc, 0, 0, 0);
                        acc = __builtin_amdgcn_mfma_f32_16x16x32_fp8_fp8((long)(((unsigned long long)k1[u].y << 32) | k1[u].x), bq[2], acc, 0, 0, 0);
                        acc = __builtin_amdgcn_mfma_f32_16x16x32_fp8_fp8((long)(((unsigned long long)k1[u].w << 32) | k1[u].z), bq[3], acc, 0, 0, 0);
                        if (l15 < 4) {
#pragma unroll
                            for (int rg = 0; rg < 4; ++rg) SCR[((tl0 + u) * 16 + 4 * g4 + rg) * 4 + l15] = acc[rg] * 3.452669831e-4f; }
                    }
                }
            }
            asm volatile("s_waitcnt lgkmcnt(0)" ::: "memory"); __builtin_amdgcn_wave_barrier();
            float sclh[4], offh[4];
            {
                f32x4 sv[4]; unsigned pqb[4][4];
#pragma unroll
                for (int m = 0; m < 4; ++m) sv[m] = *(const LAS f32x4*)(SCR + (F.lane + 64 * m) * 4);
#pragma unroll
                for (int g = 0; g < 4; ++g) {
                    float mx = -INFINITY;
#pragma unroll
                    for (int m = 0; m < 4; ++m) { const bool val = (F.lane + 64 * m) < n; sv[m][g] = val ? sv[m][g] : -INFINITY; mx = fmaxf(mx, sv[m][g]); }
                    mx = wmax(mx); float sm = 0.f, sq = 0.f;
#pragma unroll
                    for (int m = 0; m < 4; ++m) { const bool val = (F.lane + 64 * m) < n; const float ex = val ? expf(sv[m][g] - mx) : 0.f; sm += ex;
                        const float pf = rintf(255.0f * ex); sq += pf; pqb[m][g] = (unsigned)pf; }
                    sclh[g] = 0.0625f / (255.0f * wsum(sm)); offh[g] = 128.0f * wsum(sq);
                }
                asm volatile("s_waitcnt lgkmcnt(0)" ::: "memory"); __builtin_amdgcn_wave_barrier();
#pragma unroll
                for (int m = 0; m < 4; ++m) { const int jj = F.lane + 64 * m;
#pragma unroll
                    for (int g = 0; g < 4; ++g) ((LAS unsigned char*)SCR)[(jj >> 2) * 16 + g * 4 + (jj & 3)] = (unsigned char)pqb[m][g]; }
            }
            asm volatile("s_waitcnt lgkmcnt(0)" ::: "memory"); __builtin_amdgcn_wave_barrier();
            unsigned acc[4][16];
#pragma unroll
            for (int g = 0; g < 4; ++g)
#pragma unroll
                for (int j = 0; j < 16; ++j) acc[g][j] = 0u;
#pragma unroll 1
            for (int ib = 0; ib < 8; ib += 2) {
                u32x4 vd[2][4], pq4[2];
#pragma unroll
                for (int h = 0; h < 2; ++h) { pq4[h] = *(const LAS u32x4*)((const LAS unsigned char*)SCR + (8 * (ib + h) + g8) * 16);
#pragma unroll
                    for (int u = 0; u < 4; ++u) { const int id = IDX[32 * (ib + h) + 4 * g8 + u]; vd[h][u] = *(const u32x4*)(vb + (size_t)id * 128); } }
#pragma unroll
                for (int h = 0; h < 2; ++h)
#pragma unroll
                    for (int q = 0; q < 4; ++q) { const unsigned A_ = vd[h][0][q], B_ = vd[h][1][q], C_ = vd[h][2][q], D_ = vd[h][3][q];
                        const unsigned ablo = __builtin_amdgcn_perm(B_, A_, 0x05010400u), abhi = __builtin_amdgcn_perm(B_, A_, 0x07030602u);
                        const unsigned cdlo = __builtin_amdgcn_perm(D_, C_, 0x05010400u), cdhi = __builtin_amdgcn_perm(D_, C_, 0x07030602u);
                        const unsigned t0 = __builtin_amdgcn_perm(cdlo, ablo, 0x05040100u), t1 = __builtin_amdgcn_perm(cdlo, ablo, 0x07060302u);
                        const unsigned t2 = __builtin_amdgcn_perm(cdhi, abhi, 0x05040100u), t3 = __builtin_amdgcn_perm(cdhi, abhi, 0x07060302u);
#pragma unroll
                        for (int g = 0; g < 4; ++g) { const unsigned pg = pq4[h][g];
                            acc[g][4 * q + 0] = __builtin_amdgcn_udot4(t0, pg, acc[g][4 * q + 0], false); acc[g][4 * q + 1] = __builtin_amdgcn_udot4(t1, pg, acc[g][4 * q + 1], false);
                            acc[g][4 * q + 2] = __builtin_amdgcn_udot4(t2, pg, acc[g][4 * q + 2], false); acc[g][4 * q + 3] = __builtin_amdgcn_udot4(t3, pg, acc[g][4 * q + 3], false); } }
            }
            f32x2 mine[8];
            { const int hr = F.lane >> 4; const float scl = (hr == 0) ? sclh[0] : ((hr == 1) ? sclh[1] : ((hr == 2) ? sclh[2] : sclh[3])), off = (hr == 0) ? offh[0] : ((hr == 1) ? offh[1] : ((hr == 2) ? offh[2] : offh[3]));
#pragma unroll
              for (int q = 0; q < 8; ++q) {
                float x[4][2];
#pragma unroll
                for (int g = 0; g < 4; ++g) { float a0 = (float)acc[g][2 * q], a1 = (float)acc[g][2 * q + 1];
                    a0 += dppf<0x128, 0xF>(a0); a1 += dppf<0x128, 0xF>(a1);
                    x[g][0] = a0; x[g][1] = a1; }
                mine[q].x = (rsum4(x[0][0], x[1][0], x[2][0], x[3][0]) - off) * scl; mine[q].y = (rsum4(x[0][1], x[1][1], x[2][1], x[3][1]) - off) * scl;
              } }
            if ((F.lane & 8) == 0) { u32x4 w0, w1; const int hrow = F.lane >> 4;
                w0.x = pk2(mine[0].x, mine[0].y); w0.y = pk2(mine[1].x, mine[1].y); w0.z = pk2(mine[2].x, mine[2].y); w0.w = pk2(mine[3].x, mine[3].y);
                w1.x = pk2(mine[4].x, mine[4].y); w1.y = pk2(mine[5].x, mine[5].y); w1.z = pk2(mine[6].x, mine[6].y); w1.w = pk2(mine[7].x, mine[7].y);
                bf16* yp = Y + (size_t)t * DM + (kvh * 4 + hrow) * 128 + 16 * c8; *(u32x4*)yp = w0; *(u32x4*)(yp + 8) = w1; }
            asm volatile("s_waitcnt lgkmcnt(0)" ::: "memory"); __builtin_amdgcn_wave_barrier();
        }
    }
}

__global__ void __launch_bounds__(NTHREADS, 2) mk_fwd(Args args) {
    extern __shared__ __attribute__((aligned(16))) unsigned char lds[];
    Frame F;
    F.lds = (LAS unsigned char*)lds;
    volatile LAS unsigned* MISC = (volatile LAS unsigned*)(F.lds + MISC_OFF);
    F.tid = threadIdx.x; F.lane = F.tid & 63; F.wave = __builtin_amdgcn_readfirstlane(F.tid >> 6);
    F.bx = blockIdx.x; F.G = gridDim.x; F.gw = F.bx * NWAVES + F.wave; F.ngw = F.G * NWAVES;
    if (F.tid < 64) MISC[F.tid] = 0u;
    __syncthreads();
    unsigned char* ws = args.ws;
    XcdBarrier bar = xcd_barrier_post((unsigned*)(ws + WS_CTL) + CW_BAR, MISC + 8);
    if (F.tid == 0) { MISC[16] = xb_add((unsigned*)(ws + WS_CTL) + CW_XRANK + 64 * bar.x, 1u); }
    const int lo = args.ph_lo, hi = args.ph_hi;
#define IN(k) (lo <= (k) && (k) < hi)
#define SEAM(k) do { if (IN((k) + 1)) xcd_barrier(bar); } while (0)
#define GEMM_BF16(Aptr, Bptr, Nn, Kk, Optr, ldo) do { pg8::Gemm g{(const pg8::bf16_t*)(Aptr), (const pg8::bf16_t*)(Bptr), TOK, (Nn), (Kk)}; pg8::StaticOrder S; S.init(TOK, (Nn), F.G, F.bx); \
        pg8::EpiBf16<0> E{(pg8::bf16_t*)(Optr), (ldo), nullptr, 0, 0}; pg8::gemm_phase<pg8::EpiBf16<0>, pg8::StaticOrder, false>(F.lds, g, S, E, nullptr); } while (0)

#ifndef PROBE_MASK
#define PROBE_MASK 0
#endif
#define PRB(bit, stmt) do { if (PROBE_MASK & (1 << (bit))) { stmt; xcd_barrier(bar); } } while (0)
    if (IN(0)) { PRB(14, ph_prologue(args, F)); ph_prologue(args, F); SEAM(0); }
    if (IN(1)) { ph_mod_x(args, F); SEAM(1); }
    if (F.tid == 0) {
        unsigned* cb = (unsigned*)(ws + WS_CTL) + CW_BAR; unsigned nloc = 1u, rx = 0u, nx = 0u;
        for (unsigned j = 0; j < 16; ++j) { const unsigned c = xb_ld(&cb[XB_XCNT(j)]); if (c > 0u) { if (j < bar.x) ++rx; ++nx; } if (j == bar.x) nloc = c > 0u ? c : 1u; }
        if (nx == 0u) nx = 1u;
        MISC[17] = nloc; MISC[18] = rx; MISC[19] = nx; }
    __syncthreads();
    const XInfo XI = xcc_info(MISC);
    if (IN(2)) { PRB(8, GEMM_BF16(ws + WS_HY, ws + WS_WINE, EV_NP, 2048, ws + WS_Z, EV_NP)); GEMM_BF16(ws + WS_HY, ws + WS_WINE, EV_NP, 2048, ws + WS_Z, EV_NP); SEAM(2); }
    if (IN(3)) { ph_even_post(args, F); SEAM(3); }
    if (IN(4)) { pg8::Gemm g{(const pg8::bf16_t*)(ws + WS_LA), (const pg8::bf16_t*)(ws + WS_WL), TOK, 3072, 512}; pg8::StaticOrder S; S.init(TOK, 3072, F.G, F.bx);
                 EpiLora E{(pg8::bf16_t*)(ws + WS_Z) + 1280, EV_NP, (const float*)args.in[7], (const float*)args.in[9]};
                 pg8::gemm_phase<EpiLora, pg8::StaticOrder, false>(F.lds, g, S, E, nullptr); SEAM(4); }
    if (IN(5)) { PRB(9, ph_scan_prep(args, F)); ph_scan_prep(args, F); xcd_barrier(bar); }
    if (IN(7)) { PRB(15, scan_mfma_rows(args, F)); ph_swa_mfma(args, F); scan_mfma_rows(args, F); SEAM(7); }
    if (IN(8)) { PRB(10, ph_rwkv_finish(args, F)); ph_rwkv_finish(args, F); SEAM(8); }
    if (IN(9)) { GEMM_BF16(ws + WS_HY, ws + WS_WOUTE, 2048, 2048, ws + WS_Z, 2048); SEAM(9); }
    if (IN(10)) { PRB(11, ph_ln_mixer(args, F, 0)); ph_ln_mixer(args, F, 0); SEAM(10); }
    if (IN(11)) { GEMM_BF16(ws + WS_HY, ws + WS_WQ0, 2048, 2048, ws + WS_Z, 2048); SEAM(11); }
    if (IN(12)) { PRB(4, ph_peer_select(args, F, 0)); ph_peer_select(args, F, 0); SEAM(12); }
    if (IN(13)) { PRB(12, ph_peer_u(args, F, XI)); ph_peer_u(args, F, XI); xcd_barrier(bar); ph_peer_act(args, F); xcd_barrier(bar); PRB(13, ph_peer_v(args, F, XI)); ph_peer_v(args, F, XI); xcd_barrier(bar); ph_peer_ln(args, F, 0); SEAM(13); }
    if (IN(14)) { GEMM_BF16(ws + WS_HY, ws + WS_WINO, OD_NP, 2048, ws + WS_Z, OD_NP); SEAM(14); }
    if (IN(15)) { ph_odd_post(args, F); SEAM(15); }
    if (IN(16)) { PRB(2, ph_dsa_select(args, F, 1)); PRB(6, ph_dsa_select(args, F, 2)); PRB(7, ph_dsa_select(args, F, 0)); ph_dsa_select(args, F); SEAM(16); }
    if (IN(17)) { ph_dsa_attn(args, F, XI); SEAM(17); }
    if (IN(18)) { GEMM_BF16(ws + WS_HY, ws + WS_WOUTO, 2048, 2048, ws + WS_Z, 2048); SEAM(18); }
    if (IN(19)) { ph_ln_mixer(args, F, 1); SEAM(19); }
    if (IN(20)) { GEMM_BF16(ws + WS_HY, ws + WS_WQ1, 2048, 2048, ws + WS_Z, 2048); SEAM(20); }
    if (IN(21)) { PRB(4, ph_peer_select(args, F, 1)); ph_peer_select(args, F, 1); SEAM(21); }
    if (IN(22)) { ph_peer_u(args, F, XI); xcd_barrier(bar); ph_peer_act(args, F); xcd_barrier(bar); ph_peer_v(args, F, XI); xcd_barrier(bar); ph_peer_ln(args, F, 1); }
#undef IN
#undef SEAM
#undef GEMM_BF16
}

#ifndef MK_SPLIT
#define MK_SPLIT 0
#endif
extern "C" void kernel_launch(void* const* d_in, const int* in_sizes, int n_in, void* d_out, int out_size, void* d_ws, size_t ws_size, hipStream_t stream) {
    static int grid = 0;
    if (grid == 0) {
        int dev = 0, cus = 0;
        if (n_in != 27 || out_size != TOK * DM || ws_size < WS_END) { fprintf(stderr, "kernel_launch: unexpected shapes (n_in %d out %d ws %zu)\n", n_in, out_size, ws_size); grid = -1; return; }
        if (hipGetDevice(&dev) != hipSuccess || hipDeviceGetAttribute(&cus, hipDeviceAttributeMultiprocessorCount, dev) != hipSuccess) { grid = -1; return; }
        if (hipFuncSetAttribute((const void*)mk_fwd, hipFuncAttributeMaxDynamicSharedMemorySize, LDS_BYTES) != hipSuccess) { fprintf(stderr, "kernel_launch: hipFuncSetAttribute failed\n"); grid = -1; return; }
        int per_cu = 0;
        if (hipOccupancyMaxActiveBlocksPerMultiprocessor(&per_cu, (const void*)mk_fwd, NTHREADS, LDS_BYTES) != hipSuccess || per_cu < 1) fprintf(stderr, "kernel_launch: occupancy query says %d\n", per_cu);
        (void)hipGetLastError();
        grid = cus;
    }
    if (grid < 0) return;
    (void)hipMemsetAsync((char*)d_ws + WS_CTL, 0, CTL_ZERO_BYTES, stream);
    Args a{};
    for (int i = 0; i < 27; ++i) a.in[i] = d_in[i];
    a.out = (float*)d_out; a.ws = (unsigned char*)d_ws;
#if MK_SPLIT
    for (int p = 0; p < 23; ++p) { a.ph_lo = p; a.ph_hi = p + 1; hipLaunchKernelGGL(mk_fwd, dim3(grid), dim3(NTHREADS), LDS_BYTES, stream, a); }
#else
    a.ph_lo = 0; a.ph_hi = 23;
    hipLaunchKernelGGL(mk_fwd, dim3(grid), dim3(NTHREADS), LDS_BYTES, stream, a);
#endif
}
```

```cpp
#include <hip/hip_runtime.h>
#include <cstdio>
#include <cstdint>
namespace pg8 {
#define PG8_LAS __attribute__((address_space(3)))
typedef unsigned short bf16_t;
typedef short bf16x8 __attribute__((ext_vector_type(8)));
typedef float f32x4 __attribute__((ext_vector_type(4)));
typedef unsigned u32x4 __attribute__((ext_vector_type(4)));
constexpr int BM = 256, BK = 64, HALF = 128, HTB = HALF * BK * 2  , STAGE_BYTES = 8 * HTB, NXCD = 8, WGM = 8;

__host__ __device__ __forceinline__ int lds_byte(int r, int c) { const int st = (r >> 4) * 2 + (c >> 5), rr = r & 15, cc = c & 31, ob = rr * 64 + cc * 2; return st * 1024 + (ob ^ (((ob >> 9) & 1) << 5)); }
__host__ __device__ __forceinline__ void stage_rc(int b, int& R, int& C) { const int st = b / 1024, sb = b % 1024, swz = sb ^ (((sb >> 9) & 1) << 5); R = (st >> 1) * 16 + swz / 64; C = (st & 1) * 32 + (swz % 64) / 2; }
__host__ __device__ __forceinline__ int perm32(int rho) { const int n = rho >> 4, i = rho & 15; return 8 * (i >> 2) + 4 * n + (i & 3); }

struct Unit { int pm, pn; };
struct Gemm { const bf16_t* A; const bf16_t* Bt; int M, N, K; };

struct StaticOrder {
    int nM, nN, nwg, G, c;
    __host__ __device__ void init(int M, int N, int G_, int c_) { nM = M / BM; nN = N / BM; nwg = nM * nN; G = G_; c = c_; }
    __host__ __device__ bool next(int i, Unit& u) const {
        const long L = (long)i * G + c; if (L >= nwg) return false;
        int wgid = (int)L; { const int q = nwg / NXCD, r = nwg % NXCD, xcd = wgid % NXCD, off = wgid / NXCD; wgid = (xcd < r ? xcd * (q + 1) : r * (q + 1) + (xcd - r) * q) + off; }
        const int nig = WGM * nN, gid = wgid / nig, fm = gid * WGM, gsz = (nM - fm) < WGM ? (nM - fm) : WGM;
        u.pm = fm + ((wgid % nig) % gsz); u.pn = (wgid % nig) / gsz; return true;
    }
    __device__ __forceinline__ void a_ready(const Unit&) const {}
    __device__ __forceinline__ void done(const Unit&) const {}
};
struct CountedOrder : StaticOrder {
    const unsigned* ready; unsigned need; unsigned* tmo;
    __device__ __forceinline__ void a_ready(const Unit& u) const {
        if (threadIdx.x < 64) {
            const unsigned long long t0 = __builtin_amdgcn_s_memrealtime(); unsigned polls = 0;
            while ((unsigned)__builtin_amdgcn_readfirstlane(__hip_atomic_load(ready + 64 * u.pm, __ATOMIC_RELAXED, __HIP_MEMORY_SCOPE_AGENT)) < need) {
                if ((++polls & 255u) == 0u && __builtin_amdgcn_readfirstlane(__hip_atomic_load(tmo, __ATOMIC_RELAXED, __HIP_MEMORY_SCOPE_AGENT)) != 0u) break;
                if (__builtin_amdgcn_s_memrealtime() - t0 > 2000000ull) {
                    if (threadIdx.x == 0) { unsigned expect = 0u; __hip_atomic_compare_exchange_strong(tmo + 1, &expect, 0x600u | (unsigned)(u.pm & 0xff), __ATOMIC_RELAXED, __ATOMIC_RELAXED, __HIP_MEMORY_SCOPE_AGENT); __hip_atomic_store(tmo, 1u, __ATOMIC_RELAXED, __HIP_MEMORY_SCOPE_AGENT); }
                    break; }
                __builtin_amdgcn_s_sleep(2); }
            __builtin_amdgcn_fence(__ATOMIC_ACQUIRE, "agent");
            asm volatile("s_waitcnt vmcnt(0)" ::: "memory");
        }
#if !defined(BROKEN_HOOK_NO_BARRIER)
        asm volatile("" ::: "memory"); __builtin_amdgcn_s_barrier(); asm volatile("" ::: "memory");
#endif
    }
};

__device__ __forceinline__ unsigned cvt_pk_bf16(float lo, float hi) { unsigned r; asm volatile("v_cvt_pk_bf16_f32 %0, %1, %2" : "=v"(r) : "v"(lo), "v"(hi)); return r; }
typedef float f32x2 __attribute__((ext_vector_type(2)));
__device__ __forceinline__ f32x2 gelu_pk(f32x2 v) {
    const f32x2 av = __builtin_elementwise_abs(v), d = av * 0.2316418882f + 1.0f;
    f32x2 t; t.x = __builtin_amdgcn_rcpf(d.x); t.y = __builtin_amdgcn_rcpf(d.y);
    f32x2 q = t * 0.5307027145f + (-0.7265760135f); q = q * t + 0.7107068705f; q = q * t + (-0.142248368f); q = q * t + 0.127414796f; q = q * t;
    const f32x2 s = (v * v) * (-0.72134752044f);
    f32x2 e; e.x = __builtin_amdgcn_exp2f(s.x); e.y = __builtin_amdgcn_exp2f(s.y);
    const f32x2 m = v * (q * e), r = v - m;
    f32x2 o; o.x = v.x < 0.f ? m.x : r.x; o.y = v.y < 0.f ? m.y : r.y; return o;
}

struct EpiF32 {
    static constexpr bool PERM = false, AFTER_DRAIN = false;
    float* C; int ldc; const float* bias;
    __device__ __forceinline__ void operator()(const f32x4 (&acc)[2][2][4][2], const Unit& u, int wr, int wc, int fr, int fq) const {
        const int row0 = u.pm * BM + wr * 64 + fr, col0 = u.pn * BM + wc * 32 + 4 * fq;
        f32x4 bv[2][2];
#pragma unroll
        for (int bj = 0; bj < 2; ++bj)
#pragma unroll
            for (int n = 0; n < 2; ++n) bv[bj][n] = bias ? *(const f32x4*)(bias + col0 + bj * HALF + n * 16) : (f32x4){0.f, 0.f, 0.f, 0.f};
#pragma unroll
        for (int ai = 0; ai < 2; ++ai)
#pragma unroll
            for (int m = 0; m < 4; ++m) { float* rowp = C + (size_t)(row0 + ai * HALF + m * 16) * ldc + col0;
#pragma unroll
                for (int bj = 0; bj < 2; ++bj)
#pragma unroll
                    for (int n = 0; n < 2; ++n) *(f32x4*)(rowp + bj * HALF + n * 16) = acc[ai][bj][m][n] + bv[bj][n]; }
    }
};
template <int ACT  > struct EpiBf16 {
    static constexpr bool PERM = true, AFTER_DRAIN = false;
    bf16_t* O; int ldc; const float* bias; int split_cols; size_t split_stride;
    __device__ __forceinline__ void operator()(const f32x4 (&acc)[2][2][4][2], const Unit& u, int wr, int wc, int fr, int fq) const {
        const int row0 = u.pm * BM + wr * 64 + fr; int colt = u.pn * BM; bf16_t* base = O;
        if (split_cols) { const int t = colt / split_cols; base += (size_t)t * split_stride; colt -= t * split_cols; }
        const int col0 = colt + wc * 32 + 8 * fq, bcol0 = u.pn * BM + wc * 32 + 8 * fq;
        f32x4 bv[2][2];
#pragma unroll
        for (int bj = 0; bj < 2; ++bj)
#pragma unroll
            for (int n = 0; n < 2; ++n) bv[bj][n] = bias ? *(const f32x4*)(bias + bcol0 + bj * HALF + 4 * n) : (f32x4){0.f, 0.f, 0.f, 0.f};
#pragma unroll
        for (int ai = 0; ai < 2; ++ai)
#pragma unroll
            for (int m = 0; m < 4; ++m) { bf16_t* rowp = base + (size_t)(row0 + ai * HALF + m * 16) * ldc + col0;
#pragma unroll
                for (int bj = 0; bj < 2; ++bj) { f32x4 v0 = acc[ai][bj][m][0] + bv[bj][0], v1 = acc[ai][bj][m][1] + bv[bj][1];
                    if (ACT == 1) { f32x2 a = gelu_pk((f32x2){v0[0], v0[1]}), b = gelu_pk((f32x2){v0[2], v0[3]}), c = gelu_pk((f32x2){v1[0], v1[1]}), d = gelu_pk((f32x2){v1[2], v1[3]});
                        v0 = (f32x4){a.x, a.y, b.x, b.y}; v1 = (f32x4){c.x, c.y, d.x, d.y}; }
                    if (ACT == 2) {
#pragma unroll
                        for (int j = 0; j < 4; ++j) { v0[j] = 0.5f * v0[j] * (1.0f + erff(v0[j] * 0.70710678f)); v1[j] = 0.5f * v1[j] * (1.0f + erff(v1[j] * 0.70710678f)); } }
                    u32x4 w; w.x = cvt_pk_bf16(v0[0], v0[1]); w.y = cvt_pk_bf16(v0[2], v0[3]); w.z = cvt_pk_bf16(v1[0], v1[1]); w.w = cvt_pk_bf16(v1[2], v1[3]);
                    *(u32x4*)(rowp + bj * HALF) = w; } }
    }
};

struct PanelStats {
    unsigned* xbuf;
    unsigned* cnt;
    unsigned* tmo;
    int ntn; float eps;
    unsigned code;
    __device__ __forceinline__ bool run(const f32x4 (&v)[2][2][4][2], const Unit& u, int wr, int wc, int fr, int fq, PG8_LAS unsigned char* lds, int wid, int lane) const {
        typedef float f32x2v __attribute__((ext_vector_type(2)));
        PG8_LAS f32x2v* P = (PG8_LAS f32x2v*)lds;
        PG8_LAS f32x2v* S = (PG8_LAS f32x2v*)(lds + 8192);
        PG8_LAS unsigned* flag = (PG8_LAS unsigned*)(lds + 8192 + 2048);
#pragma unroll
        for (int ai = 0; ai < 2; ++ai)
#pragma unroll
            for (int m = 0; m < 4; ++m) {
                float s = 0.f;
#pragma unroll
                for (int bj = 0; bj < 2; ++bj)
#pragma unroll
                    for (int n = 0; n < 2; ++n) { const f32x4 x = v[ai][bj][m][n]; s += (x[0] + x[1]) + (x[2] + x[3]); }
                s += __shfl_xor(s, 16); s += __shfl_xor(s, 32);
                const float mw = s * (1.0f / 64.0f); float q = 0.f;
#pragma unroll
                for (int bj = 0; bj < 2; ++bj)
#pragma unroll
                    for (int n = 0; n < 2; ++n) { const f32x4 d = v[ai][bj][m][n] - mw; q += (d[0] * d[0] + d[1] * d[1]) + (d[2] * d[2] + d[3] * d[3]); }
                q += __shfl_xor(q, 16); q += __shfl_xor(q, 32);
                if (fq == 0) P[(ai * HALF + wr * 64 + m * 16 + fr) * 4 + wc] = (f32x2v){mw, q};
            }
        asm volatile("s_waitcnt lgkmcnt(0)" ::: "memory"); __builtin_amdgcn_s_barrier(); asm volatile("" ::: "memory");
#if defined(BROKEN_NO_WAIT)
        if (blockIdx.x >= 64) { const long long t0 = clock64(); while (clock64() - t0 < 60000) __builtin_amdgcn_s_sleep(8); }
#endif
        const int row = wid * 32 + (lane & 31);
        if (lane < 32) {
            const f32x2v a = P[row * 4 + 0], b = P[row * 4 + 1], c = P[row * 4 + 2], d = P[row * 4 + 3];
            const float mt = (a.x + b.x + c.x + d.x) * 0.25f;
            const float da = a.x - mt, db = b.x - mt, dc = c.x - mt, dd = d.x - mt;
            const float m2 = (a.y + b.y) + (c.y + d.y) + 64.0f * ((da * da + db * db) + (dc * dc + dd * dd));
            unsigned long long* slot = (unsigned long long*)xbuf + ((size_t)(u.pm * BM + row) * 4 + u.pn);
            __hip_atomic_store(slot, ((unsigned long long)__float_as_uint(m2) << 32) | __float_as_uint(mt), __ATOMIC_RELAXED, __HIP_MEMORY_SCOPE_AGENT);
        }
        asm volatile("s_waitcnt vmcnt(0)" ::: "memory");
        if (lane == 0) __hip_atomic_fetch_add(cnt + 64 * u.pm, 1u, __ATOMIC_RELAXED, __HIP_MEMORY_SCOPE_AGENT);
        if (wid == 0) {
            bool dead = false; const unsigned long long t0 = __builtin_amdgcn_s_memrealtime(); const unsigned want = 8u * (unsigned)ntn;
            for (;;) {
#if defined(BROKEN_NO_WAIT)
                break;
#endif
                if ((unsigned)__builtin_amdgcn_readfirstlane(__hip_atomic_load(cnt + 64 * u.pm, __ATOMIC_RELAXED, __HIP_MEMORY_SCOPE_AGENT)) >= want) break;
                if (__builtin_amdgcn_s_memrealtime() - t0 > 2000000ull) {
                    if (lane == 0) { unsigned expect = 0u; __hip_atomic_compare_exchange_strong(tmo + 1, &expect, code | (unsigned)(u.pm & 0xff), __ATOMIC_RELAXED, __ATOMIC_RELAXED, __HIP_MEMORY_SCOPE_AGENT);
                                     __hip_atomic_store(tmo, 1u, __ATOMIC_RELAXED, __HIP_MEMORY_SCOPE_AGENT); }
                    dead = true; break; }
                __builtin_amdgcn_s_sleep(2);
            }
            __builtin_amdgcn_fence(__ATOMIC_ACQUIRE, "agent");
            if (lane == 0) flag[0] = dead ? 1u : 0u;
        }
        asm volatile("s_waitcnt vmcnt(0) lgkmcnt(0)" ::: "memory"); __builtin_amdgcn_s_barrier(); asm volatile("" ::: "memory");
        const bool bad = flag[0] != 0u;
        if (lane < 32) {
            const unsigned long long* slot = (const unsigned long long*)xbuf + (size_t)(u.pm * BM + row) * 4; float mt[4], m2[4]; float ms = 0.f;
#pragma unroll
            for (int t = 0; t < 4; ++t) { if (t < ntn) { const unsigned long long w = __hip_atomic_load(slot + t, __ATOMIC_RELAXED, __HIP_MEMORY_SCOPE_AGENT); mt[t] = __uint_as_float((unsigned)w); m2[t] = __uint_as_float((unsigned)(w >> 32)); } else { mt[t] = 0.f; m2[t] = 0.f; } ms += mt[t]; }
            const float mean = ms / (float)ntn; float q = 0.f;
#pragma unroll
            for (int t = 0; t < 4; ++t) if (t < ntn) { const float dm = mt[t] - mean; q += m2[t] + 256.0f * dm * dm; }
            S[row] = (f32x2v){mean, 1.0f / sqrtf(q / (256.0f * (float)ntn) + eps)};
        }
        asm volatile("s_waitcnt lgkmcnt(0)" ::: "memory"); __builtin_amdgcn_s_barrier(); asm volatile("" ::: "memory");
        return bad;
    }
};
struct EpiLnRes {
    static constexpr bool PERM = false, AFTER_DRAIN = true;
    const float* base; float* out; int ldc; const float* bias; PanelStats st; unsigned poison;
    __device__ __forceinline__ void refuse(size_t i0, size_t stride, int M, int N) const { const float q = __builtin_nanf(""); for (size_t i = i0; i < (size_t)M * N; i += stride) out[(i / N) * ldc + i % N] = q;
        if (i0 == 0) { unsigned expect = 0u; __hip_atomic_compare_exchange_strong(st.tmo + 1, &expect, 0x7f0u, __ATOMIC_RELAXED, __ATOMIC_RELAXED, __HIP_MEMORY_SCOPE_AGENT); __hip_atomic_store(st.tmo, 1u, __ATOMIC_RELAXED, __HIP_MEMORY_SCOPE_AGENT); } }
    __device__ __forceinline__ void fused(f32x4 (&acc)[2][2][4][2], const Unit& u, int wr, int wc, int fr, int fq, PG8_LAS unsigned char* lds, int wid, int lane) const {
        typedef float f32x2v __attribute__((ext_vector_type(2)));
        const PG8_LAS f32x2v* S = (const PG8_LAS f32x2v*)(lds + 8192);
        const int col0 = u.pn * BM + wc * 32 + 4 * fq;
#pragma unroll
        for (int bj = 0; bj < 2; ++bj)
#pragma unroll
            for (int n = 0; n < 2; ++n) { const f32x4 bv = bias ? *(const f32x4*)(bias + col0 + bj * HALF + n * 16) : (f32x4){0.f, 0.f, 0.f, 0.f};
#pragma unroll
                for (int ai = 0; ai < 2; ++ai)
#pragma unroll
                    for (int m = 0; m < 4; ++m) acc[ai][bj][m][n] += bv; }
        const bool bad = st.run(acc, u, wr, wc, fr, fq, lds, wid, lane) || poison != 0u;
        const float qnan = __builtin_nanf("");
#pragma unroll
        for (int ai = 0; ai < 2; ++ai)
#pragma unroll
            for (int m = 0; m < 4; ++m) { const int r = ai * HALF + wr * 64 + m * 16 + fr; const f32x2v sr = S[r]; const size_t off = (size_t)(u.pm * BM + r) * ldc + col0;
#pragma unroll
                for (int bj = 0; bj < 2; ++bj)
#pragma unroll
                    for (int n = 0; n < 2; ++n) { const f32x4 bs = *(const f32x4*)(base + off + bj * HALF + n * 16); f32x4 o = bs + (acc[ai][bj][m][n] - sr.x) * sr.y;
                        if (bad) o = (f32x4){qnan, qnan, qnan, qnan}; *(f32x4*)(out + off + bj * HALF + n * 16) = o; }
                asm volatile("" ::: "memory"); }
    }
};
struct EpiLnResLn {
    static constexpr bool PERM = false, AFTER_DRAIN = true;
    const float* base; float* out; bf16_t* xn; int ldc; const float* bias; PanelStats st1, st2; unsigned poison;
    __device__ __forceinline__ void refuse(size_t i0, size_t stride, int M, int N) const { const float q = __builtin_nanf(""); for (size_t i = i0; i < (size_t)M * N; i += stride) { const size_t o = (i / N) * ldc + i % N; out[o] = q; xn[o] = (bf16_t)0x7fc0u; }
        if (i0 == 0) { unsigned expect = 0u; __hip_atomic_compare_exchange_strong(st1.tmo + 1, &expect, 0x7f0u, __ATOMIC_RELAXED, __ATOMIC_RELAXED, __HIP_MEMORY_SCOPE_AGENT); __hip_atomic_store(st1.tmo, 1u, __ATOMIC_RELAXED, __HIP_MEMORY_SCOPE_AGENT); } }
    __device__ __forceinline__ void fused(f32x4 (&acc)[2][2][4][2], const Unit& u, int wr, int wc, int fr, int fq, PG8_LAS unsigned char* lds, int wid, int lane) const {
        typedef float f32x2v __attribute__((ext_vector_type(2))); typedef unsigned u32x2v __attribute__((ext_vector_type(2)));
        const PG8_LAS f32x2v* S = (const PG8_LAS f32x2v*)(lds + 8192);
        const int col0 = u.pn * BM + wc * 32 + 4 * fq;
#pragma unroll
        for (int bj = 0; bj < 2; ++bj)
#pragma unroll
            for (int n = 0; n < 2; ++n) { const f32x4 bv = bias ? *(const f32x4*)(bias + col0 + bj * HALF + n * 16) : (f32x4){0.f, 0.f, 0.f, 0.f};
#pragma unroll
                for (int ai = 0; ai < 2; ++ai)
#pragma unroll
                    for (int m = 0; m < 4; ++m) acc[ai][bj][m][n] += bv; }
        bool bad = st1.run(acc, u, wr, wc, fr, fq, lds, wid, lane) || poison != 0u;
        const float qnan = __builtin_nanf("");
#pragma unroll
        for (int ai = 0; ai < 2; ++ai)
#pragma unroll
            for (int m = 0; m < 4; ++m) { const int r = ai * HALF + wr * 64 + m * 16 + fr; const f32x2v sr = S[r]; const size_t off = (size_t)(u.pm * BM + r) * ldc + col0;
#pragma unroll
                for (int bj = 0; bj < 2; ++bj)
#pragma unroll
                    for (int n = 0; n < 2; ++n) { const f32x4 bs = *(const f32x4*)(base + off + bj * HALF + n * 16); acc[ai][bj][m][n] = bs + (acc[ai][bj][m][n] - sr.x) * sr.y; }
                asm volatile("" : "+v"(acc[ai][0][m][0]), "+v"(acc[ai][0][m][1]), "+v"(acc[ai][1][m][0]), "+v"(acc[ai][1][m][1]));
                if (m & 1) asm volatile("" ::: "memory"); }
        const bool bad1 = bad;
        bad = st2.run(acc, u, wr, wc, fr, fq, lds, wid, lane) || bad;
#pragma unroll
        for (int ai = 0; ai < 2; ++ai)
#pragma unroll
            for (int m = 0; m < 4; ++m) { const int r = ai * HALF + wr * 64 + m * 16 + fr; const f32x2v sr = S[r]; const size_t off = (size_t)(u.pm * BM + r) * ldc + col0;
#pragma unroll
                for (int bj = 0; bj < 2; ++bj)
#pragma unroll
                    for (int n = 0; n < 2; ++n) { const f32x4 x1 = acc[ai][bj][m][n]; *(f32x4*)(out + off + bj * HALF + n * 16) = bad1 ? (f32x4){qnan, qnan, qnan, qnan} : x1;
                        const f32x4 o = (x1 - sr.x) * sr.y; u32x2v w; w.x = cvt_pk_bf16(o[0], o[1]); w.y = cvt_pk_bf16(o[2], o[3]);
                        if (bad) { w.x = 0x7fc07fc0u; w.y = 0x7fc07fc0u; } *(u32x2v*)(xn + off + bj * HALF + n * 16) = w; }
                asm volatile("" ::: "memory"); }
    }
};

template <class Epi, class Sched, bool STAMP = false>
__device__ __forceinline__ void gemm_phase(PG8_LAS unsigned char* lds, const Gemm g, const Sched& S, const Epi& E, unsigned long long* stamps) {
    const int tid = threadIdx.x, wid = __builtin_amdgcn_readfirstlane(tid >> 6), lane = tid & 63, wr = wid >> 2, wc = wid & 3, fr = lane & 15, fq = lane >> 4;
    const int K = g.K, nt = K / BK;
    int ts_lo = 0, ts_hi = 0, nts = 0; const unsigned long long rt_entry = STAMP ? (unsigned long long)wall_clock64() : 0ull;
#define PG8_STAMP() do { if (STAMP && wid == 0 && nts < 64) { const unsigned long long _c = (unsigned long long)clock64(); \
        ts_lo = (lane == nts) ? (int)(unsigned)_c : ts_lo; ts_hi = (lane == nts) ? (int)(unsigned)(_c >> 32) : ts_hi; ++nts; } } while (0)
    PG8_STAMP();
    unsigned voffA[2], voffB[2];
#pragma unroll
    for (int i = 0; i < 2; ++i) { int R, C; stage_rc(tid * 16 + i * 8192, R, C); const int Rb = Epi::PERM ? ((R & ~31) + perm32(R & 31)) : R;
        voffA[i] = (unsigned)(R * K + C) * 2u; voffB[i] = (unsigned)(Rb * K + C) * 2u; }
    const size_t kstep = (size_t)(BK * 2);
    const size_t hstep = (size_t)HALF * K * 2;
    const size_t tstep = 2 * hstep;
    const unsigned ldsw = (unsigned)wid * 1024u;
    const int aoff = lds_byte(wr * 64 + fr, fq * 8), boff = lds_byte(wc * 32 + fr, fq * 8);
#define PG8_SA(b, h) (((b) * 2 + (h)) * HTB)
#define PG8_SB(b, h) ((4 + (b) * 2 + (h)) * HTB)
#define PG8_STAGE(bufoff, gbase, voff) do { _Pragma("unroll") for (int _i = 0; _i < 2; ++_i) \
        __builtin_amdgcn_global_load_lds((const unsigned*)((const char*)(gbase) + (voff)[_i]), (PG8_LAS unsigned*)(lds + (bufoff) + ldsw + _i * 8192), 16, 0, 0); } while (0)
#define PG8_LDA(dst, b, h) do { _Pragma("unroll") for (int m = 0; m < 4; ++m) _Pragma("unroll") for (int k = 0; k < 2; ++k) dst[m][k] = *(const PG8_LAS bf16x8*)(lds + PG8_SA(b, h) + aoff + m * 2048 + k * 1024); } while (0)
#define PG8_LDB(dst, b, h) do { _Pragma("unroll") for (int n = 0; n < 2; ++n) _Pragma("unroll") for (int k = 0; k < 2; ++k) dst[n][k] = *(const PG8_LAS bf16x8*)(lds + PG8_SB(b, h) + boff + n * 2048 + k * 1024); } while (0)
#define PG8_MMA(ai, bj, At, Bt) do { __builtin_amdgcn_s_setprio(1); _Pragma("unroll") for (int m = 0; m < 4; ++m) _Pragma("unroll") for (int n = 0; n < 2; ++n) _Pragma("unroll") for (int k = 0; k < 2; ++k) \
        acc[ai][bj][m][n] = __builtin_amdgcn_mfma_f32_16x16x32_bf16(Bt[n][k], At[m][k], acc[ai][bj][m][n], 0, 0, 0); __builtin_amdgcn_s_setprio(0); } while (0)
#define PG8_WAIT_V(n) asm volatile("s_waitcnt vmcnt(" #n ")" ::: "memory")
#define PG8_WAIT_L(n) asm volatile("s_waitcnt lgkmcnt(" #n ")" ::: "memory")
#define PG8_BAR __builtin_amdgcn_s_barrier()
#define PG8_SCHED __builtin_amdgcn_sched_barrier(0)
    Unit cur, nxt; int ui = 0;
    if (!S.next(0, cur)) return;
    f32x4 acc[2][2][4][2];
#pragma unroll
    for (int a = 0; a < 2; ++a)
#pragma unroll
        for (int b = 0; b < 2; ++b)
#pragma unroll
            for (int m = 0; m < 4; ++m)
#pragma unroll
                for (int n = 0; n < 2; ++n) acc[a][b][m][n] = (f32x4){0.f, 0.f, 0.f, 0.f};
    bf16x8 At[4][2], B0[2][2], B1[2][2];
    const char* cA = (const char*)g.A + (size_t)cur.pm * tstep; const char* cB = (const char*)g.Bt + (size_t)cur.pn * tstep;
    S.a_ready(cur);
    PG8_STAGE(PG8_SB(0, 0), cB, voffB); PG8_STAGE(PG8_SA(0, 0), cA, voffA); PG8_STAGE(PG8_SB(0, 1), cB + hstep, voffB); PG8_STAGE(PG8_SA(0, 1), cA + hstep, voffA);
    if (wr == 1) PG8_BAR;
    PG8_WAIT_V(4); PG8_BAR;
    PG8_STAGE(PG8_SB(1, 0), cB + kstep, voffB); PG8_STAGE(PG8_SA(1, 0), cA + kstep, voffA); PG8_STAGE(PG8_SB(1, 1), cB + hstep + kstep, voffB);
    PG8_WAIT_V(6); PG8_BAR;
    PG8_STAMP();
    for (;;) {
        const bool has_next = S.next(ui + 1, nxt);
        const char* nA = has_next ? (const char*)g.A + (size_t)nxt.pm * tstep : cA; const char* nB = has_next ? (const char*)g.Bt + (size_t)nxt.pn * tstep : cB;
        for (int t = 0; t < nt; t += 2) {
            const bool last = (t == nt - 2);
            const char* a1 = cA + (size_t)(t + 1) * kstep;
            const char* a2 = last ? nA : cA + (size_t)(t + 2) * kstep; const char* b2 = last ? nB : cB + (size_t)(t + 2) * kstep;
            const char* a3 = a2 + kstep; const char* b3 = b2 + kstep;
            if (last && has_next) S.a_ready(nxt);
            PG8_LDB(B0, 0, 0); PG8_SCHED; PG8_LDA(At, 0, 0); PG8_STAGE(PG8_SA(1, 1), a1 + hstep, voffA);
            PG8_WAIT_L(8); PG8_BAR; PG8_WAIT_L(0); PG8_MMA(0, 0, At, B0); PG8_BAR; PG8_SCHED;
            PG8_LDB(B1, 0, 1); PG8_STAGE(PG8_SB(0, 0), b2, voffB);
            PG8_BAR; PG8_WAIT_L(0); PG8_MMA(0, 1, At, B1); PG8_BAR;
            PG8_LDA(At, 0, 1); PG8_STAGE(PG8_SA(0, 0), a2, voffA);
            PG8_BAR; PG8_WAIT_L(0); PG8_MMA(1, 0, At, B0); PG8_BAR; PG8_SCHED;
            PG8_STAGE(PG8_SB(0, 1), b2 + hstep, voffB);
            PG8_WAIT_V(6); PG8_BAR; PG8_MMA(1, 1, At, B1); PG8_BAR;
            PG8_LDB(B0, 1, 0); PG8_SCHED; PG8_LDA(At, 1, 0); PG8_STAGE(PG8_SA(0, 1), a2 + hstep, voffA);
            PG8_WAIT_L(8); PG8_BAR; PG8_WAIT_L(0); PG8_MMA(0, 0, At, B0); PG8_BAR; PG8_SCHED;
            PG8_LDB(B1, 1, 1); PG8_STAGE(PG8_SB(1, 0), b3, voffB);
            PG8_BAR; PG8_WAIT_L(0); PG8_MMA(0, 1, At, B1); PG8_BAR;
            PG8_LDA(At, 1, 1); PG8_STAGE(PG8_SA(1, 0), a3, voffA);
            PG8_BAR; PG8_WAIT_L(0); PG8_MMA(1, 0, At, B0); PG8_BAR; PG8_SCHED;
            PG8_STAGE(PG8_SB(1, 1), b3 + hstep, voffB);
            PG8_WAIT_V(6); PG8_BAR; PG8_MMA(1, 1, At, B1); PG8_BAR;
        }
        PG8_STAMP();
        if constexpr (!Epi::AFTER_DRAIN) { E(acc, cur, wr, wc, fr, fq); S.done(cur); }
        PG8_STAMP();
        if (!has_next) break;
#pragma unroll
        for (int a = 0; a < 2; ++a)
#pragma unroll
            for (int b = 0; b < 2; ++b)
#pragma unroll
                for (int m = 0; m < 4; ++m)
#pragma unroll
                    for (int n = 0; n < 2; ++n) acc[a][b][m][n] = (f32x4){0.f, 0.f, 0.f, 0.f};
        cur = nxt; cA = nA; cB = nB; ++ui;
    }
    PG8_WAIT_V(0);
    if (wr == 0) PG8_BAR;
    PG8_BAR;
    if constexpr (Epi::AFTER_DRAIN) { E.fused(acc, cur, wr, wc, fr, fq, lds, wid, lane); S.done(cur); }
    PG8_STAMP();
    if (STAMP && wid == 0) { stamps[lane] = lane < nts ? (((unsigned long long)(unsigned)ts_hi << 32) | (unsigned)ts_lo) : 0ull;
        if (lane == 62) stamps[62] = rt_entry; if (lane == 63) stamps[63] = (unsigned long long)wall_clock64(); }
#undef PG8_STAMP
#undef PG8_SA
#undef PG8_SB
#undef PG8_STAGE
#undef PG8_LDA
#undef PG8_LDB
#undef PG8_MMA
#undef PG8_WAIT_V
#undef PG8_WAIT_L
#undef PG8_BAR
#undef PG8_SCHED
}
}

#define LAS __attribute__((address_space(3)))
#define XB_TMO      128
#define XB_XCNT(j)  (256  + 64 * (j))
#define XB_XSUB(j)  (1280 + 64 * (j))
#define XB_XGEN(j)  (2304 + 64 * (j))
#define XB_TOP      3328
#define XB_TOPGEN   3392
#define XCD_BAR_WORDS 3456
#define XB_SPIN_CAP (1u << 24)

__device__ __forceinline__ unsigned xb_ld(unsigned* p)              { return __hip_atomic_load(p, __ATOMIC_RELAXED, __HIP_MEMORY_SCOPE_AGENT); }
__device__ __forceinline__ unsigned xb_add(unsigned* p, unsigned v) { return __hip_atomic_fetch_add(p, v, __ATOMIC_RELAXED, __HIP_MEMORY_SCOPE_AGENT); }
__device__ __forceinline__ unsigned xb_xcc_id() { return (unsigned)__builtin_amdgcn_s_getreg((3 << 11) | 20) & 0xFu; }
#define XB_SPIN(cond, bar) do { unsigned _sp = 0; while (cond) { __builtin_amdgcn_s_sleep(1); \
    if ((++_sp & 255u) == 0u) { if (xb_ld(&(bar)[XB_TMO])) break; if (_sp > XB_SPIN_CAP) { atomicAdd(&(bar)[XB_TMO], 1u); break; } } } } while (0)

struct XcdBarrier { unsigned* bar; unsigned x; volatile LAS unsigned* st; };

__device__ __forceinline__ XcdBarrier xcd_barrier_post(unsigned* bar, volatile LAS unsigned* st) {
    XcdBarrier b; b.bar = bar; b.x = xb_xcc_id(); b.st = st;
    if (threadIdx.x == 0) (void)xb_add(&bar[XB_XCNT(b.x)], 1u);
    return b;
}
__device__ __forceinline__ void xcd_barrier_complete(unsigned* bar, unsigned x, unsigned& nloc, unsigned& nx) {
    const unsigned G = gridDim.x * gridDim.y * gridDim.z;
    unsigned sum, cnt, mine, sp = 0u;
    for (;;) {
        sum = 0u; cnt = 0u; mine = 0u;
#pragma unroll
        for (unsigned j = 0; j < 16; ++j) { const unsigned c = xb_ld(&bar[XB_XCNT(j)]); sum += c; cnt += (c > 0u) ? 1u : 0u; mine = (j == x) ? c : mine; }
        if (sum == G) break;
        __builtin_amdgcn_s_sleep(1);
        if ((++sp & 255u) == 0u) { if (xb_ld(&bar[XB_TMO])) break; if (sp > XB_SPIN_CAP) { atomicAdd(&bar[XB_TMO], 1u); break; } }
    }
    nloc = mine > 0u ? mine : 1u; nx = cnt > 0u ? cnt : 1u;
}
__device__ __forceinline__ void xcd_barrier(const XcdBarrier& b) {
    asm volatile("s_waitcnt vmcnt(0)" ::: "memory");
    __syncthreads();
    if (threadIdx.x == 0) {
        unsigned* bar = b.bar;
        __builtin_amdgcn_s_waitcnt(0);
        unsigned nloc = b.st[0], nx = b.st[1];
        if (nloc == 0u) { xcd_barrier_complete(bar, b.x, nloc, nx); b.st[0] = nloc; b.st[1] = nx; }
        const unsigned old = xb_add(&bar[XB_XSUB(b.x)], 1u);
        const unsigned gen = old / nloc;
        if (old + 1u == (gen + 1u) * nloc) {
            __builtin_amdgcn_fence(__ATOMIC_RELEASE, "agent");
            asm volatile("s_waitcnt vmcnt(0)" ::: "memory");
            const unsigned og = xb_add(&bar[XB_TOP], 1u);
            const unsigned tg = og / nx;
            if (og + 1u == (tg + 1u) * nx) xb_add(&bar[XB_TOPGEN], 1u);
            else XB_SPIN(xb_ld(&bar[XB_TOPGEN]) == tg, bar);
            __builtin_amdgcn_fence(__ATOMIC_ACQUIRE, "agent");
            xb_add(&bar[XB_XGEN(b.x)], 1u);
            asm volatile("s_waitcnt vmcnt(0)" ::: "memory");
        } else {
            XB_SPIN(xb_ld(&bar[XB_XGEN(b.x)]) == gen, bar);
            __builtin_amdgcn_fence(__ATOMIC_ACQUIRE, "agent");
            asm volatile("s_waitcnt vmcnt(0)" ::: "memory");
        }
    }
    __syncthreads();
}

typedef unsigned short bf16;
typedef float f32x4 __attribute__((ext_vector_type(4)));
typedef float f32x16 __attribute__((ext_vector_type(16)));
typedef float f32x2 __attribute__((ext_vector_type(2)));
typedef unsigned u32x4 __attribute__((ext_vector_type(4)));
typedef unsigned u32x2 __attribute__((ext_vector_type(2)));
typedef short bf16x8 __attribute__((ext_vector_type(8)));
typedef __bf16 bf2_t __attribute__((ext_vector_type(2)));

constexpr int NTHREADS = 512, NWAVES = 8;
constexpr int LDS_BYTES = 160 * 1024;
constexpr int MISC_OFF = LDS_BYTES - 256;
constexpr int TOK = 32768, SEQ = 16384, DM = 2048;
constexpr int EV_N = 4800, EV_NP = 4864, OD_N = 4176, OD_NP = 4352;
constexpr float ALPHA = 1.41421356237f;
constexpr size_t MiB = 1u << 20;
constexpr size_t WS_CTL = 0, CTL_ZERO_BYTES = 1 * MiB;
constexpr int CW_BAR = 4096, CW_XRANK = 8192;
constexpr size_t WS_MOD = 1 * MiB, WS_SKB = 2 * MiB, WS_WL = 4 * MiB, WS_BS = 7 * MiB, WS_CNT = 9 * MiB;
constexpr size_t WS_WINE = 10 * MiB, WS_WOUTE = 29 * MiB, WS_WINO = 37 * MiB, WS_WOUTO = 54 * MiB, WS_WQ0 = 62 * MiB, WS_WQ1 = 70 * MiB;
constexpr size_t WS_HY = 78 * MiB, WS_Z = 206 * MiB, WS_LA = 510 * MiB, WS_BIG = 542 * MiB, WS_END = 1022 * MiB;

__device__ __forceinline__ float bf2f(unsigned short b) { return __uint_as_float(((unsigned)b) << 16); }
__device__ __forceinline__ unsigned pk2(float lo, float hi) { const bf2_t v = {(__bf16)lo, (__bf16)hi}; return __builtin_bit_cast(unsigned, v); }
__device__ __forceinline__ unsigned f2bf(float f) { return pk2(f, 0.f) & 0xffffu; }
__device__ __forceinline__ float lo2f(unsigned w) { return __uint_as_float(w << 16); }
__device__ __forceinline__ float hi2f(unsigned w) { return __uint_as_float(w & 0xffff0000u); }
template <int CTRL, int RM> __device__ __forceinline__ float dppo(float v) { return __int_as_float(__builtin_amdgcn_update_dpp(__float_as_int(v), __float_as_int(v), CTRL, RM, 0xF, false)); }
__device__ __forceinline__ float wsum(float v) {
    v += __int_as_float(__builtin_amdgcn_update_dpp(0, __float_as_int(v), 0xB1, 0xF, 0xF, false)); v += __int_as_float(__builtin_amdgcn_update_dpp(0, __float_as_int(v), 0x4E, 0xF, 0xF, false));
    v += __int_as_float(__builtin_amdgcn_update_dpp(0, __float_as_int(v), 0x141, 0xF, 0xF, false)); v += __int_as_float(__builtin_amdgcn_update_dpp(0, __float_as_int(v), 0x140, 0xF, 0xF, false));
    v += __int_as_float(__builtin_amdgcn_update_dpp(0, __float_as_int(v), 0x142, 0xA, 0xF, false)); v += __int_as_float(__builtin_amdgcn_update_dpp(0, __float_as_int(v), 0x143, 0xC, 0xF, false));
    return __int_as_float(__builtin_amdgcn_readlane(__float_as_int(v), 63));
}
__device__ __forceinline__ float wmax(float v) {
    v = fmaxf(v, dppo<0xB1, 0xF>(v)); v = fmaxf(v, dppo<0x4E, 0xF>(v)); v = fmaxf(v, dppo<0x141, 0xF>(v)); v = fmaxf(v, dppo<0x140, 0xF>(v));
    v = fmaxf(v, dppo<0x142, 0xA>(v)); v = fmaxf(v, dppo<0x143, 0xC>(v));
    return __int_as_float(__builtin_amdgcn_readlane(__float_as_int(v), 63));
}
__device__ __forceinline__ float xsum32(float x) { const auto r = __builtin_amdgcn_permlane32_swap(__float_as_uint(x), __float_as_uint(x), false, false); return __uint_as_float(r[0]) + __uint_as_float(r[1]); }
__device__ __forceinline__ float xsum16(float x) { const auto r = __builtin_amdgcn_permlane16_swap(__float_as_uint(x), __float_as_uint(x), false, false); return __uint_as_float(r[0]) + __uint_as_float(r[1]); }
__device__ __forceinline__ float xmax32(float x) { const auto r = __builtin_amdgcn_permlane32_swap(__float_as_uint(x), __float_as_uint(x), false, false); return fmaxf(__uint_as_float(r[0]), __uint_as_float(r[1])); }
__device__ __forceinline__ float xmax16(float x) { const auto r = __builtin_amdgcn_permlane16_swap(__float_as_uint(x), __float_as_uint(x), false, false); return fmaxf(__uint_as_float(r[0]), __uint_as_float(r[1])); }
__device__ __forceinline__ float rsum4(float v0, float v1, float v2, float v3) {
    const auto p = __builtin_amdgcn_permlane32_swap(__float_as_uint(v0), __float_as_uint(v2), false, false);
    const auto q = __builtin_amdgcn_permlane32_swap(__float_as_uint(v1), __float_as_uint(v3), false, false);
    const float P = __uint_as_float(p[0]) + __uint_as_float(p[1]);
    const float Q = __uint_as_float(q[0]) + __uint_as_float(q[1]);
    const auto t = __builtin_amdgcn_permlane16_swap(__float_as_uint(P), __float_as_uint(Q), false, false);
    return __uint_as_float(t[0]) + __uint_as_float(t[1]);
}
__device__ __forceinline__ float rdlane(float v, int l) { return __int_as_float(__builtin_amdgcn_readlane(__float_as_int(v), l)); }
__device__ __forceinline__ unsigned rdlaneu(unsigned v, int l) { return (unsigned)__builtin_amdgcn_readlane((int)v, l); }
__device__ __forceinline__ float dot2bf(unsigned a, unsigned b, float c) {
    return __builtin_amdgcn_fdot2_f32_bf16(__builtin_bit_cast(bf2_t, a), __builtin_bit_cast(bf2_t, b), c, false);
}
template <int CTRL, int RM> __device__ __forceinline__ float dppf(float v) {
    return __int_as_float(__builtin_amdgcn_update_dpp(0, __float_as_int(v), CTRL, RM, 0xF, false));
}
__device__ __forceinline__ float wsum_dpp(float v) {
    v += dppf<0xB1, 0xF>(v);
    v += dppf<0x4E, 0xF>(v);
    v += dppf<0x141, 0xF>(v);
    v += dppf<0x140, 0xF>(v);
    v += dppf<0x142, 0xA>(v);
    v += dppf<0x143, 0xC>(v);
    return rdlane(v, 63);
}
__device__ __forceinline__ float sum16_dpp(float v) {
    v += dppf<0xB1, 0xF>(v); v += dppf<0x4E, 0xF>(v); v += dppf<0x141, 0xF>(v); v += dppf<0x140, 0xF>(v);
    return v;
}
__device__ __forceinline__ float sigmoidf_(float x) { return 1.0f / (1.0f + expf(-x)); }
__device__ __forceinline__ unsigned ordkey(float f) { const unsigned u = __float_as_uint(f); return (u & 0x80000000u) ? ~u : (u | 0x80000000u); }
__device__ __forceinline__ unsigned fixkey20(float f) { const float c = fminf(fmaxf(f, -15.999f), 15.999f); return (unsigned)((int)rintf(c * 32768.0f) + (1 << 19)); }
__device__ __forceinline__ float unordkey(unsigned k) { return __uint_as_float((k & 0x80000000u) ? (k & 0x7fffffffu) : ~k); }

struct Args { const void* in[27]; float* out; unsigned char* ws; int ph_lo, ph_hi; };
struct Frame { LAS unsigned char* lds; int tid, lane, wave, bx, G, gw, ngw; };

struct EpiLora {
    static constexpr bool PERM = true, AFTER_DRAIN = false;
    pg8::bf16_t* O; int ldc; const float* w0; const float* a0;
    __device__ __forceinline__ void operator()(const pg8::f32x4 (&acc)[2][2][4][2], const pg8::Unit& u, int wr, int wc, int fr, int fq) const {
        const int row0 = u.pm * 256 + wr * 64 + fr; const int colt = u.pn * 256; const int type = u.pn >> 2;
        const int col0 = colt + wc * 32 + 8 * fq, ncol0 = col0 & 1023;
        const float* pv = (type == 0) ? w0 : a0;
        pg8::f32x4 bv[2][2];
#pragma unroll
        for (int bj = 0; bj < 2; ++bj)
#pragma unroll
            for (int n = 0; n < 2; ++n) bv[bj][n] = (type < 2) ? *(const pg8::f32x4*)(pv + ncol0 + bj * 128 + 4 * n) : (pg8::f32x4){0.f, 0.f, 0.f, 0.f};
#pragma unroll
        for (int ai = 0; ai < 2; ++ai)
#pragma unroll
            for (int m = 0; m < 4; ++m) { pg8::bf16_t* rowp = O + (size_t)(row0 + ai * 128 + m * 16) * ldc + col0;
#pragma unroll
                for (int bj = 0; bj < 2; ++bj) { pg8::f32x4 v0 = acc[ai][bj][m][0] + bv[bj][0], v1 = acc[ai][bj][m][1] + bv[bj][1];
                    if (type < 2) {
                        const float sc = (type == 0) ? 0.60653066f : 1.0f;
#pragma unroll
                        for (int j = 0; j < 4; ++j) { v0[j] = sc / (1.0f + __expf(-v0[j])); v1[j] = sc / (1.0f + __expf(-v1[j])); }
                    }
                    pg8::u32x4 w; w.x = pg8::cvt_pk_bf16(v0[0], v0[1]); w.y = pg8::cvt_pk_bf16(v0[2], v0[3]); w.z = pg8::cvt_pk_bf16(v1[0], v1[1]); w.w = pg8::cvt_pk_bf16(v1[2], v1[3]);
                    *(pg8::u32x4*)(rowp + bj * 128) = w; } }
    }
};

__device__ __forceinline__ void transpose_item(const float* W, int K, int N, int Npad, bf16* WT, LAS float* scr, int item, int lane) {
    const int nblk = Npad / 32, kb = item / nblk, nb = item % nblk, k0 = 64 * kb, n0 = 32 * nb;
    const int nl = lane & 31; const bool ok = (n0 + nl) < N;
#pragma unroll 8
    for (int i = 0; i < 32; ++i) { const int kk = 2 * i + (lane >> 5); scr[kk * 33 + nl] = ok ? W[(size_t)(k0 + kk) * N + n0 + nl] : 0.f; }
    asm volatile("s_waitcnt lgkmcnt(0)" ::: "memory");
    const int c = lane & 7;
#pragma unroll
    for (int j = 0; j < 4; ++j) { const int n = (lane >> 3) + 8 * j; const LAS float* s = scr + (8 * c) * 33 + n;
        u32x4 o; o.x = pk2(s[0 * 33], s[1 * 33]); o.y = pk2(s[2 * 33], s[3 * 33]); o.z = pk2(s[4 * 33], s[5 * 33]); o.w = pk2(s[6 * 33], s[7 * 33]);
        *(u32x4*)(WT + (size_t)(n0 + n) * K + k0 + 8 * c) = o; }
    asm volatile("s_waitcnt lgkmcnt(0)" ::: "memory");
}

__device__ __forceinline__ void ph_prologue(const Args& A, Frame& F) {
    unsigned char* ws = A.ws;
    {
        const float* c = (const float*)A.in[1]; const float* mw = (const float*)A.in[19]; const float* mb = (const float*)A.in[20];
        float* MOD = (float*)(ws + WS_MOD);
        LAS float* red = (LAS float*)F.lds;
        for (int it = F.bx; it < 96; it += F.G) {
            const int s = it / 24, cc = it % 24, col = cc * 256 + F.lane * 4;
            const float* W = mw + (size_t)s * 2048 * 6144 + col;
            f32x4 a0 = {0.f, 0.f, 0.f, 0.f}, a1 = {0.f, 0.f, 0.f, 0.f};
            const int k0 = F.wave * 256;
#pragma unroll 8
            for (int k = k0; k < k0 + 256; ++k) {
                float c0 = c[k], c1 = c[2048 + k];
                c0 = c0 / (1.0f + expf(-c0)); c1 = c1 / (1.0f + expf(-c1));
                const f32x4 w = *(const f32x4*)(W + (size_t)k * 6144);
                a0 += c0 * w; a1 += c1 * w;
            }
            *(LAS f32x4*)(red + ((F.wave * 2 + 0) * 256 + F.lane * 4)) = a0;
            *(LAS f32x4*)(red + ((F.wave * 2 + 1) * 256 + F.lane * 4)) = a1;
            __syncthreads();
            { const int b = F.tid >> 8, cl = F.tid & 255; float sm = 0.f;
#pragma unroll
              for (int w = 0; w < 8; ++w) sm += red[(w * 2 + b) * 256 + cl];
              MOD[(size_t)(s * 2 + b) * 6144 + cc * 256 + cl] = sm + mb[s * 6144 + cc * 256 + cl]; }
            __syncthreads();
        }
    }
    {
        LAS float* scr = (LAS float*)(F.lds + 16384 + F.wave * 8704);
        constexpr int I0 = 32 * (EV_NP / 32), I1 = 32 * 64, I2 = 32 * (OD_NP / 32);
        constexpr int NIT = I0 + I1 + I2 + 3 * I1;
        for (int it = F.gw; it < NIT; it += F.ngw) {
            int r = it;
            if (r < I0) { transpose_item((const float*)A.in[3], 2048, EV_N, EV_NP, (bf16*)(ws + WS_WINE), scr, r, F.lane); continue; } r -= I0;
            if (r < I1) { transpose_item((const float*)A.in[4], 2048, 2048, 2048, (bf16*)(ws + WS_WOUTE), scr, r, F.lane); continue; } r -= I1;
            if (r < I2) { transpose_item((const float*)A.in[17], 2048, OD_N, OD_NP, (bf16*)(ws + WS_WINO), scr, r, F.lane); continue; } r -= I2;
            if (r < I1) { transpose_item((const float*)A.in[18], 2048, 2048, 2048, (bf16*)(ws + WS_WOUTO), scr, r, F.lane); continue; } r -= I1;
            if (r < I1) { transpose_item((const float*)A.in[23], 2048, 2048, 2048, (bf16*)(ws + WS_WQ0), scr, r, F.lane); continue; } r -= I1;
            transpose_item((const float*)A.in[23] + (size_t)2048 * 2048, 2048, 2048, 2048, (bf16*)(ws + WS_WQ1), scr, r, F.lane);
        }
    }
    {
        const float* w2 = (const float*)A.in[8]; const float* a2 = (const float*)A.in[10]; const float* g2 = (const float*)A.in[11];
        bf16* WL = (bf16*)(ws + WS_WL);
        const int gt = F.bx * NTHREADS + F.tid, ngt = F.G * NTHREADS;
        for (int i = gt; i < 3072 * 512; i += ngt) {
            const int n = i >> 9, k = i & 511; float v = 0.f;
            if (n < 1024) { if (k < 96) v = w2[k * 1024 + n]; }
            else if (n < 2048) { if (k >= 96 && k < 192) v = a2[(k - 96) * 1024 + (n - 1024)]; }
            else { if (k >= 192 && k < 448) v = g2[(k - 192) * 1024 + (n - 2048)]; }
            WL[i] = (bf16)f2bf(v);
        }
        const float* sk = (const float*)A.in[24]; bf16* SKB = (bf16*)(ws + WS_SKB);
        for (int i = gt; i < 2 * 262144; i += ngt) SKB[i] = (bf16)f2bf(sk[i]);
    }
}

__device__ __forceinline__ void ph_mod_x(const Args& A, Frame& F) {
    const float* x = (const float*)A.in[0]; const float* MOD = (const float*)(A.ws + WS_MOD); bf16* H = (bf16*)(A.ws + WS_HY);
    for (int t = F.gw; t < TOK; t += F.ngw) {
        const int b = t >> 14; const float* sh = MOD + (size_t)(0 * 2 + b) * 6144; const float* sc = sh + 2048;
#pragma unroll
        for (int j = 0; j < 8; ++j) { const int idx = j * 256 + F.lane * 4;
            const f32x4 xv = *(const f32x4*)(x + (size_t)t * DM + idx), sv = *(const f32x4*)(sc + idx), hv = *(const f32x4*)(sh + idx);
            const f32x4 o = xv * (1.0f + sv) + hv; u32x2 w; w.x = pk2(o[0], o[1]); w.y = pk2(o[2], o[3]);
            *(u32x2*)(H + (size_t)t * DM + idx) = w; }
    }
}

__device__ __forceinline__ void ph_even_post(const Args& A, Frame& F) {
    bf16* Z = (bf16*)(A.ws + WS_Z); const int* positions = (const int*)A.in[2]; const float* mu = (const float*)A.in[6];
    bf16* RKV = (bf16*)A.out; bf16* LAp = (bf16*)(A.ws + WS_LA);
    const int i = F.lane & 31; const float inv = powf(10000.0f, -(float)i / 32.0f);
    const int i4 = F.lane & 7, hs = F.lane >> 3;
    for (int t = F.gw; t < TOK; t += F.ngw) {
        const int s = t & (SEQ - 1); bf16* zr = Z + (size_t)t * EV_NP;
        float sn, cs; sincosf((float)positions[t] * inv, &sn, &cs);
        float c4[4], s4[4];
#pragma unroll
        for (int e = 0; e < 4; ++e) { c4[e] = __shfl(cs, 4 * i4 + e); s4[e] = __shfl(sn, 4 * i4 + e); }
#pragma unroll
        for (int it = 0; it < 3; ++it) { const int hd = it * 8 + hs; if (hd < 18) { bf16* hp = zr + hd * 64 + 4 * i4;
            const u32x2 a = *(const u32x2*)hp, b = *(const u32x2*)(hp + 32);
            const float t1[4] = {lo2f(a.x), hi2f(a.x), lo2f(a.y), hi2f(a.y)}, t2[4] = {lo2f(b.x), hi2f(b.x), lo2f(b.y), hi2f(b.y)};
            float o1[4], o2[4];
#pragma unroll
            for (int e = 0; e < 4; ++e) { o1[e] = t1[e] * c4[e] - t2[e] * s4[e]; o2[e] = t2[e] * c4[e] + t1[e] * s4[e]; }
            *(u32x2*)hp = (u32x2){pk2(o1[0], o1[1]), pk2(o1[2], o1[3])}; *(u32x2*)(hp + 32) = (u32x2){pk2(o2[0], o2[1]), pk2(o2[2], o2[3])}; } }
        const bf16* zp = zr - EV_NP; const bool hasprev = s > 0;
#pragma unroll
        for (int m = 0; m < 7; ++m) { const int j = 8 * (F.lane + 64 * m); if (j < 3520) {
            const u32x4 cw = *(const u32x4*)(zr + 1280 + j); u32x4 pw = {0u, 0u, 0u, 0u}; if (hasprev) pw = *(const u32x4*)(zp + 1280 + j);
            const f32x4 m0 = *(const f32x4*)(mu + j), m1 = *(const f32x4*)(mu + j + 4);
            const unsigned cwa[4] = {cw.x, cw.y, cw.z, cw.w}, pwa[4] = {pw.x, pw.y, pw.z, pw.w}; const float mm[8] = {m0[0], m0[1], m0[2], m0[3], m1[0], m1[1], m1[2], m1[3]};
            float v[8];
#pragma unroll
            for (int q = 0; q < 4; ++q) { const float c0 = lo2f(cwa[q]), c1 = hi2f(cwa[q]), p0 = lo2f(pwa[q]), p1 = hi2f(pwa[q]); v[2 * q] = c0 + (p0 - c0) * mm[2 * q]; v[2 * q + 1] = c1 + (p1 - c1) * mm[2 * q + 1]; }
            bf16* dst;
            if (j < 3072) { dst = RKV + (size_t)(j >> 10) * TOK * 1024 + (size_t)t * 1024 + (j & 1023); }
            else if (j < 3168) { dst = LAp + (size_t)t * 512 + (j - 3072);
#pragma unroll
                for (int e = 0; e < 8; ++e) v[e] = tanhf(v[e]); }
            else if (j < 3264) { dst = LAp + (size_t)t * 512 + 96 + (j - 3168); }
            else { dst = LAp + (size_t)t * 512 + 192 + (j - 3264);
#pragma unroll
                for (int e = 0; e < 8; ++e) v[e] = sigmoidf_(v[e]); }
            *(u32x4*)dst = (u32x4){pk2(v[0], v[1]), pk2(v[2], v[3]), pk2(v[4], v[5]), pk2(v[6], v[7])};
        } }
        if (F.lane < 8) *(u32x4*)(LAp + (size_t)t * 512 + 448 + 8 * F.lane) = (u32x4){0u, 0u, 0u, 0u};
    }
}

__device__ __forceinline__ void ph_scan_pack(const Args& A, Frame& F) {
    const bf16* Z = (const bf16*)(A.ws + WS_Z); const bf16* RKV = (const bf16*)A.out;
    const float* k_k = (const float*)A.in[12]; const float* k_a = (const float*)A.in[13]; const float* r_k = (const float*)A.in[14];
    unsigned* PK = (unsigned*)(A.ws + WS_BIG); float* BS = (float*)(A.ws + WS_BS);
    const int g16 = F.lane >> 4, c16 = F.lane & 15;
    for (int it = F.gw; it < TOK * 4; it += F.ngw) {
        const int item = it * 4 + g16; const int t = item >> 4, h = item & 15, c = h * 64 + 4 * c16, b = t >> 14, s = t & (SEQ - 1);
        const u32x2 rw = *(const u32x2*)(RKV + (size_t)t * 1024 + c), kw = *(const u32x2*)(RKV + (size_t)TOK * 1024 + (size_t)t * 1024 + c), vw = *(const u32x2*)(RKV + (size_t)2 * TOK * 1024 + (size_t)t * 1024 + c);
        const u32x2 ew = *(const u32x2*)(Z + (size_t)t * EV_NP + 1280 + c), aw = *(const u32x2*)(Z + (size_t)t * EV_NP + 1280 + 1024 + c);
        const f32x4 kk4 = *(const f32x4*)(k_k + c), ka4 = *(const f32x4*)(k_a + c), rk4 = *(const f32x4*)(r_k + c);
        const float r[4] = {lo2f(rw.x), hi2f(rw.x), lo2f(rw.y), hi2f(rw.y)}, kr[4] = {lo2f(kw.x), hi2f(kw.x), lo2f(kw.y), hi2f(kw.y)}, v[4] = {lo2f(vw.x), hi2f(vw.x), lo2f(vw.y), hi2f(vw.y)};
        const float e[4] = {lo2f(ew.x), hi2f(ew.x), lo2f(ew.y), hi2f(ew.y)}, a[4] = {lo2f(aw.x), hi2f(aw.x), lo2f(aw.y), hi2f(aw.y)};
        float kkv[4], kp[4]; float ss = 0.f, bsum = 0.f;
#pragma unroll
        for (int q = 0; q < 4; ++q) { kkv[q] = kr[q] * kk4[q]; ss += kkv[q] * kkv[q]; kp[q] = kr[q] * (1.0f + (a[q] - 1.0f) * ka4[q]); bsum += r[q] * kp[q] * rk4[q]; }
        ss = sum16_dpp(ss); bsum = sum16_dpp(bsum);
        const float rn = 1.0f / fmaxf(sqrtf(ss), 1e-12f);
        if (c16 == 0) BS[(size_t)t * 16 + h] = bsum;
        unsigned w[12];
#pragma unroll
        for (int q = 0; q < 4; ++q) { const float kkn = kkv[q] * rn; w[3 * q] = pk2(r[q], e[q]); w[3 * q + 1] = pk2(kp[q], kkn); w[3 * q + 2] = pk2(kkn * a[q], v[q]); }
        u32x4* dst = (u32x4*)(PK + ((size_t)((b * 16 + h) * SEQ + s) * 64 + 4 * c16) * 3);
        dst[0] = (u32x4){w[0], w[1], w[2], w[3]}; dst[1] = (u32x4){w[4], w[5], w[6], w[7]}; dst[2] = (u32x4){w[8], w[9], w[10], w[11]};
    }
}

__device__ __forceinline__ void ph_swa(const Args& A, Frame& F) {
    const bf16* Z = (const bf16*)(A.ws + WS_Z); bf16* Y = (bf16*)(A.ws + WS_HY); const float* sinks = (const float*)A.in[5];
    LAS unsigned char* KL = F.lds; LAS unsigned char* VL = F.lds + 256 * 136;
    for (int u = F.bx; u < 512; u += F.G) {
        const int b = u >> 8, n = (u >> 1) & 127, kvh = u & 1;
        __syncthreads();
        for (int c = F.tid; c < 2048; c += NTHREADS) { const int jw = c >> 3, cc = c & 7; const int s = n * 128 - 128 + jw;
            u32x4 kv = {0u, 0u, 0u, 0u}, vv = {0u, 0u, 0u, 0u};
            if (s >= 0) { const bf16* row = Z + (size_t)(b * SEQ + s) * EV_NP; kv = *(const u32x4*)(row + 1024 + kvh * 64 + cc * 8); vv = *(const u32x4*)(row + 1152 + kvh * 64 + cc * 8); }
            *(LAS u32x2*)(KL + jw * 136 + cc * 16) = (u32x2){kv.x, kv.y}; *(LAS u32x2*)(KL + jw * 136 + cc * 16 + 8) = (u32x2){kv.z, kv.w};
            *(LAS u32x2*)(VL + jw * 136 + cc * 16) = (u32x2){vv.x, vv.y}; *(LAS u32x2*)(VL + jw * 136 + cc * 16 + 8) = (u32x2){vv.z, vv.w}; }
        __syncthreads();
        for (int it = F.wave; it < 1024; it += NWAVES) {
            const int i = it >> 3, g = it & 7, head = kvh * 8 + g; const int t = b * SEQ + n * 128 + i;
            const float qv = bf2f(Z[(size_t)t * EV_NP + head * 64 + F.lane]) * 0.125f;
            const int jw0 = i + 1 + F.lane, jw1 = jw0 + 64;
            const bool val0 = (n > 0) || (jw0 >= 128), val1 = (n > 0) || (jw1 >= 128);
            float s0 = 0.f, s1 = 0.f;
#pragma unroll
            for (int d4 = 0; d4 < 16; ++d4) {
                const u32x2 k0 = *(const LAS u32x2*)(KL + jw0 * 136 + d4 * 8), k1 = *(const LAS u32x2*)(KL + jw1 * 136 + d4 * 8);
                const float q0 = rdlane(qv, 4 * d4), q1 = rdlane(qv, 4 * d4 + 1), q2 = rdlane(qv, 4 * d4 + 2), q3 = rdlane(qv, 4 * d4 + 3);
                s0 += q0 * lo2f(k0.x) + q1 * hi2f(k0.x) + q2 * lo2f(k0.y) + q3 * hi2f(k0.y);
                s1 += q0 * lo2f(k1.x) + q1 * hi2f(k1.x) + q2 * lo2f(k1.y) + q3 * hi2f(k1.y);
            }
            const float sink = sinks[head];
            s0 = val0 ? s0 : -INFINITY; s1 = val1 ? s1 : -INFINITY;
            const float mx = fmaxf(wmax(fmaxf(s0, s1)), sink);
            float p0 = val0 ? expf(s0 - mx) : 0.f, p1 = val1 ? expf(s1 - mx) : 0.f;
            const float den = wsum(p0 + p1) + expf(sink - mx); const float rden = 1.0f / den;
            p0 *= rden; p1 *= rden;
            float o = 0.f;
            const LAS bf16* vcol = (const LAS bf16*)VL + F.lane;
#pragma unroll 8
            for (int jj = 0; jj < 64; ++jj) o += rdlane(p0, jj) * bf2f(vcol[(i + 1 + jj) * 68]);
#pragma unroll 8
            for (int jj = 0; jj < 64; ++jj) o += rdlane(p1, jj) * bf2f(vcol[(i + 65 + jj) * 68]);
            Y[(size_t)t * DM + head * 64 + F.lane] = (bf16)f2bf(o);
        }
    }
}

__device__ __forceinline__ bf16x8 as_bf8(u32x4 v) { return __builtin_bit_cast(bf16x8, v); }
__device__ __forceinline__ void ph_swa_mfma(const Args& A, Frame& F) {
    const bf16* Z = (const bf16*)(A.ws + WS_Z); bf16* Y = (bf16*)(A.ws + WS_HY); const float* sinks = (const float*)A.in[5];
    LAS bf16* KL = (LAS bf16*)F.lds;
    LAS bf16* VT = (LAS bf16*)(F.lds + 36864);
    const int l15 = F.lane & 15, g4 = F.lane >> 4;
    for (int u = F.bx; u < 512; u += F.G) {
        const int b = u >> 8, n = (u >> 1) & 127, kvh = u & 1;
        __syncthreads();
        for (int c = F.tid; c < 2048; c += NTHREADS) { const int jw = c >> 3, cc = c & 7; const int sp = n * 128 - 128 + jw;
            u32x4 kv = {0u, 0u, 0u, 0u}, vv = {0u, 0u, 0u, 0u};
            if (sp >= 0) { const bf16* row = Z + (size_t)(b * SEQ + sp) * EV_NP; kv = *(const u32x4*)(row + 1024 + kvh * 64 + cc * 8); vv = *(const u32x4*)(row + 1152 + kvh * 64 + cc * 8); }
            *(LAS u32x4*)(KL + jw * 72 + cc * 8) = kv;
            const unsigned vw[4] = {vv.x, vv.y, vv.z, vv.w};
#pragma unroll
            for (int q = 0; q < 4; ++q) { VT[(8 * cc + 2 * q) * 264 + jw] = (bf16)(vw[q] & 0xffffu); VT[(8 * cc + 2 * q + 1) * 264 + jw] = (bf16)(vw[q] >> 16); } }
        __syncthreads();
        const int head = kvh * 8 + F.wave; const float sink = sinks[head];
#pragma unroll 1
        for (int qt = 0; qt < 8; ++qt) {
            const int iq = 16 * qt + l15; const int t = b * SEQ + n * 128 + iq;
            bf16x8 qf[2];
#pragma unroll
            for (int ks = 0; ks < 2; ++ks) qf[ks] = *(const bf16x8*)(Z + (size_t)t * EV_NP + head * 64 + 32 * ks + 8 * g4);
            float sv[10][4]; float mx = -INFINITY;
#pragma unroll
            for (int kk = 0; kk < 9; ++kk) { const int kt = qt + kk;
                f32x4 acc = {0.f, 0.f, 0.f, 0.f};
#pragma unroll
                for (int ks = 0; ks < 2; ++ks) acc = __builtin_amdgcn_mfma_f32_16x16x32_bf16(*(const LAS bf16x8*)(KL + (16 * kt + l15) * 72 + 32 * ks + 8 * g4), qf[ks], acc, 0, 0, 0);
#pragma unroll
                for (int rg_ = 0; rg_ < 4; ++rg_) { const int jw = 16 * kt + 4 * g4 + rg_; const bool ok = (jw >= iq + 1) && (jw <= iq + 128) && ((n > 0) || (jw >= 128));
                    sv[kk][rg_] = ok ? acc[rg_] * 0.125f : -INFINITY; mx = fmaxf(mx, sv[kk][rg_]); } }
#pragma unroll
            for (int rg_ = 0; rg_ < 4; ++rg_) sv[9][rg_] = -INFINITY;
            mx = xmax16(mx); mx = xmax32(mx); mx = fmaxf(mx, sink);
            float sm = 0.f;
#pragma unroll
            for (int kk = 0; kk < 10; ++kk)
#pragma unroll
                for (int rg_ = 0; rg_ < 4; ++rg_) { const float pv = (sv[kk][rg_] == -INFINITY) ? 0.f : __expf(sv[kk][rg_] - mx); sv[kk][rg_] = pv; sm += pv; }
            sm = xsum16(sm); sm = xsum32(sm);
            const float rden = 1.0f / (sm + __expf(sink - mx));
            f32x4 oacc[4];
#pragma unroll
            for (int dt = 0; dt < 4; ++dt) oacc[dt] = (f32x4){0.f, 0.f, 0.f, 0.f};
#pragma unroll
            for (int pp = 0; pp < 5; ++pp) { const int ka = qt + 2 * pp, kb = (qt + 2 * pp + 1 < 16) ? (qt + 2 * pp + 1) : 15;
                const bf16x8 pb = as_bf8((u32x4){pk2(sv[2 * pp][0] * rden, sv[2 * pp][1] * rden), pk2(sv[2 * pp][2] * rden, sv[2 * pp][3] * rden),
                                                  pk2(sv[2 * pp + 1][0] * rden, sv[2 * pp + 1][1] * rden), pk2(sv[2 * pp + 1][2] * rden, sv[2 * pp + 1][3] * rden)});
#pragma unroll
                for (int dt = 0; dt < 4; ++dt) { const LAS bf16* vr = VT + (16 * dt + l15) * 264 + 4 * g4;
                    const u32x2 va = *(const LAS u32x2*)(vr + 16 * ka), vb2 = *(const LAS u32x2*)(vr + 16 * kb);
                    oacc[dt] = __builtin_amdgcn_mfma_f32_16x16x32_bf16(as_bf8((u32x4){va.x, va.y, vb2.x, vb2.y}), pb, oacc[dt], 0, 0, 0); } }
#pragma unroll
            for (int dt = 0; dt < 4; ++dt) *(u32x2*)(Y + (size_t)t * DM + head * 64 + 16 * dt + 4 * g4) = (u32x2){pk2(oacc[dt][0], oacc[dt][1]), pk2(oacc[dt][2], oacc[dt][3])};
        }
    }
}

constexpr int FR_BYTES = 15360;
__device__ __forceinline__ int fr_rho(int ks, int g, int j) { return 16 * (2 * ks + (j >> 2)) + 4 * g + (j & 3); }
__device__ __forceinline__ void ph_scan_prep(const Args& A, Frame& F) {
    const bf16* Z = (const bf16*)(A.ws + WS_Z); const bf16* RKV = (const bf16*)A.out;
    const float* k_k = (const float*)A.in[12]; const float* k_a = (const float*)A.in[13]; const float* r_k = (const float*)A.in[14];
    unsigned char* FR = A.ws + WS_BIG; float* BS = (float*)(A.ws + WS_BS);
    LAS float* EE = (LAS float*)F.lds;
    LAS float* VV = (LAS float*)(F.lds + 4096);
    LAS float* KHf = (LAS float*)(F.lds + 8192);
    LAS float* RHf = (LAS float*)(F.lds + 12352);
    LAS float* BPf = (LAS float*)(F.lds + 16512);
    LAS bf16* AHb = (LAS bf16*)(F.lds + 20672);
    LAS bf16* BHb = (LAS bf16*)(F.lds + 22976);
    LAS bf16* KHb = (LAS bf16*)(F.lds + 25280);
    LAS bf16* RHb = (LAS bf16*)(F.lds + 27584);
    LAS bf16* APT = (LAS bf16*)(F.lds + 29888);
    LAS float* GA = (LAS float*)(F.lds + 32960);
    LAS float* GB = GA + 16 * 17; LAS float* GMA = GB + 16 * 17; LAS float* GMB = GMA + 16 * 17;
    LAS float* TT = (LAS float*)(F.lds + 37312);
    LAS bf16* P1b = (LAS bf16*)(F.lds + 38400);
    LAS bf16* P2b = (LAS bf16*)(F.lds + 41472);
    LAS bf16* MAT = (LAS bf16*)(F.lds + 42240);
    LAS float* WW = (LAS float*)(F.lds + 43008);
    const int tt = F.tid >> 5, kq = F.tid & 31;
    const int l15 = F.lane & 15, g = F.lane >> 4;
    const bf16x8 zero8 = {0, 0, 0, 0, 0, 0, 0, 0};
    for (int it = F.bx; it < 32 * 1024; it += F.G) {
        const int bh = it >> 10, ch = it & 1023, b = bh >> 4, h = bh & 15;
        const int tok = b * SEQ + ch * 16 + tt, c = h * 64 + 2 * kq;
        __syncthreads();
        float e2[2], kkn[2], kka[2], kp[2], r2[2];
        {
            const unsigned rw = *(const unsigned*)(RKV + (size_t)tok * 1024 + c), kw = *(const unsigned*)(RKV + (size_t)TOK * 1024 + (size_t)tok * 1024 + c), vw = *(const unsigned*)(RKV + (size_t)2 * TOK * 1024 + (size_t)tok * 1024 + c);
            const unsigned ew = *(const unsigned*)(Z + (size_t)tok * EV_NP + 1280 + c), aw = *(const unsigned*)(Z + (size_t)tok * EV_NP + 1280 + 1024 + c);
            const float kr[2] = {lo2f(kw), hi2f(kw)}, av[2] = {lo2f(aw), hi2f(aw)};
            r2[0] = lo2f(rw); r2[1] = hi2f(rw); e2[0] = lo2f(ew); e2[1] = hi2f(ew);
            float kkv[2], ss = 0.f, bsum = 0.f;
#pragma unroll
            for (int q = 0; q < 2; ++q) { kkv[q] = kr[q] * k_k[c + q]; ss += kkv[q] * kkv[q]; kp[q] = kr[q] * (1.0f + (av[q] - 1.0f) * k_a[c + q]); bsum += r2[q] * kp[q] * r_k[c + q]; }
            ss = xsum16(sum16_dpp(ss)); bsum = xsum16(sum16_dpp(bsum));
            const float rn = 1.0f / fmaxf(sqrtf(ss), 1e-12f);
#pragma unroll
            for (int q = 0; q < 2; ++q) { kkn[q] = kkv[q] * rn; kka[q] = kkn[q] * av[q]; }
            if (kq == 0) BS[(size_t)tok * 16 + h] = bsum;
            *(LAS f32x2*)(EE + tt * 64 + 2 * kq) = (f32x2){e2[0], e2[1]};
            *(LAS f32x2*)(VV + tt * 64 + 2 * kq) = (f32x2){lo2f(vw), hi2f(vw)};
        }
        __syncthreads();
        {
            float L[2] = {0.f, 0.f}, L15[2] = {0.f, 0.f};
#pragma unroll
            for (int i = 0; i < 16; ++i) { const f32x2 ev = *(const LAS f32x2*)(EE + i * 64 + 2 * kq); L15[0] += ev.x; L15[1] += ev.y; if (i <= tt) { L[0] += ev.x; L[1] += ev.y; } }
            float kh[2], ah[2], bhv[2], rh[2], ap[2], bp[2];
#pragma unroll
            for (int q = 0; q < 2; ++q) { const float wt = __expf(-L[q]), iwt = __expf(L[q]), wprev = __expf(-(L[q] - e2[q])), wrest = __expf(-(L15[q] - L[q]));
                kh[q] = kkn[q] * wprev; ah[q] = kka[q] * iwt; bhv[q] = kp[q] * iwt; rh[q] = r2[q] * wt; ap[q] = kka[q] * wrest; bp[q] = kp[q] * wrest;
                if (tt == 15) WW[2 * kq + q] = wt; }
            KHf[tt * 65 + 2 * kq] = kh[0]; KHf[tt * 65 + 2 * kq + 1] = kh[1]; RHf[tt * 65 + 2 * kq] = rh[0]; RHf[tt * 65 + 2 * kq + 1] = rh[1]; BPf[tt * 65 + 2 * kq] = bp[0]; BPf[tt * 65 + 2 * kq + 1] = bp[1];
            *(LAS unsigned*)(KHb + tt * 72 + 2 * kq) = pk2(kh[0], kh[1]); *(LAS unsigned*)(AHb + tt * 72 + 2 * kq) = pk2(ah[0], ah[1]);
            *(LAS unsigned*)(BHb + tt * 72 + 2 * kq) = pk2(bhv[0], bhv[1]); *(LAS unsigned*)(RHb + tt * 72 + 2 * kq) = pk2(rh[0], rh[1]);
            APT[(2 * kq) * 24 + tt] = (bf16)f2bf(ap[0]); APT[(2 * kq + 1) * 24 + tt] = (bf16)f2bf(ap[1]);
        }
        __syncthreads();
        if (F.wave < 4) {
            const int mat = F.wave; const LAS bf16* X = (mat & 1) ? BHb : AHb; const LAS bf16* Y = (mat & 2) ? RHb : KHb;
            f32x4 acc = {0.f, 0.f, 0.f, 0.f};
#pragma unroll
            for (int ks = 0; ks < 2; ++ks) acc = __builtin_amdgcn_mfma_f32_16x16x32_bf16(*(const LAS bf16x8*)(X + l15 * 72 + 32 * ks + 8 * g), *(const LAS bf16x8*)(Y + l15 * 72 + 32 * ks + 8 * g), acc, 0, 0, 0);
            LAS float* dst = (mat == 0) ? GA : ((mat == 1) ? GB : ((mat == 2) ? GMA : GMB));
#pragma unroll
            for (int rg_ = 0; rg_ < 4; ++rg_) { const int i = 4 * g + rg_; const bool nz = (mat & 2) ? (i <= l15) : (i < l15); const float v = nz ? acc[rg_] : 0.f;
                dst[i * 17 + l15] = v; if (mat == 2) MAT[l15 * 24 + i] = (bf16)f2bf(v); }
        }
        __syncthreads();
        if (F.tid < 16) {
            float x[16];
#pragma unroll
            for (int i = 15; i >= 0; --i) { float v = (i == F.tid) ? 1.0f : 0.f;
#pragma unroll
                for (int m = i + 1; m < 16; ++m) v -= GA[i * 17 + m] * x[m];
                x[i] = v; }
#pragma unroll
            for (int i = 0; i < 16; ++i) TT[i * 17 + F.tid] = x[i];
        }
        __syncthreads();
        {
            float x0 = 0.f, x1 = 0.f;
#pragma unroll
            for (int m = 0; m < 16; ++m) { const float tv = TT[m * 17 + tt]; x0 -= KHf[m * 65 + 2 * kq] * tv; x1 -= KHf[m * 65 + 2 * kq + 1] * tv; }
            P1b[(2 * kq) * 24 + tt] = (bf16)f2bf(x0); P1b[(2 * kq + 1) * 24 + tt] = (bf16)f2bf(x1);
            if (F.tid < 256) { const int i = F.tid >> 4, t = F.tid & 15; float x = 0.f;
#pragma unroll
                for (int m = 0; m < 16; ++m) x -= GB[i * 17 + m] * TT[m * 17 + t];
                P2b[i * 24 + t] = (bf16)f2bf(x); }
        }
        __syncthreads();
        {
            unsigned char* fr = FR + (size_t)it * FR_BYTES;
            const int mt = F.wave >> 1, ks = F.wave & 1;
            const bf16x8 aP0 = (g < 2) ? *(const LAS bf16x8*)(P1b + (16 * (2 * ks) + l15) * 24 + 8 * g) : zero8;
            const bf16x8 aP1 = (g < 2) ? *(const LAS bf16x8*)(P1b + (16 * (2 * ks + 1) + l15) * 24 + 8 * g) : zero8;
            const bf16x8 bAP = (g < 2) ? *(const LAS bf16x8*)(APT + (16 * mt + l15) * 24 + 8 * g) : zero8;
            const f32x4 z4 = {0.f, 0.f, 0.f, 0.f};
            const f32x4 d0 = __builtin_amdgcn_mfma_f32_16x16x32_bf16(aP0, bAP, z4, 0, 0, 0), d1 = __builtin_amdgcn_mfma_f32_16x16x32_bf16(aP1, bAP, z4, 0, 0, 0);
            *(u32x4*)(fr + (size_t)(F.wave * 64 + F.lane) * 16) = (u32x4){pk2(d0[0], d0[1]), pk2(d0[2], d0[3]), pk2(d1[0], d1[1]), pk2(d1[2], d1[3])};
            if (F.wave < 4) {
                const bf16x8 aP2 = (g < 2) ? *(const LAS bf16x8*)(P2b + l15 * 24 + 8 * g) : zero8;
                const bf16x8 bA = (g < 2) ? *(const LAS bf16x8*)(APT + (16 * F.wave + l15) * 24 + 8 * g) : zero8;
                f32x4 d = __builtin_amdgcn_mfma_f32_16x16x32_bf16(aP2, bA, z4, 0, 0, 0);
#pragma unroll
                for (int rg_ = 0; rg_ < 4; ++rg_) d[rg_] += BPf[(4 * g + rg_) * 65 + 16 * F.wave + l15];
                *(u32x2*)(fr + 8192 + (size_t)(F.wave * 64 + F.lane) * 8) = (u32x2){pk2(d[0], d[1]), pk2(d[2], d[3])};
            } else if (F.wave < 6) {
                const int ks2 = F.wave - 4;
                const bf16x8 a0 = (g < 2) ? *(const LAS bf16x8*)(P1b + (16 * (2 * ks2) + l15) * 24 + 8 * g) : zero8;
                const bf16x8 a1 = (g < 2) ? *(const LAS bf16x8*)(P1b + (16 * (2 * ks2 + 1) + l15) * 24 + 8 * g) : zero8;
                const bf16x8 bM = (g < 2) ? *(const LAS bf16x8*)(MAT + l15 * 24 + 8 * g) : zero8;
                f32x4 q0 = __builtin_amdgcn_mfma_f32_16x16x32_bf16(a0, bM, z4, 0, 0, 0), q1 = __builtin_amdgcn_mfma_f32_16x16x32_bf16(a1, bM, z4, 0, 0, 0);
#pragma unroll
                for (int rg_ = 0; rg_ < 4; ++rg_) { q0[rg_] += RHf[l15 * 65 + 16 * (2 * ks2) + 4 * g + rg_]; q1[rg_] += RHf[l15 * 65 + 16 * (2 * ks2 + 1) + 4 * g + rg_]; }
                *(u32x4*)(fr + 10240 + (size_t)(ks2 * 64 + F.lane) * 16) = (u32x4){pk2(q0[0], q0[1]), pk2(q0[2], q0[3]), pk2(q1[0], q1[1]), pk2(q1[2], q1[3])};
            } else if (F.wave == 6) {
                const bf16x8 aP2 = (g < 2) ? *(const LAS bf16x8*)(P2b + l15 * 24 + 8 * g) : zero8;
                const bf16x8 bM = (g < 2) ? *(const LAS bf16x8*)(MAT + l15 * 24 + 8 * g) : zero8;
                f32x4 d = __builtin_amdgcn_mfma_f32_16x16x32_bf16(aP2, bM, z4, 0, 0, 0);
#pragma unroll
                for (int rg_ = 0; rg_ < 4; ++rg_) d[rg_] += GMB[(4 * g + rg_) * 17 + l15];
                *(u32x2*)(fr + 12288 + (size_t)F.lane * 8) = (u32x2){pk2(d[0], d[1]), pk2(d[2], d[3])};
            } else {
                *(float*)(fr + 14848 + F.lane * 4) = WW[F.lane];
            }
            if (F.tid < 256) {
                const int rg = F.tid >> 6, row = 16 * rg + l15, s4 = 4 * g;
                *(u32x2*)(fr + 12800 + (size_t)(rg * 64 + F.lane) * 8) = (u32x2){pk2(VV[s4 * 64 + row], VV[(s4 + 1) * 64 + row]), pk2(VV[(s4 + 2) * 64 + row], VV[(s4 + 3) * 64 + row])};
            }
        }
    }
}
struct ScanFrag { u32x4 g[4][2]; u32x2 f[4]; u32x4 q1[2]; u32x2 q2; u32x2 vt; f32x4 w[4]; };
__device__ __forceinline__ void scan_frag_load(ScanFrag& fr, const unsigned char* base, int rg, int lane) {
#pragma unroll
    for (int mt = 0; mt < 4; ++mt) {
#pragma unroll
        for (int ks = 0; ks < 2; ++ks) fr.g[mt][ks] = *(const u32x4*)(base + (size_t)((mt * 2 + ks) * 64 + lane) * 16);
        fr.f[mt] = *(const u32x2*)(base + 8192 + (size_t)(mt * 64 + lane) * 8);
        fr.w[mt] = *(const f32x4*)(base + 14848 + (16 * mt + 4 * (lane >> 4)) * 4); }
#pragma unroll
    for (int ks = 0; ks < 2; ++ks) fr.q1[ks] = *(const u32x4*)(base + 10240 + (size_t)(ks * 64 + lane) * 16);
    fr.q2 = *(const u32x2*)(base + 12288 + (size_t)lane * 8);
    fr.vt = *(const u32x2*)(base + 12800 + (size_t)(rg * 64 + lane) * 8);
}
__device__ __forceinline__ void scan_chunk(f32x4 (&acc)[4], const ScanFrag& fr, bf16* yout) {
    const bf16x8 sb0 = as_bf8((u32x4){pk2(acc[0][0], acc[0][1]), pk2(acc[0][2], acc[0][3]), pk2(acc[1][0], acc[1][1]), pk2(acc[1][2], acc[1][3])});
    const bf16x8 sb1 = as_bf8((u32x4){pk2(acc[2][0], acc[2][1]), pk2(acc[2][2], acc[2][3]), pk2(acc[3][0], acc[3][1]), pk2(acc[3][2], acc[3][3])});
    const bf16x8 vb = as_bf8((u32x4){fr.vt.x, fr.vt.y, 0u, 0u});
#pragma unroll
    for (int c = 0; c < 4; ++c) { f32x4 n = acc[c] * fr.w[c];
        n = __builtin_amdgcn_mfma_f32_16x16x32_bf16(as_bf8(fr.g[c][0]), sb0, n, 0, 0, 0);
        n = __builtin_amdgcn_mfma_f32_16x16x32_bf16(as_bf8(fr.g[c][1]), sb1, n, 0, 0, 0);
        n = __builtin_amdgcn_mfma_f32_16x16x32_bf16(as_bf8((u32x4){fr.f[c].x, fr.f[c].y, 0u, 0u}), vb, n, 0, 0, 0);
        acc[c] = n; }
    f32x4 y = {0.f, 0.f, 0.f, 0.f};
    y = __builtin_amdgcn_mfma_f32_16x16x32_bf16(as_bf8(fr.q1[0]), sb0, y, 0, 0, 0);
    y = __builtin_amdgcn_mfma_f32_16x16x32_bf16(as_bf8(fr.q1[1]), sb1, y, 0, 0, 0);
    y = __builtin_amdgcn_mfma_f32_16x16x32_bf16(as_bf8((u32x4){fr.q2.x, fr.q2.y, 0u, 0u}), vb, y, 0, 0, 0);
    *(u32x2*)yout = (u32x2){pk2(y[0], y[1]), pk2(y[2], y[3])};
}
#define SCAN_ASM_LD4(dst, ptr, off) asm volatile("global_load_dwordx4 %0, %1, off offset:" #off : "=v"(dst) : "v"(ptr))
#define SCAN_ASM_LD2(dst, ptr, off) asm volatile("global_load_dwordx2 %0, %1, off offset:" #off : "=v"(dst) : "v"(ptr))
__device__ __forceinline__ void scan_frag_issue(ScanFrag& fr, const unsigned char* item, int rg, int lane) {
    const unsigned char* pg0 = item + lane * 16; const unsigned char* pg1 = pg0 + 4096;
    const unsigned char* pf = item + 8192 + lane * 8; const unsigned char* pq1 = item + 10240 + lane * 16;
    const unsigned char* pq2 = item + 12288 + lane * 8; const unsigned char* pvt = item + 12800 + (rg * 64 + lane) * 8; const unsigned char* pw = item + 14848 + (lane >> 4) * 16;
    SCAN_ASM_LD4(fr.g[0][0], pg0, 0); SCAN_ASM_LD4(fr.g[0][1], pg0, 1024); SCAN_ASM_LD4(fr.g[1][0], pg0, 2048); SCAN_ASM_LD4(fr.g[1][1], pg0, 3072);
    SCAN_ASM_LD4(fr.g[2][0], pg1, 0); SCAN_ASM_LD4(fr.g[2][1], pg1, 1024); SCAN_ASM_LD4(fr.g[3][0], pg1, 2048); SCAN_ASM_LD4(fr.g[3][1], pg1, 3072);
    SCAN_ASM_LD2(fr.f[0], pf, 0); SCAN_ASM_LD2(fr.f[1], pf, 512); SCAN_ASM_LD2(fr.f[2], pf, 1024); SCAN_ASM_LD2(fr.f[3], pf, 1536);
    SCAN_ASM_LD4(fr.q1[0], pq1, 0); SCAN_ASM_LD4(fr.q1[1], pq1, 1024);
    SCAN_ASM_LD2(fr.q2, pq2, 0); SCAN_ASM_LD2(fr.vt, pvt, 0);
    SCAN_ASM_LD4(fr.w[0], pw, 0); SCAN_ASM_LD4(fr.w[1], pw, 64); SCAN_ASM_LD4(fr.w[2], pw, 128); SCAN_ASM_LD4(fr.w[3], pw, 192);
}
#define SCAN_WAIT(fr, N) asm volatile("s_waitcnt vmcnt(" #N ")" : "+v"(fr.g[0][0]), "+v"(fr.g[0][1]), "+v"(fr.g[1][0]), "+v"(fr.g[1][1]), "+v"(fr.g[2][0]), "+v"(fr.g[2][1]), "+v"(fr.g[3][0]), "+v"(fr.g[3][1]), \
        "+v"(fr.f[0]), "+v"(fr.f[1]), "+v"(fr.f[2]), "+v"(fr.f[3]), "+v"(fr.q1[0]), "+v"(fr.q1[1]), "+v"(fr.q2), "+v"(fr.vt), "+v"(fr.w[0]), "+v"(fr.w[1]), "+v"(fr.w[2]), "+v"(fr.w[3]) :: "memory")
__device__ __forceinline__ void scan_mfma_rows(const Args& A, Frame& F) {
    const unsigned char* FR = A.ws + WS_BIG; bf16* YRAW = (bf16*)A.out + (size_t)3 * TOK * 1024;
    if (F.wave != 0) return;
    for (int u = F.bx; u < 128; u += F.G) {
        const int bh = u & 31, rg = u >> 5; const unsigned char* base = FR + (size_t)bh * 1024 * FR_BYTES;
        bf16* yrow = YRAW + ((size_t)bh * 64 + 16 * rg + (F.lane & 15)) * SEQ + 4 * (F.lane >> 4);
        f32x4 acc[4];
#pragma unroll
        for (int c = 0; c < 4; ++c) acc[c] = (f32x4){0.f, 0.f, 0.f, 0.f};
        ScanFrag fa, fb;
        scan_frag_issue(fa, base, rg, F.lane);
#pragma unroll 1
        for (int ch = 0; ch < 1024; ch += 2) {
            scan_frag_issue(fb, base + (size_t)(ch + 1) * FR_BYTES, rg, F.lane);
            SCAN_WAIT(fa, 20);
            scan_chunk(acc, fa, yrow + ch * 16);
            scan_frag_issue(fa, base + (size_t)((ch + 2 < 1024) ? (ch + 2) : ch) * FR_BYTES, rg, F.lane);
            SCAN_WAIT(fb, 20);
            scan_chunk(acc, fb, yrow + (ch + 1) * 16);
        }
        asm volatile("s_waitcnt vmcnt(0)" ::: "memory");
    }
}

__device__ __forceinline__ void pair_sync(volatile LAS unsigned* cnt, unsigned target) {
    asm volatile("s_waitcnt vmcnt(0) lgkmcnt(0)" ::: "memory");
    if ((threadIdx.x & 63) == 0) (void)__hip_atomic_fetch_add((LAS unsigned*)cnt, 1u, __ATOMIC_RELAXED, __HIP_MEMORY_SCOPE_WORKGROUP);
    while (__hip_atomic_load((LAS unsigned*)cnt, __ATOMIC_RELAXED, __HIP_MEMORY_SCOPE_WORKGROUP) < target) __builtin_amdgcn_s_sleep(1);
    asm volatile("" ::: "memory");
}
__device__ __forceinline__ void swa_pairs(const Args& A, Frame& F, volatile LAS unsigned* MISC) {
    const bf16* Z = (const bf16*)(A.ws + WS_Z); bf16* Y = (bf16*)(A.ws + WS_HY); const float* sinks = (const float*)A.in[5];
    const int pr = (F.wave - 4) >> 1, mem = F.wave & 1;
    LAS unsigned char* KL = F.lds + pr * 69632; LAS unsigned char* VL = KL + 256 * 136;
    volatile LAS unsigned* cnt = MISC + 24 + pr; unsigned gen = 0u;
    for (int u = F.bx * 2 + pr; u < 512; u += F.G * 2) {
        const int b = u >> 8, n = (u >> 1) & 127, kvh = u & 1;
        gen += 2u; pair_sync(cnt, gen);
#pragma unroll 1
        for (int c0 = mem * 1024 + F.lane; c0 < mem * 1024 + 1024; c0 += 64 * 8) {
            u32x4 kv[8], vv[8];
#pragma unroll
            for (int q = 0; q < 8; ++q) { const int c = c0 + 64 * q; const int jw = c >> 3, cc = c & 7; const int sp = n * 128 - 128 + jw;
                kv[q] = (u32x4){0u, 0u, 0u, 0u}; vv[q] = kv[q];
                if (sp >= 0) { const bf16* row = Z + (size_t)(b * SEQ + sp) * EV_NP; kv[q] = *(const u32x4*)(row + 1024 + kvh * 64 + cc * 8); vv[q] = *(const u32x4*)(row + 1152 + kvh * 64 + cc * 8); } }
#pragma unroll
            for (int q = 0; q < 8; ++q) { const int c = c0 + 64 * q; const int jw = c >> 3, cc = c & 7;
                *(LAS u32x2*)(KL + jw * 136 + cc * 16) = (u32x2){kv[q].x, kv[q].y}; *(LAS u32x2*)(KL + jw * 136 + cc * 16 + 8) = (u32x2){kv[q].z, kv[q].w};
                *(LAS u32x2*)(VL + jw * 136 + cc * 16) = (u32x2){vv[q].x, vv[q].y}; *(LAS u32x2*)(VL + jw * 136 + cc * 16 + 8) = (u32x2){vv[q].z, vv[q].w}; }
        }
        gen += 2u; pair_sync(cnt, gen);
        for (int it = mem; it < 1024; it += 2) {
            const int i = it >> 3, g = it & 7, head = kvh * 8 + g; const int t = b * SEQ + n * 128 + i;
            const float qv = bf2f(Z[(size_t)t * EV_NP + head * 64 + F.lane]) * 0.125f;
            const int jw0 = i + 1 + F.lane, jw1 = jw0 + 64;
            const bool val0 = (n > 0) || (jw0 >= 128), val1 = (n > 0) || (jw1 >= 128);
            float s0 = 0.f, s1 = 0.f;
#pragma unroll
            for (int d4 = 0; d4 < 16; ++d4) {
                const u32x2 k0 = *(const LAS u32x2*)(KL + jw0 * 136 + d4 * 8), k1 = *(const LAS u32x2*)(KL + jw1 * 136 + d4 * 8);
                const float q0 = rdlane(qv, 4 * d4), q1 = rdlane(qv, 4 * d4 + 1), q2 = rdlane(qv, 4 * d4 + 2), q3 = rdlane(qv, 4 * d4 + 3);
                s0 += q0 * lo2f(k0.x) + q1 * hi2f(k0.x) + q2 * lo2f(k0.y) + q3 * hi2f(k0.y);
                s1 += q0 * lo2f(k1.x) + q1 * hi2f(k1.x) + q2 * lo2f(k1.y) + q3 * hi2f(k1.y);
            }
            const float sink = sinks[head];
            s0 = val0 ? s0 : -INFINITY; s1 = val1 ? s1 : -INFINITY;
            const float mx = fmaxf(wmax(fmaxf(s0, s1)), sink);
            float p0 = val0 ? expf(s0 - mx) : 0.f, p1 = val1 ? expf(s1 - mx) : 0.f;
            const float den = wsum(p0 + p1) + expf(sink - mx); const float rden = 1.0f / den;
            p0 *= rden; p1 *= rden;
            float o = 0.f;
            const LAS bf16* vcol = (const LAS bf16*)VL + F.lane;
#pragma unroll 8
            for (int jj = 0; jj < 64; ++jj) o += rdlane(p0, jj) * bf2f(vcol[(i + 1 + jj) * 68]);
#pragma unroll 8
            for (int jj = 0; jj < 64; ++jj) o += rdlane(p1, jj) * bf2f(vcol[(i + 65 + jj) * 68]);
            Y[(size_t)t * DM + head * 64 + F.lane] = (bf16)f2bf(o);
        }
    }
}

__device__ __forceinline__ void wsum2_dpp(float a, float b, float& ra, float& rb) {
    const auto r = __builtin_amdgcn_permlane32_swap(__float_as_uint(a), __float_as_uint(b), false, false);
    float v = __uint_as_float(r[0]) + __uint_as_float(r[1]);
    v += dppf<0xB1, 0xF>(v); v += dppf<0x4E, 0xF>(v); v += dppf<0x141, 0xF>(v); v += dppf<0x140, 0xF>(v);
    v += dppf<0x142, 0xA>(v);
    ra = rdlane(v, 31); rb = rdlane(v, 63);
}
__device__ __forceinline__ void ph_scan(const Args& A, Frame& F, volatile LAS unsigned* MISC) {
    const unsigned* PK = (const unsigned*)(A.ws + WS_BIG); bf16* YRAW = (bf16*)A.out + (size_t)3 * TOK * 1024;
    if (F.wave >= 4) { swa_pairs(A, F, MISC); return; }
    __builtin_amdgcn_s_setprio(3);
    for (int pp = F.bx * 4 + F.wave; pp < 1024; pp += F.G * 4) {
        const int rr = 2 * pp, bh = rr >> 6, vrow = rr & 63;
        const unsigned* pk = PK + ((size_t)bh * SEQ * 64 + F.lane) * 3;
        bf16* youtA = YRAW + ((size_t)bh * 64 + vrow) * SEQ; bf16* youtB = youtA + SEQ;
        f32x2 S2 = {0.f, 0.f};
        for (int t0 = 0; t0 < SEQ; t0 += 64) {
            float ykA = 0.f, ykB = 0.f;
#pragma unroll 8
            for (int j = 0; j < 64; ++j) {
                const unsigned* p = pk + (size_t)(t0 + j) * 192;
                const unsigned w0 = p[0], w1 = p[1], w2 = p[2];
                const float r = lo2f(w0), e = hi2f(w0), kp = lo2f(w1), kk = hi2f(w1), kka = lo2f(w2), vv = hi2f(w2);
                const f32x2 v2 = {rdlane(vv, vrow), rdlane(vv, vrow + 1)};
                const float dec = __expf(-e);
                const f32x2 pk2v = S2 * (f32x2){kk, kk};
                float saA, saB; wsum2_dpp(pk2v.x, pk2v.y, saA, saB); const f32x2 sa2 = {saA, saB};
                S2 = S2 * (f32x2){dec, dec} + (v2 * (f32x2){kp, kp} - sa2 * (f32x2){kka, kka});
                const f32x2 py = S2 * (f32x2){r, r};
                float yA, yB; wsum2_dpp(py.x, py.y, yA, yB);
                ykA = (F.lane == j) ? yA : ykA; ykB = (F.lane == j) ? yB : ykB;
            }
            youtA[t0 + F.lane] = (bf16)f2bf(ykA); youtB[t0 + F.lane] = (bf16)f2bf(ykB);
        }
    }
    __builtin_amdgcn_s_setprio(0);
}

__device__ __forceinline__ void ph_rwkv_finish(const Args& A, Frame& F) {
    const bf16* Z = (const bf16*)(A.ws + WS_Z); const bf16* RKV = (const bf16*)A.out; const bf16* YRAW = (const bf16*)A.out + (size_t)3 * TOK * 1024;
    const float* BS = (const float*)(A.ws + WS_BS); bf16* Y = (bf16*)(A.ws + WS_HY);
    const float* lnx_g = (const float*)A.in[15]; const float* lnx_b = (const float*)A.in[16];
    LAS float* tile = (LAS float*)(F.lds + F.wave * 16640);
    for (int it = F.gw; it < 8192; it += F.ngw) {
        const int bh = it >> 8, tb = it & 255, b = bh >> 4, h = bh & 15, t0 = tb * 64;
        for (int vr = 0; vr < 64; ++vr) tile[vr * 65 + F.lane] = bf2f(YRAW[((size_t)bh * 64 + vr) * SEQ + t0 + F.lane]);
        asm volatile("s_waitcnt lgkmcnt(0)" ::: "memory");
        const int c = h * 64 + F.lane; const float lg = lnx_g[c], lb = lnx_b[c];
        for (int j = 0; j < 64; ++j) {
            const int t = b * SEQ + t0 + j;
            const float y = tile[F.lane * 65 + j];
            const float mean = wsum(y) * (1.0f / 64.0f); const float d = y - mean; const float var = wsum(d * d) * (1.0f / 64.0f);
            const float yn = d * rsqrtf(var + 64e-5f) * lg + lb;
            const float vv = bf2f(RKV[(size_t)2 * TOK * 1024 + (size_t)t * 1024 + c]); const float g = bf2f(Z[(size_t)t * EV_NP + 1280 + 2048 + c]); const float bs = BS[(size_t)t * 16 + h];
            Y[(size_t)t * DM + 1024 + c] = (bf16)f2bf((yn + bs * vv) * g);
        }
        asm volatile("s_waitcnt lgkmcnt(0)" ::: "memory");
    }
}

constexpr size_t WS_H8 = WS_BIG + 384 * MiB, WS_HS = WS_BIG + 448 * MiB;
__device__ __forceinline__ unsigned pack_i8x4(float a, float b, float c, float d) {
    const unsigned ua = __float_as_uint(a + 12582912.0f) & 255u, ub = __float_as_uint(b + 12582912.0f) & 255u, uc = __float_as_uint(c + 12582912.0f) & 255u, ud = __float_as_uint(d + 12582912.0f);
    return ua | (ub << 8) | (uc << 16) | (ud << 24);
}
__device__ __forceinline__ void ph_ln_mixer(const Args& A, Frame& F, const int L) {
    const float* xsrc = (const float*)A.in[0]; const bf16* xsrcb = (const bf16*)A.out;
    bf16* xdst = (L == 0) ? (bf16*)A.out : (bf16*)(A.ws + WS_Z + 160 * MiB);
    const bf16* O = (const bf16*)(A.ws + WS_Z); bf16* H = (bf16*)(A.ws + WS_HY); const float* MOD = (const float*)(A.ws + WS_MOD);
    const float* lng = (const float*)A.in[21] + (size_t)(L * 2 + 0) * DM; const float* lnb = (const float*)A.in[22] + (size_t)(L * 2 + 0) * DM;
    for (int t = F.gw; t < TOK; t += F.ngw) {
        const int b = t >> 14;
        const float* gate = MOD + (size_t)((L * 2 + 0) * 2 + b) * 6144 + 4096;
        const float* sh = MOD + (size_t)((L * 2 + 1) * 2 + b) * 6144; const float* sc = sh + 2048;
        float v[32]; float sum = 0.f;
#pragma unroll
        for (int j = 0; j < 4; ++j) { const int base = (j * 64 + F.lane) * 8;
            const u32x4 ow = *(const u32x4*)(O + (size_t)t * DM + base);
            f32x4 x0, x1;
            if (L == 0) { x0 = *(const f32x4*)(xsrc + (size_t)t * DM + base); x1 = *(const f32x4*)(xsrc + (size_t)t * DM + base + 4); }
            else { const u32x4 xw = *(const u32x4*)(xsrcb + (size_t)t * DM + base); x0 = (f32x4){lo2f(xw.x), hi2f(xw.x), lo2f(xw.y), hi2f(xw.y)}; x1 = (f32x4){lo2f(xw.z), hi2f(xw.z), lo2f(xw.w), hi2f(xw.w)}; }
            const f32x4 g0 = *(const f32x4*)(gate + base), g1 = *(const f32x4*)(gate + base + 4);
            const float of[8] = {lo2f(ow.x), hi2f(ow.x), lo2f(ow.y), hi2f(ow.y), lo2f(ow.z), hi2f(ow.z), lo2f(ow.w), hi2f(ow.w)};
#pragma unroll
            for (int e = 0; e < 4; ++e) { v[j * 8 + e] = ALPHA * x0[e] + (1.0f + g0[e]) * of[e]; v[j * 8 + 4 + e] = ALPHA * x1[e] + (1.0f + g1[e]) * of[4 + e]; }
#pragma unroll
            for (int e = 0; e < 8; ++e) sum += v[j * 8 + e]; }
        const float mean = wsum(sum) * (1.0f / DM); float sq = 0.f;
#pragma unroll
        for (int e = 0; e < 32; ++e) { v[e] -= mean; sq += v[e] * v[e]; }
        const float rstd = rsqrtf(wsum(sq) * (1.0f / DM) + 1e-5f); float hmax = 0.f;
#pragma unroll
        for (int j = 0; j < 4; ++j) { const int base = (j * 64 + F.lane) * 8;
            const f32x4 lg0 = *(const f32x4*)(lng + base), lg1 = *(const f32x4*)(lng + base + 4), lb0 = *(const f32x4*)(lnb + base), lb1 = *(const f32x4*)(lnb + base + 4);
            const f32x4 s0 = *(const f32x4*)(sc + base), s1 = *(const f32x4*)(sc + base + 4), h0 = *(const f32x4*)(sh + base), h1 = *(const f32x4*)(sh + base + 4);
            f32x4 o0, o1;
#pragma unroll
            for (int e = 0; e < 4; ++e) { o0[e] = v[j * 8 + e] * rstd * lg0[e] + lb0[e]; o1[e] = v[j * 8 + 4 + e] * rstd * lg1[e] + lb1[e]; }
            { u32x4 xw; xw.x = pk2(o0[0], o0[1]); xw.y = pk2(o0[2], o0[3]); xw.z = pk2(o1[0], o1[1]); xw.w = pk2(o1[2], o1[3]); *(u32x4*)(xdst + (size_t)t * DM + base) = xw; }
            const f32x4 q0 = o0 * (1.0f + s0) + h0, q1 = o1 * (1.0f + s1) + h1;
            u32x4 w; w.x = pk2(q0[0], q0[1]); w.y = pk2(q0[2], q0[3]); w.z = pk2(q1[0], q1[1]); w.w = pk2(q1[2], q1[3]);
            *(u32x4*)(H + (size_t)t * DM + base) = w;
#pragma unroll
            for (int e = 0; e < 4; ++e) { v[j * 8 + e] = q0[e]; v[j * 8 + 4 + e] = q1[e]; hmax = fmaxf(hmax, fmaxf(fabsf(q0[e]), fabsf(q1[e]))); } }
        { hmax = wmax(hmax); const float inv = (hmax > 0.f) ? 127.0f / hmax : 0.f;
#pragma unroll
          for (int j = 0; j < 4; ++j) { const int base = (j * 64 + F.lane) * 8; u32x2 w8;
              w8.x = pack_i8x4(v[j * 8 + 0] * inv, v[j * 8 + 1] * inv, v[j * 8 + 2] * inv, v[j * 8 + 3] * inv); w8.y = pack_i8x4(v[j * 8 + 4] * inv, v[j * 8 + 5] * inv, v[j * 8 + 6] * inv, v[j * 8 + 7] * inv);
              *(u32x2*)(A.ws + WS_H8 + (size_t)t * DM + base) = w8; }
          if (F.lane == 0) ((float*)(A.ws + WS_HS))[t] = hmax * (1.0f / 127.0f); }
    }
    {
        const float* pu = (const float*)A.in[25] + (size_t)L * 16384 * 2048; const float* pv = (const float*)A.in[26] + (size_t)L * 16384 * 2048;
        unsigned char* T8 = A.ws + WS_BIG; float* SCL = (float*)(A.ws + WS_BIG + 64 * MiB);
        for (int r = F.gw; r < 32768; r += F.ngw) {
            const float* src = ((r < 16384) ? pu : pv) + (size_t)(r & 16383) * 2048;
            f32x4 f[2][4]; float amax = 0.f;
#pragma unroll
            for (int j = 0; j < 2; ++j)
#pragma unroll
                for (int c = 0; c < 4; ++c) { f[j][c] = *(const f32x4*)(src + (j * 64 + F.lane) * 16 + 4 * c);
                    amax = fmaxf(amax, fmaxf(fmaxf(fabsf(f[j][c][0]), fabsf(f[j][c][1])), fmaxf(fabsf(f[j][c][2]), fabsf(f[j][c][3])))); }
            amax = wmax(amax);
            {
                const float inv = (amax > 0.f) ? 127.0f / amax : 0.f;
#pragma unroll
                for (int j = 0; j < 2; ++j) { u32x4 w;
                    w.x = pack_i8x4(f[j][0][0] * inv, f[j][0][1] * inv, f[j][0][2] * inv, f[j][0][3] * inv); w.y = pack_i8x4(f[j][1][0] * inv, f[j][1][1] * inv, f[j][1][2] * inv, f[j][1][3] * inv);
                    w.z = pack_i8x4(f[j][2][0] * inv, f[j][2][1] * inv, f[j][2][2] * inv, f[j][2][3] * inv); w.w = pack_i8x4(f[j][3][0] * inv, f[j][3][1] * inv, f[j][3][2] * inv, f[j][3][3] * inv);
                    *(u32x4*)(T8 + (size_t)r * 2048 + (j * 64 + F.lane) * 16) = w; }
                if (F.lane == 0) SCL[r] = amax * (1.0f / 127.0f);
            }
        }
    }
}

template <int NV, int NBITS> __device__ __forceinline__ unsigned wave_tau16(const unsigned (&key)[NV]) {
    unsigned tau = 0u;
#pragma unroll 1
    for (int bit = NBITS - 1; bit >= 0; --bit) {
        const unsigned cand = tau | (1u << bit); int cnt = 0;
#pragma unroll
        for (int v = 0; v < NV; ++v) cnt += __popcll(__ballot(key[v] >= cand));
        if (cnt >= 16) tau = cand;
    }
    return tau;
}
template <int NV> __device__ __forceinline__ void wave_compact16(const unsigned (&key)[NV], const float (&val)[NV], const int (&id)[NV], unsigned tau, LAS float* ov, LAS int* oi, int lane) {
    int ngt = 0;
#pragma unroll
    for (int v = 0; v < NV; ++v) ngt += __popcll(__ballot(key[v] > tau));
    int bg = 0, be = 0;
#pragma unroll
    for (int v = 0; v < NV; ++v) {
        const bool gt = key[v] > tau, eq = key[v] == tau;
        const unsigned long long mg = __ballot(gt), me = __ballot(eq);
        const unsigned long long below = (lane == 0) ? 0ull : ((~0ull) >> (64 - lane));
        const int pg = bg + __popcll(mg & below), pe = ngt + be + __popcll(me & below);
        if (gt) { ov[pg] = val[v]; oi[pg] = id[v]; }
        if (eq && pe < 16) { ov[pe] = val[v]; oi[pe] = id[v]; }
        bg += __popcll(mg); be += __popcll(me);
    }
}

template <int CTRL, int BANK> __device__ __forceinline__ unsigned dppb(unsigned old, unsigned v) { return (unsigned)__builtin_amdgcn_update_dpp((int)old, (int)v, CTRL, 0xF, BANK, false); }
template <int CTRL> __device__ __forceinline__ unsigned dppm(unsigned v) { return (unsigned)__builtin_amdgcn_mov_dpp((int)v, CTRL, 0xF, 0xF, true); }
template <int CTRL> __device__ __forceinline__ unsigned cex(unsigned x, bool lo) { const unsigned mx = max(x, dppm<CTRL>(x)), mn = min(x, dppm<CTRL>(x)); return lo ? mx : mn; }
__device__ __forceinline__ unsigned cex4(unsigned x, bool lo) {
    unsigned t = (unsigned)__builtin_amdgcn_mov_dpp((int)x, 0x104, 0xF, 0x5, false); t = dppb<0x114, 0xA>(t, x); const unsigned mx = max(x, t), mn = min(x, t); return lo ? mx : mn; }
struct LoMasks { bool lo1, lo2, lo4, lo8, odd16, up32; };
__device__ __forceinline__ unsigned sort16_desc(unsigned x, const LoMasks& M) {
    x = cex<0xB1>(x, M.lo1);
    x = cex<0x1B>(x, M.lo2); x = cex<0xB1>(x, M.lo1);
    x = cex<0x141>(x, M.lo4); x = cex<0x4E>(x, M.lo2); x = cex<0xB1>(x, M.lo1);
    x = cex<0x140>(x, M.lo8); x = cex4(x, M.lo4); x = cex<0x4E>(x, M.lo2); x = cex<0xB1>(x, M.lo1);
    return x;
}
__device__ __forceinline__ unsigned clean16_desc(unsigned x, const LoMasks& M) {
    x = cex<0x128>(x, M.lo8); x = cex4(x, M.lo4); x = cex<0x4E>(x, M.lo2); x = cex<0xB1>(x, M.lo1); return x;
}
__device__ __forceinline__ unsigned mtop_regs(unsigned a, unsigned b) { return max(a, dppm<0x140>(b)); }
__device__ __forceinline__ unsigned mtop_rows(unsigned y, const LoMasks& M) { const auto r = __builtin_amdgcn_permlane16_swap(y, y, false, false); const unsigned pv = M.odd16 ? r[0] : r[1]; return mtop_regs(y, pv); }
__device__ __forceinline__ unsigned mtop_halves(unsigned y, const LoMasks& M) { const auto r = __builtin_amdgcn_permlane32_swap(y, y, false, false); const unsigned pv = M.up32 ? r[0] : r[1]; return mtop_regs(y, pv); }

template <int OFF, int N, int MASKX, int TOT> __device__ __forceinline__ void ce_stage(unsigned (&k)[TOT]) {
#pragma unroll
    for (int i = 0; i < N; ++i) { const int pr = i ^ MASKX; if (pr > i) { const unsigned a_ = k[OFF + i], b_ = k[OFF + pr]; k[OFF + i] = max(a_, b_); k[OFF + pr] = min(a_, b_); } }
}
template <int OFF, int TOT> __device__ __forceinline__ void sort16_regs(unsigned (&k)[TOT]) {
    ce_stage<OFF, 16, 1>(k); ce_stage<OFF, 16, 3>(k); ce_stage<OFF, 16, 1>(k); ce_stage<OFF, 16, 7>(k); ce_stage<OFF, 16, 2>(k); ce_stage<OFF, 16, 1>(k);
    ce_stage<OFF, 16, 15>(k); ce_stage<OFF, 16, 4>(k); ce_stage<OFF, 16, 2>(k); ce_stage<OFF, 16, 1>(k);
}
template <int TOT> __device__ __forceinline__ void clean16_regs(unsigned (&k)[TOT]) { ce_stage<0, 16, 8>(k); ce_stage<0, 16, 4>(k); ce_stage<0, 16, 2>(k); ce_stage<0, 16, 1>(k); }

__device__ __forceinline__ void ph_peer_select(const Args& A, Frame& F, const int L) {
    const bf16* QP = (const bf16*)(A.ws + WS_Z); const bf16* SKB = (const bf16*)(A.ws + WS_SKB) + (size_t)L * 262144;
    int* EID = (int*)(A.ws + WS_LA); float* GSM = (float*)(A.ws + WS_LA + 16 * MiB);
    LAS unsigned char* SKL = F.lds;
    LAS float* SCO = (LAS float*)(F.lds + 69632 + 4096);
    for (int it = F.bx; it < 4096; it += F.G) {
        const int tile = it >> 3, h = it & 7;
        __syncthreads();
        for (int c = F.tid; c < 4096; c += NTHREADS) { const int p = c >> 11, n = (c >> 4) & 127, cc = c & 15;
            *(LAS u32x4*)(SKL + (p * 128 + n) * 272 + cc * 16) = *(const u32x4*)(SKB + ((size_t)((p * 8 + h) * 128 + n)) * 128 + cc * 8); }
        __syncthreads();
        {
            const int p = F.wave >> 2, mt = F.wave & 3, g = F.lane >> 4, l15 = F.lane & 15;
            const bf16* qrow = QP + (size_t)(tile * 64 + mt * 16 + l15) * DM + h * 256 + p * 128 + 8 * g;
            bf16x8 afr[4];
#pragma unroll
            for (int ks = 0; ks < 4; ++ks) afr[ks] = *(const bf16x8*)(qrow + 32 * ks);
#pragma unroll
            for (int nt = 0; nt < 8; ++nt) {
                f32x4 acc = {0.f, 0.f, 0.f, 0.f};
#pragma unroll
                for (int ks = 0; ks < 4; ++ks) { const bf16x8 bfr = *(const LAS bf16x8*)(SKL + (p * 128 + nt * 16 + l15) * 272 + (32 * ks + 8 * g) * 2);
                    acc = __builtin_amdgcn_mfma_f32_16x16x32_bf16(afr[ks], bfr, acc, 0, 0, 0); }
#pragma unroll
                for (int rg = 0; rg < 4; ++rg) SCO[(p * 64 + mt * 16 + 4 * g + rg) * 132 + nt * 16 + l15] = acc[rg];
            }
        }
        __syncthreads();
        constexpr int NT = 4;
        LAS unsigned char* WB = F.lds + 141312 + F.wave * 2048;
        LoMasks M; M.lo1 = (F.lane & 1) == 0; M.lo2 = (F.lane & 2) == 0; M.lo4 = (F.lane & 4) == 0; M.lo8 = (F.lane & 8) == 0; M.odd16 = (F.lane & 16) != 0; M.up32 = (F.lane & 32) != 0;
        int pi_, pj_;
        { const int L = F.lane;
          if (L < 16) { pi_ = 0; pj_ = L; } else if (L < 24) { pi_ = 1; pj_ = L - 16; } else if (L < 29) { pi_ = 2; pj_ = L - 24; } else if (L < 33) { pi_ = 3; pj_ = L - 29; }
          else if (L < 36) { pi_ = 4; pj_ = L - 33; } else if (L < 42) { pi_ = 5 + ((L - 36) >> 1); pj_ = (L - 36) & 1; } else { pi_ = 8 + (L - 42); pj_ = 0; }
          if (L >= 50) { pi_ = 0; pj_ = 0; } }
        const bool pvalid = F.lane < 50;
        {
            const int g = F.lane >> 2, q = F.lane & 3, tok = g >> 1, sp = g & 1;
            const LAS float* srow = SCO + (sp * 64 + F.wave * 8 + tok) * 132;
            unsigned k[32]; const unsigned ib = (unsigned)(127 - q * 32);
#pragma unroll
            for (int c = 0; c < 8; ++c) { const f32x4 v = *(const LAS f32x4*)(srow + q * 32 + 4 * c);
#pragma unroll
                for (int e = 0; e < 4; ++e) k[4 * c + e] = (fixkey20(v[e]) << 7) | (ib - (unsigned)(4 * c + e)); }
            sort16_regs<0>(k); sort16_regs<16>(k);
            unsigned m[16], t2[16];
#pragma unroll
            for (int i = 0; i < 16; ++i) m[i] = max(k[i], k[31 - i]);
            clean16_regs(m);
#pragma unroll
            for (int i = 0; i < 16; ++i) t2[i] = max(m[i], dppm<0xB1>(m[15 - i]));
            clean16_regs(t2);
#pragma unroll
            for (int i = 0; i < 16; ++i) m[i] = max(t2[i], dppm<0x4E>(t2[15 - i]));
            clean16_regs(m);
            float vals[16]; int idxs[16];
#pragma unroll
            for (int e = 0; e < 16; ++e) { idxs[e] = 127 - (int)(m[e] & 127u); vals[e] = srow[idxs[e]]; }
            if (q == 0) { LAS float* tvp = (LAS float*)(WB + tok * 256) + sp * 16; LAS int* tip = (LAS int*)(WB + tok * 256 + 128) + sp * 16;
#pragma unroll
                for (int c = 0; c < 4; ++c) { *(LAS f32x4*)(tvp + 4 * c) = (f32x4){vals[4 * c], vals[4 * c + 1], vals[4 * c + 2], vals[4 * c + 3]};
                    *(LAS u32x4*)(tip + 4 * c) = (u32x4){(unsigned)idxs[4 * c], (unsigned)idxs[4 * c + 1], (unsigned)idxs[4 * c + 2], (unsigned)idxs[4 * c + 3]}; } }
        }
        asm volatile("s_waitcnt lgkmcnt(0)" ::: "memory"); __builtin_amdgcn_wave_barrier();
#pragma unroll 1
        for (int tk0 = 0; tk0 < 8; tk0 += NT) {
            unsigned z[NT];
#pragma unroll
            for (int u = 0; u < NT; ++u) { const LAS float* tv = (const LAS float*)(WB + (tk0 + u) * 256); const float cvl = tv[pi_] + tv[16 + pj_];
                z[u] = pvalid ? ((fixkey20(cvl * 0.5f) << 8) | (unsigned)(255 - (pi_ * 16 + pj_))) : 0u; }
#define ALL4(EXPR) _Pragma("unroll") for (int u = 0; u < NT; ++u) { const unsigned X = z[u]; z[u] = (EXPR); }
#define CLEAN4() ALL4(cex<0x128>(X, M.lo8)) ALL4(cex4(X, M.lo4)) ALL4(cex<0x4E>(X, M.lo2)) ALL4(cex<0xB1>(X, M.lo1))
            ALL4(cex<0xB1>(X, M.lo1))
            ALL4(cex<0x1B>(X, M.lo2)) ALL4(cex<0xB1>(X, M.lo1))
            ALL4(cex<0x141>(X, M.lo4)) ALL4(cex<0x4E>(X, M.lo2)) ALL4(cex<0xB1>(X, M.lo1))
            ALL4(cex<0x140>(X, M.lo8)) ALL4(cex4(X, M.lo4)) ALL4(cex<0x4E>(X, M.lo2)) ALL4(cex<0xB1>(X, M.lo1))
            ALL4(mtop_rows(X, M)) CLEAN4()
            ALL4(mtop_halves(X, M)) CLEAN4()
#undef ALL4
#undef CLEAN4
#pragma unroll
            for (int u = 0; u < NT; ++u) { const int t = tile * 64 + F.wave * 8 + tk0 + u;
                const LAS float* tv = (const LAS float*)(WB + (tk0 + u) * 256); const LAS int* ti = (const LAS int*)(WB + (tk0 + u) * 256 + 128);
                const int cid = 255 - (int)(z[u] & 255u), bi = (F.lane < 16) ? (cid >> 4) : 0, bj = (F.lane < 16) ? (cid & 15) : 0;
                const float bv = (F.lane < 16) ? (tv[bi] + tv[16 + bj]) : -INFINITY;
                const float mx = wmax(bv); const float ev = (F.lane < 16) ? expf(bv - mx) : 0.f; const float den = wsum(ev);
                if (F.lane < 16) { const int e1 = ti[bi], e2 = ti[16 + bj];
                    EID[(size_t)t * 128 + h * 16 + F.lane] = e1 * 128 + e2; GSM[(size_t)t * 128 + h * 16 + F.lane] = ev / den; } }
            asm volatile("s_waitcnt lgkmcnt(0)" ::: "memory"); __builtin_amdgcn_wave_barrier();
        }
    }
}

constexpr int PGB = 4;
__device__ __forceinline__ void ph_peer_gather(const Args& A, Frame& F, const int L, const bool dry = false) {
    bf16* H = (bf16*)(A.ws + WS_HY); bf16* Hout = dry ? (bf16*)(A.ws + WS_BIG + 128 * MiB) : H; float* Xout = dry ? (float*)(A.ws + WS_Z) : A.out; const unsigned char* TU = A.ws + WS_BIG; const unsigned char* TV = TU + (size_t)16384 * 2048; const float* SCL = (const float*)(A.ws + WS_BIG + 64 * MiB);
    const int* EID = (const int*)(A.ws + WS_LA); const float* GSM = (const float*)(A.ws + WS_LA + 16 * MiB);
    const float* MOD = (const float*)(A.ws + WS_MOD); float* X = A.out;
    const float* lng = (const float*)A.in[21] + (size_t)(L * 2 + 1) * DM; const float* lnb = (const float*)A.in[22] + (size_t)(L * 2 + 1) * DM;
    for (int t = F.gw; t < TOK; t += F.ngw) {
        const int b = t >> 14;
        f32x2 h2[16];
#pragma unroll
        for (int j = 0; j < 2; ++j) { const u32x4 a = *(const u32x4*)(H + (size_t)t * DM + (j * 64 + F.lane) * 16), c = *(const u32x4*)(H + (size_t)t * DM + (j * 64 + F.lane) * 16 + 8);
            const unsigned aw[8] = {a.x, a.y, a.z, a.w, c.x, c.y, c.z, c.w};
#pragma unroll
            for (int q = 0; q < 8; ++q) h2[j * 8 + q] = (f32x2){lo2f(aw[q]), hi2f(aw[q])}; }
        f32x2 o2[16];
#pragma unroll
        for (int e = 0; e < 16; ++e) o2[e] = (f32x2){0.f, 0.f};
#pragma unroll 1
        for (int e0 = 0; e0 < 128; e0 += PGB) {
            int eid[PGB]; float gw[PGB], su[PGB], sv[PGB];
#pragma unroll
            for (int q = 0; q < PGB; ++q) { eid[q] = __builtin_amdgcn_readfirstlane(EID[(size_t)t * 128 + e0 + q]); gw[q] = GSM[(size_t)t * 128 + e0 + q]; su[q] = SCL[eid[q]]; sv[q] = SCL[16384 + eid[q]]; }
            u32x4 uu[PGB][2], vv[PGB][2];
#pragma unroll
            for (int q = 0; q < PGB; ++q)
#pragma unroll
                for (int j = 0; j < 2; ++j) { uu[q][j] = *(const u32x4*)(TU + (size_t)eid[q] * 2048 + (j * 64 + F.lane) * 16); vv[q][j] = *(const u32x4*)(TV + (size_t)eid[q] * 2048 + (j * 64 + F.lane) * 16); }
#pragma unroll
            for (int q = 0; q < PGB; ++q) {
                f32x2 d2 = {0.f, 0.f};
#pragma unroll
                for (int j = 0; j < 2; ++j) { const unsigned w[4] = {uu[q][j].x, uu[q][j].y, uu[q][j].z, uu[q][j].w};
#pragma unroll
                    for (int i = 0; i < 4; ++i) { const f32x2 lo = __builtin_amdgcn_cvt_pk_f32_fp8((int)w[i], false), hi = __builtin_amdgcn_cvt_pk_f32_fp8((int)w[i], true);
                        d2 = lo * h2[j * 8 + 2 * i] + d2; d2 = hi * h2[j * 8 + 2 * i + 1] + d2; } }
                const float d = wsum(d2.x + d2.y) * su[q];
                const float act = 0.5f * d * (1.0f + erff(d * 0.70710678f)) * gw[q] * sv[q];
                const f32x2 a2 = {act, act};
#pragma unroll
                for (int j = 0; j < 2; ++j) { const unsigned w[4] = {vv[q][j].x, vv[q][j].y, vv[q][j].z, vv[q][j].w};
#pragma unroll
                    for (int i = 0; i < 4; ++i) { const f32x2 lo = __builtin_amdgcn_cvt_pk_f32_fp8((int)w[i], false), hi = __builtin_amdgcn_cvt_pk_f32_fp8((int)w[i], true);
                        o2[j * 8 + 2 * i] = a2 * lo + o2[j * 8 + 2 * i]; o2[j * 8 + 2 * i + 1] = a2 * hi + o2[j * 8 + 2 * i + 1]; } }
            }
        }
        float out[32];
#pragma unroll
        for (int e = 0; e < 16; ++e) { out[2 * e] = o2[e].x; out[2 * e + 1] = o2[e].y; }
        const float* gate = MOD + (size_t)((L * 2 + 1) * 2 + b) * 6144 + 4096;
        float sum = 0.f;
#pragma unroll
        for (int j = 0; j < 2; ++j)
#pragma unroll
            for (int c = 0; c < 4; ++c) { const int base = (j * 64 + F.lane) * 16 + 4 * c;
                const f32x4 x0 = *(const f32x4*)(X + (size_t)t * DM + base), g0 = *(const f32x4*)(gate + base);
#pragma unroll
                for (int e = 0; e < 4; ++e) { const float v = ALPHA * x0[e] + (1.0f + g0[e]) * out[j * 16 + 4 * c + e]; out[j * 16 + 4 * c + e] = v; sum += v; } }
        const float mean = wsum(sum) * (1.0f / DM); float sq = 0.f;
#pragma unroll
        for (int e = 0; e < 32; ++e) { out[e] -= mean; sq += out[e] * out[e]; }
        const float rstd = rsqrtf(wsum(sq) * (1.0f / DM) + 1e-5f);
        const float* sh = MOD + (size_t)(((L + 1) * 2 + 0) * 2 + b) * 6144; const float* sc = sh + 2048;
#pragma unroll
        for (int j = 0; j < 2; ++j) {
            float hq[16];
#pragma unroll
            for (int c = 0; c < 4; ++c) { const int base = (j * 64 + F.lane) * 16 + 4 * c;
                const f32x4 lg0 = *(const f32x4*)(lng + base), lb0 = *(const f32x4*)(lnb + base);
                f32x4 o0;
#pragma unroll
                for (int e = 0; e < 4; ++e) o0[e] = out[j * 16 + 4 * c + e] * rstd * lg0[e] + lb0[e];
                *(f32x4*)(Xout + (size_t)t * DM + base) = o0;
                if (L == 0) { const f32x4 s0 = *(const f32x4*)(sc + base), h0 = *(const f32x4*)(sh + base);
#pragma unroll
                    for (int e = 0; e < 4; ++e) hq[4 * c + e] = o0[e] * (1.0f + s0[e]) + h0[e]; } }
            if (L == 0) { u32x4 w0, w1;
                w0.x = pk2(hq[0], hq[1]); w0.y = pk2(hq[2], hq[3]); w0.z = pk2(hq[4], hq[5]); w0.w = pk2(hq[6], hq[7]);
                w1.x = pk2(hq[8], hq[9]); w1.y = pk2(hq[10], hq[11]); w1.z = pk2(hq[12], hq[13]); w1.w = pk2(hq[14], hq[15]);
                *(u32x4*)(Hout + (size_t)t * DM + (j * 64 + F.lane) * 16) = w0; *(u32x4*)(Hout + (size_t)t * DM + (j * 64 + F.lane) * 16 + 8) = w1; }
        }
    }
}

struct XInfo { int rank, nloc, rx, nx; };
__device__ __forceinline__ XInfo xcc_info(volatile LAS unsigned* MISC) { XInfo x; x.rank = (int)MISC[16]; x.nloc = (int)MISC[17]; x.rx = (int)MISC[18]; x.nx = (int)MISC[19]; return x; }
constexpr size_t WS_DP = WS_BIG + 128 * MiB;
constexpr size_t WS_ACT = WS_BIG + 80 * MiB;
__device__ __forceinline__ void ph_peer_u(const Args& A, Frame& F, const XInfo X) {
    const unsigned char* H8 = A.ws + WS_H8; const unsigned char* TU = A.ws + WS_BIG; const int* EID = (const int*)(A.ws + WS_LA); float* DP = (float*)(A.ws + WS_DP);
    LAS int* IDX = (LAS int*)(F.lds + F.wave * 1024);
    const int g16 = F.lane >> 4, c16 = F.lane & 15; const int step = X.nloc * NWAVES;
    for (int s = X.rx; s < 8; s += X.nx) {
        int t = X.rank * NWAVES + F.wave;
        int e0 = 0, e1 = 0; u32x4 ha = {0u, 0u, 0u, 0u};
        if (t < TOK) { e0 = EID[(size_t)t * 128 + F.lane]; e1 = EID[(size_t)t * 128 + 64 + F.lane]; ha = *(const u32x4*)(H8 + (size_t)t * DM + 256 * s + 16 * c16); }
        const unsigned char* ub = TU + 256 * s + 16 * c16;
        while (t < TOK) {
            const int tn = t + step; int n0 = 0, n1 = 0; u32x4 na = {0u, 0u, 0u, 0u};
            if (tn < TOK) { n0 = EID[(size_t)tn * 128 + F.lane]; n1 = EID[(size_t)tn * 128 + 64 + F.lane]; na = *(const u32x4*)(H8 + (size_t)tn * DM + 256 * s + 16 * c16); }
            IDX[F.lane] = e0; IDX[F.lane + 64] = e1;
            asm volatile("s_waitcnt lgkmcnt(0)" ::: "memory"); __builtin_amdgcn_wave_barrier();
            float keep0 = 0.f, keep1 = 0.f;
#pragma unroll
            for (int i0 = 0; i0 < 32; i0 += 8) {
                u32x4 ud[8];
#pragma unroll
                for (int u = 0; u < 8; ++u) { const int eid = IDX[4 * (i0 + u) + g16]; ud[u] = *(const u32x4*)(ub + (size_t)eid * 2048); }
#pragma unroll
                for (int u = 0; u < 8; ++u) {
                    int di = __builtin_amdgcn_sdot4((int)ud[u].x, (int)ha.x, 0, false); di = __builtin_amdgcn_sdot4((int)ud[u].y, (int)ha.y, di, false);
                    di = __builtin_amdgcn_sdot4((int)ud[u].z, (int)ha.z, di, false); di = __builtin_amdgcn_sdot4((int)ud[u].w, (int)ha.w, di, false);
                    const float d = sum16_dpp((float)di);
                    const int i = i0 + u;
                    if (i < 16) keep0 = ((i & 15) == c16) ? d : keep0; else keep1 = ((i & 15) == c16) ? d : keep1;
                }
            }
            float* dp = DP + ((size_t)s * TOK + t) * 128 + 4 * c16 + g16;
            dp[0] = keep0; dp[64] = keep1;
            asm volatile("s_waitcnt lgkmcnt(0)" ::: "memory"); __builtin_amdgcn_wave_barrier();
            e0 = n0; e1 = n1; ha = na; t = tn;
        }
    }
}
__device__ __forceinline__ void ph_peer_act(const Args& A, Frame& F) {
    const float* SCL = (const float*)(A.ws + WS_BIG + 64 * MiB); const int* EID = (const int*)(A.ws + WS_LA); const float* GSM = (const float*)(A.ws + WS_LA + 16 * MiB);
    const float* DP = (const float*)(A.ws + WS_DP); unsigned char* ACT8 = A.ws + WS_ACT; float* AS = (float*)(A.ws + WS_ACT + 8 * MiB);
    for (int t = F.gw; t < TOK; t += F.ngw) { const float hs = ((const float*)(A.ws + WS_HS))[t];
        float a[2];
#pragma unroll
        for (int m = 0; m < 2; ++m) { const int e = F.lane + 64 * m; const int eid = EID[(size_t)t * 128 + e]; float d = 0.f;
#pragma unroll
            for (int x = 0; x < 8; ++x) d += DP[((size_t)x * TOK + t) * 128 + e];
            d *= SCL[eid] * hs;
            a[m] = 0.5f * d * (1.0f + erff(d * 0.70710678f)) * GSM[(size_t)t * 128 + e] * SCL[16384 + eid]; }
        const float amax = wmax(fmaxf(fabsf(a[0]), fabsf(a[1]))); const float inv = (amax > 0.f) ? 127.0f / amax : 0.f;
#pragma unroll
        for (int m = 0; m < 2; ++m) ACT8[(size_t)t * 128 + F.lane + 64 * m] = (unsigned char)(__float_as_uint(a[m] * inv + 12582912.0f) & 255u);
        if (F.lane == 0) AS[t] = amax * (1.0f / 127.0f);
    }
}
__device__ __forceinline__ void ph_peer_v(const Args& A, Frame& F, const XInfo X) {
    const unsigned char* TV = A.ws + WS_BIG + (size_t)16384 * 2048;
    const int* EID = (const int*)(A.ws + WS_LA); const unsigned* ACT8 = (const unsigned*)(A.ws + WS_ACT); const float* AS = (const float*)(A.ws + WS_ACT + 8 * MiB); bf16* OUT = (bf16*)(A.ws + WS_Z);
    LAS int* IDX = (LAS int*)(F.lds + F.wave * 1024); LAS unsigned* ACT = (LAS unsigned*)(F.lds + F.wave * 1024 + 512);
    const int g16 = F.lane >> 4, c16 = F.lane & 15; const int step = X.nloc * NWAVES;
    for (int s = X.rx; s < 8; s += X.nx) {
        int t = X.rank * NWAVES + F.wave;
        int e0 = 0, e1 = 0; unsigned a0 = 0u;
        if (t < TOK) { e0 = EID[(size_t)t * 128 + F.lane]; e1 = EID[(size_t)t * 128 + 64 + F.lane]; a0 = ACT8[(size_t)t * 32 + (F.lane & 31)]; }
        const unsigned char* vb = TV + 256 * s + 16 * c16;
        while (t < TOK) {
            const int tn = t + step; int n0 = 0, n1 = 0; unsigned b0 = 0u;
            if (tn < TOK) { n0 = EID[(size_t)tn * 128 + F.lane]; n1 = EID[(size_t)tn * 128 + 64 + F.lane]; b0 = ACT8[(size_t)tn * 32 + (F.lane & 31)]; }
            const float as = AS[t];
            IDX[F.lane] = e0; IDX[F.lane + 64] = e1; if (F.lane < 32) ACT[F.lane] = a0;
            asm volatile("s_waitcnt lgkmcnt(0)" ::: "memory"); __builtin_amdgcn_wave_barrier();
            int acc[16];
#pragma unroll
            for (int j = 0; j < 16; ++j) acc[j] = 0;
#pragma unroll
            for (int b = 0; b < 8; b += 2) {
                u32x4 vd[2][4]; unsigned a4[2];
#pragma unroll
                for (int h = 0; h < 2; ++h) { a4[h] = ACT[4 * (b + h) + g16];
#pragma unroll
                    for (int u = 0; u < 4; ++u) { const int eid = IDX[16 * (b + h) + 4 * g16 + u]; vd[h][u] = *(const u32x4*)(vb + (size_t)eid * 2048); } }
#pragma unroll
                for (int h = 0; h < 2; ++h)
#pragma unroll
                    for (int q = 0; q < 4; ++q) { const unsigned A_ = vd[h][0][q], B_ = vd[h][1][q], C_ = vd[h][2][q], D_ = vd[h][3][q];
                        const unsigned ablo = __builtin_amdgcn_perm(B_, A_, 0x05010400u), abhi = __builtin_amdgcn_perm(B_, A_, 0x07030602u);
                        const unsigned cdlo = __builtin_amdgcn_perm(D_, C_, 0x05010400u), cdhi = __builtin_amdgcn_perm(D_, C_, 0x07030602u);
                        acc[4 * q + 0] = __builtin_amdgcn_sdot4((int)__builtin_amdgcn_perm(cdlo, ablo, 0x05040100u), (int)a4[h], acc[4 * q + 0], false);
                        acc[4 * q + 1] = __builtin_amdgcn_sdot4((int)__builtin_amdgcn_perm(cdlo, ablo, 0x07060302u), (int)a4[h], acc[4 * q + 1], false);
                        acc[4 * q + 2] = __builtin_amdgcn_sdot4((int)__builtin_amdgcn_perm(cdhi, abhi, 0x05040100u), (int)a4[h], acc[4 * q + 2], false);
                        acc[4 * q + 3] = __builtin_amdgcn_sdot4((int)__builtin_amdgcn_perm(cdhi, abhi, 0x07060302u), (int)a4[h], acc[4 * q + 3], false); }
            }
            { const float r0 = rsum4((float)acc[0], (float)acc[4], (float)acc[8], (float)acc[12]) * as, r1 = rsum4((float)acc[1], (float)acc[5], (float)acc[9], (float)acc[13]) * as;
              const float r2 = rsum4((float)acc[2], (float)acc[6], (float)acc[10], (float)acc[14]) * as, r3 = rsum4((float)acc[3], (float)acc[7], (float)acc[11], (float)acc[15]) * as;
              u32x2 w; w.x = pk2(r0, r1); w.y = pk2(r2, r3); *(u32x2*)(OUT + (size_t)t * DM + 256 * s + 16 * c16 + 4 * g16) = w; }
            asm volatile("s_waitcnt lgkmcnt(0)" ::: "memory"); __builtin_amdgcn_wave_barrier();
            e0 = n0; e1 = n1; a0 = b0; t = tn;
        }
    }
}
__device__ __forceinline__ void ph_peer_ln(const Args& A, Frame& F, const int L) {
    const bf16* OUT = (const bf16*)(A.ws + WS_Z); float* X = A.out; bf16* H = (bf16*)(A.ws + WS_HY); const float* MOD = (const float*)(A.ws + WS_MOD);
    const bf16* Xin = (L == 0) ? (const bf16*)A.out : (const bf16*)(A.ws + WS_Z + 160 * MiB); bf16* Xb = (bf16*)A.out;
    const float* lng = (const float*)A.in[21] + (size_t)(L * 2 + 1) * DM; const float* lnb = (const float*)A.in[22] + (size_t)(L * 2 + 1) * DM;
    for (int t = F.gw; t < TOK; t += F.ngw) {
        const int b = t >> 14;
        const float* gate = MOD + (size_t)((L * 2 + 1) * 2 + b) * 6144 + 4096;
        const float* sh = MOD + (size_t)(((L + 1) * 2 + 0) * 2 + b) * 6144; const float* sc = sh + 2048;
        float v[32]; float sum = 0.f;
#pragma unroll
        for (int j = 0; j < 8; ++j) { const int base = (j * 64 + F.lane) * 4;
            const u32x2 ow = *(const u32x2*)(OUT + (size_t)t * DM + base); const f32x4 o0 = {lo2f(ow.x), hi2f(ow.x), lo2f(ow.y), hi2f(ow.y)};
            const u32x2 xw = *(const u32x2*)(Xin + (size_t)t * DM + base); const f32x4 x0 = {lo2f(xw.x), hi2f(xw.x), lo2f(xw.y), hi2f(xw.y)}; const f32x4 g0 = *(const f32x4*)(gate + base);
#pragma unroll
            for (int e = 0; e < 4; ++e) { v[j * 4 + e] = ALPHA * x0[e] + (1.0f + g0[e]) * o0[e]; sum += v[j * 4 + e]; } }
        const float mean = wsum(sum) * (1.0f / DM); float sq = 0.f;
#pragma unroll
        for (int e = 0; e < 32; ++e) { v[e] -= mean; sq += v[e] * v[e]; }
        const float rstd = rsqrtf(wsum(sq) * (1.0f / DM) + 1e-5f);
#pragma unroll
        for (int j = 0; j < 8; ++j) { const int base = (j * 64 + F.lane) * 4;
            const f32x4 lg0 = *(const f32x4*)(lng + base), lb0 = *(const f32x4*)(lnb + base);
            f32x4 o0;
#pragma unroll
            for (int e = 0; e < 4; ++e) o0[e] = v[j * 4 + e] * rstd * lg0[e] + lb0[e];
            if (L == 0) { u32x2 xo; xo.x = pk2(o0[0], o0[1]); xo.y = pk2(o0[2], o0[3]); *(u32x2*)(Xb + (size_t)t * DM + base) = xo; } else *(f32x4*)(X + (size_t)t * DM + base) = o0;
            if (L == 0) { const f32x4 s0 = *(const f32x4*)(sc + base), h0 = *(const f32x4*)(sh + base); const f32x4 q0 = o0 * (1.0f + s0) + h0;
                u32x2 w; w.x = pk2(q0[0], q0[1]); w.y = pk2(q0[2], q0[3]); *(u32x2*)(H + (size_t)t * DM + base) = w; }
        }
    }
}

__device__ __forceinline__ void ph_odd_post(const Args& A, Frame& F) {
    bf16* Z = (bf16*)(A.ws + WS_Z); const int* positions = (const int*)A.in[2]; bf16* KIT = (bf16*)(A.ws + WS_BIG + 256 * MiB); unsigned char* K8 = A.ws + WS_BIG + 264 * MiB; unsigned char* V8 = A.ws + WS_BIG + 280 * MiB;
    const float inv128 = powf(10000.0f, -(float)F.lane / 64.0f); const int i32 = F.lane & 31; const float inv64 = powf(10000.0f, -(float)i32 / 32.0f);
    const int a16 = F.lane & 15, hs4 = F.lane >> 4, a8 = F.lane & 7, hs8 = F.lane >> 3;
    for (int t = F.gw; t < TOK; t += F.ngw) {
        bf16* zr = Z + (size_t)t * OD_NP; const float pos = (float)positions[t];
        const int bb = t >> 14, spos = t & (SEQ - 1);
        float sn, cs; sincosf(pos * inv128, &sn, &cs);
        float c4[4], s4[4];
#pragma unroll
        for (int e = 0; e < 4; ++e) { c4[e] = __shfl(cs, 4 * a16 + e); s4[e] = __shfl(sn, 4 * a16 + e); }
#pragma unroll
        for (int it = 0; it < 5; ++it) { const int hd = it * 4 + hs4; bf16* hp = zr + hd * 128 + 4 * a16;
            const u32x2 a = *(const u32x2*)hp, b = *(const u32x2*)(hp + 64);
            const float t1[4] = {lo2f(a.x), hi2f(a.x), lo2f(a.y), hi2f(a.y)}, t2[4] = {lo2f(b.x), hi2f(b.x), lo2f(b.y), hi2f(b.y)};
            float o1[4], o2[4];
#pragma unroll
            for (int e = 0; e < 4; ++e) { o1[e] = t1[e] * c4[e] - t2[e] * s4[e]; o2[e] = t2[e] * c4[e] + t1[e] * s4[e]; }
            *(u32x2*)hp = (u32x2){pk2(o1[0], o1[1]), pk2(o1[2], o1[3])}; *(u32x2*)(hp + 64) = (u32x2){pk2(o2[0], o2[1]), pk2(o2[2], o2[3])};
            if (it == 4) { unsigned char* k8 = K8 + ((size_t)((bb * 4 + hs4) * SEQ + spos)) * 128 + 4 * a16;
                int w1 = __builtin_amdgcn_cvt_pk_fp8_f32(o1[0] * 16.0f, o1[1] * 16.0f, 0, false); w1 = __builtin_amdgcn_cvt_pk_fp8_f32(o1[2] * 16.0f, o1[3] * 16.0f, w1, true);
                int w2 = __builtin_amdgcn_cvt_pk_fp8_f32(o2[0] * 16.0f, o2[1] * 16.0f, 0, false); w2 = __builtin_amdgcn_cvt_pk_fp8_f32(o2[2] * 16.0f, o2[3] * 16.0f, w2, true);
                *(unsigned*)k8 = (unsigned)w1; *(unsigned*)(k8 + 64) = (unsigned)w2; } }
        {
            const int e0 = F.lane * 8, kvh = e0 >> 7, d0 = e0 & 127;
            const u32x4 vw = *(const u32x4*)(zr + 2560 + e0);
            const unsigned ww[4] = {vw.x, vw.y, vw.z, vw.w}; unsigned ob[2] = {0u, 0u};
#pragma unroll
            for (int q = 0; q < 4; ++q) { const float c0 = fminf(fmaxf(lo2f(ww[q]) * 16.0f, -127.0f), 127.0f), c1 = fminf(fmaxf(hi2f(ww[q]) * 16.0f, -127.0f), 127.0f);
                const unsigned b0 = __float_as_uint(c0 + 12583040.0f) & 255u, b1 = __float_as_uint(c1 + 12583040.0f) & 255u;
                ob[q >> 1] |= (b0 | (b1 << 8)) << (16 * (q & 1)); }
            *(u32x2*)(V8 + ((size_t)((bb * 4 + kvh) * SEQ + spos)) * 128 + d0) = (u32x2){ob[0], ob[1]};
        }
        sincosf(pos * inv64, &sn, &cs);
#pragma unroll
        for (int e = 0; e < 4; ++e) { c4[e] = __shfl(cs, 4 * a8 + e); s4[e] = __shfl(sn, 4 * a8 + e); }
#pragma unroll
        for (int it = 0; it < 3; ++it) { const int hd = it * 8 + hs8; if (hd < 17) { bf16* hp = zr + 3072 + hd * 64 + 4 * a8;
            const u32x2 a = *(const u32x2*)hp, b = *(const u32x2*)(hp + 32);
            const float t1[4] = {lo2f(a.x), hi2f(a.x), lo2f(a.y), hi2f(a.y)}, t2[4] = {lo2f(b.x), hi2f(b.x), lo2f(b.y), hi2f(b.y)};
            float o1[4], o2[4];
#pragma unroll
            for (int e = 0; e < 4; ++e) { o1[e] = t1[e] * c4[e] - t2[e] * s4[e]; o2[e] = t2[e] * c4[e] + t1[e] * s4[e]; }
            const u32x2 w1 = {pk2(o1[0], o1[1]), pk2(o1[2], o1[3])}, w2 = {pk2(o2[0], o2[1]), pk2(o2[2], o2[3])};
            *(u32x2*)hp = w1; *(u32x2*)(hp + 32) = w2;
            if (hd == 16) {
                const int tile = spos >> 5, rr = spos & 31;
                bf16* kt = KIT + ((size_t)(bb * 512 + tile) * 4) * 512;
                const int d1 = 4 * a8, d2 = 32 + 4 * a8;
                *(u32x2*)(kt + ((d1 >> 4) * 64 + rr + 32 * ((d1 >> 3) & 1)) * 8 + (d1 & 7)) = w1;
                *(u32x2*)(kt + ((d2 >> 4) * 64 + rr + 32 * ((d2 >> 3) & 1)) * 8 + (d2 & 7)) = w2;
            } } }
    }
}

template <int CTRL, int RM> __device__ __forceinline__ unsigned dppu(unsigned old, unsigned v) { return (unsigned)__builtin_amdgcn_update_dpp((int)old, (int)v, CTRL, RM, 0xF, false); }
__device__ __forceinline__ void ph_dsa_select(const Args& A, Frame& F, const int mode = 0) {
    const bf16* Z = (const bf16*)(A.ws + WS_Z); unsigned short* SEL = (unsigned short*)(A.ws + WS_LA); int* CNT = (int*)(A.ws + WS_CNT); const bf16* KIT = (const bf16*)(A.ws + WS_BIG + 256 * MiB);
    LAS unsigned short* SC = (LAS unsigned short*)F.lds;
    LAS unsigned* LST = (LAS unsigned*)(F.lds + 131072);
    LAS unsigned* hist = (LAS unsigned*)(F.lds + 131072 + 16384);
    LAS unsigned* hist1 = (LAS unsigned*)(F.lds + 152576);
    LAS unsigned* res = (LAS unsigned*)(F.lds + 131072 + 16384 + 2048);
    LAS int* wtot = (LAS int*)(F.lds + 131072 + 16384 + 2048 + 64);
    const int r = F.lane & 31, hg = F.lane >> 5, tk = (r >> 2) & 1, hh = (r & 3) + 4 * (r >> 3);
    const int grp = F.wave >> 2, ltid = F.tid & 255, lw = F.wave & 3;
    for (int qd = F.bx; qd < TOK / 4; qd += F.G) {
        const int t0 = 4 * qd, b = t0 >> 14, s0 = t0 & (SEQ - 1);
        const int nkeys = s0 + 4, ntiles = (nkeys + 31) >> 5;
        bf16x8 af[2][4]; f32x2 wv[2][8];
#pragma unroll
        for (int a = 0; a < 2; ++a) {
            const bf16* qrow = Z + (size_t)(t0 + 2 * a + tk) * OD_NP + 3072 + hh * 64 + 8 * hg;
#pragma unroll
            for (int s = 0; s < 4; ++s) af[a][s] = *(const bf16x8*)(qrow + 16 * s);
            const bf16* wrow = Z + (size_t)(t0 + 2 * a + hg) * OD_NP + 4160;
            const u32x4 w0 = *(const u32x4*)(wrow), w1 = *(const u32x4*)(wrow + 8);
            const unsigned ww[8] = {w0.x, w0.y, w0.z, w0.w, w1.x, w1.y, w1.z, w1.w};
#pragma unroll
            for (int q = 0; q < 8; ++q) wv[a][q] = (f32x2){lo2f(ww[q]) * 0.03125f, hi2f(ww[q]) * 0.03125f};
        }
        __syncthreads();
        const bf16* kbase = KIT + (size_t)b * 512 * 2048 + F.lane * 8;
        if (mode != 2) {
            bf16x8 bcur[2][4];
#define DSA_LOAD1(dst, q_, tb_) do { const int tile = ((tb_) + (q_) < ntiles) ? ((tb_) + (q_)) : (ntiles - 1); const bf16* krow = kbase + (size_t)tile * 2048; \
                _Pragma("unroll") for (int s_ = 0; s_ < 4; ++s_) dst[q_][s_] = *(const bf16x8*)(krow + 512 * s_); } while (0)
#define DSA_MM(accv, src, q_, a_) do { _Pragma("unroll") for (int e = 0; e < 16; ++e) accv[e] = 0.f; \
                _Pragma("unroll") for (int s_ = 0; s_ < 4; ++s_) accv = __builtin_amdgcn_mfma_f32_32x32x16_bf16(af[a_][s_], src[q_][s_], accv, 0, 0, 0); } while (0)
#define DSA_EPI(accv, tb_, q_, a_) do { f32x2 s2_ = {0.f, 0.f}; _Pragma("unroll") for (int e = 0; e < 8; ++e) { \
                    const float x0_ = accv[2 * e], x1_ = accv[2 * e + 1]; const int r0_ = __builtin_bit_cast(int, x0_), r1_ = __builtin_bit_cast(int, x1_);        \
                    const f32x2 rl_ = {__builtin_bit_cast(float, r0_ > 0 ? r0_ : 0), __builtin_bit_cast(float, r1_ > 0 ? r1_ : 0)}; s2_ = rl_ * wv[a_][e] + s2_; } \
                float sc_ = s2_.x + s2_.y; const int key = ((tb_) + (q_)) * 32 + r; sc_ = fminf(fmaxf(sc_, -7.999f), 7.999f); const unsigned fx = (unsigned)((int)rintf(sc_ * 4096.0f) + (1 << 15)); \
                if ((tb_) + (q_) < ntiles) SC[(2 * (a_) + hg) * 16384 + key] = (unsigned short)((key <= s0 + 2 * (a_) + hg) ? fx : 0u); } while (0)
            int tb = F.wave * 2;
            if (tb < ntiles) {
                DSA_LOAD1(bcur, 0, tb); DSA_LOAD1(bcur, 1, tb);
                for (; tb < ntiles; tb += NWAVES * 2) {
                    f32x16 accA, accB;
                    DSA_MM(accA, bcur, 0, 0); DSA_MM(accB, bcur, 0, 1);
                    DSA_LOAD1(bcur, 0, tb + NWAVES * 2);
                    DSA_EPI(accA, tb, 0, 0); DSA_MM(accA, bcur, 1, 0); DSA_EPI(accB, tb, 0, 1); DSA_MM(accB, bcur, 1, 1);
                    DSA_LOAD1(bcur, 1, tb + NWAVES * 2);
                    DSA_EPI(accA, tb, 1, 0); DSA_EPI(accB, tb, 1, 1);
                }
            }
#undef DSA_LOAD1
#undef DSA_MM
#undef DSA_EPI
        }
        __syncthreads();
        if (mode == 1) continue;
#pragma unroll 1
        for (int rd = 0; rd < 2; ++rd) {
        const int tok = 2 * rd + grp;
        const int n = s0 + tok + 1; unsigned k = (unsigned)(n < 256 ? n : 256); unsigned prefix = 0u;
        const LAS unsigned short* sc = SC + tok * 16384;
        hist[grp * 256 + ltid] = 0u; hist1[grp * 256 + ltid] = 0u;
        unsigned kreg[64];
#pragma unroll
        for (int j = 0; j < 64; ++j) { const int i = ltid + 256 * j; kreg[j] = (i < n) ? (unsigned)sc[i] : 0u; }
        unsigned lmax = 0u;
#pragma unroll
        for (int j = 0; j < 64; ++j) lmax = (kreg[j] > lmax) ? kreg[j] : lmax;
        unsigned wmin = lmax;
        { unsigned x_;
          x_ = dppu<0xB1, 0xF>(wmin, wmin); wmin = x_ < wmin ? x_ : wmin; x_ = dppu<0x4E, 0xF>(wmin, wmin); wmin = x_ < wmin ? x_ : wmin;
          x_ = dppu<0x141, 0xF>(wmin, wmin); wmin = x_ < wmin ? x_ : wmin; x_ = dppu<0x140, 0xF>(wmin, wmin); wmin = x_ < wmin ? x_ : wmin;
          x_ = dppu<0x142, 0xA>(wmin, wmin); wmin = x_ < wmin ? x_ : wmin; x_ = dppu<0x143, 0xC>(wmin, wmin); wmin = x_ < wmin ? x_ : wmin; }
        if (F.lane == 63) wtot[16 + F.wave] = (int)wmin;
        __syncthreads();
        unsigned lbound = 0xFFFFFFFFu;
#pragma unroll
        for (int w = 0; w < 4; ++w) { const unsigned x = (unsigned)wtot[16 + grp * 4 + w]; lbound = x < lbound ? x : lbound; }
        LAS unsigned* seg = LST + (grp * 4 + lw) * 512; int ccnt = 0;
        {
            const unsigned lb1 = lbound > 1u ? lbound : 1u;
#pragma unroll
            for (int j = 0; j < 64; ++j) { if (256 * j < n) { const bool c = kreg[j] >= lb1; const unsigned long long m = __ballot(c);
                const int pos = ccnt + (int)__builtin_amdgcn_mbcnt_hi((unsigned)(m >> 32), __builtin_amdgcn_mbcnt_lo((unsigned)m, 0u));
                if (c && pos < 512) seg[pos] = (kreg[j] << 16) | (unsigned)(ltid + 256 * j); ccnt += __popcll(m); } }
        }
        const bool fast = ccnt <= 512;
        asm volatile("s_waitcnt lgkmcnt(0)" ::: "memory"); __builtin_amdgcn_wave_barrier();
#pragma unroll 1
        for (int pass = 0; pass < 2; ++pass) {
            const int shift = 8 - 8 * pass;
            LAS unsigned* hs = (pass == 0 ? hist : hist1) + grp * 256;
            if (fast) {
#pragma unroll
                for (int i = 0; i < 8; ++i) { if (64 * i < ccnt) { const int c_ = F.lane + 64 * i; const bool valid = c_ < ccnt; const unsigned kv = valid ? (seg[c_] >> 16) : 0u;
                    const bool match = (pass == 0) ? true : ((kv >> 8) == prefix);
                    if (valid && match) (void)__hip_atomic_fetch_add(&hs[(kv >> shift) & 255u], 1u, __ATOMIC_RELAXED, __HIP_MEMORY_SCOPE_WORKGROUP); } }
            } else {
#pragma unroll
                for (int j = 0; j < 64; ++j) { if (256 * j < n) { const unsigned kv = kreg[j]; const bool valid = ((ltid + 256 * j) < n) && (kv >= lbound);
                    const bool match = (pass == 0) ? true : ((kv >> 8) == prefix);
                    if (valid && match) (void)__hip_atomic_fetch_add(&hs[(kv >> shift) & 255u], 1u, __ATOMIC_RELAXED, __HIP_MEMORY_SCOPE_WORKGROUP); } }
            }
            __syncthreads();
            if (lw == 0) {
                const unsigned c0 = hs[4 * F.lane], c1 = hs[4 * F.lane + 1], c2 = hs[4 * F.lane + 2], c3 = hs[4 * F.lane + 3];
                const unsigned tot = c0 + c1 + c2 + c3; unsigned pre = tot;
                pre += dppu<0x111, 0xF>(0u, pre); pre += dppu<0x112, 0xF>(0u, pre); pre += dppu<0x114, 0xF>(0u, pre); pre += dppu<0x118, 0xF>(0u, pre);
                pre += dppu<0x142, 0xA>(0u, pre); pre += dppu<0x143, 0xC>(0u, pre);
                const unsigned total = (unsigned)__builtin_amdgcn_readlane((int)pre, 63); const unsigned suf = total - pre + tot;
                unsigned above = suf - tot;
                if (above < k && k <= suf) {
                    int bin;
                    if (above + c3 >= k) { bin = 3; } else { above += c3; if (above + c2 >= k) { bin = 2; } else { above += c2; if (above + c1 >= k) { bin = 1; } else { above += c1; bin = 0; } } }
                    res[grp * 2 + 0] = (unsigned)(4 * F.lane + bin); res[grp * 2 + 1] = k - above;
                }
            }
            __syncthreads();
            prefix = (prefix << 8) | res[grp * 2 + 0]; k = res[grp * 2 + 1];
        }
        const unsigned tau = prefix; const int krem = (int)k;
#define MBCNT(m_) ((int)__builtin_amdgcn_mbcnt_hi((unsigned)((m_) >> 32), __builtin_amdgcn_mbcnt_lo((unsigned)(m_), 0u)))
        int cgW = 0, ceW = 0;
        if (fast) {
#pragma unroll
            for (int i = 0; i < 8; ++i) { if (64 * i < ccnt) { const int c_ = F.lane + 64 * i; const bool valid = c_ < ccnt; const unsigned kv = valid ? (seg[c_] >> 16) : 0u;
                cgW += __popcll(__ballot(valid && kv > tau)); ceW += __popcll(__ballot(valid && kv == tau)); } }
        } else {
#pragma unroll
            for (int j = 0; j < 64; ++j) { if (256 * j < n) { const bool valid = (ltid + 256 * j) < n; const unsigned kv = kreg[j];
                cgW += __popcll(__ballot(valid && kv > tau)); ceW += __popcll(__ballot(valid && kv == tau)); } }
        }
        if (F.lane == 0) { wtot[F.wave * 2] = cgW; wtot[F.wave * 2 + 1] = ceW; }
        __syncthreads();
        int og = 0, oe = 0, totg = 0;
        for (int w = 0; w < 4; ++w) { const int a = wtot[(grp * 4 + w) * 2], e = wtot[(grp * 4 + w) * 2 + 1]; if (w < lw) { og += a; oe += e; } totg += a; }
        LAS unsigned short* sel = (LAS unsigned short*)(F.lds + 151552) + grp * 256;
        if (fast) {
#pragma unroll
            for (int i = 0; i < 8; ++i) { if (64 * i < ccnt) { const int c_ = F.lane + 64 * i; const bool valid = c_ < ccnt; const unsigned pk = valid ? seg[c_] : 0u; const unsigned kv = pk >> 16;
                const bool gt = valid && kv > tau, eq = valid && kv == tau; const unsigned long long mg = __ballot(gt), me = __ballot(eq);
                const int pg = og + MBCNT(mg), pe = oe + MBCNT(me);
                if (gt) sel[pg] = (unsigned short)(pk & 0xffffu); else if (eq && pe < krem) sel[totg + pe] = (unsigned short)(pk & 0xffffu);
                og += __popcll(mg); oe += __popcll(me); } }
        } else {
#pragma unroll
            for (int j = 0; j < 64; ++j) { if (256 * j < n) { const int i = ltid + 256 * j; const bool valid = i < n; const unsigned kv = kreg[j];
                const bool gt = valid && kv > tau, eq = valid && kv == tau; const unsigned long long mg = __ballot(gt), me = __ballot(eq);
                const int pg = og + MBCNT(mg), pe = oe + MBCNT(me);
                if (gt) sel[pg] = (unsigned short)i; else if (eq && pe < krem) sel[totg + pe] = (unsigned short)i;
                og += __popcll(mg); oe += __popcll(me); } }
        }
#undef MBCNT
        if (ltid == 0) CNT[t0 + tok] = (n < 256 ? n : 256);
        __syncthreads();
        if (ltid < 128) { int lt2 = ltid; asm volatile("" : "+v"(lt2));
            ((unsigned*)SEL)[(size_t)(t0 + 2 * rd + grp) * 128 + lt2] = ((const LAS unsigned*)(F.lds + 151552))[grp * 128 + lt2]; }
        }
    }
}

__device__ __forceinline__ float sum8_dpp(float v) { v += dppf<0xB1, 0xF>(v); v += dppf<0x4E, 0xF>(v); v += dppf<0x141, 0xF>(v); return v; }
__device__ __forceinline__ void ph_dsa_attn(const Args& A, Frame& F, const XInfo X) {
    const bf16* Z = (const bf16*)(A.ws + WS_Z); const unsigned short* SEL = (const unsigned short*)(A.ws + WS_LA); const int* CNT = (const int*)(A.ws + WS_CNT);
    const unsigned char* K8 = A.ws + WS_BIG + 264 * MiB; const unsigned char* V8 = A.ws + WS_BIG + 280 * MiB; bf16* Y = (bf16*)(A.ws + WS_HY);
    LAS int* IDX = (LAS int*)(F.lds + F.wave * 5120);
    LAS float* SCR = (LAS float*)(F.lds + F.wave * 5120 + 1024);
    const int g8 = F.lane >> 3, c8 = F.lane & 7;
    for (int sl = X.rx; sl < 8; sl += X.nx) {
        const int b = sl >> 2, kvh = sl & 3;
        const unsigned char* kb = K8 + (size_t)sl * SEQ * 128 + 16 * c8; const unsigned char* vb = V8 + (size_t)sl * SEQ * 128 + 16 * c8;
        for (int sq = X.rank * NWAVES + F.wave; sq < SEQ; sq += X.nloc * NWAVES) {
            const int t = b * SEQ + sq; const int n = CNT[t];
            const int l15 = F.lane & 15, g4 = F.lane >> 4;
            long bq[4];
#pragma unroll
            for (int c = 0; c < 2; ++c) {
                float f[16];
#pragma unroll
                for (int e = 0; e < 16; ++e) f[e] = 0.f;
                if (l15 < 4) { const bf16* qp = Z + (size_t)t * OD_NP + (kvh * 4 + l15) * 128 + 64 * c + 16 * g4; const u32x4 a = *(const u32x4*)qp, b2 = *(const u32x4*)(qp + 8);
                    const unsigned aw[8] = {a.x, a.y, a.z, a.w, b2.x, b2.y, b2.z, b2.w};
#pragma unroll
                    for (int q = 0; q < 8; ++q) { f[2 * q] = lo2f(aw[q]) * 16.0f; f[2 * q + 1] = hi2f(aw[q]) * 16.0f; } }
#pragma unroll
                for (int hf = 0; hf < 2; ++hf) {
                    int lo = __builtin_amdgcn_cvt_pk_fp8_f32(f[8 * hf + 0], f[8 * hf + 1], 0, false); lo = __builtin_amdgcn_cvt_pk_fp8_f32(f[8 * hf + 2], f[8 * hf + 3], lo, true);
                    int hi = __builtin_amdgcn_cvt_pk_fp8_f32(f[8 * hf + 4], f[8 * hf + 5], 0, false); hi = __builtin_amdgcn_cvt_pk_fp8_f32(f[8 * hf + 6], f[8 * hf + 7], hi, true);
                    bq[2 * c + hf] = (long)(((unsigned long long)(unsigned)hi << 32) | (unsigned long long)(unsigned)lo); }
            }
#pragma unroll
            for (int m = 0; m < 4; ++m) { const int jj = F.lane + 64 * m; IDX[jj] = (jj < n) ? (int)SEL[(size_t)t * 256 + jj] : 0; }
            asm volatile("s_waitcnt lgkmcnt(0)" ::: "memory"); __builtin_amdgcn_wave_barrier();
            {
                const unsigned char* kq = K8 + (size_t)sl * SEQ * 128 + 16 * g4;
#pragma unroll 1
                for (int tl0 = 0; tl0 < 16; tl0 += 4) {
                    u32x4 k0[4], k1[4];
#pragma unroll
                    for (int u = 0; u < 4; ++u) { const int id = IDX[(tl0 + u) * 16 + l15]; const unsigned char* kr = kq + (size_t)id * 128; k0[u] = *(const u32x4*)kr; k1[u] = *(const u32x4*)(kr + 64); }
#pragma unroll
                    for (int u = 0; u < 4; ++u) {
                        f32x4 acc = {0.f, 0.f, 0.f, 0.f};
                        acc = __builtin_amdgcn_mfma_f32_16x16x32_fp8_fp8((long)(((unsigned long long)k0[u].y << 32) | k0[u].x), bq[0], acc, 0, 0, 0);
                        acc = __builtin_amdgcn_mfma_f32_16x16x32_fp8_fp8((long)(((unsigned long long)k0[u].w << 32) | k0[u].z), bq[1], acc, 0, 0, 0);
                        acc = __builtin_amdgcn_mfma_f32_16x16x32_fp8_fp8((long)(((unsigned long long)k1[u].y << 32) | k1[u].x), bq[2], acc, 0, 0, 0);
                        acc = __builtin_amdgcn_mfma_f32_16x16x32_fp8_fp8((long)(((unsigned long long)k1[u].w << 32) | k1[u].z), bq[3], acc, 0, 0, 0);
                        if (l15 < 4) {
#pragma unroll
                            for (int rg = 0; rg < 4; ++rg) SCR[((tl0 + u) * 16 + 4 * g4 + rg) * 4 + l15] = acc[rg] * 3.452669831e-4f; }
                    }
                }
            }
            asm volatile("s_waitcnt lgkmcnt(0)" ::: "memory"); __builtin_amdgcn_wave_barrier();
            float sclh[4], offh[4];
            {
                f32x4 sv[4]; unsigned pqb[4][4];
#pragma unroll
                for (int m = 0; m < 4; ++m) sv[m] = *(const LAS f32x4*)(SCR + (F.lane + 64 * m) * 4);
#pragma unroll
                for (int g = 0; g < 4; ++g) {
                    float mx = -INFINITY;
#pragma unroll
                    for (int m = 0; m < 4; ++m) { const bool val = (F.lane + 64 * m) < n; sv[m][g] = val ? sv[m][g] : -INFINITY; mx = fmaxf(mx, sv[m][g]); }
                    mx = wmax(mx); float sm = 0.f, sq = 0.f;
#pragma unroll
                    for (int m = 0; m < 4; ++m) { const bool val = (F.lane + 64 * m) < n; const float ex = val ? expf(sv[m][g] - mx) : 0.f; sm += ex;
                        const float pf = rintf(255.0f * ex); sq += pf; pqb[m][g] = (unsigned)pf; }
                    sclh[g] = 0.0625f / (255.0f * wsum(sm)); offh[g] = 128.0f * wsum(sq);
                }
                asm volatile("s_waitcnt lgkmcnt(0)" ::: "memory"); __builtin_amdgcn_wave_barrier();
#pragma unroll
                for (int m = 0; m < 4; ++m) { const int jj = F.lane + 64 * m;
#pragma unroll
                    for (int g = 0; g < 4; ++g) ((LAS unsigned char*)SCR)[(jj >> 2) * 16 + g * 4 + (jj & 3)] = (unsigned char)pqb[m][g]; }
            }
            asm volatile("s_waitcnt lgkmcnt(0)" ::: "memory"); __builtin_amdgcn_wave_barrier();
            unsigned acc[4][16];
#pragma unroll
            for (int g = 0; g < 4; ++g)
#pragma unroll
                for (int j = 0; j < 16; ++j) acc[g][j] = 0u;
#pragma unroll 1
            for (int ib = 0; ib < 8; ib += 2) {
                u32x4 vd[2][4], pq4[2];
#pragma unroll
                for (int h = 0; h < 2; ++h) { pq4[h] = *(const LAS u32x4*)((const LAS unsigned char*)SCR + (8 * (ib + h) + g8) * 16);
#pragma unroll
                    for (int u = 0; u < 4; ++u) { const int id = IDX[32 * (ib + h) + 4 * g8 + u]; vd[h][u] = *(const u32x4*)(vb + (size_t)id * 128); } }
#pragma unroll
                for (int h = 0; h < 2; ++h)
#pragma unroll
                    for (int q = 0; q < 4; ++q) { const unsigned A_ = vd[h][0][q], B_ = vd[h][1][q], C_ = vd[h][2][q], D_ = vd[h][3][q];
                        const unsigned ablo = __builtin_amdgcn_perm(B_, A_, 0x05010400u), abhi = __builtin_amdgcn_perm(B_, A_, 0x07030602u);
                        const unsigned cdlo = __builtin_amdgcn_perm(D_, C_, 0x05010400u), cdhi = __builtin_amdgcn_perm(D_, C_, 0x07030602u);
                        const unsigned t0 = __builtin_amdgcn_perm(cdlo, ablo, 0x05040100u), t1 = __builtin_amdgcn_perm(cdlo, ablo, 0x07060302u);
                        const unsigned t2 = __builtin_amdgcn_perm(cdhi, abhi, 0x05040100u), t3 = __builtin_amdgcn_perm(cdhi, abhi, 0x07060302u);
#pragma unroll
                        for (int g = 0; g < 4; ++g) { const unsigned pg = pq4[h][g];
                            acc[g][4 * q + 0] = __builtin_amdgcn_udot4(t0, pg, acc[g][4 * q + 0], false); acc[g][4 * q + 1] = __builtin_amdgcn_udot4(t1, pg, acc[g][4 * q + 1], false);
                            acc[g][4 * q + 2] = __builtin_amdgcn_udot4(t2, pg, acc[g][4 * q + 2], false); acc[g][4 * q + 3] = __builtin_amdgcn_udot4(t3, pg, acc[g][4 * q + 3], false); } }
            }
            f32x2 mine[8];
            { const int hr = F.lane >> 4; const float scl = (hr == 0) ? sclh[0] : ((hr == 1) ? sclh[1] : ((hr == 2) ? sclh[2] : sclh[3])), off = (hr == 0) ? offh[0] : ((hr == 1) ? offh[1] : ((hr == 2) ? offh[2] : offh[3]));
#pragma unroll
              for (int q = 0; q < 8; ++q) {
                float x[4][2];
#pragma unroll
                for (int g = 0; g < 4; ++g) { float a0 = (float)acc[g][2 * q], a1 = (float)acc[g][2 * q + 1];
                    a0 += dppf<0x128, 0xF>(a0); a1 += dppf<0x128, 0xF>(a1);
                    x[g][0] = a0; x[g][1] = a1; }
                mine[q].x = (rsum4(x[0][0], x[1][0], x[2][0], x[3][0]) - off) * scl; mine[q].y = (rsum4(x[0][1], x[1][1], x[2][1], x[3][1]) - off) * scl;
              } }
            if ((F.lane & 8) == 0) { u32x4 w0, w1; const int hrow = F.lane >> 4;
                w0.x = pk2(mine[0].x, mine[0].y); w0.y = pk2(mine[1].x, mine[1].y); w0.z = pk2(mine[2].x, mine[2].y); w0.w = pk2(mine[3].x, mine[3].y);
                w1.x = pk2(mine[4].x, mine[4].y); w1.y = pk2(mine[5].x, mine[5].y); w1.z = pk2(mine[6].x, mine[6].y); w1.w = pk2(mine[7].x, mine[7].y);
                bf16* yp = Y + (size_t)t * DM + (kvh * 4 + hrow) * 128 + 16 * c8; *(u32x4*)yp = w0; *(u32x4*)(yp + 8) = w1; }
            asm volatile("s_waitcnt lgkmcnt(0)" ::: "memory"); __builtin_amdgcn_wave_barrier();
        }
    }
}

__global__ void __launch_bounds__(NTHREADS, 2) mk_fwd(Args args) {
    extern __shared__ __attribute__((aligned(16))) unsigned char lds[];
    Frame F;
    F.lds = (LAS unsigned char*)lds;
    volatile LAS unsigned* MISC = (volatile LAS unsigned*)(F.lds + MISC_OFF);
    F.tid = threadIdx.x; F.lane = F.tid & 63; F.wave = __builtin_amdgcn_readfirstlane(F.tid >> 6);
    F.bx = blockIdx.x; F.G = gridDim.x; F.gw = F.bx * NWAVES + F.wave; F.ngw = F.G * NWAVES;
    if (F.tid < 64) MISC[F.tid] = 0u;
    __syncthreads();
    unsigned char* ws = args.ws;
    XcdBarrier bar = xcd_barrier_post((unsigned*)(ws + WS_CTL) + CW_BAR, MISC + 8);
    if (F.tid == 0) { MISC[16] = xb_add((unsigned*)(ws + WS_CTL) + CW_XRANK + 64 * bar.x, 1u); }
    const int lo = args.ph_lo, hi = args.ph_hi;
#define IN(k) (lo <= (k) && (k) < hi)
#define SEAM(k) do { if (IN((k) + 1)) xcd_barrier(bar); } while (0)
#define GEMM_BF16(Aptr, Bptr, Nn, Kk, Optr, ldo) do { pg8::Gemm g{(const pg8::bf16_t*)(Aptr), (const pg8::bf16_t*)(Bptr), TOK, (Nn), (Kk)}; pg8::StaticOrder S; S.init(TOK, (Nn), F.G, F.bx); \
        pg8::EpiBf16<0> E{(pg8::bf16_t*)(Optr), (ldo), nullptr, 0, 0}; pg8::gemm_phase<pg8::EpiBf16<0>, pg8::StaticOrder, false>(F.lds, g, S, E, nullptr); } while (0)

#ifndef PROBE_MASK
#define PROBE_MASK 0
#endif
#define PRB(bit, stmt) do { if (PROBE_MASK & (1 << (bit))) { stmt; xcd_barrier(bar); } } while (0)
    if (IN(0)) { PRB(14, ph_prologue(args, F)); ph_prologue(args, F); SEAM(0); }
    if (IN(1)) { ph_mod_x(args, F); SEAM(1); }
    if (F.tid == 0) {
        unsigned* cb = (unsigned*)(ws + WS_CTL) + CW_BAR; unsigned nloc = 1u, rx = 0u, nx = 0u;
        for (unsigned j = 0; j < 16; ++j) { const unsigned c = xb_ld(&cb[XB_XCNT(j)]); if (c > 0u) { if (j < bar.x) ++rx; ++nx; } if (j == bar.x) nloc = c > 0u ? c : 1u; }
        if (nx == 0u) nx = 1u;
        MISC[17] = nloc; MISC[18] = rx; MISC[19] = nx; }
    __syncthreads();
    const XInfo XI = xcc_info(MISC);
    if (IN(2)) { PRB(8, GEMM_BF16(ws + WS_HY, ws + WS_WINE, EV_NP, 2048, ws + WS_Z, EV_NP)); GEMM_BF16(ws + WS_HY, ws + WS_WINE, EV_NP, 2048, ws + WS_Z, EV_NP); SEAM(2); }
    if (IN(3)) { ph_even_post(args, F); SEAM(3); }
    if (IN(4)) { pg8::Gemm g{(const pg8::bf16_t*)(ws + WS_LA), (const pg8::bf16_t*)(ws + WS_WL), TOK, 3072, 512}; pg8::StaticOrder S; S.init(TOK, 3072, F.G, F.bx);
                 EpiLora E{(pg8::bf16_t*)(ws + WS_Z) + 1280, EV_NP, (const float*)args.in[7], (const float*)args.in[9]};
                 pg8::gemm_phase<EpiLora, pg8::StaticOrder, false>(F.lds, g, S, E, nullptr); SEAM(4); }
    if (IN(5)) { PRB(9, ph_scan_prep(args, F)); ph_scan_prep(args, F); xcd_barrier(bar); }
    if (IN(7)) { PRB(15, scan_mfma_rows(args, F)); ph_swa_mfma(args, F); scan_mfma_rows(args, F); SEAM(7); }
    if (IN(8)) { PRB(10, ph_rwkv_finish(args, F)); ph_rwkv_finish(args, F); SEAM(8); }
    if (IN(9)) { GEMM_BF16(ws + WS_HY, ws + WS_WOUTE, 2048, 2048, ws + WS_Z, 2048); SEAM(9); }
    if (IN(10)) { PRB(11, ph_ln_mixer(args, F, 0)); ph_ln_mixer(args, F, 0); SEAM(10); }
    if (IN(11)) { GEMM_BF16(ws + WS_HY, ws + WS_WQ0, 2048, 2048, ws + WS_Z, 2048); SEAM(11); }
    if (IN(12)) { PRB(4, ph_peer_select(args, F, 0)); ph_peer_select(args, F, 0); SEAM(12); }
    if (IN(13)) { PRB(12, ph_peer_u(args, F, XI)); ph_peer_u(args, F, XI); xcd_barrier(bar); ph_peer_act(args, F); xcd_barrier(bar); PRB(13, ph_peer_v(args, F, XI)); ph_peer_v(args, F, XI); xcd_barrier(bar); ph_peer_ln(args, F, 0); SEAM(13); }
    if (IN(14)) { GEMM_BF16(ws + WS_HY, ws + WS_WINO, OD_NP, 2048, ws + WS_Z, OD_NP); SEAM(14); }
    if (IN(15)) { ph_odd_post(args, F); SEAM(15); }
    if (IN(16)) { PRB(2, ph_dsa_select(args, F, 1)); PRB(6, ph_dsa_select(args, F, 2)); PRB(7, ph_dsa_select(args, F, 0)); ph_dsa_select(args, F); SEAM(16); }
    if (IN(17)) { ph_dsa_attn(args, F, XI); SEAM(17); }
    if (IN(18)) { GEMM_BF16(ws + WS_HY, ws + WS_WOUTO, 2048, 2048, ws + WS_Z, 2048); SEAM(18); }
    if (IN(19)) { ph_ln_mixer(args, F, 1); SEAM(19); }
    if (IN(20)) { GEMM_BF16(ws + WS_HY, ws + WS_WQ1, 2048, 2048, ws + WS_Z, 2048); SEAM(20); }
    if (IN(21)) { PRB(4, ph_peer_select(args, F, 1)); ph_peer_select(args, F, 1); SEAM(21); }
    if (IN(22)) { ph_peer_u(args, F, XI); xcd_barrier(bar); ph_peer_act(args, F); xcd_barrier(bar); ph_peer_v(args, F, XI); xcd_barrier(bar); ph_peer_ln(args, F, 1); }
#undef IN
#undef SEAM
#undef GEMM_BF16
}

#ifndef MK_SPLIT
#define MK_SPLIT 0
#endif
extern "C" void kernel_launch(void* const* d_in, const int* in_sizes, int n_in, void* d_out, int out_size, void* d_ws, size_t ws_size, hipStream_t stream) {
    static int grid = 0;
    if (grid == 0) {
        int dev = 0, cus = 0;
        if (n_in != 27 || out_size != TOK * DM || ws_size < WS_END) { fprintf(stderr, "kernel_launch: unexpected shapes (n_in %d out %d ws %zu)\n", n_in, out_size, ws_size); grid = -1; return; }
        if (hipGetDevice(&dev) != hipSuccess || hipDeviceGetAttribute(&cus, hipDeviceAttributeMultiprocessorCount, dev) != hipSuccess) { grid = -1; return; }
        if (hipFuncSetAttribute((const void*)mk_fwd, hipFuncAttributeMaxDynamicSharedMemorySize, LDS_BYTES) != hipSuccess) { fprintf(stderr, "kernel_launch: hipFuncSetAttribute failed\n"); grid = -1; return; }
        int per_cu = 0;
        if (hipOccupancyMaxActiveBlocksPerMultiprocessor(&per_cu, (const void*)mk_fwd, NTHREADS, LDS_BYTES) != hipSuccess || per_cu < 1) fprintf(stderr, "kernel_launch: occupancy query says %d\n", per_cu);
        (void)hipGetLastError();
        grid = cus;
    }
    if (grid < 0) return;
    (void)hipMemsetAsync((char*)d_ws + WS_CTL, 0, CTL_ZERO_BYTES, stream);
    Args a{};
    for (int i = 0; i < 27; ++i) a.in[i] = d_in[i];
    a.out = (float*)d_out; a.ws = (unsigned char*)d_ws;
#if MK_SPLIT
    for (int p = 0; p < 23; ++p) { a.ph_lo = p; a.ph_hi = p + 1; hipLaunchKernelGGL(mk_fwd, dim3(grid), dim3(NTHREADS), LDS_BYTES, stream, a); }
#else
    a.ph_lo = 0; a.ph_hi = 23;
    hipLaunchKernelGGL(mk_fwd, dim3(grid), dim3(NTHREADS), LDS_BYTES, stream, a);
#endif
}
```

```cpp
#include <hip/hip_runtime.h>
#include <cstdio>
#include <cstdint>
namespace pg8 {
#define PG8_LAS __attribute__((address_space(3)))
typedef unsigned short bf16_t;
typedef short bf16x8 __attribute__((ext_vector_type(8)));
typedef float f32x4 __attribute__((ext_vector_type(4)));
typedef unsigned u32x4 __attribute__((ext_vector_type(4)));
constexpr int BM = 256, BK = 64, HALF = 128, HTB = HALF * BK * 2  , STAGE_BYTES = 8 * HTB, NXCD = 8, WGM = 8;

__host__ __device__ __forceinline__ int lds_byte(int r, int c) { const int st = (r >> 4) * 2 + (c >> 5), rr = r & 15, cc = c & 31, ob = rr * 64 + cc * 2; return st * 1024 + (ob ^ (((ob >> 9) & 1) << 5)); }
__host__ __device__ __forceinline__ void stage_rc(int b, int& R, int& C) { const int st = b / 1024, sb = b % 1024, swz = sb ^ (((sb >> 9) & 1) << 5); R = (st >> 1) * 16 + swz / 64; C = (st & 1) * 32 + (swz % 64) / 2; }
__host__ __device__ __forceinline__ int perm32(int rho) { const int n = rho >> 4, i = rho & 15; return 8 * (i >> 2) + 4 * n + (i & 3); }

struct Unit { int pm, pn; };
struct Gemm { const bf16_t* A; const bf16_t* Bt; int M, N, K; };

struct StaticOrder {
    int nM, nN, nwg, G, c;
    __host__ __device__ void init(int M, int N, int G_, int c_) { nM = M / BM; nN = N / BM; nwg = nM * nN; G = G_; c = c_; }
    __host__ __device__ bool next(int i, Unit& u) const {
        const long L = (long)i * G + c; if (L >= nwg) return false;
        int wgid = (int)L; { const int q = nwg / NXCD, r = nwg % NXCD, xcd = wgid % NXCD, off = wgid / NXCD; wgid = (xcd < r ? xcd * (q + 1) : r * (q + 1) + (xcd - r) * q) + off; }
        const int nig = WGM * nN, gid = wgid / nig, fm = gid * WGM, gsz = (nM - fm) < WGM ? (nM - fm) : WGM;
        u.pm = fm + ((wgid % nig) % gsz); u.pn = (wgid % nig) / gsz; return true;
    }
    __device__ __forceinline__ void a_ready(const Unit&) const {}
    __device__ __forceinline__ void done(const Unit&) const {}
};
struct CountedOrder : StaticOrder {
    const unsigned* ready; unsigned need; unsigned* tmo;
    __device__ __forceinline__ void a_ready(const Unit& u) const {
        if (threadIdx.x < 64) {
            const unsigned long long t0 = __builtin_amdgcn_s_memrealtime(); unsigned polls = 0;
            while ((unsigned)__builtin_amdgcn_readfirstlane(__hip_atomic_load(ready + 64 * u.pm, __ATOMIC_RELAXED, __HIP_MEMORY_SCOPE_AGENT)) < need) {
                if ((++polls & 255u) == 0u && __builtin_amdgcn_readfirstlane(__hip_atomic_load(tmo, __ATOMIC_RELAXED, __HIP_MEMORY_SCOPE_AGENT)) != 0u) break;
                if (__builtin_amdgcn_s_memrealtime() - t0 > 2000000ull) {
                    if (threadIdx.x == 0) { unsigned expect = 0u; __hip_atomic_compare_exchange_strong(tmo + 1, &expect, 0x600u | (unsigned)(u.pm & 0xff), __ATOMIC_RELAXED, __ATOMIC_RELAXED, __HIP_MEMORY_SCOPE_AGENT); __hip_atomic_store(tmo, 1u, __ATOMIC_RELAXED, __HIP_MEMORY_SCOPE_AGENT); }
                    break; }
                __builtin_amdgcn_s_sleep(2); }
            __builtin_amdgcn_fence(__ATOMIC_ACQUIRE, "agent");
            asm volatile("s_waitcnt vmcnt(0)" ::: "memory");
        }
#if !defined(BROKEN_HOOK_NO_BARRIER)
        asm volatile("" ::: "memory"); __builtin_amdgcn_s_barrier(); asm volatile("" ::: "memory");
#endif
    }
};

__device__ __forceinline__ unsigned cvt_pk_bf16(float lo, float hi) { unsigned r; asm volatile("v_cvt_pk_bf16_f32 %0, %1, %2" : "=v"(r) : "v"(lo), "v"(hi)); return r; }
typedef float f32x2 __attribute__((ext_vector_type(2)));
__device__ __forceinline__ f32x2 gelu_pk(f32x2 v) {
    const f32x2 av = __builtin_elementwise_abs(v), d = av * 0.2316418882f + 1.0f;
    f32x2 t; t.x = __builtin_amdgcn_rcpf(d.x); t.y = __builtin_amdgcn_rcpf(d.y);
    f32x2 q = t * 0.5307027145f + (-0.7265760135f); q = q * t + 0.7107068705f; q = q * t + (-0.142248368f); q = q * t + 0.127414796f; q = q * t;
    const f32x2 s = (v * v) * (-0.72134752044f);
    f32x2 e; e.x = __builtin_amdgcn_exp2f(s.x); e.y = __builtin_amdgcn_exp2f(s.y);
    const f32x2 m = v * (q * e), r = v - m;
    f32x2 o; o.x = v.x < 0.f ? m.x : r.x; o.y = v.y < 0.f ? m.y : r.y; return o;
}

struct EpiF32 {
    static constexpr bool PERM = false, AFTER_DRAIN = false;
    float* C; int ldc; const float* bias;
    __device__ __forceinline__ void operator()(const f32x4 (&acc)[2][2][4][2], const Unit& u, int wr, int wc, int fr, int fq) const {
        const int row0 = u.pm * BM + wr * 64 + fr, col0 = u.pn * BM + wc * 32 + 4 * fq;
        f32x4 bv[2][2];
#pragma unroll
        for (int bj = 0; bj < 2; ++bj)
#pragma unroll
            for (int n = 0; n < 2; ++n) bv[bj][n] = bias ? *(const f32x4*)(bias + col0 + bj * HALF + n * 16) : (f32x4){0.f, 0.f, 0.f, 0.f};
#pragma unroll
        for (int ai = 0; ai < 2; ++ai)
#pragma unroll
            for (int m = 0; m < 4; ++m) { float* rowp = C + (size_t)(row0 + ai * HALF + m * 16) * ldc + col0;
#pragma unroll
                for (int bj = 0; bj < 2; ++bj)
#pragma unroll
                    for (int n = 0; n < 2; ++n) *(f32x4*)(rowp + bj * HALF + n * 16) = acc[ai][bj][m][n] + bv[bj][n]; }
    }
};
template <int ACT  > struct EpiBf16 {
    static constexpr bool PERM = true, AFTER_DRAIN = false;
    bf16_t* O; int ldc; const float* bias; int split_cols; size_t split_stride;
    __device__ __forceinline__ void operator()(const f32x4 (&acc)[2][2][4][2], const Unit& u, int wr, int wc, int fr, int fq) const {
        const int row0 = u.pm * BM + wr * 64 + fr; int colt = u.pn * BM; bf16_t* base = O;
        if (split_cols) { const int t = colt / split_cols; base += (size_t)t * split_stride; colt -= t * split_cols; }
        const int col0 = colt + wc * 32 + 8 * fq, bcol0 = u.pn * BM + wc * 32 + 8 * fq;
        f32x4 bv[2][2];
#pragma unroll
        for (int bj = 0; bj < 2; ++bj)
#pragma unroll
            for (int n = 0; n < 2; ++n) bv[bj][n] = bias ? *(const f32x4*)(bias + bcol0 + bj * HALF + 4 * n) : (f32x4){0.f, 0.f, 0.f, 0.f};
#pragma unroll
        for (int ai = 0; ai < 2; ++ai)
#pragma unroll
            for (int m = 0; m < 4; ++m) { bf16_t* rowp = base + (size_t)(row0 + ai * HALF + m * 16) * ldc + col0;
#pragma unroll
                for (int bj = 0; bj < 2; ++bj) { f32x4 v0 = acc[ai][bj][m][0] + bv[bj][0], v1 = acc[ai][bj][m][1] + bv[bj][1];
                    if (ACT == 1) { f32x2 a = gelu_pk((f32x2){v0[0], v0[1]}), b = gelu_pk((f32x2){v0[2], v0[3]}), c = gelu_pk((f32x2){v1[0], v1[1]}), d = gelu_pk((f32x2){v1[2], v1[3]});
                        v0 = (f32x4){a.x, a.y, b.x, b.y}; v1 = (f32x4){c.x, c.y, d.x, d.y}; }
                    if (ACT == 2) {
#pragma unroll
                        for (int j = 0; j < 4; ++j) { v0[j] = 0.5f * v0[j] * (1.0f + erff(v0[j] * 0.70710678f)); v1[j] = 0.5f * v1[j] * (1.0f + erff(v1[j] * 0.70710678f)); } }
                    u32x4 w; w.x = cvt_pk_bf16(v0[0], v0[1]); w.y = cvt_pk_bf16(v0[2], v0[3]); w.z = cvt_pk_bf16(v1[0], v1[1]); w.w = cvt_pk_bf16(v1[2], v1[3]);
                    *(u32x4*)(rowp + bj * HALF) = w; } }
    }
};

struct PanelStats {
    unsigned* xbuf;
    unsigned* cnt;
    unsigned* tmo;
    int ntn; float eps;
    unsigned code;
    __device__ __forceinline__ bool run(const f32x4 (&v)[2][2][4][2], const Unit& u, int wr, int wc, int fr, int fq, PG8_LAS unsigned char* lds, int wid, int lane) const {
        typedef float f32x2v __attribute__((ext_vector_type(2)));
        PG8_LAS f32x2v* P = (PG8_LAS f32x2v*)lds;
        PG8_LAS f32x2v* S = (PG8_LAS f32x2v*)(lds + 8192);
        PG8_LAS unsigned* flag = (PG8_LAS unsigned*)(lds + 8192 + 2048);
#pragma unroll
        for (int ai = 0; ai < 2; ++ai)
#pragma unroll
            for (int m = 0; m < 4; ++m) {
                float s = 0.f;
#pragma unroll
                for (int bj = 0; bj < 2; ++bj)
#pragma unroll
                    for (int n = 0; n < 2; ++n) { const f32x4 x = v[ai][bj][m][n]; s += (x[0] + x[1]) + (x[2] + x[3]); }
                s += __shfl_xor(s, 16); s += __shfl_xor(s, 32);
                const float mw = s * (1.0f / 64.0f); float q = 0.f;
#pragma unroll
                for (int bj = 0; bj < 2; ++bj)
#pragma unroll
                    for (int n = 0; n < 2; ++n) { const f32x4 d = v[ai][bj][m][n] - mw; q += (d[0] * d[0] + d[1] * d[1]) + (d[2] * d[2] + d[3] * d[3]); }
                q += __shfl_xor(q, 16); q += __shfl_xor(q, 32);
                if (fq == 0) P[(ai * HALF + wr * 64 + m * 16 + fr) * 4 + wc] = (f32x2v){mw, q};
            }
        asm volatile("s_waitcnt lgkmcnt(0)" ::: "memory"); __builtin_amdgcn_s_barrier(); asm volatile("" ::: "memory");
#if defined(BROKEN_NO_WAIT)
        if (blockIdx.x >= 64) { const long long t0 = clock64(); while (clock64() - t0 < 60000) __builtin_amdgcn_s_sleep(8); }
#endif
        const int row = wid * 32 + (lane & 31);
        if (lane < 32) {
            const f32x2v a = P[row * 4 + 0], b = P[row * 4 + 1], c = P[row * 4 + 2], d = P[row * 4 + 3];
            const float mt = (a.x + b.x + c.x + d.x) * 0.25f;
            const float da = a.x - mt, db = b.x - mt, dc = c.x - mt, dd = d.x - mt;
            const float m2 = (a.y + b.y) + (c.y + d.y) + 64.0f * ((da * da + db * db) + (dc * dc + dd * dd));
            unsigned long long* slot = (unsigned long long*)xbuf + ((size_t)(u.pm * BM + row) * 4 + u.pn);
            __hip_atomic_store(slot, ((unsigned long long)__float_as_uint(m2) << 32) | __float_as_uint(mt), __ATOMIC_RELAXED, __HIP_MEMORY_SCOPE_AGENT);
        }
        asm volatile("s_waitcnt vmcnt(0)" ::: "memory");
        if (lane == 0) __hip_atomic_fetch_add(cnt + 64 * u.pm, 1u, __ATOMIC_RELAXED, __HIP_MEMORY_SCOPE_AGENT);
        if (wid == 0) {
            bool dead = false; const unsigned long long t0 = __builtin_amdgcn_s_memrealtime(); const unsigned want = 8u * (unsigned)ntn;
            for (;;) {
#if defined(BROKEN_NO_WAIT)
                break;
#endif
                if ((unsigned)__builtin_amdgcn_readfirstlane(__hip_atomic_load(cnt + 64 * u.pm, __ATOMIC_RELAXED, __HIP_MEMORY_SCOPE_AGENT)) >= want) break;
                if (__builtin_amdgcn_s_memrealtime() - t0 > 2000000ull) {
                    if (lane == 0) { unsigned expect = 0u; __hip_atomic_compare_exchange_strong(tmo + 1, &expect, code | (unsigned)(u.pm & 0xff), __ATOMIC_RELAXED, __ATOMIC_RELAXED, __HIP_MEMORY_SCOPE_AGENT);
                                     __hip_atomic_store(tmo, 1u, __ATOMIC_RELAXED, __HIP_MEMORY_SCOPE_AGENT); }
                    dead = true; break; }
                __builtin_amdgcn_s_sleep(2);
            }
            __builtin_amdgcn_fence(__ATOMIC_ACQUIRE, "agent");
            if (lane == 0) flag[0] = dead ? 1u : 0u;
        }
        asm volatile("s_waitcnt vmcnt(0) lgkmcnt(0)" ::: "memory"); __builtin_amdgcn_s_barrier(); asm volatile("" ::: "memory");
        const bool bad = flag[0] != 0u;
        if (lane < 32) {
            const unsigned long long* slot = (const unsigned long long*)xbuf + (size_t)(u.pm * BM + row) * 4; float mt[4], m2[4]; float ms = 0.f;
#pragma unroll
            for (int t = 0; t < 4; ++t) { if (t < ntn) { const unsigned long long w = __hip_atomic_load(slot + t, __ATOMIC_RELAXED, __HIP_MEMORY_SCOPE_AGENT); mt[t] = __uint_as_float((unsigned)w); m2[t] = __uint_as_float((unsigned)(w >> 32)); } else { mt[t] = 0.f; m2[t] = 0.f; } ms += mt[t]; }
            const float mean = ms / (float)ntn; float q = 0.f;
#pragma unroll
            for (int t = 0; t < 4; ++t) if (t < ntn) { const float dm = mt[t] - mean; q += m2[t] + 256.0f * dm * dm; }
            S[row] = (f32x2v){mean, 1.0f / sqrtf(q / (256.0f * (float)ntn) + eps)};
        }
        asm volatile("s_waitcnt lgkmcnt(0)" ::: "memory"); __builtin_amdgcn_s_barrier(); asm volatile("" ::: "memory");
        return bad;
    }
};
struct EpiLnRes {
    static constexpr bool PERM = false, AFTER_DRAIN = true;
    const float* base; float* out; int ldc; const float* bias; PanelStats st; unsigned poison;
    __device__ __forceinline__ void refuse(size_t i0, size_t stride, int M, int N) const { const float q = __builtin_nanf(""); for (size_t i = i0; i < (size_t)M * N; i += stride) out[(i / N) * ldc + i % N] = q;
        if (i0 == 0) { unsigned expect = 0u; __hip_atomic_compare_exchange_strong(st.tmo + 1, &expect, 0x7f0u, __ATOMIC_RELAXED, __ATOMIC_RELAXED, __HIP_MEMORY_SCOPE_AGENT); __hip_atomic_store(st.tmo, 1u, __ATOMIC_RELAXED, __HIP_MEMORY_SCOPE_AGENT); } }
    __device__ __forceinline__ void fused(f32x4 (&acc)[2][2][4][2], const Unit& u, int wr, int wc, int fr, int fq, PG8_LAS unsigned char* lds, int wid, int lane) const {
        typedef float f32x2v __attribute__((ext_vector_type(2)));
        const PG8_LAS f32x2v* S = (const PG8_LAS f32x2v*)(lds + 8192);
        const int col0 = u.pn * BM + wc * 32 + 4 * fq;
#pragma unroll
        for (int bj = 0; bj < 2; ++bj)
#pragma unroll
            for (int n = 0; n < 2; ++n) { const f32x4 bv = bias ? *(const f32x4*)(bias + col0 + bj * HALF + n * 16) : (f32x4){0.f, 0.f, 0.f, 0.f};
#pragma unroll
                for (int ai = 0; ai < 2; ++ai)
#pragma unroll
                    for (int m = 0; m < 4; ++m) acc[ai][bj][m][n] += bv; }
        const bool bad = st.run(acc, u, wr, wc, fr, fq, lds, wid, lane) || poison != 0u;
        const float qnan = __builtin_nanf("");
#pragma unroll
        for (int ai = 0; ai < 2; ++ai)
#pragma unroll
            for (int m = 0; m < 4; ++m) { const int r = ai * HALF + wr * 64 + m * 16 + fr; const f32x2v sr = S[r]; const size_t off = (size_t)(u.pm * BM + r) * ldc + col0;
#pragma unroll
                for (int bj = 0; bj < 2; ++bj)
#pragma unroll
                    for (int n = 0; n < 2; ++n) { const f32x4 bs = *(const f32x4*)(base + off + bj * HALF + n * 16); f32x4 o = bs + (acc[ai][bj][m][n] - sr.x) * sr.y;
                        if (bad) o = (f32x4){qnan, qnan, qnan, qnan}; *(f32x4*)(out + off + bj * HALF + n * 16) = o; }
                asm volatile("" ::: "memory"); }
    }
};
struct EpiLnResLn {
    static constexpr bool PERM = false, AFTER_DRAIN = true;
    const float* base; float* out; bf16_t* xn; int ldc; const float* bias; PanelStats st1, st2; unsigned poison;
    __device__ __forceinline__ void refuse(size_t i0, size_t stride, int M, int N) const { const float q = __builtin_nanf(""); for (size_t i = i0; i < (size_t)M * N; i += stride) { const size_t o = (i / N) * ldc + i % N; out[o] = q; xn[o] = (bf16_t)0x7fc0u; }
        if (i0 == 0) { unsigned expect = 0u; __hip_atomic_compare_exchange_strong(st1.tmo + 1, &expect, 0x7f0u, __ATOMIC_RELAXED, __ATOMIC_RELAXED, __HIP_MEMORY_SCOPE_AGENT); __hip_atomic_store(st1.tmo, 1u, __ATOMIC_RELAXED, __HIP_MEMORY_SCOPE_AGENT); } }
    __device__ __forceinline__ void fused(f32x4 (&acc)[2][2][4][2], const Unit& u, int wr, int wc, int fr, int fq, PG8_LAS unsigned char* lds, int wid, int lane) const {
        typedef float f32x2v __attribute__((ext_vector_type(2))); typedef unsigned u32x2v __attribute__((ext_vector_type(2)));
        const PG8_LAS f32x2v* S = (const PG8_LAS f32x2v*)(lds + 8192);
        const int col0 = u.pn * BM + wc * 32 + 4 * fq;
#pragma unroll
        for (int bj = 0; bj < 2; ++bj)
#pragma unroll
            for (int n = 0; n < 2; ++n) { const f32x4 bv = bias ? *(const f32x4*)(bias + col0 + bj * HALF + n * 16) : (f32x4){0.f, 0.f, 0.f, 0.f};
#pragma unroll
                for (int ai = 0; ai < 2; ++ai)
#pragma unroll
                    for (int m = 0; m < 4; ++m) acc[ai][bj][m][n] += bv; }
        bool bad = st1.run(acc, u, wr, wc, fr, fq, lds, wid, lane) || poison != 0u;
        const float qnan = __builtin_nanf("");
#pragma unroll
        for (int ai = 0; ai < 2; ++ai)
#pragma unroll
            for (int m = 0; m < 4; ++m) { const int r = ai * HALF + wr * 64 + m * 16 + fr; const f32x2v sr = S[r]; const size_t off = (size_t)(u.pm * BM + r) * ldc + col0;
#pragma unroll
                for (int bj = 0; bj < 2; ++bj)
#pragma unroll
                    for (int n = 0; n < 2; ++n) { const f32x4 bs = *(const f32x4*)(base + off + bj * HALF + n * 16); acc[ai][bj][m][n] = bs + (acc[ai][bj][m][n] - sr.x) * sr.y; }
                asm volatile("" : "+v"(acc[ai][0][m][0]), "+v"(acc[ai][0][m][1]), "+v"(acc[ai][1][m][0]), "+v"(acc[ai][1][m][1]));
                if (m & 1) asm volatile("" ::: "memory"); }
        const bool bad1 = bad;
        bad = st2.run(acc, u, wr, wc, fr, fq, lds, wid, lane) || bad;
#pragma unroll
        for (int ai = 0; ai < 2; ++ai)
#pragma unroll
            for (int m = 0; m < 4; ++m) { const int r = ai * HALF + wr * 64 + m * 16 + fr; const f32x2v sr = S[r]; const size_t off = (size_t)(u.pm * BM + r) * ldc + col0;
#pragma unroll
                for (int bj = 0; bj < 2; ++bj)
#pragma unroll
                    for (int n = 0; n < 2; ++n) { const f32x4 x1 = acc[ai][bj][m][n]; *(f32x4*)(out + off + bj * HALF + n * 16) = bad1 ? (f32x4){qnan, qnan, qnan, qnan} : x1;
                        const f32x4 o = (x1 - sr.x) * sr.y; u32x2v w; w.x = cvt_pk_bf16(o[0], o[1]); w.y = cvt_pk_bf16(o[2], o[3]);
                        if (bad) { w.x = 0x7fc07fc0u; w.y = 0x7fc07fc0u; } *(u32x2v*)(xn + off + bj * HALF + n * 16) = w; }
                asm volatile("" ::: "memory"); }
    }
};

template <class Epi, class Sched, bool STAMP = false>
__device__ __forceinline__ void gemm_phase(PG8_LAS unsigned char* lds, const Gemm g, const Sched& S, const Epi& E, unsigned long long* stamps) {
    const int tid = threadIdx.x, wid = __builtin_amdgcn_readfirstlane(tid >> 6), lane = tid & 63, wr = wid >> 2, wc = wid & 3, fr = lane & 15, fq = lane >> 4;
    const int K = g.K, nt = K / BK;
    int ts_lo = 0, ts_hi = 0, nts = 0; const unsigned long long rt_entry = STAMP ? (unsigned long long)wall_clock64() : 0ull;
#define PG8_STAMP() do { if (STAMP && wid == 0 && nts < 64) { const unsigned long long _c = (unsigned long long)clock64(); \
        ts_lo = (lane == nts) ? (int)(unsigned)_c : ts_lo; ts_hi = (lane == nts) ? (int)(unsigned)(_c >> 32) : ts_hi; ++nts; } } while (0)
    PG8_STAMP();
    unsigned voffA[2], voffB[2];
#pragma unroll
    for (int i = 0; i < 2; ++i) { int R, C; stage_rc(tid * 16 + i * 8192, R, C); const int Rb = Epi::PERM ? ((R & ~31) + perm32(R & 31)) : R;
        voffA[i] = (unsigned)(R * K + C) * 2u; voffB[i] = (unsigned)(Rb * K + C) * 2u; }
    const size_t kstep = (size_t)(BK * 2);
    const size_t hstep = (size_t)HALF * K * 2;
    const size_t tstep = 2 * hstep;
    const unsigned ldsw = (unsigned)wid * 1024u;
    const int aoff = lds_byte(wr * 64 + fr, fq * 8), boff = lds_byte(wc * 32 + fr, fq * 8);
#define PG8_SA(b, h) (((b) * 2 + (h)) * HTB)
#define PG8_SB(b, h) ((4 + (b) * 2 + (h)) * HTB)
#define PG8_STAGE(bufoff, gbase, voff) do { _Pragma("unroll") for (int _i = 0; _i < 2; ++_i) \
        __builtin_amdgcn_global_load_lds((const unsigned*)((const char*)(gbase) + (voff)[_i]), (PG8_LAS unsigned*)(lds + (bufoff) + ldsw + _i * 8192), 16, 0, 0); } while (0)
#define PG8_LDA(dst, b, h) do { _Pragma("unroll") for (int m = 0; m < 4; ++m) _Pragma("unroll") for (int k = 0; k < 2; ++k) dst[m][k] = *(const PG8_LAS bf16x8*)(lds + PG8_SA(b, h) + aoff + m * 2048 + k * 1024); } while (0)
#define PG8_LDB(dst, b, h) do { _Pragma("unroll") for (int n = 0; n < 2; ++n) _Pragma("unroll") for (int k = 0; k < 2; ++k) dst[n][k] = *(const PG8_LAS bf16x8*)(lds + PG8_SB(b, h) + boff + n * 2048 + k * 1024); } while (0)
#define PG8_MMA(ai, bj, At, Bt) do { __builtin_amdgcn_s_setprio(1); _Pragma("unroll") for (int m = 0; m < 4; ++m) _Pragma("unroll") for (int n = 0; n < 2; ++n) _Pragma("unroll") for (int k = 0; k < 2; ++k) \
        acc[ai][bj][m][n] = __builtin_amdgcn_mfma_f32_16x16x32_bf16(Bt[n][k], At[m][k], acc[ai][bj][m][n], 0, 0, 0); __builtin_amdgcn_s_setprio(0); } while (0)
#define PG8_WAIT_V(n) asm volatile("s_waitcnt vmcnt(" #n ")" ::: "memory")
#define PG8_WAIT_L(n) asm volatile("s_waitcnt lgkmcnt(" #n ")" ::: "memory")
#define PG8_BAR __builtin_amdgcn_s_barrier()
#define PG8_SCHED __builtin_amdgcn_sched_barrier(0)
    Unit cur, nxt; int ui = 0;
    if (!S.next(0, cur)) return;
    f32x4 acc[2][2][4][2];
#pragma unroll
    for (int a = 0; a < 2; ++a)
#pragma unroll
        for (int b = 0; b < 2; ++b)
#pragma unroll
            for (int m = 0; m < 4; ++m)
#pragma unroll
                for (int n = 0; n < 2; ++n) acc[a][b][m][n] = (f32x4){0.f, 0.f, 0.f, 0.f};
    bf16x8 At[4][2], B0[2][2], B1[2][2];
    const char* cA = (const char*)g.A + (size_t)cur.pm * tstep; const char* cB = (const char*)g.Bt + (size_t)cur.pn * tstep;
    S.a_ready(cur);
    PG8_STAGE(PG8_SB(0, 0), cB, voffB); PG8_STAGE(PG8_SA(0, 0), cA, voffA); PG8_STAGE(PG8_SB(0, 1), cB + hstep, voffB); PG8_STAGE(PG8_SA(0, 1), cA + hstep, voffA);
    if (wr == 1) PG8_BAR;
    PG8_WAIT_V(4); PG8_BAR;
    PG8_STAGE(PG8_SB(1, 0), cB + kstep, voffB); PG8_STAGE(PG8_SA(1, 0), cA + kstep, voffA); PG8_STAGE(PG8_SB(1, 1), cB + hstep + kstep, voffB);
    PG8_WAIT_V(6); PG8_BAR;
    PG8_STAMP();
    for (;;) {
        const bool has_next = S.next(ui + 1, nxt);
        const char* nA = has_next ? (const char*)g.A + (size_t)nxt.pm * tstep : cA; const char* nB = has_next ? (const char*)g.Bt + (size_t)nxt.pn * tstep : cB;
        for (int t = 0; t < nt; t += 2) {
            const bool last = (t == nt - 2);
            const char* a1 = cA + (size_t)(t + 1) * kstep;
            const char* a2 = last ? nA : cA + (size_t)(t + 2) * kstep; const char* b2 = last ? nB : cB + (size_t)(t + 2) * kstep;
            const char* a3 = a2 + kstep; const char* b3 = b2 + kstep;
            if (last && has_next) S.a_ready(nxt);
            PG8_LDB(B0, 0, 0); PG8_SCHED; PG8_LDA(At, 0, 0); PG8_STAGE(PG8_SA(1, 1), a1 + hstep, voffA);
            PG8_WAIT_L(8); PG8_BAR; PG8_WAIT_L(0); PG8_MMA(0, 0, At, B0); PG8_BAR; PG8_SCHED;
            PG8_LDB(B1, 0, 1); PG8_STAGE(PG8_SB(0, 0), b2, voffB);
            PG8_BAR; PG8_WAIT_L(0); PG8_MMA(0, 1, At, B1); PG8_BAR;
            PG8_LDA(At, 0, 1); PG8_STAGE(PG8_SA(0, 0), a2, voffA);
            PG8_BAR; PG8_WAIT_L(0); PG8_MMA(1, 0, At, B0); PG8_BAR; PG8_SCHED;
            PG8_STAGE(PG8_SB(0, 1), b2 + hstep, voffB);
            PG8_WAIT_V(6); PG8_BAR; PG8_MMA(1, 1, At, B1); PG8_BAR;
            PG8_LDB(B0, 1, 0); PG8_SCHED; PG8_LDA(At, 1, 0); PG8_STAGE(PG8_SA(0, 1), a2 + hstep, voffA);
            PG8_WAIT_L(8); PG8_BAR; PG8_WAIT_L(0); PG8_MMA(0, 0, At, B0); PG8_BAR; PG8_SCHED;
            PG8_LDB(B1, 1, 1); PG8_STAGE(PG8_SB(1, 0), b3, voffB);
            PG8_BAR; PG8_WAIT_L(0); PG8_MMA(0, 1, At, B1); PG8_BAR;
            PG8_LDA(At, 1, 1); PG8_STAGE(PG8_SA(1, 0), a3, voffA);
            PG8_BAR; PG8_WAIT_L(0); PG8_MMA(1, 0, At, B0); PG8_BAR; PG8_SCHED;
            PG8_STAGE(PG8_SB(1, 1), b3 + hstep, voffB);
            PG8_WAIT_V(6); PG8_BAR; PG8_MMA(1, 1, At, B1); PG8_BAR;
        }
        PG8_STAMP();
        if constexpr (!Epi::AFTER_DRAIN) { E(acc, cur, wr, wc, fr, fq); S.done(cur); }
        PG8_STAMP();
        if (!has_next) break;
#pragma unroll
        for (int a = 0; a < 2; ++a)
#pragma unroll
            for (int b = 0; b < 2; ++b)
#pragma unroll
                for (int m = 0; m < 4; ++m)
#pragma unroll
                    for (int n = 0; n < 2; ++n) acc[a][b][m][n] = (f32x4){0.f, 0.f, 0.f, 0.f};
        cur = nxt; cA = nA; cB = nB; ++ui;
    }
    PG8_WAIT_V(0);
    if (wr == 0) PG8_BAR;
    PG8_BAR;
    if constexpr (Epi::AFTER_DRAIN) { E.fused(acc, cur, wr, wc, fr, fq, lds, wid, lane); S.done(cur); }
    PG8_STAMP();
    if (STAMP && wid == 0) { stamps[lane] = lane < nts ? (((unsigned long long)(unsigned)ts_hi << 32) | (unsigned)ts_lo) : 0ull;
        if (lane == 62) stamps[62] = rt_entry; if (lane == 63) stamps[63] = (unsigned long long)wall_clock64(); }
#undef PG8_STAMP
#undef PG8_SA
#undef PG8_SB
#undef PG8_STAGE
#undef PG8_LDA
#undef PG8_LDB
#undef PG8_MMA
#undef PG8_WAIT_V
#undef PG8_WAIT_L
#undef PG8_BAR
#undef PG8_SCHED
}
}

#define LAS __attribute__((address_space(3)))
#define XB_TMO      128
#define XB_XCNT(j)  (256  + 64 * (j))
#define XB_XSUB(j)  (1280 + 64 * (j))
#define XB_XGEN(j)  (2304 + 64 * (j))
#define XB_TOP      3328
#define XB_TOPGEN   3392
#define XCD_BAR_WORDS 3456
#define XB_SPIN_CAP (1u << 24)

__device__ __forceinline__ unsigned xb_ld(unsigned* p)              { return __hip_atomic_load(p, __ATOMIC_RELAXED, __HIP_MEMORY_SCOPE_AGENT); }
__device__ __forceinline__ unsigned xb_add(unsigned* p, unsigned v) { return __hip_atomic_fetch_add(p, v, __ATOMIC_RELAXED, __HIP_MEMORY_SCOPE_AGENT); }
__device__ __forceinline__ unsigned xb_xcc_id() { return (unsigned)__builtin_amdgcn_s_getreg((3 << 11) | 20) & 0xFu; }
#define XB_SPIN(cond, bar) do { unsigned _sp = 0; while (cond) { __builtin_amdgcn_s_sleep(1); \
    if ((++_sp & 255u) == 0u) { if (xb_ld(&(bar)[XB_TMO])) break; if (_sp > XB_SPIN_CAP) { atomicAdd(&(bar)[XB_TMO], 1u); break; } } } } while (0)

struct XcdBarrier { unsigned* bar; unsigned x; volatile LAS unsigned* st; };

__device__ __forceinline__ XcdBarrier xcd_barrier_post(unsigned* bar, volatile LAS unsigned* st) {
    XcdBarrier b; b.bar = bar; b.x = xb_xcc_id(); b.st = st;
    if (threadIdx.x == 0) (void)xb_add(&bar[XB_XCNT(b.x)], 1u);
    return b;
}
__device__ __forceinline__ void xcd_barrier_complete(unsigned* bar, unsigned x, unsigned& nloc, unsigned& nx) {
    const unsigned G = gridDim.x * gridDim.y * gridDim.z;
    unsigned sum, cnt, mine, sp = 0u;
    for (;;) {
        sum = 0u; cnt = 0u; mine = 0u;
#pragma unroll
        for (unsigned j = 0; j < 16; ++j) { const unsigned c = xb_ld(&bar[XB_XCNT(j)]); sum += c; cnt += (c > 0u) ? 1u : 0u; mine = (j == x) ? c : mine; }
        if (sum == G) break;
        __builtin_amdgcn_s_sleep(1);
        if ((++sp & 255u) == 0u) { if (xb_ld(&bar[XB_TMO])) break; if (sp > XB_SPIN_CAP) { atomicAdd(&bar[XB_TMO], 1u); break; } }
    }
    nloc = mine > 0u ? mine : 1u; nx = cnt > 0u ? cnt : 1u;
}
__device__ __forceinline__ void xcd_barrier(const XcdBarrier& b) {
    asm volatile("s_waitcnt vmcnt(0)" ::: "memory");
    __syncthreads();
    if (threadIdx.x == 0) {
        unsigned* bar = b.bar;
        __builtin_amdgcn_s_waitcnt(0);
        unsigned nloc = b.st[0], nx = b.st[1];
        if (nloc == 0u) { xcd_barrier_complete(bar, b.x, nloc, nx); b.st[0] = nloc; b.st[1] = nx; }
        const unsigned old = xb_add(&bar[XB_XSUB(b.x)], 1u);
        const unsigned gen = old / nloc;
        if (old + 1u == (gen + 1u) * nloc) {
            __builtin_amdgcn_fence(__ATOMIC_RELEASE, "agent");
            asm volatile("s_waitcnt vmcnt(0)" ::: "memory");
            const unsigned og = xb_add(&bar[XB_TOP], 1u);
            const unsigned tg = og / nx;
            if (og + 1u == (tg + 1u) * nx) xb_add(&bar[XB_TOPGEN], 1u);
            else XB_SPIN(xb_ld(&bar[XB_TOPGEN]) == tg, bar);
            __builtin_amdgcn_fence(__ATOMIC_ACQUIRE, "agent");
            xb_add(&bar[XB_XGEN(b.x)], 1u);
            asm volatile("s_waitcnt vmcnt(0)" ::: "memory");
        } else {
            XB_SPIN(xb_ld(&bar[XB_XGEN(b.x)]) == gen, bar);
            __builtin_amdgcn_fence(__ATOMIC_ACQUIRE, "agent");
            asm volatile("s_waitcnt vmcnt(0)" ::: "memory");
        }
    }
    __syncthreads();
}

typedef unsigned short bf16;
typedef float f32x4 __attribute__((ext_vector_type(4)));
typedef float f32x16 __attribute__((ext_vector_type(16)));
typedef float f32x2 __attribute__((ext_vector_type(2)));
typedef unsigned u32x4 __attribute__((ext_vector_type(4)));
typedef unsigned u32x2 __attribute__((ext_vector_type(2)));
typedef short bf16x8 __attribute__((ext_vector_type(8)));
typedef __bf16 bf2_t __attribute__((ext_vector_type(2)));

constexpr int NTHREADS = 512, NWAVES = 8;
constexpr int LDS_BYTES = 160 * 1024;
constexpr int MISC_OFF = LDS_BYTES - 256;
constexpr int TOK = 32768, SEQ = 16384, DM = 2048;
constexpr int EV_N = 4800, EV_NP = 4864, OD_N = 4176, OD_NP = 4352;
constexpr float ALPHA = 1.41421356237f;
constexpr size_t MiB = 1u << 20;
constexpr size_t WS_CTL = 0, CTL_ZERO_BYTES = 1 * MiB;
constexpr int CW_BAR = 4096, CW_XRANK = 8192;
constexpr size_t WS_MOD = 1 * MiB, WS_SKB = 2 * MiB, WS_WL = 4 * MiB, WS_BS = 7 * MiB, WS_CNT = 9 * MiB;
constexpr size_t WS_WINE = 10 * MiB, WS_WOUTE = 29 * MiB, WS_WINO = 37 * MiB, WS_WOUTO = 54 * MiB, WS_WQ0 = 62 * MiB, WS_WQ1 = 70 * MiB;
constexpr size_t WS_HY = 78 * MiB, WS_Z = 206 * MiB, WS_LA = 510 * MiB, WS_BIG = 542 * MiB, WS_END = 1022 * MiB;

__device__ __forceinline__ float bf2f(unsigned short b) { return __uint_as_float(((unsigned)b) << 16); }
__device__ __forceinline__ unsigned pk2(float lo, float hi) { const bf2_t v = {(__bf16)lo, (__bf16)hi}; return __builtin_bit_cast(unsigned, v); }
__device__ __forceinline__ unsigned f2bf(float f) { return pk2(f, 0.f) & 0xffffu; }
__device__ __forceinline__ float lo2f(unsigned w) { return __uint_as_float(w << 16); }
__device__ __forceinline__ float hi2f(unsigned w) { return __uint_as_float(w & 0xffff0000u); }
template <int CTRL, int RM> __device__ __forceinline__ float dppo(float v) { return __int_as_float(__builtin_amdgcn_update_dpp(__float_as_int(v), __float_as_int(v), CTRL, RM, 0xF, false)); }
__device__ __forceinline__ float wsum(float v) {
    v += __int_as_float(__builtin_amdgcn_update_dpp(0, __float_as_int(v), 0xB1, 0xF, 0xF, false)); v += __int_as_float(__builtin_amdgcn_update_dpp(0, __float_as_int(v), 0x4E, 0xF, 0xF, false));
    v += __int_as_float(__builtin_amdgcn_update_dpp(0, __float_as_int(v), 0x141, 0xF, 0xF, false)); v += __int_as_float(__builtin_amdgcn_update_dpp(0, __float_as_int(v), 0x140, 0xF, 0xF, false));
    v += __int_as_float(__builtin_amdgcn_update_dpp(0, __float_as_int(v), 0x142, 0xA, 0xF, false)); v += __int_as_float(__builtin_amdgcn_update_dpp(0, __float_as_int(v), 0x143, 0xC, 0xF, false));
    return __int_as_float(__builtin_amdgcn_readlane(__float_as_int(v), 63));
}
__device__ __forceinline__ float wmax(float v) {
    v = fmaxf(v, dppo<0xB1, 0xF>(v)); v = fmaxf(v, dppo<0x4E, 0xF>(v)); v = fmaxf(v, dppo<0x141, 0xF>(v)); v = fmaxf(v, dppo<0x140, 0xF>(v));
    v = fmaxf(v, dppo<0x142, 0xA>(v)); v = fmaxf(v, dppo<0x143, 0xC>(v));
    return __int_as_float(__builtin_amdgcn_readlane(__float_as_int(v), 63));
}
__device__ __forceinline__ float xsum32(float x) { const auto r = __builtin_amdgcn_permlane32_swap(__float_as_uint(x), __float_as_uint(x), false, false); return __uint_as_float(r[0]) + __uint_as_float(r[1]); }
__device__ __forceinline__ float xsum16(float x) { const auto r = __builtin_amdgcn_permlane16_swap(__float_as_uint(x), __float_as_uint(x), false, false); return __uint_as_float(r[0]) + __uint_as_float(r[1]); }
__device__ __forceinline__ float xmax32(float x) { const auto r = __builtin_amdgcn_permlane32_swap(__float_as_uint(x), __float_as_uint(x), false, false); return fmaxf(__uint_as_float(r[0]), __uint_as_float(r[1])); }
__device__ __forceinline__ float xmax16(float x) { const auto r = __builtin_amdgcn_permlane16_swap(__float_as_uint(x), __float_as_uint(x), false, false); return fmaxf(__uint_as_float(r[0]), __uint_as_float(r[1])); }
__device__ __forceinline__ float rsum4(float v0, float v1, float v2, float v3) {
    const auto p = __builtin_amdgcn_permlane32_swap(__float_as_uint(v0), __float_as_uint(v2), false, false);
    const auto q = __builtin_amdgcn_permlane32_swap(__float_as_uint(v1), __float_as_uint(v3), false, false);
    const float P = __uint_as_float(p[0]) + __uint_as_float(p[1]);
    const float Q = __uint_as_float(q[0]) + __uint_as_float(q[1]);
    const auto t = __builtin_amdgcn_permlane16_swap(__float_as_uint(P), __float_as_uint(Q), false, false);
    return __uint_as_float(t[0]) + __uint_as_float(t[1]);
}
__device__ __forceinline__ float rdlane(float v, int l) { return __int_as_float(__builtin_amdgcn_readlane(__float_as_int(v), l)); }
__device__ __forceinline__ unsigned rdlaneu(unsigned v, int l) { return (unsigned)__builtin_amdgcn_readlane((int)v, l); }
__device__ __forceinline__ float dot2bf(unsigned a, unsigned b, float c) {
    return __builtin_amdgcn_fdot2_f32_bf16(__builtin_bit_cast(bf2_t, a), __builtin_bit_cast(bf2_t, b), c, false);
}
template <int CTRL, int RM> __device__ __forceinline__ float dppf(float v) {
    return __int_as_float(__builtin_amdgcn_update_dpp(0, __float_as_int(v), CTRL, RM, 0xF, false));
}
__device__ __forceinline__ float wsum_dpp(float v) {
    v += dppf<0xB1, 0xF>(v);
    v += dppf<0x4E, 0xF>(v);
    v += dppf<0x141, 0xF>(v);
    v += dppf<0x140, 0xF>(v);
    v += dppf<0x142, 0xA>(v);
    v += dppf<0x143, 0xC>(v);
    return rdlane(v, 63);
}
__device__ __forceinline__ float sum16_dpp(float v) {
    v += dppf<0xB1, 0xF>(v); v += dppf<0x4E, 0xF>(v); v += dppf<0x141, 0xF>(v); v += dppf<0x140, 0xF>(v);
    return v;
}
__device__ __forceinline__ float sigmoidf_(float x) { return 1.0f / (1.0f + expf(-x)); }
__device__ __forceinline__ unsigned ordkey(float f) { const unsigned u = __float_as_uint(f); return (u & 0x80000000u) ? ~u : (u | 0x80000000u); }
__device__ __forceinline__ unsigned fixkey20(float f) { const float c = fminf(fmaxf(f, -15.999f), 15.999f); return (unsigned)((int)rintf(c * 32768.0f) + (1 << 19)); }
__device__ __forceinline__ float unordkey(unsigned k) { return __uint_as_float((k & 0x80000000u) ? (k & 0x7fffffffu) : ~k); }

struct Args { const void* in[27]; float* out; unsigned char* ws; int ph_lo, ph_hi; };
struct Frame { LAS unsigned char* lds; int tid, lane, wave, bx, G, gw, ngw; };

struct EpiLora {
    static constexpr bool PERM = true, AFTER_DRAIN = false;
    pg8::bf16_t* O; int ldc; const float* w0; const float* a0;
    __device__ __forceinline__ void operator()(const pg8::f32x4 (&acc)[2][2][4][2], const pg8::Unit& u, int wr, int wc, int fr, int fq) const {
        const int row0 = u.pm * 256 + wr * 64 + fr; const int colt = u.pn * 256; const int type = u.pn >> 2;
        const int col0 = colt + wc * 32 + 8 * fq, ncol0 = col0 & 1023;
        const float* pv = (type == 0) ? w0 : a0;
        pg8::f32x4 bv[2][2];
#pragma unroll
        for (int bj = 0; bj < 2; ++bj)
#pragma unroll
            for (int n = 0; n < 2; ++n) bv[bj][n] = (type < 2) ? *(const pg8::f32x4*)(pv + ncol0 + bj * 128 + 4 * n) : (pg8::f32x4){0.f, 0.f, 0.f, 0.f};
#pragma unroll
        for (int ai = 0; ai < 2; ++ai)
#pragma unroll
            for (int m = 0; m < 4; ++m) { pg8::bf16_t* rowp = O + (size_t)(row0 + ai * 128 + m * 16) * ldc + col0;
#pragma unroll
                for (int bj = 0; bj < 2; ++bj) { pg8::f32x4 v0 = acc[ai][bj][m][0] + bv[bj][0], v1 = acc[ai][bj][m][1] + bv[bj][1];
                    if (type < 2) {
                        const float sc = (type == 0) ? 0.60653066f : 1.0f;
#pragma unroll
                        for (int j = 0; j < 4; ++j) { v0[j] = sc / (1.0f + __expf(-v0[j])); v1[j] = sc / (1.0f + __expf(-v1[j])); }
                    }
                    pg8::u32x4 w; w.x = pg8::cvt_pk_bf16(v0[0], v0[1]); w.y = pg8::cvt_pk_bf16(v0[2], v0[3]); w.z = pg8::cvt_pk_bf16(v1[0], v1[1]); w.w = pg8::cvt_pk_bf16(v1[2], v1[3]);
                    *(pg8::u32x4*)(rowp + bj * 128) = w; } }
    }
};

__device__ __forceinline__ void transpose_item(const float* W, int K, int N, int Npad, bf16* WT, LAS float* scr, int item, int lane) {
    const int nblk = Npad / 32, kb = item / nblk, nb = item % nblk, k0 = 64 * kb, n0 = 32 * nb;
    const int nl = lane & 31; const bool ok = (n0 + nl) < N;
#pragma unroll 8
    for (int i = 0; i < 32; ++i) { const int kk = 2 * i + (lane >> 5); scr[kk * 33 + nl] = ok ? W[(size_t)(k0 + kk) * N + n0 + nl] : 0.f; }
    asm volatile("s_waitcnt lgkmcnt(0)" ::: "memory");
    const int c = lane & 7;
#pragma unroll
    for (int j = 0; j < 4; ++j) { const int n = (lane >> 3) + 8 * j; const LAS float* s = scr + (8 * c) * 33 + n;
        u32x4 o; o.x = pk2(s[0 * 33], s[1 * 33]); o.y = pk2(s[2 * 33], s[3 * 33]); o.z = pk2(s[4 * 33], s[5 * 33]); o.w = pk2(s[6 * 33], s[7 * 33]);
        *(u32x4*)(WT + (size_t)(n0 + n) * K + k0 + 8 * c) = o; }
    asm volatile("s_waitcnt lgkmcnt(0)" ::: "memory");
}

__device__ __forceinline__ void ph_prologue(const Args& A, Frame& F) {
    unsigned char* ws = A.ws;
    {
        const float* c = (const float*)A.in[1]; const float* mw = (const float*)A.in[19]; const float* mb = (const float*)A.in[20];
        float* MOD = (float*)(ws + WS_MOD);
        LAS float* red = (LAS float*)F.lds;
        for (int it = F.bx; it < 96; it += F.G) {
            const int s = it / 24, cc = it % 24, col = cc * 256 + F.lane * 4;
            const float* W = mw + (size_t)s * 2048 * 6144 + col;
            f32x4 a0 = {0.f, 0.f, 0.f, 0.f}, a1 = {0.f, 0.f, 0.f, 0.f};
            const int k0 = F.wave * 256;
#pragma unroll 8
            for (int k = k0; k < k0 + 256; ++k) {
                float c0 = c[k], c1 = c[2048 + k];
                c0 = c0 / (1.0f + expf(-c0)); c1 = c1 / (1.0f + expf(-c1));
                const f32x4 w = *(const f32x4*)(W + (size_t)k * 6144);
                a0 += c0 * w; a1 += c1 * w;
            }
            *(LAS f32x4*)(red + ((F.wave * 2 + 0) * 256 + F.lane * 4)) = a0;
            *(LAS f32x4*)(red + ((F.wave * 2 + 1) * 256 + F.lane * 4)) = a1;
            __syncthreads();
            { const int b = F.tid >> 8, cl = F.tid & 255; float sm = 0.f;
#pragma unroll
              for (int w = 0; w < 8; ++w) sm += red[(w * 2 + b) * 256 + cl];
              MOD[(size_t)(s * 2 + b) * 6144 + cc * 256 + cl] = sm + mb[s * 6144 + cc * 256 + cl]; }
            __syncthreads();
        }
    }
    {
        LAS float* scr = (LAS float*)(F.lds + 16384 + F.wave * 8704);
        constexpr int I0 = 32 * (EV_NP / 32), I1 = 32 * 64, I2 = 32 * (OD_NP / 32);
        constexpr int NIT = I0 + I1 + I2 + 3 * I1;
        for (int it = F.gw; it < NIT; it += F.ngw) {
            int r = it;
            if (r < I0) { transpose_item((const float*)A.in[3], 2048, EV_N, EV_NP, (bf16*)(ws + WS_WINE), scr, r, F.lane); continue; } r -= I0;
            if (r < I1) { transpose_item((const float*)A.in[4], 2048, 2048, 2048, (bf16*)(ws + WS_WOUTE), scr, r, F.lane); continue; } r -= I1;
            if (r < I2) { transpose_item((const float*)A.in[17], 2048, OD_N, OD_NP, (bf16*)(ws + WS_WINO), scr, r, F.lane); continue; } r -= I2;
            if (r < I1) { transpose_item((const float*)A.in[18], 2048, 2048, 2048, (bf16*)(ws + WS_WOUTO), scr, r, F.lane); continue; } r -= I1;
            if (r < I1) { transpose_item((const float*)A.in[23], 2048, 2048, 2048, (bf16*)(ws + WS_WQ0), scr, r, F.lane); continue; } r -= I1;
            transpose_item((const float*)A.in[23] + (size_t)2048 * 2048, 2048, 2048, 2048, (bf16*)(ws + WS_WQ1), scr, r, F.lane);
        }
    }
    {
        const float* w2 = (const float*)A.in[8]; const float* a2 = (const float*)A.in[10]; const float* g2 = (const float*)A.in[11];
        bf16* WL = (bf16*)(ws + WS_WL);
        const int gt = F.bx * NTHREADS + F.tid, ngt = F.G * NTHREADS;
        for (int i = gt; i < 3072 * 512; i += ngt) {
            const int n = i >> 9, k = i & 511; float v = 0.f;
            if (n < 1024) { if (k < 96) v = w2[k * 1024 + n]; }
            else if (n < 2048) { if (k >= 96 && k < 192) v = a2[(k - 96) * 1024 + (n - 1024)]; }
            else { if (k >= 192 && k < 448) v = g2[(k - 192) * 1024 + (n - 2048)]; }
            WL[i] = (bf16)f2bf(v);
        }
        const float* sk = (const float*)A.in[24]; bf16* SKB = (bf16*)(ws + WS_SKB);
        for (int i = gt; i < 2 * 262144; i += ngt) SKB[i] = (bf16)f2bf(sk[i]);
    }
}

__device__ __forceinline__ void ph_mod_x(const Args& A, Frame& F) {
    const float* x = (const float*)A.in[0]; const float* MOD = (const float*)(A.ws + WS_MOD); bf16* H = (bf16*)(A.ws + WS_HY);
    for (int t = F.gw; t < TOK; t += F.ngw) {
        const int b = t >> 14; const float* sh = MOD + (size_t)(0 * 2 + b) * 6144; const float* sc = sh + 2048;
#pragma unroll
        for (int j = 0; j < 8; ++j) { const int idx = j * 256 + F.lane * 4;
            const f32x4 xv = *(const f32x4*)(x + (size_t)t * DM + idx), sv = *(const f32x4*)(sc + idx), hv = *(const f32x4*)(sh + idx);
            const f32x4 o = xv * (1.0f + sv) + hv; u32x2 w; w.x = pk2(o[0], o[1]); w.y = pk2(o[2], o[3]);
            *(u32x2*)(H + (size_t)t * DM + idx) = w; }
    }
}

__device__ __forceinline__ void ph_even_post(const Args& A, Frame& F) {
    bf16* Z = (bf16*)(A.ws + WS_Z); const int* positions = (const int*)A.in[2]; const float* mu = (const float*)A.in[6];
    bf16* RKV = (bf16*)A.out; bf16* LAp = (bf16*)(A.ws + WS_LA);
    const int i = F.lane & 31; const float inv = powf(10000.0f, -(float)i / 32.0f);
    const int i4 = F.lane & 7, hs = F.lane >> 3;
    for (int t = F.gw; t < TOK; t += F.ngw) {
        const int s = t & (SEQ - 1); bf16* zr = Z + (size_t)t * EV_NP;
        float sn, cs; sincosf((float)positions[t] * inv, &sn, &cs);
        float c4[4], s4[4];
#pragma unroll
        for (int e = 0; e < 4; ++e) { c4[e] = __shfl(cs, 4 * i4 + e); s4[e] = __shfl(sn, 4 * i4 + e); }
#pragma unroll
        for (int it = 0; it < 3; ++it) { const int hd = it * 8 + hs; if (hd < 18) { bf16* hp = zr + hd * 64 + 4 * i4;
            const u32x2 a = *(const u32x2*)hp, b = *(const u32x2*)(hp + 32);
            const float t1[4] = {lo2f(a.x), hi2f(a.x), lo2f(a.y), hi2f(a.y)}, t2[4] = {lo2f(b.x), hi2f(b.x), lo2f(b.y), hi2f(b.y)};
            float o1[4], o2[4];
#pragma unroll
            for (int e = 0; e < 4; ++e) { o1[e] = t1[e] * c4[e] - t2[e] * s4[e]; o2[e] = t2[e] * c4[e] + t1[e] * s4[e]; }
            *(u32x2*)hp = (u32x2){pk2(o1[0], o1[1]), pk2(o1[2], o1[3])}; *(u32x2*)(hp + 32) = (u32x2){pk2(o2[0], o2[1]), pk2(o2[2], o2[3])}; } }
        const bf16* zp = zr - EV_NP; const bool hasprev = s > 0;
#pragma unroll
        for (int m = 0; m < 7; ++m) { const int j = 8 * (F.lane + 64 * m); if (j < 3520) {
            const u32x4 cw = *(const u32x4*)(zr + 1280 + j); u32x4 pw = {0u, 0u, 0u, 0u}; if (hasprev) pw = *(const u32x4*)(zp + 1280 + j);
            const f32x4 m0 = *(const f32x4*)(mu + j), m1 = *(const f32x4*)(mu + j + 4);
            const unsigned cwa[4] = {cw.x, cw.y, cw.z, cw.w}, pwa[4] = {pw.x, pw.y, pw.z, pw.w}; const float mm[8] = {m0[0], m0[1], m0[2], m0[3], m1[0], m1[1], m1[2], m1[3]};
            float v[8];
#pragma unroll
            for (int q = 0; q < 4; ++q) { const float c0 = lo2f(cwa[q]), c1 = hi2f(cwa[q]), p0 = lo2f(pwa[q]), p1 = hi2f(pwa[q]); v[2 * q] = c0 + (p0 - c0) * mm[2 * q]; v[2 * q + 1] = c1 + (p1 - c1) * mm[2 * q + 1]; }
            bf16* dst;
            if (j < 3072) { dst = RKV + (size_t)(j >> 10) * TOK * 1024 + (size_t)t * 1024 + (j & 1023); }
            else if (j < 3168) { dst = LAp + (size_t)t * 512 + (j - 3072);
#pragma unroll
                for (int e = 0; e < 8; ++e) v[e] = tanhf(v[e]); }
            else if (j < 3264) { dst = LAp + (size_t)t * 512 + 96 + (j - 3168); }
            else { dst = LAp + (size_t)t * 512 + 192 + (j - 3264);
#pragma unroll
                for (int e = 0; e < 8; ++e) v[e] = sigmoidf_(v[e]); }
            *(u32x4*)dst = (u32x4){pk2(v[0], v[1]), pk2(v[2], v[3]), pk2(v[4], v[5]), pk2(v[6], v[7])};
        } }
        if (F.lane < 8) *(u32x4*)(LAp + (size_t)t * 512 + 448 + 8 * F.lane) = (u32x4){0u, 0u, 0u, 0u};
    }
}

__device__ __forceinline__ void ph_scan_pack(const Args& A, Frame& F) {
    const bf16* Z = (const bf16*)(A.ws + WS_Z); const bf16* RKV = (const bf16*)A.out;
    const float* k_k = (const float*)A.in[12]; const float* k_a = (const float*)A.in[13]; const float* r_k = (const float*)A.in[14];
    unsigned* PK = (unsigned*)(A.ws + WS_BIG); float* BS = (float*)(A.ws + WS_BS);
    const int g16 = F.lane >> 4, c16 = F.lane & 15;
    for (int it = F.gw; it < TOK * 4; it += F.ngw) {
        const int item = it * 4 + g16; const int t = item >> 4, h = item & 15, c = h * 64 + 4 * c16, b = t >> 14, s = t & (SEQ - 1);
        const u32x2 rw = *(const u32x2*)(RKV + (size_t)t * 1024 + c), kw = *(const u32x2*)(RKV + (size_t)TOK * 1024 + (size_t)t * 1024 + c), vw = *(const u32x2*)(RKV + (size_t)2 * TOK * 1024 + (size_t)t * 1024 + c);
        const u32x2 ew = *(const u32x2*)(Z + (size_t)t * EV_NP + 1280 + c), aw = *(const u32x2*)(Z + (size_t)t * EV_NP + 1280 + 1024 + c);
        const f32x4 kk4 = *(const f32x4*)(k_k + c), ka4 = *(const f32x4*)(k_a + c), rk4 = *(const f32x4*)(r_k + c);
        const float r[4] = {lo2f(rw.x), hi2f(rw.x), lo2f(rw.y), hi2f(rw.y)}, kr[4] = {lo2f(kw.x), hi2f(kw.x), lo2f(kw.y), hi2f(kw.y)}, v[4] = {lo2f(vw.x), hi2f(vw.x), lo2f(vw.y), hi2f(vw.y)};
        const float e[4] = {lo2f(ew.x), hi2f(ew.x), lo2f(ew.y), hi2f(ew.y)}, a[4] = {lo2f(aw.x), hi2f(aw.x), lo2f(aw.y), hi2f(aw.y)};
        float kkv[4], kp[4]; float ss = 0.f, bsum = 0.f;
#pragma unroll
        for (int q = 0; q < 4; ++q) { kkv[q] = kr[q] * kk4[q]; ss += kkv[q] * kkv[q]; kp[q] = kr[q] * (1.0f + (a[q] - 1.0f) * ka4[q]); bsum += r[q] * kp[q] * rk4[q]; }
        ss = sum16_dpp(ss); bsum = sum16_dpp(bsum);
        const float rn = 1.0f / fmaxf(sqrtf(ss), 1e-12f);
        if (c16 == 0) BS[(size_t)t * 16 + h] = bsum;
        unsigned w[12];
#pragma unroll
        for (int q = 0; q < 4; ++q) { const float kkn = kkv[q] * rn; w[3 * q] = pk2(r[q], e[q]); w[3 * q + 1] = pk2(kp[q], kkn); w[3 * q + 2] = pk2(kkn * a[q], v[q]); }
        u32x4* dst = (u32x4*)(PK + ((size_t)((b * 16 + h) * SEQ + s) * 64 + 4 * c16) * 3);
        dst[0] = (u32x4){w[0], w[1], w[2], w[3]}; dst[1] = (u32x4){w[4], w[5], w[6], w[7]}; dst[2] = (u32x4){w[8], w[9], w[10], w[11]};
    }
}

__device__ __forceinline__ void ph_swa(const Args& A, Frame& F) {
    const bf16* Z = (const bf16*)(A.ws + WS_Z); bf16* Y = (bf16*)(A.ws + WS_HY); const float* sinks = (const float*)A.in[5];
    LAS unsigned char* KL = F.lds; LAS unsigned char* VL = F.lds + 256 * 136;
    for (int u = F.bx; u < 512; u += F.G) {
        const int b = u >> 8, n = (u >> 1) & 127, kvh = u & 1;
        __syncthreads();
        for (int c = F.tid; c < 2048; c += NTHREADS) { const int jw = c >> 3, cc = c & 7; const int s = n * 128 - 128 + jw;
            u32x4 kv = {0u, 0u, 0u, 0u}, vv = {0u, 0u, 0u, 0u};
            if (s >= 0) { const bf16* row = Z + (size_t)(b * SEQ + s) * EV_NP; kv = *(const u32x4*)(row + 1024 + kvh * 64 + cc * 8); vv = *(const u32x4*)(row + 1152 + kvh * 64 + cc * 8); }
            *(LAS u32x2*)(KL + jw * 136 + cc * 16) = (u32x2){kv.x, kv.y}; *(LAS u32x2*)(KL + jw * 136 + cc * 16 + 8) = (u32x2){kv.z, kv.w};
            *(LAS u32x2*)(VL + jw * 136 + cc * 16) = (u32x2){vv.x, vv.y}; *(LAS u32x2*)(VL + jw * 136 + cc * 16 + 8) = (u32x2){vv.z, vv.w}; }
        __syncthreads();
        for (int it = F.wave; it < 1024; it += NWAVES) {
            const int i = it >> 3, g = it & 7, head = kvh * 8 + g; const int t = b * SEQ + n * 128 + i;
            const float qv = bf2f(Z[(size_t)t * EV_NP + head * 64 + F.lane]) * 0.125f;
            const int jw0 = i + 1 + F.lane, jw1 = jw0 + 64;
            const bool val0 = (n > 0) || (jw0 >= 128), val1 = (n > 0) || (jw1 >= 128);
            float s0 = 0.f, s1 = 0.f;
#pragma unroll
            for (int d4 = 0; d4 < 16; ++d4) {
                const u32x2 k0 = *(const LAS u32x2*)(KL + jw0 * 136 + d4 * 8), k1 = *(const LAS u32x2*)(KL + jw1 * 136 + d4 * 8);
                const float q0 = rdlane(qv, 4 * d4), q1 = rdlane(qv, 4 * d4 + 1), q2 = rdlane(qv, 4 * d4 + 2), q3 = rdlane(qv, 4 * d4 + 3);
                s0 += q0 * lo2f(k0.x) + q1 * hi2f(k0.x) + q2 * lo2f(k0.y) + q3 * hi2f(k0.y);
                s1 += q0 * lo2f(k1.x) + q1 * hi2f(k1.x) + q2 * lo2f(k1.y) + q3 * hi2f(k1.y);
            }
            const float sink = sinks[head];
            s0 = val0 ? s0 : -INFINITY; s1 = val1 ? s1 : -INFINITY;
            const float mx = fmaxf(wmax(fmaxf(s0, s1)), sink);
            float p0 = val0 ? expf(s0 - mx) : 0.f, p1 = val1 ? expf(s1 - mx) : 0.f;
            const float den = wsum(p0 + p1) + expf(sink - mx); const float rden = 1.0f / den;
            p0 *= rden; p1 *= rden;
            float o = 0.f;
            const LAS bf16* vcol = (const LAS bf16*)VL + F.lane;
#pragma unroll 8
            for (int jj = 0; jj < 64; ++jj) o += rdlane(p0, jj) * bf2f(vcol[(i + 1 + jj) * 68]);
#pragma unroll 8
            for (int jj = 0; jj < 64; ++jj) o += rdlane(p1, jj) * bf2f(vcol[(i + 65 + jj) * 68]);
            Y[(size_t)t * DM + head * 64 + F.lane] = (bf16)f2bf(o);
        }
    }
}

__device__ __forceinline__ bf16x8 as_bf8(u32x4 v) { return __builtin_bit_cast(bf16x8, v); }
__device__ __forceinline__ void ph_swa_mfma(const Args& A, Frame& F) {
    const bf16* Z = (const bf16*)(A.ws + WS_Z); bf16* Y = (bf16*)(A.ws + WS_HY); const float* sinks = (const float*)A.in[5];
    LAS bf16* KL = (LAS bf16*)F.lds;
    LAS bf16* VT = (LAS bf16*)(F.lds + 36864);
    const int l15 = F.lane & 15, g4 = F.lane >> 4;
    for (int u = F.bx; u < 512; u += F.G) {
        const int b = u >> 8, n = (u >> 1) & 127, kvh = u & 1;
        __syncthreads();
        for (int c = F.tid; c < 2048; c += NTHREADS) { const int jw = c >> 3, cc = c & 7; const int sp = n * 128 - 128 + jw;
            u32x4 kv = {0u, 0u, 0u, 0u}, vv = {0u, 0u, 0u, 0u};
            if (sp >= 0) { const bf16* row = Z + (size_t)(b * SEQ + sp) * EV_NP; kv = *(const u32x4*)(row + 1024 + kvh * 64 + cc * 8); vv = *(const u32x4*)(row + 1152 + kvh * 64 + cc * 8); }
            *(LAS u32x4*)(KL + jw * 72 + cc * 8) = kv;
            const unsigned vw[4] = {vv.x, vv.y, vv.z, vv.w};
#pragma unroll
            for (int q = 0; q < 4; ++q) { VT[(8 * cc + 2 * q) * 264 + jw] = (bf16)(vw[q] & 0xffffu); VT[(8 * cc + 2 * q + 1) * 264 + jw] = (bf16)(vw[q] >> 16); } }
        __syncthreads();
        const int head = kvh * 8 + F.wave; const float sink = sinks[head];
#pragma unroll 1
        for (int qt = 0; qt < 8; ++qt) {
            const int iq = 16 * qt + l15; const int t = b * SEQ + n * 128 + iq;
            bf16x8 qf[2];
#pragma unroll
            for (int ks = 0; ks < 2; ++ks) qf[ks] = *(const bf16x8*)(Z + (size_t)t * EV_NP + head * 64 + 32 * ks + 8 * g4);
            float sv[10][4]; float mx = -INFINITY;
#pragma unroll
            for (int kk = 0; kk < 9; ++kk) { const int kt = qt + kk;
                f32x4 acc = {0.f, 0.f, 0.f, 0.f};
#pragma unroll
                for (int ks = 0; ks < 2; ++ks) acc = __builtin_amdgcn_mfma_f32_16x16x32_bf16(*(const LAS bf16x8*)(KL + (16 * kt + l15) * 72 + 32 * ks + 8 * g4), qf[ks], acc, 0, 0, 0);
#pragma unroll
                for (int rg_ = 0; rg_ < 4; ++rg_) { const int jw = 16 * kt + 4 * g4 + rg_; const bool ok = (jw >= iq + 1) && (jw <= iq + 128) && ((n > 0) || (jw >= 128));
                    sv[kk][rg_] = ok ? acc[rg_] * 0.125f : -INFINITY; mx = fmaxf(mx, sv[kk][rg_]); } }
#pragma unroll
            for (int rg_ = 0; rg_ < 4; ++rg_) sv[9][rg_] = -INFINITY;
            mx = xmax16(mx); mx = xmax32(mx); mx = fmaxf(mx, sink);
            float sm = 0.f;
#pragma unroll
            for (int kk = 0; kk < 10; ++kk)
#pragma unroll
                for (int rg_ = 0; rg_ < 4; ++rg_) { const float pv = (sv[kk][rg_] == -INFINITY) ? 0.f : __expf(sv[kk][rg_] - mx); sv[kk][rg_] = pv; sm += pv; }
            sm = xsum16(sm); sm = xsum32(sm);
            const float rden = 1.0f / (sm + __expf(sink - mx));
            f32x4 oacc[4];
#pragma unroll
            for (int dt = 0; dt < 4; ++dt) oacc[dt] = (f32x4){0.f, 0.f, 0.f, 0.f};
#pragma unroll
            for (int pp = 0; pp < 5; ++pp) { const int ka = qt + 2 * pp, kb = (qt + 2 * pp + 1 < 16) ? (qt + 2 * pp + 1) : 15;
                const bf16x8 pb = as_bf8((u32x4){pk2(sv[2 * pp][0] * rden, sv[2 * pp][1] * rden), pk2(sv[2 * pp][2] * rden, sv[2 * pp][3] * rden),
                                                  pk2(sv[2 * pp + 1][0] * rden, sv[2 * pp + 1][1] * rden), pk2(sv[2 * pp + 1][2] * rden, sv[2 * pp + 1][3] * rden)});
#pragma unroll
                for (int dt = 0; dt < 4; ++dt) { const LAS bf16* vr = VT + (16 * dt + l15) * 264 + 4 * g4;
                    const u32x2 va = *(const LAS u32x2*)(vr + 16 * ka), vb2 = *(const LAS u32x2*)(vr + 16 * kb);
                    oacc[dt] = __builtin_amdgcn_mfma_f32_16x16x32_bf16(as_bf8((u32x4){va.x, va.y, vb2.x, vb2.y}), pb, oacc[dt], 0, 0, 0); } }
#pragma unroll
            for (int dt = 0; dt < 4; ++dt) *(u32x2*)(Y + (size_t)t * DM + head * 64 + 16 * dt + 4 * g4) = (u32x2){pk2(oacc[dt][0], oacc[dt][1]), pk2(oacc[dt][2], oacc[dt][3])};
        }
    }
}

constexpr int FR_BYTES = 15360;
__device__ __forceinline__ int fr_rho(int ks, int g, int j) { return 16 * (2 * ks + (j >> 2)) + 4 * g + (j & 3); }
__device__ __forceinline__ void ph_scan_prep(const Args& A, Frame& F) {
    const bf16* Z = (const bf16*)(A.ws + WS_Z); const bf16* RKV = (const bf16*)A.out;
    const float* k_k = (const float*)A.in[12]; const float* k_a = (const float*)A.in[13]; const float* r_k = (const float*)A.in[14];
    unsigned char* FR = A.ws + WS_BIG; float* BS = (float*)(A.ws + WS_BS);
    LAS float* EE = (LAS float*)F.lds;
    LAS float* VV = (LAS float*)(F.lds + 4096);
    LAS float* KHf = (LAS float*)(F.lds + 8192);
    LAS float* RHf = (LAS float*)(F.lds + 12352);
    LAS float* BPf = (LAS float*)(F.lds + 16512);
    LAS bf16* AHb = (LAS bf16*)(F.lds + 20672);
    LAS bf16* BHb = (LAS bf16*)(F.lds + 22976);
    LAS bf16* KHb = (LAS bf16*)(F.lds + 25280);
    LAS bf16* RHb = (LAS bf16*)(F.lds + 27584);
    LAS bf16* APT = (LAS bf16*)(F.lds + 29888);
    LAS float* GA = (LAS float*)(F.lds + 32960);
    LAS float* GB = GA + 16 * 17; LAS float* GMA = GB + 16 * 17; LAS float* GMB = GMA + 16 * 17;
    LAS float* TT = (LAS float*)(F.lds + 37312);
    LAS bf16* P1b = (LAS bf16*)(F.lds + 38400);
    LAS bf16* P2b = (LAS bf16*)(F.lds + 41472);
    LAS bf16* MAT = (LAS bf16*)(F.lds + 42240);
    LAS float* WW = (LAS float*)(F.lds + 43008);
    const int tt = F.tid >> 5, kq = F.tid & 31;
    const int l15 = F.lane & 15, g = F.lane >> 4;
    const bf16x8 zero8 = {0, 0, 0, 0, 0, 0, 0, 0};
    unsigned p_rw = 0u, p_kw = 0u, p_vw = 0u, p_ew = 0u, p_aw = 0u; f32x2 p_kk = {0.f, 0.f}, p_ka = {0.f, 0.f}, p_rk = {0.f, 0.f};
#define PREP_LOAD(it_) do { const int bh_ = (it_) >> 10, ch_ = (it_) & 1023, b_ = bh_ >> 4, h_ = bh_ & 15; const int tok_ = b_ * SEQ + ch_ * 16 + tt, c_ = h_ * 64 + 2 * kq; \
        p_rw = *(const unsigned*)(RKV + (size_t)tok_ * 1024 + c_); p_kw = *(const unsigned*)(RKV + (size_t)TOK * 1024 + (size_t)tok_ * 1024 + c_); p_vw = *(const unsigned*)(RKV + (size_t)2 * TOK * 1024 + (size_t)tok_ * 1024 + c_); \
        p_ew = *(const unsigned*)(Z + (size_t)tok_ * EV_NP + 1280 + c_); p_aw = *(const unsigned*)(Z + (size_t)tok_ * EV_NP + 1280 + 1024 + c_); \
        p_kk = *(const f32x2*)(k_k + c_); p_ka = *(const f32x2*)(k_a + c_); p_rk = *(const f32x2*)(r_k + c_); } while (0)
    if (F.bx < 32 * 1024) PREP_LOAD(F.bx);
    for (int it = F.bx; it < 32 * 1024; it += F.G) {
        const int bh = it >> 10, ch = it & 1023, b = bh >> 4, h = bh & 15;
        const int tok = b * SEQ + ch * 16 + tt;
        __syncthreads();
        float e2[2], kkn[2], kka[2], kp[2], r2[2];
        {
            const unsigned rw = p_rw, kw = p_kw, vw = p_vw, ew = p_ew, aw = p_aw; const f32x2 kk2 = p_kk, ka2 = p_ka, rk2 = p_rk;
            const float kr[2] = {lo2f(kw), hi2f(kw)}, av[2] = {lo2f(aw), hi2f(aw)};
            r2[0] = lo2f(rw); r2[1] = hi2f(rw); e2[0] = lo2f(ew); e2[1] = hi2f(ew);
            float kkv[2], ss = 0.f, bsum = 0.f;
#pragma unroll
            for (int q = 0; q < 2; ++q) { kkv[q] = kr[q] * kk2[q]; ss += kkv[q] * kkv[q]; kp[q] = kr[q] * (1.0f + (av[q] - 1.0f) * ka2[q]); bsum += r2[q] * kp[q] * rk2[q]; }
            ss = xsum16(sum16_dpp(ss)); bsum = xsum16(sum16_dpp(bsum));
            const float rn = 1.0f / fmaxf(sqrtf(ss), 1e-12f);
#pragma unroll
            for (int q = 0; q < 2; ++q) { kkn[q] = kkv[q] * rn; kka[q] = kkn[q] * av[q]; }
            if (kq == 0) BS[(size_t)tok * 16 + h] = bsum;
            { const int itn = it + F.G; if (itn < 32 * 1024) PREP_LOAD(itn); }
            *(LAS f32x2*)(EE + tt * 64 + 2 * kq) = (f32x2){e2[0], e2[1]};
            *(LAS f32x2*)(VV + tt * 64 + 2 * kq) = (f32x2){lo2f(vw), hi2f(vw)};
        }
        __syncthreads();
        {
            float L[2] = {0.f, 0.f}, L15[2] = {0.f, 0.f};
#pragma unroll
            for (int i = 0; i < 16; ++i) { const f32x2 ev = *(const LAS f32x2*)(EE + i * 64 + 2 * kq); L15[0] += ev.x; L15[1] += ev.y; if (i <= tt) { L[0] += ev.x; L[1] += ev.y; } }
            float kh[2], ah[2], bhv[2], rh[2], ap[2], bp[2];
#pragma unroll
            for (int q = 0; q < 2; ++q) { const float wt = __expf(-L[q]), iwt = __expf(L[q]), wprev = __expf(-(L[q] - e2[q])), wrest = __expf(-(L15[q] - L[q]));
                kh[q] = kkn[q] * wprev; ah[q] = kka[q] * iwt; bhv[q] = kp[q] * iwt; rh[q] = r2[q] * wt; ap[q] = kka[q] * wrest; bp[q] = kp[q] * wrest;
                if (tt == 15) WW[2 * kq + q] = wt; }
            KHf[tt * 65 + 2 * kq] = kh[0]; KHf[tt * 65 + 2 * kq + 1] = kh[1]; RHf[tt * 65 + 2 * kq] = rh[0]; RHf[tt * 65 + 2 * kq + 1] = rh[1]; BPf[tt * 65 + 2 * kq] = bp[0]; BPf[tt * 65 + 2 * kq + 1] = bp[1];
            *(LAS unsigned*)(KHb + tt * 72 + 2 * kq) = pk2(kh[0], kh[1]); *(LAS unsigned*)(AHb + tt * 72 + 2 * kq) = pk2(ah[0], ah[1]);
            *(LAS unsigned*)(BHb + tt * 72 + 2 * kq) = pk2(bhv[0], bhv[1]); *(LAS unsigned*)(RHb + tt * 72 + 2 * kq) = pk2(rh[0], rh[1]);
            APT[(2 * kq) * 24 + tt] = (bf16)f2bf(ap[0]); APT[(2 * kq + 1) * 24 + tt] = (bf16)f2bf(ap[1]);
        }
        __syncthreads();
        if (F.wave < 4) {
            const int mat = F.wave; const LAS bf16* X = (mat & 1) ? BHb : AHb; const LAS bf16* Y = (mat & 2) ? RHb : KHb;
            f32x4 acc = {0.f, 0.f, 0.f, 0.f};
#pragma unroll
            for (int ks = 0; ks < 2; ++ks) acc = __builtin_amdgcn_mfma_f32_16x16x32_bf16(*(const LAS bf16x8*)(X + l15 * 72 + 32 * ks + 8 * g), *(const LAS bf16x8*)(Y + l15 * 72 + 32 * ks + 8 * g), acc, 0, 0, 0);
            LAS float* dst = (mat == 0) ? GA : ((mat == 1) ? GB : ((mat == 2) ? GMA : GMB));
#pragma unroll
            for (int rg_ = 0; rg_ < 4; ++rg_) { const int i = 4 * g + rg_; const bool nz = (mat & 2) ? (i <= l15) : (i < l15); const float v = nz ? acc[rg_] : 0.f;
                dst[i * 17 + l15] = v; if (mat == 2) MAT[l15 * 24 + i] = (bf16)f2bf(v); }
        }
        __syncthreads();
        if (F.tid < 16) {
            float x[16];
#pragma unroll
            for (int i = 15; i >= 0; --i) { float v = (i == F.tid) ? 1.0f : 0.f;
#pragma unroll
                for (int m = i + 1; m < 16; ++m) v -= GA[i * 17 + m] * x[m];
                x[i] = v; }
#pragma unroll
            for (int i = 0; i < 16; ++i) TT[i * 17 + F.tid] = x[i];
        }
        __syncthreads();
        {
            float x0 = 0.f, x1 = 0.f;
#pragma unroll
            for (int m = 0; m < 16; ++m) { const float tv = TT[m * 17 + tt]; x0 -= KHf[m * 65 + 2 * kq] * tv; x1 -= KHf[m * 65 + 2 * kq + 1] * tv; }
            P1b[(2 * kq) * 24 + tt] = (bf16)f2bf(x0); P1b[(2 * kq + 1) * 24 + tt] = (bf16)f2bf(x1);
            if (F.tid < 256) { const int i = F.tid >> 4, t = F.tid & 15; float x = 0.f;
#pragma unroll
                for (int m = 0; m < 16; ++m) x -= GB[i * 17 + m] * TT[m * 17 + t];
                P2b[i * 24 + t] = (bf16)f2bf(x); }
        }
        __syncthreads();
        {
            unsigned char* fr = FR + (size_t)it * FR_BYTES;
            const int mt = F.wave >> 1, ks = F.wave & 1;
            const bf16x8 aP0 = (g < 2) ? *(const LAS bf16x8*)(P1b + (16 * (2 * ks) + l15) * 24 + 8 * g) : zero8;
            const bf16x8 aP1 = (g < 2) ? *(const LAS bf16x8*)(P1b + (16 * (2 * ks + 1) + l15) * 24 + 8 * g) : zero8;
            const bf16x8 bAP = (g < 2) ? *(const LAS bf16x8*)(APT + (16 * mt + l15) * 24 + 8 * g) : zero8;
            const f32x4 z4 = {0.f, 0.f, 0.f, 0.f};
            const f32x4 d0 = __builtin_amdgcn_mfma_f32_16x16x32_bf16(aP0, bAP, z4, 0, 0, 0), d1 = __builtin_amdgcn_mfma_f32_16x16x32_bf16(aP1, bAP, z4, 0, 0, 0);
            *(u32x4*)(fr + (size_t)(F.wave * 64 + F.lane) * 16) = (u32x4){pk2(d0[0], d0[1]), pk2(d0[2], d0[3]), pk2(d1[0], d1[1]), pk2(d1[2], d1[3])};
            if (F.wave < 4) {
                const bf16x8 aP2 = (g < 2) ? *(const LAS bf16x8*)(P2b + l15 * 24 + 8 * g) : zero8;
                const bf16x8 bA = (g < 2) ? *(const LAS bf16x8*)(APT + (16 * F.wave + l15) * 24 + 8 * g) : zero8;
                f32x4 d = __builtin_amdgcn_mfma_f32_16x16x32_bf16(aP2, bA, z4, 0, 0, 0);
#pragma unroll
                for (int rg_ = 0; rg_ < 4; ++rg_) d[rg_] += BPf[(4 * g + rg_) * 65 + 16 * F.wave + l15];
                *(u32x2*)(fr + 8192 + (size_t)(F.wave * 64 + F.lane) * 8) = (u32x2){pk2(d[0], d[1]), pk2(d[2], d[3])};
            } else if (F.wave < 6) {
                const int ks2 = F.wave - 4;
                const bf16x8 a0 = (g < 2) ? *(const LAS bf16x8*)(P1b + (16 * (2 * ks2) + l15) * 24 + 8 * g) : zero8;
                const bf16x8 a1 = (g < 2) ? *(const LAS bf16x8*)(P1b + (16 * (2 * ks2 + 1) + l15) * 24 + 8 * g) : zero8;
                const bf16x8 bM = (g < 2) ? *(const LAS bf16x8*)(MAT + l15 * 24 + 8 * g) : zero8;
                f32x4 q0 = __builtin_amdgcn_mfma_f32_16x16x32_bf16(a0, bM, z4, 0, 0, 0), q1 = __builtin_amdgcn_mfma_f32_16x16x32_bf16(a1, bM, z4, 0, 0, 0);
#pragma unroll
                for (int rg_ = 0; rg_ < 4; ++rg_) { q0[rg_] += RHf[l15 * 65 + 16 * (2 * ks2) + 4 * g + rg_]; q1[rg_] += RHf[l15 * 65 + 16 * (2 * ks2 + 1) + 4 * g + rg_]; }
                *(u32x4*)(fr + 10240 + (size_t)(ks2 * 64 + F.lane) * 16) = (u32x4){pk2(q0[0], q0[1]), pk2(q0[2], q0[3]), pk2(q1[0], q1[1]), pk2(q1[2], q1[3])};
            } else if (F.wave == 6) {
                const bf16x8 aP2 = (g < 2) ? *(const LAS bf16x8*)(P2b + l15 * 24 + 8 * g) : zero8;
                const bf16x8 bM = (g < 2) ? *(const LAS bf16x8*)(MAT + l15 * 24 + 8 * g) : zero8;
                f32x4 d = __builtin_amdgcn_mfma_f32_16x16x32_bf16(aP2, bM, z4, 0, 0, 0);
#pragma unroll
                for (int rg_ = 0; rg_ < 4; ++rg_) d[rg_] += GMB[(4 * g + rg_) * 17 + l15];
                *(u32x2*)(fr + 12288 + (size_t)F.lane * 8) = (u32x2){pk2(d[0], d[1]), pk2(d[2], d[3])};
            } else {
                *(float*)(fr + 14848 + F.lane * 4) = WW[F.lane];
            }
            if (F.tid < 256) {
                const int rg = F.tid >> 6, row = 16 * rg + l15, s4 = 4 * g;
                *(u32x2*)(fr + 12800 + (size_t)(rg * 64 + F.lane) * 8) = (u32x2){pk2(VV[s4 * 64 + row], VV[(s4 + 1) * 64 + row]), pk2(VV[(s4 + 2) * 64 + row], VV[(s4 + 3) * 64 + row])};
            }
        }
    }
}
struct ScanFrag { u32x4 g[4][2]; u32x2 f[4]; u32x4 q1[2]; u32x2 q2; u32x2 vt; f32x4 w[4]; };
__device__ __forceinline__ void scan_frag_load(ScanFrag& fr, const unsigned char* base, int rg, int lane) {
#pragma unroll
    for (int mt = 0; mt < 4; ++mt) {
#pragma unroll
        for (int ks = 0; ks < 2; ++ks) fr.g[mt][ks] = *(const u32x4*)(base + (size_t)((mt * 2 + ks) * 64 + lane) * 16);
        fr.f[mt] = *(const u32x2*)(base + 8192 + (size_t)(mt * 64 + lane) * 8);
        fr.w[mt] = *(const f32x4*)(base + 14848 + (16 * mt + 4 * (lane >> 4)) * 4); }
#pragma unroll
    for (int ks = 0; ks < 2; ++ks) fr.q1[ks] = *(const u32x4*)(base + 10240 + (size_t)(ks * 64 + lane) * 16);
    fr.q2 = *(const u32x2*)(base + 12288 + (size_t)lane * 8);
    fr.vt = *(const u32x2*)(base + 12800 + (size_t)(rg * 64 + lane) * 8);
}
__device__ __forceinline__ void scan_chunk(f32x4 (&acc)[4], const ScanFrag& fr, bf16* yout) {
    const bf16x8 sb0 = as_bf8((u32x4){pk2(acc[0][0], acc[0][1]), pk2(acc[0][2], acc[0][3]), pk2(acc[1][0], acc[1][1]), pk2(acc[1][2], acc[1][3])});
    const bf16x8 sb1 = as_bf8((u32x4){pk2(acc[2][0], acc[2][1]), pk2(acc[2][2], acc[2][3]), pk2(acc[3][0], acc[3][1]), pk2(acc[3][2], acc[3][3])});
    const bf16x8 vb = as_bf8((u32x4){fr.vt.x, fr.vt.y, 0u, 0u});
#pragma unroll
    for (int c = 0; c < 4; ++c) { f32x4 n = acc[c] * fr.w[c];
        n = __builtin_amdgcn_mfma_f32_16x16x32_bf16(as_bf8(fr.g[c][0]), sb0, n, 0, 0, 0);
        n = __builtin_amdgcn_mfma_f32_16x16x32_bf16(as_bf8(fr.g[c][1]), sb1, n, 0, 0, 0);
        n = __builtin_amdgcn_mfma_f32_16x16x32_bf16(as_bf8((u32x4){fr.f[c].x, fr.f[c].y, 0u, 0u}), vb, n, 0, 0, 0);
        acc[c] = n; }
    f32x4 y = {0.f, 0.f, 0.f, 0.f};
    y = __builtin_amdgcn_mfma_f32_16x16x32_bf16(as_bf8(fr.q1[0]), sb0, y, 0, 0, 0);
    y = __builtin_amdgcn_mfma_f32_16x16x32_bf16(as_bf8(fr.q1[1]), sb1, y, 0, 0, 0);
    y = __builtin_amdgcn_mfma_f32_16x16x32_bf16(as_bf8((u32x4){fr.q2.x, fr.q2.y, 0u, 0u}), vb, y, 0, 0, 0);
    *(u32x2*)yout = (u32x2){pk2(y[0], y[1]), pk2(y[2], y[3])};
}
#define SCAN_ASM_LD4(dst, ptr, off) asm volatile("global_load_dwordx4 %0, %1, off offset:" #off : "=v"(dst) : "v"(ptr))
#define SCAN_ASM_LD2(dst, ptr, off) asm volatile("global_load_dwordx2 %0, %1, off offset:" #off : "=v"(dst) : "v"(ptr))
__device__ __forceinline__ void scan_frag_issue(ScanFrag& fr, const unsigned char* item, int rg, int lane) {
    const unsigned char* pg0 = item + lane * 16; const unsigned char* pg1 = pg0 + 4096;
    const unsigned char* pf = item + 8192 + lane * 8; const unsigned char* pq1 = item + 10240 + lane * 16;
    const unsigned char* pq2 = item + 12288 + lane * 8; const unsigned char* pvt = item + 12800 + (rg * 64 + lane) * 8; const unsigned char* pw = item + 14848 + (lane >> 4) * 16;
    SCAN_ASM_LD4(fr.g[0][0], pg0, 0); SCAN_ASM_LD4(fr.g[0][1], pg0, 1024); SCAN_ASM_LD4(fr.g[1][0], pg0, 2048); SCAN_ASM_LD4(fr.g[1][1], pg0, 3072);
    SCAN_ASM_LD4(fr.g[2][0], pg1, 0); SCAN_ASM_LD4(fr.g[2][1], pg1, 1024); SCAN_ASM_LD4(fr.g[3][0], pg1, 2048); SCAN_ASM_LD4(fr.g[3][1], pg1, 3072);
    SCAN_ASM_LD2(fr.f[0], pf, 0); SCAN_ASM_LD2(fr.f[1], pf, 512); SCAN_ASM_LD2(fr.f[2], pf, 1024); SCAN_ASM_LD2(fr.f[3], pf, 1536);
    SCAN_ASM_LD4(fr.q1[0], pq1, 0); SCAN_ASM_LD4(fr.q1[1], pq1, 1024);
    SCAN_ASM_LD2(fr.q2, pq2, 0); SCAN_ASM_LD2(fr.vt, pvt, 0);
    SCAN_ASM_LD4(fr.w[0], pw, 0); SCAN_ASM_LD4(fr.w[1], pw, 64); SCAN_ASM_LD4(fr.w[2], pw, 128); SCAN_ASM_LD4(fr.w[3], pw, 192);
}
#define SCAN_WAIT(fr, N) asm volatile("s_waitcnt vmcnt(" #N ")" : "+v"(fr.g[0][0]), "+v"(fr.g[0][1]), "+v"(fr.g[1][0]), "+v"(fr.g[1][1]), "+v"(fr.g[2][0]), "+v"(fr.g[2][1]), "+v"(fr.g[3][0]), "+v"(fr.g[3][1]), \
        "+v"(fr.f[0]), "+v"(fr.f[1]), "+v"(fr.f[2]), "+v"(fr.f[3]), "+v"(fr.q1[0]), "+v"(fr.q1[1]), "+v"(fr.q2), "+v"(fr.vt), "+v"(fr.w[0]), "+v"(fr.w[1]), "+v"(fr.w[2]), "+v"(fr.w[3]) :: "memory")
__device__ __forceinline__ void scan_mfma_rows(const Args& A, Frame& F) {
    const unsigned char* FR = A.ws + WS_BIG; bf16* YRAW = (bf16*)A.out + (size_t)3 * TOK * 1024;
    if (F.wave != 0) return;
    for (int u = F.bx; u < 128; u += F.G) {
        const int bh = u & 31, rg = u >> 5; const unsigned char* base = FR + (size_t)bh * 1024 * FR_BYTES;
        bf16* yrow = YRAW + ((size_t)bh * 64 + 16 * rg + (F.lane & 15)) * SEQ + 4 * (F.lane >> 4);
        f32x4 acc[4];
#pragma unroll
        for (int c = 0; c < 4; ++c) acc[c] = (f32x4){0.f, 0.f, 0.f, 0.f};
        ScanFrag fa, fb;
        scan_frag_issue(fa, base, rg, F.lane);
#pragma unroll 1
        for (int ch = 0; ch < 1024; ch += 2) {
            scan_frag_issue(fb, base + (size_t)(ch + 1) * FR_BYTES, rg, F.lane);
            SCAN_WAIT(fa, 20);
            scan_chunk(acc, fa, yrow + ch * 16);
            scan_frag_issue(fa, base + (size_t)((ch + 2 < 1024) ? (ch + 2) : ch) * FR_BYTES, rg, F.lane);
            SCAN_WAIT(fb, 20);
            scan_chunk(acc, fb, yrow + (ch + 1) * 16);
        }
        asm volatile("s_waitcnt vmcnt(0)" ::: "memory");
    }
}

__device__ __forceinline__ void pair_sync(volatile LAS unsigned* cnt, unsigned target) {
    asm volatile("s_waitcnt vmcnt(0) lgkmcnt(0)" ::: "memory");
    if ((threadIdx.x & 63) == 0) (void)__hip_atomic_fetch_add((LAS unsigned*)cnt, 1u, __ATOMIC_RELAXED, __HIP_MEMORY_SCOPE_WORKGROUP);
    while (__hip_atomic_load((LAS unsigned*)cnt, __ATOMIC_RELAXED, __HIP_MEMORY_SCOPE_WORKGROUP) < target) __builtin_amdgcn_s_sleep(1);
    asm volatile("" ::: "memory");
}
__device__ __forceinline__ void swa_pairs(const Args& A, Frame& F, volatile LAS unsigned* MISC) {
    const bf16* Z = (const bf16*)(A.ws + WS_Z); bf16* Y = (bf16*)(A.ws + WS_HY); const float* sinks = (const float*)A.in[5];
    const int pr = (F.wave - 4) >> 1, mem = F.wave & 1;
    LAS unsigned char* KL = F.lds + pr * 69632; LAS unsigned char* VL = KL + 256 * 136;
    volatile LAS unsigned* cnt = MISC + 24 + pr; unsigned gen = 0u;
    for (int u = F.bx * 2 + pr; u < 512; u += F.G * 2) {
        const int b = u >> 8, n = (u >> 1) & 127, kvh = u & 1;
        gen += 2u; pair_sync(cnt, gen);
#pragma unroll 1
        for (int c0 = mem * 1024 + F.lane; c0 < mem * 1024 + 1024; c0 += 64 * 8) {
            u32x4 kv[8], vv[8];
#pragma unroll
            for (int q = 0; q < 8; ++q) { const int c = c0 + 64 * q; const int jw = c >> 3, cc = c & 7; const int sp = n * 128 - 128 + jw;
                kv[q] = (u32x4){0u, 0u, 0u, 0u}; vv[q] = kv[q];
                if (sp >= 0) { const bf16* row = Z + (size_t)(b * SEQ + sp) * EV_NP; kv[q] = *(const u32x4*)(row + 1024 + kvh * 64 + cc * 8); vv[q] = *(const u32x4*)(row + 1152 + kvh * 64 + cc * 8); } }
#pragma unroll
            for (int q = 0; q < 8; ++q) { const int c = c0 + 64 * q; const int jw = c >> 3, cc = c & 7;
                *(LAS u32x2*)(KL + jw * 136 + cc * 16) = (u32x2){kv[q].x, kv[q].y}; *(LAS u32x2*)(KL + jw * 136 + cc * 16 + 8) = (u32x2){kv[q].z, kv[q].w};
                *(LAS u32x2*)(VL + jw * 136 + cc * 16) = (u32x2){vv[q].x, vv[q].y}; *(LAS u32x2*)(VL + jw * 136 + cc * 16 + 8) = (u32x2){vv[q].z, vv[q].w}; }
        }
        gen += 2u; pair_sync(cnt, gen);
        for (int it = mem; it < 1024; it += 2) {
            const int i = it >> 3, g = it & 7, head = kvh * 8 + g; const int t = b * SEQ + n * 128 + i;
            const float qv = bf2f(Z[(size_t)t * EV_NP + head * 64 + F.lane]) * 0.125f;
            const int jw0 = i + 1 + F.lane, jw1 = jw0 + 64;
            const bool val0 = (n > 0) || (jw0 >= 128), val1 = (n > 0) || (jw1 >= 128);
            float s0 = 0.f, s1 = 0.f;
#pragma unroll
            for (int d4 = 0; d4 < 16; ++d4) {
                const u32x2 k0 = *(const LAS u32x2*)(KL + jw0 * 136 + d4 * 8), k1 = *(const LAS u32x2*)(KL + jw1 * 136 + d4 * 8);
                const float q0 = rdlane(qv, 4 * d4), q1 = rdlane(qv, 4 * d4 + 1), q2 = rdlane(qv, 4 * d4 + 2), q3 = rdlane(qv, 4 * d4 + 3);
                s0 += q0 * lo2f(k0.x) + q1 * hi2f(k0.x) + q2 * lo2f(k0.y) + q3 * hi2f(k0.y);
                s1 += q0 * lo2f(k1.x) + q1 * hi2f(k1.x) + q2 * lo2f(k1.y) + q3 * hi2f(k1.y);
            }
            const float sink = sinks[head];
            s0 = val0 ? s0 : -INFINITY; s1 = val1 ? s1 : -INFINITY;
            const float mx = fmaxf(wmax(fmaxf(s0, s1)), sink);
            float p0 = val0 ? expf(s0 - mx) : 0.f, p1 = val1 ? expf(s1 - mx) : 0.f;
            const float den = wsum(p0 + p1) + expf(sink - mx); const float rden = 1.0f / den;
            p0 *= rden; p1 *= rden;
            float o = 0.f;
            const LAS bf16* vcol = (const LAS bf16*)VL + F.lane;
#pragma unroll 8
            for (int jj = 0; jj < 64; ++jj) o += rdlane(p0, jj) * bf2f(vcol[(i + 1 + jj) * 68]);
#pragma unroll 8
            for (int jj = 0; jj < 64; ++jj) o += rdlane(p1, jj) * bf2f(vcol[(i + 65 + jj) * 68]);
            Y[(size_t)t * DM + head * 64 + F.lane] = (bf16)f2bf(o);
        }
    }
}

__device__ __forceinline__ void wsum2_dpp(float a, float b, float& ra, float& rb) {
    const auto r = __builtin_amdgcn_permlane32_swap(__float_as_uint(a), __float_as_uint(b), false, false);
    float v = __uint_as_float(r[0]) + __uint_as_float(r[1]);
    v += dppf<0xB1, 0xF>(v); v += dppf<0x4E, 0xF>(v); v += dppf<0x141, 0xF>(v); v += dppf<0x140, 0xF>(v);
    v += dppf<0x142, 0xA>(v);
    ra = rdlane(v, 31); rb = rdlane(v, 63);
}
__device__ __forceinline__ void ph_scan(const Args& A, Frame& F, volatile LAS unsigned* MISC) {
    const unsigned* PK = (const unsigned*)(A.ws + WS_BIG); bf16* YRAW = (bf16*)A.out + (size_t)3 * TOK * 1024;
    if (F.wave >= 4) { swa_pairs(A, F, MISC); return; }
    __builtin_amdgcn_s_setprio(3);
    for (int pp = F.bx * 4 + F.wave; pp < 1024; pp += F.G * 4) {
        const int rr = 2 * pp, bh = rr >> 6, vrow = rr & 63;
        const unsigned* pk = PK + ((size_t)bh * SEQ * 64 + F.lane) * 3;
        bf16* youtA = YRAW + ((size_t)bh * 64 + vrow) * SEQ; bf16* youtB = youtA + SEQ;
        f32x2 S2 = {0.f, 0.f};
        for (int t0 = 0; t0 < SEQ; t0 += 64) {
            float ykA = 0.f, ykB = 0.f;
#pragma unroll 8
            for (int j = 0; j < 64; ++j) {
                const unsigned* p = pk + (size_t)(t0 + j) * 192;
                const unsigned w0 = p[0], w1 = p[1], w2 = p[2];
                const float r = lo2f(w0), e = hi2f(w0), kp = lo2f(w1), kk = hi2f(w1), kka = lo2f(w2), vv = hi2f(w2);
                const f32x2 v2 = {rdlane(vv, vrow), rdlane(vv, vrow + 1)};
                const float dec = __expf(-e);
                const f32x2 pk2v = S2 * (f32x2){kk, kk};
                float saA, saB; wsum2_dpp(pk2v.x, pk2v.y, saA, saB); const f32x2 sa2 = {saA, saB};
                S2 = S2 * (f32x2){dec, dec} + (v2 * (f32x2){kp, kp} - sa2 * (f32x2){kka, kka});
                const f32x2 py = S2 * (f32x2){r, r};
                float yA, yB; wsum2_dpp(py.x, py.y, yA, yB);
                ykA = (F.lane == j) ? yA : ykA; ykB = (F.lane == j) ? yB : ykB;
            }
            youtA[t0 + F.lane] = (bf16)f2bf(ykA); youtB[t0 + F.lane] = (bf16)f2bf(ykB);
        }
    }
    __builtin_amdgcn_s_setprio(0);
}

__device__ __forceinline__ void ph_rwkv_finish(const Args& A, Frame& F) {
    const bf16* Z = (const bf16*)(A.ws + WS_Z); const bf16* RKV = (const bf16*)A.out; const bf16* YRAW = (const bf16*)A.out + (size_t)3 * TOK * 1024;
    const float* BS = (const float*)(A.ws + WS_BS); bf16* Y = (bf16*)(A.ws + WS_HY);
    const float* lnx_g = (const float*)A.in[15]; const float* lnx_b = (const float*)A.in[16];
    LAS float* tile = (LAS float*)(F.lds + F.wave * 16640);
    for (int it = F.gw; it < 8192; it += F.ngw) {
        const int bh = it >> 8, tb = it & 255, b = bh >> 4, h = bh & 15, t0 = tb * 64;
        for (int vr = 0; vr < 64; ++vr) tile[vr * 65 + F.lane] = bf2f(YRAW[((size_t)bh * 64 + vr) * SEQ + t0 + F.lane]);
        asm volatile("s_waitcnt lgkmcnt(0)" ::: "memory");
        const int c = h * 64 + F.lane; const float lg = lnx_g[c], lb = lnx_b[c];
        for (int j = 0; j < 64; ++j) {
            const int t = b * SEQ + t0 + j;
            const float y = tile[F.lane * 65 + j];
            const float mean = wsum(y) * (1.0f / 64.0f); const float d = y - mean; const float var = wsum(d * d) * (1.0f / 64.0f);
            const float yn = d * rsqrtf(var + 64e-5f) * lg + lb;
            const float vv = bf2f(RKV[(size_t)2 * TOK * 1024 + (size_t)t * 1024 + c]); const float g = bf2f(Z[(size_t)t * EV_NP + 1280 + 2048 + c]); const float bs = BS[(size_t)t * 16 + h];
            Y[(size_t)t * DM + 1024 + c] = (bf16)f2bf((yn + bs * vv) * g);
        }
        asm volatile("s_waitcnt lgkmcnt(0)" ::: "memory");
    }
}

constexpr size_t WS_H8 = WS_BIG + 384 * MiB, WS_HS = WS_BIG + 448 * MiB;
__device__ __forceinline__ unsigned pack_i8x4(float a, float b, float c, float d) {
    const unsigned ua = __float_as_uint(a + 12582912.0f) & 255u, ub = __float_as_uint(b + 12582912.0f) & 255u, uc = __float_as_uint(c + 12582912.0f) & 255u, ud = __float_as_uint(d + 12582912.0f);
    return ua | (ub << 8) | (uc << 16) | (ud << 24);
}
__device__ __forceinline__ void ph_ln_mixer(const Args& A, Frame& F, const int L) {
    const float* xsrc = (const float*)A.in[0]; const bf16* xsrcb = (const bf16*)A.out;
    bf16* xdst = (L == 0) ? (bf16*)A.out : (bf16*)(A.ws + WS_Z + 160 * MiB);
    const bf16* O = (const bf16*)(A.ws + WS_Z); bf16* H = (bf16*)(A.ws + WS_HY); const float* MOD = (const float*)(A.ws + WS_MOD);
    const float* lng = (const float*)A.in[21] + (size_t)(L * 2 + 0) * DM; const float* lnb = (const float*)A.in[22] + (size_t)(L * 2 + 0) * DM;
    for (int t = F.gw; t < TOK; t += F.ngw) {
        const int b = t >> 14;
        const float* gate = MOD + (size_t)((L * 2 + 0) * 2 + b) * 6144 + 4096;
        const float* sh = MOD + (size_t)((L * 2 + 1) * 2 + b) * 6144; const float* sc = sh + 2048;
        float v[32]; float sum = 0.f;
#pragma unroll
        for (int j = 0; j < 4; ++j) { const int base = (j * 64 + F.lane) * 8;
            const u32x4 ow = *(const u32x4*)(O + (size_t)t * DM + base);
            f32x4 x0, x1;
            if (L == 0) { x0 = *(const f32x4*)(xsrc + (size_t)t * DM + base); x1 = *(const f32x4*)(xsrc + (size_t)t * DM + base + 4); }
            else { const u32x4 xw = *(const u32x4*)(xsrcb + (size_t)t * DM + base); x0 = (f32x4){lo2f(xw.x), hi2f(xw.x), lo2f(xw.y), hi2f(xw.y)}; x1 = (f32x4){lo2f(xw.z), hi2f(xw.z), lo2f(xw.w), hi2f(xw.w)}; }
            const f32x4 g0 = *(const f32x4*)(gate + base), g1 = *(const f32x4*)(gate + base + 4);
            const float of[8] = {lo2f(ow.x), hi2f(ow.x), lo2f(ow.y), hi2f(ow.y), lo2f(ow.z), hi2f(ow.z), lo2f(ow.w), hi2f(ow.w)};
#pragma unroll
            for (int e = 0; e < 4; ++e) { v[j * 8 + e] = ALPHA * x0[e] + (1.0f + g0[e]) * of[e]; v[j * 8 + 4 + e] = ALPHA * x1[e] + (1.0f + g1[e]) * of[4 + e]; }
#pragma unroll
            for (int e = 0; e < 8; ++e) sum += v[j * 8 + e]; }
        const float mean = wsum(sum) * (1.0f / DM); float sq = 0.f;
#pragma unroll
        for (int e = 0; e < 32; ++e) { v[e] -= mean; sq += v[e] * v[e]; }
        const float rstd = rsqrtf(wsum(sq) * (1.0f / DM) + 1e-5f); float hmax = 0.f;
#pragma unroll
        for (int j = 0; j < 4; ++j) { const int base = (j * 64 + F.lane) * 8;
            const f32x4 lg0 = *(const f32x4*)(lng + base), lg1 = *(const f32x4*)(lng + base + 4), lb0 = *(const f32x4*)(lnb + base), lb1 = *(const f32x4*)(lnb + base + 4);
            const f32x4 s0 = *(const f32x4*)(sc + base), s1 = *(const f32x4*)(sc + base + 4), h0 = *(const f32x4*)(sh + base), h1 = *(const f32x4*)(sh + base + 4);
            f32x4 o0, o1;
#pragma unroll
            for (int e = 0; e < 4; ++e) { o0[e] = v[j * 8 + e] * rstd * lg0[e] + lb0[e]; o1[e] = v[j * 8 + 4 + e] * rstd * lg1[e] + lb1[e]; }
            { u32x4 xw; xw.x = pk2(o0[0], o0[1]); xw.y = pk2(o0[2], o0[3]); xw.z = pk2(o1[0], o1[1]); xw.w = pk2(o1[2], o1[3]); *(u32x4*)(xdst + (size_t)t * DM + base) = xw; }
            const f32x4 q0 = o0 * (1.0f + s0) + h0, q1 = o1 * (1.0f + s1) + h1;
            u32x4 w; w.x = pk2(q0[0], q0[1]); w.y = pk2(q0[2], q0[3]); w.z = pk2(q1[0], q1[1]); w.w = pk2(q1[2], q1[3]);
            *(u32x4*)(H + (size_t)t * DM + base) = w;
#pragma unroll
            for (int e = 0; e < 4; ++e) { v[j * 8 + e] = q0[e]; v[j * 8 + 4 + e] = q1[e]; hmax = fmaxf(hmax, fmaxf(fabsf(q0[e]), fabsf(q1[e]))); } }
        { hmax = wmax(hmax); const float inv = (hmax > 0.f) ? 127.0f / hmax : 0.f;
#pragma unroll
          for (int j = 0; j < 4; ++j) { const int base = (j * 64 + F.lane) * 8; u32x2 w8;
              w8.x = pack_i8x4(v[j * 8 + 0] * inv, v[j * 8 + 1] * inv, v[j * 8 + 2] * inv, v[j * 8 + 3] * inv); w8.y = pack_i8x4(v[j * 8 + 4] * inv, v[j * 8 + 5] * inv, v[j * 8 + 6] * inv, v[j * 8 + 7] * inv);
              *(u32x2*)(A.ws + WS_H8 + (size_t)t * DM + base) = w8; }
          if (F.lane == 0) ((float*)(A.ws + WS_HS))[t] = hmax * (1.0f / 127.0f); }
    }
    {
        const float* pu = (const float*)A.in[25] + (size_t)L * 16384 * 2048; const float* pv = (const float*)A.in[26] + (size_t)L * 16384 * 2048;
        unsigned char* T8 = A.ws + WS_BIG; float* SCL = (float*)(A.ws + WS_BIG + 64 * MiB);
        for (int r = F.gw; r < 32768; r += F.ngw) {
            const float* src = ((r < 16384) ? pu : pv) + (size_t)(r & 16383) * 2048;
            f32x4 f[2][4]; float amax = 0.f;
#pragma unroll
            for (int j = 0; j < 2; ++j)
#pragma unroll
                for (int c = 0; c < 4; ++c) { f[j][c] = *(const f32x4*)(src + (j * 64 + F.lane) * 16 + 4 * c);
                    amax = fmaxf(amax, fmaxf(fmaxf(fabsf(f[j][c][0]), fabsf(f[j][c][1])), fmaxf(fabsf(f[j][c][2]), fabsf(f[j][c][3])))); }
            amax = wmax(amax);
            {
                const float inv = (amax > 0.f) ? 127.0f / amax : 0.f;
#pragma unroll
                for (int j = 0; j < 2; ++j) { u32x4 w;
                    w.x = pack_i8x4(f[j][0][0] * inv, f[j][0][1] * inv, f[j][0][2] * inv, f[j][0][3] * inv); w.y = pack_i8x4(f[j][1][0] * inv, f[j][1][1] * inv, f[j][1][2] * inv, f[j][1][3] * inv);
                    w.z = pack_i8x4(f[j][2][0] * inv, f[j][2][1] * inv, f[j][2][2] * inv, f[j][2][3] * inv); w.w = pack_i8x4(f[j][3][0] * inv, f[j][3][1] * inv, f[j][3][2] * inv, f[j][3][3] * inv);
                    *(u32x4*)(T8 + (size_t)r * 2048 + (j * 64 + F.lane) * 16) = w; }
                if (F.lane == 0) SCL[r] = amax * (1.0f / 127.0f);
            }
        }
    }
}

template <int NV, int NBITS> __device__ __forceinline__ unsigned wave_tau16(const unsigned (&key)[NV]) {
    unsigned tau = 0u;
#pragma unroll 1
    for (int bit = NBITS - 1; bit >= 0; --bit) {
        const unsigned cand = tau | (1u << bit); int cnt = 0;
#pragma unroll
        for (int v = 0; v < NV; ++v) cnt += __popcll(__ballot(key[v] >= cand));
        if (cnt >= 16) tau = cand;
    }
    return tau;
}
template <int NV> __device__ __forceinline__ void wave_compact16(const unsigned (&key)[NV], const float (&val)[NV], const int (&id)[NV], unsigned tau, LAS float* ov, LAS int* oi, int lane) {
    int ngt = 0;
#pragma unroll
    for (int v = 0; v < NV; ++v) ngt += __popcll(__ballot(key[v] > tau));
    int bg = 0, be = 0;
#pragma unroll
    for (int v = 0; v < NV; ++v) {
        const bool gt = key[v] > tau, eq = key[v] == tau;
        const unsigned long long mg = __ballot(gt), me = __ballot(eq);
        const unsigned long long below = (lane == 0) ? 0ull : ((~0ull) >> (64 - lane));
        const int pg = bg + __popcll(mg & below), pe = ngt + be + __popcll(me & below);
        if (gt) { ov[pg] = val[v]; oi[pg] = id[v]; }
        if (eq && pe < 16) { ov[pe] = val[v]; oi[pe] = id[v]; }
        bg += __popcll(mg); be += __popcll(me);
    }
}

template <int CTRL, int BANK> __device__ __forceinline__ unsigned dppb(unsigned old, unsigned v) { return (unsigned)__builtin_amdgcn_update_dpp((int)old, (int)v, CTRL, 0xF, BANK, false); }
template <int CTRL> __device__ __forceinline__ unsigned dppm(unsigned v) { return (unsigned)__builtin_amdgcn_mov_dpp((int)v, CTRL, 0xF, 0xF, true); }
template <int CTRL> __device__ __forceinline__ unsigned cex(unsigned x, bool lo) { const unsigned mx = max(x, dppm<CTRL>(x)), mn = min(x, dppm<CTRL>(x)); return lo ? mx : mn; }
__device__ __forceinline__ unsigned cex4(unsigned x, bool lo) {
    unsigned t = (unsigned)__builtin_amdgcn_mov_dpp((int)x, 0x104, 0xF, 0x5, false); t = dppb<0x114, 0xA>(t, x); const unsigned mx = max(x, t), mn = min(x, t); return lo ? mx : mn; }
struct LoMasks { bool lo1, lo2, lo4, lo8, odd16, up32; };
__device__ __forceinline__ unsigned sort16_desc(unsigned x, const LoMasks& M) {
    x = cex<0xB1>(x, M.lo1);
    x = cex<0x1B>(x, M.lo2); x = cex<0xB1>(x, M.lo1);
    x = cex<0x141>(x, M.lo4); x = cex<0x4E>(x, M.lo2); x = cex<0xB1>(x, M.lo1);
    x = cex<0x140>(x, M.lo8); x = cex4(x, M.lo4); x = cex<0x4E>(x, M.lo2); x = cex<0xB1>(x, M.lo1);
    return x;
}
__device__ __forceinline__ unsigned clean16_desc(unsigned x, const LoMasks& M) {
    x = cex<0x128>(x, M.lo8); x = cex4(x, M.lo4); x = cex<0x4E>(x, M.lo2); x = cex<0xB1>(x, M.lo1); return x;
}
__device__ __forceinline__ unsigned mtop_regs(unsigned a, unsigned b) { return max(a, dppm<0x140>(b)); }
__device__ __forceinline__ unsigned mtop_rows(unsigned y, const LoMasks& M) { const auto r = __builtin_amdgcn_permlane16_swap(y, y, false, false); const unsigned pv = M.odd16 ? r[0] : r[1]; return mtop_regs(y, pv); }
__device__ __forceinline__ unsigned mtop_halves(unsigned y, const LoMasks& M) { const auto r = __builtin_amdgcn_permlane32_swap(y, y, false, false); const unsigned pv = M.up32 ? r[0] : r[1]; return mtop_regs(y, pv); }

template <int OFF, int N, int MASKX, int TOT> __device__ __forceinline__ void ce_stage(unsigned (&k)[TOT]) {
#pragma unroll
    for (int i = 0; i < N; ++i) { const int pr = i ^ MASKX; if (pr > i) { const unsigned a_ = k[OFF + i], b_ = k[OFF + pr]; k[OFF + i] = max(a_, b_); k[OFF + pr] = min(a_, b_); } }
}
template <int OFF, int TOT> __device__ __forceinline__ void sort16_regs(unsigned (&k)[TOT]) {
    ce_stage<OFF, 16, 1>(k); ce_stage<OFF, 16, 3>(k); ce_stage<OFF, 16, 1>(k); ce_stage<OFF, 16, 7>(k); ce_stage<OFF, 16, 2>(k); ce_stage<OFF, 16, 1>(k);
    ce_stage<OFF, 16, 15>(k); ce_stage<OFF, 16, 4>(k); ce_stage<OFF, 16, 2>(k); ce_stage<OFF, 16, 1>(k);
}
template <int TOT> __device__ __forceinline__ void clean16_regs(unsigned (&k)[TOT]) { ce_stage<0, 16, 8>(k); ce_stage<0, 16, 4>(k); ce_stage<0, 16, 2>(k); ce_stage<0, 16, 1>(k); }

__device__ __forceinline__ void ph_peer_select(const Args& A, Frame& F, const int L) {
    const bf16* QP = (const bf16*)(A.ws + WS_Z); const bf16* SKB = (const bf16*)(A.ws + WS_SKB) + (size_t)L * 262144;
    int* EID = (int*)(A.ws + WS_LA); float* GSM = (float*)(A.ws + WS_LA + 16 * MiB);
    LAS unsigned char* SKL = F.lds;
    LAS float* SCO = (LAS float*)(F.lds + 69632 + 4096);
    for (int it = F.bx; it < 4096; it += F.G) {
        const int tile = it >> 3, h = it & 7;
        __syncthreads();
        for (int c = F.tid; c < 4096; c += NTHREADS) { const int p = c >> 11, n = (c >> 4) & 127, cc = c & 15;
            *(LAS u32x4*)(SKL + (p * 128 + n) * 272 + cc * 16) = *(const u32x4*)(SKB + ((size_t)((p * 8 + h) * 128 + n)) * 128 + cc * 8); }
        __syncthreads();
        {
            const int p = F.wave >> 2, mt = F.wave & 3, g = F.lane >> 4, l15 = F.lane & 15;
            const bf16* qrow = QP + (size_t)(tile * 64 + mt * 16 + l15) * DM + h * 256 + p * 128 + 8 * g;
            bf16x8 afr[4];
#pragma unroll
            for (int ks = 0; ks < 4; ++ks) afr[ks] = *(const bf16x8*)(qrow + 32 * ks);
#pragma unroll
            for (int nt = 0; nt < 8; ++nt) {
                f32x4 acc = {0.f, 0.f, 0.f, 0.f};
#pragma unroll
                for (int ks = 0; ks < 4; ++ks) { const bf16x8 bfr = *(const LAS bf16x8*)(SKL + (p * 128 + nt * 16 + l15) * 272 + (32 * ks + 8 * g) * 2);
                    acc = __builtin_amdgcn_mfma_f32_16x16x32_bf16(afr[ks], bfr, acc, 0, 0, 0); }
#pragma unroll
                for (int rg = 0; rg < 4; ++rg) SCO[(p * 64 + mt * 16 + 4 * g + rg) * 132 + nt * 16 + l15] = acc[rg];
            }
        }
        __syncthreads();
        constexpr int NT = 4;
        LAS unsigned char* WB = F.lds + 141312 + F.wave * 2048;
        LoMasks M; M.lo1 = (F.lane & 1) == 0; M.lo2 = (F.lane & 2) == 0; M.lo4 = (F.lane & 4) == 0; M.lo8 = (F.lane & 8) == 0; M.odd16 = (F.lane & 16) != 0; M.up32 = (F.lane & 32) != 0;
        int pi_, pj_;
        { const int L = F.lane;
          if (L < 16) { pi_ = 0; pj_ = L; } else if (L < 24) { pi_ = 1; pj_ = L - 16; } else if (L < 29) { pi_ = 2; pj_ = L - 24; } else if (L < 33) { pi_ = 3; pj_ = L - 29; }
          else if (L < 36) { pi_ = 4; pj_ = L - 33; } else if (L < 42) { pi_ = 5 + ((L - 36) >> 1); pj_ = (L - 36) & 1; } else { pi_ = 8 + (L - 42); pj_ = 0; }
          if (L >= 50) { pi_ = 0; pj_ = 0; } }
        const bool pvalid = F.lane < 50;
        {
            const int g = F.lane >> 2, q = F.lane & 3, tok = g >> 1, sp = g & 1;
            const LAS float* srow = SCO + (sp * 64 + F.wave * 8 + tok) * 132;
            unsigned k[32]; const unsigned ib = (unsigned)(127 - q * 32);
#pragma unroll
            for (int c = 0; c < 8; ++c) { const f32x4 v = *(const LAS f32x4*)(srow + q * 32 + 4 * c);
#pragma unroll
                for (int e = 0; e < 4; ++e) k[4 * c + e] = (fixkey20(v[e]) << 7) | (ib - (unsigned)(4 * c + e)); }
            sort16_regs<0>(k); sort16_regs<16>(k);
            unsigned m[16], t2[16];
#pragma unroll
            for (int i = 0; i < 16; ++i) m[i] = max(k[i], k[31 - i]);
            clean16_regs(m);
#pragma unroll
            for (int i = 0; i < 16; ++i) t2[i] = max(m[i], dppm<0xB1>(m[15 - i]));
            clean16_regs(t2);
#pragma unroll
            for (int i = 0; i < 16; ++i) m[i] = max(t2[i], dppm<0x4E>(t2[15 - i]));
            clean16_regs(m);
            float vals[16]; int idxs[16];
#pragma unroll
            for (int e = 0; e < 16; ++e) { idxs[e] = 127 - (int)(m[e] & 127u); vals[e] = srow[idxs[e]]; }
            if (q == 0) { LAS float* tvp = (LAS float*)(WB + tok * 256) + sp * 16; LAS int* tip = (LAS int*)(WB + tok * 256 + 128) + sp * 16;
#pragma unroll
                for (int c = 0; c < 4; ++c) { *(LAS f32x4*)(tvp + 4 * c) = (f32x4){vals[4 * c], vals[4 * c + 1], vals[4 * c + 2], vals[4 * c + 3]};
                    *(LAS u32x4*)(tip + 4 * c) = (u32x4){(unsigned)idxs[4 * c], (unsigned)idxs[4 * c + 1], (unsigned)idxs[4 * c + 2], (unsigned)idxs[4 * c + 3]}; } }
        }
        asm volatile("s_waitcnt lgkmcnt(0)" ::: "memory"); __builtin_amdgcn_wave_barrier();
#pragma unroll 1
        for (int tk0 = 0; tk0 < 8; tk0 += NT) {
            unsigned z[NT];
#pragma unroll
            for (int u = 0; u < NT; ++u) { const LAS float* tv = (const LAS float*)(WB + (tk0 + u) * 256); const float cvl = tv[pi_] + tv[16 + pj_];
                z[u] = pvalid ? ((fixkey20(cvl * 0.5f) << 8) | (unsigned)(255 - (pi_ * 16 + pj_))) : 0u; }
#define ALL4(EXPR) _Pragma("unroll") for (int u = 0; u < NT; ++u) { const unsigned X = z[u]; z[u] = (EXPR); }
#define CLEAN4() ALL4(cex<0x128>(X, M.lo8)) ALL4(cex4(X, M.lo4)) ALL4(cex<0x4E>(X, M.lo2)) ALL4(cex<0xB1>(X, M.lo1))
            ALL4(cex<0xB1>(X, M.lo1))
            ALL4(cex<0x1B>(X, M.lo2)) ALL4(cex<0xB1>(X, M.lo1))
            ALL4(cex<0x141>(X, M.lo4)) ALL4(cex<0x4E>(X, M.lo2)) ALL4(cex<0xB1>(X, M.lo1))
            ALL4(cex<0x140>(X, M.lo8)) ALL4(cex4(X, M.lo4)) ALL4(cex<0x4E>(X, M.lo2)) ALL4(cex<0xB1>(X, M.lo1))
            ALL4(mtop_rows(X, M)) CLEAN4()
            ALL4(mtop_halves(X, M)) CLEAN4()
#undef ALL4
#undef CLEAN4
#pragma unroll
            for (int u = 0; u < NT; ++u) { const int t = tile * 64 + F.wave * 8 + tk0 + u;
                const LAS float* tv = (const LAS float*)(WB + (tk0 + u) * 256); const LAS int* ti = (const LAS int*)(WB + (tk0 + u) * 256 + 128);
                const int cid = 255 - (int)(z[u] & 255u), bi = (F.lane < 16) ? (cid >> 4) : 0, bj = (F.lane < 16) ? (cid & 15) : 0;
                const float bv = (F.lane < 16) ? (tv[bi] + tv[16 + bj]) : -INFINITY;
                const float mx = wmax(bv); const float ev = (F.lane < 16) ? expf(bv - mx) : 0.f; const float den = wsum(ev);
                if (F.lane < 16) { const int e1 = ti[bi], e2 = ti[16 + bj];
                    EID[(size_t)t * 128 + h * 16 + F.lane] = e1 * 128 + e2; GSM[(size_t)t * 128 + h * 16 + F.lane] = ev / den; } }
            asm volatile("s_waitcnt lgkmcnt(0)" ::: "memory"); __builtin_amdgcn_wave_barrier();
        }
    }
}

constexpr int PGB = 4;
__device__ __forceinline__ void ph_peer_gather(const Args& A, Frame& F, const int L, const bool dry = false) {
    bf16* H = (bf16*)(A.ws + WS_HY); bf16* Hout = dry ? (bf16*)(A.ws + WS_BIG + 128 * MiB) : H; float* Xout = dry ? (float*)(A.ws + WS_Z) : A.out; const unsigned char* TU = A.ws + WS_BIG; const unsigned char* TV = TU + (size_t)16384 * 2048; const float* SCL = (const float*)(A.ws + WS_BIG + 64 * MiB);
    const int* EID = (const int*)(A.ws + WS_LA); const float* GSM = (const float*)(A.ws + WS_LA + 16 * MiB);
    const float* MOD = (const float*)(A.ws + WS_MOD); float* X = A.out;
    const float* lng = (const float*)A.in[21] + (size_t)(L * 2 + 1) * DM; const float* lnb = (const float*)A.in[22] + (size_t)(L * 2 + 1) * DM;
    for (int t = F.gw; t < TOK; t += F.ngw) {
        const int b = t >> 14;
        f32x2 h2[16];
#pragma unroll
        for (int j = 0; j < 2; ++j) { const u32x4 a = *(const u32x4*)(H + (size_t)t * DM + (j * 64 + F.lane) * 16), c = *(const u32x4*)(H + (size_t)t * DM + (j * 64 + F.lane) * 16 + 8);
            const unsigned aw[8] = {a.x, a.y, a.z, a.w, c.x, c.y, c.z, c.w};
#pragma unroll
            for (int q = 0; q < 8; ++q) h2[j * 8 + q] = (f32x2){lo2f(aw[q]), hi2f(aw[q])}; }
        f32x2 o2[16];
#pragma unroll
        for (int e = 0; e < 16; ++e) o2[e] = (f32x2){0.f, 0.f};
#pragma unroll 1
        for (int e0 = 0; e0 < 128; e0 += PGB) {
            int eid[PGB]; float gw[PGB], su[PGB], sv[PGB];
#pragma unroll
            for (int q = 0; q < PGB; ++q) { eid[q] = __builtin_amdgcn_readfirstlane(EID[(size_t)t * 128 + e0 + q]); gw[q] = GSM[(size_t)t * 128 + e0 + q]; su[q] = SCL[eid[q]]; sv[q] = SCL[16384 + eid[q]]; }
            u32x4 uu[PGB][2], vv[PGB][2];
#pragma unroll
            for (int q = 0; q < PGB; ++q)
#pragma unroll
                for (int j = 0; j < 2; ++j) { uu[q][j] = *(const u32x4*)(TU + (size_t)eid[q] * 2048 + (j * 64 + F.lane) * 16); vv[q][j] = *(const u32x4*)(TV + (size_t)eid[q] * 2048 + (j * 64 + F.lane) * 16); }
#pragma unroll
            for (int q = 0; q < PGB; ++q) {
                f32x2 d2 = {0.f, 0.f};
#pragma unroll
                for (int j = 0; j < 2; ++j) { const unsigned w[4] = {uu[q][j].x, uu[q][j].y, uu[q][j].z, uu[q][j].w};
#pragma unroll
                    for (int i = 0; i < 4; ++i) { const f32x2 lo = __builtin_amdgcn_cvt_pk_f32_fp8((int)w[i], false), hi = __builtin_amdgcn_cvt_pk_f32_fp8((int)w[i], true);
                        d2 = lo * h2[j * 8 + 2 * i] + d2; d2 = hi * h2[j * 8 + 2 * i + 1] + d2; } }
                const float d = wsum(d2.x + d2.y) * su[q];
                const float act = 0.5f * d * (1.0f + erff(d * 0.70710678f)) * gw[q] * sv[q];
                const f32x2 a2 = {act, act};
#pragma unroll
                for (int j = 0; j < 2; ++j) { const unsigned w[4] = {vv[q][j].x, vv[q][j].y, vv[q][j].z, vv[q][j].w};
#pragma unroll
                    for (int i = 0; i < 4; ++i) { const f32x2 lo = __builtin_amdgcn_cvt_pk_f32_fp8((int)w[i], false), hi = __builtin_amdgcn_cvt_pk_f32_fp8((int)w[i], true);
                        o2[j * 8 + 2 * i] = a2 * lo + o2[j * 8 + 2 * i]; o2[j * 8 + 2 * i + 1] = a2 * hi + o2[j * 8 + 2 * i + 1]; } }
            }
        }
        float out[32];
#pragma unroll
        for (int e = 0; e < 16; ++e) { out[2 * e] = o2[e].x; out[2 * e + 1] = o2[e].y; }
        const float* gate = MOD + (size_t)((L * 2 + 1) * 2 + b) * 6144 + 4096;
        float sum = 0.f;
#pragma unroll
        for (int j = 0; j < 2; ++j)
#pragma unroll
            for (int c = 0; c < 4; ++c) { const int base = (j * 64 + F.lane) * 16 + 4 * c;
                const f32x4 x0 = *(const f32x4*)(X + (size_t)t * DM + base), g0 = *(const f32x4*)(gate + base);
#pragma unroll
                for (int e = 0; e < 4; ++e) { const float v = ALPHA * x0[e] + (1.0f + g0[e]) * out[j * 16 + 4 * c + e]; out[j * 16 + 4 * c + e] = v; sum += v; } }
        const float mean = wsum(sum) * (1.0f / DM); float sq = 0.f;
#pragma unroll
        for (int e = 0; e < 32; ++e) { out[e] -= mean; sq += out[e] * out[e]; }
        const float rstd = rsqrtf(wsum(sq) * (1.0f / DM) + 1e-5f);
        const float* sh = MOD + (size_t)(((L + 1) * 2 + 0) * 2 + b) * 6144; const float* sc = sh + 2048;
#pragma unroll
        for (int j = 0; j < 2; ++j) {
            float hq[16];
#pragma unroll
            for (int c = 0; c < 4; ++c) { const int base = (j * 64 + F.lane) * 16 + 4 * c;
                const f32x4 lg0 = *(const f32x4*)(lng + base), lb0 = *(const f32x4*)(lnb + base);
                f32x4 o0;
#pragma unroll
                for (int e = 0; e < 4; ++e) o0[e] = out[j * 16 + 4 * c + e] * rstd * lg0[e] + lb0[e];
                *(f32x4*)(Xout + (size_t)t * DM + base) = o0;
                if (L == 0) { const f32x4 s0 = *(const f32x4*)(sc + base), h0 = *(const f32x4*)(sh + base);
#pragma unroll
                    for (int e = 0; e < 4; ++e) hq[4 * c + e] = o0[e] * (1.0f + s0[e]) + h0[e]; } }
            if (L == 0) { u32x4 w0, w1;
                w0.x = pk2(hq[0], hq[1]); w0.y = pk2(hq[2], hq[3]); w0.z = pk2(hq[4], hq[5]); w0.w = pk2(hq[6], hq[7]);
                w1.x = pk2(hq[8], hq[9]); w1.y = pk2(hq[10], hq[11]); w1.z = pk2(hq[12], hq[13]); w1.w = pk2(hq[14], hq[15]);
                *(u32x4*)(Hout + (size_t)t * DM + (j * 64 + F.lane) * 16) = w0; *(u32x4*)(Hout + (size_t)t * DM + (j * 64 + F.lane) * 16 + 8) = w1; }
        }
    }
}

struct XInfo { int rank, nloc, rx, nx; };
__device__ __forceinline__ XInfo xcc_info(volatile LAS unsigned* MISC) { XInfo x; x.rank = (int)MISC[16]; x.nloc = (int)MISC[17]; x.rx = (int)MISC[18]; x.nx = (int)MISC[19]; return x; }
constexpr size_t WS_DP = WS_BIG + 128 * MiB;
constexpr size_t WS_ACT = WS_BIG + 80 * MiB;
__device__ __forceinline__ void ph_peer_u(const Args& A, Frame& F, const XInfo X) {
    const unsigned char* H8 = A.ws + WS_H8; const unsigned char* TU = A.ws + WS_BIG; const int* EID = (const int*)(A.ws + WS_LA); float* DP = (float*)(A.ws + WS_DP);
    LAS int* IDX = (LAS int*)(F.lds + F.wave * 1024);
    const int g16 = F.lane >> 4, c16 = F.lane & 15; const int step = X.nloc * NWAVES;
    for (int s = X.rx; s < 8; s += X.nx) {
        int t = X.rank * NWAVES + F.wave;
        int e0 = 0, e1 = 0; u32x4 ha = {0u, 0u, 0u, 0u};
        if (t < TOK) { e0 = EID[(size_t)t * 128 + F.lane]; e1 = EID[(size_t)t * 128 + 64 + F.lane]; ha = *(const u32x4*)(H8 + (size_t)t * DM + 256 * s + 16 * c16); }
        const unsigned char* ub = TU + 256 * s + 16 * c16;
        while (t < TOK) {
            const int tn = t + step; int n0 = 0, n1 = 0; u32x4 na = {0u, 0u, 0u, 0u};
            if (tn < TOK) { n0 = EID[(size_t)tn * 128 + F.lane]; n1 = EID[(size_t)tn * 128 + 64 + F.lane]; na = *(const u32x4*)(H8 + (size_t)tn * DM + 256 * s + 16 * c16); }
            IDX[F.lane] = e0; IDX[F.lane + 64] = e1;
            asm volatile("s_waitcnt lgkmcnt(0)" ::: "memory"); __builtin_amdgcn_wave_barrier();
            float keep0 = 0.f, keep1 = 0.f;
#pragma unroll
            for (int i0 = 0; i0 < 32; i0 += 8) {
                u32x4 ud[8];
#pragma unroll
                for (int u = 0; u < 8; ++u) { const int eid = IDX[4 * (i0 + u) + g16]; ud[u] = *(const u32x4*)(ub + (size_t)eid * 2048); }
#pragma unroll
                for (int u = 0; u < 8; ++u) {
                    int di = __builtin_amdgcn_sdot4((int)ud[u].x, (int)ha.x, 0, false); di = __builtin_amdgcn_sdot4((int)ud[u].y, (int)ha.y, di, false);
                    di = __builtin_amdgcn_sdot4((int)ud[u].z, (int)ha.z, di, false); di = __builtin_amdgcn_sdot4((int)ud[u].w, (int)ha.w, di, false);
                    const float d = sum16_dpp((float)di);
                    const int i = i0 + u;
                    if (i < 16) keep0 = ((i & 15) == c16) ? d : keep0; else keep1 = ((i & 15) == c16) ? d : keep1;
                }
            }
            float* dp = DP + ((size_t)s * TOK + t) * 128 + 4 * c16 + g16;
            dp[0] = keep0; dp[64] = keep1;
            asm volatile("s_waitcnt lgkmcnt(0)" ::: "memory"); __builtin_amdgcn_wave_barrier();
            e0 = n0; e1 = n1; ha = na; t = tn;
        }
    }
}
__device__ __forceinline__ void ph_peer_act(const Args& A, Frame& F) {
    const float* SCL = (const float*)(A.ws + WS_BIG + 64 * MiB); const int* EID = (const int*)(A.ws + WS_LA); const float* GSM = (const float*)(A.ws + WS_LA + 16 * MiB);
    const float* DP = (const float*)(A.ws + WS_DP); unsigned char* ACT8 = A.ws + WS_ACT; float* AS = (float*)(A.ws + WS_ACT + 8 * MiB);
    for (int t = F.gw; t < TOK; t += F.ngw) { const float hs = ((const float*)(A.ws + WS_HS))[t];
        float a[2];
#pragma unroll
        for (int m = 0; m < 2; ++m) { const int e = F.lane + 64 * m; const int eid = EID[(size_t)t * 128 + e]; float d = 0.f;
#pragma unroll
            for (int x = 0; x < 8; ++x) d += DP[((size_t)x * TOK + t) * 128 + e];
            d *= SCL[eid] * hs;
            a[m] = 0.5f * d * (1.0f + erff(d * 0.70710678f)) * GSM[(size_t)t * 128 + e] * SCL[16384 + eid]; }
        const float amax = wmax(fmaxf(fabsf(a[0]), fabsf(a[1]))); const float inv = (amax > 0.f) ? 127.0f / amax : 0.f;
#pragma unroll
        for (int m = 0; m < 2; ++m) ACT8[(size_t)t * 128 + F.lane + 64 * m] = (unsigned char)(__float_as_uint(a[m] * inv + 12582912.0f) & 255u);
        if (F.lane == 0) AS[t] = amax * (1.0f / 127.0f);
    }
}
__device__ __forceinline__ void ph_peer_v(const Args& A, Frame& F, const XInfo X) {
    const unsigned char* TV = A.ws + WS_BIG + (size_t)16384 * 2048;
    const int* EID = (const int*)(A.ws + WS_LA); const unsigned* ACT8 = (const unsigned*)(A.ws + WS_ACT); const float* AS = (const float*)(A.ws + WS_ACT + 8 * MiB); bf16* OUT = (bf16*)(A.ws + WS_Z);
    LAS int* IDX = (LAS int*)(F.lds + F.wave * 1024); LAS unsigned* ACT = (LAS unsigned*)(F.lds + F.wave * 1024 + 512);
    const int g16 = F.lane >> 4, c16 = F.lane & 15; const int step = X.nloc * NWAVES;
    for (int s = X.rx; s < 8; s += X.nx) {
        int t = X.rank * NWAVES + F.wave;
        int e0 = 0, e1 = 0; unsigned a0 = 0u;
        if (t < TOK) { e0 = EID[(size_t)t * 128 + F.lane]; e1 = EID[(size_t)t * 128 + 64 + F.lane]; a0 = ACT8[(size_t)t * 32 + (F.lane & 31)]; }
        const unsigned char* vb = TV + 256 * s + 16 * c16;
        while (t < TOK) {
            const int tn = t + step; int n0 = 0, n1 = 0; unsigned b0 = 0u;
            if (tn < TOK) { n0 = EID[(size_t)tn * 128 + F.lane]; n1 = EID[(size_t)tn * 128 + 64 + F.lane]; b0 = ACT8[(size_t)tn * 32 + (F.lane & 31)]; }
            const float as = AS[t];
            IDX[F.lane] = e0; IDX[F.lane + 64] = e1; if (F.lane < 32) ACT[F.lane] = a0;
            asm volatile("s_waitcnt lgkmcnt(0)" ::: "memory"); __builtin_amdgcn_wave_barrier();
            int acc[16];
#pragma unroll
            for (int j = 0; j < 16; ++j) acc[j] = 0;
#pragma unroll
            for (int b = 0; b < 8; b += 2) {
                u32x4 vd[2][4]; unsigned a4[2];
#pragma unroll
                for (int h = 0; h < 2; ++h) { a4[h] = ACT[4 * (b + h) + g16];
#pragma unroll
                    for (int u = 0; u < 4; ++u) { const int eid = IDX[16 * (b + h) + 4 * g16 + u]; vd[h][u] = *(const u32x4*)(vb + (size_t)eid * 2048); } }
#pragma unroll
                for (int h = 0; h < 2; ++h)
#pragma unroll
                    for (int q = 0; q < 4; ++q) { const unsigned A_ = vd[h][0][q], B_ = vd[h][1][q], C_ = vd[h][2][q], D_ = vd[h][3][q];
                        const unsigned ablo = __builtin_amdgcn_perm(B_, A_, 0x05010400u), abhi = __builtin_amdgcn_perm(B_, A_, 0x07030602u);
                        const unsigned cdlo = __builtin_amdgcn_perm(D_, C_, 0x05010400u), cdhi = __builtin_amdgcn_perm(D_, C_, 0x07030602u);
                        acc[4 * q + 0] = __builtin_amdgcn_sdot4((int)__builtin_amdgcn_perm(cdlo, ablo, 0x05040100u), (int)a4[h], acc[4 * q + 0], false);
                        acc[4 * q + 1] = __builtin_amdgcn_sdot4((int)__builtin_amdgcn_perm(cdlo, ablo, 0x07060302u), (int)a4[h], acc[4 * q + 1], false);
                        acc[4 * q + 2] = __builtin_amdgcn_sdot4((int)__builtin_amdgcn_perm(cdhi, abhi, 0x05040100u), (int)a4[h], acc[4 * q + 2], false);
                        acc[4 * q + 3] = __builtin_amdgcn_sdot4((int)__builtin_amdgcn_perm(cdhi, abhi, 0x07060302u), (int)a4[h], acc[4 * q + 3], false); }
            }
            { const float r0 = rsum4((float)acc[0], (float)acc[4], (float)acc[8], (float)acc[12]) * as, r1 = rsum4((float)acc[1], (float)acc[5], (float)acc[9], (float)acc[13]) * as;
              const float r2 = rsum4((float)acc[2], (float)acc[6], (float)acc[10], (float)acc[14]) * as, r3 = rsum4((float)acc[3], (float)acc[7], (float)acc[11], (float)acc[15]) * as;
              u32x2 w; w.x = pk2(r0, r1); w.y = pk2(r2, r3); *(u32x2*)(OUT + (size_t)t * DM + 256 * s + 16 * c16 + 4 * g16) = w; }
            asm volatile("s_waitcnt lgkmcnt(0)" ::: "memory"); __builtin_amdgcn_wave_barrier();
            e0 = n0; e1 = n1; a0 = b0; t = tn;
        }
    }
}
__device__ __forceinline__ void ph_peer_ln(const Args& A, Frame& F, const int L) {
    const bf16* OUT = (const bf16*)(A.ws + WS_Z); float* X = A.out; bf16* H = (bf16*)(A.ws + WS_HY); const float* MOD = (const float*)(A.ws + WS_MOD);
    const bf16* Xin = (L == 0) ? (const bf16*)A.out : (const bf16*)(A.ws + WS_Z + 160 * MiB); bf16* Xb = (bf16*)A.out;
    const float* lng = (const float*)A.in[21] + (size_t)(L * 2 + 1) * DM; const float* lnb = (const float*)A.in[22] + (size_t)(L * 2 + 1) * DM;
    for (int t = F.gw; t < TOK; t += F.ngw) {
        const int b = t >> 14;
        const float* gate = MOD + (size_t)((L * 2 + 1) * 2 + b) * 6144 + 4096;
        const float* sh = MOD + (size_t)(((L + 1) * 2 + 0) * 2 + b) * 6144; const float* sc = sh + 2048;
        float v[32]; float sum = 0.f;
#pragma unroll
        for (int j = 0; j < 8; ++j) { const int base = (j * 64 + F.lane) * 4;
            const u32x2 ow = *(const u32x2*)(OUT + (size_t)t * DM + base); const f32x4 o0 = {lo2f(ow.x), hi2f(ow.x), lo2f(ow.y), hi2f(ow.y)};
            const u32x2 xw = *(const u32x2*)(Xin + (size_t)t * DM + base); const f32x4 x0 = {lo2f(xw.x), hi2f(xw.x), lo2f(xw.y), hi2f(xw.y)}; const f32x4 g0 = *(const f32x4*)(gate + base);
#pragma unroll
            for (int e = 0; e < 4; ++e) { v[j * 4 + e] = ALPHA * x0[e] + (1.0f + g0[e]) * o0[e]; sum += v[j * 4 + e]; } }
        const float mean = wsum(sum) * (1.0f / DM); float sq = 0.f;
#pragma unroll
        for (int e = 0; e < 32; ++e) { v[e] -= mean; sq += v[e] * v[e]; }
        const float rstd = rsqrtf(wsum(sq) * (1.0f / DM) + 1e-5f);
#pragma unroll
        for (int j = 0; j < 8; ++j) { const int base = (j * 64 + F.lane) * 4;
            const f32x4 lg0 = *(const f32x4*)(lng + base), lb0 = *(const f32x4*)(lnb + base);
            f32x4 o0;
#pragma unroll
            for (int e = 0; e < 4; ++e) o0[e] = v[j * 4 + e] * rstd * lg0[e] + lb0[e];
            if (L == 0) { u32x2 xo; xo.x = pk2(o0[0], o0[1]); xo.y = pk2(o0[2], o0[3]); *(u32x2*)(Xb + (size_t)t * DM + base) = xo; } else *(f32x4*)(X + (size_t)t * DM + base) = o0;
            if (L == 0) { const f32x4 s0 = *(const f32x4*)(sc + base), h0 = *(const f32x4*)(sh + base); const f32x4 q0 = o0 * (1.0f + s0) + h0;
                u32x2 w; w.x = pk2(q0[0], q0[1]); w.y = pk2(q0[2], q0[3]); *(u32x2*)(H + (size_t)t * DM + base) = w; }
        }
    }
}

__device__ __forceinline__ void ph_odd_post(const Args& A, Frame& F) {
    bf16* Z = (bf16*)(A.ws + WS_Z); const int* positions = (const int*)A.in[2]; bf16* KIT = (bf16*)(A.ws + WS_BIG + 256 * MiB); unsigned char* K8 = A.ws + WS_BIG + 264 * MiB; unsigned char* V8 = A.ws + WS_BIG + 280 * MiB;
    const float inv128 = powf(10000.0f, -(float)F.lane / 64.0f); const int i32 = F.lane & 31; const float inv64 = powf(10000.0f, -(float)i32 / 32.0f);
    const int a16 = F.lane & 15, hs4 = F.lane >> 4, a8 = F.lane & 7, hs8 = F.lane >> 3;
    for (int t = F.gw; t < TOK; t += F.ngw) {
        bf16* zr = Z + (size_t)t * OD_NP; const float pos = (float)positions[t];
        const int bb = t >> 14, spos = t & (SEQ - 1);
        float sn, cs; sincosf(pos * inv128, &sn, &cs);
        float c4[4], s4[4];
#pragma unroll
        for (int e = 0; e < 4; ++e) { c4[e] = __shfl(cs, 4 * a16 + e); s4[e] = __shfl(sn, 4 * a16 + e); }
#pragma unroll
        for (int it = 0; it < 5; ++it) { const int hd = it * 4 + hs4; bf16* hp = zr + hd * 128 + 4 * a16;
            const u32x2 a = *(const u32x2*)hp, b = *(const u32x2*)(hp + 64);
            const float t1[4] = {lo2f(a.x), hi2f(a.x), lo2f(a.y), hi2f(a.y)}, t2[4] = {lo2f(b.x), hi2f(b.x), lo2f(b.y), hi2f(b.y)};
            float o1[4], o2[4];
#pragma unroll
            for (int e = 0; e < 4; ++e) { o1[e] = t1[e] * c4[e] - t2[e] * s4[e]; o2[e] = t2[e] * c4[e] + t1[e] * s4[e]; }
            *(u32x2*)hp = (u32x2){pk2(o1[0], o1[1]), pk2(o1[2], o1[3])}; *(u32x2*)(hp + 64) = (u32x2){pk2(o2[0], o2[1]), pk2(o2[2], o2[3])};
            if (it == 4) { unsigned char* k8 = K8 + ((size_t)((bb * 4 + hs4) * SEQ + spos)) * 128 + 4 * a16;
                int w1 = __builtin_amdgcn_cvt_pk_fp8_f32(o1[0] * 16.0f, o1[1] * 16.0f, 0, false); w1 = __builtin_amdgcn_cvt_pk_fp8_f32(o1[2] * 16.0f, o1[3] * 16.0f, w1, true);
                int w2 = __builtin_amdgcn_cvt_pk_fp8_f32(o2[0] * 16.0f, o2[1] * 16.0f, 0, false); w2 = __builtin_amdgcn_cvt_pk_fp8_f32(o2[2] * 16.0f, o2[3] * 16.0f, w2, true);
                *(unsigned*)k8 = (unsigned)w1; *(unsigned*)(k8 + 64) = (unsigned)w2; } }
        {
            const int e0 = F.lane * 8, kvh = e0 >> 7, d0 = e0 & 127;
            const u32x4 vw = *(const u32x4*)(zr + 2560 + e0);
            const unsigned ww[4] = {vw.x, vw.y, vw.z, vw.w}; unsigned ob[2] = {0u, 0u};
#pragma unroll
            for (int q = 0; q < 4; ++q) { const float c0 = fminf(fmaxf(lo2f(ww[q]) * 16.0f, -127.0f), 127.0f), c1 = fminf(fmaxf(hi2f(ww[q]) * 16.0f, -127.0f), 127.0f);
                const unsigned b0 = __float_as_uint(c0 + 12583040.0f) & 255u, b1 = __float_as_uint(c1 + 12583040.0f) & 255u;
                ob[q >> 1] |= (b0 | (b1 << 8)) << (16 * (q & 1)); }
            *(u32x2*)(V8 + ((size_t)((bb * 4 + kvh) * SEQ + spos)) * 128 + d0) = (u32x2){ob[0], ob[1]};
        }
        sincosf(pos * inv64, &sn, &cs);
#pragma unroll
        for (int e = 0; e < 4; ++e) { c4[e] = __shfl(cs, 4 * a8 + e); s4[e] = __shfl(sn, 4 * a8 + e); }
#pragma unroll
        for (int it = 0; it < 3; ++it) { const int hd = it * 8 + hs8; if (hd < 17) { bf16* hp = zr + 3072 + hd * 64 + 4 * a8;
            const u32x2 a = *(const u32x2*)hp, b = *(const u32x2*)(hp + 32);
            const float t1[4] = {lo2f(a.x), hi2f(a.x), lo2f(a.y), hi2f(a.y)}, t2[4] = {lo2f(b.x), hi2f(b.x), lo2f(b.y), hi2f(b.y)};
            float o1[4], o2[4];
#pragma unroll
            for (int e = 0; e < 4; ++e) { o1[e] = t1[e] * c4[e] - t2[e] * s4[e]; o2[e] = t2[e] * c4[e] + t1[e] * s4[e]; }
            const u32x2 w1 = {pk2(o1[0], o1[1]), pk2(o1[2], o1[3])}, w2 = {pk2(o2[0], o2[1]), pk2(o2[2], o2[3])};
            *(u32x2*)hp = w1; *(u32x2*)(hp + 32) = w2;
            if (hd == 16) {
                const int tile = spos >> 5, rr = spos & 31;
                bf16* kt = KIT + ((size_t)(bb * 512 + tile) * 4) * 512;
                const int d1 = 4 * a8, d2 = 32 + 4 * a8;
                *(u32x2*)(kt + ((d1 >> 4) * 64 + rr + 32 * ((d1 >> 3) & 1)) * 8 + (d1 & 7)) = w1;
                *(u32x2*)(kt + ((d2 >> 4) * 64 + rr + 32 * ((d2 >> 3) & 1)) * 8 + (d2 & 7)) = w2;
            } } }
    }
}

template <int CTRL, int RM> __device__ __forceinline__ unsigned dppu(unsigned old, unsigned v) { return (unsigned)__builtin_amdgcn_update_dpp((int)old, (int)v, CTRL, RM, 0xF, false); }
__device__ __forceinline__ void ph_dsa_select(const Args& A, Frame& F, const int mode = 0) {
    const bf16* Z = (const bf16*)(A.ws + WS_Z); unsigned short* SEL = (unsigned short*)(A.ws + WS_LA); int* CNT = (int*)(A.ws + WS_CNT); const bf16* KIT = (const bf16*)(A.ws + WS_BIG + 256 * MiB);
    LAS unsigned short* SC = (LAS unsigned short*)F.lds;
    LAS unsigned* LST = (LAS unsigned*)(F.lds + 131072);
    LAS unsigned* hist = (LAS unsigned*)(F.lds + 131072 + 16384);
    LAS unsigned* hist1 = (LAS unsigned*)(F.lds + 152576);
    LAS unsigned* res = (LAS unsigned*)(F.lds + 131072 + 16384 + 2048);
    LAS int* wtot = (LAS int*)(F.lds + 131072 + 16384 + 2048 + 64);
    const int r = F.lane & 31, hg = F.lane >> 5, tk = (r >> 2) & 1, hh = (r & 3) + 4 * (r >> 3);
    const int grp = F.wave >> 2, ltid = F.tid & 255, lw = F.wave & 3;
    for (int qd = F.bx; qd < TOK / 4; qd += F.G) {
        const int t0 = 4 * qd, b = t0 >> 14, s0 = t0 & (SEQ - 1);
        const int nkeys = s0 + 4, ntiles = (nkeys + 31) >> 5;
        bf16x8 af[2][4]; f32x2 wv[2][8];
#pragma unroll
        for (int a = 0; a < 2; ++a) {
            const bf16* qrow = Z + (size_t)(t0 + 2 * a + tk) * OD_NP + 3072 + hh * 64 + 8 * hg;
#pragma unroll
            for (int s = 0; s < 4; ++s) af[a][s] = *(const bf16x8*)(qrow + 16 * s);
            const bf16* wrow = Z + (size_t)(t0 + 2 * a + hg) * OD_NP + 4160;
            const u32x4 w0 = *(const u32x4*)(wrow), w1 = *(const u32x4*)(wrow + 8);
            const unsigned ww[8] = {w0.x, w0.y, w0.z, w0.w, w1.x, w1.y, w1.z, w1.w};
#pragma unroll
            for (int q = 0; q < 8; ++q) wv[a][q] = (f32x2){lo2f(ww[q]) * 0.03125f, hi2f(ww[q]) * 0.03125f};
        }
        __syncthreads();
        const bf16* kbase = KIT + (size_t)b * 512 * 2048 + F.lane * 8;
        if (mode != 2) {
            bf16x8 bcur[2][4];
#define DSA_LOAD1(dst, q_, tb_) do { const int tile = ((tb_) + (q_) < ntiles) ? ((tb_) + (q_)) : (ntiles - 1); const bf16* krow = kbase + (size_t)tile * 2048; \
                _Pragma("unroll") for (int s_ = 0; s_ < 4; ++s_) dst[q_][s_] = *(const bf16x8*)(krow + 512 * s_); } while (0)
#define DSA_MM(accv, src, q_, a_) do { _Pragma("unroll") for (int e = 0; e < 16; ++e) accv[e] = 0.f; \
                _Pragma("unroll") for (int s_ = 0; s_ < 4; ++s_) accv = __builtin_amdgcn_mfma_f32_32x32x16_bf16(af[a_][s_], src[q_][s_], accv, 0, 0, 0); } while (0)
#define DSA_EPI(accv, tb_, q_, a_) do { f32x2 s2_ = {0.f, 0.f}; _Pragma("unroll") for (int e = 0; e < 8; ++e) { \
                    const float x0_ = accv[2 * e], x1_ = accv[2 * e + 1]; const int r0_ = __builtin_bit_cast(int, x0_), r1_ = __builtin_bit_cast(int, x1_);        \
                    const f32x2 rl_ = {__builtin_bit_cast(float, r0_ > 0 ? r0_ : 0), __builtin_bit_cast(float, r1_ > 0 ? r1_ : 0)}; s2_ = rl_ * wv[a_][e] + s2_; } \
                float sc_ = s2_.x + s2_.y; const int key = ((tb_) + (q_)) * 32 + r; sc_ = fminf(fmaxf(sc_, -7.999f), 7.999f); const unsigned fx = (unsigned)((int)rintf(sc_ * 4096.0f) + (1 << 15)); \
                if ((tb_) + (q_) < ntiles) SC[(2 * (a_) + hg) * 16384 + key] = (unsigned short)((key <= s0 + 2 * (a_) + hg) ? fx : 0u); } while (0)
            int tb = F.wave * 2;
            if (tb < ntiles) {
                DSA_LOAD1(bcur, 0, tb); DSA_LOAD1(bcur, 1, tb);
                for (; tb < ntiles; tb += NWAVES * 2) {
                    f32x16 accA, accB;
                    DSA_MM(accA, bcur, 0, 0); DSA_MM(accB, bcur, 0, 1);
                    DSA_LOAD1(bcur, 0, tb + NWAVES * 2);
                    DSA_EPI(accA, tb, 0, 0); DSA_MM(accA, bcur, 1, 0); DSA_EPI(accB, tb, 0, 1); DSA_MM(accB, bcur, 1, 1);
                    DSA_LOAD1(bcur, 1, tb + NWAVES * 2);
                    DSA_EPI(accA, tb, 1, 0); DSA_EPI(accB, tb, 1, 1);
                }
            }
#undef DSA_LOAD1
#undef DSA_MM
#undef DSA_EPI
        }
        __syncthreads();
        if (mode == 1) continue;
#pragma unroll 1
        for (int rd = 0; rd < 2; ++rd) {
        const int tok = 2 * rd + grp;
        const int n = s0 + tok + 1; unsigned k = (unsigned)(n < 256 ? n : 256); unsigned prefix = 0u;
        const LAS unsigned short* sc = SC + tok * 16384;
        hist[grp * 256 + ltid] = 0u; hist1[grp * 256 + ltid] = 0u;
        unsigned kreg[64];
#pragma unroll
        for (int j = 0; j < 64; ++j) { const int i = ltid + 256 * j; kreg[j] = (i < n) ? (unsigned)sc[i] : 0u; }
        unsigned lmax = 0u;
#pragma unroll
        for (int j = 0; j < 64; ++j) lmax = (kreg[j] > lmax) ? kreg[j] : lmax;
        unsigned wmin = lmax;
        { unsigned x_;
          x_ = dppu<0xB1, 0xF>(wmin, wmin); wmin = x_ < wmin ? x_ : wmin; x_ = dppu<0x4E, 0xF>(wmin, wmin); wmin = x_ < wmin ? x_ : wmin;
          x_ = dppu<0x141, 0xF>(wmin, wmin); wmin = x_ < wmin ? x_ : wmin; x_ = dppu<0x140, 0xF>(wmin, wmin); wmin = x_ < wmin ? x_ : wmin;
          x_ = dppu<0x142, 0xA>(wmin, wmin); wmin = x_ < wmin ? x_ : wmin; x_ = dppu<0x143, 0xC>(wmin, wmin); wmin = x_ < wmin ? x_ : wmin; }
        if (F.lane == 63) wtot[16 + F.wave] = (int)wmin;
        __syncthreads();
        unsigned lbound = 0xFFFFFFFFu;
#pragma unroll
        for (int w = 0; w < 4; ++w) { const unsigned x = (unsigned)wtot[16 + grp * 4 + w]; lbound = x < lbound ? x : lbound; }
        LAS unsigned* seg = LST + (grp * 4 + lw) * 512; int ccnt = 0;
        {
            const unsigned lb1 = lbound > 1u ? lbound : 1u;
#pragma unroll
            for (int j = 0; j < 64; ++j) { if (256 * j < n) { const bool c = kreg[j] >= lb1; const unsigned long long m = __ballot(c);
                const int pos = ccnt + (int)__builtin_amdgcn_mbcnt_hi((unsigned)(m >> 32), __builtin_amdgcn_mbcnt_lo((unsigned)m, 0u));
                if (c && pos < 512) seg[pos] = (kreg[j] << 16) | (unsigned)(ltid + 256 * j); ccnt += __popcll(m); } }
        }
        const bool fast = ccnt <= 512;
        asm volatile("s_waitcnt lgkmcnt(0)" ::: "memory"); __builtin_amdgcn_wave_barrier();
#pragma unroll 1
        for (int pass = 0; pass < 2; ++pass) {
            const int shift = 8 - 8 * pass;
            LAS unsigned* hs = (pass == 0 ? hist : hist1) + grp * 256;
            if (fast) {
#pragma unroll
                for (int i = 0; i < 8; ++i) { if (64 * i < ccnt) { const int c_ = F.lane + 64 * i; const bool valid = c_ < ccnt; const unsigned kv = valid ? (seg[c_] >> 16) : 0u;
                    const bool match = (pass == 0) ? true : ((kv >> 8) == prefix);
                    if (valid && match) (void)__hip_atomic_fetch_add(&hs[(kv >> shift) & 255u], 1u, __ATOMIC_RELAXED, __HIP_MEMORY_SCOPE_WORKGROUP); } }
            } else {
#pragma unroll
                for (int j = 0; j < 64; ++j) { if (256 * j < n) { const unsigned kv = kreg[j]; const bool valid = ((ltid + 256 * j) < n) && (kv >= lbound);
                    const bool match = (pass == 0) ? true : ((kv >> 8) == prefix);
                    if (valid && match) (void)__hip_atomic_fetch_add(&hs[(kv >> shift) & 255u], 1u, __ATOMIC_RELAXED, __HIP_MEMORY_SCOPE_WORKGROUP); } }
            }
            __syncthreads();
            if (lw == 0) {
                const unsigned c0 = hs[4 * F.lane], c1 = hs[4 * F.lane + 1], c2 = hs[4 * F.lane + 2], c3 = hs[4 * F.lane + 3];
                const unsigned tot = c0 + c1 + c2 + c3; unsigned pre = tot;
                pre += dppu<0x111, 0xF>(0u, pre); pre += dppu<0x112, 0xF>(0u, pre); pre += dppu<0x114, 0xF>(0u, pre); pre += dppu<0x118, 0xF>(0u, pre);
                pre += dppu<0x142, 0xA>(0u, pre); pre += dppu<0x143, 0xC>(0u, pre);
                const unsigned total = (unsigned)__builtin_amdgcn_readlane((int)pre, 63); const unsigned suf = total - pre + tot;
                unsigned above = suf - tot;
                if (above < k && k <= suf) {
                    int bin;
                    if (above + c3 >= k) { bin = 3; } else { above += c3; if (above + c2 >= k) { bin = 2; } else { above += c2; if (above + c1 >= k) { bin = 1; } else { above += c1; bin = 0; } } }
                    res[grp * 2 + 0] = (unsigned)(4 * F.lane + bin); res[grp * 2 + 1] = k - above;
                }
            }
            __syncthreads();
            prefix = (prefix << 8) | res[grp * 2 + 0]; k = res[grp * 2 + 1];
        }
        const unsigned tau = prefix; const int krem = (int)k;
#define MBCNT(m_) ((int)__builtin_amdgcn_mbcnt_hi((unsigned)((m_) >> 32), __builtin_amdgcn_mbcnt_lo((unsigned)(m_), 0u)))
        int cgW = 0, ceW = 0;
        if (fast) {
#pragma unroll
            for (int i = 0; i < 8; ++i) { if (64 * i < ccnt) { const int c_ = F.lane + 64 * i; const bool valid = c_ < ccnt; const unsigned kv = valid ? (seg[c_] >> 16) : 0u;
                cgW += __popcll(__ballot(valid && kv > tau)); ceW += __popcll(__ballot(valid && kv == tau)); } }
        } else {
#pragma unroll
            for (int j = 0; j < 64; ++j) { if (256 * j < n) { const bool valid = (ltid + 256 * j) < n; const unsigned kv = kreg[j];
                cgW += __popcll(__ballot(valid && kv > tau)); ceW += __popcll(__ballot(valid && kv == tau)); } }
        }
        if (F.lane == 0) { wtot[F.wave * 2] = cgW; wtot[F.wave * 2 + 1] = ceW; }
        __syncthreads();
        int og = 0, oe = 0, totg = 0;
        for (int w = 0; w < 4; ++w) { const int a = wtot[(grp * 4 + w) * 2], e = wtot[(grp * 4 + w) * 2 + 1]; if (w < lw) { og += a; oe += e; } totg += a; }
        LAS unsigned short* sel = (LAS unsigned short*)(F.lds + 151552) + grp * 256;
        if (fast) {
#pragma unroll
            for (int i = 0; i < 8; ++i) { if (64 * i < ccnt) { const int c_ = F.lane + 64 * i; const bool valid = c_ < ccnt; const unsigned pk = valid ? seg[c_] : 0u; const unsigned kv = pk >> 16;
                const bool gt = valid && kv > tau, eq = valid && kv == tau; const unsigned long long mg = __ballot(gt), me = __ballot(eq);
                const int pg = og + MBCNT(mg), pe = oe + MBCNT(me);
                if (gt) sel[pg] = (unsigned short)(pk & 0xffffu); else if (eq && pe < krem) sel[totg + pe] = (unsigned short)(pk & 0xffffu);
                og += __popcll(mg); oe += __popcll(me); } }
        } else {
#pragma unroll
            for (int j = 0; j < 64; ++j) { if (256 * j < n) { const int i = ltid + 256 * j; const bool valid = i < n; const unsigned kv = kreg[j];
                const bool gt = valid && kv > tau, eq = valid && kv == tau; const unsigned long long mg = __ballot(gt), me = __ballot(eq);
                const int pg = og + MBCNT(mg), pe = oe + MBCNT(me);
                if (gt) sel[pg] = (unsigned short)i; else if (eq && pe < krem) sel[totg + pe] = (unsigned short)i;
                og += __popcll(mg); oe += __popcll(me); } }
        }
#undef MBCNT
        if (ltid == 0) CNT[t0 + tok] = (n < 256 ? n : 256);
        __syncthreads();
        if (ltid < 128) { int lt2 = ltid; asm volatile("" : "+v"(lt2));
            ((unsigned*)SEL)[(size_t)(t0 + 2 * rd + grp) * 128 + lt2] = ((const LAS unsigned*)(F.lds + 151552))[grp * 128 + lt2]; }
        }
    }
}

__device__ __forceinline__ float sum8_dpp(float v) { v += dppf<0xB1, 0xF>(v); v += dppf<0x4E, 0xF>(v); v += dppf<0x141, 0xF>(v); return v; }
__device__ __forceinline__ void ph_dsa_attn(const Args& A, Frame& F, const XInfo X) {
    const bf16* Z = (const bf16*)(A.ws + WS_Z); const unsigned short* SEL = (const unsigned short*)(A.ws + WS_LA); const int* CNT = (const int*)(A.ws + WS_CNT);
    const unsigned char* K8 = A.ws + WS_BIG + 264 * MiB; const unsigned char* V8 = A.ws + WS_BIG + 280 * MiB; bf16* Y = (bf16*)(A.ws + WS_HY);
    LAS int* IDX = (LAS int*)(F.lds + F.wave * 5120);
    LAS float* SCR = (LAS float*)(F.lds + F.wave * 5120 + 1024);
    const int g8 = F.lane >> 3, c8 = F.lane & 7;
    for (int sl = X.rx; sl < 8; sl += X.nx) {
        const int b = sl >> 2, kvh = sl & 3;
        const unsigned char* kb = K8 + (size_t)sl * SEQ * 128 + 16 * c8; const unsigned char* vb = V8 + (size_t)sl * SEQ * 128 + 16 * c8;
        for (int sq = X.rank * NWAVES + F.wave; sq < SEQ; sq += X.nloc * NWAVES) {
            const int t = b * SEQ + sq; const int n = CNT[t];
            const int l15 = F.lane & 15, g4 = F.lane >> 4;
            long bq[4];
#pragma unroll
            for (int c = 0; c < 2; ++c) {
                float f[16];
#pragma unroll
                for (int e = 0; e < 16; ++e) f[e] = 0.f;
                if (l15 < 4) { const bf16* qp = Z + (size_t)t * OD_NP + (kvh * 4 + l15) * 128 + 64 * c + 16 * g4; const u32x4 a = *(const u32x4*)qp, b2 = *(const u32x4*)(qp + 8);
                    const unsigned aw[8] = {a.x, a.y, a.z, a.w, b2.x, b2.y, b2.z, b2.w};
#pragma unroll
                    for (int q = 0; q < 8; ++q) { f[2 * q] = lo2f(aw[q]) * 16.0f; f[2 * q + 1] = hi2f(aw[q]) * 16.0f; } }
#pragma unroll
                for (int hf = 0; hf < 2; ++hf) {
                    int lo = __builtin_amdgcn_cvt_pk_fp8_f32(f[8 * hf + 0], f[8 * hf + 1], 0, false); lo = __builtin_amdgcn_cvt_pk_fp8_f32(f[8 * hf + 2], f[8 * hf + 3], lo, true);
                    int hi = __builtin_amdgcn_cvt_pk_fp8_f32(f[8 * hf + 4], f[8 * hf + 5], 0, false); hi = __builtin_amdgcn_cvt_pk_fp8_f32(f[8 * hf + 6], f[8 * hf + 7], hi, true);
                    bq[2 * c + hf] = (long)(((unsigned long long)(unsigned)hi << 32) | (unsigned long long)(unsigned)lo); }
            }
#pragma unroll
            for (int m = 0; m < 4; ++m) { const int jj = F.lane + 64 * m; IDX[jj] = (jj < n) ? (int)SEL[(size_t)t * 256 + jj] : 0; }
            asm volatile("s_waitcnt lgkmcnt(0)" ::: "memory"); __builtin_amdgcn_wave_barrier();
            {
                const unsigned char* kq = K8 + (size_t)sl * SEQ * 128 + 16 * g4;
#pragma unroll 1
                for (int tl0 = 0; tl0 < 16; tl0 += 4) {
                    u32x4 k0[4], k1[4];
#pragma unroll
                    for (int u = 0; u < 4; ++u) { const int id = IDX[(tl0 + u) * 16 + l15]; const unsigned char* kr = kq + (size_t)id * 128; k0[u] = *(const u32x4*)kr; k1[u] = *(const u32x4*)(kr + 64); }
#pragma unroll
                    for (int u = 0; u < 4; ++u) {
                        f32x4 acc = {0.f, 0.f, 0.f, 0.f};
                        acc = __builtin_amdgcn_mfma_f32_16x16x32_fp8_fp8((long)(((unsigned long long)k0[u].y << 32) | k0[u].x), bq[0], acc, 0, 0, 0);
                        acc = __builtin_amdgcn_mfma_f32_16x16x32_fp8_fp8((long)(((unsigned long long)k0[u].w << 32) | k0[u].z), bq[1], acc, 0, 0, 0);
                        acc = __builtin_amdgcn_mfma_f32_16x16x32_fp8_fp8((long)(((unsigned long long)k1[u].y << 32) | k1[u].x), bq[2], acc, 0, 0, 0);
                        acc = __builtin_amdgcn_mfma_f32_16x16x32_fp8_fp8((long)(((unsigned long long)k1[u].w << 32) | k1[u].z), bq[3], acc, 0, 0, 0);
                        if (l15 < 4) {
#pragma unroll
                            for (int rg = 0; rg < 4; ++rg) SCR[((tl0 + u) * 16 + 4 * g4 + rg) * 4 + l15] = acc[rg] * 3.452669831e-4f; }
                    }
                }
            }
            asm volatile("s_waitcnt lgkmcnt(0)" ::: "memory"); __builtin_amdgcn_wave_barrier();
            float sclh[4], offh[4];
            {
                f32x4 sv[4]; unsigned pqb[4][4];
#pragma unroll
                for (int m = 0; m < 4; ++m) sv[m] = *(const LAS f32x4*)(SCR + (F.lane + 64 * m) * 4);
#pragma unroll
                for (int g = 0; g < 4; ++g) {
                    float mx = -INFINITY;
#pragma unroll
                    for (int m = 0; m < 4; ++m) { const bool val = (F.lane + 64 * m) < n; sv[m][g] = val ? sv[m][g] : -INFINITY; mx = fmaxf(mx, sv[m][g]); }
                    mx = wmax(mx); float sm = 0.f, sq = 0.f;
#pragma unroll
                    for (int m = 0; m < 4; ++m) { const bool val = (F.lane + 64 * m) < n; const float ex = val ? expf(sv[m][g] - mx) : 0.f; sm += ex;
                        const float pf = rintf(255.0f * ex); sq += pf; pqb[m][g] = (unsigned)pf; }
                    sclh[g] = 0.0625f / (255.0f * wsum(sm)); offh[g] = 128.0f * wsum(sq);
                }
                asm volatile("s_waitcnt lgkmcnt(0)" ::: "memory"); __builtin_amdgcn_wave_barrier();
#pragma unroll
                for (int m = 0; m < 4; ++m) { const int jj = F.lane + 64 * m;
#pragma unroll
                    for (int g = 0; g < 4; ++g) ((LAS unsigned char*)SCR)[(jj >> 2) * 16 + g * 4 + (jj & 3)] = (unsigned char)pqb[m][g]; }
            }
            asm volatile("s_waitcnt lgkmcnt(0)" ::: "memory"); __builtin_amdgcn_wave_barrier();
            unsigned acc[4][16];
#pragma unroll
            for (int g = 0; g < 4; ++g)
#pragma unroll
                for (int j = 0; j < 16; ++j) acc[g][j] = 0u;
#pragma unroll 1
            for (int ib = 0; ib < 8; ib += 2) {
                u32x4 vd[2][4], pq4[2];
#pragma unroll
                for (int h = 0; h < 2; ++h) { pq4[h] = *(const LAS u32x4*)((const LAS unsigned char*)SCR + (8 * (ib + h) + g8) * 16);
#pragma unroll
                    for (int u = 0; u < 4; ++u) { const int id = IDX[32 * (ib + h) + 4 * g8 + u]; vd[h][u] = *(const u32x4*)(vb + (size_t)id * 128); } }
#pragma unroll
                for (int h = 0; h < 2; ++h)
#pragma unroll
                    for (int q = 0; q < 4; ++q) { const unsigned A_ = vd[h][0][q], B_ = vd[h][1][q], C_ = vd[h][2][q], D_ = vd[h][3][q];
                        const unsigned ablo = __builtin_amdgcn_perm(B_, A_, 0x05010400u), abhi = __builtin_amdgcn_perm(B_, A_, 0x07030602u);
                        const unsigned cdlo = __builtin_amdgcn_perm(D_, C_, 0x05010400u), cdhi = __builtin_amdgcn_perm(D_, C_, 0x07030602u);
                        const unsigned t0 = __builtin_amdgcn_perm(cdlo, ablo, 0x05040100u), t1 = __builtin_amdgcn_perm(cdlo, ablo, 0x07060302u);
                        const unsigned t2 = __builtin_amdgcn_perm(cdhi, abhi, 0x05040100u), t3 = __builtin_amdgcn_perm(cdhi, abhi, 0x07060302u);
#pragma unroll
                        for (int g = 0; g < 4; ++g) { const unsigned pg = pq4[h][g];
                            acc[g][4 * q + 0] = __builtin_amdgcn_udot4(t0, pg, acc[g][4 * q + 0], false); acc[g][4 * q + 1] = __builtin_amdgcn_udot4(t1, pg, acc[g][4 * q + 1], false);
                            acc[g][4 * q + 2] = __builtin_amdgcn_udot4(t2, pg, acc[g][4 * q + 2], false); acc[g][4 * q + 3] = __builtin_amdgcn_udot4(t3, pg, acc[g][4 * q + 3], false); } }
            }
            f32x2 mine[8];
            { const int hr = F.lane >> 4; const float scl = (hr == 0) ? sclh[0] : ((hr == 1) ? sclh[1] : ((hr == 2) ? sclh[2] : sclh[3])), off = (hr == 0) ? offh[0] : ((hr == 1) ? offh[1] : ((hr == 2) ? offh[2] : offh[3]));
#pragma unroll
              for (int q = 0; q < 8; ++q) {
                float x[4][2];
#pragma unroll
                for (int g = 0; g < 4; ++g) { float a0 = (float)acc[g][2 * q], a1 = (float)acc[g][2 * q + 1];
                    a0 += dppf<0x128, 0xF>(a0); a1 += dppf<0x128, 0xF>(a1);
                    x[g][0] = a0; x[g][1] = a1; }
                mine[q].x = (rsum4(x[0][0], x[1][0], x[2][0], x[3][0]) - off) * scl; mine[q].y = (rsum4(x[0][1], x[1][1], x[2][1], x[3][1]) - off) * scl;
              } }
            if ((F.lane & 8) == 0) { u32x4 w0, w1; const int hrow = F.lane >> 4;
                w0.x = pk2(mine[0].x, mine[0].y); w0.y = pk2(mine[1].x, mine[1].y); w0.z = pk2(mine[2].x, mine[2].y); w0.w = pk2(mine[3].x, mine[3].y);
                w1.x = pk2(mine[4].x, mine[4].y); w1.y = pk2(mine[5].x, mine[5].y); w1.z = pk2(mine[6].x, mine[6].y); w1.w = pk2(mine[7].x, mine[7].y);
                bf16* yp = Y + (size_t)t * DM + (kvh * 4 + hrow) * 128 + 16 * c8; *(u32x4*)yp = w0; *(u32x4*)(yp + 8) = w1; }
            asm volatile("s_waitcnt lgkmcnt(0)" ::: "memory"); __builtin_amdgcn_wave_barrier();
        }
    }
}

__global__ void __launch_bounds__(NTHREADS, 2) mk_fwd(Args args) {
    extern __shared__ __attribute__((aligned(16))) unsigned char lds[];
    Frame F;
    F.lds = (LAS unsigned char*)lds;
    volatile LAS unsigned* MISC = (volatile LAS unsigned*)(F.lds + MISC_OFF);
    F.tid = threadIdx.x; F.lane = F.tid & 63; F.wave = __builtin_amdgcn_readfirstlane(F.tid >> 6);
    F.bx = blockIdx.x; F.G = gridDim.x; F.gw = F.bx * NWAVES + F.wave; F.ngw = F.G * NWAVES;
    if (F.tid < 64) MISC[F.tid] = 0u;
    __syncthreads();
    unsigned char* ws = args.ws;
    XcdBarrier bar = xcd_barrier_post((unsigned*)(ws + WS_CTL) + CW_BAR, MISC + 8);
    if (F.tid == 0) { MISC[16] = xb_add((unsigned*)(ws + WS_CTL) + CW_XRANK + 64 * bar.x, 1u); }
    const int lo = args.ph_lo, hi = args.ph_hi;
#define IN(k) (lo <= (k) && (k) < hi)
#define SEAM(k) do { if (IN((k) + 1)) xcd_barrier(bar); } while (0)
#define GEMM_BF16(Aptr, Bptr, Nn, Kk, Optr, ldo) do { pg8::Gemm g{(const pg8::bf16_t*)(Aptr), (const pg8::bf16_t*)(Bptr), TOK, (Nn), (Kk)}; pg8::StaticOrder S; S.init(TOK, (Nn), F.G, F.bx); \
        pg8::EpiBf16<0> E{(pg8::bf16_t*)(Optr), (ldo), nullptr, 0, 0}; pg8::gemm_phase<pg8::EpiBf16<0>, pg8::StaticOrder, false>(F.lds, g, S, E, nullptr); } while (0)

#ifndef PROBE_MASK
#define PROBE_MASK 0
#endif
#define PRB(bit, stmt) do { if (PROBE_MASK & (1 << (bit))) { stmt; xcd_barrier(bar); } } while (0)
    if (IN(0)) { PRB(14, ph_prologue(args, F)); ph_prologue(args, F); SEAM(0); }
    if (IN(1)) { ph_mod_x(args, F); SEAM(1); }
    if (F.tid == 0) {
        unsigned* cb = (unsigned*)(ws + WS_CTL) + CW_BAR; unsigned nloc = 1u, rx = 0u, nx = 0u;
        for (unsigned j = 0; j < 16; ++j) { const unsigned c = xb_ld(&cb[XB_XCNT(j)]); if (c > 0u) { if (j < bar.x) ++rx; ++nx; } if (j == bar.x) nloc = c > 0u ? c : 1u; }
        if (nx == 0u) nx = 1u;
        MISC[17] = nloc; MISC[18] = rx; MISC[19] = nx; }
    __syncthreads();
    const XInfo XI = xcc_info(MISC);
    if (IN(2)) { PRB(8, GEMM_BF16(ws + WS_HY, ws + WS_WINE, EV_NP, 2048, ws + WS_Z, EV_NP)); GEMM_BF16(ws + WS_HY, ws + WS_WINE, EV_NP, 2048, ws + WS_Z, EV_NP); SEAM(2); }
    if (IN(3)) { ph_even_post(args, F); SEAM(3); }
    if (IN(4)) { pg8::Gemm g{(const pg8::bf16_t*)(ws + WS_LA), (const pg8::bf16_t*)(ws + WS_WL), TOK, 3072, 512}; pg8::StaticOrder S; S.init(TOK, 3072, F.G, F.bx);
                 EpiLora E{(pg8::bf16_t*)(ws + WS_Z) + 1280, EV_NP, (const float*)args.in[7], (const float*)args.in[9]};
                 pg8::gemm_phase<EpiLora, pg8::StaticOrder, false>(F.lds, g, S, E, nullptr); SEAM(4); }
    if (IN(5)) { PRB(9, ph_scan_prep(args, F)); ph_scan_prep(args, F); xcd_barrier(bar); }
    if (IN(7)) { PRB(15, scan_mfma_rows(args, F)); ph_swa_mfma(args, F); scan_mfma_rows(args, F); SEAM(7); }
    if (IN(8)) { PRB(10, ph_rwkv_finish(args, F)); ph_rwkv_finish(args, F); SEAM(8); }
    if (IN(9)) { GEMM_BF16(ws + WS_HY, ws + WS_WOUTE, 2048, 2048, ws + WS_Z, 2048); SEAM(9); }
    if (IN(10)) { PRB(11, ph_ln_mixer(args, F, 0)); ph_ln_mixer(args, F, 0); SEAM(10); }
    if (IN(11)) { GEMM_BF16(ws + WS_HY, ws + WS_WQ0, 2048, 2048, ws + WS_Z, 2048); SEAM(11); }
    if (IN(12)) { PRB(4, ph_peer_select(args, F, 0)); ph_peer_select(args, F, 0); SEAM(12); }
    if (IN(13)) { PRB(12, ph_peer_u(args, F, XI)); ph_peer_u(args, F, XI); xcd_barrier(bar); ph_peer_act(args, F); xcd_barrier(bar); PRB(13, ph_peer_v(args, F, XI)); ph_peer_v(args, F, XI); xcd_barrier(bar); ph_peer_ln(args, F, 0); SEAM(13); }
    if (IN(14)) { GEMM_BF16(ws + WS_HY, ws + WS_WINO, OD_NP, 2048, ws + WS_Z, OD_NP); SEAM(14); }
    if (IN(15)) { ph_odd_post(args, F); SEAM(15); }
    if (IN(16)) { PRB(2, ph_dsa_select(args, F, 1)); PRB(6, ph_dsa_select(args, F, 2)); PRB(7, ph_dsa_select(args, F, 0)); ph_dsa_select(args, F); SEAM(16); }
    if (IN(17)) { ph_dsa_attn(args, F, XI); SEAM(17); }
    if (IN(18)) { GEMM_BF16(ws + WS_HY, ws + WS_WOUTO, 2048, 2048, ws + WS_Z, 2048); SEAM(18); }
    if (IN(19)) { ph_ln_mixer(args, F, 1); SEAM(19); }
    if (IN(20)) { GEMM_BF16(ws + WS_HY, ws + WS_WQ1, 2048, 2048, ws + WS_Z, 2048); SEAM(20); }
    if (IN(21)) { PRB(4, ph_peer_select(args, F, 1)); ph_peer_select(args, F, 1); SEAM(21); }
    if (IN(22)) { ph_peer_u(args, F, XI); xcd_barrier(bar); ph_peer_act(args, F); xcd_barrier(bar); ph_peer_v(args, F, XI); xcd_barrier(bar); ph_peer_ln(args, F, 1); }
#undef IN
#undef SEAM
#undef GEMM_BF16
}

#ifndef MK_SPLIT
#define MK_SPLIT 0
#endif
extern "C" void kernel_launch(void* const* d_in, const int* in_sizes, int n_in, void* d_out, int out_size, void* d_ws, size_t ws_size, hipStream_t stream) {
    static int grid = 0;
    if (grid == 0) {
        int dev = 0, cus = 0;
        if (n_in != 27 || out_size != TOK * DM || ws_size < WS_END) { fprintf(stderr, "kernel_launch: unexpected shapes (n_in %d out %d ws %zu)\n", n_in, out_size, ws_size); grid = -1; return; }
        if (hipGetDevice(&dev) != hipSuccess || hipDeviceGetAttribute(&cus, hipDeviceAttributeMultiprocessorCount, dev) != hipSuccess) { grid = -1; return; }
        if (hipFuncSetAttribute((const void*)mk_fwd, hipFuncAttributeMaxDynamicSharedMemorySize, LDS_BYTES) != hipSuccess) { fprintf(stderr, "kernel_launch: hipFuncSetAttribute failed\n"); grid = -1; return; }
        int per_cu = 0;
        if (hipOccupancyMaxActiveBlocksPerMultiprocessor(&per_cu, (const void*)mk_fwd, NTHREADS, LDS_BYTES) != hipSuccess || per_cu < 1) fprintf(stderr, "kernel_launch: occupancy query says %d\n", per_cu);
        (void)hipGetLastError();
        grid = cus;
    }
    if (grid < 0) return;
    (void)hipMemsetAsync((char*)d_ws + WS_CTL, 0, CTL_ZERO_BYTES, stream);
    Args a{};
    for (int i = 0; i < 27; ++i) a.in[i] = d_in[i];
    a.out = (float*)d_out; a.ws = (unsigned char*)d_ws;
#if MK_SPLIT
    for (int p = 0; p < 23; ++p) { a.ph_lo = p; a.ph_hi = p + 1; hipLaunchKernelGGL(mk_fwd, dim3(grid), dim3(NTHREADS), LDS_BYTES, stream, a); }
#else
    a.ph_lo = 0; a.ph_hi = 23;
    hipLaunchKernelGGL(mk_fwd, dim3(grid), dim3(NTHREADS), LDS_BYTES, stream, a);
#endif
}
```

```cpp
#include <hip/hip_runtime.h>
#include <cstdio>
#include <cstdint>
namespace pg8 {
#define PG8_LAS __attribute__((address_space(3)))
typedef unsigned short bf16_t;
typedef short bf16x8 __attribute__((ext_vector_type(8)));
typedef float f32x4 __attribute__((ext_vector_type(4)));
typedef unsigned u32x4 __attribute__((ext_vector_type(4)));
constexpr int BM = 256, BK = 64, HALF = 128, HTB = HALF * BK * 2  , STAGE_BYTES = 8 * HTB, NXCD = 8, WGM = 8;

__host__ __device__ __forceinline__ int lds_byte(int r, int c) { const int st = (r >> 4) * 2 + (c >> 5), rr = r & 15, cc = c & 31, ob = rr * 64 + cc * 2; return st * 1024 + (ob ^ (((ob >> 9) & 1) << 5)); }
__host__ __device__ __forceinline__ void stage_rc(int b, int& R, int& C) { const int st = b / 1024, sb = b % 1024, swz = sb ^ (((sb >> 9) & 1) << 5); R = (st >> 1) * 16 + swz / 64; C = (st & 1) * 32 + (swz % 64) / 2; }
__host__ __device__ __forceinline__ int perm32(int rho) { const int n = rho >> 4, i = rho & 15; return 8 * (i >> 2) + 4 * n + (i & 3); }

struct Unit { int pm, pn; };
struct Gemm { const bf16_t* A; const bf16_t* Bt; int M, N, K; };

struct StaticOrder {
    int nM, nN, nwg, G, c;
    __host__ __device__ void init(int M, int N, int G_, int c_) { nM = M / BM; nN = N / BM; nwg = nM * nN; G = G_; c = c_; }
    __host__ __device__ bool next(int i, Unit& u) const {
        const long L = (long)i * G + c; if (L >= nwg) return false;
        int wgid = (int)L; { const int q = nwg / NXCD, r = nwg % NXCD, xcd = wgid % NXCD, off = wgid / NXCD; wgid = (xcd < r ? xcd * (q + 1) : r * (q + 1) + (xcd - r) * q) + off; }
        const int nig = WGM * nN, gid = wgid / nig, fm = gid * WGM, gsz = (nM - fm) < WGM ? (nM - fm) : WGM;
        u.pm = fm + ((wgid % nig) % gsz); u.pn = (wgid % nig) / gsz; return true;
    }
    __device__ __forceinline__ void a_ready(const Unit&) const {}
    __device__ __forceinline__ void done(const Unit&) const {}
};
struct CountedOrder : StaticOrder {
    const unsigned* ready; unsigned need; unsigned* tmo;
    __device__ __forceinline__ void a_ready(const Unit& u) const {
        if (threadIdx.x < 64) {
            const unsigned long long t0 = __builtin_amdgcn_s_memrealtime(); unsigned polls = 0;
            while ((unsigned)__builtin_amdgcn_readfirstlane(__hip_atomic_load(ready + 64 * u.pm, __ATOMIC_RELAXED, __HIP_MEMORY_SCOPE_AGENT)) < need) {
                if ((++polls & 255u) == 0u && __builtin_amdgcn_readfirstlane(__hip_atomic_load(tmo, __ATOMIC_RELAXED, __HIP_MEMORY_SCOPE_AGENT)) != 0u) break;
                if (__builtin_amdgcn_s_memrealtime() - t0 > 2000000ull) {
                    if (threadIdx.x == 0) { unsigned expect = 0u; __hip_atomic_compare_exchange_strong(tmo + 1, &expect, 0x600u | (unsigned)(u.pm & 0xff), __ATOMIC_RELAXED, __ATOMIC_RELAXED, __HIP_MEMORY_SCOPE_AGENT); __hip_atomic_store(tmo, 1u, __ATOMIC_RELAXED, __HIP_MEMORY_SCOPE_AGENT); }
                    break; }
                __builtin_amdgcn_s_sleep(2); }
            __builtin_amdgcn_fence(__ATOMIC_ACQUIRE, "agent");
            asm volatile("s_waitcnt vmcnt(0)" ::: "memory");
        }
#if !defined(BROKEN_HOOK_NO_BARRIER)
        asm volatile("" ::: "memory"); __builtin_amdgcn_s_barrier(); asm volatile("" ::: "memory");
#endif
    }
};

__device__ __forceinline__ unsigned cvt_pk_bf16(float lo, float hi) { unsigned r; asm volatile("v_cvt_pk_bf16_f32 %0, %1, %2" : "=v"(r) : "v"(lo), "v"(hi)); return r; }
typedef float f32x2 __attribute__((ext_vector_type(2)));
__device__ __forceinline__ f32x2 gelu_pk(f32x2 v) {
    const f32x2 av = __builtin_elementwise_abs(v), d = av * 0.2316418882f + 1.0f;
    f32x2 t; t.x = __builtin_amdgcn_rcpf(d.x); t.y = __builtin_amdgcn_rcpf(d.y);
    f32x2 q = t * 0.5307027145f + (-0.7265760135f); q = q * t + 0.7107068705f; q = q * t + (-0.142248368f); q = q * t + 0.127414796f; q = q * t;
    const f32x2 s = (v * v) * (-0.72134752044f);
    f32x2 e; e.x = __builtin_amdgcn_exp2f(s.x); e.y = __builtin_amdgcn_exp2f(s.y);
    const f32x2 m = v * (q * e), r = v - m;
    f32x2 o; o.x = v.x < 0.f ? m.x : r.x; o.y = v.y < 0.f ? m.y : r.y; return o;
}

struct EpiF32 {
    static constexpr bool PERM = false, AFTER_DRAIN = false;
    float* C; int ldc; const float* bias;
    __device__ __forceinline__ void operator()(const f32x4 (&acc)[2][2][4][2], const Unit& u, int wr, int wc, int fr, int fq) const {
        const int row0 = u.pm * BM + wr * 64 + fr, col0 = u.pn * BM + wc * 32 + 4 * fq;
        f32x4 bv[2][2];
#pragma unroll
        for (int bj = 0; bj < 2; ++bj)
#pragma unroll
            for (int n = 0; n < 2; ++n) bv[bj][n] = bias ? *(const f32x4*)(bias + col0 + bj * HALF + n * 16) : (f32x4){0.f, 0.f, 0.f, 0.f};
#pragma unroll
        for (int ai = 0; ai < 2; ++ai)
#pragma unroll
            for (int m = 0; m < 4; ++m) { float* rowp = C + (size_t)(row0 + ai * HALF + m * 16) * ldc + col0;
#pragma unroll
                for (int bj = 0; bj < 2; ++bj)
#pragma unroll
                    for (int n = 0; n < 2; ++n) *(f32x4*)(rowp + bj * HALF + n * 16) = acc[ai][bj][m][n] + bv[bj][n]; }
    }
};
template <int ACT  > struct EpiBf16 {
    static constexpr bool PERM = true, AFTER_DRAIN = false;
    bf16_t* O; int ldc; const float* bias; int split_cols; size_t split_stride;
    __device__ __forceinline__ void operator()(const f32x4 (&acc)[2][2][4][2], const Unit& u, int wr, int wc, int fr, int fq) const {
        const int row0 = u.pm * BM + wr * 64 + fr; int colt = u.pn * BM; bf16_t* base = O;
        if (split_cols) { const int t = colt / split_cols; base += (size_t)t * split_stride; colt -= t * split_cols; }
        const int col0 = colt + wc * 32 + 8 * fq, bcol0 = u.pn * BM + wc * 32 + 8 * fq;
        f32x4 bv[2][2];
#pragma unroll
        for (int bj = 0; bj < 2; ++bj)
#pragma unroll
            for (int n = 0; n < 2; ++n) bv[bj][n] = bias ? *(const f32x4*)(bias + bcol0 + bj * HALF + 4 * n) : (f32x4){0.f, 0.f, 0.f, 0.f};
#pragma unroll
        for (int ai = 0; ai < 2; ++ai)
#pragma unroll
            for (int m = 0; m < 4; ++m) { bf16_t* rowp = base + (size_t)(row0 + ai * HALF + m * 16) * ldc + col0;
#pragma unroll
                for (int bj = 0; bj < 2; ++bj) { f32x4 v0 = acc[ai][bj][m][0] + bv[bj][0], v1 = acc[ai][bj][m][1] + bv[bj][1];
                    if (ACT == 1) { f32x2 a = gelu_pk((f32x2){v0[0], v0[1]}), b = gelu_pk((f32x2){v0[2], v0[3]}), c = gelu_pk((f32x2){v1[0], v1[1]}), d = gelu_pk((f32x2){v1[2], v1[3]});
                        v0 = (f32x4){a.x, a.y, b.x, b.y}; v1 = (f32x4){c.x, c.y, d.x, d.y}; }
                    if (ACT == 2) {
#pragma unroll
                        for (int j = 0; j < 4; ++j) { v0[j] = 0.5f * v0[j] * (1.0f + erff(v0[j] * 0.70710678f)); v1[j] = 0.5f * v1[j] * (1.0f + erff(v1[j] * 0.70710678f)); } }
                    u32x4 w; w.x = cvt_pk_bf16(v0[0], v0[1]); w.y = cvt_pk_bf16(v0[2], v0[3]); w.z = cvt_pk_bf16(v1[0], v1[1]); w.w = cvt_pk_bf16(v1[2], v1[3]);
                    *(u32x4*)(rowp + bj * HALF) = w; } }
    }
};

struct PanelStats {
    unsigned* xbuf;
    unsigned* cnt;
    unsigned* tmo;
    int ntn; float eps;
    unsigned code;
    __device__ __forceinline__ bool run(const f32x4 (&v)[2][2][4][2], const Unit& u, int wr, int wc, int fr, int fq, PG8_LAS unsigned char* lds, int wid, int lane) const {
        typedef float f32x2v __attribute__((ext_vector_type(2)));
        PG8_LAS f32x2v* P = (PG8_LAS f32x2v*)lds;
        PG8_LAS f32x2v* S = (PG8_LAS f32x2v*)(lds + 8192);
        PG8_LAS unsigned* flag = (PG8_LAS unsigned*)(lds + 8192 + 2048);
#pragma unroll
        for (int ai = 0; ai < 2; ++ai)
#pragma unroll
            for (int m = 0; m < 4; ++m) {
                float s = 0.f;
#pragma unroll
                for (int bj = 0; bj < 2; ++bj)
#pragma unroll
                    for (int n = 0; n < 2; ++n) { const f32x4 x = v[ai][bj][m][n]; s += (x[0] + x[1]) + (x[2] + x[3]); }
                s += __shfl_xor(s, 16); s += __shfl_xor(s, 32);
                const float mw = s * (1.0f / 64.0f); float q = 0.f;
#pragma unroll
                for (int bj = 0; bj < 2; ++bj)
#pragma unroll
                    for (int n = 0; n < 2; ++n) { const f32x4 d = v[ai][bj][m][n] - mw; q += (d[0] * d[0] + d[1] * d[1]) + (d[2] * d[2] + d[3] * d[3]); }
                q += __shfl_xor(q, 16); q += __shfl_xor(q, 32);
                if (fq == 0) P[(ai * HALF + wr * 64 + m * 16 + fr) * 4 + wc] = (f32x2v){mw, q};
            }
        asm volatile("s_waitcnt lgkmcnt(0)" ::: "memory"); __builtin_amdgcn_s_barrier(); asm volatile("" ::: "memory");
#if defined(BROKEN_NO_WAIT)
        if (blockIdx.x >= 64) { const long long t0 = clock64(); while (clock64() - t0 < 60000) __builtin_amdgcn_s_sleep(8); }
#endif
        const int row = wid * 32 + (lane & 31);
        if (lane < 32) {
            const f32x2v a = P[row * 4 + 0], b = P[row * 4 + 1], c = P[row * 4 + 2], d = P[row * 4 + 3];
            const float mt = (a.x + b.x + c.x + d.x) * 0.25f;
            const float da = a.x - mt, db = b.x - mt, dc = c.x - mt, dd = d.x - mt;
            const float m2 = (a.y + b.y) + (c.y + d.y) + 64.0f * ((da * da + db * db) + (dc * dc + dd * dd));
            unsigned long long* slot = (unsigned long long*)xbuf + ((size_t)(u.pm * BM + row) * 4 + u.pn);
            __hip_atomic_store(slot, ((unsigned long long)__float_as_uint(m2) << 32) | __float_as_uint(mt), __ATOMIC_RELAXED, __HIP_MEMORY_SCOPE_AGENT);
        }
        asm volatile("s_waitcnt vmcnt(0)" ::: "memory");
        if (lane == 0) __hip_atomic_fetch_add(cnt + 64 * u.pm, 1u, __ATOMIC_RELAXED, __HIP_MEMORY_SCOPE_AGENT);
        if (wid == 0) {
            bool dead = false; const unsigned long long t0 = __builtin_amdgcn_s_memrealtime(); const unsigned want = 8u * (unsigned)ntn;
            for (;;) {
#if defined(BROKEN_NO_WAIT)
                break;
#endif
                if ((unsigned)__builtin_amdgcn_readfirstlane(__hip_atomic_load(cnt + 64 * u.pm, __ATOMIC_RELAXED, __HIP_MEMORY_SCOPE_AGENT)) >= want) break;
                if (__builtin_amdgcn_s_memrealtime() - t0 > 2000000ull) {
                    if (lane == 0) { unsigned expect = 0u; __hip_atomic_compare_exchange_strong(tmo + 1, &expect, code | (unsigned)(u.pm & 0xff), __ATOMIC_RELAXED, __ATOMIC_RELAXED, __HIP_MEMORY_SCOPE_AGENT);
                                     __hip_atomic_store(tmo, 1u, __ATOMIC_RELAXED, __HIP_MEMORY_SCOPE_AGENT); }
                    dead = true; break; }
                __builtin_amdgcn_s_sleep(2);
            }
            __builtin_amdgcn_fence(__ATOMIC_ACQUIRE, "agent");
            if (lane == 0) flag[0] = dead ? 1u : 0u;
        }
        asm volatile("s_waitcnt vmcnt(0) lgkmcnt(0)" ::: "memory"); __builtin_amdgcn_s_barrier(); asm volatile("" ::: "memory");
        const bool bad = flag[0] != 0u;
        if (lane < 32) {
            const unsigned long long* slot = (const unsigned long long*)xbuf + (size_t)(u.pm * BM + row) * 4; float mt[4], m2[4]; float ms = 0.f;
#pragma unroll
            for (int t = 0; t < 4; ++t) { if (t < ntn) { const unsigned long long w = __hip_atomic_load(slot + t, __ATOMIC_RELAXED, __HIP_MEMORY_SCOPE_AGENT); mt[t] = __uint_as_float((unsigned)w); m2[t] = __uint_as_float((unsigned)(w >> 32)); } else { mt[t] = 0.f; m2[t] = 0.f; } ms += mt[t]; }
            const float mean = ms / (float)ntn; float q = 0.f;
#pragma unroll
            for (int t = 0; t < 4; ++t) if (t < ntn) { const float dm = mt[t] - mean; q += m2[t] + 256.0f * dm * dm; }
            S[row] = (f32x2v){mean, 1.0f / sqrtf(q / (256.0f * (float)ntn) + eps)};
        }
        asm volatile("s_waitcnt lgkmcnt(0)" ::: "memory"); __builtin_amdgcn_s_barrier(); asm volatile("" ::: "memory");
        return bad;
    }
};
struct EpiLnRes {
    static constexpr bool PERM = false, AFTER_DRAIN = true;
    const float* base; float* out; int ldc; const float* bias; PanelStats st; unsigned poison;
    __device__ __forceinline__ void refuse(size_t i0, size_t stride, int M, int N) const { const float q = __builtin_nanf(""); for (size_t i = i0; i < (size_t)M * N; i += stride) out[(i / N) * ldc + i % N] = q;
        if (i0 == 0) { unsigned expect = 0u; __hip_atomic_compare_exchange_strong(st.tmo + 1, &expect, 0x7f0u, __ATOMIC_RELAXED, __ATOMIC_RELAXED, __HIP_MEMORY_SCOPE_AGENT); __hip_atomic_store(st.tmo, 1u, __ATOMIC_RELAXED, __HIP_MEMORY_SCOPE_AGENT); } }
    __device__ __forceinline__ void fused(f32x4 (&acc)[2][2][4][2], const Unit& u, int wr, int wc, int fr, int fq, PG8_LAS unsigned char* lds, int wid, int lane) const {
        typedef float f32x2v __attribute__((ext_vector_type(2)));
        const PG8_LAS f32x2v* S = (const PG8_LAS f32x2v*)(lds + 8192);
        const int col0 = u.pn * BM + wc * 32 + 4 * fq;
#pragma unroll
        for (int bj = 0; bj < 2; ++bj)
#pragma unroll
            for (int n = 0; n < 2; ++n) { const f32x4 bv = bias ? *(const f32x4*)(bias + col0 + bj * HALF + n * 16) : (f32x4){0.f, 0.f, 0.f, 0.f};
#pragma unroll
                for (int ai = 0; ai < 2; ++ai)
#pragma unroll
                    for (int m = 0; m < 4; ++m) acc[ai][bj][m][n] += bv; }
        const bool bad = st.run(acc, u, wr, wc, fr, fq, lds, wid, lane) || poison != 0u;
        const float qnan = __builtin_nanf("");
#pragma unroll
        for (int ai = 0; ai < 2; ++ai)
#pragma unroll
            for (int m = 0; m < 4; ++m) { const int r = ai * HALF + wr * 64 + m * 16 + fr; const f32x2v sr = S[r]; const size_t off = (size_t)(u.pm * BM + r) * ldc + col0;
#pragma unroll
                for (int bj = 0; bj < 2; ++bj)
#pragma unroll
                    for (int n = 0; n < 2; ++n) { const f32x4 bs = *(const f32x4*)(base + off + bj * HALF + n * 16); f32x4 o = bs + (acc[ai][bj][m][n] - sr.x) * sr.y;
                        if (bad) o = (f32x4){qnan, qnan, qnan, qnan}; *(f32x4*)(out + off + bj * HALF + n * 16) = o; }
                asm volatile("" ::: "memory"); }
    }
};
struct EpiLnResLn {
    static constexpr bool PERM = false, AFTER_DRAIN = true;
    const float* base; float* out; bf16_t* xn; int ldc; const float* bias; PanelStats st1, st2; unsigned poison;
    __device__ __forceinline__ void refuse(size_t i0, size_t stride, int M, int N) const { const float q = __builtin_nanf(""); for (size_t i = i0; i < (size_t)M * N; i += stride) { const size_t o = (i / N) * ldc + i % N; out[o] = q; xn[o] = (bf16_t)0x7fc0u; }
        if (i0 == 0) { unsigned expect = 0u; __hip_atomic_compare_exchange_strong(st1.tmo + 1, &expect, 0x7f0u, __ATOMIC_RELAXED, __ATOMIC_RELAXED, __HIP_MEMORY_SCOPE_AGENT); __hip_atomic_store(st1.tmo, 1u, __ATOMIC_RELAXED, __HIP_MEMORY_SCOPE_AGENT); } }
    __device__ __forceinline__ void fused(f32x4 (&acc)[2][2][4][2], const Unit& u, int wr, int wc, int fr, int fq, PG8_LAS unsigned char* lds, int wid, int lane) const {
        typedef float f32x2v __attribute__((ext_vector_type(2))); typedef unsigned u32x2v __attribute__((ext_vector_type(2)));
        const PG8_LAS f32x2v* S = (const PG8_LAS f32x2v*)(lds + 8192);
        const int col0 = u.pn * BM + wc * 32 + 4 * fq;
#pragma unroll
        for (int bj = 0; bj < 2; ++bj)
#pragma unroll
            for (int n = 0; n < 2; ++n) { const f32x4 bv = bias ? *(const f32x4*)(bias + col0 + bj * HALF + n * 16) : (f32x4){0.f, 0.f, 0.f, 0.f};
#pragma unroll
                for (int ai = 0; ai < 2; ++ai)
#pragma unroll
                    for (int m = 0; m < 4; ++m) acc[ai][bj][m][n] += bv; }
        bool bad = st1.run(acc, u, wr, wc, fr, fq, lds, wid, lane) || poison != 0u;
        const float qnan = __builtin_nanf("");
#pragma unroll
        for (int ai = 0; ai < 2; ++ai)
#pragma unroll
            for (int m = 0; m < 4; ++m) { const int r = ai * HALF + wr * 64 + m * 16 + fr; const f32x2v sr = S[r]; const size_t off = (size_t)(u.pm * BM + r) * ldc + col0;
#pragma unroll
                for (int bj = 0; bj < 2; ++bj)
#pragma unroll
                    for (int n = 0; n < 2; ++n) { const f32x4 bs = *(const f32x4*)(base + off + bj * HALF + n * 16); acc[ai][bj][m][n] = bs + (acc[ai][bj][m][n] - sr.x) * sr.y; }
                asm volatile("" : "+v"(acc[ai][0][m][0]), "+v"(acc[ai][0][m][1]), "+v"(acc[ai][1][m][0]), "+v"(acc[ai][1][m][1]));
                if (m & 1) asm volatile("" ::: "memory"); }
        const bool bad1 = bad;
        bad = st2.run(acc, u, wr, wc, fr, fq, lds, wid, lane) || bad;
#pragma unroll
        for (int ai = 0; ai < 2; ++ai)
#pragma unroll
            for (int m = 0; m < 4; ++m) { const int r = ai * HALF + wr * 64 + m * 16 + fr; const f32x2v sr = S[r]; const size_t off = (size_t)(u.pm * BM + r) * ldc + col0;
#pragma unroll
                for (int bj = 0; bj < 2; ++bj)
#pragma unroll
                    for (int n = 0; n < 2; ++n) { const f32x4 x1 = acc[ai][bj][m][n]; *(f32x4*)(out + off + bj * HALF + n * 16) = bad1 ? (f32x4){qnan, qnan, qnan, qnan} : x1;
                        const f32x4 o = (x1 - sr.x) * sr.y; u32x2v w; w.x = cvt_pk_bf16(o[0], o[1]); w.y = cvt_pk_bf16(o[2], o[3]);
                        if (bad) { w.x = 0x7fc07fc0u; w.y = 0x7fc07fc0u; } *(u32x2v*)(xn + off + bj * HALF + n * 16) = w; }
                asm volatile("" ::: "memory"); }
    }
};

template <class Epi, class Sched, bool STAMP = false>
__device__ __forceinline__ void gemm_phase(PG8_LAS unsigned char* lds, const Gemm g, const Sched& S, const Epi& E, unsigned long long* stamps) {
    const int tid = threadIdx.x, wid = __builtin_amdgcn_readfirstlane(tid >> 6), lane = tid & 63, wr = wid >> 2, wc = wid & 3, fr = lane & 15, fq = lane >> 4;
    const int K = g.K, nt = K / BK;
    int ts_lo = 0, ts_hi = 0, nts = 0; const unsigned long long rt_entry = STAMP ? (unsigned long long)wall_clock64() : 0ull;
#define PG8_STAMP() do { if (STAMP && wid == 0 && nts < 64) { const unsigned long long _c = (unsigned long long)clock64(); \
        ts_lo = (lane == nts) ? (int)(unsigned)_c : ts_lo; ts_hi = (lane == nts) ? (int)(unsigned)(_c >> 32) : ts_hi; ++nts; } } while (0)
    PG8_STAMP();
    unsigned voffA[2], voffB[2];
#pragma unroll
    for (int i = 0; i < 2; ++i) { int R, C; stage_rc(tid * 16 + i * 8192, R, C); const int Rb = Epi::PERM ? ((R & ~31) + perm32(R & 31)) : R;
        voffA[i] = (unsigned)(R * K + C) * 2u; voffB[i] = (unsigned)(Rb * K + C) * 2u; }
    const size_t kstep = (size_t)(BK * 2);
    const size_t hstep = (size_t)HALF * K * 2;
    const size_t tstep = 2 * hstep;
    const unsigned ldsw = (unsigned)wid * 1024u;
    const int aoff = lds_byte(wr * 64 + fr, fq * 8), boff = lds_byte(wc * 32 + fr, fq * 8);
#define PG8_SA(b, h) (((b) * 2 + (h)) * HTB)
#define PG8_SB(b, h) ((4 + (b) * 2 + (h)) * HTB)
#define PG8_STAGE(bufoff, gbase, voff) do { _Pragma("unroll") for (int _i = 0; _i < 2; ++_i) \
        __builtin_amdgcn_global_load_lds((const unsigned*)((const char*)(gbase) + (voff)[_i]), (PG8_LAS unsigned*)(lds + (bufoff) + ldsw + _i * 8192), 16, 0, 0); } while (0)
#define PG8_LDA(dst, b, h) do { _Pragma("unroll") for (int m = 0; m < 4; ++m) _Pragma("unroll") for (int k = 0; k < 2; ++k) dst[m][k] = *(const PG8_LAS bf16x8*)(lds + PG8_SA(b, h) + aoff + m * 2048 + k * 1024); } while (0)
#define PG8_LDB(dst, b, h) do { _Pragma("unroll") for (int n = 0; n < 2; ++n) _Pragma("unroll") for (int k = 0; k < 2; ++k) dst[n][k] = *(const PG8_LAS bf16x8*)(lds + PG8_SB(b, h) + boff + n * 2048 + k * 1024); } while (0)
#define PG8_MMA(ai, bj, At, Bt) do { __builtin_amdgcn_s_setprio(1); _Pragma("unroll") for (int m = 0; m < 4; ++m) _Pragma("unroll") for (int n = 0; n < 2; ++n) _Pragma("unroll") for (int k = 0; k < 2; ++k) \
        acc[ai][bj][m][n] = __builtin_amdgcn_mfma_f32_16x16x32_bf16(Bt[n][k], At[m][k], acc[ai][bj][m][n], 0, 0, 0); __builtin_amdgcn_s_setprio(0); } while (0)
#define PG8_WAIT_V(n) asm volatile("s_waitcnt vmcnt(" #n ")" ::: "memory")
#define PG8_WAIT_L(n) asm volatile("s_waitcnt lgkmcnt(" #n ")" ::: "memory")
#define PG8_BAR __builtin_amdgcn_s_barrier()
#define PG8_SCHED __builtin_amdgcn_sched_barrier(0)
    Unit cur, nxt; int ui = 0;
    if (!S.next(0, cur)) return;
    f32x4 acc[2][2][4][2];
#pragma unroll
    for (int a = 0; a < 2; ++a)
#pragma unroll
        for (int b = 0; b < 2; ++b)
#pragma unroll
            for (int m = 0; m < 4; ++m)
#pragma unroll
                for (int n = 0; n < 2; ++n) acc[a][b][m][n] = (f32x4){0.f, 0.f, 0.f, 0.f};
    bf16x8 At[4][2], B0[2][2], B1[2][2];
    const char* cA = (const char*)g.A + (size_t)cur.pm * tstep; const char* cB = (const char*)g.Bt + (size_t)cur.pn * tstep;
    S.a_ready(cur);
    PG8_STAGE(PG8_SB(0, 0), cB, voffB); PG8_STAGE(PG8_SA(0, 0), cA, voffA); PG8_STAGE(PG8_SB(0, 1), cB + hstep, voffB); PG8_STAGE(PG8_SA(0, 1), cA + hstep, voffA);
    if (wr == 1) PG8_BAR;
    PG8_WAIT_V(4); PG8_BAR;
    PG8_STAGE(PG8_SB(1, 0), cB + kstep, voffB); PG8_STAGE(PG8_SA(1, 0), cA + kstep, voffA); PG8_STAGE(PG8_SB(1, 1), cB + hstep + kstep, voffB);
    PG8_WAIT_V(6); PG8_BAR;
    PG8_STAMP();
    for (;;) {
        const bool has_next = S.next(ui + 1, nxt);
        const char* nA = has_next ? (const char*)g.A + (size_t)nxt.pm * tstep : cA; const char* nB = has_next ? (const char*)g.Bt + (size_t)nxt.pn * tstep : cB;
        for (int t = 0; t < nt; t += 2) {
            const bool last = (t == nt - 2);
            const char* a1 = cA + (size_t)(t + 1) * kstep;
            const char* a2 = last ? nA : cA + (size_t)(t + 2) * kstep; const char* b2 = last ? nB : cB + (size_t)(t + 2) * kstep;
            const char* a3 = a2 + kstep; const char* b3 = b2 + kstep;
            if (last && has_next) S.a_ready(nxt);
            PG8_LDB(B0, 0, 0); PG8_SCHED; PG8_LDA(At, 0, 0); PG8_STAGE(PG8_SA(1, 1), a1 + hstep, voffA);
            PG8_WAIT_L(8); PG8_BAR; PG8_WAIT_L(0); PG8_MMA(0, 0, At, B0); PG8_BAR; PG8_SCHED;
            PG8_LDB(B1, 0, 1); PG8_STAGE(PG8_SB(0, 0), b2, voffB);
            PG8_BAR; PG8_WAIT_L(0); PG8_MMA(0, 1, At, B1); PG8_BAR;
            PG8_LDA(At, 0, 1); PG8_STAGE(PG8_SA(0, 0), a2, voffA);
            PG8_BAR; PG8_WAIT_L(0); PG8_MMA(1, 0, At, B0); PG8_BAR; PG8_SCHED;
            PG8_STAGE(PG8_SB(0, 1), b2 + hstep, voffB);
            PG8_WAIT_V(6); PG8_BAR; PG8_MMA(1, 1, At, B1); PG8_BAR;
            PG8_LDB(B0, 1, 0); PG8_SCHED; PG8_LDA(At, 1, 0); PG8_STAGE(PG8_SA(0, 1), a2 + hstep, voffA);
            PG8_WAIT_L(8); PG8_BAR; PG8_WAIT_L(0); PG8_MMA(0, 0, At, B0); PG8_BAR; PG8_SCHED;
            PG8_LDB(B1, 1, 1); PG8_STAGE(PG8_SB(1, 0), b3, voffB);
            PG8_BAR; PG8_WAIT_L(0); PG8_MMA(0, 1, At, B1); PG8_BAR;
            PG8_LDA(At, 1, 1); PG8_STAGE(PG8_SA(1, 0), a3, voffA);
            PG8_BAR; PG8_WAIT_L(0); PG8_MMA(1, 0, At, B0); PG8_BAR; PG8_SCHED;
            PG8_STAGE(PG8_SB(1, 1), b3 + hstep, voffB);
            PG8_WAIT_V(6); PG8_BAR; PG8_MMA(1, 1, At, B1); PG8_BAR;
        }
        PG8_STAMP();
        if constexpr (!Epi::AFTER_DRAIN) { E(acc, cur, wr, wc, fr, fq); S.done(cur); }
        PG8_STAMP();
        if (!has_next) break;
#pragma unroll
        for (int a = 0; a < 2; ++a)
#pragma unroll
            for (int b = 0; b < 2; ++b)
#pragma unroll
                for (int m = 0; m < 4; ++m)
#pragma unroll
                    for (int n = 0; n < 2; ++n) acc[a][b][m][n] = (f32x4){0.f, 0.f, 0.f, 0.f};
        cur = nxt; cA = nA; cB = nB; ++ui;
    }
    PG8_WAIT_V(0);
    if (wr == 0) PG8_BAR;
    PG8_BAR;
    if constexpr (Epi::AFTER_DRAIN) { E.fused(acc, cur, wr, wc, fr, fq, lds, wid, lane); S.done(cur); }
    PG8_STAMP();
    if (STAMP && wid == 0) { stamps[lane] = lane < nts ? (((unsigned long long)(unsigned)ts_hi << 32) | (unsigned)ts_lo) : 0ull;
        if (lane == 62) stamps[62] = rt_entry; if (lane == 63) stamps[63] = (unsigned long long)wall_clock64(); }
#undef PG8_STAMP
#undef PG8_SA
#undef PG8_SB
#undef PG8_STAGE
#undef PG8_LDA
#undef PG8_LDB
#undef PG8_MMA
#undef PG8_WAIT_V
#undef PG8_WAIT_L
#undef PG8_BAR
#undef PG8_SCHED
}
}

#define LAS __attribute__((address_space(3)))
#define XB_TMO      128
#define XB_XCNT(j)  (256  + 64 * (j))
#define XB_XSUB(j)  (1280 + 64 * (j))
#define XB_XGEN(j)  (2304 + 64 * (j))
#define XB_TOP      3328
#define XB_TOPGEN   3392
#define XCD_BAR_WORDS 3456
#define XB_SPIN_CAP (1u << 24)

__device__ __forceinline__ unsigned xb_ld(unsigned* p)              { return __hip_atomic_load(p, __ATOMIC_RELAXED, __HIP_MEMORY_SCOPE_AGENT); }
__device__ __forceinline__ unsigned xb_add(unsigned* p, unsigned v) { return __hip_atomic_fetch_add(p, v, __ATOMIC_RELAXED, __HIP_MEMORY_SCOPE_AGENT); }
__device__ __forceinline__ unsigned xb_xcc_id() { return (unsigned)__builtin_amdgcn_s_getreg((3 << 11) | 20) & 0xFu; }
#define XB_SPIN(cond, bar) do { unsigned _sp = 0; while (cond) { __builtin_amdgcn_s_sleep(1); \
    if ((++_sp & 255u) == 0u) { if (xb_ld(&(bar)[XB_TMO])) break; if (_sp > XB_SPIN_CAP) { atomicAdd(&(bar)[XB_TMO], 1u); break; } } } } while (0)

struct XcdBarrier { unsigned* bar; unsigned x; volatile LAS unsigned* st; };

__device__ __forceinline__ XcdBarrier xcd_barrier_post(unsigned* bar, volatile LAS unsigned* st) {
    XcdBarrier b; b.bar = bar; b.x = xb_xcc_id(); b.st = st;
    if (threadIdx.x == 0) (void)xb_add(&bar[XB_XCNT(b.x)], 1u);
    return b;
}
__device__ __forceinline__ void xcd_barrier_complete(unsigned* bar, unsigned x, unsigned& nloc, unsigned& nx) {
    const unsigned G = gridDim.x * gridDim.y * gridDim.z;
    unsigned sum, cnt, mine, sp = 0u;
    for (;;) {
        sum = 0u; cnt = 0u; mine = 0u;
#pragma unroll
        for (unsigned j = 0; j < 16; ++j) { const unsigned c = xb_ld(&bar[XB_XCNT(j)]); sum += c; cnt += (c > 0u) ? 1u : 0u; mine = (j == x) ? c : mine; }
        if (sum == G) break;
        __builtin_amdgcn_s_sleep(1);
        if ((++sp & 255u) == 0u) { if (xb_ld(&bar[XB_TMO])) break; if (sp > XB_SPIN_CAP) { atomicAdd(&bar[XB_TMO], 1u); break; } }
    }
    nloc = mine > 0u ? mine : 1u; nx = cnt > 0u ? cnt : 1u;
}
__device__ __forceinline__ void xcd_barrier(const XcdBarrier& b) {
    asm volatile("s_waitcnt vmcnt(0)" ::: "memory");
    __syncthreads();
    if (threadIdx.x == 0) {
        unsigned* bar = b.bar;
        __builtin_amdgcn_s_waitcnt(0);
        unsigned nloc = b.st[0], nx = b.st[1];
        if (nloc == 0u) { xcd_barrier_complete(bar, b.x, nloc, nx); b.st[0] = nloc; b.st[1] = nx; }
        const unsigned old = xb_add(&bar[XB_XSUB(b.x)], 1u);
        const unsigned gen = old / nloc;
        if (old + 1u == (gen + 1u) * nloc) {
            __builtin_amdgcn_fence(__ATOMIC_RELEASE, "agent");
            asm volatile("s_waitcnt vmcnt(0)" ::: "memory");
            const unsigned og = xb_add(&bar[XB_TOP], 1u);
            const unsigned tg = og / nx;
            if (og + 1u == (tg + 1u) * nx) xb_add(&bar[XB_TOPGEN], 1u);
            else XB_SPIN(xb_ld(&bar[XB_TOPGEN]) == tg, bar);
            __builtin_amdgcn_fence(__ATOMIC_ACQUIRE, "agent");
            xb_add(&bar[XB_XGEN(b.x)], 1u);
            asm volatile("s_waitcnt vmcnt(0)" ::: "memory");
        } else {
            XB_SPIN(xb_ld(&bar[XB_XGEN(b.x)]) == gen, bar);
            __builtin_amdgcn_fence(__ATOMIC_ACQUIRE, "agent");
            asm volatile("s_waitcnt vmcnt(0)" ::: "memory");
        }
    }
    __syncthreads();
}

typedef unsigned short bf16;
typedef float f32x4 __attribute__((ext_vector_type(4)));
typedef float f32x16 __attribute__((ext_vector_type(16)));
typedef float f32x2 __attribute__((ext_vector_type(2)));
typedef unsigned u32x4 __attribute__((ext_vector_type(4)));
typedef unsigned u32x2 __attribute__((ext_vector_type(2)));
typedef short bf16x8 __attribute__((ext_vector_type(8)));
typedef __bf16 bf2_t __attribute__((ext_vector_type(2)));

constexpr int NTHREADS = 512, NWAVES = 8;
constexpr int LDS_BYTES = 160 * 1024;
constexpr int MISC_OFF = LDS_BYTES - 256;
constexpr int TOK = 32768, SEQ = 16384, DM = 2048;
constexpr int EV_N = 4800, EV_NP = 4864, OD_N = 4176, OD_NP = 4352;
constexpr float ALPHA = 1.41421356237f;
constexpr size_t MiB = 1u << 20;
constexpr size_t WS_CTL = 0, CTL_ZERO_BYTES = 1 * MiB;
constexpr int CW_BAR = 4096, CW_XRANK = 8192;
constexpr size_t WS_MOD = 1 * MiB, WS_SKB = 2 * MiB, WS_WL = 4 * MiB, WS_BS = 7 * MiB, WS_CNT = 9 * MiB;
constexpr size_t WS_WINE = 10 * MiB, WS_WOUTE = 29 * MiB, WS_WINO = 37 * MiB, WS_WOUTO = 54 * MiB, WS_WQ0 = 62 * MiB, WS_WQ1 = 70 * MiB;
constexpr size_t WS_HY = 78 * MiB, WS_Z = 206 * MiB, WS_LA = 510 * MiB, WS_BIG = 542 * MiB, WS_END = 1022 * MiB;

__device__ __forceinline__ float bf2f(unsigned short b) { return __uint_as_float(((unsigned)b) << 16); }
__device__ __forceinline__ unsigned pk2(float lo, float hi) { const bf2_t v = {(__bf16)lo, (__bf16)hi}; return __builtin_bit_cast(unsigned, v); }
__device__ __forceinline__ unsigned f2bf(float f) { return pk2(f, 0.f) & 0xffffu; }
__device__ __forceinline__ float lo2f(unsigned w) { return __uint_as_float(w << 16); }
__device__ __forceinline__ float hi2f(unsigned w) { return __uint_as_float(w & 0xffff0000u); }
template <int CTRL, int RM> __device__ __forceinline__ float dppo(float v) { return __int_as_float(__builtin_amdgcn_update_dpp(__float_as_int(v), __float_as_int(v), CTRL, RM, 0xF, false)); }
__device__ __forceinline__ float wsum(float v) {
    v += __int_as_float(__builtin_amdgcn_update_dpp(0, __float_as_int(v), 0xB1, 0xF, 0xF, false)); v += __int_as_float(__builtin_amdgcn_update_dpp(0, __float_as_int(v), 0x4E, 0xF, 0xF, false));
    v += __int_as_float(__builtin_amdgcn_update_dpp(0, __float_as_int(v), 0x141, 0xF, 0xF, false)); v += __int_as_float(__builtin_amdgcn_update_dpp(0, __float_as_int(v), 0x140, 0xF, 0xF, false));
    v += __int_as_float(__builtin_amdgcn_update_dpp(0, __float_as_int(v), 0x142, 0xA, 0xF, false)); v += __int_as_float(__builtin_amdgcn_update_dpp(0, __float_as_int(v), 0x143, 0xC, 0xF, false));
    return __int_as_float(__builtin_amdgcn_readlane(__float_as_int(v), 63));
}
__device__ __forceinline__ float wmax(float v) {
    v = fmaxf(v, dppo<0xB1, 0xF>(v)); v = fmaxf(v, dppo<0x4E, 0xF>(v)); v = fmaxf(v, dppo<0x141, 0xF>(v)); v = fmaxf(v, dppo<0x140, 0xF>(v));
    v = fmaxf(v, dppo<0x142, 0xA>(v)); v = fmaxf(v, dppo<0x143, 0xC>(v));
    return __int_as_float(__builtin_amdgcn_readlane(__float_as_int(v), 63));
}
__device__ __forceinline__ float xsum32(float x) { const auto r = __builtin_amdgcn_permlane32_swap(__float_as_uint(x), __float_as_uint(x), false, false); return __uint_as_float(r[0]) + __uint_as_float(r[1]); }
__device__ __forceinline__ float xsum16(float x) { const auto r = __builtin_amdgcn_permlane16_swap(__float_as_uint(x), __float_as_uint(x), false, false); return __uint_as_float(r[0]) + __uint_as_float(r[1]); }
__device__ __forceinline__ float xmax32(float x) { const auto r = __builtin_amdgcn_permlane32_swap(__float_as_uint(x), __float_as_uint(x), false, false); return fmaxf(__uint_as_float(r[0]), __uint_as_float(r[1])); }
__device__ __forceinline__ float xmax16(float x) { const auto r = __builtin_amdgcn_permlane16_swap(__float_as_uint(x), __float_as_uint(x), false, false); return fmaxf(__uint_as_float(r[0]), __uint_as_float(r[1])); }
__device__ __forceinline__ float rsum4(float v0, float v1, float v2, float v3) {
    const auto p = __builtin_amdgcn_permlane32_swap(__float_as_uint(v0), __float_as_uint(v2), false, false);
    const auto q = __builtin_amdgcn_permlane32_swap(__float_as_uint(v1), __float_as_uint(v3), false, false);
    const float P = __uint_as_float(p[0]) + __uint_as_float(p[1]);
    const float Q = __uint_as_float(q[0]) + __uint_as_float(q[1]);
    const auto t = __builtin_amdgcn_permlane16_swap(__float_as_uint(P), __float_as_uint(Q), false, false);
    return __uint_as_float(t[0]) + __uint_as_float(t[1]);
}
__device__ __forceinline__ float rdlane(float v, int l) { return __int_as_float(__builtin_amdgcn_readlane(__float_as_int(v), l)); }
__device__ __forceinline__ unsigned rdlaneu(unsigned v, int l) { return (unsigned)__builtin_amdgcn_readlane((int)v, l); }
__device__ __forceinline__ float dot2bf(unsigned a, unsigned b, float c) {
    return __builtin_amdgcn_fdot2_f32_bf16(__builtin_bit_cast(bf2_t, a), __builtin_bit_cast(bf2_t, b), c, false);
}
template <int CTRL, int RM> __device__ __forceinline__ float dppf(float v) {
    return __int_as_float(__builtin_amdgcn_update_dpp(0, __float_as_int(v), CTRL, RM, 0xF, false));
}
__device__ __forceinline__ float wsum_dpp(float v) {
    v += dppf<0xB1, 0xF>(v);
    v += dppf<0x4E, 0xF>(v);
    v += dppf<0x141, 0xF>(v);
    v += dppf<0x140, 0xF>(v);
    v += dppf<0x142, 0xA>(v);
    v += dppf<0x143, 0xC>(v);
    return rdlane(v, 63);
}
__device__ __forceinline__ float sum16_dpp(float v) {
    v += dppf<0xB1, 0xF>(v); v += dppf<0x4E, 0xF>(v); v += dppf<0x141, 0xF>(v); v += dppf<0x140, 0xF>(v);
    return v;
}
__device__ __forceinline__ float sigmoidf_(float x) { return 1.0f / (1.0f + expf(-x)); }
__device__ __forceinline__ unsigned ordkey(float f) { const unsigned u = __float_as_uint(f); return (u & 0x80000000u) ? ~u : (u | 0x80000000u); }
__device__ __forceinline__ unsigned fixkey20(float f) { const float c = fminf(fmaxf(f, -15.999f), 15.999f); return (unsigned)((int)rintf(c * 32768.0f) + (1 << 19)); }
__device__ __forceinline__ float unordkey(unsigned k) { return __uint_as_float((k & 0x80000000u) ? (k & 0x7fffffffu) : ~k); }

struct Args { const void* in[27]; float* out; unsigned char* ws; int ph_lo, ph_hi; };
struct Frame { LAS unsigned char* lds; int tid, lane, wave, bx, G, gw, ngw; };

struct EpiLora {
    static constexpr bool PERM = true, AFTER_DRAIN = false;
    pg8::bf16_t* O; int ldc; const float* w0; const float* a0;
    __device__ __forceinline__ void operator()(const pg8::f32x4 (&acc)[2][2][4][2], const pg8::Unit& u, int wr, int wc, int fr, int fq) const {
        const int row0 = u.pm * 256 + wr * 64 + fr; const int colt = u.pn * 256; const int type = u.pn >> 2;
        const int col0 = colt + wc * 32 + 8 * fq, ncol0 = col0 & 1023;
        const float* pv = (type == 0) ? w0 : a0;
        pg8::f32x4 bv[2][2];
#pragma unroll
        for (int bj = 0; bj < 2; ++bj)
#pragma unroll
            for (int n = 0; n < 2; ++n) bv[bj][n] = (type < 2) ? *(const pg8::f32x4*)(pv + ncol0 + bj * 128 + 4 * n) : (pg8::f32x4){0.f, 0.f, 0.f, 0.f};
#pragma unroll
        for (int ai = 0; ai < 2; ++ai)
#pragma unroll
            for (int m = 0; m < 4; ++m) { pg8::bf16_t* rowp = O + (size_t)(row0 + ai * 128 + m * 16) * ldc + col0;
#pragma unroll
                for (int bj = 0; bj < 2; ++bj) { pg8::f32x4 v0 = acc[ai][bj][m][0] + bv[bj][0], v1 = acc[ai][bj][m][1] + bv[bj][1];
                    if (type < 2) {
                        const float sc = (type == 0) ? 0.60653066f : 1.0f;
#pragma unroll
                        for (int j = 0; j < 4; ++j) { v0[j] = sc / (1.0f + __expf(-v0[j])); v1[j] = sc / (1.0f + __expf(-v1[j])); }
                    }
                    pg8::u32x4 w; w.x = pg8::cvt_pk_bf16(v0[0], v0[1]); w.y = pg8::cvt_pk_bf16(v0[2], v0[3]); w.z = pg8::cvt_pk_bf16(v1[0], v1[1]); w.w = pg8::cvt_pk_bf16(v1[2], v1[3]);
                    *(pg8::u32x4*)(rowp + bj * 128) = w; } }
    }
};

__device__ __forceinline__ void transpose_item(const float* W, int K, int N, int Npad, bf16* WT, LAS float* scr, int item, int lane) {
    const int nblk = Npad / 32, kb = item / nblk, nb = item % nblk, k0 = 64 * kb, n0 = 32 * nb;
    const int nl = lane & 31; const bool ok = (n0 + nl) < N;
#pragma unroll 8
    for (int i = 0; i < 32; ++i) { const int kk = 2 * i + (lane >> 5); scr[kk * 33 + nl] = ok ? W[(size_t)(k0 + kk) * N + n0 + nl] : 0.f; }
    asm volatile("s_waitcnt lgkmcnt(0)" ::: "memory");
    const int c = lane & 7;
#pragma unroll
    for (int j = 0; j < 4; ++j) { const int n = (lane >> 3) + 8 * j; const LAS float* s = scr + (8 * c) * 33 + n;
        u32x4 o; o.x = pk2(s[0 * 33], s[1 * 33]); o.y = pk2(s[2 * 33], s[3 * 33]); o.z = pk2(s[4 * 33], s[5 * 33]); o.w = pk2(s[6 * 33], s[7 * 33]);
        *(u32x4*)(WT + (size_t)(n0 + n) * K + k0 + 8 * c) = o; }
    asm volatile("s_waitcnt lgkmcnt(0)" ::: "memory");
}

__device__ __forceinline__ void ph_prologue(const Args& A, Frame& F) {
    unsigned char* ws = A.ws;
    {
        const float* c = (const float*)A.in[1]; const float* mw = (const float*)A.in[19]; const float* mb = (const float*)A.in[20];
        float* MOD = (float*)(ws + WS_MOD);
        LAS float* red = (LAS float*)F.lds;
        for (int it = F.bx; it < 96; it += F.G) {
            const int s = it / 24, cc = it % 24, col = cc * 256 + F.lane * 4;
            const float* W = mw + (size_t)s * 2048 * 6144 + col;
            f32x4 a0 = {0.f, 0.f, 0.f, 0.f}, a1 = {0.f, 0.f, 0.f, 0.f};
            const int k0 = F.wave * 256;
#pragma unroll 8
            for (int k = k0; k < k0 + 256; ++k) {
                float c0 = c[k], c1 = c[2048 + k];
                c0 = c0 / (1.0f + expf(-c0)); c1 = c1 / (1.0f + expf(-c1));
                const f32x4 w = *(const f32x4*)(W + (size_t)k * 6144);
                a0 += c0 * w; a1 += c1 * w;
            }
            *(LAS f32x4*)(red + ((F.wave * 2 + 0) * 256 + F.lane * 4)) = a0;
            *(LAS f32x4*)(red + ((F.wave * 2 + 1) * 256 + F.lane * 4)) = a1;
            __syncthreads();
            { const int b = F.tid >> 8, cl = F.tid & 255; float sm = 0.f;
#pragma unroll
              for (int w = 0; w < 8; ++w) sm += red[(w * 2 + b) * 256 + cl];
              MOD[(size_t)(s * 2 + b) * 6144 + cc * 256 + cl] = sm + mb[s * 6144 + cc * 256 + cl]; }
            __syncthreads();
        }
    }
    {
        LAS float* scr = (LAS float*)(F.lds + 16384 + F.wave * 8704);
        constexpr int I0 = 32 * (EV_NP / 32), I1 = 32 * 64, I2 = 32 * (OD_NP / 32);
        constexpr int NIT = I0 + I1 + I2 + 3 * I1;
        for (int it = F.gw; it < NIT; it += F.ngw) {
            int r = it;
            if (r < I0) { transpose_item((const float*)A.in[3], 2048, EV_N, EV_NP, (bf16*)(ws + WS_WINE), scr, r, F.lane); continue; } r -= I0;
            if (r < I1) { transpose_item((const float*)A.in[4], 2048, 2048, 2048, (bf16*)(ws + WS_WOUTE), scr, r, F.lane); continue; } r -= I1;
            if (r < I2) { transpose_item((const float*)A.in[17], 2048, OD_N, OD_NP, (bf16*)(ws + WS_WINO), scr, r, F.lane); continue; } r -= I2;
            if (r < I1) { transpose_item((const float*)A.in[18], 2048, 2048, 2048, (bf16*)(ws + WS_WOUTO), scr, r, F.lane); continue; } r -= I1;
            if (r < I1) { transpose_item((const float*)A.in[23], 2048, 2048, 2048, (bf16*)(ws + WS_WQ0), scr, r, F.lane); continue; } r -= I1;
            transpose_item((const float*)A.in[23] + (size_t)2048 * 2048, 2048, 2048, 2048, (bf16*)(ws + WS_WQ1), scr, r, F.lane);
        }
    }
    {
        const float* w2 = (const float*)A.in[8]; const float* a2 = (const float*)A.in[10]; const float* g2 = (const float*)A.in[11];
        bf16* WL = (bf16*)(ws + WS_WL);
        const int gt = F.bx * NTHREADS + F.tid, ngt = F.G * NTHREADS;
        for (int i = gt; i < 3072 * 512; i += ngt) {
            const int n = i >> 9, k = i & 511; float v = 0.f;
            if (n < 1024) { if (k < 96) v = w2[k * 1024 + n]; }
            else if (n < 2048) { if (k >= 96 && k < 192) v = a2[(k - 96) * 1024 + (n - 1024)]; }
            else { if (k >= 192 && k < 448) v = g2[(k - 192) * 1024 + (n - 2048)]; }
            WL[i] = (bf16)f2bf(v);
        }
        const float* sk = (const float*)A.in[24]; bf16* SKB = (bf16*)(ws + WS_SKB);
        for (int i = gt; i < 2 * 262144; i += ngt) SKB[i] = (bf16)f2bf(sk[i]);
    }
}

__device__ __forceinline__ void ph_mod_x(const Args& A, Frame& F) {
    const float* x = (const float*)A.in[0]; const float* MOD = (const float*)(A.ws + WS_MOD); bf16* H = (bf16*)(A.ws + WS_HY);
    for (int t = F.gw; t < TOK; t += F.ngw) {
        const int b = t >> 14; const float* sh = MOD + (size_t)(0 * 2 + b) * 6144; const float* sc = sh + 2048;
#pragma unroll
        for (int j = 0; j < 8; ++j) { const int idx = j * 256 + F.lane * 4;
            const f32x4 xv = *(const f32x4*)(x + (size_t)t * DM + idx), sv = *(const f32x4*)(sc + idx), hv = *(const f32x4*)(sh + idx);
            const f32x4 o = xv * (1.0f + sv) + hv; u32x2 w; w.x = pk2(o[0], o[1]); w.y = pk2(o[2], o[3]);
            *(u32x2*)(H + (size_t)t * DM + idx) = w; }
    }
}

__device__ __forceinline__ void ph_even_post(const Args& A, Frame& F) {
    bf16* Z = (bf16*)(A.ws + WS_Z); const int* positions = (const int*)A.in[2]; const float* mu = (const float*)A.in[6];
    bf16* RKV = (bf16*)A.out; bf16* LAp = (bf16*)(A.ws + WS_LA);
    const int i = F.lane & 31; const float inv = powf(10000.0f, -(float)i / 32.0f);
    const int i4 = F.lane & 7, hs = F.lane >> 3;
    for (int t = F.gw; t < TOK; t += F.ngw) {
        const int s = t & (SEQ - 1); bf16* zr = Z + (size_t)t * EV_NP;
        float sn, cs; sincosf((float)positions[t] * inv, &sn, &cs);
        float c4[4], s4[4];
#pragma unroll
        for (int e = 0; e < 4; ++e) { c4[e] = __shfl(cs, 4 * i4 + e); s4[e] = __shfl(sn, 4 * i4 + e); }
#pragma unroll
        for (int it = 0; it < 3; ++it) { const int hd = it * 8 + hs; if (hd < 18) { bf16* hp = zr + hd * 64 + 4 * i4;
            const u32x2 a = *(const u32x2*)hp, b = *(const u32x2*)(hp + 32);
            const float t1[4] = {lo2f(a.x), hi2f(a.x), lo2f(a.y), hi2f(a.y)}, t2[4] = {lo2f(b.x), hi2f(b.x), lo2f(b.y), hi2f(b.y)};
            float o1[4], o2[4];
#pragma unroll
            for (int e = 0; e < 4; ++e) { o1[e] = t1[e] * c4[e] - t2[e] * s4[e]; o2[e] = t2[e] * c4[e] + t1[e] * s4[e]; }
            *(u32x2*)hp = (u32x2){pk2(o1[0], o1[1]), pk2(o1[2], o1[3])}; *(u32x2*)(hp + 32) = (u32x2){pk2(o2[0], o2[1]), pk2(o2[2], o2[3])}; } }
        const bf16* zp = zr - EV_NP; const bool hasprev = s > 0;
#pragma unroll
        for (int m = 0; m < 7; ++m) { const int j = 8 * (F.lane + 64 * m); if (j < 3520) {
            const u32x4 cw = *(const u32x4*)(zr + 1280 + j); u32x4 pw = {0u, 0u, 0u, 0u}; if (hasprev) pw = *(const u32x4*)(zp + 1280 + j);
            const f32x4 m0 = *(const f32x4*)(mu + j), m1 = *(const f32x4*)(mu + j + 4);
            const unsigned cwa[4] = {cw.x, cw.y, cw.z, cw.w}, pwa[4] = {pw.x, pw.y, pw.z, pw.w}; const float mm[8] = {m0[0], m0[1], m0[2], m0[3], m1[0], m1[1], m1[2], m1[3]};
            float v[8];
#pragma unroll
            for (int q = 0; q < 4; ++q) { const float c0 = lo2f(cwa[q]), c1 = hi2f(cwa[q]), p0 = lo2f(pwa[q]), p1 = hi2f(pwa[q]); v[2 * q] = c0 + (p0 - c0) * mm[2 * q]; v[2 * q + 1] = c1 + (p1 - c1) * mm[2 * q + 1]; }
            bf16* dst;
            if (j < 3072) { dst = RKV + (size_t)(j >> 10) * TOK * 1024 + (size_t)t * 1024 + (j & 1023); }
            else if (j < 3168) { dst = LAp + (size_t)t * 512 + (j - 3072);
#pragma unroll
                for (int e = 0; e < 8; ++e) v[e] = tanhf(v[e]); }
            else if (j < 3264) { dst = LAp + (size_t)t * 512 + 96 + (j - 3168); }
            else { dst = LAp + (size_t)t * 512 + 192 + (j - 3264);
#pragma unroll
                for (int e = 0; e < 8; ++e) v[e] = sigmoidf_(v[e]); }
            *(u32x4*)dst = (u32x4){pk2(v[0], v[1]), pk2(v[2], v[3]), pk2(v[4], v[5]), pk2(v[6], v[7])};
        } }
        if (F.lane < 8) *(u32x4*)(LAp + (size_t)t * 512 + 448 + 8 * F.lane) = (u32x4){0u, 0u, 0u, 0u};
    }
}

__device__ __forceinline__ void ph_scan_pack(const Args& A, Frame& F) {
    const bf16* Z = (const bf16*)(A.ws + WS_Z); const bf16* RKV = (const bf16*)A.out;
    const float* k_k = (const float*)A.in[12]; const float* k_a = (const float*)A.in[13]; const float* r_k = (const float*)A.in[14];
    unsigned* PK = (unsigned*)(A.ws + WS_BIG); float* BS = (float*)(A.ws + WS_BS);
    const int g16 = F.lane >> 4, c16 = F.lane & 15;
    for (int it = F.gw; it < TOK * 4; it += F.ngw) {
        const int item = it * 4 + g16; const int t = item >> 4, h = item & 15, c = h * 64 + 4 * c16, b = t >> 14, s = t & (SEQ - 1);
        const u32x2 rw = *(const u32x2*)(RKV + (size_t)t * 1024 + c), kw = *(const u32x2*)(RKV + (size_t)TOK * 1024 + (size_t)t * 1024 + c), vw = *(const u32x2*)(RKV + (size_t)2 * TOK * 1024 + (size_t)t * 1024 + c);
        const u32x2 ew = *(const u32x2*)(Z + (size_t)t * EV_NP + 1280 + c), aw = *(const u32x2*)(Z + (size_t)t * EV_NP + 1280 + 1024 + c);
        const f32x4 kk4 = *(const f32x4*)(k_k + c), ka4 = *(const f32x4*)(k_a + c), rk4 = *(const f32x4*)(r_k + c);
        const float r[4] = {lo2f(rw.x), hi2f(rw.x), lo2f(rw.y), hi2f(rw.y)}, kr[4] = {lo2f(kw.x), hi2f(kw.x), lo2f(kw.y), hi2f(kw.y)}, v[4] = {lo2f(vw.x), hi2f(vw.x), lo2f(vw.y), hi2f(vw.y)};
        const float e[4] = {lo2f(ew.x), hi2f(ew.x), lo2f(ew.y), hi2f(ew.y)}, a[4] = {lo2f(aw.x), hi2f(aw.x), lo2f(aw.y), hi2f(aw.y)};
        float kkv[4], kp[4]; float ss = 0.f, bsum = 0.f;
#pragma unroll
        for (int q = 0; q < 4; ++q) { kkv[q] = kr[q] * kk4[q]; ss += kkv[q] * kkv[q]; kp[q] = kr[q] * (1.0f + (a[q] - 1.0f) * ka4[q]); bsum += r[q] * kp[q] * rk4[q]; }
        ss = sum16_dpp(ss); bsum = sum16_dpp(bsum);
        const float rn = 1.0f / fmaxf(sqrtf(ss), 1e-12f);
        if (c16 == 0) BS[(size_t)t * 16 + h] = bsum;
        unsigned w[12];
#pragma unroll
        for (int q = 0; q < 4; ++q) { const float kkn = kkv[q] * rn; w[3 * q] = pk2(r[q], e[q]); w[3 * q + 1] = pk2(kp[q], kkn); w[3 * q + 2] = pk2(kkn * a[q], v[q]); }
        u32x4* dst = (u32x4*)(PK + ((size_t)((b * 16 + h) * SEQ + s) * 64 + 4 * c16) * 3);
        dst[0] = (u32x4){w[0], w[1], w[2], w[3]}; dst[1] = (u32x4){w[4], w[5], w[6], w[7]}; dst[2] = (u32x4){w[8], w[9], w[10], w[11]};
    }
}

__device__ __forceinline__ void ph_swa(const Args& A, Frame& F) {
    const bf16* Z = (const bf16*)(A.ws + WS_Z); bf16* Y = (bf16*)(A.ws + WS_HY); const float* sinks = (const float*)A.in[5];
    LAS unsigned char* KL = F.lds; LAS unsigned char* VL = F.lds + 256 * 136;
    for (int u = F.bx; u < 512; u += F.G) {
        const int b = u >> 8, n = (u >> 1) & 127, kvh = u & 1;
        __syncthreads();
        for (int c = F.tid; c < 2048; c += NTHREADS) { const int jw = c >> 3, cc = c & 7; const int s = n * 128 - 128 + jw;
            u32x4 kv = {0u, 0u, 0u, 0u}, vv = {0u, 0u, 0u, 0u};
            if (s >= 0) { const bf16* row = Z + (size_t)(b * SEQ + s) * EV_NP; kv = *(const u32x4*)(row + 1024 + kvh * 64 + cc * 8); vv = *(const u32x4*)(row + 1152 + kvh * 64 + cc * 8); }
            *(LAS u32x2*)(KL + jw * 136 + cc * 16) = (u32x2){kv.x, kv.y}; *(LAS u32x2*)(KL + jw * 136 + cc * 16 + 8) = (u32x2){kv.z, kv.w};
            *(LAS u32x2*)(VL + jw * 136 + cc * 16) = (u32x2){vv.x, vv.y}; *(LAS u32x2*)(VL + jw * 136 + cc * 16 + 8) = (u32x2){vv.z, vv.w}; }
        __syncthreads();
        for (int it = F.wave; it < 1024; it += NWAVES) {
            const int i = it >> 3, g = it & 7, head = kvh * 8 + g; const int t = b * SEQ + n * 128 + i;
            const float qv = bf2f(Z[(size_t)t * EV_NP + head * 64 + F.lane]) * 0.125f;
            const int jw0 = i + 1 + F.lane, jw1 = jw0 + 64;
            const bool val0 = (n > 0) || (jw0 >= 128), val1 = (n > 0) || (jw1 >= 128);
            float s0 = 0.f, s1 = 0.f;
#pragma unroll
            for (int d4 = 0; d4 < 16; ++d4) {
                const u32x2 k0 = *(const LAS u32x2*)(KL + jw0 * 136 + d4 * 8), k1 = *(const LAS u32x2*)(KL + jw1 * 136 + d4 * 8);
                const float q0 = rdlane(qv, 4 * d4), q1 = rdlane(qv, 4 * d4 + 1), q2 = rdlane(qv, 4 * d4 + 2), q3 = rdlane(qv, 4 * d4 + 3);
                s0 += q0 * lo2f(k0.x) + q1 * hi2f(k0.x) + q2 * lo2f(k0.y) + q3 * hi2f(k0.y);
                s1 += q0 * lo2f(k1.x) + q1 * hi2f(k1.x) + q2 * lo2f(k1.y) + q3 * hi2f(k1.y);
            }
            const float sink = sinks[head];
            s0 = val0 ? s0 : -INFINITY; s1 = val1 ? s1 : -INFINITY;
            const float mx = fmaxf(wmax(fmaxf(s0, s1)), sink);
            float p0 = val0 ? expf(s0 - mx) : 0.f, p1 = val1 ? expf(s1 - mx) : 0.f;
            const float den = wsum(p0 + p1) + expf(sink - mx); const float rden = 1.0f / den;
            p0 *= rden; p1 *= rden;
            float o = 0.f;
            const LAS bf16* vcol = (const LAS bf16*)VL + F.lane;
#pragma unroll 8
            for (int jj = 0; jj < 64; ++jj) o += rdlane(p0, jj) * bf2f(vcol[(i + 1 + jj) * 68]);
#pragma unroll 8
            for (int jj = 0; jj < 64; ++jj) o += rdlane(p1, jj) * bf2f(vcol[(i + 65 + jj) * 68]);
            Y[(size_t)t * DM + head * 64 + F.lane] = (bf16)f2bf(o);
        }
    }
}

__device__ __forceinline__ bf16x8 as_bf8(u32x4 v) { return __builtin_bit_cast(bf16x8, v); }
__device__ __forceinline__ void ph_swa_mfma(const Args& A, Frame& F) {
    const bf16* Z = (const bf16*)(A.ws + WS_Z); bf16* Y = (bf16*)(A.ws + WS_HY); const float* sinks = (const float*)A.in[5];
    LAS bf16* KL = (LAS bf16*)F.lds;
    LAS bf16* VT = (LAS bf16*)(F.lds + 36864);
    const int l15 = F.lane & 15, g4 = F.lane >> 4;
    for (int u = F.bx; u < 512; u += F.G) {
        const int b = u >> 8, n = (u >> 1) & 127, kvh = u & 1;
        __syncthreads();
        for (int c = F.tid; c < 2048; c += NTHREADS) { const int jw = c >> 3, cc = c & 7; const int sp = n * 128 - 128 + jw;
            u32x4 kv = {0u, 0u, 0u, 0u}, vv = {0u, 0u, 0u, 0u};
            if (sp >= 0) { const bf16* row = Z + (size_t)(b * SEQ + sp) * EV_NP; kv = *(const u32x4*)(row + 1024 + kvh * 64 + cc * 8); vv = *(const u32x4*)(row + 1152 + kvh * 64 + cc * 8); }
            *(LAS u32x4*)(KL + jw * 72 + cc * 8) = kv;
            const unsigned vw[4] = {vv.x, vv.y, vv.z, vv.w};
#pragma unroll
            for (int q = 0; q < 4; ++q) { VT[(8 * cc + 2 * q) * 264 + jw] = (bf16)(vw[q] & 0xffffu); VT[(8 * cc + 2 * q + 1) * 264 + jw] = (bf16)(vw[q] >> 16); } }
        __syncthreads();
        const int head = kvh * 8 + F.wave; const float sink = sinks[head];
#pragma unroll 1
        for (int qt = 0; qt < 8; ++qt) {
            const int iq = 16 * qt + l15; const int t = b * SEQ + n * 128 + iq;
            bf16x8 qf[2];
#pragma unroll
            for (int ks = 0; ks < 2; ++ks) qf[ks] = *(const bf16x8*)(Z + (size_t)t * EV_NP + head * 64 + 32 * ks + 8 * g4);
            float sv[10][4]; float mx = -INFINITY;
#pragma unroll
            for (int kk = 0; kk < 9; ++kk) { const int kt = qt + kk;
                f32x4 acc = {0.f, 0.f, 0.f, 0.f};
#pragma unroll
                for (int ks = 0; ks < 2; ++ks) acc = __builtin_amdgcn_mfma_f32_16x16x32_bf16(*(const LAS bf16x8*)(KL + (16 * kt + l15) * 72 + 32 * ks + 8 * g4), qf[ks], acc, 0, 0, 0);
#pragma unroll
                for (int rg_ = 0; rg_ < 4; ++rg_) { const int jw = 16 * kt + 4 * g4 + rg_; const bool ok = (jw >= iq + 1) && (jw <= iq + 128) && ((n > 0) || (jw >= 128));
                    sv[kk][rg_] = ok ? acc[rg_] * 0.125f : -INFINITY; mx = fmaxf(mx, sv[kk][rg_]); } }
#pragma unroll
            for (int rg_ = 0; rg_ < 4; ++rg_) sv[9][rg_] = -INFINITY;
            mx = xmax16(mx); mx = xmax32(mx); mx = fmaxf(mx, sink);
            float sm = 0.f;
#pragma unroll
            for (int kk = 0; kk < 10; ++kk)
#pragma unroll
                for (int rg_ = 0; rg_ < 4; ++rg_) { const float pv = (sv[kk][rg_] == -INFINITY) ? 0.f : __expf(sv[kk][rg_] - mx); sv[kk][rg_] = pv; sm += pv; }
            sm = xsum16(sm); sm = xsum32(sm);
            const float rden = 1.0f / (sm + __expf(sink - mx));
            f32x4 oacc[4];
#pragma unroll
            for (int dt = 0; dt < 4; ++dt) oacc[dt] = (f32x4){0.f, 0.f, 0.f, 0.f};
#pragma unroll
            for (int pp = 0; pp < 5; ++pp) { const int ka = qt + 2 * pp, kb = (qt + 2 * pp + 1 < 16) ? (qt + 2 * pp + 1) : 15;
                const bf16x8 pb = as_bf8((u32x4){pk2(sv[2 * pp][0] * rden, sv[2 * pp][1] * rden), pk2(sv[2 * pp][2] * rden, sv[2 * pp][3] * rden),
                                                  pk2(sv[2 * pp + 1][0] * rden, sv[2 * pp + 1][1] * rden), pk2(sv[2 * pp + 1][2] * rden, sv[2 * pp + 1][3] * rden)});
#pragma unroll
                for (int dt = 0; dt < 4; ++dt) { const LAS bf16* vr = VT + (16 * dt + l15) * 264 + 4 * g4;
                    const u32x2 va = *(const LAS u32x2*)(vr + 16 * ka), vb2 = *(const LAS u32x2*)(vr + 16 * kb);
                    oacc[dt] = __builtin_amdgcn_mfma_f32_16x16x32_bf16(as_bf8((u32x4){va.x, va.y, vb2.x, vb2.y}), pb, oacc[dt], 0, 0, 0); } }
#pragma unroll
            for (int dt = 0; dt < 4; ++dt) *(u32x2*)(Y + (size_t)t * DM + head * 64 + 16 * dt + 4 * g4) = (u32x2){pk2(oacc[dt][0], oacc[dt][1]), pk2(oacc[dt][2], oacc[dt][3])};
        }
    }
}

constexpr int FR_BYTES = 15360;
__device__ __forceinline__ int fr_rho(int ks, int g, int j) { return 16 * (2 * ks + (j >> 2)) + 4 * g + (j & 3); }
__device__ __forceinline__ void ph_scan_prep(const Args& A, Frame& F) {
    const bf16* Z = (const bf16*)(A.ws + WS_Z); const bf16* RKV = (const bf16*)A.out;
    const float* k_k = (const float*)A.in[12]; const float* k_a = (const float*)A.in[13]; const float* r_k = (const float*)A.in[14];
    unsigned char* FR = A.ws + WS_BIG; float* BS = (float*)(A.ws + WS_BS);
    LAS float* EE = (LAS float*)F.lds;
    LAS float* VV = (LAS float*)(F.lds + 4096);
    LAS float* KHf = (LAS float*)(F.lds + 8192);
    LAS float* RHf = (LAS float*)(F.lds + 12352);
    LAS float* BPf = (LAS float*)(F.lds + 16512);
    LAS bf16* AHb = (LAS bf16*)(F.lds + 20672);
    LAS bf16* BHb = (LAS bf16*)(F.lds + 22976);
    LAS bf16* KHb = (LAS bf16*)(F.lds + 25280);
    LAS bf16* RHb = (LAS bf16*)(F.lds + 27584);
    LAS bf16* APT = (LAS bf16*)(F.lds + 29888);
    LAS float* GA = (LAS float*)(F.lds + 32960);
    LAS float* GB = GA + 16 * 17; LAS float* GMA = GB + 16 * 17; LAS float* GMB = GMA + 16 * 17;
    LAS float* TT = (LAS float*)(F.lds + 37312);
    LAS bf16* P1b = (LAS bf16*)(F.lds + 38400);
    LAS bf16* P2b = (LAS bf16*)(F.lds + 41472);
    LAS bf16* MAT = (LAS bf16*)(F.lds + 42240);
    LAS float* WW = (LAS float*)(F.lds + 43008);
    const int tt = F.tid >> 5, kq = F.tid & 31;
    const int l15 = F.lane & 15, g = F.lane >> 4;
    const bf16x8 zero8 = {0, 0, 0, 0, 0, 0, 0, 0};
    unsigned p_rw = 0u, p_kw = 0u, p_vw = 0u, p_ew = 0u, p_aw = 0u; f32x2 p_kk = {0.f, 0.f}, p_ka = {0.f, 0.f}, p_rk = {0.f, 0.f};
#define PREP_LOAD(it_) do { const int bh_ = (it_) >> 10, ch_ = (it_) & 1023, b_ = bh_ >> 4, h_ = bh_ & 15; const int tok_ = b_ * SEQ + ch_ * 16 + tt, c_ = h_ * 64 + 2 * kq; \
        p_rw = *(const unsigned*)(RKV + (size_t)tok_ * 1024 + c_); p_kw = *(const unsigned*)(RKV + (size_t)TOK * 1024 + (size_t)tok_ * 1024 + c_); p_vw = *(const unsigned*)(RKV + (size_t)2 * TOK * 1024 + (size_t)tok_ * 1024 + c_); \
        p_ew = *(const unsigned*)(Z + (size_t)tok_ * EV_NP + 1280 + c_); p_aw = *(const unsigned*)(Z + (size_t)tok_ * EV_NP + 1280 + 1024 + c_); \
        p_kk = *(const f32x2*)(k_k + c_); p_ka = *(const f32x2*)(k_a + c_); p_rk = *(const f32x2*)(r_k + c_); } while (0)
    if (F.bx < 32 * 1024) PREP_LOAD(F.bx);
    for (int it = F.bx; it < 32 * 1024; it += F.G) {
        const int bh = it >> 10, ch = it & 1023, b = bh >> 4, h = bh & 15;
        const int tok = b * SEQ + ch * 16 + tt;
        __syncthreads();
        float e2[2], kkn[2], kka[2], kp[2], r2[2];
        {
            const unsigned rw = p_rw, kw = p_kw, vw = p_vw, ew = p_ew, aw = p_aw; const f32x2 kk2 = p_kk, ka2 = p_ka, rk2 = p_rk;
            const float kr[2] = {lo2f(kw), hi2f(kw)}, av[2] = {lo2f(aw), hi2f(aw)};
            r2[0] = lo2f(rw); r2[1] = hi2f(rw); e2[0] = lo2f(ew); e2[1] = hi2f(ew);
            float kkv[2], ss = 0.f, bsum = 0.f;
#pragma unroll
            for (int q = 0; q < 2; ++q) { kkv[q] = kr[q] * kk2[q]; ss += kkv[q] * kkv[q]; kp[q] = kr[q] * (1.0f + (av[q] - 1.0f) * ka2[q]); bsum += r2[q] * kp[q] * rk2[q]; }
            ss = xsum16(sum16_dpp(ss)); bsum = xsum16(sum16_dpp(bsum));
            const float rn = 1.0f / fmaxf(sqrtf(ss), 1e-12f);
#pragma unroll
            for (int q = 0; q < 2; ++q) { kkn[q] = kkv[q] * rn; kka[q] = kkn[q] * av[q]; }
            if (kq == 0) BS[(size_t)tok * 16 + h] = bsum;
            { const int itn = it + F.G; if (itn < 32 * 1024) PREP_LOAD(itn); }
            *(LAS f32x2*)(EE + tt * 64 + 2 * kq) = (f32x2){e2[0], e2[1]};
            *(LAS f32x2*)(VV + tt * 64 + 2 * kq) = (f32x2){lo2f(vw), hi2f(vw)};
        }
        __syncthreads();
        {
            float L[2] = {0.f, 0.f}, L15[2] = {0.f, 0.f};
#pragma unroll
            for (int i = 0; i < 16; ++i) { const f32x2 ev = *(const LAS f32x2*)(EE + i * 64 + 2 * kq); L15[0] += ev.x; L15[1] += ev.y; if (i <= tt) { L[0] += ev.x; L[1] += ev.y; } }
            float kh[2], ah[2], bhv[2], rh[2], ap[2], bp[2];
#pragma unroll
            for (int q = 0; q < 2; ++q) { const float wt = __expf(-L[q]), iwt = __expf(L[q]), wprev = __expf(-(L[q] - e2[q])), wrest = __expf(-(L15[q] - L[q]));
                kh[q] = kkn[q] * wprev; ah[q] = kka[q] * iwt; bhv[q] = kp[q] * iwt; rh[q] = r2[q] * wt; ap[q] = kka[q] * wrest; bp[q] = kp[q] * wrest;
                if (tt == 15) WW[2 * kq + q] = wt; }
            KHf[tt * 65 + 2 * kq] = kh[0]; KHf[tt * 65 + 2 * kq + 1] = kh[1]; RHf[tt * 65 + 2 * kq] = rh[0]; RHf[tt * 65 + 2 * kq + 1] = rh[1]; BPf[tt * 65 + 2 * kq] = bp[0]; BPf[tt * 65 + 2 * kq + 1] = bp[1];
            *(LAS unsigned*)(KHb + tt * 72 + 2 * kq) = pk2(kh[0], kh[1]); *(LAS unsigned*)(AHb + tt * 72 + 2 * kq) = pk2(ah[0], ah[1]);
            *(LAS unsigned*)(BHb + tt * 72 + 2 * kq) = pk2(bhv[0], bhv[1]); *(LAS unsigned*)(RHb + tt * 72 + 2 * kq) = pk2(rh[0], rh[1]);
            APT[(2 * kq) * 24 + tt] = (bf16)f2bf(ap[0]); APT[(2 * kq + 1) * 24 + tt] = (bf16)f2bf(ap[1]);
        }
        __syncthreads();
        if (F.wave < 4) {
            const int mat = F.wave; const LAS bf16* X = (mat & 1) ? BHb : AHb; const LAS bf16* Y = (mat & 2) ? RHb : KHb;
            f32x4 acc = {0.f, 0.f, 0.f, 0.f};
#pragma unroll
            for (int ks = 0; ks < 2; ++ks) acc = __builtin_amdgcn_mfma_f32_16x16x32_bf16(*(const LAS bf16x8*)(X + l15 * 72 + 32 * ks + 8 * g), *(const LAS bf16x8*)(Y + l15 * 72 + 32 * ks + 8 * g), acc, 0, 0, 0);
            LAS float* dst = (mat == 0) ? GA : ((mat == 1) ? GB : ((mat == 2) ? GMA : GMB));
#pragma unroll
            for (int rg_ = 0; rg_ < 4; ++rg_) { const int i = 4 * g + rg_; const bool nz = (mat & 2) ? (i <= l15) : (i < l15); const float v = nz ? acc[rg_] : 0.f;
                dst[i * 17 + l15] = v; if (mat == 2) MAT[l15 * 24 + i] = (bf16)f2bf(v); }
        }
        __syncthreads();
        if (F.tid < 16) {
            float x[16];
#pragma unroll
            for (int i = 15; i >= 0; --i) { float v = (i == F.tid) ? 1.0f : 0.f;
#pragma unroll
                for (int m = i + 1; m < 16; ++m) v -= GA[i * 17 + m] * x[m];
                x[i] = v; }
#pragma unroll
            for (int i = 0; i < 16; ++i) TT[i * 17 + F.tid] = x[i];
        }
        __syncthreads();
        {
            float x0 = 0.f, x1 = 0.f;
#pragma unroll
            for (int m = 0; m < 16; ++m) { const float tv = TT[m * 17 + tt]; x0 -= KHf[m * 65 + 2 * kq] * tv; x1 -= KHf[m * 65 + 2 * kq + 1] * tv; }
            P1b[(2 * kq) * 24 + tt] = (bf16)f2bf(x0); P1b[(2 * kq + 1) * 24 + tt] = (bf16)f2bf(x1);
            if (F.tid < 256) { const int i = F.tid >> 4, t = F.tid & 15; float x = 0.f;
#pragma unroll
                for (int m = 0; m < 16; ++m) x -= GB[i * 17 + m] * TT[m * 17 + t];
                P2b[i * 24 + t] = (bf16)f2bf(x); }
        }
        __syncthreads();
        {
            unsigned char* fr = FR + (size_t)it * FR_BYTES;
            const int mt = F.wave >> 1, ks = F.wave & 1;
            const bf16x8 aP0 = (g < 2) ? *(const LAS bf16x8*)(P1b + (16 * (2 * ks) + l15) * 24 + 8 * g) : zero8;
            const bf16x8 aP1 = (g < 2) ? *(const LAS bf16x8*)(P1b + (16 * (2 * ks + 1) + l15) * 24 + 8 * g) : zero8;
            const bf16x8 bAP = (g < 2) ? *(const LAS bf16x8*)(APT + (16 * mt + l15) * 24 + 8 * g) : zero8;
            const f32x4 z4 = {0.f, 0.f, 0.f, 0.f};
            const f32x4 d0 = __builtin_amdgcn_mfma_f32_16x16x32_bf16(aP0, bAP, z4, 0, 0, 0), d1 = __builtin_amdgcn_mfma_f32_16x16x32_bf16(aP1, bAP, z4, 0, 0, 0);
            *(u32x4*)(fr + (size_t)(F.wave * 64 + F.lane) * 16) = (u32x4){pk2(d0[0], d0[1]), pk2(d0[2], d0[3]), pk2(d1[0], d1[1]), pk2(d1[2], d1[3])};
            if (F.wave < 4) {
                const bf16x8 aP2 = (g < 2) ? *(const LAS bf16x8*)(P2b + l15 * 24 + 8 * g) : zero8;
                const bf16x8 bA = (g < 2) ? *(const LAS bf16x8*)(APT + (16 * F.wave + l15) * 24 + 8 * g) : zero8;
                f32x4 d = __builtin_amdgcn_mfma_f32_16x16x32_bf16(aP2, bA, z4, 0, 0, 0);
#pragma unroll
                for (int rg_ = 0; rg_ < 4; ++rg_) d[rg_] += BPf[(4 * g + rg_) * 65 + 16 * F.wave + l15];
                *(u32x2*)(fr + 8192 + (size_t)(F.wave * 64 + F.lane) * 8) = (u32x2){pk2(d[0], d[1]), pk2(d[2], d[3])};
            } else if (F.wave < 6) {
                const int ks2 = F.wave - 4;
                const bf16x8 a0 = (g < 2) ? *(const LAS bf16x8*)(P1b + (16 * (2 * ks2) + l15) * 24 + 8 * g) : zero8;
                const bf16x8 a1 = (g < 2) ? *(const LAS bf16x8*)(P1b + (16 * (2 * ks2 + 1) + l15) * 24 + 8 * g) : zero8;
                const bf16x8 bM = (g < 2) ? *(const LAS bf16x8*)(MAT + l15 * 24 + 8 * g) : zero8;
                f32x4 q0 = __builtin_amdgcn_mfma_f32_16x16x32_bf16(a0, bM, z4, 0, 0, 0), q1 = __builtin_amdgcn_mfma_f32_16x16x32_bf16(a1, bM, z4, 0, 0, 0);
#pragma unroll
                for (int rg_ = 0; rg_ < 4; ++rg_) { q0[rg_] += RHf[l15 * 65 + 16 * (2 * ks2) + 4 * g + rg_]; q1[rg_] += RHf[l15 * 65 + 16 * (2 * ks2 + 1) + 4 * g + rg_]; }
                *(u32x4*)(fr + 10240 + (size_t)(ks2 * 64 + F.lane) * 16) = (u32x4){pk2(q0[0], q0[1]), pk2(q0[2], q0[3]), pk2(q1[0], q1[1]), pk2(q1[2], q1[3])};
            } else if (F.wave == 6) {
                const bf16x8 aP2 = (g < 2) ? *(const LAS bf16x8*)(P2b + l15 * 24 + 8 * g) : zero8;
                const bf16x8 bM = (g < 2) ? *(const LAS bf16x8*)(MAT + l15 * 24 + 8 * g) : zero8;
                f32x4 d = __builtin_amdgcn_mfma_f32_16x16x32_bf16(aP2, bM, z4, 0, 0, 0);
#pragma unroll
                for (int rg_ = 0; rg_ < 4; ++rg_) d[rg_] += GMB[(4 * g + rg_) * 17 + l15];
                *(u32x2*)(fr + 12288 + (size_t)F.lane * 8) = (u32x2){pk2(d[0], d[1]), pk2(d[2], d[3])};
            } else {
                *(float*)(fr + 14848 + F.lane * 4) = WW[F.lane];
            }
            if (F.tid < 256) {
                const int rg = F.tid >> 6, row = 16 * rg + l15, s4 = 4 * g;
                *(u32x2*)(fr + 12800 + (size_t)(rg * 64 + F.lane) * 8) = (u32x2){pk2(VV[s4 * 64 + row], VV[(s4 + 1) * 64 + row]), pk2(VV[(s4 + 2) * 64 + row], VV[(s4 + 3) * 64 + row])};
            }
        }
    }
}
struct ScanFrag { u32x4 g[4][2]; u32x2 f[4]; u32x4 q1[2]; u32x2 q2; u32x2 vt; f32x4 w[4]; };
__device__ __forceinline__ void scan_frag_load(ScanFrag& fr, const unsigned char* base, int rg, int lane) {
#pragma unroll
    for (int mt = 0; mt < 4; ++mt) {
#pragma unroll
        for (int ks = 0; ks < 2; ++ks) fr.g[mt][ks] = *(const u32x4*)(base + (size_t)((mt * 2 + ks) * 64 + lane) * 16);
        fr.f[mt] = *(const u32x2*)(base + 8192 + (size_t)(mt * 64 + lane) * 8);
        fr.w[mt] = *(const f32x4*)(base + 14848 + (16 * mt + 4 * (lane >> 4)) * 4); }
#pragma unroll
    for (int ks = 0; ks < 2; ++ks) fr.q1[ks] = *(const u32x4*)(base + 10240 + (size_t)(ks * 64 + lane) * 16);
    fr.q2 = *(const u32x2*)(base + 12288 + (size_t)lane * 8);
    fr.vt = *(const u32x2*)(base + 12800 + (size_t)(rg * 64 + lane) * 8);
}
__device__ __forceinline__ void scan_chunk(f32x4 (&acc)[4], const ScanFrag& fr, bf16* yout) {
    const bf16x8 sb0 = as_bf8((u32x4){pk2(acc[0][0], acc[0][1]), pk2(acc[0][2], acc[0][3]), pk2(acc[1][0], acc[1][1]), pk2(acc[1][2], acc[1][3])});
    const bf16x8 sb1 = as_bf8((u32x4){pk2(acc[2][0], acc[2][1]), pk2(acc[2][2], acc[2][3]), pk2(acc[3][0], acc[3][1]), pk2(acc[3][2], acc[3][3])});
    const bf16x8 vb = as_bf8((u32x4){fr.vt.x, fr.vt.y, 0u, 0u});
#pragma unroll
    for (int c = 0; c < 4; ++c) { f32x4 n = acc[c] * fr.w[c];
        n = __builtin_amdgcn_mfma_f32_16x16x32_bf16(as_bf8(fr.g[c][0]), sb0, n, 0, 0, 0);
        n = __builtin_amdgcn_mfma_f32_16x16x32_bf16(as_bf8(fr.g[c][1]), sb1, n, 0, 0, 0);
        n = __builtin_amdgcn_mfma_f32_16x16x32_bf16(as_bf8((u32x4){fr.f[c].x, fr.f[c].y, 0u, 0u}), vb, n, 0, 0, 0);
        acc[c] = n; }
    f32x4 y = {0.f, 0.f, 0.f, 0.f};
    y = __builtin_amdgcn_mfma_f32_16x16x32_bf16(as_bf8(fr.q1[0]), sb0, y, 0, 0, 0);
    y = __builtin_amdgcn_mfma_f32_16x16x32_bf16(as_bf8(fr.q1[1]), sb1, y, 0, 0, 0);
    y = __builtin_amdgcn_mfma_f32_16x16x32_bf16(as_bf8((u32x4){fr.q2.x, fr.q2.y, 0u, 0u}), vb, y, 0, 0, 0);
    *(u32x2*)yout = (u32x2){pk2(y[0], y[1]), pk2(y[2], y[3])};
}
#define SCAN_ASM_LD4(dst, ptr, off) asm volatile("global_load_dwordx4 %0, %1, off offset:" #off : "=v"(dst) : "v"(ptr))
#define SCAN_ASM_LD2(dst, ptr, off) asm volatile("global_load_dwordx2 %0, %1, off offset:" #off : "=v"(dst) : "v"(ptr))
__device__ __forceinline__ void scan_frag_issue(ScanFrag& fr, const unsigned char* item, int rg, int lane) {
    const unsigned char* pg0 = item + lane * 16; const unsigned char* pg1 = pg0 + 4096;
    const unsigned char* pf = item + 8192 + lane * 8; const unsigned char* pq1 = item + 10240 + lane * 16;
    const unsigned char* pq2 = item + 12288 + lane * 8; const unsigned char* pvt = item + 12800 + (rg * 64 + lane) * 8; const unsigned char* pw = item + 14848 + (lane >> 4) * 16;
    SCAN_ASM_LD4(fr.g[0][0], pg0, 0); SCAN_ASM_LD4(fr.g[0][1], pg0, 1024); SCAN_ASM_LD4(fr.g[1][0], pg0, 2048); SCAN_ASM_LD4(fr.g[1][1], pg0, 3072);
    SCAN_ASM_LD4(fr.g[2][0], pg1, 0); SCAN_ASM_LD4(fr.g[2][1], pg1, 1024); SCAN_ASM_LD4(fr.g[3][0], pg1, 2048); SCAN_ASM_LD4(fr.g[3][1], pg1, 3072);
    SCAN_ASM_LD2(fr.f[0], pf, 0); SCAN_ASM_LD2(fr.f[1], pf, 512); SCAN_ASM_LD2(fr.f[2], pf, 1024); SCAN_ASM_LD2(fr.f[3], pf, 1536);
    SCAN_ASM_LD4(fr.q1[0], pq1, 0); SCAN_ASM_LD4(fr.q1[1], pq1, 1024);
    SCAN_ASM_LD2(fr.q2, pq2, 0); SCAN_ASM_LD2(fr.vt, pvt, 0);
    SCAN_ASM_LD4(fr.w[0], pw, 0); SCAN_ASM_LD4(fr.w[1], pw, 64); SCAN_ASM_LD4(fr.w[2], pw, 128); SCAN_ASM_LD4(fr.w[3], pw, 192);
}
#define SCAN_WAIT(fr, N) asm volatile("s_waitcnt vmcnt(" #N ")" : "+v"(fr.g[0][0]), "+v"(fr.g[0][1]), "+v"(fr.g[1][0]), "+v"(fr.g[1][1]), "+v"(fr.g[2][0]), "+v"(fr.g[2][1]), "+v"(fr.g[3][0]), "+v"(fr.g[3][1]), \
        "+v"(fr.f[0]), "+v"(fr.f[1]), "+v"(fr.f[2]), "+v"(fr.f[3]), "+v"(fr.q1[0]), "+v"(fr.q1[1]), "+v"(fr.q2), "+v"(fr.vt), "+v"(fr.w[0]), "+v"(fr.w[1]), "+v"(fr.w[2]), "+v"(fr.w[3]) :: "memory")
__device__ __forceinline__ void scan_mfma_rows(const Args& A, Frame& F) {
    const unsigned char* FR = A.ws + WS_BIG; bf16* YRAW = (bf16*)A.out + (size_t)3 * TOK * 1024;
    if (F.wave != 0) return;
    for (int u = F.bx; u < 128; u += F.G) {
        const int bh = u & 31, rg = u >> 5; const unsigned char* base = FR + (size_t)bh * 1024 * FR_BYTES;
        bf16* yrow = YRAW + ((size_t)bh * 64 + 16 * rg + (F.lane & 15)) * SEQ + 4 * (F.lane >> 4);
        f32x4 acc[4];
#pragma unroll
        for (int c = 0; c < 4; ++c) acc[c] = (f32x4){0.f, 0.f, 0.f, 0.f};
        ScanFrag fa, fb;
        scan_frag_issue(fa, base, rg, F.lane);
#pragma unroll 1
        for (int ch = 0; ch < 1024; ch += 2) {
            scan_frag_issue(fb, base + (size_t)(ch + 1) * FR_BYTES, rg, F.lane);
            SCAN_WAIT(fa, 20);
            scan_chunk(acc, fa, yrow + ch * 16);
            scan_frag_issue(fa, base + (size_t)((ch + 2 < 1024) ? (ch + 2) : ch) * FR_BYTES, rg, F.lane);
            SCAN_WAIT(fb, 20);
            scan_chunk(acc, fb, yrow + (ch + 1) * 16);
        }
        asm volatile("s_waitcnt vmcnt(0)" ::: "memory");
    }
}

__device__ __forceinline__ void pair_sync(volatile LAS unsigned* cnt, unsigned target) {
    asm volatile("s_waitcnt vmcnt(0) lgkmcnt(0)" ::: "memory");
    if ((threadIdx.x & 63) == 0) (void)__hip_atomic_fetch_add((LAS unsigned*)cnt, 1u, __ATOMIC_RELAXED, __HIP_MEMORY_SCOPE_WORKGROUP);
    while (__hip_atomic_load((LAS unsigned*)cnt, __ATOMIC_RELAXED, __HIP_MEMORY_SCOPE_WORKGROUP) < target) __builtin_amdgcn_s_sleep(1);
    asm volatile("" ::: "memory");
}
__device__ __forceinline__ void swa_pairs(const Args& A, Frame& F, volatile LAS unsigned* MISC) {
    const bf16* Z = (const bf16*)(A.ws + WS_Z); bf16* Y = (bf16*)(A.ws + WS_HY); const float* sinks = (const float*)A.in[5];
    const int pr = (F.wave - 4) >> 1, mem = F.wave & 1;
    LAS unsigned char* KL = F.lds + pr * 69632; LAS unsigned char* VL = KL + 256 * 136;
    volatile LAS unsigned* cnt = MISC + 24 + pr; unsigned gen = 0u;
    for (int u = F.bx * 2 + pr; u < 512; u += F.G * 2) {
        const int b = u >> 8, n = (u >> 1) & 127, kvh = u & 1;
        gen += 2u; pair_sync(cnt, gen);
#pragma unroll 1
        for (int c0 = mem * 1024 + F.lane; c0 < mem * 1024 + 1024; c0 += 64 * 8) {
            u32x4 kv[8], vv[8];
#pragma unroll
            for (int q = 0; q < 8; ++q) { const int c = c0 + 64 * q; const int jw = c >> 3, cc = c & 7; const int sp = n * 128 - 128 + jw;
                kv[q] = (u32x4){0u, 0u, 0u, 0u}; vv[q] = kv[q];
                if (sp >= 0) { const bf16* row = Z + (size_t)(b * SEQ + sp) * EV_NP; kv[q] = *(const u32x4*)(row + 1024 + kvh * 64 + cc * 8); vv[q] = *(const u32x4*)(row + 1152 + kvh * 64 + cc * 8); } }
#pragma unroll
            for (int q = 0; q < 8; ++q) { const int c = c0 + 64 * q; const int jw = c >> 3, cc = c & 7;
                *(LAS u32x2*)(KL + jw * 136 + cc * 16) = (u32x2){kv[q].x, kv[q].y}; *(LAS u32x2*)(KL + jw * 136 + cc * 16 + 8) = (u32x2){kv[q].z, kv[q].w};
                *(LAS u32x2*)(VL + jw * 136 + cc * 16) = (u32x2){vv[q].x, vv[q].y}; *(LAS u32x2*)(VL + jw * 136 + cc * 16 + 8) = (u32x2){vv[q].z, vv[q].w}; }
        }
        gen += 2u; pair_sync(cnt, gen);
        for (int it = mem; it < 1024; it += 2) {
            const int i = it >> 3, g = it & 7, head = kvh * 8 + g; const int t = b * SEQ + n * 128 + i;
            const float qv = bf2f(Z[(size_t)t * EV_NP + head * 64 + F.lane]) * 0.125f;
            const int jw0 = i + 1 + F.lane, jw1 = jw0 + 64;
            const bool val0 = (n > 0) || (jw0 >= 128), val1 = (n > 0) || (jw1 >= 128);
            float s0 = 0.f, s1 = 0.f;
#pragma unroll
            for (int d4 = 0; d4 < 16; ++d4) {
                const u32x2 k0 = *(const LAS u32x2*)(KL + jw0 * 136 + d4 * 8), k1 = *(const LAS u32x2*)(KL + jw1 * 136 + d4 * 8);
                const float q0 = rdlane(qv, 4 * d4), q1 = rdlane(qv, 4 * d4 + 1), q2 = rdlane(qv, 4 * d4 + 2), q3 = rdlane(qv, 4 * d4 + 3);
                s0 += q0 * lo2f(k0.x) + q1 * hi2f(k0.x) + q2 * lo2f(k0.y) + q3 * hi2f(k0.y);
                s1 += q0 * lo2f(k1.x) + q1 * hi2f(k1.x) + q2 * lo2f(k1.y) + q3 * hi2f(k1.y);
            }
            const float sink = sinks[head];
            s0 = val0 ? s0 : -INFINITY; s1 = val1 ? s1 : -INFINITY;
            const float mx = fmaxf(wmax(fmaxf(s0, s1)), sink);
            float p0 = val0 ? expf(s0 - mx) : 0.f, p1 = val1 ? expf(s1 - mx) : 0.f;
            const float den = wsum(p0 + p1) + expf(sink - mx); const float rden = 1.0f / den;
            p0 *= rden; p1 *= rden;
            float o = 0.f;
            const LAS bf16* vcol = (const LAS bf16*)VL + F.lane;
#pragma unroll 8
            for (int jj = 0; jj < 64; ++jj) o += rdlane(p0, jj) * bf2f(vcol[(i + 1 + jj) * 68]);
#pragma unroll 8
            for (int jj = 0; jj < 64; ++jj) o += rdlane(p1, jj) * bf2f(vcol[(i + 65 + jj) * 68]);
            Y[(size_t)t * DM + head * 64 + F.lane] = (bf16)f2bf(o);
        }
    }
}

__device__ __forceinline__ void wsum2_dpp(float a, float b, float& ra, float& rb) {
    const auto r = __builtin_amdgcn_permlane32_swap(__float_as_uint(a), __float_as_uint(b), false, false);
    float v = __uint_as_float(r[0]) + __uint_as_float(r[1]);
    v += dppf<0xB1, 0xF>(v); v += dppf<0x4E, 0xF>(v); v += dppf<0x141, 0xF>(v); v += dppf<0x140, 0xF>(v);
    v += dppf<0x142, 0xA>(v);
    ra = rdlane(v, 31); rb = rdlane(v, 63);
}
__device__ __forceinline__ void ph_scan(const Args& A, Frame& F, volatile LAS unsigned* MISC) {
    const unsigned* PK = (const unsigned*)(A.ws + WS_BIG); bf16* YRAW = (bf16*)A.out + (size_t)3 * TOK * 1024;
    if (F.wave >= 4) { swa_pairs(A, F, MISC); return; }
    __builtin_amdgcn_s_setprio(3);
    for (int pp = F.bx * 4 + F.wave; pp < 1024; pp += F.G * 4) {
        const int rr = 2 * pp, bh = rr >> 6, vrow = rr & 63;
        const unsigned* pk = PK + ((size_t)bh * SEQ * 64 + F.lane) * 3;
        bf16* youtA = YRAW + ((size_t)bh * 64 + vrow) * SEQ; bf16* youtB = youtA + SEQ;
        f32x2 S2 = {0.f, 0.f};
        for (int t0 = 0; t0 < SEQ; t0 += 64) {
            float ykA = 0.f, ykB = 0.f;
#pragma unroll 8
            for (int j = 0; j < 64; ++j) {
                const unsigned* p = pk + (size_t)(t0 + j) * 192;
                const unsigned w0 = p[0], w1 = p[1], w2 = p[2];
                const float r = lo2f(w0), e = hi2f(w0), kp = lo2f(w1), kk = hi2f(w1), kka = lo2f(w2), vv = hi2f(w2);
                const f32x2 v2 = {rdlane(vv, vrow), rdlane(vv, vrow + 1)};
                const float dec = __expf(-e);
                const f32x2 pk2v = S2 * (f32x2){kk, kk};
                float saA, saB; wsum2_dpp(pk2v.x, pk2v.y, saA, saB); const f32x2 sa2 = {saA, saB};
                S2 = S2 * (f32x2){dec, dec} + (v2 * (f32x2){kp, kp} - sa2 * (f32x2){kka, kka});
                const f32x2 py = S2 * (f32x2){r, r};
                float yA, yB; wsum2_dpp(py.x, py.y, yA, yB);
                ykA = (F.lane == j) ? yA : ykA; ykB = (F.lane == j) ? yB : ykB;
            }
            youtA[t0 + F.lane] = (bf16)f2bf(ykA); youtB[t0 + F.lane] = (bf16)f2bf(ykB);
        }
    }
    __builtin_amdgcn_s_setprio(0);
}

__device__ __forceinline__ void ph_rwkv_finish(const Args& A, Frame& F) {
    const bf16* Z = (const bf16*)(A.ws + WS_Z); const bf16* RKV = (const bf16*)A.out; const bf16* YRAW = (const bf16*)A.out + (size_t)3 * TOK * 1024;
    const float* BS = (const float*)(A.ws + WS_BS); bf16* Y = (bf16*)(A.ws + WS_HY);
    const float* lnx_g = (const float*)A.in[15]; const float* lnx_b = (const float*)A.in[16];
    LAS float* tile = (LAS float*)(F.lds + F.wave * 16640);
    for (int it = F.gw; it < 8192; it += F.ngw) {
        const int bh = it >> 8, tb = it & 255, b = bh >> 4, h = bh & 15, t0 = tb * 64;
        for (int vr = 0; vr < 64; ++vr) tile[vr * 65 + F.lane] = bf2f(YRAW[((size_t)bh * 64 + vr) * SEQ + t0 + F.lane]);
        asm volatile("s_waitcnt lgkmcnt(0)" ::: "memory");
        const int c = h * 64 + F.lane; const float lg = lnx_g[c], lb = lnx_b[c];
        for (int j = 0; j < 64; ++j) {
            const int t = b * SEQ + t0 + j;
            const float y = tile[F.lane * 65 + j];
            const float mean = wsum(y) * (1.0f / 64.0f); const float d = y - mean; const float var = wsum(d * d) * (1.0f / 64.0f);
            const float yn = d * rsqrtf(var + 64e-5f) * lg + lb;
            const float vv = bf2f(RKV[(size_t)2 * TOK * 1024 + (size_t)t * 1024 + c]); const float g = bf2f(Z[(size_t)t * EV_NP + 1280 + 2048 + c]); const float bs = BS[(size_t)t * 16 + h];
            Y[(size_t)t * DM + 1024 + c] = (bf16)f2bf((yn + bs * vv) * g);
        }
        asm volatile("s_waitcnt lgkmcnt(0)" ::: "memory");
    }
}

constexpr size_t WS_H8 = WS_BIG + 384 * MiB, WS_HS = WS_BIG + 448 * MiB;
__device__ __forceinline__ unsigned pack_i8x4(float a, float b, float c, float d) {
    const unsigned ua = __float_as_uint(a + 12582912.0f) & 255u, ub = __float_as_uint(b + 12582912.0f) & 255u, uc = __float_as_uint(c + 12582912.0f) & 255u, ud = __float_as_uint(d + 12582912.0f);
    return ua | (ub << 8) | (uc << 16) | (ud << 24);
}
__device__ __forceinline__ void ph_ln_mixer(const Args& A, Frame& F, const int L) {
    const float* xsrc = (const float*)A.in[0]; const bf16* xsrcb = (const bf16*)A.out;
    bf16* xdst = (L == 0) ? (bf16*)A.out : (bf16*)(A.ws + WS_Z + 160 * MiB);
    const bf16* O = (const bf16*)(A.ws + WS_Z); bf16* H = (bf16*)(A.ws + WS_HY); const float* MOD = (const float*)(A.ws + WS_MOD);
    const float* lng = (const float*)A.in[21] + (size_t)(L * 2 + 0) * DM; const float* lnb = (const float*)A.in[22] + (size_t)(L * 2 + 0) * DM;
    for (int t = F.gw; t < TOK; t += F.ngw) {
        const int b = t >> 14;
        const float* gate = MOD + (size_t)((L * 2 + 0) * 2 + b) * 6144 + 4096;
        const float* sh = MOD + (size_t)((L * 2 + 1) * 2 + b) * 6144; const float* sc = sh + 2048;
        float v[32]; float sum = 0.f;
#pragma unroll
        for (int j = 0; j < 4; ++j) { const int base = (j * 64 + F.lane) * 8;
            const u32x4 ow = *(const u32x4*)(O + (size_t)t * DM + base);
            f32x4 x0, x1;
            if (L == 0) { x0 = *(const f32x4*)(xsrc + (size_t)t * DM + base); x1 = *(const f32x4*)(xsrc + (size_t)t * DM + base + 4); }
            else { const u32x4 xw = *(const u32x4*)(xsrcb + (size_t)t * DM + base); x0 = (f32x4){lo2f(xw.x), hi2f(xw.x), lo2f(xw.y), hi2f(xw.y)}; x1 = (f32x4){lo2f(xw.z), hi2f(xw.z), lo2f(xw.w), hi2f(xw.w)}; }
            const f32x4 g0 = *(const f32x4*)(gate + base), g1 = *(const f32x4*)(gate + base + 4);
            const float of[8] = {lo2f(ow.x), hi2f(ow.x), lo2f(ow.y), hi2f(ow.y), lo2f(ow.z), hi2f(ow.z), lo2f(ow.w), hi2f(ow.w)};
#pragma unroll
            for (int e = 0; e < 4; ++e) { v[j * 8 + e] = ALPHA * x0[e] + (1.0f + g0[e]) * of[e]; v[j * 8 + 4 + e] = ALPHA * x1[e] + (1.0f + g1[e]) * of[4 + e]; }
#pragma unroll
            for (int e = 0; e < 8; ++e) sum += v[j * 8 + e]; }
        const float mean = wsum(sum) * (1.0f / DM); float sq = 0.f;
#pragma unroll
        for (int e = 0; e < 32; ++e) { v[e] -= mean; sq += v[e] * v[e]; }
        const float rstd = rsqrtf(wsum(sq) * (1.0f / DM) + 1e-5f); float hmax = 0.f;
#pragma unroll
        for (int j = 0; j < 4; ++j) { const int base = (j * 64 + F.lane) * 8;
            const f32x4 lg0 = *(const f32x4*)(lng + base), lg1 = *(const f32x4*)(lng + base + 4), lb0 = *(const f32x4*)(lnb + base), lb1 = *(const f32x4*)(lnb + base + 4);
            const f32x4 s0 = *(const f32x4*)(sc + base), s1 = *(const f32x4*)(sc + base + 4), h0 = *(const f32x4*)(sh + base), h1 = *(const f32x4*)(sh + base + 4);
            f32x4 o0, o1;
#pragma unroll
            for (int e = 0; e < 4; ++e) { o0[e] = v[j * 8 + e] * rstd * lg0[e] + lb0[e]; o1[e] = v[j * 8 + 4 + e] * rstd * lg1[e] + lb1[e]; }
            { u32x4 xw; xw.x = pk2(o0[0], o0[1]); xw.y = pk2(o0[2], o0[3]); xw.z = pk2(o1[0], o1[1]); xw.w = pk2(o1[2], o1[3]); *(u32x4*)(xdst + (size_t)t * DM + base) = xw; }
            const f32x4 q0 = o0 * (1.0f + s0) + h0, q1 = o1 * (1.0f + s1) + h1;
            u32x4 w; w.x = pk2(q0[0], q0[1]); w.y = pk2(q0[2], q0[3]); w.z = pk2(q1[0], q1[1]); w.w = pk2(q1[2], q1[3]);
            *(u32x4*)(H + (size_t)t * DM + base) = w;
#pragma unroll
            for (int e = 0; e < 4; ++e) { v[j * 8 + e] = q0[e]; v[j * 8 + 4 + e] = q1[e]; hmax = fmaxf(hmax, fmaxf(fabsf(q0[e]), fabsf(q1[e]))); } }
        { hmax = wmax(hmax); const float inv = (hmax > 0.f) ? 127.0f / hmax : 0.f;
#pragma unroll
          for (int j = 0; j < 4; ++j) { const int base = (j * 64 + F.lane) * 8; u32x2 w8;
              w8.x = pack_i8x4(v[j * 8 + 0] * inv, v[j * 8 + 1] * inv, v[j * 8 + 2] * inv, v[j * 8 + 3] * inv); w8.y = pack_i8x4(v[j * 8 + 4] * inv, v[j * 8 + 5] * inv, v[j * 8 + 6] * inv, v[j * 8 + 7] * inv);
              *(u32x2*)(A.ws + WS_H8 + (size_t)t * DM + base) = w8; }
          if (F.lane == 0) ((float*)(A.ws + WS_HS))[t] = hmax * (1.0f / 127.0f); }
    }
    {
        const float* pu = (const float*)A.in[25] + (size_t)L * 16384 * 2048; const float* pv = (const float*)A.in[26] + (size_t)L * 16384 * 2048;
        unsigned char* T8 = A.ws + WS_BIG; float* SCL = (float*)(A.ws + WS_BIG + 64 * MiB);
        for (int r = F.gw; r < 32768; r += F.ngw) {
            const float* src = ((r < 16384) ? pu : pv) + (size_t)(r & 16383) * 2048;
            f32x4 f[2][4]; float amax = 0.f;
#pragma unroll
            for (int j = 0; j < 2; ++j)
#pragma unroll
                for (int c = 0; c < 4; ++c) { f[j][c] = *(const f32x4*)(src + (j * 64 + F.lane) * 16 + 4 * c);
                    amax = fmaxf(amax, fmaxf(fmaxf(fabsf(f[j][c][0]), fabsf(f[j][c][1])), fmaxf(fabsf(f[j][c][2]), fabsf(f[j][c][3])))); }
            amax = wmax(amax);
            {
                const float inv = (amax > 0.f) ? 127.0f / amax : 0.f;
#pragma unroll
                for (int j = 0; j < 2; ++j) { u32x4 w;
                    w.x = pack_i8x4(f[j][0][0] * inv, f[j][0][1] * inv, f[j][0][2] * inv, f[j][0][3] * inv); w.y = pack_i8x4(f[j][1][0] * inv, f[j][1][1] * inv, f[j][1][2] * inv, f[j][1][3] * inv);
                    w.z = pack_i8x4(f[j][2][0] * inv, f[j][2][1] * inv, f[j][2][2] * inv, f[j][2][3] * inv); w.w = pack_i8x4(f[j][3][0] * inv, f[j][3][1] * inv, f[j][3][2] * inv, f[j][3][3] * inv);
                    *(u32x4*)(T8 + (size_t)r * 2048 + (j * 64 + F.lane) * 16) = w; }
                if (F.lane == 0) SCL[r] = amax * (1.0f / 127.0f);
            }
        }
    }
}

template <int NV, int NBITS> __device__ __forceinline__ unsigned wave_tau16(const unsigned (&key)[NV]) {
    unsigned tau = 0u;
#pragma unroll 1
    for (int bit = NBITS - 1; bit >= 0; --bit) {
        const unsigned cand = tau | (1u << bit); int cnt = 0;
#pragma unroll
        for (int v = 0; v < NV; ++v) cnt += __popcll(__ballot(key[v] >= cand));
        if (cnt >= 16) tau = cand;
    }
    return tau;
}
template <int NV> __device__ __forceinline__ void wave_compact16(const unsigned (&key)[NV], const float (&val)[NV], const int (&id)[NV], unsigned tau, LAS float* ov, LAS int* oi, int lane) {
    int ngt = 0;
#pragma unroll
    for (int v = 0; v < NV; ++v) ngt += __popcll(__ballot(key[v] > tau));
    int bg = 0, be = 0;
#pragma unroll
    for (int v = 0; v < NV; ++v) {
        const bool gt = key[v] > tau, eq = key[v] == tau;
        const unsigned long long mg = __ballot(gt), me = __ballot(eq);
        const unsigned long long below = (lane == 0) ? 0ull : ((~0ull) >> (64 - lane));
        const int pg = bg + __popcll(mg & below), pe = ngt + be + __popcll(me & below);
        if (gt) { ov[pg] = val[v]; oi[pg] = id[v]; }
        if (eq && pe < 16) { ov[pe] = val[v]; oi[pe] = id[v]; }
        bg += __popcll(mg); be += __popcll(me);
    }
}

template <int CTRL, int BANK> __device__ __forceinline__ unsigned dppb(unsigned old, unsigned v) { return (unsigned)__builtin_amdgcn_update_dpp((int)old, (int)v, CTRL, 0xF, BANK, false); }
template <int CTRL> __device__ __forceinline__ unsigned dppm(unsigned v) { return (unsigned)__builtin_amdgcn_mov_dpp((int)v, CTRL, 0xF, 0xF, true); }
template <int CTRL> __device__ __forceinline__ unsigned cex(unsigned x, bool lo) { const unsigned mx = max(x, dppm<CTRL>(x)), mn = min(x, dppm<CTRL>(x)); return lo ? mx : mn; }
__device__ __forceinline__ unsigned cex4(unsigned x, bool lo) {
    unsigned t = (unsigned)__builtin_amdgcn_mov_dpp((int)x, 0x104, 0xF, 0x5, false); t = dppb<0x114, 0xA>(t, x); const unsigned mx = max(x, t), mn = min(x, t); return lo ? mx : mn; }
struct LoMasks { bool lo1, lo2, lo4, lo8, odd16, up32; };
__device__ __forceinline__ unsigned sort16_desc(unsigned x, const LoMasks& M) {
    x = cex<0xB1>(x, M.lo1);
    x = cex<0x1B>(x, M.lo2); x = cex<0xB1>(x, M.lo1);
    x = cex<0x141>(x, M.lo4); x = cex<0x4E>(x, M.lo2); x = cex<0xB1>(x, M.lo1);
    x = cex<0x140>(x, M.lo8); x = cex4(x, M.lo4); x = cex<0x4E>(x, M.lo2); x = cex<0xB1>(x, M.lo1);
    return x;
}
__device__ __forceinline__ unsigned clean16_desc(unsigned x, const LoMasks& M) {
    x = cex<0x128>(x, M.lo8); x = cex4(x, M.lo4); x = cex<0x4E>(x, M.lo2); x = cex<0xB1>(x, M.lo1); return x;
}
__device__ __forceinline__ unsigned mtop_regs(unsigned a, unsigned b) { return max(a, dppm<0x140>(b)); }
__device__ __forceinline__ unsigned mtop_rows(unsigned y, const LoMasks& M) { const auto r = __builtin_amdgcn_permlane16_swap(y, y, false, false); const unsigned pv = M.odd16 ? r[0] : r[1]; return mtop_regs(y, pv); }
__device__ __forceinline__ unsigned mtop_halves(unsigned y, const LoMasks& M) { const auto r = __builtin_amdgcn_permlane32_swap(y, y, false, false); const unsigned pv = M.up32 ? r[0] : r[1]; return mtop_regs(y, pv); }

template <int OFF, int N, int MASKX, int TOT> __device__ __forceinline__ void ce_stage(unsigned (&k)[TOT]) {
#pragma unroll
    for (int i = 0; i < N; ++i) { const int pr = i ^ MASKX; if (pr > i) { const unsigned a_ = k[OFF + i], b_ = k[OFF + pr]; k[OFF + i] = max(a_, b_); k[OFF + pr] = min(a_, b_); } }
}
template <int OFF, int TOT> __device__ __forceinline__ void sort16_regs(unsigned (&k)[TOT]) {
    ce_stage<OFF, 16, 1>(k); ce_stage<OFF, 16, 3>(k); ce_stage<OFF, 16, 1>(k); ce_stage<OFF, 16, 7>(k); ce_stage<OFF, 16, 2>(k); ce_stage<OFF, 16, 1>(k);
    ce_stage<OFF, 16, 15>(k); ce_stage<OFF, 16, 4>(k); ce_stage<OFF, 16, 2>(k); ce_stage<OFF, 16, 1>(k);
}
template <int TOT> __device__ __forceinline__ void clean16_regs(unsigned (&k)[TOT]) { ce_stage<0, 16, 8>(k); ce_stage<0, 16, 4>(k); ce_stage<0, 16, 2>(k); ce_stage<0, 16, 1>(k); }

__device__ __forceinline__ void ph_peer_select(const Args& A, Frame& F, const int L) {
    const bf16* QP = (const bf16*)(A.ws + WS_Z); const bf16* SKB = (const bf16*)(A.ws + WS_SKB) + (size_t)L * 262144;
    int* EID = (int*)(A.ws + WS_LA); float* GSM = (float*)(A.ws + WS_LA + 16 * MiB);
    LAS unsigned char* SKL = F.lds;
    LAS float* SCO = (LAS float*)(F.lds + 69632 + 4096);
    for (int it = F.bx; it < 4096; it += F.G) {
        const int tile = it >> 3, h = it & 7;
        __syncthreads();
        for (int c = F.tid; c < 4096; c += NTHREADS) { const int p = c >> 11, n = (c >> 4) & 127, cc = c & 15;
            *(LAS u32x4*)(SKL + (p * 128 + n) * 272 + cc * 16) = *(const u32x4*)(SKB + ((size_t)((p * 8 + h) * 128 + n)) * 128 + cc * 8); }
        __syncthreads();
        {
            const int p = F.wave >> 2, mt = F.wave & 3, g = F.lane >> 4, l15 = F.lane & 15;
            const bf16* qrow = QP + (size_t)(tile * 64 + mt * 16 + l15) * DM + h * 256 + p * 128 + 8 * g;
            bf16x8 afr[4];
#pragma unroll
            for (int ks = 0; ks < 4; ++ks) afr[ks] = *(const bf16x8*)(qrow + 32 * ks);
#pragma unroll
            for (int nt = 0; nt < 8; ++nt) {
                f32x4 acc = {0.f, 0.f, 0.f, 0.f};
#pragma unroll
                for (int ks = 0; ks < 4; ++ks) { const bf16x8 bfr = *(const LAS bf16x8*)(SKL + (p * 128 + nt * 16 + l15) * 272 + (32 * ks + 8 * g) * 2);
                    acc = __builtin_amdgcn_mfma_f32_16x16x32_bf16(afr[ks], bfr, acc, 0, 0, 0); }
#pragma unroll
                for (int rg = 0; rg < 4; ++rg) SCO[(p * 64 + mt * 16 + 4 * g + rg) * 132 + nt * 16 + l15] = acc[rg];
            }
        }
        __syncthreads();
        constexpr int NT = 4;
        LAS unsigned char* WB = F.lds + 141312 + F.wave * 2048;
        LoMasks M; M.lo1 = (F.lane & 1) == 0; M.lo2 = (F.lane & 2) == 0; M.lo4 = (F.lane & 4) == 0; M.lo8 = (F.lane & 8) == 0; M.odd16 = (F.lane & 16) != 0; M.up32 = (F.lane & 32) != 0;
        int pi_, pj_;
        { const int L = F.lane;
          if (L < 16) { pi_ = 0; pj_ = L; } else if (L < 24) { pi_ = 1; pj_ = L - 16; } else if (L < 29) { pi_ = 2; pj_ = L - 24; } else if (L < 33) { pi_ = 3; pj_ = L - 29; }
          else if (L < 36) { pi_ = 4; pj_ = L - 33; } else if (L < 42) { pi_ = 5 + ((L - 36) >> 1); pj_ = (L - 36) & 1; } else { pi_ = 8 + (L - 42); pj_ = 0; }
          if (L >= 50) { pi_ = 0; pj_ = 0; } }
        const bool pvalid = F.lane < 50;
        {
            const int g = F.lane >> 2, q = F.lane & 3, tok = g >> 1, sp = g & 1;
            const LAS float* srow = SCO + (sp * 64 + F.wave * 8 + tok) * 132;
            unsigned k[32]; const unsigned ib = (unsigned)(127 - q * 32);
#pragma unroll
            for (int c = 0; c < 8; ++c) { const f32x4 v = *(const LAS f32x4*)(srow + q * 32 + 4 * c);
#pragma unroll
                for (int e = 0; e < 4; ++e) k[4 * c + e] = (fixkey20(v[e]) << 7) | (ib - (unsigned)(4 * c + e)); }
            sort16_regs<0>(k); sort16_regs<16>(k);
            unsigned m[16], t2[16];
#pragma unroll
            for (int i = 0; i < 16; ++i) m[i] = max(k[i], k[31 - i]);
            clean16_regs(m);
#pragma unroll
            for (int i = 0; i < 16; ++i) t2[i] = max(m[i], dppm<0xB1>(m[15 - i]));
            clean16_regs(t2);
#pragma unroll
            for (int i = 0; i < 16; ++i) m[i] = max(t2[i], dppm<0x4E>(t2[15 - i]));
            clean16_regs(m);
            float vals[16]; int idxs[16];
#pragma unroll
            for (int e = 0; e < 16; ++e) { idxs[e] = 127 - (int)(m[e] & 127u); vals[e] = srow[idxs[e]]; }
            if (q == 0) { LAS float* tvp = (LAS float*)(WB + tok * 256) + sp * 16; LAS int* tip = (LAS int*)(WB + tok * 256 + 128) + sp * 16;
#pragma unroll
                for (int c = 0; c < 4; ++c) { *(LAS f32x4*)(tvp + 4 * c) = (f32x4){vals[4 * c], vals[4 * c + 1], vals[4 * c + 2], vals[4 * c + 3]};
                    *(LAS u32x4*)(tip + 4 * c) = (u32x4){(unsigned)idxs[4 * c], (unsigned)idxs[4 * c + 1], (unsigned)idxs[4 * c + 2], (unsigned)idxs[4 * c + 3]}; } }
        }
        asm volatile("s_waitcnt lgkmcnt(0)" ::: "memory"); __builtin_amdgcn_wave_barrier();
#pragma unroll 1
        for (int tk0 = 0; tk0 < 8; tk0 += NT) {
            unsigned z[NT];
#pragma unroll
            for (int u = 0; u < NT; ++u) { const LAS float* tv = (const LAS float*)(WB + (tk0 + u) * 256); const float cvl = tv[pi_] + tv[16 + pj_];
                z[u] = pvalid ? ((fixkey20(cvl * 0.5f) << 8) | (unsigned)(255 - (pi_ * 16 + pj_))) : 0u; }
#define ALL4(EXPR) _Pragma("unroll") for (int u = 0; u < NT; ++u) { const unsigned X = z[u]; z[u] = (EXPR); }
#define CLEAN4() ALL4(cex<0x128>(X, M.lo8)) ALL4(cex4(X, M.lo4)) ALL4(cex<0x4E>(X, M.lo2)) ALL4(cex<0xB1>(X, M.lo1))
            ALL4(cex<0xB1>(X, M.lo1))
            ALL4(cex<0x1B>(X, M.lo2)) ALL4(cex<0xB1>(X, M.lo1))
            ALL4(cex<0x141>(X, M.lo4)) ALL4(cex<0x4E>(X, M.lo2)) ALL4(cex<0xB1>(X, M.lo1))
            ALL4(cex<0x140>(X, M.lo8)) ALL4(cex4(X, M.lo4)) ALL4(cex<0x4E>(X, M.lo2)) ALL4(cex<0xB1>(X, M.lo1))
            ALL4(mtop_rows(X, M)) CLEAN4()
            ALL4(mtop_halves(X, M)) CLEAN4()
#undef ALL4
#undef CLEAN4
#pragma unroll
            for (int u = 0; u < NT; ++u) { const int t = tile * 64 + F.wave * 8 + tk0 + u;
                const LAS float* tv = (const LAS float*)(WB + (tk0 + u) * 256); const LAS int* ti = (const LAS int*)(WB + (tk0 + u) * 256 + 128);
                const int cid = 255 - (int)(z[u] & 255u), bi = (F.lane < 16) ? (cid >> 4) : 0, bj = (F.lane < 16) ? (cid & 15) : 0;
                const float bv = (F.lane < 16) ? (tv[bi] + tv[16 + bj]) : -INFINITY;
                const float mx = wmax(bv); const float ev = (F.lane < 16) ? expf(bv - mx) : 0.f; const float den = wsum(ev);
                if (F.lane < 16) { const int e1 = ti[bi], e2 = ti[16 + bj];
                    EID[(size_t)t * 128 + h * 16 + F.lane] = e1 * 128 + e2; GSM[(size_t)t * 128 + h * 16 + F.lane] = ev / den; } }
            asm volatile("s_waitcnt lgkmcnt(0)" ::: "memory"); __builtin_amdgcn_wave_barrier();
        }
    }
}

constexpr int PGB = 4;
__device__ __forceinline__ void ph_peer_gather(const Args& A, Frame& F, const int L, const bool dry = false) {
    bf16* H = (bf16*)(A.ws + WS_HY); bf16* Hout = dry ? (bf16*)(A.ws + WS_BIG + 128 * MiB) : H; float* Xout = dry ? (float*)(A.ws + WS_Z) : A.out; const unsigned char* TU = A.ws + WS_BIG; const unsigned char* TV = TU + (size_t)16384 * 2048; const float* SCL = (const float*)(A.ws + WS_BIG + 64 * MiB);
    const int* EID = (const int*)(A.ws + WS_LA); const float* GSM = (const float*)(A.ws + WS_LA + 16 * MiB);
    const float* MOD = (const float*)(A.ws + WS_MOD); float* X = A.out;
    const float* lng = (const float*)A.in[21] + (size_t)(L * 2 + 1) * DM; const float* lnb = (const float*)A.in[22] + (size_t)(L * 2 + 1) * DM;
    for (int t = F.gw; t < TOK; t += F.ngw) {
        const int b = t >> 14;
        f32x2 h2[16];
#pragma unroll
        for (int j = 0; j < 2; ++j) { const u32x4 a = *(const u32x4*)(H + (size_t)t * DM + (j * 64 + F.lane) * 16), c = *(const u32x4*)(H + (size_t)t * DM + (j * 64 + F.lane) * 16 + 8);
            const unsigned aw[8] = {a.x, a.y, a.z, a.w, c.x, c.y, c.z, c.w};
#pragma unroll
            for (int q = 0; q < 8; ++q) h2[j * 8 + q] = (f32x2){lo2f(aw[q]), hi2f(aw[q])}; }
        f32x2 o2[16];
#pragma unroll
        for (int e = 0; e < 16; ++e) o2[e] = (f32x2){0.f, 0.f};
#pragma unroll 1
        for (int e0 = 0; e0 < 128; e0 += PGB) {
            int eid[PGB]; float gw[PGB], su[PGB], sv[PGB];
#pragma unroll
            for (int q = 0; q < PGB; ++q) { eid[q] = __builtin_amdgcn_readfirstlane(EID[(size_t)t * 128 + e0 + q]); gw[q] = GSM[(size_t)t * 128 + e0 + q]; su[q] = SCL[eid[q]]; sv[q] = SCL[16384 + eid[q]]; }
            u32x4 uu[PGB][2], vv[PGB][2];
#pragma unroll
            for (int q = 0; q < PGB; ++q)
#pragma unroll
                for (int j = 0; j < 2; ++j) { uu[q][j] = *(const u32x4*)(TU + (size_t)eid[q] * 2048 + (j * 64 + F.lane) * 16); vv[q][j] = *(const u32x4*)(TV + (size_t)eid[q] * 2048 + (j * 64 + F.lane) * 16); }
#pragma unroll
            for (int q = 0; q < PGB; ++q) {
                f32x2 d2 = {0.f, 0.f};
#pragma unroll
                for (int j = 0; j < 2; ++j) { const unsigned w[4] = {uu[q][j].x, uu[q][j].y, uu[q][j].z, uu[q][j].w};
#pragma unroll
                    for (int i = 0; i < 4; ++i) { const f32x2 lo = __builtin_amdgcn_cvt_pk_f32_fp8((int)w[i], false), hi = __builtin_amdgcn_cvt_pk_f32_fp8((int)w[i], true);
                        d2 = lo * h2[j * 8 + 2 * i] + d2; d2 = hi * h2[j * 8 + 2 * i + 1] + d2; } }
                const float d = wsum(d2.x + d2.y) * su[q];
                const float act = 0.5f * d * (1.0f + erff(d * 0.70710678f)) * gw[q] * sv[q];
                const f32x2 a2 = {act, act};
#pragma unroll
                for (int j = 0; j < 2; ++j) { const unsigned w[4] = {vv[q][j].x, vv[q][j].y, vv[q][j].z, vv[q][j].w};
#pragma unroll
                    for (int i = 0; i < 4; ++i) { const f32x2 lo = __builtin_amdgcn_cvt_pk_f32_fp8((int)w[i], false), hi = __builtin_amdgcn_cvt_pk_f32_fp8((int)w[i], true);
                        o2[j * 8 + 2 * i] = a2 * lo + o2[j * 8 + 2 * i]; o2[j * 8 + 2 * i + 1] = a2 * hi + o2[j * 8 + 2 * i + 1]; } }
            }
        }
        float out[32];
#pragma unroll
        for (int e = 0; e < 16; ++e) { out[2 * e] = o2[e].x; out[2 * e + 1] = o2[e].y; }
        const float* gate = MOD + (size_t)((L * 2 + 1) * 2 + b) * 6144 + 4096;
        float sum = 0.f;
#pragma unroll
        for (int j = 0; j < 2; ++j)
#pragma unroll
            for (int c = 0; c < 4; ++c) { const int base = (j * 64 + F.lane) * 16 + 4 * c;
                const f32x4 x0 = *(const f32x4*)(X + (size_t)t * DM + base), g0 = *(const f32x4*)(gate + base);
#pragma unroll
                for (int e = 0; e < 4; ++e) { const float v = ALPHA * x0[e] + (1.0f + g0[e]) * out[j * 16 + 4 * c + e]; out[j * 16 + 4 * c + e] = v; sum += v; } }
        const float mean = wsum(sum) * (1.0f / DM); float sq = 0.f;
#pragma unroll
        for (int e = 0; e < 32; ++e) { out[e] -= mean; sq += out[e] * out[e]; }
        const float rstd = rsqrtf(wsum(sq) * (1.0f / DM) + 1e-5f);
        const float* sh = MOD + (size_t)(((L + 1) * 2 + 0) * 2 + b) * 6144; const float* sc = sh + 2048;
#pragma unroll
        for (int j = 0; j < 2; ++j) {
            float hq[16];
#pragma unroll
            for (int c = 0; c < 4; ++c) { const int base = (j * 64 + F.lane) * 16 + 4 * c;
                const f32x4 lg0 = *(const f32x4*)(lng + base), lb0 = *(const f32x4*)(lnb + base);
                f32x4 o0;
#pragma unroll
                for (int e = 0; e < 4; ++e) o0[e] = out[j * 16 + 4 * c + e] * rstd * lg0[e] + lb0[e];
                *(f32x4*)(Xout + (size_t)t * DM + base) = o0;
                if (L == 0) { const f32x4 s0 = *(const f32x4*)(sc + base), h0 = *(const f32x4*)(sh + base);
#pragma unroll
                    for (int e = 0; e < 4; ++e) hq[4 * c + e] = o0[e] * (1.0f + s0[e]) + h0[e]; } }
            if (L == 0) { u32x4 w0, w1;
                w0.x = pk2(hq[0], hq[1]); w0.y = pk2(hq[2], hq[3]); w0.z = pk2(hq[4], hq[5]); w0.w = pk2(hq[6], hq[7]);
                w1.x = pk2(hq[8], hq[9]); w1.y = pk2(hq[10], hq[11]); w1.z = pk2(hq[12], hq[13]); w1.w = pk2(hq[14], hq[15]);
                *(u32x4*)(Hout + (size_t)t * DM + (j * 64 + F.lane) * 16) = w0; *(u32x4*)(Hout + (size_t)t * DM + (j * 64 + F.lane) * 16 + 8) = w1; }
        }
    }
}

struct XInfo { int rank, nloc, rx, nx; };
__device__ __forceinline__ XInfo xcc_info(volatile LAS unsigned* MISC) { XInfo x; x.rank = (int)MISC[16]; x.nloc = (int)MISC[17]; x.rx = (int)MISC[18]; x.nx = (int)MISC[19]; return x; }
constexpr size_t WS_DP = WS_BIG + 128 * MiB;
constexpr size_t WS_ACT = WS_BIG + 80 * MiB;
__device__ __forceinline__ void ph_peer_u(const Args& A, Frame& F, const XInfo X) {
    const unsigned char* H8 = A.ws + WS_H8; const unsigned char* TU = A.ws + WS_BIG; const int* EID = (const int*)(A.ws + WS_LA); float* DP = (float*)(A.ws + WS_DP);
    LAS int* IDX = (LAS int*)(F.lds + F.wave * 1024);
    const int g16 = F.lane >> 4, c16 = F.lane & 15; const int step = X.nloc * NWAVES;
    for (int s = X.rx; s < 8; s += X.nx) {
        int t = X.rank * NWAVES + F.wave;
        int e0 = 0, e1 = 0; u32x4 ha = {0u, 0u, 0u, 0u};
        if (t < TOK) { e0 = EID[(size_t)t * 128 + F.lane]; e1 = EID[(size_t)t * 128 + 64 + F.lane]; ha = *(const u32x4*)(H8 + (size_t)t * DM + 256 * s + 16 * c16); }
        const unsigned char* ub = TU + 256 * s + 16 * c16;
        while (t < TOK) {
            const int tn = t + step; int n0 = 0, n1 = 0; u32x4 na = {0u, 0u, 0u, 0u};
            if (tn < TOK) { n0 = EID[(size_t)tn * 128 + F.lane]; n1 = EID[(size_t)tn * 128 + 64 + F.lane]; na = *(const u32x4*)(H8 + (size_t)tn * DM + 256 * s + 16 * c16); }
            IDX[F.lane] = e0; IDX[F.lane + 64] = e1;
            asm volatile("s_waitcnt lgkmcnt(0)" ::: "memory"); __builtin_amdgcn_wave_barrier();
            float keep0 = 0.f, keep1 = 0.f;
#pragma unroll
            for (int i0 = 0; i0 < 32; i0 += 8) {
                u32x4 ud[8];
#pragma unroll
                for (int u = 0; u < 8; ++u) { const int eid = IDX[4 * (i0 + u) + g16]; ud[u] = *(const u32x4*)(ub + (size_t)eid * 2048); }
#pragma unroll
                for (int u = 0; u < 8; ++u) {
                    int di = __builtin_amdgcn_sdot4((int)ud[u].x, (int)ha.x, 0, false); di = __builtin_amdgcn_sdot4((int)ud[u].y, (int)ha.y, di, false);
                    di = __builtin_amdgcn_sdot4((int)ud[u].z, (int)ha.z, di, false); di = __builtin_amdgcn_sdot4((int)ud[u].w, (int)ha.w, di, false);
                    const float d = sum16_dpp((float)di);
                    const int i = i0 + u;
                    if (i < 16) keep0 = ((i & 15) == c16) ? d : keep0; else keep1 = ((i & 15) == c16) ? d : keep1;
                }
            }
            float* dp = DP + ((size_t)s * TOK + t) * 128 + 4 * c16 + g16;
            dp[0] = keep0; dp[64] = keep1;
            asm volatile("s_waitcnt lgkmcnt(0)" ::: "memory"); __builtin_amdgcn_wave_barrier();
            e0 = n0; e1 = n1; ha = na; t = tn;
        }
    }
}
__device__ __forceinline__ void ph_peer_act(const Args& A, Frame& F) {
    const float* SCL = (const float*)(A.ws + WS_BIG + 64 * MiB); const int* EID = (const int*)(A.ws + WS_LA); const float* GSM = (const float*)(A.ws + WS_LA + 16 * MiB);
    const float* DP = (const float*)(A.ws + WS_DP); unsigned char* ACT8 = A.ws + WS_ACT; float* AS = (float*)(A.ws + WS_ACT + 8 * MiB);
    for (int t = F.gw; t < TOK; t += F.ngw) { const float hs = ((const float*)(A.ws + WS_HS))[t];
        float a[2];
#pragma unroll
        for (int m = 0; m < 2; ++m) { const int e = F.lane + 64 * m; const int eid = EID[(size_t)t * 128 + e]; float d = 0.f;
#pragma unroll
            for (int x = 0; x < 8; ++x) d += DP[((size_t)x * TOK + t) * 128 + e];
            d *= SCL[eid] * hs;
            a[m] = 0.5f * d * (1.0f + erff(d * 0.70710678f)) * GSM[(size_t)t * 128 + e] * SCL[16384 + eid]; }
        const float amax = wmax(fmaxf(fabsf(a[0]), fabsf(a[1]))); const float inv = (amax > 0.f) ? 127.0f / amax : 0.f;
#pragma unroll
        for (int m = 0; m < 2; ++m) ACT8[(size_t)t * 128 + F.lane + 64 * m] = (unsigned char)(__float_as_uint(a[m] * inv + 12582912.0f) & 255u);
        if (F.lane == 0) AS[t] = amax * (1.0f / 127.0f);
    }
}
__device__ __forceinline__ void ph_peer_v(const Args& A, Frame& F, const XInfo X) {
    const unsigned char* TV = A.ws + WS_BIG + (size_t)16384 * 2048;
    const int* EID = (const int*)(A.ws + WS_LA); const unsigned* ACT8 = (const unsigned*)(A.ws + WS_ACT); const float* AS = (const float*)(A.ws + WS_ACT + 8 * MiB); bf16* OUT = (bf16*)(A.ws + WS_Z);
    LAS int* IDX = (LAS int*)(F.lds + F.wave * 1024); LAS unsigned* ACT = (LAS unsigned*)(F.lds + F.wave * 1024 + 512);
    const int g16 = F.lane >> 4, c16 = F.lane & 15; const int step = X.nloc * NWAVES;
    for (int s = X.rx; s < 8; s += X.nx) {
        int t = X.rank * NWAVES + F.wave;
        int e0 = 0, e1 = 0; unsigned a0 = 0u;
        if (t < TOK) { e0 = EID[(size_t)t * 128 + F.lane]; e1 = EID[(size_t)t * 128 + 64 + F.lane]; a0 = ACT8[(size_t)t * 32 + (F.lane & 31)]; }
        const unsigned char* vb = TV + 256 * s + 16 * c16;
        while (t < TOK) {
            const int tn = t + step; int n0 = 0, n1 = 0; unsigned b0 = 0u;
            if (tn < TOK) { n0 = EID[(size_t)tn * 128 + F.lane]; n1 = EID[(size_t)tn * 128 + 64 + F.lane]; b0 = ACT8[(size_t)tn * 32 + (F.lane & 31)]; }
            const float as = AS[t];
            IDX[F.lane] = e0; IDX[F.lane + 64] = e1; if (F.lane < 32) ACT[F.lane] = a0;
            asm volatile("s_waitcnt lgkmcnt(0)" ::: "memory"); __builtin_amdgcn_wave_barrier();
            int acc[16];
#pragma unroll
            for (int j = 0; j < 16; ++j) acc[j] = 0;
#pragma unroll
            for (int b = 0; b < 8; b += 2) {
                u32x4 vd[2][4]; unsigned a4[2];
#pragma unroll
                for (int h = 0; h < 2; ++h) { a4[h] = ACT[4 * (b + h) + g16];
#pragma unroll
                    for (int u = 0; u < 4; ++u) { const int eid = IDX[16 * (b + h) + 4 * g16 + u]; vd[h][u] = *(const u32x4*)(vb + (size_t)eid * 2048); } }
#pragma unroll
                for (int h = 0; h < 2; ++h)
#pragma unroll
                    for (int q = 0; q < 4; ++q) { const unsigned A_ = vd[h][0][q], B_ = vd[h][1][q], C_ = vd[h][2][q], D_ = vd[h][3][q];
                        const unsigned ablo = __builtin_amdgcn_perm(B_, A_, 0x05010400u), abhi = __builtin_amdgcn_perm(B_, A_, 0x07030602u);
                        const unsigned cdlo = __builtin_amdgcn_perm(D_, C_, 0x05010400u), cdhi = __builtin_amdgcn_perm(D_, C_, 0x07030602u);
                        acc[4 * q + 0] = __builtin_amdgcn_sdot4((int)__builtin_amdgcn_perm(cdlo, ablo, 0x05040100u), (int)a4[h], acc[4 * q + 0], false);
                        acc[4 * q + 1] = __builtin_amdgcn_sdot4((int)__builtin_amdgcn_perm(cdlo, ablo, 0x07060302u), (int)a4[h], acc[4 * q + 1], false);
                        acc[4 * q + 2] = __builtin_amdgcn_sdot4((int)__builtin_amdgcn_perm(cdhi, abhi, 0x05040100u), (int)a4[h], acc[4 * q + 2], false);
                        acc[4 * q + 3] = __builtin_amdgcn_sdot4((int)__builtin_amdgcn_perm(cdhi, abhi, 0x07060302u), (int)a4[h], acc[4 * q + 3], false); }
            }
            { const float r0 = rsum4((float)acc[0], (float)acc[4], (float)acc[8], (float)acc[12]) * as, r1 = rsum4((float)acc[1], (float)acc[5], (float)acc[9], (float)acc[13]) * as;
              const float r2 = rsum4((float)acc[2], (float)acc[6], (float)acc[10], (float)acc[14]) * as, r3 = rsum4((float)acc[3], (float)acc[7], (float)acc[11], (float)acc[15]) * as;
              u32x2 w; w.x = pk2(r0, r1); w.y = pk2(r2, r3); *(u32x2*)(OUT + (size_t)t * DM + 256 * s + 16 * c16 + 4 * g16) = w; }
            asm volatile("s_waitcnt lgkmcnt(0)" ::: "memory"); __builtin_amdgcn_wave_barrier();
            e0 = n0; e1 = n1; a0 = b0; t = tn;
        }
    }
}
__device__ __forceinline__ void ph_peer_ln(const Args& A, Frame& F, const int L) {
    const bf16* OUT = (const bf16*)(A.ws + WS_Z); float* X = A.out; bf16* H = (bf16*)(A.ws + WS_HY); const float* MOD = (const float*)(A.ws + WS_MOD);
    const bf16* Xin = (L == 0) ? (const bf16*)A.out : (const bf16*)(A.ws + WS_Z + 160 * MiB); bf16* Xb = (bf16*)A.out;
    const float* lng = (const float*)A.in[21] + (size_t)(L * 2 + 1) * DM; const float* lnb = (const float*)A.in[22] + (size_t)(L * 2 + 1) * DM;
    for (int t = F.gw; t < TOK; t += F.ngw) {
        const int b = t >> 14;
        const float* gate = MOD + (size_t)((L * 2 + 1) * 2 + b) * 6144 + 4096;
        const float* sh = MOD + (size_t)(((L + 1) * 2 + 0) * 2 + b) * 6144; const float* sc = sh + 2048;
        float v[32]; float sum = 0.f;
#pragma unroll
        for (int j = 0; j < 8; ++j) { const int base = (j * 64 + F.lane) * 4;
            const u32x2 ow = *(const u32x2*)(OUT + (size_t)t * DM + base); const f32x4 o0 = {lo2f(ow.x), hi2f(ow.x), lo2f(ow.y), hi2f(ow.y)};
            const u32x2 xw = *(const u32x2*)(Xin + (size_t)t * DM + base); const f32x4 x0 = {lo2f(xw.x), hi2f(xw.x), lo2f(xw.y), hi2f(xw.y)}; const f32x4 g0 = *(const f32x4*)(gate + base);
#pragma unroll
            for (int e = 0; e < 4; ++e) { v[j * 4 + e] = ALPHA * x0[e] + (1.0f + g0[e]) * o0[e]; sum += v[j * 4 + e]; } }
        const float mean = wsum(sum) * (1.0f / DM); float sq = 0.f;
#pragma unroll
        for (int e = 0; e < 32; ++e) { v[e] -= mean; sq += v[e] * v[e]; }
        const float rstd = rsqrtf(wsum(sq) * (1.0f / DM) + 1e-5f);
#pragma unroll
        for (int j = 0; j < 8; ++j) { const int base = (j * 64 + F.lane) * 4;
            const f32x4 lg0 = *(const f32x4*)(lng + base), lb0 = *(const f32x4*)(lnb + base);
            f32x4 o0;
#pragma unroll
            for (int e = 0; e < 4; ++e) o0[e] = v[j * 4 + e] * rstd * lg0[e] + lb0[e];
            if (L == 0) { u32x2 xo; xo.x = pk2(o0[0], o0[1]); xo.y = pk2(o0[2], o0[3]); *(u32x2*)(Xb + (size_t)t * DM + base) = xo; } else *(f32x4*)(X + (size_t)t * DM + base) = o0;
            if (L == 0) { const f32x4 s0 = *(const f32x4*)(sc + base), h0 = *(const f32x4*)(sh + base); const f32x4 q0 = o0 * (1.0f + s0) + h0;
                u32x2 w; w.x = pk2(q0[0], q0[1]); w.y = pk2(q0[2], q0[3]); *(u32x2*)(H + (size_t)t * DM + base) = w; }
        }
    }
}

__device__ __forceinline__ void ph_odd_post(const Args& A, Frame& F) {
    bf16* Z = (bf16*)(A.ws + WS_Z); const int* positions = (const int*)A.in[2]; bf16* KIT = (bf16*)(A.ws + WS_BIG + 256 * MiB); unsigned char* K8 = A.ws + WS_BIG + 264 * MiB; unsigned char* V8 = A.ws + WS_BIG + 280 * MiB;
    const float inv128 = powf(10000.0f, -(float)F.lane / 64.0f); const int i32 = F.lane & 31; const float inv64 = powf(10000.0f, -(float)i32 / 32.0f);
    const int a16 = F.lane & 15, hs4 = F.lane >> 4, a8 = F.lane & 7, hs8 = F.lane >> 3;
    for (int t = F.gw; t < TOK; t += F.ngw) {
        bf16* zr = Z + (size_t)t * OD_NP; const float pos = (float)positions[t];
        const int bb = t >> 14, spos = t & (SEQ - 1);
        float sn, cs; sincosf(pos * inv128, &sn, &cs);
        float c4[4], s4[4];
#pragma unroll
        for (int e = 0; e < 4; ++e) { c4[e] = __shfl(cs, 4 * a16 + e); s4[e] = __shfl(sn, 4 * a16 + e); }
#pragma unroll
        for (int it = 0; it < 5; ++it) { const int hd = it * 4 + hs4; bf16* hp = zr + hd * 128 + 4 * a16;
            const u32x2 a = *(const u32x2*)hp, b = *(const u32x2*)(hp + 64);
            const float t1[4] = {lo2f(a.x), hi2f(a.x), lo2f(a.y), hi2f(a.y)}, t2[4] = {lo2f(b.x), hi2f(b.x), lo2f(b.y), hi2f(b.y)};
            float o1[4], o2[4];
#pragma unroll
            for (int e = 0; e < 4; ++e) { o1[e] = t1[e] * c4[e] - t2[e] * s4[e]; o2[e] = t2[e] * c4[e] + t1[e] * s4[e]; }
            *(u32x2*)hp = (u32x2){pk2(o1[0], o1[1]), pk2(o1[2], o1[3])}; *(u32x2*)(hp + 64) = (u32x2){pk2(o2[0], o2[1]), pk2(o2[2], o2[3])};
            if (it == 4) { unsigned char* k8 = K8 + ((size_t)((bb * 4 + hs4) * SEQ + spos)) * 128 + 4 * a16;
                int w1 = __builtin_amdgcn_cvt_pk_fp8_f32(o1[0] * 16.0f, o1[1] * 16.0f, 0, false); w1 = __builtin_amdgcn_cvt_pk_fp8_f32(o1[2] * 16.0f, o1[3] * 16.0f, w1, true);
                int w2 = __builtin_amdgcn_cvt_pk_fp8_f32(o2[0] * 16.0f, o2[1] * 16.0f, 0, false); w2 = __builtin_amdgcn_cvt_pk_fp8_f32(o2[2] * 16.0f, o2[3] * 16.0f, w2, true);
                *(unsigned*)k8 = (unsigned)w1; *(unsigned*)(k8 + 64) = (unsigned)w2; } }
        {
            const int e0 = F.lane * 8, kvh = e0 >> 7, d0 = e0 & 127;
            const u32x4 vw = *(const u32x4*)(zr + 2560 + e0);
            const unsigned ww[4] = {vw.x, vw.y, vw.z, vw.w}; unsigned ob[2] = {0u, 0u};
#pragma unroll
            for (int q = 0; q < 4; ++q) { const float c0 = fminf(fmaxf(lo2f(ww[q]) * 16.0f, -127.0f), 127.0f), c1 = fminf(fmaxf(hi2f(ww[q]) * 16.0f, -127.0f), 127.0f);
                const unsigned b0 = __float_as_uint(c0 + 12583040.0f) & 255u, b1 = __float_as_uint(c1 + 12583040.0f) & 255u;
                ob[q >> 1] |= (b0 | (b1 << 8)) << (16 * (q & 1)); }
            *(u32x2*)(V8 + ((size_t)((bb * 4 + kvh) * SEQ + spos)) * 128 + d0) = (u32x2){ob[0], ob[1]};
        }
        sincosf(pos * inv64, &sn, &cs);
#pragma unroll
        for (int e = 0; e < 4; ++e) { c4[e] = __shfl(cs, 4 * a8 + e); s4[e] = __shfl(sn, 4 * a8 + e); }
#pragma unroll
        for (int it = 0; it < 3; ++it) { const int hd = it * 8 + hs8; if (hd < 17) { bf16* hp = zr + 3072 + hd * 64 + 4 * a8;
            const u32x2 a = *(const u32x2*)hp, b = *(const u32x2*)(hp + 32);
            const float t1[4] = {lo2f(a.x), hi2f(a.x), lo2f(a.y), hi2f(a.y)}, t2[4] = {lo2f(b.x), hi2f(b.x), lo2f(b.y), hi2f(b.y)};
            float o1[4], o2[4];
#pragma unroll
            for (int e = 0; e < 4; ++e) { o1[e] = t1[e] * c4[e] - t2[e] * s4[e]; o2[e] = t2[e] * c4[e] + t1[e] * s4[e]; }
            const u32x2 w1 = {pk2(o1[0], o1[1]), pk2(o1[2], o1[3])}, w2 = {pk2(o2[0], o2[1]), pk2(o2[2], o2[3])};
            *(u32x2*)hp = w1; *(u32x2*)(hp + 32) = w2;
            if (hd == 16) {
                const int tile = spos >> 5, rr = spos & 31;
                bf16* kt = KIT + ((size_t)(bb * 512 + tile) * 4) * 512;
                const int d1 = 4 * a8, d2 = 32 + 4 * a8;
                *(u32x2*)(kt + ((d1 >> 4) * 64 + rr + 32 * ((d1 >> 3) & 1)) * 8 + (d1 & 7)) = w1;
                *(u32x2*)(kt + ((d2 >> 4) * 64 + rr + 32 * ((d2 >> 3) & 1)) * 8 + (d2 & 7)) = w2;
            } } }
    }
}

template <int CTRL, int RM> __device__ __forceinline__ unsigned dppu(unsigned old, unsigned v) { return (unsigned)__builtin_amdgcn_update_dpp((int)old, (int)v, CTRL, RM, 0xF, false); }
__device__ __forceinline__ void ph_dsa_select(const Args& A, Frame& F, const int mode = 0) {
    const bf16* Z = (const bf16*)(A.ws + WS_Z); unsigned short* SEL = (unsigned short*)(A.ws + WS_LA); int* CNT = (int*)(A.ws + WS_CNT); const bf16* KIT = (const bf16*)(A.ws + WS_BIG + 256 * MiB);
    LAS unsigned short* SC = (LAS unsigned short*)F.lds;
    LAS unsigned* LST = (LAS unsigned*)(F.lds + 131072);
    LAS unsigned* hist = (LAS unsigned*)(F.lds + 131072 + 16384);
    LAS unsigned* hist1 = (LAS unsigned*)(F.lds + 152576);
    LAS unsigned* res = (LAS unsigned*)(F.lds + 131072 + 16384 + 2048);
    LAS int* wtot = (LAS int*)(F.lds + 131072 + 16384 + 2048 + 64);
    const int r = F.lane & 31, hg = F.lane >> 5, tk = (r >> 2) & 1, hh = (r & 3) + 4 * (r >> 3);
    const int grp = F.wave >> 2, ltid = F.tid & 255, lw = F.wave & 3;
    for (int qd = F.bx; qd < TOK / 4; qd += F.G) {
        const int t0 = 4 * qd, b = t0 >> 14, s0 = t0 & (SEQ - 1);
        const int nkeys = s0 + 4, ntiles = (nkeys + 31) >> 5;
        bf16x8 af[2][4]; f32x2 wv[2][8];
#pragma unroll
        for (int a = 0; a < 2; ++a) {
            const bf16* qrow = Z + (size_t)(t0 + 2 * a + tk) * OD_NP + 3072 + hh * 64 + 8 * hg;
#pragma unroll
            for (int s = 0; s < 4; ++s) af[a][s] = *(const bf16x8*)(qrow + 16 * s);
            const bf16* wrow = Z + (size_t)(t0 + 2 * a + hg) * OD_NP + 4160;
            const u32x4 w0 = *(const u32x4*)(wrow), w1 = *(const u32x4*)(wrow + 8);
            const unsigned ww[8] = {w0.x, w0.y, w0.z, w0.w, w1.x, w1.y, w1.z, w1.w};
#pragma unroll
            for (int q = 0; q < 8; ++q) wv[a][q] = (f32x2){lo2f(ww[q]) * 0.03125f, hi2f(ww[q]) * 0.03125f};
        }
        __syncthreads();
        const bf16* kbase = KIT + (size_t)b * 512 * 2048 + F.lane * 8;
        if (mode != 2) {
            bf16x8 bcur[2][4];
#define DSA_LOAD1(dst, q_, tb_) do { const int tile = ((tb_) + (q_) < ntiles) ? ((tb_) + (q_)) : (ntiles - 1); const bf16* krow = kbase + (size_t)tile * 2048; \
                _Pragma("unroll") for (int s_ = 0; s_ < 4; ++s_) dst[q_][s_] = *(const bf16x8*)(krow + 512 * s_); } while (0)
#define DSA_MM(accv, src, q_, a_) do { _Pragma("unroll") for (int e = 0; e < 16; ++e) accv[e] = 0.f; \
                _Pragma("unroll") for (int s_ = 0; s_ < 4; ++s_) accv = __builtin_amdgcn_mfma_f32_32x32x16_bf16(af[a_][s_], src[q_][s_], accv, 0, 0, 0); } while (0)
#define DSA_EPI(accv, tb_, q_, a_) do { f32x2 s2_ = {0.f, 0.f}; _Pragma("unroll") for (int e = 0; e < 8; ++e) { \
                    const float x0_ = accv[2 * e], x1_ = accv[2 * e + 1]; const int r0_ = __builtin_bit_cast(int, x0_), r1_ = __builtin_bit_cast(int, x1_);        \
                    const f32x2 rl_ = {__builtin_bit_cast(float, r0_ > 0 ? r0_ : 0), __builtin_bit_cast(float, r1_ > 0 ? r1_ : 0)}; s2_ = rl_ * wv[a_][e] + s2_; } \
                float sc_ = s2_.x + s2_.y; const int key = ((tb_) + (q_)) * 32 + r; sc_ = fminf(fmaxf(sc_, -7.999f), 7.999f); const unsigned fx = (unsigned)((int)rintf(sc_ * 4096.0f) + (1 << 15)); \
                if ((tb_) + (q_) < ntiles) SC[(2 * (a_) + hg) * 16384 + key] = (unsigned short)((key <= s0 + 2 * (a_) + hg) ? fx : 0u); } while (0)
            int tb = F.wave * 2;
            if (tb < ntiles) {
                DSA_LOAD1(bcur, 0, tb); DSA_LOAD1(bcur, 1, tb);
                for (; tb < ntiles; tb += NWAVES * 2) {
                    f32x16 accA, accB;
                    DSA_MM(accA, bcur, 0, 0); DSA_MM(accB, bcur, 0, 1);
                    DSA_LOAD1(bcur, 0, tb + NWAVES * 2);
                    DSA_EPI(accA, tb, 0, 0); DSA_MM(accA, bcur, 1, 0); DSA_EPI(accB, tb, 0, 1); DSA_MM(accB, bcur, 1, 1);
                    DSA_LOAD1(bcur, 1, tb + NWAVES * 2);
                    DSA_EPI(accA, tb, 1, 0); DSA_EPI(accB, tb, 1, 1);
                }
            }
#undef DSA_LOAD1
#undef DSA_MM
#undef DSA_EPI
        }
        __syncthreads();
        if (mode == 1) continue;
#pragma unroll 1
        for (int rd = 0; rd < 2; ++rd) {
        const int tok = 2 * rd + grp;
        const int n = s0 + tok + 1; unsigned k = (unsigned)(n < 256 ? n : 256); unsigned prefix = 0u;
        const LAS unsigned short* sc = SC + tok * 16384;
        hist[grp * 256 + ltid] = 0u; hist1[grp * 256 + ltid] = 0u;
        unsigned kreg[64];
#pragma unroll
        for (int j = 0; j < 64; ++j) { const int i = ltid + 256 * j; kreg[j] = (i < n) ? (unsigned)sc[i] : 0u; }
        unsigned lmax = 0u;
#pragma unroll
        for (int j = 0; j < 64; ++j) lmax = (kreg[j] > lmax) ? kreg[j] : lmax;
        unsigned wmin = lmax;
        { unsigned x_;
          x_ = dppu<0xB1, 0xF>(wmin, wmin); wmin = x_ < wmin ? x_ : wmin; x_ = dppu<0x4E, 0xF>(wmin, wmin); wmin = x_ < wmin ? x_ : wmin;
          x_ = dppu<0x141, 0xF>(wmin, wmin); wmin = x_ < wmin ? x_ : wmin; x_ = dppu<0x140, 0xF>(wmin, wmin); wmin = x_ < wmin ? x_ : wmin;
          x_ = dppu<0x142, 0xA>(wmin, wmin); wmin = x_ < wmin ? x_ : wmin; x_ = dppu<0x143, 0xC>(wmin, wmin); wmin = x_ < wmin ? x_ : wmin; }
        if (F.lane == 63) wtot[16 + F.wave] = (int)wmin;
        __syncthreads();
        unsigned lbound = 0xFFFFFFFFu;
#pragma unroll
        for (int w = 0; w < 4; ++w) { const unsigned x = (unsigned)wtot[16 + grp * 4 + w]; lbound = x < lbound ? x : lbound; }
        LAS unsigned* seg = LST + (grp * 4 + lw) * 512; int ccnt = 0;
        {
            const unsigned lb1 = lbound > 1u ? lbound : 1u;
#pragma unroll
            for (int j = 0; j < 64; ++j) { if (256 * j < n) { const bool c = kreg[j] >= lb1; const unsigned long long m = __ballot(c);
                const int pos = ccnt + (int)__builtin_amdgcn_mbcnt_hi((unsigned)(m >> 32), __builtin_amdgcn_mbcnt_lo((unsigned)m, 0u));
                if (c && pos < 512) seg[pos] = (kreg[j] << 16) | (unsigned)(ltid + 256 * j); ccnt += __popcll(m); } }
        }
        const bool fast = ccnt <= 512;
        asm volatile("s_waitcnt lgkmcnt(0)" ::: "memory"); __builtin_amdgcn_wave_barrier();
#pragma unroll 1
        for (int pass = 0; pass < 2; ++pass) {
            const int shift = 8 - 8 * pass;
            LAS unsigned* hs = (pass == 0 ? hist : hist1) + grp * 256;
            if (fast) {
#pragma unroll
                for (int i = 0; i < 8; ++i) { if (64 * i < ccnt) { const int c_ = F.lane + 64 * i; const bool valid = c_ < ccnt; const unsigned kv = valid ? (seg[c_] >> 16) : 0u;
                    const bool match = (pass == 0) ? true : ((kv >> 8) == prefix);
                    if (valid && match) (void)__hip_atomic_fetch_add(&hs[(kv >> shift) & 255u], 1u, __ATOMIC_RELAXED, __HIP_MEMORY_SCOPE_WORKGROUP); } }
            } else {
#pragma unroll
                for (int j = 0; j < 64; ++j) { if (256 * j < n) { const unsigned kv = kreg[j]; const bool valid = ((ltid + 256 * j) < n) && (kv >= lbound);
                    const bool match = (pass == 0) ? true : ((kv >> 8) == prefix);
                    if (valid && match) (void)__hip_atomic_fetch_add(&hs[(kv >> shift) & 255u], 1u, __ATOMIC_RELAXED, __HIP_MEMORY_SCOPE_WORKGROUP); } }
            }
            __syncthreads();
            if (lw == 0) {
                const unsigned c0 = hs[4 * F.lane], c1 = hs[4 * F.lane + 1], c2 = hs[4 * F.lane + 2], c3 = hs[4 * F.lane + 3];
                const unsigned tot = c0 + c1 + c2 + c3; unsigned pre = tot;
                pre += dppu<0x111, 0xF>(0u, pre); pre += dppu<0x112, 0xF>(0u, pre); pre += dppu<0x114, 0xF>(0u, pre); pre += dppu<0x118, 0xF>(0u, pre);
                pre += dppu<0x142, 0xA>(0u, pre); pre += dppu<0x143, 0xC>(0u, pre);
                const unsigned total = (unsigned)__builtin_amdgcn_readlane((int)pre, 63); const unsigned suf = total - pre + tot;
                unsigned above = suf - tot;
                if (above < k && k <= suf) {
                    int bin;
                    if (above + c3 >= k) { bin = 3; } else { above += c3; if (above + c2 >= k) { bin = 2; } else { above += c2; if (above + c1 >= k) { bin = 1; } else { above += c1; bin = 0; } } }
                    res[grp * 2 + 0] = (unsigned)(4 * F.lane + bin); res[grp * 2 + 1] = k - above;
                }
            }
            __syncthreads();
            prefix = (prefix << 8) | res[grp * 2 + 0]; k = res[grp * 2 + 1];
        }
        const unsigned tau = prefix; const int krem = (int)k;
#define MBCNT(m_) ((int)__builtin_amdgcn_mbcnt_hi((unsigned)((m_) >> 32), __builtin_amdgcn_mbcnt_lo((unsigned)(m_), 0u)))
        int cgW = 0, ceW = 0;
        if (fast) {
#pragma unroll
            for (int i = 0; i < 8; ++i) { if (64 * i < ccnt) { const int c_ = F.lane + 64 * i; const bool valid = c_ < ccnt; const unsigned kv = valid ? (seg[c_] >> 16) : 0u;
                cgW += __popcll(__ballot(valid && kv > tau)); ceW += __popcll(__ballot(valid && kv == tau)); } }
        } else {
#pragma unroll
            for (int j = 0; j < 64; ++j) { if (256 * j < n) { const bool valid = (ltid + 256 * j) < n; const unsigned kv = kreg[j];
                cgW += __popcll(__ballot(valid && kv > tau)); ceW += __popcll(__ballot(valid && kv == tau)); } }
        }
        if (F.lane == 0) { wtot[F.wave * 2] = cgW; wtot[F.wave * 2 + 1] = ceW; }
        __syncthreads();
        int og = 0, oe = 0, totg = 0;
        for (int w = 0; w < 4; ++w) { const int a = wtot[(grp * 4 + w) * 2], e = wtot[(grp * 4 + w) * 2 + 1]; if (w < lw) { og += a; oe += e; } totg += a; }
        LAS unsigned short* sel = (LAS unsigned short*)(F.lds + 151552) + grp * 256;
        if (fast) {
#pragma unroll
            for (int i = 0; i < 8; ++i) { if (64 * i < ccnt) { const int c_ = F.lane + 64 * i; const bool valid = c_ < ccnt; const unsigned pk = valid ? seg[c_] : 0u; const unsigned kv = pk >> 16;
                const bool gt = valid && kv > tau, eq = valid && kv == tau; const unsigned long long mg = __ballot(gt), me = __ballot(eq);
                const int pg = og + MBCNT(mg), pe = oe + MBCNT(me);
                if (gt) sel[pg] = (unsigned short)(pk & 0xffffu); else if (eq && pe < krem) sel[totg + pe] = (unsigned short)(pk & 0xffffu);
                og += __popcll(mg); oe += __popcll(me); } }
        } else {
#pragma unroll
            for (int j = 0; j < 64; ++j) { if (256 * j < n) { const int i = ltid + 256 * j; const bool valid = i < n; const unsigned kv = kreg[j];
                const bool gt = valid && kv > tau, eq = valid && kv == tau; const unsigned long long mg = __ballot(gt), me = __ballot(eq);
                const int pg = og + MBCNT(mg), pe = oe + MBCNT(me);
                if (gt) sel[pg] = (unsigned short)i; else if (eq && pe < krem) sel[totg + pe] = (unsigned short)i;
                og += __popcll(mg); oe += __popcll(me); } }
        }
#undef MBCNT
        if (ltid == 0) CNT[t0 + tok] = (n < 256 ? n : 256);
        __syncthreads();
        if (ltid < 128) { int lt2 = ltid; asm volatile("" : "+v"(lt2));
            ((unsigned*)SEL)[(size_t)(t0 + 2 * rd + grp) * 128 + lt2] = ((const LAS unsigned*)(F.lds + 151552))[grp * 128 + lt2]; }
        }
    }
}

__device__ __forceinline__ float sum8_dpp(float v) { v += dppf<0xB1, 0xF>(v); v += dppf<0x4E, 0xF>(v); v += dppf<0x141, 0xF>(v); return v; }
__device__ __forceinline__ void ph_dsa_attn(const Args& A, Frame& F, const XInfo X) {
    const bf16* Z = (const bf16*)(A.ws + WS_Z); const unsigned short* SEL = (const unsigned short*)(A.ws + WS_LA); const int* CNT = (const int*)(A.ws + WS_CNT);
    const unsigned char* K8 = A.ws + WS_BIG + 264 * MiB; const unsigned char* V8 = A.ws + WS_BIG + 280 * MiB; bf16* Y = (bf16*)(A.ws + WS_HY);
    LAS int* IDX = (LAS int*)(F.lds + F.wave * 5120);
    LAS float* SCR = (LAS float*)(F.lds + F.wave * 5120 + 1024);
    const int g8 = F.lane >> 3, c8 = F.lane & 7;
    for (int sl = X.rx; sl < 8; sl += X.nx) {
        const int b = sl >> 2, kvh = sl & 3;
        const unsigned char* kb = K8 + (size_t)sl * SEQ * 128 + 16 * c8; const unsigned char* vb = V8 + (size_t)sl * SEQ * 128 + 16 * c8;
        const int l15 = F.lane & 15, g4 = F.lane >> 4;
        int pf_n = 0; unsigned pf_sel[4] = {0u, 0u, 0u, 0u}; u32x4 pf_qa[2], pf_qb[2];
#pragma unroll
        for (int c = 0; c < 2; ++c) { pf_qa[c] = (u32x4){0u, 0u, 0u, 0u}; pf_qb[c] = (u32x4){0u, 0u, 0u, 0u}; }
#define AT_LOAD(sq_) do { const int t_ = b * SEQ + (sq_); pf_n = CNT[t_]; \
            _Pragma("unroll") for (int m = 0; m < 4; ++m) pf_sel[m] = (unsigned)SEL[(size_t)t_ * 256 + F.lane + 64 * m]; \
            if (l15 < 4) { _Pragma("unroll") for (int c = 0; c < 2; ++c) { const bf16* qp = Z + (size_t)t_ * OD_NP + (kvh * 4 + l15) * 128 + 64 * c + 16 * g4; pf_qa[c] = *(const u32x4*)qp; pf_qb[c] = *(const u32x4*)(qp + 8); } } } while (0)
        { const int sq0 = X.rank * NWAVES + F.wave; if (sq0 < SEQ) AT_LOAD(sq0); }
        for (int sq = X.rank * NWAVES + F.wave; sq < SEQ; sq += X.nloc * NWAVES) {
            const int t = b * SEQ + sq; const int n = pf_n;
            const unsigned csel[4] = {pf_sel[0], pf_sel[1], pf_sel[2], pf_sel[3]}; const u32x4 cqa[2] = {pf_qa[0], pf_qa[1]}, cqb[2] = {pf_qb[0], pf_qb[1]};
            { const int sqn = sq + X.nloc * NWAVES; if (sqn < SEQ) AT_LOAD(sqn); }
            long bq[4];
#pragma unroll
            for (int c = 0; c < 2; ++c) {
                float f[16];
#pragma unroll
                for (int e = 0; e < 16; ++e) f[e] = 0.f;
                if (l15 < 4) { const u32x4 a = cqa[c], b2 = cqb[c];
                    const unsigned aw[8] = {a.x, a.y, a.z, a.w, b2.x, b2.y, b2.z, b2.w};
#pragma unroll
                    for (int q = 0; q < 8; ++q) { f[2 * q] = lo2f(aw[q]) * 16.0f; f[2 * q + 1] = hi2f(aw[q]) * 16.0f; } }
#pragma unroll
                for (int hf = 0; hf < 2; ++hf) {
                    int lo = __builtin_amdgcn_cvt_pk_fp8_f32(f[8 * hf + 0], f[8 * hf + 1], 0, false); lo = __builtin_amdgcn_cvt_pk_fp8_f32(f[8 * hf + 2], f[8 * hf + 3], lo, true);
                    int hi = __builtin_amdgcn_cvt_pk_fp8_f32(f[8 * hf + 4], f[8 * hf + 5], 0, false); hi = __builtin_amdgcn_cvt_pk_fp8_f32(f[8 * hf + 6], f[8 * hf + 7], hi, true);
                    bq[2 * c + hf] = (long)(((unsigned long long)(unsigned)hi << 32) | (unsigned long long)(unsigned)lo); }
            }
#pragma unroll
            for (int m = 0; m < 4; ++m) { const int jj = F.lane + 64 * m; IDX[jj] = (jj < n) ? (int)csel[m] : 0; }
            asm volatile("s_waitcnt lgkmcnt(0)" ::: "memory"); __builtin_amdgcn_wave_barrier();
            {
                const unsigned char* kq = K8 + (size_t)sl * SEQ * 128 + 16 * g4;
#pragma unroll 1
                for (int tl0 = 0; tl0 < 16; tl0 += 4) {
                    u32x4 k0[4], k1[4];
#pragma unroll
                    for (int u = 0; u < 4; ++u) { const int id = IDX[(tl0 + u) * 16 + l15]; const unsigned char* kr = kq + (size_t)id * 128; k0[u] = *(const u32x4*)kr; k1[u] = *(const u32x4*)(kr + 64); }
#pragma unroll
                    for (int u = 0; u < 4; ++u) {
                        f32x4 acc = {0.f, 0.f, 0.f, 0.f};
                        acc = __builtin_amdgcn_mfma_f32_16x16x32_fp8_fp8((long)(((unsigned long long)k0[u].y << 32) | k0[u].x), bq[0], acc, 0, 0, 0);
                        acc = __builtin_amdgcn_mfma_f32_16x16x32_fp8_fp8((long)(((unsigned long long)k0[u].w << 32) | k0[u].z), bq[1], acc, 0, 0, 0);
                        acc = __builtin_amdgcn_mfma_f32_16x16x32_fp8_fp8((long)(((unsigned long long)k1[u].y << 32) | k1[u].x), bq[2], acc, 0, 0, 0);
                        acc = __builtin_amdgcn_mfma_f32_16x16x32_fp8_fp8((long)(((unsigned long long)k1[u].w << 32) | k1[u].z), bq[3], acc, 0, 0, 0);
                        if (l15 < 4) {
#pragma unroll
                            for (int rg = 0; rg < 4; ++rg) SCR[((tl0 + u) * 16 + 4 * g4 + rg) * 4 + l15] = acc[rg] * 3.452669831e-4f; }
                    }
                }
            }
            asm volatile("s_waitcnt lgkmcnt(0)" ::: "memory"); __builtin_amdgcn_wave_barrier();
            float sclh[4], offh[4];
            {
                f32x4 sv[4]; unsigned pqb[4][4];
#pragma unroll
                for (int m = 0; m < 4; ++m) sv[m] = *(const LAS f32x4*)(SCR + (F.lane + 64 * m) * 4);
#pragma unroll
                for (int g = 0; g < 4; ++g) {
                    float mx = -INFINITY;
#pragma unroll
                    for (int m = 0; m < 4; ++m) { const bool val = (F.lane + 64 * m) < n; sv[m][g] = val ? sv[m][g] : -INFINITY; mx = fmaxf(mx, sv[m][g]); }
                    mx = wmax(mx); float sm = 0.f, sq = 0.f;
#pragma unroll
                    for (int m = 0; m < 4; ++m) { const bool val = (F.lane + 64 * m) < n; const float ex = val ? expf(sv[m][g] - mx) : 0.f; sm += ex;
                        const float pf = rintf(255.0f * ex); sq += pf; pqb[m][g] = (unsigned)pf; }
                    sclh[g] = 0.0625f / (255.0f * wsum(sm)); offh[g] = 128.0f * wsum(sq);
                }
                asm volatile("s_waitcnt lgkmcnt(0)" ::: "memory"); __builtin_amdgcn_wave_barrier();
#pragma unroll
                for (int m = 0; m < 4; ++m) { const int jj = F.lane + 64 * m;
#pragma unroll
                    for (int g = 0; g < 4; ++g) ((LAS unsigned char*)SCR)[(jj >> 2) * 16 + g * 4 + (jj & 3)] = (unsigned char)pqb[m][g]; }
            }
            asm volatile("s_waitcnt lgkmcnt(0)" ::: "memory"); __builtin_amdgcn_wave_barrier();
            unsigned acc[4][16];
#pragma unroll
            for (int g = 0; g < 4; ++g)
#pragma unroll
                for (int j = 0; j < 16; ++j) acc[g][j] = 0u;
#pragma unroll 1
            for (int ib = 0; ib < 8; ib += 2) {
                u32x4 vd[2][4], pq4[2];
#pragma unroll
                for (int h = 0; h < 2; ++h) { pq4[h] = *(const LAS u32x4*)((const LAS unsigned char*)SCR + (8 * (ib + h) + g8) * 16);
#pragma unroll
                    for (int u = 0; u < 4; ++u) { const int id = IDX[32 * (ib + h) + 4 * g8 + u]; vd[h][u] = *(const u32x4*)(vb + (size_t)id * 128); } }
#pragma unroll
                for (int h = 0; h < 2; ++h)
#pragma unroll
                    for (int q = 0; q < 4; ++q) { const unsigned A_ = vd[h][0][q], B_ = vd[h][1][q], C_ = vd[h][2][q], D_ = vd[h][3][q];
                        const unsigned ablo = __builtin_amdgcn_perm(B_, A_, 0x05010400u), abhi = __builtin_amdgcn_perm(B_, A_, 0x07030602u);
                        const unsigned cdlo = __builtin_amdgcn_perm(D_, C_, 0x05010400u), cdhi = __builtin_amdgcn_perm(D_, C_, 0x07030602u);
                        const unsigned t0 = __builtin_amdgcn_perm(cdlo, ablo, 0x05040100u), t1 = __builtin_amdgcn_perm(cdlo, ablo, 0x07060302u);
                        const unsigned t2 = __builtin_amdgcn_perm(cdhi, abhi, 0x05040100u), t3 = __builtin_amdgcn_perm(cdhi, abhi, 0x07060302u);
#pragma unroll
                        for (int g = 0; g < 4; ++g) { const unsigned pg = pq4[h][g];
                            acc[g][4 * q + 0] = __builtin_amdgcn_udot4(t0, pg, acc[g][4 * q + 0], false); acc[g][4 * q + 1] = __builtin_amdgcn_udot4(t1, pg, acc[g][4 * q + 1], false);
                            acc[g][4 * q + 2] = __builtin_amdgcn_udot4(t2, pg, acc[g][4 * q + 2], false); acc[g][4 * q + 3] = __builtin_amdgcn_udot4(t3, pg, acc[g][4 * q + 3], false); } }
            }
            f32x2 mine[8];
            { const int hr = F.lane >> 4; const float scl = (hr == 0) ? sclh[0] : ((hr == 1) ? sclh[1] : ((hr == 2) ? sclh[2] : sclh[3])), off = (hr == 0) ? offh[0] : ((hr == 1) ? offh[1] : ((hr == 2) ? offh[2] : offh[3]));
#pragma unroll
              for (int q = 0; q < 8; ++q) {
                float x[4][2];
#pragma unroll
                for (int g = 0; g < 4; ++g) { float a0 = (float)acc[g][2 * q], a1 = (float)acc[g][2 * q + 1];
                    a0 += dppf<0x128, 0xF>(a0); a1 += dppf<0x128, 0xF>(a1);
                    x[g][0] = a0; x[g][1] = a1; }
                mine[q].x = (rsum4(x[0][0], x[1][0], x[2][0], x[3][0]) - off) * scl; mine[q].y = (rsum4(x[0][1], x[1][1], x[2][1], x[3][1]) - off) * scl;
              } }
            if ((F.lane & 8) == 0) { u32x4 w0, w1; const int hrow = F.lane >> 4;
                w0.x = pk2(mine[0].x, mine[0].y); w0.y = pk2(mine[1].x, mine[1].y); w0.z = pk2(mine[2].x, mine[2].y); w0.w = pk2(mine[3].x, mine[3].y);
                w1.x = pk2(mine[4].x, mine[4].y); w1.y = pk2(mine[5].x, mine[5].y); w1.z = pk2(mine[6].x, mine[6].y); w1.w = pk2(mine[7].x, mine[7].y);
                bf16* yp = Y + (size_t)t * DM + (kvh * 4 + hrow) * 128 + 16 * c8; *(u32x4*)yp = w0; *(u32x4*)(yp + 8) = w1; }
            asm volatile("s_waitcnt lgkmcnt(0)" ::: "memory"); __builtin_amdgcn_wave_barrier();
        }
    }
}

__global__ void __launch_bounds__(NTHREADS, 2) mk_fwd(Args args) {
    extern __shared__ __attribute__((aligned(16))) unsigned char lds[];
    Frame F;
    F.lds = (LAS unsigned char*)lds;
    volatile LAS unsigned* MISC = (volatile LAS unsigned*)(F.lds + MISC_OFF);
    F.tid = threadIdx.x; F.lane = F.tid & 63; F.wave = __builtin_amdgcn_readfirstlane(F.tid >> 6);
    F.bx = blockIdx.x; F.G = gridDim.x; F.gw = F.bx * NWAVES + F.wave; F.ngw = F.G * NWAVES;
    if (F.tid < 64) MISC[F.tid] = 0u;
    __syncthreads();
    unsigned char* ws = args.ws;
    XcdBarrier bar = xcd_barrier_post((unsigned*)(ws + WS_CTL) + CW_BAR, MISC + 8);
    if (F.tid == 0) { MISC[16] = xb_add((unsigned*)(ws + WS_CTL) + CW_XRANK + 64 * bar.x, 1u); }
    const int lo = args.ph_lo, hi = args.ph_hi;
#define IN(k) (lo <= (k) && (k) < hi)
#define SEAM(k) do { if (IN((k) + 1)) xcd_barrier(bar); } while (0)
#define GEMM_BF16(Aptr, Bptr, Nn, Kk, Optr, ldo) do { pg8::Gemm g{(const pg8::bf16_t*)(Aptr), (const pg8::bf16_t*)(Bptr), TOK, (Nn), (Kk)}; pg8::StaticOrder S; S.init(TOK, (Nn), F.G, F.bx); \
        pg8::EpiBf16<0> E{(pg8::bf16_t*)(Optr), (ldo), nullptr, 0, 0}; pg8::gemm_phase<pg8::EpiBf16<0>, pg8::StaticOrder, false>(F.lds, g, S, E, nullptr); } while (0)

#ifndef PROBE_MASK
#define PROBE_MASK 0
#endif
#define PRB(bit, stmt) do { if (PROBE_MASK & (1 << (bit))) { stmt; xcd_barrier(bar); } } while (0)
    if (IN(0)) { PRB(14, ph_prologue(args, F)); ph_prologue(args, F); SEAM(0); }
    if (IN(1)) { ph_mod_x(args, F); SEAM(1); }
    if (F.tid == 0) {
        unsigned* cb = (unsigned*)(ws + WS_CTL) + CW_BAR; unsigned nloc = 1u, rx = 0u, nx = 0u;
        for (unsigned j = 0; j < 16; ++j) { const unsigned c = xb_ld(&cb[XB_XCNT(j)]); if (c > 0u) { if (j < bar.x) ++rx; ++nx; } if (j == bar.x) nloc = c > 0u ? c : 1u; }
        if (nx == 0u) nx = 1u;
        MISC[17] = nloc; MISC[18] = rx; MISC[19] = nx; }
    __syncthreads();
    const XInfo XI = xcc_info(MISC);
    if (IN(2)) { PRB(8, GEMM_BF16(ws + WS_HY, ws + WS_WINE, EV_NP, 2048, ws + WS_Z, EV_NP)); GEMM_BF16(ws + WS_HY, ws + WS_WINE, EV_NP, 2048, ws + WS_Z, EV_NP); SEAM(2); }
    if (IN(3)) { ph_even_post(args, F); SEAM(3); }
    if (IN(4)) { pg8::Gemm g{(const pg8::bf16_t*)(ws + WS_LA), (const pg8::bf16_t*)(ws + WS_WL), TOK, 3072, 512}; pg8::StaticOrder S; S.init(TOK, 3072, F.G, F.bx);
                 EpiLora E{(pg8::bf16_t*)(ws + WS_Z) + 1280, EV_NP, (const float*)args.in[7], (const float*)args.in[9]};
                 pg8::gemm_phase<EpiLora, pg8::StaticOrder, false>(F.lds, g, S, E, nullptr); SEAM(4); }
    if (IN(5)) { PRB(9, ph_scan_prep(args, F)); ph_scan_prep(args, F); xcd_barrier(bar); }
    if (IN(7)) { PRB(15, scan_mfma_rows(args, F)); ph_swa_mfma(args, F); scan_mfma_rows(args, F); SEAM(7); }
    if (IN(8)) { PRB(10, ph_rwkv_finish(args, F)); ph_rwkv_finish(args, F); SEAM(8); }
    if (IN(9)) { GEMM_BF16(ws + WS_HY, ws + WS_WOUTE, 2048, 2048, ws + WS_Z, 2048); SEAM(9); }
    if (IN(10)) { PRB(11, ph_ln_mixer(args, F, 0)); ph_ln_mixer(args, F, 0); SEAM(10); }
    if (IN(11)) { GEMM_BF16(ws + WS_HY, ws + WS_WQ0, 2048, 2048, ws + WS_Z, 2048); SEAM(11); }
    if (IN(12)) { PRB(4, ph_peer_select(args, F, 0)); ph_peer_select(args, F, 0); SEAM(12); }
    if (IN(13)) { PRB(12, ph_peer_u(args, F, XI)); ph_peer_u(args, F, XI); xcd_barrier(bar); ph_peer_act(args, F); xcd_barrier(bar); PRB(13, ph_peer_v(args, F, XI)); ph_peer_v(args, F, XI); xcd_barrier(bar); ph_peer_ln(args, F, 0); SEAM(13); }
    if (IN(14)) { GEMM_BF16(ws + WS_HY, ws + WS_WINO, OD_NP, 2048, ws + WS_Z, OD_NP); SEAM(14); }
    if (IN(15)) { ph_odd_post(args, F); SEAM(15); }
    if (IN(16)) { PRB(2, ph_dsa_select(args, F, 1)); PRB(6, ph_dsa_select(args, F, 2)); PRB(7, ph_dsa_select(args, F, 0)); ph_dsa_select(args, F); SEAM(16); }
    if (IN(17)) { ph_dsa_attn(args, F, XI); SEAM(17); }
    if (IN(18)) { GEMM_BF16(ws + WS_HY, ws + WS_WOUTO, 2048, 2048, ws + WS_Z, 2048); SEAM(18); }
    if (IN(19)) { ph_ln_mixer(args, F, 1); SEAM(19); }
    if (IN(20)) { GEMM_BF16(ws + WS_HY, ws + WS_WQ1, 2048, 2048, ws + WS_Z, 2048); SEAM(20); }
    if (IN(21)) { PRB(4, ph_peer_select(args, F, 1)); ph_peer_select(args, F, 1); SEAM(21); }
    if (IN(22)) { ph_peer_u(args, F, XI); xcd_barrier(bar); ph_peer_act(args, F); xcd_barrier(bar); ph_peer_v(args, F, XI); xcd_barrier(bar); ph_peer_ln(args, F, 1); }
#undef IN
#undef SEAM
#undef GEMM_BF16
}

#ifndef MK_SPLIT
#define MK_SPLIT 0
#endif
extern "C" void kernel_launch(void* const* d_in, const int* in_sizes, int n_in, void* d_out, int out_size, void* d_ws, size_t ws_size, hipStream_t stream) {
    static int grid = 0;
    if (grid == 0) {
        int dev = 0, cus = 0;
        if (n_in != 27 || out_size != TOK * DM || ws_size < WS_END) { fprintf(stderr, "kernel_launch: unexpected shapes (n_in %d out %d ws %zu)\n", n_in, out_size, ws_size); grid = -1; return; }
        if (hipGetDevice(&dev) != hipSuccess || hipDeviceGetAttribute(&cus, hipDeviceAttributeMultiprocessorCount, dev) != hipSuccess) { grid = -1; return; }
        if (hipFuncSetAttribute((const void*)mk_fwd, hipFuncAttributeMaxDynamicSharedMemorySize, LDS_BYTES) != hipSuccess) { fprintf(stderr, "kernel_launch: hipFuncSetAttribute failed\n"); grid = -1; return; }
        int per_cu = 0;
        if (hipOccupancyMaxActiveBlocksPerMultiprocessor(&per_cu, (const void*)mk_fwd, NTHREADS, LDS_BYTES) != hipSuccess || per_cu < 1) fprintf(stderr, "kernel_launch: occupancy query says %d\n", per_cu);
        (void)hipGetLastError();
        grid = cus;
    }
    if (grid < 0) return;
    (void)hipMemsetAsync((char*)d_ws + WS_CTL, 0, CTL_ZERO_BYTES, stream);
    Args a{};
    for (int i = 0; i < 27; ++i) a.in[i] = d_in[i];
    a.out = (float*)d_out; a.ws = (unsigned char*)d_ws;
#if MK_SPLIT
    for (int p = 0; p < 23; ++p) { a.ph_lo = p; a.ph_hi = p + 1; hipLaunchKernelGGL(mk_fwd, dim3(grid), dim3(NTHREADS), LDS_BYTES, stream, a); }
#else
    a.ph_lo = 0; a.ph_hi = 23;
    hipLaunchKernelGGL(mk_fwd, dim3(grid), dim3(NTHREADS), LDS_BYTES, stream, a);
#endif
}
```

```cpp
#include <hip/hip_runtime.h>
#include <cstdio>
#include <cstdint>
namespace pg8 {
#define PG8_LAS __attribute__((address_space(3)))
typedef unsigned short bf16_t;
typedef short bf16x8 __attribute__((ext_vector_type(8)));
typedef float f32x4 __attribute__((ext_vector_type(4)));
typedef unsigned u32x4 __attribute__((ext_vector_type(4)));
constexpr int BM = 256, BK = 64, HALF = 128, HTB = HALF * BK * 2  , STAGE_BYTES = 8 * HTB, NXCD = 8, WGM = 8;

__host__ __device__ __forceinline__ int lds_byte(int r, int c) { const int st = (r >> 4) * 2 + (c >> 5), rr = r & 15, cc = c & 31, ob = rr * 64 + cc * 2; return st * 1024 + (ob ^ (((ob >> 9) & 1) << 5)); }
__host__ __device__ __forceinline__ void stage_rc(int b, int& R, int& C) { const int st = b / 1024, sb = b % 1024, swz = sb ^ (((sb >> 9) & 1) << 5); R = (st >> 1) * 16 + swz / 64; C = (st & 1) * 32 + (swz % 64) / 2; }
__host__ __device__ __forceinline__ int perm32(int rho) { const int n = rho >> 4, i = rho & 15; return 8 * (i >> 2) + 4 * n + (i & 3); }

struct Unit { int pm, pn; };
struct Gemm { const bf16_t* A; const bf16_t* Bt; int M, N, K; };

struct StaticOrder {
    int nM, nN, nwg, G, c;
    __host__ __device__ void init(int M, int N, int G_, int c_) { nM = M / BM; nN = N / BM; nwg = nM * nN; G = G_; c = c_; }
    __host__ __device__ bool next(int i, Unit& u) const {
        const long L = (long)i * G + c; if (L >= nwg) return false;
        int wgid = (int)L; { const int q = nwg / NXCD, r = nwg % NXCD, xcd = wgid % NXCD, off = wgid / NXCD; wgid = (xcd < r ? xcd * (q + 1) : r * (q + 1) + (xcd - r) * q) + off; }
        const int nig = WGM * nN, gid = wgid / nig, fm = gid * WGM, gsz = (nM - fm) < WGM ? (nM - fm) : WGM;
        u.pm = fm + ((wgid % nig) % gsz); u.pn = (wgid % nig) / gsz; return true;
    }
    __device__ __forceinline__ void a_ready(const Unit&) const {}
    __device__ __forceinline__ void done(const Unit&) const {}
};
struct CountedOrder : StaticOrder {
    const unsigned* ready; unsigned need; unsigned* tmo;
    __device__ __forceinline__ void a_ready(const Unit& u) const {
        if (threadIdx.x < 64) {
            const unsigned long long t0 = __builtin_amdgcn_s_memrealtime(); unsigned polls = 0;
            while ((unsigned)__builtin_amdgcn_readfirstlane(__hip_atomic_load(ready + 64 * u.pm, __ATOMIC_RELAXED, __HIP_MEMORY_SCOPE_AGENT)) < need) {
                if ((++polls & 255u) == 0u && __builtin_amdgcn_readfirstlane(__hip_atomic_load(tmo, __ATOMIC_RELAXED, __HIP_MEMORY_SCOPE_AGENT)) != 0u) break;
                if (__builtin_amdgcn_s_memrealtime() - t0 > 2000000ull) {
                    if (threadIdx.x == 0) { unsigned expect = 0u; __hip_atomic_compare_exchange_strong(tmo + 1, &expect, 0x600u | (unsigned)(u.pm & 0xff), __ATOMIC_RELAXED, __ATOMIC_RELAXED, __HIP_MEMORY_SCOPE_AGENT); __hip_atomic_store(tmo, 1u, __ATOMIC_RELAXED, __HIP_MEMORY_SCOPE_AGENT); }
                    break; }
                __builtin_amdgcn_s_sleep(2); }
            __builtin_amdgcn_fence(__ATOMIC_ACQUIRE, "agent");
            asm volatile("s_waitcnt vmcnt(0)" ::: "memory");
        }
#if !defined(BROKEN_HOOK_NO_BARRIER)
        asm volatile("" ::: "memory"); __builtin_amdgcn_s_barrier(); asm volatile("" ::: "memory");
#endif
    }
};

__device__ __forceinline__ unsigned cvt_pk_bf16(float lo, float hi) { unsigned r; asm volatile("v_cvt_pk_bf16_f32 %0, %1, %2" : "=v"(r) : "v"(lo), "v"(hi)); return r; }
typedef float f32x2 __attribute__((ext_vector_type(2)));
__device__ __forceinline__ f32x2 gelu_pk(f32x2 v) {
    const f32x2 av = __builtin_elementwise_abs(v), d = av * 0.2316418882f + 1.0f;
    f32x2 t; t.x = __builtin_amdgcn_rcpf(d.x); t.y = __builtin_amdgcn_rcpf(d.y);
    f32x2 q = t * 0.5307027145f + (-0.7265760135f); q = q * t + 0.7107068705f; q = q * t + (-0.142248368f); q = q * t + 0.127414796f; q = q * t;
    const f32x2 s = (v * v) * (-0.72134752044f);
    f32x2 e; e.x = __builtin_amdgcn_exp2f(s.x); e.y = __builtin_amdgcn_exp2f(s.y);
    const f32x2 m = v * (q * e), r = v - m;
    f32x2 o; o.x = v.x < 0.f ? m.x : r.x; o.y = v.y < 0.f ? m.y : r.y; return o;
}

struct EpiF32 {
    static constexpr bool PERM = false, AFTER_DRAIN = false;
    float* C; int ldc; const float* bias;
    __device__ __forceinline__ void operator()(const f32x4 (&acc)[2][2][4][2], const Unit& u, int wr, int wc, int fr, int fq) const {
        const int row0 = u.pm * BM + wr * 64 + fr, col0 = u.pn * BM + wc * 32 + 4 * fq;
        f32x4 bv[2][2];
#pragma unroll
        for (int bj = 0; bj < 2; ++bj)
#pragma unroll
            for (int n = 0; n < 2; ++n) bv[bj][n] = bias ? *(const f32x4*)(bias + col0 + bj * HALF + n * 16) : (f32x4){0.f, 0.f, 0.f, 0.f};
#pragma unroll
        for (int ai = 0; ai < 2; ++ai)
#pragma unroll
            for (int m = 0; m < 4; ++m) { float* rowp = C + (size_t)(row0 + ai * HALF + m * 16) * ldc + col0;
#pragma unroll
                for (int bj = 0; bj < 2; ++bj)
#pragma unroll
                    for (int n = 0; n < 2; ++n) *(f32x4*)(rowp + bj * HALF + n * 16) = acc[ai][bj][m][n] + bv[bj][n]; }
    }
};
template <int ACT  > struct EpiBf16 {
    static constexpr bool PERM = true, AFTER_DRAIN = false;
    bf16_t* O; int ldc; const float* bias; int split_cols; size_t split_stride;
    __device__ __forceinline__ void operator()(const f32x4 (&acc)[2][2][4][2], const Unit& u, int wr, int wc, int fr, int fq) const {
        const int row0 = u.pm * BM + wr * 64 + fr; int colt = u.pn * BM; bf16_t* base = O;
        if (split_cols) { const int t = colt / split_cols; base += (size_t)t * split_stride; colt -= t * split_cols; }
        const int col0 = colt + wc * 32 + 8 * fq, bcol0 = u.pn * BM + wc * 32 + 8 * fq;
        f32x4 bv[2][2];
#pragma unroll
        for (int bj = 0; bj < 2; ++bj)
#pragma unroll
            for (int n = 0; n < 2; ++n) bv[bj][n] = bias ? *(const f32x4*)(bias + bcol0 + bj * HALF + 4 * n) : (f32x4){0.f, 0.f, 0.f, 0.f};
#pragma unroll
        for (int ai = 0; ai < 2; ++ai)
#pragma unroll
            for (int m = 0; m < 4; ++m) { bf16_t* rowp = base + (size_t)(row0 + ai * HALF + m * 16) * ldc + col0;
#pragma unroll
                for (int bj = 0; bj < 2; ++bj) { f32x4 v0 = acc[ai][bj][m][0] + bv[bj][0], v1 = acc[ai][bj][m][1] + bv[bj][1];
                    if (ACT == 1) { f32x2 a = gelu_pk((f32x2){v0[0], v0[1]}), b = gelu_pk((f32x2){v0[2], v0[3]}), c = gelu_pk((f32x2){v1[0], v1[1]}), d = gelu_pk((f32x2){v1[2], v1[3]});
                        v0 = (f32x4){a.x, a.y, b.x, b.y}; v1 = (f32x4){c.x, c.y, d.x, d.y}; }
                    if (ACT == 2) {
#pragma unroll
                        for (int j = 0; j < 4; ++j) { v0[j] = 0.5f * v0[j] * (1.0f + erff(v0[j] * 0.70710678f)); v1[j] = 0.5f * v1[j] * (1.0f + erff(v1[j] * 0.70710678f)); } }
                    u32x4 w; w.x = cvt_pk_bf16(v0[0], v0[1]); w.y = cvt_pk_bf16(v0[2], v0[3]); w.z = cvt_pk_bf16(v1[0], v1[1]); w.w = cvt_pk_bf16(v1[2], v1[3]);
                    *(u32x4*)(rowp + bj * HALF) = w; } }
    }
};

struct PanelStats {
    unsigned* xbuf;
    unsigned* cnt;
    unsigned* tmo;
    int ntn; float eps;
    unsigned code;
    __device__ __forceinline__ bool run(const f32x4 (&v)[2][2][4][2], const Unit& u, int wr, int wc, int fr, int fq, PG8_LAS unsigned char* lds, int wid, int lane) const {
        typedef float f32x2v __attribute__((ext_vector_type(2)));
        PG8_LAS f32x2v* P = (PG8_LAS f32x2v*)lds;
        PG8_LAS f32x2v* S = (PG8_LAS f32x2v*)(lds + 8192);
        PG8_LAS unsigned* flag = (PG8_LAS unsigned*)(lds + 8192 + 2048);
#pragma unroll
        for (int ai = 0; ai < 2; ++ai)
#pragma unroll
            for (int m = 0; m < 4; ++m) {
                float s = 0.f;
#pragma unroll
                for (int bj = 0; bj < 2; ++bj)
#pragma unroll
                    for (int n = 0; n < 2; ++n) { const f32x4 x = v[ai][bj][m][n]; s += (x[0] + x[1]) + (x[2] + x[3]); }
                s += __shfl_xor(s, 16); s += __shfl_xor(s, 32);
                const float mw = s * (1.0f / 64.0f); float q = 0.f;
#pragma unroll
                for (int bj = 0; bj < 2; ++bj)
#pragma unroll
                    for (int n = 0; n < 2; ++n) { const f32x4 d = v[ai][bj][m][n] - mw; q += (d[0] * d[0] + d[1] * d[1]) + (d[2] * d[2] + d[3] * d[3]); }
                q += __shfl_xor(q, 16); q += __shfl_xor(q, 32);
                if (fq == 0) P[(ai * HALF + wr * 64 + m * 16 + fr) * 4 + wc] = (f32x2v){mw, q};
            }
        asm volatile("s_waitcnt lgkmcnt(0)" ::: "memory"); __builtin_amdgcn_s_barrier(); asm volatile("" ::: "memory");
#if defined(BROKEN_NO_WAIT)
        if (blockIdx.x >= 64) { const long long t0 = clock64(); while (clock64() - t0 < 60000) __builtin_amdgcn_s_sleep(8); }
#endif
        const int row = wid * 32 + (lane & 31);
        if (lane < 32) {
            const f32x2v a = P[row * 4 + 0], b = P[row * 4 + 1], c = P[row * 4 + 2], d = P[row * 4 + 3];
            const float mt = (a.x + b.x + c.x + d.x) * 0.25f;
            const float da = a.x - mt, db = b.x - mt, dc = c.x - mt, dd = d.x - mt;
            const float m2 = (a.y + b.y) + (c.y + d.y) + 64.0f * ((da * da + db * db) + (dc * dc + dd * dd));
            unsigned long long* slot = (unsigned long long*)xbuf + ((size_t)(u.pm * BM + row) * 4 + u.pn);
            __hip_atomic_store(slot, ((unsigned long long)__float_as_uint(m2) << 32) | __float_as_uint(mt), __ATOMIC_RELAXED, __HIP_MEMORY_SCOPE_AGENT);
        }
        asm volatile("s_waitcnt vmcnt(0)" ::: "memory");
        if (lane == 0) __hip_atomic_fetch_add(cnt + 64 * u.pm, 1u, __ATOMIC_RELAXED, __HIP_MEMORY_SCOPE_AGENT);
        if (wid == 0) {
            bool dead = false; const unsigned long long t0 = __builtin_amdgcn_s_memrealtime(); const unsigned want = 8u * (unsigned)ntn;
            for (;;) {
#if defined(BROKEN_NO_WAIT)
                break;
#endif
                if ((unsigned)__builtin_amdgcn_readfirstlane(__hip_atomic_load(cnt + 64 * u.pm, __ATOMIC_RELAXED, __HIP_MEMORY_SCOPE_AGENT)) >= want) break;
                if (__builtin_amdgcn_s_memrealtime() - t0 > 2000000ull) {
                    if (lane == 0) { unsigned expect = 0u; __hip_atomic_compare_exchange_strong(tmo + 1, &expect, code | (unsigned)(u.pm & 0xff), __ATOMIC_RELAXED, __ATOMIC_RELAXED, __HIP_MEMORY_SCOPE_AGENT);
                                     __hip_atomic_store(tmo, 1u, __ATOMIC_RELAXED, __HIP_MEMORY_SCOPE_AGENT); }
                    dead = true; break; }
                __builtin_amdgcn_s_sleep(2);
            }
            __builtin_amdgcn_fence(__ATOMIC_ACQUIRE, "agent");
            if (lane == 0) flag[0] = dead ? 1u : 0u;
        }
        asm volatile("s_waitcnt vmcnt(0) lgkmcnt(0)" ::: "memory"); __builtin_amdgcn_s_barrier(); asm volatile("" ::: "memory");
        const bool bad = flag[0] != 0u;
        if (lane < 32) {
            const unsigned long long* slot = (const unsigned long long*)xbuf + (size_t)(u.pm * BM + row) * 4; float mt[4], m2[4]; float ms = 0.f;
#pragma unroll
            for (int t = 0; t < 4; ++t) { if (t < ntn) { const unsigned long long w = __hip_atomic_load(slot + t, __ATOMIC_RELAXED, __HIP_MEMORY_SCOPE_AGENT); mt[t] = __uint_as_float((unsigned)w); m2[t] = __uint_as_float((unsigned)(w >> 32)); } else { mt[t] = 0.f; m2[t] = 0.f; } ms += mt[t]; }
            const float mean = ms / (float)ntn; float q = 0.f;
#pragma unroll
            for (int t = 0; t < 4; ++t) if (t < ntn) { const float dm = mt[t] - mean; q += m2[t] + 256.0f * dm * dm; }
            S[row] = (f32x2v){mean, 1.0f / sqrtf(q / (256.0f * (float)ntn) + eps)};
        }
        asm volatile("s_waitcnt lgkmcnt(0)" ::: "memory"); __builtin_amdgcn_s_barrier(); asm volatile("" ::: "memory");
        return bad;
    }
};
struct EpiLnRes {
    static constexpr bool PERM = false, AFTER_DRAIN = true;
    const float* base; float* out; int ldc; const float* bias; PanelStats st; unsigned poison;
    __device__ __forceinline__ void refuse(size_t i0, size_t stride, int M, int N) const { const float q = __builtin_nanf(""); for (size_t i = i0; i < (size_t)M * N; i += stride) out[(i / N) * ldc + i % N] = q;
        if (i0 == 0) { unsigned expect = 0u; __hip_atomic_compare_exchange_strong(st.tmo + 1, &expect, 0x7f0u, __ATOMIC_RELAXED, __ATOMIC_RELAXED, __HIP_MEMORY_SCOPE_AGENT); __hip_atomic_store(st.tmo, 1u, __ATOMIC_RELAXED, __HIP_MEMORY_SCOPE_AGENT); } }
    __device__ __forceinline__ void fused(f32x4 (&acc)[2][2][4][2], const Unit& u, int wr, int wc, int fr, int fq, PG8_LAS unsigned char* lds, int wid, int lane) const {
        typedef float f32x2v __attribute__((ext_vector_type(2)));
        const PG8_LAS f32x2v* S = (const PG8_LAS f32x2v*)(lds + 8192);
        const int col0 = u.pn * BM + wc * 32 + 4 * fq;
#pragma unroll
        for (int bj = 0; bj < 2; ++bj)
#pragma unroll
            for (int n = 0; n < 2; ++n) { const f32x4 bv = bias ? *(const f32x4*)(bias + col0 + bj * HALF + n * 16) : (f32x4){0.f, 0.f, 0.f, 0.f};
#pragma unroll
                for (int ai = 0; ai < 2; ++ai)
#pragma unroll
                    for (int m = 0; m < 4; ++m) acc[ai][bj][m][n] += bv; }
        const bool bad = st.run(acc, u, wr, wc, fr, fq, lds, wid, lane) || poison != 0u;
        const float qnan = __builtin_nanf("");
#pragma unroll
        for (int ai = 0; ai < 2; ++ai)
#pragma unroll
            for (int m = 0; m < 4; ++m) { const int r = ai * HALF + wr * 64 + m * 16 + fr; const f32x2v sr = S[r]; const size_t off = (size_t)(u.pm * BM + r) * ldc + col0;
#pragma unroll
                for (int bj = 0; bj < 2; ++bj)
#pragma unroll
                    for (int n = 0; n < 2; ++n) { const f32x4 bs = *(const f32x4*)(base + off + bj * HALF + n * 16); f32x4 o = bs + (acc[ai][bj][m][n] - sr.x) * sr.y;
                        if (bad) o = (f32x4){qnan, qnan, qnan, qnan}; *(f32x4*)(out + off + bj * HALF + n * 16) = o; }
                asm volatile("" ::: "memory"); }
    }
};
struct EpiLnResLn {
    static constexpr bool PERM = false, AFTER_DRAIN = true;
    const float* base; float* out; bf16_t* xn; int ldc; const float* bias; PanelStats st1, st2; unsigned poison;
    __device__ __forceinline__ void refuse(size_t i0, size_t stride, int M, int N) const { const float q = __builtin_nanf(""); for (size_t i = i0; i < (size_t)M * N; i += stride) { const size_t o = (i / N) * ldc + i % N; out[o] = q; xn[o] = (bf16_t)0x7fc0u; }
        if (i0 == 0) { unsigned expect = 0u; __hip_atomic_compare_exchange_strong(st1.tmo + 1, &expect, 0x7f0u, __ATOMIC_RELAXED, __ATOMIC_RELAXED, __HIP_MEMORY_SCOPE_AGENT); __hip_atomic_store(st1.tmo, 1u, __ATOMIC_RELAXED, __HIP_MEMORY_SCOPE_AGENT); } }
    __device__ __forceinline__ void fused(f32x4 (&acc)[2][2][4][2], const Unit& u, int wr, int wc, int fr, int fq, PG8_LAS unsigned char* lds, int wid, int lane) const {
        typedef float f32x2v __attribute__((ext_vector_type(2))); typedef unsigned u32x2v __attribute__((ext_vector_type(2)));
        const PG8_LAS f32x2v* S = (const PG8_LAS f32x2v*)(lds + 8192);
        const int col0 = u.pn * BM + wc * 32 + 4 * fq;
#pragma unroll
        for (int bj = 0; bj < 2; ++bj)
#pragma unroll
            for (int n = 0; n < 2; ++n) { const f32x4 bv = bias ? *(const f32x4*)(bias + col0 + bj * HALF + n * 16) : (f32x4){0.f, 0.f, 0.f, 0.f};
#pragma unroll
                for (int ai = 0; ai < 2; ++ai)
#pragma unroll
                    for (int m = 0; m < 4; ++m) acc[ai][bj][m][n] += bv; }
        bool bad = st1.run(acc, u, wr, wc, fr, fq, lds, wid, lane) || poison != 0u;
        const float qnan = __builtin_nanf("");
#pragma unroll
        for (int ai = 0; ai < 2; ++ai)
#pragma unroll
            for (int m = 0; m < 4; ++m) { const int r = ai * HALF + wr * 64 + m * 16 + fr; const f32x2v sr = S[r]; const size_t off = (size_t)(u.pm * BM + r) * ldc + col0;
#pragma unroll
                for (int bj = 0; bj < 2; ++bj)
#pragma unroll
                    for (int n = 0; n < 2; ++n) { const f32x4 bs = *(const f32x4*)(base + off + bj * HALF + n * 16); acc[ai][bj][m][n] = bs + (acc[ai][bj][m][n] - sr.x) * sr.y; }
                asm volatile("" : "+v"(acc[ai][0][m][0]), "+v"(acc[ai][0][m][1]), "+v"(acc[ai][1][m][0]), "+v"(acc[ai][1][m][1]));
                if (m & 1) asm volatile("" ::: "memory"); }
        const bool bad1 = bad;
        bad = st2.run(acc, u, wr, wc, fr, fq, lds, wid, lane) || bad;
#pragma unroll
        for (int ai = 0; ai < 2; ++ai)
#pragma unroll
            for (int m = 0; m < 4; ++m) { const int r = ai * HALF + wr * 64 + m * 16 + fr; const f32x2v sr = S[r]; const size_t off = (size_t)(u.pm * BM + r) * ldc + col0;
#pragma unroll
                for (int bj = 0; bj < 2; ++bj)
#pragma unroll
                    for (int n = 0; n < 2; ++n) { const f32x4 x1 = acc[ai][bj][m][n]; *(f32x4*)(out + off + bj * HALF + n * 16) = bad1 ? (f32x4){qnan, qnan, qnan, qnan} : x1;
                        const f32x4 o = (x1 - sr.x) * sr.y; u32x2v w; w.x = cvt_pk_bf16(o[0], o[1]); w.y = cvt_pk_bf16(o[2], o[3]);
                        if (bad) { w.x = 0x7fc07fc0u; w.y = 0x7fc07fc0u; } *(u32x2v*)(xn + off + bj * HALF + n * 16) = w; }
                asm volatile("" ::: "memory"); }
    }
};

template <class Epi, class Sched, bool STAMP = false>
__device__ __forceinline__ void gemm_phase(PG8_LAS unsigned char* lds, const Gemm g, const Sched& S, const Epi& E, unsigned long long* stamps) {
    const int tid = threadIdx.x, wid = __builtin_amdgcn_readfirstlane(tid >> 6), lane = tid & 63, wr = wid >> 2, wc = wid & 3, fr = lane & 15, fq = lane >> 4;
    const int K = g.K, nt = K / BK;
    int ts_lo = 0, ts_hi = 0, nts = 0; const unsigned long long rt_entry = STAMP ? (unsigned long long)wall_clock64() : 0ull;
#define PG8_STAMP() do { if (STAMP && wid == 0 && nts < 64) { const unsigned long long _c = (unsigned long long)clock64(); \
        ts_lo = (lane == nts) ? (int)(unsigned)_c : ts_lo; ts_hi = (lane == nts) ? (int)(unsigned)(_c >> 32) : ts_hi; ++nts; } } while (0)
    PG8_STAMP();
    unsigned voffA[2], voffB[2];
#pragma unroll
    for (int i = 0; i < 2; ++i) { int R, C; stage_rc(tid * 16 + i * 8192, R, C); const int Rb = Epi::PERM ? ((R & ~31) + perm32(R & 31)) : R;
        voffA[i] = (unsigned)(R * K + C) * 2u; voffB[i] = (unsigned)(Rb * K + C) * 2u; }
    const size_t kstep = (size_t)(BK * 2);
    const size_t hstep = (size_t)HALF * K * 2;
    const size_t tstep = 2 * hstep;
    const unsigned ldsw = (unsigned)wid * 1024u;
    const int aoff = lds_byte(wr * 64 + fr, fq * 8), boff = lds_byte(wc * 32 + fr, fq * 8);
#define PG8_SA(b, h) (((b) * 2 + (h)) * HTB)
#define PG8_SB(b, h) ((4 + (b) * 2 + (h)) * HTB)
#define PG8_STAGE(bufoff, gbase, voff) do { _Pragma("unroll") for (int _i = 0; _i < 2; ++_i) \
        __builtin_amdgcn_global_load_lds((const unsigned*)((const char*)(gbase) + (voff)[_i]), (PG8_LAS unsigned*)(lds + (bufoff) + ldsw + _i * 8192), 16, 0, 0); } while (0)
#define PG8_LDA(dst, b, h) do { _Pragma("unroll") for (int m = 0; m < 4; ++m) _Pragma("unroll") for (int k = 0; k < 2; ++k) dst[m][k] = *(const PG8_LAS bf16x8*)(lds + PG8_SA(b, h) + aoff + m * 2048 + k * 1024); } while (0)
#define PG8_LDB(dst, b, h) do { _Pragma("unroll") for (int n = 0; n < 2; ++n) _Pragma("unroll") for (int k = 0; k < 2; ++k) dst[n][k] = *(const PG8_LAS bf16x8*)(lds + PG8_SB(b, h) + boff + n * 2048 + k * 1024); } while (0)
#define PG8_MMA(ai, bj, At, Bt) do { __builtin_amdgcn_s_setprio(1); _Pragma("unroll") for (int m = 0; m < 4; ++m) _Pragma("unroll") for (int n = 0; n < 2; ++n) _Pragma("unroll") for (int k = 0; k < 2; ++k) \
        acc[ai][bj][m][n] = __builtin_amdgcn_mfma_f32_16x16x32_bf16(Bt[n][k], At[m][k], acc[ai][bj][m][n], 0, 0, 0); __builtin_amdgcn_s_setprio(0); } while (0)
#define PG8_WAIT_V(n) asm volatile("s_waitcnt vmcnt(" #n ")" ::: "memory")
#define PG8_WAIT_L(n) asm volatile("s_waitcnt lgkmcnt(" #n ")" ::: "memory")
#define PG8_BAR __builtin_amdgcn_s_barrier()
#define PG8_SCHED __builtin_amdgcn_sched_barrier(0)
    Unit cur, nxt; int ui = 0;
    if (!S.next(0, cur)) return;
    f32x4 acc[2][2][4][2];
#pragma unroll
    for (int a = 0; a < 2; ++a)
#pragma unroll
        for (int b = 0; b < 2; ++b)
#pragma unroll
            for (int m = 0; m < 4; ++m)
#pragma unroll
                for (int n = 0; n < 2; ++n) acc[a][b][m][n] = (f32x4){0.f, 0.f, 0.f, 0.f};
    bf16x8 At[4][2], B0[2][2], B1[2][2];
    const char* cA = (const char*)g.A + (size_t)cur.pm * tstep; const char* cB = (const char*)g.Bt + (size_t)cur.pn * tstep;
    S.a_ready(cur);
    PG8_STAGE(PG8_SB(0, 0), cB, voffB); PG8_STAGE(PG8_SA(0, 0), cA, voffA); PG8_STAGE(PG8_SB(0, 1), cB + hstep, voffB); PG8_STAGE(PG8_SA(0, 1), cA + hstep, voffA);
    if (wr == 1) PG8_BAR;
    PG8_WAIT_V(4); PG8_BAR;
    PG8_STAGE(PG8_SB(1, 0), cB + kstep, voffB); PG8_STAGE(PG8_SA(1, 0), cA + kstep, voffA); PG8_STAGE(PG8_SB(1, 1), cB + hstep + kstep, voffB);
    PG8_WAIT_V(6); PG8_BAR;
    PG8_STAMP();
    for (;;) {
        const bool has_next = S.next(ui + 1, nxt);
        const char* nA = has_next ? (const char*)g.A + (size_t)nxt.pm * tstep : cA; const char* nB = has_next ? (const char*)g.Bt + (size_t)nxt.pn * tstep : cB;
        for (int t = 0; t < nt; t += 2) {
            const bool last = (t == nt - 2);
            const char* a1 = cA + (size_t)(t + 1) * kstep;
            const char* a2 = last ? nA : cA + (size_t)(t + 2) * kstep; const char* b2 = last ? nB : cB + (size_t)(t + 2) * kstep;
            const char* a3 = a2 + kstep; const char* b3 = b2 + kstep;
            if (last && has_next) S.a_ready(nxt);
            PG8_LDB(B0, 0, 0); PG8_SCHED; PG8_LDA(At, 0, 0); PG8_STAGE(PG8_SA(1, 1), a1 + hstep, voffA);
            PG8_WAIT_L(8); PG8_BAR; PG8_WAIT_L(0); PG8_MMA(0, 0, At, B0); PG8_BAR; PG8_SCHED;
            PG8_LDB(B1, 0, 1); PG8_STAGE(PG8_SB(0, 0), b2, voffB);
            PG8_BAR; PG8_WAIT_L(0); PG8_MMA(0, 1, At, B1); PG8_BAR;
            PG8_LDA(At, 0, 1); PG8_STAGE(PG8_SA(0, 0), a2, voffA);
            PG8_BAR; PG8_WAIT_L(0); PG8_MMA(1, 0, At, B0); PG8_BAR; PG8_SCHED;
            PG8_STAGE(PG8_SB(0, 1), b2 + hstep, voffB);
            PG8_WAIT_V(6); PG8_BAR; PG8_MMA(1, 1, At, B1); PG8_BAR;
            PG8_LDB(B0, 1, 0); PG8_SCHED; PG8_LDA(At, 1, 0); PG8_STAGE(PG8_SA(0, 1), a2 + hstep, voffA);
            PG8_WAIT_L(8); PG8_BAR; PG8_WAIT_L(0); PG8_MMA(0, 0, At, B0); PG8_BAR; PG8_SCHED;
            PG8_LDB(B1, 1, 1); PG8_STAGE(PG8_SB(1, 0), b3, voffB);
            PG8_BAR; PG8_WAIT_L(0); PG8_MMA(0, 1, At, B1); PG8_BAR;
            PG8_LDA(At, 1, 1); PG8_STAGE(PG8_SA(1, 0), a3, voffA);
            PG8_BAR; PG8_WAIT_L(0); PG8_MMA(1, 0, At, B0); PG8_BAR; PG8_SCHED;
            PG8_STAGE(PG8_SB(1, 1), b3 + hstep, voffB);
            PG8_WAIT_V(6); PG8_BAR; PG8_MMA(1, 1, At, B1); PG8_BAR;
        }
        PG8_STAMP();
        if constexpr (!Epi::AFTER_DRAIN) { E(acc, cur, wr, wc, fr, fq); S.done(cur); }
        PG8_STAMP();
        if (!has_next) break;
#pragma unroll
        for (int a = 0; a < 2; ++a)
#pragma unroll
            for (int b = 0; b < 2; ++b)
#pragma unroll
                for (int m = 0; m < 4; ++m)
#pragma unroll
                    for (int n = 0; n < 2; ++n) acc[a][b][m][n] = (f32x4){0.f, 0.f, 0.f, 0.f};
        cur = nxt; cA = nA; cB = nB; ++ui;
    }
    PG8_WAIT_V(0);
    if (wr == 0) PG8_BAR;
    PG8_BAR;
    if constexpr (Epi::AFTER_DRAIN) { E.fused(acc, cur, wr, wc, fr, fq, lds, wid, lane); S.done(cur); }
    PG8_STAMP();
    if (STAMP && wid == 0) { stamps[lane] = lane < nts ? (((unsigned long long)(unsigned)ts_hi << 32) | (unsigned)ts_lo) : 0ull;
        if (lane == 62) stamps[62] = rt_entry; if (lane == 63) stamps[63] = (unsigned long long)wall_clock64(); }
#undef PG8_STAMP
#undef PG8_SA
#undef PG8_SB
#undef PG8_STAGE
#undef PG8_LDA
#undef PG8_LDB
#undef PG8_MMA
#undef PG8_WAIT_V
#undef PG8_WAIT_L
#undef PG8_BAR
#undef PG8_SCHED
}
}

#define LAS __attribute__((address_space(3)))
#define XB_TMO      128
#define XB_XCNT(j)  (256  + 64 * (j))
#define XB_XSUB(j)  (1280 + 64 * (j))
#define XB_XGEN(j)  (2304 + 64 * (j))
#define XB_TOP      3328
#define XB_TOPGEN   3392
#define XCD_BAR_WORDS 3456
#define XB_SPIN_CAP (1u << 24)

__device__ __forceinline__ unsigned xb_ld(unsigned* p)              { return __hip_atomic_load(p, __ATOMIC_RELAXED, __HIP_MEMORY_SCOPE_AGENT); }
__device__ __forceinline__ unsigned xb_add(unsigned* p, unsigned v) { return __hip_atomic_fetch_add(p, v, __ATOMIC_RELAXED, __HIP_MEMORY_SCOPE_AGENT); }
__device__ __forceinline__ unsigned xb_xcc_id() { return (unsigned)__builtin_amdgcn_s_getreg((3 << 11) | 20) & 0xFu; }
#define XB_SPIN(cond, bar) do { unsigned _sp = 0; while (cond) { __builtin_amdgcn_s_sleep(1); \
    if ((++_sp & 255u) == 0u) { if (xb_ld(&(bar)[XB_TMO])) break; if (_sp > XB_SPIN_CAP) { atomicAdd(&(bar)[XB_TMO], 1u); break; } } } } while (0)

struct XcdBarrier { unsigned* bar; unsigned x; volatile LAS unsigned* st; };

__device__ __forceinline__ XcdBarrier xcd_barrier_post(unsigned* bar, volatile LAS unsigned* st) {
    XcdBarrier b; b.bar = bar; b.x = xb_xcc_id(); b.st = st;
    if (threadIdx.x == 0) (void)xb_add(&bar[XB_XCNT(b.x)], 1u);
    return b;
}
__device__ __forceinline__ void xcd_barrier_complete(unsigned* bar, unsigned x, unsigned& nloc, unsigned& nx) {
    const unsigned G = gridDim.x * gridDim.y * gridDim.z;
    unsigned sum, cnt, mine, sp = 0u;
    for (;;) {
        sum = 0u; cnt = 0u; mine = 0u;
#pragma unroll
        for (unsigned j = 0; j < 16; ++j) { const unsigned c = xb_ld(&bar[XB_XCNT(j)]); sum += c; cnt += (c > 0u) ? 1u : 0u; mine = (j == x) ? c : mine; }
        if (sum == G) break;
        __builtin_amdgcn_s_sleep(1);
        if ((++sp & 255u) == 0u) { if (xb_ld(&bar[XB_TMO])) break; if (sp > XB_SPIN_CAP) { atomicAdd(&bar[XB_TMO], 1u); break; } }
    }
    nloc = mine > 0u ? mine : 1u; nx = cnt > 0u ? cnt : 1u;
}
__device__ __forceinline__ void xcd_barrier(const XcdBarrier& b) {
    asm volatile("s_waitcnt vmcnt(0)" ::: "memory");
    __syncthreads();
    if (threadIdx.x == 0) {
        unsigned* bar = b.bar;
        __builtin_amdgcn_s_waitcnt(0);
        unsigned nloc = b.st[0], nx = b.st[1];
        if (nloc == 0u) { xcd_barrier_complete(bar, b.x, nloc, nx); b.st[0] = nloc; b.st[1] = nx; }
        const unsigned old = xb_add(&bar[XB_XSUB(b.x)], 1u);
        const unsigned gen = old / nloc;
        if (old + 1u == (gen + 1u) * nloc) {
            __builtin_amdgcn_fence(__ATOMIC_RELEASE, "agent");
            asm volatile("s_waitcnt vmcnt(0)" ::: "memory");
            const unsigned og = xb_add(&bar[XB_TOP], 1u);
            const unsigned tg = og / nx;
            if (og + 1u == (tg + 1u) * nx) xb_add(&bar[XB_TOPGEN], 1u);
            else XB_SPIN(xb_ld(&bar[XB_TOPGEN]) == tg, bar);
            __builtin_amdgcn_fence(__ATOMIC_ACQUIRE, "agent");
            xb_add(&bar[XB_XGEN(b.x)], 1u);
            asm volatile("s_waitcnt vmcnt(0)" ::: "memory");
        } else {
            XB_SPIN(xb_ld(&bar[XB_XGEN(b.x)]) == gen, bar);
            __builtin_amdgcn_fence(__ATOMIC_ACQUIRE, "agent");
            asm volatile("s_waitcnt vmcnt(0)" ::: "memory");
        }
    }
    __syncthreads();
}

typedef unsigned short bf16;
typedef float f32x4 __attribute__((ext_vector_type(4)));
typedef float f32x16 __attribute__((ext_vector_type(16)));
typedef float f32x2 __attribute__((ext_vector_type(2)));
typedef unsigned u32x4 __attribute__((ext_vector_type(4)));
typedef unsigned u32x2 __attribute__((ext_vector_type(2)));
typedef short bf16x8 __attribute__((ext_vector_type(8)));
typedef __bf16 bf2_t __attribute__((ext_vector_type(2)));

constexpr int NTHREADS = 512, NWAVES = 8;
constexpr int LDS_BYTES = 160 * 1024;
constexpr int MISC_OFF = LDS_BYTES - 256;
constexpr int TOK = 32768, SEQ = 16384, DM = 2048;
constexpr int EV_N = 4800, EV_NP = 4864, OD_N = 4176, OD_NP = 4352;
constexpr float ALPHA = 1.41421356237f;
constexpr size_t MiB = 1u << 20;
constexpr size_t WS_CTL = 0, CTL_ZERO_BYTES = 1 * MiB;
constexpr int CW_BAR = 4096, CW_XRANK = 8192;
constexpr size_t WS_MOD = 1 * MiB, WS_SKB = 2 * MiB, WS_WL = 4 * MiB, WS_BS = 7 * MiB, WS_CNT = 9 * MiB;
constexpr size_t WS_WINE = 10 * MiB, WS_WOUTE = 29 * MiB, WS_WINO = 37 * MiB, WS_WOUTO = 54 * MiB, WS_WQ0 = 62 * MiB, WS_WQ1 = 70 * MiB;
constexpr size_t WS_HY = 78 * MiB, WS_Z = 206 * MiB, WS_LA = 510 * MiB, WS_BIG = 542 * MiB, WS_END = 1022 * MiB;

__device__ __forceinline__ float bf2f(unsigned short b) { return __uint_as_float(((unsigned)b) << 16); }
__device__ __forceinline__ unsigned pk2(float lo, float hi) { const bf2_t v = {(__bf16)lo, (__bf16)hi}; return __builtin_bit_cast(unsigned, v); }
__device__ __forceinline__ unsigned f2bf(float f) { return pk2(f, 0.f) & 0xffffu; }
__device__ __forceinline__ float lo2f(unsigned w) { return __uint_as_float(w << 16); }
__device__ __forceinline__ float hi2f(unsigned w) { return __uint_as_float(w & 0xffff0000u); }
template <int CTRL, int RM> __device__ __forceinline__ float dppo(float v) { return __int_as_float(__builtin_amdgcn_update_dpp(__float_as_int(v), __float_as_int(v), CTRL, RM, 0xF, false)); }
__device__ __forceinline__ float wsum(float v) {
    v += __int_as_float(__builtin_amdgcn_update_dpp(0, __float_as_int(v), 0xB1, 0xF, 0xF, false)); v += __int_as_float(__builtin_amdgcn_update_dpp(0, __float_as_int(v), 0x4E, 0xF, 0xF, false));
    v += __int_as_float(__builtin_amdgcn_update_dpp(0, __float_as_int(v), 0x141, 0xF, 0xF, false)); v += __int_as_float(__builtin_amdgcn_update_dpp(0, __float_as_int(v), 0x140, 0xF, 0xF, false));
    v += __int_as_float(__builtin_amdgcn_update_dpp(0, __float_as_int(v), 0x142, 0xA, 0xF, false)); v += __int_as_float(__builtin_amdgcn_update_dpp(0, __float_as_int(v), 0x143, 0xC, 0xF, false));
    return __int_as_float(__builtin_amdgcn_readlane(__float_as_int(v), 63));
}
__device__ __forceinline__ float wmax(float v) {
    v = fmaxf(v, dppo<0xB1, 0xF>(v)); v = fmaxf(v, dppo<0x4E, 0xF>(v)); v = fmaxf(v, dppo<0x141, 0xF>(v)); v = fmaxf(v, dppo<0x140, 0xF>(v));
    v = fmaxf(v, dppo<0x142, 0xA>(v)); v = fmaxf(v, dppo<0x143, 0xC>(v));
    return __int_as_float(__builtin_amdgcn_readlane(__float_as_int(v), 63));
}
__device__ __forceinline__ float xsum32(float x) { const auto r = __builtin_amdgcn_permlane32_swap(__float_as_uint(x), __float_as_uint(x), false, false); return __uint_as_float(r[0]) + __uint_as_float(r[1]); }
__device__ __forceinline__ float xsum16(float x) { const auto r = __builtin_amdgcn_permlane16_swap(__float_as_uint(x), __float_as_uint(x), false, false); return __uint_as_float(r[0]) + __uint_as_float(r[1]); }
__device__ __forceinline__ float xmax32(float x) { const auto r = __builtin_amdgcn_permlane32_swap(__float_as_uint(x), __float_as_uint(x), false, false); return fmaxf(__uint_as_float(r[0]), __uint_as_float(r[1])); }
__device__ __forceinline__ float xmax16(float x) { const auto r = __builtin_amdgcn_permlane16_swap(__float_as_uint(x), __float_as_uint(x), false, false); return fmaxf(__uint_as_float(r[0]), __uint_as_float(r[1])); }
__device__ __forceinline__ float rsum4(float v0, float v1, float v2, float v3) {
    const auto p = __builtin_amdgcn_permlane32_swap(__float_as_uint(v0), __float_as_uint(v2), false, false);
    const auto q = __builtin_amdgcn_permlane32_swap(__float_as_uint(v1), __float_as_uint(v3), false, false);
    const float P = __uint_as_float(p[0]) + __uint_as_float(p[1]);
    const float Q = __uint_as_float(q[0]) + __uint_as_float(q[1]);
    const auto t = __builtin_amdgcn_permlane16_swap(__float_as_uint(P), __float_as_uint(Q), false, false);
    return __uint_as_float(t[0]) + __uint_as_float(t[1]);
}
__device__ __forceinline__ float rdlane(float v, int l) { return __int_as_float(__builtin_amdgcn_readlane(__float_as_int(v), l)); }
__device__ __forceinline__ unsigned rdlaneu(unsigned v, int l) { return (unsigned)__builtin_amdgcn_readlane((int)v, l); }
__device__ __forceinline__ float dot2bf(unsigned a, unsigned b, float c) {
    return __builtin_amdgcn_fdot2_f32_bf16(__builtin_bit_cast(bf2_t, a), __builtin_bit_cast(bf2_t, b), c, false);
}
template <int CTRL, int RM> __device__ __forceinline__ float dppf(float v) {
    return __int_as_float(__builtin_amdgcn_update_dpp(0, __float_as_int(v), CTRL, RM, 0xF, false));
}
__device__ __forceinline__ float wsum_dpp(float v) {
    v += dppf<0xB1, 0xF>(v);
    v += dppf<0x4E, 0xF>(v);
    v += dppf<0x141, 0xF>(v);
    v += dppf<0x140, 0xF>(v);
    v += dppf<0x142, 0xA>(v);
    v += dppf<0x143, 0xC>(v);
    return rdlane(v, 63);
}
__device__ __forceinline__ float sum16_dpp(float v) {
    v += dppf<0xB1, 0xF>(v); v += dppf<0x4E, 0xF>(v); v += dppf<0x141, 0xF>(v); v += dppf<0x140, 0xF>(v);
    return v;
}
__device__ __forceinline__ float sigmoidf_(float x) { return 1.0f / (1.0f + expf(-x)); }
__device__ __forceinline__ unsigned ordkey(float f) { const unsigned u = __float_as_uint(f); return (u & 0x80000000u) ? ~u : (u | 0x80000000u); }
__device__ __forceinline__ unsigned fixkey20(float f) { const float c = fminf(fmaxf(f, -15.999f), 15.999f); return (unsigned)((int)rintf(c * 32768.0f) + (1 << 19)); }
__device__ __forceinline__ float unordkey(unsigned k) { return __uint_as_float((k & 0x80000000u) ? (k & 0x7fffffffu) : ~k); }

struct Args { const void* in[27]; float* out; unsigned char* ws; int ph_lo, ph_hi; };
struct Frame { LAS unsigned char* lds; int tid, lane, wave, bx, G, gw, ngw; };

struct EpiLora {
    static constexpr bool PERM = true, AFTER_DRAIN = false;
    pg8::bf16_t* O; int ldc; const float* w0; const float* a0;
    __device__ __forceinline__ void operator()(const pg8::f32x4 (&acc)[2][2][4][2], const pg8::Unit& u, int wr, int wc, int fr, int fq) const {
        const int row0 = u.pm * 256 + wr * 64 + fr; const int colt = u.pn * 256; const int type = u.pn >> 2;
        const int col0 = colt + wc * 32 + 8 * fq, ncol0 = col0 & 1023;
        const float* pv = (type == 0) ? w0 : a0;
        pg8::f32x4 bv[2][2];
#pragma unroll
        for (int bj = 0; bj < 2; ++bj)
#pragma unroll
            for (int n = 0; n < 2; ++n) bv[bj][n] = (type < 2) ? *(const pg8::f32x4*)(pv + ncol0 + bj * 128 + 4 * n) : (pg8::f32x4){0.f, 0.f, 0.f, 0.f};
#pragma unroll
        for (int ai = 0; ai < 2; ++ai)
#pragma unroll
            for (int m = 0; m < 4; ++m) { pg8::bf16_t* rowp = O + (size_t)(row0 + ai * 128 + m * 16) * ldc + col0;
#pragma unroll
                for (int bj = 0; bj < 2; ++bj) { pg8::f32x4 v0 = acc[ai][bj][m][0] + bv[bj][0], v1 = acc[ai][bj][m][1] + bv[bj][1];
                    if (type < 2) {
                        const float sc = (type == 0) ? 0.60653066f : 1.0f;
#pragma unroll
                        for (int j = 0; j < 4; ++j) { v0[j] = sc / (1.0f + __expf(-v0[j])); v1[j] = sc / (1.0f + __expf(-v1[j])); }
                    }
                    pg8::u32x4 w; w.x = pg8::cvt_pk_bf16(v0[0], v0[1]); w.y = pg8::cvt_pk_bf16(v0[2], v0[3]); w.z = pg8::cvt_pk_bf16(v1[0], v1[1]); w.w = pg8::cvt_pk_bf16(v1[2], v1[3]);
                    *(pg8::u32x4*)(rowp + bj * 128) = w; } }
    }
};

__device__ __forceinline__ void transpose_item(const float* W, int K, int N, int Npad, bf16* WT, LAS float* scr, int item, int lane) {
    const int nblk = Npad / 32, kb = item / nblk, nb = item % nblk, k0 = 64 * kb, n0 = 32 * nb;
    const int nl = lane & 31; const bool ok = (n0 + nl) < N;
#pragma unroll 8
    for (int i = 0; i < 32; ++i) { const int kk = 2 * i + (lane >> 5); scr[kk * 33 + nl] = ok ? W[(size_t)(k0 + kk) * N + n0 + nl] : 0.f; }
    asm volatile("s_waitcnt lgkmcnt(0)" ::: "memory");
    const int c = lane & 7;
#pragma unroll
    for (int j = 0; j < 4; ++j) { const int n = (lane >> 3) + 8 * j; const LAS float* s = scr + (8 * c) * 33 + n;
        u32x4 o; o.x = pk2(s[0 * 33], s[1 * 33]); o.y = pk2(s[2 * 33], s[3 * 33]); o.z = pk2(s[4 * 33], s[5 * 33]); o.w = pk2(s[6 * 33], s[7 * 33]);
        *(u32x4*)(WT + (size_t)(n0 + n) * K + k0 + 8 * c) = o; }
    asm volatile("s_waitcnt lgkmcnt(0)" ::: "memory");
}

__device__ __forceinline__ void ph_prologue(const Args& A, Frame& F) {
    unsigned char* ws = A.ws;
    {
        const float* c = (const float*)A.in[1]; const float* mw = (const float*)A.in[19]; const float* mb = (const float*)A.in[20];
        float* MOD = (float*)(ws + WS_MOD);
        LAS float* red = (LAS float*)F.lds;
        for (int it = F.bx; it < 96; it += F.G) {
            const int s = it / 24, cc = it % 24, col = cc * 256 + F.lane * 4;
            const float* W = mw + (size_t)s * 2048 * 6144 + col;
            f32x4 a0 = {0.f, 0.f, 0.f, 0.f}, a1 = {0.f, 0.f, 0.f, 0.f};
            const int k0 = F.wave * 256;
#pragma unroll 8
            for (int k = k0; k < k0 + 256; ++k) {
                float c0 = c[k], c1 = c[2048 + k];
                c0 = c0 / (1.0f + expf(-c0)); c1 = c1 / (1.0f + expf(-c1));
                const f32x4 w = *(const f32x4*)(W + (size_t)k * 6144);
                a0 += c0 * w; a1 += c1 * w;
            }
            *(LAS f32x4*)(red + ((F.wave * 2 + 0) * 256 + F.lane * 4)) = a0;
            *(LAS f32x4*)(red + ((F.wave * 2 + 1) * 256 + F.lane * 4)) = a1;
            __syncthreads();
            { const int b = F.tid >> 8, cl = F.tid & 255; float sm = 0.f;
#pragma unroll
              for (int w = 0; w < 8; ++w) sm += red[(w * 2 + b) * 256 + cl];
              MOD[(size_t)(s * 2 + b) * 6144 + cc * 256 + cl] = sm + mb[s * 6144 + cc * 256 + cl]; }
            __syncthreads();
        }
    }
    {
        LAS float* scr = (LAS float*)(F.lds + 16384 + F.wave * 8704);
        constexpr int I0 = 32 * (EV_NP / 32), I1 = 32 * 64, I2 = 32 * (OD_NP / 32);
        constexpr int NIT = I0 + I1 + I2 + 3 * I1;
        for (int it = F.gw; it < NIT; it += F.ngw) {
            int r = it;
            if (r < I0) { transpose_item((const float*)A.in[3], 2048, EV_N, EV_NP, (bf16*)(ws + WS_WINE), scr, r, F.lane); continue; } r -= I0;
            if (r < I1) { transpose_item((const float*)A.in[4], 2048, 2048, 2048, (bf16*)(ws + WS_WOUTE), scr, r, F.lane); continue; } r -= I1;
            if (r < I2) { transpose_item((const float*)A.in[17], 2048, OD_N, OD_NP, (bf16*)(ws + WS_WINO), scr, r, F.lane); continue; } r -= I2;
            if (r < I1) { transpose_item((const float*)A.in[18], 2048, 2048, 2048, (bf16*)(ws + WS_WOUTO), scr, r, F.lane); continue; } r -= I1;
            if (r < I1) { transpose_item((const float*)A.in[23], 2048, 2048, 2048, (bf16*)(ws + WS_WQ0), scr, r, F.lane); continue; } r -= I1;
            transpose_item((const float*)A.in[23] + (size_t)2048 * 2048, 2048, 2048, 2048, (bf16*)(ws + WS_WQ1), scr, r, F.lane);
        }
    }
    {
        const float* w2 = (const float*)A.in[8]; const float* a2 = (const float*)A.in[10]; const float* g2 = (const float*)A.in[11];
        bf16* WL = (bf16*)(ws + WS_WL);
        const int gt = F.bx * NTHREADS + F.tid, ngt = F.G * NTHREADS;
        for (int i = gt; i < 3072 * 512; i += ngt) {
            const int n = i >> 9, k = i & 511; float v = 0.f;
            if (n < 1024) { if (k < 96) v = w2[k * 1024 + n]; }
            else if (n < 2048) { if (k >= 96 && k < 192) v = a2[(k - 96) * 1024 + (n - 1024)]; }
            else { if (k >= 192 && k < 448) v = g2[(k - 192) * 1024 + (n - 2048)]; }
            WL[i] = (bf16)f2bf(v);
        }
        const float* sk = (const float*)A.in[24]; bf16* SKB = (bf16*)(ws + WS_SKB);
        for (int i = gt; i < 2 * 262144; i += ngt) SKB[i] = (bf16)f2bf(sk[i]);
    }
}

__device__ __forceinline__ void ph_mod_x(const Args& A, Frame& F) {
    const float* x = (const float*)A.in[0]; const float* MOD = (const float*)(A.ws + WS_MOD); bf16* H = (bf16*)(A.ws + WS_HY);
    for (int t = F.gw; t < TOK; t += F.ngw) {
        const int b = t >> 14; const float* sh = MOD + (size_t)(0 * 2 + b) * 6144; const float* sc = sh + 2048;
#pragma unroll
        for (int j = 0; j < 8; ++j) { const int idx = j * 256 + F.lane * 4;
            const f32x4 xv = *(const f32x4*)(x + (size_t)t * DM + idx), sv = *(const f32x4*)(sc + idx), hv = *(const f32x4*)(sh + idx);
            const f32x4 o = xv * (1.0f + sv) + hv; u32x2 w; w.x = pk2(o[0], o[1]); w.y = pk2(o[2], o[3]);
            *(u32x2*)(H + (size_t)t * DM + idx) = w; }
    }
}

__device__ __forceinline__ void ph_even_post(const Args& A, Frame& F) {
    bf16* Z = (bf16*)(A.ws + WS_Z); const int* positions = (const int*)A.in[2]; const float* mu = (const float*)A.in[6];
    bf16* RKV = (bf16*)A.out; bf16* LAp = (bf16*)(A.ws + WS_LA);
    const int i = F.lane & 31; const float inv = powf(10000.0f, -(float)i / 32.0f);
    const int i4 = F.lane & 7, hs = F.lane >> 3;
    for (int t = F.gw; t < TOK; t += F.ngw) {
        const int s = t & (SEQ - 1); bf16* zr = Z + (size_t)t * EV_NP;
        float sn, cs; sincosf((float)positions[t] * inv, &sn, &cs);
        float c4[4], s4[4];
#pragma unroll
        for (int e = 0; e < 4; ++e) { c4[e] = __shfl(cs, 4 * i4 + e); s4[e] = __shfl(sn, 4 * i4 + e); }
#pragma unroll
        for (int it = 0; it < 3; ++it) { const int hd = it * 8 + hs; if (hd < 18) { bf16* hp = zr + hd * 64 + 4 * i4;
            const u32x2 a = *(const u32x2*)hp, b = *(const u32x2*)(hp + 32);
            const float t1[4] = {lo2f(a.x), hi2f(a.x), lo2f(a.y), hi2f(a.y)}, t2[4] = {lo2f(b.x), hi2f(b.x), lo2f(b.y), hi2f(b.y)};
            float o1[4], o2[4];
#pragma unroll
            for (int e = 0; e < 4; ++e) { o1[e] = t1[e] * c4[e] - t2[e] * s4[e]; o2[e] = t2[e] * c4[e] + t1[e] * s4[e]; }
            *(u32x2*)hp = (u32x2){pk2(o1[0], o1[1]), pk2(o1[2], o1[3])}; *(u32x2*)(hp + 32) = (u32x2){pk2(o2[0], o2[1]), pk2(o2[2], o2[3])}; } }
        const bf16* zp = zr - EV_NP; const bool hasprev = s > 0;
#pragma unroll
        for (int m = 0; m < 7; ++m) { const int j = 8 * (F.lane + 64 * m); if (j < 3520) {
            const u32x4 cw = *(const u32x4*)(zr + 1280 + j); u32x4 pw = {0u, 0u, 0u, 0u}; if (hasprev) pw = *(const u32x4*)(zp + 1280 + j);
            const f32x4 m0 = *(const f32x4*)(mu + j), m1 = *(const f32x4*)(mu + j + 4);
            const unsigned cwa[4] = {cw.x, cw.y, cw.z, cw.w}, pwa[4] = {pw.x, pw.y, pw.z, pw.w}; const float mm[8] = {m0[0], m0[1], m0[2], m0[3], m1[0], m1[1], m1[2], m1[3]};
            float v[8];
#pragma unroll
            for (int q = 0; q < 4; ++q) { const float c0 = lo2f(cwa[q]), c1 = hi2f(cwa[q]), p0 = lo2f(pwa[q]), p1 = hi2f(pwa[q]); v[2 * q] = c0 + (p0 - c0) * mm[2 * q]; v[2 * q + 1] = c1 + (p1 - c1) * mm[2 * q + 1]; }
            bf16* dst;
            if (j < 3072) { dst = RKV + (size_t)(j >> 10) * TOK * 1024 + (size_t)t * 1024 + (j & 1023); }
            else if (j < 3168) { dst = LAp + (size_t)t * 512 + (j - 3072);
#pragma unroll
                for (int e = 0; e < 8; ++e) v[e] = tanhf(v[e]); }
            else if (j < 3264) { dst = LAp + (size_t)t * 512 + 96 + (j - 3168); }
            else { dst = LAp + (size_t)t * 512 + 192 + (j - 3264);
#pragma unroll
                for (int e = 0; e < 8; ++e) v[e] = sigmoidf_(v[e]); }
            *(u32x4*)dst = (u32x4){pk2(v[0], v[1]), pk2(v[2], v[3]), pk2(v[4], v[5]), pk2(v[6], v[7])};
        } }
        if (F.lane < 8) *(u32x4*)(LAp + (size_t)t * 512 + 448 + 8 * F.lane) = (u32x4){0u, 0u, 0u, 0u};
    }
}

__device__ __forceinline__ void ph_scan_pack(const Args& A, Frame& F) {
    const bf16* Z = (const bf16*)(A.ws + WS_Z); const bf16* RKV = (const bf16*)A.out;
    const float* k_k = (const float*)A.in[12]; const float* k_a = (const float*)A.in[13]; const float* r_k = (const float*)A.in[14];
    unsigned* PK = (unsigned*)(A.ws + WS_BIG); float* BS = (float*)(A.ws + WS_BS);
    const int g16 = F.lane >> 4, c16 = F.lane & 15;
    for (int it = F.gw; it < TOK * 4; it += F.ngw) {
        const int item = it * 4 + g16; const int t = item >> 4, h = item & 15, c = h * 64 + 4 * c16, b = t >> 14, s = t & (SEQ - 1);
        const u32x2 rw = *(const u32x2*)(RKV + (size_t)t * 1024 + c), kw = *(const u32x2*)(RKV + (size_t)TOK * 1024 + (size_t)t * 1024 + c), vw = *(const u32x2*)(RKV + (size_t)2 * TOK * 1024 + (size_t)t * 1024 + c);
        const u32x2 ew = *(const u32x2*)(Z + (size_t)t * EV_NP + 1280 + c), aw = *(const u32x2*)(Z + (size_t)t * EV_NP + 1280 + 1024 + c);
        const f32x4 kk4 = *(const f32x4*)(k_k + c), ka4 = *(const f32x4*)(k_a + c), rk4 = *(const f32x4*)(r_k + c);
        const float r[4] = {lo2f(rw.x), hi2f(rw.x), lo2f(rw.y), hi2f(rw.y)}, kr[4] = {lo2f(kw.x), hi2f(kw.x), lo2f(kw.y), hi2f(kw.y)}, v[4] = {lo2f(vw.x), hi2f(vw.x), lo2f(vw.y), hi2f(vw.y)};
        const float e[4] = {lo2f(ew.x), hi2f(ew.x), lo2f(ew.y), hi2f(ew.y)}, a[4] = {lo2f(aw.x), hi2f(aw.x), lo2f(aw.y), hi2f(aw.y)};
        float kkv[4], kp[4]; float ss = 0.f, bsum = 0.f;
#pragma unroll
        for (int q = 0; q < 4; ++q) { kkv[q] = kr[q] * kk4[q]; ss += kkv[q] * kkv[q]; kp[q] = kr[q] * (1.0f + (a[q] - 1.0f) * ka4[q]); bsum += r[q] * kp[q] * rk4[q]; }
        ss = sum16_dpp(ss); bsum = sum16_dpp(bsum);
        const float rn = 1.0f / fmaxf(sqrtf(ss), 1e-12f);
        if (c16 == 0) BS[(size_t)t * 16 + h] = bsum;
        unsigned w[12];
#pragma unroll
        for (int q = 0; q < 4; ++q) { const float kkn = kkv[q] * rn; w[3 * q] = pk2(r[q], e[q]); w[3 * q + 1] = pk2(kp[q], kkn); w[3 * q + 2] = pk2(kkn * a[q], v[q]); }
        u32x4* dst = (u32x4*)(PK + ((size_t)((b * 16 + h) * SEQ + s) * 64 + 4 * c16) * 3);
        dst[0] = (u32x4){w[0], w[1], w[2], w[3]}; dst[1] = (u32x4){w[4], w[5], w[6], w[7]}; dst[2] = (u32x4){w[8], w[9], w[10], w[11]};
    }
}

__device__ __forceinline__ void ph_swa(const Args& A, Frame& F) {
    const bf16* Z = (const bf16*)(A.ws + WS_Z); bf16* Y = (bf16*)(A.ws + WS_HY); const float* sinks = (const float*)A.in[5];
    LAS unsigned char* KL = F.lds; LAS unsigned char* VL = F.lds + 256 * 136;
    for (int u = F.bx; u < 512; u += F.G) {
        const int b = u >> 8, n = (u >> 1) & 127, kvh = u & 1;
        __syncthreads();
        for (int c = F.tid; c < 2048; c += NTHREADS) { const int jw = c >> 3, cc = c & 7; const int s = n * 128 - 128 + jw;
            u32x4 kv = {0u, 0u, 0u, 0u}, vv = {0u, 0u, 0u, 0u};
            if (s >= 0) { const bf16* row = Z + (size_t)(b * SEQ + s) * EV_NP; kv = *(const u32x4*)(row + 1024 + kvh * 64 + cc * 8); vv = *(const u32x4*)(row + 1152 + kvh * 64 + cc * 8); }
            *(LAS u32x2*)(KL + jw * 136 + cc * 16) = (u32x2){kv.x, kv.y}; *(LAS u32x2*)(KL + jw * 136 + cc * 16 + 8) = (u32x2){kv.z, kv.w};
            *(LAS u32x2*)(VL + jw * 136 + cc * 16) = (u32x2){vv.x, vv.y}; *(LAS u32x2*)(VL + jw * 136 + cc * 16 + 8) = (u32x2){vv.z, vv.w}; }
        __syncthreads();
        for (int it = F.wave; it < 1024; it += NWAVES) {
            const int i = it >> 3, g = it & 7, head = kvh * 8 + g; const int t = b * SEQ + n * 128 + i;
            const float qv = bf2f(Z[(size_t)t * EV_NP + head * 64 + F.lane]) * 0.125f;
            const int jw0 = i + 1 + F.lane, jw1 = jw0 + 64;
            const bool val0 = (n > 0) || (jw0 >= 128), val1 = (n > 0) || (jw1 >= 128);
            float s0 = 0.f, s1 = 0.f;
#pragma unroll
            for (int d4 = 0; d4 < 16; ++d4) {
                const u32x2 k0 = *(const LAS u32x2*)(KL + jw0 * 136 + d4 * 8), k1 = *(const LAS u32x2*)(KL + jw1 * 136 + d4 * 8);
                const float q0 = rdlane(qv, 4 * d4), q1 = rdlane(qv, 4 * d4 + 1), q2 = rdlane(qv, 4 * d4 + 2), q3 = rdlane(qv, 4 * d4 + 3);
                s0 += q0 * lo2f(k0.x) + q1 * hi2f(k0.x) + q2 * lo2f(k0.y) + q3 * hi2f(k0.y);
                s1 += q0 * lo2f(k1.x) + q1 * hi2f(k1.x) + q2 * lo2f(k1.y) + q3 * hi2f(k1.y);
            }
            const float sink = sinks[head];
            s0 = val0 ? s0 : -INFINITY; s1 = val1 ? s1 : -INFINITY;
            const float mx = fmaxf(wmax(fmaxf(s0, s1)), sink);
            float p0 = val0 ? expf(s0 - mx) : 0.f, p1 = val1 ? expf(s1 - mx) : 0.f;
            const float den = wsum(p0 + p1) + expf(sink - mx); const float rden = 1.0f / den;
            p0 *= rden; p1 *= rden;
            float o = 0.f;
            const LAS bf16* vcol = (const LAS bf16*)VL + F.lane;
#pragma unroll 8
            for (int jj = 0; jj < 64; ++jj) o += rdlane(p0, jj) * bf2f(vcol[(i + 1 + jj) * 68]);
#pragma unroll 8
            for (int jj = 0; jj < 64; ++jj) o += rdlane(p1, jj) * bf2f(vcol[(i + 65 + jj) * 68]);
            Y[(size_t)t * DM + head * 64 + F.lane] = (bf16)f2bf(o);
        }
    }
}

__device__ __forceinline__ bf16x8 as_bf8(u32x4 v) { return __builtin_bit_cast(bf16x8, v); }
__device__ __forceinline__ void ph_swa_mfma(const Args& A, Frame& F) {
    const bf16* Z = (const bf16*)(A.ws + WS_Z); bf16* Y = (bf16*)(A.ws + WS_HY); const float* sinks = (const float*)A.in[5];
    LAS bf16* KL = (LAS bf16*)F.lds;
    LAS bf16* VT = (LAS bf16*)(F.lds + 36864);
    const int l15 = F.lane & 15, g4 = F.lane >> 4;
    for (int u = F.bx; u < 512; u += F.G) {
        const int b = u >> 8, n = (u >> 1) & 127, kvh = u & 1;
        __syncthreads();
        for (int c = F.tid; c < 2048; c += NTHREADS) { const int jw = c >> 3, cc = c & 7; const int sp = n * 128 - 128 + jw;
            u32x4 kv = {0u, 0u, 0u, 0u}, vv = {0u, 0u, 0u, 0u};
            if (sp >= 0) { const bf16* row = Z + (size_t)(b * SEQ + sp) * EV_NP; kv = *(const u32x4*)(row + 1024 + kvh * 64 + cc * 8); vv = *(const u32x4*)(row + 1152 + kvh * 64 + cc * 8); }
            *(LAS u32x4*)(KL + jw * 72 + cc * 8) = kv;
            const unsigned vw[4] = {vv.x, vv.y, vv.z, vv.w};
#pragma unroll
            for (int q = 0; q < 4; ++q) { VT[(8 * cc + 2 * q) * 264 + jw] = (bf16)(vw[q] & 0xffffu); VT[(8 * cc + 2 * q + 1) * 264 + jw] = (bf16)(vw[q] >> 16); } }
        __syncthreads();
        const int head = kvh * 8 + F.wave; const float sink = sinks[head];
#pragma unroll 1
        for (int qt = 0; qt < 8; ++qt) {
            const int iq = 16 * qt + l15; const int t = b * SEQ + n * 128 + iq;
            bf16x8 qf[2];
#pragma unroll
            for (int ks = 0; ks < 2; ++ks) qf[ks] = *(const bf16x8*)(Z + (size_t)t * EV_NP + head * 64 + 32 * ks + 8 * g4);
            float sv[10][4]; float mx = -INFINITY;
#pragma unroll
            for (int kk = 0; kk < 9; ++kk) { const int kt = qt + kk;
                f32x4 acc = {0.f, 0.f, 0.f, 0.f};
#pragma unroll
                for (int ks = 0; ks < 2; ++ks) acc = __builtin_amdgcn_mfma_f32_16x16x32_bf16(*(const LAS bf16x8*)(KL + (16 * kt + l15) * 72 + 32 * ks + 8 * g4), qf[ks], acc, 0, 0, 0);
#pragma unroll
                for (int rg_ = 0; rg_ < 4; ++rg_) { const int jw = 16 * kt + 4 * g4 + rg_; const bool ok = (jw >= iq + 1) && (jw <= iq + 128) && ((n > 0) || (jw >= 128));
                    sv[kk][rg_] = ok ? acc[rg_] * 0.125f : -INFINITY; mx = fmaxf(mx, sv[kk][rg_]); } }
#pragma unroll
            for (int rg_ = 0; rg_ < 4; ++rg_) sv[9][rg_] = -INFINITY;
            mx = xmax16(mx); mx = xmax32(mx); mx = fmaxf(mx, sink);
            float sm = 0.f;
#pragma unroll
            for (int kk = 0; kk < 10; ++kk)
#pragma unroll
                for (int rg_ = 0; rg_ < 4; ++rg_) { const float pv = (sv[kk][rg_] == -INFINITY) ? 0.f : __expf(sv[kk][rg_] - mx); sv[kk][rg_] = pv; sm += pv; }
            sm = xsum16(sm); sm = xsum32(sm);
            const float rden = 1.0f / (sm + __expf(sink - mx));
            f32x4 oacc[4];
#pragma unroll
            for (int dt = 0; dt < 4; ++dt) oacc[dt] = (f32x4){0.f, 0.f, 0.f, 0.f};
#pragma unroll
            for (int pp = 0; pp < 5; ++pp) { const int ka = qt + 2 * pp, kb = (qt + 2 * pp + 1 < 16) ? (qt + 2 * pp + 1) : 15;
                const bf16x8 pb = as_bf8((u32x4){pk2(sv[2 * pp][0] * rden, sv[2 * pp][1] * rden), pk2(sv[2 * pp][2] * rden, sv[2 * pp][3] * rden),
                                                  pk2(sv[2 * pp + 1][0] * rden, sv[2 * pp + 1][1] * rden), pk2(sv[2 * pp + 1][2] * rden, sv[2 * pp + 1][3] * rden)});
#pragma unroll
                for (int dt = 0; dt < 4; ++dt) { const LAS bf16* vr = VT + (16 * dt + l15) * 264 + 4 * g4;
                    const u32x2 va = *(const LAS u32x2*)(vr + 16 * ka), vb2 = *(const LAS u32x2*)(vr + 16 * kb);
                    oacc[dt] = __builtin_amdgcn_mfma_f32_16x16x32_bf16(as_bf8((u32x4){va.x, va.y, vb2.x, vb2.y}), pb, oacc[dt], 0, 0, 0); } }
#pragma unroll
            for (int dt = 0; dt < 4; ++dt) *(u32x2*)(Y + (size_t)t * DM + head * 64 + 16 * dt + 4 * g4) = (u32x2){pk2(oacc[dt][0], oacc[dt][1]), pk2(oacc[dt][2], oacc[dt][3])};
        }
    }
}

constexpr int FR_BYTES = 15360;
__device__ __forceinline__ int fr_rho(int ks, int g, int j) { return 16 * (2 * ks + (j >> 2)) + 4 * g + (j & 3); }
__device__ __forceinline__ void ph_scan_prep(const Args& A, Frame& F) {
    const bf16* Z = (const bf16*)(A.ws + WS_Z); const bf16* RKV = (const bf16*)A.out;
    const float* k_k = (const float*)A.in[12]; const float* k_a = (const float*)A.in[13]; const float* r_k = (const float*)A.in[14];
    unsigned char* FR = A.ws + WS_BIG; float* BS = (float*)(A.ws + WS_BS);
    LAS float* EE = (LAS float*)F.lds;
    LAS float* VV = (LAS float*)(F.lds + 4096);
    LAS float* KHf = (LAS float*)(F.lds + 8192);
    LAS float* RHf = (LAS float*)(F.lds + 12352);
    LAS float* BPf = (LAS float*)(F.lds + 16512);
    LAS bf16* AHb = (LAS bf16*)(F.lds + 20672);
    LAS bf16* BHb = (LAS bf16*)(F.lds + 22976);
    LAS bf16* KHb = (LAS bf16*)(F.lds + 25280);
    LAS bf16* RHb = (LAS bf16*)(F.lds + 27584);
    LAS bf16* APT = (LAS bf16*)(F.lds + 29888);
    LAS float* GA = (LAS float*)(F.lds + 32960);
    LAS float* GB = GA + 16 * 17; LAS float* GMA = GB + 16 * 17; LAS float* GMB = GMA + 16 * 17;
    LAS float* TT = (LAS float*)(F.lds + 37312);
    LAS bf16* P1b = (LAS bf16*)(F.lds + 38400);
    LAS bf16* P2b = (LAS bf16*)(F.lds + 41472);
    LAS bf16* MAT = (LAS bf16*)(F.lds + 42240);
    LAS float* WW = (LAS float*)(F.lds + 43008);
    const int tt = F.tid >> 5, kq = F.tid & 31;
    const int l15 = F.lane & 15, g = F.lane >> 4;
    const bf16x8 zero8 = {0, 0, 0, 0, 0, 0, 0, 0};
    unsigned p_rw = 0u, p_kw = 0u, p_vw = 0u, p_ew = 0u, p_aw = 0u; f32x2 p_kk = {0.f, 0.f}, p_ka = {0.f, 0.f}, p_rk = {0.f, 0.f};
#define PREP_LOAD(it_) do { const int bh_ = (it_) >> 10, ch_ = (it_) & 1023, b_ = bh_ >> 4, h_ = bh_ & 15; const int tok_ = b_ * SEQ + ch_ * 16 + tt, c_ = h_ * 64 + 2 * kq; \
        p_rw = *(const unsigned*)(RKV + (size_t)tok_ * 1024 + c_); p_kw = *(const unsigned*)(RKV + (size_t)TOK * 1024 + (size_t)tok_ * 1024 + c_); p_vw = *(const unsigned*)(RKV + (size_t)2 * TOK * 1024 + (size_t)tok_ * 1024 + c_); \
        p_ew = *(const unsigned*)(Z + (size_t)tok_ * EV_NP + 1280 + c_); p_aw = *(const unsigned*)(Z + (size_t)tok_ * EV_NP + 1280 + 1024 + c_); \
        p_kk = *(const f32x2*)(k_k + c_); p_ka = *(const f32x2*)(k_a + c_); p_rk = *(const f32x2*)(r_k + c_); } while (0)
    if (F.bx < 32 * 1024) PREP_LOAD(F.bx);
    for (int it = F.bx; it < 32 * 1024; it += F.G) {
        const int bh = it >> 10, ch = it & 1023, b = bh >> 4, h = bh & 15;
        const int tok = b * SEQ + ch * 16 + tt;
        __syncthreads();
        float e2[2], kkn[2], kka[2], kp[2], r2[2];
        {
            const unsigned rw = p_rw, kw = p_kw, vw = p_vw, ew = p_ew, aw = p_aw; const f32x2 kk2 = p_kk, ka2 = p_ka, rk2 = p_rk;
            const float kr[2] = {lo2f(kw), hi2f(kw)}, av[2] = {lo2f(aw), hi2f(aw)};
            r2[0] = lo2f(rw); r2[1] = hi2f(rw); e2[0] = lo2f(ew); e2[1] = hi2f(ew);
            float kkv[2], ss = 0.f, bsum = 0.f;
#pragma unroll
            for (int q = 0; q < 2; ++q) { kkv[q] = kr[q] * kk2[q]; ss += kkv[q] * kkv[q]; kp[q] = kr[q] * (1.0f + (av[q] - 1.0f) * ka2[q]); bsum += r2[q] * kp[q] * rk2[q]; }
            ss = xsum16(sum16_dpp(ss)); bsum = xsum16(sum16_dpp(bsum));
            const float rn = 1.0f / fmaxf(sqrtf(ss), 1e-12f);
#pragma unroll
            for (int q = 0; q < 2; ++q) { kkn[q] = kkv[q] * rn; kka[q] = kkn[q] * av[q]; }
            if (kq == 0) BS[(size_t)tok * 16 + h] = bsum;
            { const int itn = it + F.G; if (itn < 32 * 1024) PREP_LOAD(itn); }
            *(LAS f32x2*)(EE + tt * 64 + 2 * kq) = (f32x2){e2[0], e2[1]};
            *(LAS f32x2*)(VV + tt * 64 + 2 * kq) = (f32x2){lo2f(vw), hi2f(vw)};
        }
        __syncthreads();
        {
            float L[2] = {0.f, 0.f}, L15[2] = {0.f, 0.f};
#pragma unroll
            for (int i = 0; i < 16; ++i) { const f32x2 ev = *(const LAS f32x2*)(EE + i * 64 + 2 * kq); L15[0] += ev.x; L15[1] += ev.y; if (i <= tt) { L[0] += ev.x; L[1] += ev.y; } }
            float kh[2], ah[2], bhv[2], rh[2], ap[2], bp[2];
#pragma unroll
            for (int q = 0; q < 2; ++q) { const float wt = __expf(-L[q]), iwt = __expf(L[q]), wprev = __expf(-(L[q] - e2[q])), wrest = __expf(-(L15[q] - L[q]));
                kh[q] = kkn[q] * wprev; ah[q] = kka[q] * iwt; bhv[q] = kp[q] * iwt; rh[q] = r2[q] * wt; ap[q] = kka[q] * wrest; bp[q] = kp[q] * wrest;
                if (tt == 15) WW[2 * kq + q] = wt; }
            KHf[tt * 65 + 2 * kq] = kh[0]; KHf[tt * 65 + 2 * kq + 1] = kh[1]; RHf[tt * 65 + 2 * kq] = rh[0]; RHf[tt * 65 + 2 * kq + 1] = rh[1]; BPf[tt * 65 + 2 * kq] = bp[0]; BPf[tt * 65 + 2 * kq + 1] = bp[1];
            *(LAS unsigned*)(KHb + tt * 72 + 2 * kq) = pk2(kh[0], kh[1]); *(LAS unsigned*)(AHb + tt * 72 + 2 * kq) = pk2(ah[0], ah[1]);
            *(LAS unsigned*)(BHb + tt * 72 + 2 * kq) = pk2(bhv[0], bhv[1]); *(LAS unsigned*)(RHb + tt * 72 + 2 * kq) = pk2(rh[0], rh[1]);
            APT[(2 * kq) * 24 + tt] = (bf16)f2bf(ap[0]); APT[(2 * kq + 1) * 24 + tt] = (bf16)f2bf(ap[1]);
        }
        __syncthreads();
        if (F.wave < 4) {
            const int mat = F.wave; const LAS bf16* X = (mat & 1) ? BHb : AHb; const LAS bf16* Y = (mat & 2) ? RHb : KHb;
            f32x4 acc = {0.f, 0.f, 0.f, 0.f};
#pragma unroll
            for (int ks = 0; ks < 2; ++ks) acc = __builtin_amdgcn_mfma_f32_16x16x32_bf16(*(const LAS bf16x8*)(X + l15 * 72 + 32 * ks + 8 * g), *(const LAS bf16x8*)(Y + l15 * 72 + 32 * ks + 8 * g), acc, 0, 0, 0);
            LAS float* dst = (mat == 0) ? GA : ((mat == 1) ? GB : ((mat == 2) ? GMA : GMB));
#pragma unroll
            for (int rg_ = 0; rg_ < 4; ++rg_) { const int i = 4 * g + rg_; const bool nz = (mat & 2) ? (i <= l15) : (i < l15); const float v = nz ? acc[rg_] : 0.f;
                dst[i * 17 + l15] = v; if (mat == 2) MAT[l15 * 24 + i] = (bf16)f2bf(v); }
        }
        __syncthreads();
        if (F.tid < 16) {
            float x[16];
#pragma unroll
            for (int i = 15; i >= 0; --i) { float v = (i == F.tid) ? 1.0f : 0.f;
#pragma unroll
                for (int m = i + 1; m < 16; ++m) v -= GA[i * 17 + m] * x[m];
                x[i] = v; }
#pragma unroll
            for (int i = 0; i < 16; ++i) TT[i * 17 + F.tid] = x[i];
        }
        __syncthreads();
        {
            float x0 = 0.f, x1 = 0.f;
#pragma unroll
            for (int m = 0; m < 16; ++m) { const float tv = TT[m * 17 + tt]; x0 -= KHf[m * 65 + 2 * kq] * tv; x1 -= KHf[m * 65 + 2 * kq + 1] * tv; }
            P1b[(2 * kq) * 24 + tt] = (bf16)f2bf(x0); P1b[(2 * kq + 1) * 24 + tt] = (bf16)f2bf(x1);
            if (F.tid < 256) { const int i = F.tid >> 4, t = F.tid & 15; float x = 0.f;
#pragma unroll
                for (int m = 0; m < 16; ++m) x -= GB[i * 17 + m] * TT[m * 17 + t];
                P2b[i * 24 + t] = (bf16)f2bf(x); }
        }
        __syncthreads();
        {
            unsigned char* fr = FR + (size_t)it * FR_BYTES;
            const int mt = F.wave >> 1, ks = F.wave & 1;
            const bf16x8 aP0 = (g < 2) ? *(const LAS bf16x8*)(P1b + (16 * (2 * ks) + l15) * 24 + 8 * g) : zero8;
            const bf16x8 aP1 = (g < 2) ? *(const LAS bf16x8*)(P1b + (16 * (2 * ks + 1) + l15) * 24 + 8 * g) : zero8;
            const bf16x8 bAP = (g < 2) ? *(const LAS bf16x8*)(APT + (16 * mt + l15) * 24 + 8 * g) : zero8;
            const f32x4 z4 = {0.f, 0.f, 0.f, 0.f};
            const f32x4 d0 = __builtin_amdgcn_mfma_f32_16x16x32_bf16(aP0, bAP, z4, 0, 0, 0), d1 = __builtin_amdgcn_mfma_f32_16x16x32_bf16(aP1, bAP, z4, 0, 0, 0);
            *(u32x4*)(fr + (size_t)(F.wave * 64 + F.lane) * 16) = (u32x4){pk2(d0[0], d0[1]), pk2(d0[2], d0[3]), pk2(d1[0], d1[1]), pk2(d1[2], d1[3])};
            if (F.wave < 4) {
                const bf16x8 aP2 = (g < 2) ? *(const LAS bf16x8*)(P2b + l15 * 24 + 8 * g) : zero8;
                const bf16x8 bA = (g < 2) ? *(const LAS bf16x8*)(APT + (16 * F.wave + l15) * 24 + 8 * g) : zero8;
                f32x4 d = __builtin_amdgcn_mfma_f32_16x16x32_bf16(aP2, bA, z4, 0, 0, 0);
#pragma unroll
                for (int rg_ = 0; rg_ < 4; ++rg_) d[rg_] += BPf[(4 * g + rg_) * 65 + 16 * F.wave + l15];
                *(u32x2*)(fr + 8192 + (size_t)(F.wave * 64 + F.lane) * 8) = (u32x2){pk2(d[0], d[1]), pk2(d[2], d[3])};
            } else if (F.wave < 6) {
                const int ks2 = F.wave - 4;
                const bf16x8 a0 = (g < 2) ? *(const LAS bf16x8*)(P1b + (16 * (2 * ks2) + l15) * 24 + 8 * g) : zero8;
                const bf16x8 a1 = (g < 2) ? *(const LAS bf16x8*)(P1b + (16 * (2 * ks2 + 1) + l15) * 24 + 8 * g) : zero8;
                const bf16x8 bM = (g < 2) ? *(const LAS bf16x8*)(MAT + l15 * 24 + 8 * g) : zero8;
                f32x4 q0 = __builtin_amdgcn_mfma_f32_16x16x32_bf16(a0, bM, z4, 0, 0, 0), q1 = __builtin_amdgcn_mfma_f32_16x16x32_bf16(a1, bM, z4, 0, 0, 0);
#pragma unroll
                for (int rg_ = 0; rg_ < 4; ++rg_) { q0[rg_] += RHf[l15 * 65 + 16 * (2 * ks2) + 4 * g + rg_]; q1[rg_] += RHf[l15 * 65 + 16 * (2 * ks2 + 1) + 4 * g + rg_]; }
                *(u32x4*)(fr + 10240 + (size_t)(ks2 * 64 + F.lane) * 16) = (u32x4){pk2(q0[0], q0[1]), pk2(q0[2], q0[3]), pk2(q1[0], q1[1]), pk2(q1[2], q1[3])};
            } else if (F.wave == 6) {
                const bf16x8 aP2 = (g < 2) ? *(const LAS bf16x8*)(P2b + l15 * 24 + 8 * g) : zero8;
                const bf16x8 bM = (g < 2) ? *(const LAS bf16x8*)(MAT + l15 * 24 + 8 * g) : zero8;
                f32x4 d = __builtin_amdgcn_mfma_f32_16x16x32_bf16(aP2, bM, z4, 0, 0, 0);
#pragma unroll
                for (int rg_ = 0; rg_ < 4; ++rg_) d[rg_] += GMB[(4 * g + rg_) * 17 + l15];
                *(u32x2*)(fr + 12288 + (size_t)F.lane * 8) = (u32x2){pk2(d[0], d[1]), pk2(d[2], d[3])};
            } else {
                *(float*)(fr + 14848 + F.lane * 4) = WW[F.lane];
            }
            if (F.tid < 256) {
                const int rg = F.tid >> 6, row = 16 * rg + l15, s4 = 4 * g;
                *(u32x2*)(fr + 12800 + (size_t)(rg * 64 + F.lane) * 8) = (u32x2){pk2(VV[s4 * 64 + row], VV[(s4 + 1) * 64 + row]), pk2(VV[(s4 + 2) * 64 + row], VV[(s4 + 3) * 64 + row])};
            }
        }
    }
}
struct ScanFrag { u32x4 g[4][2]; u32x2 f[4]; u32x4 q1[2]; u32x2 q2; u32x2 vt; f32x4 w[4]; };
__device__ __forceinline__ void scan_frag_load(ScanFrag& fr, const unsigned char* base, int rg, int lane) {
#pragma unroll
    for (int mt = 0; mt < 4; ++mt) {
#pragma unroll
        for (int ks = 0; ks < 2; ++ks) fr.g[mt][ks] = *(const u32x4*)(base + (size_t)((mt * 2 + ks) * 64 + lane) * 16);
        fr.f[mt] = *(const u32x2*)(base + 8192 + (size_t)(mt * 64 + lane) * 8);
        fr.w[mt] = *(const f32x4*)(base + 14848 + (16 * mt + 4 * (lane >> 4)) * 4); }
#pragma unroll
    for (int ks = 0; ks < 2; ++ks) fr.q1[ks] = *(const u32x4*)(base + 10240 + (size_t)(ks * 64 + lane) * 16);
    fr.q2 = *(const u32x2*)(base + 12288 + (size_t)lane * 8);
    fr.vt = *(const u32x2*)(base + 12800 + (size_t)(rg * 64 + lane) * 8);
}
__device__ __forceinline__ void scan_chunk(f32x4 (&acc)[4], const ScanFrag& fr, bf16* yout) {
    const bf16x8 sb0 = as_bf8((u32x4){pk2(acc[0][0], acc[0][1]), pk2(acc[0][2], acc[0][3]), pk2(acc[1][0], acc[1][1]), pk2(acc[1][2], acc[1][3])});
    const bf16x8 sb1 = as_bf8((u32x4){pk2(acc[2][0], acc[2][1]), pk2(acc[2][2], acc[2][3]), pk2(acc[3][0], acc[3][1]), pk2(acc[3][2], acc[3][3])});
    const bf16x8 vb = as_bf8((u32x4){fr.vt.x, fr.vt.y, 0u, 0u});
#pragma unroll
    for (int c = 0; c < 4; ++c) { f32x4 n = acc[c] * fr.w[c];
        n = __builtin_amdgcn_mfma_f32_16x16x32_bf16(as_bf8(fr.g[c][0]), sb0, n, 0, 0, 0);
        n = __builtin_amdgcn_mfma_f32_16x16x32_bf16(as_bf8(fr.g[c][1]), sb1, n, 0, 0, 0);
        n = __builtin_amdgcn_mfma_f32_16x16x32_bf16(as_bf8((u32x4){fr.f[c].x, fr.f[c].y, 0u, 0u}), vb, n, 0, 0, 0);
        acc[c] = n; }
    f32x4 y = {0.f, 0.f, 0.f, 0.f};
    y = __builtin_amdgcn_mfma_f32_16x16x32_bf16(as_bf8(fr.q1[0]), sb0, y, 0, 0, 0);
    y = __builtin_amdgcn_mfma_f32_16x16x32_bf16(as_bf8(fr.q1[1]), sb1, y, 0, 0, 0);
    y = __builtin_amdgcn_mfma_f32_16x16x32_bf16(as_bf8((u32x4){fr.q2.x, fr.q2.y, 0u, 0u}), vb, y, 0, 0, 0);
    *(u32x2*)yout = (u32x2){pk2(y[0], y[1]), pk2(y[2], y[3])};
}
#define SCAN_ASM_LD4(dst, ptr, off) asm volatile("global_load_dwordx4 %0, %1, off offset:" #off : "=v"(dst) : "v"(ptr))
#define SCAN_ASM_LD2(dst, ptr, off) asm volatile("global_load_dwordx2 %0, %1, off offset:" #off : "=v"(dst) : "v"(ptr))
__device__ __forceinline__ void scan_frag_issue(ScanFrag& fr, const unsigned char* item, int rg, int lane) {
    const unsigned char* pg0 = item + lane * 16; const unsigned char* pg1 = pg0 + 4096;
    const unsigned char* pf = item + 8192 + lane * 8; const unsigned char* pq1 = item + 10240 + lane * 16;
    const unsigned char* pq2 = item + 12288 + lane * 8; const unsigned char* pvt = item + 12800 + (rg * 64 + lane) * 8; const unsigned char* pw = item + 14848 + (lane >> 4) * 16;
    SCAN_ASM_LD4(fr.g[0][0], pg0, 0); SCAN_ASM_LD4(fr.g[0][1], pg0, 1024); SCAN_ASM_LD4(fr.g[1][0], pg0, 2048); SCAN_ASM_LD4(fr.g[1][1], pg0, 3072);
    SCAN_ASM_LD4(fr.g[2][0], pg1, 0); SCAN_ASM_LD4(fr.g[2][1], pg1, 1024); SCAN_ASM_LD4(fr.g[3][0], pg1, 2048); SCAN_ASM_LD4(fr.g[3][1], pg1, 3072);
    SCAN_ASM_LD2(fr.f[0], pf, 0); SCAN_ASM_LD2(fr.f[1], pf, 512); SCAN_ASM_LD2(fr.f[2], pf, 1024); SCAN_ASM_LD2(fr.f[3], pf, 1536);
    SCAN_ASM_LD4(fr.q1[0], pq1, 0); SCAN_ASM_LD4(fr.q1[1], pq1, 1024);
    SCAN_ASM_LD2(fr.q2, pq2, 0); SCAN_ASM_LD2(fr.vt, pvt, 0);
    SCAN_ASM_LD4(fr.w[0], pw, 0); SCAN_ASM_LD4(fr.w[1], pw, 64); SCAN_ASM_LD4(fr.w[2], pw, 128); SCAN_ASM_LD4(fr.w[3], pw, 192);
}
#define SCAN_WAIT(fr, N) asm volatile("s_waitcnt vmcnt(" #N ")" : "+v"(fr.g[0][0]), "+v"(fr.g[0][1]), "+v"(fr.g[1][0]), "+v"(fr.g[1][1]), "+v"(fr.g[2][0]), "+v"(fr.g[2][1]), "+v"(fr.g[3][0]), "+v"(fr.g[3][1]), \
        "+v"(fr.f[0]), "+v"(fr.f[1]), "+v"(fr.f[2]), "+v"(fr.f[3]), "+v"(fr.q1[0]), "+v"(fr.q1[1]), "+v"(fr.q2), "+v"(fr.vt), "+v"(fr.w[0]), "+v"(fr.w[1]), "+v"(fr.w[2]), "+v"(fr.w[3]) :: "memory")
__device__ __forceinline__ void scan_mfma_rows(const Args& A, Frame& F) {
    const unsigned char* FR = A.ws + WS_BIG; bf16* YRAW = (bf16*)A.out + (size_t)3 * TOK * 1024;
    if (F.wave != 0) return;
    for (int u = F.bx; u < 128; u += F.G) {
        const int bh = u & 31, rg = u >> 5; const unsigned char* base = FR + (size_t)bh * 1024 * FR_BYTES;
        bf16* yrow = YRAW + ((size_t)bh * 64 + 16 * rg + (F.lane & 15)) * SEQ + 4 * (F.lane >> 4);
        f32x4 acc[4];
#pragma unroll
        for (int c = 0; c < 4; ++c) acc[c] = (f32x4){0.f, 0.f, 0.f, 0.f};
        ScanFrag fa, fb;
        scan_frag_issue(fa, base, rg, F.lane);
#pragma unroll 1
        for (int ch = 0; ch < 1024; ch += 2) {
            scan_frag_issue(fb, base + (size_t)(ch + 1) * FR_BYTES, rg, F.lane);
            SCAN_WAIT(fa, 20);
            scan_chunk(acc, fa, yrow + ch * 16);
            scan_frag_issue(fa, base + (size_t)((ch + 2 < 1024) ? (ch + 2) : ch) * FR_BYTES, rg, F.lane);
            SCAN_WAIT(fb, 20);
            scan_chunk(acc, fb, yrow + (ch + 1) * 16);
        }
        asm volatile("s_waitcnt vmcnt(0)" ::: "memory");
    }
}

__device__ __forceinline__ void pair_sync(volatile LAS unsigned* cnt, unsigned target) {
    asm volatile("s_waitcnt vmcnt(0) lgkmcnt(0)" ::: "memory");
    if ((threadIdx.x & 63) == 0) (void)__hip_atomic_fetch_add((LAS unsigned*)cnt, 1u, __ATOMIC_RELAXED, __HIP_MEMORY_SCOPE_WORKGROUP);
    while (__hip_atomic_load((LAS unsigned*)cnt, __ATOMIC_RELAXED, __HIP_MEMORY_SCOPE_WORKGROUP) < target) __builtin_amdgcn_s_sleep(1);
    asm volatile("" ::: "memory");
}
__device__ __forceinline__ void swa_pairs(const Args& A, Frame& F, volatile LAS unsigned* MISC) {
    const bf16* Z = (const bf16*)(A.ws + WS_Z); bf16* Y = (bf16*)(A.ws + WS_HY); const float* sinks = (const float*)A.in[5];
    const int pr = (F.wave - 4) >> 1, mem = F.wave & 1;
    LAS unsigned char* KL = F.lds + pr * 69632; LAS unsigned char* VL = KL + 256 * 136;
    volatile LAS unsigned* cnt = MISC + 24 + pr; unsigned gen = 0u;
    for (int u = F.bx * 2 + pr; u < 512; u += F.G * 2) {
        const int b = u >> 8, n = (u >> 1) & 127, kvh = u & 1;
        gen += 2u; pair_sync(cnt, gen);
#pragma unroll 1
        for (int c0 = mem * 1024 + F.lane; c0 < mem * 1024 + 1024; c0 += 64 * 8) {
            u32x4 kv[8], vv[8];
#pragma unroll
            for (int q = 0; q < 8; ++q) { const int c = c0 + 64 * q; const int jw = c >> 3, cc = c & 7; const int sp = n * 128 - 128 + jw;
                kv[q] = (u32x4){0u, 0u, 0u, 0u}; vv[q] = kv[q];
                if (sp >= 0) { const bf16* row = Z + (size_t)(b * SEQ + sp) * EV_NP; kv[q] = *(const u32x4*)(row + 1024 + kvh * 64 + cc * 8); vv[q] = *(const u32x4*)(row + 1152 + kvh * 64 + cc * 8); } }
#pragma unroll
            for (int q = 0; q < 8; ++q) { const int c = c0 + 64 * q; const int jw = c >> 3, cc = c & 7;
                *(LAS u32x2*)(KL + jw * 136 + cc * 16) = (u32x2){kv[q].x, kv[q].y}; *(LAS u32x2*)(KL + jw * 136 + cc * 16 + 8) = (u32x2){kv[q].z, kv[q].w};
                *(LAS u32x2*)(VL + jw * 136 + cc * 16) = (u32x2){vv[q].x, vv[q].y}; *(LAS u32x2*)(VL + jw * 136 + cc * 16 + 8) = (u32x2){vv[q].z, vv[q].w}; }
        }
        gen += 2u; pair_sync(cnt, gen);
        for (int it = mem; it < 1024; it += 2) {
            const int i = it >> 3, g = it & 7, head = kvh * 8 + g; const int t = b * SEQ + n * 128 + i;
            const float qv = bf2f(Z[(size_t)t * EV_NP + head * 64 + F.lane]) * 0.125f;
            const int jw0 = i + 1 + F.lane, jw1 = jw0 + 64;
            const bool val0 = (n > 0) || (jw0 >= 128), val1 = (n > 0) || (jw1 >= 128);
            float s0 = 0.f, s1 = 0.f;
#pragma unroll
            for (int d4 = 0; d4 < 16; ++d4) {
                const u32x2 k0 = *(const LAS u32x2*)(KL + jw0 * 136 + d4 * 8), k1 = *(const LAS u32x2*)(KL + jw1 * 136 + d4 * 8);
                const float q0 = rdlane(qv, 4 * d4), q1 = rdlane(qv, 4 * d4 + 1), q2 = rdlane(qv, 4 * d4 + 2), q3 = rdlane(qv, 4 * d4 + 3);
                s0 += q0 * lo2f(k0.x) + q1 * hi2f(k0.x) + q2 * lo2f(k0.y) + q3 * hi2f(k0.y);
                s1 += q0 * lo2f(k1.x) + q1 * hi2f(k1.x) + q2 * lo2f(k1.y) + q3 * hi2f(k1.y);
            }
            const float sink = sinks[head];
            s0 = val0 ? s0 : -INFINITY; s1 = val1 ? s1 : -INFINITY;
            const float mx = fmaxf(wmax(fmaxf(s0, s1)), sink);
            float p0 = val0 ? expf(s0 - mx) : 0.f, p1 = val1 ? expf(s1 - mx) : 0.f;
            const float den = wsum(p0 + p1) + expf(sink - mx); const float rden = 1.0f / den;
            p0 *= rden; p1 *= rden;
            float o = 0.f;
            const LAS bf16* vcol = (const LAS bf16*)VL + F.lane;
#pragma unroll 8
            for (int jj = 0; jj < 64; ++jj) o += rdlane(p0, jj) * bf2f(vcol[(i + 1 + jj) * 68]);
#pragma unroll 8
            for (int jj = 0; jj < 64; ++jj) o += rdlane(p1, jj) * bf2f(vcol[(i + 65 + jj) * 68]);
            Y[(size_t)t * DM + head * 64 + F.lane] = (bf16)f2bf(o);
        }
    }
}

__device__ __forceinline__ void wsum2_dpp(float a, float b, float& ra, float& rb) {
    const auto r = __builtin_amdgcn_permlane32_swap(__float_as_uint(a), __float_as_uint(b), false, false);
    float v = __uint_as_float(r[0]) + __uint_as_float(r[1]);
    v += dppf<0xB1, 0xF>(v); v += dppf<0x4E, 0xF>(v); v += dppf<0x141, 0xF>(v); v += dppf<0x140, 0xF>(v);
    v += dppf<0x142, 0xA>(v);
    ra = rdlane(v, 31); rb = rdlane(v, 63);
}
__device__ __forceinline__ void ph_scan(const Args& A, Frame& F, volatile LAS unsigned* MISC) {
    const unsigned* PK = (const unsigned*)(A.ws + WS_BIG); bf16* YRAW = (bf16*)A.out + (size_t)3 * TOK * 1024;
    if (F.wave >= 4) { swa_pairs(A, F, MISC); return; }
    __builtin_amdgcn_s_setprio(3);
    for (int pp = F.bx * 4 + F.wave; pp < 1024; pp += F.G * 4) {
        const int rr = 2 * pp, bh = rr >> 6, vrow = rr & 63;
        const unsigned* pk = PK + ((size_t)bh * SEQ * 64 + F.lane) * 3;
        bf16* youtA = YRAW + ((size_t)bh * 64 + vrow) * SEQ; bf16* youtB = youtA + SEQ;
        f32x2 S2 = {0.f, 0.f};
        for (int t0 = 0; t0 < SEQ; t0 += 64) {
            float ykA = 0.f, ykB = 0.f;
#pragma unroll 8
            for (int j = 0; j < 64; ++j) {
                const unsigned* p = pk + (size_t)(t0 + j) * 192;
                const unsigned w0 = p[0], w1 = p[1], w2 = p[2];
                const float r = lo2f(w0), e = hi2f(w0), kp = lo2f(w1), kk = hi2f(w1), kka = lo2f(w2), vv = hi2f(w2);
                const f32x2 v2 = {rdlane(vv, vrow), rdlane(vv, vrow + 1)};
                const float dec = __expf(-e);
                const f32x2 pk2v = S2 * (f32x2){kk, kk};
                float saA, saB; wsum2_dpp(pk2v.x, pk2v.y, saA, saB); const f32x2 sa2 = {saA, saB};
                S2 = S2 * (f32x2){dec, dec} + (v2 * (f32x2){kp, kp} - sa2 * (f32x2){kka, kka});
                const f32x2 py = S2 * (f32x2){r, r};
                float yA, yB; wsum2_dpp(py.x, py.y, yA, yB);
                ykA = (F.lane == j) ? yA : ykA; ykB = (F.lane == j) ? yB : ykB;
            }
            youtA[t0 + F.lane] = (bf16)f2bf(ykA); youtB[t0 + F.lane] = (bf16)f2bf(ykB);
        }
    }
    __builtin_amdgcn_s_setprio(0);
}

__device__ __forceinline__ void ph_rwkv_finish(const Args& A, Frame& F) {
    const bf16* Z = (const bf16*)(A.ws + WS_Z); const bf16* RKV = (const bf16*)A.out; const bf16* YRAW = (const bf16*)A.out + (size_t)3 * TOK * 1024;
    const float* BS = (const float*)(A.ws + WS_BS); bf16* Y = (bf16*)(A.ws + WS_HY);
    const float* lnx_g = (const float*)A.in[15]; const float* lnx_b = (const float*)A.in[16];
    LAS float* tile = (LAS float*)(F.lds + F.wave * 16640);
    for (int it = F.gw; it < 8192; it += F.ngw) {
        const int bh = it >> 8, tb = it & 255, b = bh >> 4, h = bh & 15, t0 = tb * 64;
        for (int vr = 0; vr < 64; ++vr) tile[vr * 65 + F.lane] = bf2f(YRAW[((size_t)bh * 64 + vr) * SEQ + t0 + F.lane]);
        asm volatile("s_waitcnt lgkmcnt(0)" ::: "memory");
        const int c = h * 64 + F.lane; const float lg = lnx_g[c], lb = lnx_b[c];
        for (int j = 0; j < 64; ++j) {
            const int t = b * SEQ + t0 + j;
            const float y = tile[F.lane * 65 + j];
            const float mean = wsum(y) * (1.0f / 64.0f); const float d = y - mean; const float var = wsum(d * d) * (1.0f / 64.0f);
            const float yn = d * rsqrtf(var + 64e-5f) * lg + lb;
            const float vv = bf2f(RKV[(size_t)2 * TOK * 1024 + (size_t)t * 1024 + c]); const float g = bf2f(Z[(size_t)t * EV_NP + 1280 + 2048 + c]); const float bs = BS[(size_t)t * 16 + h];
            Y[(size_t)t * DM + 1024 + c] = (bf16)f2bf((yn + bs * vv) * g);
        }
        asm volatile("s_waitcnt lgkmcnt(0)" ::: "memory");
    }
}

constexpr size_t WS_H8 = WS_BIG + 384 * MiB, WS_HS = WS_BIG + 448 * MiB;
__device__ __forceinline__ unsigned pack_i8x4(float a, float b, float c, float d) {
    const unsigned ua = __float_as_uint(a + 12582912.0f) & 255u, ub = __float_as_uint(b + 12582912.0f) & 255u, uc = __float_as_uint(c + 12582912.0f) & 255u, ud = __float_as_uint(d + 12582912.0f);
    return ua | (ub << 8) | (uc << 16) | (ud << 24);
}
__device__ __forceinline__ void ph_ln_mixer(const Args& A, Frame& F, const int L) {
    const float* xsrc = (const float*)A.in[0]; const bf16* xsrcb = (const bf16*)A.out;
    bf16* xdst = (L == 0) ? (bf16*)A.out : (bf16*)(A.ws + WS_Z + 160 * MiB);
    const bf16* O = (const bf16*)(A.ws + WS_Z); bf16* H = (bf16*)(A.ws + WS_HY); const float* MOD = (const float*)(A.ws + WS_MOD);
    const float* lng = (const float*)A.in[21] + (size_t)(L * 2 + 0) * DM; const float* lnb = (const float*)A.in[22] + (size_t)(L * 2 + 0) * DM;
    for (int t = F.gw; t < TOK; t += F.ngw) {
        const int b = t >> 14;
        const float* gate = MOD + (size_t)((L * 2 + 0) * 2 + b) * 6144 + 4096;
        const float* sh = MOD + (size_t)((L * 2 + 1) * 2 + b) * 6144; const float* sc = sh + 2048;
        float v[32]; float sum = 0.f;
#pragma unroll
        for (int j = 0; j < 4; ++j) { const int base = (j * 64 + F.lane) * 8;
            const u32x4 ow = *(const u32x4*)(O + (size_t)t * DM + base);
            f32x4 x0, x1;
            if (L == 0) { x0 = *(const f32x4*)(xsrc + (size_t)t * DM + base); x1 = *(const f32x4*)(xsrc + (size_t)t * DM + base + 4); }
            else { const u32x4 xw = *(const u32x4*)(xsrcb + (size_t)t * DM + base); x0 = (f32x4){lo2f(xw.x), hi2f(xw.x), lo2f(xw.y), hi2f(xw.y)}; x1 = (f32x4){lo2f(xw.z), hi2f(xw.z), lo2f(xw.w), hi2f(xw.w)}; }
            const f32x4 g0 = *(const f32x4*)(gate + base), g1 = *(const f32x4*)(gate + base + 4);
            const float of[8] = {lo2f(ow.x), hi2f(ow.x), lo2f(ow.y), hi2f(ow.y), lo2f(ow.z), hi2f(ow.z), lo2f(ow.w), hi2f(ow.w)};
#pragma unroll
            for (int e = 0; e < 4; ++e) { v[j * 8 + e] = ALPHA * x0[e] + (1.0f + g0[e]) * of[e]; v[j * 8 + 4 + e] = ALPHA * x1[e] + (1.0f + g1[e]) * of[4 + e]; }
#pragma unroll
            for (int e = 0; e < 8; ++e) sum += v[j * 8 + e]; }
        const float mean = wsum(sum) * (1.0f / DM); float sq = 0.f;
#pragma unroll
        for (int e = 0; e < 32; ++e) { v[e] -= mean; sq += v[e] * v[e]; }
        const float rstd = rsqrtf(wsum(sq) * (1.0f / DM) + 1e-5f); float hmax = 0.f;
#pragma unroll
        for (int j = 0; j < 4; ++j) { const int base = (j * 64 + F.lane) * 8;
            const f32x4 lg0 = *(const f32x4*)(lng + base), lg1 = *(const f32x4*)(lng + base + 4), lb0 = *(const f32x4*)(lnb + base), lb1 = *(const f32x4*)(lnb + base + 4);
            const f32x4 s0 = *(const f32x4*)(sc + base), s1 = *(const f32x4*)(sc + base + 4), h0 = *(const f32x4*)(sh + base), h1 = *(const f32x4*)(sh + base + 4);
            f32x4 o0, o1;
#pragma unroll
            for (int e = 0; e < 4; ++e) { o0[e] = v[j * 8 + e] * rstd * lg0[e] + lb0[e]; o1[e] = v[j * 8 + 4 + e] * rstd * lg1[e] + lb1[e]; }
            { u32x4 xw; xw.x = pk2(o0[0], o0[1]); xw.y = pk2(o0[2], o0[3]); xw.z = pk2(o1[0], o1[1]); xw.w = pk2(o1[2], o1[3]); *(u32x4*)(xdst + (size_t)t * DM + base) = xw; }
            const f32x4 q0 = o0 * (1.0f + s0) + h0, q1 = o1 * (1.0f + s1) + h1;
            u32x4 w; w.x = pk2(q0[0], q0[1]); w.y = pk2(q0[2], q0[3]); w.z = pk2(q1[0], q1[1]); w.w = pk2(q1[2], q1[3]);
            *(u32x4*)(H + (size_t)t * DM + base) = w;
#pragma unroll
            for (int e = 0; e < 4; ++e) { v[j * 8 + e] = q0[e]; v[j * 8 + 4 + e] = q1[e]; hmax = fmaxf(hmax, fmaxf(fabsf(q0[e]), fabsf(q1[e]))); } }
        { hmax = wmax(hmax); const float inv = (hmax > 0.f) ? 127.0f / hmax : 0.f;
#pragma unroll
          for (int j = 0; j < 4; ++j) { const int base = (j * 64 + F.lane) * 8; u32x2 w8;
              w8.x = pack_i8x4(v[j * 8 + 0] * inv, v[j * 8 + 1] * inv, v[j * 8 + 2] * inv, v[j * 8 + 3] * inv); w8.y = pack_i8x4(v[j * 8 + 4] * inv, v[j * 8 + 5] * inv, v[j * 8 + 6] * inv, v[j * 8 + 7] * inv);
              *(u32x2*)(A.ws + WS_H8 + (size_t)t * DM + base) = w8; }
          if (F.lane == 0) ((float*)(A.ws + WS_HS))[t] = hmax * (1.0f / 127.0f); }
    }
    {
        const float* pu = (const float*)A.in[25] + (size_t)L * 16384 * 2048; const float* pv = (const float*)A.in[26] + (size_t)L * 16384 * 2048;
        unsigned char* T8 = A.ws + WS_BIG; float* SCL = (float*)(A.ws + WS_BIG + 64 * MiB);
        for (int r = F.gw; r < 32768; r += F.ngw) {
            const float* src = ((r < 16384) ? pu : pv) + (size_t)(r & 16383) * 2048;
            f32x4 f[2][4]; float amax = 0.f;
#pragma unroll
            for (int j = 0; j < 2; ++j)
#pragma unroll
                for (int c = 0; c < 4; ++c) { f[j][c] = *(const f32x4*)(src + (j * 64 + F.lane) * 16 + 4 * c);
                    amax = fmaxf(amax, fmaxf(fmaxf(fabsf(f[j][c][0]), fabsf(f[j][c][1])), fmaxf(fabsf(f[j][c][2]), fabsf(f[j][c][3])))); }
            amax = wmax(amax);
            {
                const float inv = (amax > 0.f) ? 127.0f / amax : 0.f;
#pragma unroll
                for (int j = 0; j < 2; ++j) { u32x4 w;
                    w.x = pack_i8x4(f[j][0][0] * inv, f[j][0][1] * inv, f[j][0][2] * inv, f[j][0][3] * inv); w.y = pack_i8x4(f[j][1][0] * inv, f[j][1][1] * inv, f[j][1][2] * inv, f[j][1][3] * inv);
                    w.z = pack_i8x4(f[j][2][0] * inv, f[j][2][1] * inv, f[j][2][2] * inv, f[j][2][3] * inv); w.w = pack_i8x4(f[j][3][0] * inv, f[j][3][1] * inv, f[j][3][2] * inv, f[j][3][3] * inv);
                    *(u32x4*)(T8 + (size_t)r * 2048 + (j * 64 + F.lane) * 16) = w; }
                if (F.lane == 0) SCL[r] = amax * (1.0f / 127.0f);
            }
        }
    }
}

template <int NV, int NBITS> __device__ __forceinline__ unsigned wave_tau16(const unsigned (&key)[NV]) {
    unsigned tau = 0u;
#pragma unroll 1
    for (int bit = NBITS - 1; bit >= 0; --bit) {
        const unsigned cand = tau | (1u << bit); int cnt = 0;
#pragma unroll
        for (int v = 0; v < NV; ++v) cnt += __popcll(__ballot(key[v] >= cand));
        if (cnt >= 16) tau = cand;
    }
    return tau;
}
template <int NV> __device__ __forceinline__ void wave_compact16(const unsigned (&key)[NV], const float (&val)[NV], const int (&id)[NV], unsigned tau, LAS float* ov, LAS int* oi, int lane) {
    int ngt = 0;
#pragma unroll
    for (int v = 0; v < NV; ++v) ngt += __popcll(__ballot(key[v] > tau));
    int bg = 0, be = 0;
#pragma unroll
    for (int v = 0; v < NV; ++v) {
        const bool gt = key[v] > tau, eq = key[v] == tau;
        const unsigned long long mg = __ballot(gt), me = __ballot(eq);
        const unsigned long long below = (lane == 0) ? 0ull : ((~0ull) >> (64 - lane));
        const int pg = bg + __popcll(mg & below), pe = ngt + be + __popcll(me & below);
        if (gt) { ov[pg] = val[v]; oi[pg] = id[v]; }
        if (eq && pe < 16) { ov[pe] = val[v]; oi[pe] = id[v]; }
        bg += __popcll(mg); be += __popcll(me);
    }
}

template <int CTRL, int BANK> __device__ __forceinline__ unsigned dppb(unsigned old, unsigned v) { return (unsigned)__builtin_amdgcn_update_dpp((int)old, (int)v, CTRL, 0xF, BANK, false); }
template <int CTRL> __device__ __forceinline__ unsigned dppm(unsigned v) { return (unsigned)__builtin_amdgcn_mov_dpp((int)v, CTRL, 0xF, 0xF, true); }
template <int CTRL> __device__ __forceinline__ unsigned cex(unsigned x, bool lo) { const unsigned mx = max(x, dppm<CTRL>(x)), mn = min(x, dppm<CTRL>(x)); return lo ? mx : mn; }
__device__ __forceinline__ unsigned cex4(unsigned x, bool lo) {
    unsigned t = (unsigned)__builtin_amdgcn_mov_dpp((int)x, 0x104, 0xF, 0x5, false); t = dppb<0x114, 0xA>(t, x); const unsigned mx = max(x, t), mn = min(x, t); return lo ? mx : mn; }
struct LoMasks { bool lo1, lo2, lo4, lo8, odd16, up32; };
__device__ __forceinline__ unsigned sort16_desc(unsigned x, const LoMasks& M) {
    x = cex<0xB1>(x, M.lo1);
    x = cex<0x1B>(x, M.lo2); x = cex<0xB1>(x, M.lo1);
    x = cex<0x141>(x, M.lo4); x = cex<0x4E>(x, M.lo2); x = cex<0xB1>(x, M.lo1);
    x = cex<0x140>(x, M.lo8); x = cex4(x, M.lo4); x = cex<0x4E>(x, M.lo2); x = cex<0xB1>(x, M.lo1);
    return x;
}
__device__ __forceinline__ unsigned clean16_desc(unsigned x, const LoMasks& M) {
    x = cex<0x128>(x, M.lo8); x = cex4(x, M.lo4); x = cex<0x4E>(x, M.lo2); x = cex<0xB1>(x, M.lo1); return x;
}
__device__ __forceinline__ unsigned mtop_regs(unsigned a, unsigned b) { return max(a, dppm<0x140>(b)); }
__device__ __forceinline__ unsigned mtop_rows(unsigned y, const LoMasks& M) { const auto r = __builtin_amdgcn_permlane16_swap(y, y, false, false); const unsigned pv = M.odd16 ? r[0] : r[1]; return mtop_regs(y, pv); }
__device__ __forceinline__ unsigned mtop_halves(unsigned y, const LoMasks& M) { const auto r = __builtin_amdgcn_permlane32_swap(y, y, false, false); const unsigned pv = M.up32 ? r[0] : r[1]; return mtop_regs(y, pv); }

template <int OFF, int N, int MASKX, int TOT> __device__ __forceinline__ void ce_stage(unsigned (&k)[TOT]) {
#pragma unroll
    for (int i = 0; i < N; ++i) { const int pr = i ^ MASKX; if (pr > i) { const unsigned a_ = k[OFF + i], b_ = k[OFF + pr]; k[OFF + i] = max(a_, b_); k[OFF + pr] = min(a_, b_); } }
}
template <int OFF, int TOT> __device__ __forceinline__ void sort16_regs(unsigned (&k)[TOT]) {
    ce_stage<OFF, 16, 1>(k); ce_stage<OFF, 16, 3>(k); ce_stage<OFF, 16, 1>(k); ce_stage<OFF, 16, 7>(k); ce_stage<OFF, 16, 2>(k); ce_stage<OFF, 16, 1>(k);
    ce_stage<OFF, 16, 15>(k); ce_stage<OFF, 16, 4>(k); ce_stage<OFF, 16, 2>(k); ce_stage<OFF, 16, 1>(k);
}
template <int TOT> __device__ __forceinline__ void clean16_regs(unsigned (&k)[TOT]) { ce_stage<0, 16, 8>(k); ce_stage<0, 16, 4>(k); ce_stage<0, 16, 2>(k); ce_stage<0, 16, 1>(k); }

__device__ __forceinline__ void ph_peer_select(const Args& A, Frame& F, const int L) {
    const bf16* QP = (const bf16*)(A.ws + WS_Z); const bf16* SKB = (const bf16*)(A.ws + WS_SKB) + (size_t)L * 262144;
    int* EID = (int*)(A.ws + WS_LA); float* GSM = (float*)(A.ws + WS_LA + 16 * MiB);
    LAS unsigned char* SKL = F.lds;
    LAS float* SCO = (LAS float*)(F.lds + 69632 + 4096);
    for (int it = F.bx; it < 4096; it += F.G) {
        const int tile = it >> 3, h = it & 7;
        __syncthreads();
        for (int c = F.tid; c < 4096; c += NTHREADS) { const int p = c >> 11, n = (c >> 4) & 127, cc = c & 15;
            *(LAS u32x4*)(SKL + (p * 128 + n) * 272 + cc * 16) = *(const u32x4*)(SKB + ((size_t)((p * 8 + h) * 128 + n)) * 128 + cc * 8); }
        __syncthreads();
        {
            const int p = F.wave >> 2, mt = F.wave & 3, g = F.lane >> 4, l15 = F.lane & 15;
            const bf16* qrow = QP + (size_t)(tile * 64 + mt * 16 + l15) * DM + h * 256 + p * 128 + 8 * g;
            bf16x8 afr[4];
#pragma unroll
            for (int ks = 0; ks < 4; ++ks) afr[ks] = *(const bf16x8*)(qrow + 32 * ks);
#pragma unroll
            for (int nt = 0; nt < 8; ++nt) {
                f32x4 acc = {0.f, 0.f, 0.f, 0.f};
#pragma unroll
                for (int ks = 0; ks < 4; ++ks) { const bf16x8 bfr = *(const LAS bf16x8*)(SKL + (p * 128 + nt * 16 + l15) * 272 + (32 * ks + 8 * g) * 2);
                    acc = __builtin_amdgcn_mfma_f32_16x16x32_bf16(afr[ks], bfr, acc, 0, 0, 0); }
#pragma unroll
                for (int rg = 0; rg < 4; ++rg) SCO[(p * 64 + mt * 16 + 4 * g + rg) * 132 + nt * 16 + l15] = acc[rg];
            }
        }
        __syncthreads();
        constexpr int NT = 4;
        LAS unsigned char* WB = F.lds + 141312 + F.wave * 2048;
        LoMasks M; M.lo1 = (F.lane & 1) == 0; M.lo2 = (F.lane & 2) == 0; M.lo4 = (F.lane & 4) == 0; M.lo8 = (F.lane & 8) == 0; M.odd16 = (F.lane & 16) != 0; M.up32 = (F.lane & 32) != 0;
        int pi_, pj_;
        { const int L = F.lane;
          if (L < 16) { pi_ = 0; pj_ = L; } else if (L < 24) { pi_ = 1; pj_ = L - 16; } else if (L < 29) { pi_ = 2; pj_ = L - 24; } else if (L < 33) { pi_ = 3; pj_ = L - 29; }
          else if (L < 36) { pi_ = 4; pj_ = L - 33; } else if (L < 42) { pi_ = 5 + ((L - 36) >> 1); pj_ = (L - 36) & 1; } else { pi_ = 8 + (L - 42); pj_ = 0; }
          if (L >= 50) { pi_ = 0; pj_ = 0; } }
        const bool pvalid = F.lane < 50;
        {
            const int g = F.lane >> 2, q = F.lane & 3, tok = g >> 1, sp = g & 1;
            const LAS float* srow = SCO + (sp * 64 + F.wave * 8 + tok) * 132;
            unsigned k[32]; const unsigned ib = (unsigned)(127 - q * 32);
#pragma unroll
            for (int c = 0; c < 8; ++c) { const f32x4 v = *(const LAS f32x4*)(srow + q * 32 + 4 * c);
#pragma unroll
                for (int e = 0; e < 4; ++e) k[4 * c + e] = (fixkey20(v[e]) << 7) | (ib - (unsigned)(4 * c + e)); }
            sort16_regs<0>(k); sort16_regs<16>(k);
            unsigned m[16], t2[16];
#pragma unroll
            for (int i = 0; i < 16; ++i) m[i] = max(k[i], k[31 - i]);
            clean16_regs(m);
#pragma unroll
            for (int i = 0; i < 16; ++i) t2[i] = max(m[i], dppm<0xB1>(m[15 - i]));
            clean16_regs(t2);
#pragma unroll
            for (int i = 0; i < 16; ++i) m[i] = max(t2[i], dppm<0x4E>(t2[15 - i]));
            clean16_regs(m);
            float vals[16]; int idxs[16];
#pragma unroll
            for (int e = 0; e < 16; ++e) { idxs[e] = 127 - (int)(m[e] & 127u); vals[e] = srow[idxs[e]]; }
            if (q == 0) { LAS float* tvp = (LAS float*)(WB + tok * 256) + sp * 16; LAS int* tip = (LAS int*)(WB + tok * 256 + 128) + sp * 16;
#pragma unroll
                for (int c = 0; c < 4; ++c) { *(LAS f32x4*)(tvp + 4 * c) = (f32x4){vals[4 * c], vals[4 * c + 1], vals[4 * c + 2], vals[4 * c + 3]};
                    *(LAS u32x4*)(tip + 4 * c) = (u32x4){(unsigned)idxs[4 * c], (unsigned)idxs[4 * c + 1], (unsigned)idxs[4 * c + 2], (unsigned)idxs[4 * c + 3]}; } }
        }
        asm volatile("s_waitcnt lgkmcnt(0)" ::: "memory"); __builtin_amdgcn_wave_barrier();
#pragma unroll 1
        for (int tk0 = 0; tk0 < 8; tk0 += NT) {
            unsigned z[NT];
#pragma unroll
            for (int u = 0; u < NT; ++u) { const LAS float* tv = (const LAS float*)(WB + (tk0 + u) * 256); const float cvl = tv[pi_] + tv[16 + pj_];
                z[u] = pvalid ? ((fixkey20(cvl * 0.5f) << 8) | (unsigned)(255 - (pi_ * 16 + pj_))) : 0u; }
#define ALL4(EXPR) _Pragma("unroll") for (int u = 0; u < NT; ++u) { const unsigned X = z[u]; z[u] = (EXPR); }
#define CLEAN4() ALL4(cex<0x128>(X, M.lo8)) ALL4(cex4(X, M.lo4)) ALL4(cex<0x4E>(X, M.lo2)) ALL4(cex<0xB1>(X, M.lo1))
            ALL4(cex<0xB1>(X, M.lo1))
            ALL4(cex<0x1B>(X, M.lo2)) ALL4(cex<0xB1>(X, M.lo1))
            ALL4(cex<0x141>(X, M.lo4)) ALL4(cex<0x4E>(X, M.lo2)) ALL4(cex<0xB1>(X, M.lo1))
            ALL4(cex<0x140>(X, M.lo8)) ALL4(cex4(X, M.lo4)) ALL4(cex<0x4E>(X, M.lo2)) ALL4(cex<0xB1>(X, M.lo1))
            ALL4(mtop_rows(X, M)) CLEAN4()
            ALL4(mtop_halves(X, M)) CLEAN4()
#undef ALL4
#undef CLEAN4
#pragma unroll
            for (int u = 0; u < NT; ++u) { const int t = tile * 64 + F.wave * 8 + tk0 + u;
                const LAS float* tv = (const LAS float*)(WB + (tk0 + u) * 256); const LAS int* ti = (const LAS int*)(WB + (tk0 + u) * 256 + 128);
                const int cid = 255 - (int)(z[u] & 255u), bi = (F.lane < 16) ? (cid >> 4) : 0, bj = (F.lane < 16) ? (cid & 15) : 0;
                const float bv = (F.lane < 16) ? (tv[bi] + tv[16 + bj]) : -INFINITY;
                const float mx = wmax(bv); const float ev = (F.lane < 16) ? expf(bv - mx) : 0.f; const float den = wsum(ev);
                if (F.lane < 16) { const int e1 = ti[bi], e2 = ti[16 + bj];
                    EID[(size_t)t * 128 + h * 16 + F.lane] = e1 * 128 + e2; GSM[(size_t)t * 128 + h * 16 + F.lane] = ev / den; } }
            asm volatile("s_waitcnt lgkmcnt(0)" ::: "memory"); __builtin_amdgcn_wave_barrier();
        }
    }
}

constexpr int PGB = 4;
__device__ __forceinline__ void ph_peer_gather(const Args& A, Frame& F, const int L, const bool dry = false) {
    bf16* H = (bf16*)(A.ws + WS_HY); bf16* Hout = dry ? (bf16*)(A.ws + WS_BIG + 128 * MiB) : H; float* Xout = dry ? (float*)(A.ws + WS_Z) : A.out; const unsigned char* TU = A.ws + WS_BIG; const unsigned char* TV = TU + (size_t)16384 * 2048; const float* SCL = (const float*)(A.ws + WS_BIG + 64 * MiB);
    const int* EID = (const int*)(A.ws + WS_LA); const float* GSM = (const float*)(A.ws + WS_LA + 16 * MiB);
    const float* MOD = (const float*)(A.ws + WS_MOD); float* X = A.out;
    const float* lng = (const float*)A.in[21] + (size_t)(L * 2 + 1) * DM; const float* lnb = (const float*)A.in[22] + (size_t)(L * 2 + 1) * DM;
    for (int t = F.gw; t < TOK; t += F.ngw) {
        const int b = t >> 14;
        f32x2 h2[16];
#pragma unroll
        for (int j = 0; j < 2; ++j) { const u32x4 a = *(const u32x4*)(H + (size_t)t * DM + (j * 64 + F.lane) * 16), c = *(const u32x4*)(H + (size_t)t * DM + (j * 64 + F.lane) * 16 + 8);
            const unsigned aw[8] = {a.x, a.y, a.z, a.w, c.x, c.y, c.z, c.w};
#pragma unroll
            for (int q = 0; q < 8; ++q) h2[j * 8 + q] = (f32x2){lo2f(aw[q]), hi2f(aw[q])}; }
        f32x2 o2[16];
#pragma unroll
        for (int e = 0; e < 16; ++e) o2[e] = (f32x2){0.f, 0.f};
#pragma unroll 1
        for (int e0 = 0; e0 < 128; e0 += PGB) {
            int eid[PGB]; float gw[PGB], su[PGB], sv[PGB];
#pragma unroll
            for (int q = 0; q < PGB; ++q) { eid[q] = __builtin_amdgcn_readfirstlane(EID[(size_t)t * 128 + e0 + q]); gw[q] = GSM[(size_t)t * 128 + e0 + q]; su[q] = SCL[eid[q]]; sv[q] = SCL[16384 + eid[q]]; }
            u32x4 uu[PGB][2], vv[PGB][2];
#pragma unroll
            for (int q = 0; q < PGB; ++q)
#pragma unroll
                for (int j = 0; j < 2; ++j) { uu[q][j] = *(const u32x4*)(TU + (size_t)eid[q] * 2048 + (j * 64 + F.lane) * 16); vv[q][j] = *(const u32x4*)(TV + (size_t)eid[q] * 2048 + (j * 64 + F.lane) * 16); }
#pragma unroll
            for (int q = 0; q < PGB; ++q) {
                f32x2 d2 = {0.f, 0.f};
#pragma unroll
                for (int j = 0; j < 2; ++j) { const unsigned w[4] = {uu[q][j].x, uu[q][j].y, uu[q][j].z, uu[q][j].w};
#pragma unroll
                    for (int i = 0; i < 4; ++i) { const f32x2 lo = __builtin_amdgcn_cvt_pk_f32_fp8((int)w[i], false), hi = __builtin_amdgcn_cvt_pk_f32_fp8((int)w[i], true);
                        d2 = lo * h2[j * 8 + 2 * i] + d2; d2 = hi * h2[j * 8 + 2 * i + 1] + d2; } }
                const float d = wsum(d2.x + d2.y) * su[q];
                const float act = 0.5f * d * (1.0f + erff(d * 0.70710678f)) * gw[q] * sv[q];
                const f32x2 a2 = {act, act};
#pragma unroll
                for (int j = 0; j < 2; ++j) { const unsigned w[4] = {vv[q][j].x, vv[q][j].y, vv[q][j].z, vv[q][j].w};
#pragma unroll
                    for (int i = 0; i < 4; ++i) { const f32x2 lo = __builtin_amdgcn_cvt_pk_f32_fp8((int)w[i], false), hi = __builtin_amdgcn_cvt_pk_f32_fp8((int)w[i], true);
                        o2[j * 8 + 2 * i] = a2 * lo + o2[j * 8 + 2 * i]; o2[j * 8 + 2 * i + 1] = a2 * hi + o2[j * 8 + 2 * i + 1]; } }
            }
        }
        float out[32];
#pragma unroll
        for (int e = 0; e < 16; ++e) { out[2 * e] = o2[e].x; out[2 * e + 1] = o2[e].y; }
        const float* gate = MOD + (size_t)((L * 2 + 1) * 2 + b) * 6144 + 4096;
        float sum = 0.f;
#pragma unroll
        for (int j = 0; j < 2; ++j)
#pragma unroll
            for (int c = 0; c < 4; ++c) { const int base = (j * 64 + F.lane) * 16 + 4 * c;
                const f32x4 x0 = *(const f32x4*)(X + (size_t)t * DM + base), g0 = *(const f32x4*)(gate + base);
#pragma unroll
                for (int e = 0; e < 4; ++e) { const float v = ALPHA * x0[e] + (1.0f + g0[e]) * out[j * 16 + 4 * c + e]; out[j * 16 + 4 * c + e] = v; sum += v; } }
        const float mean = wsum(sum) * (1.0f / DM); float sq = 0.f;
#pragma unroll
        for (int e = 0; e < 32; ++e) { out[e] -= mean; sq += out[e] * out[e]; }
        const float rstd = rsqrtf(wsum(sq) * (1.0f / DM) + 1e-5f);
        const float* sh = MOD + (size_t)(((L + 1) * 2 + 0) * 2 + b) * 6144; const float* sc = sh + 2048;
#pragma unroll
        for (int j = 0; j < 2; ++j) {
            float hq[16];
#pragma unroll
            for (int c = 0; c < 4; ++c) { const int base = (j * 64 + F.lane) * 16 + 4 * c;
                const f32x4 lg0 = *(const f32x4*)(lng + base), lb0 = *(const f32x4*)(lnb + base);
                f32x4 o0;
#pragma unroll
                for (int e = 0; e < 4; ++e) o0[e] = out[j * 16 + 4 * c + e] * rstd * lg0[e] + lb0[e];
                *(f32x4*)(Xout + (size_t)t * DM + base) = o0;
                if (L == 0) { const f32x4 s0 = *(const f32x4*)(sc + base), h0 = *(const f32x4*)(sh + base);
#pragma unroll
                    for (int e = 0; e < 4; ++e) hq[4 * c + e] = o0[e] * (1.0f + s0[e]) + h0[e]; } }
            if (L == 0) { u32x4 w0, w1;
                w0.x = pk2(hq[0], hq[1]); w0.y = pk2(hq[2], hq[3]); w0.z = pk2(hq[4], hq[5]); w0.w = pk2(hq[6], hq[7]);
                w1.x = pk2(hq[8], hq[9]); w1.y = pk2(hq[10], hq[11]); w1.z = pk2(hq[12], hq[13]); w1.w = pk2(hq[14], hq[15]);
                *(u32x4*)(Hout + (size_t)t * DM + (j * 64 + F.lane) * 16) = w0; *(u32x4*)(Hout + (size_t)t * DM + (j * 64 + F.lane) * 16 + 8) = w1; }
        }
    }
}

struct XInfo { int rank, nloc, rx, nx; };
__device__ __forceinline__ XInfo xcc_info(volatile LAS unsigned* MISC) { XInfo x; x.rank = (int)MISC[16]; x.nloc = (int)MISC[17]; x.rx = (int)MISC[18]; x.nx = (int)MISC[19]; return x; }
constexpr size_t WS_DP = WS_BIG + 128 * MiB;
constexpr size_t WS_ACT = WS_BIG + 80 * MiB;
__device__ __forceinline__ void ph_peer_u(const Args& A, Frame& F, const XInfo X) {
    const unsigned char* H8 = A.ws + WS_H8; const unsigned char* TU = A.ws + WS_BIG; const int* EID = (const int*)(A.ws + WS_LA); float* DP = (float*)(A.ws + WS_DP);
    LAS int* IDX = (LAS int*)(F.lds + F.wave * 1024);
    const int g16 = F.lane >> 4, c16 = F.lane & 15; const int step = X.nloc * NWAVES;
    for (int s = X.rx; s < 8; s += X.nx) {
        int t = X.rank * NWAVES + F.wave;
        int e0 = 0, e1 = 0; u32x4 ha = {0u, 0u, 0u, 0u};
        if (t < TOK) { e0 = EID[(size_t)t * 128 + F.lane]; e1 = EID[(size_t)t * 128 + 64 + F.lane]; ha = *(const u32x4*)(H8 + (size_t)t * DM + 256 * s + 16 * c16); }
        const unsigned char* ub = TU + 256 * s + 16 * c16;
        while (t < TOK) {
            const int tn = t + step; int n0 = 0, n1 = 0; u32x4 na = {0u, 0u, 0u, 0u};
            if (tn < TOK) { n0 = EID[(size_t)tn * 128 + F.lane]; n1 = EID[(size_t)tn * 128 + 64 + F.lane]; na = *(const u32x4*)(H8 + (size_t)tn * DM + 256 * s + 16 * c16); }
            IDX[F.lane] = e0; IDX[F.lane + 64] = e1;
            asm volatile("s_waitcnt lgkmcnt(0)" ::: "memory"); __builtin_amdgcn_wave_barrier();
            float keep0 = 0.f, keep1 = 0.f;
#pragma unroll
            for (int i0 = 0; i0 < 32; i0 += 8) {
                u32x4 ud[8];
#pragma unroll
                for (int u = 0; u < 8; ++u) { const int eid = IDX[4 * (i0 + u) + g16]; ud[u] = *(const u32x4*)(ub + (size_t)eid * 2048); }
#pragma unroll
                for (int u = 0; u < 8; ++u) {
                    int di = __builtin_amdgcn_sdot4((int)ud[u].x, (int)ha.x, 0, false); di = __builtin_amdgcn_sdot4((int)ud[u].y, (int)ha.y, di, false);
                    di = __builtin_amdgcn_sdot4((int)ud[u].z, (int)ha.z, di, false); di = __builtin_amdgcn_sdot4((int)ud[u].w, (int)ha.w, di, false);
                    const float d = sum16_dpp((float)di);
                    const int i = i0 + u;
                    if (i < 16) keep0 = ((i & 15) == c16) ? d : keep0; else keep1 = ((i & 15) == c16) ? d : keep1;
                }
            }
            float* dp = DP + ((size_t)s * TOK + t) * 128 + 4 * c16 + g16;
            dp[0] = keep0; dp[64] = keep1;
            asm volatile("s_waitcnt lgkmcnt(0)" ::: "memory"); __builtin_amdgcn_wave_barrier();
            e0 = n0; e1 = n1; ha = na; t = tn;
        }
    }
}
__device__ __forceinline__ void ph_peer_act(const Args& A, Frame& F) {
    const float* SCL = (const float*)(A.ws + WS_BIG + 64 * MiB); const int* EID = (const int*)(A.ws + WS_LA); const float* GSM = (const float*)(A.ws + WS_LA + 16 * MiB);
    const float* DP = (const float*)(A.ws + WS_DP); unsigned char* ACT8 = A.ws + WS_ACT; float* AS = (float*)(A.ws + WS_ACT + 8 * MiB);
    for (int t = F.gw; t < TOK; t += F.ngw) { const float hs = ((const float*)(A.ws + WS_HS))[t];
        float a[2];
#pragma unroll
        for (int m = 0; m < 2; ++m) { const int e = F.lane + 64 * m; const int eid = EID[(size_t)t * 128 + e]; float d = 0.f;
#pragma unroll
            for (int x = 0; x < 8; ++x) d += DP[((size_t)x * TOK + t) * 128 + e];
            d *= SCL[eid] * hs;
            a[m] = 0.5f * d * (1.0f + erff(d * 0.70710678f)) * GSM[(size_t)t * 128 + e] * SCL[16384 + eid]; }
        const float amax = wmax(fmaxf(fabsf(a[0]), fabsf(a[1]))); const float inv = (amax > 0.f) ? 127.0f / amax : 0.f;
#pragma unroll
        for (int m = 0; m < 2; ++m) ACT8[(size_t)t * 128 + F.lane + 64 * m] = (unsigned char)(__float_as_uint(a[m] * inv + 12582912.0f) & 255u);
        if (F.lane == 0) AS[t] = amax * (1.0f / 127.0f);
    }
}
__device__ __forceinline__ void ph_peer_v(const Args& A, Frame& F, const XInfo X) {
    const unsigned char* TV = A.ws + WS_BIG + (size_t)16384 * 2048;
    const int* EID = (const int*)(A.ws + WS_LA); const unsigned* ACT8 = (const unsigned*)(A.ws + WS_ACT); const float* AS = (const float*)(A.ws + WS_ACT + 8 * MiB); bf16* OUT = (bf16*)(A.ws + WS_Z);
    LAS int* IDX = (LAS int*)(F.lds + F.wave * 1024); LAS unsigned* ACT = (LAS unsigned*)(F.lds + F.wave * 1024 + 512);
    const int g16 = F.lane >> 4, c16 = F.lane & 15; const int step = X.nloc * NWAVES;
    for (int s = X.rx; s < 8; s += X.nx) {
        int t = X.rank * NWAVES + F.wave;
        int e0 = 0, e1 = 0; unsigned a0 = 0u;
        if (t < TOK) { e0 = EID[(size_t)t * 128 + F.lane]; e1 = EID[(size_t)t * 128 + 64 + F.lane]; a0 = ACT8[(size_t)t * 32 + (F.lane & 31)]; }
        const unsigned char* vb = TV + 256 * s + 16 * c16;
        while (t < TOK) {
            const int tn = t + step; int n0 = 0, n1 = 0; unsigned b0 = 0u;
            if (tn < TOK) { n0 = EID[(size_t)tn * 128 + F.lane]; n1 = EID[(size_t)tn * 128 + 64 + F.lane]; b0 = ACT8[(size_t)tn * 32 + (F.lane & 31)]; }
            const float as = AS[t];
            IDX[F.lane] = e0; IDX[F.lane + 64] = e1; if (F.lane < 32) ACT[F.lane] = a0;
            asm volatile("s_waitcnt lgkmcnt(0)" ::: "memory"); __builtin_amdgcn_wave_barrier();
            int acc[16];
#pragma unroll
            for (int j = 0; j < 16; ++j) acc[j] = 0;
#pragma unroll
            for (int b = 0; b < 8; b += 2) {
                u32x4 vd[2][4]; unsigned a4[2];
#pragma unroll
                for (int h = 0; h < 2; ++h) { a4[h] = ACT[4 * (b + h) + g16];
#pragma unroll
                    for (int u = 0; u < 4; ++u) { const int eid = IDX[16 * (b + h) + 4 * g16 + u]; vd[h][u] = *(const u32x4*)(vb + (size_t)eid * 2048); } }
#pragma unroll
                for (int h = 0; h < 2; ++h)
#pragma unroll
                    for (int q = 0; q < 4; ++q) { const unsigned A_ = vd[h][0][q], B_ = vd[h][1][q], C_ = vd[h][2][q], D_ = vd[h][3][q];
                        const unsigned ablo = __builtin_amdgcn_perm(B_, A_, 0x05010400u), abhi = __builtin_amdgcn_perm(B_, A_, 0x07030602u);
                        const unsigned cdlo = __builtin_amdgcn_perm(D_, C_, 0x05010400u), cdhi = __builtin_amdgcn_perm(D_, C_, 0x07030602u);
                        acc[4 * q + 0] = __builtin_amdgcn_sdot4((int)__builtin_amdgcn_perm(cdlo, ablo, 0x05040100u), (int)a4[h], acc[4 * q + 0], false);
                        acc[4 * q + 1] = __builtin_amdgcn_sdot4((int)__builtin_amdgcn_perm(cdlo, ablo, 0x07060302u), (int)a4[h], acc[4 * q + 1], false);
                        acc[4 * q + 2] = __builtin_amdgcn_sdot4((int)__builtin_amdgcn_perm(cdhi, abhi, 0x05040100u), (int)a4[h], acc[4 * q + 2], false);
                        acc[4 * q + 3] = __builtin_amdgcn_sdot4((int)__builtin_amdgcn_perm(cdhi, abhi, 0x07060302u), (int)a4[h], acc[4 * q + 3], false); }
            }
            { const float r0 = rsum4((float)acc[0], (float)acc[4], (float)acc[8], (float)acc[12]) * as, r1 = rsum4((float)acc[1], (float)acc[5], (float)acc[9], (float)acc[13]) * as;
              const float r2 = rsum4((float)acc[2], (float)acc[6], (float)acc[10], (float)acc[14]) * as, r3 = rsum4((float)acc[3], (float)acc[7], (float)acc[11], (float)acc[15]) * as;
              u32x2 w; w.x = pk2(r0, r1); w.y = pk2(r2, r3); *(u32x2*)(OUT + (size_t)t * DM + 256 * s + 16 * c16 + 4 * g16) = w; }
            asm volatile("s_waitcnt lgkmcnt(0)" ::: "memory"); __builtin_amdgcn_wave_barrier();
            e0 = n0; e1 = n1; a0 = b0; t = tn;
        }
    }
}
__device__ __forceinline__ void ph_peer_ln(const Args& A, Frame& F, const int L) {
    const bf16* OUT = (const bf16*)(A.ws + WS_Z); float* X = A.out; bf16* H = (bf16*)(A.ws + WS_HY); const float* MOD = (const float*)(A.ws + WS_MOD);
    const bf16* Xin = (L == 0) ? (const bf16*)A.out : (const bf16*)(A.ws + WS_Z + 160 * MiB); bf16* Xb = (bf16*)A.out;
    const float* lng = (const float*)A.in[21] + (size_t)(L * 2 + 1) * DM; const float* lnb = (const float*)A.in[22] + (size_t)(L * 2 + 1) * DM;
    for (int t = F.gw; t < TOK; t += F.ngw) {
        const int b = t >> 14;
        const float* gate = MOD + (size_t)((L * 2 + 1) * 2 + b) * 6144 + 4096;
        const float* sh = MOD + (size_t)(((L + 1) * 2 + 0) * 2 + b) * 6144; const float* sc = sh + 2048;
        float v[32]; float sum = 0.f;
#pragma unroll
        for (int j = 0; j < 8; ++j) { const int base = (j * 64 + F.lane) * 4;
            const u32x2 ow = *(const u32x2*)(OUT + (size_t)t * DM + base); const f32x4 o0 = {lo2f(ow.x), hi2f(ow.x), lo2f(ow.y), hi2f(ow.y)};
            const u32x2 xw = *(const u32x2*)(Xin + (size_t)t * DM + base); const f32x4 x0 = {lo2f(xw.x), hi2f(xw.x), lo2f(xw.y), hi2f(xw.y)}; const f32x4 g0 = *(const f32x4*)(gate + base);
#pragma unroll
            for (int e = 0; e < 4; ++e) { v[j * 4 + e] = ALPHA * x0[e] + (1.0f + g0[e]) * o0[e]; sum += v[j * 4 + e]; } }
        const float mean = wsum(sum) * (1.0f / DM); float sq = 0.f;
#pragma unroll
        for (int e = 0; e < 32; ++e) { v[e] -= mean; sq += v[e] * v[e]; }
        const float rstd = rsqrtf(wsum(sq) * (1.0f / DM) + 1e-5f);
#pragma unroll
        for (int j = 0; j < 8; ++j) { const int base = (j * 64 + F.lane) * 4;
            const f32x4 lg0 = *(const f32x4*)(lng + base), lb0 = *(const f32x4*)(lnb + base);
            f32x4 o0;
#pragma unroll
            for (int e = 0; e < 4; ++e) o0[e] = v[j * 4 + e] * rstd * lg0[e] + lb0[e];
            if (L == 0) { u32x2 xo; xo.x = pk2(o0[0], o0[1]); xo.y = pk2(o0[2], o0[3]); *(u32x2*)(Xb + (size_t)t * DM + base) = xo; } else *(f32x4*)(X + (size_t)t * DM + base) = o0;
            if (L == 0) { const f32x4 s0 = *(const f32x4*)(sc + base), h0 = *(const f32x4*)(sh + base); const f32x4 q0 = o0 * (1.0f + s0) + h0;
                u32x2 w; w.x = pk2(q0[0], q0[1]); w.y = pk2(q0[2], q0[3]); *(u32x2*)(H + (size_t)t * DM + base) = w; }
        }
    }
}

__device__ __forceinline__ void ph_odd_post(const Args& A, Frame& F) {
    bf16* Z = (bf16*)(A.ws + WS_Z); const int* positions = (const int*)A.in[2]; bf16* KIT = (bf16*)(A.ws + WS_BIG + 256 * MiB); unsigned char* K8 = A.ws + WS_BIG + 264 * MiB; unsigned char* V8 = A.ws + WS_BIG + 280 * MiB;
    const float inv128 = powf(10000.0f, -(float)F.lane / 64.0f); const int i32 = F.lane & 31; const float inv64 = powf(10000.0f, -(float)i32 / 32.0f);
    const int a16 = F.lane & 15, hs4 = F.lane >> 4, a8 = F.lane & 7, hs8 = F.lane >> 3;
    for (int t = F.gw; t < TOK; t += F.ngw) {
        bf16* zr = Z + (size_t)t * OD_NP; const float pos = (float)positions[t];
        const int bb = t >> 14, spos = t & (SEQ - 1);
        float sn, cs; sincosf(pos * inv128, &sn, &cs);
        float c4[4], s4[4];
#pragma unroll
        for (int e = 0; e < 4; ++e) { c4[e] = __shfl(cs, 4 * a16 + e); s4[e] = __shfl(sn, 4 * a16 + e); }
#pragma unroll
        for (int it = 0; it < 5; ++it) { const int hd = it * 4 + hs4; bf16* hp = zr + hd * 128 + 4 * a16;
            const u32x2 a = *(const u32x2*)hp, b = *(const u32x2*)(hp + 64);
            const float t1[4] = {lo2f(a.x), hi2f(a.x), lo2f(a.y), hi2f(a.y)}, t2[4] = {lo2f(b.x), hi2f(b.x), lo2f(b.y), hi2f(b.y)};
            float o1[4], o2[4];
#pragma unroll
            for (int e = 0; e < 4; ++e) { o1[e] = t1[e] * c4[e] - t2[e] * s4[e]; o2[e] = t2[e] * c4[e] + t1[e] * s4[e]; }
            *(u32x2*)hp = (u32x2){pk2(o1[0], o1[1]), pk2(o1[2], o1[3])}; *(u32x2*)(hp + 64) = (u32x2){pk2(o2[0], o2[1]), pk2(o2[2], o2[3])};
            if (it == 4) { unsigned char* k8 = K8 + ((size_t)((bb * 4 + hs4) * SEQ + spos)) * 128 + 4 * a16;
                int w1 = __builtin_amdgcn_cvt_pk_fp8_f32(o1[0] * 16.0f, o1[1] * 16.0f, 0, false); w1 = __builtin_amdgcn_cvt_pk_fp8_f32(o1[2] * 16.0f, o1[3] * 16.0f, w1, true);
                int w2 = __builtin_amdgcn_cvt_pk_fp8_f32(o2[0] * 16.0f, o2[1] * 16.0f, 0, false); w2 = __builtin_amdgcn_cvt_pk_fp8_f32(o2[2] * 16.0f, o2[3] * 16.0f, w2, true);
                *(unsigned*)k8 = (unsigned)w1; *(unsigned*)(k8 + 64) = (unsigned)w2; } }
        {
            const int e0 = F.lane * 8, kvh = e0 >> 7, d0 = e0 & 127;
            const u32x4 vw = *(const u32x4*)(zr + 2560 + e0);
            const unsigned ww[4] = {vw.x, vw.y, vw.z, vw.w}; unsigned ob[2] = {0u, 0u};
#pragma unroll
            for (int q = 0; q < 4; ++q) { const float c0 = fminf(fmaxf(lo2f(ww[q]) * 16.0f, -127.0f), 127.0f), c1 = fminf(fmaxf(hi2f(ww[q]) * 16.0f, -127.0f), 127.0f);
                const unsigned b0 = __float_as_uint(c0 + 12583040.0f) & 255u, b1 = __float_as_uint(c1 + 12583040.0f) & 255u;
                ob[q >> 1] |= (b0 | (b1 << 8)) << (16 * (q & 1)); }
            *(u32x2*)(V8 + ((size_t)((bb * 4 + kvh) * SEQ + spos)) * 128 + d0) = (u32x2){ob[0], ob[1]};
        }
        sincosf(pos * inv64, &sn, &cs);
#pragma unroll
        for (int e = 0; e < 4; ++e) { c4[e] = __shfl(cs, 4 * a8 + e); s4[e] = __shfl(sn, 4 * a8 + e); }
#pragma unroll
        for (int it = 0; it < 3; ++it) { const int hd = it * 8 + hs8; if (hd < 17) { bf16* hp = zr + 3072 + hd * 64 + 4 * a8;
            const u32x2 a = *(const u32x2*)hp, b = *(const u32x2*)(hp + 32);
            const float t1[4] = {lo2f(a.x), hi2f(a.x), lo2f(a.y), hi2f(a.y)}, t2[4] = {lo2f(b.x), hi2f(b.x), lo2f(b.y), hi2f(b.y)};
            float o1[4], o2[4];
#pragma unroll
            for (int e = 0; e < 4; ++e) { o1[e] = t1[e] * c4[e] - t2[e] * s4[e]; o2[e] = t2[e] * c4[e] + t1[e] * s4[e]; }
            const u32x2 w1 = {pk2(o1[0], o1[1]), pk2(o1[2], o1[3])}, w2 = {pk2(o2[0], o2[1]), pk2(o2[2], o2[3])};
            *(u32x2*)hp = w1; *(u32x2*)(hp + 32) = w2;
            if (hd == 16) {
                const int tile = spos >> 5, rr = spos & 31;
                bf16* kt = KIT + ((size_t)(bb * 512 + tile) * 4) * 512;
                const int d1 = 4 * a8, d2 = 32 + 4 * a8;
                *(u32x2*)(kt + ((d1 >> 4) * 64 + rr + 32 * ((d1 >> 3) & 1)) * 8 + (d1 & 7)) = w1;
                *(u32x2*)(kt + ((d2 >> 4) * 64 + rr + 32 * ((d2 >> 3) & 1)) * 8 + (d2 & 7)) = w2;
            } } }
    }
}

template <int CTRL, int RM> __device__ __forceinline__ unsigned dppu(unsigned old, unsigned v) { return (unsigned)__builtin_amdgcn_update_dpp((int)old, (int)v, CTRL, RM, 0xF, false); }
__device__ __forceinline__ void ph_dsa_select(const Args& A, Frame& F, const int mode = 0) {
    const bf16* Z = (const bf16*)(A.ws + WS_Z); unsigned short* SEL = (unsigned short*)(A.ws + WS_LA); int* CNT = (int*)(A.ws + WS_CNT); const bf16* KIT = (const bf16*)(A.ws + WS_BIG + 256 * MiB);
    LAS unsigned short* SC = (LAS unsigned short*)F.lds;
    LAS unsigned* LST = (LAS unsigned*)(F.lds + 131072);
    LAS unsigned* hist = (LAS unsigned*)(F.lds + 131072 + 16384);
    LAS unsigned* hist1 = (LAS unsigned*)(F.lds + 152576);
    LAS unsigned* res = (LAS unsigned*)(F.lds + 131072 + 16384 + 2048);
    LAS int* wtot = (LAS int*)(F.lds + 131072 + 16384 + 2048 + 64);
    const int r = F.lane & 31, hg = F.lane >> 5, tk = (r >> 2) & 1, hh = (r & 3) + 4 * (r >> 3);
    const int grp = F.wave >> 2, ltid = F.tid & 255, lw = F.wave & 3;
    LAS bf16* QPRE = (LAS bf16*)(F.lds + 154624);
    u32x4 pq_q = {0u, 0u, 0u, 0u}, pq_w = {0u, 0u, 0u, 0u};
#define DS_LOAD(qd_) do { pq_q = *(const u32x4*)(Z + (size_t)(4 * (qd_) + (F.tid >> 7)) * OD_NP + 3072 + 8 * (F.tid & 127)); \
        if (F.tid < 8) pq_w = *(const u32x4*)(Z + (size_t)(4 * (qd_) + (F.tid >> 1)) * OD_NP + 4160 + 8 * (F.tid & 1)); } while (0)
#define DS_STAGE() do { *(LAS u32x4*)(QPRE + 8 * F.tid) = pq_q; if (F.tid < 8) *(LAS u32x4*)(QPRE + 4096 + 8 * F.tid) = pq_w; } while (0)
    if (F.bx < TOK / 4) { DS_LOAD(F.bx); DS_STAGE(); }
    for (int qd = F.bx; qd < TOK / 4; qd += F.G) {
        const int t0 = 4 * qd, b = t0 >> 14, s0 = t0 & (SEQ - 1);
        const int nkeys = s0 + 4, ntiles = (nkeys + 31) >> 5;
        __syncthreads();
        bf16x8 af[2][4]; f32x2 wv[2][8];
#pragma unroll
        for (int a = 0; a < 2; ++a) {
            const LAS bf16* qrow = QPRE + ((2 * a + tk) * 16 + hh) * 64 + 8 * hg;
#pragma unroll
            for (int s = 0; s < 4; ++s) af[a][s] = *(const LAS bf16x8*)(qrow + 16 * s);
            const LAS bf16* wrow = QPRE + 4096 + (2 * a + hg) * 16;
            const u32x4 w0 = *(const LAS u32x4*)(wrow), w1 = *(const LAS u32x4*)(wrow + 8);
            const unsigned ww[8] = {w0.x, w0.y, w0.z, w0.w, w1.x, w1.y, w1.z, w1.w};
#pragma unroll
            for (int q = 0; q < 8; ++q) wv[a][q] = (f32x2){lo2f(ww[q]) * 0.03125f, hi2f(ww[q]) * 0.03125f};
        }
        const bf16* kbase = KIT + (size_t)b * 512 * 2048 + F.lane * 8;
        if (mode != 2) {
            bf16x8 bcur[2][4];
#define DSA_LOAD1(dst, q_, tb_) do { const int tile = ((tb_) + (q_) < ntiles) ? ((tb_) + (q_)) : (ntiles - 1); const bf16* krow = kbase + (size_t)tile * 2048; \
                _Pragma("unroll") for (int s_ = 0; s_ < 4; ++s_) dst[q_][s_] = *(const bf16x8*)(krow + 512 * s_); } while (0)
#define DSA_MM(accv, src, q_, a_) do { _Pragma("unroll") for (int e = 0; e < 16; ++e) accv[e] = 0.f; \
                _Pragma("unroll") for (int s_ = 0; s_ < 4; ++s_) accv = __builtin_amdgcn_mfma_f32_32x32x16_bf16(af[a_][s_], src[q_][s_], accv, 0, 0, 0); } while (0)
#define DSA_EPI(accv, tb_, q_, a_) do { f32x2 s2_ = {0.f, 0.f}; _Pragma("unroll") for (int e = 0; e < 8; ++e) { \
                    const float x0_ = accv[2 * e], x1_ = accv[2 * e + 1]; const int r0_ = __builtin_bit_cast(int, x0_), r1_ = __builtin_bit_cast(int, x1_);        \
                    const f32x2 rl_ = {__builtin_bit_cast(float, r0_ > 0 ? r0_ : 0), __builtin_bit_cast(float, r1_ > 0 ? r1_ : 0)}; s2_ = rl_ * wv[a_][e] + s2_; } \
                float sc_ = s2_.x + s2_.y; const int key = ((tb_) + (q_)) * 32 + r; sc_ = fminf(fmaxf(sc_, -7.999f), 7.999f); const unsigned fx = (unsigned)((int)rintf(sc_ * 4096.0f) + (1 << 15)); \
                if ((tb_) + (q_) < ntiles) SC[(2 * (a_) + hg) * 16384 + key] = (unsigned short)((key <= s0 + 2 * (a_) + hg) ? fx : 0u); } while (0)
            int tb = F.wave * 2;
            if (tb < ntiles) {
                DSA_LOAD1(bcur, 0, tb); DSA_LOAD1(bcur, 1, tb);
                for (; tb < ntiles; tb += NWAVES * 2) {
                    f32x16 accA, accB;
                    DSA_MM(accA, bcur, 0, 0); DSA_MM(accB, bcur, 0, 1);
                    DSA_LOAD1(bcur, 0, tb + NWAVES * 2);
                    DSA_EPI(accA, tb, 0, 0); DSA_MM(accA, bcur, 1, 0); DSA_EPI(accB, tb, 0, 1); DSA_MM(accB, bcur, 1, 1);
                    DSA_LOAD1(bcur, 1, tb + NWAVES * 2);
                    DSA_EPI(accA, tb, 1, 0); DSA_EPI(accB, tb, 1, 1);
                }
            }
#undef DSA_LOAD1
#undef DSA_MM
#undef DSA_EPI
        }
        __syncthreads();
        const int qdn = qd + F.G; if (qdn < TOK / 4) DS_LOAD(qdn);
        if (mode == 1) { if (qdn < TOK / 4) DS_STAGE(); continue; }
#pragma unroll 1
        for (int rd = 0; rd < 2; ++rd) {
        const int tok = 2 * rd + grp;
        const int n = s0 + tok + 1; unsigned k = (unsigned)(n < 256 ? n : 256); unsigned prefix = 0u;
        const LAS unsigned short* sc = SC + tok * 16384;
        hist[grp * 256 + ltid] = 0u; hist1[grp * 256 + ltid] = 0u;
        unsigned kreg[64];
#pragma unroll
        for (int j = 0; j < 64; ++j) { const int i = ltid + 256 * j; kreg[j] = (i < n) ? (unsigned)sc[i] : 0u; }
        unsigned lmax = 0u;
#pragma unroll
        for (int j = 0; j < 64; ++j) lmax = (kreg[j] > lmax) ? kreg[j] : lmax;
        unsigned wmin = lmax;
        { unsigned x_;
          x_ = dppu<0xB1, 0xF>(wmin, wmin); wmin = x_ < wmin ? x_ : wmin; x_ = dppu<0x4E, 0xF>(wmin, wmin); wmin = x_ < wmin ? x_ : wmin;
          x_ = dppu<0x141, 0xF>(wmin, wmin); wmin = x_ < wmin ? x_ : wmin; x_ = dppu<0x140, 0xF>(wmin, wmin); wmin = x_ < wmin ? x_ : wmin;
          x_ = dppu<0x142, 0xA>(wmin, wmin); wmin = x_ < wmin ? x_ : wmin; x_ = dppu<0x143, 0xC>(wmin, wmin); wmin = x_ < wmin ? x_ : wmin; }
        if (F.lane == 63) wtot[16 + F.wave] = (int)wmin;
        __syncthreads();
        unsigned lbound = 0xFFFFFFFFu;
#pragma unroll
        for (int w = 0; w < 4; ++w) { const unsigned x = (unsigned)wtot[16 + grp * 4 + w]; lbound = x < lbound ? x : lbound; }
        LAS unsigned* seg = LST + (grp * 4 + lw) * 512; int ccnt = 0;
        {
            const unsigned lb1 = lbound > 1u ? lbound : 1u;
#pragma unroll
            for (int j = 0; j < 64; ++j) { if (256 * j < n) { const bool c = kreg[j] >= lb1; const unsigned long long m = __ballot(c);
                const int pos = ccnt + (int)__builtin_amdgcn_mbcnt_hi((unsigned)(m >> 32), __builtin_amdgcn_mbcnt_lo((unsigned)m, 0u));
                if (c && pos < 512) seg[pos] = (kreg[j] << 16) | (unsigned)(ltid + 256 * j); ccnt += __popcll(m); } }
        }
        const bool fast = ccnt <= 512;
        asm volatile("s_waitcnt lgkmcnt(0)" ::: "memory"); __builtin_amdgcn_wave_barrier();
#pragma unroll 1
        for (int pass = 0; pass < 2; ++pass) {
            const int shift = 8 - 8 * pass;
            LAS unsigned* hs = (pass == 0 ? hist : hist1) + grp * 256;
            if (fast) {
#pragma unroll
                for (int i = 0; i < 8; ++i) { if (64 * i < ccnt) { const int c_ = F.lane + 64 * i; const bool valid = c_ < ccnt; const unsigned kv = valid ? (seg[c_] >> 16) : 0u;
                    const bool match = (pass == 0) ? true : ((kv >> 8) == prefix);
                    if (valid && match) (void)__hip_atomic_fetch_add(&hs[(kv >> shift) & 255u], 1u, __ATOMIC_RELAXED, __HIP_MEMORY_SCOPE_WORKGROUP); } }
            } else {
#pragma unroll
                for (int j = 0; j < 64; ++j) { if (256 * j < n) { const unsigned kv = kreg[j]; const bool valid = ((ltid + 256 * j) < n) && (kv >= lbound);
                    const bool match = (pass == 0) ? true : ((kv >> 8) == prefix);
                    if (valid && match) (void)__hip_atomic_fetch_add(&hs[(kv >> shift) & 255u], 1u, __ATOMIC_RELAXED, __HIP_MEMORY_SCOPE_WORKGROUP); } }
            }
            __syncthreads();
            if (lw == 0) {
                const unsigned c0 = hs[4 * F.lane], c1 = hs[4 * F.lane + 1], c2 = hs[4 * F.lane + 2], c3 = hs[4 * F.lane + 3];
                const unsigned tot = c0 + c1 + c2 + c3; unsigned pre = tot;
                pre += dppu<0x111, 0xF>(0u, pre); pre += dppu<0x112, 0xF>(0u, pre); pre += dppu<0x114, 0xF>(0u, pre); pre += dppu<0x118, 0xF>(0u, pre);
                pre += dppu<0x142, 0xA>(0u, pre); pre += dppu<0x143, 0xC>(0u, pre);
                const unsigned total = (unsigned)__builtin_amdgcn_readlane((int)pre, 63); const unsigned suf = total - pre + tot;
                unsigned above = suf - tot;
                if (above < k && k <= suf) {
                    int bin;
                    if (above + c3 >= k) { bin = 3; } else { above += c3; if (above + c2 >= k) { bin = 2; } else { above += c2; if (above + c1 >= k) { bin = 1; } else { above += c1; bin = 0; } } }
                    res[grp * 2 + 0] = (unsigned)(4 * F.lane + bin); res[grp * 2 + 1] = k - above;
                }
            }
            __syncthreads();
            prefix = (prefix << 8) | res[grp * 2 + 0]; k = res[grp * 2 + 1];
        }
        const unsigned tau = prefix; const int krem = (int)k;
#define MBCNT(m_) ((int)__builtin_amdgcn_mbcnt_hi((unsigned)((m_) >> 32), __builtin_amdgcn_mbcnt_lo((unsigned)(m_), 0u)))
        int cgW = 0, ceW = 0;
        if (fast) {
#pragma unroll
            for (int i = 0; i < 8; ++i) { if (64 * i < ccnt) { const int c_ = F.lane + 64 * i; const bool valid = c_ < ccnt; const unsigned kv = valid ? (seg[c_] >> 16) : 0u;
                cgW += __popcll(__ballot(valid && kv > tau)); ceW += __popcll(__ballot(valid && kv == tau)); } }
        } else {
#pragma unroll
            for (int j = 0; j < 64; ++j) { if (256 * j < n) { const bool valid = (ltid + 256 * j) < n; const unsigned kv = kreg[j];
                cgW += __popcll(__ballot(valid && kv > tau)); ceW += __popcll(__ballot(valid && kv == tau)); } }
        }
        if (F.lane == 0) { wtot[F.wave * 2] = cgW; wtot[F.wave * 2 + 1] = ceW; }
        __syncthreads();
        int og = 0, oe = 0, totg = 0;
        for (int w = 0; w < 4; ++w) { const int a = wtot[(grp * 4 + w) * 2], e = wtot[(grp * 4 + w) * 2 + 1]; if (w < lw) { og += a; oe += e; } totg += a; }
        LAS unsigned short* sel = (LAS unsigned short*)(F.lds + 151552) + grp * 256;
        if (fast) {
#pragma unroll
            for (int i = 0; i < 8; ++i) { if (64 * i < ccnt) { const int c_ = F.lane + 64 * i; const bool valid = c_ < ccnt; const unsigned pk = valid ? seg[c_] : 0u; const unsigned kv = pk >> 16;
                const bool gt = valid && kv > tau, eq = valid && kv == tau; const unsigned long long mg = __ballot(gt), me = __ballot(eq);
                const int pg = og + MBCNT(mg), pe = oe + MBCNT(me);
                if (gt) sel[pg] = (unsigned short)(pk & 0xffffu); else if (eq && pe < krem) sel[totg + pe] = (unsigned short)(pk & 0xffffu);
                og += __popcll(mg); oe += __popcll(me); } }
        } else {
#pragma unroll
            for (int j = 0; j < 64; ++j) { if (256 * j < n) { const int i = ltid + 256 * j; const bool valid = i < n; const unsigned kv = kreg[j];
                const bool gt = valid && kv > tau, eq = valid && kv == tau; const unsigned long long mg = __ballot(gt), me = __ballot(eq);
                const int pg = og + MBCNT(mg), pe = oe + MBCNT(me);
                if (gt) sel[pg] = (unsigned short)i; else if (eq && pe < krem) sel[totg + pe] = (unsigned short)i;
                og += __popcll(mg); oe += __popcll(me); } }
        }
#undef MBCNT
        if (ltid == 0) CNT[t0 + tok] = (n < 256 ? n : 256);
        __syncthreads();
        if (ltid < 128) { int lt2 = ltid; asm volatile("" : "+v"(lt2));
            ((unsigned*)SEL)[(size_t)(t0 + 2 * rd + grp) * 128 + lt2] = ((const LAS unsigned*)(F.lds + 151552))[grp * 128 + lt2]; }
        }
        if (qdn < TOK / 4) DS_STAGE();
    }
#undef DS_LOAD
#undef DS_STAGE
}

__device__ __forceinline__ float sum8_dpp(float v) { v += dppf<0xB1, 0xF>(v); v += dppf<0x4E, 0xF>(v); v += dppf<0x141, 0xF>(v); return v; }
__device__ __forceinline__ void ph_dsa_attn(const Args& A, Frame& F, const XInfo X) {
    const bf16* Z = (const bf16*)(A.ws + WS_Z); const unsigned short* SEL = (const unsigned short*)(A.ws + WS_LA); const int* CNT = (const int*)(A.ws + WS_CNT);
    const unsigned char* K8 = A.ws + WS_BIG + 264 * MiB; const unsigned char* V8 = A.ws + WS_BIG + 280 * MiB; bf16* Y = (bf16*)(A.ws + WS_HY);
    LAS int* IDX = (LAS int*)(F.lds + F.wave * 5120);
    LAS float* SCR = (LAS float*)(F.lds + F.wave * 5120 + 1024);
    const int g8 = F.lane >> 3, c8 = F.lane & 7;
    for (int sl = X.rx; sl < 8; sl += X.nx) {
        const int b = sl >> 2, kvh = sl & 3;
        const unsigned char* kb = K8 + (size_t)sl * SEQ * 128 + 16 * c8; const unsigned char* vb = V8 + (size_t)sl * SEQ * 128 + 16 * c8;
        const int l15 = F.lane & 15, g4 = F.lane >> 4;
        int pf_n = 0; unsigned pf_sel[4] = {0u, 0u, 0u, 0u}; u32x4 pf_qa[2], pf_qb[2];
#pragma unroll
        for (int c = 0; c < 2; ++c) { pf_qa[c] = (u32x4){0u, 0u, 0u, 0u}; pf_qb[c] = (u32x4){0u, 0u, 0u, 0u}; }
#define AT_LOAD(sq_) do { const int t_ = b * SEQ + (sq_); pf_n = CNT[t_]; \
            _Pragma("unroll") for (int m = 0; m < 4; ++m) pf_sel[m] = (unsigned)SEL[(size_t)t_ * 256 + F.lane + 64 * m]; \
            if (l15 < 4) { _Pragma("unroll") for (int c = 0; c < 2; ++c) { const bf16* qp = Z + (size_t)t_ * OD_NP + (kvh * 4 + l15) * 128 + 64 * c + 16 * g4; pf_qa[c] = *(const u32x4*)qp; pf_qb[c] = *(const u32x4*)(qp + 8); } } } while (0)
        { const int sq0 = X.rank * NWAVES + F.wave; if (sq0 < SEQ) AT_LOAD(sq0); }
        for (int sq = X.rank * NWAVES + F.wave; sq < SEQ; sq += X.nloc * NWAVES) {
            const int t = b * SEQ + sq; const int n = pf_n;
            const unsigned csel[4] = {pf_sel[0], pf_sel[1], pf_sel[2], pf_sel[3]}; const u32x4 cqa[2] = {pf_qa[0], pf_qa[1]}, cqb[2] = {pf_qb[0], pf_qb[1]};
            { const int sqn = sq + X.nloc * NWAVES; if (sqn < SEQ) AT_LOAD(sqn); }
            long bq[4];
#pragma unroll
            for (int c = 0; c < 2; ++c) {
                float f[16];
#pragma unroll
                for (int e = 0; e < 16; ++e) f[e] = 0.f;
                if (l15 < 4) { const u32x4 a = cqa[c], b2 = cqb[c];
                    const unsigned aw[8] = {a.x, a.y, a.z, a.w, b2.x, b2.y, b2.z, b2.w};
#pragma unroll
                    for (int q = 0; q < 8; ++q) { f[2 * q] = lo2f(aw[q]) * 16.0f; f[2 * q + 1] = hi2f(aw[q]) * 16.0f; } }
#pragma unroll
                for (int hf = 0; hf < 2; ++hf) {
                    int lo = __builtin_amdgcn_cvt_pk_fp8_f32(f[8 * hf + 0], f[8 * hf + 1], 0, false); lo = __builtin_amdgcn_cvt_pk_fp8_f32(f[8 * hf + 2], f[8 * hf + 3], lo, true);
                    int hi = __builtin_amdgcn_cvt_pk_fp8_f32(f[8 * hf + 4], f[8 * hf + 5], 0, false); hi = __builtin_amdgcn_cvt_pk_fp8_f32(f[8 * hf + 6], f[8 * hf + 7], hi, true);
                    bq[2 * c + hf] = (long)(((unsigned long long)(unsigned)hi << 32) | (unsigned long long)(unsigned)lo); }
            }
#pragma unroll
            for (int m = 0; m < 4; ++m) { const int jj = F.lane + 64 * m; IDX[jj] = (jj < n) ? (int)csel[m] : 0; }
            asm volatile("s_waitcnt lgkmcnt(0)" ::: "memory"); __builtin_amdgcn_wave_barrier();
            {
                const unsigned char* kq = K8 + (size_t)sl * SEQ * 128 + 16 * g4;
#pragma unroll 1
                for (int tl0 = 0; tl0 < 16; tl0 += 4) {
                    u32x4 k0[4], k1[4];
#pragma unroll
                    for (int u = 0; u < 4; ++u) { const int id = IDX[(tl0 + u) * 16 + l15]; const unsigned char* kr = kq + (size_t)id * 128; k0[u] = *(const u32x4*)kr; k1[u] = *(const u32x4*)(kr + 64); }
#pragma unroll
                    for (int u = 0; u < 4; ++u) {
                        f32x4 acc = {0.f, 0.f, 0.f, 0.f};
                        acc = __builtin_amdgcn_mfma_f32_16x16x32_fp8_fp8((long)(((unsigned long long)k0[u].y << 32) | k0[u].x), bq[0], acc, 0, 0, 0);
                        acc = __builtin_amdgcn_mfma_f32_16x16x32_fp8_fp8((long)(((unsigned long long)k0[u].w << 32) | k0[u].z), bq[1], acc, 0, 0, 0);
                        acc = __builtin_amdgcn_mfma_f32_16x16x32_fp8_fp8((long)(((unsigned long long)k1[u].y << 32) | k1[u].x), bq[2], acc, 0, 0, 0);
                        acc = __builtin_amdgcn_mfma_f32_16x16x32_fp8_fp8((long)(((unsigned long long)k1[u].w << 32) | k1[u].z), bq[3], acc, 0, 0, 0);
                        if (l15 < 4) {
#pragma unroll
                            for (int rg = 0; rg < 4; ++rg) SCR[((tl0 + u) * 16 + 4 * g4 + rg) * 4 + l15] = acc[rg] * 3.452669831e-4f; }
                    }
                }
            }
            asm volatile("s_waitcnt lgkmcnt(0)" ::: "memory"); __builtin_amdgcn_wave_barrier();
            float sclh[4], offh[4];
            {
                f32x4 sv[4]; unsigned pqb[4][4];
#pragma unroll
                for (int m = 0; m < 4; ++m) sv[m] = *(const LAS f32x4*)(SCR + (F.lane + 64 * m) * 4);
#pragma unroll
                for (int g = 0; g < 4; ++g) {
                    float mx = -INFINITY;
#pragma unroll
                    for (int m = 0; m < 4; ++m) { const bool val = (F.lane + 64 * m) < n; sv[m][g] = val ? sv[m][g] : -INFINITY; mx = fmaxf(mx, sv[m][g]); }
                    mx = wmax(mx); float sm = 0.f, sq = 0.f;
#pragma unroll
                    for (int m = 0; m < 4; ++m) { const bool val = (F.lane + 64 * m) < n; const float ex = val ? expf(sv[m][g] - mx) : 0.f; sm += ex;
                        const float pf = rintf(255.0f * ex); sq += pf; pqb[m][g] = (unsigned)pf; }
                    sclh[g] = 0.0625f / (255.0f * wsum(sm)); offh[g] = 128.0f * wsum(sq);
                }
                asm volatile("s_waitcnt lgkmcnt(0)" ::: "memory"); __builtin_amdgcn_wave_barrier();
#pragma unroll
                for (int m = 0; m < 4; ++m) { const int jj = F.lane + 64 * m;
#pragma unroll
                    for (int g = 0; g < 4; ++g) ((LAS unsigned char*)SCR)[(jj >> 2) * 16 + g * 4 + (jj & 3)] = (unsigned char)pqb[m][g]; }
            }
            asm volatile("s_waitcnt lgkmcnt(0)" ::: "memory"); __builtin_amdgcn_wave_barrier();
            unsigned acc[4][16];
#pragma unroll
            for (int g = 0; g < 4; ++g)
#pragma unroll
                for (int j = 0; j < 16; ++j) acc[g][j] = 0u;
#pragma unroll 1
            for (int ib = 0; ib < 8; ib += 2) {
                u32x4 vd[2][4], pq4[2];
#pragma unroll
                for (int h = 0; h < 2; ++h) { pq4[h] = *(const LAS u32x4*)((const LAS unsigned char*)SCR + (8 * (ib + h) + g8) * 16);
#pragma unroll
                    for (int u = 0; u < 4; ++u) { const int id = IDX[32 * (ib + h) + 4 * g8 + u]; vd[h][u] = *(const u32x4*)(vb + (size_t)id * 128); } }
#pragma unroll
                for (int h = 0; h < 2; ++h)
#pragma unroll
                    for (int q = 0; q < 4; ++q) { const unsigned A_ = vd[h][0][q], B_ = vd[h][1][q], C_ = vd[h][2][q], D_ = vd[h][3][q];
                        const unsigned ablo = __builtin_amdgcn_perm(B_, A_, 0x05010400u), abhi = __builtin_amdgcn_perm(B_, A_, 0x07030602u);
                        const unsigned cdlo = __builtin_amdgcn_perm(D_, C_, 0x05010400u), cdhi = __builtin_amdgcn_perm(D_, C_, 0x07030602u);
                        const unsigned t0 = __builtin_amdgcn_perm(cdlo, ablo, 0x05040100u), t1 = __builtin_amdgcn_perm(cdlo, ablo, 0x07060302u);
                        const unsigned t2 = __builtin_amdgcn_perm(cdhi, abhi, 0x05040100u), t3 = __builtin_amdgcn_perm(cdhi, abhi, 0x07060302u);
#pragma unroll
                        for (int g = 0; g < 4; ++g) { const unsigned pg = pq4[h][g];
                            acc[g][4 * q + 0] = __builtin_amdgcn_udot4(t0, pg, acc[g][4 * q + 0], false); acc[g][4 * q + 1] = __builtin_amdgcn_udot4(t1, pg, acc[g][4 * q + 1], false);
                            acc[g][4 * q + 2] = __builtin_amdgcn_udot4(t2, pg, acc[g][4 * q + 2], false); acc[g][4 * q + 3] = __builtin_amdgcn_udot4(t3, pg, acc[g][4 * q + 3], false); } }
            }
            f32x2 mine[8];
            { const int hr = F.lane >> 4; const float scl = (hr == 0) ? sclh[0] : ((hr == 1) ? sclh[1] : ((hr == 2) ? sclh[2] : sclh[3])), off = (hr == 0) ? offh[0] : ((hr == 1) ? offh[1] : ((hr == 2) ? offh[2] : offh[3]));
#pragma unroll
              for (int q = 0; q < 8; ++q) {
                float x[4][2];
#pragma unroll
                for (int g = 0; g < 4; ++g) { float a0 = (float)acc[g][2 * q], a1 = (float)acc[g][2 * q + 1];
                    a0 += dppf<0x128, 0xF>(a0); a1 += dppf<0x128, 0xF>(a1);
                    x[g][0] = a0; x[g][1] = a1; }
                mine[q].x = (rsum4(x[0][0], x[1][0], x[2][0], x[3][0]) - off) * scl; mine[q].y = (rsum4(x[0][1], x[1][1], x[2][1], x[3][1]) - off) * scl;
              } }
            if ((F.lane & 8) == 0) { u32x4 w0, w1; const int hrow = F.lane >> 4;
                w0.x = pk2(mine[0].x, mine[0].y); w0.y = pk2(mine[1].x, mine[1].y); w0.z = pk2(mine[2].x, mine[2].y); w0.w = pk2(mine[3].x, mine[3].y);
                w1.x = pk2(mine[4].x, mine[4].y); w1.y = pk2(mine[5].x, mine[5].y); w1.z = pk2(mine[6].x, mine[6].y); w1.w = pk2(mine[7].x, mine[7].y);
                bf16* yp = Y + (size_t)t * DM + (kvh * 4 + hrow) * 128 + 16 * c8; *(u32x4*)yp = w0; *(u32x4*)(yp + 8) = w1; }
            asm volatile("s_waitcnt lgkmcnt(0)" ::: "memory"); __builtin_amdgcn_wave_barrier();
        }
    }
}

__global__ void __launch_bounds__(NTHREADS, 2) mk_fwd(Args args) {
    extern __shared__ __attribute__((aligned(16))) unsigned char lds[];
    Frame F;
    F.lds = (LAS unsigned char*)lds;
    volatile LAS unsigned* MISC = (volatile LAS unsigned*)(F.lds + MISC_OFF);
    F.tid = threadIdx.x; F.lane = F.tid & 63; F.wave = __builtin_amdgcn_readfirstlane(F.tid >> 6);
    F.bx = blockIdx.x; F.G = gridDim.x; F.gw = F.bx * NWAVES + F.wave; F.ngw = F.G * NWAVES;
    if (F.tid < 64) MISC[F.tid] = 0u;
    __syncthreads();
    unsigned char* ws = args.ws;
    XcdBarrier bar = xcd_barrier_post((unsigned*)(ws + WS_CTL) + CW_BAR, MISC + 8);
    if (F.tid == 0) { MISC[16] = xb_add((unsigned*)(ws + WS_CTL) + CW_XRANK + 64 * bar.x, 1u); }
    const int lo = args.ph_lo, hi = args.ph_hi;
#define IN(k) (lo <= (k) && (k) < hi)
#define SEAM(k) do { if (IN((k) + 1)) xcd_barrier(bar); } while (0)
#define GEMM_BF16(Aptr, Bptr, Nn, Kk, Optr, ldo) do { pg8::Gemm g{(const pg8::bf16_t*)(Aptr), (const pg8::bf16_t*)(Bptr), TOK, (Nn), (Kk)}; pg8::StaticOrder S; S.init(TOK, (Nn), F.G, F.bx); \
        pg8::EpiBf16<0> E{(pg8::bf16_t*)(Optr), (ldo), nullptr, 0, 0}; pg8::gemm_phase<pg8::EpiBf16<0>, pg8::StaticOrder, false>(F.lds, g, S, E, nullptr); } while (0)

#ifndef PROBE_MASK
#define PROBE_MASK 0
#endif
#define PRB(bit, stmt) do { if (PROBE_MASK & (1 << (bit))) { stmt; xcd_barrier(bar); } } while (0)
    if (IN(0)) { PRB(14, ph_prologue(args, F)); ph_prologue(args, F); SEAM(0); }
    if (IN(1)) { ph_mod_x(args, F); SEAM(1); }
    if (F.tid == 0) {
        unsigned* cb = (unsigned*)(ws + WS_CTL) + CW_BAR; unsigned nloc = 1u, rx = 0u, nx = 0u;
        for (unsigned j = 0; j < 16; ++j) { const unsigned c = xb_ld(&cb[XB_XCNT(j)]); if (c > 0u) { if (j < bar.x) ++rx; ++nx; } if (j == bar.x) nloc = c > 0u ? c : 1u; }
        if (nx == 0u) nx = 1u;
        MISC[17] = nloc; MISC[18] = rx; MISC[19] = nx; }
    __syncthreads();
    const XInfo XI = xcc_info(MISC);
    if (IN(2)) { PRB(8, GEMM_BF16(ws + WS_HY, ws + WS_WINE, EV_NP, 2048, ws + WS_Z, EV_NP)); GEMM_BF16(ws + WS_HY, ws + WS_WINE, EV_NP, 2048, ws + WS_Z, EV_NP); SEAM(2); }
    if (IN(3)) { ph_even_post(args, F); SEAM(3); }
    if (IN(4)) { pg8::Gemm g{(const pg8::bf16_t*)(ws + WS_LA), (const pg8::bf16_t*)(ws + WS_WL), TOK, 3072, 512}; pg8::StaticOrder S; S.init(TOK, 3072, F.G, F.bx);
                 EpiLora E{(pg8::bf16_t*)(ws + WS_Z) + 1280, EV_NP, (const float*)args.in[7], (const float*)args.in[9]};
                 pg8::gemm_phase<EpiLora, pg8::StaticOrder, false>(F.lds, g, S, E, nullptr); SEAM(4); }
    if (IN(5)) { PRB(9, ph_scan_prep(args, F)); ph_scan_prep(args, F); xcd_barrier(bar); }
    if (IN(7)) { PRB(15, scan_mfma_rows(args, F)); ph_swa_mfma(args, F); scan_mfma_rows(args, F); SEAM(7); }
    if (IN(8)) { PRB(10, ph_rwkv_finish(args, F)); ph_rwkv_finish(args, F); SEAM(8); }
    if (IN(9)) { GEMM_BF16(ws + WS_HY, ws + WS_WOUTE, 2048, 2048, ws + WS_Z, 2048); SEAM(9); }
    if (IN(10)) { PRB(11, ph_ln_mixer(args, F, 0)); ph_ln_mixer(args, F, 0); SEAM(10); }
    if (IN(11)) { GEMM_BF16(ws + WS_HY, ws + WS_WQ0, 2048, 2048, ws + WS_Z, 2048); SEAM(11); }
    if (IN(12)) { PRB(4, ph_peer_select(args, F, 0)); ph_peer_select(args, F, 0); SEAM(12); }
    if (IN(13)) { PRB(12, ph_peer_u(args, F, XI)); ph_peer_u(args, F, XI); xcd_barrier(bar); ph_peer_act(args, F); xcd_barrier(bar); PRB(13, ph_peer_v(args, F, XI)); ph_peer_v(args, F, XI); xcd_barrier(bar); ph_peer_ln(args, F, 0); SEAM(13); }
    if (IN(14)) { GEMM_BF16(ws + WS_HY, ws + WS_WINO, OD_NP, 2048, ws + WS_Z, OD_NP); SEAM(14); }
    if (IN(15)) { ph_odd_post(args, F); SEAM(15); }
    if (IN(16)) { PRB(2, ph_dsa_select(args, F, 1)); PRB(6, ph_dsa_select(args, F, 2)); PRB(7, ph_dsa_select(args, F, 0)); ph_dsa_select(args, F); SEAM(16); }
    if (IN(17)) { ph_dsa_attn(args, F, XI); SEAM(17); }
    if (IN(18)) { GEMM_BF16(ws + WS_HY, ws + WS_WOUTO, 2048, 2048, ws + WS_Z, 2048); SEAM(18); }
    if (IN(19)) { ph_ln_mixer(args, F, 1); SEAM(19); }
    if (IN(20)) { GEMM_BF16(ws + WS_HY, ws + WS_WQ1, 2048, 2048, ws + WS_Z, 2048); SEAM(20); }
    if (IN(21)) { PRB(4, ph_peer_select(args, F, 1)); ph_peer_select(args, F, 1); SEAM(21); }
    if (IN(22)) { ph_peer_u(args, F, XI); xcd_barrier(bar); ph_peer_act(args, F); xcd_barrier(bar); ph_peer_v(args, F, XI); xcd_barrier(bar); ph_peer_ln(args, F, 1); }
#undef IN
#undef SEAM
#undef GEMM_BF16
}

#ifndef MK_SPLIT
#define MK_SPLIT 0
#endif
extern "C" void kernel_launch(void* const* d_in, const int* in_sizes, int n_in, void* d_out, int out_size, void* d_ws, size_t ws_size, hipStream_t stream) {
    static int grid = 0;
    if (grid == 0) {
        int dev = 0, cus = 0;
        if (n_in != 27 || out_size != TOK * DM || ws_size < WS_END) { fprintf(stderr, "kernel_launch: unexpected shapes (n_in %d out %d ws %zu)\n", n_in, out_size, ws_size); grid = -1; return; }
        if (hipGetDevice(&dev) != hipSuccess || hipDeviceGetAttribute(&cus, hipDeviceAttributeMultiprocessorCount, dev) != hipSuccess) { grid = -1; return; }
        if (hipFuncSetAttribute((const void*)mk_fwd, hipFuncAttributeMaxDynamicSharedMemorySize, LDS_BYTES) != hipSuccess) { fprintf(stderr, "kernel_launch: hipFuncSetAttribute failed\n"); grid = -1; return; }
        int per_cu = 0;
        if (hipOccupancyMaxActiveBlocksPerMultiprocessor(&per_cu, (const void*)mk_fwd, NTHREADS, LDS_BYTES) != hipSuccess || per_cu < 1) fprintf(stderr, "kernel_launch: occupancy query says %d\n", per_cu);
        (void)hipGetLastError();
        grid = cus;
    }
    if (grid < 0) return;
    (void)hipMemsetAsync((char*)d_ws + WS_CTL, 0, CTL_ZERO_BYTES, stream);
    Args a{};
    for (int i = 0; i < 27; ++i) a.in[i] = d_in[i];
    a.out = (float*)d_out; a.ws = (unsigned char*)d_ws;
#if MK_SPLIT
    for (int p = 0; p < 23; ++p) { a.ph_lo = p; a.ph_hi = p + 1; hipLaunchKernelGGL(mk_fwd, dim3(grid), dim3(NTHREADS), LDS_BYTES, stream, a); }
#else
    a.ph_lo = 0; a.ph_hi = 23;
    hipLaunchKernelGGL(mk_fwd, dim3(grid), dim3(NTHREADS), LDS_BYTES, stream, a);
#endif
}
```

```cpp
#include <hip/hip_runtime.h>
#include <cstdio>
#include <cstdint>
namespace pg8 {
#define PG8_LAS __attribute__((address_space(3)))
typedef unsigned short bf16_t;
typedef short bf16x8 __attribute__((ext_vector_type(8)));
typedef float f32x4 __attribute__((ext_vector_type(4)));
typedef unsigned u32x4 __attribute__((ext_vector_type(4)));
constexpr int BM = 256, BK = 64, HALF = 128, HTB = HALF * BK * 2  , STAGE_BYTES = 8 * HTB, NXCD = 8, WGM = 8;

__host__ __device__ __forceinline__ int lds_byte(int r, int c) { const int st = (r >> 4) * 2 + (c >> 5), rr = r & 15, cc = c & 31, ob = rr * 64 + cc * 2; return st * 1024 + (ob ^ (((ob >> 9) & 1) << 5)); }
__host__ __device__ __forceinline__ void stage_rc(int b, int& R, int& C) { const int st = b / 1024, sb = b % 1024, swz = sb ^ (((sb >> 9) & 1) << 5); R = (st >> 1) * 16 + swz / 64; C = (st & 1) * 32 + (swz % 64) / 2; }
__host__ __device__ __forceinline__ int perm32(int rho) { const int n = rho >> 4, i = rho & 15; return 8 * (i >> 2) + 4 * n + (i & 3); }

struct Unit { int pm, pn; };
struct Gemm { const bf16_t* A; const bf16_t* Bt; int M, N, K; };

struct StaticOrder {
    int nM, nN, nwg, G, c;
    __host__ __device__ void init(int M, int N, int G_, int c_) { nM = M / BM; nN = N / BM; nwg = nM * nN; G = G_; c = c_; }
    __host__ __device__ bool next(int i, Unit& u) const {
        const long L = (long)i * G + c; if (L >= nwg) return false;
        int wgid = (int)L; { const int q = nwg / NXCD, r = nwg % NXCD, xcd = wgid % NXCD, off = wgid / NXCD; wgid = (xcd < r ? xcd * (q + 1) : r * (q + 1) + (xcd - r) * q) + off; }
        const int nig = WGM * nN, gid = wgid / nig, fm = gid * WGM, gsz = (nM - fm) < WGM ? (nM - fm) : WGM;
        u.pm = fm + ((wgid % nig) % gsz); u.pn = (wgid % nig) / gsz; return true;
    }
    __device__ __forceinline__ void a_ready(const Unit&) const {}
    __device__ __forceinline__ void done(const Unit&) const {}
};
struct CountedOrder : StaticOrder {
    const unsigned* ready; unsigned need; unsigned* tmo;
    __device__ __forceinline__ void a_ready(const Unit& u) const {
        if (threadIdx.x < 64) {
            const unsigned long long t0 = __builtin_amdgcn_s_memrealtime(); unsigned polls = 0;
            while ((unsigned)__builtin_amdgcn_readfirstlane(__hip_atomic_load(ready + 64 * u.pm, __ATOMIC_RELAXED, __HIP_MEMORY_SCOPE_AGENT)) < need) {
                if ((++polls & 255u) == 0u && __builtin_amdgcn_readfirstlane(__hip_atomic_load(tmo, __ATOMIC_RELAXED, __HIP_MEMORY_SCOPE_AGENT)) != 0u) break;
                if (__builtin_amdgcn_s_memrealtime() - t0 > 2000000ull) {
                    if (threadIdx.x == 0) { unsigned expect = 0u; __hip_atomic_compare_exchange_strong(tmo + 1, &expect, 0x600u | (unsigned)(u.pm & 0xff), __ATOMIC_RELAXED, __ATOMIC_RELAXED, __HIP_MEMORY_SCOPE_AGENT); __hip_atomic_store(tmo, 1u, __ATOMIC_RELAXED, __HIP_MEMORY_SCOPE_AGENT); }
                    break; }
                __builtin_amdgcn_s_sleep(2); }
            __builtin_amdgcn_fence(__ATOMIC_ACQUIRE, "agent");
            asm volatile("s_waitcnt vmcnt(0)" ::: "memory");
        }
#if !defined(BROKEN_HOOK_NO_BARRIER)
        asm volatile("" ::: "memory"); __builtin_amdgcn_s_barrier(); asm volatile("" ::: "memory");
#endif
    }
};

__device__ __forceinline__ unsigned cvt_pk_bf16(float lo, float hi) { unsigned r; asm volatile("v_cvt_pk_bf16_f32 %0, %1, %2" : "=v"(r) : "v"(lo), "v"(hi)); return r; }
typedef float f32x2 __attribute__((ext_vector_type(2)));
__device__ __forceinline__ f32x2 gelu_pk(f32x2 v) {
    const f32x2 av = __builtin_elementwise_abs(v), d = av * 0.2316418882f + 1.0f;
    f32x2 t; t.x = __builtin_amdgcn_rcpf(d.x); t.y = __builtin_amdgcn_rcpf(d.y);
    f32x2 q = t * 0.5307027145f + (-0.7265760135f); q = q * t + 0.7107068705f; q = q * t + (-0.142248368f); q = q * t + 0.127414796f; q = q * t;
    const f32x2 s = (v * v) * (-0.72134752044f);
    f32x2 e; e.x = __builtin_amdgcn_exp2f(s.x); e.y = __builtin_amdgcn_exp2f(s.y);
    const f32x2 m = v * (q * e), r = v - m;
    f32x2 o; o.x = v.x < 0.f ? m.x : r.x; o.y = v.y < 0.f ? m.y : r.y; return o;
}

struct EpiF32 {
    static constexpr bool PERM = false, AFTER_DRAIN = false;
    float* C; int ldc; const float* bias;
    __device__ __forceinline__ void operator()(const f32x4 (&acc)[2][2][4][2], const Unit& u, int wr, int wc, int fr, int fq) const {
        const int row0 = u.pm * BM + wr * 64 + fr, col0 = u.pn * BM + wc * 32 + 4 * fq;
        f32x4 bv[2][2];
#pragma unroll
        for (int bj = 0; bj < 2; ++bj)
#pragma unroll
            for (int n = 0; n < 2; ++n) bv[bj][n] = bias ? *(const f32x4*)(bias + col0 + bj * HALF + n * 16) : (f32x4){0.f, 0.f, 0.f, 0.f};
#pragma unroll
        for (int ai = 0; ai < 2; ++ai)
#pragma unroll
            for (int m = 0; m < 4; ++m) { float* rowp = C + (size_t)(row0 + ai * HALF + m * 16) * ldc + col0;
#pragma unroll
                for (int bj = 0; bj < 2; ++bj)
#pragma unroll
                    for (int n = 0; n < 2; ++n) *(f32x4*)(rowp + bj * HALF + n * 16) = acc[ai][bj][m][n] + bv[bj][n]; }
    }
};
template <int ACT  > struct EpiBf16 {
    static constexpr bool PERM = true, AFTER_DRAIN = false;
    bf16_t* O; int ldc; const float* bias; int split_cols; size_t split_stride;
    __device__ __forceinline__ void operator()(const f32x4 (&acc)[2][2][4][2], const Unit& u, int wr, int wc, int fr, int fq) const {
        const int row0 = u.pm * BM + wr * 64 + fr; int colt = u.pn * BM; bf16_t* base = O;
        if (split_cols) { const int t = colt / split_cols; base += (size_t)t * split_stride; colt -= t * split_cols; }
        const int col0 = colt + wc * 32 + 8 * fq, bcol0 = u.pn * BM + wc * 32 + 8 * fq;
        f32x4 bv[2][2];
#pragma unroll
        for (int bj = 0; bj < 2; ++bj)
#pragma unroll
            for (int n = 0; n < 2; ++n) bv[bj][n] = bias ? *(const f32x4*)(bias + bcol0 + bj * HALF + 4 * n) : (f32x4){0.f, 0.f, 0.f, 0.f};
#pragma unroll
        for (int ai = 0; ai < 2; ++ai)
#pragma unroll
            for (int m = 0; m < 4; ++m) { bf16_t* rowp = base + (size_t)(row0 + ai * HALF + m * 16) * ldc + col0;
#pragma unroll
                for (int bj = 0; bj < 2; ++bj) { f32x4 v0 = acc[ai][bj][m][0] + bv[bj][0], v1 = acc[ai][bj][m][1] + bv[bj][1];
                    if (ACT == 1) { f32x2 a = gelu_pk((f32x2){v0[0], v0[1]}), b = gelu_pk((f32x2){v0[2], v0[3]}), c = gelu_pk((f32x2){v1[0], v1[1]}), d = gelu_pk((f32x2){v1[2], v1[3]});
                        v0 = (f32x4){a.x, a.y, b.x, b.y}; v1 = (f32x4){c.x, c.y, d.x, d.y}; }
                    if (ACT == 2) {
#pragma unroll
                        for (int j = 0; j < 4; ++j) { v0[j] = 0.5f * v0[j] * (1.0f + erff(v0[j] * 0.70710678f)); v1[j] = 0.5f * v1[j] * (1.0f + erff(v1[j] * 0.70710678f)); } }
                    u32x4 w; w.x = cvt_pk_bf16(v0[0], v0[1]); w.y = cvt_pk_bf16(v0[2], v0[3]); w.z = cvt_pk_bf16(v1[0], v1[1]); w.w = cvt_pk_bf16(v1[2], v1[3]);
                    *(u32x4*)(rowp + bj * HALF) = w; } }
    }
};

struct PanelStats {
    unsigned* xbuf;
    unsigned* cnt;
    unsigned* tmo;
    int ntn; float eps;
    unsigned code;
    __device__ __forceinline__ bool run(const f32x4 (&v)[2][2][4][2], const Unit& u, int wr, int wc, int fr, int fq, PG8_LAS unsigned char* lds, int wid, int lane) const {
        typedef float f32x2v __attribute__((ext_vector_type(2)));
        PG8_LAS f32x2v* P = (PG8_LAS f32x2v*)lds;
        PG8_LAS f32x2v* S = (PG8_LAS f32x2v*)(lds + 8192);
        PG8_LAS unsigned* flag = (PG8_LAS unsigned*)(lds + 8192 + 2048);
#pragma unroll
        for (int ai = 0; ai < 2; ++ai)
#pragma unroll
            for (int m = 0; m < 4; ++m) {
                float s = 0.f;
#pragma unroll
                for (int bj = 0; bj < 2; ++bj)
#pragma unroll
                    for (int n = 0; n < 2; ++n) { const f32x4 x = v[ai][bj][m][n]; s += (x[0] + x[1]) + (x[2] + x[3]); }
                s += __shfl_xor(s, 16); s += __shfl_xor(s, 32);
                const float mw = s * (1.0f / 64.0f); float q = 0.f;
#pragma unroll
                for (int bj = 0; bj < 2; ++bj)
#pragma unroll
                    for (int n = 0; n < 2; ++n) { const f32x4 d = v[ai][bj][m][n] - mw; q += (d[0] * d[0] + d[1] * d[1]) + (d[2] * d[2] + d[3] * d[3]); }
                q += __shfl_xor(q, 16); q += __shfl_xor(q, 32);
                if (fq == 0) P[(ai * HALF + wr * 64 + m * 16 + fr) * 4 + wc] = (f32x2v){mw, q};
            }
        asm volatile("s_waitcnt lgkmcnt(0)" ::: "memory"); __builtin_amdgcn_s_barrier(); asm volatile("" ::: "memory");
#if defined(BROKEN_NO_WAIT)
        if (blockIdx.x >= 64) { const long long t0 = clock64(); while (clock64() - t0 < 60000) __builtin_amdgcn_s_sleep(8); }
#endif
        const int row = wid * 32 + (lane & 31);
        if (lane < 32) {
            const f32x2v a = P[row * 4 + 0], b = P[row * 4 + 1], c = P[row * 4 + 2], d = P[row * 4 + 3];
            const float mt = (a.x + b.x + c.x + d.x) * 0.25f;
            const float da = a.x - mt, db = b.x - mt, dc = c.x - mt, dd = d.x - mt;
            const float m2 = (a.y + b.y) + (c.y + d.y) + 64.0f * ((da * da + db * db) + (dc * dc + dd * dd));
            unsigned long long* slot = (unsigned long long*)xbuf + ((size_t)(u.pm * BM + row) * 4 + u.pn);
            __hip_atomic_store(slot, ((unsigned long long)__float_as_uint(m2) << 32) | __float_as_uint(mt), __ATOMIC_RELAXED, __HIP_MEMORY_SCOPE_AGENT);
        }
        asm volatile("s_waitcnt vmcnt(0)" ::: "memory");
        if (lane == 0) __hip_atomic_fetch_add(cnt + 64 * u.pm, 1u, __ATOMIC_RELAXED, __HIP_MEMORY_SCOPE_AGENT);
        if (wid == 0) {
            bool dead = false; const unsigned long long t0 = __builtin_amdgcn_s_memrealtime(); const unsigned want = 8u * (unsigned)ntn;
            for (;;) {
#if defined(BROKEN_NO_WAIT)
                break;
#endif
                if ((unsigned)__builtin_amdgcn_readfirstlane(__hip_atomic_load(cnt + 64 * u.pm, __ATOMIC_RELAXED, __HIP_MEMORY_SCOPE_AGENT)) >= want) break;
                if (__builtin_amdgcn_s_memrealtime() - t0 > 2000000ull) {
                    if (lane == 0) { unsigned expect = 0u; __hip_atomic_compare_exchange_strong(tmo + 1, &expect, code | (unsigned)(u.pm & 0xff), __ATOMIC_RELAXED, __ATOMIC_RELAXED, __HIP_MEMORY_SCOPE_AGENT);
                                     __hip_atomic_store(tmo, 1u, __ATOMIC_RELAXED, __HIP_MEMORY_SCOPE_AGENT); }
                    dead = true; break; }
                __builtin_amdgcn_s_sleep(2);
            }
            __builtin_amdgcn_fence(__ATOMIC_ACQUIRE, "agent");
            if (lane == 0) flag[0] = dead ? 1u : 0u;
        }
        asm volatile("s_waitcnt vmcnt(0) lgkmcnt(0)" ::: "memory"); __builtin_amdgcn_s_barrier(); asm volatile("" ::: "memory");
        const bool bad = flag[0] != 0u;
        if (lane < 32) {
            const unsigned long long* slot = (const unsigned long long*)xbuf + (size_t)(u.pm * BM + row) * 4; float mt[4], m2[4]; float ms = 0.f;
#pragma unroll
            for (int t = 0; t < 4; ++t) { if (t < ntn) { const unsigned long long w = __hip_atomic_load(slot + t, __ATOMIC_RELAXED, __HIP_MEMORY_SCOPE_AGENT); mt[t] = __uint_as_float((unsigned)w); m2[t] = __uint_as_float((unsigned)(w >> 32)); } else { mt[t] = 0.f; m2[t] = 0.f; } ms += mt[t]; }
            const float mean = ms / (float)ntn; float q = 0.f;
#pragma unroll
            for (int t = 0; t < 4; ++t) if (t < ntn) { const float dm = mt[t] - mean; q += m2[t] + 256.0f * dm * dm; }
            S[row] = (f32x2v){mean, 1.0f / sqrtf(q / (256.0f * (float)ntn) + eps)};
        }
        asm volatile("s_waitcnt lgkmcnt(0)" ::: "memory"); __builtin_amdgcn_s_barrier(); asm volatile("" ::: "memory");
        return bad;
    }
};
struct EpiLnRes {
    static constexpr bool PERM = false, AFTER_DRAIN = true;
    const float* base; float* out; int ldc; const float* bias; PanelStats st; unsigned poison;
    __device__ __forceinline__ void refuse(size_t i0, size_t stride, int M, int N) const { const float q = __builtin_nanf(""); for (size_t i = i0; i < (size_t)M * N; i += stride) out[(i / N) * ldc + i % N] = q;
        if (i0 == 0) { unsigned expect = 0u; __hip_atomic_compare_exchange_strong(st.tmo + 1, &expect, 0x7f0u, __ATOMIC_RELAXED, __ATOMIC_RELAXED, __HIP_MEMORY_SCOPE_AGENT); __hip_atomic_store(st.tmo, 1u, __ATOMIC_RELAXED, __HIP_MEMORY_SCOPE_AGENT); } }
    __device__ __forceinline__ void fused(f32x4 (&acc)[2][2][4][2], const Unit& u, int wr, int wc, int fr, int fq, PG8_LAS unsigned char* lds, int wid, int lane) const {
        typedef float f32x2v __attribute__((ext_vector_type(2)));
        const PG8_LAS f32x2v* S = (const PG8_LAS f32x2v*)(lds + 8192);
        const int col0 = u.pn * BM + wc * 32 + 4 * fq;
#pragma unroll
        for (int bj = 0; bj < 2; ++bj)
#pragma unroll
            for (int n = 0; n < 2; ++n) { const f32x4 bv = bias ? *(const f32x4*)(bias + col0 + bj * HALF + n * 16) : (f32x4){0.f, 0.f, 0.f, 0.f};
#pragma unroll
                for (int ai = 0; ai < 2; ++ai)
#pragma unroll
                    for (int m = 0; m < 4; ++m) acc[ai][bj][m][n] += bv; }
        const bool bad = st.run(acc, u, wr, wc, fr, fq, lds, wid, lane) || poison != 0u;
        const float qnan = __builtin_nanf("");
#pragma unroll
        for (int ai = 0; ai < 2; ++ai)
#pragma unroll
            for (int m = 0; m < 4; ++m) { const int r = ai * HALF + wr * 64 + m * 16 + fr; const f32x2v sr = S[r]; const size_t off = (size_t)(u.pm * BM + r) * ldc + col0;
#pragma unroll
                for (int bj = 0; bj < 2; ++bj)
#pragma unroll
                    for (int n = 0; n < 2; ++n) { const f32x4 bs = *(const f32x4*)(base + off + bj * HALF + n * 16); f32x4 o = bs + (acc[ai][bj][m][n] - sr.x) * sr.y;
                        if (bad) o = (f32x4){qnan, qnan, qnan, qnan}; *(f32x4*)(out + off + bj * HALF + n * 16) = o; }
                asm volatile("" ::: "memory"); }
    }
};
struct EpiLnResLn {
    static constexpr bool PERM = false, AFTER_DRAIN = true;
    const float* base; float* out; bf16_t* xn; int ldc; const float* bias; PanelStats st1, st2; unsigned poison;
    __device__ __forceinline__ void refuse(size_t i0, size_t stride, int M, int N) const { const float q = __builtin_nanf(""); for (size_t i = i0; i < (size_t)M * N; i += stride) { const size_t o = (i / N) * ldc + i % N; out[o] = q; xn[o] = (bf16_t)0x7fc0u; }
        if (i0 == 0) { unsigned expect = 0u; __hip_atomic_compare_exchange_strong(st1.tmo + 1, &expect, 0x7f0u, __ATOMIC_RELAXED, __ATOMIC_RELAXED, __HIP_MEMORY_SCOPE_AGENT); __hip_atomic_store(st1.tmo, 1u, __ATOMIC_RELAXED, __HIP_MEMORY_SCOPE_AGENT); } }
    __device__ __forceinline__ void fused(f32x4 (&acc)[2][2][4][2], const Unit& u, int wr, int wc, int fr, int fq, PG8_LAS unsigned char* lds, int wid, int lane) const {
        typedef float f32x2v __attribute__((ext_vector_type(2))); typedef unsigned u32x2v __attribute__((ext_vector_type(2)));
        const PG8_LAS f32x2v* S = (const PG8_LAS f32x2v*)(lds + 8192);
        const int col0 = u.pn * BM + wc * 32 + 4 * fq;
#pragma unroll
        for (int bj = 0; bj < 2; ++bj)
#pragma unroll
            for (int n = 0; n < 2; ++n) { const f32x4 bv = bias ? *(const f32x4*)(bias + col0 + bj * HALF + n * 16) : (f32x4){0.f, 0.f, 0.f, 0.f};
#pragma unroll
                for (int ai = 0; ai < 2; ++ai)
#pragma unroll
                    for (int m = 0; m < 4; ++m) acc[ai][bj][m][n] += bv; }
        bool bad = st1.run(acc, u, wr, wc, fr, fq, lds, wid, lane) || poison != 0u;
        const float qnan = __builtin_nanf("");
#pragma unroll
        for (int ai = 0; ai < 2; ++ai)
#pragma unroll
            for (int m = 0; m < 4; ++m) { const int r = ai * HALF + wr * 64 + m * 16 + fr; const f32x2v sr = S[r]; const size_t off = (size_t)(u.pm * BM + r) * ldc + col0;
#pragma unroll
                for (int bj = 0; bj < 2; ++bj)
#pragma unroll
                    for (int n = 0; n < 2; ++n) { const f32x4 bs = *(const f32x4*)(base + off + bj * HALF + n * 16); acc[ai][bj][m][n] = bs + (acc[ai][bj][m][n] - sr.x) * sr.y; }
                asm volatile("" : "+v"(acc[ai][0][m][0]), "+v"(acc[ai][0][m][1]), "+v"(acc[ai][1][m][0]), "+v"(acc[ai][1][m][1]));
                if (m & 1) asm volatile("" ::: "memory"); }
        const bool bad1 = bad;
        bad = st2.run(acc, u, wr, wc, fr, fq, lds, wid, lane) || bad;
#pragma unroll
        for (int ai = 0; ai < 2; ++ai)
#pragma unroll
            for (int m = 0; m < 4; ++m) { const int r = ai * HALF + wr * 64 + m * 16 + fr; const f32x2v sr = S[r]; const size_t off = (size_t)(u.pm * BM + r) * ldc + col0;
#pragma unroll
                for (int bj = 0; bj < 2; ++bj)
#pragma unroll
                    for (int n = 0; n < 2; ++n) { const f32x4 x1 = acc[ai][bj][m][n]; *(f32x4*)(out + off + bj * HALF + n * 16) = bad1 ? (f32x4){qnan, qnan, qnan, qnan} : x1;
                        const f32x4 o = (x1 - sr.x) * sr.y; u32x2v w; w.x = cvt_pk_bf16(o[0], o[1]); w.y = cvt_pk_bf16(o[2], o[3]);
                        if (bad) { w.x = 0x7fc07fc0u; w.y = 0x7fc07fc0u; } *(u32x2v*)(xn + off + bj * HALF + n * 16) = w; }
                asm volatile("" ::: "memory"); }
    }
};

template <class Epi, class Sched, bool STAMP = false>
__device__ __forceinline__ void gemm_phase(PG8_LAS unsigned char* lds, const Gemm g, const Sched& S, const Epi& E, unsigned long long* stamps) {
    const int tid = threadIdx.x, wid = __builtin_amdgcn_readfirstlane(tid >> 6), lane = tid & 63, wr = wid >> 2, wc = wid & 3, fr = lane & 15, fq = lane >> 4;
    const int K = g.K, nt = K / BK;
    int ts_lo = 0, ts_hi = 0, nts = 0; const unsigned long long rt_entry = STAMP ? (unsigned long long)wall_clock64() : 0ull;
#define PG8_STAMP() do { if (STAMP && wid == 0 && nts < 64) { const unsigned long long _c = (unsigned long long)clock64(); \
        ts_lo = (lane == nts) ? (int)(unsigned)_c : ts_lo; ts_hi = (lane == nts) ? (int)(unsigned)(_c >> 32) : ts_hi; ++nts; } } while (0)
    PG8_STAMP();
    unsigned voffA[2], voffB[2];
#pragma unroll
    for (int i = 0; i < 2; ++i) { int R, C; stage_rc(tid * 16 + i * 8192, R, C); const int Rb = Epi::PERM ? ((R & ~31) + perm32(R & 31)) : R;
        voffA[i] = (unsigned)(R * K + C) * 2u; voffB[i] = (unsigned)(Rb * K + C) * 2u; }
    const size_t kstep = (size_t)(BK * 2);
    const size_t hstep = (size_t)HALF * K * 2;
    const size_t tstep = 2 * hstep;
    const unsigned ldsw = (unsigned)wid * 1024u;
    const int aoff = lds_byte(wr * 64 + fr, fq * 8), boff = lds_byte(wc * 32 + fr, fq * 8);
#define PG8_SA(b, h) (((b) * 2 + (h)) * HTB)
#define PG8_SB(b, h) ((4 + (b) * 2 + (h)) * HTB)
#define PG8_STAGE(bufoff, gbase, voff) do { _Pragma("unroll") for (int _i = 0; _i < 2; ++_i) \
        __builtin_amdgcn_global_load_lds((const unsigned*)((const char*)(gbase) + (voff)[_i]), (PG8_LAS unsigned*)(lds + (bufoff) + ldsw + _i * 8192), 16, 0, 0); } while (0)
#define PG8_LDA(dst, b, h) do { _Pragma("unroll") for (int m = 0; m < 4; ++m) _Pragma("unroll") for (int k = 0; k < 2; ++k) dst[m][k] = *(const PG8_LAS bf16x8*)(lds + PG8_SA(b, h) + aoff + m * 2048 + k * 1024); } while (0)
#define PG8_LDB(dst, b, h) do { _Pragma("unroll") for (int n = 0; n < 2; ++n) _Pragma("unroll") for (int k = 0; k < 2; ++k) dst[n][k] = *(const PG8_LAS bf16x8*)(lds + PG8_SB(b, h) + boff + n * 2048 + k * 1024); } while (0)
#define PG8_MMA(ai, bj, At, Bt) do { __builtin_amdgcn_s_setprio(1); _Pragma("unroll") for (int m = 0; m < 4; ++m) _Pragma("unroll") for (int n = 0; n < 2; ++n) _Pragma("unroll") for (int k = 0; k < 2; ++k) \
        acc[ai][bj][m][n] = __builtin_amdgcn_mfma_f32_16x16x32_bf16(Bt[n][k], At[m][k], acc[ai][bj][m][n], 0, 0, 0); __builtin_amdgcn_s_setprio(0); } while (0)
#define PG8_WAIT_V(n) asm volatile("s_waitcnt vmcnt(" #n ")" ::: "memory")
#define PG8_WAIT_L(n) asm volatile("s_waitcnt lgkmcnt(" #n ")" ::: "memory")
#define PG8_BAR __builtin_amdgcn_s_barrier()
#define PG8_SCHED __builtin_amdgcn_sched_barrier(0)
    Unit cur, nxt; int ui = 0;
    if (!S.next(0, cur)) return;
    f32x4 acc[2][2][4][2];
#pragma unroll
    for (int a = 0; a < 2; ++a)
#pragma unroll
        for (int b = 0; b < 2; ++b)
#pragma unroll
            for (int m = 0; m < 4; ++m)
#pragma unroll
                for (int n = 0; n < 2; ++n) acc[a][b][m][n] = (f32x4){0.f, 0.f, 0.f, 0.f};
    bf16x8 At[4][2], B0[2][2], B1[2][2];
    const char* cA = (const char*)g.A + (size_t)cur.pm * tstep; const char* cB = (const char*)g.Bt + (size_t)cur.pn * tstep;
    S.a_ready(cur);
    PG8_STAGE(PG8_SB(0, 0), cB, voffB); PG8_STAGE(PG8_SA(0, 0), cA, voffA); PG8_STAGE(PG8_SB(0, 1), cB + hstep, voffB); PG8_STAGE(PG8_SA(0, 1), cA + hstep, voffA);
    if (wr == 1) PG8_BAR;
    PG8_WAIT_V(4); PG8_BAR;
    PG8_STAGE(PG8_SB(1, 0), cB + kstep, voffB); PG8_STAGE(PG8_SA(1, 0), cA + kstep, voffA); PG8_STAGE(PG8_SB(1, 1), cB + hstep + kstep, voffB);
    PG8_WAIT_V(6); PG8_BAR;
    PG8_STAMP();
    for (;;) {
        const bool has_next = S.next(ui + 1, nxt);
        const char* nA = has_next ? (const char*)g.A + (size_t)nxt.pm * tstep : cA; const char* nB = has_next ? (const char*)g.Bt + (size_t)nxt.pn * tstep : cB;
        for (int t = 0; t < nt; t += 2) {
            const bool last = (t == nt - 2);
            const char* a1 = cA + (size_t)(t + 1) * kstep;
            const char* a2 = last ? nA : cA + (size_t)(t + 2) * kstep; const char* b2 = last ? nB : cB + (size_t)(t + 2) * kstep;
            const char* a3 = a2 + kstep; const char* b3 = b2 + kstep;
            if (last && has_next) S.a_ready(nxt);
            PG8_LDB(B0, 0, 0); PG8_SCHED; PG8_LDA(At, 0, 0); PG8_STAGE(PG8_SA(1, 1), a1 + hstep, voffA);
            PG8_WAIT_L(8); PG8_BAR; PG8_WAIT_L(0); PG8_MMA(0, 0, At, B0); PG8_BAR; PG8_SCHED;
            PG8_LDB(B1, 0, 1); PG8_STAGE(PG8_SB(0, 0), b2, voffB);
            PG8_BAR; PG8_WAIT_L(0); PG8_MMA(0, 1, At, B1); PG8_BAR;
            PG8_LDA(At, 0, 1); PG8_STAGE(PG8_SA(0, 0), a2, voffA);
            PG8_BAR; PG8_WAIT_L(0); PG8_MMA(1, 0, At, B0); PG8_BAR; PG8_SCHED;
            PG8_STAGE(PG8_SB(0, 1), b2 + hstep, voffB);
            PG8_WAIT_V(6); PG8_BAR; PG8_MMA(1, 1, At, B1); PG8_BAR;
            PG8_LDB(B0, 1, 0); PG8_SCHED; PG8_LDA(At, 1, 0); PG8_STAGE(PG8_SA(0, 1), a2 + hstep, voffA);
            PG8_WAIT_L(8); PG8_BAR; PG8_WAIT_L(0); PG8_MMA(0, 0, At, B0); PG8_BAR; PG8_SCHED;
            PG8_LDB(B1, 1, 1); PG8_STAGE(PG8_SB(1, 0), b3, voffB);
            PG8_BAR; PG8_WAIT_L(0); PG8_MMA(0, 1, At, B1); PG8_BAR;
            PG8_LDA(At, 1, 1); PG8_STAGE(PG8_SA(1, 0), a3, voffA);
            PG8_BAR; PG8_WAIT_L(0); PG8_MMA(1, 0, At, B0); PG8_BAR; PG8_SCHED;
            PG8_STAGE(PG8_SB(1, 1), b3 + hstep, voffB);
            PG8_WAIT_V(6); PG8_BAR; PG8_MMA(1, 1, At, B1); PG8_BAR;
        }
        PG8_STAMP();
        if constexpr (!Epi::AFTER_DRAIN) { E(acc, cur, wr, wc, fr, fq); S.done(cur); }
        PG8_STAMP();
        if (!has_next) break;
#pragma unroll
        for (int a = 0; a < 2; ++a)
#pragma unroll
            for (int b = 0; b < 2; ++b)
#pragma unroll
                for (int m = 0; m < 4; ++m)
#pragma unroll
                    for (int n = 0; n < 2; ++n) acc[a][b][m][n] = (f32x4){0.f, 0.f, 0.f, 0.f};
        cur = nxt; cA = nA; cB = nB; ++ui;
    }
    PG8_WAIT_V(0);
    if (wr == 0) PG8_BAR;
    PG8_BAR;
    if constexpr (Epi::AFTER_DRAIN) { E.fused(acc, cur, wr, wc, fr, fq, lds, wid, lane); S.done(cur); }
    PG8_STAMP();
    if (STAMP && wid == 0) { stamps[lane] = lane < nts ? (((unsigned long long)(unsigned)ts_hi << 32) | (unsigned)ts_lo) : 0ull;
        if (lane == 62) stamps[62] = rt_entry; if (lane == 63) stamps[63] = (unsigned long long)wall_clock64(); }
#undef PG8_STAMP
#undef PG8_SA
#undef PG8_SB
#undef PG8_STAGE
#undef PG8_LDA
#undef PG8_LDB
#undef PG8_MMA
#undef PG8_WAIT_V
#undef PG8_WAIT_L
#undef PG8_BAR
#undef PG8_SCHED
}
}

#define LAS __attribute__((address_space(3)))
#define XB_TMO      128
#define XB_XCNT(j)  (256  + 64 * (j))
#define XB_XSUB(j)  (1280 + 64 * (j))
#define XB_XGEN(j)  (2304 + 64 * (j))
#define XB_TOP      3328
#define XB_TOPGEN   3392
#define XCD_BAR_WORDS 3456
#define XB_SPIN_CAP (1u << 24)

__device__ __forceinline__ unsigned xb_ld(unsigned* p)              { return __hip_atomic_load(p, __ATOMIC_RELAXED, __HIP_MEMORY_SCOPE_AGENT); }
__device__ __forceinline__ unsigned xb_add(unsigned* p, unsigned v) { return __hip_atomic_fetch_add(p, v, __ATOMIC_RELAXED, __HIP_MEMORY_SCOPE_AGENT); }
__device__ __forceinline__ unsigned xb_xcc_id() { return (unsigned)__builtin_amdgcn_s_getreg((3 << 11) | 20) & 0xFu; }
#define XB_SPIN(cond, bar) do { unsigned _sp = 0; while (cond) { __builtin_amdgcn_s_sleep(1); \
    if ((++_sp & 255u) == 0u) { if (xb_ld(&(bar)[XB_TMO])) break; if (_sp > XB_SPIN_CAP) { atomicAdd(&(bar)[XB_TMO], 1u); break; } } } } while (0)

struct XcdBarrier { unsigned* bar; unsigned x; volatile LAS unsigned* st; };

__device__ __forceinline__ XcdBarrier xcd_barrier_post(unsigned* bar, volatile LAS unsigned* st) {
    XcdBarrier b; b.bar = bar; b.x = xb_xcc_id(); b.st = st;
    if (threadIdx.x == 0) (void)xb_add(&bar[XB_XCNT(b.x)], 1u);
    return b;
}
__device__ __forceinline__ void xcd_barrier_complete(unsigned* bar, unsigned x, unsigned& nloc, unsigned& nx) {
    const unsigned G = gridDim.x * gridDim.y * gridDim.z;
    unsigned sum, cnt, mine, sp = 0u;
    for (;;) {
        sum = 0u; cnt = 0u; mine = 0u;
#pragma unroll
        for (unsigned j = 0; j < 16; ++j) { const unsigned c = xb_ld(&bar[XB_XCNT(j)]); sum += c; cnt += (c > 0u) ? 1u : 0u; mine = (j == x) ? c : mine; }
        if (sum == G) break;
        __builtin_amdgcn_s_sleep(1);
        if ((++sp & 255u) == 0u) { if (xb_ld(&bar[XB_TMO])) break; if (sp > XB_SPIN_CAP) { atomicAdd(&bar[XB_TMO], 1u); break; } }
    }
    nloc = mine > 0u ? mine : 1u; nx = cnt > 0u ? cnt : 1u;
}
__device__ __forceinline__ void xcd_barrier(const XcdBarrier& b) {
    asm volatile("s_waitcnt vmcnt(0)" ::: "memory");
    __syncthreads();
    if (threadIdx.x == 0) {
        unsigned* bar = b.bar;
        __builtin_amdgcn_s_waitcnt(0);
        unsigned nloc = b.st[0], nx = b.st[1];
        if (nloc == 0u) { xcd_barrier_complete(bar, b.x, nloc, nx); b.st[0] = nloc; b.st[1] = nx; }
        const unsigned old = xb_add(&bar[XB_XSUB(b.x)], 1u);
        const unsigned gen = old / nloc;
        if (old + 1u == (gen + 1u) * nloc) {
            __builtin_amdgcn_fence(__ATOMIC_RELEASE, "agent");
            asm volatile("s_waitcnt vmcnt(0)" ::: "memory");
            const unsigned og = xb_add(&bar[XB_TOP], 1u);
            const unsigned tg = og / nx;
            if (og + 1u == (tg + 1u) * nx) xb_add(&bar[XB_TOPGEN], 1u);
            else XB_SPIN(xb_ld(&bar[XB_TOPGEN]) == tg, bar);
            __builtin_amdgcn_fence(__ATOMIC_ACQUIRE, "agent");
            xb_add(&bar[XB_XGEN(b.x)], 1u);
            asm volatile("s_waitcnt vmcnt(0)" ::: "memory");
        } else {
            XB_SPIN(xb_ld(&bar[XB_XGEN(b.x)]) == gen, bar);
            __builtin_amdgcn_fence(__ATOMIC_ACQUIRE, "agent");
            asm volatile("s_waitcnt vmcnt(0)" ::: "memory");
        }
    }
    __syncthreads();
}

typedef unsigned short bf16;
typedef float f32x4 __attribute__((ext_vector_type(4)));
typedef float f32x16 __attribute__((ext_vector_type(16)));
typedef float f32x2 __attribute__((ext_vector_type(2)));
typedef unsigned u32x4 __attribute__((ext_vector_type(4)));
typedef unsigned u32x2 __attribute__((ext_vector_type(2)));
typedef short bf16x8 __attribute__((ext_vector_type(8)));
typedef __bf16 bf2_t __attribute__((ext_vector_type(2)));

constexpr int NTHREADS = 512, NWAVES = 8;
constexpr int LDS_BYTES = 160 * 1024;
constexpr int MISC_OFF = LDS_BYTES - 256;
constexpr int TOK = 32768, SEQ = 16384, DM = 2048;
constexpr int EV_N = 4800, EV_NP = 4864, OD_N = 4176, OD_NP = 4352;
constexpr float ALPHA = 1.41421356237f;
constexpr size_t MiB = 1u << 20;
constexpr size_t WS_CTL = 0, CTL_ZERO_BYTES = 1 * MiB;
constexpr int CW_BAR = 4096, CW_XRANK = 8192;
constexpr size_t WS_MOD = 1 * MiB, WS_SKB = 2 * MiB, WS_WL = 4 * MiB, WS_BS = 7 * MiB, WS_CNT = 9 * MiB;
constexpr size_t WS_WINE = 10 * MiB, WS_WOUTE = 29 * MiB, WS_WINO = 37 * MiB, WS_WOUTO = 54 * MiB, WS_WQ0 = 62 * MiB, WS_WQ1 = 70 * MiB;
constexpr size_t WS_HY = 78 * MiB, WS_Z = 206 * MiB, WS_LA = 510 * MiB, WS_BIG = 542 * MiB, WS_END = 1022 * MiB;

__device__ __forceinline__ float bf2f(unsigned short b) { return __uint_as_float(((unsigned)b) << 16); }
__device__ __forceinline__ unsigned pk2(float lo, float hi) { const bf2_t v = {(__bf16)lo, (__bf16)hi}; return __builtin_bit_cast(unsigned, v); }
__device__ __forceinline__ unsigned f2bf(float f) { return pk2(f, 0.f) & 0xffffu; }
__device__ __forceinline__ float lo2f(unsigned w) { return __uint_as_float(w << 16); }
__device__ __forceinline__ float hi2f(unsigned w) { return __uint_as_float(w & 0xffff0000u); }
template <int CTRL, int RM> __device__ __forceinline__ float dppo(float v) { return __int_as_float(__builtin_amdgcn_update_dpp(__float_as_int(v), __float_as_int(v), CTRL, RM, 0xF, false)); }
__device__ __forceinline__ float wsum(float v) {
    v += __int_as_float(__builtin_amdgcn_update_dpp(0, __float_as_int(v), 0xB1, 0xF, 0xF, false)); v += __int_as_float(__builtin_amdgcn_update_dpp(0, __float_as_int(v), 0x4E, 0xF, 0xF, false));
    v += __int_as_float(__builtin_amdgcn_update_dpp(0, __float_as_int(v), 0x141, 0xF, 0xF, false)); v += __int_as_float(__builtin_amdgcn_update_dpp(0, __float_as_int(v), 0x140, 0xF, 0xF, false));
    v += __int_as_float(__builtin_amdgcn_update_dpp(0, __float_as_int(v), 0x142, 0xA, 0xF, false)); v += __int_as_float(__builtin_amdgcn_update_dpp(0, __float_as_int(v), 0x143, 0xC, 0xF, false));
    return __int_as_float(__builtin_amdgcn_readlane(__float_as_int(v), 63));
}
__device__ __forceinline__ float wmax(float v) {
    v = fmaxf(v, dppo<0xB1, 0xF>(v)); v = fmaxf(v, dppo<0x4E, 0xF>(v)); v = fmaxf(v, dppo<0x141, 0xF>(v)); v = fmaxf(v, dppo<0x140, 0xF>(v));
    v = fmaxf(v, dppo<0x142, 0xA>(v)); v = fmaxf(v, dppo<0x143, 0xC>(v));
    return __int_as_float(__builtin_amdgcn_readlane(__float_as_int(v), 63));
}
__device__ __forceinline__ float xsum32(float x) { const auto r = __builtin_amdgcn_permlane32_swap(__float_as_uint(x), __float_as_uint(x), false, false); return __uint_as_float(r[0]) + __uint_as_float(r[1]); }
__device__ __forceinline__ float xsum16(float x) { const auto r = __builtin_amdgcn_permlane16_swap(__float_as_uint(x), __float_as_uint(x), false, false); return __uint_as_float(r[0]) + __uint_as_float(r[1]); }
__device__ __forceinline__ float xmax32(float x) { const auto r = __builtin_amdgcn_permlane32_swap(__float_as_uint(x), __float_as_uint(x), false, false); return fmaxf(__uint_as_float(r[0]), __uint_as_float(r[1])); }
__device__ __forceinline__ float xmax16(float x) { const auto r = __builtin_amdgcn_permlane16_swap(__float_as_uint(x), __float_as_uint(x), false, false); return fmaxf(__uint_as_float(r[0]), __uint_as_float(r[1])); }
__device__ __forceinline__ float rsum4(float v0, float v1, float v2, float v3) {
    const auto p = __builtin_amdgcn_permlane32_swap(__float_as_uint(v0), __float_as_uint(v2), false, false);
    const auto q = __builtin_amdgcn_permlane32_swap(__float_as_uint(v1), __float_as_uint(v3), false, false);
    const float P = __uint_as_float(p[0]) + __uint_as_float(p[1]);
    const float Q = __uint_as_float(q[0]) + __uint_as_float(q[1]);
    const auto t = __builtin_amdgcn_permlane16_swap(__float_as_uint(P), __float_as_uint(Q), false, false);
    return __uint_as_float(t[0]) + __uint_as_float(t[1]);
}
__device__ __forceinline__ float rdlane(float v, int l) { return __int_as_float(__builtin_amdgcn_readlane(__float_as_int(v), l)); }
__device__ __forceinline__ unsigned rdlaneu(unsigned v, int l) { return (unsigned)__builtin_amdgcn_readlane((int)v, l); }
__device__ __forceinline__ float dot2bf(unsigned a, unsigned b, float c) {
    return __builtin_amdgcn_fdot2_f32_bf16(__builtin_bit_cast(bf2_t, a), __builtin_bit_cast(bf2_t, b), c, false);
}
template <int CTRL, int RM> __device__ __forceinline__ float dppf(float v) {
    return __int_as_float(__builtin_amdgcn_update_dpp(0, __float_as_int(v), CTRL, RM, 0xF, false));
}
__device__ __forceinline__ float wsum_dpp(float v) {
    v += dppf<0xB1, 0xF>(v);
    v += dppf<0x4E, 0xF>(v);
    v += dppf<0x141, 0xF>(v);
    v += dppf<0x140, 0xF>(v);
    v += dppf<0x142, 0xA>(v);
    v += dppf<0x143, 0xC>(v);
    return rdlane(v, 63);
}
__device__ __forceinline__ float sum16_dpp(float v) {
    v += dppf<0xB1, 0xF>(v); v += dppf<0x4E, 0xF>(v); v += dppf<0x141, 0xF>(v); v += dppf<0x140, 0xF>(v);
    return v;
}
__device__ __forceinline__ float sigmoidf_(float x) { return 1.0f / (1.0f + expf(-x)); }
__device__ __forceinline__ unsigned ordkey(float f) { const unsigned u = __float_as_uint(f); return (u & 0x80000000u) ? ~u : (u | 0x80000000u); }
__device__ __forceinline__ unsigned fixkey20(float f) { const float c = fminf(fmaxf(f, -15.999f), 15.999f); return (unsigned)((int)rintf(c * 32768.0f) + (1 << 19)); }
__device__ __forceinline__ float unordkey(unsigned k) { return __uint_as_float((k & 0x80000000u) ? (k & 0x7fffffffu) : ~k); }

struct Args { const void* in[27]; float* out; unsigned char* ws; int ph_lo, ph_hi; };
struct Frame { LAS unsigned char* lds; int tid, lane, wave, bx, G, gw, ngw; };

struct EpiLora {
    static constexpr bool PERM = true, AFTER_DRAIN = false;
    pg8::bf16_t* O; int ldc; const float* w0; const float* a0;
    __device__ __forceinline__ void operator()(const pg8::f32x4 (&acc)[2][2][4][2], const pg8::Unit& u, int wr, int wc, int fr, int fq) const {
        const int row0 = u.pm * 256 + wr * 64 + fr; const int colt = u.pn * 256; const int type = u.pn >> 2;
        const int col0 = colt + wc * 32 + 8 * fq, ncol0 = col0 & 1023;
        const float* pv = (type == 0) ? w0 : a0;
        pg8::f32x4 bv[2][2];
#pragma unroll
        for (int bj = 0; bj < 2; ++bj)
#pragma unroll
            for (int n = 0; n < 2; ++n) bv[bj][n] = (type < 2) ? *(const pg8::f32x4*)(pv + ncol0 + bj * 128 + 4 * n) : (pg8::f32x4){0.f, 0.f, 0.f, 0.f};
#pragma unroll
        for (int ai = 0; ai < 2; ++ai)
#pragma unroll
            for (int m = 0; m < 4; ++m) { pg8::bf16_t* rowp = O + (size_t)(row0 + ai * 128 + m * 16) * ldc + col0;
#pragma unroll
                for (int bj = 0; bj < 2; ++bj) { pg8::f32x4 v0 = acc[ai][bj][m][0] + bv[bj][0], v1 = acc[ai][bj][m][1] + bv[bj][1];
                    if (type < 2) {
                        const float sc = (type == 0) ? 0.60653066f : 1.0f;
#pragma unroll
                        for (int j = 0; j < 4; ++j) { v0[j] = sc / (1.0f + __expf(-v0[j])); v1[j] = sc / (1.0f + __expf(-v1[j])); }
                    }
                    pg8::u32x4 w; w.x = pg8::cvt_pk_bf16(v0[0], v0[1]); w.y = pg8::cvt_pk_bf16(v0[2], v0[3]); w.z = pg8::cvt_pk_bf16(v1[0], v1[1]); w.w = pg8::cvt_pk_bf16(v1[2], v1[3]);
                    *(pg8::u32x4*)(rowp + bj * 128) = w; } }
    }
};

__device__ __forceinline__ void transpose_item(const float* W, int K, int N, int Npad, bf16* WT, LAS float* scr, int item, int lane) {
    const int nblk = Npad / 32, kb = item / nblk, nb = item % nblk, k0 = 64 * kb, n0 = 32 * nb;
    const int nl = lane & 31; const bool ok = (n0 + nl) < N;
#pragma unroll 8
    for (int i = 0; i < 32; ++i) { const int kk = 2 * i + (lane >> 5); scr[kk * 33 + nl] = ok ? W[(size_t)(k0 + kk) * N + n0 + nl] : 0.f; }
    asm volatile("s_waitcnt lgkmcnt(0)" ::: "memory");
    const int c = lane & 7;
#pragma unroll
    for (int j = 0; j < 4; ++j) { const int n = (lane >> 3) + 8 * j; const LAS float* s = scr + (8 * c) * 33 + n;
        u32x4 o; o.x = pk2(s[0 * 33], s[1 * 33]); o.y = pk2(s[2 * 33], s[3 * 33]); o.z = pk2(s[4 * 33], s[5 * 33]); o.w = pk2(s[6 * 33], s[7 * 33]);
        *(u32x4*)(WT + (size_t)(n0 + n) * K + k0 + 8 * c) = o; }
    asm volatile("s_waitcnt lgkmcnt(0)" ::: "memory");
}

__device__ __forceinline__ void ph_prologue(const Args& A, Frame& F) {
    unsigned char* ws = A.ws;
    {
        const float* c = (const float*)A.in[1]; const float* mw = (const float*)A.in[19]; const float* mb = (const float*)A.in[20];
        float* MOD = (float*)(ws + WS_MOD);
        LAS float* red = (LAS float*)F.lds;
        for (int it = F.bx; it < 96; it += F.G) {
            const int s = it / 24, cc = it % 24, col = cc * 256 + F.lane * 4;
            const float* W = mw + (size_t)s * 2048 * 6144 + col;
            f32x4 a0 = {0.f, 0.f, 0.f, 0.f}, a1 = {0.f, 0.f, 0.f, 0.f};
            const int k0 = F.wave * 256;
#pragma unroll 8
            for (int k = k0; k < k0 + 256; ++k) {
                float c0 = c[k], c1 = c[2048 + k];
                c0 = c0 / (1.0f + expf(-c0)); c1 = c1 / (1.0f + expf(-c1));
                const f32x4 w = *(const f32x4*)(W + (size_t)k * 6144);
                a0 += c0 * w; a1 += c1 * w;
            }
            *(LAS f32x4*)(red + ((F.wave * 2 + 0) * 256 + F.lane * 4)) = a0;
            *(LAS f32x4*)(red + ((F.wave * 2 + 1) * 256 + F.lane * 4)) = a1;
            __syncthreads();
            { const int b = F.tid >> 8, cl = F.tid & 255; float sm = 0.f;
#pragma unroll
              for (int w = 0; w < 8; ++w) sm += red[(w * 2 + b) * 256 + cl];
              MOD[(size_t)(s * 2 + b) * 6144 + cc * 256 + cl] = sm + mb[s * 6144 + cc * 256 + cl]; }
            __syncthreads();
        }
    }
    {
        LAS float* scr = (LAS float*)(F.lds + 16384 + F.wave * 8704);
        constexpr int I0 = 32 * (EV_NP / 32), I1 = 32 * 64, I2 = 32 * (OD_NP / 32);
        constexpr int NIT = I0 + I1 + I2 + 3 * I1;
        for (int it = F.gw; it < NIT; it += F.ngw) {
            int r = it;
            if (r < I0) { transpose_item((const float*)A.in[3], 2048, EV_N, EV_NP, (bf16*)(ws + WS_WINE), scr, r, F.lane); continue; } r -= I0;
            if (r < I1) { transpose_item((const float*)A.in[4], 2048, 2048, 2048, (bf16*)(ws + WS_WOUTE), scr, r, F.lane); continue; } r -= I1;
            if (r < I2) { transpose_item((const float*)A.in[17], 2048, OD_N, OD_NP, (bf16*)(ws + WS_WINO), scr, r, F.lane); continue; } r -= I2;
            if (r < I1) { transpose_item((const float*)A.in[18], 2048, 2048, 2048, (bf16*)(ws + WS_WOUTO), scr, r, F.lane); continue; } r -= I1;
            if (r < I1) { transpose_item((const float*)A.in[23], 2048, 2048, 2048, (bf16*)(ws + WS_WQ0), scr, r, F.lane); continue; } r -= I1;
            transpose_item((const float*)A.in[23] + (size_t)2048 * 2048, 2048, 2048, 2048, (bf16*)(ws + WS_WQ1), scr, r, F.lane);
        }
    }
    {
        const float* w2 = (const float*)A.in[8]; const float* a2 = (const float*)A.in[10]; const float* g2 = (const float*)A.in[11];
        bf16* WL = (bf16*)(ws + WS_WL);
        const int gt = F.bx * NTHREADS + F.tid, ngt = F.G * NTHREADS;
        for (int i = gt; i < 3072 * 512; i += ngt) {
            const int n = i >> 9, k = i & 511; float v = 0.f;
            if (n < 1024) { if (k < 96) v = w2[k * 1024 + n]; }
            else if (n < 2048) { if (k >= 96 && k < 192) v = a2[(k - 96) * 1024 + (n - 1024)]; }
            else { if (k >= 192 && k < 448) v = g2[(k - 192) * 1024 + (n - 2048)]; }
            WL[i] = (bf16)f2bf(v);
        }
        const float* sk = (const float*)A.in[24]; bf16* SKB = (bf16*)(ws + WS_SKB);
        for (int i = gt; i < 2 * 262144; i += ngt) SKB[i] = (bf16)f2bf(sk[i]);
    }
}

__device__ __forceinline__ void ph_mod_x(const Args& A, Frame& F) {
    const float* x = (const float*)A.in[0]; const float* MOD = (const float*)(A.ws + WS_MOD); bf16* H = (bf16*)(A.ws + WS_HY);
    for (int t = F.gw; t < TOK; t += F.ngw) {
        const int b = t >> 14; const float* sh = MOD + (size_t)(0 * 2 + b) * 6144; const float* sc = sh + 2048;
#pragma unroll
        for (int j = 0; j < 8; ++j) { const int idx = j * 256 + F.lane * 4;
            const f32x4 xv = *(const f32x4*)(x + (size_t)t * DM + idx), sv = *(const f32x4*)(sc + idx), hv = *(const f32x4*)(sh + idx);
            const f32x4 o = xv * (1.0f + sv) + hv; u32x2 w; w.x = pk2(o[0], o[1]); w.y = pk2(o[2], o[3]);
            *(u32x2*)(H + (size_t)t * DM + idx) = w; }
    }
}

__device__ __forceinline__ void ph_even_post(const Args& A, Frame& F) {
    bf16* Z = (bf16*)(A.ws + WS_Z); const int* positions = (const int*)A.in[2]; const float* mu = (const float*)A.in[6];
    bf16* RKV = (bf16*)A.out; bf16* LAp = (bf16*)(A.ws + WS_LA);
    const int i = F.lane & 31; const float inv = powf(10000.0f, -(float)i / 32.0f);
    const int i4 = F.lane & 7, hs = F.lane >> 3;
    for (int t = F.gw; t < TOK; t += F.ngw) {
        const int s = t & (SEQ - 1); bf16* zr = Z + (size_t)t * EV_NP;
        float sn, cs; sincosf((float)positions[t] * inv, &sn, &cs);
        float c4[4], s4[4];
#pragma unroll
        for (int e = 0; e < 4; ++e) { c4[e] = __shfl(cs, 4 * i4 + e); s4[e] = __shfl(sn, 4 * i4 + e); }
#pragma unroll
        for (int it = 0; it < 3; ++it) { const int hd = it * 8 + hs; if (hd < 18) { bf16* hp = zr + hd * 64 + 4 * i4;
            const u32x2 a = *(const u32x2*)hp, b = *(const u32x2*)(hp + 32);
            const float t1[4] = {lo2f(a.x), hi2f(a.x), lo2f(a.y), hi2f(a.y)}, t2[4] = {lo2f(b.x), hi2f(b.x), lo2f(b.y), hi2f(b.y)};
            float o1[4], o2[4];
#pragma unroll
            for (int e = 0; e < 4; ++e) { o1[e] = t1[e] * c4[e] - t2[e] * s4[e]; o2[e] = t2[e] * c4[e] + t1[e] * s4[e]; }
            *(u32x2*)hp = (u32x2){pk2(o1[0], o1[1]), pk2(o1[2], o1[3])}; *(u32x2*)(hp + 32) = (u32x2){pk2(o2[0], o2[1]), pk2(o2[2], o2[3])}; } }
        const bf16* zp = zr - EV_NP; const bool hasprev = s > 0;
#pragma unroll
        for (int m = 0; m < 7; ++m) { const int j = 8 * (F.lane + 64 * m); if (j < 3520) {
            const u32x4 cw = *(const u32x4*)(zr + 1280 + j); u32x4 pw = {0u, 0u, 0u, 0u}; if (hasprev) pw = *(const u32x4*)(zp + 1280 + j);
            const f32x4 m0 = *(const f32x4*)(mu + j), m1 = *(const f32x4*)(mu + j + 4);
            const unsigned cwa[4] = {cw.x, cw.y, cw.z, cw.w}, pwa[4] = {pw.x, pw.y, pw.z, pw.w}; const float mm[8] = {m0[0], m0[1], m0[2], m0[3], m1[0], m1[1], m1[2], m1[3]};
            float v[8];
#pragma unroll
            for (int q = 0; q < 4; ++q) { const float c0 = lo2f(cwa[q]), c1 = hi2f(cwa[q]), p0 = lo2f(pwa[q]), p1 = hi2f(pwa[q]); v[2 * q] = c0 + (p0 - c0) * mm[2 * q]; v[2 * q + 1] = c1 + (p1 - c1) * mm[2 * q + 1]; }
            bf16* dst;
            if (j < 3072) { dst = RKV + (size_t)(j >> 10) * TOK * 1024 + (size_t)t * 1024 + (j & 1023); }
            else if (j < 3168) { dst = LAp + (size_t)t * 512 + (j - 3072);
#pragma unroll
                for (int e = 0; e < 8; ++e) v[e] = tanhf(v[e]); }
            else if (j < 3264) { dst = LAp + (size_t)t * 512 + 96 + (j - 3168); }
            else { dst = LAp + (size_t)t * 512 + 192 + (j - 3264);
#pragma unroll
                for (int e = 0; e < 8; ++e) v[e] = sigmoidf_(v[e]); }
            *(u32x4*)dst = (u32x4){pk2(v[0], v[1]), pk2(v[2], v[3]), pk2(v[4], v[5]), pk2(v[6], v[7])};
        } }
        if (F.lane < 8) *(u32x4*)(LAp + (size_t)t * 512 + 448 + 8 * F.lane) = (u32x4){0u, 0u, 0u, 0u};
    }
}

__device__ __forceinline__ void ph_scan_pack(const Args& A, Frame& F) {
    const bf16* Z = (const bf16*)(A.ws + WS_Z); const bf16* RKV = (const bf16*)A.out;
    const float* k_k = (const float*)A.in[12]; const float* k_a = (const float*)A.in[13]; const float* r_k = (const float*)A.in[14];
    unsigned* PK = (unsigned*)(A.ws + WS_BIG); float* BS = (float*)(A.ws + WS_BS);
    const int g16 = F.lane >> 4, c16 = F.lane & 15;
    for (int it = F.gw; it < TOK * 4; it += F.ngw) {
        const int item = it * 4 + g16; const int t = item >> 4, h = item & 15, c = h * 64 + 4 * c16, b = t >> 14, s = t & (SEQ - 1);
        const u32x2 rw = *(const u32x2*)(RKV + (size_t)t * 1024 + c), kw = *(const u32x2*)(RKV + (size_t)TOK * 1024 + (size_t)t * 1024 + c), vw = *(const u32x2*)(RKV + (size_t)2 * TOK * 1024 + (size_t)t * 1024 + c);
        const u32x2 ew = *(const u32x2*)(Z + (size_t)t * EV_NP + 1280 + c), aw = *(const u32x2*)(Z + (size_t)t * EV_NP + 1280 + 1024 + c);
        const f32x4 kk4 = *(const f32x4*)(k_k + c), ka4 = *(const f32x4*)(k_a + c), rk4 = *(const f32x4*)(r_k + c);
        const float r[4] = {lo2f(rw.x), hi2f(rw.x), lo2f(rw.y), hi2f(rw.y)}, kr[4] = {lo2f(kw.x), hi2f(kw.x), lo2f(kw.y), hi2f(kw.y)}, v[4] = {lo2f(vw.x), hi2f(vw.x), lo2f(vw.y), hi2f(vw.y)};
        const float e[4] = {lo2f(ew.x), hi2f(ew.x), lo2f(ew.y), hi2f(ew.y)}, a[4] = {lo2f(aw.x), hi2f(aw.x), lo2f(aw.y), hi2f(aw.y)};
        float kkv[4], kp[4]; float ss = 0.f, bsum = 0.f;
#pragma unroll
        for (int q = 0; q < 4; ++q) { kkv[q] = kr[q] * kk4[q]; ss += kkv[q] * kkv[q]; kp[q] = kr[q] * (1.0f + (a[q] - 1.0f) * ka4[q]); bsum += r[q] * kp[q] * rk4[q]; }
        ss = sum16_dpp(ss); bsum = sum16_dpp(bsum);
        const float rn = 1.0f / fmaxf(sqrtf(ss), 1e-12f);
        if (c16 == 0) BS[(size_t)t * 16 + h] = bsum;
        unsigned w[12];
#pragma unroll
        for (int q = 0; q < 4; ++q) { const float kkn = kkv[q] * rn; w[3 * q] = pk2(r[q], e[q]); w[3 * q + 1] = pk2(kp[q], kkn); w[3 * q + 2] = pk2(kkn * a[q], v[q]); }
        u32x4* dst = (u32x4*)(PK + ((size_t)((b * 16 + h) * SEQ + s) * 64 + 4 * c16) * 3);
        dst[0] = (u32x4){w[0], w[1], w[2], w[3]}; dst[1] = (u32x4){w[4], w[5], w[6], w[7]}; dst[2] = (u32x4){w[8], w[9], w[10], w[11]};
    }
}

__device__ __forceinline__ void ph_swa(const Args& A, Frame& F) {
    const bf16* Z = (const bf16*)(A.ws + WS_Z); bf16* Y = (bf16*)(A.ws + WS_HY); const float* sinks = (const float*)A.in[5];
    LAS unsigned char* KL = F.lds; LAS unsigned char* VL = F.lds + 256 * 136;
    for (int u = F.bx; u < 512; u += F.G) {
        const int b = u >> 8, n = (u >> 1) & 127, kvh = u & 1;
        __syncthreads();
        for (int c = F.tid; c < 2048; c += NTHREADS) { const int jw = c >> 3, cc = c & 7; const int s = n * 128 - 128 + jw;
            u32x4 kv = {0u, 0u, 0u, 0u}, vv = {0u, 0u, 0u, 0u};
            if (s >= 0) { const bf16* row = Z + (size_t)(b * SEQ + s) * EV_NP; kv = *(const u32x4*)(row + 1024 + kvh * 64 + cc * 8); vv = *(const u32x4*)(row + 1152 + kvh * 64 + cc * 8); }
            *(LAS u32x2*)(KL + jw * 136 + cc * 16) = (u32x2){kv.x, kv.y}; *(LAS u32x2*)(KL + jw * 136 + cc * 16 + 8) = (u32x2){kv.z, kv.w};
            *(LAS u32x2*)(VL + jw * 136 + cc * 16) = (u32x2){vv.x, vv.y}; *(LAS u32x2*)(VL + jw * 136 + cc * 16 + 8) = (u32x2){vv.z, vv.w}; }
        __syncthreads();
        for (int it = F.wave; it < 1024; it += NWAVES) {
            const int i = it >> 3, g = it & 7, head = kvh * 8 + g; const int t = b * SEQ + n * 128 + i;
            const float qv = bf2f(Z[(size_t)t * EV_NP + head * 64 + F.lane]) * 0.125f;
            const int jw0 = i + 1 + F.lane, jw1 = jw0 + 64;
            const bool val0 = (n > 0) || (jw0 >= 128), val1 = (n > 0) || (jw1 >= 128);
            float s0 = 0.f, s1 = 0.f;
#pragma unroll
            for (int d4 = 0; d4 < 16; ++d4) {
                const u32x2 k0 = *(const LAS u32x2*)(KL + jw0 * 136 + d4 * 8), k1 = *(const LAS u32x2*)(KL + jw1 * 136 + d4 * 8);
                const float q0 = rdlane(qv, 4 * d4), q1 = rdlane(qv, 4 * d4 + 1), q2 = rdlane(qv, 4 * d4 + 2), q3 = rdlane(qv, 4 * d4 + 3);
                s0 += q0 * lo2f(k0.x) + q1 * hi2f(k0.x) + q2 * lo2f(k0.y) + q3 * hi2f(k0.y);
                s1 += q0 * lo2f(k1.x) + q1 * hi2f(k1.x) + q2 * lo2f(k1.y) + q3 * hi2f(k1.y);
            }
            const float sink = sinks[head];
            s0 = val0 ? s0 : -INFINITY; s1 = val1 ? s1 : -INFINITY;
            const float mx = fmaxf(wmax(fmaxf(s0, s1)), sink);
            float p0 = val0 ? expf(s0 - mx) : 0.f, p1 = val1 ? expf(s1 - mx) : 0.f;
            const float den = wsum(p0 + p1) + expf(sink - mx); const float rden = 1.0f / den;
            p0 *= rden; p1 *= rden;
            float o = 0.f;
            const LAS bf16* vcol = (const LAS bf16*)VL + F.lane;
#pragma unroll 8
            for (int jj = 0; jj < 64; ++jj) o += rdlane(p0, jj) * bf2f(vcol[(i + 1 + jj) * 68]);
#pragma unroll 8
            for (int jj = 0; jj < 64; ++jj) o += rdlane(p1, jj) * bf2f(vcol[(i + 65 + jj) * 68]);
            Y[(size_t)t * DM + head * 64 + F.lane] = (bf16)f2bf(o);
        }
    }
}

__device__ __forceinline__ bf16x8 as_bf8(u32x4 v) { return __builtin_bit_cast(bf16x8, v); }
__device__ __forceinline__ void ph_swa_mfma(const Args& A, Frame& F) {
    const bf16* Z = (const bf16*)(A.ws + WS_Z); bf16* Y = (bf16*)(A.ws + WS_HY); const float* sinks = (const float*)A.in[5];
    LAS bf16* KL = (LAS bf16*)F.lds;
    LAS bf16* VT = (LAS bf16*)(F.lds + 36864);
    const int l15 = F.lane & 15, g4 = F.lane >> 4;
    for (int u = F.bx; u < 512; u += F.G) {
        const int b = u >> 8, n = (u >> 1) & 127, kvh = u & 1;
        __syncthreads();
        for (int c = F.tid; c < 2048; c += NTHREADS) { const int jw = c >> 3, cc = c & 7; const int sp = n * 128 - 128 + jw;
            u32x4 kv = {0u, 0u, 0u, 0u}, vv = {0u, 0u, 0u, 0u};
            if (sp >= 0) { const bf16* row = Z + (size_t)(b * SEQ + sp) * EV_NP; kv = *(const u32x4*)(row + 1024 + kvh * 64 + cc * 8); vv = *(const u32x4*)(row + 1152 + kvh * 64 + cc * 8); }
            *(LAS u32x4*)(KL + jw * 72 + cc * 8) = kv;
            const unsigned vw[4] = {vv.x, vv.y, vv.z, vv.w};
#pragma unroll
            for (int q = 0; q < 4; ++q) { VT[(8 * cc + 2 * q) * 264 + jw] = (bf16)(vw[q] & 0xffffu); VT[(8 * cc + 2 * q + 1) * 264 + jw] = (bf16)(vw[q] >> 16); } }
        __syncthreads();
        const int head = kvh * 8 + F.wave; const float sink = sinks[head];
        bf16x8 nqf[2];
#pragma unroll
        for (int ks = 0; ks < 2; ++ks) nqf[ks] = *(const bf16x8*)(Z + (size_t)(b * SEQ + n * 128 + l15) * EV_NP + head * 64 + 32 * ks + 8 * g4);
#pragma unroll 1
        for (int qt = 0; qt < 8; ++qt) {
            const int iq = 16 * qt + l15; const int t = b * SEQ + n * 128 + iq;
            bf16x8 qf[2];
#pragma unroll
            for (int ks = 0; ks < 2; ++ks) qf[ks] = nqf[ks];
            if (qt < 7) {
#pragma unroll
                for (int ks = 0; ks < 2; ++ks) nqf[ks] = *(const bf16x8*)(Z + (size_t)(t + 16) * EV_NP + head * 64 + 32 * ks + 8 * g4); }
            float sv[10][4]; float mx = -INFINITY;
#pragma unroll
            for (int kk = 0; kk < 9; ++kk) { const int kt = qt + kk;
                f32x4 acc = {0.f, 0.f, 0.f, 0.f};
#pragma unroll
                for (int ks = 0; ks < 2; ++ks) acc = __builtin_amdgcn_mfma_f32_16x16x32_bf16(*(const LAS bf16x8*)(KL + (16 * kt + l15) * 72 + 32 * ks + 8 * g4), qf[ks], acc, 0, 0, 0);
#pragma unroll
                for (int rg_ = 0; rg_ < 4; ++rg_) { const int jw = 16 * kt + 4 * g4 + rg_; const bool ok = (jw >= iq + 1) && (jw <= iq + 128) && ((n > 0) || (jw >= 128));
                    sv[kk][rg_] = ok ? acc[rg_] * 0.125f : -INFINITY; mx = fmaxf(mx, sv[kk][rg_]); } }
#pragma unroll
            for (int rg_ = 0; rg_ < 4; ++rg_) sv[9][rg_] = -INFINITY;
            mx = xmax16(mx); mx = xmax32(mx); mx = fmaxf(mx, sink);
            float sm = 0.f;
#pragma unroll
            for (int kk = 0; kk < 10; ++kk)
#pragma unroll
                for (int rg_ = 0; rg_ < 4; ++rg_) { const float pv = (sv[kk][rg_] == -INFINITY) ? 0.f : __expf(sv[kk][rg_] - mx); sv[kk][rg_] = pv; sm += pv; }
            sm = xsum16(sm); sm = xsum32(sm);
            const float rden = 1.0f / (sm + __expf(sink - mx));
            f32x4 oacc[4];
#pragma unroll
            for (int dt = 0; dt < 4; ++dt) oacc[dt] = (f32x4){0.f, 0.f, 0.f, 0.f};
#pragma unroll
            for (int pp = 0; pp < 5; ++pp) { const int ka = qt + 2 * pp, kb = (qt + 2 * pp + 1 < 16) ? (qt + 2 * pp + 1) : 15;
                const bf16x8 pb = as_bf8((u32x4){pk2(sv[2 * pp][0] * rden, sv[2 * pp][1] * rden), pk2(sv[2 * pp][2] * rden, sv[2 * pp][3] * rden),
                                                  pk2(sv[2 * pp + 1][0] * rden, sv[2 * pp + 1][1] * rden), pk2(sv[2 * pp + 1][2] * rden, sv[2 * pp + 1][3] * rden)});
#pragma unroll
                for (int dt = 0; dt < 4; ++dt) { const LAS bf16* vr = VT + (16 * dt + l15) * 264 + 4 * g4;
                    const u32x2 va = *(const LAS u32x2*)(vr + 16 * ka), vb2 = *(const LAS u32x2*)(vr + 16 * kb);
                    oacc[dt] = __builtin_amdgcn_mfma_f32_16x16x32_bf16(as_bf8((u32x4){va.x, va.y, vb2.x, vb2.y}), pb, oacc[dt], 0, 0, 0); } }
#pragma unroll
            for (int dt = 0; dt < 4; ++dt) *(u32x2*)(Y + (size_t)t * DM + head * 64 + 16 * dt + 4 * g4) = (u32x2){pk2(oacc[dt][0], oacc[dt][1]), pk2(oacc[dt][2], oacc[dt][3])};
        }
    }
}

constexpr int FR_BYTES = 15360;
__device__ __forceinline__ int fr_rho(int ks, int g, int j) { return 16 * (2 * ks + (j >> 2)) + 4 * g + (j & 3); }
__device__ __forceinline__ void ph_scan_prep(const Args& A, Frame& F) {
    const bf16* Z = (const bf16*)(A.ws + WS_Z); const bf16* RKV = (const bf16*)A.out;
    const float* k_k = (const float*)A.in[12]; const float* k_a = (const float*)A.in[13]; const float* r_k = (const float*)A.in[14];
    unsigned char* FR = A.ws + WS_BIG; float* BS = (float*)(A.ws + WS_BS);
    LAS float* EE = (LAS float*)F.lds;
    LAS float* VV = (LAS float*)(F.lds + 4096);
    LAS float* KHf = (LAS float*)(F.lds + 8192);
    LAS float* RHf = (LAS float*)(F.lds + 12352);
    LAS float* BPf = (LAS float*)(F.lds + 16512);
    LAS bf16* AHb = (LAS bf16*)(F.lds + 20672);
    LAS bf16* BHb = (LAS bf16*)(F.lds + 22976);
    LAS bf16* KHb = (LAS bf16*)(F.lds + 25280);
    LAS bf16* RHb = (LAS bf16*)(F.lds + 27584);
    LAS bf16* APT = (LAS bf16*)(F.lds + 29888);
    LAS float* GA = (LAS float*)(F.lds + 32960);
    LAS float* GB = GA + 16 * 17; LAS float* GMA = GB + 16 * 17; LAS float* GMB = GMA + 16 * 17;
    LAS float* TT = (LAS float*)(F.lds + 37312);
    LAS bf16* P1b = (LAS bf16*)(F.lds + 38400);
    LAS bf16* P2b = (LAS bf16*)(F.lds + 41472);
    LAS bf16* MAT = (LAS bf16*)(F.lds + 42240);
    LAS float* WW = (LAS float*)(F.lds + 43008);
    const int tt = F.tid >> 5, kq = F.tid & 31;
    const int l15 = F.lane & 15, g = F.lane >> 4;
    const bf16x8 zero8 = {0, 0, 0, 0, 0, 0, 0, 0};
    unsigned p_rw = 0u, p_kw = 0u, p_vw = 0u, p_ew = 0u, p_aw = 0u; f32x2 p_kk = {0.f, 0.f}, p_ka = {0.f, 0.f}, p_rk = {0.f, 0.f};
#define PREP_LOAD(it_) do { const int bh_ = (it_) >> 10, ch_ = (it_) & 1023, b_ = bh_ >> 4, h_ = bh_ & 15; const int tok_ = b_ * SEQ + ch_ * 16 + tt, c_ = h_ * 64 + 2 * kq; \
        p_rw = *(const unsigned*)(RKV + (size_t)tok_ * 1024 + c_); p_kw = *(const unsigned*)(RKV + (size_t)TOK * 1024 + (size_t)tok_ * 1024 + c_); p_vw = *(const unsigned*)(RKV + (size_t)2 * TOK * 1024 + (size_t)tok_ * 1024 + c_); \
        p_ew = *(const unsigned*)(Z + (size_t)tok_ * EV_NP + 1280 + c_); p_aw = *(const unsigned*)(Z + (size_t)tok_ * EV_NP + 1280 + 1024 + c_); \
        p_kk = *(const f32x2*)(k_k + c_); p_ka = *(const f32x2*)(k_a + c_); p_rk = *(const f32x2*)(r_k + c_); } while (0)
    if (F.bx < 32 * 1024) PREP_LOAD(F.bx);
    for (int it = F.bx; it < 32 * 1024; it += F.G) {
        const int bh = it >> 10, ch = it & 1023, b = bh >> 4, h = bh & 15;
        const int tok = b * SEQ + ch * 16 + tt;
        __syncthreads();
        float e2[2], kkn[2], kka[2], kp[2], r2[2];
        {
            const unsigned rw = p_rw, kw = p_kw, vw = p_vw, ew = p_ew, aw = p_aw; const f32x2 kk2 = p_kk, ka2 = p_ka, rk2 = p_rk;
            const float kr[2] = {lo2f(kw), hi2f(kw)}, av[2] = {lo2f(aw), hi2f(aw)};
            r2[0] = lo2f(rw); r2[1] = hi2f(rw); e2[0] = lo2f(ew); e2[1] = hi2f(ew);
            float kkv[2], ss = 0.f, bsum = 0.f;
#pragma unroll
            for (int q = 0; q < 2; ++q) { kkv[q] = kr[q] * kk2[q]; ss += kkv[q] * kkv[q]; kp[q] = kr[q] * (1.0f + (av[q] - 1.0f) * ka2[q]); bsum += r2[q] * kp[q] * rk2[q]; }
            ss = xsum16(sum16_dpp(ss)); bsum = xsum16(sum16_dpp(bsum));
            const float rn = 1.0f / fmaxf(sqrtf(ss), 1e-12f);
#pragma unroll
            for (int q = 0; q < 2; ++q) { kkn[q] = kkv[q] * rn; kka[q] = kkn[q] * av[q]; }
            if (kq == 0) BS[(size_t)tok * 16 + h] = bsum;
            { const int itn = it + F.G; if (itn < 32 * 1024) PREP_LOAD(itn); }
            *(LAS f32x2*)(EE + tt * 64 + 2 * kq) = (f32x2){e2[0], e2[1]};
            *(LAS f32x2*)(VV + tt * 64 + 2 * kq) = (f32x2){lo2f(vw), hi2f(vw)};
        }
        __syncthreads();
        {
            float L[2] = {0.f, 0.f}, L15[2] = {0.f, 0.f};
#pragma unroll
            for (int i = 0; i < 16; ++i) { const f32x2 ev = *(const LAS f32x2*)(EE + i * 64 + 2 * kq); L15[0] += ev.x; L15[1] += ev.y; if (i <= tt) { L[0] += ev.x; L[1] += ev.y; } }
            float kh[2], ah[2], bhv[2], rh[2], ap[2], bp[2];
#pragma unroll
            for (int q = 0; q < 2; ++q) { const float wt = __expf(-L[q]), iwt = __expf(L[q]), wprev = __expf(-(L[q] - e2[q])), wrest = __expf(-(L15[q] - L[q]));
                kh[q] = kkn[q] * wprev; ah[q] = kka[q] * iwt; bhv[q] = kp[q] * iwt; rh[q] = r2[q] * wt; ap[q] = kka[q] * wrest; bp[q] = kp[q] * wrest;
                if (tt == 15) WW[2 * kq + q] = wt; }
            KHf[tt * 65 + 2 * kq] = kh[0]; KHf[tt * 65 + 2 * kq + 1] = kh[1]; RHf[tt * 65 + 2 * kq] = rh[0]; RHf[tt * 65 + 2 * kq + 1] = rh[1]; BPf[tt * 65 + 2 * kq] = bp[0]; BPf[tt * 65 + 2 * kq + 1] = bp[1];
            *(LAS unsigned*)(KHb + tt * 72 + 2 * kq) = pk2(kh[0], kh[1]); *(LAS unsigned*)(AHb + tt * 72 + 2 * kq) = pk2(ah[0], ah[1]);
            *(LAS unsigned*)(BHb + tt * 72 + 2 * kq) = pk2(bhv[0], bhv[1]); *(LAS unsigned*)(RHb + tt * 72 + 2 * kq) = pk2(rh[0], rh[1]);
            APT[(2 * kq) * 24 + tt] = (bf16)f2bf(ap[0]); APT[(2 * kq + 1) * 24 + tt] = (bf16)f2bf(ap[1]);
        }
        __syncthreads();
        if (F.wave < 4) {
            const int mat = F.wave; const LAS bf16* X = (mat & 1) ? BHb : AHb; const LAS bf16* Y = (mat & 2) ? RHb : KHb;
            f32x4 acc = {0.f, 0.f, 0.f, 0.f};
#pragma unroll
            for (int ks = 0; ks < 2; ++ks) acc = __builtin_amdgcn_mfma_f32_16x16x32_bf16(*(const LAS bf16x8*)(X + l15 * 72 + 32 * ks + 8 * g), *(const LAS bf16x8*)(Y + l15 * 72 + 32 * ks + 8 * g), acc, 0, 0, 0);
            LAS float* dst = (mat == 0) ? GA : ((mat == 1) ? GB : ((mat == 2) ? GMA : GMB));
#pragma unroll
            for (int rg_ = 0; rg_ < 4; ++rg_) { const int i = 4 * g + rg_; const bool nz = (mat & 2) ? (i <= l15) : (i < l15); const float v = nz ? acc[rg_] : 0.f;
                dst[i * 17 + l15] = v; if (mat == 2) MAT[l15 * 24 + i] = (bf16)f2bf(v); }
        }
        __syncthreads();
        if (F.tid < 16) {
            float x[16];
#pragma unroll
            for (int i = 15; i >= 0; --i) { float v = (i == F.tid) ? 1.0f : 0.f;
#pragma unroll
                for (int m = i + 1; m < 16; ++m) v -= GA[i * 17 + m] * x[m];
                x[i] = v; }
#pragma unroll
            for (int i = 0; i < 16; ++i) TT[i * 17 + F.tid] = x[i];
        }
        __syncthreads();
        {
            float x0 = 0.f, x1 = 0.f;
#pragma unroll
            for (int m = 0; m < 16; ++m) { const float tv = TT[m * 17 + tt]; x0 -= KHf[m * 65 + 2 * kq] * tv; x1 -= KHf[m * 65 + 2 * kq + 1] * tv; }
            P1b[(2 * kq) * 24 + tt] = (bf16)f2bf(x0); P1b[(2 * kq + 1) * 24 + tt] = (bf16)f2bf(x1);
            if (F.tid < 256) { const int i = F.tid >> 4, t = F.tid & 15; float x = 0.f;
#pragma unroll
                for (int m = 0; m < 16; ++m) x -= GB[i * 17 + m] * TT[m * 17 + t];
                P2b[i * 24 + t] = (bf16)f2bf(x); }
        }
        __syncthreads();
        {
            unsigned char* fr = FR + (size_t)it * FR_BYTES;
            const int mt = F.wave >> 1, ks = F.wave & 1;
            const bf16x8 aP0 = (g < 2) ? *(const LAS bf16x8*)(P1b + (16 * (2 * ks) + l15) * 24 + 8 * g) : zero8;
            const bf16x8 aP1 = (g < 2) ? *(const LAS bf16x8*)(P1b + (16 * (2 * ks + 1) + l15) * 24 + 8 * g) : zero8;
            const bf16x8 bAP = (g < 2) ? *(const LAS bf16x8*)(APT + (16 * mt + l15) * 24 + 8 * g) : zero8;
            const f32x4 z4 = {0.f, 0.f, 0.f, 0.f};
            const f32x4 d0 = __builtin_amdgcn_mfma_f32_16x16x32_bf16(aP0, bAP, z4, 0, 0, 0), d1 = __builtin_amdgcn_mfma_f32_16x16x32_bf16(aP1, bAP, z4, 0, 0, 0);
            *(u32x4*)(fr + (size_t)(F.wave * 64 + F.lane) * 16) = (u32x4){pk2(d0[0], d0[1]), pk2(d0[2], d0[3]), pk2(d1[0], d1[1]), pk2(d1[2], d1[3])};
            if (F.wave < 4) {
                const bf16x8 aP2 = (g < 2) ? *(const LAS bf16x8*)(P2b + l15 * 24 + 8 * g) : zero8;
                const bf16x8 bA = (g < 2) ? *(const LAS bf16x8*)(APT + (16 * F.wave + l15) * 24 + 8 * g) : zero8;
                f32x4 d = __builtin_amdgcn_mfma_f32_16x16x32_bf16(aP2, bA, z4, 0, 0, 0);
#pragma unroll
                for (int rg_ = 0; rg_ < 4; ++rg_) d[rg_] += BPf[(4 * g + rg_) * 65 + 16 * F.wave + l15];
                *(u32x2*)(fr + 8192 + (size_t)(F.wave * 64 + F.lane) * 8) = (u32x2){pk2(d[0], d[1]), pk2(d[2], d[3])};
            } else if (F.wave < 6) {
                const int ks2 = F.wave - 4;
                const bf16x8 a0 = (g < 2) ? *(const LAS bf16x8*)(P1b + (16 * (2 * ks2) + l15) * 24 + 8 * g) : zero8;
                const bf16x8 a1 = (g < 2) ? *(const LAS bf16x8*)(P1b + (16 * (2 * ks2 + 1) + l15) * 24 + 8 * g) : zero8;
                const bf16x8 bM = (g < 2) ? *(const LAS bf16x8*)(MAT + l15 * 24 + 8 * g) : zero8;
                f32x4 q0 = __builtin_amdgcn_mfma_f32_16x16x32_bf16(a0, bM, z4, 0, 0, 0), q1 = __builtin_amdgcn_mfma_f32_16x16x32_bf16(a1, bM, z4, 0, 0, 0);
#pragma unroll
                for (int rg_ = 0; rg_ < 4; ++rg_) { q0[rg_] += RHf[l15 * 65 + 16 * (2 * ks2) + 4 * g + rg_]; q1[rg_] += RHf[l15 * 65 + 16 * (2 * ks2 + 1) + 4 * g + rg_]; }
                *(u32x4*)(fr + 10240 + (size_t)(ks2 * 64 + F.lane) * 16) = (u32x4){pk2(q0[0], q0[1]), pk2(q0[2], q0[3]), pk2(q1[0], q1[1]), pk2(q1[2], q1[3])};
            } else if (F.wave == 6) {
                const bf16x8 aP2 = (g < 2) ? *(const LAS bf16x8*)(P2b + l15 * 24 + 8 * g) : zero8;
                const bf16x8 bM = (g < 2) ? *(const LAS bf16x8*)(MAT + l15 * 24 + 8 * g) : zero8;
                f32x4 d = __builtin_amdgcn_mfma_f32_16x16x32_bf16(aP2, bM, z4, 0, 0, 0);
#pragma unroll
                for (int rg_ = 0; rg_ < 4; ++rg_) d[rg_] += GMB[(4 * g + rg_) * 17 + l15];
                *(u32x2*)(fr + 12288 + (size_t)F.lane * 8) = (u32x2){pk2(d[0], d[1]), pk2(d[2], d[3])};
            } else {
                *(float*)(fr + 14848 + F.lane * 4) = WW[F.lane];
            }
            if (F.tid < 256) {
                const int rg = F.tid >> 6, row = 16 * rg + l15, s4 = 4 * g;
                *(u32x2*)(fr + 12800 + (size_t)(rg * 64 + F.lane) * 8) = (u32x2){pk2(VV[s4 * 64 + row], VV[(s4 + 1) * 64 + row]), pk2(VV[(s4 + 2) * 64 + row], VV[(s4 + 3) * 64 + row])};
            }
        }
    }
}
struct ScanFrag { u32x4 g[4][2]; u32x2 f[4]; u32x4 q1[2]; u32x2 q2; u32x2 vt; f32x4 w[4]; };
__device__ __forceinline__ void scan_frag_load(ScanFrag& fr, const unsigned char* base, int rg, int lane) {
#pragma unroll
    for (int mt = 0; mt < 4; ++mt) {
#pragma unroll
        for (int ks = 0; ks < 2; ++ks) fr.g[mt][ks] = *(const u32x4*)(base + (size_t)((mt * 2 + ks) * 64 + lane) * 16);
        fr.f[mt] = *(const u32x2*)(base + 8192 + (size_t)(mt * 64 + lane) * 8);
        fr.w[mt] = *(const f32x4*)(base + 14848 + (16 * mt + 4 * (lane >> 4)) * 4); }
#pragma unroll
    for (int ks = 0; ks < 2; ++ks) fr.q1[ks] = *(const u32x4*)(base + 10240 + (size_t)(ks * 64 + lane) * 16);
    fr.q2 = *(const u32x2*)(base + 12288 + (size_t)lane * 8);
    fr.vt = *(const u32x2*)(base + 12800 + (size_t)(rg * 64 + lane) * 8);
}
__device__ __forceinline__ void scan_chunk(f32x4 (&acc)[4], const ScanFrag& fr, bf16* yout) {
    const bf16x8 sb0 = as_bf8((u32x4){pk2(acc[0][0], acc[0][1]), pk2(acc[0][2], acc[0][3]), pk2(acc[1][0], acc[1][1]), pk2(acc[1][2], acc[1][3])});
    const bf16x8 sb1 = as_bf8((u32x4){pk2(acc[2][0], acc[2][1]), pk2(acc[2][2], acc[2][3]), pk2(acc[3][0], acc[3][1]), pk2(acc[3][2], acc[3][3])});
    const bf16x8 vb = as_bf8((u32x4){fr.vt.x, fr.vt.y, 0u, 0u});
#pragma unroll
    for (int c = 0; c < 4; ++c) { f32x4 n = acc[c] * fr.w[c];
        n = __builtin_amdgcn_mfma_f32_16x16x32_bf16(as_bf8(fr.g[c][0]), sb0, n, 0, 0, 0);
        n = __builtin_amdgcn_mfma_f32_16x16x32_bf16(as_bf8(fr.g[c][1]), sb1, n, 0, 0, 0);
        n = __builtin_amdgcn_mfma_f32_16x16x32_bf16(as_bf8((u32x4){fr.f[c].x, fr.f[c].y, 0u, 0u}), vb, n, 0, 0, 0);
        acc[c] = n; }
    f32x4 y = {0.f, 0.f, 0.f, 0.f};
    y = __builtin_amdgcn_mfma_f32_16x16x32_bf16(as_bf8(fr.q1[0]), sb0, y, 0, 0, 0);
    y = __builtin_amdgcn_mfma_f32_16x16x32_bf16(as_bf8(fr.q1[1]), sb1, y, 0, 0, 0);
    y = __builtin_amdgcn_mfma_f32_16x16x32_bf16(as_bf8((u32x4){fr.q2.x, fr.q2.y, 0u, 0u}), vb, y, 0, 0, 0);
    *(u32x2*)yout = (u32x2){pk2(y[0], y[1]), pk2(y[2], y[3])};
}
#define SCAN_ASM_LD4(dst, ptr, off) asm volatile("global_load_dwordx4 %0, %1, off offset:" #off : "=v"(dst) : "v"(ptr))
#define SCAN_ASM_LD2(dst, ptr, off) asm volatile("global_load_dwordx2 %0, %1, off offset:" #off : "=v"(dst) : "v"(ptr))
__device__ __forceinline__ void scan_frag_issue(ScanFrag& fr, const unsigned char* item, int rg, int lane) {
    const unsigned char* pg0 = item + lane * 16; const unsigned char* pg1 = pg0 + 4096;
    const unsigned char* pf = item + 8192 + lane * 8; const unsigned char* pq1 = item + 10240 + lane * 16;
    const unsigned char* pq2 = item + 12288 + lane * 8; const unsigned char* pvt = item + 12800 + (rg * 64 + lane) * 8; const unsigned char* pw = item + 14848 + (lane >> 4) * 16;
    SCAN_ASM_LD4(fr.g[0][0], pg0, 0); SCAN_ASM_LD4(fr.g[0][1], pg0, 1024); SCAN_ASM_LD4(fr.g[1][0], pg0, 2048); SCAN_ASM_LD4(fr.g[1][1], pg0, 3072);
    SCAN_ASM_LD4(fr.g[2][0], pg1, 0); SCAN_ASM_LD4(fr.g[2][1], pg1, 1024); SCAN_ASM_LD4(fr.g[3][0], pg1, 2048); SCAN_ASM_LD4(fr.g[3][1], pg1, 3072);
    SCAN_ASM_LD2(fr.f[0], pf, 0); SCAN_ASM_LD2(fr.f[1], pf, 512); SCAN_ASM_LD2(fr.f[2], pf, 1024); SCAN_ASM_LD2(fr.f[3], pf, 1536);
    SCAN_ASM_LD4(fr.q1[0], pq1, 0); SCAN_ASM_LD4(fr.q1[1], pq1, 1024);
    SCAN_ASM_LD2(fr.q2, pq2, 0); SCAN_ASM_LD2(fr.vt, pvt, 0);
    SCAN_ASM_LD4(fr.w[0], pw, 0); SCAN_ASM_LD4(fr.w[1], pw, 64); SCAN_ASM_LD4(fr.w[2], pw, 128); SCAN_ASM_LD4(fr.w[3], pw, 192);
}
#define SCAN_WAIT(fr, N) asm volatile("s_waitcnt vmcnt(" #N ")" : "+v"(fr.g[0][0]), "+v"(fr.g[0][1]), "+v"(fr.g[1][0]), "+v"(fr.g[1][1]), "+v"(fr.g[2][0]), "+v"(fr.g[2][1]), "+v"(fr.g[3][0]), "+v"(fr.g[3][1]), \
        "+v"(fr.f[0]), "+v"(fr.f[1]), "+v"(fr.f[2]), "+v"(fr.f[3]), "+v"(fr.q1[0]), "+v"(fr.q1[1]), "+v"(fr.q2), "+v"(fr.vt), "+v"(fr.w[0]), "+v"(fr.w[1]), "+v"(fr.w[2]), "+v"(fr.w[3]) :: "memory")
__device__ __forceinline__ void scan_mfma_rows(const Args& A, Frame& F) {
    const unsigned char* FR = A.ws + WS_BIG; bf16* YRAW = (bf16*)A.out + (size_t)3 * TOK * 1024;
    if (F.wave != 0) return;
    for (int u = F.bx; u < 128; u += F.G) {
        const int bh = u & 31, rg = u >> 5; const unsigned char* base = FR + (size_t)bh * 1024 * FR_BYTES;
        bf16* yrow = YRAW + ((size_t)bh * 64 + 16 * rg + (F.lane & 15)) * SEQ + 4 * (F.lane >> 4);
        f32x4 acc[4];
#pragma unroll
        for (int c = 0; c < 4; ++c) acc[c] = (f32x4){0.f, 0.f, 0.f, 0.f};
        ScanFrag fa, fb;
        scan_frag_issue(fa, base, rg, F.lane);
#pragma unroll 1
        for (int ch = 0; ch < 1024; ch += 2) {
            scan_frag_issue(fb, base + (size_t)(ch + 1) * FR_BYTES, rg, F.lane);
            SCAN_WAIT(fa, 20);
            scan_chunk(acc, fa, yrow + ch * 16);
            scan_frag_issue(fa, base + (size_t)((ch + 2 < 1024) ? (ch + 2) : ch) * FR_BYTES, rg, F.lane);
            SCAN_WAIT(fb, 20);
            scan_chunk(acc, fb, yrow + (ch + 1) * 16);
        }
        asm volatile("s_waitcnt vmcnt(0)" ::: "memory");
    }
}

__device__ __forceinline__ void pair_sync(volatile LAS unsigned* cnt, unsigned target) {
    asm volatile("s_waitcnt vmcnt(0) lgkmcnt(0)" ::: "memory");
    if ((threadIdx.x & 63) == 0) (void)__hip_atomic_fetch_add((LAS unsigned*)cnt, 1u, __ATOMIC_RELAXED, __HIP_MEMORY_SCOPE_WORKGROUP);
    while (__hip_atomic_load((LAS unsigned*)cnt, __ATOMIC_RELAXED, __HIP_MEMORY_SCOPE_WORKGROUP) < target) __builtin_amdgcn_s_sleep(1);
    asm volatile("" ::: "memory");
}
__device__ __forceinline__ void swa_pairs(const Args& A, Frame& F, volatile LAS unsigned* MISC) {
    const bf16* Z = (const bf16*)(A.ws + WS_Z); bf16* Y = (bf16*)(A.ws + WS_HY); const float* sinks = (const float*)A.in[5];
    const int pr = (F.wave - 4) >> 1, mem = F.wave & 1;
    LAS unsigned char* KL = F.lds + pr * 69632; LAS unsigned char* VL = KL + 256 * 136;
    volatile LAS unsigned* cnt = MISC + 24 + pr; unsigned gen = 0u;
    for (int u = F.bx * 2 + pr; u < 512; u += F.G * 2) {
        const int b = u >> 8, n = (u >> 1) & 127, kvh = u & 1;
        gen += 2u; pair_sync(cnt, gen);
#pragma unroll 1
        for (int c0 = mem * 1024 + F.lane; c0 < mem * 1024 + 1024; c0 += 64 * 8) {
            u32x4 kv[8], vv[8];
#pragma unroll
            for (int q = 0; q < 8; ++q) { const int c = c0 + 64 * q; const int jw = c >> 3, cc = c & 7; const int sp = n * 128 - 128 + jw;
                kv[q] = (u32x4){0u, 0u, 0u, 0u}; vv[q] = kv[q];
                if (sp >= 0) { const bf16* row = Z + (size_t)(b * SEQ + sp) * EV_NP; kv[q] = *(const u32x4*)(row + 1024 + kvh * 64 + cc * 8); vv[q] = *(const u32x4*)(row + 1152 + kvh * 64 + cc * 8); } }
#pragma unroll
            for (int q = 0; q < 8; ++q) { const int c = c0 + 64 * q; const int jw = c >> 3, cc = c & 7;
                *(LAS u32x2*)(KL + jw * 136 + cc * 16) = (u32x2){kv[q].x, kv[q].y}; *(LAS u32x2*)(KL + jw * 136 + cc * 16 + 8) = (u32x2){kv[q].z, kv[q].w};
                *(LAS u32x2*)(VL + jw * 136 + cc * 16) = (u32x2){vv[q].x, vv[q].y}; *(LAS u32x2*)(VL + jw * 136 + cc * 16 + 8) = (u32x2){vv[q].z, vv[q].w}; }
        }
        gen += 2u; pair_sync(cnt, gen);
        for (int it = mem; it < 1024; it += 2) {
            const int i = it >> 3, g = it & 7, head = kvh * 8 + g; const int t = b * SEQ + n * 128 + i;
            const float qv = bf2f(Z[(size_t)t * EV_NP + head * 64 + F.lane]) * 0.125f;
            const int jw0 = i + 1 + F.lane, jw1 = jw0 + 64;
            const bool val0 = (n > 0) || (jw0 >= 128), val1 = (n > 0) || (jw1 >= 128);
            float s0 = 0.f, s1 = 0.f;
#pragma unroll
            for (int d4 = 0; d4 < 16; ++d4) {
                const u32x2 k0 = *(const LAS u32x2*)(KL + jw0 * 136 + d4 * 8), k1 = *(const LAS u32x2*)(KL + jw1 * 136 + d4 * 8);
                const float q0 = rdlane(qv, 4 * d4), q1 = rdlane(qv, 4 * d4 + 1), q2 = rdlane(qv, 4 * d4 + 2), q3 = rdlane(qv, 4 * d4 + 3);
                s0 += q0 * lo2f(k0.x) + q1 * hi2f(k0.x) + q2 * lo2f(k0.y) + q3 * hi2f(k0.y);
                s1 += q0 * lo2f(k1.x) + q1 * hi2f(k1.x) + q2 * lo2f(k1.y) + q3 * hi2f(k1.y);
            }
            const float sink = sinks[head];
            s0 = val0 ? s0 : -INFINITY; s1 = val1 ? s1 : -INFINITY;
            const float mx = fmaxf(wmax(fmaxf(s0, s1)), sink);
            float p0 = val0 ? expf(s0 - mx) : 0.f, p1 = val1 ? expf(s1 - mx) : 0.f;
            const float den = wsum(p0 + p1) + expf(sink - mx); const float rden = 1.0f / den;
            p0 *= rden; p1 *= rden;
            float o = 0.f;
            const LAS bf16* vcol = (const LAS bf16*)VL + F.lane;
#pragma unroll 8
            for (int jj = 0; jj < 64; ++jj) o += rdlane(p0, jj) * bf2f(vcol[(i + 1 + jj) * 68]);
#pragma unroll 8
            for (int jj = 0; jj < 64; ++jj) o += rdlane(p1, jj) * bf2f(vcol[(i + 65 + jj) * 68]);
            Y[(size_t)t * DM + head * 64 + F.lane] = (bf16)f2bf(o);
        }
    }
}

__device__ __forceinline__ void wsum2_dpp(float a, float b, float& ra, float& rb) {
    const auto r = __builtin_amdgcn_permlane32_swap(__float_as_uint(a), __float_as_uint(b), false, false);
    float v = __uint_as_float(r[0]) + __uint_as_float(r[1]);
    v += dppf<0xB1, 0xF>(v); v += dppf<0x4E, 0xF>(v); v += dppf<0x141, 0xF>(v); v += dppf<0x140, 0xF>(v);
    v += dppf<0x142, 0xA>(v);
    ra = rdlane(v, 31); rb = rdlane(v, 63);
}
__device__ __forceinline__ void ph_scan(const Args& A, Frame& F, volatile LAS unsigned* MISC) {
    const unsigned* PK = (const unsigned*)(A.ws + WS_BIG); bf16* YRAW = (bf16*)A.out + (size_t)3 * TOK * 1024;
    if (F.wave >= 4) { swa_pairs(A, F, MISC); return; }
    __builtin_amdgcn_s_setprio(3);
    for (int pp = F.bx * 4 + F.wave; pp < 1024; pp += F.G * 4) {
        const int rr = 2 * pp, bh = rr >> 6, vrow = rr & 63;
        const unsigned* pk = PK + ((size_t)bh * SEQ * 64 + F.lane) * 3;
        bf16* youtA = YRAW + ((size_t)bh * 64 + vrow) * SEQ; bf16* youtB = youtA + SEQ;
        f32x2 S2 = {0.f, 0.f};
        for (int t0 = 0; t0 < SEQ; t0 += 64) {
            float ykA = 0.f, ykB = 0.f;
#pragma unroll 8
            for (int j = 0; j < 64; ++j) {
                const unsigned* p = pk + (size_t)(t0 + j) * 192;
                const unsigned w0 = p[0], w1 = p[1], w2 = p[2];
                const float r = lo2f(w0), e = hi2f(w0), kp = lo2f(w1), kk = hi2f(w1), kka = lo2f(w2), vv = hi2f(w2);
                const f32x2 v2 = {rdlane(vv, vrow), rdlane(vv, vrow + 1)};
                const float dec = __expf(-e);
                const f32x2 pk2v = S2 * (f32x2){kk, kk};
                float saA, saB; wsum2_dpp(pk2v.x, pk2v.y, saA, saB); const f32x2 sa2 = {saA, saB};
                S2 = S2 * (f32x2){dec, dec} + (v2 * (f32x2){kp, kp} - sa2 * (f32x2){kka, kka});
                const f32x2 py = S2 * (f32x2){r, r};
                float yA, yB; wsum2_dpp(py.x, py.y, yA, yB);
                ykA = (F.lane == j) ? yA : ykA; ykB = (F.lane == j) ? yB : ykB;
            }
            youtA[t0 + F.lane] = (bf16)f2bf(ykA); youtB[t0 + F.lane] = (bf16)f2bf(ykB);
        }
    }
    __builtin_amdgcn_s_setprio(0);
}

__device__ __forceinline__ void ph_rwkv_finish(const Args& A, Frame& F) {
    const bf16* Z = (const bf16*)(A.ws + WS_Z); const bf16* RKV = (const bf16*)A.out; const bf16* YRAW = (const bf16*)A.out + (size_t)3 * TOK * 1024;
    const float* BS = (const float*)(A.ws + WS_BS); bf16* Y = (bf16*)(A.ws + WS_HY);
    const float* lnx_g = (const float*)A.in[15]; const float* lnx_b = (const float*)A.in[16];
    LAS float* tile = (LAS float*)(F.lds + F.wave * 16640);
    for (int it = F.gw; it < 8192; it += F.ngw) {
        const int bh = it >> 8, tb = it & 255, b = bh >> 4, h = bh & 15, t0 = tb * 64;
        for (int vr = 0; vr < 64; ++vr) tile[vr * 65 + F.lane] = bf2f(YRAW[((size_t)bh * 64 + vr) * SEQ + t0 + F.lane]);
        asm volatile("s_waitcnt lgkmcnt(0)" ::: "memory");
        const int c = h * 64 + F.lane; const float lg = lnx_g[c], lb = lnx_b[c];
        for (int j = 0; j < 64; ++j) {
            const int t = b * SEQ + t0 + j;
            const float y = tile[F.lane * 65 + j];
            const float mean = wsum(y) * (1.0f / 64.0f); const float d = y - mean; const float var = wsum(d * d) * (1.0f / 64.0f);
            const float yn = d * rsqrtf(var + 64e-5f) * lg + lb;
            const float vv = bf2f(RKV[(size_t)2 * TOK * 1024 + (size_t)t * 1024 + c]); const float g = bf2f(Z[(size_t)t * EV_NP + 1280 + 2048 + c]); const float bs = BS[(size_t)t * 16 + h];
            Y[(size_t)t * DM + 1024 + c] = (bf16)f2bf((yn + bs * vv) * g);
        }
        asm volatile("s_waitcnt lgkmcnt(0)" ::: "memory");
    }
}

constexpr size_t WS_H8 = WS_BIG + 384 * MiB, WS_HS = WS_BIG + 448 * MiB;
__device__ __forceinline__ unsigned pack_i8x4(float a, float b, float c, float d) {
    const unsigned ua = __float_as_uint(a + 12582912.0f) & 255u, ub = __float_as_uint(b + 12582912.0f) & 255u, uc = __float_as_uint(c + 12582912.0f) & 255u, ud = __float_as_uint(d + 12582912.0f);
    return ua | (ub << 8) | (uc << 16) | (ud << 24);
}
__device__ __forceinline__ void ph_ln_mixer(const Args& A, Frame& F, const int L) {
    const float* xsrc = (const float*)A.in[0]; const bf16* xsrcb = (const bf16*)A.out;
    bf16* xdst = (L == 0) ? (bf16*)A.out : (bf16*)(A.ws + WS_Z + 160 * MiB);
    const bf16* O = (const bf16*)(A.ws + WS_Z); bf16* H = (bf16*)(A.ws + WS_HY); const float* MOD = (const float*)(A.ws + WS_MOD);
    const float* lng = (const float*)A.in[21] + (size_t)(L * 2 + 0) * DM; const float* lnb = (const float*)A.in[22] + (size_t)(L * 2 + 0) * DM;
    for (int t = F.gw; t < TOK; t += F.ngw) {
        const int b = t >> 14;
        const float* gate = MOD + (size_t)((L * 2 + 0) * 2 + b) * 6144 + 4096;
        const float* sh = MOD + (size_t)((L * 2 + 1) * 2 + b) * 6144; const float* sc = sh + 2048;
        float v[32]; float sum = 0.f;
#pragma unroll
        for (int j = 0; j < 4; ++j) { const int base = (j * 64 + F.lane) * 8;
            const u32x4 ow = *(const u32x4*)(O + (size_t)t * DM + base);
            f32x4 x0, x1;
            if (L == 0) { x0 = *(const f32x4*)(xsrc + (size_t)t * DM + base); x1 = *(const f32x4*)(xsrc + (size_t)t * DM + base + 4); }
            else { const u32x4 xw = *(const u32x4*)(xsrcb + (size_t)t * DM + base); x0 = (f32x4){lo2f(xw.x), hi2f(xw.x), lo2f(xw.y), hi2f(xw.y)}; x1 = (f32x4){lo2f(xw.z), hi2f(xw.z), lo2f(xw.w), hi2f(xw.w)}; }
            const f32x4 g0 = *(const f32x4*)(gate + base), g1 = *(const f32x4*)(gate + base + 4);
            const float of[8] = {lo2f(ow.x), hi2f(ow.x), lo2f(ow.y), hi2f(ow.y), lo2f(ow.z), hi2f(ow.z), lo2f(ow.w), hi2f(ow.w)};
#pragma unroll
            for (int e = 0; e < 4; ++e) { v[j * 8 + e] = ALPHA * x0[e] + (1.0f + g0[e]) * of[e]; v[j * 8 + 4 + e] = ALPHA * x1[e] + (1.0f + g1[e]) * of[4 + e]; }
#pragma unroll
            for (int e = 0; e < 8; ++e) sum += v[j * 8 + e]; }
        const float mean = wsum(sum) * (1.0f / DM); float sq = 0.f;
#pragma unroll
        for (int e = 0; e < 32; ++e) { v[e] -= mean; sq += v[e] * v[e]; }
        const float rstd = rsqrtf(wsum(sq) * (1.0f / DM) + 1e-5f); float hmax = 0.f;
#pragma unroll
        for (int j = 0; j < 4; ++j) { const int base = (j * 64 + F.lane) * 8;
            const f32x4 lg0 = *(const f32x4*)(lng + base), lg1 = *(const f32x4*)(lng + base + 4), lb0 = *(const f32x4*)(lnb + base), lb1 = *(const f32x4*)(lnb + base + 4);
            const f32x4 s0 = *(const f32x4*)(sc + base), s1 = *(const f32x4*)(sc + base + 4), h0 = *(const f32x4*)(sh + base), h1 = *(const f32x4*)(sh + base + 4);
            f32x4 o0, o1;
#pragma unroll
            for (int e = 0; e < 4; ++e) { o0[e] = v[j * 8 + e] * rstd * lg0[e] + lb0[e]; o1[e] = v[j * 8 + 4 + e] * rstd * lg1[e] + lb1[e]; }
            { u32x4 xw; xw.x = pk2(o0[0], o0[1]); xw.y = pk2(o0[2], o0[3]); xw.z = pk2(o1[0], o1[1]); xw.w = pk2(o1[2], o1[3]); *(u32x4*)(xdst + (size_t)t * DM + base) = xw; }
            const f32x4 q0 = o0 * (1.0f + s0) + h0, q1 = o1 * (1.0f + s1) + h1;
            u32x4 w; w.x = pk2(q0[0], q0[1]); w.y = pk2(q0[2], q0[3]); w.z = pk2(q1[0], q1[1]); w.w = pk2(q1[2], q1[3]);
            *(u32x4*)(H + (size_t)t * DM + base) = w;
#pragma unroll
            for (int e = 0; e < 4; ++e) { v[j * 8 + e] = q0[e]; v[j * 8 + 4 + e] = q1[e]; hmax = fmaxf(hmax, fmaxf(fabsf(q0[e]), fabsf(q1[e]))); } }
        { hmax = wmax(hmax); const float inv = (hmax > 0.f) ? 127.0f / hmax : 0.f;
#pragma unroll
          for (int j = 0; j < 4; ++j) { const int base = (j * 64 + F.lane) * 8; u32x2 w8;
              w8.x = pack_i8x4(v[j * 8 + 0] * inv, v[j * 8 + 1] * inv, v[j * 8 + 2] * inv, v[j * 8 + 3] * inv); w8.y = pack_i8x4(v[j * 8 + 4] * inv, v[j * 8 + 5] * inv, v[j * 8 + 6] * inv, v[j * 8 + 7] * inv);
              *(u32x2*)(A.ws + WS_H8 + (size_t)t * DM + base) = w8; }
          if (F.lane == 0) ((float*)(A.ws + WS_HS))[t] = hmax * (1.0f / 127.0f); }
    }
    {
        const float* pu = (const float*)A.in[25] + (size_t)L * 16384 * 2048; const float* pv = (const float*)A.in[26] + (size_t)L * 16384 * 2048;
        unsigned char* T8 = A.ws + WS_BIG; float* SCL = (float*)(A.ws + WS_BIG + 64 * MiB);
        for (int r = F.gw; r < 32768; r += F.ngw) {
            const float* src = ((r < 16384) ? pu : pv) + (size_t)(r & 16383) * 2048;
            f32x4 f[2][4]; float amax = 0.f;
#pragma unroll
            for (int j = 0; j < 2; ++j)
#pragma unroll
                for (int c = 0; c < 4; ++c) { f[j][c] = *(const f32x4*)(src + (j * 64 + F.lane) * 16 + 4 * c);
                    amax = fmaxf(amax, fmaxf(fmaxf(fabsf(f[j][c][0]), fabsf(f[j][c][1])), fmaxf(fabsf(f[j][c][2]), fabsf(f[j][c][3])))); }
            amax = wmax(amax);
            {
                const float inv = (amax > 0.f) ? 127.0f / amax : 0.f;
#pragma unroll
                for (int j = 0; j < 2; ++j) { u32x4 w;
                    w.x = pack_i8x4(f[j][0][0] * inv, f[j][0][1] * inv, f[j][0][2] * inv, f[j][0][3] * inv); w.y = pack_i8x4(f[j][1][0] * inv, f[j][1][1] * inv, f[j][1][2] * inv, f[j][1][3] * inv);
                    w.z = pack_i8x4(f[j][2][0] * inv, f[j][2][1] * inv, f[j][2][2] * inv, f[j][2][3] * inv); w.w = pack_i8x4(f[j][3][0] * inv, f[j][3][1] * inv, f[j][3][2] * inv, f[j][3][3] * inv);
                    *(u32x4*)(T8 + (size_t)r * 2048 + (j * 64 + F.lane) * 16) = w; }
                if (F.lane == 0) SCL[r] = amax * (1.0f / 127.0f);
            }
        }
    }
}

template <int NV, int NBITS> __device__ __forceinline__ unsigned wave_tau16(const unsigned (&key)[NV]) {
    unsigned tau = 0u;
#pragma unroll 1
    for (int bit = NBITS - 1; bit >= 0; --bit) {
        const unsigned cand = tau | (1u << bit); int cnt = 0;
#pragma unroll
        for (int v = 0; v < NV; ++v) cnt += __popcll(__ballot(key[v] >= cand));
        if (cnt >= 16) tau = cand;
    }
    return tau;
}
template <int NV> __device__ __forceinline__ void wave_compact16(const unsigned (&key)[NV], const float (&val)[NV], const int (&id)[NV], unsigned tau, LAS float* ov, LAS int* oi, int lane) {
    int ngt = 0;
#pragma unroll
    for (int v = 0; v < NV; ++v) ngt += __popcll(__ballot(key[v] > tau));
    int bg = 0, be = 0;
#pragma unroll
    for (int v = 0; v < NV; ++v) {
        const bool gt = key[v] > tau, eq = key[v] == tau;
        const unsigned long long mg = __ballot(gt), me = __ballot(eq);
        const unsigned long long below = (lane == 0) ? 0ull : ((~0ull) >> (64 - lane));
        const int pg = bg + __popcll(mg & below), pe = ngt + be + __popcll(me & below);
        if (gt) { ov[pg] = val[v]; oi[pg] = id[v]; }
        if (eq && pe < 16) { ov[pe] = val[v]; oi[pe] = id[v]; }
        bg += __popcll(mg); be += __popcll(me);
    }
}

template <int CTRL, int BANK> __device__ __forceinline__ unsigned dppb(unsigned old, unsigned v) { return (unsigned)__builtin_amdgcn_update_dpp((int)old, (int)v, CTRL, 0xF, BANK, false); }
template <int CTRL> __device__ __forceinline__ unsigned dppm(unsigned v) { return (unsigned)__builtin_amdgcn_mov_dpp((int)v, CTRL, 0xF, 0xF, true); }
template <int CTRL> __device__ __forceinline__ unsigned cex(unsigned x, bool lo) { const unsigned mx = max(x, dppm<CTRL>(x)), mn = min(x, dppm<CTRL>(x)); return lo ? mx : mn; }
__device__ __forceinline__ unsigned cex4(unsigned x, bool lo) {
    unsigned t = (unsigned)__builtin_amdgcn_mov_dpp((int)x, 0x104, 0xF, 0x5, false); t = dppb<0x114, 0xA>(t, x); const unsigned mx = max(x, t), mn = min(x, t); return lo ? mx : mn; }
struct LoMasks { bool lo1, lo2, lo4, lo8, odd16, up32; };
__device__ __forceinline__ unsigned sort16_desc(unsigned x, const LoMasks& M) {
    x = cex<0xB1>(x, M.lo1);
    x = cex<0x1B>(x, M.lo2); x = cex<0xB1>(x, M.lo1);
    x = cex<0x141>(x, M.lo4); x = cex<0x4E>(x, M.lo2); x = cex<0xB1>(x, M.lo1);
    x = cex<0x140>(x, M.lo8); x = cex4(x, M.lo4); x = cex<0x4E>(x, M.lo2); x = cex<0xB1>(x, M.lo1);
    return x;
}
__device__ __forceinline__ unsigned clean16_desc(unsigned x, const LoMasks& M) {
    x = cex<0x128>(x, M.lo8); x = cex4(x, M.lo4); x = cex<0x4E>(x, M.lo2); x = cex<0xB1>(x, M.lo1); return x;
}
__device__ __forceinline__ unsigned mtop_regs(unsigned a, unsigned b) { return max(a, dppm<0x140>(b)); }
__device__ __forceinline__ unsigned mtop_rows(unsigned y, const LoMasks& M) { const auto r = __builtin_amdgcn_permlane16_swap(y, y, false, false); const unsigned pv = M.odd16 ? r[0] : r[1]; return mtop_regs(y, pv); }
__device__ __forceinline__ unsigned mtop_halves(unsigned y, const LoMasks& M) { const auto r = __builtin_amdgcn_permlane32_swap(y, y, false, false); const unsigned pv = M.up32 ? r[0] : r[1]; return mtop_regs(y, pv); }

template <int OFF, int N, int MASKX, int TOT> __device__ __forceinline__ void ce_stage(unsigned (&k)[TOT]) {
#pragma unroll
    for (int i = 0; i < N; ++i) { const int pr = i ^ MASKX; if (pr > i) { const unsigned a_ = k[OFF + i], b_ = k[OFF + pr]; k[OFF + i] = max(a_, b_); k[OFF + pr] = min(a_, b_); } }
}
template <int OFF, int TOT> __device__ __forceinline__ void sort16_regs(unsigned (&k)[TOT]) {
    ce_stage<OFF, 16, 1>(k); ce_stage<OFF, 16, 3>(k); ce_stage<OFF, 16, 1>(k); ce_stage<OFF, 16, 7>(k); ce_stage<OFF, 16, 2>(k); ce_stage<OFF, 16, 1>(k);
    ce_stage<OFF, 16, 15>(k); ce_stage<OFF, 16, 4>(k); ce_stage<OFF, 16, 2>(k); ce_stage<OFF, 16, 1>(k);
}
template <int TOT> __device__ __forceinline__ void clean16_regs(unsigned (&k)[TOT]) { ce_stage<0, 16, 8>(k); ce_stage<0, 16, 4>(k); ce_stage<0, 16, 2>(k); ce_stage<0, 16, 1>(k); }

__device__ __forceinline__ void ph_peer_select(const Args& A, Frame& F, const int L) {
    const bf16* QP = (const bf16*)(A.ws + WS_Z); const bf16* SKB = (const bf16*)(A.ws + WS_SKB) + (size_t)L * 262144;
    int* EID = (int*)(A.ws + WS_LA); float* GSM = (float*)(A.ws + WS_LA + 16 * MiB);
    LAS unsigned char* SKL = F.lds;
    LAS float* SCO = (LAS float*)(F.lds + 69632 + 4096);
    for (int it = F.bx; it < 4096; it += F.G) {
        const int tile = it >> 3, h = it & 7;
        __syncthreads();
        for (int c = F.tid; c < 4096; c += NTHREADS) { const int p = c >> 11, n = (c >> 4) & 127, cc = c & 15;
            *(LAS u32x4*)(SKL + (p * 128 + n) * 272 + cc * 16) = *(const u32x4*)(SKB + ((size_t)((p * 8 + h) * 128 + n)) * 128 + cc * 8); }
        __syncthreads();
        {
            const int p = F.wave >> 2, mt = F.wave & 3, g = F.lane >> 4, l15 = F.lane & 15;
            const bf16* qrow = QP + (size_t)(tile * 64 + mt * 16 + l15) * DM + h * 256 + p * 128 + 8 * g;
            bf16x8 afr[4];
#pragma unroll
            for (int ks = 0; ks < 4; ++ks) afr[ks] = *(const bf16x8*)(qrow + 32 * ks);
#pragma unroll
            for (int nt = 0; nt < 8; ++nt) {
                f32x4 acc = {0.f, 0.f, 0.f, 0.f};
#pragma unroll
                for (int ks = 0; ks < 4; ++ks) { const bf16x8 bfr = *(const LAS bf16x8*)(SKL + (p * 128 + nt * 16 + l15) * 272 + (32 * ks + 8 * g) * 2);
                    acc = __builtin_amdgcn_mfma_f32_16x16x32_bf16(afr[ks], bfr, acc, 0, 0, 0); }
#pragma unroll
                for (int rg = 0; rg < 4; ++rg) SCO[(p * 64 + mt * 16 + 4 * g + rg) * 132 + nt * 16 + l15] = acc[rg];
            }
        }
        __syncthreads();
        constexpr int NT = 4;
        LAS unsigned char* WB = F.lds + 141312 + F.wave * 2048;
        LoMasks M; M.lo1 = (F.lane & 1) == 0; M.lo2 = (F.lane & 2) == 0; M.lo4 = (F.lane & 4) == 0; M.lo8 = (F.lane & 8) == 0; M.odd16 = (F.lane & 16) != 0; M.up32 = (F.lane & 32) != 0;
        int pi_, pj_;
        { const int L = F.lane;
          if (L < 16) { pi_ = 0; pj_ = L; } else if (L < 24) { pi_ = 1; pj_ = L - 16; } else if (L < 29) { pi_ = 2; pj_ = L - 24; } else if (L < 33) { pi_ = 3; pj_ = L - 29; }
          else if (L < 36) { pi_ = 4; pj_ = L - 33; } else if (L < 42) { pi_ = 5 + ((L - 36) >> 1); pj_ = (L - 36) & 1; } else { pi_ = 8 + (L - 42); pj_ = 0; }
          if (L >= 50) { pi_ = 0; pj_ = 0; } }
        const bool pvalid = F.lane < 50;
        {
            const int g = F.lane >> 2, q = F.lane & 3, tok = g >> 1, sp = g & 1;
            const LAS float* srow = SCO + (sp * 64 + F.wave * 8 + tok) * 132;
            unsigned k[32]; const unsigned ib = (unsigned)(127 - q * 32);
#pragma unroll
            for (int c = 0; c < 8; ++c) { const f32x4 v = *(const LAS f32x4*)(srow + q * 32 + 4 * c);
#pragma unroll
                for (int e = 0; e < 4; ++e) k[4 * c + e] = (fixkey20(v[e]) << 7) | (ib - (unsigned)(4 * c + e)); }
            sort16_regs<0>(k); sort16_regs<16>(k);
            unsigned m[16], t2[16];
#pragma unroll
            for (int i = 0; i < 16; ++i) m[i] = max(k[i], k[31 - i]);
            clean16_regs(m);
#pragma unroll
            for (int i = 0; i < 16; ++i) t2[i] = max(m[i], dppm<0xB1>(m[15 - i]));
            clean16_regs(t2);
#pragma unroll
            for (int i = 0; i < 16; ++i) m[i] = max(t2[i], dppm<0x4E>(t2[15 - i]));
            clean16_regs(m);
            float vals[16]; int idxs[16];
#pragma unroll
            for (int e = 0; e < 16; ++e) { idxs[e] = 127 - (int)(m[e] & 127u); vals[e] = srow[idxs[e]]; }
            if (q == 0) { LAS float* tvp = (LAS float*)(WB + tok * 256) + sp * 16; LAS int* tip = (LAS int*)(WB + tok * 256 + 128) + sp * 16;
#pragma unroll
                for (int c = 0; c < 4; ++c) { *(LAS f32x4*)(tvp + 4 * c) = (f32x4){vals[4 * c], vals[4 * c + 1], vals[4 * c + 2], vals[4 * c + 3]};
                    *(LAS u32x4*)(tip + 4 * c) = (u32x4){(unsigned)idxs[4 * c], (unsigned)idxs[4 * c + 1], (unsigned)idxs[4 * c + 2], (unsigned)idxs[4 * c + 3]}; } }
        }
        asm volatile("s_waitcnt lgkmcnt(0)" ::: "memory"); __builtin_amdgcn_wave_barrier();
#pragma unroll 1
        for (int tk0 = 0; tk0 < 8; tk0 += NT) {
            unsigned z[NT];
#pragma unroll
            for (int u = 0; u < NT; ++u) { const LAS float* tv = (const LAS float*)(WB + (tk0 + u) * 256); const float cvl = tv[pi_] + tv[16 + pj_];
                z[u] = pvalid ? ((fixkey20(cvl * 0.5f) << 8) | (unsigned)(255 - (pi_ * 16 + pj_))) : 0u; }
#define ALL4(EXPR) _Pragma("unroll") for (int u = 0; u < NT; ++u) { const unsigned X = z[u]; z[u] = (EXPR); }
#define CLEAN4() ALL4(cex<0x128>(X, M.lo8)) ALL4(cex4(X, M.lo4)) ALL4(cex<0x4E>(X, M.lo2)) ALL4(cex<0xB1>(X, M.lo1))
            ALL4(cex<0xB1>(X, M.lo1))
            ALL4(cex<0x1B>(X, M.lo2)) ALL4(cex<0xB1>(X, M.lo1))
            ALL4(cex<0x141>(X, M.lo4)) ALL4(cex<0x4E>(X, M.lo2)) ALL4(cex<0xB1>(X, M.lo1))
            ALL4(cex<0x140>(X, M.lo8)) ALL4(cex4(X, M.lo4)) ALL4(cex<0x4E>(X, M.lo2)) ALL4(cex<0xB1>(X, M.lo1))
            ALL4(mtop_rows(X, M)) CLEAN4()
            ALL4(mtop_halves(X, M)) CLEAN4()
#undef ALL4
#undef CLEAN4
#pragma unroll
            for (int u = 0; u < NT; ++u) { const int t = tile * 64 + F.wave * 8 + tk0 + u;
                const LAS float* tv = (const LAS float*)(WB + (tk0 + u) * 256); const LAS int* ti = (const LAS int*)(WB + (tk0 + u) * 256 + 128);
                const int cid = 255 - (int)(z[u] & 255u), bi = (F.lane < 16) ? (cid >> 4) : 0, bj = (F.lane < 16) ? (cid & 15) : 0;
                const float bv = (F.lane < 16) ? (tv[bi] + tv[16 + bj]) : -INFINITY;
                const float mx = wmax(bv); const float ev = (F.lane < 16) ? expf(bv - mx) : 0.f; const float den = wsum(ev);
                if (F.lane < 16) { const int e1 = ti[bi], e2 = ti[16 + bj];
                    EID[(size_t)t * 128 + h * 16 + F.lane] = e1 * 128 + e2; GSM[(size_t)t * 128 + h * 16 + F.lane] = ev / den; } }
            asm volatile("s_waitcnt lgkmcnt(0)" ::: "memory"); __builtin_amdgcn_wave_barrier();
        }
    }
}

constexpr int PGB = 4;
__device__ __forceinline__ void ph_peer_gather(const Args& A, Frame& F, const int L, const bool dry = false) {
    bf16* H = (bf16*)(A.ws + WS_HY); bf16* Hout = dry ? (bf16*)(A.ws + WS_BIG + 128 * MiB) : H; float* Xout = dry ? (float*)(A.ws + WS_Z) : A.out; const unsigned char* TU = A.ws + WS_BIG; const unsigned char* TV = TU + (size_t)16384 * 2048; const float* SCL = (const float*)(A.ws + WS_BIG + 64 * MiB);
    const int* EID = (const int*)(A.ws + WS_LA); const float* GSM = (const float*)(A.ws + WS_LA + 16 * MiB);
    const float* MOD = (const float*)(A.ws + WS_MOD); float* X = A.out;
    const float* lng = (const float*)A.in[21] + (size_t)(L * 2 + 1) * DM; const float* lnb = (const float*)A.in[22] + (size_t)(L * 2 + 1) * DM;
    for (int t = F.gw; t < TOK; t += F.ngw) {
        const int b = t >> 14;
        f32x2 h2[16];
#pragma unroll
        for (int j = 0; j < 2; ++j) { const u32x4 a = *(const u32x4*)(H + (size_t)t * DM + (j * 64 + F.lane) * 16), c = *(const u32x4*)(H + (size_t)t * DM + (j * 64 + F.lane) * 16 + 8);
            const unsigned aw[8] = {a.x, a.y, a.z, a.w, c.x, c.y, c.z, c.w};
#pragma unroll
            for (int q = 0; q < 8; ++q) h2[j * 8 + q] = (f32x2){lo2f(aw[q]), hi2f(aw[q])}; }
        f32x2 o2[16];
#pragma unroll
        for (int e = 0; e < 16; ++e) o2[e] = (f32x2){0.f, 0.f};
#pragma unroll 1
        for (int e0 = 0; e0 < 128; e0 += PGB) {
            int eid[PGB]; float gw[PGB], su[PGB], sv[PGB];
#pragma unroll
            for (int q = 0; q < PGB; ++q) { eid[q] = __builtin_amdgcn_readfirstlane(EID[(size_t)t * 128 + e0 + q]); gw[q] = GSM[(size_t)t * 128 + e0 + q]; su[q] = SCL[eid[q]]; sv[q] = SCL[16384 + eid[q]]; }
            u32x4 uu[PGB][2], vv[PGB][2];
#pragma unroll
            for (int q = 0; q < PGB; ++q)
#pragma unroll
                for (int j = 0; j < 2; ++j) { uu[q][j] = *(const u32x4*)(TU + (size_t)eid[q] * 2048 + (j * 64 + F.lane) * 16); vv[q][j] = *(const u32x4*)(TV + (size_t)eid[q] * 2048 + (j * 64 + F.lane) * 16); }
#pragma unroll
            for (int q = 0; q < PGB; ++q) {
                f32x2 d2 = {0.f, 0.f};
#pragma unroll
                for (int j = 0; j < 2; ++j) { const unsigned w[4] = {uu[q][j].x, uu[q][j].y, uu[q][j].z, uu[q][j].w};
#pragma unroll
                    for (int i = 0; i < 4; ++i) { const f32x2 lo = __builtin_amdgcn_cvt_pk_f32_fp8((int)w[i], false), hi = __builtin_amdgcn_cvt_pk_f32_fp8((int)w[i], true);
                        d2 = lo * h2[j * 8 + 2 * i] + d2; d2 = hi * h2[j * 8 + 2 * i + 1] + d2; } }
                const float d = wsum(d2.x + d2.y) * su[q];
                const float act = 0.5f * d * (1.0f + erff(d * 0.70710678f)) * gw[q] * sv[q];
                const f32x2 a2 = {act, act};
#pragma unroll
                for (int j = 0; j < 2; ++j) { const unsigned w[4] = {vv[q][j].x, vv[q][j].y, vv[q][j].z, vv[q][j].w};
#pragma unroll
                    for (int i = 0; i < 4; ++i) { const f32x2 lo = __builtin_amdgcn_cvt_pk_f32_fp8((int)w[i], false), hi = __builtin_amdgcn_cvt_pk_f32_fp8((int)w[i], true);
                        o2[j * 8 + 2 * i] = a2 * lo + o2[j * 8 + 2 * i]; o2[j * 8 + 2 * i + 1] = a2 * hi + o2[j * 8 + 2 * i + 1]; } }
            }
        }
        float out[32];
#pragma unroll
        for (int e = 0; e < 16; ++e) { out[2 * e] = o2[e].x; out[2 * e + 1] = o2[e].y; }
        const float* gate = MOD + (size_t)((L * 2 + 1) * 2 + b) * 6144 + 4096;
        float sum = 0.f;
#pragma unroll
        for (int j = 0; j < 2; ++j)
#pragma unroll
            for (int c = 0; c < 4; ++c) { const int base = (j * 64 + F.lane) * 16 + 4 * c;
                const f32x4 x0 = *(const f32x4*)(X + (size_t)t * DM + base), g0 = *(const f32x4*)(gate + base);
#pragma unroll
                for (int e = 0; e < 4; ++e) { const float v = ALPHA * x0[e] + (1.0f + g0[e]) * out[j * 16 + 4 * c + e]; out[j * 16 + 4 * c + e] = v; sum += v; } }
        const float mean = wsum(sum) * (1.0f / DM); float sq = 0.f;
#pragma unroll
        for (int e = 0; e < 32; ++e) { out[e] -= mean; sq += out[e] * out[e]; }
        const float rstd = rsqrtf(wsum(sq) * (1.0f / DM) + 1e-5f);
        const float* sh = MOD + (size_t)(((L + 1) * 2 + 0) * 2 + b) * 6144; const float* sc = sh + 2048;
#pragma unroll
        for (int j = 0; j < 2; ++j) {
            float hq[16];
#pragma unroll
            for (int c = 0; c < 4; ++c) { const int base = (j * 64 + F.lane) * 16 + 4 * c;
                const f32x4 lg0 = *(const f32x4*)(lng + base), lb0 = *(const f32x4*)(lnb + base);
                f32x4 o0;
#pragma unroll
                for (int e = 0; e < 4; ++e) o0[e] = out[j * 16 + 4 * c + e] * rstd * lg0[e] + lb0[e];
                *(f32x4*)(Xout + (size_t)t * DM + base) = o0;
                if (L == 0) { const f32x4 s0 = *(const f32x4*)(sc + base), h0 = *(const f32x4*)(sh + base);
#pragma unroll
                    for (int e = 0; e < 4; ++e) hq[4 * c + e] = o0[e] * (1.0f + s0[e]) + h0[e]; } }
            if (L == 0) { u32x4 w0, w1;
                w0.x = pk2(hq[0], hq[1]); w0.y = pk2(hq[2], hq[3]); w0.z = pk2(hq[4], hq[5]); w0.w = pk2(hq[6], hq[7]);
                w1.x = pk2(hq[8], hq[9]); w1.y = pk2(hq[10], hq[11]); w1.z = pk2(hq[12], hq[13]); w1.w = pk2(hq[14], hq[15]);
                *(u32x4*)(Hout + (size_t)t * DM + (j * 64 + F.lane) * 16) = w0; *(u32x4*)(Hout + (size_t)t * DM + (j * 64 + F.lane) * 16 + 8) = w1; }
        }
    }
}

struct XInfo { int rank, nloc, rx, nx; };
__device__ __forceinline__ XInfo xcc_info(volatile LAS unsigned* MISC) { XInfo x; x.rank = (int)MISC[16]; x.nloc = (int)MISC[17]; x.rx = (int)MISC[18]; x.nx = (int)MISC[19]; return x; }
constexpr size_t WS_DP = WS_BIG + 128 * MiB;
constexpr size_t WS_ACT = WS_BIG + 80 * MiB;
__device__ __forceinline__ void ph_peer_u(const Args& A, Frame& F, const XInfo X) {
    const unsigned char* H8 = A.ws + WS_H8; const unsigned char* TU = A.ws + WS_BIG; const int* EID = (const int*)(A.ws + WS_LA); float* DP = (float*)(A.ws + WS_DP);
    LAS int* IDX = (LAS int*)(F.lds + F.wave * 1024);
    const int g16 = F.lane >> 4, c16 = F.lane & 15; const int step = X.nloc * NWAVES;
    for (int s = X.rx; s < 8; s += X.nx) {
        int t = X.rank * NWAVES + F.wave;
        int e0 = 0, e1 = 0; u32x4 ha = {0u, 0u, 0u, 0u};
        if (t < TOK) { e0 = EID[(size_t)t * 128 + F.lane]; e1 = EID[(size_t)t * 128 + 64 + F.lane]; ha = *(const u32x4*)(H8 + (size_t)t * DM + 256 * s + 16 * c16); }
        const unsigned char* ub = TU + 256 * s + 16 * c16;
        while (t < TOK) {
            const int tn = t + step; int n0 = 0, n1 = 0; u32x4 na = {0u, 0u, 0u, 0u};
            if (tn < TOK) { n0 = EID[(size_t)tn * 128 + F.lane]; n1 = EID[(size_t)tn * 128 + 64 + F.lane]; na = *(const u32x4*)(H8 + (size_t)tn * DM + 256 * s + 16 * c16); }
            IDX[F.lane] = e0; IDX[F.lane + 64] = e1;
            asm volatile("s_waitcnt lgkmcnt(0)" ::: "memory"); __builtin_amdgcn_wave_barrier();
            float keep0 = 0.f, keep1 = 0.f;
#pragma unroll
            for (int i0 = 0; i0 < 32; i0 += 8) {
                u32x4 ud[8];
#pragma unroll
                for (int u = 0; u < 8; ++u) { const int eid = IDX[4 * (i0 + u) + g16]; ud[u] = *(const u32x4*)(ub + (size_t)eid * 2048); }
#pragma unroll
                for (int u = 0; u < 8; ++u) {
                    int di = __builtin_amdgcn_sdot4((int)ud[u].x, (int)ha.x, 0, false); di = __builtin_amdgcn_sdot4((int)ud[u].y, (int)ha.y, di, false);
                    di = __builtin_amdgcn_sdot4((int)ud[u].z, (int)ha.z, di, false); di = __builtin_amdgcn_sdot4((int)ud[u].w, (int)ha.w, di, false);
                    const float d = sum16_dpp((float)di);
                    const int i = i0 + u;
                    if (i < 16) keep0 = ((i & 15) == c16) ? d : keep0; else keep1 = ((i & 15) == c16) ? d : keep1;
                }
            }
            float* dp = DP + ((size_t)s * TOK + t) * 128 + 4 * c16 + g16;
            dp[0] = keep0; dp[64] = keep1;
            asm volatile("s_waitcnt lgkmcnt(0)" ::: "memory"); __builtin_amdgcn_wave_barrier();
            e0 = n0; e1 = n1; ha = na; t = tn;
        }
    }
}
__device__ __forceinline__ void ph_peer_act(const Args& A, Frame& F) {
    const float* SCL = (const float*)(A.ws + WS_BIG + 64 * MiB); const int* EID = (const int*)(A.ws + WS_LA); const float* GSM = (const float*)(A.ws + WS_LA + 16 * MiB);
    const float* DP = (const float*)(A.ws + WS_DP); unsigned char* ACT8 = A.ws + WS_ACT; float* AS = (float*)(A.ws + WS_ACT + 8 * MiB);
    int pe[2] = {0, 0};
    if (F.gw < TOK) { pe[0] = EID[(size_t)F.gw * 128 + F.lane]; pe[1] = EID[(size_t)F.gw * 128 + 64 + F.lane]; }
    for (int t = F.gw; t < TOK; t += F.ngw) { const float hs = ((const float*)(A.ws + WS_HS))[t];
        const int ce[2] = {pe[0], pe[1]};
        { const int tn = t + F.ngw; if (tn < TOK) { pe[0] = EID[(size_t)tn * 128 + F.lane]; pe[1] = EID[(size_t)tn * 128 + 64 + F.lane]; } }
        float a[2];
#pragma unroll
        for (int m = 0; m < 2; ++m) { const int e = F.lane + 64 * m; const int eid = ce[m]; float d = 0.f;
#pragma unroll
            for (int x = 0; x < 8; ++x) d += DP[((size_t)x * TOK + t) * 128 + e];
            d *= SCL[eid] * hs;
            a[m] = 0.5f * d * (1.0f + erff(d * 0.70710678f)) * GSM[(size_t)t * 128 + e] * SCL[16384 + eid]; }
        const float amax = wmax(fmaxf(fabsf(a[0]), fabsf(a[1]))); const float inv = (amax > 0.f) ? 127.0f / amax : 0.f;
#pragma unroll
        for (int m = 0; m < 2; ++m) ACT8[(size_t)t * 128 + F.lane + 64 * m] = (unsigned char)(__float_as_uint(a[m] * inv + 12582912.0f) & 255u);
        if (F.lane == 0) AS[t] = amax * (1.0f / 127.0f);
    }
}
__device__ __forceinline__ void ph_peer_v(const Args& A, Frame& F, const XInfo X) {
    const unsigned char* TV = A.ws + WS_BIG + (size_t)16384 * 2048;
    const int* EID = (const int*)(A.ws + WS_LA); const unsigned* ACT8 = (const unsigned*)(A.ws + WS_ACT); const float* AS = (const float*)(A.ws + WS_ACT + 8 * MiB); bf16* OUT = (bf16*)(A.ws + WS_Z);
    LAS int* IDX = (LAS int*)(F.lds + F.wave * 1024); LAS unsigned* ACT = (LAS unsigned*)(F.lds + F.wave * 1024 + 512);
    const int g16 = F.lane >> 4, c16 = F.lane & 15; const int step = X.nloc * NWAVES;
    for (int s = X.rx; s < 8; s += X.nx) {
        int t = X.rank * NWAVES + F.wave;
        int e0 = 0, e1 = 0; unsigned a0 = 0u;
        if (t < TOK) { e0 = EID[(size_t)t * 128 + F.lane]; e1 = EID[(size_t)t * 128 + 64 + F.lane]; a0 = ACT8[(size_t)t * 32 + (F.lane & 31)]; }
        const unsigned char* vb = TV + 256 * s + 16 * c16;
        while (t < TOK) {
            const int tn = t + step; int n0 = 0, n1 = 0; unsigned b0 = 0u;
            if (tn < TOK) { n0 = EID[(size_t)tn * 128 + F.lane]; n1 = EID[(size_t)tn * 128 + 64 + F.lane]; b0 = ACT8[(size_t)tn * 32 + (F.lane & 31)]; }
            const float as = AS[t];
            IDX[F.lane] = e0; IDX[F.lane + 64] = e1; if (F.lane < 32) ACT[F.lane] = a0;
            asm volatile("s_waitcnt lgkmcnt(0)" ::: "memory"); __builtin_amdgcn_wave_barrier();
            int acc[16];
#pragma unroll
            for (int j = 0; j < 16; ++j) acc[j] = 0;
#pragma unroll
            for (int b = 0; b < 8; b += 2) {
                u32x4 vd[2][4]; unsigned a4[2];
#pragma unroll
                for (int h = 0; h < 2; ++h) { a4[h] = ACT[4 * (b + h) + g16];
#pragma unroll
                    for (int u = 0; u < 4; ++u) { const int eid = IDX[16 * (b + h) + 4 * g16 + u]; vd[h][u] = *(const u32x4*)(vb + (size_t)eid * 2048); } }
#pragma unroll
                for (int h = 0; h < 2; ++h)
#pragma unroll
                    for (int q = 0; q < 4; ++q) { const unsigned A_ = vd[h][0][q], B_ = vd[h][1][q], C_ = vd[h][2][q], D_ = vd[h][3][q];
                        const unsigned ablo = __builtin_amdgcn_perm(B_, A_, 0x05010400u), abhi = __builtin_amdgcn_perm(B_, A_, 0x07030602u);
                        const unsigned cdlo = __builtin_amdgcn_perm(D_, C_, 0x05010400u), cdhi = __builtin_amdgcn_perm(D_, C_, 0x07030602u);
                        acc[4 * q + 0] = __builtin_amdgcn_sdot4((int)__builtin_amdgcn_perm(cdlo, ablo, 0x05040100u), (int)a4[h], acc[4 * q + 0], false);
                        acc[4 * q + 1] = __builtin_amdgcn_sdot4((int)__builtin_amdgcn_perm(cdlo, ablo, 0x07060302u), (int)a4[h], acc[4 * q + 1], false);
                        acc[4 * q + 2] = __builtin_amdgcn_sdot4((int)__builtin_amdgcn_perm(cdhi, abhi, 0x05040100u), (int)a4[h], acc[4 * q + 2], false);
                        acc[4 * q + 3] = __builtin_amdgcn_sdot4((int)__builtin_amdgcn_perm(cdhi, abhi, 0x07060302u), (int)a4[h], acc[4 * q + 3], false); }
            }
            { const float r0 = rsum4((float)acc[0], (float)acc[4], (float)acc[8], (float)acc[12]) * as, r1 = rsum4((float)acc[1], (float)acc[5], (float)acc[9], (float)acc[13]) * as;
              const float r2 = rsum4((float)acc[2], (float)acc[6], (float)acc[10], (float)acc[14]) * as, r3 = rsum4((float)acc[3], (float)acc[7], (float)acc[11], (float)acc[15]) * as;
              u32x2 w; w.x = pk2(r0, r1); w.y = pk2(r2, r3); *(u32x2*)(OUT + (size_t)t * DM + 256 * s + 16 * c16 + 4 * g16) = w; }
            asm volatile("s_waitcnt lgkmcnt(0)" ::: "memory"); __builtin_amdgcn_wave_barrier();
            e0 = n0; e1 = n1; a0 = b0; t = tn;
        }
    }
}
__device__ __forceinline__ void ph_peer_ln(const Args& A, Frame& F, const int L) {
    const bf16* OUT = (const bf16*)(A.ws + WS_Z); float* X = A.out; bf16* H = (bf16*)(A.ws + WS_HY); const float* MOD = (const float*)(A.ws + WS_MOD);
    const bf16* Xin = (L == 0) ? (const bf16*)A.out : (const bf16*)(A.ws + WS_Z + 160 * MiB); bf16* Xb = (bf16*)A.out;
    const float* lng = (const float*)A.in[21] + (size_t)(L * 2 + 1) * DM; const float* lnb = (const float*)A.in[22] + (size_t)(L * 2 + 1) * DM;
    for (int t = F.gw; t < TOK; t += F.ngw) {
        const int b = t >> 14;
        const float* gate = MOD + (size_t)((L * 2 + 1) * 2 + b) * 6144 + 4096;
        const float* sh = MOD + (size_t)(((L + 1) * 2 + 0) * 2 + b) * 6144; const float* sc = sh + 2048;
        float v[32]; float sum = 0.f;
#pragma unroll
        for (int j = 0; j < 8; ++j) { const int base = (j * 64 + F.lane) * 4;
            const u32x2 ow = *(const u32x2*)(OUT + (size_t)t * DM + base); const f32x4 o0 = {lo2f(ow.x), hi2f(ow.x), lo2f(ow.y), hi2f(ow.y)};
            const u32x2 xw = *(const u32x2*)(Xin + (size_t)t * DM + base); const f32x4 x0 = {lo2f(xw.x), hi2f(xw.x), lo2f(xw.y), hi2f(xw.y)}; const f32x4 g0 = *(const f32x4*)(gate + base);
#pragma unroll
            for (int e = 0; e < 4; ++e) { v[j * 4 + e] = ALPHA * x0[e] + (1.0f + g0[e]) * o0[e]; sum += v[j * 4 + e]; } }
        const float mean = wsum(sum) * (1.0f / DM); float sq = 0.f;
#pragma unroll
        for (int e = 0; e < 32; ++e) { v[e] -= mean; sq += v[e] * v[e]; }
        const float rstd = rsqrtf(wsum(sq) * (1.0f / DM) + 1e-5f);
#pragma unroll
        for (int j = 0; j < 8; ++j) { const int base = (j * 64 + F.lane) * 4;
            const f32x4 lg0 = *(const f32x4*)(lng + base), lb0 = *(const f32x4*)(lnb + base);
            f32x4 o0;
#pragma unroll
            for (int e = 0; e < 4; ++e) o0[e] = v[j * 4 + e] * rstd * lg0[e] + lb0[e];
            if (L == 0) { u32x2 xo; xo.x = pk2(o0[0], o0[1]); xo.y = pk2(o0[2], o0[3]); *(u32x2*)(Xb + (size_t)t * DM + base) = xo; } else *(f32x4*)(X + (size_t)t * DM + base) = o0;
            if (L == 0) { const f32x4 s0 = *(const f32x4*)(sc + base), h0 = *(const f32x4*)(sh + base); const f32x4 q0 = o0 * (1.0f + s0) + h0;
                u32x2 w; w.x = pk2(q0[0], q0[1]); w.y = pk2(q0[2], q0[3]); *(u32x2*)(H + (size_t)t * DM + base) = w; }
        }
    }
}

__device__ __forceinline__ void ph_odd_post(const Args& A, Frame& F) {
    bf16* Z = (bf16*)(A.ws + WS_Z); const int* positions = (const int*)A.in[2]; bf16* KIT = (bf16*)(A.ws + WS_BIG + 256 * MiB); unsigned char* K8 = A.ws + WS_BIG + 264 * MiB; unsigned char* V8 = A.ws + WS_BIG + 280 * MiB;
    const float inv128 = powf(10000.0f, -(float)F.lane / 64.0f); const int i32 = F.lane & 31; const float inv64 = powf(10000.0f, -(float)i32 / 32.0f);
    const int a16 = F.lane & 15, hs4 = F.lane >> 4, a8 = F.lane & 7, hs8 = F.lane >> 3;
    for (int t = F.gw; t < TOK; t += F.ngw) {
        bf16* zr = Z + (size_t)t * OD_NP; const float pos = (float)positions[t];
        const int bb = t >> 14, spos = t & (SEQ - 1);
        float sn, cs; sincosf(pos * inv128, &sn, &cs);
        float c4[4], s4[4];
#pragma unroll
        for (int e = 0; e < 4; ++e) { c4[e] = __shfl(cs, 4 * a16 + e); s4[e] = __shfl(sn, 4 * a16 + e); }
#pragma unroll
        for (int it = 0; it < 5; ++it) { const int hd = it * 4 + hs4; bf16* hp = zr + hd * 128 + 4 * a16;
            const u32x2 a = *(const u32x2*)hp, b = *(const u32x2*)(hp + 64);
            const float t1[4] = {lo2f(a.x), hi2f(a.x), lo2f(a.y), hi2f(a.y)}, t2[4] = {lo2f(b.x), hi2f(b.x), lo2f(b.y), hi2f(b.y)};
            float o1[4], o2[4];
#pragma unroll
            for (int e = 0; e < 4; ++e) { o1[e] = t1[e] * c4[e] - t2[e] * s4[e]; o2[e] = t2[e] * c4[e] + t1[e] * s4[e]; }
            *(u32x2*)hp = (u32x2){pk2(o1[0], o1[1]), pk2(o1[2], o1[3])}; *(u32x2*)(hp + 64) = (u32x2){pk2(o2[0], o2[1]), pk2(o2[2], o2[3])};
            if (it == 4) { unsigned char* k8 = K8 + ((size_t)((bb * 4 + hs4) * SEQ + spos)) * 128 + 4 * a16;
                int w1 = __builtin_amdgcn_cvt_pk_fp8_f32(o1[0] * 16.0f, o1[1] * 16.0f, 0, false); w1 = __builtin_amdgcn_cvt_pk_fp8_f32(o1[2] * 16.0f, o1[3] * 16.0f, w1, true);
                int w2 = __builtin_amdgcn_cvt_pk_fp8_f32(o2[0] * 16.0f, o2[1] * 16.0f, 0, false); w2 = __builtin_amdgcn_cvt_pk_fp8_f32(o2[2] * 16.0f, o2[3] * 16.0f, w2, true);
                *(unsigned*)k8 = (unsigned)w1; *(unsigned*)(k8 + 64) = (unsigned)w2; } }
        {
            const int e0 = F.lane * 8, kvh = e0 >> 7, d0 = e0 & 127;
            const u32x4 vw = *(const u32x4*)(zr + 2560 + e0);
            const unsigned ww[4] = {vw.x, vw.y, vw.z, vw.w}; unsigned ob[2] = {0u, 0u};
#pragma unroll
            for (int q = 0; q < 4; ++q) { const float c0 = fminf(fmaxf(lo2f(ww[q]) * 16.0f, -127.0f), 127.0f), c1 = fminf(fmaxf(hi2f(ww[q]) * 16.0f, -127.0f), 127.0f);
                const unsigned b0 = __float_as_uint(c0 + 12583040.0f) & 255u, b1 = __float_as_uint(c1 + 12583040.0f) & 255u;
                ob[q >> 1] |= (b0 | (b1 << 8)) << (16 * (q & 1)); }
            *(u32x2*)(V8 + ((size_t)((bb * 4 + kvh) * SEQ + spos)) * 128 + d0) = (u32x2){ob[0], ob[1]};
        }
        sincosf(pos * inv64, &sn, &cs);
#pragma unroll
        for (int e = 0; e < 4; ++e) { c4[e] = __shfl(cs, 4 * a8 + e); s4[e] = __shfl(sn, 4 * a8 + e); }
#pragma unroll
        for (int it = 0; it < 3; ++it) { const int hd = it * 8 + hs8; if (hd < 17) { bf16* hp = zr + 3072 + hd * 64 + 4 * a8;
            const u32x2 a = *(const u32x2*)hp, b = *(const u32x2*)(hp + 32);
            const float t1[4] = {lo2f(a.x), hi2f(a.x), lo2f(a.y), hi2f(a.y)}, t2[4] = {lo2f(b.x), hi2f(b.x), lo2f(b.y), hi2f(b.y)};
            float o1[4], o2[4];
#pragma unroll
            for (int e = 0; e < 4; ++e) { o1[e] = t1[e] * c4[e] - t2[e] * s4[e]; o2[e] = t2[e] * c4[e] + t1[e] * s4[e]; }
            const u32x2 w1 = {pk2(o1[0], o1[1]), pk2(o1[2], o1[3])}, w2 = {pk2(o2[0], o2[1]), pk2(o2[2], o2[3])};
            *(u32x2*)hp = w1; *(u32x2*)(hp + 32) = w2;
            if (hd == 16) {
                const int tile = spos >> 5, rr = spos & 31;
                bf16* kt = KIT + ((size_t)(bb * 512 + tile) * 4) * 512;
                const int d1 = 4 * a8, d2 = 32 + 4 * a8;
                *(u32x2*)(kt + ((d1 >> 4) * 64 + rr + 32 * ((d1 >> 3) & 1)) * 8 + (d1 & 7)) = w1;
                *(u32x2*)(kt + ((d2 >> 4) * 64 + rr + 32 * ((d2 >> 3) & 1)) * 8 + (d2 & 7)) = w2;
            } } }
    }
}

template <int CTRL, int RM> __device__ __forceinline__ unsigned dppu(unsigned old, unsigned v) { return (unsigned)__builtin_amdgcn_update_dpp((int)old, (int)v, CTRL, RM, 0xF, false); }
__device__ __forceinline__ void ph_dsa_select(const Args& A, Frame& F, const int mode = 0) {
    const bf16* Z = (const bf16*)(A.ws + WS_Z); unsigned short* SEL = (unsigned short*)(A.ws + WS_LA); int* CNT = (int*)(A.ws + WS_CNT); const bf16* KIT = (const bf16*)(A.ws + WS_BIG + 256 * MiB);
    LAS unsigned short* SC = (LAS unsigned short*)F.lds;
    LAS unsigned* LST = (LAS unsigned*)(F.lds + 131072);
    LAS unsigned* hist = (LAS unsigned*)(F.lds + 131072 + 16384);
    LAS unsigned* hist1 = (LAS unsigned*)(F.lds + 152576);
    LAS unsigned* res = (LAS unsigned*)(F.lds + 131072 + 16384 + 2048);
    LAS int* wtot = (LAS int*)(F.lds + 131072 + 16384 + 2048 + 64);
    const int r = F.lane & 31, hg = F.lane >> 5, tk = (r >> 2) & 1, hh = (r & 3) + 4 * (r >> 3);
    const int grp = F.wave >> 2, ltid = F.tid & 255, lw = F.wave & 3;
    LAS bf16* QPRE = (LAS bf16*)(F.lds + 154624);
    u32x4 pq_q = {0u, 0u, 0u, 0u}, pq_w = {0u, 0u, 0u, 0u};
#define DS_LOAD(qd_) do { pq_q = *(const u32x4*)(Z + (size_t)(4 * (qd_) + (F.tid >> 7)) * OD_NP + 3072 + 8 * (F.tid & 127)); \
        if (F.tid < 8) pq_w = *(const u32x4*)(Z + (size_t)(4 * (qd_) + (F.tid >> 1)) * OD_NP + 4160 + 8 * (F.tid & 1)); } while (0)
#define DS_STAGE() do { *(LAS u32x4*)(QPRE + 8 * F.tid) = pq_q; if (F.tid < 8) *(LAS u32x4*)(QPRE + 4096 + 8 * F.tid) = pq_w; } while (0)
    if (F.bx < TOK / 4) { DS_LOAD(F.bx); DS_STAGE(); }
    for (int qd = F.bx; qd < TOK / 4; qd += F.G) {
        const int t0 = 4 * qd, b = t0 >> 14, s0 = t0 & (SEQ - 1);
        const int nkeys = s0 + 4, ntiles = (nkeys + 31) >> 5;
        __syncthreads();
        bf16x8 af[2][4]; f32x2 wv[2][8];
#pragma unroll
        for (int a = 0; a < 2; ++a) {
            const LAS bf16* qrow = QPRE + ((2 * a + tk) * 16 + hh) * 64 + 8 * hg;
#pragma unroll
            for (int s = 0; s < 4; ++s) af[a][s] = *(const LAS bf16x8*)(qrow + 16 * s);
            const LAS bf16* wrow = QPRE + 4096 + (2 * a + hg) * 16;
            const u32x4 w0 = *(const LAS u32x4*)(wrow), w1 = *(const LAS u32x4*)(wrow + 8);
            const unsigned ww[8] = {w0.x, w0.y, w0.z, w0.w, w1.x, w1.y, w1.z, w1.w};
#pragma unroll
            for (int q = 0; q < 8; ++q) wv[a][q] = (f32x2){lo2f(ww[q]) * 0.03125f, hi2f(ww[q]) * 0.03125f};
        }
        const bf16* kbase = KIT + (size_t)b * 512 * 2048 + F.lane * 8;
        if (mode != 2) {
            bf16x8 bcur[2][4];
#define DSA_LOAD1(dst, q_, tb_) do { const int tile = ((tb_) + (q_) < ntiles) ? ((tb_) + (q_)) : (ntiles - 1); const bf16* krow = kbase + (size_t)tile * 2048; \
                _Pragma("unroll") for (int s_ = 0; s_ < 4; ++s_) dst[q_][s_] = *(const bf16x8*)(krow + 512 * s_); } while (0)
#define DSA_MM(accv, src, q_, a_) do { _Pragma("unroll") for (int e = 0; e < 16; ++e) accv[e] = 0.f; \
                _Pragma("unroll") for (int s_ = 0; s_ < 4; ++s_) accv = __builtin_amdgcn_mfma_f32_32x32x16_bf16(af[a_][s_], src[q_][s_], accv, 0, 0, 0); } while (0)
#define DSA_EPI(accv, tb_, q_, a_) do { f32x2 s2_ = {0.f, 0.f}; _Pragma("unroll") for (int e = 0; e < 8; ++e) { \
                    const float x0_ = accv[2 * e], x1_ = accv[2 * e + 1]; const int r0_ = __builtin_bit_cast(int, x0_), r1_ = __builtin_bit_cast(int, x1_);        \
                    const f32x2 rl_ = {__builtin_bit_cast(float, r0_ > 0 ? r0_ : 0), __builtin_bit_cast(float, r1_ > 0 ? r1_ : 0)}; s2_ = rl_ * wv[a_][e] + s2_; } \
                float sc_ = s2_.x + s2_.y; const int key = ((tb_) + (q_)) * 32 + r; sc_ = fminf(fmaxf(sc_, -7.999f), 7.999f); const unsigned fx = (unsigned)((int)rintf(sc_ * 4096.0f) + (1 << 15)); \
                if ((tb_) + (q_) < ntiles) SC[(2 * (a_) + hg) * 16384 + key] = (unsigned short)((key <= s0 + 2 * (a_) + hg) ? fx : 0u); } while (0)
            int tb = F.wave * 2;
            if (tb < ntiles) {
                DSA_LOAD1(bcur, 0, tb); DSA_LOAD1(bcur, 1, tb);
                for (; tb < ntiles; tb += NWAVES * 2) {
                    f32x16 accA, accB;
                    DSA_MM(accA, bcur, 0, 0); DSA_MM(accB, bcur, 0, 1);
                    DSA_LOAD1(bcur, 0, tb + NWAVES * 2);
                    DSA_EPI(accA, tb, 0, 0); DSA_MM(accA, bcur, 1, 0); DSA_EPI(accB, tb, 0, 1); DSA_MM(accB, bcur, 1, 1);
                    DSA_LOAD1(bcur, 1, tb + NWAVES * 2);
                    DSA_EPI(accA, tb, 1, 0); DSA_EPI(accB, tb, 1, 1);
                }
            }
#undef DSA_LOAD1
#undef DSA_MM
#undef DSA_EPI
        }
        __syncthreads();
        const int qdn = qd + F.G; if (qdn < TOK / 4) DS_LOAD(qdn);
        if (mode == 1) { if (qdn < TOK / 4) DS_STAGE(); continue; }
#pragma unroll 1
        for (int rd = 0; rd < 2; ++rd) {
        const int tok = 2 * rd + grp;
        const int n = s0 + tok + 1; unsigned k = (unsigned)(n < 256 ? n : 256); unsigned prefix = 0u;
        const LAS unsigned short* sc = SC + tok * 16384;
        hist[grp * 256 + ltid] = 0u; hist1[grp * 256 + ltid] = 0u;
        unsigned kreg[64];
#pragma unroll
        for (int j = 0; j < 64; ++j) { const int i = ltid + 256 * j; kreg[j] = (i < n) ? (unsigned)sc[i] : 0u; }
        unsigned lmax = 0u;
#pragma unroll
        for (int j = 0; j < 64; ++j) lmax = (kreg[j] > lmax) ? kreg[j] : lmax;
        unsigned wmin = lmax;
        { unsigned x_;
          x_ = dppu<0xB1, 0xF>(wmin, wmin); wmin = x_ < wmin ? x_ : wmin; x_ = dppu<0x4E, 0xF>(wmin, wmin); wmin = x_ < wmin ? x_ : wmin;
          x_ = dppu<0x141, 0xF>(wmin, wmin); wmin = x_ < wmin ? x_ : wmin; x_ = dppu<0x140, 0xF>(wmin, wmin); wmin = x_ < wmin ? x_ : wmin;
          x_ = dppu<0x142, 0xA>(wmin, wmin); wmin = x_ < wmin ? x_ : wmin; x_ = dppu<0x143, 0xC>(wmin, wmin); wmin = x_ < wmin ? x_ : wmin; }
        if (F.lane == 63) wtot[16 + F.wave] = (int)wmin;
        __syncthreads();
        unsigned lbound = 0xFFFFFFFFu;
#pragma unroll
        for (int w = 0; w < 4; ++w) { const unsigned x = (unsigned)wtot[16 + grp * 4 + w]; lbound = x < lbound ? x : lbound; }
        LAS unsigned* seg = LST + (grp * 4 + lw) * 512; int ccnt = 0;
        {
            const unsigned lb1 = lbound > 1u ? lbound : 1u;
#pragma unroll
            for (int j = 0; j < 64; ++j) { if (256 * j < n) { const bool c = kreg[j] >= lb1; const unsigned long long m = __ballot(c);
                const int pos = ccnt + (int)__builtin_amdgcn_mbcnt_hi((unsigned)(m >> 32), __builtin_amdgcn_mbcnt_lo((unsigned)m, 0u));
                if (c && pos < 512) seg[pos] = (kreg[j] << 16) | (unsigned)(ltid + 256 * j); ccnt += __popcll(m); } }
        }
        const bool fast = ccnt <= 512;
        asm volatile("s_waitcnt lgkmcnt(0)" ::: "memory"); __builtin_amdgcn_wave_barrier();
#pragma unroll 1
        for (int pass = 0; pass < 2; ++pass) {
            const int shift = 8 - 8 * pass;
            LAS unsigned* hs = (pass == 0 ? hist : hist1) + grp * 256;
            if (fast) {
#pragma unroll
                for (int i = 0; i < 8; ++i) { if (64 * i < ccnt) { const int c_ = F.lane + 64 * i; const bool valid = c_ < ccnt; const unsigned kv = valid ? (seg[c_] >> 16) : 0u;
                    const bool match = (pass == 0) ? true : ((kv >> 8) == prefix);
                    if (valid && match) (void)__hip_atomic_fetch_add(&hs[(kv >> shift) & 255u], 1u, __ATOMIC_RELAXED, __HIP_MEMORY_SCOPE_WORKGROUP); } }
            } else {
#pragma unroll
                for (int j = 0; j < 64; ++j) { if (256 * j < n) { const unsigned kv = kreg[j]; const bool valid = ((ltid + 256 * j) < n) && (kv >= lbound);
                    const bool match = (pass == 0) ? true : ((kv >> 8) == prefix);
                    if (valid && match) (void)__hip_atomic_fetch_add(&hs[(kv >> shift) & 255u], 1u, __ATOMIC_RELAXED, __HIP_MEMORY_SCOPE_WORKGROUP); } }
            }
            __syncthreads();
            if (lw == 0) {
                const unsigned c0 = hs[4 * F.lane], c1 = hs[4 * F.lane + 1], c2 = hs[4 * F.lane + 2], c3 = hs[4 * F.lane + 3];
                const unsigned tot = c0 + c1 + c2 + c3; unsigned pre = tot;
                pre += dppu<0x111, 0xF>(0u, pre); pre += dppu<0x112, 0xF>(0u, pre); pre += dppu<0x114, 0xF>(0u, pre); pre += dppu<0x118, 0xF>(0u, pre);
                pre += dppu<0x142, 0xA>(0u, pre); pre += dppu<0x143, 0xC>(0u, pre);
                const unsigned total = (unsigned)__builtin_amdgcn_readlane((int)pre, 63); const unsigned suf = total - pre + tot;
                unsigned above = suf - tot;
                if (above < k && k <= suf) {
                    int bin;
                    if (above + c3 >= k) { bin = 3; } else { above += c3; if (above + c2 >= k) { bin = 2; } else { above += c2; if (above + c1 >= k) { bin = 1; } else { above += c1; bin = 0; } } }
                    res[grp * 2 + 0] = (unsigned)(4 * F.lane + bin); res[grp * 2 + 1] = k - above;
                }
            }
            __syncthreads();
            prefix = (prefix << 8) | res[grp * 2 + 0]; k = res[grp * 2 + 1];
        }
        const unsigned tau = prefix; const int krem = (int)k;
#define MBCNT(m_) ((int)__builtin_amdgcn_mbcnt_hi((unsigned)((m_) >> 32), __builtin_amdgcn_mbcnt_lo((unsigned)(m_), 0u)))
        int cgW = 0, ceW = 0;
        if (fast) {
#pragma unroll
            for (int i = 0; i < 8; ++i) { if (64 * i < ccnt) { const int c_ = F.lane + 64 * i; const bool valid = c_ < ccnt; const unsigned kv = valid ? (seg[c_] >> 16) : 0u;
                cgW += __popcll(__ballot(valid && kv > tau)); ceW += __popcll(__ballot(valid && kv == tau)); } }
        } else {
#pragma unroll
            for (int j = 0; j < 64; ++j) { if (256 * j < n) { const bool valid = (ltid + 256 * j) < n; const unsigned kv = kreg[j];
                cgW += __popcll(__ballot(valid && kv > tau)); ceW += __popcll(__ballot(valid && kv == tau)); } }
        }
        if (F.lane == 0) { wtot[F.wave * 2] = cgW; wtot[F.wave * 2 + 1] = ceW; }
        __syncthreads();
        int og = 0, oe = 0, totg = 0;
        for (int w = 0; w < 4; ++w) { const int a = wtot[(grp * 4 + w) * 2], e = wtot[(grp * 4 + w) * 2 + 1]; if (w < lw) { og += a; oe += e; } totg += a; }
        LAS unsigned short* sel = (LAS unsigned short*)(F.lds + 151552) + grp * 256;
        if (fast) {
#pragma unroll
            for (int i = 0; i < 8; ++i) { if (64 * i < ccnt) { const int c_ = F.lane + 64 * i; const bool valid = c_ < ccnt; const unsigned pk = valid ? seg[c_] : 0u; const unsigned kv = pk >> 16;
                const bool gt = valid && kv > tau, eq = valid && kv == tau; const unsigned long long mg = __ballot(gt), me = __ballot(eq);
                const int pg = og + MBCNT(mg), pe = oe + MBCNT(me);
                if (gt) sel[pg] = (unsigned short)(pk & 0xffffu); else if (eq && pe < krem) sel[totg + pe] = (unsigned short)(pk & 0xffffu);
                og += __popcll(mg); oe += __popcll(me); } }
        } else {
#pragma unroll
            for (int j = 0; j < 64; ++j) { if (256 * j < n) { const int i = ltid + 256 * j; const bool valid = i < n; const unsigned kv = kreg[j];
                const bool gt = valid && kv > tau, eq = valid && kv == tau; const unsigned long long mg = __ballot(gt), me = __ballot(eq);
                const int pg = og + MBCNT(mg), pe = oe + MBCNT(me);
                if (gt) sel[pg] = (unsigned short)i; else if (eq && pe < krem) sel[totg + pe] = (unsigned short)i;
                og += __popcll(mg); oe += __popcll(me); } }
        }
#undef MBCNT
        if (ltid == 0) CNT[t0 + tok] = (n < 256 ? n : 256);
        __syncthreads();
        if (ltid < 128) { int lt2 = ltid; asm volatile("" : "+v"(lt2));
            ((unsigned*)SEL)[(size_t)(t0 + 2 * rd + grp) * 128 + lt2] = ((const LAS unsigned*)(F.lds + 151552))[grp * 128 + lt2]; }
        }
        if (qdn < TOK / 4) DS_STAGE();
    }
#undef DS_LOAD
#undef DS_STAGE
}

__device__ __forceinline__ float sum8_dpp(float v) { v += dppf<0xB1, 0xF>(v); v += dppf<0x4E, 0xF>(v); v += dppf<0x141, 0xF>(v); return v; }
__device__ __forceinline__ void ph_dsa_attn(const Args& A, Frame& F, const XInfo X) {
    const bf16* Z = (const bf16*)(A.ws + WS_Z); const unsigned short* SEL = (const unsigned short*)(A.ws + WS_LA); const int* CNT = (const int*)(A.ws + WS_CNT);
    const unsigned char* K8 = A.ws + WS_BIG + 264 * MiB; const unsigned char* V8 = A.ws + WS_BIG + 280 * MiB; bf16* Y = (bf16*)(A.ws + WS_HY);
    LAS int* IDX = (LAS int*)(F.lds + F.wave * 5120);
    LAS float* SCR = (LAS float*)(F.lds + F.wave * 5120 + 1024);
    const int g8 = F.lane >> 3, c8 = F.lane & 7;
    for (int sl = X.rx; sl < 8; sl += X.nx) {
        const int b = sl >> 2, kvh = sl & 3;
        const unsigned char* kb = K8 + (size_t)sl * SEQ * 128 + 16 * c8; const unsigned char* vb = V8 + (size_t)sl * SEQ * 128 + 16 * c8;
        const int l15 = F.lane & 15, g4 = F.lane >> 4;
        int pf_n = 0; unsigned pf_sel[4] = {0u, 0u, 0u, 0u}; u32x4 pf_qa[2], pf_qb[2];
#pragma unroll
        for (int c = 0; c < 2; ++c) { pf_qa[c] = (u32x4){0u, 0u, 0u, 0u}; pf_qb[c] = (u32x4){0u, 0u, 0u, 0u}; }
#define AT_LOAD(sq_) do { const int t_ = b * SEQ + (sq_); pf_n = CNT[t_]; \
            _Pragma("unroll") for (int m = 0; m < 4; ++m) pf_sel[m] = (unsigned)SEL[(size_t)t_ * 256 + F.lane + 64 * m]; \
            if (l15 < 4) { _Pragma("unroll") for (int c = 0; c < 2; ++c) { const bf16* qp = Z + (size_t)t_ * OD_NP + (kvh * 4 + l15) * 128 + 64 * c + 16 * g4; pf_qa[c] = *(const u32x4*)qp; pf_qb[c] = *(const u32x4*)(qp + 8); } } } while (0)
        { const int sq0 = X.rank * NWAVES + F.wave; if (sq0 < SEQ) AT_LOAD(sq0); }
        for (int sq = X.rank * NWAVES + F.wave; sq < SEQ; sq += X.nloc * NWAVES) {
            const int t = b * SEQ + sq; const int n = pf_n;
            const unsigned csel[4] = {pf_sel[0], pf_sel[1], pf_sel[2], pf_sel[3]}; const u32x4 cqa[2] = {pf_qa[0], pf_qa[1]}, cqb[2] = {pf_qb[0], pf_qb[1]};
            { const int sqn = sq + X.nloc * NWAVES; if (sqn < SEQ) AT_LOAD(sqn); }
            long bq[4];
#pragma unroll
            for (int c = 0; c < 2; ++c) {
                float f[16];
#pragma unroll
                for (int e = 0; e < 16; ++e) f[e] = 0.f;
                if (l15 < 4) { const u32x4 a = cqa[c], b2 = cqb[c];
                    const unsigned aw[8] = {a.x, a.y, a.z, a.w, b2.x, b2.y, b2.z, b2.w};
#pragma unroll
                    for (int q = 0; q < 8; ++q) { f[2 * q] = lo2f(aw[q]) * 16.0f; f[2 * q + 1] = hi2f(aw[q]) * 16.0f; } }
#pragma unroll
                for (int hf = 0; hf < 2; ++hf) {
                    int lo = __builtin_amdgcn_cvt_pk_fp8_f32(f[8 * hf + 0], f[8 * hf + 1], 0, false); lo = __builtin_amdgcn_cvt_pk_fp8_f32(f[8 * hf + 2], f[8 * hf + 3], lo, true);
                    int hi = __builtin_amdgcn_cvt_pk_fp8_f32(f[8 * hf + 4], f[8 * hf + 5], 0, false); hi = __builtin_amdgcn_cvt_pk_fp8_f32(f[8 * hf + 6], f[8 * hf + 7], hi, true);
                    bq[2 * c + hf] = (long)(((unsigned long long)(unsigned)hi << 32) | (unsigned long long)(unsigned)lo); }
            }
#pragma unroll
            for (int m = 0; m < 4; ++m) { const int jj = F.lane + 64 * m; IDX[jj] = (jj < n) ? (int)csel[m] : 0; }
            asm volatile("s_waitcnt lgkmcnt(0)" ::: "memory"); __builtin_amdgcn_wave_barrier();
            {
                const unsigned char* kq = K8 + (size_t)sl * SEQ * 128 + 16 * g4;
#pragma unroll 1
                for (int tl0 = 0; tl0 < 16; tl0 += 4) {
                    u32x4 k0[4], k1[4];
#pragma unroll
                    for (int u = 0; u < 4; ++u) { const int id = IDX[(tl0 + u) * 16 + l15]; const unsigned char* kr = kq + (size_t)id * 128; k0[u] = *(const u32x4*)kr; k1[u] = *(const u32x4*)(kr + 64); }
#pragma unroll
                    for (int u = 0; u < 4; ++u) {
                        f32x4 acc = {0.f, 0.f, 0.f, 0.f};
                        acc = __builtin_amdgcn_mfma_f32_16x16x32_fp8_fp8((long)(((unsigned long long)k0[u].y << 32) | k0[u].x), bq[0], acc, 0, 0, 0);
                        acc = __builtin_amdgcn_mfma_f32_16x16x32_fp8_fp8((long)(((unsigned long long)k0[u].w << 32) | k0[u].z), bq[1], acc, 0, 0, 0);
                        acc = __builtin_amdgcn_mfma_f32_16x16x32_fp8_fp8((long)(((unsigned long long)k1[u].y << 32) | k1[u].x), bq[2], acc, 0, 0, 0);
                        acc = __builtin_amdgcn_mfma_f32_16x16x32_fp8_fp8((long)(((unsigned long long)k1[u].w << 32) | k1[u].z), bq[3], acc, 0, 0, 0);
                        if (l15 < 4) {
#pragma unroll
                            for (int rg = 0; rg < 4; ++rg) SCR[((tl0 + u) * 16 + 4 * g4 + rg) * 4 + l15] = acc[rg] * 3.452669831e-4f; }
                    }
                }
            }
            asm volatile("s_waitcnt lgkmcnt(0)" ::: "memory"); __builtin_amdgcn_wave_barrier();
            float sclh[4], offh[4];
            {
                f32x4 sv[4]; unsigned pqb[4][4];
#pragma unroll
                for (int m = 0; m < 4; ++m) sv[m] = *(const LAS f32x4*)(SCR + (F.lane + 64 * m) * 4);
#pragma unroll
                for (int g = 0; g < 4; ++g) {
                    float mx = -INFINITY;
#pragma unroll
                    for (int m = 0; m < 4; ++m) { const bool val = (F.lane + 64 * m) < n; sv[m][g] = val ? sv[m][g] : -INFINITY; mx = fmaxf(mx, sv[m][g]); }
                    mx = wmax(mx); float sm = 0.f, sq = 0.f;
#pragma unroll
                    for (int m = 0; m < 4; ++m) { const bool val = (F.lane + 64 * m) < n; const float ex = val ? expf(sv[m][g] - mx) : 0.f; sm += ex;
                        const float pf = rintf(255.0f * ex); sq += pf; pqb[m][g] = (unsigned)pf; }
                    sclh[g] = 0.0625f / (255.0f * wsum(sm)); offh[g] = 128.0f * wsum(sq);
                }
                asm volatile("s_waitcnt lgkmcnt(0)" ::: "memory"); __builtin_amdgcn_wave_barrier();
#pragma unroll
                for (int m = 0; m < 4; ++m) { const int jj = F.lane + 64 * m;
#pragma unroll
                    for (int g = 0; g < 4; ++g) ((LAS unsigned char*)SCR)[(jj >> 2) * 16 + g * 4 + (jj & 3)] = (unsigned char)pqb[m][g]; }
            }
            asm volatile("s_waitcnt lgkmcnt(0)" ::: "memory"); __builtin_amdgcn_wave_barrier();
            unsigned acc[4][16];
#pragma unroll
            for (int g = 0; g < 4; ++g)
#pragma unroll
                for (int j = 0; j < 16; ++j) acc[g][j] = 0u;
#pragma unroll 1
            for (int ib = 0; ib < 8; ib += 2) {
                u32x4 vd[2][4], pq4[2];
#pragma unroll
                for (int h = 0; h < 2; ++h) { pq4[h] = *(const LAS u32x4*)((const LAS unsigned char*)SCR + (8 * (ib + h) + g8) * 16);
#pragma unroll
                    for (int u = 0; u < 4; ++u) { const int id = IDX[32 * (ib + h) + 4 * g8 + u]; vd[h][u] = *(const u32x4*)(vb + (size_t)id * 128); } }
#pragma unroll
                for (int h = 0; h < 2; ++h)
#pragma unroll
                    for (int q = 0; q < 4; ++q) { const unsigned A_ = vd[h][0][q], B_ = vd[h][1][q], C_ = vd[h][2][q], D_ = vd[h][3][q];
                        const unsigned ablo = __builtin_amdgcn_perm(B_, A_, 0x05010400u), abhi = __builtin_amdgcn_perm(B_, A_, 0x07030602u);
                        const unsigned cdlo = __builtin_amdgcn_perm(D_, C_, 0x05010400u), cdhi = __builtin_amdgcn_perm(D_, C_, 0x07030602u);
                        const unsigned t0 = __builtin_amdgcn_perm(cdlo, ablo, 0x05040100u), t1 = __builtin_amdgcn_perm(cdlo, ablo, 0x07060302u);
                        const unsigned t2 = __builtin_amdgcn_perm(cdhi, abhi, 0x05040100u), t3 = __builtin_amdgcn_perm(cdhi, abhi, 0x07060302u);
#pragma unroll
                        for (int g = 0; g < 4; ++g) { const unsigned pg = pq4[h][g];
                            acc[g][4 * q + 0] = __builtin_amdgcn_udot4(t0, pg, acc[g][4 * q + 0], false); acc[g][4 * q + 1] = __builtin_amdgcn_udot4(t1, pg, acc[g][4 * q + 1], false);
                            acc[g][4 * q + 2] = __builtin_amdgcn_udot4(t2, pg, acc[g][4 * q + 2], false); acc[g][4 * q + 3] = __builtin_amdgcn_udot4(t3, pg, acc[g][4 * q + 3], false); } }
            }
            f32x2 mine[8];
            { const int hr = F.lane >> 4; const float scl = (hr == 0) ? sclh[0] : ((hr == 1) ? sclh[1] : ((hr == 2) ? sclh[2] : sclh[3])), off = (hr == 0) ? offh[0] : ((hr == 1) ? offh[1] : ((hr == 2) ? offh[2] : offh[3]));
#pragma unroll
              for (int q = 0; q < 8; ++q) {
                float x[4][2];
#pragma unroll
                for (int g = 0; g < 4; ++g) { float a0 = (float)acc[g][2 * q], a1 = (float)acc[g][2 * q + 1];
                    a0 += dppf<0x128, 0xF>(a0); a1 += dppf<0x128, 0xF>(a1);
                    x[g][0] = a0; x[g][1] = a1; }
                mine[q].x = (rsum4(x[0][0], x[1][0], x[2][0], x[3][0]) - off) * scl; mine[q].y = (rsum4(x[0][1], x[1][1], x[2][1], x[3][1]) - off) * scl;
              } }
            if ((F.lane & 8) == 0) { u32x4 w0, w1; const int hrow = F.lane >> 4;
                w0.x = pk2(mine[0].x, mine[0].y); w0.y = pk2(mine[1].x, mine[1].y); w0.z = pk2(mine[2].x, mine[2].y); w0.w = pk2(mine[3].x, mine[3].y);
                w1.x = pk2(mine[4].x, mine[4].y); w1.y = pk2(mine[5].x, mine[5].y); w1.z = pk2(mine[6].x, mine[6].y); w1.w = pk2(mine[7].x, mine[7].y);
                bf16* yp = Y + (size_t)t * DM + (kvh * 4 + hrow) * 128 + 16 * c8; *(u32x4*)yp = w0; *(u32x4*)(yp + 8) = w1; }
            asm volatile("s_waitcnt lgkmcnt(0)" ::: "memory"); __builtin_amdgcn_wave_barrier();
        }
    }
}

__global__ void __launch_bounds__(NTHREADS, 2) mk_fwd(Args args) {
    extern __shared__ __attribute__((aligned(16))) unsigned char lds[];
    Frame F;
    F.lds = (LAS unsigned char*)lds;
    volatile LAS unsigned* MISC = (volatile LAS unsigned*)(F.lds + MISC_OFF);
    F.tid = threadIdx.x; F.lane = F.tid & 63; F.wave = __builtin_amdgcn_readfirstlane(F.tid >> 6);
    F.bx = blockIdx.x; F.G = gridDim.x; F.gw = F.bx * NWAVES + F.wave; F.ngw = F.G * NWAVES;
    if (F.tid < 64) MISC[F.tid] = 0u;
    __syncthreads();
    unsigned char* ws = args.ws;
    XcdBarrier bar = xcd_barrier_post((unsigned*)(ws + WS_CTL) + CW_BAR, MISC + 8);
    if (F.tid == 0) { MISC[16] = xb_add((unsigned*)(ws + WS_CTL) + CW_XRANK + 64 * bar.x, 1u); }
    const int lo = args.ph_lo, hi = args.ph_hi;
#define IN(k) (lo <= (k) && (k) < hi)
#define SEAM(k) do { if (IN((k) + 1)) xcd_barrier(bar); } while (0)
#define GEMM_BF16(Aptr, Bptr, Nn, Kk, Optr, ldo) do { pg8::Gemm g{(const pg8::bf16_t*)(Aptr), (const pg8::bf16_t*)(Bptr), TOK, (Nn), (Kk)}; pg8::StaticOrder S; S.init(TOK, (Nn), F.G, F.bx); \
        pg8::EpiBf16<0> E{(pg8::bf16_t*)(Optr), (ldo), nullptr, 0, 0}; pg8::gemm_phase<pg8::EpiBf16<0>, pg8::StaticOrder, false>(F.lds, g, S, E, nullptr); } while (0)

#ifndef PROBE_MASK
#define PROBE_MASK 0
#endif
#define PRB(bit, stmt) do { if (PROBE_MASK & (1 << (bit))) { stmt; xcd_barrier(bar); } } while (0)
    if (IN(0)) { PRB(14, ph_prologue(args, F)); ph_prologue(args, F); SEAM(0); }
    if (IN(1)) { ph_mod_x(args, F); SEAM(1); }
    if (F.tid == 0) {
        unsigned* cb = (unsigned*)(ws + WS_CTL) + CW_BAR; unsigned nloc = 1u, rx = 0u, nx = 0u;
        for (unsigned j = 0; j < 16; ++j) { const unsigned c = xb_ld(&cb[XB_XCNT(j)]); if (c > 0u) { if (j < bar.x) ++rx; ++nx; } if (j == bar.x) nloc = c > 0u ? c : 1u; }
        if (nx == 0u) nx = 1u;
        MISC[17] = nloc; MISC[18] = rx; MISC[19] = nx; }
    __syncthreads();
    const XInfo XI = xcc_info(MISC);
    if (IN(2)) { PRB(8, GEMM_BF16(ws + WS_HY, ws + WS_WINE, EV_NP, 2048, ws + WS_Z, EV_NP)); GEMM_BF16(ws + WS_HY, ws + WS_WINE, EV_NP, 2048, ws + WS_Z, EV_NP); SEAM(2); }
    if (IN(3)) { ph_even_post(args, F); SEAM(3); }
    if (IN(4)) { pg8::Gemm g{(const pg8::bf16_t*)(ws + WS_LA), (const pg8::bf16_t*)(ws + WS_WL), TOK, 3072, 512}; pg8::StaticOrder S; S.init(TOK, 3072, F.G, F.bx);
                 EpiLora E{(pg8::bf16_t*)(ws + WS_Z) + 1280, EV_NP, (const float*)args.in[7], (const float*)args.in[9]};
                 pg8::gemm_phase<EpiLora, pg8::StaticOrder, false>(F.lds, g, S, E, nullptr); SEAM(4); }
    if (IN(5)) { PRB(9, ph_scan_prep(args, F)); ph_scan_prep(args, F); xcd_barrier(bar); }
    if (IN(7)) { PRB(15, scan_mfma_rows(args, F)); ph_swa_mfma(args, F); scan_mfma_rows(args, F); SEAM(7); }
    if (IN(8)) { PRB(10, ph_rwkv_finish(args, F)); ph_rwkv_finish(args, F); SEAM(8); }
    if (IN(9)) { GEMM_BF16(ws + WS_HY, ws + WS_WOUTE, 2048, 2048, ws + WS_Z, 2048); SEAM(9); }
    if (IN(10)) { PRB(11, ph_ln_mixer(args, F, 0)); ph_ln_mixer(args, F, 0); SEAM(10); }
    if (IN(11)) { GEMM_BF16(ws + WS_HY, ws + WS_WQ0, 2048, 2048, ws + WS_Z, 2048); SEAM(11); }
    if (IN(12)) { PRB(4, ph_peer_select(args, F, 0)); ph_peer_select(args, F, 0); SEAM(12); }
    if (IN(13)) { PRB(12, ph_peer_u(args, F, XI)); ph_peer_u(args, F, XI); xcd_barrier(bar); ph_peer_act(args, F); xcd_barrier(bar); PRB(13, ph_peer_v(args, F, XI)); ph_peer_v(args, F, XI); xcd_barrier(bar); ph_peer_ln(args, F, 0); SEAM(13); }
    if (IN(14)) { GEMM_BF16(ws + WS_HY, ws + WS_WINO, OD_NP, 2048, ws + WS_Z, OD_NP); SEAM(14); }
    if (IN(15)) { ph_odd_post(args, F); SEAM(15); }
    if (IN(16)) { PRB(2, ph_dsa_select(args, F, 1)); PRB(6, ph_dsa_select(args, F, 2)); PRB(7, ph_dsa_select(args, F, 0)); ph_dsa_select(args, F); SEAM(16); }
    if (IN(17)) { ph_dsa_attn(args, F, XI); SEAM(17); }
    if (IN(18)) { GEMM_BF16(ws + WS_HY, ws + WS_WOUTO, 2048, 2048, ws + WS_Z, 2048); SEAM(18); }
    if (IN(19)) { ph_ln_mixer(args, F, 1); SEAM(19); }
    if (IN(20)) { GEMM_BF16(ws + WS_HY, ws + WS_WQ1, 2048, 2048, ws + WS_Z, 2048); SEAM(20); }
    if (IN(21)) { PRB(4, ph_peer_select(args, F, 1)); ph_peer_select(args, F, 1); SEAM(21); }
    if (IN(22)) { ph_peer_u(args, F, XI); xcd_barrier(bar); ph_peer_act(args, F); xcd_barrier(bar); ph_peer_v(args, F, XI); xcd_barrier(bar); ph_peer_ln(args, F, 1); }
#undef IN
#undef SEAM
#undef GEMM_BF16
}

#ifndef MK_SPLIT
#define MK_SPLIT 0
#endif
extern "C" void kernel_launch(void* const* d_in, const int* in_sizes, int n_in, void* d_out, int out_size, void* d_ws, size_t ws_size, hipStream_t stream) {
    static int grid = 0;
    if (grid == 0) {
        int dev = 0, cus = 0;
        if (n_in != 27 || out_size != TOK * DM || ws_size < WS_END) { fprintf(stderr, "kernel_launch: unexpected shapes (n_in %d out %d ws %zu)\n", n_in, out_size, ws_size); grid = -1; return; }
        if (hipGetDevice(&dev) != hipSuccess || hipDeviceGetAttribute(&cus, hipDeviceAttributeMultiprocessorCount, dev) != hipSuccess) { grid = -1; return; }
        if (hipFuncSetAttribute((const void*)mk_fwd, hipFuncAttributeMaxDynamicSharedMemorySize, LDS_BYTES) != hipSuccess) { fprintf(stderr, "kernel_launch: hipFuncSetAttribute failed\n"); grid = -1; return; }
        int per_cu = 0;
        if (hipOccupancyMaxActiveBlocksPerMultiprocessor(&per_cu, (const void*)mk_fwd, NTHREADS, LDS_BYTES) != hipSuccess || per_cu < 1) fprintf(stderr, "kernel_launch: occupancy query says %d\n", per_cu);
        (void)hipGetLastError();
        grid = cus;
    }
    if (grid < 0) return;
    (void)hipMemsetAsync((char*)d_ws + WS_CTL, 0, CTL_ZERO_BYTES, stream);
    Args a{};
    for (int i = 0; i < 27; ++i) a.in[i] = d_in[i];
    a.out = (float*)d_out; a.ws = (unsigned char*)d_ws;
#if MK_SPLIT
    for (int p = 0; p < 23; ++p) { a.ph_lo = p; a.ph_hi = p + 1; hipLaunchKernelGGL(mk_fwd, dim3(grid), dim3(NTHREADS), LDS_BYTES, stream, a); }
#else
    a.ph_lo = 0; a.ph_hi = 23;
    hipLaunchKernelGGL(mk_fwd, dim3(grid), dim3(NTHREADS), LDS_BYTES, stream, a);
#endif
}
```
